# Optimizing an MI355X kernel written in HIP

```python
import jax
import jax.numpy as jnp
from jax import lax
import numpy as np

D_MODEL = 1024
BATCH = 4
SEQ = 8192
DEPTH = 1

HEAD_DIM = 64
RWKV_WIDTH = D_MODEL // 2
RWKV_HEADS = RWKV_WIDTH // HEAD_DIM
ATTN_WIDTH = D_MODEL - RWKV_WIDTH
ATTN_HEADS = ATTN_WIDTH // HEAD_DIM
MIX_WIDTH = RWKV_WIDTH + ATTN_WIDTH
DECAY_RANK = 64
ICLR_RANK = 64
GATE_RANK = 128
RWKV_SPLITS = (RWKV_WIDTH, 2 * RWKV_WIDTH, 3 * RWKV_WIDTH, 3 * RWKV_WIDTH + DECAY_RANK, 3 * RWKV_WIDTH + DECAY_RANK + ICLR_RANK)
RWKV_COLS = 3 * RWKV_WIDTH + DECAY_RANK + ICLR_RANK + GATE_RANK
IN_COLS = RWKV_COLS + 3 * ATTN_WIDTH
DILATED_PATTERNS = ((128, 1), (512, 4), (2048, 16))
ROPE_THETA = 10000.0
PEER_HEADS = 8
PEER_N_KEYS = 128
PEER_N_EXPERTS = PEER_N_KEYS * PEER_N_KEYS
PEER_QUERY_DIM = 256
PEER_SUBKEY_DIM = PEER_QUERY_DIM // 2
PEER_TOPK = 16
PEER_TOKEN_BLOCK = 128
RMS_EPS = 1e-6
GN_EPS = 64e-5

kernel_name = 'hybrid_rwkv7_dilated_attn_peer'


def rms_norm(x, g):
    xf = x.astype(jnp.float32)
    y = xf * lax.rsqrt(jnp.mean(xf * xf, axis=-1, keepdims=True) + RMS_EPS)
    return (y * g.astype(jnp.float32)).astype(x.dtype)


def rope(x):
    s, dh = x.shape[1], x.shape[-1]
    inv_freq = ROPE_THETA ** (-jnp.arange(0, dh, 2, dtype=jnp.float32) / dh)
    ang = jnp.arange(s, dtype=jnp.float32)[:, None] * inv_freq[None, :]
    cos = jnp.cos(ang)[None, :, None, :]
    sin = jnp.sin(ang)[None, :, None, :]
    xf = x.astype(jnp.float32)
    x1, x2 = xf[..., : dh // 2], xf[..., dh // 2:]
    return jnp.concatenate([x1 * cos - x2 * sin, x1 * sin + x2 * cos], axis=-1).astype(x.dtype)


def rwkv7_time_mix(z, mu, w0, w_up, a0, a_up, g_up, k_k, k_a, r_k, gn_w, gn_b):
    f32 = jnp.float32
    b, s, _ = z.shape
    zf = z.astype(f32)
    z_prev = jnp.pad(zf, ((0, 0), (1, 0), (0, 0)))[:, :-1]
    zm = zf + (z_prev - zf) * mu.astype(f32)
    r, k, v, wd, ad, gd = jnp.split(zm, RWKV_SPLITS, axis=-1)
    w_log = -jax.nn.softplus(-(w0.astype(f32) + jnp.tanh(wd) @ w_up.astype(f32))) - 0.5
    decay = jnp.exp(-jnp.exp(w_log))
    a = jax.nn.sigmoid(a0.astype(f32) + ad @ a_up.astype(f32))
    g = jax.nn.sigmoid(gd) @ g_up.astype(f32)

    def heads(t):
        return t.reshape(b, s, RWKV_HEADS, HEAD_DIM)

    kk = heads(k * k_k.astype(f32))
    kk = kk / jnp.maximum(jnp.sqrt(jnp.sum(kk * kk, axis=-1, keepdims=True)), 1e-12)
    k = k * (1.0 + (a - 1.0) * k_a.astype(f32))
    r_h, k_h, v_h, w_h, a_h = heads(r), heads(k), heads(v), heads(decay), heads(a)

    def step(state, inp):
        r_t, w_t, k_t, v_t, a_t, b_t = inp
        sa = jnp.einsum('bhij,bhj->bhi', state, a_t)
        state = (state * w_t[:, :, None, :] + sa[..., None] * b_t[:, :, None, :]
                 + v_t[..., None] * k_t[:, :, None, :])
        return state, jnp.einsum('bhij,bhj->bhi', state, r_t)

    xs = tuple(jnp.moveaxis(t, 1, 0) for t in (r_h, w_h, k_h, v_h, -kk, kk * a_h))
    state0 = jnp.zeros((b, RWKV_HEADS, HEAD_DIM, HEAD_DIM), f32)
    _, y = lax.scan(step, state0, xs)
    y = jnp.moveaxis(y, 0, 1)
    mean = jnp.mean(y, axis=-1, keepdims=True)
    var = jnp.mean(jnp.square(y - mean), axis=-1, keepdims=True)
    y = ((y - mean) * lax.rsqrt(var + GN_EPS)).reshape(b, s, RWKV_WIDTH) * gn_w.astype(f32) + gn_b.astype(f32)
    bonus = jnp.sum(r_h * k_h * r_k.astype(f32), axis=-1, keepdims=True) * v_h
    return ((y + bonus.reshape(b, s, RWKV_WIDTH)) * g).astype(z.dtype)


def dilated_window_partial(q, k, v, window, dilation):
    f32 = jnp.float32
    b, s, h, dh = q.shape
    n = window // dilation
    span = dilation * n
    sp = -(-s // span) * span
    nb = sp // span

    def to_blocks(t):
        t = jnp.pad(t.astype(f32), ((0, 0), (0, sp - s), (0, 0), (0, 0)))
        t = jnp.moveaxis(t.reshape(b, sp // dilation, dilation, h, dh), 2, 1)
        return t.reshape(b, dilation, nb, n, h, dh)

    def with_prev(t):
        prev = jnp.pad(t, ((0, 0), (0, 0), (1, 0), (0, 0), (0, 0), (0, 0)))[:, :, :-1]
        return jnp.concatenate([prev, t], axis=3)

    qb = to_blocks(q)
    kw = with_prev(to_blocks(k))
    vw = with_prev(to_blocks(v))
    scores = jnp.einsum('brnqhd,brnkhd->brnhqk', qb, kw) * (dh ** -0.5)
    qi = jnp.arange(n)[:, None]
    ki = jnp.arange(2 * n)[None, :]
    dist = n + qi - ki
    band = (dist >= 0) & (dist <= n)
    valid = band[None] & ((jnp.arange(nb)[:, None, None] > 0) | (ki[None] >= n))
    scores = jnp.where(valid[None, None, :, None], scores, -jnp.inf)
    m = jnp.max(scores, axis=-1)
    p = jnp.exp(scores - m[..., None])
    l = jnp.sum(p, axis=-1)
    num = jnp.einsum('brnhqk,brnkhd->brnqhd', p, vw)

    def from_blocks(t):
        rest = t.shape[4:]
        t = jnp.moveaxis(t.reshape(b, dilation, sp // dilation, *rest), 1, 2)
        return t.reshape(b, sp, *rest)[:, :s]

    return from_blocks(num), from_blocks(jnp.moveaxis(m, 3, 4)), from_blocks(jnp.moveaxis(l, 3, 4))


def dilated_mixture_attention(z):
    b, s, _ = z.shape
    q, k, v = jnp.split(z, 3, axis=-1)
    q = rope(q.reshape(b, s, ATTN_HEADS, HEAD_DIM))
    k = rope(k.reshape(b, s, ATTN_HEADS, HEAD_DIM))
    v = v.reshape(b, s, ATTN_HEADS, HEAD_DIM)
    parts = [dilated_window_partial(q, k, v, w, d) for (w, d) in DILATED_PATTERNS]
    m_all = jnp.stack([p[1] for p in parts])
    wts = jnp.exp(m_all - jnp.max(m_all, axis=0))
    num = sum(p[0] * wts[i][..., None] for i, p in enumerate(parts))
    den = sum(p[2] * wts[i] for i, p in enumerate(parts))
    return (num / den[..., None]).reshape(b, s, ATTN_WIDTH).astype(z.dtype)


def peer_ffn(x, w_q, sub_keys, u_tab, v_tab):
    f32 = jnp.float32
    b, s, d = x.shape
    q = jnp.einsum('bsd,dq->bsq', x, w_q).reshape(b, s, PEER_HEADS, 2, PEER_SUBKEY_DIM)
    scores = jnp.einsum('bshcq,ckq->bshck', q.astype(f32), sub_keys.astype(f32))
    top_s, top_i = lax.top_k(scores, PEER_TOPK)
    cand_s = (top_s[..., 0, :, None] + top_s[..., 1, None, :]).reshape(b, s, PEER_HEADS, PEER_TOPK * PEER_TOPK)
    cand_i = (top_i[..., 0, :, None] * PEER_N_KEYS + top_i[..., 1, None, :]).reshape(b, s, PEER_HEADS, PEER_TOPK * PEER_TOPK)
    best_s, pos = lax.top_k(cand_s, PEER_TOPK)
    expert = jnp.take_along_axis(cand_i, pos, axis=-1)
    gate = jax.nn.softmax(best_s, axis=-1).astype(x.dtype)
    t = b * s
    nblk = t // PEER_TOKEN_BLOCK
    xb = x.reshape(nblk, PEER_TOKEN_BLOCK, d)
    eb = expert.reshape(nblk, PEER_TOKEN_BLOCK, PEER_HEADS, PEER_TOPK)
    gb = gate.reshape(nblk, PEER_TOKEN_BLOCK, PEER_HEADS, PEER_TOPK)

    def eval_block(args):
        xc, ec, gc = args
        u = u_tab[ec]
        act = jax.nn.gelu(jnp.einsum('cd,chkd->chk', xc, u), approximate=False)
        return jnp.einsum('chk,chkd->cd', act * gc, v_tab[ec])

    y = lax.map(eval_block, (xb, eb, gb))
    return y.reshape(b, s, d)


def setup_inputs(seed: int = 0) -> dict:
    key = jax.random.key(seed)
    ks = jax.random.split(key, 22)
    L, D = DEPTH, D_MODEL
    f32 = jnp.float32

    def nrm(k, shape, scale):
        return jax.random.normal(k, shape, f32) * scale

    return {
        'x': nrm(ks[0], (BATCH, SEQ, D), 1.0),
        'norm_mix': 1.0 + nrm(ks[1], (L, D), 0.02),
        'w_in': nrm(ks[2], (L, D, IN_COLS), D ** -0.5),
        'rwkv_mu': jax.random.uniform(ks[3], (L, RWKV_COLS), f32),
        'rwkv_w0': jax.random.uniform(ks[4], (L, RWKV_WIDTH), f32, -6.0, -1.0),
        'rwkv_w_up': nrm(ks[5], (L, DECAY_RANK, RWKV_WIDTH), 0.1),
        'rwkv_a0': nrm(ks[6], (L, RWKV_WIDTH), 0.1),
        'rwkv_a_up': nrm(ks[7], (L, ICLR_RANK, RWKV_WIDTH), 0.5 * ICLR_RANK ** -0.5),
        'rwkv_g_up': nrm(ks[8], (L, GATE_RANK, RWKV_WIDTH), GATE_RANK ** -0.5),
        'rwkv_k_k': 0.85 + nrm(ks[9], (L, RWKV_WIDTH), 0.02),
        'rwkv_k_a': 1.0 + nrm(ks[10], (L, RWKV_WIDTH), 0.02),
        'rwkv_r_k': nrm(ks[11], (L, RWKV_HEADS, HEAD_DIM), 0.1),
        'rwkv_gn_w': 1.0 + nrm(ks[12], (L, RWKV_WIDTH), 0.02),
        'rwkv_gn_b': nrm(ks[13], (L, RWKV_WIDTH), 0.02),
        'w_out': nrm(ks[14], (L, MIX_WIDTH, D), MIX_WIDTH ** -0.5),
        'norm_ffn': 1.0 + nrm(ks[15], (L, D), 0.02),
        'peer_w_q': nrm(ks[16], (L, D, PEER_HEADS * PEER_QUERY_DIM), D ** -0.5),
        'peer_sub_keys': nrm(ks[17], (L, 2, PEER_N_KEYS, PEER_SUBKEY_DIM), PEER_SUBKEY_DIM ** -0.5),
        'peer_u': nrm(ks[18], (L, PEER_N_EXPERTS, D), D ** -0.5),
        'peer_v': nrm(ks[19], (L, PEER_N_EXPERTS, D), 0.5),
        'norm_final': 1.0 + nrm(ks[20], (D,), 0.02),
    }


def reference(x, norm_mix, w_in, rwkv_mu, rwkv_w0, rwkv_w_up, rwkv_a0, rwkv_a_up, rwkv_g_up,
              rwkv_k_k, rwkv_k_a, rwkv_r_k, rwkv_gn_w, rwkv_gn_b, w_out, norm_ffn,
              peer_w_q, peer_sub_keys, peer_u, peer_v, norm_final):
    h = x
    for layer in range(DEPTH):
        xn = rms_norm(h, norm_mix[layer])
        z = jnp.einsum('bsd,dc->bsc', xn, w_in[layer])
        y_rwkv = rwkv7_time_mix(z[..., :RWKV_COLS], rwkv_mu[layer], rwkv_w0[layer], rwkv_w_up[layer],
                                rwkv_a0[layer], rwkv_a_up[layer], rwkv_g_up[layer], rwkv_k_k[layer],
                                rwkv_k_a[layer], rwkv_r_k[layer], rwkv_gn_w[layer], rwkv_gn_b[layer])
        y_attn = dilated_mixture_attention(z[..., RWKV_COLS:])
        mixed = jnp.concatenate([y_rwkv, y_attn], axis=-1)
        h = h + jnp.einsum('bsm,md->bsd', mixed, w_out[layer])
        h = h + peer_ffn(rms_norm(h, norm_ffn[layer]), peer_w_q[layer], peer_sub_keys[layer],
                         peer_u[layer], peer_v[layer])
    return rms_norm(h, norm_final)
```

```cpp
#include <hip/hip_runtime.h>
#include <cstdio>
#include <cstdint>

#ifndef MK_N_LAUNCHES
#define MK_N_LAUNCHES 9
#endif

#define GAS __attribute__((address_space(1)))
#define LAS __attribute__((address_space(3)))
typedef unsigned short bf16;
typedef unsigned v4u __attribute__((ext_vector_type(4)));
typedef unsigned v2u __attribute__((ext_vector_type(2)));
typedef float f32x4 __attribute__((ext_vector_type(4)));
typedef float f32x2 __attribute__((ext_vector_type(2)));
typedef short bf16x8 __attribute__((ext_vector_type(8)));
typedef GAS unsigned gu32;
#define RLX_AGENT __ATOMIC_RELAXED, __HIP_MEMORY_SCOPE_AGENT
#define LDS_WAIT() asm volatile("s_waitcnt lgkmcnt(0)" ::: "memory")
#define VM_WAIT() asm volatile("s_waitcnt vmcnt(0)" ::: "memory")

constexpr int DM = 1024, NB = 4, SEQ = 8192, T = NB * SEQ;
constexpr int HD = 64, RWW = 512, NHR = 8, NHA = 8;
constexpr int IN_COLS = 3328;
constexpr int C_R = 0, C_K = 512, C_V = 1024, C_WD = 1536, C_AD = 1600, C_GD = 1664, C_AQ = 1792, C_AK = 2304, C_AV = 2816;
constexpr int PHEADS = 8, NKEYS = 128, PQ = 2048, TOPK = 16, NEXP = 16384;
constexpr float RMS_EPS = 1e-6f, GN_EPS = 64e-5f;
constexpr int NWAVES = 8, NTHREADS = 512;
constexpr int NPHASE = 9;

constexpr size_t MiB = 1u << 20;
constexpr size_t WS_CTL = 0, CTL_ZERO_BYTES = 1 * MiB;
constexpr size_t WS_WIN = 2 * MiB;
constexpr size_t WS_WOUT = 10 * MiB;
constexpr size_t WS_WQ = 12 * MiB;
constexpr size_t WS_XN = 16 * MiB;
constexpr size_t WS_Z = 80 * MiB;
constexpr size_t WS_QP = 80 * MiB;
constexpr size_t WS_G = 288 * MiB;
constexpr size_t WS_YMIX = 352 * MiB;
constexpr size_t WS_UB = 416 * MiB;
constexpr size_t WS_VB = 448 * MiB;
constexpr size_t WS_EID = 480 * MiB;
constexpr size_t WS_GATE = 496 * MiB;
constexpr size_t WS_END = 512 * MiB;

constexpr int CW_BAR = 4096;

__device__ __forceinline__ unsigned f2bf(float f) { unsigned u = __builtin_bit_cast(unsigned, f); return (u + 0x7fffu + ((u >> 16) & 1u)) >> 16; }
__device__ __forceinline__ unsigned pk2(float lo, float hi) { return f2bf(lo) | (f2bf(hi) << 16); }
__device__ __forceinline__ float bflo(unsigned u) { return __builtin_bit_cast(float, u << 16); }
__device__ __forceinline__ float bfhi(unsigned u) { return __builtin_bit_cast(float, u & 0xffff0000u); }
__device__ __forceinline__ float bf2f(bf16 h) { return __builtin_bit_cast(float, (unsigned)h << 16); }

template <int CTRL> __device__ __forceinline__ float dppf(float x) { return __builtin_bit_cast(float, __builtin_amdgcn_update_dpp(0, __builtin_bit_cast(int, x), CTRL, 0xF, 0xF, true)); }
template <int CTRL> __device__ __forceinline__ int dppi(int x) { return __builtin_amdgcn_update_dpp(0, x, CTRL, 0xF, 0xF, true); }
__device__ __forceinline__ float rdlane(float v, int l) { return __builtin_bit_cast(float, __builtin_amdgcn_readlane(__builtin_bit_cast(int, v), l)); }
__device__ __forceinline__ float sum8(float v) { v += dppf<0xB1>(v); v += dppf<0x4E>(v); v += dppf<0x141>(v); return v; }
__device__ __forceinline__ float sum16(float v) { v = sum8(v); v += dppf<0x140>(v); return v; }
__device__ __forceinline__ float wave_sum(float v) { v = sum16(v); return (rdlane(v, 0) + rdlane(v, 16)) + (rdlane(v, 32) + rdlane(v, 48)); }
__device__ __forceinline__ float wave_max(float v) {
    v = fmaxf(v, dppf<0xB1>(v)); v = fmaxf(v, dppf<0x4E>(v)); v = fmaxf(v, dppf<0x141>(v)); v = fmaxf(v, dppf<0x140>(v));
    return fmaxf(fmaxf(rdlane(v, 0), rdlane(v, 16)), fmaxf(rdlane(v, 32), rdlane(v, 48)));
}
__device__ __forceinline__ int wave_min_i(int v) {
    v = min(v, dppi<0xB1>(v)); v = min(v, dppi<0x4E>(v)); v = min(v, dppi<0x141>(v)); v = min(v, dppi<0x140>(v));
    return min(min(__builtin_amdgcn_readlane(v, 0), __builtin_amdgcn_readlane(v, 16)), min(__builtin_amdgcn_readlane(v, 32), __builtin_amdgcn_readlane(v, 48)));
}

namespace pg8 {
#define PG8_LAS __attribute__((address_space(3)))
typedef unsigned short bf16_t;
typedef unsigned u32x4 __attribute__((ext_vector_type(4)));
constexpr int BM = 256, BK = 64, HALF = 128, HTB = HALF * BK * 2, STAGE_BYTES = 8 * HTB, NXCD = 8, WGM = 8;
__host__ __device__ __forceinline__ int lds_byte(int r, int c) { const int st = (r >> 4) * 2 + (c >> 5), rr = r & 15, cc = c & 31, ob = rr * 64 + cc * 2; return st * 1024 + (ob ^ (((ob >> 9) & 1) << 5)); }
__host__ __device__ __forceinline__ void stage_rc(int b, int& R, int& C) { const int st = b / 1024, sb = b % 1024, swz = sb ^ (((sb >> 9) & 1) << 5); R = (st >> 1) * 16 + swz / 64; C = (st & 1) * 32 + (swz % 64) / 2; }
__host__ __device__ __forceinline__ int perm32(int rho) { const int n = rho >> 4, i = rho & 15; return 8 * (i >> 2) + 4 * n + (i & 3); }
struct Unit { int pm, pn; };
struct Gemm { const bf16_t* A; const bf16_t* Bt; int M, N, K; };
struct StaticOrder {
    int nM, nN, nwg, G, c;
    __host__ __device__ void init(int M, int N, int G_, int c_) { nM = M / BM; nN = N / BM; nwg = nM * nN; G = G_; c = c_; }
    __host__ __device__ bool next(int i, Unit& u) const {
        const long L = (long)i * G + c; if (L >= nwg) return false;
        int wgid = (int)L; { const int q = nwg / NXCD, r = nwg % NXCD, xcd = wgid % NXCD, off = wgid / NXCD; wgid = (xcd < r ? xcd * (q + 1) : r * (q + 1) + (xcd - r) * q) + off; }
        const int nig = WGM * nN, gid = wgid / nig, fm = gid * WGM, gsz = (nM - fm) < WGM ? (nM - fm) : WGM;
        u.pm = fm + ((wgid % nig) % gsz); u.pn = (wgid % nig) / gsz; return true;
    }
    __device__ __forceinline__ void a_ready(const Unit&) const {}
    __device__ __forceinline__ void done(const Unit&) const {}
};
__device__ __forceinline__ unsigned cvt_pk_bf16(float lo, float hi) { unsigned r; asm volatile("v_cvt_pk_bf16_f32 %0, %1, %2" : "=v"(r) : "v"(lo), "v"(hi)); return r; }
struct EpiBf16 {
    static constexpr bool PERM = true, AFTER_DRAIN = false;
    bf16_t* O; int ldc;
    __device__ __forceinline__ void operator()(const f32x4 (&acc)[2][2][4][2], const Unit& u, int wr, int wc, int fr, int fq) const {
        const int row0 = u.pm * BM + wr * 64 + fr; const int col0 = u.pn * BM + wc * 32 + 8 * fq;
#pragma unroll
        for (int ai = 0; ai < 2; ++ai)
#pragma unroll
            for (int m = 0; m < 4; ++m) { bf16_t* rowp = O + (size_t)(row0 + ai * HALF + m * 16) * ldc + col0;
#pragma unroll
                for (int bj = 0; bj < 2; ++bj) { const f32x4 v0 = acc[ai][bj][m][0], v1 = acc[ai][bj][m][1];
                    u32x4 w; w.x = cvt_pk_bf16(v0[0], v0[1]); w.y = cvt_pk_bf16(v0[2], v0[3]); w.z = cvt_pk_bf16(v1[0], v1[1]); w.w = cvt_pk_bf16(v1[2], v1[3]);
                    *(u32x4*)(rowp + bj * HALF) = w; } }
    }
};
struct EpiF32Res {
    static constexpr bool PERM = true, AFTER_DRAIN = false;
    const float* res; float* O; int ldc;
    __device__ __forceinline__ void operator()(const f32x4 (&acc)[2][2][4][2], const Unit& u, int wr, int wc, int fr, int fq) const {
        const int row0 = u.pm * BM + wr * 64 + fr; const int col0 = u.pn * BM + wc * 32 + 8 * fq;
#pragma unroll
        for (int ai = 0; ai < 2; ++ai)
#pragma unroll
            for (int m = 0; m < 4; ++m) { const size_t off = (size_t)(row0 + ai * HALF + m * 16) * ldc + col0;
#pragma unroll
                for (int bj = 0; bj < 2; ++bj) { const f32x4 r0 = *(const f32x4*)(res + off + bj * HALF), r1 = *(const f32x4*)(res + off + bj * HALF + 4);
                    *(f32x4*)(O + off + bj * HALF) = acc[ai][bj][m][0] + r0; *(f32x4*)(O + off + bj * HALF + 4) = acc[ai][bj][m][1] + r1; } }
    }
};

template <class Epi, class Sched, bool ALIGN_EPI = false, bool SP2 = false>
__device__ __forceinline__ void gemm_phase(PG8_LAS unsigned char* lds, const Gemm g, const Sched& S, const Epi& E) {
    const int tid = threadIdx.x, wid = __builtin_amdgcn_readfirstlane(tid >> 6), lane = tid & 63, wr = wid >> 2, wc = wid & 3, fr = lane & 15, fq = lane >> 4;
    const int K = g.K, nt = K / BK;
    unsigned voffA[2], voffB[2];
#pragma unroll
    for (int i = 0; i < 2; ++i) { int R, C; stage_rc(tid * 16 + i * 8192, R, C); const int Rb = Epi::PERM ? ((R & ~31) + perm32(R & 31)) : R;
        voffA[i] = (unsigned)(R * K + C) * 2u; voffB[i] = (unsigned)(Rb * K + C) * 2u; }
    const size_t kstep = (size_t)(BK * 2);
    const size_t hstep = (size_t)HALF * K * 2;
    const size_t tstep = 2 * hstep;
    const unsigned ldsw = (unsigned)wid * 1024u;
    const int aoff = lds_byte(wr * 64 + fr, fq * 8), boff = lds_byte(wc * 32 + fr, fq * 8);
#define PG8_SA(b, h) (((b) * 2 + (h)) * HTB)
#define PG8_SB(b, h) ((4 + (b) * 2 + (h)) * HTB)
#define PG8_STAGE(bufoff, gbase, voff) do { _Pragma("unroll") for (int _i = 0; _i < 2; ++_i) \
        __builtin_amdgcn_global_load_lds((const unsigned*)((const char*)(gbase) + (voff)[_i]), (PG8_LAS unsigned*)(lds + (bufoff) + ldsw + _i * 8192), 16, 0, 0); } while (0)
#define PG8_LDA(dst, b, h) do { _Pragma("unroll") for (int m = 0; m < 4; ++m) _Pragma("unroll") for (int k = 0; k < 2; ++k) dst[m][k] = *(const PG8_LAS bf16x8*)(lds + PG8_SA(b, h) + aoff + m * 2048 + k * 1024); } while (0)
#define PG8_LDB(dst, b, h) do { _Pragma("unroll") for (int n = 0; n < 2; ++n) _Pragma("unroll") for (int k = 0; k < 2; ++k) dst[n][k] = *(const PG8_LAS bf16x8*)(lds + PG8_SB(b, h) + boff + n * 2048 + k * 1024); } while (0)
#define PG8_MMA(ai, bj, At, Bt) do { __builtin_amdgcn_s_setprio(1); _Pragma("unroll") for (int m = 0; m < 4; ++m) _Pragma("unroll") for (int n = 0; n < 2; ++n) _Pragma("unroll") for (int k = 0; k < 2; ++k) \
        acc[ai][bj][m][n] = __builtin_amdgcn_mfma_f32_16x16x32_bf16(Bt[n][k], At[m][k], acc[ai][bj][m][n], 0, 0, 0); __builtin_amdgcn_s_setprio(0); } while (0)
#define PG8_WAIT_V(n) asm volatile("s_waitcnt vmcnt(" #n ")" ::: "memory")
#define PG8_WAIT_L(n) asm volatile("s_waitcnt lgkmcnt(" #n ")" ::: "memory")
#define PG8_BAR __builtin_amdgcn_s_barrier()
#define PG8_SCHED __builtin_amdgcn_sched_barrier(0)
    Unit cur, nxt; int ui = 0;
    if (!S.next(0, cur)) return;
    f32x4 acc[2][2][4][2];
#pragma unroll
    for (int a = 0; a < 2; ++a)
#pragma unroll
        for (int b = 0; b < 2; ++b)
#pragma unroll
            for (int m = 0; m < 4; ++m)
#pragma unroll
                for (int n = 0; n < 2; ++n) acc[a][b][m][n] = (f32x4){0.f, 0.f, 0.f, 0.f};
    bf16x8 At[4][2], B0[2][2], B1[2][2];
    const char* cA = (const char*)g.A + (size_t)cur.pm * tstep; const char* cB = (const char*)g.Bt + (size_t)cur.pn * tstep;
    S.a_ready(cur);
    if constexpr (SP2) {
        PG8_STAGE(PG8_SB(0, 0), cB, voffB); PG8_STAGE(PG8_SB(0, 1), cB + hstep, voffB); PG8_STAGE(PG8_SA(0, 0), cA, voffA); PG8_STAGE(PG8_SA(0, 1), cA + hstep, voffA);
        if (wr == 1) PG8_BAR;
        PG8_WAIT_V(2); PG8_BAR;
        PG8_STAGE(PG8_SB(1, 0), cB + kstep, voffB); PG8_STAGE(PG8_SA(1, 0), cA + kstep, voffA); PG8_STAGE(PG8_SB(1, 1), cB + hstep + kstep, voffB);
        PG8_WAIT_V(6); PG8_BAR;
    } else {
        PG8_STAGE(PG8_SB(0, 0), cB, voffB); PG8_STAGE(PG8_SA(0, 0), cA, voffA); PG8_STAGE(PG8_SB(0, 1), cB + hstep, voffB); PG8_STAGE(PG8_SA(0, 1), cA + hstep, voffA);
        if (wr == 1) PG8_BAR;
        PG8_WAIT_V(4); PG8_BAR;
        PG8_STAGE(PG8_SB(1, 0), cB + kstep, voffB); PG8_STAGE(PG8_SA(1, 0), cA + kstep, voffA); PG8_STAGE(PG8_SB(1, 1), cB + hstep + kstep, voffB);
        PG8_WAIT_V(6); PG8_BAR;
    }
    for (;;) {
        const bool has_next = S.next(ui + 1, nxt);
        const char* nA = has_next ? (const char*)g.A + (size_t)nxt.pm * tstep : cA; const char* nB = has_next ? (const char*)g.Bt + (size_t)nxt.pn * tstep : cB;
        for (int t = 0; t < nt; t += 2) {
            const bool last = (t == nt - 2);
            const char* a1 = cA + (size_t)(t + 1) * kstep;
            const char* a2 = last ? nA : cA + (size_t)(t + 2) * kstep; const char* b2 = last ? nB : cB + (size_t)(t + 2) * kstep;
            const char* a3 = a2 + kstep; const char* b3 = b2 + kstep;
            if (last && has_next) S.a_ready(nxt);
            if constexpr (SP2) {
            PG8_LDB(B0, 0, 0); PG8_LDB(B1, 0, 1); PG8_SCHED; PG8_LDA(At, 0, 0); PG8_STAGE(PG8_SA(1, 1), a1 + hstep, voffA);
            PG8_WAIT_V(8); PG8_WAIT_L(0); PG8_BAR; PG8_MMA(0, 0, At, B0); PG8_MMA(0, 1, At, B1); PG8_BAR; PG8_SCHED;
            PG8_LDA(At, 0, 1); PG8_STAGE(PG8_SB(0, 0), b2, voffB); PG8_STAGE(PG8_SB(0, 1), b2 + hstep, voffB); PG8_STAGE(PG8_SA(0, 0), a2, voffA);
            PG8_WAIT_V(8); PG8_WAIT_L(0); PG8_BAR; PG8_MMA(1, 0, At, B0); PG8_MMA(1, 1, At, B1); PG8_BAR; PG8_SCHED;
            PG8_LDB(B0, 1, 0); PG8_LDB(B1, 1, 1); PG8_SCHED; PG8_LDA(At, 1, 0); PG8_STAGE(PG8_SA(0, 1), a2 + hstep, voffA);
            PG8_WAIT_V(8); PG8_WAIT_L(0); PG8_BAR; PG8_MMA(0, 0, At, B0); PG8_MMA(0, 1, At, B1); PG8_BAR; PG8_SCHED;
            PG8_LDA(At, 1, 1); PG8_STAGE(PG8_SB(1, 0), b3, voffB); PG8_STAGE(PG8_SB(1, 1), b3 + hstep, voffB); PG8_STAGE(PG8_SA(1, 0), a3, voffA);
            PG8_WAIT_V(8); PG8_WAIT_L(0); PG8_BAR; PG8_MMA(1, 0, At, B0); PG8_MMA(1, 1, At, B1); PG8_BAR; PG8_SCHED;
            } else {
            PG8_LDB(B0, 0, 0); PG8_SCHED; PG8_LDA(At, 0, 0); PG8_STAGE(PG8_SA(1, 1), a1 + hstep, voffA);
            PG8_WAIT_L(8); PG8_BAR; PG8_WAIT_L(0); PG8_MMA(0, 0, At, B0); PG8_BAR; PG8_SCHED;
            PG8_LDB(B1, 0, 1); PG8_STAGE(PG8_SB(0, 0), b2, voffB);
            PG8_BAR; PG8_WAIT_L(0); PG8_MMA(0, 1, At, B1); PG8_BAR;
            PG8_LDA(At, 0, 1); PG8_STAGE(PG8_SA(0, 0), a2, voffA);
            PG8_BAR; PG8_WAIT_L(0); PG8_MMA(1, 0, At, B0); PG8_BAR; PG8_SCHED;
            PG8_STAGE(PG8_SB(0, 1), b2 + hstep, voffB);
            PG8_WAIT_V(6); PG8_BAR; PG8_MMA(1, 1, At, B1); PG8_BAR;
            PG8_LDB(B0, 1, 0); PG8_SCHED; PG8_LDA(At, 1, 0); PG8_STAGE(PG8_SA(0, 1), a2 + hstep, voffA);
            PG8_WAIT_L(8); PG8_BAR; PG8_WAIT_L(0); PG8_MMA(0, 0, At, B0); PG8_BAR; PG8_SCHED;
            PG8_LDB(B1, 1, 1); PG8_STAGE(PG8_SB(1, 0), b3, voffB);
            PG8_BAR; PG8_WAIT_L(0); PG8_MMA(0, 1, At, B1); PG8_BAR;
            PG8_LDA(At, 1, 1); PG8_STAGE(PG8_SA(1, 0), a3, voffA);
            PG8_BAR; PG8_WAIT_L(0); PG8_MMA(1, 0, At, B0); PG8_BAR; PG8_SCHED;
            PG8_STAGE(PG8_SB(1, 1), b3 + hstep, voffB);
            PG8_WAIT_V(6); PG8_BAR; PG8_MMA(1, 1, At, B1); PG8_BAR;
            }
        }
        if constexpr (ALIGN_EPI) { if (wr == 0) PG8_BAR; }
        if constexpr (!Epi::AFTER_DRAIN) { E(acc, cur, wr, wc, fr, fq); S.done(cur); }
        if (!has_next) break;
#pragma unroll
        for (int a = 0; a < 2; ++a)
#pragma unroll
            for (int b = 0; b < 2; ++b)
#pragma unroll
                for (int m = 0; m < 4; ++m)
#pragma unroll
                    for (int n = 0; n < 2; ++n) acc[a][b][m][n] = (f32x4){0.f, 0.f, 0.f, 0.f};
        cur = nxt; cA = nA; cB = nB; ++ui;
        if constexpr (ALIGN_EPI) { if (wr == 1) PG8_BAR; }
    }
    PG8_WAIT_V(0);
    if constexpr (!ALIGN_EPI) { if (wr == 0) PG8_BAR; }
    PG8_BAR;
#undef PG8_SA
#undef PG8_SB
#undef PG8_STAGE
#undef PG8_LDA
#undef PG8_LDB
#undef PG8_MMA
#undef PG8_WAIT_V
#undef PG8_WAIT_L
#undef PG8_BAR
#undef PG8_SCHED
}
}

#define XB_TMO      128
#define XB_XCNT(j)  (256  + 64 * (j))
#define XB_XSUB(j)  (1280 + 64 * (j))
#define XB_XGEN(j)  (2304 + 64 * (j))
#define XB_TOP      3328
#define XB_TOPGEN   3392
#define XCD_BAR_WORDS 3456
#define XB_SPIN_CAP (1u << 22)
__device__ __forceinline__ unsigned xb_ld(unsigned* p)              { return __hip_atomic_load(p, __ATOMIC_RELAXED, __HIP_MEMORY_SCOPE_AGENT); }
__device__ __forceinline__ unsigned xb_add(unsigned* p, unsigned v) { return __hip_atomic_fetch_add(p, v, __ATOMIC_RELAXED, __HIP_MEMORY_SCOPE_AGENT); }
__device__ __forceinline__ unsigned xb_xcc_id() { return (unsigned)__builtin_amdgcn_s_getreg((3 << 11) | 20) & 0xFu; }
#define XB_SPIN(cond, bar) do { unsigned _sp = 0; while (cond) { __builtin_amdgcn_s_sleep(1); \
    if ((++_sp & 255u) == 0u) { if (xb_ld(&(bar)[XB_TMO])) break; if (_sp > XB_SPIN_CAP) { atomicAdd(&(bar)[XB_TMO], 1u); break; } } } } while (0)
struct XcdBarrier { unsigned* bar; unsigned x; volatile LAS unsigned* st; };
__device__ __forceinline__ XcdBarrier xcd_barrier_post(unsigned* bar, volatile LAS unsigned* st) {
    XcdBarrier b; b.bar = bar; b.x = xb_xcc_id(); b.st = st;
    if (threadIdx.x == 0) (void)xb_add(&bar[XB_XCNT(b.x)], 1u);
    return b;
}
__device__ __forceinline__ void xcd_barrier_complete(unsigned* bar, unsigned x, unsigned& nloc, unsigned& nx) {
    const unsigned G = gridDim.x * gridDim.y * gridDim.z;
    unsigned sum, cnt, mine, sp = 0u;
    for (;;) {
        sum = 0u; cnt = 0u; mine = 0u;
#pragma unroll
        for (unsigned j = 0; j < 16; ++j) { const unsigned c = xb_ld(&bar[XB_XCNT(j)]); sum += c; cnt += (c > 0u) ? 1u : 0u; mine = (j == x) ? c : mine; }
        if (sum == G) break;
        __builtin_amdgcn_s_sleep(1);
        if ((++sp & 255u) == 0u) { if (xb_ld(&bar[XB_TMO])) break; if (sp > XB_SPIN_CAP) { atomicAdd(&bar[XB_TMO], 1u); break; } }
    }
    nloc = mine > 0u ? mine : 1u; nx = cnt > 0u ? cnt : 1u;
}
__device__ __forceinline__ void xcd_barrier(const XcdBarrier& b) {
    asm volatile("s_waitcnt vmcnt(0)" ::: "memory");
    __syncthreads();
    if (threadIdx.x == 0) {
        unsigned* bar = b.bar;
        __builtin_amdgcn_s_waitcnt(0);
        unsigned nloc = b.st[0], nx = b.st[1];
        if (nloc == 0u) { xcd_barrier_complete(bar, b.x, nloc, nx); b.st[0] = nloc; b.st[1] = nx; }
        const unsigned old = xb_add(&bar[XB_XSUB(b.x)], 1u);
        const unsigned gen = old / nloc;
        if (old + 1u == (gen + 1u) * nloc) {
            __builtin_amdgcn_fence(__ATOMIC_RELEASE, "agent");
            asm volatile("s_waitcnt vmcnt(0)" ::: "memory");
            const unsigned og = xb_add(&bar[XB_TOP], 1u);
            const unsigned tg = og / nx;
            if (og + 1u == (tg + 1u) * nx) xb_add(&bar[XB_TOPGEN], 1u);
            else XB_SPIN(xb_ld(&bar[XB_TOPGEN]) == tg, bar);
            __builtin_amdgcn_fence(__ATOMIC_ACQUIRE, "agent");
            xb_add(&bar[XB_XGEN(b.x)], 1u);
            asm volatile("s_waitcnt vmcnt(0)" ::: "memory");
        } else {
            XB_SPIN(xb_ld(&bar[XB_XGEN(b.x)]) == gen, bar);
            __builtin_amdgcn_fence(__ATOMIC_ACQUIRE, "agent");
            asm volatile("s_waitcnt vmcnt(0)" ::: "memory");
        }
    }
    __syncthreads();
}

constexpr int RING_OFF = 0, RING_BYTES = 131072;
constexpr int LDSCTL_OFF = RING_BYTES, MISC_OFF = LDSCTL_OFF + 320;
constexpr int LDS_BYTES = 147456;

struct Frame {
    LAS unsigned char* lds;
    volatile LAS unsigned* MISC;
    gu32* ctl;
    int tid, lane, wave, G, wg;
    const float* in[21];
    float* out;
    unsigned char* ws;
};

__device__ __forceinline__ void p0_transpose_item(const float* W, int K, int N, bf16* WT, LAS float* scr, int item, int lane) {
    const int nblk = N / 32, kb = item / nblk, nb = item % nblk, k0 = 64 * kb, n0 = 32 * nb;
#pragma unroll 8
    for (int i = 0; i < 32; ++i) { const int kk = 2 * i + (lane >> 5); scr[kk * 33 + (lane & 31)] = W[(size_t)(k0 + kk) * N + n0 + (lane & 31)]; }
    LDS_WAIT(); asm volatile("" ::: "memory");
    const int c = lane & 7;
#pragma unroll
    for (int j = 0; j < 4; ++j) { const int n = (lane >> 3) + 8 * j; const LAS float* s = scr + (8 * c) * 33 + n;
        v4u o; o.x = pk2(s[0 * 33], s[1 * 33]); o.y = pk2(s[2 * 33], s[3 * 33]); o.z = pk2(s[4 * 33], s[5 * 33]); o.w = pk2(s[6 * 33], s[7 * 33]);
        *(GAS v4u*)(WT + (size_t)(n0 + n) * K + k0 + 8 * c) = o; }
    LDS_WAIT(); asm volatile("" ::: "memory");
}
__device__ __forceinline__ void rms_row_to_bf16(int lane, const float* xrow, const float* gain, bf16* orow) {
    const GAS f32x4* xr = (const GAS f32x4*)xrow + lane;
    const GAS f32x4* gr = (const GAS f32x4*)gain + lane;
    f32x4 v[4]; float s = 0.f;
#pragma unroll
    for (int j = 0; j < 4; ++j) { v[j] = xr[64 * j]; s += (v[j].x * v[j].x + v[j].y * v[j].y) + (v[j].z * v[j].z + v[j].w * v[j].w); }
    const float rstd = 1.f / sqrtf(wave_sum(s) * (1.f / DM) + RMS_EPS);
    GAS unsigned long long* o8 = (GAS unsigned long long*)orow + lane;
#pragma unroll
    for (int j = 0; j < 4; ++j) { const f32x4 gg = gr[64 * j];
        o8[64 * j] = (unsigned long long)pk2(v[j].x * rstd * gg.x, v[j].y * rstd * gg.y) | ((unsigned long long)pk2(v[j].z * rstd * gg.z, v[j].w * rstd * gg.w) << 32); }
}
__device__ __forceinline__ void cvt_row_to_bf16(int lane, const float* xrow, bf16* orow) {
    const GAS f32x4* xr = (const GAS f32x4*)xrow + lane;
    GAS unsigned long long* o8 = (GAS unsigned long long*)orow + lane;
#pragma unroll
    for (int j = 0; j < 4; ++j) { const f32x4 v = xr[64 * j]; o8[64 * j] = (unsigned long long)pk2(v.x, v.y) | ((unsigned long long)pk2(v.z, v.w) << 32); }
}
__device__ __forceinline__ void p0_prologue(Frame& F) {
    LAS float* scr = (LAS float*)(F.lds + RING_OFF + F.wave * 16384);
    const int gw = F.wg * NWAVES + F.wave, NGW = F.G * NWAVES;
    constexpr int I_IN = (DM / 64) * (IN_COLS / 32), I_OUT = (DM / 64) * (DM / 32), I_Q = (DM / 64) * (PQ / 32);
    constexpr int NITEMS = I_IN + I_OUT + I_Q;
    bf16* win_t = (bf16*)(F.ws + WS_WIN); bf16* wout_t = (bf16*)(F.ws + WS_WOUT); bf16* wq_t = (bf16*)(F.ws + WS_WQ);
    for (int it = gw; it < NITEMS; it += NGW) {
        int r = it;
        if (r < I_IN) { p0_transpose_item(F.in[2], DM, IN_COLS, win_t, scr, r, F.lane); continue; } r -= I_IN;
        if (r < I_OUT) { p0_transpose_item(F.in[14], DM, DM, wout_t, scr, r, F.lane); continue; } r -= I_OUT;
        p0_transpose_item(F.in[16], DM, PQ, wq_t, scr, r, F.lane);
    }
    bf16* XN = (bf16*)(F.ws + WS_XN);
    for (int m = gw; m < T; m += NGW) rms_row_to_bf16(F.lane, F.in[0] + (size_t)m * DM, F.in[1], XN + (size_t)m * DM);
    bf16* UB = (bf16*)(F.ws + WS_UB); bf16* VB = (bf16*)(F.ws + WS_VB);
    for (int m = gw; m < NEXP; m += NGW) { cvt_row_to_bf16(F.lane, F.in[18] + (size_t)m * DM, UB + (size_t)m * DM); cvt_row_to_bf16(F.lane, F.in[19] + (size_t)m * DM, VB + (size_t)m * DM); }
}

__device__ __forceinline__ void p2_prep(Frame& F) {
    bf16* Z = (bf16*)(F.ws + WS_Z);
    float* E = F.out; float* A = F.out + (size_t)T * RWW; float* Gt = (float*)(F.ws + WS_G);
    const float* mu = F.in[3]; const float* w0 = F.in[4]; const float* w_up = F.in[5]; const float* a0 = F.in[6]; const float* a_up = F.in[7]; const float* g_up = F.in[8];
    LAS float* act = (LAS float*)(F.lds + RING_OFF);
    const int tid = F.tid;
    const float inv_freq = powf(10000.0f, -(float)(2 * (tid & 31)) / 64.0f);
    for (int blk = F.wg; blk < T / 16; blk += F.G) {
        const int g0 = blk * 16;
        {
            const int tok = tid >> 5, cg = tid & 31, g = g0 + tok, s = g & (SEQ - 1);
            const v4u zc = *(const GAS v4u*)(Z + (size_t)g * IN_COLS + C_WD + cg * 8);
            v4u zp = (v4u){0u, 0u, 0u, 0u};
            if (s > 0) zp = *(const GAS v4u*)(Z + (size_t)(g - 1) * IN_COLS + C_WD + cg * 8);
            float zv[8], pv[8];
            zv[0] = bflo(zc.x); zv[1] = bfhi(zc.x); zv[2] = bflo(zc.y); zv[3] = bfhi(zc.y); zv[4] = bflo(zc.z); zv[5] = bfhi(zc.z); zv[6] = bflo(zc.w); zv[7] = bfhi(zc.w);
            pv[0] = bflo(zp.x); pv[1] = bfhi(zp.x); pv[2] = bflo(zp.y); pv[3] = bfhi(zp.y); pv[4] = bflo(zp.z); pv[5] = bfhi(zp.z); pv[6] = bflo(zp.w); pv[7] = bfhi(zp.w);
#pragma unroll
            for (int j = 0; j < 8; ++j) { const int c = cg * 8 + j; const float m = mu[C_WD + c]; float v = zv[j] + (pv[j] - zv[j]) * m;
                if (c < 64) v = tanhf(v); else if (c >= 128) v = 1.f / (1.f + __expf(-v));
                act[c * 16 + tok] = v; }
        }
        __syncthreads();
        {
            const int c = tid;
            float aE[16], aA[16], aG[16];
#pragma unroll
            for (int k = 0; k < 16; ++k) { aE[k] = 0.f; aA[k] = 0.f; aG[k] = 0.f; }
            for (int m = 0; m < 64; ++m) {
                const float wv = w_up[m * RWW + c], av = a_up[m * RWW + c];
                const LAS f32x4* p1 = (const LAS f32x4*)(act + m * 16); const LAS f32x4* p2 = (const LAS f32x4*)(act + (64 + m) * 16);
#pragma unroll
                for (int q = 0; q < 4; ++q) { const f32x4 x1 = p1[q], x2 = p2[q];
#pragma unroll
                    for (int j = 0; j < 4; ++j) { aE[q * 4 + j] += x1[j] * wv; aA[q * 4 + j] += x2[j] * av; } }
            }
            for (int m = 0; m < 128; ++m) {
                const float gv = g_up[m * RWW + c];
                const LAS f32x4* p3 = (const LAS f32x4*)(act + (128 + m) * 16);
#pragma unroll
                for (int q = 0; q < 4; ++q) { const f32x4 x3 = p3[q];
#pragma unroll
                    for (int j = 0; j < 4; ++j) aG[q * 4 + j] += x3[j] * gv; }
            }
            const float w0c = w0[c], a0c = a0[c];
#pragma unroll
            for (int k = 0; k < 16; ++k) { const size_t o = (size_t)(g0 + k) * RWW + c;
                E[o] = 0.60653066f / (1.f + __expf(-(w0c + aE[k])));
                A[o] = 1.f / (1.f + __expf(-(a0c + aA[k])));
                Gt[o] = aG[k]; }
        }
        {
            const int i = tid & 31, grp = tid >> 5;
            for (int k = 0; k < 16; ++k) { const int g = g0 + k, s = g & (SEQ - 1);
                const float ang = (float)s * inv_freq;
                const double r = (double)ang - rint((double)ang * 0.15915494309189535) * 6.283185307179586;
                const float rf = (float)r; const float cs = cosf(rf), sn = sinf(rf);
                bf16* p = Z + (size_t)g * IN_COLS + C_AQ + grp * 64 + i;
                const float x1 = bf2f(p[0]), x2 = bf2f(p[32]);
                p[0] = (bf16)f2bf(x1 * cs - x2 * sn); p[32] = (bf16)f2bf(x1 * sn + x2 * cs); }
        }
        __syncthreads();
    }
}

__device__ __forceinline__ void rwkv_chain(Frame& F, int chain) {
    const int b = chain >> 3, h = chain & 7;
    const bf16* Z = (const bf16*)(F.ws + WS_Z);
    const float* E = F.out; const float* A = F.out + (size_t)T * RWW; const float* Gt = (const float*)(F.ws + WS_G);
    bf16* Y = (bf16*)(F.ws + WS_YMIX);
    const float* mu = F.in[3]; const float* k_k = F.in[9]; const float* k_a = F.in[10]; const float* r_k = F.in[11]; const float* gn_w = F.in[12]; const float* gn_b = F.in[13];
    LAS float* sR = (LAS float*)(F.lds + RING_OFF); LAS float* sW = sR + 4096; LAS float* sK = sW + 4096; LAS float* sAi = sK + 4096; LAS float* sBi = sAi + 4096; LAS float* sV = sBi + 4096; LAS float* sY = sV + 4096;
    const int tid = F.tid, c = tid & 63, w = tid >> 6, col = h * 64 + c;
    const int ri = tid >> 3, jq = tid & 7;
    const float mu_r = mu[C_R + col], mu_k = mu[C_K + col], mu_v = mu[C_V + col], kkc = k_k[col], kac = k_a[col], rkc = r_k[col], gw = gn_w[col], gb = gn_b[col];
    float st[8];
#pragma unroll
    for (int j = 0; j < 8; ++j) st[j] = 0.f;
    for (int blk = 0; blk < SEQ / 64; ++blk) {
        const int g0 = b * SEQ + blk * 64;
#pragma unroll 2
        for (int i = 0; i < 8; ++i) { const int tt = w + 8 * i, g = g0 + tt, s = blk * 64 + tt;
            const bf16* zr = Z + (size_t)g * IN_COLS + col;
            const float zr_ = bf2f(zr[C_R]), zk_ = bf2f(zr[C_K]), zv_ = bf2f(zr[C_V]);
            float pr = 0.f, pk = 0.f, pv = 0.f;
            if (s > 0) { const bf16* zq = zr - IN_COLS; pr = bf2f(zq[C_R]); pk = bf2f(zq[C_K]); pv = bf2f(zq[C_V]); }
            const float r = zr_ + (pr - zr_) * mu_r, k = zk_ + (pk - zk_) * mu_k, v = zv_ + (pv - zv_) * mu_v;
            const float e = E[(size_t)g * RWW + col], a = A[(size_t)g * RWW + col];
            float kk = k * kkc; const float n2 = wave_sum(kk * kk); kk = kk / fmaxf(sqrtf(n2), 1e-12f);
            const float k2 = k * (1.f + (a - 1.f) * kac);
            sR[tt * 64 + c] = r; sW[tt * 64 + c] = __expf(-e); sK[tt * 64 + c] = k2; sAi[tt * 64 + c] = -kk; sBi[tt * 64 + c] = kk * a; sV[tt * 64 + c] = v; }
        __syncthreads();
        for (int tt = 0; tt < 64; ++tt) {
            const LAS f32x4* pa = (const LAS f32x4*)(sAi + tt * 64 + jq * 8); const LAS f32x4* pw = (const LAS f32x4*)(sW + tt * 64 + jq * 8);
            const LAS f32x4* pb = (const LAS f32x4*)(sBi + tt * 64 + jq * 8); const LAS f32x4* pk = (const LAS f32x4*)(sK + tt * 64 + jq * 8);
            const LAS f32x4* pr = (const LAS f32x4*)(sR + tt * 64 + jq * 8);
            const f32x4 a0 = pa[0], a1 = pa[1], w0 = pw[0], w1 = pw[1], b0 = pb[0], b1 = pb[1], k0 = pk[0], k1 = pk[1], r0 = pr[0], r1 = pr[1];
            const float vi = sV[tt * 64 + ri];
            float sa = (st[0] * a0[0] + st[1] * a0[1]) + (st[2] * a0[2] + st[3] * a0[3]) + (st[4] * a1[0] + st[5] * a1[1]) + (st[6] * a1[2] + st[7] * a1[3]);
            sa = sum8(sa);
#pragma unroll
            for (int j = 0; j < 4; ++j) { st[j] = st[j] * w0[j] + sa * b0[j] + vi * k0[j]; st[4 + j] = st[4 + j] * w1[j] + sa * b1[j] + vi * k1[j]; }
            float y = (st[0] * r0[0] + st[1] * r0[1]) + (st[2] * r0[2] + st[3] * r0[3]) + (st[4] * r1[0] + st[5] * r1[1]) + (st[6] * r1[2] + st[7] * r1[3]);
            y = sum8(y);
            if (jq == 0) sY[tt * 64 + ri] = y;
        }
        __syncthreads();
#pragma unroll 2
        for (int i = 0; i < 8; ++i) { const int tt = w + 8 * i, g = g0 + tt;
            const float y = sY[tt * 64 + c];
            const float mean = wave_sum(y) * (1.f / 64.f); const float d = y - mean; const float var = wave_sum(d * d) * (1.f / 64.f);
            const float yn = d * (1.f / sqrtf(var + GN_EPS)) * gw + gb;
            const float r = sR[tt * 64 + c], k2 = sK[tt * 64 + c], v = sV[tt * 64 + c];
            const float bonus = wave_sum(r * k2 * rkc) * v;
            const float o = (yn + bonus) * Gt[(size_t)g * RWW + col];
            Y[(size_t)g * DM + col] = (bf16)f2bf(o); }
        __syncthreads();
    }
}

__device__ __forceinline__ void attn_item(Frame& F, int item) {
    const int bh = item >> 13, t = item & (SEQ - 1), b = bh >> 3, h = bh & 7, lane = F.lane;
    const bf16* Z = (const bf16*)(F.ws + WS_Z);
    bf16* Y = (bf16*)(F.ws + WS_YMIX);
    const size_t g = (size_t)b * SEQ + t;
    const GAS v4u* qp = (const GAS v4u*)(Z + g * IN_COLS + C_AQ + h * 64);
    v4u q[8];
#pragma unroll
    for (int i = 0; i < 8; ++i) q[i] = qp[i];
    float sc[7];
#pragma unroll
    for (int pass = 0; pass < 7; ++pass) {
        const int idx = lane + 64 * pass; const int p = (idx >= 258) ? 2 : (idx >= 129 ? 1 : 0); const int j = idx - p * 129; const int tk = t - (j << (2 * p));
        const bool valid = (idx < 387) && (tk >= 0); const int tkc = tk < 0 ? 0 : tk;
        const GAS v4u* kp = (const GAS v4u*)(Z + ((size_t)b * SEQ + tkc) * IN_COLS + C_AK + h * 64);
        float d = 0.f;
#pragma unroll
        for (int i = 0; i < 8; ++i) { const v4u kv = kp[i];
            d += bflo(q[i].x) * bflo(kv.x) + bfhi(q[i].x) * bfhi(kv.x); d += bflo(q[i].y) * bflo(kv.y) + bfhi(q[i].y) * bfhi(kv.y);
            d += bflo(q[i].z) * bflo(kv.z) + bfhi(q[i].z) * bfhi(kv.z); d += bflo(q[i].w) * bflo(kv.w) + bfhi(q[i].w) * bfhi(kv.w); }
        sc[pass] = valid ? d * 0.125f : -INFINITY;
    }
    float m = sc[0];
#pragma unroll
    for (int pass = 1; pass < 7; ++pass) m = fmaxf(m, sc[pass]);
    m = wave_max(m);
    float l = 0.f;
#pragma unroll
    for (int pass = 0; pass < 7; ++pass) { sc[pass] = __expf(sc[pass] - m); l += sc[pass]; }
    l = wave_sum(l);
    float acc = 0.f;
    const bf16* vbase = Z + (size_t)b * SEQ * IN_COLS + C_AV + h * 64 + lane;
#pragma unroll
    for (int pass = 0; pass < 7; ++pass) {
        const int nl = pass < 6 ? 64 : 3;
#pragma unroll 8
        for (int l2 = 0; l2 < nl; ++l2) {
            const int idx = l2 + 64 * pass; const int p = (idx >= 258) ? 2 : (idx >= 129 ? 1 : 0); const int j = idx - p * 129; const int tk = t - (j << (2 * p));
            const float pv = rdlane(sc[pass], l2);
            const int tkc = tk < 0 ? 0 : tk;
            acc += pv * bf2f(vbase[(size_t)tkc * IN_COLS]);
        }
    }
    Y[g * DM + RWW + h * 64 + lane] = (bf16)f2bf(acc / l);
}

__device__ __forceinline__ void p3_mixers(Frame& F) {
    const int nrw = (F.G >= 64) ? 32 : (F.G > 1 ? F.G / 2 : 0);
    if (F.wg < nrw || nrw == 0) {
        if (nrw == 0) { for (int ch = 0; ch < NB * NHR; ++ch) rwkv_chain(F, ch); }
        else for (int ch = F.wg; ch < NB * NHR; ch += nrw) rwkv_chain(F, ch);
        if (nrw != 0) return;
    }
    const int na = F.G - nrw, wa = F.wg - nrw;
    const int nchunks = NB * NHA * SEQ / 64;
    for (int ch = wa; ch < nchunks; ch += na)
        for (int i = 0; i < 8; ++i) attn_item(F, ch * 64 + F.wave * 8 + i);
}

__device__ __forceinline__ void p5_xn2(Frame& F) {
    const int gw = F.wg * NWAVES + F.wave, NGW = F.G * NWAVES;
    bf16* XN = (bf16*)(F.ws + WS_XN);
    for (int m = gw; m < T; m += NGW) rms_row_to_bf16(F.lane, F.out + (size_t)m * DM, F.in[15], XN + (size_t)m * DM);
}

template <int NS> __device__ __forceinline__ void wave_top16(float (&v)[NS], int lane, float& out_s, int& out_i) {
    out_s = 0.f; out_i = 0;
    for (int it = 0; it < 16; ++it) {
        float m = v[0];
#pragma unroll
        for (int s = 1; s < NS; ++s) m = fmaxf(m, v[s]);
        const float M = wave_max(m);
        int cand = 0x7fffffff;
#pragma unroll
        for (int s = NS - 1; s >= 0; --s) if (v[s] == M) cand = lane * NS + s;
        const int I = wave_min_i(cand);
        if (lane == it) { out_s = M; out_i = I; }
#pragma unroll
        for (int s = 0; s < NS; ++s) if (lane * NS + s == I) v[s] = -INFINITY;
    }
}
__device__ __forceinline__ void p7_topk(Frame& F) {
    const bf16* QP = (const bf16*)(F.ws + WS_QP);
    int* EID = (int*)(F.ws + WS_EID); float* GATE = (float*)(F.ws + WS_GATE);
    const float* sk = F.in[17];
    LAS float* SK = (LAS float*)(F.lds + RING_OFF);
    for (int e = F.tid; e < 2 * 128 * 128; e += NTHREADS) { const int c = e >> 14, k = (e >> 7) & 127, d = e & 127; SK[(c * 128 + d) * 128 + k] = sk[e]; }
    __syncthreads();
    const int lane = F.lane;
    const int gw = F.wg * NWAVES + F.wave, NGW = F.G * NWAVES;
    for (int item = gw; item < T * PHEADS; item += NGW) {
        const int t = item >> 3, h = item & 7;
        float ts[2]; int ti[2];
#pragma unroll
        for (int c = 0; c < 2; ++c) {
            const unsigned qd = *(const GAS unsigned*)(QP + (size_t)t * PQ + h * 256 + c * 128 + 2 * lane);
            const float q0 = bflo(qd), q1 = bfhi(qd);
            float s0 = 0.f, s1 = 0.f;
            const LAS f32x2* kp = (const LAS f32x2*)(SK + c * 16384) + lane;
#pragma unroll 8
            for (int d2 = 0; d2 < 64; ++d2) { const float qe = rdlane(q0, d2), qo = rdlane(q1, d2);
                const f32x2 ka = kp[(2 * d2) * 64], kb = kp[(2 * d2 + 1) * 64];
                s0 += qe * ka.x + qo * kb.x; s1 += qe * ka.y + qo * kb.y; }
            float v[2] = {s0, s1};
            wave_top16<2>(v, lane, ts[c], ti[c]);
        }
        const float a_s = __shfl(ts[0], lane >> 2); const int a_i = __shfl(ti[0], lane >> 2);
        float cv[4]; int ce[4];
#pragma unroll
        for (int s = 0; s < 4; ++s) { const int j = (lane & 3) * 4 + s; cv[s] = a_s + __shfl(ts[1], j); ce[s] = a_i * NKEYS + __shfl(ti[1], j); }
        float bs; int bi;
        wave_top16<4>(cv, lane, bs, bi);
        int eid = 0;
        { const int ol = bi >> 2, os = bi & 3;
          const int e0 = __shfl(ce[0], ol), e1 = __shfl(ce[1], ol), e2 = __shfl(ce[2], ol), e3 = __shfl(ce[3], ol);
          eid = os == 0 ? e0 : (os == 1 ? e1 : (os == 2 ? e2 : e3)); }
        const float mx = rdlane(bs, 0);
        float ex = lane < 16 ? __expf(bs - mx) : 0.f;
        const float den = wave_sum(ex);
        if (lane < 16) { EID[(size_t)t * 128 + h * 16 + lane] = eid; GATE[(size_t)t * 128 + h * 16 + lane] = ex / den; }
    }
}

__device__ __forceinline__ void unpack8(const v4u a, float* f) { f[0] = bflo(a.x); f[1] = bfhi(a.x); f[2] = bflo(a.y); f[3] = bfhi(a.y); f[4] = bflo(a.z); f[5] = bfhi(a.z); f[6] = bflo(a.w); f[7] = bfhi(a.w); }
__device__ __forceinline__ void p8_gather(Frame& F) {
    const bf16* XN = (const bf16*)(F.ws + WS_XN);
    const bf16* UB = (const bf16*)(F.ws + WS_UB); const bf16* VB = (const bf16*)(F.ws + WS_VB);
    const int* EID = (const int*)(F.ws + WS_EID); const float* GATE = (const float*)(F.ws + WS_GATE);
    const float* nf = F.in[20];
    const int lane = F.lane;
    const int gw = F.wg * NWAVES + F.wave, NGW = F.G * NWAVES;
    for (int t = gw; t < T; t += NGW) {
        float x[16];
        { const GAS v4u* xp = (const GAS v4u*)(XN + (size_t)t * DM); unpack8(xp[lane], x); unpack8(xp[64 + lane], x + 8); }
        const int e_lo = EID[(size_t)t * 128 + lane], e_hi = EID[(size_t)t * 128 + 64 + lane];
        const float g_lo = GATE[(size_t)t * 128 + lane], g_hi = GATE[(size_t)t * 128 + 64 + lane];
        float acc[16];
#pragma unroll
        for (int k = 0; k < 16; ++k) acc[k] = 0.f;
        for (int jj = 0; jj < 128; jj += 4) {
            v4u ua[4], ub[4], va[4], vb[4]; float gt[4];
#pragma unroll
            for (int u = 0; u < 4; ++u) { const int j = jj + u;
                int e = (j < 64) ? __builtin_amdgcn_readlane(e_lo, j & 63) : __builtin_amdgcn_readlane(e_hi, j & 63);
                gt[u] = (j < 64) ? rdlane(g_lo, j & 63) : rdlane(g_hi, j & 63);
                e = e & (NEXP - 1);
                const GAS v4u* up = (const GAS v4u*)(UB + (size_t)e * DM); const GAS v4u* vp = (const GAS v4u*)(VB + (size_t)e * DM);
                ua[u] = up[lane]; ub[u] = up[64 + lane]; va[u] = vp[lane]; vb[u] = vp[64 + lane]; }
#pragma unroll
            for (int u = 0; u < 4; ++u) {
                float f[16]; unpack8(ua[u], f); unpack8(ub[u], f + 8);
                float d = 0.f;
#pragma unroll
                for (int k = 0; k < 16; ++k) d += x[k] * f[k];
                d = wave_sum(d);
                const float a = 0.5f * d * (1.f + erff(d * 0.70710678118654752f)) * gt[u];
                unpack8(va[u], f); unpack8(vb[u], f + 8);
#pragma unroll
                for (int k = 0; k < 16; ++k) acc[k] += a * f[k];
            }
        }
        float* hrow = F.out + (size_t)t * DM;
        f32x4 h0 = *(const GAS f32x4*)(hrow + lane * 8), h1 = *(const GAS f32x4*)(hrow + lane * 8 + 4), h2 = *(const GAS f32x4*)(hrow + 512 + lane * 8), h3 = *(const GAS f32x4*)(hrow + 512 + lane * 8 + 4);
        float hv[16];
#pragma unroll
        for (int k = 0; k < 4; ++k) { hv[k] = h0[k] + acc[k]; hv[4 + k] = h1[k] + acc[4 + k]; hv[8 + k] = h2[k] + acc[8 + k]; hv[12 + k] = h3[k] + acc[12 + k]; }
        float ss = 0.f;
#pragma unroll
        for (int k = 0; k < 16; ++k) ss += hv[k] * hv[k];
        const float rstd = 1.f / sqrtf(wave_sum(ss) * (1.f / DM) + RMS_EPS);
        const f32x4 n0 = *(const GAS f32x4*)(nf + lane * 8), n1 = *(const GAS f32x4*)(nf + lane * 8 + 4), n2 = *(const GAS f32x4*)(nf + 512 + lane * 8), n3 = *(const GAS f32x4*)(nf + 512 + lane * 8 + 4);
        f32x4 o0, o1, o2, o3;
#pragma unroll
        for (int k = 0; k < 4; ++k) { o0[k] = hv[k] * rstd * n0[k]; o1[k] = hv[4 + k] * rstd * n1[k]; o2[k] = hv[8 + k] * rstd * n2[k]; o3[k] = hv[12 + k] * rstd * n3[k]; }
        *(GAS f32x4*)(hrow + lane * 8) = o0; *(GAS f32x4*)(hrow + lane * 8 + 4) = o1; *(GAS f32x4*)(hrow + 512 + lane * 8) = o2; *(GAS f32x4*)(hrow + 512 + lane * 8 + 4) = o3;
    }
}

struct Args { const float* in[21]; float* out; unsigned char* ws; int ph_lo, ph_hi; };
static_assert(sizeof(Args) == 21 * 8 + 8 + 8 + 8, "Args has no padding");

__global__ void __launch_bounds__(NTHREADS, 2) fwd_kernel(Args args) {
    extern __shared__ __attribute__((aligned(16))) unsigned char lds[];
    Frame F;
    F.lds = (LAS unsigned char*)lds;
    F.MISC = (volatile LAS unsigned*)(F.lds + MISC_OFF);
    F.tid = threadIdx.x; F.lane = F.tid & 63; F.wave = __builtin_amdgcn_readfirstlane(F.tid >> 6);
    F.G = gridDim.x; F.wg = blockIdx.x;
#pragma unroll
    for (int i = 0; i < 21; ++i) F.in[i] = args.in[i];
    F.out = args.out; F.ws = args.ws;
    F.ctl = (gu32*)(args.ws + WS_CTL);
    for (int u = F.tid; u < (LDS_BYTES - LDSCTL_OFF) / 4; u += NTHREADS) ((LAS unsigned*)(F.lds + LDSCTL_OFF))[u] = 0u;
    __syncthreads();
    const int lo = args.ph_lo, hi = args.ph_hi;
    const bool fused = (hi - lo) > 1;
    XcdBarrier bar; bar.bar = (unsigned*)(F.ctl + CW_BAR); bar.x = 0; bar.st = nullptr;
    if (fused) bar = xcd_barrier_post((unsigned*)(F.ctl + CW_BAR), F.MISC + 8);
#define IN(k) (lo <= (k) && (k) < hi)
#define SEAM(k) do { if (IN(k) && IN((k) + 1)) xcd_barrier(bar); } while (0)

    if (IN(0)) { p0_prologue(F); SEAM(0); }
    if (IN(1)) {
        pg8::Gemm g{(const bf16*)(F.ws + WS_XN), (const bf16*)(F.ws + WS_WIN), T, IN_COLS, DM}; pg8::StaticOrder S; S.init(T, IN_COLS, F.G, F.wg);
        pg8::EpiBf16 E{(bf16*)(F.ws + WS_Z), IN_COLS};
        pg8::gemm_phase<pg8::EpiBf16, pg8::StaticOrder, true, true>(F.lds + RING_OFF, g, S, E);
        SEAM(1);
    }
    if (IN(2)) { p2_prep(F); SEAM(2); }
    if (IN(3)) { p3_mixers(F); SEAM(3); }
    if (IN(4)) {
        pg8::Gemm g{(const bf16*)(F.ws + WS_YMIX), (const bf16*)(F.ws + WS_WOUT), T, DM, DM}; pg8::StaticOrder S; S.init(T, DM, F.G, F.wg);
        pg8::EpiF32Res E{F.in[0], F.out, DM};
        pg8::gemm_phase<pg8::EpiF32Res, pg8::StaticOrder, true, true>(F.lds + RING_OFF, g, S, E);
        SEAM(4);
    }
    if (IN(5)) { p5_xn2(F); SEAM(5); }
    if (IN(6)) {
        pg8::Gemm g{(const bf16*)(F.ws + WS_XN), (const bf16*)(F.ws + WS_WQ), T, PQ, DM}; pg8::StaticOrder S; S.init(T, PQ, F.G, F.wg);
        pg8::EpiBf16 E{(bf16*)(F.ws + WS_QP), PQ};
        pg8::gemm_phase<pg8::EpiBf16, pg8::StaticOrder, true, true>(F.lds + RING_OFF, g, S, E);
        SEAM(6);
    }
    if (IN(7)) { p7_topk(F); SEAM(7); }
    if (IN(8)) { p8_gather(F); }
#undef IN
#undef SEAM
}

extern "C" void kernel_launch(void* const* d_in, const int* in_sizes, int n_in, void* d_out, int out_size, void* d_ws, size_t ws_size, hipStream_t stream) {
    static int grid = 0;
    if (grid == 0) {
        if (n_in != 21 || in_sizes[0] != T * DM || out_size != T * DM || ws_size < WS_END) {
            fprintf(stderr, "kernel_launch: unexpected shapes: n_in %d in0 %d out %d ws %zu (need %zu); nothing launched\n", n_in, n_in > 0 ? in_sizes[0] : -1, out_size, ws_size, (size_t)WS_END); grid = -1; return; }
        int dev = 0, cus = 0, per_cu = 0;
        if (hipGetDevice(&dev) != hipSuccess || hipDeviceGetAttribute(&cus, hipDeviceAttributeMultiprocessorCount, dev) != hipSuccess) { grid = -1; return; }
        if (hipFuncSetAttribute((const void*)fwd_kernel, hipFuncAttributeMaxDynamicSharedMemorySize, LDS_BYTES) != hipSuccess) { fprintf(stderr, "kernel_launch: hipFuncSetAttribute failed\n"); grid = -1; return; }
        if (hipOccupancyMaxActiveBlocksPerMultiprocessor(&per_cu, (const void*)fwd_kernel, NTHREADS, LDS_BYTES) != hipSuccess || per_cu < 1) { fprintf(stderr, "kernel_launch: occupancy query says %d\n", per_cu); per_cu = 1; }
        (void)hipGetLastError();
        grid = cus;
    }
    if (grid < 0) return;
    (void)hipMemsetAsync((char*)d_ws + WS_CTL, 0, CTL_ZERO_BYTES, stream);
    Args a{};
    for (int i = 0; i < 21; ++i) a.in[i] = (const float*)d_in[i];
    a.out = (float*)d_out; a.ws = (unsigned char*)d_ws;
    if (MK_N_LAUNCHES == 1) {
        a.ph_lo = 0; a.ph_hi = NPHASE;
        void* kargs[] = {&a};
        hipError_t e = hipLaunchCooperativeKernel((const void*)fwd_kernel, dim3(grid), dim3(NTHREADS), kargs, LDS_BYTES, stream);
        if (e != hipSuccess) fprintf(stderr, "kernel_launch: cooperative launch failed: %s (grid %d)\n", hipGetErrorString(e), grid);
    } else {
        for (int p = 0; p < NPHASE; ++p) { a.ph_lo = p; a.ph_hi = p + 1;
            hipLaunchKernelGGL(fwd_kernel, dim3(grid), dim3(NTHREADS), LDS_BYTES, stream, a); }
    }
}
```

```cpp
#include <hip/hip_runtime.h>
#include <cstdio>
#include <cstdint>

#ifndef MK_N_LAUNCHES
#define MK_N_LAUNCHES 1
#endif

#define GAS __attribute__((address_space(1)))
#define LAS __attribute__((address_space(3)))
typedef unsigned short bf16;
typedef unsigned v4u __attribute__((ext_vector_type(4)));
typedef unsigned v2u __attribute__((ext_vector_type(2)));
typedef float f32x4 __attribute__((ext_vector_type(4)));
typedef float f32x2 __attribute__((ext_vector_type(2)));
typedef short bf16x8 __attribute__((ext_vector_type(8)));
typedef GAS unsigned gu32;
#define RLX_AGENT __ATOMIC_RELAXED, __HIP_MEMORY_SCOPE_AGENT
#define LDS_WAIT() asm volatile("s_waitcnt lgkmcnt(0)" ::: "memory")
#define VM_WAIT() asm volatile("s_waitcnt vmcnt(0)" ::: "memory")

constexpr int DM = 1024, NB = 4, SEQ = 8192, T = NB * SEQ;
constexpr int HD = 64, RWW = 512, NHR = 8, NHA = 8;
constexpr int IN_COLS = 3328;
constexpr int C_R = 0, C_K = 512, C_V = 1024, C_WD = 1536, C_AD = 1600, C_GD = 1664, C_AQ = 1792, C_AK = 2304, C_AV = 2816;
constexpr int PHEADS = 8, NKEYS = 128, PQ = 2048, TOPK = 16, NEXP = 16384;
constexpr float RMS_EPS = 1e-6f, GN_EPS = 64e-5f;
constexpr int NWAVES = 8, NTHREADS = 512;
constexpr int NPHASE = 9;

constexpr size_t MiB = 1u << 20;
constexpr size_t WS_CTL = 0, CTL_ZERO_BYTES = 1 * MiB;
constexpr size_t WS_WIN = 2 * MiB;
constexpr size_t WS_WOUT = 10 * MiB;
constexpr size_t WS_WQ = 12 * MiB;
constexpr size_t WS_XN = 16 * MiB;
constexpr size_t WS_Z = 80 * MiB;
constexpr size_t WS_QP = 80 * MiB;
constexpr size_t WS_G = 288 * MiB;
constexpr size_t WS_YMIX = 352 * MiB;
constexpr size_t WS_UB = 416 * MiB;
constexpr size_t WS_VB = 448 * MiB;
constexpr size_t WS_EID = 480 * MiB;
constexpr size_t WS_GATE = 496 * MiB;
constexpr size_t WS_END = 512 * MiB;

constexpr int CW_BAR = 4096;

__device__ __forceinline__ unsigned f2bf(float f) { unsigned u = __builtin_bit_cast(unsigned, f); return (u + 0x7fffu + ((u >> 16) & 1u)) >> 16; }
__device__ __forceinline__ unsigned pk2(float lo, float hi) { return f2bf(lo) | (f2bf(hi) << 16); }
__device__ __forceinline__ float bflo(unsigned u) { return __builtin_bit_cast(float, u << 16); }
__device__ __forceinline__ float bfhi(unsigned u) { return __builtin_bit_cast(float, u & 0xffff0000u); }
__device__ __forceinline__ float bf2f(bf16 h) { return __builtin_bit_cast(float, (unsigned)h << 16); }

template <int CTRL> __device__ __forceinline__ float dppf(float x) { return __builtin_bit_cast(float, __builtin_amdgcn_update_dpp(0, __builtin_bit_cast(int, x), CTRL, 0xF, 0xF, true)); }
template <int CTRL> __device__ __forceinline__ int dppi(int x) { return __builtin_amdgcn_update_dpp(0, x, CTRL, 0xF, 0xF, true); }
__device__ __forceinline__ float rdlane(float v, int l) { return __builtin_bit_cast(float, __builtin_amdgcn_readlane(__builtin_bit_cast(int, v), l)); }
__device__ __forceinline__ float sum8(float v) { v += dppf<0xB1>(v); v += dppf<0x4E>(v); v += dppf<0x141>(v); return v; }
__device__ __forceinline__ float sum16(float v) { v = sum8(v); v += dppf<0x140>(v); return v; }
__device__ __forceinline__ float wave_sum(float v) { v = sum16(v); return (rdlane(v, 0) + rdlane(v, 16)) + (rdlane(v, 32) + rdlane(v, 48)); }
__device__ __forceinline__ float wave_max(float v) {
    v = fmaxf(v, dppf<0xB1>(v)); v = fmaxf(v, dppf<0x4E>(v)); v = fmaxf(v, dppf<0x141>(v)); v = fmaxf(v, dppf<0x140>(v));
    return fmaxf(fmaxf(rdlane(v, 0), rdlane(v, 16)), fmaxf(rdlane(v, 32), rdlane(v, 48)));
}
__device__ __forceinline__ int wave_min_i(int v) {
    v = min(v, dppi<0xB1>(v)); v = min(v, dppi<0x4E>(v)); v = min(v, dppi<0x141>(v)); v = min(v, dppi<0x140>(v));
    return min(min(__builtin_amdgcn_readlane(v, 0), __builtin_amdgcn_readlane(v, 16)), min(__builtin_amdgcn_readlane(v, 32), __builtin_amdgcn_readlane(v, 48)));
}

namespace pg8 {
#define PG8_LAS __attribute__((address_space(3)))
typedef unsigned short bf16_t;
typedef unsigned u32x4 __attribute__((ext_vector_type(4)));
constexpr int BM = 256, BK = 64, HALF = 128, HTB = HALF * BK * 2, STAGE_BYTES = 8 * HTB, NXCD = 8, WGM = 8;
__host__ __device__ __forceinline__ int lds_byte(int r, int c) { const int st = (r >> 4) * 2 + (c >> 5), rr = r & 15, cc = c & 31, ob = rr * 64 + cc * 2; return st * 1024 + (ob ^ (((ob >> 9) & 1) << 5)); }
__host__ __device__ __forceinline__ void stage_rc(int b, int& R, int& C) { const int st = b / 1024, sb = b % 1024, swz = sb ^ (((sb >> 9) & 1) << 5); R = (st >> 1) * 16 + swz / 64; C = (st & 1) * 32 + (swz % 64) / 2; }
__host__ __device__ __forceinline__ int perm32(int rho) { const int n = rho >> 4, i = rho & 15; return 8 * (i >> 2) + 4 * n + (i & 3); }
struct Unit { int pm, pn; };
struct Gemm { const bf16_t* A; const bf16_t* Bt; int M, N, K; };
struct StaticOrder {
    int nM, nN, nwg, G, c;
    __host__ __device__ void init(int M, int N, int G_, int c_) { nM = M / BM; nN = N / BM; nwg = nM * nN; G = G_; c = c_; }
    __host__ __device__ bool next(int i, Unit& u) const {
        const long L = (long)i * G + c; if (L >= nwg) return false;
        int wgid = (int)L; { const int q = nwg / NXCD, r = nwg % NXCD, xcd = wgid % NXCD, off = wgid / NXCD; wgid = (xcd < r ? xcd * (q + 1) : r * (q + 1) + (xcd - r) * q) + off; }
        const int nig = WGM * nN, gid = wgid / nig, fm = gid * WGM, gsz = (nM - fm) < WGM ? (nM - fm) : WGM;
        u.pm = fm + ((wgid % nig) % gsz); u.pn = (wgid % nig) / gsz; return true;
    }
    __device__ __forceinline__ void a_ready(const Unit&) const {}
    __device__ __forceinline__ void done(const Unit&) const {}
};
__device__ __forceinline__ unsigned cvt_pk_bf16(float lo, float hi) { unsigned r; asm volatile("v_cvt_pk_bf16_f32 %0, %1, %2" : "=v"(r) : "v"(lo), "v"(hi)); return r; }
struct EpiBf16 {
    static constexpr bool PERM = true, AFTER_DRAIN = false;
    bf16_t* O; int ldc;
    __device__ __forceinline__ void operator()(const f32x4 (&acc)[2][2][4][2], const Unit& u, int wr, int wc, int fr, int fq) const {
        const int row0 = u.pm * BM + wr * 64 + fr; const int col0 = u.pn * BM + wc * 32 + 8 * fq;
#pragma unroll
        for (int ai = 0; ai < 2; ++ai)
#pragma unroll
            for (int m = 0; m < 4; ++m) { bf16_t* rowp = O + (size_t)(row0 + ai * HALF + m * 16) * ldc + col0;
#pragma unroll
                for (int bj = 0; bj < 2; ++bj) { const f32x4 v0 = acc[ai][bj][m][0], v1 = acc[ai][bj][m][1];
                    u32x4 w; w.x = cvt_pk_bf16(v0[0], v0[1]); w.y = cvt_pk_bf16(v0[2], v0[3]); w.z = cvt_pk_bf16(v1[0], v1[1]); w.w = cvt_pk_bf16(v1[2], v1[3]);
                    *(u32x4*)(rowp + bj * HALF) = w; } }
    }
};
struct EpiF32Res {
    static constexpr bool PERM = true, AFTER_DRAIN = false;
    const float* res; float* O; int ldc;
    __device__ __forceinline__ void operator()(const f32x4 (&acc)[2][2][4][2], const Unit& u, int wr, int wc, int fr, int fq) const {
        const int row0 = u.pm * BM + wr * 64 + fr; const int col0 = u.pn * BM + wc * 32 + 8 * fq;
#pragma unroll
        for (int ai = 0; ai < 2; ++ai)
#pragma unroll
            for (int m = 0; m < 4; ++m) { const size_t off = (size_t)(row0 + ai * HALF + m * 16) * ldc + col0;
#pragma unroll
                for (int bj = 0; bj < 2; ++bj) { const f32x4 r0 = *(const f32x4*)(res + off + bj * HALF), r1 = *(const f32x4*)(res + off + bj * HALF + 4);
                    *(f32x4*)(O + off + bj * HALF) = acc[ai][bj][m][0] + r0; *(f32x4*)(O + off + bj * HALF + 4) = acc[ai][bj][m][1] + r1; } }
    }
};

template <class Epi, class Sched, bool ALIGN_EPI = false, bool SP2 = false>
__device__ __forceinline__ void gemm_phase(PG8_LAS unsigned char* lds, const Gemm g, const Sched& S, const Epi& E) {
    const int tid = threadIdx.x, wid = __builtin_amdgcn_readfirstlane(tid >> 6), lane = tid & 63, wr = wid >> 2, wc = wid & 3, fr = lane & 15, fq = lane >> 4;
    const int K = g.K, nt = K / BK;
    unsigned voffA[2], voffB[2];
#pragma unroll
    for (int i = 0; i < 2; ++i) { int R, C; stage_rc(tid * 16 + i * 8192, R, C); const int Rb = Epi::PERM ? ((R & ~31) + perm32(R & 31)) : R;
        voffA[i] = (unsigned)(R * K + C) * 2u; voffB[i] = (unsigned)(Rb * K + C) * 2u; }
    const size_t kstep = (size_t)(BK * 2);
    const size_t hstep = (size_t)HALF * K * 2;
    const size_t tstep = 2 * hstep;
    const unsigned ldsw = (unsigned)wid * 1024u;
    const int aoff = lds_byte(wr * 64 + fr, fq * 8), boff = lds_byte(wc * 32 + fr, fq * 8);
#define PG8_SA(b, h) (((b) * 2 + (h)) * HTB)
#define PG8_SB(b, h) ((4 + (b) * 2 + (h)) * HTB)
#define PG8_STAGE(bufoff, gbase, voff) do { _Pragma("unroll") for (int _i = 0; _i < 2; ++_i) \
        __builtin_amdgcn_global_load_lds((const unsigned*)((const char*)(gbase) + (voff)[_i]), (PG8_LAS unsigned*)(lds + (bufoff) + ldsw + _i * 8192), 16, 0, 0); } while (0)
#define PG8_LDA(dst, b, h) do { _Pragma("unroll") for (int m = 0; m < 4; ++m) _Pragma("unroll") for (int k = 0; k < 2; ++k) dst[m][k] = *(const PG8_LAS bf16x8*)(lds + PG8_SA(b, h) + aoff + m * 2048 + k * 1024); } while (0)
#define PG8_LDB(dst, b, h) do { _Pragma("unroll") for (int n = 0; n < 2; ++n) _Pragma("unroll") for (int k = 0; k < 2; ++k) dst[n][k] = *(const PG8_LAS bf16x8*)(lds + PG8_SB(b, h) + boff + n * 2048 + k * 1024); } while (0)
#define PG8_MMA(ai, bj, At, Bt) do { __builtin_amdgcn_s_setprio(1); _Pragma("unroll") for (int m = 0; m < 4; ++m) _Pragma("unroll") for (int n = 0; n < 2; ++n) _Pragma("unroll") for (int k = 0; k < 2; ++k) \
        acc[ai][bj][m][n] = __builtin_amdgcn_mfma_f32_16x16x32_bf16(Bt[n][k], At[m][k], acc[ai][bj][m][n], 0, 0, 0); __builtin_amdgcn_s_setprio(0); } while (0)
#define PG8_WAIT_V(n) asm volatile("s_waitcnt vmcnt(" #n ")" ::: "memory")
#define PG8_WAIT_L(n) asm volatile("s_waitcnt lgkmcnt(" #n ")" ::: "memory")
#define PG8_BAR __builtin_amdgcn_s_barrier()
#define PG8_SCHED __builtin_amdgcn_sched_barrier(0)
    Unit cur, nxt; int ui = 0;
    if (!S.next(0, cur)) return;
    f32x4 acc[2][2][4][2];
#pragma unroll
    for (int a = 0; a < 2; ++a)
#pragma unroll
        for (int b = 0; b < 2; ++b)
#pragma unroll
            for (int m = 0; m < 4; ++m)
#pragma unroll
                for (int n = 0; n < 2; ++n) acc[a][b][m][n] = (f32x4){0.f, 0.f, 0.f, 0.f};
    bf16x8 At[4][2], B0[2][2], B1[2][2];
    const char* cA = (const char*)g.A + (size_t)cur.pm * tstep; const char* cB = (const char*)g.Bt + (size_t)cur.pn * tstep;
    S.a_ready(cur);
    if constexpr (SP2) {
        PG8_STAGE(PG8_SB(0, 0), cB, voffB); PG8_STAGE(PG8_SB(0, 1), cB + hstep, voffB); PG8_STAGE(PG8_SA(0, 0), cA, voffA); PG8_STAGE(PG8_SA(0, 1), cA + hstep, voffA);
        if (wr == 1) PG8_BAR;
        PG8_WAIT_V(2); PG8_BAR;
        PG8_STAGE(PG8_SB(1, 0), cB + kstep, voffB); PG8_STAGE(PG8_SA(1, 0), cA + kstep, voffA); PG8_STAGE(PG8_SB(1, 1), cB + hstep + kstep, voffB);
        PG8_WAIT_V(6); PG8_BAR;
    } else {
        PG8_STAGE(PG8_SB(0, 0), cB, voffB); PG8_STAGE(PG8_SA(0, 0), cA, voffA); PG8_STAGE(PG8_SB(0, 1), cB + hstep, voffB); PG8_STAGE(PG8_SA(0, 1), cA + hstep, voffA);
        if (wr == 1) PG8_BAR;
        PG8_WAIT_V(4); PG8_BAR;
        PG8_STAGE(PG8_SB(1, 0), cB + kstep, voffB); PG8_STAGE(PG8_SA(1, 0), cA + kstep, voffA); PG8_STAGE(PG8_SB(1, 1), cB + hstep + kstep, voffB);
        PG8_WAIT_V(6); PG8_BAR;
    }
    for (;;) {
        const bool has_next = S.next(ui + 1, nxt);
        const char* nA = has_next ? (const char*)g.A + (size_t)nxt.pm * tstep : cA; const char* nB = has_next ? (const char*)g.Bt + (size_t)nxt.pn * tstep : cB;
        for (int t = 0; t < nt; t += 2) {
            const bool last = (t == nt - 2);
            const char* a1 = cA + (size_t)(t + 1) * kstep;
            const char* a2 = last ? nA : cA + (size_t)(t + 2) * kstep; const char* b2 = last ? nB : cB + (size_t)(t + 2) * kstep;
            const char* a3 = a2 + kstep; const char* b3 = b2 + kstep;
            if (last && has_next) S.a_ready(nxt);
            if constexpr (SP2) {
            PG8_LDB(B0, 0, 0); PG8_LDB(B1, 0, 1); PG8_SCHED; PG8_LDA(At, 0, 0); PG8_STAGE(PG8_SA(1, 1), a1 + hstep, voffA);
            PG8_WAIT_V(8); PG8_WAIT_L(0); PG8_BAR; PG8_MMA(0, 0, At, B0); PG8_MMA(0, 1, At, B1); PG8_BAR; PG8_SCHED;
            PG8_LDA(At, 0, 1); PG8_STAGE(PG8_SB(0, 0), b2, voffB); PG8_STAGE(PG8_SB(0, 1), b2 + hstep, voffB); PG8_STAGE(PG8_SA(0, 0), a2, voffA);
            PG8_WAIT_V(8); PG8_WAIT_L(0); PG8_BAR; PG8_MMA(1, 0, At, B0); PG8_MMA(1, 1, At, B1); PG8_BAR; PG8_SCHED;
            PG8_LDB(B0, 1, 0); PG8_LDB(B1, 1, 1); PG8_SCHED; PG8_LDA(At, 1, 0); PG8_STAGE(PG8_SA(0, 1), a2 + hstep, voffA);
            PG8_WAIT_V(8); PG8_WAIT_L(0); PG8_BAR; PG8_MMA(0, 0, At, B0); PG8_MMA(0, 1, At, B1); PG8_BAR; PG8_SCHED;
            PG8_LDA(At, 1, 1); PG8_STAGE(PG8_SB(1, 0), b3, voffB); PG8_STAGE(PG8_SB(1, 1), b3 + hstep, voffB); PG8_STAGE(PG8_SA(1, 0), a3, voffA);
            PG8_WAIT_V(8); PG8_WAIT_L(0); PG8_BAR; PG8_MMA(1, 0, At, B0); PG8_MMA(1, 1, At, B1); PG8_BAR; PG8_SCHED;
            } else {
            PG8_LDB(B0, 0, 0); PG8_SCHED; PG8_LDA(At, 0, 0); PG8_STAGE(PG8_SA(1, 1), a1 + hstep, voffA);
            PG8_WAIT_L(8); PG8_BAR; PG8_WAIT_L(0); PG8_MMA(0, 0, At, B0); PG8_BAR; PG8_SCHED;
            PG8_LDB(B1, 0, 1); PG8_STAGE(PG8_SB(0, 0), b2, voffB);
            PG8_BAR; PG8_WAIT_L(0); PG8_MMA(0, 1, At, B1); PG8_BAR;
            PG8_LDA(At, 0, 1); PG8_STAGE(PG8_SA(0, 0), a2, voffA);
            PG8_BAR; PG8_WAIT_L(0); PG8_MMA(1, 0, At, B0); PG8_BAR; PG8_SCHED;
            PG8_STAGE(PG8_SB(0, 1), b2 + hstep, voffB);
            PG8_WAIT_V(6); PG8_BAR; PG8_MMA(1, 1, At, B1); PG8_BAR;
            PG8_LDB(B0, 1, 0); PG8_SCHED; PG8_LDA(At, 1, 0); PG8_STAGE(PG8_SA(0, 1), a2 + hstep, voffA);
            PG8_WAIT_L(8); PG8_BAR; PG8_WAIT_L(0); PG8_MMA(0, 0, At, B0); PG8_BAR; PG8_SCHED;
            PG8_LDB(B1, 1, 1); PG8_STAGE(PG8_SB(1, 0), b3, voffB);
            PG8_BAR; PG8_WAIT_L(0); PG8_MMA(0, 1, At, B1); PG8_BAR;
            PG8_LDA(At, 1, 1); PG8_STAGE(PG8_SA(1, 0), a3, voffA);
            PG8_BAR; PG8_WAIT_L(0); PG8_MMA(1, 0, At, B0); PG8_BAR; PG8_SCHED;
            PG8_STAGE(PG8_SB(1, 1), b3 + hstep, voffB);
            PG8_WAIT_V(6); PG8_BAR; PG8_MMA(1, 1, At, B1); PG8_BAR;
            }
        }
        if constexpr (ALIGN_EPI) { if (wr == 0) PG8_BAR; }
        if constexpr (!Epi::AFTER_DRAIN) { E(acc, cur, wr, wc, fr, fq); S.done(cur); }
        if (!has_next) break;
#pragma unroll
        for (int a = 0; a < 2; ++a)
#pragma unroll
            for (int b = 0; b < 2; ++b)
#pragma unroll
                for (int m = 0; m < 4; ++m)
#pragma unroll
                    for (int n = 0; n < 2; ++n) acc[a][b][m][n] = (f32x4){0.f, 0.f, 0.f, 0.f};
        cur = nxt; cA = nA; cB = nB; ++ui;
        if constexpr (ALIGN_EPI) { if (wr == 1) PG8_BAR; }
    }
    PG8_WAIT_V(0);
    if constexpr (!ALIGN_EPI) { if (wr == 0) PG8_BAR; }
    PG8_BAR;
#undef PG8_SA
#undef PG8_SB
#undef PG8_STAGE
#undef PG8_LDA
#undef PG8_LDB
#undef PG8_MMA
#undef PG8_WAIT_V
#undef PG8_WAIT_L
#undef PG8_BAR
#undef PG8_SCHED
}
}

#define XB_TMO      128
#define XB_XCNT(j)  (256  + 64 * (j))
#define XB_XSUB(j)  (1280 + 64 * (j))
#define XB_XGEN(j)  (2304 + 64 * (j))
#define XB_TOP      3328
#define XB_TOPGEN   3392
#define XCD_BAR_WORDS 3456
#define XB_SPIN_CAP (1u << 22)
__device__ __forceinline__ unsigned xb_ld(unsigned* p)              { return __hip_atomic_load(p, __ATOMIC_RELAXED, __HIP_MEMORY_SCOPE_AGENT); }
__device__ __forceinline__ unsigned xb_add(unsigned* p, unsigned v) { return __hip_atomic_fetch_add(p, v, __ATOMIC_RELAXED, __HIP_MEMORY_SCOPE_AGENT); }
__device__ __forceinline__ unsigned xb_xcc_id() { return (unsigned)__builtin_amdgcn_s_getreg((3 << 11) | 20) & 0xFu; }
#define XB_SPIN(cond, bar) do { unsigned _sp = 0; while (cond) { __builtin_amdgcn_s_sleep(1); \
    if ((++_sp & 255u) == 0u) { if (xb_ld(&(bar)[XB_TMO])) break; if (_sp > XB_SPIN_CAP) { atomicAdd(&(bar)[XB_TMO], 1u); break; } } } } while (0)
struct XcdBarrier { unsigned* bar; unsigned x; volatile LAS unsigned* st; };
__device__ __forceinline__ XcdBarrier xcd_barrier_post(unsigned* bar, volatile LAS unsigned* st) {
    XcdBarrier b; b.bar = bar; b.x = xb_xcc_id(); b.st = st;
    if (threadIdx.x == 0) (void)xb_add(&bar[XB_XCNT(b.x)], 1u);
    return b;
}
__device__ __forceinline__ void xcd_barrier_complete(unsigned* bar, unsigned x, unsigned& nloc, unsigned& nx) {
    const unsigned G = gridDim.x * gridDim.y * gridDim.z;
    unsigned sum, cnt, mine, sp = 0u;
    for (;;) {
        sum = 0u; cnt = 0u; mine = 0u;
#pragma unroll
        for (unsigned j = 0; j < 16; ++j) { const unsigned c = xb_ld(&bar[XB_XCNT(j)]); sum += c; cnt += (c > 0u) ? 1u : 0u; mine = (j == x) ? c : mine; }
        if (sum == G) break;
        __builtin_amdgcn_s_sleep(1);
        if ((++sp & 255u) == 0u) { if (xb_ld(&bar[XB_TMO])) break; if (sp > XB_SPIN_CAP) { atomicAdd(&bar[XB_TMO], 1u); break; } }
    }
    nloc = mine > 0u ? mine : 1u; nx = cnt > 0u ? cnt : 1u;
}
__device__ __forceinline__ void xcd_barrier(const XcdBarrier& b) {
    asm volatile("s_waitcnt vmcnt(0)" ::: "memory");
    __syncthreads();
    if (threadIdx.x == 0) {
        unsigned* bar = b.bar;
        __builtin_amdgcn_s_waitcnt(0);
        unsigned nloc = b.st[0], nx = b.st[1];
        if (nloc == 0u) { xcd_barrier_complete(bar, b.x, nloc, nx); b.st[0] = nloc; b.st[1] = nx; }
        const unsigned old = xb_add(&bar[XB_XSUB(b.x)], 1u);
        const unsigned gen = old / nloc;
        if (old + 1u == (gen + 1u) * nloc) {
            __builtin_amdgcn_fence(__ATOMIC_RELEASE, "agent");
            asm volatile("s_waitcnt vmcnt(0)" ::: "memory");
            const unsigned og = xb_add(&bar[XB_TOP], 1u);
            const unsigned tg = og / nx;
            if (og + 1u == (tg + 1u) * nx) xb_add(&bar[XB_TOPGEN], 1u);
            else XB_SPIN(xb_ld(&bar[XB_TOPGEN]) == tg, bar);
            __builtin_amdgcn_fence(__ATOMIC_ACQUIRE, "agent");
            xb_add(&bar[XB_XGEN(b.x)], 1u);
            asm volatile("s_waitcnt vmcnt(0)" ::: "memory");
        } else {
            XB_SPIN(xb_ld(&bar[XB_XGEN(b.x)]) == gen, bar);
            __builtin_amdgcn_fence(__ATOMIC_ACQUIRE, "agent");
            asm volatile("s_waitcnt vmcnt(0)" ::: "memory");
        }
    }
    __syncthreads();
}

constexpr int RING_OFF = 0, RING_BYTES = 131072;
constexpr int LDSCTL_OFF = RING_BYTES, MISC_OFF = LDSCTL_OFF + 320;
constexpr int LDS_BYTES = 147456;

struct Frame {
    LAS unsigned char* lds;
    volatile LAS unsigned* MISC;
    gu32* ctl;
    int tid, lane, wave, G, wg;
    const float* in[21];
    float* out;
    unsigned char* ws;
};

__device__ __forceinline__ void p0_transpose_item(const float* W, int K, int N, bf16* WT, LAS float* scr, int item, int lane) {
    const int nblk = N / 32, kb = item / nblk, nb = item % nblk, k0 = 64 * kb, n0 = 32 * nb;
#pragma unroll 8
    for (int i = 0; i < 32; ++i) { const int kk = 2 * i + (lane >> 5); scr[kk * 33 + (lane & 31)] = W[(size_t)(k0 + kk) * N + n0 + (lane & 31)]; }
    LDS_WAIT(); asm volatile("" ::: "memory");
    const int c = lane & 7;
#pragma unroll
    for (int j = 0; j < 4; ++j) { const int n = (lane >> 3) + 8 * j; const LAS float* s = scr + (8 * c) * 33 + n;
        v4u o; o.x = pk2(s[0 * 33], s[1 * 33]); o.y = pk2(s[2 * 33], s[3 * 33]); o.z = pk2(s[4 * 33], s[5 * 33]); o.w = pk2(s[6 * 33], s[7 * 33]);
        *(GAS v4u*)(WT + (size_t)(n0 + n) * K + k0 + 8 * c) = o; }
    LDS_WAIT(); asm volatile("" ::: "memory");
}
__device__ __forceinline__ void rms_row_to_bf16(int lane, const float* xrow, const float* gain, bf16* orow) {
    const GAS f32x4* xr = (const GAS f32x4*)xrow + lane;
    const GAS f32x4* gr = (const GAS f32x4*)gain + lane;
    f32x4 v[4]; float s = 0.f;
#pragma unroll
    for (int j = 0; j < 4; ++j) { v[j] = xr[64 * j]; s += (v[j].x * v[j].x + v[j].y * v[j].y) + (v[j].z * v[j].z + v[j].w * v[j].w); }
    const float rstd = 1.f / sqrtf(wave_sum(s) * (1.f / DM) + RMS_EPS);
    GAS unsigned long long* o8 = (GAS unsigned long long*)orow + lane;
#pragma unroll
    for (int j = 0; j < 4; ++j) { const f32x4 gg = gr[64 * j];
        o8[64 * j] = (unsigned long long)pk2(v[j].x * rstd * gg.x, v[j].y * rstd * gg.y) | ((unsigned long long)pk2(v[j].z * rstd * gg.z, v[j].w * rstd * gg.w) << 32); }
}
__device__ __forceinline__ void cvt_row_to_bf16(int lane, const float* xrow, bf16* orow) {
    const GAS f32x4* xr = (const GAS f32x4*)xrow + lane;
    GAS unsigned long long* o8 = (GAS unsigned long long*)orow + lane;
#pragma unroll
    for (int j = 0; j < 4; ++j) { const f32x4 v = xr[64 * j]; o8[64 * j] = (unsigned long long)pk2(v.x, v.y) | ((unsigned long long)pk2(v.z, v.w) << 32); }
}
__device__ __forceinline__ void p0_prologue(Frame& F) {
    LAS float* scr = (LAS float*)(F.lds + RING_OFF + F.wave * 16384);
    const int gw = F.wg * NWAVES + F.wave, NGW = F.G * NWAVES;
    constexpr int I_IN = (DM / 64) * (IN_COLS / 32), I_OUT = (DM / 64) * (DM / 32), I_Q = (DM / 64) * (PQ / 32);
    constexpr int NITEMS = I_IN + I_OUT + I_Q;
    bf16* win_t = (bf16*)(F.ws + WS_WIN); bf16* wout_t = (bf16*)(F.ws + WS_WOUT); bf16* wq_t = (bf16*)(F.ws + WS_WQ);
    for (int it = gw; it < NITEMS; it += NGW) {
        int r = it;
        if (r < I_IN) { p0_transpose_item(F.in[2], DM, IN_COLS, win_t, scr, r, F.lane); continue; } r -= I_IN;
        if (r < I_OUT) { p0_transpose_item(F.in[14], DM, DM, wout_t, scr, r, F.lane); continue; } r -= I_OUT;
        p0_transpose_item(F.in[16], DM, PQ, wq_t, scr, r, F.lane);
    }
    bf16* XN = (bf16*)(F.ws + WS_XN);
    for (int m = gw; m < T; m += NGW) rms_row_to_bf16(F.lane, F.in[0] + (size_t)m * DM, F.in[1], XN + (size_t)m * DM);
    bf16* UB = (bf16*)(F.ws + WS_UB); bf16* VB = (bf16*)(F.ws + WS_VB);
    for (int m = gw; m < NEXP; m += NGW) { cvt_row_to_bf16(F.lane, F.in[18] + (size_t)m * DM, UB + (size_t)m * DM); cvt_row_to_bf16(F.lane, F.in[19] + (size_t)m * DM, VB + (size_t)m * DM); }
}

__device__ __forceinline__ void p2_prep(Frame& F) {
    bf16* Z = (bf16*)(F.ws + WS_Z);
    float* E = F.out; float* A = F.out + (size_t)T * RWW; float* Gt = (float*)(F.ws + WS_G);
    const float* mu = F.in[3]; const float* w0 = F.in[4]; const float* w_up = F.in[5]; const float* a0 = F.in[6]; const float* a_up = F.in[7]; const float* g_up = F.in[8];
    LAS float* act = (LAS float*)(F.lds + RING_OFF);
    const int tid = F.tid;
    const float inv_freq = powf(10000.0f, -(float)(2 * (tid & 31)) / 64.0f);
    for (int blk = F.wg; blk < T / 16; blk += F.G) {
        const int g0 = blk * 16;
        {
            const int tok = tid >> 5, cg = tid & 31, g = g0 + tok, s = g & (SEQ - 1);
            const v4u zc = *(const GAS v4u*)(Z + (size_t)g * IN_COLS + C_WD + cg * 8);
            v4u zp = (v4u){0u, 0u, 0u, 0u};
            if (s > 0) zp = *(const GAS v4u*)(Z + (size_t)(g - 1) * IN_COLS + C_WD + cg * 8);
            float zv[8], pv[8];
            zv[0] = bflo(zc.x); zv[1] = bfhi(zc.x); zv[2] = bflo(zc.y); zv[3] = bfhi(zc.y); zv[4] = bflo(zc.z); zv[5] = bfhi(zc.z); zv[6] = bflo(zc.w); zv[7] = bfhi(zc.w);
            pv[0] = bflo(zp.x); pv[1] = bfhi(zp.x); pv[2] = bflo(zp.y); pv[3] = bfhi(zp.y); pv[4] = bflo(zp.z); pv[5] = bfhi(zp.z); pv[6] = bflo(zp.w); pv[7] = bfhi(zp.w);
#pragma unroll
            for (int j = 0; j < 8; ++j) { const int c = cg * 8 + j; const float m = mu[C_WD + c]; float v = zv[j] + (pv[j] - zv[j]) * m;
                if (c < 64) v = tanhf(v); else if (c >= 128) v = 1.f / (1.f + __expf(-v));
                act[c * 16 + tok] = v; }
        }
        __syncthreads();
        {
            const int c = tid;
            float aE[16], aA[16], aG[16];
#pragma unroll
            for (int k = 0; k < 16; ++k) { aE[k] = 0.f; aA[k] = 0.f; aG[k] = 0.f; }
            for (int m = 0; m < 64; ++m) {
                const float wv = w_up[m * RWW + c], av = a_up[m * RWW + c];
                const LAS f32x4* p1 = (const LAS f32x4*)(act + m * 16); const LAS f32x4* p2 = (const LAS f32x4*)(act + (64 + m) * 16);
#pragma unroll
                for (int q = 0; q < 4; ++q) { const f32x4 x1 = p1[q], x2 = p2[q];
#pragma unroll
                    for (int j = 0; j < 4; ++j) { aE[q * 4 + j] += x1[j] * wv; aA[q * 4 + j] += x2[j] * av; } }
            }
            for (int m = 0; m < 128; ++m) {
                const float gv = g_up[m * RWW + c];
                const LAS f32x4* p3 = (const LAS f32x4*)(act + (128 + m) * 16);
#pragma unroll
                for (int q = 0; q < 4; ++q) { const f32x4 x3 = p3[q];
#pragma unroll
                    for (int j = 0; j < 4; ++j) aG[q * 4 + j] += x3[j] * gv; }
            }
            const float w0c = w0[c], a0c = a0[c];
#pragma unroll
            for (int k = 0; k < 16; ++k) { const size_t o = (size_t)(g0 + k) * RWW + c;
                E[o] = 0.60653066f / (1.f + __expf(-(w0c + aE[k])));
                A[o] = 1.f / (1.f + __expf(-(a0c + aA[k])));
                Gt[o] = aG[k]; }
        }
        {
            const int i = tid & 31, grp = tid >> 5;
            for (int k = 0; k < 16; ++k) { const int g = g0 + k, s = g & (SEQ - 1);
                const float ang = (float)s * inv_freq;
                const double r = (double)ang - rint((double)ang * 0.15915494309189535) * 6.283185307179586;
                const float rf = (float)r; const float cs = cosf(rf), sn = sinf(rf);
                bf16* p = Z + (size_t)g * IN_COLS + C_AQ + grp * 64 + i;
                const float x1 = bf2f(p[0]), x2 = bf2f(p[32]);
                p[0] = (bf16)f2bf(x1 * cs - x2 * sn); p[32] = (bf16)f2bf(x1 * sn + x2 * cs); }
        }
        __syncthreads();
    }
}

__device__ __forceinline__ void rwkv_chain(Frame& F, int chain) {
    const int b = chain >> 3, h = chain & 7;
    const bf16* Z = (const bf16*)(F.ws + WS_Z);
    const float* E = F.out; const float* A = F.out + (size_t)T * RWW; const float* Gt = (const float*)(F.ws + WS_G);
    bf16* Y = (bf16*)(F.ws + WS_YMIX);
    const float* mu = F.in[3]; const float* k_k = F.in[9]; const float* k_a = F.in[10]; const float* r_k = F.in[11]; const float* gn_w = F.in[12]; const float* gn_b = F.in[13];
    LAS float* sR = (LAS float*)(F.lds + RING_OFF); LAS float* sW = sR + 4096; LAS float* sK = sW + 4096; LAS float* sAi = sK + 4096; LAS float* sBi = sAi + 4096; LAS float* sV = sBi + 4096; LAS float* sY = sV + 4096;
    const int tid = F.tid, c = tid & 63, w = tid >> 6, col = h * 64 + c;
    const int ri = tid >> 3, jq = tid & 7;
    const float mu_r = mu[C_R + col], mu_k = mu[C_K + col], mu_v = mu[C_V + col], kkc = k_k[col], kac = k_a[col], rkc = r_k[col], gw = gn_w[col], gb = gn_b[col];
    float st[8];
#pragma unroll
    for (int j = 0; j < 8; ++j) st[j] = 0.f;
    for (int blk = 0; blk < SEQ / 64; ++blk) {
        const int g0 = b * SEQ + blk * 64;
#pragma unroll 2
        for (int i = 0; i < 8; ++i) { const int tt = w + 8 * i, g = g0 + tt, s = blk * 64 + tt;
            const bf16* zr = Z + (size_t)g * IN_COLS + col;
            const float zr_ = bf2f(zr[C_R]), zk_ = bf2f(zr[C_K]), zv_ = bf2f(zr[C_V]);
            float pr = 0.f, pk = 0.f, pv = 0.f;
            if (s > 0) { const bf16* zq = zr - IN_COLS; pr = bf2f(zq[C_R]); pk = bf2f(zq[C_K]); pv = bf2f(zq[C_V]); }
            const float r = zr_ + (pr - zr_) * mu_r, k = zk_ + (pk - zk_) * mu_k, v = zv_ + (pv - zv_) * mu_v;
            const float e = E[(size_t)g * RWW + col], a = A[(size_t)g * RWW + col];
            float kk = k * kkc; const float n2 = wave_sum(kk * kk); kk = kk / fmaxf(sqrtf(n2), 1e-12f);
            const float k2 = k * (1.f + (a - 1.f) * kac);
            sR[tt * 64 + c] = r; sW[tt * 64 + c] = __expf(-e); sK[tt * 64 + c] = k2; sAi[tt * 64 + c] = -kk; sBi[tt * 64 + c] = kk * a; sV[tt * 64 + c] = v; }
        __syncthreads();
        for (int tt = 0; tt < 64; ++tt) {
            const LAS f32x4* pa = (const LAS f32x4*)(sAi + tt * 64 + jq * 8); const LAS f32x4* pw = (const LAS f32x4*)(sW + tt * 64 + jq * 8);
            const LAS f32x4* pb = (const LAS f32x4*)(sBi + tt * 64 + jq * 8); const LAS f32x4* pk = (const LAS f32x4*)(sK + tt * 64 + jq * 8);
            const LAS f32x4* pr = (const LAS f32x4*)(sR + tt * 64 + jq * 8);
            const f32x4 a0 = pa[0], a1 = pa[1], w0 = pw[0], w1 = pw[1], b0 = pb[0], b1 = pb[1], k0 = pk[0], k1 = pk[1], r0 = pr[0], r1 = pr[1];
            const float vi = sV[tt * 64 + ri];
            float sa = (st[0] * a0[0] + st[1] * a0[1]) + (st[2] * a0[2] + st[3] * a0[3]) + (st[4] * a1[0] + st[5] * a1[1]) + (st[6] * a1[2] + st[7] * a1[3]);
            sa = sum8(sa);
#pragma unroll
            for (int j = 0; j < 4; ++j) { st[j] = st[j] * w0[j] + sa * b0[j] + vi * k0[j]; st[4 + j] = st[4 + j] * w1[j] + sa * b1[j] + vi * k1[j]; }
            float y = (st[0] * r0[0] + st[1] * r0[1]) + (st[2] * r0[2] + st[3] * r0[3]) + (st[4] * r1[0] + st[5] * r1[1]) + (st[6] * r1[2] + st[7] * r1[3]);
            y = sum8(y);
            if (jq == 0) sY[tt * 64 + ri] = y;
        }
        __syncthreads();
#pragma unroll 2
        for (int i = 0; i < 8; ++i) { const int tt = w + 8 * i, g = g0 + tt;
            const float y = sY[tt * 64 + c];
            const float mean = wave_sum(y) * (1.f / 64.f); const float d = y - mean; const float var = wave_sum(d * d) * (1.f / 64.f);
            const float yn = d * (1.f / sqrtf(var + GN_EPS)) * gw + gb;
            const float r = sR[tt * 64 + c], k2 = sK[tt * 64 + c], v = sV[tt * 64 + c];
            const float bonus = wave_sum(r * k2 * rkc) * v;
            const float o = (yn + bonus) * Gt[(size_t)g * RWW + col];
            Y[(size_t)g * DM + col] = (bf16)f2bf(o); }
        __syncthreads();
    }
}

typedef float f32x16 __attribute__((ext_vector_type(16)));
typedef short s16x4 __attribute__((ext_vector_type(4)));
typedef short v4i16_t __attribute__((ext_vector_type(4)));
constexpr int AT_XO = 0, AT_XO_STRIDE = 136, AT_XM = 512 * AT_XO_STRIDE, AT_XL = AT_XM + 2048, AT_V = AT_XL + 2048, AT_LDS_END = AT_V + 8 * 4096;
static_assert(AT_LDS_END <= RING_BYTES, "attention LDS");
__device__ __forceinline__ float xhalf(float v) { return __shfl_xor(v, 32); }
__device__ __forceinline__ void attn_block(Frame& F, int item) {
    const int bh = item >> 4, blk = item & 15, b = bh >> 3, h = bh & 7, t0 = blk * 512;
    const int lane = F.lane, w = F.wave, ql = lane & 31, hh = lane >> 5;
    const bf16* Zb = (const bf16*)(F.ws + WS_Z) + (size_t)b * SEQ * IN_COLS;
    bf16* Y = (bf16*)(F.ws + WS_YMIX);
    LAS unsigned char* lds = F.lds + RING_OFF;
    LAS unsigned char* Vw = lds + AT_V + w * 4096;
    LAS float* XM = (LAS float*)(lds + AT_XM); LAS float* XL = (LAS float*)(lds + AT_XL);
    constexpr float C2 = 0.125f * 1.4426950408889634f;
    for (int pass = 0; pass < 3; ++pass) {
        const int sh = pass == 0 ? 4 : (pass == 1 ? 2 : 0), d = 1 << sh;
        for (int uu = 0; uu < 2; ++uu) {
            const int u = w + 8 * uu, rho = u & (d - 1), tau = u >> sh;
            const int qoff = rho + (32 * tau + ql) * d;
            bf16x8 qf[4];
            { const bf16* qp = Zb + (size_t)(t0 + qoff) * IN_COLS + C_AQ + h * 64 + 8 * hh;
#pragma unroll
              for (int s = 0; s < 4; ++s) qf[s] = *(const GAS bf16x8*)(qp + 16 * s); }
            f32x16 sc[5];
            const int tkb = t0 + rho + (32 * tau - 128) * d;
#pragma unroll
            for (int kt = 0; kt < 5; ++kt) {
                const int tk0 = tkb + 32 * kt * d;
                if (tk0 >= 0) {
                    const bf16* kp = Zb + (size_t)(tk0 + ql * d) * IN_COLS + C_AK + h * 64 + 8 * hh;
                    bf16x8 kf[4];
#pragma unroll
                    for (int s = 0; s < 4; ++s) kf[s] = *(const GAS bf16x8*)(kp + 16 * s);
                    f32x16 acc;
#pragma unroll
                    for (int r = 0; r < 16; ++r) acc[r] = 0.f;
#pragma unroll
                    for (int s = 0; s < 4; ++s) acc = __builtin_amdgcn_mfma_f32_32x32x16_bf16(kf[s], qf[s], acc, 0, 0, 0);
                    if (kt == 0 || kt == 4) {
#pragma unroll
                        for (int r = 0; r < 16; ++r) { const int kidx = (r & 3) + 8 * (r >> 2) + 4 * hh;
                            const bool ok = (kt == 0) ? (kidx >= ql) : (kidx <= ql);
                            acc[r] = ok ? acc[r] : -INFINITY; }
                    }
                    sc[kt] = acc;
                } else {
#pragma unroll
                    for (int r = 0; r < 16; ++r) sc[kt][r] = -INFINITY;
                }
            }
            float m = -INFINITY;
#pragma unroll
            for (int kt = 0; kt < 5; ++kt)
#pragma unroll
                for (int r = 0; r < 16; ++r) m = fmaxf(m, sc[kt][r]);
            m = fmaxf(m, xhalf(m));
            const float ms = m * C2;
            float l = 0.f;
#pragma unroll
            for (int kt = 0; kt < 5; ++kt)
#pragma unroll
                for (int r = 0; r < 16; ++r) { const float p = __builtin_amdgcn_exp2f(sc[kt][r] * C2 - ms); sc[kt][r] = p; l += p; }
            l += xhalf(l);
            f32x16 O[2];
#pragma unroll
            for (int r = 0; r < 16; ++r) { O[0][r] = 0.f; O[1][r] = 0.f; }
#pragma unroll
            for (int kt = 0; kt < 5; ++kt) {
                const int tk0 = tkb + 32 * kt * d;
                if (tk0 >= 0) {
                    v4u vr[4];
#pragma unroll
                    for (int i = 0; i < 4; ++i) { const int kidx = i * 8 + (lane >> 3), ch = lane & 7;
                        vr[i] = *(const GAS v4u*)(Zb + (size_t)(tk0 + kidx * d) * IN_COLS + C_AV + h * 64 + ch * 8); }
#pragma unroll
                    for (int i = 0; i < 4; ++i) { const int kidx = i * 8 + (lane >> 3), ch = lane & 7;
                        *(LAS v4u*)(Vw + kidx * 128 + ((ch ^ (((kidx >> 1) & 1) << 2)) << 4)) = vr[i]; }
                    asm volatile("s_waitcnt lgkmcnt(0)" ::: "memory");
#pragma unroll
                    for (int s = 0; s < 2; ++s) {
                        bf16x8 pf;
#pragma unroll
                        for (int j = 0; j < 8; ++j) pf[j] = (short)f2bf(sc[kt][8 * s + j]);
#pragma unroll
                        for (int dt = 0; dt < 2; ++dt) {
                            bf16x8 vf;
#pragma unroll
                            for (int pp = 0; pp < 2; ++pp) {
                                const int i16 = lane & 15, db = (lane >> 4) & 1;
                                const int row = 16 * s + 8 * pp + 4 * hh + (i16 >> 2);
                                const int byte = 64 * dt + 32 * db + 8 * (i16 & 3);
                                const int chunk = (byte >> 4) ^ (((row >> 1) & 1) << 2);
                                const s16x4 t4 = __builtin_bit_cast(s16x4, __builtin_amdgcn_ds_read_tr16_b64_v4i16((LAS v4i16_t*)(Vw + row * 128 + (chunk << 4) + (byte & 15))));
                                vf[4 * pp + 0] = t4[0]; vf[4 * pp + 1] = t4[1]; vf[4 * pp + 2] = t4[2]; vf[4 * pp + 3] = t4[3];
                            }
                            O[dt] = __builtin_amdgcn_mfma_f32_32x32x16_bf16(vf, pf, O[dt], 0, 0, 0);
                        }
                    }
                    asm volatile("s_waitcnt lgkmcnt(0)" ::: "memory");
                }
            }
            LAS unsigned char* xo = lds + AT_XO + qoff * AT_XO_STRIDE + 8 * hh;
            float wa = 0.f, wb = 1.f, Mx = ms, ln = l;
            if (pass > 0) { const float msa = XM[qoff], la = XL[qoff]; Mx = fmaxf(msa, ms); wa = la * __builtin_amdgcn_exp2f(msa - Mx); wb = __builtin_amdgcn_exp2f(ms - Mx); ln = wa + wb * l; }
            const float inv = 1.f / ln;
#pragma unroll
            for (int dt = 0; dt < 2; ++dt)
#pragma unroll
                for (int g4 = 0; g4 < 4; ++g4) {
                    LAS v2u* p = (LAS v2u*)(xo + (32 * dt + 8 * g4) * 2);
                    float o0 = O[dt][4 * g4] * wb, o1 = O[dt][4 * g4 + 1] * wb, o2 = O[dt][4 * g4 + 2] * wb, o3 = O[dt][4 * g4 + 3] * wb;
                    if (pass > 0) { const v2u old = *p; o0 += bflo(old.x) * wa; o1 += bfhi(old.x) * wa; o2 += bflo(old.y) * wa; o3 += bfhi(old.y) * wa; }
                    v2u nw; nw.x = pk2(o0 * inv, o1 * inv); nw.y = pk2(o2 * inv, o3 * inv);
                    *p = nw;
                }
            if (hh == 0) { XM[qoff] = Mx; XL[qoff] = ln; }
        }
        __syncthreads();
    }
#pragma unroll
    for (int i = 0; i < 8; ++i) { const int row = (F.tid >> 3) + 64 * i, ch = F.tid & 7;
        LAS v2u* p = (LAS v2u*)(lds + AT_XO + row * AT_XO_STRIDE + ch * 16);
        const v2u a = p[0], c = p[1];
        v4u o; o.x = a.x; o.y = a.y; o.z = c.x; o.w = c.y;
        *(GAS v4u*)(Y + ((size_t)b * SEQ + t0 + row) * DM + RWW + h * 64 + ch * 8) = o; }
    __syncthreads();
}

__device__ __forceinline__ void p3_mixers(Frame& F) {
    const int nrw = (F.G >= 64) ? 32 : (F.G > 1 ? F.G / 2 : 0);
    if (F.wg < nrw || nrw == 0) {
        if (nrw == 0) { for (int ch = 0; ch < NB * NHR; ++ch) rwkv_chain(F, ch); }
        else for (int ch = F.wg; ch < NB * NHR; ch += nrw) rwkv_chain(F, ch);
        if (nrw != 0) return;
    }
    const int na = F.G - nrw, wa = F.wg - nrw;
    for (int item = wa; item < NB * NHA * (SEQ / 512); item += na) attn_block(F, item);
}

__device__ __forceinline__ void p5_xn2(Frame& F) {
    const int gw = F.wg * NWAVES + F.wave, NGW = F.G * NWAVES;
    bf16* XN = (bf16*)(F.ws + WS_XN);
    for (int m = gw; m < T; m += NGW) rms_row_to_bf16(F.lane, F.out + (size_t)m * DM, F.in[15], XN + (size_t)m * DM);
}

template <int NS> __device__ __forceinline__ void wave_top16(float (&v)[NS], int lane, float& out_s, int& out_i) {
    out_s = 0.f; out_i = 0;
    for (int it = 0; it < 16; ++it) {
        float m = v[0];
#pragma unroll
        for (int s = 1; s < NS; ++s) m = fmaxf(m, v[s]);
        const float M = wave_max(m);
        int cand = 0x7fffffff;
#pragma unroll
        for (int s = NS - 1; s >= 0; --s) if (v[s] == M) cand = lane * NS + s;
        const int I = wave_min_i(cand);
        if (lane == it) { out_s = M; out_i = I; }
#pragma unroll
        for (int s = 0; s < NS; ++s) if (lane * NS + s == I) v[s] = -INFINITY;
    }
}
__device__ __forceinline__ void p7_topk(Frame& F) {
    const bf16* QP = (const bf16*)(F.ws + WS_QP);
    int* EID = (int*)(F.ws + WS_EID); float* GATE = (float*)(F.ws + WS_GATE);
    const float* sk = F.in[17];
    LAS float* SK = (LAS float*)(F.lds + RING_OFF);
    for (int e = F.tid; e < 2 * 128 * 128; e += NTHREADS) { const int c = e >> 14, k = (e >> 7) & 127, d = e & 127; SK[(c * 128 + d) * 128 + k] = sk[e]; }
    __syncthreads();
    const int lane = F.lane;
    const int gw = F.wg * NWAVES + F.wave, NGW = F.G * NWAVES;
    for (int item = gw; item < T * PHEADS; item += NGW) {
        const int t = item >> 3, h = item & 7;
        float ts[2]; int ti[2];
#pragma unroll
        for (int c = 0; c < 2; ++c) {
            const unsigned qd = *(const GAS unsigned*)(QP + (size_t)t * PQ + h * 256 + c * 128 + 2 * lane);
            const float q0 = bflo(qd), q1 = bfhi(qd);
            float s0 = 0.f, s1 = 0.f;
            const LAS f32x2* kp = (const LAS f32x2*)(SK + c * 16384) + lane;
#pragma unroll 8
            for (int d2 = 0; d2 < 64; ++d2) { const float qe = rdlane(q0, d2), qo = rdlane(q1, d2);
                const f32x2 ka = kp[(2 * d2) * 64], kb = kp[(2 * d2 + 1) * 64];
                s0 += qe * ka.x + qo * kb.x; s1 += qe * ka.y + qo * kb.y; }
            float v[2] = {s0, s1};
            wave_top16<2>(v, lane, ts[c], ti[c]);
        }
        const float a_s = __shfl(ts[0], lane >> 2); const int a_i = __shfl(ti[0], lane >> 2);
        float cv[4]; int ce[4];
#pragma unroll
        for (int s = 0; s < 4; ++s) { const int j = (lane & 3) * 4 + s; cv[s] = a_s + __shfl(ts[1], j); ce[s] = a_i * NKEYS + __shfl(ti[1], j); }
        float bs; int bi;
        wave_top16<4>(cv, lane, bs, bi);
        int eid = 0;
        { const int ol = bi >> 2, os = bi & 3;
          const int e0 = __shfl(ce[0], ol), e1 = __shfl(ce[1], ol), e2 = __shfl(ce[2], ol), e3 = __shfl(ce[3], ol);
          eid = os == 0 ? e0 : (os == 1 ? e1 : (os == 2 ? e2 : e3)); }
        const float mx = rdlane(bs, 0);
        float ex = lane < 16 ? __expf(bs - mx) : 0.f;
        const float den = wave_sum(ex);
        if (lane < 16) { EID[(size_t)t * 128 + h * 16 + lane] = eid; GATE[(size_t)t * 128 + h * 16 + lane] = ex / den; }
    }
}

__device__ __forceinline__ void unpack8(const v4u a, float* f) { f[0] = bflo(a.x); f[1] = bfhi(a.x); f[2] = bflo(a.y); f[3] = bfhi(a.y); f[4] = bflo(a.z); f[5] = bfhi(a.z); f[6] = bflo(a.w); f[7] = bfhi(a.w); }
__device__ __forceinline__ void p8_gather(Frame& F) {
    const bf16* XN = (const bf16*)(F.ws + WS_XN);
    const bf16* UB = (const bf16*)(F.ws + WS_UB); const bf16* VB = (const bf16*)(F.ws + WS_VB);
    const int* EID = (const int*)(F.ws + WS_EID); const float* GATE = (const float*)(F.ws + WS_GATE);
    const float* nf = F.in[20];
    const int lane = F.lane;
    const int gw = F.wg * NWAVES + F.wave, NGW = F.G * NWAVES;
    for (int t = gw; t < T; t += NGW) {
        float x[16];
        { const GAS v4u* xp = (const GAS v4u*)(XN + (size_t)t * DM); unpack8(xp[lane], x); unpack8(xp[64 + lane], x + 8); }
        const int e_lo = EID[(size_t)t * 128 + lane], e_hi = EID[(size_t)t * 128 + 64 + lane];
        const float g_lo = GATE[(size_t)t * 128 + lane], g_hi = GATE[(size_t)t * 128 + 64 + lane];
        float acc[16];
#pragma unroll
        for (int k = 0; k < 16; ++k) acc[k] = 0.f;
        for (int jj = 0; jj < 128; jj += 4) {
            v4u ua[4], ub[4], va[4], vb[4]; float gt[4];
#pragma unroll
            for (int u = 0; u < 4; ++u) { const int j = jj + u;
                int e = (j < 64) ? __builtin_amdgcn_readlane(e_lo, j & 63) : __builtin_amdgcn_readlane(e_hi, j & 63);
                gt[u] = (j < 64) ? rdlane(g_lo, j & 63) : rdlane(g_hi, j & 63);
                e = e & (NEXP - 1);
                const GAS v4u* up = (const GAS v4u*)(UB + (size_t)e * DM); const GAS v4u* vp = (const GAS v4u*)(VB + (size_t)e * DM);
                ua[u] = up[lane]; ub[u] = up[64 + lane]; va[u] = vp[lane]; vb[u] = vp[64 + lane]; }
#pragma unroll
            for (int u = 0; u < 4; ++u) {
                float f[16]; unpack8(ua[u], f); unpack8(ub[u], f + 8);
                float d = 0.f;
#pragma unroll
                for (int k = 0; k < 16; ++k) d += x[k] * f[k];
                d = wave_sum(d);
                const float a = 0.5f * d * (1.f + erff(d * 0.70710678118654752f)) * gt[u];
                unpack8(va[u], f); unpack8(vb[u], f + 8);
#pragma unroll
                for (int k = 0; k < 16; ++k) acc[k] += a * f[k];
            }
        }
        float* hrow = F.out + (size_t)t * DM;
        f32x4 h0 = *(const GAS f32x4*)(hrow + lane * 8), h1 = *(const GAS f32x4*)(hrow + lane * 8 + 4), h2 = *(const GAS f32x4*)(hrow + 512 + lane * 8), h3 = *(const GAS f32x4*)(hrow + 512 + lane * 8 + 4);
        float hv[16];
#pragma unroll
        for (int k = 0; k < 4; ++k) { hv[k] = h0[k] + acc[k]; hv[4 + k] = h1[k] + acc[4 + k]; hv[8 + k] = h2[k] + acc[8 + k]; hv[12 + k] = h3[k] + acc[12 + k]; }
        float ss = 0.f;
#pragma unroll
        for (int k = 0; k < 16; ++k) ss += hv[k] * hv[k];
        const float rstd = 1.f / sqrtf(wave_sum(ss) * (1.f / DM) + RMS_EPS);
        const f32x4 n0 = *(const GAS f32x4*)(nf + lane * 8), n1 = *(const GAS f32x4*)(nf + lane * 8 + 4), n2 = *(const GAS f32x4*)(nf + 512 + lane * 8), n3 = *(const GAS f32x4*)(nf + 512 + lane * 8 + 4);
        f32x4 o0, o1, o2, o3;
#pragma unroll
        for (int k = 0; k < 4; ++k) { o0[k] = hv[k] * rstd * n0[k]; o1[k] = hv[4 + k] * rstd * n1[k]; o2[k] = hv[8 + k] * rstd * n2[k]; o3[k] = hv[12 + k] * rstd * n3[k]; }
        *(GAS f32x4*)(hrow + lane * 8) = o0; *(GAS f32x4*)(hrow + lane * 8 + 4) = o1; *(GAS f32x4*)(hrow + 512 + lane * 8) = o2; *(GAS f32x4*)(hrow + 512 + lane * 8 + 4) = o3;
    }
}

struct Args { const float* in[21]; float* out; unsigned char* ws; int ph_lo, ph_hi; };
static_assert(sizeof(Args) == 21 * 8 + 8 + 8 + 8, "Args has no padding");

__global__ void __launch_bounds__(NTHREADS, 2) fwd_kernel(Args args) {
    extern __shared__ __attribute__((aligned(16))) unsigned char lds[];
    Frame F;
    F.lds = (LAS unsigned char*)lds;
    F.MISC = (volatile LAS unsigned*)(F.lds + MISC_OFF);
    F.tid = threadIdx.x; F.lane = F.tid & 63; F.wave = __builtin_amdgcn_readfirstlane(F.tid >> 6);
    F.G = gridDim.x; F.wg = blockIdx.x;
#pragma unroll
    for (int i = 0; i < 21; ++i) F.in[i] = args.in[i];
    F.out = args.out; F.ws = args.ws;
    F.ctl = (gu32*)(args.ws + WS_CTL);
    for (int u = F.tid; u < (LDS_BYTES - LDSCTL_OFF) / 4; u += NTHREADS) ((LAS unsigned*)(F.lds + LDSCTL_OFF))[u] = 0u;
    __syncthreads();
    const int lo = args.ph_lo, hi = args.ph_hi;
    const bool fused = (hi - lo) > 1;
    XcdBarrier bar; bar.bar = (unsigned*)(F.ctl + CW_BAR); bar.x = 0; bar.st = nullptr;
    if (fused) bar = xcd_barrier_post((unsigned*)(F.ctl + CW_BAR), F.MISC + 8);
#define IN(k) (lo <= (k) && (k) < hi)
#define SEAM(k) do { if (IN(k) && IN((k) + 1)) xcd_barrier(bar); } while (0)

    if (IN(0)) { p0_prologue(F); SEAM(0); }
    if (IN(1)) {
        pg8::Gemm g{(const bf16*)(F.ws + WS_XN), (const bf16*)(F.ws + WS_WIN), T, IN_COLS, DM}; pg8::StaticOrder S; S.init(T, IN_COLS, F.G, F.wg);
        pg8::EpiBf16 E{(bf16*)(F.ws + WS_Z), IN_COLS};
        pg8::gemm_phase<pg8::EpiBf16, pg8::StaticOrder, true, true>(F.lds + RING_OFF, g, S, E);
        SEAM(1);
    }
    if (IN(2)) { p2_prep(F); SEAM(2); }
    if (IN(3)) { p3_mixers(F); SEAM(3); }
    if (IN(4)) {
        pg8::Gemm g{(const bf16*)(F.ws + WS_YMIX), (const bf16*)(F.ws + WS_WOUT), T, DM, DM}; pg8::StaticOrder S; S.init(T, DM, F.G, F.wg);
        pg8::EpiF32Res E{F.in[0], F.out, DM};
        pg8::gemm_phase<pg8::EpiF32Res, pg8::StaticOrder, true, true>(F.lds + RING_OFF, g, S, E);
        SEAM(4);
    }
    if (IN(5)) { p5_xn2(F); SEAM(5); }
    if (IN(6)) {
        pg8::Gemm g{(const bf16*)(F.ws + WS_XN), (const bf16*)(F.ws + WS_WQ), T, PQ, DM}; pg8::StaticOrder S; S.init(T, PQ, F.G, F.wg);
        pg8::EpiBf16 E{(bf16*)(F.ws + WS_QP), PQ};
        pg8::gemm_phase<pg8::EpiBf16, pg8::StaticOrder, true, true>(F.lds + RING_OFF, g, S, E);
        SEAM(6);
    }
    if (IN(7)) { p7_topk(F); SEAM(7); }
    if (IN(8)) { p8_gather(F); }
#undef IN
#undef SEAM
}

extern "C" void kernel_launch(void* const* d_in, const int* in_sizes, int n_in, void* d_out, int out_size, void* d_ws, size_t ws_size, hipStream_t stream) {
    static int grid = 0;
    if (grid == 0) {
        if (n_in != 21 || in_sizes[0] != T * DM || out_size != T * DM || ws_size < WS_END) {
            fprintf(stderr, "kernel_launch: unexpected shapes: n_in %d in0 %d out %d ws %zu (need %zu); nothing launched\n", n_in, n_in > 0 ? in_sizes[0] : -1, out_size, ws_size, (size_t)WS_END); grid = -1; return; }
        int dev = 0, cus = 0, per_cu = 0;
        if (hipGetDevice(&dev) != hipSuccess || hipDeviceGetAttribute(&cus, hipDeviceAttributeMultiprocessorCount, dev) != hipSuccess) { grid = -1; return; }
        if (hipFuncSetAttribute((const void*)fwd_kernel, hipFuncAttributeMaxDynamicSharedMemorySize, LDS_BYTES) != hipSuccess) { fprintf(stderr, "kernel_launch: hipFuncSetAttribute failed\n"); grid = -1; return; }
        if (hipOccupancyMaxActiveBlocksPerMultiprocessor(&per_cu, (const void*)fwd_kernel, NTHREADS, LDS_BYTES) != hipSuccess || per_cu < 1) { fprintf(stderr, "kernel_launch: occupancy query says %d\n", per_cu); per_cu = 1; }
        (void)hipGetLastError();
        grid = cus;
    }
    if (grid < 0) return;
    (void)hipMemsetAsync((char*)d_ws + WS_CTL, 0, CTL_ZERO_BYTES, stream);
    Args a{};
    for (int i = 0; i < 21; ++i) a.in[i] = (const float*)d_in[i];
    a.out = (float*)d_out; a.ws = (unsigned char*)d_ws;
    if (MK_N_LAUNCHES == 1) {
        a.ph_lo = 0; a.ph_hi = NPHASE;
        void* kargs[] = {&a};
        hipError_t e = hipLaunchCooperativeKernel((const void*)fwd_kernel, dim3(grid), dim3(NTHREADS), kargs, LDS_BYTES, stream);
        if (e != hipSuccess) fprintf(stderr, "kernel_launch: cooperative launch failed: %s (grid %d)\n", hipGetErrorString(e), grid);
    } else {
        for (int p = 0; p < NPHASE; ++p) { a.ph_lo = p; a.ph_hi = p + 1;
            hipLaunchKernelGGL(fwd_kernel, dim3(grid), dim3(NTHREADS), LDS_BYTES, stream, a); }
    }
}
```

```cpp
#include <hip/hip_runtime.h>
#include <cstdio>
#include <cstdint>

#ifndef MK_N_LAUNCHES
#define MK_N_LAUNCHES 1
#endif

#define GAS __attribute__((address_space(1)))
#define LAS __attribute__((address_space(3)))
typedef unsigned short bf16;
typedef unsigned v4u __attribute__((ext_vector_type(4)));
typedef unsigned v2u __attribute__((ext_vector_type(2)));
typedef float f32x4 __attribute__((ext_vector_type(4)));
typedef float f32x2 __attribute__((ext_vector_type(2)));
typedef short bf16x8 __attribute__((ext_vector_type(8)));
typedef GAS unsigned gu32;
#define RLX_AGENT __ATOMIC_RELAXED, __HIP_MEMORY_SCOPE_AGENT
#define LDS_WAIT() asm volatile("s_waitcnt lgkmcnt(0)" ::: "memory")
#define VM_WAIT() asm volatile("s_waitcnt vmcnt(0)" ::: "memory")

constexpr int DM = 1024, NB = 4, SEQ = 8192, T = NB * SEQ;
constexpr int HD = 64, RWW = 512, NHR = 8, NHA = 8;
constexpr int IN_COLS = 3328;
constexpr int C_R = 0, C_K = 512, C_V = 1024, C_WD = 1536, C_AD = 1600, C_GD = 1664, C_AQ = 1792, C_AK = 2304, C_AV = 2816;
constexpr int PHEADS = 8, NKEYS = 128, PQ = 2048, TOPK = 16, NEXP = 16384;
constexpr float RMS_EPS = 1e-6f, GN_EPS = 64e-5f;
constexpr int NWAVES = 8, NTHREADS = 512;
constexpr int NPHASE = 10;

constexpr size_t MiB = 1u << 20;
constexpr size_t WS_CTL = 0, CTL_ZERO_BYTES = 1 * MiB;
constexpr size_t WS_WIN = 2 * MiB;
constexpr size_t WS_WOUT = 10 * MiB;
constexpr size_t WS_WQ = 12 * MiB;
constexpr size_t WS_XN = 16 * MiB;
constexpr size_t WS_Z = 80 * MiB;
constexpr size_t WS_QP = 80 * MiB;
constexpr size_t WS_G = 288 * MiB;
constexpr size_t WS_YMIX = 352 * MiB;
constexpr size_t WS_UB = 416 * MiB;
constexpr size_t WS_VB = 448 * MiB;
constexpr size_t WS_EID = 480 * MiB;
constexpr size_t WS_GATE = 496 * MiB;
constexpr size_t WS_END = 512 * MiB;
constexpr size_t WS_WUPT = 1 * MiB, WS_AUPT = WS_WUPT + 65536, WS_GUPT = WS_AUPT + 65536;
constexpr size_t WS_BONUS = 9 * MiB;
constexpr size_t WS_RWY0 = WS_XN;
constexpr size_t WS_RWSS = WS_G;
constexpr size_t WS_RWRH = WS_EID;

constexpr int CW_BAR = 4096;

__device__ __forceinline__ unsigned f2bf(float f) { unsigned u = __builtin_bit_cast(unsigned, f); return (u + 0x7fffu + ((u >> 16) & 1u)) >> 16; }
__device__ __forceinline__ unsigned pk2(float lo, float hi) { return f2bf(lo) | (f2bf(hi) << 16); }
__device__ __forceinline__ float bflo(unsigned u) { return __builtin_bit_cast(float, u << 16); }
__device__ __forceinline__ float bfhi(unsigned u) { return __builtin_bit_cast(float, u & 0xffff0000u); }
__device__ __forceinline__ float bf2f(bf16 h) { return __builtin_bit_cast(float, (unsigned)h << 16); }

template <int CTRL> __device__ __forceinline__ float dppf(float x) { return __builtin_bit_cast(float, __builtin_amdgcn_update_dpp(0, __builtin_bit_cast(int, x), CTRL, 0xF, 0xF, true)); }
template <int CTRL> __device__ __forceinline__ int dppi(int x) { return __builtin_amdgcn_update_dpp(0, x, CTRL, 0xF, 0xF, true); }
__device__ __forceinline__ float rdlane(float v, int l) { return __builtin_bit_cast(float, __builtin_amdgcn_readlane(__builtin_bit_cast(int, v), l)); }
__device__ __forceinline__ float sum8(float v) { v += dppf<0xB1>(v); v += dppf<0x4E>(v); v += dppf<0x141>(v); return v; }
__device__ __forceinline__ float sum16(float v) { v = sum8(v); v += dppf<0x140>(v); return v; }
__device__ __forceinline__ float wave_sum(float v) { v = sum16(v); return (rdlane(v, 0) + rdlane(v, 16)) + (rdlane(v, 32) + rdlane(v, 48)); }
__device__ __forceinline__ float wave_max(float v) {
    v = fmaxf(v, dppf<0xB1>(v)); v = fmaxf(v, dppf<0x4E>(v)); v = fmaxf(v, dppf<0x141>(v)); v = fmaxf(v, dppf<0x140>(v));
    return fmaxf(fmaxf(rdlane(v, 0), rdlane(v, 16)), fmaxf(rdlane(v, 32), rdlane(v, 48)));
}
__device__ __forceinline__ int wave_min_i(int v) {
    v = min(v, dppi<0xB1>(v)); v = min(v, dppi<0x4E>(v)); v = min(v, dppi<0x141>(v)); v = min(v, dppi<0x140>(v));
    return min(min(__builtin_amdgcn_readlane(v, 0), __builtin_amdgcn_readlane(v, 16)), min(__builtin_amdgcn_readlane(v, 32), __builtin_amdgcn_readlane(v, 48)));
}

namespace pg8 {
#define PG8_LAS __attribute__((address_space(3)))
typedef unsigned short bf16_t;
typedef unsigned u32x4 __attribute__((ext_vector_type(4)));
constexpr int BM = 256, BK = 64, HALF = 128, HTB = HALF * BK * 2, STAGE_BYTES = 8 * HTB, NXCD = 8, WGM = 8;
__host__ __device__ __forceinline__ int lds_byte(int r, int c) { const int st = (r >> 4) * 2 + (c >> 5), rr = r & 15, cc = c & 31, ob = rr * 64 + cc * 2; return st * 1024 + (ob ^ (((ob >> 9) & 1) << 5)); }
__host__ __device__ __forceinline__ void stage_rc(int b, int& R, int& C) { const int st = b / 1024, sb = b % 1024, swz = sb ^ (((sb >> 9) & 1) << 5); R = (st >> 1) * 16 + swz / 64; C = (st & 1) * 32 + (swz % 64) / 2; }
__host__ __device__ __forceinline__ int perm32(int rho) { const int n = rho >> 4, i = rho & 15; return 8 * (i >> 2) + 4 * n + (i & 3); }
struct Unit { int pm, pn; };
struct Gemm { const bf16_t* A; const bf16_t* Bt; int M, N, K; };
struct StaticOrder {
    int nM, nN, nwg, G, c;
    __host__ __device__ void init(int M, int N, int G_, int c_) { nM = M / BM; nN = N / BM; nwg = nM * nN; G = G_; c = c_; }
    __host__ __device__ bool next(int i, Unit& u) const {
        const long L = (long)i * G + c; if (L >= nwg) return false;
        int wgid = (int)L; { const int q = nwg / NXCD, r = nwg % NXCD, xcd = wgid % NXCD, off = wgid / NXCD; wgid = (xcd < r ? xcd * (q + 1) : r * (q + 1) + (xcd - r) * q) + off; }
        const int nig = WGM * nN, gid = wgid / nig, fm = gid * WGM, gsz = (nM - fm) < WGM ? (nM - fm) : WGM;
        u.pm = fm + ((wgid % nig) % gsz); u.pn = (wgid % nig) / gsz; return true;
    }
    __device__ __forceinline__ void a_ready(const Unit&) const {}
    __device__ __forceinline__ void done(const Unit&) const {}
};
__device__ __forceinline__ unsigned cvt_pk_bf16(float lo, float hi) { unsigned r; asm volatile("v_cvt_pk_bf16_f32 %0, %1, %2" : "=v"(r) : "v"(lo), "v"(hi)); return r; }
struct EpiBf16 {
    static constexpr bool PERM = true, AFTER_DRAIN = false;
    bf16_t* O; int ldc;
    __device__ __forceinline__ void operator()(const f32x4 (&acc)[2][2][4][2], const Unit& u, int wr, int wc, int fr, int fq) const {
        const int row0 = u.pm * BM + wr * 64 + fr; const int col0 = u.pn * BM + wc * 32 + 8 * fq;
#pragma unroll
        for (int ai = 0; ai < 2; ++ai)
#pragma unroll
            for (int m = 0; m < 4; ++m) { bf16_t* rowp = O + (size_t)(row0 + ai * HALF + m * 16) * ldc + col0;
#pragma unroll
                for (int bj = 0; bj < 2; ++bj) { const f32x4 v0 = acc[ai][bj][m][0], v1 = acc[ai][bj][m][1];
                    u32x4 w; w.x = cvt_pk_bf16(v0[0], v0[1]); w.y = cvt_pk_bf16(v0[2], v0[3]); w.z = cvt_pk_bf16(v1[0], v1[1]); w.w = cvt_pk_bf16(v1[2], v1[3]);
                    *(u32x4*)(rowp + bj * HALF) = w; } }
    }
};
struct EpiF32Res {
    static constexpr bool PERM = true, AFTER_DRAIN = false;
    const float* res; float* O; int ldc;
    __device__ __forceinline__ void operator()(const f32x4 (&acc)[2][2][4][2], const Unit& u, int wr, int wc, int fr, int fq) const {
        const int row0 = u.pm * BM + wr * 64 + fr; const int col0 = u.pn * BM + wc * 32 + 8 * fq;
#pragma unroll
        for (int ai = 0; ai < 2; ++ai)
#pragma unroll
            for (int m = 0; m < 4; ++m) { const size_t off = (size_t)(row0 + ai * HALF + m * 16) * ldc + col0;
#pragma unroll
                for (int bj = 0; bj < 2; ++bj) { const f32x4 r0 = *(const f32x4*)(res + off + bj * HALF), r1 = *(const f32x4*)(res + off + bj * HALF + 4);
                    *(f32x4*)(O + off + bj * HALF) = acc[ai][bj][m][0] + r0; *(f32x4*)(O + off + bj * HALF + 4) = acc[ai][bj][m][1] + r1; } }
    }
};

template <class Epi, class Sched, bool ALIGN_EPI = false, bool SP2 = false>
__device__ __forceinline__ void gemm_phase(PG8_LAS unsigned char* lds, const Gemm g, const Sched& S, const Epi& E) {
    const int tid = threadIdx.x, wid = __builtin_amdgcn_readfirstlane(tid >> 6), lane = tid & 63, wr = wid >> 2, wc = wid & 3, fr = lane & 15, fq = lane >> 4;
    const int K = g.K, nt = K / BK;
    unsigned voffA[2], voffB[2];
#pragma unroll
    for (int i = 0; i < 2; ++i) { int R, C; stage_rc(tid * 16 + i * 8192, R, C); const int Rb = Epi::PERM ? ((R & ~31) + perm32(R & 31)) : R;
        voffA[i] = (unsigned)(R * K + C) * 2u; voffB[i] = (unsigned)(Rb * K + C) * 2u; }
    const size_t kstep = (size_t)(BK * 2);
    const size_t hstep = (size_t)HALF * K * 2;
    const size_t tstep = 2 * hstep;
    const unsigned ldsw = (unsigned)wid * 1024u;
    const int aoff = lds_byte(wr * 64 + fr, fq * 8), boff = lds_byte(wc * 32 + fr, fq * 8);
#define PG8_SA(b, h) (((b) * 2 + (h)) * HTB)
#define PG8_SB(b, h) ((4 + (b) * 2 + (h)) * HTB)
#define PG8_STAGE(bufoff, gbase, voff) do { _Pragma("unroll") for (int _i = 0; _i < 2; ++_i) \
        __builtin_amdgcn_global_load_lds((const unsigned*)((const char*)(gbase) + (voff)[_i]), (PG8_LAS unsigned*)(lds + (bufoff) + ldsw + _i * 8192), 16, 0, 0); } while (0)
#define PG8_LDA(dst, b, h) do { _Pragma("unroll") for (int m = 0; m < 4; ++m) _Pragma("unroll") for (int k = 0; k < 2; ++k) dst[m][k] = *(const PG8_LAS bf16x8*)(lds + PG8_SA(b, h) + aoff + m * 2048 + k * 1024); } while (0)
#define PG8_LDB(dst, b, h) do { _Pragma("unroll") for (int n = 0; n < 2; ++n) _Pragma("unroll") for (int k = 0; k < 2; ++k) dst[n][k] = *(const PG8_LAS bf16x8*)(lds + PG8_SB(b, h) + boff + n * 2048 + k * 1024); } while (0)
#define PG8_MMA(ai, bj, At, Bt) do { __builtin_amdgcn_s_setprio(1); _Pragma("unroll") for (int m = 0; m < 4; ++m) _Pragma("unroll") for (int n = 0; n < 2; ++n) _Pragma("unroll") for (int k = 0; k < 2; ++k) \
        acc[ai][bj][m][n] = __builtin_amdgcn_mfma_f32_16x16x32_bf16(Bt[n][k], At[m][k], acc[ai][bj][m][n], 0, 0, 0); __builtin_amdgcn_s_setprio(0); } while (0)
#define PG8_WAIT_V(n) asm volatile("s_waitcnt vmcnt(" #n ")" ::: "memory")
#define PG8_WAIT_L(n) asm volatile("s_waitcnt lgkmcnt(" #n ")" ::: "memory")
#define PG8_BAR __builtin_amdgcn_s_barrier()
#define PG8_SCHED __builtin_amdgcn_sched_barrier(0)
    Unit cur, nxt; int ui = 0;
    if (!S.next(0, cur)) return;
    f32x4 acc[2][2][4][2];
#pragma unroll
    for (int a = 0; a < 2; ++a)
#pragma unroll
        for (int b = 0; b < 2; ++b)
#pragma unroll
            for (int m = 0; m < 4; ++m)
#pragma unroll
                for (int n = 0; n < 2; ++n) acc[a][b][m][n] = (f32x4){0.f, 0.f, 0.f, 0.f};
    bf16x8 At[4][2], B0[2][2], B1[2][2];
    const char* cA = (const char*)g.A + (size_t)cur.pm * tstep; const char* cB = (const char*)g.Bt + (size_t)cur.pn * tstep;
    S.a_ready(cur);
    if constexpr (SP2) {
        PG8_STAGE(PG8_SB(0, 0), cB, voffB); PG8_STAGE(PG8_SB(0, 1), cB + hstep, voffB); PG8_STAGE(PG8_SA(0, 0), cA, voffA); PG8_STAGE(PG8_SA(0, 1), cA + hstep, voffA);
        if (wr == 1) PG8_BAR;
        PG8_WAIT_V(2); PG8_BAR;
        PG8_STAGE(PG8_SB(1, 0), cB + kstep, voffB); PG8_STAGE(PG8_SA(1, 0), cA + kstep, voffA); PG8_STAGE(PG8_SB(1, 1), cB + hstep + kstep, voffB);
        PG8_WAIT_V(6); PG8_BAR;
    } else {
        PG8_STAGE(PG8_SB(0, 0), cB, voffB); PG8_STAGE(PG8_SA(0, 0), cA, voffA); PG8_STAGE(PG8_SB(0, 1), cB + hstep, voffB); PG8_STAGE(PG8_SA(0, 1), cA + hstep, voffA);
        if (wr == 1) PG8_BAR;
        PG8_WAIT_V(4); PG8_BAR;
        PG8_STAGE(PG8_SB(1, 0), cB + kstep, voffB); PG8_STAGE(PG8_SA(1, 0), cA + kstep, voffA); PG8_STAGE(PG8_SB(1, 1), cB + hstep + kstep, voffB);
        PG8_WAIT_V(6); PG8_BAR;
    }
    for (;;) {
        const bool has_next = S.next(ui + 1, nxt);
        const char* nA = has_next ? (const char*)g.A + (size_t)nxt.pm * tstep : cA; const char* nB = has_next ? (const char*)g.Bt + (size_t)nxt.pn * tstep : cB;
        for (int t = 0; t < nt; t += 2) {
            const bool last = (t == nt - 2);
            const char* a1 = cA + (size_t)(t + 1) * kstep;
            const char* a2 = last ? nA : cA + (size_t)(t + 2) * kstep; const char* b2 = last ? nB : cB + (size_t)(t + 2) * kstep;
            const char* a3 = a2 + kstep; const char* b3 = b2 + kstep;
            if (last && has_next) S.a_ready(nxt);
            if constexpr (SP2) {
            PG8_LDB(B0, 0, 0); PG8_LDB(B1, 0, 1); PG8_SCHED; PG8_LDA(At, 0, 0); PG8_STAGE(PG8_SA(1, 1), a1 + hstep, voffA);
            PG8_WAIT_V(8); PG8_WAIT_L(0); PG8_BAR; PG8_MMA(0, 0, At, B0); PG8_MMA(0, 1, At, B1); PG8_BAR; PG8_SCHED;
            PG8_LDA(At, 0, 1); PG8_STAGE(PG8_SB(0, 0), b2, voffB); PG8_STAGE(PG8_SB(0, 1), b2 + hstep, voffB); PG8_STAGE(PG8_SA(0, 0), a2, voffA);
            PG8_WAIT_V(8); PG8_WAIT_L(0); PG8_BAR; PG8_MMA(1, 0, At, B0); PG8_MMA(1, 1, At, B1); PG8_BAR; PG8_SCHED;
            PG8_LDB(B0, 1, 0); PG8_LDB(B1, 1, 1); PG8_SCHED; PG8_LDA(At, 1, 0); PG8_STAGE(PG8_SA(0, 1), a2 + hstep, voffA);
            PG8_WAIT_V(8); PG8_WAIT_L(0); PG8_BAR; PG8_MMA(0, 0, At, B0); PG8_MMA(0, 1, At, B1); PG8_BAR; PG8_SCHED;
            PG8_LDA(At, 1, 1); PG8_STAGE(PG8_SB(1, 0), b3, voffB); PG8_STAGE(PG8_SB(1, 1), b3 + hstep, voffB); PG8_STAGE(PG8_SA(1, 0), a3, voffA);
            PG8_WAIT_V(8); PG8_WAIT_L(0); PG8_BAR; PG8_MMA(1, 0, At, B0); PG8_MMA(1, 1, At, B1); PG8_BAR; PG8_SCHED;
            } else {
            PG8_LDB(B0, 0, 0); PG8_SCHED; PG8_LDA(At, 0, 0); PG8_STAGE(PG8_SA(1, 1), a1 + hstep, voffA);
            PG8_WAIT_L(8); PG8_BAR; PG8_WAIT_L(0); PG8_MMA(0, 0, At, B0); PG8_BAR; PG8_SCHED;
            PG8_LDB(B1, 0, 1); PG8_STAGE(PG8_SB(0, 0), b2, voffB);
            PG8_BAR; PG8_WAIT_L(0); PG8_MMA(0, 1, At, B1); PG8_BAR;
            PG8_LDA(At, 0, 1); PG8_STAGE(PG8_SA(0, 0), a2, voffA);
            PG8_BAR; PG8_WAIT_L(0); PG8_MMA(1, 0, At, B0); PG8_BAR; PG8_SCHED;
            PG8_STAGE(PG8_SB(0, 1), b2 + hstep, voffB);
            PG8_WAIT_V(6); PG8_BAR; PG8_MMA(1, 1, At, B1); PG8_BAR;
            PG8_LDB(B0, 1, 0); PG8_SCHED; PG8_LDA(At, 1, 0); PG8_STAGE(PG8_SA(0, 1), a2 + hstep, voffA);
            PG8_WAIT_L(8); PG8_BAR; PG8_WAIT_L(0); PG8_MMA(0, 0, At, B0); PG8_BAR; PG8_SCHED;
            PG8_LDB(B1, 1, 1); PG8_STAGE(PG8_SB(1, 0), b3, voffB);
            PG8_BAR; PG8_WAIT_L(0); PG8_MMA(0, 1, At, B1); PG8_BAR;
            PG8_LDA(At, 1, 1); PG8_STAGE(PG8_SA(1, 0), a3, voffA);
            PG8_BAR; PG8_WAIT_L(0); PG8_MMA(1, 0, At, B0); PG8_BAR; PG8_SCHED;
            PG8_STAGE(PG8_SB(1, 1), b3 + hstep, voffB);
            PG8_WAIT_V(6); PG8_BAR; PG8_MMA(1, 1, At, B1); PG8_BAR;
            }
        }
        if constexpr (ALIGN_EPI) { if (wr == 0) PG8_BAR; }
        if constexpr (!Epi::AFTER_DRAIN) { E(acc, cur, wr, wc, fr, fq); S.done(cur); }
        if (!has_next) break;
#pragma unroll
        for (int a = 0; a < 2; ++a)
#pragma unroll
            for (int b = 0; b < 2; ++b)
#pragma unroll
                for (int m = 0; m < 4; ++m)
#pragma unroll
                    for (int n = 0; n < 2; ++n) acc[a][b][m][n] = (f32x4){0.f, 0.f, 0.f, 0.f};
        cur = nxt; cA = nA; cB = nB; ++ui;
        if constexpr (ALIGN_EPI) { if (wr == 1) PG8_BAR; }
    }
    PG8_WAIT_V(0);
    if constexpr (!ALIGN_EPI) { if (wr == 0) PG8_BAR; }
    PG8_BAR;
#undef PG8_SA
#undef PG8_SB
#undef PG8_STAGE
#undef PG8_LDA
#undef PG8_LDB
#undef PG8_MMA
#undef PG8_WAIT_V
#undef PG8_WAIT_L
#undef PG8_BAR
#undef PG8_SCHED
}
}

#define XB_TMO      128
#define XB_XCNT(j)  (256  + 64 * (j))
#define XB_XSUB(j)  (1280 + 64 * (j))
#define XB_XGEN(j)  (2304 + 64 * (j))
#define XB_TOP      3328
#define XB_TOPGEN   3392
#define XCD_BAR_WORDS 3456
#define XB_SPIN_CAP (1u << 22)
__device__ __forceinline__ unsigned xb_ld(unsigned* p)              { return __hip_atomic_load(p, __ATOMIC_RELAXED, __HIP_MEMORY_SCOPE_AGENT); }
__device__ __forceinline__ unsigned xb_add(unsigned* p, unsigned v) { return __hip_atomic_fetch_add(p, v, __ATOMIC_RELAXED, __HIP_MEMORY_SCOPE_AGENT); }
__device__ __forceinline__ unsigned xb_xcc_id() { return (unsigned)__builtin_amdgcn_s_getreg((3 << 11) | 20) & 0xFu; }
#define XB_SPIN(cond, bar) do { unsigned _sp = 0; while (cond) { __builtin_amdgcn_s_sleep(1); \
    if ((++_sp & 255u) == 0u) { if (xb_ld(&(bar)[XB_TMO])) break; if (_sp > XB_SPIN_CAP) { atomicAdd(&(bar)[XB_TMO], 1u); break; } } } } while (0)
struct XcdBarrier { unsigned* bar; unsigned x; volatile LAS unsigned* st; };
__device__ __forceinline__ XcdBarrier xcd_barrier_post(unsigned* bar, volatile LAS unsigned* st) {
    XcdBarrier b; b.bar = bar; b.x = xb_xcc_id(); b.st = st;
    if (threadIdx.x == 0) (void)xb_add(&bar[XB_XCNT(b.x)], 1u);
    return b;
}
__device__ __forceinline__ void xcd_barrier_complete(unsigned* bar, unsigned x, unsigned& nloc, unsigned& nx) {
    const unsigned G = gridDim.x * gridDim.y * gridDim.z;
    unsigned sum, cnt, mine, sp = 0u;
    for (;;) {
        sum = 0u; cnt = 0u; mine = 0u;
#pragma unroll
        for (unsigned j = 0; j < 16; ++j) { const unsigned c = xb_ld(&bar[XB_XCNT(j)]); sum += c; cnt += (c > 0u) ? 1u : 0u; mine = (j == x) ? c : mine; }
        if (sum == G) break;
        __builtin_amdgcn_s_sleep(1);
        if ((++sp & 255u) == 0u) { if (xb_ld(&bar[XB_TMO])) break; if (sp > XB_SPIN_CAP) { atomicAdd(&bar[XB_TMO], 1u); break; } }
    }
    nloc = mine > 0u ? mine : 1u; nx = cnt > 0u ? cnt : 1u;
}
__device__ __forceinline__ void xcd_barrier(const XcdBarrier& b) {
    asm volatile("s_waitcnt vmcnt(0)" ::: "memory");
    __syncthreads();
    if (threadIdx.x == 0) {
        unsigned* bar = b.bar;
        __builtin_amdgcn_s_waitcnt(0);
        unsigned nloc = b.st[0], nx = b.st[1];
        if (nloc == 0u) { xcd_barrier_complete(bar, b.x, nloc, nx); b.st[0] = nloc; b.st[1] = nx; }
        const unsigned old = xb_add(&bar[XB_XSUB(b.x)], 1u);
        const unsigned gen = old / nloc;
        if (old + 1u == (gen + 1u) * nloc) {
            __builtin_amdgcn_fence(__ATOMIC_RELEASE, "agent");
            asm volatile("s_waitcnt vmcnt(0)" ::: "memory");
            const unsigned og = xb_add(&bar[XB_TOP], 1u);
            const unsigned tg = og / nx;
            if (og + 1u == (tg + 1u) * nx) xb_add(&bar[XB_TOPGEN], 1u);
            else XB_SPIN(xb_ld(&bar[XB_TOPGEN]) == tg, bar);
            __builtin_amdgcn_fence(__ATOMIC_ACQUIRE, "agent");
            xb_add(&bar[XB_XGEN(b.x)], 1u);
            asm volatile("s_waitcnt vmcnt(0)" ::: "memory");
        } else {
            XB_SPIN(xb_ld(&bar[XB_XGEN(b.x)]) == gen, bar);
            __builtin_amdgcn_fence(__ATOMIC_ACQUIRE, "agent");
            asm volatile("s_waitcnt vmcnt(0)" ::: "memory");
        }
    }
    __syncthreads();
}

constexpr int RING_OFF = 0, RING_BYTES = 131072;
constexpr int LDSCTL_OFF = 143360, MISC_OFF = LDSCTL_OFF + 320;
constexpr int LDS_BYTES = 147456;

struct Frame {
    LAS unsigned char* lds;
    volatile LAS unsigned* MISC;
    gu32* ctl;
    int tid, lane, wave, G, wg;
    const float* in[21];
    float* out;
    unsigned char* ws;
};

__device__ __forceinline__ void p0_transpose_item(const float* W, int K, int N, bf16* WT, LAS float* scr, int item, int lane) {
    const int nblk = N / 32, kb = item / nblk, nb = item % nblk, k0 = 64 * kb, n0 = 32 * nb;
#pragma unroll 8
    for (int i = 0; i < 32; ++i) { const int kk = 2 * i + (lane >> 5); scr[kk * 33 + (lane & 31)] = W[(size_t)(k0 + kk) * N + n0 + (lane & 31)]; }
    LDS_WAIT(); asm volatile("" ::: "memory");
    const int c = lane & 7;
#pragma unroll
    for (int j = 0; j < 4; ++j) { const int n = (lane >> 3) + 8 * j; const LAS float* s = scr + (8 * c) * 33 + n;
        v4u o; o.x = pk2(s[0 * 33], s[1 * 33]); o.y = pk2(s[2 * 33], s[3 * 33]); o.z = pk2(s[4 * 33], s[5 * 33]); o.w = pk2(s[6 * 33], s[7 * 33]);
        *(GAS v4u*)(WT + (size_t)(n0 + n) * K + k0 + 8 * c) = o; }
    LDS_WAIT(); asm volatile("" ::: "memory");
}
__device__ __forceinline__ void rms_row_to_bf16(int lane, const float* xrow, const float* gain, bf16* orow) {
    const GAS f32x4* xr = (const GAS f32x4*)xrow + lane;
    const GAS f32x4* gr = (const GAS f32x4*)gain + lane;
    f32x4 v[4]; float s = 0.f;
#pragma unroll
    for (int j = 0; j < 4; ++j) { v[j] = xr[64 * j]; s += (v[j].x * v[j].x + v[j].y * v[j].y) + (v[j].z * v[j].z + v[j].w * v[j].w); }
    const float rstd = 1.f / sqrtf(wave_sum(s) * (1.f / DM) + RMS_EPS);
    GAS unsigned long long* o8 = (GAS unsigned long long*)orow + lane;
#pragma unroll
    for (int j = 0; j < 4; ++j) { const f32x4 gg = gr[64 * j];
        o8[64 * j] = (unsigned long long)pk2(v[j].x * rstd * gg.x, v[j].y * rstd * gg.y) | ((unsigned long long)pk2(v[j].z * rstd * gg.z, v[j].w * rstd * gg.w) << 32); }
}
__device__ __forceinline__ void cvt_row_to_bf16(int lane, const float* xrow, bf16* orow) {
    const GAS f32x4* xr = (const GAS f32x4*)xrow + lane;
    GAS unsigned long long* o8 = (GAS unsigned long long*)orow + lane;
#pragma unroll
    for (int j = 0; j < 4; ++j) { const f32x4 v = xr[64 * j]; o8[64 * j] = (unsigned long long)pk2(v.x, v.y) | ((unsigned long long)pk2(v.z, v.w) << 32); }
}
__device__ __forceinline__ void p0_prologue(Frame& F) {
    LAS float* scr = (LAS float*)(F.lds + RING_OFF + F.wave * 16384);
    const int gw = F.wg * NWAVES + F.wave, NGW = F.G * NWAVES;
    constexpr int I_IN = (DM / 64) * (IN_COLS / 32), I_OUT = (DM / 64) * (DM / 32), I_Q = (DM / 64) * (PQ / 32);
    constexpr int NITEMS = I_IN + I_OUT + I_Q;
    bf16* win_t = (bf16*)(F.ws + WS_WIN); bf16* wout_t = (bf16*)(F.ws + WS_WOUT); bf16* wq_t = (bf16*)(F.ws + WS_WQ);
    for (int it = gw; it < NITEMS; it += NGW) {
        int r = it;
        if (r < I_IN) { p0_transpose_item(F.in[2], DM, IN_COLS, win_t, scr, r, F.lane); continue; } r -= I_IN;
        if (r < I_OUT) { p0_transpose_item(F.in[14], DM, DM, wout_t, scr, r, F.lane); continue; } r -= I_OUT;
        p0_transpose_item(F.in[16], DM, PQ, wq_t, scr, r, F.lane);
    }
    {
        constexpr int I_W = (64 / 64) * (RWW / 32), I_G = (128 / 64) * (RWW / 32);
        for (int it = gw; it < 2 * I_W + I_G; it += NGW) {
            int r = it;
            if (r < I_W) { p0_transpose_item(F.in[5], 64, RWW, (bf16*)(F.ws + WS_WUPT), scr, r, F.lane); continue; } r -= I_W;
            if (r < I_W) { p0_transpose_item(F.in[7], 64, RWW, (bf16*)(F.ws + WS_AUPT), scr, r, F.lane); continue; } r -= I_W;
            p0_transpose_item(F.in[8], 128, RWW, (bf16*)(F.ws + WS_GUPT), scr, r, F.lane);
        }
    }
    bf16* XN = (bf16*)(F.ws + WS_XN);
    for (int m = gw; m < T; m += NGW) rms_row_to_bf16(F.lane, F.in[0] + (size_t)m * DM, F.in[1], XN + (size_t)m * DM);
    bf16* UB = (bf16*)(F.ws + WS_UB); bf16* VB = (bf16*)(F.ws + WS_VB);
    for (int m = gw; m < NEXP; m += NGW) { cvt_row_to_bf16(F.lane, F.in[18] + (size_t)m * DM, UB + (size_t)m * DM); cvt_row_to_bf16(F.lane, F.in[19] + (size_t)m * DM, VB + (size_t)m * DM); }
}

__device__ __forceinline__ void p2_rope(Frame& F) {
    bf16* Z = (bf16*)(F.ws + WS_Z);
    const int tid = F.tid, i = tid & 31, grp = tid >> 5;
    const float inv_freq = powf(10000.0f, -(float)(2 * i) / 64.0f);
    for (int blk = F.wg; blk < T / 16; blk += F.G) {
        for (int k = 0; k < 16; ++k) { const int g = blk * 16 + k, s = g & (SEQ - 1);
            const float ang = (float)s * inv_freq;
            const double r = (double)ang - rint((double)ang * 0.15915494309189535) * 6.283185307179586;
            const float rf = (float)r; const float cs = cosf(rf), sn = sinf(rf);
            bf16* p = Z + (size_t)g * IN_COLS + C_AQ + grp * 64 + i;
            const float x1 = bf2f(p[0]), x2 = bf2f(p[32]);
            p[0] = (bf16)f2bf(x1 * cs - x2 * sn); p[32] = (bf16)f2bf(x1 * sn + x2 * cs); }
    }
}

typedef float f32x16 __attribute__((ext_vector_type(16)));
constexpr int SBS = 144;
constexpr int R1_EPRE = 0, R1_APRE = 16384, R1_AAB = 0, R1_X = 16384;
constexpr int R1_AT = 32768, R1_BT = 41984, R1_KT = 51200, R1_RT = 60416, R1_AHT = R1_BT, R1_U0T = R1_KT;
constexpr int R1_BBT = 69632, R1_KBT = 78848, R1_VT = 88064;
constexpr int R1_ACTW = 97280, R1_ACTA = 106496, R1_AAK = 97280, R1_ARB = 106496, R1_ARK = 115712;
constexpr int R1_BONUS = 124928, R1_WEND = 125184, R1_SEGS = 125440, R1_TII = 125440, R1_END = 129536;
static_assert(R1_END <= LDSCTL_OFF, "R1 LDS");
__device__ __forceinline__ int crow(int r, int hh) { return (r & 3) + 8 * (r >> 2) + 4 * hh; }
template <int KS> __device__ __forceinline__ f32x16 wtile(const LAS unsigned char* A, int sa, const LAS unsigned char* B, int sb, f32x16 acc, int lane) {
    const int row = lane & 31, hh = lane >> 5;
#pragma unroll
    for (int s = 0; s < KS; ++s) { const bf16x8 a = *(const LAS bf16x8*)(A + row * sa + 32 * s + 16 * hh); const bf16x8 b = *(const LAS bf16x8*)(B + row * sb + 32 * s + 16 * hh);
        acc = __builtin_amdgcn_mfma_f32_32x32x16_bf16(a, b, acc, 0, 0, 0); }
    return acc;
}
template <int KS> __device__ __forceinline__ f32x16 wtile_gb(const LAS unsigned char* A, int sa, const bf16* Bg, int ldb, f32x16 acc, int lane) {
    const int row = lane & 31, hh = lane >> 5;
#pragma unroll
    for (int s = 0; s < KS; ++s) { const bf16x8 a = *(const LAS bf16x8*)(A + row * sa + 32 * s + 16 * hh); const bf16x8 b = *(const GAS bf16x8*)(Bg + (size_t)row * ldb + 16 * s + 8 * hh);
        acc = __builtin_amdgcn_mfma_f32_32x32x16_bf16(a, b, acc, 0, 0, 0); }
    return acc;
}
__device__ __forceinline__ f32x16 zero16() { f32x16 z;
#pragma unroll
    for (int r = 0; r < 16; ++r) z[r] = 0.f;
    return z; }

__device__ __forceinline__ void rwkv_r1_item(Frame& F, int item) {
    const int chain = item >> 7, chunk = item & 127, b = chain >> 3, h = chain & 7;
    const int g0 = b * SEQ + chunk * 64;
    int tid_ = F.tid; asm volatile("" : "+v"(tid_));
    const int tid = tid_, lane = tid & 63, w = __builtin_amdgcn_readfirstlane(tid >> 6), hh = lane >> 5, cl = lane & 31;
    const bf16* Z = (const bf16*)(F.ws + WS_Z);
    LAS unsigned char* lds = F.lds + RING_OFF;
    const float* mu = F.in[3];
    {
        const int t = tid >> 3, cg = tid & 7; const bool first = (chunk == 0 && t == 0);
        const bf16* zr = Z + (size_t)(g0 + t) * IN_COLS;
        const v4u cw = *(const GAS v4u*)(zr + C_WD + cg * 8), ca = *(const GAS v4u*)(zr + C_AD + cg * 8);
        v4u pw = (v4u){0u, 0u, 0u, 0u}, pa = (v4u){0u, 0u, 0u, 0u};
        if (!first) { pw = *(const GAS v4u*)(zr - IN_COLS + C_WD + cg * 8); pa = *(const GAS v4u*)(zr - IN_COLS + C_AD + cg * 8); }
        float fw[8], fa[8], qw[8], qa[8];
        fw[0] = bflo(cw.x); fw[1] = bfhi(cw.x); fw[2] = bflo(cw.y); fw[3] = bfhi(cw.y); fw[4] = bflo(cw.z); fw[5] = bfhi(cw.z); fw[6] = bflo(cw.w); fw[7] = bfhi(cw.w);
        fa[0] = bflo(ca.x); fa[1] = bfhi(ca.x); fa[2] = bflo(ca.y); fa[3] = bfhi(ca.y); fa[4] = bflo(ca.z); fa[5] = bfhi(ca.z); fa[6] = bflo(ca.w); fa[7] = bfhi(ca.w);
        qw[0] = bflo(pw.x); qw[1] = bfhi(pw.x); qw[2] = bflo(pw.y); qw[3] = bfhi(pw.y); qw[4] = bflo(pw.z); qw[5] = bfhi(pw.z); qw[6] = bflo(pw.w); qw[7] = bfhi(pw.w);
        qa[0] = bflo(pa.x); qa[1] = bfhi(pa.x); qa[2] = bflo(pa.y); qa[3] = bfhi(pa.y); qa[4] = bflo(pa.z); qa[5] = bfhi(pa.z); qa[6] = bflo(pa.w); qa[7] = bfhi(pa.w);
#pragma unroll
        for (int j = 0; j < 8; ++j) { const int c = cg * 8 + j; fw[j] = tanhf(fw[j] + (qw[j] - fw[j]) * mu[C_WD + c]); fa[j] = fa[j] + (qa[j] - fa[j]) * mu[C_AD + c]; }
        v4u ow, oa; ow.x = pk2(fw[0], fw[1]); ow.y = pk2(fw[2], fw[3]); ow.z = pk2(fw[4], fw[5]); ow.w = pk2(fw[6], fw[7]);
        oa.x = pk2(fa[0], fa[1]); oa.y = pk2(fa[2], fa[3]); oa.z = pk2(fa[4], fa[5]); oa.w = pk2(fa[6], fa[7]);
        *(LAS v4u*)(lds + R1_ACTW + t * SBS + cg * 16) = ow; *(LAS v4u*)(lds + R1_ACTA + t * SBS + cg * 16) = oa;
    }
    __syncthreads();
    {
        const int p = w >> 2, mt = (w >> 1) & 1, nt = w & 1;
        const bf16* upt = (const bf16*)(F.ws + (p == 0 ? WS_WUPT : WS_AUPT)) + (size_t)(h * 64 + nt * 32) * 64;
        const f32x16 acc = wtile_gb<4>(lds + (p == 0 ? R1_ACTW : R1_ACTA) + mt * 32 * SBS, SBS, upt, 64, zero16(), lane);
        LAS float* O = (LAS float*)(lds + (p == 0 ? R1_EPRE : R1_APRE));
#pragma unroll
        for (int r = 0; r < 16; ++r) O[(mt * 32 + crow(r, hh)) * 64 + nt * 32 + cl] = acc[r];
    }
    __syncthreads();
    {
        const int c = tid & 63, ts = tid >> 6, col = h * 64 + c;
        const float mu_r = mu[C_R + col], mu_k = mu[C_K + col], mu_v = mu[C_V + col], kkc = F.in[9][col], kac = F.in[10][col], rkc = F.in[11][col], w0c = F.in[4][col], a0c = F.in[6][col];
        const LAS float* EP = (const LAS float*)(lds + R1_EPRE); const LAS float* AP = (const LAS float*)(lds + R1_APRE);
        LAS float* SEGS = (LAS float*)(lds + R1_SEGS); LAS float* BON = (LAS float*)(lds + R1_BONUS);
        const bf16* zb = Z + (size_t)(g0 + 8 * ts) * IN_COLS + col;
        float pr = 0.f, pk = 0.f, pv = 0.f;
        if (!(chunk == 0 && ts == 0)) { pr = bf2f(zb[C_R - IN_COLS]); pk = bf2f(zb[C_K - IN_COLS]); pv = bf2f(zb[C_V - IN_COLS]); }
        float rr[8], k2[8], ai[8], bi[8], vv[8], ee[8], cs[8]; float run = 0.f;
#pragma unroll
        for (int i = 0; i < 8; ++i) {
            const float zr = bf2f(zb[(size_t)i * IN_COLS + C_R]), zk = bf2f(zb[(size_t)i * IN_COLS + C_K]), zv = bf2f(zb[(size_t)i * IN_COLS + C_V]);
            const float r = zr + (pr - zr) * mu_r, k = zk + (pk - zk) * mu_k, v = zv + (pv - zv) * mu_v; pr = zr; pk = zk; pv = zv;
            const float e = 0.60653066f / (1.f + __expf(-(w0c + EP[(8 * ts + i) * 64 + c])));
            const float a = 1.f / (1.f + __expf(-(a0c + AP[(8 * ts + i) * 64 + c])));
            float kk = k * kkc; const float n2 = wave_sum(kk * kk); kk = kk / fmaxf(sqrtf(n2), 1e-12f);
            const float kq = k * (1.f + (a - 1.f) * kac);
            const float bon = wave_sum(r * kq * rkc); if (c == 0) BON[8 * ts + i] = bon;
            rr[i] = r; k2[i] = kq; ai[i] = -kk; bi[i] = kk * a; vv[i] = v; ee[i] = e; run += e; cs[i] = run;
        }
        SEGS[ts * 64 + c] = run;
        __syncthreads();
        float off = 0.f, tot = 0.f;
#pragma unroll
        for (int q = 0; q < 8; ++q) { const float sv = SEGS[q * 64 + c]; tot += sv; off += (q < ts) ? sv : 0.f; }
        float bb[8], kb[8];
#pragma unroll
        for (int i = 0; i < 8; ++i) { const float L = off + cs[i];
            const float Wm = __expf(-(L - ee[i])), Wi = __expf(-L), iW = __expf(L), We = __expf(-(tot - L));
            const int t = 8 * ts + i;
            *(LAS bf16*)(lds + R1_AT + t * SBS + c * 2) = (bf16)f2bf(ai[i] * Wm);
            *(LAS bf16*)(lds + R1_BT + t * SBS + c * 2) = (bf16)f2bf(bi[i] * iW);
            *(LAS bf16*)(lds + R1_KT + t * SBS + c * 2) = (bf16)f2bf(k2[i] * iW);
            *(LAS bf16*)(lds + R1_RT + t * SBS + c * 2) = (bf16)f2bf(rr[i] * Wi);
            bb[i] = bi[i] * We; kb[i] = k2[i] * We; }
        v4u o; o.x = pk2(bb[0], bb[1]); o.y = pk2(bb[2], bb[3]); o.z = pk2(bb[4], bb[5]); o.w = pk2(bb[6], bb[7]);
        *(LAS v4u*)(lds + R1_BBT + c * SBS + ts * 16) = o;
        o.x = pk2(kb[0], kb[1]); o.y = pk2(kb[2], kb[3]); o.z = pk2(kb[4], kb[5]); o.w = pk2(kb[6], kb[7]);
        *(LAS v4u*)(lds + R1_KBT + c * SBS + ts * 16) = o;
        o.x = pk2(vv[0], vv[1]); o.y = pk2(vv[2], vv[3]); o.z = pk2(vv[4], vv[5]); o.w = pk2(vv[6], vv[7]);
        *(LAS v4u*)(lds + R1_VT + c * SBS + ts * 16) = o;
        if (ts == 0) ((LAS float*)(lds + R1_WEND))[c] = __expf(-tot);
    }
    __syncthreads();
#pragma unroll
    for (int u = 0; u < 2; ++u) {
        const int idx = w * 2 + u, p = idx >> 2, mt = (idx >> 1) & 1, nt = idx & 1;
        const LAS unsigned char* Aop = lds + ((p == 0 || p == 2) ? R1_BT : R1_KT) + mt * 32 * SBS;
        const LAS unsigned char* Bop = lds + (p < 2 ? R1_AT : R1_RT) + nt * 32 * SBS;
        f32x16 acc = wtile<4>(Aop, SBS, Bop, SBS, zero16(), lane);
        const int n = nt * 32 + cl;
#pragma unroll
        for (int r = 0; r < 16; ++r) { const int m = mt * 32 + crow(r, hh); const bool keep = (p < 2) ? (m < n) : (m <= n); acc[r] = keep ? acc[r] : 0.f; }
#pragma unroll
        for (int g4 = 0; g4 < 4; ++g4) { const int m0 = mt * 32 + 8 * g4 + 4 * hh;
            if (p == 0) *(LAS f32x4*)(lds + R1_AAB + (n * 64 + m0) * 4) = (f32x4){acc[4 * g4], acc[4 * g4 + 1], acc[4 * g4 + 2], acc[4 * g4 + 3]};
            else { v2u o; o.x = pk2(acc[4 * g4], acc[4 * g4 + 1]); o.y = pk2(acc[4 * g4 + 2], acc[4 * g4 + 3]);
                   *(LAS v2u*)(lds + (p == 1 ? R1_AAK : (p == 2 ? R1_ARB : R1_ARK)) + n * SBS + m0 * 2) = o; } }
    }
    __syncthreads();
    if (w < 4) {
        const int mt = w >> 1, nt = w & 1;
        const f32x16 acc = wtile<4>(lds + R1_AAK + mt * 32 * SBS, SBS, lds + R1_VT + nt * 32 * SBS, SBS, zero16(), lane);
        LAS float* X = (LAS float*)(lds + R1_X);
#pragma unroll
        for (int r = 0; r < 16; ++r) X[(mt * 32 + crow(r, hh)) * 64 + nt * 32 + cl] = acc[r];
    } else if (w == 4) {
        const int bk = lane >> 4, c = lane & 15;
        const LAS float* AAB = (const LAS float*)(lds + R1_AAB);
        float Tc[16]; const float fc = (float)c;
#pragma unroll
        for (int s2 = 0; s2 < 16; ++s2) { float val = fmaxf(0.f, 1.f - fabsf((float)s2 - fc));
#pragma unroll
            for (int r = 0; r < s2; ++r) val += AAB[(16 * bk + s2) * 64 + 16 * bk + r] * Tc[r];
            Tc[s2] = val; }
        LAS float* TII = (LAS float*)(lds + R1_TII);
#pragma unroll
        for (int s2 = 0; s2 < 16; ++s2) TII[(bk * 16 + s2) * 16 + c] = Tc[s2];
    }
    __syncthreads();
    {
        const int c16 = lane & 15, g = lane >> 4;
        const LAS float* AAB = (const LAS float*)(lds + R1_AAB); const LAS float* TII = (const LAS float*)(lds + R1_TII); const LAS float* X = (const LAS float*)(lds + R1_X);
        f32x4 o[4];
#pragma unroll
        for (int i = 0; i < 4; ++i) {
            f32x4 acc;
            if (w < 4) {
#pragma unroll
                for (int q = 0; q < 4; ++q) acc[q] = bf2f(*(const LAS bf16*)(lds + R1_AT + (16 * i + 4 * g + q) * SBS + (16 * w + c16) * 2));
            } else {
#pragma unroll
                for (int q = 0; q < 4; ++q) acc[q] = X[(16 * i + 4 * g + q) * 64 + 16 * (w - 4) + c16];
            }
#pragma unroll
            for (int j = 0; j < i; ++j) { const f32x4 a4 = *(const LAS f32x4*)(AAB + (16 * i + c16) * 64 + 16 * j + 4 * g);
#pragma unroll
                for (int q = 0; q < 4; ++q) acc = __builtin_amdgcn_mfma_f32_16x16x4f32(a4[q], o[j][q], acc, 0, 0, 0); }
            const f32x4 t4 = *(const LAS f32x4*)(TII + (i * 16 + c16) * 16 + 4 * g);
            f32x4 res = (f32x4){0.f, 0.f, 0.f, 0.f};
#pragma unroll
            for (int q = 0; q < 4; ++q) res = __builtin_amdgcn_mfma_f32_16x16x4f32(t4[q], acc[q], res, 0, 0, 0);
            o[i] = res;
            v2u ov; ov.x = pk2(res[0], res[1]); ov.y = pk2(res[2], res[3]);
            *(LAS v2u*)(lds + (w < 4 ? R1_AHT : R1_U0T) + (16 * (w & 3) + c16) * SBS + (16 * i + 4 * g) * 2) = ov;
        }
    }
    __syncthreads();
    {
        float* Mg = F.out + (size_t)item * 4096; float* NTg = F.out + (size_t)T * RWW + (size_t)item * 4096;
        float* Y0g = (float*)(F.ws + WS_RWY0) + (size_t)item * 4096; bf16* RHg = (bf16*)(F.ws + WS_RWRH) + (size_t)item * 4096;
#pragma unroll
        for (int u = 0; u < 2; ++u) {
            const int idx = w * 2 + u, p = idx >> 2, mt = (idx >> 1) & 1, nt = idx & 1; const int n = nt * 32 + cl;
            if (p == 0) {
                f32x16 acc = wtile<4>(lds + R1_BBT + mt * 32 * SBS, SBS, lds + R1_AHT + nt * 32 * SBS, SBS, zero16(), lane);
                const LAS float* WE = (const LAS float*)(lds + R1_WEND);
#pragma unroll
                for (int r = 0; r < 16; ++r) { const int m = mt * 32 + crow(r, hh); Mg[m * 64 + n] = acc[r] + (m == n ? WE[m] : 0.f); }
            } else if (p == 1) {
                f32x16 acc = wtile<4>(lds + R1_U0T + mt * 32 * SBS, SBS, lds + R1_BBT + nt * 32 * SBS, SBS, zero16(), lane);
                acc = wtile<4>(lds + R1_VT + mt * 32 * SBS, SBS, lds + R1_KBT + nt * 32 * SBS, SBS, acc, lane);
#pragma unroll
                for (int r = 0; r < 16; ++r) NTg[(mt * 32 + crow(r, hh)) * 64 + n] = acc[r];
            } else if (p == 2) {
                f32x16 acc = wtile<4>(lds + R1_AHT + mt * 32 * SBS, SBS, lds + R1_ARB + nt * 32 * SBS, SBS, zero16(), lane);
#pragma unroll
                for (int g4 = 0; g4 < 4; ++g4) { const int m0 = mt * 32 + 8 * g4 + 4 * hh;
                    const v2u rt = *(const LAS v2u*)(lds + R1_RT + n * SBS + m0 * 2);
                    v2u ov; ov.x = pk2(acc[4 * g4] + bflo(rt.x), acc[4 * g4 + 1] + bfhi(rt.x)); ov.y = pk2(acc[4 * g4 + 2] + bflo(rt.y), acc[4 * g4 + 3] + bfhi(rt.y));
                    *(GAS v2u*)(RHg + n * 64 + m0) = ov; }
            } else {
                f32x16 acc = wtile<4>(lds + R1_ARB + mt * 32 * SBS, SBS, lds + R1_U0T + nt * 32 * SBS, SBS, zero16(), lane);
                acc = wtile<4>(lds + R1_ARK + mt * 32 * SBS, SBS, lds + R1_VT + nt * 32 * SBS, SBS, acc, lane);
#pragma unroll
                for (int r = 0; r < 16; ++r) Y0g[(mt * 32 + crow(r, hh)) * 64 + n] = acc[r];
            }
        }
        if (tid < 64) ((float*)(F.ws + WS_BONUS))[(size_t)item * 64 + tid] = ((const LAS float*)(lds + R1_BONUS))[tid];
    }
    __syncthreads();
}

__device__ __forceinline__ void rwkv_r2_chain(Frame& F, int chain) {
    const int w = F.wave; if (w >= 4) return;
    const int lane = F.lane, n16 = lane & 15, g = lane >> 4;
    const float* Mg = F.out + (size_t)chain * 128 * 4096; const float* NTg = F.out + (size_t)T * RWW + (size_t)chain * 128 * 4096;
    float* SSg = (float*)(F.ws + WS_RWSS) + (size_t)chain * 128 * 4096;
    f32x4 st[4];
#pragma unroll
    for (int rt = 0; rt < 4; ++rt) st[rt] = (f32x4){0.f, 0.f, 0.f, 0.f};
    f32x4 ma[4][4], nv[4];
#pragma unroll
    for (int rt = 0; rt < 4; ++rt) {
#pragma unroll
        for (int kt = 0; kt < 4; ++kt) ma[rt][kt] = *(const GAS f32x4*)(Mg + (16 * rt + n16) * 64 + 16 * kt + 4 * g);
        nv[rt] = *(const GAS f32x4*)(NTg + (16 * w + n16) * 64 + 16 * rt + 4 * g); }
    for (int c = 0; c < 128; ++c) {
#pragma unroll
        for (int rt = 0; rt < 4; ++rt) *(GAS f32x4*)(SSg + (size_t)c * 4096 + (16 * w + n16) * 64 + 16 * rt + 4 * g) = st[rt];
        if (c == 127) break;
        f32x4 nw[4];
#pragma unroll
        for (int rt = 0; rt < 4; ++rt) { f32x4 acc = nv[rt];
#pragma unroll
            for (int kt = 0; kt < 4; ++kt)
#pragma unroll
                for (int q = 0; q < 4; ++q) acc = __builtin_amdgcn_mfma_f32_16x16x4f32(ma[rt][kt][q], st[kt][q], acc, 0, 0, 0);
            nw[rt] = acc; }
        const float* Mn = Mg + (size_t)(c + 1) * 4096; const float* Nn = NTg + (size_t)(c + 1) * 4096;
#pragma unroll
        for (int rt = 0; rt < 4; ++rt) {
#pragma unroll
            for (int kt = 0; kt < 4; ++kt) ma[rt][kt] = *(const GAS f32x4*)(Mn + (16 * rt + n16) * 64 + 16 * kt + 4 * g);
            nv[rt] = *(const GAS f32x4*)(Nn + (16 * w + n16) * 64 + 16 * rt + 4 * g); }
#pragma unroll
        for (int rt = 0; rt < 4; ++rt) st[rt] = nw[rt];
    }
}

constexpr int R3_RH = 0, R3_S = 9216, R3_SG = 18432, R3_SGS = 272, R3_YL = R3_SG + 64 * R3_SGS, R3_GL = R3_YL + 16384, R3_END = R3_GL + 16384;
static_assert(R3_END <= LDSCTL_OFF, "R3 LDS");
__device__ __forceinline__ void rwkv_r3_item(Frame& F, int item) {
    const int chain = item >> 7, chunk = item & 127, b = chain >> 3, h = chain & 7;
    const int g0 = b * SEQ + chunk * 64;
    int tid_ = F.tid; asm volatile("" : "+v"(tid_));
    const int tid = tid_, lane = tid & 63, w = __builtin_amdgcn_readfirstlane(tid >> 6), hh = lane >> 5, cl = lane & 31;
    const bf16* Z = (const bf16*)(F.ws + WS_Z);
    LAS unsigned char* lds = F.lds + RING_OFF;
    const float* mu = F.in[3];
    {
        const int t = tid >> 3, cg = tid & 7;
        const bf16* RHg = (const bf16*)(F.ws + WS_RWRH) + (size_t)item * 4096;
        *(LAS v4u*)(lds + R3_RH + t * SBS + cg * 16) = *(const GAS v4u*)(RHg + t * 64 + cg * 8);
        const float* SSg = (const float*)(F.ws + WS_RWSS) + (size_t)item * 4096;
        const f32x4 s0 = *(const GAS f32x4*)(SSg + t * 64 + cg * 8), s1 = *(const GAS f32x4*)(SSg + t * 64 + cg * 8 + 4);
        v4u o; o.x = pk2(s0[0], s0[1]); o.y = pk2(s0[2], s0[3]); o.z = pk2(s1[0], s1[1]); o.w = pk2(s1[2], s1[3]);
        *(LAS v4u*)(lds + R3_S + t * SBS + cg * 16) = o;
        const bool first = (chunk == 0 && t == 0);
        const bf16* zr = Z + (size_t)(g0 + t) * IN_COLS + C_GD + cg * 16;
#pragma unroll
        for (int q = 0; q < 2; ++q) {
            const v4u cw = *(const GAS v4u*)(zr + q * 8); v4u pw = (v4u){0u, 0u, 0u, 0u};
            if (!first) pw = *(const GAS v4u*)(zr - IN_COLS + q * 8);
            float fw[8], qw[8];
            fw[0] = bflo(cw.x); fw[1] = bfhi(cw.x); fw[2] = bflo(cw.y); fw[3] = bfhi(cw.y); fw[4] = bflo(cw.z); fw[5] = bfhi(cw.z); fw[6] = bflo(cw.w); fw[7] = bfhi(cw.w);
            qw[0] = bflo(pw.x); qw[1] = bfhi(pw.x); qw[2] = bflo(pw.y); qw[3] = bfhi(pw.y); qw[4] = bflo(pw.z); qw[5] = bfhi(pw.z); qw[6] = bflo(pw.w); qw[7] = bfhi(pw.w);
#pragma unroll
            for (int j = 0; j < 8; ++j) { const float v = fw[j] + (qw[j] - fw[j]) * mu[C_GD + cg * 16 + q * 8 + j]; fw[j] = 1.f / (1.f + __expf(-v)); }
            v4u og; og.x = pk2(fw[0], fw[1]); og.y = pk2(fw[2], fw[3]); og.z = pk2(fw[4], fw[5]); og.w = pk2(fw[6], fw[7]);
            *(LAS v4u*)(lds + R3_SG + t * R3_SGS + (cg * 16 + q * 8) * 2) = og;
        }
    }
    __syncthreads();
    {
        const int mt = (w >> 1) & 1, nt = w & 1; const int n = nt * 32 + cl;
        if (w < 4) {
            const float* Y0g = (const float*)(F.ws + WS_RWY0) + (size_t)item * 4096;
            f32x16 acc;
#pragma unroll
            for (int r = 0; r < 16; ++r) acc[r] = Y0g[(mt * 32 + crow(r, hh)) * 64 + n];
            acc = wtile<4>(lds + R3_RH + mt * 32 * SBS, SBS, lds + R3_S + nt * 32 * SBS, SBS, acc, lane);
            LAS float* YL = (LAS float*)(lds + R3_YL);
#pragma unroll
            for (int r = 0; r < 16; ++r) YL[(mt * 32 + crow(r, hh)) * 64 + n] = acc[r];
        } else {
            const bf16* gut = (const bf16*)(F.ws + WS_GUPT) + (size_t)(h * 64 + nt * 32) * 128;
            const f32x16 acc = wtile_gb<8>(lds + R3_SG + mt * 32 * R3_SGS, R3_SGS, gut, 128, zero16(), lane);
            LAS float* GL = (LAS float*)(lds + R3_GL);
#pragma unroll
            for (int r = 0; r < 16; ++r) GL[(mt * 32 + crow(r, hh)) * 64 + n] = acc[r];
        }
    }
    __syncthreads();
    {
        const int c = tid & 63, ts = tid >> 6, col = h * 64 + c;
        const float mu_v = mu[C_V + col], gw = F.in[12][col], gb = F.in[13][col];
        const LAS float* YL = (const LAS float*)(lds + R3_YL); const LAS float* GL = (const LAS float*)(lds + R3_GL);
        const float* BON = (const float*)(F.ws + WS_BONUS) + (size_t)item * 64;
        bf16* Y = (bf16*)(F.ws + WS_YMIX);
        const bf16* zb = Z + (size_t)(g0 + 8 * ts) * IN_COLS + col;
        float pv = 0.f; if (!(chunk == 0 && ts == 0)) pv = bf2f(zb[C_V - IN_COLS]);
#pragma unroll
        for (int i = 0; i < 8; ++i) { const int t = 8 * ts + i;
            const float zv = bf2f(zb[(size_t)i * IN_COLS + C_V]); const float v = zv + (pv - zv) * mu_v; pv = zv;
            const float y = YL[t * 64 + c];
            const float mean = wave_sum(y) * (1.f / 64.f); const float d = y - mean; const float var = wave_sum(d * d) * (1.f / 64.f);
            const float yn = d * (1.f / sqrtf(var + GN_EPS)) * gw + gb;
            const float o = (yn + BON[t] * v) * GL[t * 64 + c];
            Y[(size_t)(g0 + t) * DM + col] = (bf16)f2bf(o); }
    }
    __syncthreads();
}

typedef short s16x4 __attribute__((ext_vector_type(4)));
typedef short v4i16_t __attribute__((ext_vector_type(4)));
constexpr int AT_XO = 0, AT_XO_STRIDE = 136, AT_XM = 512 * AT_XO_STRIDE, AT_XL = AT_XM + 2048, AT_V = AT_XL + 2048, AT_LDS_END = AT_V + 8 * 4096;
static_assert(AT_LDS_END <= RING_BYTES, "attention LDS");
__device__ __forceinline__ float xhalf(float v) { return __shfl_xor(v, 32); }
__device__ __forceinline__ void attn_block(Frame& F, int item) {
    const int bh = item >> 4, blk = item & 15, b = bh >> 3, h = bh & 7, t0 = blk * 512;
    int tid_ = F.tid; asm volatile("" : "+v"(tid_));
    const int lane = tid_ & 63, w = __builtin_amdgcn_readfirstlane(tid_ >> 6), ql = lane & 31, hh = lane >> 5;
    const bf16* Zb = (const bf16*)(F.ws + WS_Z) + (size_t)b * SEQ * IN_COLS;
    bf16* Y = (bf16*)(F.ws + WS_YMIX);
    LAS unsigned char* lds = F.lds + RING_OFF;
    LAS unsigned char* Vw = lds + AT_V + w * 4096;
    LAS float* XM = (LAS float*)(lds + AT_XM); LAS float* XL = (LAS float*)(lds + AT_XL);
    constexpr float C2 = 0.125f * 1.4426950408889634f;
    for (int pass = 0; pass < 3; ++pass) {
        const int sh = pass == 0 ? 4 : (pass == 1 ? 2 : 0), d = 1 << sh;
        for (int uu = 0; uu < 2; ++uu) {
            const int u = w + 8 * uu, rho = u & (d - 1), tau = u >> sh;
            const int qoff = rho + (32 * tau + ql) * d;
            bf16x8 qf[4];
            { const bf16* qp = Zb + (size_t)(t0 + qoff) * IN_COLS + C_AQ + h * 64 + 8 * hh;
#pragma unroll
              for (int s = 0; s < 4; ++s) qf[s] = *(const GAS bf16x8*)(qp + 16 * s); }
            f32x16 sc[5];
            const int tkb = t0 + rho + (32 * tau - 128) * d;
#pragma unroll
            for (int kt = 0; kt < 5; ++kt) {
                const int tk0 = tkb + 32 * kt * d;
                if (tk0 >= 0) {
                    const bf16* kp = Zb + (size_t)(tk0 + ql * d) * IN_COLS + C_AK + h * 64 + 8 * hh;
                    bf16x8 kf[4];
#pragma unroll
                    for (int s = 0; s < 4; ++s) kf[s] = *(const GAS bf16x8*)(kp + 16 * s);
                    f32x16 acc;
#pragma unroll
                    for (int r = 0; r < 16; ++r) acc[r] = 0.f;
#pragma unroll
                    for (int s = 0; s < 4; ++s) acc = __builtin_amdgcn_mfma_f32_32x32x16_bf16(kf[s], qf[s], acc, 0, 0, 0);
                    if (kt == 0 || kt == 4) {
#pragma unroll
                        for (int r = 0; r < 16; ++r) { const int kidx = (r & 3) + 8 * (r >> 2) + 4 * hh;
                            const bool ok = (kt == 0) ? (kidx >= ql) : (kidx <= ql);
                            acc[r] = ok ? acc[r] : -INFINITY; }
                    }
                    sc[kt] = acc;
                } else {
#pragma unroll
                    for (int r = 0; r < 16; ++r) sc[kt][r] = -INFINITY;
                }
            }
            float m = -INFINITY;
#pragma unroll
            for (int kt = 0; kt < 5; ++kt)
#pragma unroll
                for (int r = 0; r < 16; ++r) m = fmaxf(m, sc[kt][r]);
            m = fmaxf(m, xhalf(m));
            const float ms = m * C2;
            float l = 0.f;
#pragma unroll
            for (int kt = 0; kt < 5; ++kt)
#pragma unroll
                for (int r = 0; r < 16; ++r) { const float p = __builtin_amdgcn_exp2f(sc[kt][r] * C2 - ms); sc[kt][r] = p; l += p; }
            l += xhalf(l);
            f32x16 O[2];
#pragma unroll
            for (int r = 0; r < 16; ++r) { O[0][r] = 0.f; O[1][r] = 0.f; }
#pragma unroll
            for (int kt = 0; kt < 5; ++kt) {
                const int tk0 = tkb + 32 * kt * d;
                if (tk0 >= 0) {
                    v4u vr[4];
#pragma unroll
                    for (int i = 0; i < 4; ++i) { const int kidx = i * 8 + (lane >> 3), ch = lane & 7;
                        vr[i] = *(const GAS v4u*)(Zb + (size_t)(tk0 + kidx * d) * IN_COLS + C_AV + h * 64 + ch * 8); }
#pragma unroll
                    for (int i = 0; i < 4; ++i) { const int kidx = i * 8 + (lane >> 3), ch = lane & 7;
                        *(LAS v4u*)(Vw + kidx * 128 + ((ch ^ (((kidx >> 1) & 1) << 2)) << 4)) = vr[i]; }
                    asm volatile("s_waitcnt lgkmcnt(0)" ::: "memory");
#pragma unroll
                    for (int s = 0; s < 2; ++s) {
                        bf16x8 pf;
#pragma unroll
                        for (int j = 0; j < 8; ++j) pf[j] = (short)f2bf(sc[kt][8 * s + j]);
#pragma unroll
                        for (int dt = 0; dt < 2; ++dt) {
                            bf16x8 vf;
#pragma unroll
                            for (int pp = 0; pp < 2; ++pp) {
                                const int i16 = lane & 15, db = (lane >> 4) & 1;
                                const int row = 16 * s + 8 * pp + 4 * hh + (i16 >> 2);
                                const int byte = 64 * dt + 32 * db + 8 * (i16 & 3);
                                const int chunk = (byte >> 4) ^ (((row >> 1) & 1) << 2);
                                const s16x4 t4 = __builtin_bit_cast(s16x4, __builtin_amdgcn_ds_read_tr16_b64_v4i16((LAS v4i16_t*)(Vw + row * 128 + (chunk << 4) + (byte & 15))));
                                vf[4 * pp + 0] = t4[0]; vf[4 * pp + 1] = t4[1]; vf[4 * pp + 2] = t4[2]; vf[4 * pp + 3] = t4[3];
                            }
                            O[dt] = __builtin_amdgcn_mfma_f32_32x32x16_bf16(vf, pf, O[dt], 0, 0, 0);
                        }
                    }
                    asm volatile("s_waitcnt lgkmcnt(0)" ::: "memory");
                }
            }
            LAS unsigned char* xo = lds + AT_XO + qoff * AT_XO_STRIDE + 8 * hh;
            float wa = 0.f, wb = 1.f, Mx = ms, ln = l;
            if (pass > 0) { const float msa = XM[qoff], la = XL[qoff]; Mx = fmaxf(msa, ms); wa = la * __builtin_amdgcn_exp2f(msa - Mx); wb = __builtin_amdgcn_exp2f(ms - Mx); ln = wa + wb * l; }
            const float inv = 1.f / ln;
#pragma unroll
            for (int dt = 0; dt < 2; ++dt)
#pragma unroll
                for (int g4 = 0; g4 < 4; ++g4) {
                    LAS v2u* p = (LAS v2u*)(xo + (32 * dt + 8 * g4) * 2);
                    float o0 = O[dt][4 * g4] * wb, o1 = O[dt][4 * g4 + 1] * wb, o2 = O[dt][4 * g4 + 2] * wb, o3 = O[dt][4 * g4 + 3] * wb;
                    if (pass > 0) { const v2u old = *p; o0 += bflo(old.x) * wa; o1 += bfhi(old.x) * wa; o2 += bflo(old.y) * wa; o3 += bfhi(old.y) * wa; }
                    v2u nw; nw.x = pk2(o0 * inv, o1 * inv); nw.y = pk2(o2 * inv, o3 * inv);
                    *p = nw;
                }
            if (hh == 0) { XM[qoff] = Mx; XL[qoff] = ln; }
        }
        __syncthreads();
    }
#pragma unroll
    for (int i = 0; i < 8; ++i) { const int row = (tid_ >> 3) + 64 * i, ch = tid_ & 7;
        LAS v2u* p = (LAS v2u*)(lds + AT_XO + row * AT_XO_STRIDE + ch * 16);
        const v2u a = p[0], c = p[1];
        v4u o; o.x = a.x; o.y = a.y; o.z = c.x; o.w = c.y;
        *(GAS v4u*)(Y + ((size_t)b * SEQ + t0 + row) * DM + RWW + h * 64 + ch * 8) = o; }
    __syncthreads();
}

__device__ __forceinline__ void p3_mixers(Frame& F) {
    const int nrw = (F.G >= 64) ? 32 : 0;
    if (nrw == 0) { for (int ch = 0; ch < NB * NHR; ++ch) rwkv_r2_chain(F, ch); }
    else if (F.wg < nrw) { for (int ch = F.wg; ch < NB * NHR; ch += nrw) rwkv_r2_chain(F, ch); return; }
    const int na = F.G - nrw, wa = F.wg - nrw;
    for (int item = wa; item < NB * NHA * (SEQ / 512); item += na) attn_block(F, item);
}

__device__ __forceinline__ void p5_xn2(Frame& F) {
    const int gw = F.wg * NWAVES + F.wave, NGW = F.G * NWAVES;
    bf16* XN = (bf16*)(F.ws + WS_XN);
    for (int m = gw; m < T; m += NGW) rms_row_to_bf16(F.lane, F.out + (size_t)m * DM, F.in[15], XN + (size_t)m * DM);
}

template <int NS> __device__ __forceinline__ void wave_top16(float (&v)[NS], int lane, float& out_s, int& out_i) {
    out_s = 0.f; out_i = 0;
    for (int it = 0; it < 16; ++it) {
        float m = v[0];
#pragma unroll
        for (int s = 1; s < NS; ++s) m = fmaxf(m, v[s]);
        const float M = wave_max(m);
        int cand = 0x7fffffff;
#pragma unroll
        for (int s = NS - 1; s >= 0; --s) if (v[s] == M) cand = lane * NS + s;
        const int I = wave_min_i(cand);
        if (lane == it) { out_s = M; out_i = I; }
#pragma unroll
        for (int s = 0; s < NS; ++s) if (lane * NS + s == I) v[s] = -INFINITY;
    }
}
__device__ __forceinline__ void p7_topk(Frame& F) {
    const bf16* QP = (const bf16*)(F.ws + WS_QP);
    int* EID = (int*)(F.ws + WS_EID); float* GATE = (float*)(F.ws + WS_GATE);
    const float* sk = F.in[17];
    LAS float* SK = (LAS float*)(F.lds + RING_OFF);
    for (int e = F.tid; e < 2 * 128 * 128; e += NTHREADS) { const int c = e >> 14, k = (e >> 7) & 127, d = e & 127; SK[(c * 128 + d) * 128 + k] = sk[e]; }
    __syncthreads();
    const int lane = F.lane;
    const int gw = F.wg * NWAVES + F.wave, NGW = F.G * NWAVES;
    for (int item = gw; item < T * PHEADS; item += NGW) {
        const int t = item >> 3, h = item & 7;
        float ts[2]; int ti[2];
#pragma unroll
        for (int c = 0; c < 2; ++c) {
            const unsigned qd = *(const GAS unsigned*)(QP + (size_t)t * PQ + h * 256 + c * 128 + 2 * lane);
            const float q0 = bflo(qd), q1 = bfhi(qd);
            float s0 = 0.f, s1 = 0.f;
            const LAS f32x2* kp = (const LAS f32x2*)(SK + c * 16384) + lane;
#pragma unroll 8
            for (int d2 = 0; d2 < 64; ++d2) { const float qe = rdlane(q0, d2), qo = rdlane(q1, d2);
                const f32x2 ka = kp[(2 * d2) * 64], kb = kp[(2 * d2 + 1) * 64];
                s0 += qe * ka.x + qo * kb.x; s1 += qe * ka.y + qo * kb.y; }
            float v[2] = {s0, s1};
            wave_top16<2>(v, lane, ts[c], ti[c]);
        }
        const float a_s = __shfl(ts[0], lane >> 2); const int a_i = __shfl(ti[0], lane >> 2);
        float cv[4]; int ce[4];
#pragma unroll
        for (int s = 0; s < 4; ++s) { const int j = (lane & 3) * 4 + s; cv[s] = a_s + __shfl(ts[1], j); ce[s] = a_i * NKEYS + __shfl(ti[1], j); }
        float bs; int bi;
        wave_top16<4>(cv, lane, bs, bi);
        int eid = 0;
        { const int ol = bi >> 2, os = bi & 3;
          const int e0 = __shfl(ce[0], ol), e1 = __shfl(ce[1], ol), e2 = __shfl(ce[2], ol), e3 = __shfl(ce[3], ol);
          eid = os == 0 ? e0 : (os == 1 ? e1 : (os == 2 ? e2 : e3)); }
        const float mx = rdlane(bs, 0);
        float ex = lane < 16 ? __expf(bs - mx) : 0.f;
        const float den = wave_sum(ex);
        if (lane < 16) { EID[(size_t)t * 128 + h * 16 + lane] = eid; GATE[(size_t)t * 128 + h * 16 + lane] = ex / den; }
    }
}

__device__ __forceinline__ void unpack8(const v4u a, float* f) { f[0] = bflo(a.x); f[1] = bfhi(a.x); f[2] = bflo(a.y); f[3] = bfhi(a.y); f[4] = bflo(a.z); f[5] = bfhi(a.z); f[6] = bflo(a.w); f[7] = bfhi(a.w); }
__device__ __forceinline__ void p8_gather(Frame& F) {
    const bf16* XN = (const bf16*)(F.ws + WS_XN);
    const bf16* UB = (const bf16*)(F.ws + WS_UB); const bf16* VB = (const bf16*)(F.ws + WS_VB);
    const int* EID = (const int*)(F.ws + WS_EID); const float* GATE = (const float*)(F.ws + WS_GATE);
    const float* nf = F.in[20];
    const int lane = F.lane;
    const int gw = F.wg * NWAVES + F.wave, NGW = F.G * NWAVES;
    for (int t = gw; t < T; t += NGW) {
        float x[16];
        { const GAS v4u* xp = (const GAS v4u*)(XN + (size_t)t * DM); unpack8(xp[lane], x); unpack8(xp[64 + lane], x + 8); }
        const int e_lo = EID[(size_t)t * 128 + lane], e_hi = EID[(size_t)t * 128 + 64 + lane];
        const float g_lo = GATE[(size_t)t * 128 + lane], g_hi = GATE[(size_t)t * 128 + 64 + lane];
        float acc[16];
#pragma unroll
        for (int k = 0; k < 16; ++k) acc[k] = 0.f;
        for (int jj = 0; jj < 128; jj += 4) {
            v4u ua[4], ub[4], va[4], vb[4]; float gt[4];
#pragma unroll
            for (int u = 0; u < 4; ++u) { const int j = jj + u;
                int e = (j < 64) ? __builtin_amdgcn_readlane(e_lo, j & 63) : __builtin_amdgcn_readlane(e_hi, j & 63);
                gt[u] = (j < 64) ? rdlane(g_lo, j & 63) : rdlane(g_hi, j & 63);
                e = e & (NEXP - 1);
                const GAS v4u* up = (const GAS v4u*)(UB + (size_t)e * DM); const GAS v4u* vp = (const GAS v4u*)(VB + (size_t)e * DM);
                ua[u] = up[lane]; ub[u] = up[64 + lane]; va[u] = vp[lane]; vb[u] = vp[64 + lane]; }
#pragma unroll
            for (int u = 0; u < 4; ++u) {
                float f[16]; unpack8(ua[u], f); unpack8(ub[u], f + 8);
                float d = 0.f;
#pragma unroll
                for (int k = 0; k < 16; ++k) d += x[k] * f[k];
                d = wave_sum(d);
                const float a = 0.5f * d * (1.f + erff(d * 0.70710678118654752f)) * gt[u];
                unpack8(va[u], f); unpack8(vb[u], f + 8);
#pragma unroll
                for (int k = 0; k < 16; ++k) acc[k] += a * f[k];
            }
        }
        float* hrow = F.out + (size_t)t * DM;
        f32x4 h0 = *(const GAS f32x4*)(hrow + lane * 8), h1 = *(const GAS f32x4*)(hrow + lane * 8 + 4), h2 = *(const GAS f32x4*)(hrow + 512 + lane * 8), h3 = *(const GAS f32x4*)(hrow + 512 + lane * 8 + 4);
        float hv[16];
#pragma unroll
        for (int k = 0; k < 4; ++k) { hv[k] = h0[k] + acc[k]; hv[4 + k] = h1[k] + acc[4 + k]; hv[8 + k] = h2[k] + acc[8 + k]; hv[12 + k] = h3[k] + acc[12 + k]; }
        float ss = 0.f;
#pragma unroll
        for (int k = 0; k < 16; ++k) ss += hv[k] * hv[k];
        const float rstd = 1.f / sqrtf(wave_sum(ss) * (1.f / DM) + RMS_EPS);
        const f32x4 n0 = *(const GAS f32x4*)(nf + lane * 8), n1 = *(const GAS f32x4*)(nf + lane * 8 + 4), n2 = *(const GAS f32x4*)(nf + 512 + lane * 8), n3 = *(const GAS f32x4*)(nf + 512 + lane * 8 + 4);
        f32x4 o0, o1, o2, o3;
#pragma unroll
        for (int k = 0; k < 4; ++k) { o0[k] = hv[k] * rstd * n0[k]; o1[k] = hv[4 + k] * rstd * n1[k]; o2[k] = hv[8 + k] * rstd * n2[k]; o3[k] = hv[12 + k] * rstd * n3[k]; }
        *(GAS f32x4*)(hrow + lane * 8) = o0; *(GAS f32x4*)(hrow + lane * 8 + 4) = o1; *(GAS f32x4*)(hrow + 512 + lane * 8) = o2; *(GAS f32x4*)(hrow + 512 + lane * 8 + 4) = o3;
    }
}

struct Args { const float* in[21]; float* out; unsigned char* ws; int ph_lo, ph_hi; };
static_assert(sizeof(Args) == 21 * 8 + 8 + 8 + 8, "Args has no padding");

__global__ void __launch_bounds__(NTHREADS, 2) fwd_kernel(Args args) {
    extern __shared__ __attribute__((aligned(16))) unsigned char lds[];
    Frame F;
    F.lds = (LAS unsigned char*)lds;
    F.MISC = (volatile LAS unsigned*)(F.lds + MISC_OFF);
    F.tid = threadIdx.x; F.lane = F.tid & 63; F.wave = __builtin_amdgcn_readfirstlane(F.tid >> 6);
    F.G = gridDim.x; F.wg = blockIdx.x;
#pragma unroll
    for (int i = 0; i < 21; ++i) F.in[i] = args.in[i];
    F.out = args.out; F.ws = args.ws;
    F.ctl = (gu32*)(args.ws + WS_CTL);
    for (int u = F.tid; u < (LDS_BYTES - LDSCTL_OFF) / 4; u += NTHREADS) ((LAS unsigned*)(F.lds + LDSCTL_OFF))[u] = 0u;
    __syncthreads();
    const int lo = args.ph_lo, hi = args.ph_hi;
    const bool fused = (hi - lo) > 1;
    XcdBarrier bar; bar.bar = (unsigned*)(F.ctl + CW_BAR); bar.x = 0; bar.st = nullptr;
    if (fused) bar = xcd_barrier_post((unsigned*)(F.ctl + CW_BAR), F.MISC + 8);
#define IN(k) (lo <= (k) && (k) < hi)
#define SEAM(k) do { if (IN(k) && IN((k) + 1)) xcd_barrier(bar); } while (0)

    if (IN(0)) { p0_prologue(F); SEAM(0); }
    if (IN(1)) {
        pg8::Gemm g{(const bf16*)(F.ws + WS_XN), (const bf16*)(F.ws + WS_WIN), T, IN_COLS, DM}; pg8::StaticOrder S; S.init(T, IN_COLS, F.G, F.wg);
        pg8::EpiBf16 E{(bf16*)(F.ws + WS_Z), IN_COLS};
        pg8::gemm_phase<pg8::EpiBf16, pg8::StaticOrder, true, true>(F.lds + RING_OFF, g, S, E);
        SEAM(1);
    }
    if (IN(2)) { p2_rope(F); for (int item = F.wg; item < NB * NHR * 128; item += F.G) rwkv_r1_item(F, item); SEAM(2); }
    if (IN(3)) { p3_mixers(F); SEAM(3); }
    if (IN(4)) { for (int item = F.wg; item < NB * NHR * 128; item += F.G) rwkv_r3_item(F, item); SEAM(4); }
    if (IN(5)) {
        pg8::Gemm g{(const bf16*)(F.ws + WS_YMIX), (const bf16*)(F.ws + WS_WOUT), T, DM, DM}; pg8::StaticOrder S; S.init(T, DM, F.G, F.wg);
        pg8::EpiF32Res E{F.in[0], F.out, DM};
        pg8::gemm_phase<pg8::EpiF32Res, pg8::StaticOrder, true, true>(F.lds + RING_OFF, g, S, E);
        SEAM(5);
    }
    if (IN(6)) { p5_xn2(F); SEAM(6); }
    if (IN(7)) {
        pg8::Gemm g{(const bf16*)(F.ws + WS_XN), (const bf16*)(F.ws + WS_WQ), T, PQ, DM}; pg8::StaticOrder S; S.init(T, PQ, F.G, F.wg);
        pg8::EpiBf16 E{(bf16*)(F.ws + WS_QP), PQ};
        pg8::gemm_phase<pg8::EpiBf16, pg8::StaticOrder, true, true>(F.lds + RING_OFF, g, S, E);
        SEAM(7);
    }
    if (IN(8)) { p7_topk(F); SEAM(8); }
    if (IN(9)) { p8_gather(F); }
#undef IN
#undef SEAM
}

extern "C" void kernel_launch(void* const* d_in, const int* in_sizes, int n_in, void* d_out, int out_size, void* d_ws, size_t ws_size, hipStream_t stream) {
    static int grid = 0;
    if (grid == 0) {
        if (n_in != 21 || in_sizes[0] != T * DM || out_size != T * DM || ws_size < WS_END) {
            fprintf(stderr, "kernel_launch: unexpected shapes: n_in %d in0 %d out %d ws %zu (need %zu); nothing launched\n", n_in, n_in > 0 ? in_sizes[0] : -1, out_size, ws_size, (size_t)WS_END); grid = -1; return; }
        int dev = 0, cus = 0, per_cu = 0;
        if (hipGetDevice(&dev) != hipSuccess || hipDeviceGetAttribute(&cus, hipDeviceAttributeMultiprocessorCount, dev) != hipSuccess) { grid = -1; return; }
        if (hipFuncSetAttribute((const void*)fwd_kernel, hipFuncAttributeMaxDynamicSharedMemorySize, LDS_BYTES) != hipSuccess) { fprintf(stderr, "kernel_launch: hipFuncSetAttribute failed\n"); grid = -1; return; }
        if (hipOccupancyMaxActiveBlocksPerMultiprocessor(&per_cu, (const void*)fwd_kernel, NTHREADS, LDS_BYTES) != hipSuccess || per_cu < 1) { fprintf(stderr, "kernel_launch: occupancy query says %d\n", per_cu); per_cu = 1; }
        (void)hipGetLastError();
        grid = cus;
    }
    if (grid < 0) return;
    (void)hipMemsetAsync((char*)d_ws + WS_CTL, 0, CTL_ZERO_BYTES, stream);
    Args a{};
    for (int i = 0; i < 21; ++i) a.in[i] = (const float*)d_in[i];
    a.out = (float*)d_out; a.ws = (unsigned char*)d_ws;
    if (MK_N_LAUNCHES == 1) {
        a.ph_lo = 0; a.ph_hi = NPHASE;
        void* kargs[] = {&a};
        hipError_t e = hipLaunchCooperativeKernel((const void*)fwd_kernel, dim3(grid), dim3(NTHREADS), kargs, LDS_BYTES, stream);
        if (e != hipSuccess) fprintf(stderr, "kernel_launch: cooperative launch failed: %s (grid %d)\n", hipGetErrorString(e), grid);
    } else {
        for (int p = 0; p < NPHASE; ++p) { a.ph_lo = p; a.ph_hi = p + 1;
            hipLaunchKernelGGL(fwd_kernel, dim3(grid), dim3(NTHREADS), LDS_BYTES, stream, a); }
    }
}
```

```cpp
#include <hip/hip_runtime.h>
#include <cstdio>
#include <cstdint>

#ifndef MK_N_LAUNCHES
#define MK_N_LAUNCHES 1
#endif

#define GAS __attribute__((address_space(1)))
#define LAS __attribute__((address_space(3)))
typedef unsigned short bf16;
typedef unsigned v4u __attribute__((ext_vector_type(4)));
typedef unsigned v2u __attribute__((ext_vector_type(2)));
typedef float f32x4 __attribute__((ext_vector_type(4)));
typedef float f32x2 __attribute__((ext_vector_type(2)));
typedef short bf16x8 __attribute__((ext_vector_type(8)));
typedef GAS unsigned gu32;
#define RLX_AGENT __ATOMIC_RELAXED, __HIP_MEMORY_SCOPE_AGENT
#define LDS_WAIT() asm volatile("s_waitcnt lgkmcnt(0)" ::: "memory")
#define VM_WAIT() asm volatile("s_waitcnt vmcnt(0)" ::: "memory")

constexpr int DM = 1024, NB = 4, SEQ = 8192, T = NB * SEQ;
constexpr int HD = 64, RWW = 512, NHR = 8, NHA = 8;
constexpr int IN_COLS = 3328;
constexpr int C_R = 0, C_K = 512, C_V = 1024, C_WD = 1536, C_AD = 1600, C_GD = 1664, C_AQ = 1792, C_AK = 2304, C_AV = 2816;
constexpr int PHEADS = 8, NKEYS = 128, PQ = 2048, TOPK = 16, NEXP = 16384;
constexpr float RMS_EPS = 1e-6f, GN_EPS = 64e-5f;
constexpr int NWAVES = 8, NTHREADS = 512;
constexpr int NPHASE = 10;

constexpr size_t MiB = 1u << 20;
constexpr size_t WS_CTL = 0, CTL_ZERO_BYTES = 1 * MiB;
constexpr size_t WS_WIN = 2 * MiB;
constexpr size_t WS_WOUT = 10 * MiB;
constexpr size_t WS_WQ = 12 * MiB;
constexpr size_t WS_XN = 16 * MiB;
constexpr size_t WS_Z = 80 * MiB;
constexpr size_t WS_QP = 80 * MiB;
constexpr size_t WS_G = 288 * MiB;
constexpr size_t WS_YMIX = 352 * MiB;
constexpr size_t WS_UB = 416 * MiB;
constexpr size_t WS_VB = 448 * MiB;
constexpr size_t WS_EID = 480 * MiB;
constexpr size_t WS_GATE = 496 * MiB;
constexpr size_t WS_END = 512 * MiB;
constexpr size_t WS_WUPT = 1 * MiB, WS_AUPT = WS_WUPT + 65536, WS_GUPT = WS_AUPT + 65536;
constexpr size_t WS_BONUS = 9 * MiB;
constexpr size_t WS_RWY0 = WS_XN;
constexpr size_t WS_RWSS = WS_G;
constexpr size_t WS_RWRH = WS_EID;

constexpr int CW_BAR = 4096;

__device__ __forceinline__ unsigned f2bf(float f) { unsigned u = __builtin_bit_cast(unsigned, f); return (u + 0x7fffu + ((u >> 16) & 1u)) >> 16; }
__device__ __forceinline__ unsigned pk2(float lo, float hi) { return f2bf(lo) | (f2bf(hi) << 16); }
__device__ __forceinline__ float bflo(unsigned u) { return __builtin_bit_cast(float, u << 16); }
__device__ __forceinline__ float bfhi(unsigned u) { return __builtin_bit_cast(float, u & 0xffff0000u); }
__device__ __forceinline__ float bf2f(bf16 h) { return __builtin_bit_cast(float, (unsigned)h << 16); }

template <int CTRL> __device__ __forceinline__ float dppf(float x) { return __builtin_bit_cast(float, __builtin_amdgcn_update_dpp(0, __builtin_bit_cast(int, x), CTRL, 0xF, 0xF, true)); }
template <int CTRL> __device__ __forceinline__ int dppi(int x) { return __builtin_amdgcn_update_dpp(0, x, CTRL, 0xF, 0xF, true); }
__device__ __forceinline__ float rdlane(float v, int l) { return __builtin_bit_cast(float, __builtin_amdgcn_readlane(__builtin_bit_cast(int, v), l)); }
__device__ __forceinline__ float sum8(float v) { v += dppf<0xB1>(v); v += dppf<0x4E>(v); v += dppf<0x141>(v); return v; }
__device__ __forceinline__ float sum16(float v) { v = sum8(v); v += dppf<0x140>(v); return v; }
__device__ __forceinline__ float wave_sum(float v) { v = sum16(v); return (rdlane(v, 0) + rdlane(v, 16)) + (rdlane(v, 32) + rdlane(v, 48)); }
__device__ __forceinline__ float wave_max(float v) {
    v = fmaxf(v, dppf<0xB1>(v)); v = fmaxf(v, dppf<0x4E>(v)); v = fmaxf(v, dppf<0x141>(v)); v = fmaxf(v, dppf<0x140>(v));
    return fmaxf(fmaxf(rdlane(v, 0), rdlane(v, 16)), fmaxf(rdlane(v, 32), rdlane(v, 48)));
}
__device__ __forceinline__ int wave_min_i(int v) {
    v = min(v, dppi<0xB1>(v)); v = min(v, dppi<0x4E>(v)); v = min(v, dppi<0x141>(v)); v = min(v, dppi<0x140>(v));
    return min(min(__builtin_amdgcn_readlane(v, 0), __builtin_amdgcn_readlane(v, 16)), min(__builtin_amdgcn_readlane(v, 32), __builtin_amdgcn_readlane(v, 48)));
}

namespace pg8 {
#define PG8_LAS __attribute__((address_space(3)))
typedef unsigned short bf16_t;
typedef unsigned u32x4 __attribute__((ext_vector_type(4)));
constexpr int BM = 256, BK = 64, HALF = 128, HTB = HALF * BK * 2, STAGE_BYTES = 8 * HTB, NXCD = 8, WGM = 8;
__host__ __device__ __forceinline__ int lds_byte(int r, int c) { const int st = (r >> 4) * 2 + (c >> 5), rr = r & 15, cc = c & 31, ob = rr * 64 + cc * 2; return st * 1024 + (ob ^ (((ob >> 9) & 1) << 5)); }
__host__ __device__ __forceinline__ void stage_rc(int b, int& R, int& C) { const int st = b / 1024, sb = b % 1024, swz = sb ^ (((sb >> 9) & 1) << 5); R = (st >> 1) * 16 + swz / 64; C = (st & 1) * 32 + (swz % 64) / 2; }
__host__ __device__ __forceinline__ int perm32(int rho) { const int n = rho >> 4, i = rho & 15; return 8 * (i >> 2) + 4 * n + (i & 3); }
struct Unit { int pm, pn; };
struct Gemm { const bf16_t* A; const bf16_t* Bt; int M, N, K; };
struct StaticOrder {
    int nM, nN, nwg, G, c;
    __host__ __device__ void init(int M, int N, int G_, int c_) { nM = M / BM; nN = N / BM; nwg = nM * nN; G = G_; c = c_; }
    __host__ __device__ bool next(int i, Unit& u) const {
        const long L = (long)i * G + c; if (L >= nwg) return false;
        int wgid = (int)L; { const int q = nwg / NXCD, r = nwg % NXCD, xcd = wgid % NXCD, off = wgid / NXCD; wgid = (xcd < r ? xcd * (q + 1) : r * (q + 1) + (xcd - r) * q) + off; }
        const int nig = WGM * nN, gid = wgid / nig, fm = gid * WGM, gsz = (nM - fm) < WGM ? (nM - fm) : WGM;
        u.pm = fm + ((wgid % nig) % gsz); u.pn = (wgid % nig) / gsz; return true;
    }
    __device__ __forceinline__ void a_ready(const Unit&) const {}
    __device__ __forceinline__ void done(const Unit&) const {}
};
__device__ __forceinline__ unsigned cvt_pk_bf16(float lo, float hi) { unsigned r; asm volatile("v_cvt_pk_bf16_f32 %0, %1, %2" : "=v"(r) : "v"(lo), "v"(hi)); return r; }
struct EpiBf16 {
    static constexpr bool PERM = true, AFTER_DRAIN = false;
    bf16_t* O; int ldc;
    __device__ __forceinline__ void operator()(const f32x4 (&acc)[2][2][4][2], const Unit& u, int wr, int wc, int fr, int fq) const {
        const int row0 = u.pm * BM + wr * 64 + fr; const int col0 = u.pn * BM + wc * 32 + 8 * fq;
#pragma unroll
        for (int ai = 0; ai < 2; ++ai)
#pragma unroll
            for (int m = 0; m < 4; ++m) { bf16_t* rowp = O + (size_t)(row0 + ai * HALF + m * 16) * ldc + col0;
#pragma unroll
                for (int bj = 0; bj < 2; ++bj) { const f32x4 v0 = acc[ai][bj][m][0], v1 = acc[ai][bj][m][1];
                    u32x4 w; w.x = cvt_pk_bf16(v0[0], v0[1]); w.y = cvt_pk_bf16(v0[2], v0[3]); w.z = cvt_pk_bf16(v1[0], v1[1]); w.w = cvt_pk_bf16(v1[2], v1[3]);
                    *(u32x4*)(rowp + bj * HALF) = w; } }
    }
};
struct EpiF32Res {
    static constexpr bool PERM = true, AFTER_DRAIN = false;
    const float* res; float* O; int ldc;
    __device__ __forceinline__ void operator()(const f32x4 (&acc)[2][2][4][2], const Unit& u, int wr, int wc, int fr, int fq) const {
        const int row0 = u.pm * BM + wr * 64 + fr; const int col0 = u.pn * BM + wc * 32 + 8 * fq;
#pragma unroll
        for (int ai = 0; ai < 2; ++ai)
#pragma unroll
            for (int m = 0; m < 4; ++m) { const size_t off = (size_t)(row0 + ai * HALF + m * 16) * ldc + col0;
#pragma unroll
                for (int bj = 0; bj < 2; ++bj) { const f32x4 r0 = *(const f32x4*)(res + off + bj * HALF), r1 = *(const f32x4*)(res + off + bj * HALF + 4);
                    *(f32x4*)(O + off + bj * HALF) = acc[ai][bj][m][0] + r0; *(f32x4*)(O + off + bj * HALF + 4) = acc[ai][bj][m][1] + r1; } }
    }
};

template <class Epi, class Sched, bool ALIGN_EPI = false, bool SP2 = false>
__device__ __forceinline__ void gemm_phase(PG8_LAS unsigned char* lds, const Gemm g, const Sched& S, const Epi& E) {
    const int tid = threadIdx.x, wid = __builtin_amdgcn_readfirstlane(tid >> 6), lane = tid & 63, wr = wid >> 2, wc = wid & 3, fr = lane & 15, fq = lane >> 4;
    const int K = g.K, nt = K / BK;
    unsigned voffA[2], voffB[2];
#pragma unroll
    for (int i = 0; i < 2; ++i) { int R, C; stage_rc(tid * 16 + i * 8192, R, C); const int Rb = Epi::PERM ? ((R & ~31) + perm32(R & 31)) : R;
        voffA[i] = (unsigned)(R * K + C) * 2u; voffB[i] = (unsigned)(Rb * K + C) * 2u; }
    const size_t kstep = (size_t)(BK * 2);
    const size_t hstep = (size_t)HALF * K * 2;
    const size_t tstep = 2 * hstep;
    const unsigned ldsw = (unsigned)wid * 1024u;
    const int aoff = lds_byte(wr * 64 + fr, fq * 8), boff = lds_byte(wc * 32 + fr, fq * 8);
#define PG8_SA(b, h) (((b) * 2 + (h)) * HTB)
#define PG8_SB(b, h) ((4 + (b) * 2 + (h)) * HTB)
#define PG8_STAGE(bufoff, gbase, voff) do { _Pragma("unroll") for (int _i = 0; _i < 2; ++_i) \
        __builtin_amdgcn_global_load_lds((const unsigned*)((const char*)(gbase) + (voff)[_i]), (PG8_LAS unsigned*)(lds + (bufoff) + ldsw + _i * 8192), 16, 0, 0); } while (0)
#define PG8_LDA(dst, b, h) do { _Pragma("unroll") for (int m = 0; m < 4; ++m) _Pragma("unroll") for (int k = 0; k < 2; ++k) dst[m][k] = *(const PG8_LAS bf16x8*)(lds + PG8_SA(b, h) + aoff + m * 2048 + k * 1024); } while (0)
#define PG8_LDB(dst, b, h) do { _Pragma("unroll") for (int n = 0; n < 2; ++n) _Pragma("unroll") for (int k = 0; k < 2; ++k) dst[n][k] = *(const PG8_LAS bf16x8*)(lds + PG8_SB(b, h) + boff + n * 2048 + k * 1024); } while (0)
#define PG8_MMA(ai, bj, At, Bt) do { __builtin_amdgcn_s_setprio(1); _Pragma("unroll") for (int m = 0; m < 4; ++m) _Pragma("unroll") for (int n = 0; n < 2; ++n) _Pragma("unroll") for (int k = 0; k < 2; ++k) \
        acc[ai][bj][m][n] = __builtin_amdgcn_mfma_f32_16x16x32_bf16(Bt[n][k], At[m][k], acc[ai][bj][m][n], 0, 0, 0); __builtin_amdgcn_s_setprio(0); } while (0)
#define PG8_WAIT_V(n) asm volatile("s_waitcnt vmcnt(" #n ")" ::: "memory")
#define PG8_WAIT_L(n) asm volatile("s_waitcnt lgkmcnt(" #n ")" ::: "memory")
#define PG8_BAR __builtin_amdgcn_s_barrier()
#define PG8_SCHED __builtin_amdgcn_sched_barrier(0)
    Unit cur, nxt; int ui = 0;
    if (!S.next(0, cur)) return;
    f32x4 acc[2][2][4][2];
#pragma unroll
    for (int a = 0; a < 2; ++a)
#pragma unroll
        for (int b = 0; b < 2; ++b)
#pragma unroll
            for (int m = 0; m < 4; ++m)
#pragma unroll
                for (int n = 0; n < 2; ++n) acc[a][b][m][n] = (f32x4){0.f, 0.f, 0.f, 0.f};
    bf16x8 At[4][2], B0[2][2], B1[2][2];
    const char* cA = (const char*)g.A + (size_t)cur.pm * tstep; const char* cB = (const char*)g.Bt + (size_t)cur.pn * tstep;
    S.a_ready(cur);
    if constexpr (SP2) {
        PG8_STAGE(PG8_SB(0, 0), cB, voffB); PG8_STAGE(PG8_SB(0, 1), cB + hstep, voffB); PG8_STAGE(PG8_SA(0, 0), cA, voffA); PG8_STAGE(PG8_SA(0, 1), cA + hstep, voffA);
        if (wr == 1) PG8_BAR;
        PG8_WAIT_V(2); PG8_BAR;
        PG8_STAGE(PG8_SB(1, 0), cB + kstep, voffB); PG8_STAGE(PG8_SA(1, 0), cA + kstep, voffA); PG8_STAGE(PG8_SB(1, 1), cB + hstep + kstep, voffB);
        PG8_WAIT_V(6); PG8_BAR;
    } else {
        PG8_STAGE(PG8_SB(0, 0), cB, voffB); PG8_STAGE(PG8_SA(0, 0), cA, voffA); PG8_STAGE(PG8_SB(0, 1), cB + hstep, voffB); PG8_STAGE(PG8_SA(0, 1), cA + hstep, voffA);
        if (wr == 1) PG8_BAR;
        PG8_WAIT_V(4); PG8_BAR;
        PG8_STAGE(PG8_SB(1, 0), cB + kstep, voffB); PG8_STAGE(PG8_SA(1, 0), cA + kstep, voffA); PG8_STAGE(PG8_SB(1, 1), cB + hstep + kstep, voffB);
        PG8_WAIT_V(6); PG8_BAR;
    }
    for (;;) {
        const bool has_next = S.next(ui + 1, nxt);
        const char* nA = has_next ? (const char*)g.A + (size_t)nxt.pm * tstep : cA; const char* nB = has_next ? (const char*)g.Bt + (size_t)nxt.pn * tstep : cB;
        for (int t = 0; t < nt; t += 2) {
            const bool last = (t == nt - 2);
            const char* a1 = cA + (size_t)(t + 1) * kstep;
            const char* a2 = last ? nA : cA + (size_t)(t + 2) * kstep; const char* b2 = last ? nB : cB + (size_t)(t + 2) * kstep;
            const char* a3 = a2 + kstep; const char* b3 = b2 + kstep;
            if (last && has_next) S.a_ready(nxt);
            if constexpr (SP2) {
            PG8_LDB(B0, 0, 0); PG8_LDB(B1, 0, 1); PG8_SCHED; PG8_LDA(At, 0, 0); PG8_STAGE(PG8_SA(1, 1), a1 + hstep, voffA);
            PG8_WAIT_V(8); PG8_WAIT_L(0); PG8_BAR; PG8_MMA(0, 0, At, B0); PG8_MMA(0, 1, At, B1); PG8_BAR; PG8_SCHED;
            PG8_LDA(At, 0, 1); PG8_STAGE(PG8_SB(0, 0), b2, voffB); PG8_STAGE(PG8_SB(0, 1), b2 + hstep, voffB); PG8_STAGE(PG8_SA(0, 0), a2, voffA);
            PG8_WAIT_V(8); PG8_WAIT_L(0); PG8_BAR; PG8_MMA(1, 0, At, B0); PG8_MMA(1, 1, At, B1); PG8_BAR; PG8_SCHED;
            PG8_LDB(B0, 1, 0); PG8_LDB(B1, 1, 1); PG8_SCHED; PG8_LDA(At, 1, 0); PG8_STAGE(PG8_SA(0, 1), a2 + hstep, voffA);
            PG8_WAIT_V(8); PG8_WAIT_L(0); PG8_BAR; PG8_MMA(0, 0, At, B0); PG8_MMA(0, 1, At, B1); PG8_BAR; PG8_SCHED;
            PG8_LDA(At, 1, 1); PG8_STAGE(PG8_SB(1, 0), b3, voffB); PG8_STAGE(PG8_SB(1, 1), b3 + hstep, voffB); PG8_STAGE(PG8_SA(1, 0), a3, voffA);
            PG8_WAIT_V(8); PG8_WAIT_L(0); PG8_BAR; PG8_MMA(1, 0, At, B0); PG8_MMA(1, 1, At, B1); PG8_BAR; PG8_SCHED;
            } else {
            PG8_LDB(B0, 0, 0); PG8_SCHED; PG8_LDA(At, 0, 0); PG8_STAGE(PG8_SA(1, 1), a1 + hstep, voffA);
            PG8_WAIT_L(8); PG8_BAR; PG8_WAIT_L(0); PG8_MMA(0, 0, At, B0); PG8_BAR; PG8_SCHED;
            PG8_LDB(B1, 0, 1); PG8_STAGE(PG8_SB(0, 0), b2, voffB);
            PG8_BAR; PG8_WAIT_L(0); PG8_MMA(0, 1, At, B1); PG8_BAR;
            PG8_LDA(At, 0, 1); PG8_STAGE(PG8_SA(0, 0), a2, voffA);
            PG8_BAR; PG8_WAIT_L(0); PG8_MMA(1, 0, At, B0); PG8_BAR; PG8_SCHED;
            PG8_STAGE(PG8_SB(0, 1), b2 + hstep, voffB);
            PG8_WAIT_V(6); PG8_BAR; PG8_MMA(1, 1, At, B1); PG8_BAR;
            PG8_LDB(B0, 1, 0); PG8_SCHED; PG8_LDA(At, 1, 0); PG8_STAGE(PG8_SA(0, 1), a2 + hstep, voffA);
            PG8_WAIT_L(8); PG8_BAR; PG8_WAIT_L(0); PG8_MMA(0, 0, At, B0); PG8_BAR; PG8_SCHED;
            PG8_LDB(B1, 1, 1); PG8_STAGE(PG8_SB(1, 0), b3, voffB);
            PG8_BAR; PG8_WAIT_L(0); PG8_MMA(0, 1, At, B1); PG8_BAR;
            PG8_LDA(At, 1, 1); PG8_STAGE(PG8_SA(1, 0), a3, voffA);
            PG8_BAR; PG8_WAIT_L(0); PG8_MMA(1, 0, At, B0); PG8_BAR; PG8_SCHED;
            PG8_STAGE(PG8_SB(1, 1), b3 + hstep, voffB);
            PG8_WAIT_V(6); PG8_BAR; PG8_MMA(1, 1, At, B1); PG8_BAR;
            }
        }
        if constexpr (ALIGN_EPI) { if (wr == 0) PG8_BAR; }
        if constexpr (!Epi::AFTER_DRAIN) { E(acc, cur, wr, wc, fr, fq); S.done(cur); }
        if (!has_next) break;
#pragma unroll
        for (int a = 0; a < 2; ++a)
#pragma unroll
            for (int b = 0; b < 2; ++b)
#pragma unroll
                for (int m = 0; m < 4; ++m)
#pragma unroll
                    for (int n = 0; n < 2; ++n) acc[a][b][m][n] = (f32x4){0.f, 0.f, 0.f, 0.f};
        cur = nxt; cA = nA; cB = nB; ++ui;
        if constexpr (ALIGN_EPI) { if (wr == 1) PG8_BAR; }
    }
    PG8_WAIT_V(0);
    if constexpr (!ALIGN_EPI) { if (wr == 0) PG8_BAR; }
    PG8_BAR;
#undef PG8_SA
#undef PG8_SB
#undef PG8_STAGE
#undef PG8_LDA
#undef PG8_LDB
#undef PG8_MMA
#undef PG8_WAIT_V
#undef PG8_WAIT_L
#undef PG8_BAR
#undef PG8_SCHED
}
}

#define XB_TMO      128
#define XB_XCNT(j)  (256  + 64 * (j))
#define XB_XSUB(j)  (1280 + 64 * (j))
#define XB_XGEN(j)  (2304 + 64 * (j))
#define XB_TOP      3328
#define XB_TOPGEN   3392
#define XCD_BAR_WORDS 3456
#define XB_SPIN_CAP (1u << 22)
__device__ __forceinline__ unsigned xb_ld(unsigned* p)              { return __hip_atomic_load(p, __ATOMIC_RELAXED, __HIP_MEMORY_SCOPE_AGENT); }
__device__ __forceinline__ unsigned xb_add(unsigned* p, unsigned v) { return __hip_atomic_fetch_add(p, v, __ATOMIC_RELAXED, __HIP_MEMORY_SCOPE_AGENT); }
__device__ __forceinline__ unsigned xb_xcc_id() { return (unsigned)__builtin_amdgcn_s_getreg((3 << 11) | 20) & 0xFu; }
#define XB_SPIN(cond, bar) do { unsigned _sp = 0; while (cond) { __builtin_amdgcn_s_sleep(1); \
    if ((++_sp & 255u) == 0u) { if (xb_ld(&(bar)[XB_TMO])) break; if (_sp > XB_SPIN_CAP) { atomicAdd(&(bar)[XB_TMO], 1u); break; } } } } while (0)
struct XcdBarrier { unsigned* bar; unsigned x; volatile LAS unsigned* st; };
__device__ __forceinline__ XcdBarrier xcd_barrier_post(unsigned* bar, volatile LAS unsigned* st) {
    XcdBarrier b; b.bar = bar; b.x = xb_xcc_id(); b.st = st;
    if (threadIdx.x == 0) (void)xb_add(&bar[XB_XCNT(b.x)], 1u);
    return b;
}
__device__ __forceinline__ void xcd_barrier_complete(unsigned* bar, unsigned x, unsigned& nloc, unsigned& nx) {
    const unsigned G = gridDim.x * gridDim.y * gridDim.z;
    unsigned sum, cnt, mine, sp = 0u;
    for (;;) {
        sum = 0u; cnt = 0u; mine = 0u;
#pragma unroll
        for (unsigned j = 0; j < 16; ++j) { const unsigned c = xb_ld(&bar[XB_XCNT(j)]); sum += c; cnt += (c > 0u) ? 1u : 0u; mine = (j == x) ? c : mine; }
        if (sum == G) break;
        __builtin_amdgcn_s_sleep(1);
        if ((++sp & 255u) == 0u) { if (xb_ld(&bar[XB_TMO])) break; if (sp > XB_SPIN_CAP) { atomicAdd(&bar[XB_TMO], 1u); break; } }
    }
    nloc = mine > 0u ? mine : 1u; nx = cnt > 0u ? cnt : 1u;
}
__device__ __forceinline__ void xcd_barrier(const XcdBarrier& b) {
    asm volatile("s_waitcnt vmcnt(0)" ::: "memory");
    __syncthreads();
    if (threadIdx.x == 0) {
        unsigned* bar = b.bar;
        __builtin_amdgcn_s_waitcnt(0);
        unsigned nloc = b.st[0], nx = b.st[1];
        if (nloc == 0u) { xcd_barrier_complete(bar, b.x, nloc, nx); b.st[0] = nloc; b.st[1] = nx; }
        const unsigned old = xb_add(&bar[XB_XSUB(b.x)], 1u);
        const unsigned gen = old / nloc;
        if (old + 1u == (gen + 1u) * nloc) {
            __builtin_amdgcn_fence(__ATOMIC_RELEASE, "agent");
            asm volatile("s_waitcnt vmcnt(0)" ::: "memory");
            const unsigned og = xb_add(&bar[XB_TOP], 1u);
            const unsigned tg = og / nx;
            if (og + 1u == (tg + 1u) * nx) xb_add(&bar[XB_TOPGEN], 1u);
            else XB_SPIN(xb_ld(&bar[XB_TOPGEN]) == tg, bar);
            __builtin_amdgcn_fence(__ATOMIC_ACQUIRE, "agent");
            xb_add(&bar[XB_XGEN(b.x)], 1u);
            asm volatile("s_waitcnt vmcnt(0)" ::: "memory");
        } else {
            XB_SPIN(xb_ld(&bar[XB_XGEN(b.x)]) == gen, bar);
            __builtin_amdgcn_fence(__ATOMIC_ACQUIRE, "agent");
            asm volatile("s_waitcnt vmcnt(0)" ::: "memory");
        }
    }
    __syncthreads();
}

constexpr int RING_OFF = 0, RING_BYTES = 131072;
constexpr int LDSCTL_OFF = 162816, MISC_OFF = LDSCTL_OFF + 320;
constexpr int LDS_BYTES = 163840;

struct Frame {
    LAS unsigned char* lds;
    volatile LAS unsigned* MISC;
    gu32* ctl;
    int tid, lane, wave, G, wg;
    const float* in[21];
    float* out;
    unsigned char* ws;
};

__device__ __forceinline__ void p0_transpose_item(const float* W, int K, int N, bf16* WT, LAS float* scr, int item, int lane) {
    const int nblk = N / 32, kb = item / nblk, nb = item % nblk, k0 = 64 * kb, n0 = 32 * nb;
#pragma unroll 8
    for (int i = 0; i < 32; ++i) { const int kk = 2 * i + (lane >> 5); scr[kk * 33 + (lane & 31)] = W[(size_t)(k0 + kk) * N + n0 + (lane & 31)]; }
    LDS_WAIT(); asm volatile("" ::: "memory");
    const int c = lane & 7;
#pragma unroll
    for (int j = 0; j < 4; ++j) { const int n = (lane >> 3) + 8 * j; const LAS float* s = scr + (8 * c) * 33 + n;
        v4u o; o.x = pk2(s[0 * 33], s[1 * 33]); o.y = pk2(s[2 * 33], s[3 * 33]); o.z = pk2(s[4 * 33], s[5 * 33]); o.w = pk2(s[6 * 33], s[7 * 33]);
        *(GAS v4u*)(WT + (size_t)(n0 + n) * K + k0 + 8 * c) = o; }
    LDS_WAIT(); asm volatile("" ::: "memory");
}
__device__ __forceinline__ void rms_row_to_bf16(int lane, const float* xrow, const float* gain, bf16* orow) {
    const GAS f32x4* xr = (const GAS f32x4*)xrow + lane;
    const GAS f32x4* gr = (const GAS f32x4*)gain + lane;
    f32x4 v[4]; float s = 0.f;
#pragma unroll
    for (int j = 0; j < 4; ++j) { v[j] = xr[64 * j]; s += (v[j].x * v[j].x + v[j].y * v[j].y) + (v[j].z * v[j].z + v[j].w * v[j].w); }
    const float rstd = 1.f / sqrtf(wave_sum(s) * (1.f / DM) + RMS_EPS);
    GAS unsigned long long* o8 = (GAS unsigned long long*)orow + lane;
#pragma unroll
    for (int j = 0; j < 4; ++j) { const f32x4 gg = gr[64 * j];
        o8[64 * j] = (unsigned long long)pk2(v[j].x * rstd * gg.x, v[j].y * rstd * gg.y) | ((unsigned long long)pk2(v[j].z * rstd * gg.z, v[j].w * rstd * gg.w) << 32); }
}
__device__ __forceinline__ void cvt_row_to_bf16(int lane, const float* xrow, bf16* orow) {
    const GAS f32x4* xr = (const GAS f32x4*)xrow + lane;
    GAS unsigned long long* o8 = (GAS unsigned long long*)orow + lane;
#pragma unroll
    for (int j = 0; j < 4; ++j) { const f32x4 v = xr[64 * j]; o8[64 * j] = (unsigned long long)pk2(v.x, v.y) | ((unsigned long long)pk2(v.z, v.w) << 32); }
}
__device__ __forceinline__ void p0_prologue(Frame& F) {
    LAS float* scr = (LAS float*)(F.lds + RING_OFF + F.wave * 16384);
    const int gw = F.wg * NWAVES + F.wave, NGW = F.G * NWAVES;
    constexpr int I_IN = (DM / 64) * (IN_COLS / 32), I_OUT = (DM / 64) * (DM / 32), I_Q = (DM / 64) * (PQ / 32);
    constexpr int NITEMS = I_IN + I_OUT + I_Q;
    bf16* win_t = (bf16*)(F.ws + WS_WIN); bf16* wout_t = (bf16*)(F.ws + WS_WOUT); bf16* wq_t = (bf16*)(F.ws + WS_WQ);
    for (int it = gw; it < NITEMS; it += NGW) {
        int r = it;
        if (r < I_IN) { p0_transpose_item(F.in[2], DM, IN_COLS, win_t, scr, r, F.lane); continue; } r -= I_IN;
        if (r < I_OUT) { p0_transpose_item(F.in[14], DM, DM, wout_t, scr, r, F.lane); continue; } r -= I_OUT;
        p0_transpose_item(F.in[16], DM, PQ, wq_t, scr, r, F.lane);
    }
    {
        constexpr int I_W = (64 / 64) * (RWW / 32), I_G = (128 / 64) * (RWW / 32);
        for (int it = gw; it < 2 * I_W + I_G; it += NGW) {
            int r = it;
            if (r < I_W) { p0_transpose_item(F.in[5], 64, RWW, (bf16*)(F.ws + WS_WUPT), scr, r, F.lane); continue; } r -= I_W;
            if (r < I_W) { p0_transpose_item(F.in[7], 64, RWW, (bf16*)(F.ws + WS_AUPT), scr, r, F.lane); continue; } r -= I_W;
            p0_transpose_item(F.in[8], 128, RWW, (bf16*)(F.ws + WS_GUPT), scr, r, F.lane);
        }
    }
    bf16* XN = (bf16*)(F.ws + WS_XN);
    for (int m = gw; m < T; m += NGW) rms_row_to_bf16(F.lane, F.in[0] + (size_t)m * DM, F.in[1], XN + (size_t)m * DM);
    bf16* UB = (bf16*)(F.ws + WS_UB); bf16* VB = (bf16*)(F.ws + WS_VB);
    for (int m = gw; m < NEXP; m += NGW) { cvt_row_to_bf16(F.lane, F.in[18] + (size_t)m * DM, UB + (size_t)m * DM); cvt_row_to_bf16(F.lane, F.in[19] + (size_t)m * DM, VB + (size_t)m * DM); }
}

__device__ __forceinline__ void p2_rope(Frame& F) {
    bf16* Z = (bf16*)(F.ws + WS_Z);
    const int tid = F.tid, i = tid & 31, grp = tid >> 5;
    const float inv_freq = powf(10000.0f, -(float)(2 * i) / 64.0f);
    for (int blk = F.wg; blk < T / 16; blk += F.G) {
        for (int k = 0; k < 16; ++k) { const int g = blk * 16 + k, s = g & (SEQ - 1);
            const float ang = (float)s * inv_freq;
            const double r = (double)ang - rint((double)ang * 0.15915494309189535) * 6.283185307179586;
            const float rf = (float)r; const float cs = cosf(rf), sn = sinf(rf);
            bf16* p = Z + (size_t)g * IN_COLS + C_AQ + grp * 64 + i;
            const float x1 = bf2f(p[0]), x2 = bf2f(p[32]);
            p[0] = (bf16)f2bf(x1 * cs - x2 * sn); p[32] = (bf16)f2bf(x1 * sn + x2 * cs); }
    }
}

typedef float f32x16 __attribute__((ext_vector_type(16)));
constexpr int SBS = 144;
constexpr int R1_EPRE = 0, R1_APRE = 16384, R1_AAB = 0, R1_X = 16384;
constexpr int R1_AT = 32768, R1_BT = 41984, R1_KT = 51200, R1_RT = 60416, R1_AHT = R1_BT, R1_U0T = R1_KT;
constexpr int R1_BBT = 69632, R1_KBT = 78848, R1_VT = 88064;
constexpr int R1_ACTW = 97280, R1_ACTA = 106496, R1_AAK = 97280, R1_ARB = 106496, R1_ARK = 115712;
constexpr int R1_BONUS = 124928, R1_WEND = 125184, R1_SEGS = 125440, R1_TII = 125440, R1_END = 129536;
static_assert(R1_END <= LDSCTL_OFF, "R1 LDS");
__device__ __forceinline__ int crow(int r, int hh) { return (r & 3) + 8 * (r >> 2) + 4 * hh; }
template <int KS> __device__ __forceinline__ f32x16 wtile(const LAS unsigned char* A, int sa, const LAS unsigned char* B, int sb, f32x16 acc, int lane) {
    const int row = lane & 31, hh = lane >> 5;
#pragma unroll
    for (int s = 0; s < KS; ++s) { const bf16x8 a = *(const LAS bf16x8*)(A + row * sa + 32 * s + 16 * hh); const bf16x8 b = *(const LAS bf16x8*)(B + row * sb + 32 * s + 16 * hh);
        acc = __builtin_amdgcn_mfma_f32_32x32x16_bf16(a, b, acc, 0, 0, 0); }
    return acc;
}
template <int KS> __device__ __forceinline__ f32x16 wtile_gb(const LAS unsigned char* A, int sa, const bf16* Bg, int ldb, f32x16 acc, int lane) {
    const int row = lane & 31, hh = lane >> 5;
#pragma unroll
    for (int s = 0; s < KS; ++s) { const bf16x8 a = *(const LAS bf16x8*)(A + row * sa + 32 * s + 16 * hh); const bf16x8 b = *(const GAS bf16x8*)(Bg + (size_t)row * ldb + 16 * s + 8 * hh);
        acc = __builtin_amdgcn_mfma_f32_32x32x16_bf16(a, b, acc, 0, 0, 0); }
    return acc;
}
__device__ __forceinline__ f32x16 zero16() { f32x16 z;
#pragma unroll
    for (int r = 0; r < 16; ++r) z[r] = 0.f;
    return z; }

__device__ __forceinline__ void rwkv_r1_item(Frame& F, int item) {
    const int chain = item >> 7, chunk = item & 127, b = chain >> 3, h = chain & 7;
    const int g0 = b * SEQ + chunk * 64;
    int tid_ = F.tid; asm volatile("" : "+v"(tid_));
    const int tid = tid_, lane = tid & 63, w = __builtin_amdgcn_readfirstlane(tid >> 6), hh = lane >> 5, cl = lane & 31;
    const bf16* Z = (const bf16*)(F.ws + WS_Z);
    LAS unsigned char* lds = F.lds + RING_OFF;
    const float* mu = F.in[3];
    {
        const int t = tid >> 3, cg = tid & 7; const bool first = (chunk == 0 && t == 0);
        const bf16* zr = Z + (size_t)(g0 + t) * IN_COLS;
        const v4u cw = *(const GAS v4u*)(zr + C_WD + cg * 8), ca = *(const GAS v4u*)(zr + C_AD + cg * 8);
        v4u pw = (v4u){0u, 0u, 0u, 0u}, pa = (v4u){0u, 0u, 0u, 0u};
        if (!first) { pw = *(const GAS v4u*)(zr - IN_COLS + C_WD + cg * 8); pa = *(const GAS v4u*)(zr - IN_COLS + C_AD + cg * 8); }
        float fw[8], fa[8], qw[8], qa[8];
        fw[0] = bflo(cw.x); fw[1] = bfhi(cw.x); fw[2] = bflo(cw.y); fw[3] = bfhi(cw.y); fw[4] = bflo(cw.z); fw[5] = bfhi(cw.z); fw[6] = bflo(cw.w); fw[7] = bfhi(cw.w);
        fa[0] = bflo(ca.x); fa[1] = bfhi(ca.x); fa[2] = bflo(ca.y); fa[3] = bfhi(ca.y); fa[4] = bflo(ca.z); fa[5] = bfhi(ca.z); fa[6] = bflo(ca.w); fa[7] = bfhi(ca.w);
        qw[0] = bflo(pw.x); qw[1] = bfhi(pw.x); qw[2] = bflo(pw.y); qw[3] = bfhi(pw.y); qw[4] = bflo(pw.z); qw[5] = bfhi(pw.z); qw[6] = bflo(pw.w); qw[7] = bfhi(pw.w);
        qa[0] = bflo(pa.x); qa[1] = bfhi(pa.x); qa[2] = bflo(pa.y); qa[3] = bfhi(pa.y); qa[4] = bflo(pa.z); qa[5] = bfhi(pa.z); qa[6] = bflo(pa.w); qa[7] = bfhi(pa.w);
#pragma unroll
        for (int j = 0; j < 8; ++j) { const int c = cg * 8 + j; fw[j] = tanhf(fw[j] + (qw[j] - fw[j]) * mu[C_WD + c]); fa[j] = fa[j] + (qa[j] - fa[j]) * mu[C_AD + c]; }
        v4u ow, oa; ow.x = pk2(fw[0], fw[1]); ow.y = pk2(fw[2], fw[3]); ow.z = pk2(fw[4], fw[5]); ow.w = pk2(fw[6], fw[7]);
        oa.x = pk2(fa[0], fa[1]); oa.y = pk2(fa[2], fa[3]); oa.z = pk2(fa[4], fa[5]); oa.w = pk2(fa[6], fa[7]);
        *(LAS v4u*)(lds + R1_ACTW + t * SBS + cg * 16) = ow; *(LAS v4u*)(lds + R1_ACTA + t * SBS + cg * 16) = oa;
    }
    __syncthreads();
    {
        const int p = w >> 2, mt = (w >> 1) & 1, nt = w & 1;
        const bf16* upt = (const bf16*)(F.ws + (p == 0 ? WS_WUPT : WS_AUPT)) + (size_t)(h * 64 + nt * 32) * 64;
        const f32x16 acc = wtile_gb<4>(lds + (p == 0 ? R1_ACTW : R1_ACTA) + mt * 32 * SBS, SBS, upt, 64, zero16(), lane);
        LAS float* O = (LAS float*)(lds + (p == 0 ? R1_EPRE : R1_APRE));
#pragma unroll
        for (int r = 0; r < 16; ++r) O[(mt * 32 + crow(r, hh)) * 64 + nt * 32 + cl] = acc[r];
    }
    __syncthreads();
    {
        const int c = tid & 63, ts = tid >> 6, col = h * 64 + c;
        const float mu_r = mu[C_R + col], mu_k = mu[C_K + col], mu_v = mu[C_V + col], kkc = F.in[9][col], kac = F.in[10][col], rkc = F.in[11][col], w0c = F.in[4][col], a0c = F.in[6][col];
        const LAS float* EP = (const LAS float*)(lds + R1_EPRE); const LAS float* AP = (const LAS float*)(lds + R1_APRE);
        LAS float* SEGS = (LAS float*)(lds + R1_SEGS); LAS float* BON = (LAS float*)(lds + R1_BONUS);
        const bf16* zb = Z + (size_t)(g0 + 8 * ts) * IN_COLS + col;
        float pr = 0.f, pk = 0.f, pv = 0.f;
        if (!(chunk == 0 && ts == 0)) { pr = bf2f(zb[C_R - IN_COLS]); pk = bf2f(zb[C_K - IN_COLS]); pv = bf2f(zb[C_V - IN_COLS]); }
        float rr[8], k2[8], ai[8], bi[8], vv[8], ee[8], cs[8]; float run = 0.f;
#pragma unroll
        for (int i = 0; i < 8; ++i) {
            const float zr = bf2f(zb[(size_t)i * IN_COLS + C_R]), zk = bf2f(zb[(size_t)i * IN_COLS + C_K]), zv = bf2f(zb[(size_t)i * IN_COLS + C_V]);
            const float r = zr + (pr - zr) * mu_r, k = zk + (pk - zk) * mu_k, v = zv + (pv - zv) * mu_v; pr = zr; pk = zk; pv = zv;
            const float e = 0.60653066f / (1.f + __expf(-(w0c + EP[(8 * ts + i) * 64 + c])));
            const float a = 1.f / (1.f + __expf(-(a0c + AP[(8 * ts + i) * 64 + c])));
            float kk = k * kkc; const float n2 = wave_sum(kk * kk); kk = kk / fmaxf(sqrtf(n2), 1e-12f);
            const float kq = k * (1.f + (a - 1.f) * kac);
            const float bon = wave_sum(r * kq * rkc); if (c == 0) BON[8 * ts + i] = bon;
            rr[i] = r; k2[i] = kq; ai[i] = -kk; bi[i] = kk * a; vv[i] = v; ee[i] = e; run += e; cs[i] = run;
        }
        SEGS[ts * 64 + c] = run;
        __syncthreads();
        float off = 0.f, tot = 0.f;
#pragma unroll
        for (int q = 0; q < 8; ++q) { const float sv = SEGS[q * 64 + c]; tot += sv; off += (q < ts) ? sv : 0.f; }
        float bb[8], kb[8];
#pragma unroll
        for (int i = 0; i < 8; ++i) { const float L = off + cs[i];
            const float Wm = __expf(-(L - ee[i])), Wi = __expf(-L), iW = __expf(L), We = __expf(-(tot - L));
            const int t = 8 * ts + i;
            *(LAS bf16*)(lds + R1_AT + t * SBS + c * 2) = (bf16)f2bf(ai[i] * Wm);
            *(LAS bf16*)(lds + R1_BT + t * SBS + c * 2) = (bf16)f2bf(bi[i] * iW);
            *(LAS bf16*)(lds + R1_KT + t * SBS + c * 2) = (bf16)f2bf(k2[i] * iW);
            *(LAS bf16*)(lds + R1_RT + t * SBS + c * 2) = (bf16)f2bf(rr[i] * Wi);
            bb[i] = bi[i] * We; kb[i] = k2[i] * We; }
        v4u o; o.x = pk2(bb[0], bb[1]); o.y = pk2(bb[2], bb[3]); o.z = pk2(bb[4], bb[5]); o.w = pk2(bb[6], bb[7]);
        *(LAS v4u*)(lds + R1_BBT + c * SBS + ts * 16) = o;
        o.x = pk2(kb[0], kb[1]); o.y = pk2(kb[2], kb[3]); o.z = pk2(kb[4], kb[5]); o.w = pk2(kb[6], kb[7]);
        *(LAS v4u*)(lds + R1_KBT + c * SBS + ts * 16) = o;
        o.x = pk2(vv[0], vv[1]); o.y = pk2(vv[2], vv[3]); o.z = pk2(vv[4], vv[5]); o.w = pk2(vv[6], vv[7]);
        *(LAS v4u*)(lds + R1_VT + c * SBS + ts * 16) = o;
        if (ts == 0) ((LAS float*)(lds + R1_WEND))[c] = __expf(-tot);
    }
    __syncthreads();
#pragma unroll
    for (int u = 0; u < 2; ++u) {
        const int idx = w * 2 + u, p = idx >> 2, mt = (idx >> 1) & 1, nt = idx & 1;
        const LAS unsigned char* Aop = lds + ((p == 0 || p == 2) ? R1_BT : R1_KT) + mt * 32 * SBS;
        const LAS unsigned char* Bop = lds + (p < 2 ? R1_AT : R1_RT) + nt * 32 * SBS;
        f32x16 acc = wtile<4>(Aop, SBS, Bop, SBS, zero16(), lane);
        const int n = nt * 32 + cl;
#pragma unroll
        for (int r = 0; r < 16; ++r) { const int m = mt * 32 + crow(r, hh); const bool keep = (p < 2) ? (m < n) : (m <= n); acc[r] = keep ? acc[r] : 0.f; }
#pragma unroll
        for (int g4 = 0; g4 < 4; ++g4) { const int m0 = mt * 32 + 8 * g4 + 4 * hh;
            if (p == 0) *(LAS f32x4*)(lds + R1_AAB + (n * 64 + m0) * 4) = (f32x4){acc[4 * g4], acc[4 * g4 + 1], acc[4 * g4 + 2], acc[4 * g4 + 3]};
            else { v2u o; o.x = pk2(acc[4 * g4], acc[4 * g4 + 1]); o.y = pk2(acc[4 * g4 + 2], acc[4 * g4 + 3]);
                   *(LAS v2u*)(lds + (p == 1 ? R1_AAK : (p == 2 ? R1_ARB : R1_ARK)) + n * SBS + m0 * 2) = o; } }
    }
    __syncthreads();
    if (w < 4) {
        const int mt = w >> 1, nt = w & 1;
        const f32x16 acc = wtile<4>(lds + R1_AAK + mt * 32 * SBS, SBS, lds + R1_VT + nt * 32 * SBS, SBS, zero16(), lane);
        LAS float* X = (LAS float*)(lds + R1_X);
#pragma unroll
        for (int r = 0; r < 16; ++r) X[(mt * 32 + crow(r, hh)) * 64 + nt * 32 + cl] = acc[r];
    } else if (w == 4) {
        const int bk = lane >> 4, c = lane & 15;
        const LAS float* AAB = (const LAS float*)(lds + R1_AAB);
        float Tc[16]; const float fc = (float)c;
#pragma unroll
        for (int s2 = 0; s2 < 16; ++s2) { float val = fmaxf(0.f, 1.f - fabsf((float)s2 - fc));
#pragma unroll
            for (int r = 0; r < s2; ++r) val += AAB[(16 * bk + s2) * 64 + 16 * bk + r] * Tc[r];
            Tc[s2] = val; }
        LAS float* TII = (LAS float*)(lds + R1_TII);
#pragma unroll
        for (int s2 = 0; s2 < 16; ++s2) TII[(bk * 16 + s2) * 16 + c] = Tc[s2];
    }
    __syncthreads();
    {
        const int c16 = lane & 15, g = lane >> 4;
        const LAS float* AAB = (const LAS float*)(lds + R1_AAB); const LAS float* TII = (const LAS float*)(lds + R1_TII); const LAS float* X = (const LAS float*)(lds + R1_X);
        f32x4 o[4];
#pragma unroll
        for (int i = 0; i < 4; ++i) {
            f32x4 acc;
            if (w < 4) {
#pragma unroll
                for (int q = 0; q < 4; ++q) acc[q] = bf2f(*(const LAS bf16*)(lds + R1_AT + (16 * i + 4 * g + q) * SBS + (16 * w + c16) * 2));
            } else {
#pragma unroll
                for (int q = 0; q < 4; ++q) acc[q] = X[(16 * i + 4 * g + q) * 64 + 16 * (w - 4) + c16];
            }
#pragma unroll
            for (int j = 0; j < i; ++j) { const f32x4 a4 = *(const LAS f32x4*)(AAB + (16 * i + c16) * 64 + 16 * j + 4 * g);
#pragma unroll
                for (int q = 0; q < 4; ++q) acc = __builtin_amdgcn_mfma_f32_16x16x4f32(a4[q], o[j][q], acc, 0, 0, 0); }
            const f32x4 t4 = *(const LAS f32x4*)(TII + (i * 16 + c16) * 16 + 4 * g);
            f32x4 res = (f32x4){0.f, 0.f, 0.f, 0.f};
#pragma unroll
            for (int q = 0; q < 4; ++q) res = __builtin_amdgcn_mfma_f32_16x16x4f32(t4[q], acc[q], res, 0, 0, 0);
            o[i] = res;
            v2u ov; ov.x = pk2(res[0], res[1]); ov.y = pk2(res[2], res[3]);
            *(LAS v2u*)(lds + (w < 4 ? R1_AHT : R1_U0T) + (16 * (w & 3) + c16) * SBS + (16 * i + 4 * g) * 2) = ov;
        }
    }
    __syncthreads();
    {
        float* Mg = F.out + (size_t)item * 4096; float* NTg = F.out + (size_t)T * RWW + (size_t)item * 4096;
        float* Y0g = (float*)(F.ws + WS_RWY0) + (size_t)item * 4096; bf16* RHg = (bf16*)(F.ws + WS_RWRH) + (size_t)item * 4096;
#pragma unroll
        for (int u = 0; u < 2; ++u) {
            const int idx = w * 2 + u, p = idx >> 2, mt = (idx >> 1) & 1, nt = idx & 1; const int n = nt * 32 + cl;
            if (p == 0) {
                f32x16 acc = wtile<4>(lds + R1_BBT + mt * 32 * SBS, SBS, lds + R1_AHT + nt * 32 * SBS, SBS, zero16(), lane);
                const LAS float* WE = (const LAS float*)(lds + R1_WEND);
#pragma unroll
                for (int r = 0; r < 16; ++r) { const int m = mt * 32 + crow(r, hh); Mg[m * 64 + n] = acc[r] + (m == n ? WE[m] : 0.f); }
            } else if (p == 1) {
                f32x16 acc = wtile<4>(lds + R1_U0T + mt * 32 * SBS, SBS, lds + R1_BBT + nt * 32 * SBS, SBS, zero16(), lane);
                acc = wtile<4>(lds + R1_VT + mt * 32 * SBS, SBS, lds + R1_KBT + nt * 32 * SBS, SBS, acc, lane);
#pragma unroll
                for (int r = 0; r < 16; ++r) NTg[(mt * 32 + crow(r, hh)) * 64 + n] = acc[r];
            } else if (p == 2) {
                f32x16 acc = wtile<4>(lds + R1_AHT + mt * 32 * SBS, SBS, lds + R1_ARB + nt * 32 * SBS, SBS, zero16(), lane);
#pragma unroll
                for (int g4 = 0; g4 < 4; ++g4) { const int m0 = mt * 32 + 8 * g4 + 4 * hh;
                    const v2u rt = *(const LAS v2u*)(lds + R1_RT + n * SBS + m0 * 2);
                    v2u ov; ov.x = pk2(acc[4 * g4] + bflo(rt.x), acc[4 * g4 + 1] + bfhi(rt.x)); ov.y = pk2(acc[4 * g4 + 2] + bflo(rt.y), acc[4 * g4 + 3] + bfhi(rt.y));
                    *(GAS v2u*)(RHg + n * 64 + m0) = ov; }
            } else {
                f32x16 acc = wtile<4>(lds + R1_ARB + mt * 32 * SBS, SBS, lds + R1_U0T + nt * 32 * SBS, SBS, zero16(), lane);
                acc = wtile<4>(lds + R1_ARK + mt * 32 * SBS, SBS, lds + R1_VT + nt * 32 * SBS, SBS, acc, lane);
#pragma unroll
                for (int r = 0; r < 16; ++r) Y0g[(mt * 32 + crow(r, hh)) * 64 + n] = acc[r];
            }
        }
        if (tid < 64) ((float*)(F.ws + WS_BONUS))[(size_t)item * 64 + tid] = ((const LAS float*)(lds + R1_BONUS))[tid];
    }
    __syncthreads();
}

__device__ __forceinline__ void rwkv_r2_chain(Frame& F, int chain) {
    const int w = F.wave; if (w >= 4) return;
    const int lane = F.lane, n16 = lane & 15, g = lane >> 4;
    const float* Mg = F.out + (size_t)chain * 128 * 4096; const float* NTg = F.out + (size_t)T * RWW + (size_t)chain * 128 * 4096;
    float* SSg = (float*)(F.ws + WS_RWSS) + (size_t)chain * 128 * 4096;
    f32x4 st[4];
#pragma unroll
    for (int rt = 0; rt < 4; ++rt) st[rt] = (f32x4){0.f, 0.f, 0.f, 0.f};
    f32x4 ma[4][4], nv[4];
#pragma unroll
    for (int rt = 0; rt < 4; ++rt) {
#pragma unroll
        for (int kt = 0; kt < 4; ++kt) ma[rt][kt] = *(const GAS f32x4*)(Mg + (16 * rt + n16) * 64 + 16 * kt + 4 * g);
        nv[rt] = *(const GAS f32x4*)(NTg + (16 * w + n16) * 64 + 16 * rt + 4 * g); }
    for (int c = 0; c < 128; ++c) {
#pragma unroll
        for (int rt = 0; rt < 4; ++rt) *(GAS f32x4*)(SSg + (size_t)c * 4096 + (16 * w + n16) * 64 + 16 * rt + 4 * g) = st[rt];
        if (c == 127) break;
        f32x4 nw[4];
#pragma unroll
        for (int rt = 0; rt < 4; ++rt) { f32x4 acc = nv[rt];
#pragma unroll
            for (int kt = 0; kt < 4; ++kt)
#pragma unroll
                for (int q = 0; q < 4; ++q) acc = __builtin_amdgcn_mfma_f32_16x16x4f32(ma[rt][kt][q], st[kt][q], acc, 0, 0, 0);
            nw[rt] = acc; }
        const float* Mn = Mg + (size_t)(c + 1) * 4096; const float* Nn = NTg + (size_t)(c + 1) * 4096;
#pragma unroll
        for (int rt = 0; rt < 4; ++rt) {
#pragma unroll
            for (int kt = 0; kt < 4; ++kt) ma[rt][kt] = *(const GAS f32x4*)(Mn + (16 * rt + n16) * 64 + 16 * kt + 4 * g);
            nv[rt] = *(const GAS f32x4*)(Nn + (16 * w + n16) * 64 + 16 * rt + 4 * g); }
#pragma unroll
        for (int rt = 0; rt < 4; ++rt) st[rt] = nw[rt];
    }
}

constexpr int R3_RH = 0, R3_S = 9216, R3_SG = 18432, R3_SGS = 272, R3_YL = R3_SG + 64 * R3_SGS, R3_GL = R3_YL + 16384, R3_END = R3_GL + 16384;
static_assert(R3_END <= LDSCTL_OFF, "R3 LDS");
__device__ __forceinline__ void rwkv_r3_item(Frame& F, int item) {
    const int chain = item >> 7, chunk = item & 127, b = chain >> 3, h = chain & 7;
    const int g0 = b * SEQ + chunk * 64;
    int tid_ = F.tid; asm volatile("" : "+v"(tid_));
    const int tid = tid_, lane = tid & 63, w = __builtin_amdgcn_readfirstlane(tid >> 6), hh = lane >> 5, cl = lane & 31;
    const bf16* Z = (const bf16*)(F.ws + WS_Z);
    LAS unsigned char* lds = F.lds + RING_OFF;
    const float* mu = F.in[3];
    {
        const int t = tid >> 3, cg = tid & 7;
        const bf16* RHg = (const bf16*)(F.ws + WS_RWRH) + (size_t)item * 4096;
        *(LAS v4u*)(lds + R3_RH + t * SBS + cg * 16) = *(const GAS v4u*)(RHg + t * 64 + cg * 8);
        const float* SSg = (const float*)(F.ws + WS_RWSS) + (size_t)item * 4096;
        const f32x4 s0 = *(const GAS f32x4*)(SSg + t * 64 + cg * 8), s1 = *(const GAS f32x4*)(SSg + t * 64 + cg * 8 + 4);
        v4u o; o.x = pk2(s0[0], s0[1]); o.y = pk2(s0[2], s0[3]); o.z = pk2(s1[0], s1[1]); o.w = pk2(s1[2], s1[3]);
        *(LAS v4u*)(lds + R3_S + t * SBS + cg * 16) = o;
        const bool first = (chunk == 0 && t == 0);
        const bf16* zr = Z + (size_t)(g0 + t) * IN_COLS + C_GD + cg * 16;
#pragma unroll
        for (int q = 0; q < 2; ++q) {
            const v4u cw = *(const GAS v4u*)(zr + q * 8); v4u pw = (v4u){0u, 0u, 0u, 0u};
            if (!first) pw = *(const GAS v4u*)(zr - IN_COLS + q * 8);
            float fw[8], qw[8];
            fw[0] = bflo(cw.x); fw[1] = bfhi(cw.x); fw[2] = bflo(cw.y); fw[3] = bfhi(cw.y); fw[4] = bflo(cw.z); fw[5] = bfhi(cw.z); fw[6] = bflo(cw.w); fw[7] = bfhi(cw.w);
            qw[0] = bflo(pw.x); qw[1] = bfhi(pw.x); qw[2] = bflo(pw.y); qw[3] = bfhi(pw.y); qw[4] = bflo(pw.z); qw[5] = bfhi(pw.z); qw[6] = bflo(pw.w); qw[7] = bfhi(pw.w);
#pragma unroll
            for (int j = 0; j < 8; ++j) { const float v = fw[j] + (qw[j] - fw[j]) * mu[C_GD + cg * 16 + q * 8 + j]; fw[j] = 1.f / (1.f + __expf(-v)); }
            v4u og; og.x = pk2(fw[0], fw[1]); og.y = pk2(fw[2], fw[3]); og.z = pk2(fw[4], fw[5]); og.w = pk2(fw[6], fw[7]);
            *(LAS v4u*)(lds + R3_SG + t * R3_SGS + (cg * 16 + q * 8) * 2) = og;
        }
    }
    __syncthreads();
    {
        const int mt = (w >> 1) & 1, nt = w & 1; const int n = nt * 32 + cl;
        if (w < 4) {
            const float* Y0g = (const float*)(F.ws + WS_RWY0) + (size_t)item * 4096;
            f32x16 acc;
#pragma unroll
            for (int r = 0; r < 16; ++r) acc[r] = Y0g[(mt * 32 + crow(r, hh)) * 64 + n];
            acc = wtile<4>(lds + R3_RH + mt * 32 * SBS, SBS, lds + R3_S + nt * 32 * SBS, SBS, acc, lane);
            LAS float* YL = (LAS float*)(lds + R3_YL);
#pragma unroll
            for (int r = 0; r < 16; ++r) YL[(mt * 32 + crow(r, hh)) * 64 + n] = acc[r];
        } else {
            const bf16* gut = (const bf16*)(F.ws + WS_GUPT) + (size_t)(h * 64 + nt * 32) * 128;
            const f32x16 acc = wtile_gb<8>(lds + R3_SG + mt * 32 * R3_SGS, R3_SGS, gut, 128, zero16(), lane);
            LAS float* GL = (LAS float*)(lds + R3_GL);
#pragma unroll
            for (int r = 0; r < 16; ++r) GL[(mt * 32 + crow(r, hh)) * 64 + n] = acc[r];
        }
    }
    __syncthreads();
    {
        const int c = tid & 63, ts = tid >> 6, col = h * 64 + c;
        const float mu_v = mu[C_V + col], gw = F.in[12][col], gb = F.in[13][col];
        const LAS float* YL = (const LAS float*)(lds + R3_YL); const LAS float* GL = (const LAS float*)(lds + R3_GL);
        const float* BON = (const float*)(F.ws + WS_BONUS) + (size_t)item * 64;
        bf16* Y = (bf16*)(F.ws + WS_YMIX);
        const bf16* zb = Z + (size_t)(g0 + 8 * ts) * IN_COLS + col;
        float pv = 0.f; if (!(chunk == 0 && ts == 0)) pv = bf2f(zb[C_V - IN_COLS]);
#pragma unroll
        for (int i = 0; i < 8; ++i) { const int t = 8 * ts + i;
            const float zv = bf2f(zb[(size_t)i * IN_COLS + C_V]); const float v = zv + (pv - zv) * mu_v; pv = zv;
            const float y = YL[t * 64 + c];
            const float mean = wave_sum(y) * (1.f / 64.f); const float d = y - mean; const float var = wave_sum(d * d) * (1.f / 64.f);
            const float yn = d * (1.f / sqrtf(var + GN_EPS)) * gw + gb;
            const float o = (yn + BON[t] * v) * GL[t * 64 + c];
            Y[(size_t)(g0 + t) * DM + col] = (bf16)f2bf(o); }
    }
    __syncthreads();
}

typedef short s16x4 __attribute__((ext_vector_type(4)));
typedef short v4i16_t __attribute__((ext_vector_type(4)));
constexpr int AT_XO = 0, AT_XO_STRIDE = 136, AT_XM = 512 * AT_XO_STRIDE, AT_XL = AT_XM + 2048, AT_V = AT_XL + 2048, AT_LDS_END = AT_V + 8 * 4096;
static_assert(AT_LDS_END <= RING_BYTES, "attention LDS");
__device__ __forceinline__ float xhalf(float v) { return __shfl_xor(v, 32); }
__device__ __forceinline__ void attn_block(Frame& F, int item) {
    const int bh = item >> 4, blk = item & 15, b = bh >> 3, h = bh & 7, t0 = blk * 512;
    int tid_ = F.tid; asm volatile("" : "+v"(tid_));
    const int lane = tid_ & 63, w = __builtin_amdgcn_readfirstlane(tid_ >> 6), ql = lane & 31, hh = lane >> 5;
    const bf16* Zb = (const bf16*)(F.ws + WS_Z) + (size_t)b * SEQ * IN_COLS;
    bf16* Y = (bf16*)(F.ws + WS_YMIX);
    LAS unsigned char* lds = F.lds + RING_OFF;
    LAS unsigned char* Vw = lds + AT_V + w * 4096;
    LAS float* XM = (LAS float*)(lds + AT_XM); LAS float* XL = (LAS float*)(lds + AT_XL);
    constexpr float C2 = 0.125f * 1.4426950408889634f;
    for (int pass = 0; pass < 3; ++pass) {
        const int sh = pass == 0 ? 4 : (pass == 1 ? 2 : 0), d = 1 << sh;
        for (int uu = 0; uu < 2; ++uu) {
            const int u = w + 8 * uu, rho = u & (d - 1), tau = u >> sh;
            const int qoff = rho + (32 * tau + ql) * d;
            bf16x8 qf[4];
            { const bf16* qp = Zb + (size_t)(t0 + qoff) * IN_COLS + C_AQ + h * 64 + 8 * hh;
#pragma unroll
              for (int s = 0; s < 4; ++s) qf[s] = *(const GAS bf16x8*)(qp + 16 * s); }
            f32x16 sc[5];
            const int tkb = t0 + rho + (32 * tau - 128) * d;
#pragma unroll
            for (int kt = 0; kt < 5; ++kt) {
                const int tk0 = tkb + 32 * kt * d;
                if (tk0 >= 0) {
                    const bf16* kp = Zb + (size_t)(tk0 + ql * d) * IN_COLS + C_AK + h * 64 + 8 * hh;
                    bf16x8 kf[4];
#pragma unroll
                    for (int s = 0; s < 4; ++s) kf[s] = *(const GAS bf16x8*)(kp + 16 * s);
                    f32x16 acc;
#pragma unroll
                    for (int r = 0; r < 16; ++r) acc[r] = 0.f;
#pragma unroll
                    for (int s = 0; s < 4; ++s) acc = __builtin_amdgcn_mfma_f32_32x32x16_bf16(kf[s], qf[s], acc, 0, 0, 0);
                    if (kt == 0 || kt == 4) {
#pragma unroll
                        for (int r = 0; r < 16; ++r) { const int kidx = (r & 3) + 8 * (r >> 2) + 4 * hh;
                            const bool ok = (kt == 0) ? (kidx >= ql) : (kidx <= ql);
                            acc[r] = ok ? acc[r] : -INFINITY; }
                    }
                    sc[kt] = acc;
                } else {
#pragma unroll
                    for (int r = 0; r < 16; ++r) sc[kt][r] = -INFINITY;
                }
            }
            float m = -INFINITY;
#pragma unroll
            for (int kt = 0; kt < 5; ++kt)
#pragma unroll
                for (int r = 0; r < 16; ++r) m = fmaxf(m, sc[kt][r]);
            m = fmaxf(m, xhalf(m));
            const float ms = m * C2;
            float l = 0.f;
#pragma unroll
            for (int kt = 0; kt < 5; ++kt)
#pragma unroll
                for (int r = 0; r < 16; ++r) { const float p = __builtin_amdgcn_exp2f(sc[kt][r] * C2 - ms); sc[kt][r] = p; l += p; }
            l += xhalf(l);
            f32x16 O[2];
#pragma unroll
            for (int r = 0; r < 16; ++r) { O[0][r] = 0.f; O[1][r] = 0.f; }
#pragma unroll
            for (int kt = 0; kt < 5; ++kt) {
                const int tk0 = tkb + 32 * kt * d;
                if (tk0 >= 0) {
                    v4u vr[4];
#pragma unroll
                    for (int i = 0; i < 4; ++i) { const int kidx = i * 8 + (lane >> 3), ch = lane & 7;
                        vr[i] = *(const GAS v4u*)(Zb + (size_t)(tk0 + kidx * d) * IN_COLS + C_AV + h * 64 + ch * 8); }
#pragma unroll
                    for (int i = 0; i < 4; ++i) { const int kidx = i * 8 + (lane >> 3), ch = lane & 7;
                        *(LAS v4u*)(Vw + kidx * 128 + ((ch ^ (((kidx >> 1) & 1) << 2)) << 4)) = vr[i]; }
                    asm volatile("s_waitcnt lgkmcnt(0)" ::: "memory");
#pragma unroll
                    for (int s = 0; s < 2; ++s) {
                        bf16x8 pf;
#pragma unroll
                        for (int j = 0; j < 8; ++j) pf[j] = (short)f2bf(sc[kt][8 * s + j]);
#pragma unroll
                        for (int dt = 0; dt < 2; ++dt) {
                            bf16x8 vf;
#pragma unroll
                            for (int pp = 0; pp < 2; ++pp) {
                                const int i16 = lane & 15, db = (lane >> 4) & 1;
                                const int row = 16 * s + 8 * pp + 4 * hh + (i16 >> 2);
                                const int byte = 64 * dt + 32 * db + 8 * (i16 & 3);
                                const int chunk = (byte >> 4) ^ (((row >> 1) & 1) << 2);
                                const s16x4 t4 = __builtin_bit_cast(s16x4, __builtin_amdgcn_ds_read_tr16_b64_v4i16((LAS v4i16_t*)(Vw + row * 128 + (chunk << 4) + (byte & 15))));
                                vf[4 * pp + 0] = t4[0]; vf[4 * pp + 1] = t4[1]; vf[4 * pp + 2] = t4[2]; vf[4 * pp + 3] = t4[3];
                            }
                            O[dt] = __builtin_amdgcn_mfma_f32_32x32x16_bf16(vf, pf, O[dt], 0, 0, 0);
                        }
                    }
                    asm volatile("s_waitcnt lgkmcnt(0)" ::: "memory");
                }
            }
            LAS unsigned char* xo = lds + AT_XO + qoff * AT_XO_STRIDE + 8 * hh;
            float wa = 0.f, wb = 1.f, Mx = ms, ln = l;
            if (pass > 0) { const float msa = XM[qoff], la = XL[qoff]; Mx = fmaxf(msa, ms); wa = la * __builtin_amdgcn_exp2f(msa - Mx); wb = __builtin_amdgcn_exp2f(ms - Mx); ln = wa + wb * l; }
            const float inv = 1.f / ln;
#pragma unroll
            for (int dt = 0; dt < 2; ++dt)
#pragma unroll
                for (int g4 = 0; g4 < 4; ++g4) {
                    LAS v2u* p = (LAS v2u*)(xo + (32 * dt + 8 * g4) * 2);
                    float o0 = O[dt][4 * g4] * wb, o1 = O[dt][4 * g4 + 1] * wb, o2 = O[dt][4 * g4 + 2] * wb, o3 = O[dt][4 * g4 + 3] * wb;
                    if (pass > 0) { const v2u old = *p; o0 += bflo(old.x) * wa; o1 += bfhi(old.x) * wa; o2 += bflo(old.y) * wa; o3 += bfhi(old.y) * wa; }
                    v2u nw; nw.x = pk2(o0 * inv, o1 * inv); nw.y = pk2(o2 * inv, o3 * inv);
                    *p = nw;
                }
            if (hh == 0) { XM[qoff] = Mx; XL[qoff] = ln; }
        }
        __syncthreads();
    }
#pragma unroll
    for (int i = 0; i < 8; ++i) { const int row = (tid_ >> 3) + 64 * i, ch = tid_ & 7;
        LAS v2u* p = (LAS v2u*)(lds + AT_XO + row * AT_XO_STRIDE + ch * 16);
        const v2u a = p[0], c = p[1];
        v4u o; o.x = a.x; o.y = a.y; o.z = c.x; o.w = c.y;
        *(GAS v4u*)(Y + ((size_t)b * SEQ + t0 + row) * DM + RWW + h * 64 + ch * 8) = o; }
    __syncthreads();
}

__device__ __forceinline__ void p3_mixers(Frame& F) {
    const int nrw = (F.G >= 64) ? 32 : 0;
    if (nrw == 0) { for (int ch = 0; ch < NB * NHR; ++ch) rwkv_r2_chain(F, ch); }
    else if (F.wg < nrw) { for (int ch = F.wg; ch < NB * NHR; ch += nrw) rwkv_r2_chain(F, ch); return; }
    const int na = F.G - nrw, wa = F.wg - nrw;
    for (int item = wa; item < NB * NHA * (SEQ / 512); item += na) attn_block(F, item);
}

__device__ __forceinline__ void p5_xn2(Frame& F) {
    const int gw = F.wg * NWAVES + F.wave, NGW = F.G * NWAVES;
    bf16* XN = (bf16*)(F.ws + WS_XN);
    for (int m = gw; m < T; m += NGW) rms_row_to_bf16(F.lane, F.out + (size_t)m * DM, F.in[15], XN + (size_t)m * DM);
}

constexpr int TK_SKS = 272, TK_SKH = 0, TK_SKL = 2 * 128 * TK_SKS, TK_LUT = 2 * TK_SKL, TK_END = TK_LUT + 8 * 2048;
__device__ __forceinline__ unsigned f2ord(float f) { const unsigned u = __builtin_bit_cast(unsigned, f); return u ^ ((unsigned)((int)u >> 31) | 0x80000000u); }
__device__ __forceinline__ float ord2f(unsigned o) { const unsigned u = (o & 0x80000000u) ? (o ^ 0x80000000u) : ~o; return __builtin_bit_cast(float, u); }
__device__ __forceinline__ void ce_desc(unsigned& a, unsigned& b) { const unsigned mx = a > b ? a : b, mn = a > b ? b : a; a = mx; b = mn; }
template <int N, int OFF, int TOT> __device__ __forceinline__ void bitonic_sort_desc(unsigned (&v)[TOT]) {
#pragma unroll
    for (int k = 2; k <= N; k <<= 1)
#pragma unroll
        for (int j = k >> 1; j > 0; j >>= 1)
#pragma unroll
            for (int i = 0; i < N; ++i) { const int l = i ^ j; if (l > i) { if ((i & k) == 0) ce_desc(v[OFF + i], v[OFF + l]); else ce_desc(v[OFF + l], v[OFF + i]); } }
}
template <int OFFA, int OFFB, int TOT> __device__ __forceinline__ void merge_top16(unsigned (&v)[TOT]) {
#pragma unroll
    for (int i = 0; i < 16; ++i) { const unsigned x = v[OFFA + i], y = v[OFFB + 15 - i]; v[OFFA + i] = x > y ? x : y; }
#pragma unroll
    for (int j = 8; j > 0; j >>= 1)
#pragma unroll
        for (int i = 0; i < 16; ++i) { const int l = i ^ j; if (l > i) ce_desc(v[OFFA + i], v[OFFA + l]); }
}
__device__ __forceinline__ void top16_of_64(unsigned (&k)[64]) {
    bitonic_sort_desc<16, 0, 64>(k); bitonic_sort_desc<16, 16, 64>(k); bitonic_sort_desc<16, 32, 64>(k); bitonic_sort_desc<16, 48, 64>(k);
    merge_top16<0, 16, 64>(k); merge_top16<32, 48, 64>(k); merge_top16<0, 32, 64>(k);
}
__device__ __forceinline__ void p7_topk(Frame& F) {
    static_assert(TK_END <= LDSCTL_OFF, "topk LDS");
    const bf16* QP = (const bf16*)(F.ws + WS_QP);
    int* EID = (int*)(F.ws + WS_EID); float* GATE = (float*)(F.ws + WS_GATE);
    const float* sk = F.in[17];
    LAS unsigned char* lds = F.lds + RING_OFF;
    for (int e = F.tid; e < 2 * 128 * 64; e += NTHREADS) {
        const int c = e >> 13, k = (e >> 6) & 127, d2 = e & 63;
        const f32x2 v = *(const GAS f32x2*)(sk + (size_t)(c * 128 + k) * 128 + 2 * d2);
        const unsigned h0 = f2bf(v.x), h1 = f2bf(v.y);
        const float r0 = v.x - __builtin_bit_cast(float, h0 << 16), r1 = v.y - __builtin_bit_cast(float, h1 << 16);
        *(LAS unsigned*)(lds + TK_SKH + (c * 128 + k) * TK_SKS + d2 * 4) = h0 | (h1 << 16);
        *(LAS unsigned*)(lds + TK_SKL + (c * 128 + k) * TK_SKS + d2 * 4) = pk2(r0, r1);
    }
    __syncthreads();
    const int gw = F.wg * NWAVES + F.wave, NGW = F.G * NWAVES;
    for (int tile = gw; tile < T * PHEADS / 32; tile += NGW) {
        int lane_ = F.lane; asm volatile("" : "+v"(lane_));
        const int lane = lane_, hh = lane >> 5, cl = lane & 31;
        const int P = tile * 32 + cl, t = P >> 3, h = P & 7;
        unsigned kAB[2][16];
#pragma unroll
        for (int c = 0; c < 2; ++c) {
            bf16x8 qf[8];
            const bf16* qp = QP + (size_t)t * PQ + h * 256 + c * 128 + 8 * hh;
#pragma unroll
            for (int s2 = 0; s2 < 8; ++s2) qf[s2] = *(const GAS bf16x8*)(qp + 16 * s2);
            unsigned k[64];
#pragma unroll
            for (int mt = 0; mt < 4; ++mt) {
                f32x16 acc = zero16();
                const LAS unsigned char* ah = lds + TK_SKH + (c * 128 + mt * 32 + cl) * TK_SKS + 16 * hh;
                const LAS unsigned char* al = lds + TK_SKL + (c * 128 + mt * 32 + cl) * TK_SKS + 16 * hh;
#pragma unroll
                for (int s2 = 0; s2 < 8; ++s2) {
                    acc = __builtin_amdgcn_mfma_f32_32x32x16_bf16(*(const LAS bf16x8*)(ah + 32 * s2), qf[s2], acc, 0, 0, 0);
                    acc = __builtin_amdgcn_mfma_f32_32x32x16_bf16(*(const LAS bf16x8*)(al + 32 * s2), qf[s2], acc, 0, 0, 0); }
#pragma unroll
                for (int r = 0; r < 16; ++r) { const int idx = 32 * mt + (r & 3) + 8 * (r >> 2) + 4 * hh; k[mt * 16 + r] = (f2ord(acc[r]) & ~127u) | (unsigned)(127 - idx); }
            }
            top16_of_64(k);
            unsigned m[32];
#pragma unroll
            for (int i = 0; i < 16; ++i) { m[i] = k[i]; m[16 + i] = (unsigned)__shfl_xor((int)k[i], 32); }
            merge_top16<0, 16, 32>(m);
#pragma unroll
            for (int i = 0; i < 16; ++i) kAB[c][i] = m[i];
        }
        float fa[16], fb[16];
#pragma unroll
        for (int i = 0; i < 16; ++i) { fa[i] = ord2f(kAB[0][i] & ~127u); fb[i] = ord2f(kAB[1][i] & ~127u); }
        unsigned cd[64]; int n = 0;
#pragma unroll
        for (int i = 0; i < 16; ++i)
#pragma unroll
            for (int j = 0; j < 16; ++j) if ((i + 1) * (j + 1) <= 16) { cd[n] = (f2ord(fa[i] + fb[j]) & ~255u) | (unsigned)(255 - (i * 16 + j)); ++n; }
#pragma unroll
        for (int q = 50; q < 64; ++q) cd[q] = 0u;
        top16_of_64(cd);
        LAS unsigned char* lut = lds + TK_LUT + (F.wave * 64 + lane) * 32;
#pragma unroll
        for (int q = 0; q < 4; ++q) {
            unsigned wa = 0u, wb = 0u;
#pragma unroll
            for (int b4 = 0; b4 < 4; ++b4) { wa |= (127u - (kAB[0][4 * q + b4] & 127u)) << (8 * b4); wb |= (127u - (kAB[1][4 * q + b4] & 127u)) << (8 * b4); }
            *(LAS unsigned*)(lut + 4 * q) = wa; *(LAS unsigned*)(lut + 16 + 4 * q) = wb; }
        float gv[16]; float den = 0.f; const float mx = ord2f(cd[0] & ~255u);
#pragma unroll
        for (int q = 0; q < 16; ++q) { gv[q] = __expf(ord2f(cd[q] & ~255u) - mx); den += gv[q]; }
        const float inv = 1.f / den;
        asm volatile("s_waitcnt lgkmcnt(0)" ::: "memory");
        int ev[16];
#pragma unroll
        for (int q = 0; q < 16; ++q) { const unsigned pos = 255u - (cd[q] & 255u);
            const unsigned ia = *(const LAS unsigned char*)(lut + (pos >> 4)), ib = *(const LAS unsigned char*)(lut + 16 + (pos & 15u));
            ev[q] = (int)(ia * NKEYS + ib); }
        if (hh == 0) {
            int* ep = EID + (size_t)t * 128 + h * 16; float* gp = GATE + (size_t)t * 128 + h * 16;
#pragma unroll
            for (int q = 0; q < 4; ++q) {
                *(GAS v4u*)(ep + 4 * q) = (v4u){(unsigned)ev[4 * q], (unsigned)ev[4 * q + 1], (unsigned)ev[4 * q + 2], (unsigned)ev[4 * q + 3]};
                *(GAS f32x4*)(gp + 4 * q) = (f32x4){gv[4 * q] * inv, gv[4 * q + 1] * inv, gv[4 * q + 2] * inv, gv[4 * q + 3] * inv}; }
        }
        asm volatile("s_waitcnt lgkmcnt(0)" ::: "memory");
    }
}

__device__ __forceinline__ void unpack8(const v4u a, float* f) { f[0] = bflo(a.x); f[1] = bfhi(a.x); f[2] = bflo(a.y); f[3] = bfhi(a.y); f[4] = bflo(a.z); f[5] = bfhi(a.z); f[6] = bflo(a.w); f[7] = bfhi(a.w); }
__device__ __forceinline__ void p8_gather(Frame& F) {
    const bf16* XN = (const bf16*)(F.ws + WS_XN);
    const bf16* UB = (const bf16*)(F.ws + WS_UB); const bf16* VB = (const bf16*)(F.ws + WS_VB);
    const int* EID = (const int*)(F.ws + WS_EID); const float* GATE = (const float*)(F.ws + WS_GATE);
    const float* nf = F.in[20];
    const int lane = F.lane;
    const int gw = F.wg * NWAVES + F.wave, NGW = F.G * NWAVES;
    for (int t = gw; t < T; t += NGW) {
        float x[16];
        { const GAS v4u* xp = (const GAS v4u*)(XN + (size_t)t * DM); unpack8(xp[lane], x); unpack8(xp[64 + lane], x + 8); }
        const int e_lo = EID[(size_t)t * 128 + lane], e_hi = EID[(size_t)t * 128 + 64 + lane];
        const float g_lo = GATE[(size_t)t * 128 + lane], g_hi = GATE[(size_t)t * 128 + 64 + lane];
        float acc[16];
#pragma unroll
        for (int k = 0; k < 16; ++k) acc[k] = 0.f;
        for (int jj = 0; jj < 128; jj += 4) {
            v4u ua[4], ub[4], va[4], vb[4]; float gt[4];
#pragma unroll
            for (int u = 0; u < 4; ++u) { const int j = jj + u;
                int e = (j < 64) ? __builtin_amdgcn_readlane(e_lo, j & 63) : __builtin_amdgcn_readlane(e_hi, j & 63);
                gt[u] = (j < 64) ? rdlane(g_lo, j & 63) : rdlane(g_hi, j & 63);
                e = e & (NEXP - 1);
                const GAS v4u* up = (const GAS v4u*)(UB + (size_t)e * DM); const GAS v4u* vp = (const GAS v4u*)(VB + (size_t)e * DM);
                ua[u] = up[lane]; ub[u] = up[64 + lane]; va[u] = vp[lane]; vb[u] = vp[64 + lane]; }
#pragma unroll
            for (int u = 0; u < 4; ++u) {
                float f[16]; unpack8(ua[u], f); unpack8(ub[u], f + 8);
                float d = 0.f;
#pragma unroll
                for (int k = 0; k < 16; ++k) d += x[k] * f[k];
                d = wave_sum(d);
                const float a = 0.5f * d * (1.f + erff(d * 0.70710678118654752f)) * gt[u];
                unpack8(va[u], f); unpack8(vb[u], f + 8);
#pragma unroll
                for (int k = 0; k < 16; ++k) acc[k] += a * f[k];
            }
        }
        float* hrow = F.out + (size_t)t * DM;
        f32x4 h0 = *(const GAS f32x4*)(hrow + lane * 8), h1 = *(const GAS f32x4*)(hrow + lane * 8 + 4), h2 = *(const GAS f32x4*)(hrow + 512 + lane * 8), h3 = *(const GAS f32x4*)(hrow + 512 + lane * 8 + 4);
        float hv[16];
#pragma unroll
        for (int k = 0; k < 4; ++k) { hv[k] = h0[k] + acc[k]; hv[4 + k] = h1[k] + acc[4 + k]; hv[8 + k] = h2[k] + acc[8 + k]; hv[12 + k] = h3[k] + acc[12 + k]; }
        float ss = 0.f;
#pragma unroll
        for (int k = 0; k < 16; ++k) ss += hv[k] * hv[k];
        const float rstd = 1.f / sqrtf(wave_sum(ss) * (1.f / DM) + RMS_EPS);
        const f32x4 n0 = *(const GAS f32x4*)(nf + lane * 8), n1 = *(const GAS f32x4*)(nf + lane * 8 + 4), n2 = *(const GAS f32x4*)(nf + 512 + lane * 8), n3 = *(const GAS f32x4*)(nf + 512 + lane * 8 + 4);
        f32x4 o0, o1, o2, o3;
#pragma unroll
        for (int k = 0; k < 4; ++k) { o0[k] = hv[k] * rstd * n0[k]; o1[k] = hv[4 + k] * rstd * n1[k]; o2[k] = hv[8 + k] * rstd * n2[k]; o3[k] = hv[12 + k] * rstd * n3[k]; }
        *(GAS f32x4*)(hrow + lane * 8) = o0; *(GAS f32x4*)(hrow + lane * 8 + 4) = o1; *(GAS f32x4*)(hrow + 512 + lane * 8) = o2; *(GAS f32x4*)(hrow + 512 + lane * 8 + 4) = o3;
    }
}

struct Args { const float* in[21]; float* out; unsigned char* ws; int ph_lo, ph_hi; };
static_assert(sizeof(Args) == 21 * 8 + 8 + 8 + 8, "Args has no padding");

__global__ void __launch_bounds__(NTHREADS, 2) fwd_kernel(Args args) {
    extern __shared__ __attribute__((aligned(16))) unsigned char lds[];
    Frame F;
    F.lds = (LAS unsigned char*)lds;
    F.MISC = (volatile LAS unsigned*)(F.lds + MISC_OFF);
    F.tid = threadIdx.x; F.lane = F.tid & 63; F.wave = __builtin_amdgcn_readfirstlane(F.tid >> 6);
    F.G = gridDim.x; F.wg = blockIdx.x;
#pragma unroll
    for (int i = 0; i < 21; ++i) F.in[i] = args.in[i];
    F.out = args.out; F.ws = args.ws;
    F.ctl = (gu32*)(args.ws + WS_CTL);
    for (int u = F.tid; u < (LDS_BYTES - LDSCTL_OFF) / 4; u += NTHREADS) ((LAS unsigned*)(F.lds + LDSCTL_OFF))[u] = 0u;
    __syncthreads();
    const int lo = args.ph_lo, hi = args.ph_hi;
    const bool fused = (hi - lo) > 1;
    XcdBarrier bar; bar.bar = (unsigned*)(F.ctl + CW_BAR); bar.x = 0; bar.st = nullptr;
    if (fused) bar = xcd_barrier_post((unsigned*)(F.ctl + CW_BAR), F.MISC + 8);
#define IN(k) (lo <= (k) && (k) < hi)
#define SEAM(k) do { if (IN(k) && IN((k) + 1)) xcd_barrier(bar); } while (0)

    if (IN(0)) { p0_prologue(F); SEAM(0); }
    if (IN(1)) {
        pg8::Gemm g{(const bf16*)(F.ws + WS_XN), (const bf16*)(F.ws + WS_WIN), T, IN_COLS, DM}; pg8::StaticOrder S; S.init(T, IN_COLS, F.G, F.wg);
        pg8::EpiBf16 E{(bf16*)(F.ws + WS_Z), IN_COLS};
        pg8::gemm_phase<pg8::EpiBf16, pg8::StaticOrder, true, true>(F.lds + RING_OFF, g, S, E);
        SEAM(1);
    }
    if (IN(2)) { p2_rope(F); for (int item = F.wg; item < NB * NHR * 128; item += F.G) rwkv_r1_item(F, item); SEAM(2); }
    if (IN(3)) { p3_mixers(F); SEAM(3); }
    if (IN(4)) { for (int item = F.wg; item < NB * NHR * 128; item += F.G) rwkv_r3_item(F, item); SEAM(4); }
    if (IN(5)) {
        pg8::Gemm g{(const bf16*)(F.ws + WS_YMIX), (const bf16*)(F.ws + WS_WOUT), T, DM, DM}; pg8::StaticOrder S; S.init(T, DM, F.G, F.wg);
        pg8::EpiF32Res E{F.in[0], F.out, DM};
        pg8::gemm_phase<pg8::EpiF32Res, pg8::StaticOrder, true, true>(F.lds + RING_OFF, g, S, E);
        SEAM(5);
    }
    if (IN(6)) { p5_xn2(F); SEAM(6); }
    if (IN(7)) {
        pg8::Gemm g{(const bf16*)(F.ws + WS_XN), (const bf16*)(F.ws + WS_WQ), T, PQ, DM}; pg8::StaticOrder S; S.init(T, PQ, F.G, F.wg);
        pg8::EpiBf16 E{(bf16*)(F.ws + WS_QP), PQ};
        pg8::gemm_phase<pg8::EpiBf16, pg8::StaticOrder, true, true>(F.lds + RING_OFF, g, S, E);
        SEAM(7);
    }
    if (IN(8)) { p7_topk(F); SEAM(8); }
    if (IN(9)) { p8_gather(F); }
#undef IN
#undef SEAM
}

extern "C" void kernel_launch(void* const* d_in, const int* in_sizes, int n_in, void* d_out, int out_size, void* d_ws, size_t ws_size, hipStream_t stream) {
    static int grid = 0;
    if (grid == 0) {
        if (n_in != 21 || in_sizes[0] != T * DM || out_size != T * DM || ws_size < WS_END) {
            fprintf(stderr, "kernel_launch: unexpected shapes: n_in %d in0 %d out %d ws %zu (need %zu); nothing launched\n", n_in, n_in > 0 ? in_sizes[0] : -1, out_size, ws_size, (size_t)WS_END); grid = -1; return; }
        int dev = 0, cus = 0, per_cu = 0;
        if (hipGetDevice(&dev) != hipSuccess || hipDeviceGetAttribute(&cus, hipDeviceAttributeMultiprocessorCount, dev) != hipSuccess) { grid = -1; return; }
        if (hipFuncSetAttribute((const void*)fwd_kernel, hipFuncAttributeMaxDynamicSharedMemorySize, LDS_BYTES) != hipSuccess) { fprintf(stderr, "kernel_launch: hipFuncSetAttribute failed\n"); grid = -1; return; }
        if (hipOccupancyMaxActiveBlocksPerMultiprocessor(&per_cu, (const void*)fwd_kernel, NTHREADS, LDS_BYTES) != hipSuccess || per_cu < 1) { fprintf(stderr, "kernel_launch: occupancy query says %d\n", per_cu); per_cu = 1; }
        (void)hipGetLastError();
        grid = cus;
    }
    if (grid < 0) return;
    (void)hipMemsetAsync((char*)d_ws + WS_CTL, 0, CTL_ZERO_BYTES, stream);
    Args a{};
    for (int i = 0; i < 21; ++i) a.in[i] = (const float*)d_in[i];
    a.out = (float*)d_out; a.ws = (unsigned char*)d_ws;
    if (MK_N_LAUNCHES == 1) {
        a.ph_lo = 0; a.ph_hi = NPHASE;
        void* kargs[] = {&a};
        hipError_t e = hipLaunchCooperativeKernel((const void*)fwd_kernel, dim3(grid), dim3(NTHREADS), kargs, LDS_BYTES, stream);
        if (e != hipSuccess) fprintf(stderr, "kernel_launch: cooperative launch failed: %s (grid %d)\n", hipGetErrorString(e), grid);
    } else {
        for (int p = 0; p < NPHASE; ++p) { a.ph_lo = p; a.ph_hi = p + 1;
            hipLaunchKernelGGL(fwd_kernel, dim3(grid), dim3(NTHREADS), LDS_BYTES, stream, a); }
    }
}
```

```cpp
#include <hip/hip_runtime.h>
#include <cstdio>
#include <cstdint>

#ifndef MK_N_LAUNCHES
#define MK_N_LAUNCHES 1
#endif

#define GAS __attribute__((address_space(1)))
#define LAS __attribute__((address_space(3)))
typedef unsigned short bf16;
typedef unsigned v4u __attribute__((ext_vector_type(4)));
typedef unsigned v2u __attribute__((ext_vector_type(2)));
typedef float f32x4 __attribute__((ext_vector_type(4)));
typedef float f32x2 __attribute__((ext_vector_type(2)));
typedef short bf16x8 __attribute__((ext_vector_type(8)));
typedef GAS unsigned gu32;
#define RLX_AGENT __ATOMIC_RELAXED, __HIP_MEMORY_SCOPE_AGENT
#define LDS_WAIT() asm volatile("s_waitcnt lgkmcnt(0)" ::: "memory")
#define VM_WAIT() asm volatile("s_waitcnt vmcnt(0)" ::: "memory")

constexpr int DM = 1024, NB = 4, SEQ = 8192, T = NB * SEQ;
constexpr int HD = 64, RWW = 512, NHR = 8, NHA = 8;
constexpr int IN_COLS = 3328;
constexpr int C_R = 0, C_K = 512, C_V = 1024, C_WD = 1536, C_AD = 1600, C_GD = 1664, C_AQ = 1792, C_AK = 2304, C_AV = 2816;
constexpr int PHEADS = 8, NKEYS = 128, PQ = 2048, TOPK = 16, NEXP = 16384;
constexpr float RMS_EPS = 1e-6f, GN_EPS = 64e-5f;
constexpr int NWAVES = 8, NTHREADS = 512;
constexpr int NPHASE = 10;

constexpr size_t MiB = 1u << 20;
constexpr size_t WS_CTL = 0, CTL_ZERO_BYTES = 1 * MiB;
constexpr size_t WS_WIN = 2 * MiB;
constexpr size_t WS_WOUT = 10 * MiB;
constexpr size_t WS_WQ = 12 * MiB;
constexpr size_t WS_XN = 16 * MiB;
constexpr size_t WS_Z = 80 * MiB;
constexpr size_t WS_QP = 80 * MiB;
constexpr size_t WS_G = 288 * MiB;
constexpr size_t WS_YMIX = 352 * MiB;
constexpr size_t WS_UQ = 416 * MiB;
constexpr size_t WS_VQ = 432 * MiB;
constexpr size_t WS_SU = 448 * MiB;
constexpr size_t WS_SV = 449 * MiB;
constexpr size_t WS_EID = 480 * MiB;
constexpr size_t WS_GATE = 496 * MiB;
constexpr size_t WS_END = 512 * MiB;
constexpr size_t WS_WUPT = 1 * MiB, WS_AUPT = WS_WUPT + 65536, WS_GUPT = WS_AUPT + 65536;
constexpr size_t WS_BONUS = 9 * MiB;
constexpr size_t WS_RWY0 = WS_XN;
constexpr size_t WS_RWSS = WS_G;
constexpr size_t WS_RWRH = WS_EID;

constexpr int CW_BAR = 4096;

__device__ __forceinline__ unsigned f2bf(float f) { unsigned u = __builtin_bit_cast(unsigned, f); return (u + 0x7fffu + ((u >> 16) & 1u)) >> 16; }
__device__ __forceinline__ unsigned pk2(float lo, float hi) { return f2bf(lo) | (f2bf(hi) << 16); }
__device__ __forceinline__ float bflo(unsigned u) { return __builtin_bit_cast(float, u << 16); }
__device__ __forceinline__ float bfhi(unsigned u) { return __builtin_bit_cast(float, u & 0xffff0000u); }
__device__ __forceinline__ float bf2f(bf16 h) { return __builtin_bit_cast(float, (unsigned)h << 16); }

template <int CTRL> __device__ __forceinline__ float dppf(float x) { return __builtin_bit_cast(float, __builtin_amdgcn_update_dpp(0, __builtin_bit_cast(int, x), CTRL, 0xF, 0xF, true)); }
template <int CTRL> __device__ __forceinline__ int dppi(int x) { return __builtin_amdgcn_update_dpp(0, x, CTRL, 0xF, 0xF, true); }
__device__ __forceinline__ float rdlane(float v, int l) { return __builtin_bit_cast(float, __builtin_amdgcn_readlane(__builtin_bit_cast(int, v), l)); }
__device__ __forceinline__ float sum8(float v) { v += dppf<0xB1>(v); v += dppf<0x4E>(v); v += dppf<0x141>(v); return v; }
__device__ __forceinline__ float sum16(float v) { v = sum8(v); v += dppf<0x140>(v); return v; }
__device__ __forceinline__ float wave_sum(float v) { v = sum16(v); return (rdlane(v, 0) + rdlane(v, 16)) + (rdlane(v, 32) + rdlane(v, 48)); }
__device__ __forceinline__ float wave_max(float v) {
    v = fmaxf(v, dppf<0xB1>(v)); v = fmaxf(v, dppf<0x4E>(v)); v = fmaxf(v, dppf<0x141>(v)); v = fmaxf(v, dppf<0x140>(v));
    return fmaxf(fmaxf(rdlane(v, 0), rdlane(v, 16)), fmaxf(rdlane(v, 32), rdlane(v, 48)));
}
__device__ __forceinline__ int wave_min_i(int v) {
    v = min(v, dppi<0xB1>(v)); v = min(v, dppi<0x4E>(v)); v = min(v, dppi<0x141>(v)); v = min(v, dppi<0x140>(v));
    return min(min(__builtin_amdgcn_readlane(v, 0), __builtin_amdgcn_readlane(v, 16)), min(__builtin_amdgcn_readlane(v, 32), __builtin_amdgcn_readlane(v, 48)));
}

namespace pg8 {
#define PG8_LAS __attribute__((address_space(3)))
typedef unsigned short bf16_t;
typedef unsigned u32x4 __attribute__((ext_vector_type(4)));
constexpr int BM = 256, BK = 64, HALF = 128, HTB = HALF * BK * 2, STAGE_BYTES = 8 * HTB, NXCD = 8, WGM = 8;
__host__ __device__ __forceinline__ int lds_byte(int r, int c) { const int st = (r >> 4) * 2 + (c >> 5), rr = r & 15, cc = c & 31, ob = rr * 64 + cc * 2; return st * 1024 + (ob ^ (((ob >> 9) & 1) << 5)); }
__host__ __device__ __forceinline__ void stage_rc(int b, int& R, int& C) { const int st = b / 1024, sb = b % 1024, swz = sb ^ (((sb >> 9) & 1) << 5); R = (st >> 1) * 16 + swz / 64; C = (st & 1) * 32 + (swz % 64) / 2; }
__host__ __device__ __forceinline__ int perm32(int rho) { const int n = rho >> 4, i = rho & 15; return 8 * (i >> 2) + 4 * n + (i & 3); }
struct Unit { int pm, pn; };
struct Gemm { const bf16_t* A; const bf16_t* Bt; int M, N, K; };
struct StaticOrder {
    int nM, nN, nwg, G, c;
    __host__ __device__ void init(int M, int N, int G_, int c_) { nM = M / BM; nN = N / BM; nwg = nM * nN; G = G_; c = c_; }
    __host__ __device__ bool next(int i, Unit& u) const {
        const long L = (long)i * G + c; if (L >= nwg) return false;
        int wgid = (int)L; { const int q = nwg / NXCD, r = nwg % NXCD, xcd = wgid % NXCD, off = wgid / NXCD; wgid = (xcd < r ? xcd * (q + 1) : r * (q + 1) + (xcd - r) * q) + off; }
        const int nig = WGM * nN, gid = wgid / nig, fm = gid * WGM, gsz = (nM - fm) < WGM ? (nM - fm) : WGM;
        u.pm = fm + ((wgid % nig) % gsz); u.pn = (wgid % nig) / gsz; return true;
    }
    __device__ __forceinline__ void a_ready(const Unit&) const {}
    __device__ __forceinline__ void done(const Unit&) const {}
};
__device__ __forceinline__ unsigned cvt_pk_bf16(float lo, float hi) { unsigned r; asm volatile("v_cvt_pk_bf16_f32 %0, %1, %2" : "=v"(r) : "v"(lo), "v"(hi)); return r; }
struct EpiBf16 {
    static constexpr bool PERM = true, AFTER_DRAIN = false;
    bf16_t* O; int ldc;
    __device__ __forceinline__ void operator()(const f32x4 (&acc)[2][2][4][2], const Unit& u, int wr, int wc, int fr, int fq) const {
        const int row0 = u.pm * BM + wr * 64 + fr; const int col0 = u.pn * BM + wc * 32 + 8 * fq;
#pragma unroll
        for (int ai = 0; ai < 2; ++ai)
#pragma unroll
            for (int m = 0; m < 4; ++m) { bf16_t* rowp = O + (size_t)(row0 + ai * HALF + m * 16) * ldc + col0;
#pragma unroll
                for (int bj = 0; bj < 2; ++bj) { const f32x4 v0 = acc[ai][bj][m][0], v1 = acc[ai][bj][m][1];
                    u32x4 w; w.x = cvt_pk_bf16(v0[0], v0[1]); w.y = cvt_pk_bf16(v0[2], v0[3]); w.z = cvt_pk_bf16(v1[0], v1[1]); w.w = cvt_pk_bf16(v1[2], v1[3]);
                    *(u32x4*)(rowp + bj * HALF) = w; } }
    }
};
struct EpiF32Res {
    static constexpr bool PERM = true, AFTER_DRAIN = false;
    const float* res; float* O; int ldc;
    __device__ __forceinline__ void operator()(const f32x4 (&acc)[2][2][4][2], const Unit& u, int wr, int wc, int fr, int fq) const {
        const int row0 = u.pm * BM + wr * 64 + fr; const int col0 = u.pn * BM + wc * 32 + 8 * fq;
#pragma unroll
        for (int ai = 0; ai < 2; ++ai)
#pragma unroll
            for (int m = 0; m < 4; ++m) { const size_t off = (size_t)(row0 + ai * HALF + m * 16) * ldc + col0;
#pragma unroll
                for (int bj = 0; bj < 2; ++bj) { const f32x4 r0 = *(const f32x4*)(res + off + bj * HALF), r1 = *(const f32x4*)(res + off + bj * HALF + 4);
                    *(f32x4*)(O + off + bj * HALF) = acc[ai][bj][m][0] + r0; *(f32x4*)(O + off + bj * HALF + 4) = acc[ai][bj][m][1] + r1; } }
    }
};

template <class Epi, class Sched, bool ALIGN_EPI = false, bool SP2 = false>
__device__ __forceinline__ void gemm_phase(PG8_LAS unsigned char* lds, const Gemm g, const Sched& S, const Epi& E) {
    const int tid = threadIdx.x, wid = __builtin_amdgcn_readfirstlane(tid >> 6), lane = tid & 63, wr = wid >> 2, wc = wid & 3, fr = lane & 15, fq = lane >> 4;
    const int K = g.K, nt = K / BK;
    unsigned voffA[2], voffB[2];
#pragma unroll
    for (int i = 0; i < 2; ++i) { int R, C; stage_rc(tid * 16 + i * 8192, R, C); const int Rb = Epi::PERM ? ((R & ~31) + perm32(R & 31)) : R;
        voffA[i] = (unsigned)(R * K + C) * 2u; voffB[i] = (unsigned)(Rb * K + C) * 2u; }
    const size_t kstep = (size_t)(BK * 2);
    const size_t hstep = (size_t)HALF * K * 2;
    const size_t tstep = 2 * hstep;
    const unsigned ldsw = (unsigned)wid * 1024u;
    const int aoff = lds_byte(wr * 64 + fr, fq * 8), boff = lds_byte(wc * 32 + fr, fq * 8);
#define PG8_SA(b, h) (((b) * 2 + (h)) * HTB)
#define PG8_SB(b, h) ((4 + (b) * 2 + (h)) * HTB)
#define PG8_STAGE(bufoff, gbase, voff) do { _Pragma("unroll") for (int _i = 0; _i < 2; ++_i) \
        __builtin_amdgcn_global_load_lds((const unsigned*)((const char*)(gbase) + (voff)[_i]), (PG8_LAS unsigned*)(lds + (bufoff) + ldsw + _i * 8192), 16, 0, 0); } while (0)
#define PG8_LDA(dst, b, h) do { _Pragma("unroll") for (int m = 0; m < 4; ++m) _Pragma("unroll") for (int k = 0; k < 2; ++k) dst[m][k] = *(const PG8_LAS bf16x8*)(lds + PG8_SA(b, h) + aoff + m * 2048 + k * 1024); } while (0)
#define PG8_LDB(dst, b, h) do { _Pragma("unroll") for (int n = 0; n < 2; ++n) _Pragma("unroll") for (int k = 0; k < 2; ++k) dst[n][k] = *(const PG8_LAS bf16x8*)(lds + PG8_SB(b, h) + boff + n * 2048 + k * 1024); } while (0)
#define PG8_MMA(ai, bj, At, Bt) do { __builtin_amdgcn_s_setprio(1); _Pragma("unroll") for (int m = 0; m < 4; ++m) _Pragma("unroll") for (int n = 0; n < 2; ++n) _Pragma("unroll") for (int k = 0; k < 2; ++k) \
        acc[ai][bj][m][n] = __builtin_amdgcn_mfma_f32_16x16x32_bf16(Bt[n][k], At[m][k], acc[ai][bj][m][n], 0, 0, 0); __builtin_amdgcn_s_setprio(0); } while (0)
#define PG8_WAIT_V(n) asm volatile("s_waitcnt vmcnt(" #n ")" ::: "memory")
#define PG8_WAIT_L(n) asm volatile("s_waitcnt lgkmcnt(" #n ")" ::: "memory")
#define PG8_BAR __builtin_amdgcn_s_barrier()
#define PG8_SCHED __builtin_amdgcn_sched_barrier(0)
    Unit cur, nxt; int ui = 0;
    if (!S.next(0, cur)) return;
    f32x4 acc[2][2][4][2];
#pragma unroll
    for (int a = 0; a < 2; ++a)
#pragma unroll
        for (int b = 0; b < 2; ++b)
#pragma unroll
            for (int m = 0; m < 4; ++m)
#pragma unroll
                for (int n = 0; n < 2; ++n) acc[a][b][m][n] = (f32x4){0.f, 0.f, 0.f, 0.f};
    bf16x8 At[4][2], B0[2][2], B1[2][2];
    const char* cA = (const char*)g.A + (size_t)cur.pm * tstep; const char* cB = (const char*)g.Bt + (size_t)cur.pn * tstep;
    S.a_ready(cur);
    if constexpr (SP2) {
        PG8_STAGE(PG8_SB(0, 0), cB, voffB); PG8_STAGE(PG8_SB(0, 1), cB + hstep, voffB); PG8_STAGE(PG8_SA(0, 0), cA, voffA); PG8_STAGE(PG8_SA(0, 1), cA + hstep, voffA);
        if (wr == 1) PG8_BAR;
        PG8_WAIT_V(2); PG8_BAR;
        PG8_STAGE(PG8_SB(1, 0), cB + kstep, voffB); PG8_STAGE(PG8_SA(1, 0), cA + kstep, voffA); PG8_STAGE(PG8_SB(1, 1), cB + hstep + kstep, voffB);
        PG8_WAIT_V(6); PG8_BAR;
    } else {
        PG8_STAGE(PG8_SB(0, 0), cB, voffB); PG8_STAGE(PG8_SA(0, 0), cA, voffA); PG8_STAGE(PG8_SB(0, 1), cB + hstep, voffB); PG8_STAGE(PG8_SA(0, 1), cA + hstep, voffA);
        if (wr == 1) PG8_BAR;
        PG8_WAIT_V(4); PG8_BAR;
        PG8_STAGE(PG8_SB(1, 0), cB + kstep, voffB); PG8_STAGE(PG8_SA(1, 0), cA + kstep, voffA); PG8_STAGE(PG8_SB(1, 1), cB + hstep + kstep, voffB);
        PG8_WAIT_V(6); PG8_BAR;
    }
    for (;;) {
        const bool has_next = S.next(ui + 1, nxt);
        const char* nA = has_next ? (const char*)g.A + (size_t)nxt.pm * tstep : cA; const char* nB = has_next ? (const char*)g.Bt + (size_t)nxt.pn * tstep : cB;
        for (int t = 0; t < nt; t += 2) {
            const bool last = (t == nt - 2);
            const char* a1 = cA + (size_t)(t + 1) * kstep;
            const char* a2 = last ? nA : cA + (size_t)(t + 2) * kstep; const char* b2 = last ? nB : cB + (size_t)(t + 2) * kstep;
            const char* a3 = a2 + kstep; const char* b3 = b2 + kstep;
            if (last && has_next) S.a_ready(nxt);
            if constexpr (SP2) {
            PG8_LDB(B0, 0, 0); PG8_LDB(B1, 0, 1); PG8_SCHED; PG8_LDA(At, 0, 0); PG8_STAGE(PG8_SA(1, 1), a1 + hstep, voffA);
            PG8_WAIT_V(8); PG8_WAIT_L(0); PG8_BAR; PG8_MMA(0, 0, At, B0); PG8_MMA(0, 1, At, B1); PG8_BAR; PG8_SCHED;
            PG8_LDA(At, 0, 1); PG8_STAGE(PG8_SB(0, 0), b2, voffB); PG8_STAGE(PG8_SB(0, 1), b2 + hstep, voffB); PG8_STAGE(PG8_SA(0, 0), a2, voffA);
            PG8_WAIT_V(8); PG8_WAIT_L(0); PG8_BAR; PG8_MMA(1, 0, At, B0); PG8_MMA(1, 1, At, B1); PG8_BAR; PG8_SCHED;
            PG8_LDB(B0, 1, 0); PG8_LDB(B1, 1, 1); PG8_SCHED; PG8_LDA(At, 1, 0); PG8_STAGE(PG8_SA(0, 1), a2 + hstep, voffA);
            PG8_WAIT_V(8); PG8_WAIT_L(0); PG8_BAR; PG8_MMA(0, 0, At, B0); PG8_MMA(0, 1, At, B1); PG8_BAR; PG8_SCHED;
            PG8_LDA(At, 1, 1); PG8_STAGE(PG8_SB(1, 0), b3, voffB); PG8_STAGE(PG8_SB(1, 1), b3 + hstep, voffB); PG8_STAGE(PG8_SA(1, 0), a3, voffA);
            PG8_WAIT_V(8); PG8_WAIT_L(0); PG8_BAR; PG8_MMA(1, 0, At, B0); PG8_MMA(1, 1, At, B1); PG8_BAR; PG8_SCHED;
            } else {
            PG8_LDB(B0, 0, 0); PG8_SCHED; PG8_LDA(At, 0, 0); PG8_STAGE(PG8_SA(1, 1), a1 + hstep, voffA);
            PG8_WAIT_L(8); PG8_BAR; PG8_WAIT_L(0); PG8_MMA(0, 0, At, B0); PG8_BAR; PG8_SCHED;
            PG8_LDB(B1, 0, 1); PG8_STAGE(PG8_SB(0, 0), b2, voffB);
            PG8_BAR; PG8_WAIT_L(0); PG8_MMA(0, 1, At, B1); PG8_BAR;
            PG8_LDA(At, 0, 1); PG8_STAGE(PG8_SA(0, 0), a2, voffA);
            PG8_BAR; PG8_WAIT_L(0); PG8_MMA(1, 0, At, B0); PG8_BAR; PG8_SCHED;
            PG8_STAGE(PG8_SB(0, 1), b2 + hstep, voffB);
            PG8_WAIT_V(6); PG8_BAR; PG8_MMA(1, 1, At, B1); PG8_BAR;
            PG8_LDB(B0, 1, 0); PG8_SCHED; PG8_LDA(At, 1, 0); PG8_STAGE(PG8_SA(0, 1), a2 + hstep, voffA);
            PG8_WAIT_L(8); PG8_BAR; PG8_WAIT_L(0); PG8_MMA(0, 0, At, B0); PG8_BAR; PG8_SCHED;
            PG8_LDB(B1, 1, 1); PG8_STAGE(PG8_SB(1, 0), b3, voffB);
            PG8_BAR; PG8_WAIT_L(0); PG8_MMA(0, 1, At, B1); PG8_BAR;
            PG8_LDA(At, 1, 1); PG8_STAGE(PG8_SA(1, 0), a3, voffA);
            PG8_BAR; PG8_WAIT_L(0); PG8_MMA(1, 0, At, B0); PG8_BAR; PG8_SCHED;
            PG8_STAGE(PG8_SB(1, 1), b3 + hstep, voffB);
            PG8_WAIT_V(6); PG8_BAR; PG8_MMA(1, 1, At, B1); PG8_BAR;
            }
        }
        if constexpr (ALIGN_EPI) { if (wr == 0) PG8_BAR; }
        if constexpr (!Epi::AFTER_DRAIN) { E(acc, cur, wr, wc, fr, fq); S.done(cur); }
        if (!has_next) break;
#pragma unroll
        for (int a = 0; a < 2; ++a)
#pragma unroll
            for (int b = 0; b < 2; ++b)
#pragma unroll
                for (int m = 0; m < 4; ++m)
#pragma unroll
                    for (int n = 0; n < 2; ++n) acc[a][b][m][n] = (f32x4){0.f, 0.f, 0.f, 0.f};
        cur = nxt; cA = nA; cB = nB; ++ui;
        if constexpr (ALIGN_EPI) { if (wr == 1) PG8_BAR; }
    }
    PG8_WAIT_V(0);
    if constexpr (!ALIGN_EPI) { if (wr == 0) PG8_BAR; }
    PG8_BAR;
#undef PG8_SA
#undef PG8_SB
#undef PG8_STAGE
#undef PG8_LDA
#undef PG8_LDB
#undef PG8_MMA
#undef PG8_WAIT_V
#undef PG8_WAIT_L
#undef PG8_BAR
#undef PG8_SCHED
}
}

#define XB_TMO      128
#define XB_XCNT(j)  (256  + 64 * (j))
#define XB_XSUB(j)  (1280 + 64 * (j))
#define XB_XGEN(j)  (2304 + 64 * (j))
#define XB_TOP      3328
#define XB_TOPGEN   3392
#define XCD_BAR_WORDS 3456
#define XB_SPIN_CAP (1u << 22)
__device__ __forceinline__ unsigned xb_ld(unsigned* p)              { return __hip_atomic_load(p, __ATOMIC_RELAXED, __HIP_MEMORY_SCOPE_AGENT); }
__device__ __forceinline__ unsigned xb_add(unsigned* p, unsigned v) { return __hip_atomic_fetch_add(p, v, __ATOMIC_RELAXED, __HIP_MEMORY_SCOPE_AGENT); }
__device__ __forceinline__ unsigned xb_xcc_id() { return (unsigned)__builtin_amdgcn_s_getreg((3 << 11) | 20) & 0xFu; }
#define XB_SPIN(cond, bar) do { unsigned _sp = 0; while (cond) { __builtin_amdgcn_s_sleep(1); \
    if ((++_sp & 255u) == 0u) { if (xb_ld(&(bar)[XB_TMO])) break; if (_sp > XB_SPIN_CAP) { atomicAdd(&(bar)[XB_TMO], 1u); break; } } } } while (0)
struct XcdBarrier { unsigned* bar; unsigned x; volatile LAS unsigned* st; };
__device__ __forceinline__ XcdBarrier xcd_barrier_post(unsigned* bar, volatile LAS unsigned* st) {
    XcdBarrier b; b.bar = bar; b.x = xb_xcc_id(); b.st = st;
    if (threadIdx.x == 0) (void)xb_add(&bar[XB_XCNT(b.x)], 1u);
    return b;
}
__device__ __forceinline__ void xcd_barrier_complete(unsigned* bar, unsigned x, unsigned& nloc, unsigned& nx) {
    const unsigned G = gridDim.x * gridDim.y * gridDim.z;
    unsigned sum, cnt, mine, sp = 0u;
    for (;;) {
        sum = 0u; cnt = 0u; mine = 0u;
#pragma unroll
        for (unsigned j = 0; j < 16; ++j) { const unsigned c = xb_ld(&bar[XB_XCNT(j)]); sum += c; cnt += (c > 0u) ? 1u : 0u; mine = (j == x) ? c : mine; }
        if (sum == G) break;
        __builtin_amdgcn_s_sleep(1);
        if ((++sp & 255u) == 0u) { if (xb_ld(&bar[XB_TMO])) break; if (sp > XB_SPIN_CAP) { atomicAdd(&bar[XB_TMO], 1u); break; } }
    }
    nloc = mine > 0u ? mine : 1u; nx = cnt > 0u ? cnt : 1u;
}
__device__ __forceinline__ void xcd_barrier(const XcdBarrier& b) {
    asm volatile("s_waitcnt vmcnt(0)" ::: "memory");
    __syncthreads();
    if (threadIdx.x == 0) {
        unsigned* bar = b.bar;
        __builtin_amdgcn_s_waitcnt(0);
        unsigned nloc = b.st[0], nx = b.st[1];
        if (nloc == 0u) { xcd_barrier_complete(bar, b.x, nloc, nx); b.st[0] = nloc; b.st[1] = nx; }
        const unsigned old = xb_add(&bar[XB_XSUB(b.x)], 1u);
        const unsigned gen = old / nloc;
        if (old + 1u == (gen + 1u) * nloc) {
            __builtin_amdgcn_fence(__ATOMIC_RELEASE, "agent");
            asm volatile("s_waitcnt vmcnt(0)" ::: "memory");
            const unsigned og = xb_add(&bar[XB_TOP], 1u);
            const unsigned tg = og / nx;
            if (og + 1u == (tg + 1u) * nx) xb_add(&bar[XB_TOPGEN], 1u);
            else XB_SPIN(xb_ld(&bar[XB_TOPGEN]) == tg, bar);
            __builtin_amdgcn_fence(__ATOMIC_ACQUIRE, "agent");
            xb_add(&bar[XB_XGEN(b.x)], 1u);
            asm volatile("s_waitcnt vmcnt(0)" ::: "memory");
        } else {
            XB_SPIN(xb_ld(&bar[XB_XGEN(b.x)]) == gen, bar);
            __builtin_amdgcn_fence(__ATOMIC_ACQUIRE, "agent");
            asm volatile("s_waitcnt vmcnt(0)" ::: "memory");
        }
    }
    __syncthreads();
}

constexpr int RING_OFF = 0, RING_BYTES = 131072;
constexpr int LDSCTL_OFF = 162816, MISC_OFF = LDSCTL_OFF + 320;
constexpr int LDS_BYTES = 163840;

struct Frame {
    LAS unsigned char* lds;
    volatile LAS unsigned* MISC;
    gu32* ctl;
    int tid, lane, wave, G, wg;
    const float* in[21];
    float* out;
    unsigned char* ws;
};

__device__ __forceinline__ void p0_transpose_item(const float* W, int K, int N, bf16* WT, LAS float* scr, int item, int lane) {
    const int nblk = N / 32, kb = item / nblk, nb = item % nblk, k0 = 64 * kb, n0 = 32 * nb;
#pragma unroll 8
    for (int i = 0; i < 32; ++i) { const int kk = 2 * i + (lane >> 5); scr[kk * 33 + (lane & 31)] = W[(size_t)(k0 + kk) * N + n0 + (lane & 31)]; }
    LDS_WAIT(); asm volatile("" ::: "memory");
    const int c = lane & 7;
#pragma unroll
    for (int j = 0; j < 4; ++j) { const int n = (lane >> 3) + 8 * j; const LAS float* s = scr + (8 * c) * 33 + n;
        v4u o; o.x = pk2(s[0 * 33], s[1 * 33]); o.y = pk2(s[2 * 33], s[3 * 33]); o.z = pk2(s[4 * 33], s[5 * 33]); o.w = pk2(s[6 * 33], s[7 * 33]);
        *(GAS v4u*)(WT + (size_t)(n0 + n) * K + k0 + 8 * c) = o; }
    LDS_WAIT(); asm volatile("" ::: "memory");
}
__device__ __forceinline__ void rms_row_to_bf16(int lane, const float* xrow, const float* gain, bf16* orow) {
    const GAS f32x4* xr = (const GAS f32x4*)xrow + lane;
    const GAS f32x4* gr = (const GAS f32x4*)gain + lane;
    f32x4 v[4]; float s = 0.f;
#pragma unroll
    for (int j = 0; j < 4; ++j) { v[j] = xr[64 * j]; s += (v[j].x * v[j].x + v[j].y * v[j].y) + (v[j].z * v[j].z + v[j].w * v[j].w); }
    const float rstd = 1.f / sqrtf(wave_sum(s) * (1.f / DM) + RMS_EPS);
    GAS unsigned long long* o8 = (GAS unsigned long long*)orow + lane;
#pragma unroll
    for (int j = 0; j < 4; ++j) { const f32x4 gg = gr[64 * j];
        o8[64 * j] = (unsigned long long)pk2(v[j].x * rstd * gg.x, v[j].y * rstd * gg.y) | ((unsigned long long)pk2(v[j].z * rstd * gg.z, v[j].w * rstd * gg.w) << 32); }
}
__device__ __forceinline__ void cvt_row_to_bf16(int lane, const float* xrow, bf16* orow) {
    const GAS f32x4* xr = (const GAS f32x4*)xrow + lane;
    GAS unsigned long long* o8 = (GAS unsigned long long*)orow + lane;
#pragma unroll
    for (int j = 0; j < 4; ++j) { const f32x4 v = xr[64 * j]; o8[64 * j] = (unsigned long long)pk2(v.x, v.y) | ((unsigned long long)pk2(v.z, v.w) << 32); }
}
__device__ __forceinline__ void p0_prologue(Frame& F) {
    LAS float* scr = (LAS float*)(F.lds + RING_OFF + F.wave * 16384);
    const int gw = F.wg * NWAVES + F.wave, NGW = F.G * NWAVES;
    constexpr int I_IN = (DM / 64) * (IN_COLS / 32), I_OUT = (DM / 64) * (DM / 32), I_Q = (DM / 64) * (PQ / 32);
    constexpr int NITEMS = I_IN + I_OUT + I_Q;
    bf16* win_t = (bf16*)(F.ws + WS_WIN); bf16* wout_t = (bf16*)(F.ws + WS_WOUT); bf16* wq_t = (bf16*)(F.ws + WS_WQ);
    for (int it = gw; it < NITEMS; it += NGW) {
        int r = it;
        if (r < I_IN) { p0_transpose_item(F.in[2], DM, IN_COLS, win_t, scr, r, F.lane); continue; } r -= I_IN;
        if (r < I_OUT) { p0_transpose_item(F.in[14], DM, DM, wout_t, scr, r, F.lane); continue; } r -= I_OUT;
        p0_transpose_item(F.in[16], DM, PQ, wq_t, scr, r, F.lane);
    }
    {
        constexpr int I_W = (64 / 64) * (RWW / 32), I_G = (128 / 64) * (RWW / 32);
        for (int it = gw; it < 2 * I_W + I_G; it += NGW) {
            int r = it;
            if (r < I_W) { p0_transpose_item(F.in[5], 64, RWW, (bf16*)(F.ws + WS_WUPT), scr, r, F.lane); continue; } r -= I_W;
            if (r < I_W) { p0_transpose_item(F.in[7], 64, RWW, (bf16*)(F.ws + WS_AUPT), scr, r, F.lane); continue; } r -= I_W;
            p0_transpose_item(F.in[8], 128, RWW, (bf16*)(F.ws + WS_GUPT), scr, r, F.lane);
        }
    }
    bf16* XN = (bf16*)(F.ws + WS_XN);
    for (int m = gw; m < T; m += NGW) rms_row_to_bf16(F.lane, F.in[0] + (size_t)m * DM, F.in[1], XN + (size_t)m * DM);
    for (int m = gw; m < 2 * NEXP; m += NGW) {
        const int tab = m >= NEXP, row = tab ? m - NEXP : m;
        const GAS f32x4* xr = (const GAS f32x4*)(F.in[18 + tab] + (size_t)row * DM) + F.lane * 4;
        f32x4 v[4]; float am = 0.f;
#pragma unroll
        for (int j = 0; j < 4; ++j) { v[j] = xr[j]; am = fmaxf(am, fmaxf(fmaxf(fabsf(v[j].x), fabsf(v[j].y)), fmaxf(fabsf(v[j].z), fabsf(v[j].w)))); }
        am = wave_max(am);
        const float sc = am > 0.f ? am * (1.f / 127.f) : 1.f, inv = am > 0.f ? 127.f / am : 0.f;
        v4u o;
#pragma unroll
        for (int j = 0; j < 4; ++j) {
            const int bias = tab ? 128 : 0;
            const unsigned b0 = (unsigned)((int)rintf(v[j].x * inv) + bias) & 255u, b1 = (unsigned)((int)rintf(v[j].y * inv) + bias) & 255u,
                           b2 = (unsigned)((int)rintf(v[j].z * inv) + bias) & 255u, b3 = (unsigned)((int)rintf(v[j].w * inv) + bias) & 255u;
            o[j] = b0 | (b1 << 8) | (b2 << 16) | (b3 << 24); }
        *(GAS v4u*)(F.ws + (tab ? WS_VQ : WS_UQ) + (size_t)row * DM + F.lane * 16) = o;
        if (F.lane == 0) ((float*)(F.ws + (tab ? WS_SV : WS_SU)))[row] = sc;
    }
}

__device__ __forceinline__ void p2_rope(Frame& F) {
    bf16* Z = (bf16*)(F.ws + WS_Z);
    const int tid = F.tid, i = tid & 31, grp = tid >> 5;
    const float inv_freq = powf(10000.0f, -(float)(2 * i) / 64.0f);
    for (int blk = F.wg; blk < T / 16; blk += F.G) {
        for (int k = 0; k < 16; ++k) { const int g = blk * 16 + k, s = g & (SEQ - 1);
            const float ang = (float)s * inv_freq;
            const double r = (double)ang - rint((double)ang * 0.15915494309189535) * 6.283185307179586;
            const float rf = (float)r; const float cs = cosf(rf), sn = sinf(rf);
            bf16* p = Z + (size_t)g * IN_COLS + C_AQ + grp * 64 + i;
            const float x1 = bf2f(p[0]), x2 = bf2f(p[32]);
            p[0] = (bf16)f2bf(x1 * cs - x2 * sn); p[32] = (bf16)f2bf(x1 * sn + x2 * cs); }
    }
}

typedef float f32x16 __attribute__((ext_vector_type(16)));
constexpr int SBS = 144;
constexpr int R1_EPRE = 0, R1_APRE = 16384, R1_AAB = 0, R1_X = 16384;
constexpr int R1_AT = 32768, R1_BT = 41984, R1_KT = 51200, R1_RT = 60416, R1_AHT = R1_BT, R1_U0T = R1_KT;
constexpr int R1_BBT = 69632, R1_KBT = 78848, R1_VT = 88064;
constexpr int R1_ACTW = 97280, R1_ACTA = 106496, R1_AAK = 97280, R1_ARB = 106496, R1_ARK = 115712;
constexpr int R1_BONUS = 124928, R1_WEND = 125184, R1_SEGS = 125440, R1_TII = 125440, R1_END = 129536;
static_assert(R1_END <= LDSCTL_OFF, "R1 LDS");
__device__ __forceinline__ int crow(int r, int hh) { return (r & 3) + 8 * (r >> 2) + 4 * hh; }
template <int KS> __device__ __forceinline__ f32x16 wtile(const LAS unsigned char* A, int sa, const LAS unsigned char* B, int sb, f32x16 acc, int lane) {
    const int row = lane & 31, hh = lane >> 5;
#pragma unroll
    for (int s = 0; s < KS; ++s) { const bf16x8 a = *(const LAS bf16x8*)(A + row * sa + 32 * s + 16 * hh); const bf16x8 b = *(const LAS bf16x8*)(B + row * sb + 32 * s + 16 * hh);
        acc = __builtin_amdgcn_mfma_f32_32x32x16_bf16(a, b, acc, 0, 0, 0); }
    return acc;
}
template <int KS> __device__ __forceinline__ f32x16 wtile_gb(const LAS unsigned char* A, int sa, const bf16* Bg, int ldb, f32x16 acc, int lane) {
    const int row = lane & 31, hh = lane >> 5;
#pragma unroll
    for (int s = 0; s < KS; ++s) { const bf16x8 a = *(const LAS bf16x8*)(A + row * sa + 32 * s + 16 * hh); const bf16x8 b = *(const GAS bf16x8*)(Bg + (size_t)row * ldb + 16 * s + 8 * hh);
        acc = __builtin_amdgcn_mfma_f32_32x32x16_bf16(a, b, acc, 0, 0, 0); }
    return acc;
}
__device__ __forceinline__ f32x16 zero16() { f32x16 z;
#pragma unroll
    for (int r = 0; r < 16; ++r) z[r] = 0.f;
    return z; }

__device__ __forceinline__ void rwkv_r1_item(Frame& F, int item) {
    const int chain = item >> 7, chunk = item & 127, b = chain >> 3, h = chain & 7;
    const int g0 = b * SEQ + chunk * 64;
    int tid_ = F.tid; asm volatile("" : "+v"(tid_));
    const int tid = tid_, lane = tid & 63, w = __builtin_amdgcn_readfirstlane(tid >> 6), hh = lane >> 5, cl = lane & 31;
    const bf16* Z = (const bf16*)(F.ws + WS_Z);
    LAS unsigned char* lds = F.lds + RING_OFF;
    const float* mu = F.in[3];
    {
        const int t = tid >> 3, cg = tid & 7; const bool first = (chunk == 0 && t == 0);
        const bf16* zr = Z + (size_t)(g0 + t) * IN_COLS;
        const v4u cw = *(const GAS v4u*)(zr + C_WD + cg * 8), ca = *(const GAS v4u*)(zr + C_AD + cg * 8);
        v4u pw = (v4u){0u, 0u, 0u, 0u}, pa = (v4u){0u, 0u, 0u, 0u};
        if (!first) { pw = *(const GAS v4u*)(zr - IN_COLS + C_WD + cg * 8); pa = *(const GAS v4u*)(zr - IN_COLS + C_AD + cg * 8); }
        float fw[8], fa[8], qw[8], qa[8];
        fw[0] = bflo(cw.x); fw[1] = bfhi(cw.x); fw[2] = bflo(cw.y); fw[3] = bfhi(cw.y); fw[4] = bflo(cw.z); fw[5] = bfhi(cw.z); fw[6] = bflo(cw.w); fw[7] = bfhi(cw.w);
        fa[0] = bflo(ca.x); fa[1] = bfhi(ca.x); fa[2] = bflo(ca.y); fa[3] = bfhi(ca.y); fa[4] = bflo(ca.z); fa[5] = bfhi(ca.z); fa[6] = bflo(ca.w); fa[7] = bfhi(ca.w);
        qw[0] = bflo(pw.x); qw[1] = bfhi(pw.x); qw[2] = bflo(pw.y); qw[3] = bfhi(pw.y); qw[4] = bflo(pw.z); qw[5] = bfhi(pw.z); qw[6] = bflo(pw.w); qw[7] = bfhi(pw.w);
        qa[0] = bflo(pa.x); qa[1] = bfhi(pa.x); qa[2] = bflo(pa.y); qa[3] = bfhi(pa.y); qa[4] = bflo(pa.z); qa[5] = bfhi(pa.z); qa[6] = bflo(pa.w); qa[7] = bfhi(pa.w);
#pragma unroll
        for (int j = 0; j < 8; ++j) { const int c = cg * 8 + j; fw[j] = tanhf(fw[j] + (qw[j] - fw[j]) * mu[C_WD + c]); fa[j] = fa[j] + (qa[j] - fa[j]) * mu[C_AD + c]; }
        v4u ow, oa; ow.x = pk2(fw[0], fw[1]); ow.y = pk2(fw[2], fw[3]); ow.z = pk2(fw[4], fw[5]); ow.w = pk2(fw[6], fw[7]);
        oa.x = pk2(fa[0], fa[1]); oa.y = pk2(fa[2], fa[3]); oa.z = pk2(fa[4], fa[5]); oa.w = pk2(fa[6], fa[7]);
        *(LAS v4u*)(lds + R1_ACTW + t * SBS + cg * 16) = ow; *(LAS v4u*)(lds + R1_ACTA + t * SBS + cg * 16) = oa;
    }
    __syncthreads();
    {
        const int p = w >> 2, mt = (w >> 1) & 1, nt = w & 1;
        const bf16* upt = (const bf16*)(F.ws + (p == 0 ? WS_WUPT : WS_AUPT)) + (size_t)(h * 64 + nt * 32) * 64;
        const f32x16 acc = wtile_gb<4>(lds + (p == 0 ? R1_ACTW : R1_ACTA) + mt * 32 * SBS, SBS, upt, 64, zero16(), lane);
        LAS float* O = (LAS float*)(lds + (p == 0 ? R1_EPRE : R1_APRE));
#pragma unroll
        for (int r = 0; r < 16; ++r) O[(mt * 32 + crow(r, hh)) * 64 + nt * 32 + cl] = acc[r];
    }
    __syncthreads();
    {
        const int c = tid & 63, ts = tid >> 6, col = h * 64 + c;
        const float mu_r = mu[C_R + col], mu_k = mu[C_K + col], mu_v = mu[C_V + col], kkc = F.in[9][col], kac = F.in[10][col], rkc = F.in[11][col], w0c = F.in[4][col], a0c = F.in[6][col];
        const LAS float* EP = (const LAS float*)(lds + R1_EPRE); const LAS float* AP = (const LAS float*)(lds + R1_APRE);
        LAS float* SEGS = (LAS float*)(lds + R1_SEGS); LAS float* BON = (LAS float*)(lds + R1_BONUS);
        const bf16* zb = Z + (size_t)(g0 + 8 * ts) * IN_COLS + col;
        float pr = 0.f, pk = 0.f, pv = 0.f;
        if (!(chunk == 0 && ts == 0)) { pr = bf2f(zb[C_R - IN_COLS]); pk = bf2f(zb[C_K - IN_COLS]); pv = bf2f(zb[C_V - IN_COLS]); }
        float rr[8], k2[8], ai[8], bi[8], vv[8], ee[8], cs[8]; float run = 0.f;
#pragma unroll
        for (int i = 0; i < 8; ++i) {
            const float zr = bf2f(zb[(size_t)i * IN_COLS + C_R]), zk = bf2f(zb[(size_t)i * IN_COLS + C_K]), zv = bf2f(zb[(size_t)i * IN_COLS + C_V]);
            const float r = zr + (pr - zr) * mu_r, k = zk + (pk - zk) * mu_k, v = zv + (pv - zv) * mu_v; pr = zr; pk = zk; pv = zv;
            const float e = 0.60653066f / (1.f + __expf(-(w0c + EP[(8 * ts + i) * 64 + c])));
            const float a = 1.f / (1.f + __expf(-(a0c + AP[(8 * ts + i) * 64 + c])));
            float kk = k * kkc; const float n2 = wave_sum(kk * kk); kk = kk / fmaxf(sqrtf(n2), 1e-12f);
            const float kq = k * (1.f + (a - 1.f) * kac);
            const float bon = wave_sum(r * kq * rkc); if (c == 0) BON[8 * ts + i] = bon;
            rr[i] = r; k2[i] = kq; ai[i] = -kk; bi[i] = kk * a; vv[i] = v; ee[i] = e; run += e; cs[i] = run;
        }
        SEGS[ts * 64 + c] = run;
        __syncthreads();
        float off = 0.f, tot = 0.f;
#pragma unroll
        for (int q = 0; q < 8; ++q) { const float sv = SEGS[q * 64 + c]; tot += sv; off += (q < ts) ? sv : 0.f; }
        float bb[8], kb[8];
#pragma unroll
        for (int i = 0; i < 8; ++i) { const float L = off + cs[i];
            const float Wm = __expf(-(L - ee[i])), Wi = __expf(-L), iW = __expf(L), We = __expf(-(tot - L));
            const int t = 8 * ts + i;
            *(LAS bf16*)(lds + R1_AT + t * SBS + c * 2) = (bf16)f2bf(ai[i] * Wm);
            *(LAS bf16*)(lds + R1_BT + t * SBS + c * 2) = (bf16)f2bf(bi[i] * iW);
            *(LAS bf16*)(lds + R1_KT + t * SBS + c * 2) = (bf16)f2bf(k2[i] * iW);
            *(LAS bf16*)(lds + R1_RT + t * SBS + c * 2) = (bf16)f2bf(rr[i] * Wi);
            bb[i] = bi[i] * We; kb[i] = k2[i] * We; }
        v4u o; o.x = pk2(bb[0], bb[1]); o.y = pk2(bb[2], bb[3]); o.z = pk2(bb[4], bb[5]); o.w = pk2(bb[6], bb[7]);
        *(LAS v4u*)(lds + R1_BBT + c * SBS + ts * 16) = o;
        o.x = pk2(kb[0], kb[1]); o.y = pk2(kb[2], kb[3]); o.z = pk2(kb[4], kb[5]); o.w = pk2(kb[6], kb[7]);
        *(LAS v4u*)(lds + R1_KBT + c * SBS + ts * 16) = o;
        o.x = pk2(vv[0], vv[1]); o.y = pk2(vv[2], vv[3]); o.z = pk2(vv[4], vv[5]); o.w = pk2(vv[6], vv[7]);
        *(LAS v4u*)(lds + R1_VT + c * SBS + ts * 16) = o;
        if (ts == 0) ((LAS float*)(lds + R1_WEND))[c] = __expf(-tot);
    }
    __syncthreads();
#pragma unroll
    for (int u = 0; u < 2; ++u) {
        const int idx = w * 2 + u, p = idx >> 2, mt = (idx >> 1) & 1, nt = idx & 1;
        const LAS unsigned char* Aop = lds + ((p == 0 || p == 2) ? R1_BT : R1_KT) + mt * 32 * SBS;
        const LAS unsigned char* Bop = lds + (p < 2 ? R1_AT : R1_RT) + nt * 32 * SBS;
        f32x16 acc = wtile<4>(Aop, SBS, Bop, SBS, zero16(), lane);
        const int n = nt * 32 + cl;
#pragma unroll
        for (int r = 0; r < 16; ++r) { const int m = mt * 32 + crow(r, hh); const bool keep = (p < 2) ? (m < n) : (m <= n); acc[r] = keep ? acc[r] : 0.f; }
#pragma unroll
        for (int g4 = 0; g4 < 4; ++g4) { const int m0 = mt * 32 + 8 * g4 + 4 * hh;
            if (p == 0) *(LAS f32x4*)(lds + R1_AAB + (n * 64 + m0) * 4) = (f32x4){acc[4 * g4], acc[4 * g4 + 1], acc[4 * g4 + 2], acc[4 * g4 + 3]};
            else { v2u o; o.x = pk2(acc[4 * g4], acc[4 * g4 + 1]); o.y = pk2(acc[4 * g4 + 2], acc[4 * g4 + 3]);
                   *(LAS v2u*)(lds + (p == 1 ? R1_AAK : (p == 2 ? R1_ARB : R1_ARK)) + n * SBS + m0 * 2) = o; } }
    }
    __syncthreads();
    if (w < 4) {
        const int mt = w >> 1, nt = w & 1;
        const f32x16 acc = wtile<4>(lds + R1_AAK + mt * 32 * SBS, SBS, lds + R1_VT + nt * 32 * SBS, SBS, zero16(), lane);
        LAS float* X = (LAS float*)(lds + R1_X);
#pragma unroll
        for (int r = 0; r < 16; ++r) X[(mt * 32 + crow(r, hh)) * 64 + nt * 32 + cl] = acc[r];
    } else if (w == 4) {
        const int bk = lane >> 4, c = lane & 15;
        const LAS float* AAB = (const LAS float*)(lds + R1_AAB);
        float Tc[16]; const float fc = (float)c;
#pragma unroll
        for (int s2 = 0; s2 < 16; ++s2) { float val = fmaxf(0.f, 1.f - fabsf((float)s2 - fc));
#pragma unroll
            for (int r = 0; r < s2; ++r) val += AAB[(16 * bk + s2) * 64 + 16 * bk + r] * Tc[r];
            Tc[s2] = val; }
        LAS float* TII = (LAS float*)(lds + R1_TII);
#pragma unroll
        for (int s2 = 0; s2 < 16; ++s2) TII[(bk * 16 + s2) * 16 + c] = Tc[s2];
    }
    __syncthreads();
    {
        const int c16 = lane & 15, g = lane >> 4;
        const LAS float* AAB = (const LAS float*)(lds + R1_AAB); const LAS float* TII = (const LAS float*)(lds + R1_TII); const LAS float* X = (const LAS float*)(lds + R1_X);
        f32x4 o[4];
#pragma unroll
        for (int i = 0; i < 4; ++i) {
            f32x4 acc;
            if (w < 4) {
#pragma unroll
                for (int q = 0; q < 4; ++q) acc[q] = bf2f(*(const LAS bf16*)(lds + R1_AT + (16 * i + 4 * g + q) * SBS + (16 * w + c16) * 2));
            } else {
#pragma unroll
                for (int q = 0; q < 4; ++q) acc[q] = X[(16 * i + 4 * g + q) * 64 + 16 * (w - 4) + c16];
            }
#pragma unroll
            for (int j = 0; j < i; ++j) { const f32x4 a4 = *(const LAS f32x4*)(AAB + (16 * i + c16) * 64 + 16 * j + 4 * g);
#pragma unroll
                for (int q = 0; q < 4; ++q) acc = __builtin_amdgcn_mfma_f32_16x16x4f32(a4[q], o[j][q], acc, 0, 0, 0); }
            const f32x4 t4 = *(const LAS f32x4*)(TII + (i * 16 + c16) * 16 + 4 * g);
            f32x4 res = (f32x4){0.f, 0.f, 0.f, 0.f};
#pragma unroll
            for (int q = 0; q < 4; ++q) res = __builtin_amdgcn_mfma_f32_16x16x4f32(t4[q], acc[q], res, 0, 0, 0);
            o[i] = res;
            v2u ov; ov.x = pk2(res[0], res[1]); ov.y = pk2(res[2], res[3]);
            *(LAS v2u*)(lds + (w < 4 ? R1_AHT : R1_U0T) + (16 * (w & 3) + c16) * SBS + (16 * i + 4 * g) * 2) = ov;
        }
    }
    __syncthreads();
    {
        float* Mg = F.out + (size_t)item * 4096; float* NTg = F.out + (size_t)T * RWW + (size_t)item * 4096;
        float* Y0g = (float*)(F.ws + WS_RWY0) + (size_t)item * 4096; bf16* RHg = (bf16*)(F.ws + WS_RWRH) + (size_t)item * 4096;
#pragma unroll
        for (int u = 0; u < 2; ++u) {
            const int idx = w * 2 + u, p = idx >> 2, mt = (idx >> 1) & 1, nt = idx & 1; const int n = nt * 32 + cl;
            if (p == 0) {
                f32x16 acc = wtile<4>(lds + R1_BBT + mt * 32 * SBS, SBS, lds + R1_AHT + nt * 32 * SBS, SBS, zero16(), lane);
                const LAS float* WE = (const LAS float*)(lds + R1_WEND);
#pragma unroll
                for (int r = 0; r < 16; ++r) { const int m = mt * 32 + crow(r, hh); Mg[m * 64 + n] = acc[r] + (m == n ? WE[m] : 0.f); }
            } else if (p == 1) {
                f32x16 acc = wtile<4>(lds + R1_U0T + mt * 32 * SBS, SBS, lds + R1_BBT + nt * 32 * SBS, SBS, zero16(), lane);
                acc = wtile<4>(lds + R1_VT + mt * 32 * SBS, SBS, lds + R1_KBT + nt * 32 * SBS, SBS, acc, lane);
#pragma unroll
                for (int r = 0; r < 16; ++r) NTg[(mt * 32 + crow(r, hh)) * 64 + n] = acc[r];
            } else if (p == 2) {
                f32x16 acc = wtile<4>(lds + R1_AHT + mt * 32 * SBS, SBS, lds + R1_ARB + nt * 32 * SBS, SBS, zero16(), lane);
#pragma unroll
                for (int g4 = 0; g4 < 4; ++g4) { const int m0 = mt * 32 + 8 * g4 + 4 * hh;
                    const v2u rt = *(const LAS v2u*)(lds + R1_RT + n * SBS + m0 * 2);
                    v2u ov; ov.x = pk2(acc[4 * g4] + bflo(rt.x), acc[4 * g4 + 1] + bfhi(rt.x)); ov.y = pk2(acc[4 * g4 + 2] + bflo(rt.y), acc[4 * g4 + 3] + bfhi(rt.y));
                    *(GAS v2u*)(RHg + n * 64 + m0) = ov; }
            } else {
                f32x16 acc = wtile<4>(lds + R1_ARB + mt * 32 * SBS, SBS, lds + R1_U0T + nt * 32 * SBS, SBS, zero16(), lane);
                acc = wtile<4>(lds + R1_ARK + mt * 32 * SBS, SBS, lds + R1_VT + nt * 32 * SBS, SBS, acc, lane);
#pragma unroll
                for (int r = 0; r < 16; ++r) Y0g[(mt * 32 + crow(r, hh)) * 64 + n] = acc[r];
            }
        }
        if (tid < 64) ((float*)(F.ws + WS_BONUS))[(size_t)item * 64 + tid] = ((const LAS float*)(lds + R1_BONUS))[tid];
    }
    __syncthreads();
}

__device__ __forceinline__ void rwkv_r2_chain(Frame& F, int chain) {
    const int w = F.wave; if (w >= 4) return;
    const int lane = F.lane, n16 = lane & 15, g = lane >> 4;
    const float* Mg = F.out + (size_t)chain * 128 * 4096; const float* NTg = F.out + (size_t)T * RWW + (size_t)chain * 128 * 4096;
    float* SSg = (float*)(F.ws + WS_RWSS) + (size_t)chain * 128 * 4096;
    f32x4 st[4];
#pragma unroll
    for (int rt = 0; rt < 4; ++rt) st[rt] = (f32x4){0.f, 0.f, 0.f, 0.f};
    f32x4 ma[4][4], nv[4];
#pragma unroll
    for (int rt = 0; rt < 4; ++rt) {
#pragma unroll
        for (int kt = 0; kt < 4; ++kt) ma[rt][kt] = *(const GAS f32x4*)(Mg + (16 * rt + n16) * 64 + 16 * kt + 4 * g);
        nv[rt] = *(const GAS f32x4*)(NTg + (16 * w + n16) * 64 + 16 * rt + 4 * g); }
    for (int c = 0; c < 128; ++c) {
#pragma unroll
        for (int rt = 0; rt < 4; ++rt) *(GAS f32x4*)(SSg + (size_t)c * 4096 + (16 * w + n16) * 64 + 16 * rt + 4 * g) = st[rt];
        if (c == 127) break;
        f32x4 nw[4];
#pragma unroll
        for (int rt = 0; rt < 4; ++rt) { f32x4 acc = nv[rt];
#pragma unroll
            for (int kt = 0; kt < 4; ++kt)
#pragma unroll
                for (int q = 0; q < 4; ++q) acc = __builtin_amdgcn_mfma_f32_16x16x4f32(ma[rt][kt][q], st[kt][q], acc, 0, 0, 0);
            nw[rt] = acc; }
        const float* Mn = Mg + (size_t)(c + 1) * 4096; const float* Nn = NTg + (size_t)(c + 1) * 4096;
#pragma unroll
        for (int rt = 0; rt < 4; ++rt) {
#pragma unroll
            for (int kt = 0; kt < 4; ++kt) ma[rt][kt] = *(const GAS f32x4*)(Mn + (16 * rt + n16) * 64 + 16 * kt + 4 * g);
            nv[rt] = *(const GAS f32x4*)(Nn + (16 * w + n16) * 64 + 16 * rt + 4 * g); }
#pragma unroll
        for (int rt = 0; rt < 4; ++rt) st[rt] = nw[rt];
    }
}

constexpr int R3_RH = 0, R3_S = 9216, R3_SG = 18432, R3_SGS = 272, R3_YL = R3_SG + 64 * R3_SGS, R3_GL = R3_YL + 16384, R3_END = R3_GL + 16384;
static_assert(R3_END <= LDSCTL_OFF, "R3 LDS");
__device__ __forceinline__ void rwkv_r3_item(Frame& F, int item) {
    const int chain = item >> 7, chunk = item & 127, b = chain >> 3, h = chain & 7;
    const int g0 = b * SEQ + chunk * 64;
    int tid_ = F.tid; asm volatile("" : "+v"(tid_));
    const int tid = tid_, lane = tid & 63, w = __builtin_amdgcn_readfirstlane(tid >> 6), hh = lane >> 5, cl = lane & 31;
    const bf16* Z = (const bf16*)(F.ws + WS_Z);
    LAS unsigned char* lds = F.lds + RING_OFF;
    const float* mu = F.in[3];
    {
        const int t = tid >> 3, cg = tid & 7;
        const bf16* RHg = (const bf16*)(F.ws + WS_RWRH) + (size_t)item * 4096;
        *(LAS v4u*)(lds + R3_RH + t * SBS + cg * 16) = *(const GAS v4u*)(RHg + t * 64 + cg * 8);
        const float* SSg = (const float*)(F.ws + WS_RWSS) + (size_t)item * 4096;
        const f32x4 s0 = *(const GAS f32x4*)(SSg + t * 64 + cg * 8), s1 = *(const GAS f32x4*)(SSg + t * 64 + cg * 8 + 4);
        v4u o; o.x = pk2(s0[0], s0[1]); o.y = pk2(s0[2], s0[3]); o.z = pk2(s1[0], s1[1]); o.w = pk2(s1[2], s1[3]);
        *(LAS v4u*)(lds + R3_S + t * SBS + cg * 16) = o;
        const bool first = (chunk == 0 && t == 0);
        const bf16* zr = Z + (size_t)(g0 + t) * IN_COLS + C_GD + cg * 16;
#pragma unroll
        for (int q = 0; q < 2; ++q) {
            const v4u cw = *(const GAS v4u*)(zr + q * 8); v4u pw = (v4u){0u, 0u, 0u, 0u};
            if (!first) pw = *(const GAS v4u*)(zr - IN_COLS + q * 8);
            float fw[8], qw[8];
            fw[0] = bflo(cw.x); fw[1] = bfhi(cw.x); fw[2] = bflo(cw.y); fw[3] = bfhi(cw.y); fw[4] = bflo(cw.z); fw[5] = bfhi(cw.z); fw[6] = bflo(cw.w); fw[7] = bfhi(cw.w);
            qw[0] = bflo(pw.x); qw[1] = bfhi(pw.x); qw[2] = bflo(pw.y); qw[3] = bfhi(pw.y); qw[4] = bflo(pw.z); qw[5] = bfhi(pw.z); qw[6] = bflo(pw.w); qw[7] = bfhi(pw.w);
#pragma unroll
            for (int j = 0; j < 8; ++j) { const float v = fw[j] + (qw[j] - fw[j]) * mu[C_GD + cg * 16 + q * 8 + j]; fw[j] = 1.f / (1.f + __expf(-v)); }
            v4u og; og.x = pk2(fw[0], fw[1]); og.y = pk2(fw[2], fw[3]); og.z = pk2(fw[4], fw[5]); og.w = pk2(fw[6], fw[7]);
            *(LAS v4u*)(lds + R3_SG + t * R3_SGS + (cg * 16 + q * 8) * 2) = og;
        }
    }
    __syncthreads();
    {
        const int mt = (w >> 1) & 1, nt = w & 1; const int n = nt * 32 + cl;
        if (w < 4) {
            const float* Y0g = (const float*)(F.ws + WS_RWY0) + (size_t)item * 4096;
            f32x16 acc;
#pragma unroll
            for (int r = 0; r < 16; ++r) acc[r] = Y0g[(mt * 32 + crow(r, hh)) * 64 + n];
            acc = wtile<4>(lds + R3_RH + mt * 32 * SBS, SBS, lds + R3_S + nt * 32 * SBS, SBS, acc, lane);
            LAS float* YL = (LAS float*)(lds + R3_YL);
#pragma unroll
            for (int r = 0; r < 16; ++r) YL[(mt * 32 + crow(r, hh)) * 64 + n] = acc[r];
        } else {
            const bf16* gut = (const bf16*)(F.ws + WS_GUPT) + (size_t)(h * 64 + nt * 32) * 128;
            const f32x16 acc = wtile_gb<8>(lds + R3_SG + mt * 32 * R3_SGS, R3_SGS, gut, 128, zero16(), lane);
            LAS float* GL = (LAS float*)(lds + R3_GL);
#pragma unroll
            for (int r = 0; r < 16; ++r) GL[(mt * 32 + crow(r, hh)) * 64 + n] = acc[r];
        }
    }
    __syncthreads();
    {
        const int c = tid & 63, ts = tid >> 6, col = h * 64 + c;
        const float mu_v = mu[C_V + col], gw = F.in[12][col], gb = F.in[13][col];
        const LAS float* YL = (const LAS float*)(lds + R3_YL); const LAS float* GL = (const LAS float*)(lds + R3_GL);
        const float* BON = (const float*)(F.ws + WS_BONUS) + (size_t)item * 64;
        bf16* Y = (bf16*)(F.ws + WS_YMIX);
        const bf16* zb = Z + (size_t)(g0 + 8 * ts) * IN_COLS + col;
        float pv = 0.f; if (!(chunk == 0 && ts == 0)) pv = bf2f(zb[C_V - IN_COLS]);
#pragma unroll
        for (int i = 0; i < 8; ++i) { const int t = 8 * ts + i;
            const float zv = bf2f(zb[(size_t)i * IN_COLS + C_V]); const float v = zv + (pv - zv) * mu_v; pv = zv;
            const float y = YL[t * 64 + c];
            const float mean = wave_sum(y) * (1.f / 64.f); const float d = y - mean; const float var = wave_sum(d * d) * (1.f / 64.f);
            const float yn = d * (1.f / sqrtf(var + GN_EPS)) * gw + gb;
            const float o = (yn + BON[t] * v) * GL[t * 64 + c];
            Y[(size_t)(g0 + t) * DM + col] = (bf16)f2bf(o); }
    }
    __syncthreads();
}

typedef short s16x4 __attribute__((ext_vector_type(4)));
typedef short v4i16_t __attribute__((ext_vector_type(4)));
constexpr int AT_XO = 0, AT_XO_STRIDE = 136, AT_XM = 512 * AT_XO_STRIDE, AT_XL = AT_XM + 2048, AT_V = AT_XL + 2048, AT_LDS_END = AT_V + 8 * 4096;
static_assert(AT_LDS_END <= RING_BYTES, "attention LDS");
__device__ __forceinline__ float xhalf(float v) { return __shfl_xor(v, 32); }
__device__ __forceinline__ void attn_block(Frame& F, int item) {
    const int bh = item >> 4, blk = item & 15, b = bh >> 3, h = bh & 7, t0 = blk * 512;
    int tid_ = F.tid; asm volatile("" : "+v"(tid_));
    const int lane = tid_ & 63, w = __builtin_amdgcn_readfirstlane(tid_ >> 6), ql = lane & 31, hh = lane >> 5;
    const bf16* Zb = (const bf16*)(F.ws + WS_Z) + (size_t)b * SEQ * IN_COLS;
    bf16* Y = (bf16*)(F.ws + WS_YMIX);
    LAS unsigned char* lds = F.lds + RING_OFF;
    LAS unsigned char* Vw = lds + AT_V + w * 4096;
    LAS float* XM = (LAS float*)(lds + AT_XM); LAS float* XL = (LAS float*)(lds + AT_XL);
    constexpr float C2 = 0.125f * 1.4426950408889634f;
    for (int pass = 0; pass < 3; ++pass) {
        const int sh = pass == 0 ? 4 : (pass == 1 ? 2 : 0), d = 1 << sh;
        for (int uu = 0; uu < 2; ++uu) {
            const int u = w + 8 * uu, rho = u & (d - 1), tau = u >> sh;
            const int qoff = rho + (32 * tau + ql) * d;
            bf16x8 qf[4];
            { const bf16* qp = Zb + (size_t)(t0 + qoff) * IN_COLS + C_AQ + h * 64 + 8 * hh;
#pragma unroll
              for (int s = 0; s < 4; ++s) qf[s] = *(const GAS bf16x8*)(qp + 16 * s); }
            f32x16 sc[5];
            const int tkb = t0 + rho + (32 * tau - 128) * d;
#pragma unroll
            for (int kt = 0; kt < 5; ++kt) {
                const int tk0 = tkb + 32 * kt * d;
                if (tk0 >= 0) {
                    const bf16* kp = Zb + (size_t)(tk0 + ql * d) * IN_COLS + C_AK + h * 64 + 8 * hh;
                    bf16x8 kf[4];
#pragma unroll
                    for (int s = 0; s < 4; ++s) kf[s] = *(const GAS bf16x8*)(kp + 16 * s);
                    f32x16 acc;
#pragma unroll
                    for (int r = 0; r < 16; ++r) acc[r] = 0.f;
#pragma unroll
                    for (int s = 0; s < 4; ++s) acc = __builtin_amdgcn_mfma_f32_32x32x16_bf16(kf[s], qf[s], acc, 0, 0, 0);
                    if (kt == 0 || kt == 4) {
#pragma unroll
                        for (int r = 0; r < 16; ++r) { const int kidx = (r & 3) + 8 * (r >> 2) + 4 * hh;
                            const bool ok = (kt == 0) ? (kidx >= ql) : (kidx <= ql);
                            acc[r] = ok ? acc[r] : -INFINITY; }
                    }
                    sc[kt] = acc;
                } else {
#pragma unroll
                    for (int r = 0; r < 16; ++r) sc[kt][r] = -INFINITY;
                }
            }
            float m = -INFINITY;
#pragma unroll
            for (int kt = 0; kt < 5; ++kt)
#pragma unroll
                for (int r = 0; r < 16; ++r) m = fmaxf(m, sc[kt][r]);
            m = fmaxf(m, xhalf(m));
            const float ms = m * C2;
            float l = 0.f;
#pragma unroll
            for (int kt = 0; kt < 5; ++kt)
#pragma unroll
                for (int r = 0; r < 16; ++r) { const float p = __builtin_amdgcn_exp2f(sc[kt][r] * C2 - ms); sc[kt][r] = p; l += p; }
            l += xhalf(l);
            f32x16 O[2];
#pragma unroll
            for (int r = 0; r < 16; ++r) { O[0][r] = 0.f; O[1][r] = 0.f; }
#pragma unroll
            for (int kt = 0; kt < 5; ++kt) {
                const int tk0 = tkb + 32 * kt * d;
                if (tk0 >= 0) {
                    v4u vr[4];
#pragma unroll
                    for (int i = 0; i < 4; ++i) { const int kidx = i * 8 + (lane >> 3), ch = lane & 7;
                        vr[i] = *(const GAS v4u*)(Zb + (size_t)(tk0 + kidx * d) * IN_COLS + C_AV + h * 64 + ch * 8); }
#pragma unroll
                    for (int i = 0; i < 4; ++i) { const int kidx = i * 8 + (lane >> 3), ch = lane & 7;
                        *(LAS v4u*)(Vw + kidx * 128 + ((ch ^ (((kidx >> 1) & 1) << 2)) << 4)) = vr[i]; }
                    asm volatile("s_waitcnt lgkmcnt(0)" ::: "memory");
#pragma unroll
                    for (int s = 0; s < 2; ++s) {
                        bf16x8 pf;
#pragma unroll
                        for (int j = 0; j < 8; ++j) pf[j] = (short)f2bf(sc[kt][8 * s + j]);
#pragma unroll
                        for (int dt = 0; dt < 2; ++dt) {
                            bf16x8 vf;
#pragma unroll
                            for (int pp = 0; pp < 2; ++pp) {
                                const int i16 = lane & 15, db = (lane >> 4) & 1;
                                const int row = 16 * s + 8 * pp + 4 * hh + (i16 >> 2);
                                const int byte = 64 * dt + 32 * db + 8 * (i16 & 3);
                                const int chunk = (byte >> 4) ^ (((row >> 1) & 1) << 2);
                                const s16x4 t4 = __builtin_bit_cast(s16x4, __builtin_amdgcn_ds_read_tr16_b64_v4i16((LAS v4i16_t*)(Vw + row * 128 + (chunk << 4) + (byte & 15))));
                                vf[4 * pp + 0] = t4[0]; vf[4 * pp + 1] = t4[1]; vf[4 * pp + 2] = t4[2]; vf[4 * pp + 3] = t4[3];
                            }
                            O[dt] = __builtin_amdgcn_mfma_f32_32x32x16_bf16(vf, pf, O[dt], 0, 0, 0);
                        }
                    }
                    asm volatile("s_waitcnt lgkmcnt(0)" ::: "memory");
                }
            }
            LAS unsigned char* xo = lds + AT_XO + qoff * AT_XO_STRIDE + 8 * hh;
            float wa = 0.f, wb = 1.f, Mx = ms, ln = l;
            if (pass > 0) { const float msa = XM[qoff], la = XL[qoff]; Mx = fmaxf(msa, ms); wa = la * __builtin_amdgcn_exp2f(msa - Mx); wb = __builtin_amdgcn_exp2f(ms - Mx); ln = wa + wb * l; }
            const float inv = 1.f / ln;
#pragma unroll
            for (int dt = 0; dt < 2; ++dt)
#pragma unroll
                for (int g4 = 0; g4 < 4; ++g4) {
                    LAS v2u* p = (LAS v2u*)(xo + (32 * dt + 8 * g4) * 2);
                    float o0 = O[dt][4 * g4] * wb, o1 = O[dt][4 * g4 + 1] * wb, o2 = O[dt][4 * g4 + 2] * wb, o3 = O[dt][4 * g4 + 3] * wb;
                    if (pass > 0) { const v2u old = *p; o0 += bflo(old.x) * wa; o1 += bfhi(old.x) * wa; o2 += bflo(old.y) * wa; o3 += bfhi(old.y) * wa; }
                    v2u nw; nw.x = pk2(o0 * inv, o1 * inv); nw.y = pk2(o2 * inv, o3 * inv);
                    *p = nw;
                }
            if (hh == 0) { XM[qoff] = Mx; XL[qoff] = ln; }
        }
        __syncthreads();
    }
#pragma unroll
    for (int i = 0; i < 8; ++i) { const int row = (tid_ >> 3) + 64 * i, ch = tid_ & 7;
        LAS v2u* p = (LAS v2u*)(lds + AT_XO + row * AT_XO_STRIDE + ch * 16);
        const v2u a = p[0], c = p[1];
        v4u o; o.x = a.x; o.y = a.y; o.z = c.x; o.w = c.y;
        *(GAS v4u*)(Y + ((size_t)b * SEQ + t0 + row) * DM + RWW + h * 64 + ch * 8) = o; }
    __syncthreads();
}

__device__ __forceinline__ void p3_mixers(Frame& F) {
    const int nrw = (F.G >= 64) ? 32 : 0;
    if (nrw == 0) { for (int ch = 0; ch < NB * NHR; ++ch) rwkv_r2_chain(F, ch); }
    else if (F.wg < nrw) { for (int ch = F.wg; ch < NB * NHR; ch += nrw) rwkv_r2_chain(F, ch); return; }
    const int na = F.G - nrw, wa = F.wg - nrw;
    for (int item = wa; item < NB * NHA * (SEQ / 512); item += na) attn_block(F, item);
}

__device__ __forceinline__ void p5_xn2(Frame& F) {
    const int gw = F.wg * NWAVES + F.wave, NGW = F.G * NWAVES;
    bf16* XN = (bf16*)(F.ws + WS_XN);
    for (int m = gw; m < T; m += NGW) rms_row_to_bf16(F.lane, F.out + (size_t)m * DM, F.in[15], XN + (size_t)m * DM);
}

constexpr int TK_SKS = 272, TK_SKH = 0, TK_SKL = 2 * 128 * TK_SKS, TK_LUT = 2 * TK_SKL, TK_END = TK_LUT + 8 * 2048;
__device__ __forceinline__ unsigned f2ord(float f) { const unsigned u = __builtin_bit_cast(unsigned, f); return u ^ ((unsigned)((int)u >> 31) | 0x80000000u); }
__device__ __forceinline__ float ord2f(unsigned o) { const unsigned u = (o & 0x80000000u) ? (o ^ 0x80000000u) : ~o; return __builtin_bit_cast(float, u); }
__device__ __forceinline__ void ce_desc(unsigned& a, unsigned& b) { const unsigned mx = a > b ? a : b, mn = a > b ? b : a; a = mx; b = mn; }
template <int N, int OFF, int TOT> __device__ __forceinline__ void bitonic_sort_desc(unsigned (&v)[TOT]) {
#pragma unroll
    for (int k = 2; k <= N; k <<= 1)
#pragma unroll
        for (int j = k >> 1; j > 0; j >>= 1)
#pragma unroll
            for (int i = 0; i < N; ++i) { const int l = i ^ j; if (l > i) { if ((i & k) == 0) ce_desc(v[OFF + i], v[OFF + l]); else ce_desc(v[OFF + l], v[OFF + i]); } }
}
template <int OFFA, int OFFB, int TOT> __device__ __forceinline__ void merge_top16(unsigned (&v)[TOT]) {
#pragma unroll
    for (int i = 0; i < 16; ++i) { const unsigned x = v[OFFA + i], y = v[OFFB + 15 - i]; v[OFFA + i] = x > y ? x : y; }
#pragma unroll
    for (int j = 8; j > 0; j >>= 1)
#pragma unroll
        for (int i = 0; i < 16; ++i) { const int l = i ^ j; if (l > i) ce_desc(v[OFFA + i], v[OFFA + l]); }
}
__device__ __forceinline__ void top16_of_64(unsigned (&k)[64]) {
    bitonic_sort_desc<16, 0, 64>(k); bitonic_sort_desc<16, 16, 64>(k); bitonic_sort_desc<16, 32, 64>(k); bitonic_sort_desc<16, 48, 64>(k);
    merge_top16<0, 16, 64>(k); merge_top16<32, 48, 64>(k); merge_top16<0, 32, 64>(k);
}
__device__ __forceinline__ void p7_topk(Frame& F) {
    static_assert(TK_END <= LDSCTL_OFF, "topk LDS");
    const bf16* QP = (const bf16*)(F.ws + WS_QP);
    int* EID = (int*)(F.ws + WS_EID); float* GATE = (float*)(F.ws + WS_GATE);
    const float* sk = F.in[17];
    LAS unsigned char* lds = F.lds + RING_OFF;
    for (int e = F.tid; e < 2 * 128 * 64; e += NTHREADS) {
        const int c = e >> 13, k = (e >> 6) & 127, d2 = e & 63;
        const f32x2 v = *(const GAS f32x2*)(sk + (size_t)(c * 128 + k) * 128 + 2 * d2);
        const unsigned h0 = f2bf(v.x), h1 = f2bf(v.y);
        const float r0 = v.x - __builtin_bit_cast(float, h0 << 16), r1 = v.y - __builtin_bit_cast(float, h1 << 16);
        *(LAS unsigned*)(lds + TK_SKH + (c * 128 + k) * TK_SKS + d2 * 4) = h0 | (h1 << 16);
        *(LAS unsigned*)(lds + TK_SKL + (c * 128 + k) * TK_SKS + d2 * 4) = pk2(r0, r1);
    }
    __syncthreads();
    const int gw = F.wg * NWAVES + F.wave, NGW = F.G * NWAVES;
    for (int tile = gw; tile < T * PHEADS / 32; tile += NGW) {
        int lane_ = F.lane; asm volatile("" : "+v"(lane_));
        const int lane = lane_, hh = lane >> 5, cl = lane & 31;
        const int P = tile * 32 + cl, t = P >> 3, h = P & 7;
        unsigned kAB[2][16];
#pragma unroll
        for (int c = 0; c < 2; ++c) {
            bf16x8 qf[8];
            const bf16* qp = QP + (size_t)t * PQ + h * 256 + c * 128 + 8 * hh;
#pragma unroll
            for (int s2 = 0; s2 < 8; ++s2) qf[s2] = *(const GAS bf16x8*)(qp + 16 * s2);
            unsigned k[64];
#pragma unroll
            for (int mt = 0; mt < 4; ++mt) {
                f32x16 acc = zero16();
                const LAS unsigned char* ah = lds + TK_SKH + (c * 128 + mt * 32 + cl) * TK_SKS + 16 * hh;
                const LAS unsigned char* al = lds + TK_SKL + (c * 128 + mt * 32 + cl) * TK_SKS + 16 * hh;
#pragma unroll
                for (int s2 = 0; s2 < 8; ++s2) {
                    acc = __builtin_amdgcn_mfma_f32_32x32x16_bf16(*(const LAS bf16x8*)(ah + 32 * s2), qf[s2], acc, 0, 0, 0);
                    acc = __builtin_amdgcn_mfma_f32_32x32x16_bf16(*(const LAS bf16x8*)(al + 32 * s2), qf[s2], acc, 0, 0, 0); }
#pragma unroll
                for (int r = 0; r < 16; ++r) { const int idx = 32 * mt + (r & 3) + 8 * (r >> 2) + 4 * hh; k[mt * 16 + r] = (f2ord(acc[r]) & ~127u) | (unsigned)(127 - idx); }
            }
            top16_of_64(k);
            unsigned m[32];
#pragma unroll
            for (int i = 0; i < 16; ++i) { m[i] = k[i]; m[16 + i] = (unsigned)__shfl_xor((int)k[i], 32); }
            merge_top16<0, 16, 32>(m);
#pragma unroll
            for (int i = 0; i < 16; ++i) kAB[c][i] = m[i];
        }
        float fa[16], fb[16];
#pragma unroll
        for (int i = 0; i < 16; ++i) { fa[i] = ord2f(kAB[0][i] & ~127u); fb[i] = ord2f(kAB[1][i] & ~127u); }
        unsigned cd[64]; int n = 0;
#pragma unroll
        for (int i = 0; i < 16; ++i)
#pragma unroll
            for (int j = 0; j < 16; ++j) if ((i + 1) * (j + 1) <= 16) { cd[n] = (f2ord(fa[i] + fb[j]) & ~255u) | (unsigned)(255 - (i * 16 + j)); ++n; }
#pragma unroll
        for (int q = 50; q < 64; ++q) cd[q] = 0u;
        top16_of_64(cd);
        LAS unsigned char* lut = lds + TK_LUT + (F.wave * 64 + lane) * 32;
#pragma unroll
        for (int q = 0; q < 4; ++q) {
            unsigned wa = 0u, wb = 0u;
#pragma unroll
            for (int b4 = 0; b4 < 4; ++b4) { wa |= (127u - (kAB[0][4 * q + b4] & 127u)) << (8 * b4); wb |= (127u - (kAB[1][4 * q + b4] & 127u)) << (8 * b4); }
            *(LAS unsigned*)(lut + 4 * q) = wa; *(LAS unsigned*)(lut + 16 + 4 * q) = wb; }
        float gv[16]; float den = 0.f; const float mx = ord2f(cd[0] & ~255u);
#pragma unroll
        for (int q = 0; q < 16; ++q) { gv[q] = __expf(ord2f(cd[q] & ~255u) - mx); den += gv[q]; }
        const float inv = 1.f / den;
        asm volatile("s_waitcnt lgkmcnt(0)" ::: "memory");
        int ev[16];
#pragma unroll
        for (int q = 0; q < 16; ++q) { const unsigned pos = 255u - (cd[q] & 255u);
            const unsigned ia = *(const LAS unsigned char*)(lut + (pos >> 4)), ib = *(const LAS unsigned char*)(lut + 16 + (pos & 15u));
            ev[q] = (int)(ia * NKEYS + ib); }
        if (hh == 0) {
            int* ep = EID + (size_t)t * 128 + h * 16; float* gp = GATE + (size_t)t * 128 + h * 16;
#pragma unroll
            for (int q = 0; q < 4; ++q) {
                *(GAS v4u*)(ep + 4 * q) = (v4u){(unsigned)ev[4 * q], (unsigned)ev[4 * q + 1], (unsigned)ev[4 * q + 2], (unsigned)ev[4 * q + 3]};
                *(GAS f32x4*)(gp + 4 * q) = (f32x4){gv[4 * q] * inv, gv[4 * q + 1] * inv, gv[4 * q + 2] * inv, gv[4 * q + 3] * inv}; }
        }
        asm volatile("s_waitcnt lgkmcnt(0)" ::: "memory");
    }
}

constexpr int GA_WAVE_BYTES = 4608, GA_CNT = 4096, GA_OFF = 4096 + 64;
__device__ __forceinline__ int wave_sum_i(int v) { v += dppi<0xB1>(v); v += dppi<0x4E>(v); v += dppi<0x141>(v); v += dppi<0x140>(v);
    return (__builtin_amdgcn_readlane(v, 0) + __builtin_amdgcn_readlane(v, 16)) + (__builtin_amdgcn_readlane(v, 32) + __builtin_amdgcn_readlane(v, 48)); }
struct PairBuf { v4u u, v; float su, sv; int e; float g; };
__device__ __forceinline__ void p8_gather(Frame& F) {
    const bf16* XN = (const bf16*)(F.ws + WS_XN);
    const unsigned char* UQ = F.ws + WS_UQ; const unsigned char* VQ = F.ws + WS_VQ;
    const float* SU = (const float*)(F.ws + WS_SU); const float* SV = (const float*)(F.ws + WS_SV);
    const int* EID = (const int*)(F.ws + WS_EID); const float* GATE = (const float*)(F.ws + WS_GATE);
    const float* nf = F.in[20];
    const int gw = F.wg * NWAVES + F.wave, NGW = F.G * NWAVES;
    LAS unsigned char* wl = F.lds + RING_OFF + F.wave * GA_WAVE_BYTES;
    for (int tg = gw; tg < T / 4; tg += NGW) {
        int lane_ = F.lane; asm volatile("" : "+v"(lane_));
        const int lane = lane_;
        int xq[4][4]; float sx[4];
#pragma unroll
        for (int tk = 0; tk < 4; ++tk) {
            const GAS v4u* xp = (const GAS v4u*)(XN + (size_t)(4 * tg + tk) * DM + lane * 16);
            const v4u a = xp[0], b = xp[1];
            float x[16]; x[0] = bflo(a.x); x[1] = bfhi(a.x); x[2] = bflo(a.y); x[3] = bfhi(a.y); x[4] = bflo(a.z); x[5] = bfhi(a.z); x[6] = bflo(a.w); x[7] = bfhi(a.w);
            x[8] = bflo(b.x); x[9] = bfhi(b.x); x[10] = bflo(b.y); x[11] = bfhi(b.y); x[12] = bflo(b.z); x[13] = bfhi(b.z); x[14] = bflo(b.w); x[15] = bfhi(b.w);
            float am = 0.f;
#pragma unroll
            for (int i = 0; i < 16; ++i) am = fmaxf(am, fabsf(x[i]));
            am = wave_max(am);
            sx[tk] = am > 0.f ? am * (1.f / 127.f) : 1.f; const float inv = am > 0.f ? 127.f / am : 0.f;
#pragma unroll
            for (int q = 0; q < 4; ++q) {
                const unsigned b0 = (unsigned)(int)rintf(x[4 * q] * inv) & 255u, b1 = (unsigned)(int)rintf(x[4 * q + 1] * inv) & 255u, b2 = (unsigned)(int)rintf(x[4 * q + 2] * inv) & 255u, b3 = (unsigned)(int)rintf(x[4 * q + 3] * inv) & 255u;
                xq[tk][q] = (int)(b0 | (b1 << 8) | (b2 << 16) | (b3 << 24)); }
        }
        LAS unsigned* cnt = (LAS unsigned*)(wl + GA_CNT); LAS unsigned* offs = (LAS unsigned*)(wl + GA_OFF);
        if (lane < 16) cnt[lane] = 0u;
        asm volatile("s_waitcnt lgkmcnt(0)" ::: "memory");
        int ee[8]; float gg[8]; unsigned pos[8];
#pragma unroll
        for (int tk = 0; tk < 4; ++tk) {
            const size_t base = (size_t)(4 * tg + tk) * 128;
            ee[2 * tk] = (EID[base + lane] & (NEXP - 1)) | (tk << 14); ee[2 * tk + 1] = (EID[base + 64 + lane] & (NEXP - 1)) | (tk << 14);
            gg[2 * tk] = GATE[base + lane]; gg[2 * tk + 1] = GATE[base + 64 + lane]; }
#pragma unroll
        for (int q = 0; q < 8; ++q) pos[q] = __hip_atomic_fetch_add(cnt + ((ee[q] >> 10) & 15), 1u, __ATOMIC_RELAXED, __HIP_MEMORY_SCOPE_WAVEFRONT);
        asm volatile("s_waitcnt lgkmcnt(0)" ::: "memory");
        if (lane < 16) {
            const int c0 = (int)cnt[lane]; int v = c0;
            v += __builtin_amdgcn_update_dpp(0, v, 0x111, 0xF, 0xF, true); v += __builtin_amdgcn_update_dpp(0, v, 0x112, 0xF, 0xF, true);
            v += __builtin_amdgcn_update_dpp(0, v, 0x114, 0xF, 0xF, true); v += __builtin_amdgcn_update_dpp(0, v, 0x118, 0xF, 0xF, true);
            offs[lane] = (unsigned)(v - c0);
        }
        asm volatile("s_waitcnt lgkmcnt(0)" ::: "memory");
#pragma unroll
        for (int q = 0; q < 8; ++q) { const unsigned idx = offs[(ee[q] >> 10) & 15] + pos[q];
            *(LAS v2u*)(wl + idx * 8) = (v2u){(unsigned)ee[q], __builtin_bit_cast(unsigned, gg[q])}; }
        asm volatile("s_waitcnt lgkmcnt(0)" ::: "memory");
        float y[4][16]; float yo[4];
#pragma unroll
        for (int tk = 0; tk < 4; ++tk) { yo[tk] = 0.f;
#pragma unroll
            for (int i = 0; i < 16; ++i) y[tk][i] = 0.f; }
#define GA_LOAD(B, j) do { const int e_ = __builtin_amdgcn_readlane((int)ent.x, (j)); const int ex_ = e_ & (NEXP - 1); \
            (B).u = *(const GAS v4u*)(UQ + (size_t)ex_ * DM + lane * 16); (B).v = *(const GAS v4u*)(VQ + (size_t)ex_ * DM + lane * 16); \
            (B).su = SU[ex_]; (B).sv = SV[ex_]; (B).e = e_; (B).g = __builtin_bit_cast(float, __builtin_amdgcn_readlane((int)ent.y, (j))); } while (0)
#define GA_PAIR(B, TK) do { int d_ = __builtin_amdgcn_sdot4(xq[TK][0], (int)(B).u.x, 0, false); d_ = __builtin_amdgcn_sdot4(xq[TK][1], (int)(B).u.y, d_, false); \
            d_ = __builtin_amdgcn_sdot4(xq[TK][2], (int)(B).u.z, d_, false); d_ = __builtin_amdgcn_sdot4(xq[TK][3], (int)(B).u.w, d_, false); \
            const float h_ = (float)wave_sum_i(d_) * ((B).su * sx[TK]); \
            const float a_ = 0.5f * h_ * (1.f + erff(h_ * 0.70710678118654752f)) * (B).g * (B).sv; yo[TK] += a_ * 128.f; \
            _Pragma("unroll") for (int q_ = 0; q_ < 4; ++q_) { const unsigned w_ = (B).v[q_]; \
                y[TK][4 * q_] += a_ * (float)(w_ & 255u); y[TK][4 * q_ + 1] += a_ * (float)((w_ >> 8) & 255u); y[TK][4 * q_ + 2] += a_ * (float)((w_ >> 16) & 255u); y[TK][4 * q_ + 3] += a_ * (float)(w_ >> 24); } } while (0)
#define GA_COMP(B) do { const int tk_ = ((B).e >> 14) & 3; if (tk_ == 0) GA_PAIR(B, 0); else if (tk_ == 1) GA_PAIR(B, 1); else if (tk_ == 2) GA_PAIR(B, 2); else GA_PAIR(B, 3); } while (0)
        for (int ch = 0; ch < 8; ++ch) {
            const v2u ent = *(const LAS v2u*)(wl + (ch * 64 + lane) * 8);
            PairBuf A0, A1, A2, A3, B0, B1, B2, B3;
            GA_LOAD(A0, 0); GA_LOAD(A1, 1); GA_LOAD(A2, 2); GA_LOAD(A3, 3);
            for (int jb = 0; jb < 64; jb += 8) {
                GA_LOAD(B0, jb + 4); GA_LOAD(B1, jb + 5); GA_LOAD(B2, jb + 6); GA_LOAD(B3, jb + 7);
                GA_COMP(A0); GA_COMP(A1); GA_COMP(A2); GA_COMP(A3);
                if (jb + 8 < 64) { GA_LOAD(A0, jb + 8); GA_LOAD(A1, jb + 9); GA_LOAD(A2, jb + 10); GA_LOAD(A3, jb + 11); }
                GA_COMP(B0); GA_COMP(B1); GA_COMP(B2); GA_COMP(B3);
            }
        }
#undef GA_LOAD
#undef GA_PAIR
#undef GA_COMP
#pragma unroll
        for (int tk = 0; tk < 4; ++tk) {
            float* hrow = F.out + (size_t)(4 * tg + tk) * DM + lane * 16;
            float hv[16]; float ss = 0.f;
#pragma unroll
            for (int q = 0; q < 4; ++q) { const f32x4 h4 = *(const GAS f32x4*)(hrow + 4 * q);
#pragma unroll
                for (int i = 0; i < 4; ++i) { const float v = h4[i] + (y[tk][4 * q + i] - yo[tk]); hv[4 * q + i] = v; ss += v * v; } }
            const float rstd = 1.f / sqrtf(wave_sum(ss) * (1.f / DM) + RMS_EPS);
#pragma unroll
            for (int q = 0; q < 4; ++q) { const f32x4 n4 = *(const GAS f32x4*)(nf + lane * 16 + 4 * q);
                *(GAS f32x4*)(hrow + 4 * q) = (f32x4){hv[4 * q] * rstd * n4[0], hv[4 * q + 1] * rstd * n4[1], hv[4 * q + 2] * rstd * n4[2], hv[4 * q + 3] * rstd * n4[3]}; }
        }
    }
}

struct Args { const float* in[21]; float* out; unsigned char* ws; int ph_lo, ph_hi; };
static_assert(sizeof(Args) == 21 * 8 + 8 + 8 + 8, "Args has no padding");

__global__ void __launch_bounds__(NTHREADS, 2) fwd_kernel(Args args) {
    extern __shared__ __attribute__((aligned(16))) unsigned char lds[];
    Frame F;
    F.lds = (LAS unsigned char*)lds;
    F.MISC = (volatile LAS unsigned*)(F.lds + MISC_OFF);
    F.tid = threadIdx.x; F.lane = F.tid & 63; F.wave = __builtin_amdgcn_readfirstlane(F.tid >> 6);
    F.G = gridDim.x; F.wg = blockIdx.x;
#pragma unroll
    for (int i = 0; i < 21; ++i) F.in[i] = args.in[i];
    F.out = args.out; F.ws = args.ws;
    F.ctl = (gu32*)(args.ws + WS_CTL);
    for (int u = F.tid; u < (LDS_BYTES - LDSCTL_OFF) / 4; u += NTHREADS) ((LAS unsigned*)(F.lds + LDSCTL_OFF))[u] = 0u;
    __syncthreads();
    const int lo = args.ph_lo, hi = args.ph_hi;
    const bool fused = (hi - lo) > 1;
    XcdBarrier bar; bar.bar = (unsigned*)(F.ctl + CW_BAR); bar.x = 0; bar.st = nullptr;
    if (fused) bar = xcd_barrier_post((unsigned*)(F.ctl + CW_BAR), F.MISC + 8);
#define IN(k) (lo <= (k) && (k) < hi)
#define SEAM(k) do { if (IN(k) && IN((k) + 1)) xcd_barrier(bar); } while (0)

    if (IN(0)) { p0_prologue(F); SEAM(0); }
    if (IN(1)) {
        pg8::Gemm g{(const bf16*)(F.ws + WS_XN), (const bf16*)(F.ws + WS_WIN), T, IN_COLS, DM}; pg8::StaticOrder S; S.init(T, IN_COLS, F.G, F.wg);
        pg8::EpiBf16 E{(bf16*)(F.ws + WS_Z), IN_COLS};
        pg8::gemm_phase<pg8::EpiBf16, pg8::StaticOrder, true, true>(F.lds + RING_OFF, g, S, E);
        SEAM(1);
    }
    if (IN(2)) { p2_rope(F); for (int item = F.wg; item < NB * NHR * 128; item += F.G) rwkv_r1_item(F, item); SEAM(2); }
    if (IN(3)) { p3_mixers(F); SEAM(3); }
    if (IN(4)) { for (int item = F.wg; item < NB * NHR * 128; item += F.G) rwkv_r3_item(F, item); SEAM(4); }
    if (IN(5)) {
        pg8::Gemm g{(const bf16*)(F.ws + WS_YMIX), (const bf16*)(F.ws + WS_WOUT), T, DM, DM}; pg8::StaticOrder S; S.init(T, DM, F.G, F.wg);
        pg8::EpiF32Res E{F.in[0], F.out, DM};
        pg8::gemm_phase<pg8::EpiF32Res, pg8::StaticOrder, true, true>(F.lds + RING_OFF, g, S, E);
        SEAM(5);
    }
    if (IN(6)) { p5_xn2(F); SEAM(6); }
    if (IN(7)) {
        pg8::Gemm g{(const bf16*)(F.ws + WS_XN), (const bf16*)(F.ws + WS_WQ), T, PQ, DM}; pg8::StaticOrder S; S.init(T, PQ, F.G, F.wg);
        pg8::EpiBf16 E{(bf16*)(F.ws + WS_QP), PQ};
        pg8::gemm_phase<pg8::EpiBf16, pg8::StaticOrder, true, true>(F.lds + RING_OFF, g, S, E);
        SEAM(7);
    }
    if (IN(8)) { p7_topk(F); SEAM(8); }
    if (IN(9)) { p8_gather(F); }
#undef IN
#undef SEAM
}

extern "C" void kernel_launch(void* const* d_in, const int* in_sizes, int n_in, void* d_out, int out_size, void* d_ws, size_t ws_size, hipStream_t stream) {
    static int grid = 0;
    if (grid == 0) {
        if (n_in != 21 || in_sizes[0] != T * DM || out_size != T * DM || ws_size < WS_END) {
            fprintf(stderr, "kernel_launch: unexpected shapes: n_in %d in0 %d out %d ws %zu (need %zu); nothing launched\n", n_in, n_in > 0 ? in_sizes[0] : -1, out_size, ws_size, (size_t)WS_END); grid = -1; return; }
        int dev = 0, cus = 0, per_cu = 0;
        if (hipGetDevice(&dev) != hipSuccess || hipDeviceGetAttribute(&cus, hipDeviceAttributeMultiprocessorCount, dev) != hipSuccess) { grid = -1; return; }
        if (hipFuncSetAttribute((const void*)fwd_kernel, hipFuncAttributeMaxDynamicSharedMemorySize, LDS_BYTES) != hipSuccess) { fprintf(stderr, "kernel_launch: hipFuncSetAttribute failed\n"); grid = -1; return; }
        if (hipOccupancyMaxActiveBlocksPerMultiprocessor(&per_cu, (const void*)fwd_kernel, NTHREADS, LDS_BYTES) != hipSuccess || per_cu < 1) { fprintf(stderr, "kernel_launch: occupancy query says %d\n", per_cu); per_cu = 1; }
        (void)hipGetLastError();
        grid = cus;
    }
    if (grid < 0) return;
    (void)hipMemsetAsync((char*)d_ws + WS_CTL, 0, CTL_ZERO_BYTES, stream);
    Args a{};
    for (int i = 0; i < 21; ++i) a.in[i] = (const float*)d_in[i];
    a.out = (float*)d_out; a.ws = (unsigned char*)d_ws;
    if (MK_N_LAUNCHES == 1) {
        a.ph_lo = 0; a.ph_hi = NPHASE;
        void* kargs[] = {&a};
        hipError_t e = hipLaunchCooperativeKernel((const void*)fwd_kernel, dim3(grid), dim3(NTHREADS), kargs, LDS_BYTES, stream);
        if (e != hipSuccess) fprintf(stderr, "kernel_launch: cooperative launch failed: %s (grid %d)\n", hipGetErrorString(e), grid);
    } else {
        for (int p = 0; p < NPHASE; ++p) { a.ph_lo = p; a.ph_hi = p + 1;
            hipLaunchKernelGGL(fwd_kernel, dim3(grid), dim3(NTHREADS), LDS_BYTES, stream, a); }
    }
}
```

```cpp
#include <hip/hip_runtime.h>
#include <cstdio>
#include <cstdint>

#ifndef MK_N_LAUNCHES
#define MK_N_LAUNCHES 1
#endif

#ifndef REP_MASK
#define REP_MASK 0
#endif
#define GAS __attribute__((address_space(1)))
#define LAS __attribute__((address_space(3)))
typedef unsigned short bf16;
typedef unsigned v4u __attribute__((ext_vector_type(4)));
typedef unsigned v2u __attribute__((ext_vector_type(2)));
typedef float f32x4 __attribute__((ext_vector_type(4)));
typedef float f32x2 __attribute__((ext_vector_type(2)));
typedef short bf16x8 __attribute__((ext_vector_type(8)));
typedef GAS unsigned gu32;
#define RLX_AGENT __ATOMIC_RELAXED, __HIP_MEMORY_SCOPE_AGENT
#define LDS_WAIT() asm volatile("s_waitcnt lgkmcnt(0)" ::: "memory")
#define VM_WAIT() asm volatile("s_waitcnt vmcnt(0)" ::: "memory")

constexpr int DM = 1024, NB = 4, SEQ = 8192, T = NB * SEQ;
constexpr int HD = 64, RWW = 512, NHR = 8, NHA = 8;
constexpr int IN_COLS = 3328;
constexpr int C_R = 0, C_K = 512, C_V = 1024, C_WD = 1536, C_AD = 1600, C_GD = 1664, C_AQ = 1792, C_AK = 2304, C_AV = 2816;
constexpr int PHEADS = 8, NKEYS = 128, PQ = 2048, TOPK = 16, NEXP = 16384;
constexpr float RMS_EPS = 1e-6f, GN_EPS = 64e-5f;
constexpr int NWAVES = 8, NTHREADS = 512;
constexpr int NPHASE = 10;

constexpr size_t MiB = 1u << 20;
constexpr size_t WS_CTL = 0, CTL_ZERO_BYTES = 1 * MiB;
constexpr size_t WS_WIN = 2 * MiB;
constexpr size_t WS_WOUT = 10 * MiB;
constexpr size_t WS_WQ = 12 * MiB;
constexpr size_t WS_XN = 16 * MiB;
constexpr size_t WS_Z = 80 * MiB;
constexpr size_t WS_QP = 80 * MiB;
constexpr size_t WS_G = 288 * MiB;
constexpr size_t WS_YMIX = 352 * MiB;
constexpr size_t WS_UQ = 416 * MiB;
constexpr size_t WS_VQ = 432 * MiB;
constexpr size_t WS_SU = 448 * MiB;
constexpr size_t WS_SV = 449 * MiB;
constexpr size_t WS_EID = 480 * MiB;
constexpr size_t WS_GATE = 496 * MiB;
constexpr size_t WS_END = 512 * MiB;
constexpr size_t WS_WUPT = 1 * MiB, WS_AUPT = WS_WUPT + 65536, WS_GUPT = WS_AUPT + 65536;
constexpr size_t WS_BONUS = 9 * MiB;
constexpr size_t WS_RWY0 = WS_XN;
constexpr size_t WS_RWSS = WS_G;
constexpr size_t WS_RWRH = WS_EID;

constexpr int CW_BAR = 4096;

__device__ __forceinline__ unsigned f2bf(float f) { unsigned u = __builtin_bit_cast(unsigned, f); return (u + 0x7fffu + ((u >> 16) & 1u)) >> 16; }
__device__ __forceinline__ unsigned pk2(float lo, float hi) { return f2bf(lo) | (f2bf(hi) << 16); }
__device__ __forceinline__ float bflo(unsigned u) { return __builtin_bit_cast(float, u << 16); }
__device__ __forceinline__ float bfhi(unsigned u) { return __builtin_bit_cast(float, u & 0xffff0000u); }
__device__ __forceinline__ float bf2f(bf16 h) { return __builtin_bit_cast(float, (unsigned)h << 16); }

template <int CTRL> __device__ __forceinline__ float dppf(float x) { return __builtin_bit_cast(float, __builtin_amdgcn_update_dpp(0, __builtin_bit_cast(int, x), CTRL, 0xF, 0xF, true)); }
template <int CTRL> __device__ __forceinline__ int dppi(int x) { return __builtin_amdgcn_update_dpp(0, x, CTRL, 0xF, 0xF, true); }
__device__ __forceinline__ float rdlane(float v, int l) { return __builtin_bit_cast(float, __builtin_amdgcn_readlane(__builtin_bit_cast(int, v), l)); }
__device__ __forceinline__ float sum8(float v) { v += dppf<0xB1>(v); v += dppf<0x4E>(v); v += dppf<0x141>(v); return v; }
__device__ __forceinline__ float sum16(float v) { v = sum8(v); v += dppf<0x140>(v); return v; }
__device__ __forceinline__ float wave_sum(float v) { v = sum16(v); return (rdlane(v, 0) + rdlane(v, 16)) + (rdlane(v, 32) + rdlane(v, 48)); }
__device__ __forceinline__ float wave_max(float v) {
    v = fmaxf(v, dppf<0xB1>(v)); v = fmaxf(v, dppf<0x4E>(v)); v = fmaxf(v, dppf<0x141>(v)); v = fmaxf(v, dppf<0x140>(v));
    return fmaxf(fmaxf(rdlane(v, 0), rdlane(v, 16)), fmaxf(rdlane(v, 32), rdlane(v, 48)));
}
__device__ __forceinline__ int wave_min_i(int v) {
    v = min(v, dppi<0xB1>(v)); v = min(v, dppi<0x4E>(v)); v = min(v, dppi<0x141>(v)); v = min(v, dppi<0x140>(v));
    return min(min(__builtin_amdgcn_readlane(v, 0), __builtin_amdgcn_readlane(v, 16)), min(__builtin_amdgcn_readlane(v, 32), __builtin_amdgcn_readlane(v, 48)));
}

namespace pg8 {
#define PG8_LAS __attribute__((address_space(3)))
typedef unsigned short bf16_t;
typedef unsigned u32x4 __attribute__((ext_vector_type(4)));
constexpr int BM = 256, BK = 64, HALF = 128, HTB = HALF * BK * 2, STAGE_BYTES = 8 * HTB, NXCD = 8, WGM = 8;
__host__ __device__ __forceinline__ int lds_byte(int r, int c) { const int st = (r >> 4) * 2 + (c >> 5), rr = r & 15, cc = c & 31, ob = rr * 64 + cc * 2; return st * 1024 + (ob ^ (((ob >> 9) & 1) << 5)); }
__host__ __device__ __forceinline__ void stage_rc(int b, int& R, int& C) { const int st = b / 1024, sb = b % 1024, swz = sb ^ (((sb >> 9) & 1) << 5); R = (st >> 1) * 16 + swz / 64; C = (st & 1) * 32 + (swz % 64) / 2; }
__host__ __device__ __forceinline__ int perm32(int rho) { const int n = rho >> 4, i = rho & 15; return 8 * (i >> 2) + 4 * n + (i & 3); }
struct Unit { int pm, pn; };
struct Gemm { const bf16_t* A; const bf16_t* Bt; int M, N, K; };
struct StaticOrder {
    int nM, nN, nwg, G, c;
    __host__ __device__ void init(int M, int N, int G_, int c_) { nM = M / BM; nN = N / BM; nwg = nM * nN; G = G_; c = c_; }
    __host__ __device__ bool next(int i, Unit& u) const {
        const long L = (long)i * G + c; if (L >= nwg) return false;
        int wgid = (int)L; { const int q = nwg / NXCD, r = nwg % NXCD, xcd = wgid % NXCD, off = wgid / NXCD; wgid = (xcd < r ? xcd * (q + 1) : r * (q + 1) + (xcd - r) * q) + off; }
        const int nig = WGM * nN, gid = wgid / nig, fm = gid * WGM, gsz = (nM - fm) < WGM ? (nM - fm) : WGM;
        u.pm = fm + ((wgid % nig) % gsz); u.pn = (wgid % nig) / gsz; return true;
    }
    __device__ __forceinline__ void a_ready(const Unit&) const {}
    __device__ __forceinline__ void done(const Unit&) const {}
};
__device__ __forceinline__ unsigned cvt_pk_bf16(float lo, float hi) { unsigned r; asm volatile("v_cvt_pk_bf16_f32 %0, %1, %2" : "=v"(r) : "v"(lo), "v"(hi)); return r; }
struct EpiBf16 {
    static constexpr bool PERM = true, AFTER_DRAIN = false;
    bf16_t* O; int ldc;
    __device__ __forceinline__ void operator()(const f32x4 (&acc)[2][2][4][2], const Unit& u, int wr, int wc, int fr, int fq) const {
        const int row0 = u.pm * BM + wr * 64 + fr; const int col0 = u.pn * BM + wc * 32 + 8 * fq;
#pragma unroll
        for (int ai = 0; ai < 2; ++ai)
#pragma unroll
            for (int m = 0; m < 4; ++m) { bf16_t* rowp = O + (size_t)(row0 + ai * HALF + m * 16) * ldc + col0;
#pragma unroll
                for (int bj = 0; bj < 2; ++bj) { const f32x4 v0 = acc[ai][bj][m][0], v1 = acc[ai][bj][m][1];
                    u32x4 w; w.x = cvt_pk_bf16(v0[0], v0[1]); w.y = cvt_pk_bf16(v0[2], v0[3]); w.z = cvt_pk_bf16(v1[0], v1[1]); w.w = cvt_pk_bf16(v1[2], v1[3]);
                    *(u32x4*)(rowp + bj * HALF) = w; } }
    }
};
struct EpiF32Res {
    static constexpr bool PERM = true, AFTER_DRAIN = false;
    const float* res; float* O; int ldc;
    __device__ __forceinline__ void operator()(const f32x4 (&acc)[2][2][4][2], const Unit& u, int wr, int wc, int fr, int fq) const {
        const int row0 = u.pm * BM + wr * 64 + fr; const int col0 = u.pn * BM + wc * 32 + 8 * fq;
#pragma unroll
        for (int ai = 0; ai < 2; ++ai)
#pragma unroll
            for (int m = 0; m < 4; ++m) { const size_t off = (size_t)(row0 + ai * HALF + m * 16) * ldc + col0;
#pragma unroll
                for (int bj = 0; bj < 2; ++bj) { const f32x4 r0 = *(const f32x4*)(res + off + bj * HALF), r1 = *(const f32x4*)(res + off + bj * HALF + 4);
                    *(f32x4*)(O + off + bj * HALF) = acc[ai][bj][m][0] + r0; *(f32x4*)(O + off + bj * HALF + 4) = acc[ai][bj][m][1] + r1; } }
    }
};

template <class Epi, class Sched, bool ALIGN_EPI = false, bool SP2 = false>
__device__ __forceinline__ void gemm_phase(PG8_LAS unsigned char* lds, const Gemm g, const Sched& S, const Epi& E) {
    const int tid = threadIdx.x, wid = __builtin_amdgcn_readfirstlane(tid >> 6), lane = tid & 63, wr = wid >> 2, wc = wid & 3, fr = lane & 15, fq = lane >> 4;
    const int K = g.K, nt = K / BK;
    unsigned voffA[2], voffB[2];
#pragma unroll
    for (int i = 0; i < 2; ++i) { int R, C; stage_rc(tid * 16 + i * 8192, R, C); const int Rb = Epi::PERM ? ((R & ~31) + perm32(R & 31)) : R;
        voffA[i] = (unsigned)(R * K + C) * 2u; voffB[i] = (unsigned)(Rb * K + C) * 2u; }
    const size_t kstep = (size_t)(BK * 2);
    const size_t hstep = (size_t)HALF * K * 2;
    const size_t tstep = 2 * hstep;
    const unsigned ldsw = (unsigned)wid * 1024u;
    const int aoff = lds_byte(wr * 64 + fr, fq * 8), boff = lds_byte(wc * 32 + fr, fq * 8);
#define PG8_SA(b, h) (((b) * 2 + (h)) * HTB)
#define PG8_SB(b, h) ((4 + (b) * 2 + (h)) * HTB)
#define PG8_STAGE(bufoff, gbase, voff) do { _Pragma("unroll") for (int _i = 0; _i < 2; ++_i) \
        __builtin_amdgcn_global_load_lds((const unsigned*)((const char*)(gbase) + (voff)[_i]), (PG8_LAS unsigned*)(lds + (bufoff) + ldsw + _i * 8192), 16, 0, 0); } while (0)
#define PG8_LDA(dst, b, h) do { _Pragma("unroll") for (int m = 0; m < 4; ++m) _Pragma("unroll") for (int k = 0; k < 2; ++k) dst[m][k] = *(const PG8_LAS bf16x8*)(lds + PG8_SA(b, h) + aoff + m * 2048 + k * 1024); } while (0)
#define PG8_LDB(dst, b, h) do { _Pragma("unroll") for (int n = 0; n < 2; ++n) _Pragma("unroll") for (int k = 0; k < 2; ++k) dst[n][k] = *(const PG8_LAS bf16x8*)(lds + PG8_SB(b, h) + boff + n * 2048 + k * 1024); } while (0)
#define PG8_MMA(ai, bj, At, Bt) do { __builtin_amdgcn_s_setprio(1); _Pragma("unroll") for (int m = 0; m < 4; ++m) _Pragma("unroll") for (int n = 0; n < 2; ++n) _Pragma("unroll") for (int k = 0; k < 2; ++k) \
        acc[ai][bj][m][n] = __builtin_amdgcn_mfma_f32_16x16x32_bf16(Bt[n][k], At[m][k], acc[ai][bj][m][n], 0, 0, 0); __builtin_amdgcn_s_setprio(0); } while (0)
#define PG8_WAIT_V(n) asm volatile("s_waitcnt vmcnt(" #n ")" ::: "memory")
#define PG8_WAIT_L(n) asm volatile("s_waitcnt lgkmcnt(" #n ")" ::: "memory")
#define PG8_BAR __builtin_amdgcn_s_barrier()
#define PG8_SCHED __builtin_amdgcn_sched_barrier(0)
    Unit cur, nxt; int ui = 0;
    if (!S.next(0, cur)) return;
    f32x4 acc[2][2][4][2];
#pragma unroll
    for (int a = 0; a < 2; ++a)
#pragma unroll
        for (int b = 0; b < 2; ++b)
#pragma unroll
            for (int m = 0; m < 4; ++m)
#pragma unroll
                for (int n = 0; n < 2; ++n) acc[a][b][m][n] = (f32x4){0.f, 0.f, 0.f, 0.f};
    bf16x8 At[4][2], B0[2][2], B1[2][2];
    const char* cA = (const char*)g.A + (size_t)cur.pm * tstep; const char* cB = (const char*)g.Bt + (size_t)cur.pn * tstep;
    S.a_ready(cur);
    if constexpr (SP2) {
        PG8_STAGE(PG8_SB(0, 0), cB, voffB); PG8_STAGE(PG8_SB(0, 1), cB + hstep, voffB); PG8_STAGE(PG8_SA(0, 0), cA, voffA); PG8_STAGE(PG8_SA(0, 1), cA + hstep, voffA);
        if (wr == 1) PG8_BAR;
        PG8_WAIT_V(2); PG8_BAR;
        PG8_STAGE(PG8_SB(1, 0), cB + kstep, voffB); PG8_STAGE(PG8_SA(1, 0), cA + kstep, voffA); PG8_STAGE(PG8_SB(1, 1), cB + hstep + kstep, voffB);
        PG8_WAIT_V(6); PG8_BAR;
    } else {
        PG8_STAGE(PG8_SB(0, 0), cB, voffB); PG8_STAGE(PG8_SA(0, 0), cA, voffA); PG8_STAGE(PG8_SB(0, 1), cB + hstep, voffB); PG8_STAGE(PG8_SA(0, 1), cA + hstep, voffA);
        if (wr == 1) PG8_BAR;
        PG8_WAIT_V(4); PG8_BAR;
        PG8_STAGE(PG8_SB(1, 0), cB + kstep, voffB); PG8_STAGE(PG8_SA(1, 0), cA + kstep, voffA); PG8_STAGE(PG8_SB(1, 1), cB + hstep + kstep, voffB);
        PG8_WAIT_V(6); PG8_BAR;
    }
    for (;;) {
        const bool has_next = S.next(ui + 1, nxt);
        const char* nA = has_next ? (const char*)g.A + (size_t)nxt.pm * tstep : cA; const char* nB = has_next ? (const char*)g.Bt + (size_t)nxt.pn * tstep : cB;
        for (int t = 0; t < nt; t += 2) {
            const bool last = (t == nt - 2);
            const char* a1 = cA + (size_t)(t + 1) * kstep;
            const char* a2 = last ? nA : cA + (size_t)(t + 2) * kstep; const char* b2 = last ? nB : cB + (size_t)(t + 2) * kstep;
            const char* a3 = a2 + kstep; const char* b3 = b2 + kstep;
            if (last && has_next) S.a_ready(nxt);
            if constexpr (SP2) {
            PG8_LDB(B0, 0, 0); PG8_LDB(B1, 0, 1); PG8_SCHED; PG8_LDA(At, 0, 0); PG8_STAGE(PG8_SA(1, 1), a1 + hstep, voffA);
            PG8_WAIT_V(8); PG8_WAIT_L(0); PG8_BAR; PG8_MMA(0, 0, At, B0); PG8_MMA(0, 1, At, B1); PG8_BAR; PG8_SCHED;
            PG8_LDA(At, 0, 1); PG8_STAGE(PG8_SB(0, 0), b2, voffB); PG8_STAGE(PG8_SB(0, 1), b2 + hstep, voffB); PG8_STAGE(PG8_SA(0, 0), a2, voffA);
            PG8_WAIT_V(8); PG8_WAIT_L(0); PG8_BAR; PG8_MMA(1, 0, At, B0); PG8_MMA(1, 1, At, B1); PG8_BAR; PG8_SCHED;
            PG8_LDB(B0, 1, 0); PG8_LDB(B1, 1, 1); PG8_SCHED; PG8_LDA(At, 1, 0); PG8_STAGE(PG8_SA(0, 1), a2 + hstep, voffA);
            PG8_WAIT_V(8); PG8_WAIT_L(0); PG8_BAR; PG8_MMA(0, 0, At, B0); PG8_MMA(0, 1, At, B1); PG8_BAR; PG8_SCHED;
            PG8_LDA(At, 1, 1); PG8_STAGE(PG8_SB(1, 0), b3, voffB); PG8_STAGE(PG8_SB(1, 1), b3 + hstep, voffB); PG8_STAGE(PG8_SA(1, 0), a3, voffA);
            PG8_WAIT_V(8); PG8_WAIT_L(0); PG8_BAR; PG8_MMA(1, 0, At, B0); PG8_MMA(1, 1, At, B1); PG8_BAR; PG8_SCHED;
            } else {
            PG8_LDB(B0, 0, 0); PG8_SCHED; PG8_LDA(At, 0, 0); PG8_STAGE(PG8_SA(1, 1), a1 + hstep, voffA);
            PG8_WAIT_L(8); PG8_BAR; PG8_WAIT_L(0); PG8_MMA(0, 0, At, B0); PG8_BAR; PG8_SCHED;
            PG8_LDB(B1, 0, 1); PG8_STAGE(PG8_SB(0, 0), b2, voffB);
            PG8_BAR; PG8_WAIT_L(0); PG8_MMA(0, 1, At, B1); PG8_BAR;
            PG8_LDA(At, 0, 1); PG8_STAGE(PG8_SA(0, 0), a2, voffA);
            PG8_BAR; PG8_WAIT_L(0); PG8_MMA(1, 0, At, B0); PG8_BAR; PG8_SCHED;
            PG8_STAGE(PG8_SB(0, 1), b2 + hstep, voffB);
            PG8_WAIT_V(6); PG8_BAR; PG8_MMA(1, 1, At, B1); PG8_BAR;
            PG8_LDB(B0, 1, 0); PG8_SCHED; PG8_LDA(At, 1, 0); PG8_STAGE(PG8_SA(0, 1), a2 + hstep, voffA);
            PG8_WAIT_L(8); PG8_BAR; PG8_WAIT_L(0); PG8_MMA(0, 0, At, B0); PG8_BAR; PG8_SCHED;
            PG8_LDB(B1, 1, 1); PG8_STAGE(PG8_SB(1, 0), b3, voffB);
            PG8_BAR; PG8_WAIT_L(0); PG8_MMA(0, 1, At, B1); PG8_BAR;
            PG8_LDA(At, 1, 1); PG8_STAGE(PG8_SA(1, 0), a3, voffA);
            PG8_BAR; PG8_WAIT_L(0); PG8_MMA(1, 0, At, B0); PG8_BAR; PG8_SCHED;
            PG8_STAGE(PG8_SB(1, 1), b3 + hstep, voffB);
            PG8_WAIT_V(6); PG8_BAR; PG8_MMA(1, 1, At, B1); PG8_BAR;
            }
        }
        if constexpr (ALIGN_EPI) { if (wr == 0) PG8_BAR; }
        if constexpr (!Epi::AFTER_DRAIN) { E(acc, cur, wr, wc, fr, fq); S.done(cur); }
        if (!has_next) break;
#pragma unroll
        for (int a = 0; a < 2; ++a)
#pragma unroll
            for (int b = 0; b < 2; ++b)
#pragma unroll
                for (int m = 0; m < 4; ++m)
#pragma unroll
                    for (int n = 0; n < 2; ++n) acc[a][b][m][n] = (f32x4){0.f, 0.f, 0.f, 0.f};
        cur = nxt; cA = nA; cB = nB; ++ui;
        if constexpr (ALIGN_EPI) { if (wr == 1) PG8_BAR; }
    }
    PG8_WAIT_V(0);
    if constexpr (!ALIGN_EPI) { if (wr == 0) PG8_BAR; }
    PG8_BAR;
#undef PG8_SA
#undef PG8_SB
#undef PG8_STAGE
#undef PG8_LDA
#undef PG8_LDB
#undef PG8_MMA
#undef PG8_WAIT_V
#undef PG8_WAIT_L
#undef PG8_BAR
#undef PG8_SCHED
}
}

#define XB_TMO      128
#define XB_XCNT(j)  (256  + 64 * (j))
#define XB_XSUB(j)  (1280 + 64 * (j))
#define XB_XGEN(j)  (2304 + 64 * (j))
#define XB_TOP      3328
#define XB_TOPGEN   3392
#define XCD_BAR_WORDS 3456
#define XB_SPIN_CAP (1u << 22)
__device__ __forceinline__ unsigned xb_ld(unsigned* p)              { return __hip_atomic_load(p, __ATOMIC_RELAXED, __HIP_MEMORY_SCOPE_AGENT); }
__device__ __forceinline__ unsigned xb_add(unsigned* p, unsigned v) { return __hip_atomic_fetch_add(p, v, __ATOMIC_RELAXED, __HIP_MEMORY_SCOPE_AGENT); }
__device__ __forceinline__ unsigned xb_xcc_id() { return (unsigned)__builtin_amdgcn_s_getreg((3 << 11) | 20) & 0xFu; }
#define XB_SPIN(cond, bar) do { unsigned _sp = 0; while (cond) { __builtin_amdgcn_s_sleep(1); \
    if ((++_sp & 255u) == 0u) { if (xb_ld(&(bar)[XB_TMO])) break; if (_sp > XB_SPIN_CAP) { atomicAdd(&(bar)[XB_TMO], 1u); break; } } } } while (0)
struct XcdBarrier { unsigned* bar; unsigned x; volatile LAS unsigned* st; };
__device__ __forceinline__ XcdBarrier xcd_barrier_post(unsigned* bar, volatile LAS unsigned* st) {
    XcdBarrier b; b.bar = bar; b.x = xb_xcc_id(); b.st = st;
    if (threadIdx.x == 0) (void)xb_add(&bar[XB_XCNT(b.x)], 1u);
    return b;
}
__device__ __forceinline__ void xcd_barrier_complete(unsigned* bar, unsigned x, unsigned& nloc, unsigned& nx) {
    const unsigned G = gridDim.x * gridDim.y * gridDim.z;
    unsigned sum, cnt, mine, sp = 0u;
    for (;;) {
        sum = 0u; cnt = 0u; mine = 0u;
#pragma unroll
        for (unsigned j = 0; j < 16; ++j) { const unsigned c = xb_ld(&bar[XB_XCNT(j)]); sum += c; cnt += (c > 0u) ? 1u : 0u; mine = (j == x) ? c : mine; }
        if (sum == G) break;
        __builtin_amdgcn_s_sleep(1);
        if ((++sp & 255u) == 0u) { if (xb_ld(&bar[XB_TMO])) break; if (sp > XB_SPIN_CAP) { atomicAdd(&bar[XB_TMO], 1u); break; } }
    }
    nloc = mine > 0u ? mine : 1u; nx = cnt > 0u ? cnt : 1u;
}
__device__ __forceinline__ void xcd_barrier(const XcdBarrier& b) {
    asm volatile("s_waitcnt vmcnt(0)" ::: "memory");
    __syncthreads();
    if (threadIdx.x == 0) {
        unsigned* bar = b.bar;
        __builtin_amdgcn_s_waitcnt(0);
        unsigned nloc = b.st[0], nx = b.st[1];
        if (nloc == 0u) { xcd_barrier_complete(bar, b.x, nloc, nx); b.st[0] = nloc; b.st[1] = nx; }
        const unsigned old = xb_add(&bar[XB_XSUB(b.x)], 1u);
        const unsigned gen = old / nloc;
        if (old + 1u == (gen + 1u) * nloc) {
            __builtin_amdgcn_fence(__ATOMIC_RELEASE, "agent");
            asm volatile("s_waitcnt vmcnt(0)" ::: "memory");
            const unsigned og = xb_add(&bar[XB_TOP], 1u);
            const unsigned tg = og / nx;
            if (og + 1u == (tg + 1u) * nx) xb_add(&bar[XB_TOPGEN], 1u);
            else XB_SPIN(xb_ld(&bar[XB_TOPGEN]) == tg, bar);
            __builtin_amdgcn_fence(__ATOMIC_ACQUIRE, "agent");
            xb_add(&bar[XB_XGEN(b.x)], 1u);
            asm volatile("s_waitcnt vmcnt(0)" ::: "memory");
        } else {
            XB_SPIN(xb_ld(&bar[XB_XGEN(b.x)]) == gen, bar);
            __builtin_amdgcn_fence(__ATOMIC_ACQUIRE, "agent");
            asm volatile("s_waitcnt vmcnt(0)" ::: "memory");
        }
    }
    __syncthreads();
}

constexpr int RING_OFF = 0, RING_BYTES = 131072;
constexpr int LDSCTL_OFF = 162816, MISC_OFF = LDSCTL_OFF + 320;
constexpr int LDS_BYTES = 163840;

struct Frame {
    LAS unsigned char* lds;
    volatile LAS unsigned* MISC;
    gu32* ctl;
    int tid, lane, wave, G, wg;
    const float* in[21];
    float* out;
    unsigned char* ws;
};

__device__ __forceinline__ void p0_transpose_item(const float* W, int K, int N, bf16* WT, LAS float* scr, int item, int lane) {
    const int nblk = N / 32, kb = item / nblk, nb = item % nblk, k0 = 64 * kb, n0 = 32 * nb;
#pragma unroll 8
    for (int i = 0; i < 32; ++i) { const int kk = 2 * i + (lane >> 5); scr[kk * 33 + (lane & 31)] = W[(size_t)(k0 + kk) * N + n0 + (lane & 31)]; }
    LDS_WAIT(); asm volatile("" ::: "memory");
    const int c = lane & 7;
#pragma unroll
    for (int j = 0; j < 4; ++j) { const int n = (lane >> 3) + 8 * j; const LAS float* s = scr + (8 * c) * 33 + n;
        v4u o; o.x = pk2(s[0 * 33], s[1 * 33]); o.y = pk2(s[2 * 33], s[3 * 33]); o.z = pk2(s[4 * 33], s[5 * 33]); o.w = pk2(s[6 * 33], s[7 * 33]);
        *(GAS v4u*)(WT + (size_t)(n0 + n) * K + k0 + 8 * c) = o; }
    LDS_WAIT(); asm volatile("" ::: "memory");
}
__device__ __forceinline__ void rms_row_to_bf16(int lane, const float* xrow, const float* gain, bf16* orow) {
    const GAS f32x4* xr = (const GAS f32x4*)xrow + lane;
    const GAS f32x4* gr = (const GAS f32x4*)gain + lane;
    f32x4 v[4]; float s = 0.f;
#pragma unroll
    for (int j = 0; j < 4; ++j) { v[j] = xr[64 * j]; s += (v[j].x * v[j].x + v[j].y * v[j].y) + (v[j].z * v[j].z + v[j].w * v[j].w); }
    const float rstd = 1.f / sqrtf(wave_sum(s) * (1.f / DM) + RMS_EPS);
    GAS unsigned long long* o8 = (GAS unsigned long long*)orow + lane;
#pragma unroll
    for (int j = 0; j < 4; ++j) { const f32x4 gg = gr[64 * j];
        o8[64 * j] = (unsigned long long)pk2(v[j].x * rstd * gg.x, v[j].y * rstd * gg.y) | ((unsigned long long)pk2(v[j].z * rstd * gg.z, v[j].w * rstd * gg.w) << 32); }
}
__device__ __forceinline__ void cvt_row_to_bf16(int lane, const float* xrow, bf16* orow) {
    const GAS f32x4* xr = (const GAS f32x4*)xrow + lane;
    GAS unsigned long long* o8 = (GAS unsigned long long*)orow + lane;
#pragma unroll
    for (int j = 0; j < 4; ++j) { const f32x4 v = xr[64 * j]; o8[64 * j] = (unsigned long long)pk2(v.x, v.y) | ((unsigned long long)pk2(v.z, v.w) << 32); }
}
__device__ __forceinline__ void p0_prologue(Frame& F) {
    LAS float* scr = (LAS float*)(F.lds + RING_OFF + F.wave * 16384);
    const int gw = F.wg * NWAVES + F.wave, NGW = F.G * NWAVES;
    constexpr int I_IN = (DM / 64) * (IN_COLS / 32), I_OUT = (DM / 64) * (DM / 32), I_Q = (DM / 64) * (PQ / 32);
    constexpr int NITEMS = I_IN + I_OUT + I_Q;
    bf16* win_t = (bf16*)(F.ws + WS_WIN); bf16* wout_t = (bf16*)(F.ws + WS_WOUT); bf16* wq_t = (bf16*)(F.ws + WS_WQ);
    for (int it = gw; it < NITEMS; it += NGW) {
        int r = it;
        if (r < I_IN) { p0_transpose_item(F.in[2], DM, IN_COLS, win_t, scr, r, F.lane); continue; } r -= I_IN;
        if (r < I_OUT) { p0_transpose_item(F.in[14], DM, DM, wout_t, scr, r, F.lane); continue; } r -= I_OUT;
        p0_transpose_item(F.in[16], DM, PQ, wq_t, scr, r, F.lane);
    }
    {
        constexpr int I_W = (64 / 64) * (RWW / 32), I_G = (128 / 64) * (RWW / 32);
        for (int it = gw; it < 2 * I_W + I_G; it += NGW) {
            int r = it;
            if (r < I_W) { p0_transpose_item(F.in[5], 64, RWW, (bf16*)(F.ws + WS_WUPT), scr, r, F.lane); continue; } r -= I_W;
            if (r < I_W) { p0_transpose_item(F.in[7], 64, RWW, (bf16*)(F.ws + WS_AUPT), scr, r, F.lane); continue; } r -= I_W;
            p0_transpose_item(F.in[8], 128, RWW, (bf16*)(F.ws + WS_GUPT), scr, r, F.lane);
        }
    }
    bf16* XN = (bf16*)(F.ws + WS_XN);
    for (int m = gw; m < T; m += NGW) rms_row_to_bf16(F.lane, F.in[0] + (size_t)m * DM, F.in[1], XN + (size_t)m * DM);
    for (int m = gw; m < 2 * NEXP; m += NGW) {
        const int tab = m >= NEXP, row = tab ? m - NEXP : m;
        const GAS f32x4* xr = (const GAS f32x4*)(F.in[18 + tab] + (size_t)row * DM) + F.lane * 4;
        f32x4 v[4]; float am = 0.f;
#pragma unroll
        for (int j = 0; j < 4; ++j) { v[j] = xr[j]; am = fmaxf(am, fmaxf(fmaxf(fabsf(v[j].x), fabsf(v[j].y)), fmaxf(fabsf(v[j].z), fabsf(v[j].w)))); }
        am = wave_max(am);
        const float sc = am > 0.f ? am * (1.f / 127.f) : 1.f, inv = am > 0.f ? 127.f / am : 0.f;
        v4u o;
#pragma unroll
        for (int j = 0; j < 4; ++j) {
            const int bias = tab ? 128 : 0;
            const unsigned b0 = (unsigned)((int)rintf(v[j].x * inv) + bias) & 255u, b1 = (unsigned)((int)rintf(v[j].y * inv) + bias) & 255u,
                           b2 = (unsigned)((int)rintf(v[j].z * inv) + bias) & 255u, b3 = (unsigned)((int)rintf(v[j].w * inv) + bias) & 255u;
            o[j] = b0 | (b1 << 8) | (b2 << 16) | (b3 << 24); }
        *(GAS v4u*)(F.ws + (tab ? WS_VQ : WS_UQ) + (size_t)row * DM + F.lane * 16) = o;
        if (F.lane == 0) ((float*)(F.ws + (tab ? WS_SV : WS_SU)))[row] = sc;
    }
}

__device__ __forceinline__ void p2_rope(Frame& F) {
    bf16* Z = (bf16*)(F.ws + WS_Z);
    const int tid = F.tid, i = tid & 31, grp = tid >> 5;
    const float inv_freq = powf(10000.0f, -(float)(2 * i) / 64.0f);
    for (int blk = F.wg; blk < T / 16; blk += F.G) {
        for (int k = 0; k < 16; ++k) { const int g = blk * 16 + k, s = g & (SEQ - 1);
            const float ang = (float)s * inv_freq;
            const double r = (double)ang - rint((double)ang * 0.15915494309189535) * 6.283185307179586;
            const float rf = (float)r; const float cs = cosf(rf), sn = sinf(rf);
            bf16* p = Z + (size_t)g * IN_COLS + C_AQ + grp * 64 + i;
            const float x1 = bf2f(p[0]), x2 = bf2f(p[32]);
            p[0] = (bf16)f2bf(x1 * cs - x2 * sn); p[32] = (bf16)f2bf(x1 * sn + x2 * cs); }
    }
}

typedef float f32x16 __attribute__((ext_vector_type(16)));
constexpr int SBS = 144;
constexpr int R1_EPRE = 0, R1_APRE = 16384, R1_AAB = 0, R1_X = 16384;
constexpr int R1_AT = 32768, R1_BT = 41984, R1_KT = 51200, R1_RT = 60416, R1_AHT = R1_BT, R1_U0T = R1_KT;
constexpr int R1_BBT = 69632, R1_KBT = 78848, R1_VT = 88064;
constexpr int R1_ACTW = 97280, R1_ACTA = 106496, R1_AAK = 97280, R1_ARB = 106496, R1_ARK = 115712;
constexpr int R1_BONUS = 124928, R1_WEND = 125184, R1_SEGS = 125440, R1_TII = 125440, R1_END = 129536;
static_assert(R1_END <= LDSCTL_OFF, "R1 LDS");
__device__ __forceinline__ int crow(int r, int hh) { return (r & 3) + 8 * (r >> 2) + 4 * hh; }
template <int KS> __device__ __forceinline__ f32x16 wtile(const LAS unsigned char* A, int sa, const LAS unsigned char* B, int sb, f32x16 acc, int lane) {
    const int row = lane & 31, hh = lane >> 5;
#pragma unroll
    for (int s = 0; s < KS; ++s) { const bf16x8 a = *(const LAS bf16x8*)(A + row * sa + 32 * s + 16 * hh); const bf16x8 b = *(const LAS bf16x8*)(B + row * sb + 32 * s + 16 * hh);
        acc = __builtin_amdgcn_mfma_f32_32x32x16_bf16(a, b, acc, 0, 0, 0); }
    return acc;
}
template <int KS> __device__ __forceinline__ f32x16 wtile_gb(const LAS unsigned char* A, int sa, const bf16* Bg, int ldb, f32x16 acc, int lane) {
    const int row = lane & 31, hh = lane >> 5;
#pragma unroll
    for (int s = 0; s < KS; ++s) { const bf16x8 a = *(const LAS bf16x8*)(A + row * sa + 32 * s + 16 * hh); const bf16x8 b = *(const GAS bf16x8*)(Bg + (size_t)row * ldb + 16 * s + 8 * hh);
        acc = __builtin_amdgcn_mfma_f32_32x32x16_bf16(a, b, acc, 0, 0, 0); }
    return acc;
}
__device__ __forceinline__ f32x16 zero16() { f32x16 z;
#pragma unroll
    for (int r = 0; r < 16; ++r) z[r] = 0.f;
    return z; }

struct R1Pre { v4u wd[2], ad[2], z[4]; };
__device__ __forceinline__ int r13_item(int wg, int G, int idx) { return G == 256 ? ((wg >> 3) * 128 + (wg & 7) + 8 * idx) : (wg + G * idx); }
__device__ __forceinline__ int r13_count(int wg, int G) { return G == 256 ? 16 : ((NB * NHR * 128 - wg + G - 1) / G); }
__device__ __forceinline__ void rwkv_r1_prefetch(Frame& F, int item, int tid, R1Pre& P) {
    const int chain = item >> 7, chunk = item & 127, b = chain >> 3, h = chain & 7, g0 = b * SEQ + chunk * 64;
    const bf16* Z = (const bf16*)(F.ws + WS_Z);
    const v4u z0 = (v4u){0u, 0u, 0u, 0u};
    { const int t = tid >> 3, cg = tid & 7; const bool first = (chunk == 0 && t == 0);
      const bf16* zr = Z + (size_t)(g0 + t) * IN_COLS;
      P.wd[0] = *(const GAS v4u*)(zr + C_WD + cg * 8); P.ad[0] = *(const GAS v4u*)(zr + C_AD + cg * 8);
      P.wd[1] = z0; P.ad[1] = z0;
      if (!first) { P.wd[1] = *(const GAS v4u*)(zr - IN_COLS + C_WD + cg * 8); P.ad[1] = *(const GAS v4u*)(zr - IN_COLS + C_AD + cg * 8); } }
#pragma unroll
    for (int q = 0; q < 4; ++q) { const int p = tid + 512 * q; P.z[q] = z0;
        if (p < 65 * 24) { const int row = p / 24, rem = p - row * 24, seg = rem >> 3, ch = rem & 7;
            if (!(chunk == 0 && row == 0)) P.z[q] = *(const GAS v4u*)(Z + (size_t)(g0 - 1 + row) * IN_COLS + seg * 512 + h * 64 + ch * 8); } }
}
constexpr int R1_ZS = R1_AT, R1_ZSS = 384;
static_assert(65 * R1_ZSS <= 4 * 9216, "ZS fits in the At..Rt region");
__device__ __forceinline__ void rwkv_r1_item(Frame& F, int item, int next_item, R1Pre& P) {
    const int chain = item >> 7, chunk = item & 127, b = chain >> 3, h = chain & 7;
    const int g0 = b * SEQ + chunk * 64;
    int tid_ = F.tid; asm volatile("" : "+v"(tid_));
    const int tid = tid_, lane = tid & 63, w = __builtin_amdgcn_readfirstlane(tid >> 6), hh = lane >> 5, cl = lane & 31;
    const bf16* Z = (const bf16*)(F.ws + WS_Z);
    LAS unsigned char* lds = F.lds + RING_OFF;
    const float* mu = F.in[3];
    {
        const int t = tid >> 3, cg = tid & 7;
        const v4u cw = P.wd[0], ca = P.ad[0], pw = P.wd[1], pa = P.ad[1];
        float fw[8], fa[8], qw[8], qa[8];
        fw[0] = bflo(cw.x); fw[1] = bfhi(cw.x); fw[2] = bflo(cw.y); fw[3] = bfhi(cw.y); fw[4] = bflo(cw.z); fw[5] = bfhi(cw.z); fw[6] = bflo(cw.w); fw[7] = bfhi(cw.w);
        fa[0] = bflo(ca.x); fa[1] = bfhi(ca.x); fa[2] = bflo(ca.y); fa[3] = bfhi(ca.y); fa[4] = bflo(ca.z); fa[5] = bfhi(ca.z); fa[6] = bflo(ca.w); fa[7] = bfhi(ca.w);
        qw[0] = bflo(pw.x); qw[1] = bfhi(pw.x); qw[2] = bflo(pw.y); qw[3] = bfhi(pw.y); qw[4] = bflo(pw.z); qw[5] = bfhi(pw.z); qw[6] = bflo(pw.w); qw[7] = bfhi(pw.w);
        qa[0] = bflo(pa.x); qa[1] = bfhi(pa.x); qa[2] = bflo(pa.y); qa[3] = bfhi(pa.y); qa[4] = bflo(pa.z); qa[5] = bfhi(pa.z); qa[6] = bflo(pa.w); qa[7] = bfhi(pa.w);
#pragma unroll
        for (int j = 0; j < 8; ++j) { const int c = cg * 8 + j; const float xw = fw[j] + (qw[j] - fw[j]) * mu[C_WD + c];
            const float ex = __expf(2.f * xw); fw[j] = 1.f - 2.f / (ex + 1.f);
            fa[j] = fa[j] + (qa[j] - fa[j]) * mu[C_AD + c]; }
        v4u ow, oa; ow.x = pk2(fw[0], fw[1]); ow.y = pk2(fw[2], fw[3]); ow.z = pk2(fw[4], fw[5]); ow.w = pk2(fw[6], fw[7]);
        oa.x = pk2(fa[0], fa[1]); oa.y = pk2(fa[2], fa[3]); oa.z = pk2(fa[4], fa[5]); oa.w = pk2(fa[6], fa[7]);
        *(LAS v4u*)(lds + R1_ACTW + t * SBS + cg * 16) = ow; *(LAS v4u*)(lds + R1_ACTA + t * SBS + cg * 16) = oa;
#pragma unroll
        for (int q = 0; q < 4; ++q) { const int p = tid + 512 * q;
            if (p < 65 * 24) { const int row = p / 24, rem = p - row * 24; *(LAS v4u*)(lds + R1_ZS + row * R1_ZSS + rem * 16) = P.z[q]; } }
        if (next_item >= 0) rwkv_r1_prefetch(F, next_item, tid, P);
    }
    __syncthreads();
    {
        const int p = w >> 2, mt = (w >> 1) & 1, nt = w & 1;
        const bf16* upt = (const bf16*)(F.ws + (p == 0 ? WS_WUPT : WS_AUPT)) + (size_t)(h * 64 + nt * 32) * 64;
        const f32x16 acc = wtile_gb<4>(lds + (p == 0 ? R1_ACTW : R1_ACTA) + mt * 32 * SBS, SBS, upt, 64, zero16(), lane);
        LAS float* O = (LAS float*)(lds + (p == 0 ? R1_EPRE : R1_APRE));
#pragma unroll
        for (int r = 0; r < 16; ++r) O[(mt * 32 + crow(r, hh)) * 64 + nt * 32 + cl] = acc[r];
    }
    __syncthreads();
    {
        const int c = tid & 63, ts = tid >> 6, col = h * 64 + c;
        const float mu_r = mu[C_R + col], mu_k = mu[C_K + col], mu_v = mu[C_V + col], kkc = F.in[9][col], kac = F.in[10][col], rkc = F.in[11][col], w0c = F.in[4][col], a0c = F.in[6][col];
        const LAS float* EP = (const LAS float*)(lds + R1_EPRE); const LAS float* AP = (const LAS float*)(lds + R1_APRE);
        LAS float* SEGS = (LAS float*)(lds + R1_SEGS); LAS float* BON = (LAS float*)(lds + R1_BONUS);
        const LAS bf16* zb = (const LAS bf16*)(lds + R1_ZS + (8 * ts) * R1_ZSS) + c;
        float pr = bf2f(zb[0]), pk = bf2f(zb[64]), pv = bf2f(zb[128]);
        float rr[8], k2[8], ai[8], bi[8], vv[8], ee[8], cs[8]; float run = 0.f;
#pragma unroll
        for (int i = 0; i < 8; ++i) {
            const float zr = bf2f(zb[(i + 1) * (R1_ZSS / 2)]), zk = bf2f(zb[(i + 1) * (R1_ZSS / 2) + 64]), zv = bf2f(zb[(i + 1) * (R1_ZSS / 2) + 128]);
            const float r = zr + (pr - zr) * mu_r, k = zk + (pk - zk) * mu_k, v = zv + (pv - zv) * mu_v; pr = zr; pk = zk; pv = zv;
            const float e = 0.60653066f / (1.f + __expf(-(w0c + EP[(8 * ts + i) * 64 + c])));
            const float a = 1.f / (1.f + __expf(-(a0c + AP[(8 * ts + i) * 64 + c])));
            float kk = k * kkc; const float n2 = wave_sum(kk * kk); kk = kk / fmaxf(sqrtf(n2), 1e-12f);
            const float kq = k * (1.f + (a - 1.f) * kac);
            const float bon = wave_sum(r * kq * rkc); if (c == 0) BON[8 * ts + i] = bon;
            rr[i] = r; k2[i] = kq; ai[i] = -kk; bi[i] = kk * a; vv[i] = v; ee[i] = e; run += e; cs[i] = run;
        }
        SEGS[ts * 64 + c] = run;
        __syncthreads();
        float off = 0.f, tot = 0.f;
#pragma unroll
        for (int q = 0; q < 8; ++q) { const float sv = SEGS[q * 64 + c]; tot += sv; off += (q < ts) ? sv : 0.f; }
        float bb[8], kb[8];
#pragma unroll
        for (int i = 0; i < 8; ++i) { const float L = off + cs[i];
            const float Wm = __expf(-(L - ee[i])), Wi = __expf(-L), iW = __expf(L), We = __expf(-(tot - L));
            const int t = 8 * ts + i;
            *(LAS bf16*)(lds + R1_AT + t * SBS + c * 2) = (bf16)f2bf(ai[i] * Wm);
            *(LAS bf16*)(lds + R1_BT + t * SBS + c * 2) = (bf16)f2bf(bi[i] * iW);
            *(LAS bf16*)(lds + R1_KT + t * SBS + c * 2) = (bf16)f2bf(k2[i] * iW);
            *(LAS bf16*)(lds + R1_RT + t * SBS + c * 2) = (bf16)f2bf(rr[i] * Wi);
            bb[i] = bi[i] * We; kb[i] = k2[i] * We; }
        v4u o; o.x = pk2(bb[0], bb[1]); o.y = pk2(bb[2], bb[3]); o.z = pk2(bb[4], bb[5]); o.w = pk2(bb[6], bb[7]);
        *(LAS v4u*)(lds + R1_BBT + c * SBS + ts * 16) = o;
        o.x = pk2(kb[0], kb[1]); o.y = pk2(kb[2], kb[3]); o.z = pk2(kb[4], kb[5]); o.w = pk2(kb[6], kb[7]);
        *(LAS v4u*)(lds + R1_KBT + c * SBS + ts * 16) = o;
        o.x = pk2(vv[0], vv[1]); o.y = pk2(vv[2], vv[3]); o.z = pk2(vv[4], vv[5]); o.w = pk2(vv[6], vv[7]);
        *(LAS v4u*)(lds + R1_VT + c * SBS + ts * 16) = o;
        if (ts == 0) ((LAS float*)(lds + R1_WEND))[c] = __expf(-tot);
    }
    __syncthreads();
#pragma unroll
    for (int u = 0; u < 2; ++u) {
        const int idx = w * 2 + u, p = idx >> 2, mt = (idx >> 1) & 1, nt = idx & 1;
        const LAS unsigned char* Aop = lds + ((p == 0 || p == 2) ? R1_BT : R1_KT) + mt * 32 * SBS;
        const LAS unsigned char* Bop = lds + (p < 2 ? R1_AT : R1_RT) + nt * 32 * SBS;
        f32x16 acc = wtile<4>(Aop, SBS, Bop, SBS, zero16(), lane);
        const int n = nt * 32 + cl;
#pragma unroll
        for (int r = 0; r < 16; ++r) { const int m = mt * 32 + crow(r, hh); const bool keep = (p < 2) ? (m < n) : (m <= n); acc[r] = keep ? acc[r] : 0.f; }
#pragma unroll
        for (int g4 = 0; g4 < 4; ++g4) { const int m0 = mt * 32 + 8 * g4 + 4 * hh;
            if (p == 0) *(LAS f32x4*)(lds + R1_AAB + (n * 64 + m0) * 4) = (f32x4){acc[4 * g4], acc[4 * g4 + 1], acc[4 * g4 + 2], acc[4 * g4 + 3]};
            else { v2u o; o.x = pk2(acc[4 * g4], acc[4 * g4 + 1]); o.y = pk2(acc[4 * g4 + 2], acc[4 * g4 + 3]);
                   *(LAS v2u*)(lds + (p == 1 ? R1_AAK : (p == 2 ? R1_ARB : R1_ARK)) + n * SBS + m0 * 2) = o; } }
    }
    __syncthreads();
    if (w < 4) {
        const int mt = w >> 1, nt = w & 1;
        const f32x16 acc = wtile<4>(lds + R1_AAK + mt * 32 * SBS, SBS, lds + R1_VT + nt * 32 * SBS, SBS, zero16(), lane);
        LAS float* X = (LAS float*)(lds + R1_X);
#pragma unroll
        for (int r = 0; r < 16; ++r) X[(mt * 32 + crow(r, hh)) * 64 + nt * 32 + cl] = acc[r];
    } else if (w == 4) {
        const int bk = lane >> 4, c = lane & 15;
        const LAS float* AAB = (const LAS float*)(lds + R1_AAB);
        float Tc[16]; const float fc = (float)c;
#pragma unroll
        for (int s2 = 0; s2 < 16; ++s2) Tc[s2] = fmaxf(0.f, 1.f - fabsf((float)s2 - fc));
#pragma unroll
        for (int r = 0; r < 15; ++r)
#pragma unroll
            for (int s2 = r + 1; s2 < 16; ++s2) Tc[s2] += AAB[(16 * bk + s2) * 64 + 16 * bk + r] * Tc[r];
        LAS float* TII = (LAS float*)(lds + R1_TII);
#pragma unroll
        for (int s2 = 0; s2 < 16; ++s2) TII[(bk * 16 + s2) * 16 + c] = Tc[s2];
    }
    __syncthreads();
    {
        const int c16 = lane & 15, g = lane >> 4;
        const LAS float* AAB = (const LAS float*)(lds + R1_AAB); const LAS float* TII = (const LAS float*)(lds + R1_TII); const LAS float* X = (const LAS float*)(lds + R1_X);
        f32x4 o[4];
#pragma unroll
        for (int i = 0; i < 4; ++i) {
            f32x4 acc;
            if (w < 4) {
#pragma unroll
                for (int q = 0; q < 4; ++q) acc[q] = bf2f(*(const LAS bf16*)(lds + R1_AT + (16 * i + 4 * g + q) * SBS + (16 * w + c16) * 2));
            } else {
#pragma unroll
                for (int q = 0; q < 4; ++q) acc[q] = X[(16 * i + 4 * g + q) * 64 + 16 * (w - 4) + c16];
            }
#pragma unroll
            for (int j = 0; j < i; ++j) { const f32x4 a4 = *(const LAS f32x4*)(AAB + (16 * i + c16) * 64 + 16 * j + 4 * g);
#pragma unroll
                for (int q = 0; q < 4; ++q) acc = __builtin_amdgcn_mfma_f32_16x16x4f32(a4[q], o[j][q], acc, 0, 0, 0); }
            const f32x4 t4 = *(const LAS f32x4*)(TII + (i * 16 + c16) * 16 + 4 * g);
            f32x4 res = (f32x4){0.f, 0.f, 0.f, 0.f};
#pragma unroll
            for (int q = 0; q < 4; ++q) res = __builtin_amdgcn_mfma_f32_16x16x4f32(t4[q], acc[q], res, 0, 0, 0);
            o[i] = res;
            v2u ov; ov.x = pk2(res[0], res[1]); ov.y = pk2(res[2], res[3]);
            *(LAS v2u*)(lds + (w < 4 ? R1_AHT : R1_U0T) + (16 * (w & 3) + c16) * SBS + (16 * i + 4 * g) * 2) = ov;
        }
    }
    __syncthreads();
    {
        float* Mg = F.out + (size_t)item * 4096; float* NTg = F.out + (size_t)T * RWW + (size_t)item * 4096;
        float* Y0g = (float*)(F.ws + WS_RWY0) + (size_t)item * 4096; bf16* RHg = (bf16*)(F.ws + WS_RWRH) + (size_t)item * 4096;
#pragma unroll
        for (int u = 0; u < 2; ++u) {
            const int idx = w * 2 + u, p = idx >> 2, mt = (idx >> 1) & 1, nt = idx & 1; const int n = nt * 32 + cl;
            if (p == 0) {
                f32x16 acc = wtile<4>(lds + R1_BBT + mt * 32 * SBS, SBS, lds + R1_AHT + nt * 32 * SBS, SBS, zero16(), lane);
                const LAS float* WE = (const LAS float*)(lds + R1_WEND);
#pragma unroll
                for (int r = 0; r < 16; ++r) { const int m = mt * 32 + crow(r, hh); Mg[m * 64 + n] = acc[r] + (m == n ? WE[m] : 0.f); }
            } else if (p == 1) {
                f32x16 acc = wtile<4>(lds + R1_U0T + mt * 32 * SBS, SBS, lds + R1_BBT + nt * 32 * SBS, SBS, zero16(), lane);
                acc = wtile<4>(lds + R1_VT + mt * 32 * SBS, SBS, lds + R1_KBT + nt * 32 * SBS, SBS, acc, lane);
#pragma unroll
                for (int r = 0; r < 16; ++r) NTg[(mt * 32 + crow(r, hh)) * 64 + n] = acc[r];
            } else if (p == 2) {
                f32x16 acc = wtile<4>(lds + R1_AHT + mt * 32 * SBS, SBS, lds + R1_ARB + nt * 32 * SBS, SBS, zero16(), lane);
#pragma unroll
                for (int g4 = 0; g4 < 4; ++g4) { const int m0 = mt * 32 + 8 * g4 + 4 * hh;
                    const v2u rt = *(const LAS v2u*)(lds + R1_RT + n * SBS + m0 * 2);
                    v2u ov; ov.x = pk2(acc[4 * g4] + bflo(rt.x), acc[4 * g4 + 1] + bfhi(rt.x)); ov.y = pk2(acc[4 * g4 + 2] + bflo(rt.y), acc[4 * g4 + 3] + bfhi(rt.y));
                    *(GAS v2u*)(RHg + n * 64 + m0) = ov; }
            } else {
                f32x16 acc = wtile<4>(lds + R1_ARB + mt * 32 * SBS, SBS, lds + R1_U0T + nt * 32 * SBS, SBS, zero16(), lane);
                acc = wtile<4>(lds + R1_ARK + mt * 32 * SBS, SBS, lds + R1_VT + nt * 32 * SBS, SBS, acc, lane);
#pragma unroll
                for (int r = 0; r < 16; ++r) Y0g[(mt * 32 + crow(r, hh)) * 64 + n] = acc[r];
            }
        }
        if (tid < 64) ((float*)(F.ws + WS_BONUS))[(size_t)item * 64 + tid] = ((const LAS float*)(lds + R1_BONUS))[tid];
    }
    __syncthreads();
}

__device__ __forceinline__ void rwkv_r2_chain(Frame& F, int chain) {
    const int w = F.wave; if (w >= 4) return;
    const int lane = F.lane, n16 = lane & 15, g = lane >> 4;
    const float* Mg = F.out + (size_t)chain * 128 * 4096; const float* NTg = F.out + (size_t)T * RWW + (size_t)chain * 128 * 4096;
    float* SSg = (float*)(F.ws + WS_RWSS) + (size_t)chain * 128 * 4096;
    f32x4 st[4];
#pragma unroll
    for (int rt = 0; rt < 4; ++rt) st[rt] = (f32x4){0.f, 0.f, 0.f, 0.f};
    f32x4 ma[4][4], nv[4];
#pragma unroll
    for (int rt = 0; rt < 4; ++rt) {
#pragma unroll
        for (int kt = 0; kt < 4; ++kt) ma[rt][kt] = *(const GAS f32x4*)(Mg + (16 * rt + n16) * 64 + 16 * kt + 4 * g);
        nv[rt] = *(const GAS f32x4*)(NTg + (16 * w + n16) * 64 + 16 * rt + 4 * g); }
    for (int c = 0; c < 128; ++c) {
#pragma unroll
        for (int rt = 0; rt < 4; ++rt) *(GAS f32x4*)(SSg + (size_t)c * 4096 + (16 * w + n16) * 64 + 16 * rt + 4 * g) = st[rt];
        if (c == 127) break;
        f32x4 nw[4];
#pragma unroll
        for (int rt = 0; rt < 4; ++rt) { f32x4 acc = nv[rt];
#pragma unroll
            for (int kt = 0; kt < 4; ++kt)
#pragma unroll
                for (int q = 0; q < 4; ++q) acc = __builtin_amdgcn_mfma_f32_16x16x4f32(ma[rt][kt][q], st[kt][q], acc, 0, 0, 0);
            nw[rt] = acc; }
        const float* Mn = Mg + (size_t)(c + 1) * 4096; const float* Nn = NTg + (size_t)(c + 1) * 4096;
#pragma unroll
        for (int rt = 0; rt < 4; ++rt) {
#pragma unroll
            for (int kt = 0; kt < 4; ++kt) ma[rt][kt] = *(const GAS f32x4*)(Mn + (16 * rt + n16) * 64 + 16 * kt + 4 * g);
            nv[rt] = *(const GAS f32x4*)(Nn + (16 * w + n16) * 64 + 16 * rt + 4 * g); }
#pragma unroll
        for (int rt = 0; rt < 4; ++rt) st[rt] = nw[rt];
    }
}

constexpr int R3_RH = 0, R3_S = 9216, R3_SG = 18432, R3_SGS = 272, R3_YL = R3_SG + 64 * R3_SGS, R3_GL = R3_YL + 16384, R3_END = R3_GL + 16384;
static_assert(R3_END <= LDSCTL_OFF, "R3 LDS");
__device__ __forceinline__ void rwkv_r3_item(Frame& F, int item) {
    const int chain = item >> 7, chunk = item & 127, b = chain >> 3, h = chain & 7;
    const int g0 = b * SEQ + chunk * 64;
    int tid_ = F.tid; asm volatile("" : "+v"(tid_));
    const int tid = tid_, lane = tid & 63, w = __builtin_amdgcn_readfirstlane(tid >> 6), hh = lane >> 5, cl = lane & 31;
    const bf16* Z = (const bf16*)(F.ws + WS_Z);
    LAS unsigned char* lds = F.lds + RING_OFF;
    const float* mu = F.in[3];
    {
        const int t = tid >> 3, cg = tid & 7;
        const bf16* RHg = (const bf16*)(F.ws + WS_RWRH) + (size_t)item * 4096;
        *(LAS v4u*)(lds + R3_RH + t * SBS + cg * 16) = *(const GAS v4u*)(RHg + t * 64 + cg * 8);
        const float* SSg = (const float*)(F.ws + WS_RWSS) + (size_t)item * 4096;
        const f32x4 s0 = *(const GAS f32x4*)(SSg + t * 64 + cg * 8), s1 = *(const GAS f32x4*)(SSg + t * 64 + cg * 8 + 4);
        v4u o; o.x = pk2(s0[0], s0[1]); o.y = pk2(s0[2], s0[3]); o.z = pk2(s1[0], s1[1]); o.w = pk2(s1[2], s1[3]);
        *(LAS v4u*)(lds + R3_S + t * SBS + cg * 16) = o;
        const bool first = (chunk == 0 && t == 0);
        const bf16* zr = Z + (size_t)(g0 + t) * IN_COLS + C_GD + cg * 16;
#pragma unroll
        for (int q = 0; q < 2; ++q) {
            const v4u cw = *(const GAS v4u*)(zr + q * 8); v4u pw = (v4u){0u, 0u, 0u, 0u};
            if (!first) pw = *(const GAS v4u*)(zr - IN_COLS + q * 8);
            float fw[8], qw[8];
            fw[0] = bflo(cw.x); fw[1] = bfhi(cw.x); fw[2] = bflo(cw.y); fw[3] = bfhi(cw.y); fw[4] = bflo(cw.z); fw[5] = bfhi(cw.z); fw[6] = bflo(cw.w); fw[7] = bfhi(cw.w);
            qw[0] = bflo(pw.x); qw[1] = bfhi(pw.x); qw[2] = bflo(pw.y); qw[3] = bfhi(pw.y); qw[4] = bflo(pw.z); qw[5] = bfhi(pw.z); qw[6] = bflo(pw.w); qw[7] = bfhi(pw.w);
#pragma unroll
            for (int j = 0; j < 8; ++j) { const float v = fw[j] + (qw[j] - fw[j]) * mu[C_GD + cg * 16 + q * 8 + j]; fw[j] = 1.f / (1.f + __expf(-v)); }
            v4u og; og.x = pk2(fw[0], fw[1]); og.y = pk2(fw[2], fw[3]); og.z = pk2(fw[4], fw[5]); og.w = pk2(fw[6], fw[7]);
            *(LAS v4u*)(lds + R3_SG + t * R3_SGS + (cg * 16 + q * 8) * 2) = og;
        }
    }
    __syncthreads();
    {
        const int mt = (w >> 1) & 1, nt = w & 1; const int n = nt * 32 + cl;
        if (w < 4) {
            const float* Y0g = (const float*)(F.ws + WS_RWY0) + (size_t)item * 4096;
            f32x16 acc;
#pragma unroll
            for (int r = 0; r < 16; ++r) acc[r] = Y0g[(mt * 32 + crow(r, hh)) * 64 + n];
            acc = wtile<4>(lds + R3_RH + mt * 32 * SBS, SBS, lds + R3_S + nt * 32 * SBS, SBS, acc, lane);
            LAS float* YL = (LAS float*)(lds + R3_YL);
#pragma unroll
            for (int r = 0; r < 16; ++r) YL[(mt * 32 + crow(r, hh)) * 64 + n] = acc[r];
        } else {
            const bf16* gut = (const bf16*)(F.ws + WS_GUPT) + (size_t)(h * 64 + nt * 32) * 128;
            const f32x16 acc = wtile_gb<8>(lds + R3_SG + mt * 32 * R3_SGS, R3_SGS, gut, 128, zero16(), lane);
            LAS float* GL = (LAS float*)(lds + R3_GL);
#pragma unroll
            for (int r = 0; r < 16; ++r) GL[(mt * 32 + crow(r, hh)) * 64 + n] = acc[r];
        }
    }
    __syncthreads();
    {
        const int c = tid & 63, ts = tid >> 6, col = h * 64 + c;
        const float mu_v = mu[C_V + col], gw = F.in[12][col], gb = F.in[13][col];
        const LAS float* YL = (const LAS float*)(lds + R3_YL); const LAS float* GL = (const LAS float*)(lds + R3_GL);
        const float* BON = (const float*)(F.ws + WS_BONUS) + (size_t)item * 64;
        bf16* Y = (bf16*)(F.ws + WS_YMIX);
        const bf16* zb = Z + (size_t)(g0 + 8 * ts) * IN_COLS + col;
        float pv = 0.f; if (!(chunk == 0 && ts == 0)) pv = bf2f(zb[C_V - IN_COLS]);
#pragma unroll
        for (int i = 0; i < 8; ++i) { const int t = 8 * ts + i;
            const float zv = bf2f(zb[(size_t)i * IN_COLS + C_V]); const float v = zv + (pv - zv) * mu_v; pv = zv;
            const float y = YL[t * 64 + c];
            const float mean = wave_sum(y) * (1.f / 64.f); const float d = y - mean; const float var = wave_sum(d * d) * (1.f / 64.f);
            const float yn = d * (1.f / sqrtf(var + GN_EPS)) * gw + gb;
            const float o = (yn + BON[t] * v) * GL[t * 64 + c];
            Y[(size_t)(g0 + t) * DM + col] = (bf16)f2bf(o); }
    }
    __syncthreads();
}

typedef short s16x4 __attribute__((ext_vector_type(4)));
typedef short v4i16_t __attribute__((ext_vector_type(4)));
constexpr int AT_XO = 0, AT_XO_STRIDE = 136, AT_XM = 512 * AT_XO_STRIDE, AT_XL = AT_XM + 2048, AT_V = AT_XL + 2048, AT_LDS_END = AT_V + 8 * 4096;
static_assert(AT_LDS_END <= RING_BYTES, "attention LDS");
__device__ __forceinline__ float xhalf(float v) { return __shfl_xor(v, 32); }
__device__ __forceinline__ void attn_block(Frame& F, int item) {
    const int bh = item >> 4, blk = item & 15, b = bh >> 3, h = bh & 7, t0 = blk * 512;
    int tid_ = F.tid; asm volatile("" : "+v"(tid_));
    const int lane = tid_ & 63, w = __builtin_amdgcn_readfirstlane(tid_ >> 6), ql = lane & 31, hh = lane >> 5;
    const bf16* Zb = (const bf16*)(F.ws + WS_Z) + (size_t)b * SEQ * IN_COLS;
    bf16* Y = (bf16*)(F.ws + WS_YMIX);
    LAS unsigned char* lds = F.lds + RING_OFF;
    LAS unsigned char* Vw = lds + AT_V + w * 4096;
    LAS float* XM = (LAS float*)(lds + AT_XM); LAS float* XL = (LAS float*)(lds + AT_XL);
    constexpr float C2 = 0.125f * 1.4426950408889634f;
    for (int pass = 0; pass < 3; ++pass) {
        const int sh = pass == 0 ? 4 : (pass == 1 ? 2 : 0), d = 1 << sh;
        for (int uu = 0; uu < 2; ++uu) {
            const int u = w + 8 * uu, rho = u & (d - 1), tau = u >> sh;
            const int qoff = rho + (32 * tau + ql) * d;
            bf16x8 qf[4];
            { const bf16* qp = Zb + (size_t)(t0 + qoff) * IN_COLS + C_AQ + h * 64 + 8 * hh;
#pragma unroll
              for (int s = 0; s < 4; ++s) qf[s] = *(const GAS bf16x8*)(qp + 16 * s); }
            f32x16 sc[5];
            const int tkb = t0 + rho + (32 * tau - 128) * d;
#pragma unroll
            for (int kt = 0; kt < 5; ++kt) {
                const int tk0 = tkb + 32 * kt * d;
                if (tk0 >= 0) {
                    const bf16* kp = Zb + (size_t)(tk0 + ql * d) * IN_COLS + C_AK + h * 64 + 8 * hh;
                    bf16x8 kf[4];
#pragma unroll
                    for (int s = 0; s < 4; ++s) kf[s] = *(const GAS bf16x8*)(kp + 16 * s);
                    f32x16 acc;
#pragma unroll
                    for (int r = 0; r < 16; ++r) acc[r] = 0.f;
#pragma unroll
                    for (int s = 0; s < 4; ++s) acc = __builtin_amdgcn_mfma_f32_32x32x16_bf16(kf[s], qf[s], acc, 0, 0, 0);
                    if (kt == 0 || kt == 4) {
#pragma unroll
                        for (int r = 0; r < 16; ++r) { const int kidx = (r & 3) + 8 * (r >> 2) + 4 * hh;
                            const bool ok = (kt == 0) ? (kidx >= ql) : (kidx <= ql);
                            acc[r] = ok ? acc[r] : -INFINITY; }
                    }
                    sc[kt] = acc;
                } else {
#pragma unroll
                    for (int r = 0; r < 16; ++r) sc[kt][r] = -INFINITY;
                }
            }
            float m = -INFINITY;
#pragma unroll
            for (int kt = 0; kt < 5; ++kt)
#pragma unroll
                for (int r = 0; r < 16; ++r) m = fmaxf(m, sc[kt][r]);
            m = fmaxf(m, xhalf(m));
            const float ms = m * C2;
            float l = 0.f;
#pragma unroll
            for (int kt = 0; kt < 5; ++kt)
#pragma unroll
                for (int r = 0; r < 16; ++r) { const float p = __builtin_amdgcn_exp2f(sc[kt][r] * C2 - ms); sc[kt][r] = p; l += p; }
            l += xhalf(l);
            f32x16 O[2];
#pragma unroll
            for (int r = 0; r < 16; ++r) { O[0][r] = 0.f; O[1][r] = 0.f; }
#pragma unroll
            for (int kt = 0; kt < 5; ++kt) {
                const int tk0 = tkb + 32 * kt * d;
                if (tk0 >= 0) {
                    v4u vr[4];
#pragma unroll
                    for (int i = 0; i < 4; ++i) { const int kidx = i * 8 + (lane >> 3), ch = lane & 7;
                        vr[i] = *(const GAS v4u*)(Zb + (size_t)(tk0 + kidx * d) * IN_COLS + C_AV + h * 64 + ch * 8); }
#pragma unroll
                    for (int i = 0; i < 4; ++i) { const int kidx = i * 8 + (lane >> 3), ch = lane & 7;
                        *(LAS v4u*)(Vw + kidx * 128 + ((ch ^ (((kidx >> 1) & 1) << 2)) << 4)) = vr[i]; }
                    asm volatile("s_waitcnt lgkmcnt(0)" ::: "memory");
#pragma unroll
                    for (int s = 0; s < 2; ++s) {
                        bf16x8 pf;
#pragma unroll
                        for (int j = 0; j < 8; ++j) pf[j] = (short)f2bf(sc[kt][8 * s + j]);
#pragma unroll
                        for (int dt = 0; dt < 2; ++dt) {
                            bf16x8 vf;
#pragma unroll
                            for (int pp = 0; pp < 2; ++pp) {
                                const int i16 = lane & 15, db = (lane >> 4) & 1;
                                const int row = 16 * s + 8 * pp + 4 * hh + (i16 >> 2);
                                const int byte = 64 * dt + 32 * db + 8 * (i16 & 3);
                                const int chunk = (byte >> 4) ^ (((row >> 1) & 1) << 2);
                                const s16x4 t4 = __builtin_bit_cast(s16x4, __builtin_amdgcn_ds_read_tr16_b64_v4i16((LAS v4i16_t*)(Vw + row * 128 + (chunk << 4) + (byte & 15))));
                                vf[4 * pp + 0] = t4[0]; vf[4 * pp + 1] = t4[1]; vf[4 * pp + 2] = t4[2]; vf[4 * pp + 3] = t4[3];
                            }
                            O[dt] = __builtin_amdgcn_mfma_f32_32x32x16_bf16(vf, pf, O[dt], 0, 0, 0);
                        }
                    }
                    asm volatile("s_waitcnt lgkmcnt(0)" ::: "memory");
                }
            }
            LAS unsigned char* xo = lds + AT_XO + qoff * AT_XO_STRIDE + 8 * hh;
            float wa = 0.f, wb = 1.f, Mx = ms, ln = l;
            if (pass > 0) { const float msa = XM[qoff], la = XL[qoff]; Mx = fmaxf(msa, ms); wa = la * __builtin_amdgcn_exp2f(msa - Mx); wb = __builtin_amdgcn_exp2f(ms - Mx); ln = wa + wb * l; }
            const float inv = 1.f / ln;
#pragma unroll
            for (int dt = 0; dt < 2; ++dt)
#pragma unroll
                for (int g4 = 0; g4 < 4; ++g4) {
                    LAS v2u* p = (LAS v2u*)(xo + (32 * dt + 8 * g4) * 2);
                    float o0 = O[dt][4 * g4] * wb, o1 = O[dt][4 * g4 + 1] * wb, o2 = O[dt][4 * g4 + 2] * wb, o3 = O[dt][4 * g4 + 3] * wb;
                    if (pass > 0) { const v2u old = *p; o0 += bflo(old.x) * wa; o1 += bfhi(old.x) * wa; o2 += bflo(old.y) * wa; o3 += bfhi(old.y) * wa; }
                    v2u nw; nw.x = pk2(o0 * inv, o1 * inv); nw.y = pk2(o2 * inv, o3 * inv);
                    *p = nw;
                }
            if (hh == 0) { XM[qoff] = Mx; XL[qoff] = ln; }
        }
        __syncthreads();
    }
#pragma unroll
    for (int i = 0; i < 8; ++i) { const int row = (tid_ >> 3) + 64 * i, ch = tid_ & 7;
        LAS v2u* p = (LAS v2u*)(lds + AT_XO + row * AT_XO_STRIDE + ch * 16);
        const v2u a = p[0], c = p[1];
        v4u o; o.x = a.x; o.y = a.y; o.z = c.x; o.w = c.y;
        *(GAS v4u*)(Y + ((size_t)b * SEQ + t0 + row) * DM + RWW + h * 64 + ch * 8) = o; }
    __syncthreads();
}

__device__ __forceinline__ void p3_mixers(Frame& F) {
    const int nrw = (F.G >= 64) ? 32 : 0;
    if (nrw == 0) { for (int ch = 0; ch < NB * NHR; ++ch) rwkv_r2_chain(F, ch); }
    else if (F.wg < nrw) { for (int ch = F.wg; ch < NB * NHR; ch += nrw) rwkv_r2_chain(F, ch); return; }
    const int na = F.G - nrw, wa = F.wg - nrw;
    for (int item = wa; item < NB * NHA * (SEQ / 512); item += na) attn_block(F, item);
}

__device__ __forceinline__ void p5_xn2(Frame& F) {
    const int gw = F.wg * NWAVES + F.wave, NGW = F.G * NWAVES;
    bf16* XN = (bf16*)(F.ws + WS_XN);
    for (int m = gw; m < T; m += NGW) rms_row_to_bf16(F.lane, F.out + (size_t)m * DM, F.in[15], XN + (size_t)m * DM);
}

constexpr int TK_SKS = 272, TK_SKH = 0, TK_SKL = 2 * 128 * TK_SKS, TK_LUT = 2 * TK_SKL, TK_END = TK_LUT + 8 * 2048;
__device__ __forceinline__ unsigned f2ord(float f) { const unsigned u = __builtin_bit_cast(unsigned, f); return u ^ ((unsigned)((int)u >> 31) | 0x80000000u); }
__device__ __forceinline__ float ord2f(unsigned o) { const unsigned u = (o & 0x80000000u) ? (o ^ 0x80000000u) : ~o; return __builtin_bit_cast(float, u); }
__device__ __forceinline__ void ce_desc(unsigned& a, unsigned& b) { const unsigned mx = a > b ? a : b, mn = a > b ? b : a; a = mx; b = mn; }
template <int N, int OFF, int TOT> __device__ __forceinline__ void bitonic_sort_desc(unsigned (&v)[TOT]) {
#pragma unroll
    for (int k = 2; k <= N; k <<= 1)
#pragma unroll
        for (int j = k >> 1; j > 0; j >>= 1)
#pragma unroll
            for (int i = 0; i < N; ++i) { const int l = i ^ j; if (l > i) { if ((i & k) == 0) ce_desc(v[OFF + i], v[OFF + l]); else ce_desc(v[OFF + l], v[OFF + i]); } }
}
template <int OFFA, int OFFB, int TOT> __device__ __forceinline__ void merge_top16(unsigned (&v)[TOT]) {
#pragma unroll
    for (int i = 0; i < 16; ++i) { const unsigned x = v[OFFA + i], y = v[OFFB + 15 - i]; v[OFFA + i] = x > y ? x : y; }
#pragma unroll
    for (int j = 8; j > 0; j >>= 1)
#pragma unroll
        for (int i = 0; i < 16; ++i) { const int l = i ^ j; if (l > i) ce_desc(v[OFFA + i], v[OFFA + l]); }
}
__device__ __forceinline__ void top16_of_64(unsigned (&k)[64]) {
    bitonic_sort_desc<16, 0, 64>(k); bitonic_sort_desc<16, 16, 64>(k); bitonic_sort_desc<16, 32, 64>(k); bitonic_sort_desc<16, 48, 64>(k);
    merge_top16<0, 16, 64>(k); merge_top16<32, 48, 64>(k); merge_top16<0, 32, 64>(k);
}
__device__ __forceinline__ void p7_topk(Frame& F) {
    static_assert(TK_END <= LDSCTL_OFF, "topk LDS");
    const bf16* QP = (const bf16*)(F.ws + WS_QP);
    int* EID = (int*)(F.ws + WS_EID); float* GATE = (float*)(F.ws + WS_GATE);
    const float* sk = F.in[17];
    LAS unsigned char* lds = F.lds + RING_OFF;
    for (int e = F.tid; e < 2 * 128 * 64; e += NTHREADS) {
        const int c = e >> 13, k = (e >> 6) & 127, d2 = e & 63;
        const f32x2 v = *(const GAS f32x2*)(sk + (size_t)(c * 128 + k) * 128 + 2 * d2);
        const unsigned h0 = f2bf(v.x), h1 = f2bf(v.y);
        const float r0 = v.x - __builtin_bit_cast(float, h0 << 16), r1 = v.y - __builtin_bit_cast(float, h1 << 16);
        *(LAS unsigned*)(lds + TK_SKH + (c * 128 + k) * TK_SKS + d2 * 4) = h0 | (h1 << 16);
        *(LAS unsigned*)(lds + TK_SKL + (c * 128 + k) * TK_SKS + d2 * 4) = pk2(r0, r1);
    }
    __syncthreads();
    const int gw = F.wg * NWAVES + F.wave, NGW = F.G * NWAVES;
    for (int tile = gw; tile < T * PHEADS / 32; tile += NGW) {
        int lane_ = F.lane; asm volatile("" : "+v"(lane_));
        const int lane = lane_, hh = lane >> 5, cl = lane & 31;
        const int P = tile * 32 + cl, t = P >> 3, h = P & 7;
        unsigned kAB[2][16];
#pragma unroll
        for (int c = 0; c < 2; ++c) {
            bf16x8 qf[8];
            const bf16* qp = QP + (size_t)t * PQ + h * 256 + c * 128 + 8 * hh;
#pragma unroll
            for (int s2 = 0; s2 < 8; ++s2) qf[s2] = *(const GAS bf16x8*)(qp + 16 * s2);
            unsigned k[64];
#pragma unroll
            for (int mt = 0; mt < 4; ++mt) {
                f32x16 acc = zero16();
                const LAS unsigned char* ah = lds + TK_SKH + (c * 128 + mt * 32 + cl) * TK_SKS + 16 * hh;
                const LAS unsigned char* al = lds + TK_SKL + (c * 128 + mt * 32 + cl) * TK_SKS + 16 * hh;
#pragma unroll
                for (int s2 = 0; s2 < 8; ++s2) {
                    acc = __builtin_amdgcn_mfma_f32_32x32x16_bf16(*(const LAS bf16x8*)(ah + 32 * s2), qf[s2], acc, 0, 0, 0);
                    acc = __builtin_amdgcn_mfma_f32_32x32x16_bf16(*(const LAS bf16x8*)(al + 32 * s2), qf[s2], acc, 0, 0, 0); }
#pragma unroll
                for (int r = 0; r < 16; ++r) { const int idx = 32 * mt + (r & 3) + 8 * (r >> 2) + 4 * hh; k[mt * 16 + r] = (f2ord(acc[r]) & ~127u) | (unsigned)(127 - idx); }
            }
            top16_of_64(k);
            unsigned m[32];
#pragma unroll
            for (int i = 0; i < 16; ++i) { m[i] = k[i]; m[16 + i] = (unsigned)__shfl_xor((int)k[i], 32); }
            merge_top16<0, 16, 32>(m);
#pragma unroll
            for (int i = 0; i < 16; ++i) kAB[c][i] = m[i];
        }
        float fa[16], fb[16];
#pragma unroll
        for (int i = 0; i < 16; ++i) { fa[i] = ord2f(kAB[0][i] & ~127u); fb[i] = ord2f(kAB[1][i] & ~127u); }
        unsigned cd[64]; int n = 0;
#pragma unroll
        for (int i = 0; i < 16; ++i)
#pragma unroll
            for (int j = 0; j < 16; ++j) if ((i + 1) * (j + 1) <= 16) { cd[n] = (f2ord(fa[i] + fb[j]) & ~255u) | (unsigned)(255 - (i * 16 + j)); ++n; }
#pragma unroll
        for (int q = 50; q < 64; ++q) cd[q] = 0u;
        top16_of_64(cd);
        LAS unsigned char* lut = lds + TK_LUT + (F.wave * 64 + lane) * 32;
#pragma unroll
        for (int q = 0; q < 4; ++q) {
            unsigned wa = 0u, wb = 0u;
#pragma unroll
            for (int b4 = 0; b4 < 4; ++b4) { wa |= (127u - (kAB[0][4 * q + b4] & 127u)) << (8 * b4); wb |= (127u - (kAB[1][4 * q + b4] & 127u)) << (8 * b4); }
            *(LAS unsigned*)(lut + 4 * q) = wa; *(LAS unsigned*)(lut + 16 + 4 * q) = wb; }
        float gv[16]; float den = 0.f; const float mx = ord2f(cd[0] & ~255u);
#pragma unroll
        for (int q = 0; q < 16; ++q) { gv[q] = __expf(ord2f(cd[q] & ~255u) - mx); den += gv[q]; }
        const float inv = 1.f / den;
        asm volatile("s_waitcnt lgkmcnt(0)" ::: "memory");
        int ev[16];
#pragma unroll
        for (int q = 0; q < 16; ++q) { const unsigned pos = 255u - (cd[q] & 255u);
            const unsigned ia = *(const LAS unsigned char*)(lut + (pos >> 4)), ib = *(const LAS unsigned char*)(lut + 16 + (pos & 15u));
            ev[q] = (int)(ia * NKEYS + ib); }
        if (hh == 0) {
            int* ep = EID + (size_t)t * 128 + h * 16; float* gp = GATE + (size_t)t * 128 + h * 16;
#pragma unroll
            for (int q = 0; q < 4; ++q) {
                *(GAS v4u*)(ep + 4 * q) = (v4u){(unsigned)ev[4 * q], (unsigned)ev[4 * q + 1], (unsigned)ev[4 * q + 2], (unsigned)ev[4 * q + 3]};
                *(GAS f32x4*)(gp + 4 * q) = (f32x4){gv[4 * q] * inv, gv[4 * q + 1] * inv, gv[4 * q + 2] * inv, gv[4 * q + 3] * inv}; }
        }
        asm volatile("s_waitcnt lgkmcnt(0)" ::: "memory");
    }
}

constexpr int GA_WAVE_BYTES = 4608, GA_CNT = 4096, GA_OFF = 4096 + 64;
__device__ __forceinline__ int wave_sum_i(int v) { v += dppi<0xB1>(v); v += dppi<0x4E>(v); v += dppi<0x141>(v); v += dppi<0x140>(v);
    return (__builtin_amdgcn_readlane(v, 0) + __builtin_amdgcn_readlane(v, 16)) + (__builtin_amdgcn_readlane(v, 32) + __builtin_amdgcn_readlane(v, 48)); }
struct PairBuf { v4u u, v; float su, sv; int e; float g; };
__device__ __forceinline__ void p8_gather(Frame& F) {
    const bf16* XN = (const bf16*)(F.ws + WS_XN);
    const unsigned char* UQ = F.ws + WS_UQ; const unsigned char* VQ = F.ws + WS_VQ;
    const float* SU = (const float*)(F.ws + WS_SU); const float* SV = (const float*)(F.ws + WS_SV);
    const int* EID = (const int*)(F.ws + WS_EID); const float* GATE = (const float*)(F.ws + WS_GATE);
    const float* nf = F.in[20];
    const int gw = F.wg * NWAVES + F.wave, NGW = F.G * NWAVES;
    LAS unsigned char* wl = F.lds + RING_OFF + F.wave * GA_WAVE_BYTES;
    for (int tg = gw; tg < T / 4; tg += NGW) {
        int lane_ = F.lane; asm volatile("" : "+v"(lane_));
        const int lane = lane_;
        int xq[4][4]; float sx[4];
#pragma unroll
        for (int tk = 0; tk < 4; ++tk) {
            const GAS v4u* xp = (const GAS v4u*)(XN + (size_t)(4 * tg + tk) * DM + lane * 16);
            const v4u a = xp[0], b = xp[1];
            float x[16]; x[0] = bflo(a.x); x[1] = bfhi(a.x); x[2] = bflo(a.y); x[3] = bfhi(a.y); x[4] = bflo(a.z); x[5] = bfhi(a.z); x[6] = bflo(a.w); x[7] = bfhi(a.w);
            x[8] = bflo(b.x); x[9] = bfhi(b.x); x[10] = bflo(b.y); x[11] = bfhi(b.y); x[12] = bflo(b.z); x[13] = bfhi(b.z); x[14] = bflo(b.w); x[15] = bfhi(b.w);
            float am = 0.f;
#pragma unroll
            for (int i = 0; i < 16; ++i) am = fmaxf(am, fabsf(x[i]));
            am = wave_max(am);
            sx[tk] = am > 0.f ? am * (1.f / 127.f) : 1.f; const float inv = am > 0.f ? 127.f / am : 0.f;
#pragma unroll
            for (int q = 0; q < 4; ++q) {
                const unsigned b0 = (unsigned)(int)rintf(x[4 * q] * inv) & 255u, b1 = (unsigned)(int)rintf(x[4 * q + 1] * inv) & 255u, b2 = (unsigned)(int)rintf(x[4 * q + 2] * inv) & 255u, b3 = (unsigned)(int)rintf(x[4 * q + 3] * inv) & 255u;
                xq[tk][q] = (int)(b0 | (b1 << 8) | (b2 << 16) | (b3 << 24)); }
        }
        LAS unsigned* cnt = (LAS unsigned*)(wl + GA_CNT); LAS unsigned* offs = (LAS unsigned*)(wl + GA_OFF);
        if (lane < 16) cnt[lane] = 0u;
        asm volatile("s_waitcnt lgkmcnt(0)" ::: "memory");
        int ee[8]; float gg[8]; unsigned pos[8];
#pragma unroll
        for (int tk = 0; tk < 4; ++tk) {
            const size_t base = (size_t)(4 * tg + tk) * 128;
            ee[2 * tk] = (EID[base + lane] & (NEXP - 1)) | (tk << 14); ee[2 * tk + 1] = (EID[base + 64 + lane] & (NEXP - 1)) | (tk << 14);
            gg[2 * tk] = GATE[base + lane]; gg[2 * tk + 1] = GATE[base + 64 + lane]; }
#pragma unroll
        for (int q = 0; q < 8; ++q) pos[q] = __hip_atomic_fetch_add(cnt + ((ee[q] >> 10) & 15), 1u, __ATOMIC_RELAXED, __HIP_MEMORY_SCOPE_WAVEFRONT);
        asm volatile("s_waitcnt lgkmcnt(0)" ::: "memory");
        if (lane < 16) {
            const int c0 = (int)cnt[lane]; int v = c0;
            v += __builtin_amdgcn_update_dpp(0, v, 0x111, 0xF, 0xF, true); v += __builtin_amdgcn_update_dpp(0, v, 0x112, 0xF, 0xF, true);
            v += __builtin_amdgcn_update_dpp(0, v, 0x114, 0xF, 0xF, true); v += __builtin_amdgcn_update_dpp(0, v, 0x118, 0xF, 0xF, true);
            offs[lane] = (unsigned)(v - c0);
        }
        asm volatile("s_waitcnt lgkmcnt(0)" ::: "memory");
#pragma unroll
        for (int q = 0; q < 8; ++q) { const unsigned idx = offs[(ee[q] >> 10) & 15] + pos[q];
            *(LAS v2u*)(wl + idx * 8) = (v2u){(unsigned)ee[q], __builtin_bit_cast(unsigned, gg[q])}; }
        asm volatile("s_waitcnt lgkmcnt(0)" ::: "memory");
        float y[4][16]; float yo[4];
#pragma unroll
        for (int tk = 0; tk < 4; ++tk) { yo[tk] = 0.f;
#pragma unroll
            for (int i = 0; i < 16; ++i) y[tk][i] = 0.f; }
#define GA_LOAD(B, j) do { const int e_ = __builtin_amdgcn_readlane((int)ent.x, (j)); const int ex_ = e_ & (NEXP - 1); \
            (B).u = *(const GAS v4u*)(UQ + (size_t)ex_ * DM + lane * 16); (B).v = *(const GAS v4u*)(VQ + (size_t)ex_ * DM + lane * 16); \
            (B).su = SU[ex_]; (B).sv = SV[ex_]; (B).e = e_; (B).g = __builtin_bit_cast(float, __builtin_amdgcn_readlane((int)ent.y, (j))); } while (0)
#define GA_PAIR(B, TK) do { int d_ = __builtin_amdgcn_sdot4(xq[TK][0], (int)(B).u.x, 0, false); d_ = __builtin_amdgcn_sdot4(xq[TK][1], (int)(B).u.y, d_, false); \
            d_ = __builtin_amdgcn_sdot4(xq[TK][2], (int)(B).u.z, d_, false); d_ = __builtin_amdgcn_sdot4(xq[TK][3], (int)(B).u.w, d_, false); \
            const float h_ = (float)wave_sum_i(d_) * ((B).su * sx[TK]); \
            const float a_ = 0.5f * h_ * (1.f + erff(h_ * 0.70710678118654752f)) * (B).g * (B).sv; yo[TK] += a_ * 128.f; \
            _Pragma("unroll") for (int q_ = 0; q_ < 4; ++q_) { const unsigned w_ = (B).v[q_]; \
                y[TK][4 * q_] += a_ * (float)(w_ & 255u); y[TK][4 * q_ + 1] += a_ * (float)((w_ >> 8) & 255u); y[TK][4 * q_ + 2] += a_ * (float)((w_ >> 16) & 255u); y[TK][4 * q_ + 3] += a_ * (float)(w_ >> 24); } } while (0)
#define GA_COMP(B) do { const int tk_ = ((B).e >> 14) & 3; if (tk_ == 0) GA_PAIR(B, 0); else if (tk_ == 1) GA_PAIR(B, 1); else if (tk_ == 2) GA_PAIR(B, 2); else GA_PAIR(B, 3); } while (0)
        for (int ch = 0; ch < 8; ++ch) {
            const v2u ent = *(const LAS v2u*)(wl + (ch * 64 + lane) * 8);
            PairBuf A0, A1, A2, A3, B0, B1, B2, B3;
            GA_LOAD(A0, 0); GA_LOAD(A1, 1); GA_LOAD(A2, 2); GA_LOAD(A3, 3);
            for (int jb = 0; jb < 64; jb += 8) {
                GA_LOAD(B0, jb + 4); GA_LOAD(B1, jb + 5); GA_LOAD(B2, jb + 6); GA_LOAD(B3, jb + 7);
                GA_COMP(A0); GA_COMP(A1); GA_COMP(A2); GA_COMP(A3);
                if (jb + 8 < 64) { GA_LOAD(A0, jb + 8); GA_LOAD(A1, jb + 9); GA_LOAD(A2, jb + 10); GA_LOAD(A3, jb + 11); }
                GA_COMP(B0); GA_COMP(B1); GA_COMP(B2); GA_COMP(B3);
            }
        }
#undef GA_LOAD
#undef GA_PAIR
#undef GA_COMP
#pragma unroll
        for (int tk = 0; tk < 4; ++tk) {
            float* hrow = F.out + (size_t)(4 * tg + tk) * DM + lane * 16;
            float hv[16]; float ss = 0.f;
#pragma unroll
            for (int q = 0; q < 4; ++q) { const f32x4 h4 = *(const GAS f32x4*)(hrow + 4 * q);
#pragma unroll
                for (int i = 0; i < 4; ++i) { const float v = h4[i] + (y[tk][4 * q + i] - yo[tk]); hv[4 * q + i] = v; ss += v * v; } }
            const float rstd = 1.f / sqrtf(wave_sum(ss) * (1.f / DM) + RMS_EPS);
#pragma unroll
            for (int q = 0; q < 4; ++q) { const f32x4 n4 = *(const GAS f32x4*)(nf + lane * 16 + 4 * q);
                *(GAS f32x4*)(hrow + 4 * q) = (f32x4){hv[4 * q] * rstd * n4[0], hv[4 * q + 1] * rstd * n4[1], hv[4 * q + 2] * rstd * n4[2], hv[4 * q + 3] * rstd * n4[3]}; }
        }
    }
}

struct Args { const float* in[21]; float* out; unsigned char* ws; int ph_lo, ph_hi; };
static_assert(sizeof(Args) == 21 * 8 + 8 + 8 + 8, "Args has no padding");

__global__ void __launch_bounds__(NTHREADS, 2) fwd_kernel(Args args) {
    extern __shared__ __attribute__((aligned(16))) unsigned char lds[];
    Frame F;
    F.lds = (LAS unsigned char*)lds;
    F.MISC = (volatile LAS unsigned*)(F.lds + MISC_OFF);
    F.tid = threadIdx.x; F.lane = F.tid & 63; F.wave = __builtin_amdgcn_readfirstlane(F.tid >> 6);
    F.G = gridDim.x; F.wg = blockIdx.x;
#pragma unroll
    for (int i = 0; i < 21; ++i) F.in[i] = args.in[i];
    F.out = args.out; F.ws = args.ws;
    F.ctl = (gu32*)(args.ws + WS_CTL);
    for (int u = F.tid; u < (LDS_BYTES - LDSCTL_OFF) / 4; u += NTHREADS) ((LAS unsigned*)(F.lds + LDSCTL_OFF))[u] = 0u;
    __syncthreads();
    const int lo = args.ph_lo, hi = args.ph_hi;
    const bool fused = (hi - lo) > 1;
    XcdBarrier bar; bar.bar = (unsigned*)(F.ctl + CW_BAR); bar.x = 0; bar.st = nullptr;
    if (fused) bar = xcd_barrier_post((unsigned*)(F.ctl + CW_BAR), F.MISC + 8);
#define IN(k) (lo <= (k) && (k) < hi)
#define REPS(k) (((REP_MASK >> (k)) & 1) ? 2 : 1)
#define REPLOOP(k) for (int rep_ = 0; rep_ < REPS(k); ++rep_, (rep_ < REPS(k) ? xcd_barrier(bar) : (void)0))
#define SEAM(k) do { if (IN(k) && IN((k) + 1)) xcd_barrier(bar); } while (0)

    if (IN(0)) { REPLOOP(0) p0_prologue(F); SEAM(0); }
    if (IN(1)) { REPLOOP(1) {
        pg8::Gemm g{(const bf16*)(F.ws + WS_XN), (const bf16*)(F.ws + WS_WIN), T, IN_COLS, DM}; pg8::StaticOrder S; S.init(T, IN_COLS, F.G, F.wg);
        pg8::EpiBf16 E{(bf16*)(F.ws + WS_Z), IN_COLS};
        pg8::gemm_phase<pg8::EpiBf16, pg8::StaticOrder, true, true>(F.lds + RING_OFF, g, S, E); }
        SEAM(1);
    }
    if (IN(2)) { p2_rope(F); REPLOOP(2) { const int cnt = r13_count(F.wg, F.G); R1Pre P;
            if (cnt > 0) rwkv_r1_prefetch(F, r13_item(F.wg, F.G, 0), F.tid, P);
            for (int i = 0; i < cnt; ++i) rwkv_r1_item(F, r13_item(F.wg, F.G, i), i + 1 < cnt ? r13_item(F.wg, F.G, i + 1) : -1, P); }
        SEAM(2); }
    if (IN(3)) { REPLOOP(3) p3_mixers(F); SEAM(3); }
    if (IN(4)) { REPLOOP(4) for (int item = F.wg; item < NB * NHR * 128; item += F.G) rwkv_r3_item(F, item); SEAM(4); }
    if (IN(5)) { REPLOOP(5) {
        pg8::Gemm g{(const bf16*)(F.ws + WS_YMIX), (const bf16*)(F.ws + WS_WOUT), T, DM, DM}; pg8::StaticOrder S; S.init(T, DM, F.G, F.wg);
        pg8::EpiF32Res E{F.in[0], F.out, DM};
        pg8::gemm_phase<pg8::EpiF32Res, pg8::StaticOrder, true, true>(F.lds + RING_OFF, g, S, E); }
        SEAM(5);
    }
    if (IN(6)) { REPLOOP(6) p5_xn2(F); SEAM(6); }
    if (IN(7)) { REPLOOP(7) {
        pg8::Gemm g{(const bf16*)(F.ws + WS_XN), (const bf16*)(F.ws + WS_WQ), T, PQ, DM}; pg8::StaticOrder S; S.init(T, PQ, F.G, F.wg);
        pg8::EpiBf16 E{(bf16*)(F.ws + WS_QP), PQ};
        pg8::gemm_phase<pg8::EpiBf16, pg8::StaticOrder, true, true>(F.lds + RING_OFF, g, S, E); }
        SEAM(7);
    }
    if (IN(8)) { REPLOOP(8) p7_topk(F); SEAM(8); }
    if (IN(9)) { p8_gather(F); }
#undef IN
#undef SEAM
}

extern "C" void kernel_launch(void* const* d_in, const int* in_sizes, int n_in, void* d_out, int out_size, void* d_ws, size_t ws_size, hipStream_t stream) {
    static int grid = 0;
    if (grid == 0) {
        if (n_in != 21 || in_sizes[0] != T * DM || out_size != T * DM || ws_size < WS_END) {
            fprintf(stderr, "kernel_launch: unexpected shapes: n_in %d in0 %d out %d ws %zu (need %zu); nothing launched\n", n_in, n_in > 0 ? in_sizes[0] : -1, out_size, ws_size, (size_t)WS_END); grid = -1; return; }
        int dev = 0, cus = 0, per_cu = 0;
        if (hipGetDevice(&dev) != hipSuccess || hipDeviceGetAttribute(&cus, hipDeviceAttributeMultiprocessorCount, dev) != hipSuccess) { grid = -1; return; }
        if (hipFuncSetAttribute((const void*)fwd_kernel, hipFuncAttributeMaxDynamicSharedMemorySize, LDS_BYTES) != hipSuccess) { fprintf(stderr, "kernel_launch: hipFuncSetAttribute failed\n"); grid = -1; return; }
        if (hipOccupancyMaxActiveBlocksPerMultiprocessor(&per_cu, (const void*)fwd_kernel, NTHREADS, LDS_BYTES) != hipSuccess || per_cu < 1) { fprintf(stderr, "kernel_launch: occupancy query says %d\n", per_cu); per_cu = 1; }
        (void)hipGetLastError();
        grid = cus;
    }
    if (grid < 0) return;
    (void)hipMemsetAsync((char*)d_ws + WS_CTL, 0, CTL_ZERO_BYTES, stream);
    Args a{};
    for (int i = 0; i < 21; ++i) a.in[i] = (const float*)d_in[i];
    a.out = (float*)d_out; a.ws = (unsigned char*)d_ws;
    if (MK_N_LAUNCHES == 1) {
        a.ph_lo = 0; a.ph_hi = NPHASE;
        void* kargs[] = {&a};
        hipError_t e = hipLaunchCooperativeKernel((const void*)fwd_kernel, dim3(grid), dim3(NTHREADS), kargs, LDS_BYTES, stream);
        if (e != hipSuccess) fprintf(stderr, "kernel_launch: cooperative launch failed: %s (grid %d)\n", hipGetErrorString(e), grid);
    } else {
        for (int p = 0; p < NPHASE; ++p) { a.ph_lo = p; a.ph_hi = p + 1;
            hipLaunchKernelGGL(fwd_kernel, dim3(grid), dim3(NTHREADS), LDS_BYTES, stream, a); }
    }
}
```

```cpp
#include <hip/hip_runtime.h>
#include <cstdio>
#include <cstdint>

#ifndef MK_N_LAUNCHES
#define MK_N_LAUNCHES 1
#endif

#ifndef REP_MASK
#define REP_MASK 0
#endif
#define GAS __attribute__((address_space(1)))
#define LAS __attribute__((address_space(3)))
typedef unsigned short bf16;
typedef unsigned v4u __attribute__((ext_vector_type(4)));
typedef unsigned v2u __attribute__((ext_vector_type(2)));
typedef float f32x4 __attribute__((ext_vector_type(4)));
typedef float f32x2 __attribute__((ext_vector_type(2)));
typedef short bf16x8 __attribute__((ext_vector_type(8)));
typedef GAS unsigned gu32;
#define RLX_AGENT __ATOMIC_RELAXED, __HIP_MEMORY_SCOPE_AGENT
#define LDS_WAIT() asm volatile("s_waitcnt lgkmcnt(0)" ::: "memory")
#define VM_WAIT() asm volatile("s_waitcnt vmcnt(0)" ::: "memory")
#define LDS_BARRIER() do { asm volatile("s_waitcnt lgkmcnt(0)" ::: "memory"); __builtin_amdgcn_s_barrier(); asm volatile("" ::: "memory"); } while (0)

constexpr int DM = 1024, NB = 4, SEQ = 8192, T = NB * SEQ;
constexpr int HD = 64, RWW = 512, NHR = 8, NHA = 8;
constexpr int IN_COLS = 3328;
constexpr int C_R = 0, C_K = 512, C_V = 1024, C_WD = 1536, C_AD = 1600, C_GD = 1664, C_AQ = 1792, C_AK = 2304, C_AV = 2816;
constexpr int PHEADS = 8, NKEYS = 128, PQ = 2048, TOPK = 16, NEXP = 16384;
constexpr float RMS_EPS = 1e-6f, GN_EPS = 64e-5f;
constexpr int NWAVES = 8, NTHREADS = 512;
constexpr int NPHASE = 10;

constexpr size_t MiB = 1u << 20;
constexpr size_t WS_CTL = 0, CTL_ZERO_BYTES = 1 * MiB;
constexpr size_t WS_WIN = 2 * MiB;
constexpr size_t WS_WOUT = 10 * MiB;
constexpr size_t WS_WQ = 12 * MiB;
constexpr size_t WS_XN = 16 * MiB;
constexpr size_t WS_Z = 80 * MiB;
constexpr size_t WS_QP = 80 * MiB;
constexpr size_t WS_G = 288 * MiB;
constexpr size_t WS_YMIX = 352 * MiB;
constexpr size_t WS_UQ = 416 * MiB;
constexpr size_t WS_VQ = 432 * MiB;
constexpr size_t WS_SU = 448 * MiB;
constexpr size_t WS_SV = 449 * MiB;
constexpr size_t WS_EID = 480 * MiB;
constexpr size_t WS_GATE = 496 * MiB;
constexpr size_t WS_END = 512 * MiB;
constexpr size_t WS_WUPT = 1 * MiB, WS_AUPT = WS_WUPT + 65536, WS_GUPT = WS_AUPT + 65536;
constexpr size_t WS_BONUS = 9 * MiB;
constexpr size_t WS_RWY0 = WS_XN;
constexpr size_t WS_RWSS = WS_G;
constexpr size_t WS_RWRH = WS_EID;

constexpr int CW_BAR = 4096;

typedef __bf16 hbf16x2_t __attribute__((ext_vector_type(2)));
__device__ __forceinline__ unsigned pk2(float lo, float hi) { const f32x2 v = {lo, hi}; const hbf16x2_t b = __builtin_convertvector(v, hbf16x2_t); return __builtin_bit_cast(unsigned, b); }
__device__ __forceinline__ unsigned f2bf(float f) { return pk2(f, 0.f) & 0xffffu; }
__device__ __forceinline__ float frcp(float x) { return __builtin_amdgcn_rcpf(x); }
__device__ __forceinline__ float frsq(float x) { return __builtin_amdgcn_rsqf(x); }
__device__ __forceinline__ float bflo(unsigned u) { return __builtin_bit_cast(float, u << 16); }
__device__ __forceinline__ float bfhi(unsigned u) { return __builtin_bit_cast(float, u & 0xffff0000u); }
__device__ __forceinline__ float bf2f(bf16 h) { return __builtin_bit_cast(float, (unsigned)h << 16); }

template <int CTRL> __device__ __forceinline__ float dppf(float x) { return __builtin_bit_cast(float, __builtin_amdgcn_update_dpp(0, __builtin_bit_cast(int, x), CTRL, 0xF, 0xF, true)); }
template <int CTRL> __device__ __forceinline__ int dppi(int x) { return __builtin_amdgcn_update_dpp(0, x, CTRL, 0xF, 0xF, true); }
__device__ __forceinline__ float rdlane(float v, int l) { return __builtin_bit_cast(float, __builtin_amdgcn_readlane(__builtin_bit_cast(int, v), l)); }
__device__ __forceinline__ float sum8(float v) { v += dppf<0xB1>(v); v += dppf<0x4E>(v); v += dppf<0x141>(v); return v; }
__device__ __forceinline__ float sum16(float v) { v = sum8(v); v += dppf<0x140>(v); return v; }
__device__ __forceinline__ float wave_sum(float v) { v = sum16(v);
    v += __builtin_bit_cast(float, __builtin_amdgcn_update_dpp(0, __builtin_bit_cast(int, v), 0x142, 0xA, 0xF, false));
    v += __builtin_bit_cast(float, __builtin_amdgcn_update_dpp(0, __builtin_bit_cast(int, v), 0x143, 0xC, 0xF, false));
    return rdlane(v, 63); }
__device__ __forceinline__ float wave_max(float v) {
    v = fmaxf(v, dppf<0xB1>(v)); v = fmaxf(v, dppf<0x4E>(v)); v = fmaxf(v, dppf<0x141>(v)); v = fmaxf(v, dppf<0x140>(v));
    return fmaxf(fmaxf(rdlane(v, 0), rdlane(v, 16)), fmaxf(rdlane(v, 32), rdlane(v, 48)));
}
__device__ __forceinline__ int wave_min_i(int v) {
    v = min(v, dppi<0xB1>(v)); v = min(v, dppi<0x4E>(v)); v = min(v, dppi<0x141>(v)); v = min(v, dppi<0x140>(v));
    return min(min(__builtin_amdgcn_readlane(v, 0), __builtin_amdgcn_readlane(v, 16)), min(__builtin_amdgcn_readlane(v, 32), __builtin_amdgcn_readlane(v, 48)));
}

namespace pg8 {
#define PG8_LAS __attribute__((address_space(3)))
typedef unsigned short bf16_t;
typedef unsigned u32x4 __attribute__((ext_vector_type(4)));
constexpr int BM = 256, BK = 64, HALF = 128, HTB = HALF * BK * 2, STAGE_BYTES = 8 * HTB, NXCD = 8, WGM = 8;
__host__ __device__ __forceinline__ int lds_byte(int r, int c) { const int st = (r >> 4) * 2 + (c >> 5), rr = r & 15, cc = c & 31, ob = rr * 64 + cc * 2; return st * 1024 + (ob ^ (((ob >> 9) & 1) << 5)); }
__host__ __device__ __forceinline__ void stage_rc(int b, int& R, int& C) { const int st = b / 1024, sb = b % 1024, swz = sb ^ (((sb >> 9) & 1) << 5); R = (st >> 1) * 16 + swz / 64; C = (st & 1) * 32 + (swz % 64) / 2; }
__host__ __device__ __forceinline__ int perm32(int rho) { const int n = rho >> 4, i = rho & 15; return 8 * (i >> 2) + 4 * n + (i & 3); }
struct Unit { int pm, pn; };
struct Gemm { const bf16_t* A; const bf16_t* Bt; int M, N, K; };
struct StaticOrder {
    int nM, nN, nwg, G, c;
    __host__ __device__ void init(int M, int N, int G_, int c_) { nM = M / BM; nN = N / BM; nwg = nM * nN; G = G_; c = c_; }
    __host__ __device__ bool next(int i, Unit& u) const {
        const long L = (long)i * G + c; if (L >= nwg) return false;
        int wgid = (int)L; { const int q = nwg / NXCD, r = nwg % NXCD, xcd = wgid % NXCD, off = wgid / NXCD; wgid = (xcd < r ? xcd * (q + 1) : r * (q + 1) + (xcd - r) * q) + off; }
        const int nig = WGM * nN, gid = wgid / nig, fm = gid * WGM, gsz = (nM - fm) < WGM ? (nM - fm) : WGM;
        u.pm = fm + ((wgid % nig) % gsz); u.pn = (wgid % nig) / gsz; return true;
    }
    __device__ __forceinline__ void a_ready(const Unit&) const {}
    __device__ __forceinline__ void done(const Unit&) const {}
};
__device__ __forceinline__ unsigned cvt_pk_bf16(float lo, float hi) { unsigned r; asm volatile("v_cvt_pk_bf16_f32 %0, %1, %2" : "=v"(r) : "v"(lo), "v"(hi)); return r; }
struct EpiBf16 {
    static constexpr bool PERM = true, AFTER_DRAIN = false;
    bf16_t* O; int ldc;
    __device__ __forceinline__ void operator()(const f32x4 (&acc)[2][2][4][2], const Unit& u, int wr, int wc, int fr, int fq) const {
        const int row0 = u.pm * BM + wr * 64 + fr; const int col0 = u.pn * BM + wc * 32 + 8 * fq;
#pragma unroll
        for (int ai = 0; ai < 2; ++ai)
#pragma unroll
            for (int m = 0; m < 4; ++m) { bf16_t* rowp = O + (size_t)(row0 + ai * HALF + m * 16) * ldc + col0;
#pragma unroll
                for (int bj = 0; bj < 2; ++bj) { const f32x4 v0 = acc[ai][bj][m][0], v1 = acc[ai][bj][m][1];
                    u32x4 w; w.x = cvt_pk_bf16(v0[0], v0[1]); w.y = cvt_pk_bf16(v0[2], v0[3]); w.z = cvt_pk_bf16(v1[0], v1[1]); w.w = cvt_pk_bf16(v1[2], v1[3]);
                    *(u32x4*)(rowp + bj * HALF) = w; } }
    }
};
struct EpiF32Res {
    static constexpr bool PERM = true, AFTER_DRAIN = false;
    const float* res; float* O; int ldc;
    __device__ __forceinline__ void operator()(const f32x4 (&acc)[2][2][4][2], const Unit& u, int wr, int wc, int fr, int fq) const {
        const int row0 = u.pm * BM + wr * 64 + fr; const int col0 = u.pn * BM + wc * 32 + 8 * fq;
#pragma unroll
        for (int ai = 0; ai < 2; ++ai)
#pragma unroll
            for (int m = 0; m < 4; ++m) { const size_t off = (size_t)(row0 + ai * HALF + m * 16) * ldc + col0;
#pragma unroll
                for (int bj = 0; bj < 2; ++bj) { const f32x4 r0 = *(const f32x4*)(res + off + bj * HALF), r1 = *(const f32x4*)(res + off + bj * HALF + 4);
                    *(f32x4*)(O + off + bj * HALF) = acc[ai][bj][m][0] + r0; *(f32x4*)(O + off + bj * HALF + 4) = acc[ai][bj][m][1] + r1; } }
    }
};

template <class Epi, class Sched, bool ALIGN_EPI = false, bool SP2 = false>
__device__ __forceinline__ void gemm_phase(PG8_LAS unsigned char* lds, const Gemm g, const Sched& S, const Epi& E) {
    const int tid = threadIdx.x, wid = __builtin_amdgcn_readfirstlane(tid >> 6), lane = tid & 63, wr = wid >> 2, wc = wid & 3, fr = lane & 15, fq = lane >> 4;
    const int K = g.K, nt = K / BK;
    unsigned voffA[2], voffB[2];
#pragma unroll
    for (int i = 0; i < 2; ++i) { int R, C; stage_rc(tid * 16 + i * 8192, R, C); const int Rb = Epi::PERM ? ((R & ~31) + perm32(R & 31)) : R;
        voffA[i] = (unsigned)(R * K + C) * 2u; voffB[i] = (unsigned)(Rb * K + C) * 2u; }
    const size_t kstep = (size_t)(BK * 2);
    const size_t hstep = (size_t)HALF * K * 2;
    const size_t tstep = 2 * hstep;
    const unsigned ldsw = (unsigned)wid * 1024u;
    const int aoff = lds_byte(wr * 64 + fr, fq * 8), boff = lds_byte(wc * 32 + fr, fq * 8);
#define PG8_SA(b, h) (((b) * 2 + (h)) * HTB)
#define PG8_SB(b, h) ((4 + (b) * 2 + (h)) * HTB)
#define PG8_STAGE(bufoff, gbase, voff) do { _Pragma("unroll") for (int _i = 0; _i < 2; ++_i) \
        __builtin_amdgcn_global_load_lds((const unsigned*)((const char*)(gbase) + (voff)[_i]), (PG8_LAS unsigned*)(lds + (bufoff) + ldsw + _i * 8192), 16, 0, 0); } while (0)
#define PG8_LDA(dst, b, h) do { _Pragma("unroll") for (int m = 0; m < 4; ++m) _Pragma("unroll") for (int k = 0; k < 2; ++k) dst[m][k] = *(const PG8_LAS bf16x8*)(lds + PG8_SA(b, h) + aoff + m * 2048 + k * 1024); } while (0)
#define PG8_LDB(dst, b, h) do { _Pragma("unroll") for (int n = 0; n < 2; ++n) _Pragma("unroll") for (int k = 0; k < 2; ++k) dst[n][k] = *(const PG8_LAS bf16x8*)(lds + PG8_SB(b, h) + boff + n * 2048 + k * 1024); } while (0)
#define PG8_MMA(ai, bj, At, Bt) do { __builtin_amdgcn_s_setprio(1); _Pragma("unroll") for (int m = 0; m < 4; ++m) _Pragma("unroll") for (int n = 0; n < 2; ++n) _Pragma("unroll") for (int k = 0; k < 2; ++k) \
        acc[ai][bj][m][n] = __builtin_amdgcn_mfma_f32_16x16x32_bf16(Bt[n][k], At[m][k], acc[ai][bj][m][n], 0, 0, 0); __builtin_amdgcn_s_setprio(0); } while (0)
#define PG8_WAIT_V(n) asm volatile("s_waitcnt vmcnt(" #n ")" ::: "memory")
#define PG8_WAIT_L(n) asm volatile("s_waitcnt lgkmcnt(" #n ")" ::: "memory")
#define PG8_BAR __builtin_amdgcn_s_barrier()
#define PG8_SCHED __builtin_amdgcn_sched_barrier(0)
    Unit cur, nxt; int ui = 0;
    if (!S.next(0, cur)) return;
    f32x4 acc[2][2][4][2];
#pragma unroll
    for (int a = 0; a < 2; ++a)
#pragma unroll
        for (int b = 0; b < 2; ++b)
#pragma unroll
            for (int m = 0; m < 4; ++m)
#pragma unroll
                for (int n = 0; n < 2; ++n) acc[a][b][m][n] = (f32x4){0.f, 0.f, 0.f, 0.f};
    bf16x8 At[4][2], B0[2][2], B1[2][2];
    const char* cA = (const char*)g.A + (size_t)cur.pm * tstep; const char* cB = (const char*)g.Bt + (size_t)cur.pn * tstep;
    S.a_ready(cur);
    if constexpr (SP2) {
        PG8_STAGE(PG8_SB(0, 0), cB, voffB); PG8_STAGE(PG8_SB(0, 1), cB + hstep, voffB); PG8_STAGE(PG8_SA(0, 0), cA, voffA); PG8_STAGE(PG8_SA(0, 1), cA + hstep, voffA);
        if (wr == 1) PG8_BAR;
        PG8_WAIT_V(2); PG8_BAR;
        PG8_STAGE(PG8_SB(1, 0), cB + kstep, voffB); PG8_STAGE(PG8_SA(1, 0), cA + kstep, voffA); PG8_STAGE(PG8_SB(1, 1), cB + hstep + kstep, voffB);
        PG8_WAIT_V(6); PG8_BAR;
    } else {
        PG8_STAGE(PG8_SB(0, 0), cB, voffB); PG8_STAGE(PG8_SA(0, 0), cA, voffA); PG8_STAGE(PG8_SB(0, 1), cB + hstep, voffB); PG8_STAGE(PG8_SA(0, 1), cA + hstep, voffA);
        if (wr == 1) PG8_BAR;
        PG8_WAIT_V(4); PG8_BAR;
        PG8_STAGE(PG8_SB(1, 0), cB + kstep, voffB); PG8_STAGE(PG8_SA(1, 0), cA + kstep, voffA); PG8_STAGE(PG8_SB(1, 1), cB + hstep + kstep, voffB);
        PG8_WAIT_V(6); PG8_BAR;
    }
    for (;;) {
        const bool has_next = S.next(ui + 1, nxt);
        const char* nA = has_next ? (const char*)g.A + (size_t)nxt.pm * tstep : cA; const char* nB = has_next ? (const char*)g.Bt + (size_t)nxt.pn * tstep : cB;
        for (int t = 0; t < nt; t += 2) {
            const bool last = (t == nt - 2);
            const char* a1 = cA + (size_t)(t + 1) * kstep;
            const char* a2 = last ? nA : cA + (size_t)(t + 2) * kstep; const char* b2 = last ? nB : cB + (size_t)(t + 2) * kstep;
            const char* a3 = a2 + kstep; const char* b3 = b2 + kstep;
            if (last && has_next) S.a_ready(nxt);
            if constexpr (SP2) {
            PG8_LDB(B0, 0, 0); PG8_LDB(B1, 0, 1); PG8_SCHED; PG8_LDA(At, 0, 0); PG8_STAGE(PG8_SA(1, 1), a1 + hstep, voffA);
            PG8_WAIT_V(8); PG8_WAIT_L(0); PG8_BAR; PG8_MMA(0, 0, At, B0); PG8_MMA(0, 1, At, B1); PG8_BAR; PG8_SCHED;
            PG8_LDA(At, 0, 1); PG8_STAGE(PG8_SB(0, 0), b2, voffB); PG8_STAGE(PG8_SB(0, 1), b2 + hstep, voffB); PG8_STAGE(PG8_SA(0, 0), a2, voffA);
            PG8_WAIT_V(8); PG8_WAIT_L(0); PG8_BAR; PG8_MMA(1, 0, At, B0); PG8_MMA(1, 1, At, B1); PG8_BAR; PG8_SCHED;
            PG8_LDB(B0, 1, 0); PG8_LDB(B1, 1, 1); PG8_SCHED; PG8_LDA(At, 1, 0); PG8_STAGE(PG8_SA(0, 1), a2 + hstep, voffA);
            PG8_WAIT_V(8); PG8_WAIT_L(0); PG8_BAR; PG8_MMA(0, 0, At, B0); PG8_MMA(0, 1, At, B1); PG8_BAR; PG8_SCHED;
            PG8_LDA(At, 1, 1); PG8_STAGE(PG8_SB(1, 0), b3, voffB); PG8_STAGE(PG8_SB(1, 1), b3 + hstep, voffB); PG8_STAGE(PG8_SA(1, 0), a3, voffA);
            PG8_WAIT_V(8); PG8_WAIT_L(0); PG8_BAR; PG8_MMA(1, 0, At, B0); PG8_MMA(1, 1, At, B1); PG8_BAR; PG8_SCHED;
            } else {
            PG8_LDB(B0, 0, 0); PG8_SCHED; PG8_LDA(At, 0, 0); PG8_STAGE(PG8_SA(1, 1), a1 + hstep, voffA);
            PG8_WAIT_L(8); PG8_BAR; PG8_WAIT_L(0); PG8_MMA(0, 0, At, B0); PG8_BAR; PG8_SCHED;
            PG8_LDB(B1, 0, 1); PG8_STAGE(PG8_SB(0, 0), b2, voffB);
            PG8_BAR; PG8_WAIT_L(0); PG8_MMA(0, 1, At, B1); PG8_BAR;
            PG8_LDA(At, 0, 1); PG8_STAGE(PG8_SA(0, 0), a2, voffA);
            PG8_BAR; PG8_WAIT_L(0); PG8_MMA(1, 0, At, B0); PG8_BAR; PG8_SCHED;
            PG8_STAGE(PG8_SB(0, 1), b2 + hstep, voffB);
            PG8_WAIT_V(6); PG8_BAR; PG8_MMA(1, 1, At, B1); PG8_BAR;
            PG8_LDB(B0, 1, 0); PG8_SCHED; PG8_LDA(At, 1, 0); PG8_STAGE(PG8_SA(0, 1), a2 + hstep, voffA);
            PG8_WAIT_L(8); PG8_BAR; PG8_WAIT_L(0); PG8_MMA(0, 0, At, B0); PG8_BAR; PG8_SCHED;
            PG8_LDB(B1, 1, 1); PG8_STAGE(PG8_SB(1, 0), b3, voffB);
            PG8_BAR; PG8_WAIT_L(0); PG8_MMA(0, 1, At, B1); PG8_BAR;
            PG8_LDA(At, 1, 1); PG8_STAGE(PG8_SA(1, 0), a3, voffA);
            PG8_BAR; PG8_WAIT_L(0); PG8_MMA(1, 0, At, B0); PG8_BAR; PG8_SCHED;
            PG8_STAGE(PG8_SB(1, 1), b3 + hstep, voffB);
            PG8_WAIT_V(6); PG8_BAR; PG8_MMA(1, 1, At, B1); PG8_BAR;
            }
        }
        if constexpr (ALIGN_EPI) { if (wr == 0) PG8_BAR; }
        if constexpr (!Epi::AFTER_DRAIN) { E(acc, cur, wr, wc, fr, fq); S.done(cur); }
        if (!has_next) break;
#pragma unroll
        for (int a = 0; a < 2; ++a)
#pragma unroll
            for (int b = 0; b < 2; ++b)
#pragma unroll
                for (int m = 0; m < 4; ++m)
#pragma unroll
                    for (int n = 0; n < 2; ++n) acc[a][b][m][n] = (f32x4){0.f, 0.f, 0.f, 0.f};
        cur = nxt; cA = nA; cB = nB; ++ui;
        if constexpr (ALIGN_EPI) { if (wr == 1) PG8_BAR; }
    }
    PG8_WAIT_V(0);
    if constexpr (!ALIGN_EPI) { if (wr == 0) PG8_BAR; }
    PG8_BAR;
#undef PG8_SA
#undef PG8_SB
#undef PG8_STAGE
#undef PG8_LDA
#undef PG8_LDB
#undef PG8_MMA
#undef PG8_WAIT_V
#undef PG8_WAIT_L
#undef PG8_BAR
#undef PG8_SCHED
}
}

#define XB_TMO      128
#define XB_XCNT(j)  (256  + 64 * (j))
#define XB_XSUB(j)  (1280 + 64 * (j))
#define XB_XGEN(j)  (2304 + 64 * (j))
#define XB_TOP      3328
#define XB_TOPGEN   3392
#define XCD_BAR_WORDS 3456
#define XB_SPIN_CAP (1u << 22)
__device__ __forceinline__ unsigned xb_ld(unsigned* p)              { return __hip_atomic_load(p, __ATOMIC_RELAXED, __HIP_MEMORY_SCOPE_AGENT); }
__device__ __forceinline__ unsigned xb_add(unsigned* p, unsigned v) { return __hip_atomic_fetch_add(p, v, __ATOMIC_RELAXED, __HIP_MEMORY_SCOPE_AGENT); }
__device__ __forceinline__ unsigned xb_xcc_id() { return (unsigned)__builtin_amdgcn_s_getreg((3 << 11) | 20) & 0xFu; }
#define XB_SPIN(cond, bar) do { unsigned _sp = 0; while (cond) { __builtin_amdgcn_s_sleep(1); \
    if ((++_sp & 255u) == 0u) { if (xb_ld(&(bar)[XB_TMO])) break; if (_sp > XB_SPIN_CAP) { atomicAdd(&(bar)[XB_TMO], 1u); break; } } } } while (0)
struct XcdBarrier { unsigned* bar; unsigned x; volatile LAS unsigned* st; };
__device__ __forceinline__ XcdBarrier xcd_barrier_post(unsigned* bar, volatile LAS unsigned* st) {
    XcdBarrier b; b.bar = bar; b.x = xb_xcc_id(); b.st = st;
    if (threadIdx.x == 0) (void)xb_add(&bar[XB_XCNT(b.x)], 1u);
    return b;
}
__device__ __forceinline__ void xcd_barrier_complete(unsigned* bar, unsigned x, unsigned& nloc, unsigned& nx) {
    const unsigned G = gridDim.x * gridDim.y * gridDim.z;
    unsigned sum, cnt, mine, sp = 0u;
    for (;;) {
        sum = 0u; cnt = 0u; mine = 0u;
#pragma unroll
        for (unsigned j = 0; j < 16; ++j) { const unsigned c = xb_ld(&bar[XB_XCNT(j)]); sum += c; cnt += (c > 0u) ? 1u : 0u; mine = (j == x) ? c : mine; }
        if (sum == G) break;
        __builtin_amdgcn_s_sleep(1);
        if ((++sp & 255u) == 0u) { if (xb_ld(&bar[XB_TMO])) break; if (sp > XB_SPIN_CAP) { atomicAdd(&bar[XB_TMO], 1u); break; } }
    }
    nloc = mine > 0u ? mine : 1u; nx = cnt > 0u ? cnt : 1u;
}
__device__ __forceinline__ void xcd_barrier(const XcdBarrier& b) {
    asm volatile("s_waitcnt vmcnt(0)" ::: "memory");
    __syncthreads();
    if (threadIdx.x == 0) {
        unsigned* bar = b.bar;
        __builtin_amdgcn_s_waitcnt(0);
        unsigned nloc = b.st[0], nx = b.st[1];
        if (nloc == 0u) { xcd_barrier_complete(bar, b.x, nloc, nx); b.st[0] = nloc; b.st[1] = nx; }
        const unsigned old = xb_add(&bar[XB_XSUB(b.x)], 1u);
        const unsigned gen = old / nloc;
        if (old + 1u == (gen + 1u) * nloc) {
            __builtin_amdgcn_fence(__ATOMIC_RELEASE, "agent");
            asm volatile("s_waitcnt vmcnt(0)" ::: "memory");
            const unsigned og = xb_add(&bar[XB_TOP], 1u);
            const unsigned tg = og / nx;
            if (og + 1u == (tg + 1u) * nx) xb_add(&bar[XB_TOPGEN], 1u);
            else XB_SPIN(xb_ld(&bar[XB_TOPGEN]) == tg, bar);
            __builtin_amdgcn_fence(__ATOMIC_ACQUIRE, "agent");
            xb_add(&bar[XB_XGEN(b.x)], 1u);
            asm volatile("s_waitcnt vmcnt(0)" ::: "memory");
        } else {
            XB_SPIN(xb_ld(&bar[XB_XGEN(b.x)]) == gen, bar);
            __builtin_amdgcn_fence(__ATOMIC_ACQUIRE, "agent");
            asm volatile("s_waitcnt vmcnt(0)" ::: "memory");
        }
    }
    __syncthreads();
}

constexpr int RING_OFF = 0, RING_BYTES = 131072;
constexpr int LDSCTL_OFF = 162816, MISC_OFF = LDSCTL_OFF + 320;
constexpr int LDS_BYTES = 163840;

struct Frame {
    LAS unsigned char* lds;
    volatile LAS unsigned* MISC;
    gu32* ctl;
    int tid, lane, wave, G, wg;
    const float* in[21];
    float* out;
    unsigned char* ws;
};

__device__ __forceinline__ void p0_transpose_item(const float* W, int K, int N, bf16* WT, LAS float* scr, int item, int lane) {
    const int nblk = N / 32, kb = item / nblk, nb = item % nblk, k0 = 64 * kb, n0 = 32 * nb;
#pragma unroll 8
    for (int i = 0; i < 32; ++i) { const int kk = 2 * i + (lane >> 5); scr[kk * 33 + (lane & 31)] = W[(size_t)(k0 + kk) * N + n0 + (lane & 31)]; }
    LDS_WAIT(); asm volatile("" ::: "memory");
    const int c = lane & 7;
#pragma unroll
    for (int j = 0; j < 4; ++j) { const int n = (lane >> 3) + 8 * j; const LAS float* s = scr + (8 * c) * 33 + n;
        v4u o; o.x = pk2(s[0 * 33], s[1 * 33]); o.y = pk2(s[2 * 33], s[3 * 33]); o.z = pk2(s[4 * 33], s[5 * 33]); o.w = pk2(s[6 * 33], s[7 * 33]);
        *(GAS v4u*)(WT + (size_t)(n0 + n) * K + k0 + 8 * c) = o; }
    LDS_WAIT(); asm volatile("" ::: "memory");
}
__device__ __forceinline__ void rms_row_to_bf16(int lane, const float* xrow, const float* gain, bf16* orow) {
    const GAS f32x4* xr = (const GAS f32x4*)xrow + lane;
    const GAS f32x4* gr = (const GAS f32x4*)gain + lane;
    f32x4 v[4]; float s = 0.f;
#pragma unroll
    for (int j = 0; j < 4; ++j) { v[j] = xr[64 * j]; s += (v[j].x * v[j].x + v[j].y * v[j].y) + (v[j].z * v[j].z + v[j].w * v[j].w); }
    const float rstd = frsq(wave_sum(s) * (1.f / DM) + RMS_EPS);
    GAS unsigned long long* o8 = (GAS unsigned long long*)orow + lane;
#pragma unroll
    for (int j = 0; j < 4; ++j) { const f32x4 gg = gr[64 * j];
        o8[64 * j] = (unsigned long long)pk2(v[j].x * rstd * gg.x, v[j].y * rstd * gg.y) | ((unsigned long long)pk2(v[j].z * rstd * gg.z, v[j].w * rstd * gg.w) << 32); }
}
__device__ __forceinline__ void cvt_row_to_bf16(int lane, const float* xrow, bf16* orow) {
    const GAS f32x4* xr = (const GAS f32x4*)xrow + lane;
    GAS unsigned long long* o8 = (GAS unsigned long long*)orow + lane;
#pragma unroll
    for (int j = 0; j < 4; ++j) { const f32x4 v = xr[64 * j]; o8[64 * j] = (unsigned long long)pk2(v.x, v.y) | ((unsigned long long)pk2(v.z, v.w) << 32); }
}
__device__ __forceinline__ void p0_prologue(Frame& F) {
    LAS float* scr = (LAS float*)(F.lds + RING_OFF + F.wave * 16384);
    const int gw = F.wg * NWAVES + F.wave, NGW = F.G * NWAVES;
    constexpr int I_IN = (DM / 64) * (IN_COLS / 32), I_OUT = (DM / 64) * (DM / 32), I_Q = (DM / 64) * (PQ / 32);
    constexpr int NITEMS = I_IN + I_OUT + I_Q;
    bf16* win_t = (bf16*)(F.ws + WS_WIN); bf16* wout_t = (bf16*)(F.ws + WS_WOUT); bf16* wq_t = (bf16*)(F.ws + WS_WQ);
    for (int it = gw; it < NITEMS; it += NGW) {
        int r = it;
        if (r < I_IN) { p0_transpose_item(F.in[2], DM, IN_COLS, win_t, scr, r, F.lane); continue; } r -= I_IN;
        if (r < I_OUT) { p0_transpose_item(F.in[14], DM, DM, wout_t, scr, r, F.lane); continue; } r -= I_OUT;
        p0_transpose_item(F.in[16], DM, PQ, wq_t, scr, r, F.lane);
    }
    {
        constexpr int I_W = (64 / 64) * (RWW / 32), I_G = (128 / 64) * (RWW / 32);
        for (int it = gw; it < 2 * I_W + I_G; it += NGW) {
            int r = it;
            if (r < I_W) { p0_transpose_item(F.in[5], 64, RWW, (bf16*)(F.ws + WS_WUPT), scr, r, F.lane); continue; } r -= I_W;
            if (r < I_W) { p0_transpose_item(F.in[7], 64, RWW, (bf16*)(F.ws + WS_AUPT), scr, r, F.lane); continue; } r -= I_W;
            p0_transpose_item(F.in[8], 128, RWW, (bf16*)(F.ws + WS_GUPT), scr, r, F.lane);
        }
    }
    bf16* XN = (bf16*)(F.ws + WS_XN);
    for (int m = gw; m < T; m += NGW) rms_row_to_bf16(F.lane, F.in[0] + (size_t)m * DM, F.in[1], XN + (size_t)m * DM);
    for (int m = gw; m < 2 * NEXP; m += NGW) {
        const int tab = m >= NEXP, row = tab ? m - NEXP : m;
        const GAS f32x4* xr = (const GAS f32x4*)(F.in[18 + tab] + (size_t)row * DM) + F.lane * 4;
        f32x4 v[4]; float am = 0.f;
#pragma unroll
        for (int j = 0; j < 4; ++j) { v[j] = xr[j]; am = fmaxf(am, fmaxf(fmaxf(fabsf(v[j].x), fabsf(v[j].y)), fmaxf(fabsf(v[j].z), fabsf(v[j].w)))); }
        am = wave_max(am);
        const float sc = am > 0.f ? am * (1.f / 127.f) : 1.f, inv = am > 0.f ? 127.f / am : 0.f;
        v4u o;
#pragma unroll
        for (int j = 0; j < 4; ++j) {
            const int bias = tab ? 128 : 0;
            const unsigned b0 = (unsigned)((int)rintf(v[j].x * inv) + bias) & 255u, b1 = (unsigned)((int)rintf(v[j].y * inv) + bias) & 255u,
                           b2 = (unsigned)((int)rintf(v[j].z * inv) + bias) & 255u, b3 = (unsigned)((int)rintf(v[j].w * inv) + bias) & 255u;
            o[j] = b0 | (b1 << 8) | (b2 << 16) | (b3 << 24); }
        *(GAS v4u*)(F.ws + (tab ? WS_VQ : WS_UQ) + (size_t)row * DM + F.lane * 16) = o;
        if (F.lane == 0) ((float*)(F.ws + (tab ? WS_SV : WS_SU)))[row] = sc;
    }
}

__device__ __forceinline__ void p2_rope(Frame& F) {
    bf16* Z = (bf16*)(F.ws + WS_Z);
    const int tid = F.tid, i = tid & 31, grp = tid >> 5;
    const float inv_freq = powf(10000.0f, -(float)(2 * i) / 64.0f);
    for (int blk = F.wg; blk < T / 16; blk += F.G) {
        for (int k = 0; k < 16; ++k) { const int g = blk * 16 + k, s = g & (SEQ - 1);
            const float ang = (float)s * inv_freq;
            const double r = (double)ang - rint((double)ang * 0.15915494309189535) * 6.283185307179586;
            const float rf = (float)r; const float cs = cosf(rf), sn = sinf(rf);
            bf16* p = Z + (size_t)g * IN_COLS + C_AQ + grp * 64 + i;
            const float x1 = bf2f(p[0]), x2 = bf2f(p[32]);
            p[0] = (bf16)f2bf(x1 * cs - x2 * sn); p[32] = (bf16)f2bf(x1 * sn + x2 * cs); }
    }
}

typedef float f32x16 __attribute__((ext_vector_type(16)));
constexpr int SBS = 144;
constexpr int R1_EPRE = 0, R1_APRE = 16384, R1_AAB = 0, R1_X = 16384;
constexpr int R1_AT = 32768, R1_BT = 41984, R1_KT = 51200, R1_RT = 60416, R1_AHT = R1_BT, R1_U0T = R1_KT;
constexpr int R1_BBT = 69632, R1_KBT = 78848, R1_VT = 88064;
constexpr int R1_ACTW = 97280, R1_ACTA = 106496, R1_AAK = 97280, R1_ARB = 106496, R1_ARK = 115712;
constexpr int R1_BONUS = 124928, R1_WEND = 125184, R1_SEGS = 125440, R1_TII = 125440, R1_END = 129536;
static_assert(R1_END <= LDSCTL_OFF, "R1 LDS");
__device__ __forceinline__ int crow(int r, int hh) { return (r & 3) + 8 * (r >> 2) + 4 * hh; }
template <int KS> __device__ __forceinline__ f32x16 wtile(const LAS unsigned char* A, int sa, const LAS unsigned char* B, int sb, f32x16 acc, int lane) {
    const int row = lane & 31, hh = lane >> 5;
#pragma unroll
    for (int s = 0; s < KS; ++s) { const bf16x8 a = *(const LAS bf16x8*)(A + row * sa + 32 * s + 16 * hh); const bf16x8 b = *(const LAS bf16x8*)(B + row * sb + 32 * s + 16 * hh);
        acc = __builtin_amdgcn_mfma_f32_32x32x16_bf16(a, b, acc, 0, 0, 0); }
    return acc;
}
template <int KS> __device__ __forceinline__ f32x16 wtile_gb(const LAS unsigned char* A, int sa, const bf16* Bg, int ldb, f32x16 acc, int lane) {
    const int row = lane & 31, hh = lane >> 5;
#pragma unroll
    for (int s = 0; s < KS; ++s) { const bf16x8 a = *(const LAS bf16x8*)(A + row * sa + 32 * s + 16 * hh); const bf16x8 b = *(const GAS bf16x8*)(Bg + (size_t)row * ldb + 16 * s + 8 * hh);
        acc = __builtin_amdgcn_mfma_f32_32x32x16_bf16(a, b, acc, 0, 0, 0); }
    return acc;
}
__device__ __forceinline__ f32x16 zero16() { f32x16 z;
#pragma unroll
    for (int r = 0; r < 16; ++r) z[r] = 0.f;
    return z; }

struct R1Pre { v4u wd[2], ad[2], z[4]; };
__device__ __forceinline__ int r13_item(int wg, int G, int idx) { return G == 256 ? ((wg >> 3) * 128 + (wg & 7) + 8 * idx) : (wg + G * idx); }
__device__ __forceinline__ int r13_count(int wg, int G) { return G == 256 ? 16 : ((NB * NHR * 128 - wg + G - 1) / G); }
__device__ __forceinline__ void rwkv_r1_prefetch(Frame& F, int item, int tid, R1Pre& P) {
    const int chain = item >> 7, chunk = item & 127, b = chain >> 3, h = chain & 7, g0 = b * SEQ + chunk * 64;
    const bf16* Z = (const bf16*)(F.ws + WS_Z);
    const v4u z0 = (v4u){0u, 0u, 0u, 0u};
    { const int t = tid >> 3, cg = tid & 7; const bool first = (chunk == 0 && t == 0);
      const bf16* zr = Z + (size_t)(g0 + t) * IN_COLS;
      P.wd[0] = *(const GAS v4u*)(zr + C_WD + cg * 8); P.ad[0] = *(const GAS v4u*)(zr + C_AD + cg * 8);
      P.wd[1] = z0; P.ad[1] = z0;
      if (!first) { P.wd[1] = *(const GAS v4u*)(zr - IN_COLS + C_WD + cg * 8); P.ad[1] = *(const GAS v4u*)(zr - IN_COLS + C_AD + cg * 8); } }
#pragma unroll
    for (int q = 0; q < 4; ++q) { const int p = tid + 512 * q; P.z[q] = z0;
        if (p < 65 * 24) { const int row = p / 24, rem = p - row * 24, seg = rem >> 3, ch = rem & 7;
            if (!(chunk == 0 && row == 0)) P.z[q] = *(const GAS v4u*)(Z + (size_t)(g0 - 1 + row) * IN_COLS + seg * 512 + h * 64 + ch * 8); } }
}
constexpr int R1_ZS = R1_AT, R1_ZSS = 384;
static_assert(65 * R1_ZSS <= 4 * 9216, "ZS fits in the At..Rt region");
__device__ __forceinline__ void rwkv_r1_item(Frame& F, int item, int next_item, R1Pre& P) {
    const int chain = item >> 7, chunk = item & 127, b = chain >> 3, h = chain & 7;
    const int g0 = b * SEQ + chunk * 64;
    int tid_ = F.tid; asm volatile("" : "+v"(tid_));
    const int tid = tid_, lane = tid & 63, w = __builtin_amdgcn_readfirstlane(tid >> 6), hh = lane >> 5, cl = lane & 31;
    const bf16* Z = (const bf16*)(F.ws + WS_Z);
    LAS unsigned char* lds = F.lds + RING_OFF;
    const float* mu = F.in[3];
    {
        const int t = tid >> 3, cg = tid & 7;
        const v4u cw = P.wd[0], ca = P.ad[0], pw = P.wd[1], pa = P.ad[1];
        float fw[8], fa[8], qw[8], qa[8];
        fw[0] = bflo(cw.x); fw[1] = bfhi(cw.x); fw[2] = bflo(cw.y); fw[3] = bfhi(cw.y); fw[4] = bflo(cw.z); fw[5] = bfhi(cw.z); fw[6] = bflo(cw.w); fw[7] = bfhi(cw.w);
        fa[0] = bflo(ca.x); fa[1] = bfhi(ca.x); fa[2] = bflo(ca.y); fa[3] = bfhi(ca.y); fa[4] = bflo(ca.z); fa[5] = bfhi(ca.z); fa[6] = bflo(ca.w); fa[7] = bfhi(ca.w);
        qw[0] = bflo(pw.x); qw[1] = bfhi(pw.x); qw[2] = bflo(pw.y); qw[3] = bfhi(pw.y); qw[4] = bflo(pw.z); qw[5] = bfhi(pw.z); qw[6] = bflo(pw.w); qw[7] = bfhi(pw.w);
        qa[0] = bflo(pa.x); qa[1] = bfhi(pa.x); qa[2] = bflo(pa.y); qa[3] = bfhi(pa.y); qa[4] = bflo(pa.z); qa[5] = bfhi(pa.z); qa[6] = bflo(pa.w); qa[7] = bfhi(pa.w);
#pragma unroll
        for (int j = 0; j < 8; ++j) { const int c = cg * 8 + j; const float xw = fw[j] + (qw[j] - fw[j]) * mu[C_WD + c];
            const float ex = __expf(2.f * xw); fw[j] = 1.f - 2.f * frcp(ex + 1.f);
            fa[j] = fa[j] + (qa[j] - fa[j]) * mu[C_AD + c]; }
        v4u ow, oa; ow.x = pk2(fw[0], fw[1]); ow.y = pk2(fw[2], fw[3]); ow.z = pk2(fw[4], fw[5]); ow.w = pk2(fw[6], fw[7]);
        oa.x = pk2(fa[0], fa[1]); oa.y = pk2(fa[2], fa[3]); oa.z = pk2(fa[4], fa[5]); oa.w = pk2(fa[6], fa[7]);
        *(LAS v4u*)(lds + R1_ACTW + t * SBS + cg * 16) = ow; *(LAS v4u*)(lds + R1_ACTA + t * SBS + cg * 16) = oa;
#pragma unroll
        for (int q = 0; q < 4; ++q) { const int p = tid + 512 * q;
            if (p < 65 * 24) { const int row = p / 24, rem = p - row * 24; *(LAS v4u*)(lds + R1_ZS + row * R1_ZSS + rem * 16) = P.z[q]; } }
        if (next_item >= 0) rwkv_r1_prefetch(F, next_item, tid, P);
    }
    LDS_BARRIER();
    {
        const int p = w >> 2, mt = (w >> 1) & 1, nt = w & 1;
        const bf16* upt = (const bf16*)(F.ws + (p == 0 ? WS_WUPT : WS_AUPT)) + (size_t)(h * 64 + nt * 32) * 64;
        const f32x16 acc = wtile_gb<4>(lds + (p == 0 ? R1_ACTW : R1_ACTA) + mt * 32 * SBS, SBS, upt, 64, zero16(), lane);
        LAS float* O = (LAS float*)(lds + (p == 0 ? R1_EPRE : R1_APRE));
#pragma unroll
        for (int r = 0; r < 16; ++r) O[(mt * 32 + crow(r, hh)) * 64 + nt * 32 + cl] = acc[r];
    }
    LDS_BARRIER();
    {
        const int c = tid & 63, ts = tid >> 6, col = h * 64 + c;
        const float mu_r = mu[C_R + col], mu_k = mu[C_K + col], mu_v = mu[C_V + col], kkc = F.in[9][col], kac = F.in[10][col], rkc = F.in[11][col], w0c = F.in[4][col], a0c = F.in[6][col];
        const LAS float* EP = (const LAS float*)(lds + R1_EPRE); const LAS float* AP = (const LAS float*)(lds + R1_APRE);
        LAS float* SEGS = (LAS float*)(lds + R1_SEGS); LAS float* BON = (LAS float*)(lds + R1_BONUS);
        const LAS bf16* zb = (const LAS bf16*)(lds + R1_ZS + (8 * ts) * R1_ZSS) + c;
        float pr = bf2f(zb[0]), pk = bf2f(zb[64]), pv = bf2f(zb[128]);
        float rr[8], k2[8], ai[8], bi[8], vv[8], ee[8], cs[8]; float run = 0.f;
#pragma unroll
        for (int i = 0; i < 8; ++i) {
            const float zr = bf2f(zb[(i + 1) * (R1_ZSS / 2)]), zk = bf2f(zb[(i + 1) * (R1_ZSS / 2) + 64]), zv = bf2f(zb[(i + 1) * (R1_ZSS / 2) + 128]);
            const float r = zr + (pr - zr) * mu_r, k = zk + (pk - zk) * mu_k, v = zv + (pv - zv) * mu_v; pr = zr; pk = zk; pv = zv;
            const float e = 0.60653066f * frcp(1.f + __expf(-(w0c + EP[(8 * ts + i) * 64 + c])));
            const float a = frcp(1.f + __expf(-(a0c + AP[(8 * ts + i) * 64 + c])));
            float kk = k * kkc; const float n2 = wave_sum(kk * kk); kk = kk * frsq(fmaxf(n2, 1e-24f));
            const float kq = k * (1.f + (a - 1.f) * kac);
            const float bon = wave_sum(r * kq * rkc); if (c == 0) BON[8 * ts + i] = bon;
            rr[i] = r; k2[i] = kq; ai[i] = -kk; bi[i] = kk * a; vv[i] = v; ee[i] = e; run += e; cs[i] = run;
        }
        SEGS[ts * 64 + c] = run;
        LDS_BARRIER();
        float off = 0.f, tot = 0.f;
#pragma unroll
        for (int q = 0; q < 8; ++q) { const float sv = SEGS[q * 64 + c]; tot += sv; off += (q < ts) ? sv : 0.f; }
        float bb[8], kb[8];
#pragma unroll
        for (int i = 0; i < 8; ++i) { const float L = off + cs[i];
            const float Wm = __expf(-(L - ee[i])), Wi = __expf(-L), iW = __expf(L), We = __expf(-(tot - L));
            const int t = 8 * ts + i;
            *(LAS bf16*)(lds + R1_AT + t * SBS + c * 2) = (bf16)f2bf(ai[i] * Wm);
            *(LAS bf16*)(lds + R1_BT + t * SBS + c * 2) = (bf16)f2bf(bi[i] * iW);
            *(LAS bf16*)(lds + R1_KT + t * SBS + c * 2) = (bf16)f2bf(k2[i] * iW);
            *(LAS bf16*)(lds + R1_RT + t * SBS + c * 2) = (bf16)f2bf(rr[i] * Wi);
            bb[i] = bi[i] * We; kb[i] = k2[i] * We; }
        v4u o; o.x = pk2(bb[0], bb[1]); o.y = pk2(bb[2], bb[3]); o.z = pk2(bb[4], bb[5]); o.w = pk2(bb[6], bb[7]);
        *(LAS v4u*)(lds + R1_BBT + c * SBS + ts * 16) = o;
        o.x = pk2(kb[0], kb[1]); o.y = pk2(kb[2], kb[3]); o.z = pk2(kb[4], kb[5]); o.w = pk2(kb[6], kb[7]);
        *(LAS v4u*)(lds + R1_KBT + c * SBS + ts * 16) = o;
        o.x = pk2(vv[0], vv[1]); o.y = pk2(vv[2], vv[3]); o.z = pk2(vv[4], vv[5]); o.w = pk2(vv[6], vv[7]);
        *(LAS v4u*)(lds + R1_VT + c * SBS + ts * 16) = o;
        if (ts == 0) ((LAS float*)(lds + R1_WEND))[c] = __expf(-tot);
    }
    LDS_BARRIER();
#pragma unroll
    for (int u = 0; u < 2; ++u) {
        const int idx = w * 2 + u, p = idx >> 2, mt = (idx >> 1) & 1, nt = idx & 1;
        const LAS unsigned char* Aop = lds + ((p == 0 || p == 2) ? R1_BT : R1_KT) + mt * 32 * SBS;
        const LAS unsigned char* Bop = lds + (p < 2 ? R1_AT : R1_RT) + nt * 32 * SBS;
        f32x16 acc = wtile<4>(Aop, SBS, Bop, SBS, zero16(), lane);
        const int n = nt * 32 + cl;
#pragma unroll
        for (int r = 0; r < 16; ++r) { const int m = mt * 32 + crow(r, hh); const bool keep = (p < 2) ? (m < n) : (m <= n); acc[r] = keep ? acc[r] : 0.f; }
#pragma unroll
        for (int g4 = 0; g4 < 4; ++g4) { const int m0 = mt * 32 + 8 * g4 + 4 * hh;
            if (p == 0) *(LAS f32x4*)(lds + R1_AAB + (n * 64 + m0) * 4) = (f32x4){acc[4 * g4], acc[4 * g4 + 1], acc[4 * g4 + 2], acc[4 * g4 + 3]};
            else { v2u o; o.x = pk2(acc[4 * g4], acc[4 * g4 + 1]); o.y = pk2(acc[4 * g4 + 2], acc[4 * g4 + 3]);
                   *(LAS v2u*)(lds + (p == 1 ? R1_AAK : (p == 2 ? R1_ARB : R1_ARK)) + n * SBS + m0 * 2) = o; } }
    }
    LDS_BARRIER();
    if (w < 4) {
        const int mt = w >> 1, nt = w & 1;
        const f32x16 acc = wtile<4>(lds + R1_AAK + mt * 32 * SBS, SBS, lds + R1_VT + nt * 32 * SBS, SBS, zero16(), lane);
        LAS float* X = (LAS float*)(lds + R1_X);
#pragma unroll
        for (int r = 0; r < 16; ++r) X[(mt * 32 + crow(r, hh)) * 64 + nt * 32 + cl] = acc[r];
    } else if (w == 4) {
        const int bk = lane >> 4, c = lane & 15;
        const LAS float* AAB = (const LAS float*)(lds + R1_AAB);
        float Tc[16]; const float fc = (float)c;
#pragma unroll
        for (int s2 = 0; s2 < 16; ++s2) Tc[s2] = fmaxf(0.f, 1.f - fabsf((float)s2 - fc));
#pragma unroll
        for (int r = 0; r < 15; ++r)
#pragma unroll
            for (int s2 = r + 1; s2 < 16; ++s2) Tc[s2] += AAB[(16 * bk + s2) * 64 + 16 * bk + r] * Tc[r];
        LAS float* TII = (LAS float*)(lds + R1_TII);
#pragma unroll
        for (int s2 = 0; s2 < 16; ++s2) TII[(bk * 16 + s2) * 16 + c] = Tc[s2];
    }
    LDS_BARRIER();
    {
        const int c16 = lane & 15, g = lane >> 4;
        const LAS float* AAB = (const LAS float*)(lds + R1_AAB); const LAS float* TII = (const LAS float*)(lds + R1_TII); const LAS float* X = (const LAS float*)(lds + R1_X);
        f32x4 o[4];
#pragma unroll
        for (int i = 0; i < 4; ++i) {
            f32x4 acc;
            if (w < 4) {
#pragma unroll
                for (int q = 0; q < 4; ++q) acc[q] = bf2f(*(const LAS bf16*)(lds + R1_AT + (16 * i + 4 * g + q) * SBS + (16 * w + c16) * 2));
            } else {
#pragma unroll
                for (int q = 0; q < 4; ++q) acc[q] = X[(16 * i + 4 * g + q) * 64 + 16 * (w - 4) + c16];
            }
#pragma unroll
            for (int j = 0; j < i; ++j) { const f32x4 a4 = *(const LAS f32x4*)(AAB + (16 * i + c16) * 64 + 16 * j + 4 * g);
#pragma unroll
                for (int q = 0; q < 4; ++q) acc = __builtin_amdgcn_mfma_f32_16x16x4f32(a4[q], o[j][q], acc, 0, 0, 0); }
            const f32x4 t4 = *(const LAS f32x4*)(TII + (i * 16 + c16) * 16 + 4 * g);
            f32x4 res = (f32x4){0.f, 0.f, 0.f, 0.f};
#pragma unroll
            for (int q = 0; q < 4; ++q) res = __builtin_amdgcn_mfma_f32_16x16x4f32(t4[q], acc[q], res, 0, 0, 0);
            o[i] = res;
            v2u ov; ov.x = pk2(res[0], res[1]); ov.y = pk2(res[2], res[3]);
            *(LAS v2u*)(lds + (w < 4 ? R1_AHT : R1_U0T) + (16 * (w & 3) + c16) * SBS + (16 * i + 4 * g) * 2) = ov;
        }
    }
    LDS_BARRIER();
    {
        float* Mg = F.out + (size_t)item * 4096; float* NTg = F.out + (size_t)T * RWW + (size_t)item * 4096;
        float* Y0g = (float*)(F.ws + WS_RWY0) + (size_t)item * 4096; bf16* RHg = (bf16*)(F.ws + WS_RWRH) + (size_t)item * 4096;
#pragma unroll
        for (int u = 0; u < 2; ++u) {
            const int idx = w * 2 + u, p = idx >> 2, mt = (idx >> 1) & 1, nt = idx & 1; const int n = nt * 32 + cl;
            if (p == 0) {
                f32x16 acc = wtile<4>(lds + R1_AHT + mt * 32 * SBS, SBS, lds + R1_BBT + nt * 32 * SBS, SBS, zero16(), lane);
                const float we = ((const LAS float*)(lds + R1_WEND))[n];
#pragma unroll
                for (int g4 = 0; g4 < 4; ++g4) { const int m0 = mt * 32 + 8 * g4 + 4 * hh;
                    *(GAS f32x4*)(Mg + n * 64 + m0) = (f32x4){acc[4 * g4] + (m0 == n ? we : 0.f), acc[4 * g4 + 1] + (m0 + 1 == n ? we : 0.f), acc[4 * g4 + 2] + (m0 + 2 == n ? we : 0.f), acc[4 * g4 + 3] + (m0 + 3 == n ? we : 0.f)}; }
            } else if (p == 1) {
                f32x16 acc = wtile<4>(lds + R1_BBT + mt * 32 * SBS, SBS, lds + R1_U0T + nt * 32 * SBS, SBS, zero16(), lane);
                acc = wtile<4>(lds + R1_KBT + mt * 32 * SBS, SBS, lds + R1_VT + nt * 32 * SBS, SBS, acc, lane);
#pragma unroll
                for (int g4 = 0; g4 < 4; ++g4) *(GAS f32x4*)(NTg + n * 64 + mt * 32 + 8 * g4 + 4 * hh) = (f32x4){acc[4 * g4], acc[4 * g4 + 1], acc[4 * g4 + 2], acc[4 * g4 + 3]};
            } else if (p == 2) {
                f32x16 acc = wtile<4>(lds + R1_AHT + mt * 32 * SBS, SBS, lds + R1_ARB + nt * 32 * SBS, SBS, zero16(), lane);
#pragma unroll
                for (int g4 = 0; g4 < 4; ++g4) { const int m0 = mt * 32 + 8 * g4 + 4 * hh;
                    const v2u rt = *(const LAS v2u*)(lds + R1_RT + n * SBS + m0 * 2);
                    v2u ov; ov.x = pk2(acc[4 * g4] + bflo(rt.x), acc[4 * g4 + 1] + bfhi(rt.x)); ov.y = pk2(acc[4 * g4 + 2] + bflo(rt.y), acc[4 * g4 + 3] + bfhi(rt.y));
                    *(GAS v2u*)(RHg + n * 64 + m0) = ov; }
            } else {
                f32x16 acc = wtile<4>(lds + R1_U0T + mt * 32 * SBS, SBS, lds + R1_ARB + nt * 32 * SBS, SBS, zero16(), lane);
                acc = wtile<4>(lds + R1_VT + mt * 32 * SBS, SBS, lds + R1_ARK + nt * 32 * SBS, SBS, acc, lane);
#pragma unroll
                for (int g4 = 0; g4 < 4; ++g4) *(GAS f32x4*)(Y0g + n * 64 + mt * 32 + 8 * g4 + 4 * hh) = (f32x4){acc[4 * g4], acc[4 * g4 + 1], acc[4 * g4 + 2], acc[4 * g4 + 3]};
            }
        }
        if (tid < 64) ((float*)(F.ws + WS_BONUS))[(size_t)item * 64 + tid] = ((const LAS float*)(lds + R1_BONUS))[tid];
    }
    LDS_BARRIER();
}

__device__ __forceinline__ void rwkv_r2_chain(Frame& F, int chain) {
    const int w = F.wave; if (w >= 4) return;
    const int lane = F.lane, n16 = lane & 15, g = lane >> 4;
    const float* Mg = F.out + (size_t)chain * 128 * 4096; const float* NTg = F.out + (size_t)T * RWW + (size_t)chain * 128 * 4096;
    float* SSg = (float*)(F.ws + WS_RWSS) + (size_t)chain * 128 * 4096;
    f32x4 st[4];
#pragma unroll
    for (int rt = 0; rt < 4; ++rt) st[rt] = (f32x4){0.f, 0.f, 0.f, 0.f};
    f32x4 ma[4][4], nv[4];
#pragma unroll
    for (int rt = 0; rt < 4; ++rt) {
#pragma unroll
        for (int kt = 0; kt < 4; ++kt) ma[rt][kt] = *(const GAS f32x4*)(Mg + (16 * rt + n16) * 64 + 16 * kt + 4 * g);
        nv[rt] = *(const GAS f32x4*)(NTg + (16 * w + n16) * 64 + 16 * rt + 4 * g); }
    for (int c = 0; c < 128; ++c) {
#pragma unroll
        for (int rt = 0; rt < 4; ++rt) *(GAS f32x4*)(SSg + (size_t)c * 4096 + (16 * w + n16) * 64 + 16 * rt + 4 * g) = st[rt];
        if (c == 127) break;
        f32x4 nw[4];
#pragma unroll
        for (int rt = 0; rt < 4; ++rt) { f32x4 acc = nv[rt];
#pragma unroll
            for (int kt = 0; kt < 4; ++kt)
#pragma unroll
                for (int q = 0; q < 4; ++q) acc = __builtin_amdgcn_mfma_f32_16x16x4f32(ma[rt][kt][q], st[kt][q], acc, 0, 0, 0);
            nw[rt] = acc; }
        const float* Mn = Mg + (size_t)(c + 1) * 4096; const float* Nn = NTg + (size_t)(c + 1) * 4096;
#pragma unroll
        for (int rt = 0; rt < 4; ++rt) {
#pragma unroll
            for (int kt = 0; kt < 4; ++kt) ma[rt][kt] = *(const GAS f32x4*)(Mn + (16 * rt + n16) * 64 + 16 * kt + 4 * g);
            nv[rt] = *(const GAS f32x4*)(Nn + (16 * w + n16) * 64 + 16 * rt + 4 * g); }
#pragma unroll
        for (int rt = 0; rt < 4; ++rt) st[rt] = nw[rt];
    }
}

constexpr int R3_RH = 0, R3_S = 9216, R3_SG = 18432, R3_SGS = 272, R3_YL = R3_SG + 64 * R3_SGS, R3_GL = R3_YL + 16384, R3_END = R3_GL + 16384;
static_assert(R3_END <= LDSCTL_OFF, "R3 LDS");
__device__ __forceinline__ void rwkv_r3_item(Frame& F, int item) {
    const int chain = item >> 7, chunk = item & 127, b = chain >> 3, h = chain & 7;
    const int g0 = b * SEQ + chunk * 64;
    int tid_ = F.tid; asm volatile("" : "+v"(tid_));
    const int tid = tid_, lane = tid & 63, w = __builtin_amdgcn_readfirstlane(tid >> 6), hh = lane >> 5, cl = lane & 31;
    const bf16* Z = (const bf16*)(F.ws + WS_Z);
    LAS unsigned char* lds = F.lds + RING_OFF;
    const float* mu = F.in[3];
    {
        const int t = tid >> 3, cg = tid & 7;
        const bf16* RHg = (const bf16*)(F.ws + WS_RWRH) + (size_t)item * 4096;
        *(LAS v4u*)(lds + R3_RH + t * SBS + cg * 16) = *(const GAS v4u*)(RHg + t * 64 + cg * 8);
        const float* SSg = (const float*)(F.ws + WS_RWSS) + (size_t)item * 4096;
        const f32x4 s0 = *(const GAS f32x4*)(SSg + t * 64 + cg * 8), s1 = *(const GAS f32x4*)(SSg + t * 64 + cg * 8 + 4);
        v4u o; o.x = pk2(s0[0], s0[1]); o.y = pk2(s0[2], s0[3]); o.z = pk2(s1[0], s1[1]); o.w = pk2(s1[2], s1[3]);
        *(LAS v4u*)(lds + R3_S + t * SBS + cg * 16) = o;
        const bool first = (chunk == 0 && t == 0);
        const bf16* zr = Z + (size_t)(g0 + t) * IN_COLS + C_GD + cg * 16;
#pragma unroll
        for (int q = 0; q < 2; ++q) {
            const v4u cw = *(const GAS v4u*)(zr + q * 8); v4u pw = (v4u){0u, 0u, 0u, 0u};
            if (!first) pw = *(const GAS v4u*)(zr - IN_COLS + q * 8);
            float fw[8], qw[8];
            fw[0] = bflo(cw.x); fw[1] = bfhi(cw.x); fw[2] = bflo(cw.y); fw[3] = bfhi(cw.y); fw[4] = bflo(cw.z); fw[5] = bfhi(cw.z); fw[6] = bflo(cw.w); fw[7] = bfhi(cw.w);
            qw[0] = bflo(pw.x); qw[1] = bfhi(pw.x); qw[2] = bflo(pw.y); qw[3] = bfhi(pw.y); qw[4] = bflo(pw.z); qw[5] = bfhi(pw.z); qw[6] = bflo(pw.w); qw[7] = bfhi(pw.w);
#pragma unroll
            for (int j = 0; j < 8; ++j) { const float v = fw[j] + (qw[j] - fw[j]) * mu[C_GD + cg * 16 + q * 8 + j]; fw[j] = frcp(1.f + __expf(-v)); }
            v4u og; og.x = pk2(fw[0], fw[1]); og.y = pk2(fw[2], fw[3]); og.z = pk2(fw[4], fw[5]); og.w = pk2(fw[6], fw[7]);
            *(LAS v4u*)(lds + R3_SG + t * R3_SGS + (cg * 16 + q * 8) * 2) = og;
        }
    }
    LDS_BARRIER();
    {
        const int mt = (w >> 1) & 1, nt = w & 1; const int n = nt * 32 + cl;
        if (w < 4) {
            const float* Y0g = (const float*)(F.ws + WS_RWY0) + (size_t)item * 4096;
            f32x16 acc;
#pragma unroll
            for (int r = 0; r < 16; ++r) acc[r] = Y0g[(mt * 32 + crow(r, hh)) * 64 + n];
            acc = wtile<4>(lds + R3_RH + mt * 32 * SBS, SBS, lds + R3_S + nt * 32 * SBS, SBS, acc, lane);
            LAS float* YL = (LAS float*)(lds + R3_YL);
#pragma unroll
            for (int r = 0; r < 16; ++r) YL[(mt * 32 + crow(r, hh)) * 64 + n] = acc[r];
        } else {
            const bf16* gut = (const bf16*)(F.ws + WS_GUPT) + (size_t)(h * 64 + nt * 32) * 128;
            const f32x16 acc = wtile_gb<8>(lds + R3_SG + mt * 32 * R3_SGS, R3_SGS, gut, 128, zero16(), lane);
            LAS float* GL = (LAS float*)(lds + R3_GL);
#pragma unroll
            for (int r = 0; r < 16; ++r) GL[(mt * 32 + crow(r, hh)) * 64 + n] = acc[r];
        }
    }
    LDS_BARRIER();
    {
        const int c = tid & 63, ts = tid >> 6, col = h * 64 + c;
        const float mu_v = mu[C_V + col], gw = F.in[12][col], gb = F.in[13][col];
        const LAS float* YL = (const LAS float*)(lds + R3_YL); const LAS float* GL = (const LAS float*)(lds + R3_GL);
        const float* BON = (const float*)(F.ws + WS_BONUS) + (size_t)item * 64;
        bf16* Y = (bf16*)(F.ws + WS_YMIX);
        const bf16* zb = Z + (size_t)(g0 + 8 * ts) * IN_COLS + col;
        float pv = 0.f; if (!(chunk == 0 && ts == 0)) pv = bf2f(zb[C_V - IN_COLS]);
#pragma unroll
        for (int i = 0; i < 8; ++i) { const int t = 8 * ts + i;
            const float zv = bf2f(zb[(size_t)i * IN_COLS + C_V]); const float v = zv + (pv - zv) * mu_v; pv = zv;
            const float y = YL[t * 64 + c];
            const float mean = wave_sum(y) * (1.f / 64.f); const float d = y - mean; const float var = wave_sum(d * d) * (1.f / 64.f);
            const float yn = d * frsq(var + GN_EPS) * gw + gb;
            const float o = (yn + BON[t] * v) * GL[t * 64 + c];
            Y[(size_t)(g0 + t) * DM + col] = (bf16)f2bf(o); }
    }
    LDS_BARRIER();
}

typedef short s16x4 __attribute__((ext_vector_type(4)));
typedef short v4i16_t __attribute__((ext_vector_type(4)));
constexpr int AT_XO = 0, AT_XO_STRIDE = 136, AT_XM = 512 * AT_XO_STRIDE, AT_XL = AT_XM + 2048, AT_V = AT_XL + 2048, AT_LDS_END = AT_V + 8 * 4096;
static_assert(AT_LDS_END <= RING_BYTES, "attention LDS");
__device__ __forceinline__ float xhalf(float v) { return __shfl_xor(v, 32); }
__device__ __forceinline__ void attn_block(Frame& F, int item) {
    const int bh = item >> 4, blk = item & 15, b = bh >> 3, h = bh & 7, t0 = blk * 512;
    int tid_ = F.tid; asm volatile("" : "+v"(tid_));
    const int lane = tid_ & 63, w = __builtin_amdgcn_readfirstlane(tid_ >> 6), ql = lane & 31, hh = lane >> 5;
    const bf16* Zb = (const bf16*)(F.ws + WS_Z) + (size_t)b * SEQ * IN_COLS;
    bf16* Y = (bf16*)(F.ws + WS_YMIX);
    LAS unsigned char* lds = F.lds + RING_OFF;
    LAS unsigned char* Vw = lds + AT_V + w * 4096;
    LAS float* XM = (LAS float*)(lds + AT_XM); LAS float* XL = (LAS float*)(lds + AT_XL);
    constexpr float C2 = 0.125f * 1.4426950408889634f;
    for (int pass = 0; pass < 3; ++pass) {
        const int sh = pass == 0 ? 4 : (pass == 1 ? 2 : 0), d = 1 << sh;
        for (int uu = 0; uu < 2; ++uu) {
            const int u = w + 8 * uu, rho = u & (d - 1), tau = u >> sh;
            const int qoff = rho + (32 * tau + ql) * d;
            bf16x8 qf[4];
            { const bf16* qp = Zb + (size_t)(t0 + qoff) * IN_COLS + C_AQ + h * 64 + 8 * hh;
#pragma unroll
              for (int s = 0; s < 4; ++s) qf[s] = *(const GAS bf16x8*)(qp + 16 * s); }
            f32x16 sc[5];
            const int tkb = t0 + rho + (32 * tau - 128) * d;
#pragma unroll
            for (int kt = 0; kt < 5; ++kt) {
                const int tk0 = tkb + 32 * kt * d;
                if (tk0 >= 0) {
                    const bf16* kp = Zb + (size_t)(tk0 + ql * d) * IN_COLS + C_AK + h * 64 + 8 * hh;
                    bf16x8 kf[4];
#pragma unroll
                    for (int s = 0; s < 4; ++s) kf[s] = *(const GAS bf16x8*)(kp + 16 * s);
                    f32x16 acc;
#pragma unroll
                    for (int r = 0; r < 16; ++r) acc[r] = 0.f;
#pragma unroll
                    for (int s = 0; s < 4; ++s) acc = __builtin_amdgcn_mfma_f32_32x32x16_bf16(kf[s], qf[s], acc, 0, 0, 0);
                    if (kt == 0 || kt == 4) {
#pragma unroll
                        for (int r = 0; r < 16; ++r) { const int kidx = (r & 3) + 8 * (r >> 2) + 4 * hh;
                            const bool ok = (kt == 0) ? (kidx >= ql) : (kidx <= ql);
                            acc[r] = ok ? acc[r] : -INFINITY; }
                    }
                    sc[kt] = acc;
                } else {
#pragma unroll
                    for (int r = 0; r < 16; ++r) sc[kt][r] = -INFINITY;
                }
            }
            float m = -INFINITY;
#pragma unroll
            for (int kt = 0; kt < 5; ++kt)
#pragma unroll
                for (int r = 0; r < 16; ++r) m = fmaxf(m, sc[kt][r]);
            m = fmaxf(m, xhalf(m));
            const float ms = m * C2;
            float l = 0.f;
#pragma unroll
            for (int kt = 0; kt < 5; ++kt)
#pragma unroll
                for (int r = 0; r < 16; ++r) { const float p = __builtin_amdgcn_exp2f(sc[kt][r] * C2 - ms); sc[kt][r] = p; l += p; }
            l += xhalf(l);
            f32x16 O[2];
#pragma unroll
            for (int r = 0; r < 16; ++r) { O[0][r] = 0.f; O[1][r] = 0.f; }
#pragma unroll
            for (int kt = 0; kt < 5; ++kt) {
                const int tk0 = tkb + 32 * kt * d;
                if (tk0 >= 0) {
                    v4u vr[4];
#pragma unroll
                    for (int i = 0; i < 4; ++i) { const int kidx = i * 8 + (lane >> 3), ch = lane & 7;
                        vr[i] = *(const GAS v4u*)(Zb + (size_t)(tk0 + kidx * d) * IN_COLS + C_AV + h * 64 + ch * 8); }
#pragma unroll
                    for (int i = 0; i < 4; ++i) { const int kidx = i * 8 + (lane >> 3), ch = lane & 7;
                        *(LAS v4u*)(Vw + kidx * 128 + ((ch ^ (((kidx >> 1) & 1) << 2)) << 4)) = vr[i]; }
                    asm volatile("s_waitcnt lgkmcnt(0)" ::: "memory");
#pragma unroll
                    for (int s = 0; s < 2; ++s) {
                        bf16x8 pf;
#pragma unroll
                        for (int j = 0; j < 8; ++j) pf[j] = (short)f2bf(sc[kt][8 * s + j]);
#pragma unroll
                        for (int dt = 0; dt < 2; ++dt) {
                            bf16x8 vf;
#pragma unroll
                            for (int pp = 0; pp < 2; ++pp) {
                                const int i16 = lane & 15, db = (lane >> 4) & 1;
                                const int row = 16 * s + 8 * pp + 4 * hh + (i16 >> 2);
                                const int byte = 64 * dt + 32 * db + 8 * (i16 & 3);
                                const int chunk = (byte >> 4) ^ (((row >> 1) & 1) << 2);
                                const s16x4 t4 = __builtin_bit_cast(s16x4, __builtin_amdgcn_ds_read_tr16_b64_v4i16((LAS v4i16_t*)(Vw + row * 128 + (chunk << 4) + (byte & 15))));
                                vf[4 * pp + 0] = t4[0]; vf[4 * pp + 1] = t4[1]; vf[4 * pp + 2] = t4[2]; vf[4 * pp + 3] = t4[3];
                            }
                            O[dt] = __builtin_amdgcn_mfma_f32_32x32x16_bf16(vf, pf, O[dt], 0, 0, 0);
                        }
                    }
                    asm volatile("s_waitcnt lgkmcnt(0)" ::: "memory");
                }
            }
            LAS unsigned char* xo = lds + AT_XO + qoff * AT_XO_STRIDE + 8 * hh;
            float wa = 0.f, wb = 1.f, Mx = ms, ln = l;
            if (pass > 0) { const float msa = XM[qoff], la = XL[qoff]; Mx = fmaxf(msa, ms); wa = la * __builtin_amdgcn_exp2f(msa - Mx); wb = __builtin_amdgcn_exp2f(ms - Mx); ln = wa + wb * l; }
            const float inv = 1.f / ln;
#pragma unroll
            for (int dt = 0; dt < 2; ++dt)
#pragma unroll
                for (int g4 = 0; g4 < 4; ++g4) {
                    LAS v2u* p = (LAS v2u*)(xo + (32 * dt + 8 * g4) * 2);
                    float o0 = O[dt][4 * g4] * wb, o1 = O[dt][4 * g4 + 1] * wb, o2 = O[dt][4 * g4 + 2] * wb, o3 = O[dt][4 * g4 + 3] * wb;
                    if (pass > 0) { const v2u old = *p; o0 += bflo(old.x) * wa; o1 += bfhi(old.x) * wa; o2 += bflo(old.y) * wa; o3 += bfhi(old.y) * wa; }
                    v2u nw; nw.x = pk2(o0 * inv, o1 * inv); nw.y = pk2(o2 * inv, o3 * inv);
                    *p = nw;
                }
            if (hh == 0) { XM[qoff] = Mx; XL[qoff] = ln; }
        }
        LDS_BARRIER();
    }
#pragma unroll
    for (int i = 0; i < 8; ++i) { const int row = (tid_ >> 3) + 64 * i, ch = tid_ & 7;
        LAS v2u* p = (LAS v2u*)(lds + AT_XO + row * AT_XO_STRIDE + ch * 16);
        const v2u a = p[0], c = p[1];
        v4u o; o.x = a.x; o.y = a.y; o.z = c.x; o.w = c.y;
        *(GAS v4u*)(Y + ((size_t)b * SEQ + t0 + row) * DM + RWW + h * 64 + ch * 8) = o; }
    LDS_BARRIER();
}

__device__ __forceinline__ void p3_mixers(Frame& F) {
    const int nrw = (F.G >= 64) ? 32 : 0;
    if (nrw == 0) { for (int ch = 0; ch < NB * NHR; ++ch) rwkv_r2_chain(F, ch); }
    else if (F.wg < nrw) { for (int ch = F.wg; ch < NB * NHR; ch += nrw) rwkv_r2_chain(F, ch); return; }
    const int na = F.G - nrw, wa = F.wg - nrw;
    for (int item = wa; item < NB * NHA * (SEQ / 512); item += na) attn_block(F, item);
}

__device__ __forceinline__ void p5_xn2(Frame& F) {
    const int gw = F.wg * NWAVES + F.wave, NGW = F.G * NWAVES;
    bf16* XN = (bf16*)(F.ws + WS_XN);
    for (int m = gw; m < T; m += NGW) rms_row_to_bf16(F.lane, F.out + (size_t)m * DM, F.in[15], XN + (size_t)m * DM);
}

constexpr int TK_SKS = 272, TK_SKH = 0, TK_SKL = 2 * 128 * TK_SKS, TK_LUT = 2 * TK_SKL, TK_END = TK_LUT + 8 * 2048;
__device__ __forceinline__ unsigned f2ord(float f) { const unsigned u = __builtin_bit_cast(unsigned, f); return u ^ ((unsigned)((int)u >> 31) | 0x80000000u); }
__device__ __forceinline__ float ord2f(unsigned o) { const unsigned u = (o & 0x80000000u) ? (o ^ 0x80000000u) : ~o; return __builtin_bit_cast(float, u); }
__device__ __forceinline__ void ce_desc(unsigned& a, unsigned& b) { const unsigned mx = a > b ? a : b, mn = a > b ? b : a; a = mx; b = mn; }
template <int N, int OFF, int TOT> __device__ __forceinline__ void bitonic_sort_desc(unsigned (&v)[TOT]) {
#pragma unroll
    for (int k = 2; k <= N; k <<= 1)
#pragma unroll
        for (int j = k >> 1; j > 0; j >>= 1)
#pragma unroll
            for (int i = 0; i < N; ++i) { const int l = i ^ j; if (l > i) { if ((i & k) == 0) ce_desc(v[OFF + i], v[OFF + l]); else ce_desc(v[OFF + l], v[OFF + i]); } }
}
template <int OFFA, int OFFB, int TOT> __device__ __forceinline__ void merge_top16(unsigned (&v)[TOT]) {
#pragma unroll
    for (int i = 0; i < 16; ++i) { const unsigned x = v[OFFA + i], y = v[OFFB + 15 - i]; v[OFFA + i] = x > y ? x : y; }
#pragma unroll
    for (int j = 8; j > 0; j >>= 1)
#pragma unroll
        for (int i = 0; i < 16; ++i) { const int l = i ^ j; if (l > i) ce_desc(v[OFFA + i], v[OFFA + l]); }
}
__device__ __forceinline__ void top16_of_64(unsigned (&k)[64]) {
    bitonic_sort_desc<16, 0, 64>(k); bitonic_sort_desc<16, 16, 64>(k); bitonic_sort_desc<16, 32, 64>(k); bitonic_sort_desc<16, 48, 64>(k);
    merge_top16<0, 16, 64>(k); merge_top16<32, 48, 64>(k); merge_top16<0, 32, 64>(k);
}
__device__ __forceinline__ void p7_topk(Frame& F) {
    static_assert(TK_END <= LDSCTL_OFF, "topk LDS");
    const bf16* QP = (const bf16*)(F.ws + WS_QP);
    int* EID = (int*)(F.ws + WS_EID); float* GATE = (float*)(F.ws + WS_GATE);
    const float* sk = F.in[17];
    LAS unsigned char* lds = F.lds + RING_OFF;
    for (int e = F.tid; e < 2 * 128 * 64; e += NTHREADS) {
        const int c = e >> 13, k = (e >> 6) & 127, d2 = e & 63;
        const f32x2 v = *(const GAS f32x2*)(sk + (size_t)(c * 128 + k) * 128 + 2 * d2);
        const unsigned h0 = f2bf(v.x), h1 = f2bf(v.y);
        const float r0 = v.x - __builtin_bit_cast(float, h0 << 16), r1 = v.y - __builtin_bit_cast(float, h1 << 16);
        *(LAS unsigned*)(lds + TK_SKH + (c * 128 + k) * TK_SKS + d2 * 4) = h0 | (h1 << 16);
        *(LAS unsigned*)(lds + TK_SKL + (c * 128 + k) * TK_SKS + d2 * 4) = pk2(r0, r1);
    }
    __syncthreads();
    const int gw = F.wg * NWAVES + F.wave, NGW = F.G * NWAVES;
    for (int tile = gw; tile < T * PHEADS / 32; tile += NGW) {
        int lane_ = F.lane; asm volatile("" : "+v"(lane_));
        const int lane = lane_, hh = lane >> 5, cl = lane & 31;
        const int P = tile * 32 + cl, t = P >> 3, h = P & 7;
        unsigned kAB[2][16];
#pragma unroll
        for (int c = 0; c < 2; ++c) {
            bf16x8 qf[8];
            const bf16* qp = QP + (size_t)t * PQ + h * 256 + c * 128 + 8 * hh;
#pragma unroll
            for (int s2 = 0; s2 < 8; ++s2) qf[s2] = *(const GAS bf16x8*)(qp + 16 * s2);
            unsigned k[64];
#pragma unroll
            for (int mt = 0; mt < 4; ++mt) {
                f32x16 acc = zero16();
                const LAS unsigned char* ah = lds + TK_SKH + (c * 128 + mt * 32 + cl) * TK_SKS + 16 * hh;
                const LAS unsigned char* al = lds + TK_SKL + (c * 128 + mt * 32 + cl) * TK_SKS + 16 * hh;
#pragma unroll
                for (int s2 = 0; s2 < 8; ++s2) {
                    acc = __builtin_amdgcn_mfma_f32_32x32x16_bf16(*(const LAS bf16x8*)(ah + 32 * s2), qf[s2], acc, 0, 0, 0);
                    acc = __builtin_amdgcn_mfma_f32_32x32x16_bf16(*(const LAS bf16x8*)(al + 32 * s2), qf[s2], acc, 0, 0, 0); }
#pragma unroll
                for (int r = 0; r < 16; ++r) { const int idx = 32 * mt + (r & 3) + 8 * (r >> 2) + 4 * hh; k[mt * 16 + r] = (f2ord(acc[r]) & ~127u) | (unsigned)(127 - idx); }
            }
            top16_of_64(k);
            unsigned m[32];
#pragma unroll
            for (int i = 0; i < 16; ++i) { m[i] = k[i]; m[16 + i] = (unsigned)__shfl_xor((int)k[i], 32); }
            merge_top16<0, 16, 32>(m);
#pragma unroll
            for (int i = 0; i < 16; ++i) kAB[c][i] = m[i];
        }
        float fa[16], fb[16];
#pragma unroll
        for (int i = 0; i < 16; ++i) { fa[i] = ord2f(kAB[0][i] & ~127u); fb[i] = ord2f(kAB[1][i] & ~127u); }
        unsigned cd[64]; int n = 0;
#pragma unroll
        for (int i = 0; i < 16; ++i)
#pragma unroll
            for (int j = 0; j < 16; ++j) if ((i + 1) * (j + 1) <= 16) { cd[n] = (f2ord(fa[i] + fb[j]) & ~255u) | (unsigned)(255 - (i * 16 + j)); ++n; }
#pragma unroll
        for (int q = 50; q < 64; ++q) cd[q] = 0u;
        top16_of_64(cd);
        LAS unsigned char* lut = lds + TK_LUT + (F.wave * 64 + lane) * 32;
#pragma unroll
        for (int q = 0; q < 4; ++q) {
            unsigned wa = 0u, wb = 0u;
#pragma unroll
            for (int b4 = 0; b4 < 4; ++b4) { wa |= (127u - (kAB[0][4 * q + b4] & 127u)) << (8 * b4); wb |= (127u - (kAB[1][4 * q + b4] & 127u)) << (8 * b4); }
            *(LAS unsigned*)(lut + 4 * q) = wa; *(LAS unsigned*)(lut + 16 + 4 * q) = wb; }
        float gv[16]; float den = 0.f; const float mx = ord2f(cd[0] & ~255u);
#pragma unroll
        for (int q = 0; q < 16; ++q) { gv[q] = __expf(ord2f(cd[q] & ~255u) - mx); den += gv[q]; }
        const float inv = 1.f / den;
        asm volatile("s_waitcnt lgkmcnt(0)" ::: "memory");
        int ev[16];
#pragma unroll
        for (int q = 0; q < 16; ++q) { const unsigned pos = 255u - (cd[q] & 255u);
            const unsigned ia = *(const LAS unsigned char*)(lut + (pos >> 4)), ib = *(const LAS unsigned char*)(lut + 16 + (pos & 15u));
            ev[q] = (int)(ia * NKEYS + ib); }
        if (hh == 0) {
            int* ep = EID + (size_t)t * 128 + h * 16; float* gp = GATE + (size_t)t * 128 + h * 16;
#pragma unroll
            for (int q = 0; q < 4; ++q) {
                *(GAS v4u*)(ep + 4 * q) = (v4u){(unsigned)ev[4 * q], (unsigned)ev[4 * q + 1], (unsigned)ev[4 * q + 2], (unsigned)ev[4 * q + 3]};
                *(GAS f32x4*)(gp + 4 * q) = (f32x4){gv[4 * q] * inv, gv[4 * q + 1] * inv, gv[4 * q + 2] * inv, gv[4 * q + 3] * inv}; }
        }
        asm volatile("s_waitcnt lgkmcnt(0)" ::: "memory");
    }
}

constexpr int GA_WAVE_BYTES = 4608, GA_CNT = 4096, GA_OFF = 4096 + 64;
__device__ __forceinline__ int wave_sum_i(int v) { v += dppi<0xB1>(v); v += dppi<0x4E>(v); v += dppi<0x141>(v); v += dppi<0x140>(v);
    return (__builtin_amdgcn_readlane(v, 0) + __builtin_amdgcn_readlane(v, 16)) + (__builtin_amdgcn_readlane(v, 32) + __builtin_amdgcn_readlane(v, 48)); }
struct PairBuf { v4u u, v; float su, sv; int e; float g; };
__device__ __forceinline__ void p8_gather(Frame& F) {
    const bf16* XN = (const bf16*)(F.ws + WS_XN);
    const unsigned char* UQ = F.ws + WS_UQ; const unsigned char* VQ = F.ws + WS_VQ;
    const float* SU = (const float*)(F.ws + WS_SU); const float* SV = (const float*)(F.ws + WS_SV);
    const int* EID = (const int*)(F.ws + WS_EID); const float* GATE = (const float*)(F.ws + WS_GATE);
    const float* nf = F.in[20];
    const int gw = F.wg * NWAVES + F.wave, NGW = F.G * NWAVES;
    LAS unsigned char* wl = F.lds + RING_OFF + F.wave * GA_WAVE_BYTES;
    for (int tg = gw; tg < T / 4; tg += NGW) {
        int lane_ = F.lane; asm volatile("" : "+v"(lane_));
        const int lane = lane_;
        int xq[4][4]; float sx[4];
#pragma unroll
        for (int tk = 0; tk < 4; ++tk) {
            const GAS v4u* xp = (const GAS v4u*)(XN + (size_t)(4 * tg + tk) * DM + lane * 16);
            const v4u a = xp[0], b = xp[1];
            float x[16]; x[0] = bflo(a.x); x[1] = bfhi(a.x); x[2] = bflo(a.y); x[3] = bfhi(a.y); x[4] = bflo(a.z); x[5] = bfhi(a.z); x[6] = bflo(a.w); x[7] = bfhi(a.w);
            x[8] = bflo(b.x); x[9] = bfhi(b.x); x[10] = bflo(b.y); x[11] = bfhi(b.y); x[12] = bflo(b.z); x[13] = bfhi(b.z); x[14] = bflo(b.w); x[15] = bfhi(b.w);
            float am = 0.f;
#pragma unroll
            for (int i = 0; i < 16; ++i) am = fmaxf(am, fabsf(x[i]));
            am = wave_max(am);
            sx[tk] = am > 0.f ? am * (1.f / 127.f) : 1.f; const float inv = am > 0.f ? 127.f / am : 0.f;
#pragma unroll
            for (int q = 0; q < 4; ++q) {
                const unsigned b0 = (unsigned)(int)rintf(x[4 * q] * inv) & 255u, b1 = (unsigned)(int)rintf(x[4 * q + 1] * inv) & 255u, b2 = (unsigned)(int)rintf(x[4 * q + 2] * inv) & 255u, b3 = (unsigned)(int)rintf(x[4 * q + 3] * inv) & 255u;
                xq[tk][q] = (int)(b0 | (b1 << 8) | (b2 << 16) | (b3 << 24)); }
        }
        LAS unsigned* cnt = (LAS unsigned*)(wl + GA_CNT); LAS unsigned* offs = (LAS unsigned*)(wl + GA_OFF);
        if (lane < 16) cnt[lane] = 0u;
        asm volatile("s_waitcnt lgkmcnt(0)" ::: "memory");
        int ee[8]; float gg[8]; unsigned pos[8];
#pragma unroll
        for (int tk = 0; tk < 4; ++tk) {
            const size_t base = (size_t)(4 * tg + tk) * 128;
            ee[2 * tk] = (EID[base + lane] & (NEXP - 1)) | (tk << 14); ee[2 * tk + 1] = (EID[base + 64 + lane] & (NEXP - 1)) | (tk << 14);
            gg[2 * tk] = GATE[base + lane]; gg[2 * tk + 1] = GATE[base + 64 + lane]; }
#pragma unroll
        for (int q = 0; q < 8; ++q) pos[q] = __hip_atomic_fetch_add(cnt + ((ee[q] >> 10) & 15), 1u, __ATOMIC_RELAXED, __HIP_MEMORY_SCOPE_WAVEFRONT);
        asm volatile("s_waitcnt lgkmcnt(0)" ::: "memory");
        if (lane < 16) {
            const int c0 = (int)cnt[lane]; int v = c0;
            v += __builtin_amdgcn_update_dpp(0, v, 0x111, 0xF, 0xF, true); v += __builtin_amdgcn_update_dpp(0, v, 0x112, 0xF, 0xF, true);
            v += __builtin_amdgcn_update_dpp(0, v, 0x114, 0xF, 0xF, true); v += __builtin_amdgcn_update_dpp(0, v, 0x118, 0xF, 0xF, true);
            offs[lane] = (unsigned)(v - c0);
        }
        asm volatile("s_waitcnt lgkmcnt(0)" ::: "memory");
#pragma unroll
        for (int q = 0; q < 8; ++q) { const unsigned idx = offs[(ee[q] >> 10) & 15] + pos[q];
            *(LAS unsigned*)(wl + idx * 4) = (unsigned)ee[q]; *(LAS float*)(wl + 2048 + idx * 4) = gg[q]; }
        asm volatile("s_waitcnt lgkmcnt(0)" ::: "memory");
        float y[4][16]; float yo[4];
#pragma unroll
        for (int tk = 0; tk < 4; ++tk) { yo[tk] = 0.f;
#pragma unroll
            for (int i = 0; i < 16; ++i) y[tk][i] = 0.f; }
#define GA_DOT(U, TK) (__builtin_amdgcn_sdot4(xq[TK][3], (int)(U).w, __builtin_amdgcn_sdot4(xq[TK][2], (int)(U).z, __builtin_amdgcn_sdot4(xq[TK][1], (int)(U).y, __builtin_amdgcn_sdot4(xq[TK][0], (int)(U).x, 0, false), false), false), false))
#define GA_AXPY(V, A, TK) do { yo[TK] += (A) * 128.f; \
            _Pragma("unroll") for (int q_ = 0; q_ < 4; ++q_) { const unsigned w_ = (V)[q_]; \
                y[TK][4 * q_] += (A) * (float)(w_ & 255u); y[TK][4 * q_ + 1] += (A) * (float)((w_ >> 8) & 255u); y[TK][4 * q_ + 2] += (A) * (float)((w_ >> 16) & 255u); y[TK][4 * q_ + 3] += (A) * (float)(w_ >> 24); } } while (0)
        for (int ch = 0; ch < 32; ++ch) {
            v2u ent; ent.x = *(const LAS unsigned*)(wl + (ch * 16 + (lane >> 2)) * 4); ent.y = 0u;
            const float my_g = *(const LAS float*)(wl + 2048 + (ch * 16 + (lane >> 2)) * 4);
            const int my_e = (int)ent.x & (NEXP - 1), my_tk = ((int)ent.x >> 14) & 3;
            const float my_su = SU[my_e], my_sv = SV[my_e];
            int d[16];
            {
                v4u ub[2][4]; int eb[2][4];
#pragma unroll
                for (int q = 0; q < 4; ++q) { eb[0][q] = __builtin_amdgcn_readlane((int)ent.x, 4 * q); ub[0][q] = *(const GAS v4u*)(UQ + (size_t)(eb[0][q] & (NEXP - 1)) * DM + lane * 16); }
#pragma unroll
                for (int jb = 0; jb < 4; ++jb) {
                    if (jb + 1 < 4) {
#pragma unroll
                        for (int q = 0; q < 4; ++q) { eb[(jb + 1) & 1][q] = __builtin_amdgcn_readlane((int)ent.x, 4 * (4 * (jb + 1) + q)); ub[(jb + 1) & 1][q] = *(const GAS v4u*)(UQ + (size_t)(eb[(jb + 1) & 1][q] & (NEXP - 1)) * DM + lane * 16); } }
                    __builtin_amdgcn_sched_barrier(0);
#pragma unroll
                    for (int q = 0; q < 4; ++q) { const int tk_ = (eb[jb & 1][q] >> 14) & 3; const v4u u_ = ub[jb & 1][q]; int r_;
                        if (tk_ == 0) r_ = GA_DOT(u_, 0); else if (tk_ == 1) r_ = GA_DOT(u_, 1); else if (tk_ == 2) r_ = GA_DOT(u_, 2); else r_ = GA_DOT(u_, 3);
                        d[4 * jb + q] = r_; }
                    __builtin_amdgcn_sched_barrier(0);
                }
            }
#pragma unroll
            for (int j = 0; j < 8; ++j) { const auto r = __builtin_amdgcn_permlane32_swap((unsigned)d[j], (unsigned)d[j + 8], false, false); d[j] = (int)r[0] + (int)r[1]; }
#pragma unroll
            for (int j = 0; j < 4; ++j) { const auto r = __builtin_amdgcn_permlane16_swap((unsigned)d[j], (unsigned)d[j + 4], false, false); d[j] = (int)r[0] + (int)r[1]; }
#pragma unroll
            for (int j = 0; j < 2; ++j) { const int u_ = d[j] + dppi<0x128>(d[j]), w_ = d[j + 2] + dppi<0x128>(d[j + 2]); d[j] = (lane & 8) ? w_ : u_; }
            { const int u_ = d[0] + dppi<0x141>(d[0]), w_ = d[1] + dppi<0x141>(d[1]); d[0] = (lane & 4) ? w_ : u_; }
            d[0] += dppi<0x4E>(d[0]); d[0] += dppi<0xB1>(d[0]);
            const float sxl = my_tk == 0 ? sx[0] : (my_tk == 1 ? sx[1] : (my_tk == 2 ? sx[2] : sx[3]));
            const float h_ = (float)d[0] * (my_su * sxl);
            const float areg = 0.5f * h_ * (1.f + erff(h_ * 0.70710678118654752f)) * my_g * my_sv;
            {
                v4u vb[2][4]; int eb[2][4];
#pragma unroll
                for (int q = 0; q < 4; ++q) { eb[0][q] = __builtin_amdgcn_readlane((int)ent.x, 4 * q); vb[0][q] = *(const GAS v4u*)(VQ + (size_t)(eb[0][q] & (NEXP - 1)) * DM + lane * 16); }
#pragma unroll
                for (int jb = 0; jb < 4; ++jb) {
                    if (jb + 1 < 4) {
#pragma unroll
                        for (int q = 0; q < 4; ++q) { eb[(jb + 1) & 1][q] = __builtin_amdgcn_readlane((int)ent.x, 4 * (4 * (jb + 1) + q)); vb[(jb + 1) & 1][q] = *(const GAS v4u*)(VQ + (size_t)(eb[(jb + 1) & 1][q] & (NEXP - 1)) * DM + lane * 16); } }
                    __builtin_amdgcn_sched_barrier(0);
#pragma unroll
                    for (int q = 0; q < 4; ++q) { const int tk_ = (eb[jb & 1][q] >> 14) & 3; const v4u v_ = vb[jb & 1][q]; const float a_ = rdlane(areg, 4 * (4 * jb + q));
                        if (tk_ == 0) GA_AXPY(v_, a_, 0); else if (tk_ == 1) GA_AXPY(v_, a_, 1); else if (tk_ == 2) GA_AXPY(v_, a_, 2); else GA_AXPY(v_, a_, 3); }
                    __builtin_amdgcn_sched_barrier(0);
                }
            }
        }
#undef GA_DOT
#undef GA_AXPY
#pragma unroll
        for (int tk = 0; tk < 4; ++tk) {
            float* hrow = F.out + (size_t)(4 * tg + tk) * DM + lane * 16;
            float hv[16]; float ss = 0.f;
#pragma unroll
            for (int q = 0; q < 4; ++q) { const f32x4 h4 = *(const GAS f32x4*)(hrow + 4 * q);
#pragma unroll
                for (int i = 0; i < 4; ++i) { const float v = h4[i] + (y[tk][4 * q + i] - yo[tk]); hv[4 * q + i] = v; ss += v * v; } }
            const float rstd = frsq(wave_sum(ss) * (1.f / DM) + RMS_EPS);
#pragma unroll
            for (int q = 0; q < 4; ++q) { const f32x4 n4 = *(const GAS f32x4*)(nf + lane * 16 + 4 * q);
                *(GAS f32x4*)(hrow + 4 * q) = (f32x4){hv[4 * q] * rstd * n4[0], hv[4 * q + 1] * rstd * n4[1], hv[4 * q + 2] * rstd * n4[2], hv[4 * q + 3] * rstd * n4[3]}; }
        }
    }
}

struct Args { const float* in[21]; float* out; unsigned char* ws; int ph_lo, ph_hi; };
static_assert(sizeof(Args) == 21 * 8 + 8 + 8 + 8, "Args has no padding");

__global__ void __launch_bounds__(NTHREADS, 2) fwd_kernel(Args args) {
    extern __shared__ __attribute__((aligned(16))) unsigned char lds[];
    Frame F;
    F.lds = (LAS unsigned char*)lds;
    F.MISC = (volatile LAS unsigned*)(F.lds + MISC_OFF);
    F.tid = threadIdx.x; F.lane = F.tid & 63; F.wave = __builtin_amdgcn_readfirstlane(F.tid >> 6);
    F.G = gridDim.x; F.wg = blockIdx.x;
#pragma unroll
    for (int i = 0; i < 21; ++i) F.in[i] = args.in[i];
    F.out = args.out; F.ws = args.ws;
    F.ctl = (gu32*)(args.ws + WS_CTL);
    for (int u = F.tid; u < (LDS_BYTES - LDSCTL_OFF) / 4; u += NTHREADS) ((LAS unsigned*)(F.lds + LDSCTL_OFF))[u] = 0u;
    __syncthreads();
    const int lo = args.ph_lo, hi = args.ph_hi;
    const bool fused = (hi - lo) > 1;
    XcdBarrier bar; bar.bar = (unsigned*)(F.ctl + CW_BAR); bar.x = 0; bar.st = nullptr;
    if (fused) bar = xcd_barrier_post((unsigned*)(F.ctl + CW_BAR), F.MISC + 8);
#define IN(k) (lo <= (k) && (k) < hi)
#define REPS(k) (((REP_MASK >> (k)) & 1) ? 2 : 1)
#define REPLOOP(k) for (int rep_ = 0; rep_ < REPS(k); ++rep_, (rep_ < REPS(k) ? xcd_barrier(bar) : (void)0))
#define SEAM(k) do { if (IN(k) && IN((k) + 1)) xcd_barrier(bar); } while (0)

    if (IN(0)) { REPLOOP(0) p0_prologue(F); SEAM(0); }
    if (IN(1)) { REPLOOP(1) {
        pg8::Gemm g{(const bf16*)(F.ws + WS_XN), (const bf16*)(F.ws + WS_WIN), T, IN_COLS, DM}; pg8::StaticOrder S; S.init(T, IN_COLS, F.G, F.wg);
        pg8::EpiBf16 E{(bf16*)(F.ws + WS_Z), IN_COLS};
        pg8::gemm_phase<pg8::EpiBf16, pg8::StaticOrder, true, true>(F.lds + RING_OFF, g, S, E); }
        SEAM(1);
    }
    if (IN(2)) { p2_rope(F); REPLOOP(2) { const int cnt = r13_count(F.wg, F.G); R1Pre P;
            if (cnt > 0) rwkv_r1_prefetch(F, r13_item(F.wg, F.G, 0), F.tid, P);
            for (int i = 0; i < cnt; ++i) rwkv_r1_item(F, r13_item(F.wg, F.G, i), i + 1 < cnt ? r13_item(F.wg, F.G, i + 1) : -1, P); }
        SEAM(2); }
    if (IN(3)) { REPLOOP(3) p3_mixers(F); SEAM(3); }
    if (IN(4)) { REPLOOP(4) for (int item = F.wg; item < NB * NHR * 128; item += F.G) rwkv_r3_item(F, item); SEAM(4); }
    if (IN(5)) { REPLOOP(5) {
        pg8::Gemm g{(const bf16*)(F.ws + WS_YMIX), (const bf16*)(F.ws + WS_WOUT), T, DM, DM}; pg8::StaticOrder S; S.init(T, DM, F.G, F.wg);
        pg8::EpiF32Res E{F.in[0], F.out, DM};
        pg8::gemm_phase<pg8::EpiF32Res, pg8::StaticOrder, true, true>(F.lds + RING_OFF, g, S, E); }
        SEAM(5);
    }
    if (IN(6)) { REPLOOP(6) p5_xn2(F); SEAM(6); }
    if (IN(7)) { REPLOOP(7) {
        pg8::Gemm g{(const bf16*)(F.ws + WS_XN), (const bf16*)(F.ws + WS_WQ), T, PQ, DM}; pg8::StaticOrder S; S.init(T, PQ, F.G, F.wg);
        pg8::EpiBf16 E{(bf16*)(F.ws + WS_QP), PQ};
        pg8::gemm_phase<pg8::EpiBf16, pg8::StaticOrder, true, true>(F.lds + RING_OFF, g, S, E); }
        SEAM(7);
    }
    if (IN(8)) { REPLOOP(8) p7_topk(F); SEAM(8); }
    if (IN(9)) { p8_gather(F); }
#undef IN
#undef SEAM
}

extern "C" void kernel_launch(void* const* d_in, const int* in_sizes, int n_in, void* d_out, int out_size, void* d_ws, size_t ws_size, hipStream_t stream) {
    static int grid = 0;
    if (grid == 0) {
        if (n_in != 21 || in_sizes[0] != T * DM || out_size != T * DM || ws_size < WS_END) {
            fprintf(stderr, "kernel_launch: unexpected shapes: n_in %d in0 %d out %d ws %zu (need %zu); nothing launched\n", n_in, n_in > 0 ? in_sizes[0] : -1, out_size, ws_size, (size_t)WS_END); grid = -1; return; }
        int dev = 0, cus = 0, per_cu = 0;
        if (hipGetDevice(&dev) != hipSuccess || hipDeviceGetAttribute(&cus, hipDeviceAttributeMultiprocessorCount, dev) != hipSuccess) { grid = -1; return; }
        if (hipFuncSetAttribute((const void*)fwd_kernel, hipFuncAttributeMaxDynamicSharedMemorySize, LDS_BYTES) != hipSuccess) { fprintf(stderr, "kernel_launch: hipFuncSetAttribute failed\n"); grid = -1; return; }
        if (hipOccupancyMaxActiveBlocksPerMultiprocessor(&per_cu, (const void*)fwd_kernel, NTHREADS, LDS_BYTES) != hipSuccess || per_cu < 1) { fprintf(stderr, "kernel_launch: occupancy query says %d\n", per_cu); per_cu = 1; }
        (void)hipGetLastError();
        grid = cus;
    }
    if (grid < 0) return;
    (void)hipMemsetAsync((char*)d_ws + WS_CTL, 0, CTL_ZERO_BYTES, stream);
    Args a{};
    for (int i = 0; i < 21; ++i) a.in[i] = (const float*)d_in[i];
    a.out = (float*)d_out; a.ws = (unsigned char*)d_ws;
    if (MK_N_LAUNCHES == 1) {
        a.ph_lo = 0; a.ph_hi = NPHASE;
        void* kargs[] = {&a};
        hipError_t e = hipLaunchCooperativeKernel((const void*)fwd_kernel, dim3(grid), dim3(NTHREADS), kargs, LDS_BYTES, stream);
        if (e != hipSuccess) fprintf(stderr, "kernel_launch: cooperative launch failed: %s (grid %d)\n", hipGetErrorString(e), grid);
    } else {
        for (int p = 0; p < NPHASE; ++p) { a.ph_lo = p; a.ph_hi = p + 1;
            hipLaunchKernelGGL(fwd_kernel, dim3(grid), dim3(NTHREADS), LDS_BYTES, stream, a); }
    }
}
```

```cpp
#include <hip/hip_runtime.h>
#include <cstdio>
#include <cstdint>

#ifndef MK_N_LAUNCHES
#define MK_N_LAUNCHES 1
#endif

#ifndef REP_MASK
#define REP_MASK 0
#endif
#define GAS __attribute__((address_space(1)))
#define LAS __attribute__((address_space(3)))
typedef unsigned short bf16;
typedef unsigned v4u __attribute__((ext_vector_type(4)));
typedef unsigned v2u __attribute__((ext_vector_type(2)));
typedef float f32x4 __attribute__((ext_vector_type(4)));
typedef float f32x2 __attribute__((ext_vector_type(2)));
typedef short bf16x8 __attribute__((ext_vector_type(8)));
typedef GAS unsigned gu32;
#define RLX_AGENT __ATOMIC_RELAXED, __HIP_MEMORY_SCOPE_AGENT
#define LDS_WAIT() asm volatile("s_waitcnt lgkmcnt(0)" ::: "memory")
#define VM_WAIT() asm volatile("s_waitcnt vmcnt(0)" ::: "memory")
#define LDS_BARRIER() do { asm volatile("s_waitcnt lgkmcnt(0)" ::: "memory"); __builtin_amdgcn_s_barrier(); asm volatile("" ::: "memory"); } while (0)

constexpr int DM = 1024, NB = 4, SEQ = 8192, T = NB * SEQ;
constexpr int HD = 64, RWW = 512, NHR = 8, NHA = 8;
constexpr int IN_COLS = 3328;
constexpr int C_R = 0, C_K = 512, C_V = 1024, C_WD = 1536, C_AD = 1600, C_GD = 1664, C_AQ = 1792, C_AK = 2304, C_AV = 2816;
constexpr int PHEADS = 8, NKEYS = 128, PQ = 2048, TOPK = 16, NEXP = 16384;
constexpr float RMS_EPS = 1e-6f, GN_EPS = 64e-5f;
constexpr int NWAVES = 8, NTHREADS = 512;
constexpr int NPHASE = 10;

constexpr size_t MiB = 1u << 20;
constexpr size_t WS_CTL = 0, CTL_ZERO_BYTES = 1 * MiB;
constexpr size_t WS_WIN = 2 * MiB;
constexpr size_t WS_WOUT = 10 * MiB;
constexpr size_t WS_WQ = 12 * MiB;
constexpr size_t WS_XN = 16 * MiB;
constexpr size_t WS_Z = 80 * MiB;
constexpr size_t WS_QP = 80 * MiB;
constexpr size_t WS_G = 288 * MiB;
constexpr size_t WS_YMIX = 352 * MiB;
constexpr size_t WS_UQ = 416 * MiB;
constexpr size_t WS_VQ = 432 * MiB;
constexpr size_t WS_SU = 448 * MiB;
constexpr size_t WS_SV = 449 * MiB;
constexpr size_t WS_EID = 480 * MiB;
constexpr size_t WS_GATE = 496 * MiB;
constexpr size_t WS_END = 512 * MiB;
constexpr size_t WS_WUPT = 1 * MiB, WS_AUPT = WS_WUPT + 65536, WS_GUPT = WS_AUPT + 65536;
constexpr size_t WS_BONUS = 9 * MiB;
constexpr size_t WS_RWY0 = WS_XN;
constexpr size_t WS_RWSS = WS_G;
constexpr size_t WS_RWRH = WS_EID;

constexpr int CW_BAR = 4096;

typedef __bf16 hbf16x2_t __attribute__((ext_vector_type(2)));
__device__ __forceinline__ unsigned pk2(float lo, float hi) { const f32x2 v = {lo, hi}; const hbf16x2_t b = __builtin_convertvector(v, hbf16x2_t); return __builtin_bit_cast(unsigned, b); }
__device__ __forceinline__ unsigned f2bf(float f) { return pk2(f, 0.f) & 0xffffu; }
__device__ __forceinline__ float frcp(float x) { return __builtin_amdgcn_rcpf(x); }
__device__ __forceinline__ float frsq(float x) { return __builtin_amdgcn_rsqf(x); }
__device__ __forceinline__ float bflo(unsigned u) { return __builtin_bit_cast(float, u << 16); }
__device__ __forceinline__ float bfhi(unsigned u) { return __builtin_bit_cast(float, u & 0xffff0000u); }
__device__ __forceinline__ float bf2f(bf16 h) { return __builtin_bit_cast(float, (unsigned)h << 16); }

template <int CTRL> __device__ __forceinline__ float dppf(float x) { return __builtin_bit_cast(float, __builtin_amdgcn_update_dpp(0, __builtin_bit_cast(int, x), CTRL, 0xF, 0xF, true)); }
template <int CTRL> __device__ __forceinline__ int dppi(int x) { return __builtin_amdgcn_update_dpp(0, x, CTRL, 0xF, 0xF, true); }
__device__ __forceinline__ float rdlane(float v, int l) { return __builtin_bit_cast(float, __builtin_amdgcn_readlane(__builtin_bit_cast(int, v), l)); }
__device__ __forceinline__ float sum8(float v) { v += dppf<0xB1>(v); v += dppf<0x4E>(v); v += dppf<0x141>(v); return v; }
__device__ __forceinline__ float sum16(float v) { v = sum8(v); v += dppf<0x140>(v); return v; }
__device__ __forceinline__ float wave_sum(float v) { v = sum16(v);
    v += __builtin_bit_cast(float, __builtin_amdgcn_update_dpp(0, __builtin_bit_cast(int, v), 0x142, 0xA, 0xF, false));
    v += __builtin_bit_cast(float, __builtin_amdgcn_update_dpp(0, __builtin_bit_cast(int, v), 0x143, 0xC, 0xF, false));
    return rdlane(v, 63); }
__device__ __forceinline__ float wave_max(float v) {
    v = fmaxf(v, dppf<0xB1>(v)); v = fmaxf(v, dppf<0x4E>(v)); v = fmaxf(v, dppf<0x141>(v)); v = fmaxf(v, dppf<0x140>(v));
    return fmaxf(fmaxf(rdlane(v, 0), rdlane(v, 16)), fmaxf(rdlane(v, 32), rdlane(v, 48)));
}
__device__ __forceinline__ int wave_min_i(int v) {
    v = min(v, dppi<0xB1>(v)); v = min(v, dppi<0x4E>(v)); v = min(v, dppi<0x141>(v)); v = min(v, dppi<0x140>(v));
    return min(min(__builtin_amdgcn_readlane(v, 0), __builtin_amdgcn_readlane(v, 16)), min(__builtin_amdgcn_readlane(v, 32), __builtin_amdgcn_readlane(v, 48)));
}

namespace pg8 {
#define PG8_LAS __attribute__((address_space(3)))
typedef unsigned short bf16_t;
typedef unsigned u32x4 __attribute__((ext_vector_type(4)));
constexpr int BM = 256, BK = 64, HALF = 128, HTB = HALF * BK * 2, STAGE_BYTES = 8 * HTB, NXCD = 8, WGM = 8;
__host__ __device__ __forceinline__ int lds_byte(int r, int c) { const int st = (r >> 4) * 2 + (c >> 5), rr = r & 15, cc = c & 31, ob = rr * 64 + cc * 2; return st * 1024 + (ob ^ (((ob >> 9) & 1) << 5)); }
__host__ __device__ __forceinline__ void stage_rc(int b, int& R, int& C) { const int st = b / 1024, sb = b % 1024, swz = sb ^ (((sb >> 9) & 1) << 5); R = (st >> 1) * 16 + swz / 64; C = (st & 1) * 32 + (swz % 64) / 2; }
__host__ __device__ __forceinline__ int perm32(int rho) { const int n = rho >> 4, i = rho & 15; return 8 * (i >> 2) + 4 * n + (i & 3); }
struct Unit { int pm, pn; };
struct Gemm { const bf16_t* A; const bf16_t* Bt; int M, N, K; };
struct StaticOrder {
    int nM, nN, nwg, G, c;
    __host__ __device__ void init(int M, int N, int G_, int c_) { nM = M / BM; nN = N / BM; nwg = nM * nN; G = G_; c = c_; }
    __host__ __device__ bool next(int i, Unit& u) const {
        const long L = (long)i * G + c; if (L >= nwg) return false;
        int wgid = (int)L; { const int q = nwg / NXCD, r = nwg % NXCD, xcd = wgid % NXCD, off = wgid / NXCD; wgid = (xcd < r ? xcd * (q + 1) : r * (q + 1) + (xcd - r) * q) + off; }
        const int nig = WGM * nN, gid = wgid / nig, fm = gid * WGM, gsz = (nM - fm) < WGM ? (nM - fm) : WGM;
        u.pm = fm + ((wgid % nig) % gsz); u.pn = (wgid % nig) / gsz; return true;
    }
    __device__ __forceinline__ void a_ready(const Unit&) const {}
    __device__ __forceinline__ void done(const Unit&) const {}
};
__device__ __forceinline__ unsigned cvt_pk_bf16(float lo, float hi) { unsigned r; asm volatile("v_cvt_pk_bf16_f32 %0, %1, %2" : "=v"(r) : "v"(lo), "v"(hi)); return r; }
struct EpiBf16 {
    static constexpr bool PERM = true, AFTER_DRAIN = false;
    bf16_t* O; int ldc;
    __device__ __forceinline__ void operator()(const f32x4 (&acc)[2][2][4][2], const Unit& u, int wr, int wc, int fr, int fq) const {
        const int row0 = u.pm * BM + wr * 64 + fr; const int col0 = u.pn * BM + wc * 32 + 8 * fq;
#pragma unroll
        for (int ai = 0; ai < 2; ++ai)
#pragma unroll
            for (int m = 0; m < 4; ++m) { bf16_t* rowp = O + (size_t)(row0 + ai * HALF + m * 16) * ldc + col0;
#pragma unroll
                for (int bj = 0; bj < 2; ++bj) { const f32x4 v0 = acc[ai][bj][m][0], v1 = acc[ai][bj][m][1];
                    u32x4 w; w.x = cvt_pk_bf16(v0[0], v0[1]); w.y = cvt_pk_bf16(v0[2], v0[3]); w.z = cvt_pk_bf16(v1[0], v1[1]); w.w = cvt_pk_bf16(v1[2], v1[3]);
                    *(u32x4*)(rowp + bj * HALF) = w; } }
    }
};
struct EpiF32Res {
    static constexpr bool PERM = true, AFTER_DRAIN = false;
    const float* res; float* O; int ldc;
    __device__ __forceinline__ void operator()(const f32x4 (&acc)[2][2][4][2], const Unit& u, int wr, int wc, int fr, int fq) const {
        const int row0 = u.pm * BM + wr * 64 + fr; const int col0 = u.pn * BM + wc * 32 + 8 * fq;
#pragma unroll
        for (int ai = 0; ai < 2; ++ai)
#pragma unroll
            for (int m = 0; m < 4; ++m) { const size_t off = (size_t)(row0 + ai * HALF + m * 16) * ldc + col0;
#pragma unroll
                for (int bj = 0; bj < 2; ++bj) { const f32x4 r0 = *(const f32x4*)(res + off + bj * HALF), r1 = *(const f32x4*)(res + off + bj * HALF + 4);
                    *(f32x4*)(O + off + bj * HALF) = acc[ai][bj][m][0] + r0; *(f32x4*)(O + off + bj * HALF + 4) = acc[ai][bj][m][1] + r1; } }
    }
};

template <class Epi, class Sched, bool ALIGN_EPI = false, bool SP2 = false>
__device__ __forceinline__ void gemm_phase(PG8_LAS unsigned char* lds, const Gemm g, const Sched& S, const Epi& E) {
    const int tid = threadIdx.x, wid = __builtin_amdgcn_readfirstlane(tid >> 6), lane = tid & 63, wr = wid >> 2, wc = wid & 3, fr = lane & 15, fq = lane >> 4;
    const int K = g.K, nt = K / BK;
    unsigned voffA[2], voffB[2];
#pragma unroll
    for (int i = 0; i < 2; ++i) { int R, C; stage_rc(tid * 16 + i * 8192, R, C); const int Rb = Epi::PERM ? ((R & ~31) + perm32(R & 31)) : R;
        voffA[i] = (unsigned)(R * K + C) * 2u; voffB[i] = (unsigned)(Rb * K + C) * 2u; }
    const size_t kstep = (size_t)(BK * 2);
    const size_t hstep = (size_t)HALF * K * 2;
    const size_t tstep = 2 * hstep;
    const unsigned ldsw = (unsigned)wid * 1024u;
    const int aoff = lds_byte(wr * 64 + fr, fq * 8), boff = lds_byte(wc * 32 + fr, fq * 8);
#define PG8_SA(b, h) (((b) * 2 + (h)) * HTB)
#define PG8_SB(b, h) ((4 + (b) * 2 + (h)) * HTB)
#define PG8_STAGE(bufoff, gbase, voff) do { _Pragma("unroll") for (int _i = 0; _i < 2; ++_i) \
        __builtin_amdgcn_global_load_lds((const unsigned*)((const char*)(gbase) + (voff)[_i]), (PG8_LAS unsigned*)(lds + (bufoff) + ldsw + _i * 8192), 16, 0, 0); } while (0)
#define PG8_LDA(dst, b, h) do { _Pragma("unroll") for (int m = 0; m < 4; ++m) _Pragma("unroll") for (int k = 0; k < 2; ++k) dst[m][k] = *(const PG8_LAS bf16x8*)(lds + PG8_SA(b, h) + aoff + m * 2048 + k * 1024); } while (0)
#define PG8_LDB(dst, b, h) do { _Pragma("unroll") for (int n = 0; n < 2; ++n) _Pragma("unroll") for (int k = 0; k < 2; ++k) dst[n][k] = *(const PG8_LAS bf16x8*)(lds + PG8_SB(b, h) + boff + n * 2048 + k * 1024); } while (0)
#define PG8_MMA(ai, bj, At, Bt) do { __builtin_amdgcn_s_setprio(1); _Pragma("unroll") for (int m = 0; m < 4; ++m) _Pragma("unroll") for (int n = 0; n < 2; ++n) _Pragma("unroll") for (int k = 0; k < 2; ++k) \
        acc[ai][bj][m][n] = __builtin_amdgcn_mfma_f32_16x16x32_bf16(Bt[n][k], At[m][k], acc[ai][bj][m][n], 0, 0, 0); __builtin_amdgcn_s_setprio(0); } while (0)
#define PG8_WAIT_V(n) asm volatile("s_waitcnt vmcnt(" #n ")" ::: "memory")
#define PG8_WAIT_L(n) asm volatile("s_waitcnt lgkmcnt(" #n ")" ::: "memory")
#define PG8_BAR __builtin_amdgcn_s_barrier()
#define PG8_SCHED __builtin_amdgcn_sched_barrier(0)
    Unit cur, nxt; int ui = 0;
    if (!S.next(0, cur)) return;
    f32x4 acc[2][2][4][2];
#pragma unroll
    for (int a = 0; a < 2; ++a)
#pragma unroll
        for (int b = 0; b < 2; ++b)
#pragma unroll
            for (int m = 0; m < 4; ++m)
#pragma unroll
                for (int n = 0; n < 2; ++n) acc[a][b][m][n] = (f32x4){0.f, 0.f, 0.f, 0.f};
    bf16x8 At[4][2], B0[2][2], B1[2][2];
    const char* cA = (const char*)g.A + (size_t)cur.pm * tstep; const char* cB = (const char*)g.Bt + (size_t)cur.pn * tstep;
    S.a_ready(cur);
    if constexpr (SP2) {
        PG8_STAGE(PG8_SB(0, 0), cB, voffB); PG8_STAGE(PG8_SB(0, 1), cB + hstep, voffB); PG8_STAGE(PG8_SA(0, 0), cA, voffA); PG8_STAGE(PG8_SA(0, 1), cA + hstep, voffA);
        if (wr == 1) PG8_BAR;
        PG8_WAIT_V(2); PG8_BAR;
        PG8_STAGE(PG8_SB(1, 0), cB + kstep, voffB); PG8_STAGE(PG8_SA(1, 0), cA + kstep, voffA); PG8_STAGE(PG8_SB(1, 1), cB + hstep + kstep, voffB);
        PG8_WAIT_V(6); PG8_BAR;
    } else {
        PG8_STAGE(PG8_SB(0, 0), cB, voffB); PG8_STAGE(PG8_SA(0, 0), cA, voffA); PG8_STAGE(PG8_SB(0, 1), cB + hstep, voffB); PG8_STAGE(PG8_SA(0, 1), cA + hstep, voffA);
        if (wr == 1) PG8_BAR;
        PG8_WAIT_V(4); PG8_BAR;
        PG8_STAGE(PG8_SB(1, 0), cB + kstep, voffB); PG8_STAGE(PG8_SA(1, 0), cA + kstep, voffA); PG8_STAGE(PG8_SB(1, 1), cB + hstep + kstep, voffB);
        PG8_WAIT_V(6); PG8_BAR;
    }
    for (;;) {
        const bool has_next = S.next(ui + 1, nxt);
        const char* nA = has_next ? (const char*)g.A + (size_t)nxt.pm * tstep : cA; const char* nB = has_next ? (const char*)g.Bt + (size_t)nxt.pn * tstep : cB;
        for (int t = 0; t < nt; t += 2) {
            const bool last = (t == nt - 2);
            const char* a1 = cA + (size_t)(t + 1) * kstep;
            const char* a2 = last ? nA : cA + (size_t)(t + 2) * kstep; const char* b2 = last ? nB : cB + (size_t)(t + 2) * kstep;
            const char* a3 = a2 + kstep; const char* b3 = b2 + kstep;
            if (last && has_next) S.a_ready(nxt);
            if constexpr (SP2) {
            PG8_LDB(B0, 0, 0); PG8_LDB(B1, 0, 1); PG8_SCHED; PG8_LDA(At, 0, 0); PG8_STAGE(PG8_SA(1, 1), a1 + hstep, voffA);
            PG8_WAIT_V(8); PG8_WAIT_L(0); PG8_BAR; PG8_MMA(0, 0, At, B0); PG8_MMA(0, 1, At, B1); PG8_BAR; PG8_SCHED;
            PG8_LDA(At, 0, 1); PG8_STAGE(PG8_SB(0, 0), b2, voffB); PG8_STAGE(PG8_SB(0, 1), b2 + hstep, voffB); PG8_STAGE(PG8_SA(0, 0), a2, voffA);
            PG8_WAIT_V(8); PG8_WAIT_L(0); PG8_BAR; PG8_MMA(1, 0, At, B0); PG8_MMA(1, 1, At, B1); PG8_BAR; PG8_SCHED;
            PG8_LDB(B0, 1, 0); PG8_LDB(B1, 1, 1); PG8_SCHED; PG8_LDA(At, 1, 0); PG8_STAGE(PG8_SA(0, 1), a2 + hstep, voffA);
            PG8_WAIT_V(8); PG8_WAIT_L(0); PG8_BAR; PG8_MMA(0, 0, At, B0); PG8_MMA(0, 1, At, B1); PG8_BAR; PG8_SCHED;
            PG8_LDA(At, 1, 1); PG8_STAGE(PG8_SB(1, 0), b3, voffB); PG8_STAGE(PG8_SB(1, 1), b3 + hstep, voffB); PG8_STAGE(PG8_SA(1, 0), a3, voffA);
            PG8_WAIT_V(8); PG8_WAIT_L(0); PG8_BAR; PG8_MMA(1, 0, At, B0); PG8_MMA(1, 1, At, B1); PG8_BAR; PG8_SCHED;
            } else {
            PG8_LDB(B0, 0, 0); PG8_SCHED; PG8_LDA(At, 0, 0); PG8_STAGE(PG8_SA(1, 1), a1 + hstep, voffA);
            PG8_WAIT_L(8); PG8_BAR; PG8_WAIT_L(0); PG8_MMA(0, 0, At, B0); PG8_BAR; PG8_SCHED;
            PG8_LDB(B1, 0, 1); PG8_STAGE(PG8_SB(0, 0), b2, voffB);
            PG8_BAR; PG8_WAIT_L(0); PG8_MMA(0, 1, At, B1); PG8_BAR;
            PG8_LDA(At, 0, 1); PG8_STAGE(PG8_SA(0, 0), a2, voffA);
            PG8_BAR; PG8_WAIT_L(0); PG8_MMA(1, 0, At, B0); PG8_BAR; PG8_SCHED;
            PG8_STAGE(PG8_SB(0, 1), b2 + hstep, voffB);
            PG8_WAIT_V(6); PG8_BAR; PG8_MMA(1, 1, At, B1); PG8_BAR;
            PG8_LDB(B0, 1, 0); PG8_SCHED; PG8_LDA(At, 1, 0); PG8_STAGE(PG8_SA(0, 1), a2 + hstep, voffA);
            PG8_WAIT_L(8); PG8_BAR; PG8_WAIT_L(0); PG8_MMA(0, 0, At, B0); PG8_BAR; PG8_SCHED;
            PG8_LDB(B1, 1, 1); PG8_STAGE(PG8_SB(1, 0), b3, voffB);
            PG8_BAR; PG8_WAIT_L(0); PG8_MMA(0, 1, At, B1); PG8_BAR;
            PG8_LDA(At, 1, 1); PG8_STAGE(PG8_SA(1, 0), a3, voffA);
            PG8_BAR; PG8_WAIT_L(0); PG8_MMA(1, 0, At, B0); PG8_BAR; PG8_SCHED;
            PG8_STAGE(PG8_SB(1, 1), b3 + hstep, voffB);
            PG8_WAIT_V(6); PG8_BAR; PG8_MMA(1, 1, At, B1); PG8_BAR;
            }
        }
        if constexpr (ALIGN_EPI) { if (wr == 0) PG8_BAR; }
        if constexpr (!Epi::AFTER_DRAIN) { E(acc, cur, wr, wc, fr, fq); S.done(cur); }
        if (!has_next) break;
#pragma unroll
        for (int a = 0; a < 2; ++a)
#pragma unroll
            for (int b = 0; b < 2; ++b)
#pragma unroll
                for (int m = 0; m < 4; ++m)
#pragma unroll
                    for (int n = 0; n < 2; ++n) acc[a][b][m][n] = (f32x4){0.f, 0.f, 0.f, 0.f};
        cur = nxt; cA = nA; cB = nB; ++ui;
        if constexpr (ALIGN_EPI) { if (wr == 1) PG8_BAR; }
    }
    PG8_WAIT_V(0);
    if constexpr (!ALIGN_EPI) { if (wr == 0) PG8_BAR; }
    PG8_BAR;
#undef PG8_SA
#undef PG8_SB
#undef PG8_STAGE
#undef PG8_LDA
#undef PG8_LDB
#undef PG8_MMA
#undef PG8_WAIT_V
#undef PG8_WAIT_L
#undef PG8_BAR
#undef PG8_SCHED
}
}

#define XB_TMO      128
#define XB_XCNT(j)  (256  + 64 * (j))
#define XB_XSUB(j)  (1280 + 64 * (j))
#define XB_XGEN(j)  (2304 + 64 * (j))
#define XB_TOP      3328
#define XB_TOPGEN   3392
#define XCD_BAR_WORDS 3456
#define XB_SPIN_CAP (1u << 22)
__device__ __forceinline__ unsigned xb_ld(unsigned* p)              { return __hip_atomic_load(p, __ATOMIC_RELAXED, __HIP_MEMORY_SCOPE_AGENT); }
__device__ __forceinline__ unsigned xb_add(unsigned* p, unsigned v) { return __hip_atomic_fetch_add(p, v, __ATOMIC_RELAXED, __HIP_MEMORY_SCOPE_AGENT); }
__device__ __forceinline__ unsigned xb_xcc_id() { return (unsigned)__builtin_amdgcn_s_getreg((3 << 11) | 20) & 0xFu; }
#define XB_SPIN(cond, bar) do { unsigned _sp = 0; while (cond) { __builtin_amdgcn_s_sleep(1); \
    if ((++_sp & 255u) == 0u) { if (xb_ld(&(bar)[XB_TMO])) break; if (_sp > XB_SPIN_CAP) { atomicAdd(&(bar)[XB_TMO], 1u); break; } } } } while (0)
struct XcdBarrier { unsigned* bar; unsigned x; volatile LAS unsigned* st; };
__device__ __forceinline__ XcdBarrier xcd_barrier_post(unsigned* bar, volatile LAS unsigned* st) {
    XcdBarrier b; b.bar = bar; b.x = xb_xcc_id(); b.st = st;
    if (threadIdx.x == 0) (void)xb_add(&bar[XB_XCNT(b.x)], 1u);
    return b;
}
__device__ __forceinline__ void xcd_barrier_complete(unsigned* bar, unsigned x, unsigned& nloc, unsigned& nx) {
    const unsigned G = gridDim.x * gridDim.y * gridDim.z;
    unsigned sum, cnt, mine, sp = 0u;
    for (;;) {
        sum = 0u; cnt = 0u; mine = 0u;
#pragma unroll
        for (unsigned j = 0; j < 16; ++j) { const unsigned c = xb_ld(&bar[XB_XCNT(j)]); sum += c; cnt += (c > 0u) ? 1u : 0u; mine = (j == x) ? c : mine; }
        if (sum == G) break;
        __builtin_amdgcn_s_sleep(1);
        if ((++sp & 255u) == 0u) { if (xb_ld(&bar[XB_TMO])) break; if (sp > XB_SPIN_CAP) { atomicAdd(&bar[XB_TMO], 1u); break; } }
    }
    nloc = mine > 0u ? mine : 1u; nx = cnt > 0u ? cnt : 1u;
}
__device__ __forceinline__ void xcd_barrier(const XcdBarrier& b) {
    asm volatile("s_waitcnt vmcnt(0)" ::: "memory");
    __syncthreads();
    if (threadIdx.x == 0) {
        unsigned* bar = b.bar;
        __builtin_amdgcn_s_waitcnt(0);
        unsigned nloc = b.st[0], nx = b.st[1];
        if (nloc == 0u) { xcd_barrier_complete(bar, b.x, nloc, nx); b.st[0] = nloc; b.st[1] = nx; }
        const unsigned old = xb_add(&bar[XB_XSUB(b.x)], 1u);
        const unsigned gen = old / nloc;
        if (old + 1u == (gen + 1u) * nloc) {
            __builtin_amdgcn_fence(__ATOMIC_RELEASE, "agent");
            asm volatile("s_waitcnt vmcnt(0)" ::: "memory");
            const unsigned og = xb_add(&bar[XB_TOP], 1u);
            const unsigned tg = og / nx;
            if (og + 1u == (tg + 1u) * nx) xb_add(&bar[XB_TOPGEN], 1u);
            else XB_SPIN(xb_ld(&bar[XB_TOPGEN]) == tg, bar);
            __builtin_amdgcn_fence(__ATOMIC_ACQUIRE, "agent");
            xb_add(&bar[XB_XGEN(b.x)], 1u);
            asm volatile("s_waitcnt vmcnt(0)" ::: "memory");
        } else {
            XB_SPIN(xb_ld(&bar[XB_XGEN(b.x)]) == gen, bar);
            __builtin_amdgcn_fence(__ATOMIC_ACQUIRE, "agent");
            asm volatile("s_waitcnt vmcnt(0)" ::: "memory");
        }
    }
    __syncthreads();
}

constexpr int RING_OFF = 0, RING_BYTES = 131072;
constexpr int LDSCTL_OFF = 162816, MISC_OFF = LDSCTL_OFF + 320;
constexpr int LDS_BYTES = 163840;

struct Frame {
    LAS unsigned char* lds;
    volatile LAS unsigned* MISC;
    gu32* ctl;
    int tid, lane, wave, G, wg;
    const float* in[21];
    float* out;
    unsigned char* ws;
};

__device__ __forceinline__ void p0_transpose_item(const float* W, int K, int N, bf16* WT, LAS float* scr, int item, int lane) {
    const int nblk = N / 32, kb = item / nblk, nb = item % nblk, k0 = 64 * kb, n0 = 32 * nb;
#pragma unroll 8
    for (int i = 0; i < 32; ++i) { const int kk = 2 * i + (lane >> 5); scr[kk * 33 + (lane & 31)] = W[(size_t)(k0 + kk) * N + n0 + (lane & 31)]; }
    LDS_WAIT(); asm volatile("" ::: "memory");
    const int c = lane & 7;
#pragma unroll
    for (int j = 0; j < 4; ++j) { const int n = (lane >> 3) + 8 * j; const LAS float* s = scr + (8 * c) * 33 + n;
        v4u o; o.x = pk2(s[0 * 33], s[1 * 33]); o.y = pk2(s[2 * 33], s[3 * 33]); o.z = pk2(s[4 * 33], s[5 * 33]); o.w = pk2(s[6 * 33], s[7 * 33]);
        *(GAS v4u*)(WT + (size_t)(n0 + n) * K + k0 + 8 * c) = o; }
    LDS_WAIT(); asm volatile("" ::: "memory");
}
__device__ __forceinline__ void rms_row_to_bf16(int lane, const float* xrow, const float* gain, bf16* orow) {
    const GAS f32x4* xr = (const GAS f32x4*)xrow + lane;
    const GAS f32x4* gr = (const GAS f32x4*)gain + lane;
    f32x4 v[4]; float s = 0.f;
#pragma unroll
    for (int j = 0; j < 4; ++j) { v[j] = xr[64 * j]; s += (v[j].x * v[j].x + v[j].y * v[j].y) + (v[j].z * v[j].z + v[j].w * v[j].w); }
    const float rstd = frsq(wave_sum(s) * (1.f / DM) + RMS_EPS);
    GAS unsigned long long* o8 = (GAS unsigned long long*)orow + lane;
#pragma unroll
    for (int j = 0; j < 4; ++j) { const f32x4 gg = gr[64 * j];
        o8[64 * j] = (unsigned long long)pk2(v[j].x * rstd * gg.x, v[j].y * rstd * gg.y) | ((unsigned long long)pk2(v[j].z * rstd * gg.z, v[j].w * rstd * gg.w) << 32); }
}
__device__ __forceinline__ void cvt_row_to_bf16(int lane, const float* xrow, bf16* orow) {
    const GAS f32x4* xr = (const GAS f32x4*)xrow + lane;
    GAS unsigned long long* o8 = (GAS unsigned long long*)orow + lane;
#pragma unroll
    for (int j = 0; j < 4; ++j) { const f32x4 v = xr[64 * j]; o8[64 * j] = (unsigned long long)pk2(v.x, v.y) | ((unsigned long long)pk2(v.z, v.w) << 32); }
}
__device__ __forceinline__ void p0_prologue(Frame& F) {
    LAS float* scr = (LAS float*)(F.lds + RING_OFF + F.wave * 16384);
    const int gw = F.wg * NWAVES + F.wave, NGW = F.G * NWAVES;
    constexpr int I_IN = (DM / 64) * (IN_COLS / 32), I_OUT = (DM / 64) * (DM / 32), I_Q = (DM / 64) * (PQ / 32);
    constexpr int NITEMS = I_IN + I_OUT + I_Q;
    bf16* win_t = (bf16*)(F.ws + WS_WIN); bf16* wout_t = (bf16*)(F.ws + WS_WOUT); bf16* wq_t = (bf16*)(F.ws + WS_WQ);
    for (int it = gw; it < NITEMS; it += NGW) {
        int r = it;
        if (r < I_IN) { p0_transpose_item(F.in[2], DM, IN_COLS, win_t, scr, r, F.lane); continue; } r -= I_IN;
        if (r < I_OUT) { p0_transpose_item(F.in[14], DM, DM, wout_t, scr, r, F.lane); continue; } r -= I_OUT;
        p0_transpose_item(F.in[16], DM, PQ, wq_t, scr, r, F.lane);
    }
    {
        constexpr int I_W = (64 / 64) * (RWW / 32), I_G = (128 / 64) * (RWW / 32);
        for (int it = gw; it < 2 * I_W + I_G; it += NGW) {
            int r = it;
            if (r < I_W) { p0_transpose_item(F.in[5], 64, RWW, (bf16*)(F.ws + WS_WUPT), scr, r, F.lane); continue; } r -= I_W;
            if (r < I_W) { p0_transpose_item(F.in[7], 64, RWW, (bf16*)(F.ws + WS_AUPT), scr, r, F.lane); continue; } r -= I_W;
            p0_transpose_item(F.in[8], 128, RWW, (bf16*)(F.ws + WS_GUPT), scr, r, F.lane);
        }
    }
    bf16* XN = (bf16*)(F.ws + WS_XN);
    for (int m = gw; m < T; m += NGW) rms_row_to_bf16(F.lane, F.in[0] + (size_t)m * DM, F.in[1], XN + (size_t)m * DM);
    for (int m = gw; m < 2 * NEXP; m += NGW) {
        const int tab = m >= NEXP, row = tab ? m - NEXP : m;
        const GAS f32x4* xr = (const GAS f32x4*)(F.in[18 + tab] + (size_t)row * DM) + F.lane * 4;
        f32x4 v[4]; float am = 0.f;
#pragma unroll
        for (int j = 0; j < 4; ++j) { v[j] = xr[j]; am = fmaxf(am, fmaxf(fmaxf(fabsf(v[j].x), fabsf(v[j].y)), fmaxf(fabsf(v[j].z), fabsf(v[j].w)))); }
        am = wave_max(am);
        const float sc = am > 0.f ? am * (1.f / 127.f) : 1.f, inv = am > 0.f ? 127.f / am : 0.f;
        v4u o;
#pragma unroll
        for (int j = 0; j < 4; ++j) {
            const int bias = tab ? 128 : 0;
            const unsigned b0 = (unsigned)((int)rintf(v[j].x * inv) + bias) & 255u, b1 = (unsigned)((int)rintf(v[j].y * inv) + bias) & 255u,
                           b2 = (unsigned)((int)rintf(v[j].z * inv) + bias) & 255u, b3 = (unsigned)((int)rintf(v[j].w * inv) + bias) & 255u;
            o[j] = b0 | (b1 << 8) | (b2 << 16) | (b3 << 24); }
        *(GAS v4u*)(F.ws + (tab ? WS_VQ : WS_UQ) + (size_t)row * DM + F.lane * 16) = o;
        if (F.lane == 0) ((float*)(F.ws + (tab ? WS_SV : WS_SU)))[row] = sc;
    }
}

__device__ __forceinline__ void p2_rope(Frame& F) {
    bf16* Z = (bf16*)(F.ws + WS_Z);
    const int tid = F.tid, i = tid & 31, grp = tid >> 5;
    const float inv_freq = powf(10000.0f, -(float)(2 * i) / 64.0f);
    for (int blk = F.wg; blk < T / 16; blk += F.G) {
        for (int k = 0; k < 16; ++k) { const int g = blk * 16 + k, s = g & (SEQ - 1);
            const float ang = (float)s * inv_freq;
            const double r = (double)ang - rint((double)ang * 0.15915494309189535) * 6.283185307179586;
            const float rf = (float)r; const float cs = cosf(rf), sn = sinf(rf);
            bf16* p = Z + (size_t)g * IN_COLS + C_AQ + grp * 64 + i;
            const float x1 = bf2f(p[0]), x2 = bf2f(p[32]);
            p[0] = (bf16)f2bf(x1 * cs - x2 * sn); p[32] = (bf16)f2bf(x1 * sn + x2 * cs); }
    }
}

typedef float f32x16 __attribute__((ext_vector_type(16)));
constexpr int SBS = 144;
constexpr int R1_EPRE = 0, R1_APRE = 16384, R1_AAB = 0, R1_X = 16384;
constexpr int R1_AT = 32768, R1_BT = 41984, R1_KT = 51200, R1_RT = 60416, R1_AHT = R1_BT, R1_U0T = R1_KT;
constexpr int R1_BBT = 69632, R1_KBT = 78848, R1_VT = 88064;
constexpr int R1_ACTW = 97280, R1_ACTA = 106496, R1_AAK = 97280, R1_ARB = 106496, R1_ARK = 115712;
constexpr int R1_BONUS = 124928, R1_WEND = 125184, R1_SEGS = 125440, R1_TII = 125440, R1_END = 129536;
static_assert(R1_END <= LDSCTL_OFF, "R1 LDS");
__device__ __forceinline__ int crow(int r, int hh) { return (r & 3) + 8 * (r >> 2) + 4 * hh; }
template <int KS> __device__ __forceinline__ f32x16 wtile(const LAS unsigned char* A, int sa, const LAS unsigned char* B, int sb, f32x16 acc, int lane) {
    const int row = lane & 31, hh = lane >> 5;
#pragma unroll
    for (int s = 0; s < KS; ++s) { const bf16x8 a = *(const LAS bf16x8*)(A + row * sa + 32 * s + 16 * hh); const bf16x8 b = *(const LAS bf16x8*)(B + row * sb + 32 * s + 16 * hh);
        acc = __builtin_amdgcn_mfma_f32_32x32x16_bf16(a, b, acc, 0, 0, 0); }
    return acc;
}
template <int KS> __device__ __forceinline__ f32x16 wtile_gb(const LAS unsigned char* A, int sa, const bf16* Bg, int ldb, f32x16 acc, int lane) {
    const int row = lane & 31, hh = lane >> 5;
#pragma unroll
    for (int s = 0; s < KS; ++s) { const bf16x8 a = *(const LAS bf16x8*)(A + row * sa + 32 * s + 16 * hh); const bf16x8 b = *(const GAS bf16x8*)(Bg + (size_t)row * ldb + 16 * s + 8 * hh);
        acc = __builtin_amdgcn_mfma_f32_32x32x16_bf16(a, b, acc, 0, 0, 0); }
    return acc;
}
__device__ __forceinline__ f32x16 zero16() { f32x16 z;
#pragma unroll
    for (int r = 0; r < 16; ++r) z[r] = 0.f;
    return z; }

struct R1Pre { v4u wd[2], ad[2], z[4]; };
__device__ __forceinline__ int r13_item(int wg, int G, int idx) { return G == 256 ? ((wg >> 3) * 128 + (wg & 7) + 8 * idx) : (wg + G * idx); }
__device__ __forceinline__ int r13_count(int wg, int G) { return G == 256 ? 16 : ((NB * NHR * 128 - wg + G - 1) / G); }
__device__ __forceinline__ void rwkv_r1_prefetch(Frame& F, int item, int tid, R1Pre& P) {
    const int chain = item >> 7, chunk = item & 127, b = chain >> 3, h = chain & 7, g0 = b * SEQ + chunk * 64;
    const bf16* Z = (const bf16*)(F.ws + WS_Z);
    const v4u z0 = (v4u){0u, 0u, 0u, 0u};
    { const int t = tid >> 3, cg = tid & 7; const bool first = (chunk == 0 && t == 0);
      const bf16* zr = Z + (size_t)(g0 + t) * IN_COLS;
      P.wd[0] = *(const GAS v4u*)(zr + C_WD + cg * 8); P.ad[0] = *(const GAS v4u*)(zr + C_AD + cg * 8);
      P.wd[1] = z0; P.ad[1] = z0;
      if (!first) { P.wd[1] = *(const GAS v4u*)(zr - IN_COLS + C_WD + cg * 8); P.ad[1] = *(const GAS v4u*)(zr - IN_COLS + C_AD + cg * 8); } }
#pragma unroll
    for (int q = 0; q < 4; ++q) { const int p = tid + 512 * q; P.z[q] = z0;
        if (p < 65 * 24) { const int row = p / 24, rem = p - row * 24, seg = rem >> 3, ch = rem & 7;
            if (!(chunk == 0 && row == 0)) P.z[q] = *(const GAS v4u*)(Z + (size_t)(g0 - 1 + row) * IN_COLS + seg * 512 + h * 64 + ch * 8); } }
}
constexpr int R1_ZS = R1_AT, R1_ZSS = 384;
static_assert(65 * R1_ZSS <= 4 * 9216, "ZS fits in the At..Rt region");
__device__ __forceinline__ void rwkv_r1_item(Frame& F, int item, int next_item, R1Pre& P) {
    const int chain = item >> 7, chunk = item & 127, b = chain >> 3, h = chain & 7;
    const int g0 = b * SEQ + chunk * 64;
    int tid_ = F.tid; asm volatile("" : "+v"(tid_));
    const int tid = tid_, lane = tid & 63, w = __builtin_amdgcn_readfirstlane(tid >> 6), hh = lane >> 5, cl = lane & 31;
    const bf16* Z = (const bf16*)(F.ws + WS_Z);
    LAS unsigned char* lds = F.lds + RING_OFF;
    const float* mu = F.in[3];
    {
        const int t = tid >> 3, cg = tid & 7;
        const v4u cw = P.wd[0], ca = P.ad[0], pw = P.wd[1], pa = P.ad[1];
        float fw[8], fa[8], qw[8], qa[8];
        fw[0] = bflo(cw.x); fw[1] = bfhi(cw.x); fw[2] = bflo(cw.y); fw[3] = bfhi(cw.y); fw[4] = bflo(cw.z); fw[5] = bfhi(cw.z); fw[6] = bflo(cw.w); fw[7] = bfhi(cw.w);
        fa[0] = bflo(ca.x); fa[1] = bfhi(ca.x); fa[2] = bflo(ca.y); fa[3] = bfhi(ca.y); fa[4] = bflo(ca.z); fa[5] = bfhi(ca.z); fa[6] = bflo(ca.w); fa[7] = bfhi(ca.w);
        qw[0] = bflo(pw.x); qw[1] = bfhi(pw.x); qw[2] = bflo(pw.y); qw[3] = bfhi(pw.y); qw[4] = bflo(pw.z); qw[5] = bfhi(pw.z); qw[6] = bflo(pw.w); qw[7] = bfhi(pw.w);
        qa[0] = bflo(pa.x); qa[1] = bfhi(pa.x); qa[2] = bflo(pa.y); qa[3] = bfhi(pa.y); qa[4] = bflo(pa.z); qa[5] = bfhi(pa.z); qa[6] = bflo(pa.w); qa[7] = bfhi(pa.w);
#pragma unroll
        for (int j = 0; j < 8; ++j) { const int c = cg * 8 + j; const float xw = fw[j] + (qw[j] - fw[j]) * mu[C_WD + c];
            const float ex = __expf(2.f * xw); fw[j] = 1.f - 2.f * frcp(ex + 1.f);
            fa[j] = fa[j] + (qa[j] - fa[j]) * mu[C_AD + c]; }
        v4u ow, oa; ow.x = pk2(fw[0], fw[1]); ow.y = pk2(fw[2], fw[3]); ow.z = pk2(fw[4], fw[5]); ow.w = pk2(fw[6], fw[7]);
        oa.x = pk2(fa[0], fa[1]); oa.y = pk2(fa[2], fa[3]); oa.z = pk2(fa[4], fa[5]); oa.w = pk2(fa[6], fa[7]);
        *(LAS v4u*)(lds + R1_ACTW + t * SBS + cg * 16) = ow; *(LAS v4u*)(lds + R1_ACTA + t * SBS + cg * 16) = oa;
#pragma unroll
        for (int q = 0; q < 4; ++q) { const int p = tid + 512 * q;
            if (p < 65 * 24) { const int row = p / 24, rem = p - row * 24; *(LAS v4u*)(lds + R1_ZS + row * R1_ZSS + rem * 16) = P.z[q]; } }
        if (next_item >= 0) rwkv_r1_prefetch(F, next_item, tid, P);
    }
    LDS_BARRIER();
    {
        const int p = w >> 2, mt = (w >> 1) & 1, nt = w & 1;
        const bf16* upt = (const bf16*)(F.ws + (p == 0 ? WS_WUPT : WS_AUPT)) + (size_t)(h * 64 + nt * 32) * 64;
        const f32x16 acc = wtile_gb<4>(lds + (p == 0 ? R1_ACTW : R1_ACTA) + mt * 32 * SBS, SBS, upt, 64, zero16(), lane);
        LAS float* O = (LAS float*)(lds + (p == 0 ? R1_EPRE : R1_APRE));
#pragma unroll
        for (int r = 0; r < 16; ++r) O[(mt * 32 + crow(r, hh)) * 64 + nt * 32 + cl] = acc[r];
    }
    LDS_BARRIER();
    {
        const int c = tid & 63, ts = tid >> 6, col = h * 64 + c;
        const float mu_r = mu[C_R + col], mu_k = mu[C_K + col], mu_v = mu[C_V + col], kkc = F.in[9][col], kac = F.in[10][col], rkc = F.in[11][col], w0c = F.in[4][col], a0c = F.in[6][col];
        const LAS float* EP = (const LAS float*)(lds + R1_EPRE); const LAS float* AP = (const LAS float*)(lds + R1_APRE);
        LAS float* SEGS = (LAS float*)(lds + R1_SEGS); LAS float* BON = (LAS float*)(lds + R1_BONUS);
        const LAS bf16* zb = (const LAS bf16*)(lds + R1_ZS + (8 * ts) * R1_ZSS) + c;
        float pr = bf2f(zb[0]), pk = bf2f(zb[64]), pv = bf2f(zb[128]);
        float rr[8], k2[8], ai[8], bi[8], vv[8], ee[8], cs[8]; float run = 0.f;
#pragma unroll
        for (int i = 0; i < 8; ++i) {
            const float zr = bf2f(zb[(i + 1) * (R1_ZSS / 2)]), zk = bf2f(zb[(i + 1) * (R1_ZSS / 2) + 64]), zv = bf2f(zb[(i + 1) * (R1_ZSS / 2) + 128]);
            const float r = zr + (pr - zr) * mu_r, k = zk + (pk - zk) * mu_k, v = zv + (pv - zv) * mu_v; pr = zr; pk = zk; pv = zv;
            const float e = 0.60653066f * frcp(1.f + __expf(-(w0c + EP[(8 * ts + i) * 64 + c])));
            const float a = frcp(1.f + __expf(-(a0c + AP[(8 * ts + i) * 64 + c])));
            float kk = k * kkc; const float n2 = wave_sum(kk * kk); kk = kk * frsq(fmaxf(n2, 1e-24f));
            const float kq = k * (1.f + (a - 1.f) * kac);
            const float bon = wave_sum(r * kq * rkc); if (c == 0) BON[8 * ts + i] = bon;
            rr[i] = r; k2[i] = kq; ai[i] = -kk; bi[i] = kk * a; vv[i] = v; ee[i] = e; run += e; cs[i] = run;
        }
        SEGS[ts * 64 + c] = run;
        LDS_BARRIER();
        float off = 0.f, tot = 0.f;
#pragma unroll
        for (int q = 0; q < 8; ++q) { const float sv = SEGS[q * 64 + c]; tot += sv; off += (q < ts) ? sv : 0.f; }
        float bb[8], kb[8];
#pragma unroll
        for (int i = 0; i < 8; ++i) { const float L = off + cs[i];
            const float Wm = __expf(-(L - ee[i])), Wi = __expf(-L), iW = __expf(L), We = __expf(-(tot - L));
            const int t = 8 * ts + i;
            *(LAS bf16*)(lds + R1_AT + t * SBS + c * 2) = (bf16)f2bf(ai[i] * Wm);
            *(LAS bf16*)(lds + R1_BT + t * SBS + c * 2) = (bf16)f2bf(bi[i] * iW);
            *(LAS bf16*)(lds + R1_KT + t * SBS + c * 2) = (bf16)f2bf(k2[i] * iW);
            *(LAS bf16*)(lds + R1_RT + t * SBS + c * 2) = (bf16)f2bf(rr[i] * Wi);
            bb[i] = bi[i] * We; kb[i] = k2[i] * We; }
        v4u o; o.x = pk2(bb[0], bb[1]); o.y = pk2(bb[2], bb[3]); o.z = pk2(bb[4], bb[5]); o.w = pk2(bb[6], bb[7]);
        *(LAS v4u*)(lds + R1_BBT + c * SBS + ts * 16) = o;
        o.x = pk2(kb[0], kb[1]); o.y = pk2(kb[2], kb[3]); o.z = pk2(kb[4], kb[5]); o.w = pk2(kb[6], kb[7]);
        *(LAS v4u*)(lds + R1_KBT + c * SBS + ts * 16) = o;
        o.x = pk2(vv[0], vv[1]); o.y = pk2(vv[2], vv[3]); o.z = pk2(vv[4], vv[5]); o.w = pk2(vv[6], vv[7]);
        *(LAS v4u*)(lds + R1_VT + c * SBS + ts * 16) = o;
        if (ts == 0) ((LAS float*)(lds + R1_WEND))[c] = __expf(-tot);
    }
    LDS_BARRIER();
#pragma unroll
    for (int u = 0; u < 2; ++u) {
        const int idx = w * 2 + u, p = idx >> 2, mt = (idx >> 1) & 1, nt = idx & 1;
        const LAS unsigned char* Aop = lds + ((p == 0 || p == 2) ? R1_BT : R1_KT) + mt * 32 * SBS;
        const LAS unsigned char* Bop = lds + (p < 2 ? R1_AT : R1_RT) + nt * 32 * SBS;
        f32x16 acc = wtile<4>(Aop, SBS, Bop, SBS, zero16(), lane);
        const int n = nt * 32 + cl;
#pragma unroll
        for (int r = 0; r < 16; ++r) { const int m = mt * 32 + crow(r, hh); const bool keep = (p < 2) ? (m < n) : (m <= n); acc[r] = keep ? acc[r] : 0.f; }
#pragma unroll
        for (int g4 = 0; g4 < 4; ++g4) { const int m0 = mt * 32 + 8 * g4 + 4 * hh;
            if (p == 0) *(LAS f32x4*)(lds + R1_AAB + (n * 64 + m0) * 4) = (f32x4){acc[4 * g4], acc[4 * g4 + 1], acc[4 * g4 + 2], acc[4 * g4 + 3]};
            else { v2u o; o.x = pk2(acc[4 * g4], acc[4 * g4 + 1]); o.y = pk2(acc[4 * g4 + 2], acc[4 * g4 + 3]);
                   *(LAS v2u*)(lds + (p == 1 ? R1_AAK : (p == 2 ? R1_ARB : R1_ARK)) + n * SBS + m0 * 2) = o; } }
    }
    LDS_BARRIER();
    if (w < 4) {
        const int mt = w >> 1, nt = w & 1;
        const f32x16 acc = wtile<4>(lds + R1_AAK + mt * 32 * SBS, SBS, lds + R1_VT + nt * 32 * SBS, SBS, zero16(), lane);
        LAS float* X = (LAS float*)(lds + R1_X);
#pragma unroll
        for (int r = 0; r < 16; ++r) X[(mt * 32 + crow(r, hh)) * 64 + nt * 32 + cl] = acc[r];
    } else if (w == 4) {
        const int bk = lane >> 4, c = lane & 15;
        const LAS float* AAB = (const LAS float*)(lds + R1_AAB);
        float Tc[16]; const float fc = (float)c;
#pragma unroll
        for (int s2 = 0; s2 < 16; ++s2) Tc[s2] = fmaxf(0.f, 1.f - fabsf((float)s2 - fc));
#pragma unroll
        for (int r = 0; r < 15; ++r)
#pragma unroll
            for (int s2 = r + 1; s2 < 16; ++s2) Tc[s2] += AAB[(16 * bk + s2) * 64 + 16 * bk + r] * Tc[r];
        LAS float* TII = (LAS float*)(lds + R1_TII);
#pragma unroll
        for (int s2 = 0; s2 < 16; ++s2) TII[(bk * 16 + s2) * 16 + c] = Tc[s2];
    }
    LDS_BARRIER();
    {
        const int c16 = lane & 15, g = lane >> 4;
        const LAS float* AAB = (const LAS float*)(lds + R1_AAB); const LAS float* TII = (const LAS float*)(lds + R1_TII); const LAS float* X = (const LAS float*)(lds + R1_X);
        f32x4 o[4];
#pragma unroll
        for (int i = 0; i < 4; ++i) {
            f32x4 acc;
            if (w < 4) {
#pragma unroll
                for (int q = 0; q < 4; ++q) acc[q] = bf2f(*(const LAS bf16*)(lds + R1_AT + (16 * i + 4 * g + q) * SBS + (16 * w + c16) * 2));
            } else {
#pragma unroll
                for (int q = 0; q < 4; ++q) acc[q] = X[(16 * i + 4 * g + q) * 64 + 16 * (w - 4) + c16];
            }
#pragma unroll
            for (int j = 0; j < i; ++j) { const f32x4 a4 = *(const LAS f32x4*)(AAB + (16 * i + c16) * 64 + 16 * j + 4 * g);
#pragma unroll
                for (int q = 0; q < 4; ++q) acc = __builtin_amdgcn_mfma_f32_16x16x4f32(a4[q], o[j][q], acc, 0, 0, 0); }
            const f32x4 t4 = *(const LAS f32x4*)(TII + (i * 16 + c16) * 16 + 4 * g);
            f32x4 res = (f32x4){0.f, 0.f, 0.f, 0.f};
#pragma unroll
            for (int q = 0; q < 4; ++q) res = __builtin_amdgcn_mfma_f32_16x16x4f32(t4[q], acc[q], res, 0, 0, 0);
            o[i] = res;
            v2u ov; ov.x = pk2(res[0], res[1]); ov.y = pk2(res[2], res[3]);
            *(LAS v2u*)(lds + (w < 4 ? R1_AHT : R1_U0T) + (16 * (w & 3) + c16) * SBS + (16 * i + 4 * g) * 2) = ov;
        }
    }
    LDS_BARRIER();
    {
        float* Mg = F.out + (size_t)item * 4096; float* NTg = F.out + (size_t)T * RWW + (size_t)item * 4096;
        float* Y0g = (float*)(F.ws + WS_RWY0) + (size_t)item * 4096; bf16* RHg = (bf16*)(F.ws + WS_RWRH) + (size_t)item * 4096;
#pragma unroll
        for (int u = 0; u < 2; ++u) {
            const int idx = w * 2 + u, p = idx >> 2, mt = (idx >> 1) & 1, nt = idx & 1; const int n = nt * 32 + cl;
            if (p == 0) {
                f32x16 acc = wtile<4>(lds + R1_AHT + mt * 32 * SBS, SBS, lds + R1_BBT + nt * 32 * SBS, SBS, zero16(), lane);
                const float we = ((const LAS float*)(lds + R1_WEND))[n];
#pragma unroll
                for (int g4 = 0; g4 < 4; ++g4) { const int m0 = mt * 32 + 8 * g4 + 4 * hh;
                    *(GAS f32x4*)(Mg + n * 64 + m0) = (f32x4){acc[4 * g4] + (m0 == n ? we : 0.f), acc[4 * g4 + 1] + (m0 + 1 == n ? we : 0.f), acc[4 * g4 + 2] + (m0 + 2 == n ? we : 0.f), acc[4 * g4 + 3] + (m0 + 3 == n ? we : 0.f)}; }
            } else if (p == 1) {
                f32x16 acc = wtile<4>(lds + R1_BBT + mt * 32 * SBS, SBS, lds + R1_U0T + nt * 32 * SBS, SBS, zero16(), lane);
                acc = wtile<4>(lds + R1_KBT + mt * 32 * SBS, SBS, lds + R1_VT + nt * 32 * SBS, SBS, acc, lane);
#pragma unroll
                for (int g4 = 0; g4 < 4; ++g4) *(GAS f32x4*)(NTg + n * 64 + mt * 32 + 8 * g4 + 4 * hh) = (f32x4){acc[4 * g4], acc[4 * g4 + 1], acc[4 * g4 + 2], acc[4 * g4 + 3]};
            } else if (p == 2) {
                f32x16 acc = wtile<4>(lds + R1_AHT + mt * 32 * SBS, SBS, lds + R1_ARB + nt * 32 * SBS, SBS, zero16(), lane);
#pragma unroll
                for (int g4 = 0; g4 < 4; ++g4) { const int m0 = mt * 32 + 8 * g4 + 4 * hh;
                    const v2u rt = *(const LAS v2u*)(lds + R1_RT + n * SBS + m0 * 2);
                    v2u ov; ov.x = pk2(acc[4 * g4] + bflo(rt.x), acc[4 * g4 + 1] + bfhi(rt.x)); ov.y = pk2(acc[4 * g4 + 2] + bflo(rt.y), acc[4 * g4 + 3] + bfhi(rt.y));
                    *(GAS v2u*)(RHg + n * 64 + m0) = ov; }
            } else {
                f32x16 acc = wtile<4>(lds + R1_U0T + mt * 32 * SBS, SBS, lds + R1_ARB + nt * 32 * SBS, SBS, zero16(), lane);
                acc = wtile<4>(lds + R1_VT + mt * 32 * SBS, SBS, lds + R1_ARK + nt * 32 * SBS, SBS, acc, lane);
#pragma unroll
                for (int g4 = 0; g4 < 4; ++g4) *(GAS f32x4*)(Y0g + n * 64 + mt * 32 + 8 * g4 + 4 * hh) = (f32x4){acc[4 * g4], acc[4 * g4 + 1], acc[4 * g4 + 2], acc[4 * g4 + 3]};
            }
        }
        if (tid < 64) ((float*)(F.ws + WS_BONUS))[(size_t)item * 64 + tid] = ((const LAS float*)(lds + R1_BONUS))[tid];
    }
    LDS_BARRIER();
}

__device__ __forceinline__ void rwkv_r2_chain(Frame& F, int chain) {
    const int w = F.wave; if (w >= 4) return;
    const int lane = F.lane, n16 = lane & 15, g = lane >> 4;
    const float* Mg = F.out + (size_t)chain * 128 * 4096; const float* NTg = F.out + (size_t)T * RWW + (size_t)chain * 128 * 4096;
    float* SSg = (float*)(F.ws + WS_RWSS) + (size_t)chain * 128 * 4096;
    f32x4 st[4];
#pragma unroll
    for (int rt = 0; rt < 4; ++rt) st[rt] = (f32x4){0.f, 0.f, 0.f, 0.f};
    f32x4 ma[4][4], nv[4];
#pragma unroll
    for (int rt = 0; rt < 4; ++rt) {
#pragma unroll
        for (int kt = 0; kt < 4; ++kt) ma[rt][kt] = *(const GAS f32x4*)(Mg + (16 * rt + n16) * 64 + 16 * kt + 4 * g);
        nv[rt] = *(const GAS f32x4*)(NTg + (16 * w + n16) * 64 + 16 * rt + 4 * g); }
    for (int c = 0; c < 128; ++c) {
#pragma unroll
        for (int rt = 0; rt < 4; ++rt) *(GAS f32x4*)(SSg + (size_t)c * 4096 + (16 * w + n16) * 64 + 16 * rt + 4 * g) = st[rt];
        if (c == 127) break;
        f32x4 nw[4];
#pragma unroll
        for (int rt = 0; rt < 4; ++rt) { f32x4 acc = nv[rt];
#pragma unroll
            for (int kt = 0; kt < 4; ++kt)
#pragma unroll
                for (int q = 0; q < 4; ++q) acc = __builtin_amdgcn_mfma_f32_16x16x4f32(ma[rt][kt][q], st[kt][q], acc, 0, 0, 0);
            nw[rt] = acc; }
        const float* Mn = Mg + (size_t)(c + 1) * 4096; const float* Nn = NTg + (size_t)(c + 1) * 4096;
#pragma unroll
        for (int rt = 0; rt < 4; ++rt) {
#pragma unroll
            for (int kt = 0; kt < 4; ++kt) ma[rt][kt] = *(const GAS f32x4*)(Mn + (16 * rt + n16) * 64 + 16 * kt + 4 * g);
            nv[rt] = *(const GAS f32x4*)(Nn + (16 * w + n16) * 64 + 16 * rt + 4 * g); }
#pragma unroll
        for (int rt = 0; rt < 4; ++rt) st[rt] = nw[rt];
    }
}

constexpr int R3_RH = 0, R3_S = 9216, R3_SG = 18432, R3_SGS = 272, R3_YL = R3_SG + 64 * R3_SGS, R3_GL = R3_YL + 16384, R3_END = R3_GL + 16384;
static_assert(R3_END <= LDSCTL_OFF, "R3 LDS");
__device__ __forceinline__ void rwkv_r3_item(Frame& F, int item) {
    const int chain = item >> 7, chunk = item & 127, b = chain >> 3, h = chain & 7;
    const int g0 = b * SEQ + chunk * 64;
    int tid_ = F.tid; asm volatile("" : "+v"(tid_));
    const int tid = tid_, lane = tid & 63, w = __builtin_amdgcn_readfirstlane(tid >> 6), hh = lane >> 5, cl = lane & 31;
    const bf16* Z = (const bf16*)(F.ws + WS_Z);
    LAS unsigned char* lds = F.lds + RING_OFF;
    const float* mu = F.in[3];
    {
        const int t = tid >> 3, cg = tid & 7;
        const bf16* RHg = (const bf16*)(F.ws + WS_RWRH) + (size_t)item * 4096;
        *(LAS v4u*)(lds + R3_RH + t * SBS + cg * 16) = *(const GAS v4u*)(RHg + t * 64 + cg * 8);
        const float* SSg = (const float*)(F.ws + WS_RWSS) + (size_t)item * 4096;
        const f32x4 s0 = *(const GAS f32x4*)(SSg + t * 64 + cg * 8), s1 = *(const GAS f32x4*)(SSg + t * 64 + cg * 8 + 4);
        v4u o; o.x = pk2(s0[0], s0[1]); o.y = pk2(s0[2], s0[3]); o.z = pk2(s1[0], s1[1]); o.w = pk2(s1[2], s1[3]);
        *(LAS v4u*)(lds + R3_S + t * SBS + cg * 16) = o;
        const bool first = (chunk == 0 && t == 0);
        const bf16* zr = Z + (size_t)(g0 + t) * IN_COLS + C_GD + cg * 16;
#pragma unroll
        for (int q = 0; q < 2; ++q) {
            const v4u cw = *(const GAS v4u*)(zr + q * 8); v4u pw = (v4u){0u, 0u, 0u, 0u};
            if (!first) pw = *(const GAS v4u*)(zr - IN_COLS + q * 8);
            float fw[8], qw[8];
            fw[0] = bflo(cw.x); fw[1] = bfhi(cw.x); fw[2] = bflo(cw.y); fw[3] = bfhi(cw.y); fw[4] = bflo(cw.z); fw[5] = bfhi(cw.z); fw[6] = bflo(cw.w); fw[7] = bfhi(cw.w);
            qw[0] = bflo(pw.x); qw[1] = bfhi(pw.x); qw[2] = bflo(pw.y); qw[3] = bfhi(pw.y); qw[4] = bflo(pw.z); qw[5] = bfhi(pw.z); qw[6] = bflo(pw.w); qw[7] = bfhi(pw.w);
#pragma unroll
            for (int j = 0; j < 8; ++j) { const float v = fw[j] + (qw[j] - fw[j]) * mu[C_GD + cg * 16 + q * 8 + j]; fw[j] = frcp(1.f + __expf(-v)); }
            v4u og; og.x = pk2(fw[0], fw[1]); og.y = pk2(fw[2], fw[3]); og.z = pk2(fw[4], fw[5]); og.w = pk2(fw[6], fw[7]);
            *(LAS v4u*)(lds + R3_SG + t * R3_SGS + (cg * 16 + q * 8) * 2) = og;
        }
    }
    LDS_BARRIER();
    {
        const int mt = (w >> 1) & 1, nt = w & 1; const int n = nt * 32 + cl;
        if (w < 4) {
            const float* Y0g = (const float*)(F.ws + WS_RWY0) + (size_t)item * 4096;
            f32x16 acc;
#pragma unroll
            for (int r = 0; r < 16; ++r) acc[r] = Y0g[(mt * 32 + crow(r, hh)) * 64 + n];
            acc = wtile<4>(lds + R3_RH + mt * 32 * SBS, SBS, lds + R3_S + nt * 32 * SBS, SBS, acc, lane);
            LAS float* YL = (LAS float*)(lds + R3_YL);
#pragma unroll
            for (int r = 0; r < 16; ++r) YL[(mt * 32 + crow(r, hh)) * 64 + n] = acc[r];
        } else {
            const bf16* gut = (const bf16*)(F.ws + WS_GUPT) + (size_t)(h * 64 + nt * 32) * 128;
            const f32x16 acc = wtile_gb<8>(lds + R3_SG + mt * 32 * R3_SGS, R3_SGS, gut, 128, zero16(), lane);
            LAS float* GL = (LAS float*)(lds + R3_GL);
#pragma unroll
            for (int r = 0; r < 16; ++r) GL[(mt * 32 + crow(r, hh)) * 64 + n] = acc[r];
        }
    }
    LDS_BARRIER();
    {
        const int c = tid & 63, ts = tid >> 6, col = h * 64 + c;
        const float mu_v = mu[C_V + col], gw = F.in[12][col], gb = F.in[13][col];
        const LAS float* YL = (const LAS float*)(lds + R3_YL); const LAS float* GL = (const LAS float*)(lds + R3_GL);
        const float* BON = (const float*)(F.ws + WS_BONUS) + (size_t)item * 64;
        bf16* Y = (bf16*)(F.ws + WS_YMIX);
        const bf16* zb = Z + (size_t)(g0 + 8 * ts) * IN_COLS + col;
        float pv = 0.f; if (!(chunk == 0 && ts == 0)) pv = bf2f(zb[C_V - IN_COLS]);
#pragma unroll
        for (int i = 0; i < 8; ++i) { const int t = 8 * ts + i;
            const float zv = bf2f(zb[(size_t)i * IN_COLS + C_V]); const float v = zv + (pv - zv) * mu_v; pv = zv;
            const float y = YL[t * 64 + c];
            const float mean = wave_sum(y) * (1.f / 64.f); const float d = y - mean; const float var = wave_sum(d * d) * (1.f / 64.f);
            const float yn = d * frsq(var + GN_EPS) * gw + gb;
            const float o = (yn + BON[t] * v) * GL[t * 64 + c];
            Y[(size_t)(g0 + t) * DM + col] = (bf16)f2bf(o); }
    }
    LDS_BARRIER();
}

typedef short s16x4 __attribute__((ext_vector_type(4)));
typedef short v4i16_t __attribute__((ext_vector_type(4)));
constexpr int AT_XO = 0, AT_XO_STRIDE = 136, AT_XM = 512 * AT_XO_STRIDE, AT_XL = AT_XM + 2048, AT_V = AT_XL + 2048, AT_LDS_END = AT_V + 8 * 4096;
static_assert(AT_LDS_END <= RING_BYTES, "attention LDS");
__device__ __forceinline__ float xhalf(float v) { return __shfl_xor(v, 32); }
__device__ __forceinline__ void attn_block(Frame& F, int item) {
    const int bh = item >> 4, blk = item & 15, b = bh >> 3, h = bh & 7, t0 = blk * 512;
    int tid_ = F.tid; asm volatile("" : "+v"(tid_));
    const int lane = tid_ & 63, w = __builtin_amdgcn_readfirstlane(tid_ >> 6), ql = lane & 31, hh = lane >> 5;
    const bf16* Zb = (const bf16*)(F.ws + WS_Z) + (size_t)b * SEQ * IN_COLS;
    bf16* Y = (bf16*)(F.ws + WS_YMIX);
    LAS unsigned char* lds = F.lds + RING_OFF;
    LAS unsigned char* Vw = lds + AT_V + w * 4096;
    LAS float* XM = (LAS float*)(lds + AT_XM); LAS float* XL = (LAS float*)(lds + AT_XL);
    constexpr float C2 = 0.125f * 1.4426950408889634f;
    for (int pass = 0; pass < 3; ++pass) {
        const int sh = pass == 0 ? 4 : (pass == 1 ? 2 : 0), d = 1 << sh;
        for (int uu = 0; uu < 2; ++uu) {
            const int u = w + 8 * uu, rho = u & (d - 1), tau = u >> sh;
            const int qoff = rho + (32 * tau + ql) * d;
            bf16x8 qf[4];
            { const bf16* qp = Zb + (size_t)(t0 + qoff) * IN_COLS + C_AQ + h * 64 + 8 * hh;
#pragma unroll
              for (int s = 0; s < 4; ++s) qf[s] = *(const GAS bf16x8*)(qp + 16 * s); }
            f32x16 sc[5];
            const int tkb = t0 + rho + (32 * tau - 128) * d;
#pragma unroll
            for (int kt = 0; kt < 5; ++kt) {
                const int tk0 = tkb + 32 * kt * d;
                if (tk0 >= 0) {
                    const bf16* kp = Zb + (size_t)(tk0 + ql * d) * IN_COLS + C_AK + h * 64 + 8 * hh;
                    bf16x8 kf[4];
#pragma unroll
                    for (int s = 0; s < 4; ++s) kf[s] = *(const GAS bf16x8*)(kp + 16 * s);
                    f32x16 acc;
#pragma unroll
                    for (int r = 0; r < 16; ++r) acc[r] = 0.f;
#pragma unroll
                    for (int s = 0; s < 4; ++s) acc = __builtin_amdgcn_mfma_f32_32x32x16_bf16(kf[s], qf[s], acc, 0, 0, 0);
                    if (kt == 0 || kt == 4) {
#pragma unroll
                        for (int r = 0; r < 16; ++r) { const int kidx = (r & 3) + 8 * (r >> 2) + 4 * hh;
                            const bool ok = (kt == 0) ? (kidx >= ql) : (kidx <= ql);
                            acc[r] = ok ? acc[r] : -INFINITY; }
                    }
                    sc[kt] = acc;
                } else {
#pragma unroll
                    for (int r = 0; r < 16; ++r) sc[kt][r] = -INFINITY;
                }
            }
            float m = -INFINITY;
#pragma unroll
            for (int kt = 0; kt < 5; ++kt)
#pragma unroll
                for (int r = 0; r < 16; ++r) m = fmaxf(m, sc[kt][r]);
            m = fmaxf(m, xhalf(m));
            const float ms = m * C2;
            float l = 0.f;
#pragma unroll
            for (int kt = 0; kt < 5; ++kt)
#pragma unroll
                for (int r = 0; r < 16; ++r) { const float p = __builtin_amdgcn_exp2f(sc[kt][r] * C2 - ms); sc[kt][r] = p; l += p; }
            l += xhalf(l);
            f32x16 O[2];
#pragma unroll
            for (int r = 0; r < 16; ++r) { O[0][r] = 0.f; O[1][r] = 0.f; }
#pragma unroll
            for (int kt = 0; kt < 5; ++kt) {
                const int tk0 = tkb + 32 * kt * d;
                if (tk0 >= 0) {
                    v4u vr[4];
#pragma unroll
                    for (int i = 0; i < 4; ++i) { const int kidx = i * 8 + (lane >> 3), ch = lane & 7;
                        vr[i] = *(const GAS v4u*)(Zb + (size_t)(tk0 + kidx * d) * IN_COLS + C_AV + h * 64 + ch * 8); }
#pragma unroll
                    for (int i = 0; i < 4; ++i) { const int kidx = i * 8 + (lane >> 3), ch = lane & 7;
                        *(LAS v4u*)(Vw + kidx * 128 + ((ch ^ (((kidx >> 1) & 1) << 2)) << 4)) = vr[i]; }
                    asm volatile("s_waitcnt lgkmcnt(0)" ::: "memory");
#pragma unroll
                    for (int s = 0; s < 2; ++s) {
                        bf16x8 pf;
#pragma unroll
                        for (int j = 0; j < 8; ++j) pf[j] = (short)f2bf(sc[kt][8 * s + j]);
#pragma unroll
                        for (int dt = 0; dt < 2; ++dt) {
                            bf16x8 vf;
#pragma unroll
                            for (int pp = 0; pp < 2; ++pp) {
                                const int i16 = lane & 15, db = (lane >> 4) & 1;
                                const int row = 16 * s + 8 * pp + 4 * hh + (i16 >> 2);
                                const int byte = 64 * dt + 32 * db + 8 * (i16 & 3);
                                const int chunk = (byte >> 4) ^ (((row >> 1) & 1) << 2);
                                const s16x4 t4 = __builtin_bit_cast(s16x4, __builtin_amdgcn_ds_read_tr16_b64_v4i16((LAS v4i16_t*)(Vw + row * 128 + (chunk << 4) + (byte & 15))));
                                vf[4 * pp + 0] = t4[0]; vf[4 * pp + 1] = t4[1]; vf[4 * pp + 2] = t4[2]; vf[4 * pp + 3] = t4[3];
                            }
                            O[dt] = __builtin_amdgcn_mfma_f32_32x32x16_bf16(vf, pf, O[dt], 0, 0, 0);
                        }
                    }
                    asm volatile("s_waitcnt lgkmcnt(0)" ::: "memory");
                }
            }
            LAS unsigned char* xo = lds + AT_XO + qoff * AT_XO_STRIDE + 8 * hh;
            float wa = 0.f, wb = 1.f, Mx = ms, ln = l;
            if (pass > 0) { const float msa = XM[qoff], la = XL[qoff]; Mx = fmaxf(msa, ms); wa = la * __builtin_amdgcn_exp2f(msa - Mx); wb = __builtin_amdgcn_exp2f(ms - Mx); ln = wa + wb * l; }
            const float inv = 1.f / ln;
#pragma unroll
            for (int dt = 0; dt < 2; ++dt)
#pragma unroll
                for (int g4 = 0; g4 < 4; ++g4) {
                    LAS v2u* p = (LAS v2u*)(xo + (32 * dt + 8 * g4) * 2);
                    float o0 = O[dt][4 * g4] * wb, o1 = O[dt][4 * g4 + 1] * wb, o2 = O[dt][4 * g4 + 2] * wb, o3 = O[dt][4 * g4 + 3] * wb;
                    if (pass > 0) { const v2u old = *p; o0 += bflo(old.x) * wa; o1 += bfhi(old.x) * wa; o2 += bflo(old.y) * wa; o3 += bfhi(old.y) * wa; }
                    v2u nw; nw.x = pk2(o0 * inv, o1 * inv); nw.y = pk2(o2 * inv, o3 * inv);
                    *p = nw;
                }
            if (hh == 0) { XM[qoff] = Mx; XL[qoff] = ln; }
        }
        LDS_BARRIER();
    }
#pragma unroll
    for (int i = 0; i < 8; ++i) { const int row = (tid_ >> 3) + 64 * i, ch = tid_ & 7;
        LAS v2u* p = (LAS v2u*)(lds + AT_XO + row * AT_XO_STRIDE + ch * 16);
        const v2u a = p[0], c = p[1];
        v4u o; o.x = a.x; o.y = a.y; o.z = c.x; o.w = c.y;
        *(GAS v4u*)(Y + ((size_t)b * SEQ + t0 + row) * DM + RWW + h * 64 + ch * 8) = o; }
    LDS_BARRIER();
}

__device__ __forceinline__ void p3_mixers(Frame& F) {
    const int nrw = (F.G >= 64) ? 32 : 0;
    if (nrw == 0) { for (int ch = 0; ch < NB * NHR; ++ch) rwkv_r2_chain(F, ch); }
    else if (F.wg < nrw) { for (int ch = F.wg; ch < NB * NHR; ch += nrw) rwkv_r2_chain(F, ch); return; }
    const int na = F.G - nrw, wa = F.wg - nrw;
    for (int item = wa; item < NB * NHA * (SEQ / 512); item += na) attn_block(F, item);
}

__device__ __forceinline__ void p5_xn2(Frame& F) {
    const int gw = F.wg * NWAVES + F.wave, NGW = F.G * NWAVES;
    bf16* XN = (bf16*)(F.ws + WS_XN);
    for (int m = gw; m < T; m += NGW) rms_row_to_bf16(F.lane, F.out + (size_t)m * DM, F.in[15], XN + (size_t)m * DM);
}

constexpr int TK_SKS = 272, TK_SKH = 0, TK_SKL = 2 * 128 * TK_SKS, TK_LUT = 2 * TK_SKL, TK_END = TK_LUT + 8 * 2048;
__device__ __forceinline__ unsigned f2ord(float f) { const unsigned u = __builtin_bit_cast(unsigned, f); return u ^ ((unsigned)((int)u >> 31) | 0x80000000u); }
__device__ __forceinline__ float ord2f(unsigned o) { const unsigned u = (o & 0x80000000u) ? (o ^ 0x80000000u) : ~o; return __builtin_bit_cast(float, u); }
__device__ __forceinline__ void ce_desc(unsigned& a, unsigned& b) { const unsigned mx = a > b ? a : b, mn = a > b ? b : a; a = mx; b = mn; }
template <int N, int OFF, int TOT> __device__ __forceinline__ void bitonic_sort_desc(unsigned (&v)[TOT]) {
#pragma unroll
    for (int k = 2; k <= N; k <<= 1)
#pragma unroll
        for (int j = k >> 1; j > 0; j >>= 1)
#pragma unroll
            for (int i = 0; i < N; ++i) { const int l = i ^ j; if (l > i) { if ((i & k) == 0) ce_desc(v[OFF + i], v[OFF + l]); else ce_desc(v[OFF + l], v[OFF + i]); } }
}
template <int OFFA, int OFFB, int TOT> __device__ __forceinline__ void merge_top16(unsigned (&v)[TOT]) {
#pragma unroll
    for (int i = 0; i < 16; ++i) { const unsigned x = v[OFFA + i], y = v[OFFB + 15 - i]; v[OFFA + i] = x > y ? x : y; }
#pragma unroll
    for (int j = 8; j > 0; j >>= 1)
#pragma unroll
        for (int i = 0; i < 16; ++i) { const int l = i ^ j; if (l > i) ce_desc(v[OFFA + i], v[OFFA + l]); }
}
__device__ __forceinline__ void top16_of_64(unsigned (&k)[64]) {
    bitonic_sort_desc<16, 0, 64>(k); bitonic_sort_desc<16, 16, 64>(k); bitonic_sort_desc<16, 32, 64>(k); bitonic_sort_desc<16, 48, 64>(k);
    merge_top16<0, 16, 64>(k); merge_top16<32, 48, 64>(k); merge_top16<0, 32, 64>(k);
}
__device__ __forceinline__ void p7_topk(Frame& F) {
    static_assert(TK_END <= LDSCTL_OFF, "topk LDS");
    const bf16* QP = (const bf16*)(F.ws + WS_QP);
    int* EID = (int*)(F.ws + WS_EID); float* GATE = (float*)(F.ws + WS_GATE);
    const float* sk = F.in[17];
    LAS unsigned char* lds = F.lds + RING_OFF;
    for (int e = F.tid; e < 2 * 128 * 64; e += NTHREADS) {
        const int c = e >> 13, k = (e >> 6) & 127, d2 = e & 63;
        const f32x2 v = *(const GAS f32x2*)(sk + (size_t)(c * 128 + k) * 128 + 2 * d2);
        const unsigned h0 = f2bf(v.x), h1 = f2bf(v.y);
        const float r0 = v.x - __builtin_bit_cast(float, h0 << 16), r1 = v.y - __builtin_bit_cast(float, h1 << 16);
        *(LAS unsigned*)(lds + TK_SKH + (c * 128 + k) * TK_SKS + d2 * 4) = h0 | (h1 << 16);
        *(LAS unsigned*)(lds + TK_SKL + (c * 128 + k) * TK_SKS + d2 * 4) = pk2(r0, r1);
    }
    __syncthreads();
    const int gw = F.wg * NWAVES + F.wave, NGW = F.G * NWAVES;
    for (int tile = gw; tile < T * PHEADS / 32; tile += NGW) {
        int lane_ = F.lane; asm volatile("" : "+v"(lane_));
        const int lane = lane_, hh = lane >> 5, cl = lane & 31;
        const int P = tile * 32 + cl, t = P >> 3, h = P & 7;
        unsigned kAB[2][16];
#pragma unroll
        for (int c = 0; c < 2; ++c) {
            bf16x8 qf[8];
            const bf16* qp = QP + (size_t)t * PQ + h * 256 + c * 128 + 8 * hh;
#pragma unroll
            for (int s2 = 0; s2 < 8; ++s2) qf[s2] = *(const GAS bf16x8*)(qp + 16 * s2);
            unsigned k[64];
#pragma unroll
            for (int mt = 0; mt < 4; ++mt) {
                f32x16 acc = zero16();
                const LAS unsigned char* ah = lds + TK_SKH + (c * 128 + mt * 32 + cl) * TK_SKS + 16 * hh;
                const LAS unsigned char* al = lds + TK_SKL + (c * 128 + mt * 32 + cl) * TK_SKS + 16 * hh;
#pragma unroll
                for (int s2 = 0; s2 < 8; ++s2) {
                    acc = __builtin_amdgcn_mfma_f32_32x32x16_bf16(*(const LAS bf16x8*)(ah + 32 * s2), qf[s2], acc, 0, 0, 0);
                    acc = __builtin_amdgcn_mfma_f32_32x32x16_bf16(*(const LAS bf16x8*)(al + 32 * s2), qf[s2], acc, 0, 0, 0); }
#pragma unroll
                for (int r = 0; r < 16; ++r) { const int idx = 32 * mt + (r & 3) + 8 * (r >> 2) + 4 * hh; k[mt * 16 + r] = (f2ord(acc[r]) & ~127u) | (unsigned)(127 - idx); }
            }
            top16_of_64(k);
            unsigned m[32];
#pragma unroll
            for (int i = 0; i < 16; ++i) { m[i] = k[i]; m[16 + i] = (unsigned)__shfl_xor((int)k[i], 32); }
            merge_top16<0, 16, 32>(m);
#pragma unroll
            for (int i = 0; i < 16; ++i) kAB[c][i] = m[i];
        }
        float fa[16], fb[16];
#pragma unroll
        for (int i = 0; i < 16; ++i) { fa[i] = ord2f(kAB[0][i] & ~127u); fb[i] = ord2f(kAB[1][i] & ~127u); }
        unsigned cd[64]; int n = 0;
#pragma unroll
        for (int i = 0; i < 16; ++i)
#pragma unroll
            for (int j = 0; j < 16; ++j) if ((i + 1) * (j + 1) <= 16) { cd[n] = (f2ord(fa[i] + fb[j]) & ~255u) | (unsigned)(255 - (i * 16 + j)); ++n; }
#pragma unroll
        for (int q = 50; q < 64; ++q) cd[q] = 0u;
        top16_of_64(cd);
        LAS unsigned char* lut = lds + TK_LUT + (F.wave * 64 + lane) * 32;
#pragma unroll
        for (int q = 0; q < 4; ++q) {
            unsigned wa = 0u, wb = 0u;
#pragma unroll
            for (int b4 = 0; b4 < 4; ++b4) { wa |= (127u - (kAB[0][4 * q + b4] & 127u)) << (8 * b4); wb |= (127u - (kAB[1][4 * q + b4] & 127u)) << (8 * b4); }
            *(LAS unsigned*)(lut + 4 * q) = wa; *(LAS unsigned*)(lut + 16 + 4 * q) = wb; }
        float gv[16]; float den = 0.f; const float mx = ord2f(cd[0] & ~255u);
#pragma unroll
        for (int q = 0; q < 16; ++q) { gv[q] = __expf(ord2f(cd[q] & ~255u) - mx); den += gv[q]; }
        const float inv = 1.f / den;
        asm volatile("s_waitcnt lgkmcnt(0)" ::: "memory");
        int ev[16];
#pragma unroll
        for (int q = 0; q < 16; ++q) { const unsigned pos = 255u - (cd[q] & 255u);
            const unsigned ia = *(const LAS unsigned char*)(lut + (pos >> 4)), ib = *(const LAS unsigned char*)(lut + 16 + (pos & 15u));
            ev[q] = (int)(ia * NKEYS + ib); }
        if (hh == 0) {
            int* ep = EID + (size_t)t * 128 + h * 16; float* gp = GATE + (size_t)t * 128 + h * 16;
#pragma unroll
            for (int q = 0; q < 4; ++q) {
                *(GAS v4u*)(ep + 4 * q) = (v4u){(unsigned)ev[4 * q], (unsigned)ev[4 * q + 1], (unsigned)ev[4 * q + 2], (unsigned)ev[4 * q + 3]};
                *(GAS f32x4*)(gp + 4 * q) = (f32x4){gv[4 * q] * inv, gv[4 * q + 1] * inv, gv[4 * q + 2] * inv, gv[4 * q + 3] * inv}; }
        }
        asm volatile("s_waitcnt lgkmcnt(0)" ::: "memory");
    }
}

constexpr int GA_WAVE_BYTES = 6656, GA_CNT = 4096, GA_OFF = 4096 + 128, GA_ACT = 4608;
__device__ __forceinline__ int wave_sum_i(int v) { v += dppi<0xB1>(v); v += dppi<0x4E>(v); v += dppi<0x141>(v); v += dppi<0x140>(v);
    return (__builtin_amdgcn_readlane(v, 0) + __builtin_amdgcn_readlane(v, 16)) + (__builtin_amdgcn_readlane(v, 32) + __builtin_amdgcn_readlane(v, 48)); }
struct PairBuf { v4u u, v; float su, sv; int e; float g; };
__device__ __forceinline__ void p8_gather(Frame& F, float* outp) {
    const bf16* XN = (const bf16*)(F.ws + WS_XN);
    const unsigned char* UQ = F.ws + WS_UQ; const unsigned char* VQ = F.ws + WS_VQ;
    const float* SU = (const float*)(F.ws + WS_SU); const float* SV = (const float*)(F.ws + WS_SV);
    const int* EID = (const int*)(F.ws + WS_EID); const float* GATE = (const float*)(F.ws + WS_GATE);
    const float* nf = F.in[20];
    const int gw = F.wg * NWAVES + F.wave, NGW = F.G * NWAVES;
    LAS unsigned char* wl = F.lds + RING_OFF + F.wave * GA_WAVE_BYTES;
    for (int tg = gw, sweep = 0; tg < T / 4; tg += NGW, ++sweep) {
        int lane_ = F.lane; asm volatile("" : "+v"(lane_));
        const int lane = lane_;
        int xq[4][4]; float sx[4];
#pragma unroll
        for (int tk = 0; tk < 4; ++tk) {
            const GAS v4u* xp = (const GAS v4u*)(XN + (size_t)(4 * tg + tk) * DM + lane * 16);
            const v4u a = xp[0], b = xp[1];
            float x[16]; x[0] = bflo(a.x); x[1] = bfhi(a.x); x[2] = bflo(a.y); x[3] = bfhi(a.y); x[4] = bflo(a.z); x[5] = bfhi(a.z); x[6] = bflo(a.w); x[7] = bfhi(a.w);
            x[8] = bflo(b.x); x[9] = bfhi(b.x); x[10] = bflo(b.y); x[11] = bfhi(b.y); x[12] = bflo(b.z); x[13] = bfhi(b.z); x[14] = bflo(b.w); x[15] = bfhi(b.w);
            float am = 0.f;
#pragma unroll
            for (int i = 0; i < 16; ++i) am = fmaxf(am, fabsf(x[i]));
            am = wave_max(am);
            sx[tk] = am > 0.f ? am * (1.f / 127.f) : 1.f; const float inv = am > 0.f ? 127.f / am : 0.f;
#pragma unroll
            for (int q = 0; q < 4; ++q) {
                const unsigned b0 = (unsigned)(int)rintf(x[4 * q] * inv) & 255u, b1 = (unsigned)(int)rintf(x[4 * q + 1] * inv) & 255u, b2 = (unsigned)(int)rintf(x[4 * q + 2] * inv) & 255u, b3 = (unsigned)(int)rintf(x[4 * q + 3] * inv) & 255u;
                xq[tk][q] = (int)(b0 | (b1 << 8) | (b2 << 16) | (b3 << 24)); }
        }
        LAS unsigned* cnt = (LAS unsigned*)(wl + GA_CNT); LAS unsigned* offs = (LAS unsigned*)(wl + GA_OFF);
        if (lane < 32) cnt[lane] = 0u;
        asm volatile("s_waitcnt lgkmcnt(0)" ::: "memory");
        int ee[8]; float gg[8]; unsigned pos[8];
#pragma unroll
        for (int tk = 0; tk < 4; ++tk) {
            const size_t base = (size_t)(4 * tg + tk) * 128;
            ee[2 * tk] = (EID[base + lane] & (NEXP - 1)) | (tk << 14); ee[2 * tk + 1] = (EID[base + 64 + lane] & (NEXP - 1)) | (tk << 14);
            gg[2 * tk] = GATE[base + lane]; gg[2 * tk + 1] = GATE[base + 64 + lane]; }
#pragma unroll
        for (int q = 0; q < 8; ++q) pos[q] = __hip_atomic_fetch_add(cnt + ((ee[q] >> 9) & 31), 1u, __ATOMIC_RELAXED, __HIP_MEMORY_SCOPE_WAVEFRONT);
        asm volatile("s_waitcnt lgkmcnt(0)" ::: "memory");
        if (lane < 32) {
            const int c0 = (int)cnt[lane]; int v = c0;
            v += __builtin_amdgcn_update_dpp(0, v, 0x111, 0xF, 0xF, true); v += __builtin_amdgcn_update_dpp(0, v, 0x112, 0xF, 0xF, true);
            v += __builtin_amdgcn_update_dpp(0, v, 0x114, 0xF, 0xF, true); v += __builtin_amdgcn_update_dpp(0, v, 0x118, 0xF, 0xF, true);
            const int row0 = __builtin_amdgcn_readlane(v, 15);
            offs[lane] = (unsigned)(v - c0 + (lane >= 16 ? row0 : 0));
        }
        asm volatile("s_waitcnt lgkmcnt(0)" ::: "memory");
#pragma unroll
        for (int q = 0; q < 8; ++q) { const unsigned idx = offs[(ee[q] >> 9) & 31] + pos[q];
            *(LAS unsigned*)(wl + idx * 4) = (unsigned)ee[q]; *(LAS float*)(wl + 2048 + idx * 4) = gg[q]; }
        asm volatile("s_waitcnt lgkmcnt(0)" ::: "memory");
#define GA_DOT(U, TK) (__builtin_amdgcn_sdot4(xq[TK][3], (int)(U).w, __builtin_amdgcn_sdot4(xq[TK][2], (int)(U).z, __builtin_amdgcn_sdot4(xq[TK][1], (int)(U).y, __builtin_amdgcn_sdot4(xq[TK][0], (int)(U).x, 0, false), false), false), false))
        LAS float* act = (LAS float*)(wl + GA_ACT);
        for (int ch = 0; ch < 32; ++ch) {
            const unsigned ent = *(const LAS unsigned*)(wl + (ch * 16 + (lane >> 2)) * 4);
            const float my_g = *(const LAS float*)(wl + 2048 + (ch * 16 + (lane >> 2)) * 4);
            const int my_e = (int)ent & (NEXP - 1), my_tk = ((int)ent >> 14) & 3;
            const float my_su = SU[my_e], my_sv = SV[my_e];
            int d[16];
            {
                v4u ub[2][8]; int eb[2][8];
#pragma unroll
                for (int q = 0; q < 8; ++q) { eb[0][q] = __builtin_amdgcn_readlane((int)ent, 4 * q); ub[0][q] = *(const GAS v4u*)(UQ + (size_t)(eb[0][q] & (NEXP - 1)) * DM + lane * 16); }
#pragma unroll
                for (int jb = 0; jb < 2; ++jb) {
                    if (jb == 0) {
#pragma unroll
                        for (int q = 0; q < 8; ++q) { eb[1][q] = __builtin_amdgcn_readlane((int)ent, 4 * (8 + q)); ub[1][q] = *(const GAS v4u*)(UQ + (size_t)(eb[1][q] & (NEXP - 1)) * DM + lane * 16); } }
                    __builtin_amdgcn_sched_barrier(0);
#pragma unroll
                    for (int q = 0; q < 8; ++q) { const int tk_ = (eb[jb][q] >> 14) & 3; const v4u u_ = ub[jb][q]; int r_;
                        if (tk_ == 0) r_ = GA_DOT(u_, 0); else if (tk_ == 1) r_ = GA_DOT(u_, 1); else if (tk_ == 2) r_ = GA_DOT(u_, 2); else r_ = GA_DOT(u_, 3);
                        d[8 * jb + q] = r_; }
                    __builtin_amdgcn_sched_barrier(0);
                }
            }
#pragma unroll
            for (int j = 0; j < 8; ++j) { const auto r = __builtin_amdgcn_permlane32_swap((unsigned)d[j], (unsigned)d[j + 8], false, false); d[j] = (int)r[0] + (int)r[1]; }
#pragma unroll
            for (int j = 0; j < 4; ++j) { const auto r = __builtin_amdgcn_permlane16_swap((unsigned)d[j], (unsigned)d[j + 4], false, false); d[j] = (int)r[0] + (int)r[1]; }
#pragma unroll
            for (int j = 0; j < 2; ++j) { const int u_ = d[j] + dppi<0x128>(d[j]), w_ = d[j + 2] + dppi<0x128>(d[j + 2]); d[j] = (lane & 8) ? w_ : u_; }
            { const int u_ = d[0] + dppi<0x141>(d[0]), w_ = d[1] + dppi<0x141>(d[1]); d[0] = (lane & 4) ? w_ : u_; }
            d[0] += dppi<0x4E>(d[0]); d[0] += dppi<0xB1>(d[0]);
            const float sxl = my_tk == 0 ? sx[0] : (my_tk == 1 ? sx[1] : (my_tk == 2 ? sx[2] : sx[3]));
            const float h_ = (float)d[0] * (my_su * sxl);
            const float a_ = 0.5f * h_ * (1.f + erff(h_ * 0.70710678118654752f)) * my_g * my_sv;
            if ((lane & 3) == 0) act[ch * 16 + (lane >> 2)] = a_;
        }
#undef GA_DOT
        asm volatile("s_waitcnt lgkmcnt(0)" ::: "memory");
        float y[4][16]; float yo[4];
#pragma unroll
        for (int tk = 0; tk < 4; ++tk) { yo[tk] = 0.f;
#pragma unroll
            for (int i = 0; i < 16; ++i) y[tk][i] = 0.f; }
#define GA_AXPY(V, A, TK) do { yo[TK] += (A) * 128.f; \
            _Pragma("unroll") for (int q_ = 0; q_ < 4; ++q_) { const unsigned w_ = (V)[q_]; \
                y[TK][4 * q_] += (A) * (float)(w_ & 255u); y[TK][4 * q_ + 1] += (A) * (float)((w_ >> 8) & 255u); y[TK][4 * q_ + 2] += (A) * (float)((w_ >> 16) & 255u); y[TK][4 * q_ + 3] += (A) * (float)(w_ >> 24); } } while (0)
        for (int ch = 0; ch < 8; ++ch) {
            const unsigned ent = *(const LAS unsigned*)(wl + (ch * 64 + lane) * 4);
            const float areg = act[ch * 64 + lane];
            v4u vb[2][8]; int eb[2][8];
#pragma unroll
            for (int q = 0; q < 8; ++q) { eb[0][q] = __builtin_amdgcn_readlane((int)ent, q); vb[0][q] = *(const GAS v4u*)(VQ + (size_t)(eb[0][q] & (NEXP - 1)) * DM + lane * 16); }
#pragma unroll
            for (int jb = 0; jb < 8; ++jb) {
                if (jb + 1 < 8) {
#pragma unroll
                    for (int q = 0; q < 8; ++q) { eb[(jb + 1) & 1][q] = __builtin_amdgcn_readlane((int)ent, 8 * (jb + 1) + q); vb[(jb + 1) & 1][q] = *(const GAS v4u*)(VQ + (size_t)(eb[(jb + 1) & 1][q] & (NEXP - 1)) * DM + lane * 16); } }
                __builtin_amdgcn_sched_barrier(0);
#pragma unroll
                for (int q = 0; q < 8; ++q) { const int tk_ = (eb[jb & 1][q] >> 14) & 3; const v4u v_ = vb[jb & 1][q]; const float a_ = rdlane(areg, 8 * jb + q);
                    if (tk_ == 0) GA_AXPY(v_, a_, 0); else if (tk_ == 1) GA_AXPY(v_, a_, 1); else if (tk_ == 2) GA_AXPY(v_, a_, 2); else GA_AXPY(v_, a_, 3); }
                __builtin_amdgcn_sched_barrier(0);
            }
        }
#undef GA_AXPY
#pragma unroll
        for (int tk = 0; tk < 4; ++tk) {
            float* hrow = F.out + (size_t)(4 * tg + tk) * DM + lane * 16;
            float hv[16]; float ss = 0.f;
#pragma unroll
            for (int q = 0; q < 4; ++q) { const f32x4 h4 = *(const GAS f32x4*)(hrow + 4 * q);
#pragma unroll
                for (int i = 0; i < 4; ++i) { const float v = h4[i] + (y[tk][4 * q + i] - yo[tk]); hv[4 * q + i] = v; ss += v * v; } }
            const float rstd = frsq(wave_sum(ss) * (1.f / DM) + RMS_EPS);
#pragma unroll
            for (int q = 0; q < 4; ++q) { const f32x4 n4 = *(const GAS f32x4*)(nf + lane * 16 + 4 * q);
                *(GAS f32x4*)(outp + (size_t)(4 * tg + tk) * DM + lane * 16 + 4 * q) = (f32x4){hv[4 * q] * rstd * n4[0], hv[4 * q + 1] * rstd * n4[1], hv[4 * q + 2] * rstd * n4[2], hv[4 * q + 3] * rstd * n4[3]}; }
        }
    }
}

struct Args { const float* in[21]; float* out; unsigned char* ws; int ph_lo, ph_hi; };
static_assert(sizeof(Args) == 21 * 8 + 8 + 8 + 8, "Args has no padding");

__global__ void __launch_bounds__(NTHREADS, 2) fwd_kernel(Args args) {
    extern __shared__ __attribute__((aligned(16))) unsigned char lds[];
    Frame F;
    F.lds = (LAS unsigned char*)lds;
    F.MISC = (volatile LAS unsigned*)(F.lds + MISC_OFF);
    F.tid = threadIdx.x; F.lane = F.tid & 63; F.wave = __builtin_amdgcn_readfirstlane(F.tid >> 6);
    F.G = gridDim.x; F.wg = blockIdx.x;
#pragma unroll
    for (int i = 0; i < 21; ++i) F.in[i] = args.in[i];
    F.out = args.out; F.ws = args.ws;
    F.ctl = (gu32*)(args.ws + WS_CTL);
    for (int u = F.tid; u < (LDS_BYTES - LDSCTL_OFF) / 4; u += NTHREADS) ((LAS unsigned*)(F.lds + LDSCTL_OFF))[u] = 0u;
    __syncthreads();
    const int lo = args.ph_lo, hi = args.ph_hi;
    const bool fused = (hi - lo) > 1;
    XcdBarrier bar; bar.bar = (unsigned*)(F.ctl + CW_BAR); bar.x = 0; bar.st = nullptr;
    if (fused) bar = xcd_barrier_post((unsigned*)(F.ctl + CW_BAR), F.MISC + 8);
#define IN(k) (lo <= (k) && (k) < hi)
#define REPS(k) (((REP_MASK >> (k)) & 1) ? 2 : 1)
#define REPLOOP(k) for (int rep_ = 0; rep_ < REPS(k); ++rep_, (rep_ < REPS(k) ? xcd_barrier(bar) : (void)0))
#define SEAM(k) do { if (IN(k) && IN((k) + 1)) xcd_barrier(bar); } while (0)

    if (IN(0)) { REPLOOP(0) p0_prologue(F); SEAM(0); }
    if (IN(1)) { REPLOOP(1) {
        pg8::Gemm g{(const bf16*)(F.ws + WS_XN), (const bf16*)(F.ws + WS_WIN), T, IN_COLS, DM}; pg8::StaticOrder S; S.init(T, IN_COLS, F.G, F.wg);
        pg8::EpiBf16 E{(bf16*)(F.ws + WS_Z), IN_COLS};
        pg8::gemm_phase<pg8::EpiBf16, pg8::StaticOrder, true, true>(F.lds + RING_OFF, g, S, E); }
        SEAM(1);
    }
    if (IN(2)) { p2_rope(F); REPLOOP(2) { const int cnt = r13_count(F.wg, F.G); R1Pre P;
            if (cnt > 0) rwkv_r1_prefetch(F, r13_item(F.wg, F.G, 0), F.tid, P);
            for (int i = 0; i < cnt; ++i) rwkv_r1_item(F, r13_item(F.wg, F.G, i), i + 1 < cnt ? r13_item(F.wg, F.G, i + 1) : -1, P); }
        SEAM(2); }
    if (IN(3)) { REPLOOP(3) p3_mixers(F); SEAM(3); }
    if (IN(4)) { REPLOOP(4) for (int item = F.wg; item < NB * NHR * 128; item += F.G) rwkv_r3_item(F, item); SEAM(4); }
    if (IN(5)) { REPLOOP(5) {
        pg8::Gemm g{(const bf16*)(F.ws + WS_YMIX), (const bf16*)(F.ws + WS_WOUT), T, DM, DM}; pg8::StaticOrder S; S.init(T, DM, F.G, F.wg);
        pg8::EpiF32Res E{F.in[0], F.out, DM};
        pg8::gemm_phase<pg8::EpiF32Res, pg8::StaticOrder, true, true>(F.lds + RING_OFF, g, S, E); }
        SEAM(5);
    }
    if (IN(6)) { REPLOOP(6) p5_xn2(F); SEAM(6); }
    if (IN(7)) { REPLOOP(7) {
        pg8::Gemm g{(const bf16*)(F.ws + WS_XN), (const bf16*)(F.ws + WS_WQ), T, PQ, DM}; pg8::StaticOrder S; S.init(T, PQ, F.G, F.wg);
        pg8::EpiBf16 E{(bf16*)(F.ws + WS_QP), PQ};
        pg8::gemm_phase<pg8::EpiBf16, pg8::StaticOrder, true, true>(F.lds + RING_OFF, g, S, E); }
        SEAM(7);
    }
    if (IN(8)) { REPLOOP(8) p7_topk(F); SEAM(8); }
    if (IN(9)) { if (REPS(9) > 1) { p8_gather(F, (float*)(F.ws + WS_Z)); xcd_barrier(bar); } p8_gather(F, F.out); }
#undef IN
#undef SEAM
}

extern "C" void kernel_launch(void* const* d_in, const int* in_sizes, int n_in, void* d_out, int out_size, void* d_ws, size_t ws_size, hipStream_t stream) {
    static int grid = 0;
    if (grid == 0) {
        if (n_in != 21 || in_sizes[0] != T * DM || out_size != T * DM || ws_size < WS_END) {
            fprintf(stderr, "kernel_launch: unexpected shapes: n_in %d in0 %d out %d ws %zu (need %zu); nothing launched\n", n_in, n_in > 0 ? in_sizes[0] : -1, out_size, ws_size, (size_t)WS_END); grid = -1; return; }
        int dev = 0, cus = 0, per_cu = 0;
        if (hipGetDevice(&dev) != hipSuccess || hipDeviceGetAttribute(&cus, hipDeviceAttributeMultiprocessorCount, dev) != hipSuccess) { grid = -1; return; }
        if (hipFuncSetAttribute((const void*)fwd_kernel, hipFuncAttributeMaxDynamicSharedMemorySize, LDS_BYTES) != hipSuccess) { fprintf(stderr, "kernel_launch: hipFuncSetAttribute failed\n"); grid = -1; return; }
        if (hipOccupancyMaxActiveBlocksPerMultiprocessor(&per_cu, (const void*)fwd_kernel, NTHREADS, LDS_BYTES) != hipSuccess || per_cu < 1) { fprintf(stderr, "kernel_launch: occupancy query says %d\n", per_cu); per_cu = 1; }
        (void)hipGetLastError();
        grid = cus;
    }
    if (grid < 0) return;
    (void)hipMemsetAsync((char*)d_ws + WS_CTL, 0, CTL_ZERO_BYTES, stream);
    Args a{};
    for (int i = 0; i < 21; ++i) a.in[i] = (const float*)d_in[i];
    a.out = (float*)d_out; a.ws = (unsigned char*)d_ws;
    if (MK_N_LAUNCHES == 1) {
        a.ph_lo = 0; a.ph_hi = NPHASE;
        void* kargs[] = {&a};
        hipError_t e = hipLaunchCooperativeKernel((const void*)fwd_kernel, dim3(grid), dim3(NTHREADS), kargs, LDS_BYTES, stream);
        if (e != hipSuccess) fprintf(stderr, "kernel_launch: cooperative launch failed: %s (grid %d)\n", hipGetErrorString(e), grid);
    } else {
        for (int p = 0; p < NPHASE; ++p) { a.ph_lo = p; a.ph_hi = p + 1;
            hipLaunchKernelGGL(fwd_kernel, dim3(grid), dim3(NTHREADS), LDS_BYTES, stream, a); }
    }
}
```

```cpp
#include <hip/hip_runtime.h>
#include <cstdio>
#include <cstdint>

#ifndef MK_N_LAUNCHES
#define MK_N_LAUNCHES 1
#endif

#ifndef REP_MASK
#define REP_MASK 0
#endif
#define GAS __attribute__((address_space(1)))
#define LAS __attribute__((address_space(3)))
typedef unsigned short bf16;
typedef unsigned v4u __attribute__((ext_vector_type(4)));
typedef unsigned v2u __attribute__((ext_vector_type(2)));
typedef float f32x4 __attribute__((ext_vector_type(4)));
typedef float f32x2 __attribute__((ext_vector_type(2)));
typedef short bf16x8 __attribute__((ext_vector_type(8)));
typedef GAS unsigned gu32;
#define RLX_AGENT __ATOMIC_RELAXED, __HIP_MEMORY_SCOPE_AGENT
#define LDS_WAIT() asm volatile("s_waitcnt lgkmcnt(0)" ::: "memory")
#define VM_WAIT() asm volatile("s_waitcnt vmcnt(0)" ::: "memory")
#define LDS_BARRIER() do { asm volatile("s_waitcnt lgkmcnt(0)" ::: "memory"); __builtin_amdgcn_s_barrier(); asm volatile("" ::: "memory"); } while (0)

constexpr int DM = 1024, NB = 4, SEQ = 8192, T = NB * SEQ;
constexpr int HD = 64, RWW = 512, NHR = 8, NHA = 8;
constexpr int IN_COLS = 3328;
constexpr int C_R = 0, C_K = 512, C_V = 1024, C_WD = 1536, C_AD = 1600, C_GD = 1664, C_AQ = 1792, C_AK = 2304, C_AV = 2816;
constexpr int PHEADS = 8, NKEYS = 128, PQ = 2048, TOPK = 16, NEXP = 16384;
constexpr float RMS_EPS = 1e-6f, GN_EPS = 64e-5f;
constexpr int NWAVES = 8, NTHREADS = 512;
constexpr int NPHASE = 10;

constexpr size_t MiB = 1u << 20;
constexpr size_t WS_CTL = 0, CTL_ZERO_BYTES = 1 * MiB;
constexpr size_t WS_WIN = 2 * MiB;
constexpr size_t WS_WOUT = 10 * MiB;
constexpr size_t WS_WQ = 12 * MiB;
constexpr size_t WS_XN = 16 * MiB;
constexpr size_t WS_Z = 80 * MiB;
constexpr size_t WS_QP = 80 * MiB;
constexpr size_t WS_G = 288 * MiB;
constexpr size_t WS_YMIX = 352 * MiB;
constexpr size_t WS_UQ = 416 * MiB;
constexpr size_t WS_VQ = 432 * MiB;
constexpr size_t WS_SU = 448 * MiB;
constexpr size_t WS_SV = 449 * MiB;
constexpr size_t WS_EID = 480 * MiB;
constexpr size_t WS_GATE = 496 * MiB;
constexpr size_t WS_END = 512 * MiB;
constexpr size_t WS_WUPT = 1 * MiB, WS_AUPT = WS_WUPT + 65536, WS_GUPT = WS_AUPT + 65536;
constexpr size_t WS_BONUS = 9 * MiB;
constexpr size_t WS_RWY0 = WS_XN;
constexpr size_t WS_RWSS = WS_G;
constexpr size_t WS_RWRH = WS_EID;

constexpr int CW_BAR = 4096;

typedef __bf16 hbf16x2_t __attribute__((ext_vector_type(2)));
__device__ __forceinline__ unsigned pk2(float lo, float hi) { const f32x2 v = {lo, hi}; const hbf16x2_t b = __builtin_convertvector(v, hbf16x2_t); return __builtin_bit_cast(unsigned, b); }
__device__ __forceinline__ unsigned f2bf(float f) { return pk2(f, 0.f) & 0xffffu; }
__device__ __forceinline__ float frcp(float x) { return __builtin_amdgcn_rcpf(x); }
__device__ __forceinline__ float frsq(float x) { return __builtin_amdgcn_rsqf(x); }
__device__ __forceinline__ float bflo(unsigned u) { return __builtin_bit_cast(float, u << 16); }
__device__ __forceinline__ float bfhi(unsigned u) { return __builtin_bit_cast(float, u & 0xffff0000u); }
__device__ __forceinline__ float bf2f(bf16 h) { return __builtin_bit_cast(float, (unsigned)h << 16); }

template <int CTRL> __device__ __forceinline__ float dppf(float x) { return __builtin_bit_cast(float, __builtin_amdgcn_update_dpp(0, __builtin_bit_cast(int, x), CTRL, 0xF, 0xF, true)); }
template <int CTRL> __device__ __forceinline__ int dppi(int x) { return __builtin_amdgcn_update_dpp(0, x, CTRL, 0xF, 0xF, true); }
__device__ __forceinline__ float rdlane(float v, int l) { return __builtin_bit_cast(float, __builtin_amdgcn_readlane(__builtin_bit_cast(int, v), l)); }
__device__ __forceinline__ float sum8(float v) { v += dppf<0xB1>(v); v += dppf<0x4E>(v); v += dppf<0x141>(v); return v; }
__device__ __forceinline__ float sum16(float v) { v = sum8(v); v += dppf<0x140>(v); return v; }
__device__ __forceinline__ float wave_sum(float v) { v = sum16(v);
    v += __builtin_bit_cast(float, __builtin_amdgcn_update_dpp(0, __builtin_bit_cast(int, v), 0x142, 0xA, 0xF, false));
    v += __builtin_bit_cast(float, __builtin_amdgcn_update_dpp(0, __builtin_bit_cast(int, v), 0x143, 0xC, 0xF, false));
    return rdlane(v, 63); }
__device__ __forceinline__ float wave_max(float v) {
    v = fmaxf(v, dppf<0xB1>(v)); v = fmaxf(v, dppf<0x4E>(v)); v = fmaxf(v, dppf<0x141>(v)); v = fmaxf(v, dppf<0x140>(v));
    return fmaxf(fmaxf(rdlane(v, 0), rdlane(v, 16)), fmaxf(rdlane(v, 32), rdlane(v, 48)));
}
__device__ __forceinline__ int wave_min_i(int v) {
    v = min(v, dppi<0xB1>(v)); v = min(v, dppi<0x4E>(v)); v = min(v, dppi<0x141>(v)); v = min(v, dppi<0x140>(v));
    return min(min(__builtin_amdgcn_readlane(v, 0), __builtin_amdgcn_readlane(v, 16)), min(__builtin_amdgcn_readlane(v, 32), __builtin_amdgcn_readlane(v, 48)));
}

namespace pg8 {
#define PG8_LAS __attribute__((address_space(3)))
typedef unsigned short bf16_t;
typedef unsigned u32x4 __attribute__((ext_vector_type(4)));
constexpr int BM = 256, BK = 64, HALF = 128, HTB = HALF * BK * 2, STAGE_BYTES = 8 * HTB, NXCD = 8, WGM = 8;
__host__ __device__ __forceinline__ int lds_byte(int r, int c) { const int st = (r >> 4) * 2 + (c >> 5), rr = r & 15, cc = c & 31, ob = rr * 64 + cc * 2; return st * 1024 + (ob ^ (((ob >> 9) & 1) << 5)); }
__host__ __device__ __forceinline__ void stage_rc(int b, int& R, int& C) { const int st = b / 1024, sb = b % 1024, swz = sb ^ (((sb >> 9) & 1) << 5); R = (st >> 1) * 16 + swz / 64; C = (st & 1) * 32 + (swz % 64) / 2; }
__host__ __device__ __forceinline__ int perm32(int rho) { const int n = rho >> 4, i = rho & 15; return 8 * (i >> 2) + 4 * n + (i & 3); }
struct Unit { int pm, pn; };
struct Gemm { const bf16_t* A; const bf16_t* Bt; int M, N, K; };
struct StaticOrder {
    int nM, nN, nwg, G, c;
    __host__ __device__ void init(int M, int N, int G_, int c_) { nM = M / BM; nN = N / BM; nwg = nM * nN; G = G_; c = c_; }
    __host__ __device__ bool next(int i, Unit& u) const {
        const long L = (long)i * G + c; if (L >= nwg) return false;
        int wgid = (int)L; { const int q = nwg / NXCD, r = nwg % NXCD, xcd = wgid % NXCD, off = wgid / NXCD; wgid = (xcd < r ? xcd * (q + 1) : r * (q + 1) + (xcd - r) * q) + off; }
        const int nig = WGM * nN, gid = wgid / nig, fm = gid * WGM, gsz = (nM - fm) < WGM ? (nM - fm) : WGM;
        u.pm = fm + ((wgid % nig) % gsz); u.pn = (wgid % nig) / gsz; return true;
    }
    __device__ __forceinline__ void a_ready(const Unit&) const {}
    __device__ __forceinline__ void done(const Unit&) const {}
};
__device__ __forceinline__ unsigned cvt_pk_bf16(float lo, float hi) { unsigned r; asm volatile("v_cvt_pk_bf16_f32 %0, %1, %2" : "=v"(r) : "v"(lo), "v"(hi)); return r; }
struct EpiBf16 {
    static constexpr bool PERM = true, AFTER_DRAIN = false;
    bf16_t* O; int ldc;
    __device__ __forceinline__ void operator()(const f32x4 (&acc)[2][2][4][2], const Unit& u, int wr, int wc, int fr, int fq) const {
        const int row0 = u.pm * BM + wr * 64 + fr; const int col0 = u.pn * BM + wc * 32 + 8 * fq;
#pragma unroll
        for (int ai = 0; ai < 2; ++ai)
#pragma unroll
            for (int m = 0; m < 4; ++m) { bf16_t* rowp = O + (size_t)(row0 + ai * HALF + m * 16) * ldc + col0;
#pragma unroll
                for (int bj = 0; bj < 2; ++bj) { const f32x4 v0 = acc[ai][bj][m][0], v1 = acc[ai][bj][m][1];
                    u32x4 w; w.x = cvt_pk_bf16(v0[0], v0[1]); w.y = cvt_pk_bf16(v0[2], v0[3]); w.z = cvt_pk_bf16(v1[0], v1[1]); w.w = cvt_pk_bf16(v1[2], v1[3]);
                    *(u32x4*)(rowp + bj * HALF) = w; } }
    }
};
struct EpiF32Res {
    static constexpr bool PERM = true, AFTER_DRAIN = false;
    const float* res; float* O; int ldc;
    __device__ __forceinline__ void operator()(const f32x4 (&acc)[2][2][4][2], const Unit& u, int wr, int wc, int fr, int fq) const {
        const int row0 = u.pm * BM + wr * 64 + fr; const int col0 = u.pn * BM + wc * 32 + 8 * fq;
#pragma unroll
        for (int ai = 0; ai < 2; ++ai)
#pragma unroll
            for (int m = 0; m < 4; ++m) { const size_t off = (size_t)(row0 + ai * HALF + m * 16) * ldc + col0;
#pragma unroll
                for (int bj = 0; bj < 2; ++bj) { const f32x4 r0 = *(const f32x4*)(res + off + bj * HALF), r1 = *(const f32x4*)(res + off + bj * HALF + 4);
                    *(f32x4*)(O + off + bj * HALF) = acc[ai][bj][m][0] + r0; *(f32x4*)(O + off + bj * HALF + 4) = acc[ai][bj][m][1] + r1; } }
    }
};

template <class Epi, class Sched, bool ALIGN_EPI = false, bool SP2 = false>
__device__ __forceinline__ void gemm_phase(PG8_LAS unsigned char* lds, const Gemm g, const Sched& S, const Epi& E) {
    const int tid = threadIdx.x, wid = __builtin_amdgcn_readfirstlane(tid >> 6), lane = tid & 63, wr = wid >> 2, wc = wid & 3, fr = lane & 15, fq = lane >> 4;
    const int K = g.K, nt = K / BK;
    unsigned voffA[2], voffB[2];
#pragma unroll
    for (int i = 0; i < 2; ++i) { int R, C; stage_rc(tid * 16 + i * 8192, R, C); const int Rb = Epi::PERM ? ((R & ~31) + perm32(R & 31)) : R;
        voffA[i] = (unsigned)(R * K + C) * 2u; voffB[i] = (unsigned)(Rb * K + C) * 2u; }
    const size_t kstep = (size_t)(BK * 2);
    const size_t hstep = (size_t)HALF * K * 2;
    const size_t tstep = 2 * hstep;
    const unsigned ldsw = (unsigned)wid * 1024u;
    const int aoff = lds_byte(wr * 64 + fr, fq * 8), boff = lds_byte(wc * 32 + fr, fq * 8);
#define PG8_SA(b, h) (((b) * 2 + (h)) * HTB)
#define PG8_SB(b, h) ((4 + (b) * 2 + (h)) * HTB)
#define PG8_STAGE(bufoff, gbase, voff) do { _Pragma("unroll") for (int _i = 0; _i < 2; ++_i) \
        __builtin_amdgcn_global_load_lds((const unsigned*)((const char*)(gbase) + (voff)[_i]), (PG8_LAS unsigned*)(lds + (bufoff) + ldsw + _i * 8192), 16, 0, 0); } while (0)
#define PG8_LDA(dst, b, h) do { _Pragma("unroll") for (int m = 0; m < 4; ++m) _Pragma("unroll") for (int k = 0; k < 2; ++k) dst[m][k] = *(const PG8_LAS bf16x8*)(lds + PG8_SA(b, h) + aoff + m * 2048 + k * 1024); } while (0)
#define PG8_LDB(dst, b, h) do { _Pragma("unroll") for (int n = 0; n < 2; ++n) _Pragma("unroll") for (int k = 0; k < 2; ++k) dst[n][k] = *(const PG8_LAS bf16x8*)(lds + PG8_SB(b, h) + boff + n * 2048 + k * 1024); } while (0)
#define PG8_MMA(ai, bj, At, Bt) do { __builtin_amdgcn_s_setprio(1); _Pragma("unroll") for (int m = 0; m < 4; ++m) _Pragma("unroll") for (int n = 0; n < 2; ++n) _Pragma("unroll") for (int k = 0; k < 2; ++k) \
        acc[ai][bj][m][n] = __builtin_amdgcn_mfma_f32_16x16x32_bf16(Bt[n][k], At[m][k], acc[ai][bj][m][n], 0, 0, 0); __builtin_amdgcn_s_setprio(0); } while (0)
#define PG8_WAIT_V(n) asm volatile("s_waitcnt vmcnt(" #n ")" ::: "memory")
#define PG8_WAIT_L(n) asm volatile("s_waitcnt lgkmcnt(" #n ")" ::: "memory")
#define PG8_BAR __builtin_amdgcn_s_barrier()
#define PG8_SCHED __builtin_amdgcn_sched_barrier(0)
    Unit cur, nxt; int ui = 0;
    if (!S.next(0, cur)) return;
    f32x4 acc[2][2][4][2];
#pragma unroll
    for (int a = 0; a < 2; ++a)
#pragma unroll
        for (int b = 0; b < 2; ++b)
#pragma unroll
            for (int m = 0; m < 4; ++m)
#pragma unroll
                for (int n = 0; n < 2; ++n) acc[a][b][m][n] = (f32x4){0.f, 0.f, 0.f, 0.f};
    bf16x8 At[4][2], B0[2][2], B1[2][2];
    const char* cA = (const char*)g.A + (size_t)cur.pm * tstep; const char* cB = (const char*)g.Bt + (size_t)cur.pn * tstep;
    S.a_ready(cur);
    if constexpr (SP2) {
        PG8_STAGE(PG8_SB(0, 0), cB, voffB); PG8_STAGE(PG8_SB(0, 1), cB + hstep, voffB); PG8_STAGE(PG8_SA(0, 0), cA, voffA); PG8_STAGE(PG8_SA(0, 1), cA + hstep, voffA);
        if (wr == 1) PG8_BAR;
        PG8_WAIT_V(2); PG8_BAR;
        PG8_STAGE(PG8_SB(1, 0), cB + kstep, voffB); PG8_STAGE(PG8_SA(1, 0), cA + kstep, voffA); PG8_STAGE(PG8_SB(1, 1), cB + hstep + kstep, voffB);
        PG8_WAIT_V(6); PG8_BAR;
    } else {
        PG8_STAGE(PG8_SB(0, 0), cB, voffB); PG8_STAGE(PG8_SA(0, 0), cA, voffA); PG8_STAGE(PG8_SB(0, 1), cB + hstep, voffB); PG8_STAGE(PG8_SA(0, 1), cA + hstep, voffA);
        if (wr == 1) PG8_BAR;
        PG8_WAIT_V(4); PG8_BAR;
        PG8_STAGE(PG8_SB(1, 0), cB + kstep, voffB); PG8_STAGE(PG8_SA(1, 0), cA + kstep, voffA); PG8_STAGE(PG8_SB(1, 1), cB + hstep + kstep, voffB);
        PG8_WAIT_V(6); PG8_BAR;
    }
    for (;;) {
        const bool has_next = S.next(ui + 1, nxt);
        const char* nA = has_next ? (const char*)g.A + (size_t)nxt.pm * tstep : cA; const char* nB = has_next ? (const char*)g.Bt + (size_t)nxt.pn * tstep : cB;
        for (int t = 0; t < nt; t += 2) {
            const bool last = (t == nt - 2);
            const char* a1 = cA + (size_t)(t + 1) * kstep;
            const char* a2 = last ? nA : cA + (size_t)(t + 2) * kstep; const char* b2 = last ? nB : cB + (size_t)(t + 2) * kstep;
            const char* a3 = a2 + kstep; const char* b3 = b2 + kstep;
            if (last && has_next) S.a_ready(nxt);
            if constexpr (SP2) {
            PG8_LDB(B0, 0, 0); PG8_LDB(B1, 0, 1); PG8_SCHED; PG8_LDA(At, 0, 0); PG8_STAGE(PG8_SA(1, 1), a1 + hstep, voffA);
            PG8_WAIT_V(8); PG8_WAIT_L(0); PG8_BAR; PG8_MMA(0, 0, At, B0); PG8_MMA(0, 1, At, B1); PG8_BAR; PG8_SCHED;
            PG8_LDA(At, 0, 1); PG8_STAGE(PG8_SB(0, 0), b2, voffB); PG8_STAGE(PG8_SB(0, 1), b2 + hstep, voffB); PG8_STAGE(PG8_SA(0, 0), a2, voffA);
            PG8_WAIT_V(8); PG8_WAIT_L(0); PG8_BAR; PG8_MMA(1, 0, At, B0); PG8_MMA(1, 1, At, B1); PG8_BAR; PG8_SCHED;
            PG8_LDB(B0, 1, 0); PG8_LDB(B1, 1, 1); PG8_SCHED; PG8_LDA(At, 1, 0); PG8_STAGE(PG8_SA(0, 1), a2 + hstep, voffA);
            PG8_WAIT_V(8); PG8_WAIT_L(0); PG8_BAR; PG8_MMA(0, 0, At, B0); PG8_MMA(0, 1, At, B1); PG8_BAR; PG8_SCHED;
            PG8_LDA(At, 1, 1); PG8_STAGE(PG8_SB(1, 0), b3, voffB); PG8_STAGE(PG8_SB(1, 1), b3 + hstep, voffB); PG8_STAGE(PG8_SA(1, 0), a3, voffA);
            PG8_WAIT_V(8); PG8_WAIT_L(0); PG8_BAR; PG8_MMA(1, 0, At, B0); PG8_MMA(1, 1, At, B1); PG8_BAR; PG8_SCHED;
            } else {
            PG8_LDB(B0, 0, 0); PG8_SCHED; PG8_LDA(At, 0, 0); PG8_STAGE(PG8_SA(1, 1), a1 + hstep, voffA);
            PG8_WAIT_L(8); PG8_BAR; PG8_WAIT_L(0); PG8_MMA(0, 0, At, B0); PG8_BAR; PG8_SCHED;
            PG8_LDB(B1, 0, 1); PG8_STAGE(PG8_SB(0, 0), b2, voffB);
            PG8_BAR; PG8_WAIT_L(0); PG8_MMA(0, 1, At, B1); PG8_BAR;
            PG8_LDA(At, 0, 1); PG8_STAGE(PG8_SA(0, 0), a2, voffA);
            PG8_BAR; PG8_WAIT_L(0); PG8_MMA(1, 0, At, B0); PG8_BAR; PG8_SCHED;
            PG8_STAGE(PG8_SB(0, 1), b2 + hstep, voffB);
            PG8_WAIT_V(6); PG8_BAR; PG8_MMA(1, 1, At, B1); PG8_BAR;
            PG8_LDB(B0, 1, 0); PG8_SCHED; PG8_LDA(At, 1, 0); PG8_STAGE(PG8_SA(0, 1), a2 + hstep, voffA);
            PG8_WAIT_L(8); PG8_BAR; PG8_WAIT_L(0); PG8_MMA(0, 0, At, B0); PG8_BAR; PG8_SCHED;
            PG8_LDB(B1, 1, 1); PG8_STAGE(PG8_SB(1, 0), b3, voffB);
            PG8_BAR; PG8_WAIT_L(0); PG8_MMA(0, 1, At, B1); PG8_BAR;
            PG8_LDA(At, 1, 1); PG8_STAGE(PG8_SA(1, 0), a3, voffA);
            PG8_BAR; PG8_WAIT_L(0); PG8_MMA(1, 0, At, B0); PG8_BAR; PG8_SCHED;
            PG8_STAGE(PG8_SB(1, 1), b3 + hstep, voffB);
            PG8_WAIT_V(6); PG8_BAR; PG8_MMA(1, 1, At, B1); PG8_BAR;
            }
        }
        if constexpr (ALIGN_EPI) { if (wr == 0) PG8_BAR; }
        if constexpr (!Epi::AFTER_DRAIN) { E(acc, cur, wr, wc, fr, fq); S.done(cur); }
        if (!has_next) break;
#pragma unroll
        for (int a = 0; a < 2; ++a)
#pragma unroll
            for (int b = 0; b < 2; ++b)
#pragma unroll
                for (int m = 0; m < 4; ++m)
#pragma unroll
                    for (int n = 0; n < 2; ++n) acc[a][b][m][n] = (f32x4){0.f, 0.f, 0.f, 0.f};
        cur = nxt; cA = nA; cB = nB; ++ui;
        if constexpr (ALIGN_EPI) { if (wr == 1) PG8_BAR; }
    }
    PG8_WAIT_V(0);
    if constexpr (!ALIGN_EPI) { if (wr == 0) PG8_BAR; }
    PG8_BAR;
#undef PG8_SA
#undef PG8_SB
#undef PG8_STAGE
#undef PG8_LDA
#undef PG8_LDB
#undef PG8_MMA
#undef PG8_WAIT_V
#undef PG8_WAIT_L
#undef PG8_BAR
#undef PG8_SCHED
}
}

#define XB_TMO      128
#define XB_XCNT(j)  (256  + 64 * (j))
#define XB_XSUB(j)  (1280 + 64 * (j))
#define XB_XGEN(j)  (2304 + 64 * (j))
#define XB_TOP      3328
#define XB_TOPGEN   3392
#define XCD_BAR_WORDS 3456
#define XB_SPIN_CAP (1u << 22)
__device__ __forceinline__ unsigned xb_ld(unsigned* p)              { return __hip_atomic_load(p, __ATOMIC_RELAXED, __HIP_MEMORY_SCOPE_AGENT); }
__device__ __forceinline__ unsigned xb_add(unsigned* p, unsigned v) { return __hip_atomic_fetch_add(p, v, __ATOMIC_RELAXED, __HIP_MEMORY_SCOPE_AGENT); }
__device__ __forceinline__ unsigned xb_xcc_id() { return (unsigned)__builtin_amdgcn_s_getreg((3 << 11) | 20) & 0xFu; }
#define XB_SPIN(cond, bar) do { unsigned _sp = 0; while (cond) { __builtin_amdgcn_s_sleep(1); \
    if ((++_sp & 255u) == 0u) { if (xb_ld(&(bar)[XB_TMO])) break; if (_sp > XB_SPIN_CAP) { atomicAdd(&(bar)[XB_TMO], 1u); break; } } } } while (0)
struct XcdBarrier { unsigned* bar; unsigned x; volatile LAS unsigned* st; };
__device__ __forceinline__ XcdBarrier xcd_barrier_post(unsigned* bar, volatile LAS unsigned* st) {
    XcdBarrier b; b.bar = bar; b.x = xb_xcc_id(); b.st = st;
    if (threadIdx.x == 0) (void)xb_add(&bar[XB_XCNT(b.x)], 1u);
    return b;
}
__device__ __forceinline__ void xcd_barrier_complete(unsigned* bar, unsigned x, unsigned& nloc, unsigned& nx) {
    const unsigned G = gridDim.x * gridDim.y * gridDim.z;
    unsigned sum, cnt, mine, sp = 0u;
    for (;;) {
        sum = 0u; cnt = 0u; mine = 0u;
#pragma unroll
        for (unsigned j = 0; j < 16; ++j) { const unsigned c = xb_ld(&bar[XB_XCNT(j)]); sum += c; cnt += (c > 0u) ? 1u : 0u; mine = (j == x) ? c : mine; }
        if (sum == G) break;
        __builtin_amdgcn_s_sleep(1);
        if ((++sp & 255u) == 0u) { if (xb_ld(&bar[XB_TMO])) break; if (sp > XB_SPIN_CAP) { atomicAdd(&bar[XB_TMO], 1u); break; } }
    }
    nloc = mine > 0u ? mine : 1u; nx = cnt > 0u ? cnt : 1u;
}
__device__ __forceinline__ void xcd_barrier(const XcdBarrier& b) {
    asm volatile("s_waitcnt vmcnt(0)" ::: "memory");
    __syncthreads();
    if (threadIdx.x == 0) {
        unsigned* bar = b.bar;
        __builtin_amdgcn_s_waitcnt(0);
        unsigned nloc = b.st[0], nx = b.st[1];
        if (nloc == 0u) { xcd_barrier_complete(bar, b.x, nloc, nx); b.st[0] = nloc; b.st[1] = nx; }
        const unsigned old = xb_add(&bar[XB_XSUB(b.x)], 1u);
        const unsigned gen = old / nloc;
        if (old + 1u == (gen + 1u) * nloc) {
            __builtin_amdgcn_fence(__ATOMIC_RELEASE, "agent");
            asm volatile("s_waitcnt vmcnt(0)" ::: "memory");
            const unsigned og = xb_add(&bar[XB_TOP], 1u);
            const unsigned tg = og / nx;
            if (og + 1u == (tg + 1u) * nx) xb_add(&bar[XB_TOPGEN], 1u);
            else XB_SPIN(xb_ld(&bar[XB_TOPGEN]) == tg, bar);
            __builtin_amdgcn_fence(__ATOMIC_ACQUIRE, "agent");
            xb_add(&bar[XB_XGEN(b.x)], 1u);
            asm volatile("s_waitcnt vmcnt(0)" ::: "memory");
        } else {
            XB_SPIN(xb_ld(&bar[XB_XGEN(b.x)]) == gen, bar);
            __builtin_amdgcn_fence(__ATOMIC_ACQUIRE, "agent");
            asm volatile("s_waitcnt vmcnt(0)" ::: "memory");
        }
    }
    __syncthreads();
}

constexpr int RING_OFF = 0, RING_BYTES = 131072;
constexpr int LDSCTL_OFF = 162816, MISC_OFF = LDSCTL_OFF + 320;
constexpr int LDS_BYTES = 163840;

struct Frame {
    LAS unsigned char* lds;
    volatile LAS unsigned* MISC;
    gu32* ctl;
    int tid, lane, wave, G, wg;
    const float* in[21];
    float* out;
    unsigned char* ws;
};

__device__ __forceinline__ void p0_transpose_item(const float* W, int K, int N, bf16* WT, LAS float* scr, int item, int lane) {
    const int nblk = N / 32, kb = item / nblk, nb = item % nblk, k0 = 64 * kb, n0 = 32 * nb;
#pragma unroll 8
    for (int i = 0; i < 32; ++i) { const int kk = 2 * i + (lane >> 5); scr[kk * 33 + (lane & 31)] = W[(size_t)(k0 + kk) * N + n0 + (lane & 31)]; }
    LDS_WAIT(); asm volatile("" ::: "memory");
    const int c = lane & 7;
#pragma unroll
    for (int j = 0; j < 4; ++j) { const int n = (lane >> 3) + 8 * j; const LAS float* s = scr + (8 * c) * 33 + n;
        v4u o; o.x = pk2(s[0 * 33], s[1 * 33]); o.y = pk2(s[2 * 33], s[3 * 33]); o.z = pk2(s[4 * 33], s[5 * 33]); o.w = pk2(s[6 * 33], s[7 * 33]);
        *(GAS v4u*)(WT + (size_t)(n0 + n) * K + k0 + 8 * c) = o; }
    LDS_WAIT(); asm volatile("" ::: "memory");
}
__device__ __forceinline__ void rms_row_to_bf16(int lane, const float* xrow, const float* gain, bf16* orow) {
    const GAS f32x4* xr = (const GAS f32x4*)xrow + lane;
    const GAS f32x4* gr = (const GAS f32x4*)gain + lane;
    f32x4 v[4]; float s = 0.f;
#pragma unroll
    for (int j = 0; j < 4; ++j) { v[j] = xr[64 * j]; s += (v[j].x * v[j].x + v[j].y * v[j].y) + (v[j].z * v[j].z + v[j].w * v[j].w); }
    const float rstd = frsq(wave_sum(s) * (1.f / DM) + RMS_EPS);
    GAS unsigned long long* o8 = (GAS unsigned long long*)orow + lane;
#pragma unroll
    for (int j = 0; j < 4; ++j) { const f32x4 gg = gr[64 * j];
        o8[64 * j] = (unsigned long long)pk2(v[j].x * rstd * gg.x, v[j].y * rstd * gg.y) | ((unsigned long long)pk2(v[j].z * rstd * gg.z, v[j].w * rstd * gg.w) << 32); }
}
__device__ __forceinline__ void cvt_row_to_bf16(int lane, const float* xrow, bf16* orow) {
    const GAS f32x4* xr = (const GAS f32x4*)xrow + lane;
    GAS unsigned long long* o8 = (GAS unsigned long long*)orow + lane;
#pragma unroll
    for (int j = 0; j < 4; ++j) { const f32x4 v = xr[64 * j]; o8[64 * j] = (unsigned long long)pk2(v.x, v.y) | ((unsigned long long)pk2(v.z, v.w) << 32); }
}
__device__ __forceinline__ void p0_prologue(Frame& F) {
    LAS float* scr = (LAS float*)(F.lds + RING_OFF + F.wave * 16384);
    const int gw = F.wg * NWAVES + F.wave, NGW = F.G * NWAVES;
    constexpr int I_IN = (DM / 64) * (IN_COLS / 32), I_OUT = (DM / 64) * (DM / 32), I_Q = (DM / 64) * (PQ / 32);
    constexpr int NITEMS = I_IN + I_OUT + I_Q;
    bf16* win_t = (bf16*)(F.ws + WS_WIN); bf16* wout_t = (bf16*)(F.ws + WS_WOUT); bf16* wq_t = (bf16*)(F.ws + WS_WQ);
    for (int it = gw; it < NITEMS; it += NGW) {
        int r = it;
        if (r < I_IN) { p0_transpose_item(F.in[2], DM, IN_COLS, win_t, scr, r, F.lane); continue; } r -= I_IN;
        if (r < I_OUT) { p0_transpose_item(F.in[14], DM, DM, wout_t, scr, r, F.lane); continue; } r -= I_OUT;
        p0_transpose_item(F.in[16], DM, PQ, wq_t, scr, r, F.lane);
    }
    {
        constexpr int I_W = (64 / 64) * (RWW / 32), I_G = (128 / 64) * (RWW / 32);
        for (int it = gw; it < 2 * I_W + I_G; it += NGW) {
            int r = it;
            if (r < I_W) { p0_transpose_item(F.in[5], 64, RWW, (bf16*)(F.ws + WS_WUPT), scr, r, F.lane); continue; } r -= I_W;
            if (r < I_W) { p0_transpose_item(F.in[7], 64, RWW, (bf16*)(F.ws + WS_AUPT), scr, r, F.lane); continue; } r -= I_W;
            p0_transpose_item(F.in[8], 128, RWW, (bf16*)(F.ws + WS_GUPT), scr, r, F.lane);
        }
    }
    bf16* XN = (bf16*)(F.ws + WS_XN);
    for (int m = gw; m < T; m += NGW) rms_row_to_bf16(F.lane, F.in[0] + (size_t)m * DM, F.in[1], XN + (size_t)m * DM);
    for (int m = gw; m < 2 * NEXP; m += NGW) {
        const int tab = m >= NEXP, row = tab ? m - NEXP : m;
        const GAS f32x4* xr = (const GAS f32x4*)(F.in[18 + tab] + (size_t)row * DM) + F.lane * 4;
        f32x4 v[4]; float am = 0.f;
#pragma unroll
        for (int j = 0; j < 4; ++j) { v[j] = xr[j]; am = fmaxf(am, fmaxf(fmaxf(fabsf(v[j].x), fabsf(v[j].y)), fmaxf(fabsf(v[j].z), fabsf(v[j].w)))); }
        am = wave_max(am);
        const float sc = am > 0.f ? am * (1.f / 127.f) : 1.f, inv = am > 0.f ? 127.f / am : 0.f;
        v4u o;
#pragma unroll
        for (int j = 0; j < 4; ++j) {
            const int bias = tab ? 128 : 0;
            const unsigned b0 = (unsigned)((int)rintf(v[j].x * inv) + bias) & 255u, b1 = (unsigned)((int)rintf(v[j].y * inv) + bias) & 255u,
                           b2 = (unsigned)((int)rintf(v[j].z * inv) + bias) & 255u, b3 = (unsigned)((int)rintf(v[j].w * inv) + bias) & 255u;
            o[j] = b0 | (b1 << 8) | (b2 << 16) | (b3 << 24); }
        *(GAS v4u*)(F.ws + (tab ? WS_VQ : WS_UQ) + (size_t)row * DM + F.lane * 16) = o;
        if (F.lane == 0) ((float*)(F.ws + (tab ? WS_SV : WS_SU)))[row] = sc;
    }
}

constexpr size_t WS_ROPE = WS_G;
__device__ __forceinline__ void p0_rope_table(Frame& F) {
    f32x2* tab = (f32x2*)(F.ws + WS_ROPE);
    for (int e = F.wg * NTHREADS + F.tid; e < SEQ * 32; e += F.G * NTHREADS) {
        const int sp = e >> 5, i = e & 31;
        const float inv_freq = powf(10000.0f, -(float)(2 * i) / 64.0f);
        const float ang = (float)sp * inv_freq;
        const double r = (double)ang - rint((double)ang * 0.15915494309189535) * 6.283185307179586;
        const float rf = (float)r;
        tab[e] = (f32x2){cosf(rf), sinf(rf)};
    }
}
__device__ __forceinline__ void p2_rope(Frame& F) {
    bf16* Z = (bf16*)(F.ws + WS_Z);
    const f32x2* tab = (const f32x2*)(F.ws + WS_ROPE);
    const int tid = F.tid, tk = tid >> 6, grp = (tid >> 2) & 15, i0 = (tid & 3) * 8;
    for (int blk = F.wg; blk < T / 8; blk += F.G) {
        const int g = blk * 8 + tk, sp = g & (SEQ - 1);
        bf16* p = Z + (size_t)g * IN_COLS + C_AQ + grp * 64 + i0;
        const v4u a = *(const GAS v4u*)p, b = *(const GAS v4u*)(p + 32);
        const GAS f32x4* tp = (const GAS f32x4*)(tab + sp * 32 + i0);
        float x1[8], x2[8];
        x1[0] = bflo(a.x); x1[1] = bfhi(a.x); x1[2] = bflo(a.y); x1[3] = bfhi(a.y); x1[4] = bflo(a.z); x1[5] = bfhi(a.z); x1[6] = bflo(a.w); x1[7] = bfhi(a.w);
        x2[0] = bflo(b.x); x2[1] = bfhi(b.x); x2[2] = bflo(b.y); x2[3] = bfhi(b.y); x2[4] = bflo(b.z); x2[5] = bfhi(b.z); x2[6] = bflo(b.w); x2[7] = bfhi(b.w);
        float o1[8], o2[8];
#pragma unroll
        for (int q = 0; q < 4; ++q) { const f32x4 cs = tp[q];
            o1[2 * q] = x1[2 * q] * cs[0] - x2[2 * q] * cs[1]; o2[2 * q] = x1[2 * q] * cs[1] + x2[2 * q] * cs[0];
            o1[2 * q + 1] = x1[2 * q + 1] * cs[2] - x2[2 * q + 1] * cs[3]; o2[2 * q + 1] = x1[2 * q + 1] * cs[3] + x2[2 * q + 1] * cs[2]; }
        v4u oa, ob; oa.x = pk2(o1[0], o1[1]); oa.y = pk2(o1[2], o1[3]); oa.z = pk2(o1[4], o1[5]); oa.w = pk2(o1[6], o1[7]);
        ob.x = pk2(o2[0], o2[1]); ob.y = pk2(o2[2], o2[3]); ob.z = pk2(o2[4], o2[5]); ob.w = pk2(o2[6], o2[7]);
        *(GAS v4u*)p = oa; *(GAS v4u*)(p + 32) = ob;
    }
}

typedef float f32x16 __attribute__((ext_vector_type(16)));
constexpr int SBS = 144;
constexpr int R1_EPRE = 0, R1_APRE = 16384, R1_AAB = 0, R1_X = 16384;
constexpr int R1_AT = 32768, R1_BT = 41984, R1_KT = 51200, R1_RT = 60416, R1_AHT = R1_BT, R1_U0T = R1_KT;
constexpr int R1_BBT = 69632, R1_KBT = 78848, R1_VT = 88064;
constexpr int R1_ACTW = 97280, R1_ACTA = 106496, R1_AAK = 97280, R1_ARB = 106496, R1_ARK = 115712;
constexpr int R1_BONUS = 124928, R1_WEND = 125184, R1_SEGS = 125440, R1_TII = 125440, R1_END = 129536;
static_assert(R1_END <= LDSCTL_OFF, "R1 LDS");
__device__ __forceinline__ int crow(int r, int hh) { return (r & 3) + 8 * (r >> 2) + 4 * hh; }
template <int KS> __device__ __forceinline__ f32x16 wtile(const LAS unsigned char* A, int sa, const LAS unsigned char* B, int sb, f32x16 acc, int lane) {
    const int row = lane & 31, hh = lane >> 5;
#pragma unroll
    for (int s = 0; s < KS; ++s) { const bf16x8 a = *(const LAS bf16x8*)(A + row * sa + 32 * s + 16 * hh); const bf16x8 b = *(const LAS bf16x8*)(B + row * sb + 32 * s + 16 * hh);
        acc = __builtin_amdgcn_mfma_f32_32x32x16_bf16(a, b, acc, 0, 0, 0); }
    return acc;
}
template <int KS> __device__ __forceinline__ f32x16 wtile_gb(const LAS unsigned char* A, int sa, const bf16* Bg, int ldb, f32x16 acc, int lane) {
    const int row = lane & 31, hh = lane >> 5;
#pragma unroll
    for (int s = 0; s < KS; ++s) { const bf16x8 a = *(const LAS bf16x8*)(A + row * sa + 32 * s + 16 * hh); const bf16x8 b = *(const GAS bf16x8*)(Bg + (size_t)row * ldb + 16 * s + 8 * hh);
        acc = __builtin_amdgcn_mfma_f32_32x32x16_bf16(a, b, acc, 0, 0, 0); }
    return acc;
}
__device__ __forceinline__ f32x16 zero16() { f32x16 z;
#pragma unroll
    for (int r = 0; r < 16; ++r) z[r] = 0.f;
    return z; }

struct R1Pre { v4u wd[2], ad[2], z[4]; };
__device__ __forceinline__ int r13_item(int wg, int G, int idx) { return G == 256 ? ((wg >> 3) * 128 + (wg & 7) + 8 * idx) : (wg + G * idx); }
__device__ __forceinline__ int r13_count(int wg, int G) { return G == 256 ? 16 : ((NB * NHR * 128 - wg + G - 1) / G); }
__device__ __forceinline__ void rwkv_r1_prefetch(Frame& F, int item, int tid, R1Pre& P) {
    const int chain = item >> 7, chunk = item & 127, b = chain >> 3, h = chain & 7, g0 = b * SEQ + chunk * 64;
    const bf16* Z = (const bf16*)(F.ws + WS_Z);
    const v4u z0 = (v4u){0u, 0u, 0u, 0u};
    { const int t = tid >> 3, cg = tid & 7; const bool first = (chunk == 0 && t == 0);
      const bf16* zr = Z + (size_t)(g0 + t) * IN_COLS;
      P.wd[0] = *(const GAS v4u*)(zr + C_WD + cg * 8); P.ad[0] = *(const GAS v4u*)(zr + C_AD + cg * 8);
      P.wd[1] = z0; P.ad[1] = z0;
      if (!first) { P.wd[1] = *(const GAS v4u*)(zr - IN_COLS + C_WD + cg * 8); P.ad[1] = *(const GAS v4u*)(zr - IN_COLS + C_AD + cg * 8); } }
#pragma unroll
    for (int q = 0; q < 4; ++q) { const int p = tid + 512 * q; P.z[q] = z0;
        if (p < 65 * 24) { const int row = p / 24, rem = p - row * 24, seg = rem >> 3, ch = rem & 7;
            if (!(chunk == 0 && row == 0)) P.z[q] = *(const GAS v4u*)(Z + (size_t)(g0 - 1 + row) * IN_COLS + seg * 512 + h * 64 + ch * 8); } }
}
constexpr int R1_ZS = R1_AT, R1_ZSS = 384;
static_assert(65 * R1_ZSS <= 4 * 9216, "ZS fits in the At..Rt region");
__device__ __forceinline__ void rwkv_r1_item(Frame& F, int item, int next_item, R1Pre& P) {
    const int chain = item >> 7, chunk = item & 127, b = chain >> 3, h = chain & 7;
    const int g0 = b * SEQ + chunk * 64;
    int tid_ = F.tid; asm volatile("" : "+v"(tid_));
    const int tid = tid_, lane = tid & 63, w = __builtin_amdgcn_readfirstlane(tid >> 6), hh = lane >> 5, cl = lane & 31;
    const bf16* Z = (const bf16*)(F.ws + WS_Z);
    LAS unsigned char* lds = F.lds + RING_OFF;
    const float* mu = F.in[3];
    {
        const int t = tid >> 3, cg = tid & 7;
        const v4u cw = P.wd[0], ca = P.ad[0], pw = P.wd[1], pa = P.ad[1];
        float fw[8], fa[8], qw[8], qa[8];
        fw[0] = bflo(cw.x); fw[1] = bfhi(cw.x); fw[2] = bflo(cw.y); fw[3] = bfhi(cw.y); fw[4] = bflo(cw.z); fw[5] = bfhi(cw.z); fw[6] = bflo(cw.w); fw[7] = bfhi(cw.w);
        fa[0] = bflo(ca.x); fa[1] = bfhi(ca.x); fa[2] = bflo(ca.y); fa[3] = bfhi(ca.y); fa[4] = bflo(ca.z); fa[5] = bfhi(ca.z); fa[6] = bflo(ca.w); fa[7] = bfhi(ca.w);
        qw[0] = bflo(pw.x); qw[1] = bfhi(pw.x); qw[2] = bflo(pw.y); qw[3] = bfhi(pw.y); qw[4] = bflo(pw.z); qw[5] = bfhi(pw.z); qw[6] = bflo(pw.w); qw[7] = bfhi(pw.w);
        qa[0] = bflo(pa.x); qa[1] = bfhi(pa.x); qa[2] = bflo(pa.y); qa[3] = bfhi(pa.y); qa[4] = bflo(pa.z); qa[5] = bfhi(pa.z); qa[6] = bflo(pa.w); qa[7] = bfhi(pa.w);
#pragma unroll
        for (int j = 0; j < 8; ++j) { const int c = cg * 8 + j; const float xw = fw[j] + (qw[j] - fw[j]) * mu[C_WD + c];
            const float ex = __expf(2.f * xw); fw[j] = 1.f - 2.f * frcp(ex + 1.f);
            fa[j] = fa[j] + (qa[j] - fa[j]) * mu[C_AD + c]; }
        v4u ow, oa; ow.x = pk2(fw[0], fw[1]); ow.y = pk2(fw[2], fw[3]); ow.z = pk2(fw[4], fw[5]); ow.w = pk2(fw[6], fw[7]);
        oa.x = pk2(fa[0], fa[1]); oa.y = pk2(fa[2], fa[3]); oa.z = pk2(fa[4], fa[5]); oa.w = pk2(fa[6], fa[7]);
        *(LAS v4u*)(lds + R1_ACTW + t * SBS + cg * 16) = ow; *(LAS v4u*)(lds + R1_ACTA + t * SBS + cg * 16) = oa;
#pragma unroll
        for (int q = 0; q < 4; ++q) { const int p = tid + 512 * q;
            if (p < 65 * 24) { const int row = p / 24, rem = p - row * 24; *(LAS v4u*)(lds + R1_ZS + row * R1_ZSS + rem * 16) = P.z[q]; } }
        if (next_item >= 0) rwkv_r1_prefetch(F, next_item, tid, P);
    }
    LDS_BARRIER();
    {
        const int p = w >> 2, mt = (w >> 1) & 1, nt = w & 1;
        const bf16* upt = (const bf16*)(F.ws + (p == 0 ? WS_WUPT : WS_AUPT)) + (size_t)(h * 64 + nt * 32) * 64;
        const f32x16 acc = wtile_gb<4>(lds + (p == 0 ? R1_ACTW : R1_ACTA) + mt * 32 * SBS, SBS, upt, 64, zero16(), lane);
        LAS float* O = (LAS float*)(lds + (p == 0 ? R1_EPRE : R1_APRE));
#pragma unroll
        for (int r = 0; r < 16; ++r) O[(mt * 32 + crow(r, hh)) * 64 + nt * 32 + cl] = acc[r];
    }
    LDS_BARRIER();
    {
        const int c = tid & 63, ts = tid >> 6, col = h * 64 + c;
        const float mu_r = mu[C_R + col], mu_k = mu[C_K + col], mu_v = mu[C_V + col], kkc = F.in[9][col], kac = F.in[10][col], rkc = F.in[11][col], w0c = F.in[4][col], a0c = F.in[6][col];
        const LAS float* EP = (const LAS float*)(lds + R1_EPRE); const LAS float* AP = (const LAS float*)(lds + R1_APRE);
        LAS float* SEGS = (LAS float*)(lds + R1_SEGS); LAS float* BON = (LAS float*)(lds + R1_BONUS);
        const LAS bf16* zb = (const LAS bf16*)(lds + R1_ZS + (8 * ts) * R1_ZSS) + c;
        float pr = bf2f(zb[0]), pk = bf2f(zb[64]), pv = bf2f(zb[128]);
        float rr[8], k2[8], ai[8], bi[8], vv[8], ee[8], cs[8]; float run = 0.f;
#pragma unroll
        for (int i = 0; i < 8; ++i) {
            const float zr = bf2f(zb[(i + 1) * (R1_ZSS / 2)]), zk = bf2f(zb[(i + 1) * (R1_ZSS / 2) + 64]), zv = bf2f(zb[(i + 1) * (R1_ZSS / 2) + 128]);
            const float r = zr + (pr - zr) * mu_r, k = zk + (pk - zk) * mu_k, v = zv + (pv - zv) * mu_v; pr = zr; pk = zk; pv = zv;
            const float e = 0.60653066f * frcp(1.f + __expf(-(w0c + EP[(8 * ts + i) * 64 + c])));
            const float a = frcp(1.f + __expf(-(a0c + AP[(8 * ts + i) * 64 + c])));
            float kk = k * kkc; const float n2 = wave_sum(kk * kk); kk = kk * frsq(fmaxf(n2, 1e-24f));
            const float kq = k * (1.f + (a - 1.f) * kac);
            const float bon = wave_sum(r * kq * rkc); if (c == 0) BON[8 * ts + i] = bon;
            rr[i] = r; k2[i] = kq; ai[i] = -kk; bi[i] = kk * a; vv[i] = v; ee[i] = e; run += e; cs[i] = run;
        }
        SEGS[ts * 64 + c] = run;
        LDS_BARRIER();
        float off = 0.f, tot = 0.f;
#pragma unroll
        for (int q = 0; q < 8; ++q) { const float sv = SEGS[q * 64 + c]; tot += sv; off += (q < ts) ? sv : 0.f; }
        float bb[8], kb[8];
#pragma unroll
        for (int i = 0; i < 8; ++i) { const float L = off + cs[i];
            const float Wm = __expf(-(L - ee[i])), Wi = __expf(-L), iW = __expf(L), We = __expf(-(tot - L));
            const int t = 8 * ts + i;
            *(LAS bf16*)(lds + R1_AT + t * SBS + c * 2) = (bf16)f2bf(ai[i] * Wm);
            *(LAS bf16*)(lds + R1_BT + t * SBS + c * 2) = (bf16)f2bf(bi[i] * iW);
            *(LAS bf16*)(lds + R1_KT + t * SBS + c * 2) = (bf16)f2bf(k2[i] * iW);
            *(LAS bf16*)(lds + R1_RT + t * SBS + c * 2) = (bf16)f2bf(rr[i] * Wi);
            bb[i] = bi[i] * We; kb[i] = k2[i] * We; }
        v4u o; o.x = pk2(bb[0], bb[1]); o.y = pk2(bb[2], bb[3]); o.z = pk2(bb[4], bb[5]); o.w = pk2(bb[6], bb[7]);
        *(LAS v4u*)(lds + R1_BBT + c * SBS + ts * 16) = o;
        o.x = pk2(kb[0], kb[1]); o.y = pk2(kb[2], kb[3]); o.z = pk2(kb[4], kb[5]); o.w = pk2(kb[6], kb[7]);
        *(LAS v4u*)(lds + R1_KBT + c * SBS + ts * 16) = o;
        o.x = pk2(vv[0], vv[1]); o.y = pk2(vv[2], vv[3]); o.z = pk2(vv[4], vv[5]); o.w = pk2(vv[6], vv[7]);
        *(LAS v4u*)(lds + R1_VT + c * SBS + ts * 16) = o;
        if (ts == 0) ((LAS float*)(lds + R1_WEND))[c] = __expf(-tot);
    }
    LDS_BARRIER();
#pragma unroll
    for (int u = 0; u < 2; ++u) {
        const int idx = w * 2 + u, p = idx >> 2, mt = (idx >> 1) & 1, nt = idx & 1;
        const LAS unsigned char* Aop = lds + ((p == 0 || p == 2) ? R1_BT : R1_KT) + mt * 32 * SBS;
        const LAS unsigned char* Bop = lds + (p < 2 ? R1_AT : R1_RT) + nt * 32 * SBS;
        f32x16 acc = wtile<4>(Aop, SBS, Bop, SBS, zero16(), lane);
        const int n = nt * 32 + cl;
#pragma unroll
        for (int r = 0; r < 16; ++r) { const int m = mt * 32 + crow(r, hh); const bool keep = (p < 2) ? (m < n) : (m <= n); acc[r] = keep ? acc[r] : 0.f; }
#pragma unroll
        for (int g4 = 0; g4 < 4; ++g4) { const int m0 = mt * 32 + 8 * g4 + 4 * hh;
            if (p == 0) *(LAS f32x4*)(lds + R1_AAB + (n * 64 + m0) * 4) = (f32x4){acc[4 * g4], acc[4 * g4 + 1], acc[4 * g4 + 2], acc[4 * g4 + 3]};
            else { v2u o; o.x = pk2(acc[4 * g4], acc[4 * g4 + 1]); o.y = pk2(acc[4 * g4 + 2], acc[4 * g4 + 3]);
                   *(LAS v2u*)(lds + (p == 1 ? R1_AAK : (p == 2 ? R1_ARB : R1_ARK)) + n * SBS + m0 * 2) = o; } }
    }
    LDS_BARRIER();
    if (w < 4) {
        const int mt = w >> 1, nt = w & 1;
        const f32x16 acc = wtile<4>(lds + R1_AAK + mt * 32 * SBS, SBS, lds + R1_VT + nt * 32 * SBS, SBS, zero16(), lane);
        LAS float* X = (LAS float*)(lds + R1_X);
#pragma unroll
        for (int r = 0; r < 16; ++r) X[(mt * 32 + crow(r, hh)) * 64 + nt * 32 + cl] = acc[r];
    } else if (w == 4) {
        const int bk = lane >> 4, c = lane & 15;
        const LAS float* AAB = (const LAS float*)(lds + R1_AAB);
        float Tc[16]; const float fc = (float)c;
#pragma unroll
        for (int s2 = 0; s2 < 16; ++s2) Tc[s2] = fmaxf(0.f, 1.f - fabsf((float)s2 - fc));
#pragma unroll
        for (int r = 0; r < 15; ++r)
#pragma unroll
            for (int s2 = r + 1; s2 < 16; ++s2) Tc[s2] += AAB[(16 * bk + s2) * 64 + 16 * bk + r] * Tc[r];
        LAS float* TII = (LAS float*)(lds + R1_TII);
#pragma unroll
        for (int s2 = 0; s2 < 16; ++s2) TII[(bk * 16 + s2) * 16 + c] = Tc[s2];
    }
    LDS_BARRIER();
    {
        const int c16 = lane & 15, g = lane >> 4;
        const LAS float* AAB = (const LAS float*)(lds + R1_AAB); const LAS float* TII = (const LAS float*)(lds + R1_TII); const LAS float* X = (const LAS float*)(lds + R1_X);
        f32x4 o[4];
#pragma unroll
        for (int i = 0; i < 4; ++i) {
            f32x4 acc;
            if (w < 4) {
#pragma unroll
                for (int q = 0; q < 4; ++q) acc[q] = bf2f(*(const LAS bf16*)(lds + R1_AT + (16 * i + 4 * g + q) * SBS + (16 * w + c16) * 2));
            } else {
#pragma unroll
                for (int q = 0; q < 4; ++q) acc[q] = X[(16 * i + 4 * g + q) * 64 + 16 * (w - 4) + c16];
            }
#pragma unroll
            for (int j = 0; j < i; ++j) { const f32x4 a4 = *(const LAS f32x4*)(AAB + (16 * i + c16) * 64 + 16 * j + 4 * g);
#pragma unroll
                for (int q = 0; q < 4; ++q) acc = __builtin_amdgcn_mfma_f32_16x16x4f32(a4[q], o[j][q], acc, 0, 0, 0); }
            const f32x4 t4 = *(const LAS f32x4*)(TII + (i * 16 + c16) * 16 + 4 * g);
            f32x4 res = (f32x4){0.f, 0.f, 0.f, 0.f};
#pragma unroll
            for (int q = 0; q < 4; ++q) res = __builtin_amdgcn_mfma_f32_16x16x4f32(t4[q], acc[q], res, 0, 0, 0);
            o[i] = res;
            v2u ov; ov.x = pk2(res[0], res[1]); ov.y = pk2(res[2], res[3]);
            *(LAS v2u*)(lds + (w < 4 ? R1_AHT : R1_U0T) + (16 * (w & 3) + c16) * SBS + (16 * i + 4 * g) * 2) = ov;
        }
    }
    LDS_BARRIER();
    {
        float* Mg = F.out + (size_t)item * 4096; float* NTg = F.out + (size_t)T * RWW + (size_t)item * 4096;
        float* Y0g = (float*)(F.ws + WS_RWY0) + (size_t)item * 4096; bf16* RHg = (bf16*)(F.ws + WS_RWRH) + (size_t)item * 4096;
#pragma unroll
        for (int u = 0; u < 2; ++u) {
            const int idx = w * 2 + u, p = idx >> 2, mt = (idx >> 1) & 1, nt = idx & 1; const int n = nt * 32 + cl;
            if (p == 0) {
                f32x16 acc = wtile<4>(lds + R1_AHT + mt * 32 * SBS, SBS, lds + R1_BBT + nt * 32 * SBS, SBS, zero16(), lane);
                const float we = ((const LAS float*)(lds + R1_WEND))[n];
#pragma unroll
                for (int g4 = 0; g4 < 4; ++g4) { const int m0 = mt * 32 + 8 * g4 + 4 * hh;
                    *(GAS f32x4*)(Mg + n * 64 + m0) = (f32x4){acc[4 * g4] + (m0 == n ? we : 0.f), acc[4 * g4 + 1] + (m0 + 1 == n ? we : 0.f), acc[4 * g4 + 2] + (m0 + 2 == n ? we : 0.f), acc[4 * g4 + 3] + (m0 + 3 == n ? we : 0.f)}; }
            } else if (p == 1) {
                f32x16 acc = wtile<4>(lds + R1_BBT + mt * 32 * SBS, SBS, lds + R1_U0T + nt * 32 * SBS, SBS, zero16(), lane);
                acc = wtile<4>(lds + R1_KBT + mt * 32 * SBS, SBS, lds + R1_VT + nt * 32 * SBS, SBS, acc, lane);
#pragma unroll
                for (int g4 = 0; g4 < 4; ++g4) *(GAS f32x4*)(NTg + n * 64 + mt * 32 + 8 * g4 + 4 * hh) = (f32x4){acc[4 * g4], acc[4 * g4 + 1], acc[4 * g4 + 2], acc[4 * g4 + 3]};
            } else if (p == 2) {
                f32x16 acc = wtile<4>(lds + R1_AHT + mt * 32 * SBS, SBS, lds + R1_ARB + nt * 32 * SBS, SBS, zero16(), lane);
#pragma unroll
                for (int g4 = 0; g4 < 4; ++g4) { const int m0 = mt * 32 + 8 * g4 + 4 * hh;
                    const v2u rt = *(const LAS v2u*)(lds + R1_RT + n * SBS + m0 * 2);
                    v2u ov; ov.x = pk2(acc[4 * g4] + bflo(rt.x), acc[4 * g4 + 1] + bfhi(rt.x)); ov.y = pk2(acc[4 * g4 + 2] + bflo(rt.y), acc[4 * g4 + 3] + bfhi(rt.y));
                    *(GAS v2u*)(RHg + n * 64 + m0) = ov; }
            } else {
                f32x16 acc = wtile<4>(lds + R1_U0T + mt * 32 * SBS, SBS, lds + R1_ARB + nt * 32 * SBS, SBS, zero16(), lane);
                acc = wtile<4>(lds + R1_VT + mt * 32 * SBS, SBS, lds + R1_ARK + nt * 32 * SBS, SBS, acc, lane);
#pragma unroll
                for (int g4 = 0; g4 < 4; ++g4) *(GAS f32x4*)(Y0g + n * 64 + mt * 32 + 8 * g4 + 4 * hh) = (f32x4){acc[4 * g4], acc[4 * g4 + 1], acc[4 * g4 + 2], acc[4 * g4 + 3]};
            }
        }
        if (tid < 64) ((float*)(F.ws + WS_BONUS))[(size_t)item * 64 + tid] = ((const LAS float*)(lds + R1_BONUS))[tid];
    }
    LDS_BARRIER();
}

constexpr int R2_RS = 272, R2_SLOT = 2 * 64 * R2_RS, R2_D = 6;
static_assert(2 * R2_SLOT <= LDSCTL_OFF, "R2 LDS");
__device__ __forceinline__ void rwkv_r2_chain(Frame& F, int chain) {
    int tid_ = F.tid; asm volatile("" : "+v"(tid_));
    const int lane = tid_ & 63, w = __builtin_amdgcn_readfirstlane(tid_ >> 6);
    LAS unsigned char* lds = F.lds + RING_OFF;
    const float* Mg = F.out + (size_t)chain * 128 * 4096; const float* NTg = F.out + (size_t)T * RWW + (size_t)chain * 128 * 4096;
    constexpr int NSTEP = 127;
    if (w >= 4) {
        const int L = w - 4, r = lane >> 2, f0 = (lane & 3) * 4;
        const size_t goff = (size_t)(16 * L + r) * 64 + f0 * 4;
        const int loff = (16 * L + r) * R2_RS + f0 * 16;
        f32x4 R[R2_D][8];
#define R2_ISSUE(slot_, step_) do { if ((step_) < NSTEP) { const float* mp_ = Mg + (size_t)(step_) * 4096 + goff; const float* np_ = NTg + (size_t)(step_) * 4096 + goff; \
            _Pragma("unroll") for (int k_ = 0; k_ < 4; ++k_) { R[slot_][k_] = *(const GAS f32x4*)(mp_ + 4 * k_); R[slot_][4 + k_] = *(const GAS f32x4*)(np_ + 4 * k_); } } } while (0)
#define R2_WRITE(slot_, buf_) do { LAS unsigned char* d_ = lds + (buf_) * R2_SLOT + loff; \
            _Pragma("unroll") for (int k_ = 0; k_ < 4; ++k_) { *(LAS f32x4*)(d_ + 16 * k_) = R[slot_][k_]; *(LAS f32x4*)(d_ + 64 * R2_RS + 16 * k_) = R[slot_][4 + k_]; } } while (0)
#pragma unroll
        for (int u = 0; u < R2_D; ++u) R2_ISSUE(u, u);
        R2_WRITE(0, 0);
        R2_ISSUE(0, R2_D);
        LDS_BARRIER();
        for (int c0 = 0; c0 < NSTEP; c0 += R2_D) {
#pragma unroll
            for (int u = 0; u < R2_D; ++u) { const int c = c0 + u;
                if (c < NSTEP) {
                    if (c + 1 < NSTEP) R2_WRITE((u + 1) % R2_D, (c + 1) & 1);
                    R2_ISSUE((u + 1) % R2_D, c + 1 + R2_D);
                    LDS_BARRIER();
                } }
        }
#undef R2_ISSUE
#undef R2_WRITE
        return;
    }
    const int n16 = lane & 15, g = lane >> 4;
    float* SSg = (float*)(F.ws + WS_RWSS) + (size_t)chain * 128 * 4096;
    f32x4 st[4];
#pragma unroll
    for (int rt = 0; rt < 4; ++rt) st[rt] = (f32x4){0.f, 0.f, 0.f, 0.f};
    LDS_BARRIER();
    for (int c = 0; c < NSTEP; ++c) {
#pragma unroll
        for (int rt = 0; rt < 4; ++rt) *(GAS f32x4*)(SSg + (size_t)c * 4096 + (16 * w + n16) * 64 + 16 * rt + 4 * g) = st[rt];
        const LAS unsigned char* sl_ = lds + (c & 1) * R2_SLOT;
        bf16x8 sh[2], sl[2];
#pragma unroll
        for (int ks = 0; ks < 2; ++ks) { const f32x4 a = st[2 * ks], b = st[2 * ks + 1];
            v4u h; h.x = pk2(a[0], a[1]); h.y = pk2(a[2], a[3]); h.z = pk2(b[0], b[1]); h.w = pk2(b[2], b[3]);
            v4u l; l.x = pk2(a[0] - bflo(h.x), a[1] - bfhi(h.x)); l.y = pk2(a[2] - bflo(h.y), a[3] - bfhi(h.y)); l.z = pk2(b[0] - bflo(h.z), b[1] - bfhi(h.z)); l.w = pk2(b[2] - bflo(h.w), b[3] - bfhi(h.w));
            sh[ks] = __builtin_bit_cast(bf16x8, h); sl[ks] = __builtin_bit_cast(bf16x8, l); }
        f32x4 nw[4];
#pragma unroll
        for (int rt = 0; rt < 4; ++rt) { f32x4 acc = *(const LAS f32x4*)(sl_ + 64 * R2_RS + (16 * w + n16) * R2_RS + (16 * rt + 4 * g) * 4);
#pragma unroll
            for (int ks = 0; ks < 2; ++ks) { const f32x4 a = *(const LAS f32x4*)(sl_ + (16 * rt + n16) * R2_RS + (32 * ks + 4 * g) * 4), b = *(const LAS f32x4*)(sl_ + (16 * rt + n16) * R2_RS + (32 * ks + 16 + 4 * g) * 4);
                v4u h; h.x = pk2(a[0], a[1]); h.y = pk2(a[2], a[3]); h.z = pk2(b[0], b[1]); h.w = pk2(b[2], b[3]);
                v4u l; l.x = pk2(a[0] - bflo(h.x), a[1] - bfhi(h.x)); l.y = pk2(a[2] - bflo(h.y), a[3] - bfhi(h.y)); l.z = pk2(b[0] - bflo(h.z), b[1] - bfhi(h.z)); l.w = pk2(b[2] - bflo(h.w), b[3] - bfhi(h.w));
                const bf16x8 mh = __builtin_bit_cast(bf16x8, h), ml = __builtin_bit_cast(bf16x8, l);
                acc = __builtin_amdgcn_mfma_f32_16x16x32_bf16(mh, sh[ks], acc, 0, 0, 0);
                acc = __builtin_amdgcn_mfma_f32_16x16x32_bf16(mh, sl[ks], acc, 0, 0, 0);
                acc = __builtin_amdgcn_mfma_f32_16x16x32_bf16(ml, sh[ks], acc, 0, 0, 0); }
            nw[rt] = acc; }
#pragma unroll
        for (int rt = 0; rt < 4; ++rt) st[rt] = nw[rt];
        LDS_BARRIER();
    }
#pragma unroll
    for (int rt = 0; rt < 4; ++rt) *(GAS f32x4*)(SSg + (size_t)NSTEP * 4096 + (16 * w + n16) * 64 + 16 * rt + 4 * g) = st[rt];
}

constexpr int R3_RH = 0, R3_S = 9216, R3_SG = 18432, R3_SGS = 272, R3_YL = R3_SG + 64 * R3_SGS, R3_GL = R3_YL + 16384, R3_END = R3_GL + 16384;
static_assert(R3_END <= LDSCTL_OFF, "R3 LDS");
__device__ __forceinline__ void rwkv_r3_item(Frame& F, int item) {
    const int chain = item >> 7, chunk = item & 127, b = chain >> 3, h = chain & 7;
    const int g0 = b * SEQ + chunk * 64;
    int tid_ = F.tid; asm volatile("" : "+v"(tid_));
    const int tid = tid_, lane = tid & 63, w = __builtin_amdgcn_readfirstlane(tid >> 6), hh = lane >> 5, cl = lane & 31;
    const bf16* Z = (const bf16*)(F.ws + WS_Z);
    LAS unsigned char* lds = F.lds + RING_OFF;
    const float* mu = F.in[3];
    {
        const int t = tid >> 3, cg = tid & 7;
        const bf16* RHg = (const bf16*)(F.ws + WS_RWRH) + (size_t)item * 4096;
        *(LAS v4u*)(lds + R3_RH + t * SBS + cg * 16) = *(const GAS v4u*)(RHg + t * 64 + cg * 8);
        const float* SSg = (const float*)(F.ws + WS_RWSS) + (size_t)item * 4096;
        const f32x4 s0 = *(const GAS f32x4*)(SSg + t * 64 + cg * 8), s1 = *(const GAS f32x4*)(SSg + t * 64 + cg * 8 + 4);
        v4u o; o.x = pk2(s0[0], s0[1]); o.y = pk2(s0[2], s0[3]); o.z = pk2(s1[0], s1[1]); o.w = pk2(s1[2], s1[3]);
        *(LAS v4u*)(lds + R3_S + t * SBS + cg * 16) = o;
        const bool first = (chunk == 0 && t == 0);
        const bf16* zr = Z + (size_t)(g0 + t) * IN_COLS + C_GD + cg * 16;
#pragma unroll
        for (int q = 0; q < 2; ++q) {
            const v4u cw = *(const GAS v4u*)(zr + q * 8); v4u pw = (v4u){0u, 0u, 0u, 0u};
            if (!first) pw = *(const GAS v4u*)(zr - IN_COLS + q * 8);
            float fw[8], qw[8];
            fw[0] = bflo(cw.x); fw[1] = bfhi(cw.x); fw[2] = bflo(cw.y); fw[3] = bfhi(cw.y); fw[4] = bflo(cw.z); fw[5] = bfhi(cw.z); fw[6] = bflo(cw.w); fw[7] = bfhi(cw.w);
            qw[0] = bflo(pw.x); qw[1] = bfhi(pw.x); qw[2] = bflo(pw.y); qw[3] = bfhi(pw.y); qw[4] = bflo(pw.z); qw[5] = bfhi(pw.z); qw[6] = bflo(pw.w); qw[7] = bfhi(pw.w);
#pragma unroll
            for (int j = 0; j < 8; ++j) { const float v = fw[j] + (qw[j] - fw[j]) * mu[C_GD + cg * 16 + q * 8 + j]; fw[j] = frcp(1.f + __expf(-v)); }
            v4u og; og.x = pk2(fw[0], fw[1]); og.y = pk2(fw[2], fw[3]); og.z = pk2(fw[4], fw[5]); og.w = pk2(fw[6], fw[7]);
            *(LAS v4u*)(lds + R3_SG + t * R3_SGS + (cg * 16 + q * 8) * 2) = og;
        }
    }
    LDS_BARRIER();
    {
        const int mt = (w >> 1) & 1, nt = w & 1; const int n = nt * 32 + cl;
        if (w < 4) {
            const float* Y0g = (const float*)(F.ws + WS_RWY0) + (size_t)item * 4096;
            f32x16 acc;
#pragma unroll
            for (int r = 0; r < 16; ++r) acc[r] = Y0g[(mt * 32 + crow(r, hh)) * 64 + n];
            acc = wtile<4>(lds + R3_RH + mt * 32 * SBS, SBS, lds + R3_S + nt * 32 * SBS, SBS, acc, lane);
            LAS float* YL = (LAS float*)(lds + R3_YL);
#pragma unroll
            for (int r = 0; r < 16; ++r) YL[(mt * 32 + crow(r, hh)) * 64 + n] = acc[r];
        } else {
            const bf16* gut = (const bf16*)(F.ws + WS_GUPT) + (size_t)(h * 64 + nt * 32) * 128;
            const f32x16 acc = wtile_gb<8>(lds + R3_SG + mt * 32 * R3_SGS, R3_SGS, gut, 128, zero16(), lane);
            LAS float* GL = (LAS float*)(lds + R3_GL);
#pragma unroll
            for (int r = 0; r < 16; ++r) GL[(mt * 32 + crow(r, hh)) * 64 + n] = acc[r];
        }
    }
    LDS_BARRIER();
    {
        const int c = tid & 63, ts = tid >> 6, col = h * 64 + c;
        const float mu_v = mu[C_V + col], gw = F.in[12][col], gb = F.in[13][col];
        const LAS float* YL = (const LAS float*)(lds + R3_YL); const LAS float* GL = (const LAS float*)(lds + R3_GL);
        const float* BON = (const float*)(F.ws + WS_BONUS) + (size_t)item * 64;
        bf16* Y = (bf16*)(F.ws + WS_YMIX);
        const bf16* zb = Z + (size_t)(g0 + 8 * ts) * IN_COLS + col;
        float pv = 0.f; if (!(chunk == 0 && ts == 0)) pv = bf2f(zb[C_V - IN_COLS]);
#pragma unroll
        for (int i = 0; i < 8; ++i) { const int t = 8 * ts + i;
            const float zv = bf2f(zb[(size_t)i * IN_COLS + C_V]); const float v = zv + (pv - zv) * mu_v; pv = zv;
            const float y = YL[t * 64 + c];
            const float mean = wave_sum(y) * (1.f / 64.f); const float d = y - mean; const float var = wave_sum(d * d) * (1.f / 64.f);
            const float yn = d * frsq(var + GN_EPS) * gw + gb;
            const float o = (yn + BON[t] * v) * GL[t * 64 + c];
            Y[(size_t)(g0 + t) * DM + col] = (bf16)f2bf(o); }
    }
    LDS_BARRIER();
}

typedef short s16x4 __attribute__((ext_vector_type(4)));
typedef short v4i16_t __attribute__((ext_vector_type(4)));
constexpr int AT_XO = 0, AT_XO_STRIDE = 136, AT_XM = 512 * AT_XO_STRIDE, AT_XL = AT_XM + 2048, AT_V = AT_XL + 2048, AT_LDS_END = AT_V + 8 * 4096;
static_assert(AT_LDS_END <= RING_BYTES, "attention LDS");
__device__ __forceinline__ float xhalf(float v) { return __shfl_xor(v, 32); }
__device__ __forceinline__ void attn_block(Frame& F, int item) {
    const int bh = item >> 4, blk = item & 15, b = bh >> 3, h = bh & 7, t0 = blk * 512;
    int tid_ = F.tid; asm volatile("" : "+v"(tid_));
    const int lane = tid_ & 63, w = __builtin_amdgcn_readfirstlane(tid_ >> 6), ql = lane & 31, hh = lane >> 5;
    const bf16* Zb = (const bf16*)(F.ws + WS_Z) + (size_t)b * SEQ * IN_COLS;
    bf16* Y = (bf16*)(F.ws + WS_YMIX);
    LAS unsigned char* lds = F.lds + RING_OFF;
    LAS unsigned char* Vw = lds + AT_V + w * 4096;
    LAS float* XM = (LAS float*)(lds + AT_XM); LAS float* XL = (LAS float*)(lds + AT_XL);
    constexpr float C2 = 0.125f * 1.4426950408889634f;
    for (int pass = 0; pass < 3; ++pass) {
        const int sh = pass == 0 ? 4 : (pass == 1 ? 2 : 0), d = 1 << sh;
        for (int uu = 0; uu < 2; ++uu) {
            const int u = w + 8 * uu, rho = u & (d - 1), tau = u >> sh;
            const int qoff = rho + (32 * tau + ql) * d;
            bf16x8 qf[4];
            { const bf16* qp = Zb + (size_t)(t0 + qoff) * IN_COLS + C_AQ + h * 64 + 8 * hh;
#pragma unroll
              for (int s = 0; s < 4; ++s) qf[s] = *(const GAS bf16x8*)(qp + 16 * s); }
            f32x16 sc[5];
            const int tkb = t0 + rho + (32 * tau - 128) * d;
            bf16x8 kf[5][4];
#pragma unroll
            for (int kt = 0; kt < 5; ++kt) { const int tk0 = tkb + 32 * kt * d, tkc = tk0 < 0 ? 0 : tk0;
                const bf16* kp = Zb + (size_t)(tkc + ql * d) * IN_COLS + C_AK + h * 64 + 8 * hh;
#pragma unroll
                for (int s = 0; s < 4; ++s) kf[kt][s] = *(const GAS bf16x8*)(kp + 16 * s); }
            v4u vr[4];
            { const int tkc = tkb < 0 ? 0 : tkb;
#pragma unroll
              for (int i = 0; i < 4; ++i) { const int kidx = i * 8 + (lane >> 3), ch = lane & 7;
                  vr[i] = *(const GAS v4u*)(Zb + (size_t)(tkc + kidx * d) * IN_COLS + C_AV + h * 64 + ch * 8); } }
#pragma unroll
            for (int kt = 0; kt < 5; ++kt) {
                const int tk0 = tkb + 32 * kt * d;
                f32x16 acc = zero16();
#pragma unroll
                for (int s = 0; s < 4; ++s) acc = __builtin_amdgcn_mfma_f32_32x32x16_bf16(kf[kt][s], qf[s], acc, 0, 0, 0);
                if (kt == 0 || kt == 4) {
#pragma unroll
                    for (int r = 0; r < 16; ++r) { const int kidx = (r & 3) + 8 * (r >> 2) + 4 * hh;
                        const bool ok = (kt == 0) ? (kidx >= ql) : (kidx <= ql);
                        acc[r] = ok ? acc[r] : -INFINITY; }
                }
                if (tk0 < 0) {
#pragma unroll
                    for (int r = 0; r < 16; ++r) acc[r] = -INFINITY;
                }
                sc[kt] = acc;
            }
            float m = -INFINITY;
#pragma unroll
            for (int kt = 0; kt < 5; ++kt)
#pragma unroll
                for (int r = 0; r < 16; ++r) m = fmaxf(m, sc[kt][r]);
            m = fmaxf(m, xhalf(m));
            const float ms = m * C2;
            float l = 0.f;
#pragma unroll
            for (int kt = 0; kt < 5; ++kt)
#pragma unroll
                for (int r = 0; r < 16; ++r) { const float p = __builtin_amdgcn_exp2f(sc[kt][r] * C2 - ms); sc[kt][r] = p; l += p; }
            l += xhalf(l);
            f32x16 O[2];
#pragma unroll
            for (int r = 0; r < 16; ++r) { O[0][r] = 0.f; O[1][r] = 0.f; }
#pragma unroll
            for (int kt = 0; kt < 5; ++kt) {
#pragma unroll
                for (int i = 0; i < 4; ++i) { const int kidx = i * 8 + (lane >> 3), ch = lane & 7;
                    *(LAS v4u*)(Vw + kidx * 128 + ((ch ^ (((kidx >> 1) & 1) << 2)) << 4)) = vr[i]; }
                if (kt < 4) { const int tk1 = tkb + 32 * (kt + 1) * d, tkc = tk1 < 0 ? 0 : tk1;
#pragma unroll
                    for (int i = 0; i < 4; ++i) { const int kidx = i * 8 + (lane >> 3), ch = lane & 7;
                        vr[i] = *(const GAS v4u*)(Zb + (size_t)(tkc + kidx * d) * IN_COLS + C_AV + h * 64 + ch * 8); } }
                asm volatile("s_waitcnt lgkmcnt(0)" ::: "memory");
#pragma unroll
                for (int s = 0; s < 2; ++s) {
                    v4u pw; pw.x = pk2(sc[kt][8 * s], sc[kt][8 * s + 1]); pw.y = pk2(sc[kt][8 * s + 2], sc[kt][8 * s + 3]); pw.z = pk2(sc[kt][8 * s + 4], sc[kt][8 * s + 5]); pw.w = pk2(sc[kt][8 * s + 6], sc[kt][8 * s + 7]);
                    const bf16x8 pf = __builtin_bit_cast(bf16x8, pw);
#pragma unroll
                    for (int dt = 0; dt < 2; ++dt) {
                        bf16x8 vf;
#pragma unroll
                        for (int pp = 0; pp < 2; ++pp) {
                            const int i16 = lane & 15, db = (lane >> 4) & 1;
                            const int row = 16 * s + 8 * pp + 4 * hh + (i16 >> 2);
                            const int byte = 64 * dt + 32 * db + 8 * (i16 & 3);
                            const int chunk = (byte >> 4) ^ (((row >> 1) & 1) << 2);
                            const s16x4 t4 = __builtin_bit_cast(s16x4, __builtin_amdgcn_ds_read_tr16_b64_v4i16((LAS v4i16_t*)(Vw + row * 128 + (chunk << 4) + (byte & 15))));
                            vf[4 * pp + 0] = t4[0]; vf[4 * pp + 1] = t4[1]; vf[4 * pp + 2] = t4[2]; vf[4 * pp + 3] = t4[3];
                        }
                        O[dt] = __builtin_amdgcn_mfma_f32_32x32x16_bf16(vf, pf, O[dt], 0, 0, 0);
                    }
                }
                asm volatile("s_waitcnt lgkmcnt(0)" ::: "memory");
            }
            LAS unsigned char* xo = lds + AT_XO + qoff * AT_XO_STRIDE + 8 * hh;
            float wa = 0.f, wb = 1.f, Mx = ms, ln = l;
            if (pass > 0) { const float msa = XM[qoff], la = XL[qoff]; Mx = fmaxf(msa, ms); wa = la * __builtin_amdgcn_exp2f(msa - Mx); wb = __builtin_amdgcn_exp2f(ms - Mx); ln = wa + wb * l; }
            const float inv = 1.f / ln;
#pragma unroll
            for (int dt = 0; dt < 2; ++dt)
#pragma unroll
                for (int g4 = 0; g4 < 4; ++g4) {
                    LAS v2u* p = (LAS v2u*)(xo + (32 * dt + 8 * g4) * 2);
                    float o0 = O[dt][4 * g4] * wb, o1 = O[dt][4 * g4 + 1] * wb, o2 = O[dt][4 * g4 + 2] * wb, o3 = O[dt][4 * g4 + 3] * wb;
                    if (pass > 0) { const v2u old = *p; o0 += bflo(old.x) * wa; o1 += bfhi(old.x) * wa; o2 += bflo(old.y) * wa; o3 += bfhi(old.y) * wa; }
                    v2u nw; nw.x = pk2(o0 * inv, o1 * inv); nw.y = pk2(o2 * inv, o3 * inv);
                    *p = nw;
                }
            if (hh == 0) { XM[qoff] = Mx; XL[qoff] = ln; }
        }
        LDS_BARRIER();
    }
#pragma unroll
    for (int i = 0; i < 8; ++i) { const int row = (tid_ >> 3) + 64 * i, ch = tid_ & 7;
        LAS v2u* p = (LAS v2u*)(lds + AT_XO + row * AT_XO_STRIDE + ch * 16);
        const v2u a = p[0], c = p[1];
        v4u o; o.x = a.x; o.y = a.y; o.z = c.x; o.w = c.y;
        *(GAS v4u*)(Y + ((size_t)b * SEQ + t0 + row) * DM + RWW + h * 64 + ch * 8) = o; }
    LDS_BARRIER();
}

__device__ __forceinline__ void p3_mixers(Frame& F) {
    const int nrw = (F.G >= 64) ? 32 : 0;
    if (nrw == 0) { for (int ch = 0; ch < NB * NHR; ++ch) rwkv_r2_chain(F, ch); }
    else if (F.wg < nrw) { for (int ch = F.wg; ch < NB * NHR; ch += nrw) rwkv_r2_chain(F, ch); return; }
    const int na = F.G - nrw, wa = F.wg - nrw;
#ifndef ATTN_REPS
#define ATTN_REPS 1
#endif
    for (int rep = 0; rep < ATTN_REPS; ++rep)
    for (int item = wa; item < NB * NHA * (SEQ / 512); item += na) attn_block(F, item);
}

__device__ __forceinline__ void p5_xn2(Frame& F) {
    const int gw = F.wg * NWAVES + F.wave, NGW = F.G * NWAVES;
    bf16* XN = (bf16*)(F.ws + WS_XN);
    for (int m = gw; m < T; m += NGW) rms_row_to_bf16(F.lane, F.out + (size_t)m * DM, F.in[15], XN + (size_t)m * DM);
}

constexpr int TK_SKS = 272, TK_SKH = 0, TK_SKL = 2 * 128 * TK_SKS, TK_LUT = 2 * TK_SKL, TK_END = TK_LUT + 8 * 2048;
__device__ __forceinline__ unsigned f2ord(float f) { const unsigned u = __builtin_bit_cast(unsigned, f); return u ^ ((unsigned)((int)u >> 31) | 0x80000000u); }
__device__ __forceinline__ float ord2f(unsigned o) { const unsigned u = (o & 0x80000000u) ? (o ^ 0x80000000u) : ~o; return __builtin_bit_cast(float, u); }
__device__ __forceinline__ void ce_desc(unsigned& a, unsigned& b) { const unsigned mx = a > b ? a : b, mn = a > b ? b : a; a = mx; b = mn; }
template <int N, int OFF, int TOT> __device__ __forceinline__ void bitonic_sort_desc(unsigned (&v)[TOT]) {
#pragma unroll
    for (int k = 2; k <= N; k <<= 1)
#pragma unroll
        for (int j = k >> 1; j > 0; j >>= 1)
#pragma unroll
            for (int i = 0; i < N; ++i) { const int l = i ^ j; if (l > i) { if ((i & k) == 0) ce_desc(v[OFF + i], v[OFF + l]); else ce_desc(v[OFF + l], v[OFF + i]); } }
}
template <int OFFA, int OFFB, int TOT> __device__ __forceinline__ void merge_top16(unsigned (&v)[TOT]) {
#pragma unroll
    for (int i = 0; i < 16; ++i) { const unsigned x = v[OFFA + i], y = v[OFFB + 15 - i]; v[OFFA + i] = x > y ? x : y; }
#pragma unroll
    for (int j = 8; j > 0; j >>= 1)
#pragma unroll
        for (int i = 0; i < 16; ++i) { const int l = i ^ j; if (l > i) ce_desc(v[OFFA + i], v[OFFA + l]); }
}
__device__ __forceinline__ void top16_of_64(unsigned (&k)[64]) {
    bitonic_sort_desc<16, 0, 64>(k); bitonic_sort_desc<16, 16, 64>(k); bitonic_sort_desc<16, 32, 64>(k); bitonic_sort_desc<16, 48, 64>(k);
    merge_top16<0, 16, 64>(k); merge_top16<32, 48, 64>(k); merge_top16<0, 32, 64>(k);
}
__device__ __forceinline__ void p7_topk(Frame& F) {
    static_assert(TK_END <= LDSCTL_OFF, "topk LDS");
    const bf16* QP = (const bf16*)(F.ws + WS_QP);
    int* EID = (int*)(F.ws + WS_EID); float* GATE = (float*)(F.ws + WS_GATE);
    const float* sk = F.in[17];
    LAS unsigned char* lds = F.lds + RING_OFF;
    for (int e = F.tid; e < 2 * 128 * 64; e += NTHREADS) {
        const int c = e >> 13, k = (e >> 6) & 127, d2 = e & 63;
        const f32x2 v = *(const GAS f32x2*)(sk + (size_t)(c * 128 + k) * 128 + 2 * d2);
        const unsigned h0 = f2bf(v.x), h1 = f2bf(v.y);
        const float r0 = v.x - __builtin_bit_cast(float, h0 << 16), r1 = v.y - __builtin_bit_cast(float, h1 << 16);
        *(LAS unsigned*)(lds + TK_SKH + (c * 128 + k) * TK_SKS + d2 * 4) = h0 | (h1 << 16);
        *(LAS unsigned*)(lds + TK_SKL + (c * 128 + k) * TK_SKS + d2 * 4) = pk2(r0, r1);
    }
    __syncthreads();
    const int gw = F.wg * NWAVES + F.wave, NGW = F.G * NWAVES;
    for (int tile = gw; tile < T * PHEADS / 32; tile += NGW) {
        int lane_ = F.lane; asm volatile("" : "+v"(lane_));
        const int lane = lane_, hh = lane >> 5, cl = lane & 31;
        const int P = tile * 32 + cl, t = P >> 3, h = P & 7;
        unsigned kAB[2][16];
#pragma unroll
        for (int c = 0; c < 2; ++c) {
            bf16x8 qf[8];
            const bf16* qp = QP + (size_t)t * PQ + h * 256 + c * 128 + 8 * hh;
#pragma unroll
            for (int s2 = 0; s2 < 8; ++s2) qf[s2] = *(const GAS bf16x8*)(qp + 16 * s2);
            unsigned k[64];
#pragma unroll
            for (int mt = 0; mt < 4; ++mt) {
                f32x16 acc = zero16();
                const LAS unsigned char* ah = lds + TK_SKH + (c * 128 + mt * 32 + cl) * TK_SKS + 16 * hh;
                const LAS unsigned char* al = lds + TK_SKL + (c * 128 + mt * 32 + cl) * TK_SKS + 16 * hh;
#pragma unroll
                for (int s2 = 0; s2 < 8; ++s2) {
                    acc = __builtin_amdgcn_mfma_f32_32x32x16_bf16(*(const LAS bf16x8*)(ah + 32 * s2), qf[s2], acc, 0, 0, 0);
                    acc = __builtin_amdgcn_mfma_f32_32x32x16_bf16(*(const LAS bf16x8*)(al + 32 * s2), qf[s2], acc, 0, 0, 0); }
#pragma unroll
                for (int r = 0; r < 16; ++r) { const int idx = 32 * mt + (r & 3) + 8 * (r >> 2) + 4 * hh; k[mt * 16 + r] = (f2ord(acc[r]) & ~127u) | (unsigned)(127 - idx); }
            }
            top16_of_64(k);
            unsigned m[32];
#pragma unroll
            for (int i = 0; i < 16; ++i) { m[i] = k[i]; m[16 + i] = (unsigned)__shfl_xor((int)k[i], 32); }
            merge_top16<0, 16, 32>(m);
#pragma unroll
            for (int i = 0; i < 16; ++i) kAB[c][i] = m[i];
        }
        float fa[16], fb[16];
#pragma unroll
        for (int i = 0; i < 16; ++i) { fa[i] = ord2f(kAB[0][i] & ~127u); fb[i] = ord2f(kAB[1][i] & ~127u); }
        unsigned cd[64]; int n = 0;
#pragma unroll
        for (int i = 0; i < 16; ++i)
#pragma unroll
            for (int j = 0; j < 16; ++j) if ((i + 1) * (j + 1) <= 16) { cd[n] = (f2ord(fa[i] + fb[j]) & ~255u) | (unsigned)(255 - (i * 16 + j)); ++n; }
#pragma unroll
        for (int q = 50; q < 64; ++q) cd[q] = 0u;
        top16_of_64(cd);
        LAS unsigned char* lut = lds + TK_LUT + (F.wave * 64 + lane) * 32;
#pragma unroll
        for (int q = 0; q < 4; ++q) {
            unsigned wa = 0u, wb = 0u;
#pragma unroll
            for (int b4 = 0; b4 < 4; ++b4) { wa |= (127u - (kAB[0][4 * q + b4] & 127u)) << (8 * b4); wb |= (127u - (kAB[1][4 * q + b4] & 127u)) << (8 * b4); }
            *(LAS unsigned*)(lut + 4 * q) = wa; *(LAS unsigned*)(lut + 16 + 4 * q) = wb; }
        float gv[16]; float den = 0.f; const float mx = ord2f(cd[0] & ~255u);
#pragma unroll
        for (int q = 0; q < 16; ++q) { gv[q] = __expf(ord2f(cd[q] & ~255u) - mx); den += gv[q]; }
        const float inv = 1.f / den;
        asm volatile("s_waitcnt lgkmcnt(0)" ::: "memory");
        int ev[16];
#pragma unroll
        for (int q = 0; q < 16; ++q) { const unsigned pos = 255u - (cd[q] & 255u);
            const unsigned ia = *(const LAS unsigned char*)(lut + (pos >> 4)), ib = *(const LAS unsigned char*)(lut + 16 + (pos & 15u));
            ev[q] = (int)(ia * NKEYS + ib); }
        if (hh == 0) {
            int* ep = EID + (size_t)t * 128 + h * 16; float* gp = GATE + (size_t)t * 128 + h * 16;
#pragma unroll
            for (int q = 0; q < 4; ++q) {
                *(GAS v4u*)(ep + 4 * q) = (v4u){(unsigned)ev[4 * q], (unsigned)ev[4 * q + 1], (unsigned)ev[4 * q + 2], (unsigned)ev[4 * q + 3]};
                *(GAS f32x4*)(gp + 4 * q) = (f32x4){gv[4 * q] * inv, gv[4 * q + 1] * inv, gv[4 * q + 2] * inv, gv[4 * q + 3] * inv}; }
        }
        asm volatile("s_waitcnt lgkmcnt(0)" ::: "memory");
    }
}

constexpr int GA_WAVE_BYTES = 6656, GA_CNT = 4096, GA_OFF = 4096 + 128, GA_ACT = 4608;
__device__ __forceinline__ int wave_sum_i(int v) { v += dppi<0xB1>(v); v += dppi<0x4E>(v); v += dppi<0x141>(v); v += dppi<0x140>(v);
    return (__builtin_amdgcn_readlane(v, 0) + __builtin_amdgcn_readlane(v, 16)) + (__builtin_amdgcn_readlane(v, 32) + __builtin_amdgcn_readlane(v, 48)); }
struct PairBuf { v4u u, v; float su, sv; int e; float g; };
__device__ __forceinline__ void p8_gather(Frame& F, float* outp) {
    const bf16* XN = (const bf16*)(F.ws + WS_XN);
    const unsigned char* UQ = F.ws + WS_UQ; const unsigned char* VQ = F.ws + WS_VQ;
    const float* SU = (const float*)(F.ws + WS_SU); const float* SV = (const float*)(F.ws + WS_SV);
    const int* EID = (const int*)(F.ws + WS_EID); const float* GATE = (const float*)(F.ws + WS_GATE);
    const float* nf = F.in[20];
    const int gw = F.wg * NWAVES + F.wave, NGW = F.G * NWAVES;
    LAS unsigned char* wl = F.lds + RING_OFF + F.wave * GA_WAVE_BYTES;
    for (int tg = gw, sweep = 0; tg < T / 4; tg += NGW, ++sweep) {
        int lane_ = F.lane; asm volatile("" : "+v"(lane_));
        const int lane = lane_;
        int xq[4][4]; float sx[4];
#pragma unroll
        for (int tk = 0; tk < 4; ++tk) {
            const GAS v4u* xp = (const GAS v4u*)(XN + (size_t)(4 * tg + tk) * DM + lane * 16);
            const v4u a = xp[0], b = xp[1];
            float x[16]; x[0] = bflo(a.x); x[1] = bfhi(a.x); x[2] = bflo(a.y); x[3] = bfhi(a.y); x[4] = bflo(a.z); x[5] = bfhi(a.z); x[6] = bflo(a.w); x[7] = bfhi(a.w);
            x[8] = bflo(b.x); x[9] = bfhi(b.x); x[10] = bflo(b.y); x[11] = bfhi(b.y); x[12] = bflo(b.z); x[13] = bfhi(b.z); x[14] = bflo(b.w); x[15] = bfhi(b.w);
            float am = 0.f;
#pragma unroll
            for (int i = 0; i < 16; ++i) am = fmaxf(am, fabsf(x[i]));
            am = wave_max(am);
            sx[tk] = am > 0.f ? am * (1.f / 127.f) : 1.f; const float inv = am > 0.f ? 127.f / am : 0.f;
#pragma unroll
            for (int q = 0; q < 4; ++q) {
                const unsigned b0 = (unsigned)(int)rintf(x[4 * q] * inv) & 255u, b1 = (unsigned)(int)rintf(x[4 * q + 1] * inv) & 255u, b2 = (unsigned)(int)rintf(x[4 * q + 2] * inv) & 255u, b3 = (unsigned)(int)rintf(x[4 * q + 3] * inv) & 255u;
                xq[tk][q] = (int)(b0 | (b1 << 8) | (b2 << 16) | (b3 << 24)); }
        }
        LAS unsigned* cnt = (LAS unsigned*)(wl + GA_CNT); LAS unsigned* offs = (LAS unsigned*)(wl + GA_OFF);
        if (lane < 32) cnt[lane] = 0u;
        asm volatile("s_waitcnt lgkmcnt(0)" ::: "memory");
        int ee[8]; float gg[8]; unsigned pos[8];
#pragma unroll
        for (int tk = 0; tk < 4; ++tk) {
            const size_t base = (size_t)(4 * tg + tk) * 128;
            ee[2 * tk] = (EID[base + lane] & (NEXP - 1)) | (tk << 14); ee[2 * tk + 1] = (EID[base + 64 + lane] & (NEXP - 1)) | (tk << 14);
            gg[2 * tk] = GATE[base + lane]; gg[2 * tk + 1] = GATE[base + 64 + lane]; }
#pragma unroll
        for (int q = 0; q < 8; ++q) pos[q] = __hip_atomic_fetch_add(cnt + ((ee[q] >> 9) & 31), 1u, __ATOMIC_RELAXED, __HIP_MEMORY_SCOPE_WAVEFRONT);
        asm volatile("s_waitcnt lgkmcnt(0)" ::: "memory");
        if (lane < 32) {
            const int c0 = (int)cnt[lane]; int v = c0;
            v += __builtin_amdgcn_update_dpp(0, v, 0x111, 0xF, 0xF, true); v += __builtin_amdgcn_update_dpp(0, v, 0x112, 0xF, 0xF, true);
            v += __builtin_amdgcn_update_dpp(0, v, 0x114, 0xF, 0xF, true); v += __builtin_amdgcn_update_dpp(0, v, 0x118, 0xF, 0xF, true);
            const int row0 = __builtin_amdgcn_readlane(v, 15);
            offs[lane] = (unsigned)(v - c0 + (lane >= 16 ? row0 : 0));
        }
        asm volatile("s_waitcnt lgkmcnt(0)" ::: "memory");
#pragma unroll
        for (int q = 0; q < 8; ++q) { const unsigned idx = offs[(ee[q] >> 9) & 31] + pos[q];
            *(LAS unsigned*)(wl + idx * 4) = (unsigned)ee[q]; *(LAS float*)(wl + 2048 + idx * 4) = gg[q]; }
        asm volatile("s_waitcnt lgkmcnt(0)" ::: "memory");
#define GA_DOT(U, TK) (__builtin_amdgcn_sdot4(xq[TK][3], (int)(U).w, __builtin_amdgcn_sdot4(xq[TK][2], (int)(U).z, __builtin_amdgcn_sdot4(xq[TK][1], (int)(U).y, __builtin_amdgcn_sdot4(xq[TK][0], (int)(U).x, 0, false), false), false), false))
        LAS float* act = (LAS float*)(wl + GA_ACT);
        for (int ch = 0; ch < 32; ++ch) {
            const unsigned ent = *(const LAS unsigned*)(wl + (ch * 16 + (lane >> 2)) * 4);
            const float my_g = *(const LAS float*)(wl + 2048 + (ch * 16 + (lane >> 2)) * 4);
            const int my_e = (int)ent & (NEXP - 1), my_tk = ((int)ent >> 14) & 3;
            const float my_su = SU[my_e], my_sv = SV[my_e];
            int d[16];
            {
                v4u ub[2][8]; int eb[2][8];
#pragma unroll
                for (int q = 0; q < 8; ++q) { eb[0][q] = __builtin_amdgcn_readlane((int)ent, 4 * q); ub[0][q] = *(const GAS v4u*)(UQ + (size_t)(eb[0][q] & (NEXP - 1)) * DM + lane * 16); }
#pragma unroll
                for (int jb = 0; jb < 2; ++jb) {
                    if (jb == 0) {
#pragma unroll
                        for (int q = 0; q < 8; ++q) { eb[1][q] = __builtin_amdgcn_readlane((int)ent, 4 * (8 + q)); ub[1][q] = *(const GAS v4u*)(UQ + (size_t)(eb[1][q] & (NEXP - 1)) * DM + lane * 16); } }
                    __builtin_amdgcn_sched_barrier(0);
#pragma unroll
                    for (int q = 0; q < 8; ++q) { const int tk_ = (eb[jb][q] >> 14) & 3; const v4u u_ = ub[jb][q]; int r_;
                        if (tk_ == 0) r_ = GA_DOT(u_, 0); else if (tk_ == 1) r_ = GA_DOT(u_, 1); else if (tk_ == 2) r_ = GA_DOT(u_, 2); else r_ = GA_DOT(u_, 3);
                        d[8 * jb + q] = r_; }
                    __builtin_amdgcn_sched_barrier(0);
                }
            }
#pragma unroll
            for (int j = 0; j < 8; ++j) { const auto r = __builtin_amdgcn_permlane32_swap((unsigned)d[j], (unsigned)d[j + 8], false, false); d[j] = (int)r[0] + (int)r[1]; }
#pragma unroll
            for (int j = 0; j < 4; ++j) { const auto r = __builtin_amdgcn_permlane16_swap((unsigned)d[j], (unsigned)d[j + 4], false, false); d[j] = (int)r[0] + (int)r[1]; }
#pragma unroll
            for (int j = 0; j < 2; ++j) { const int u_ = d[j] + dppi<0x128>(d[j]), w_ = d[j + 2] + dppi<0x128>(d[j + 2]); d[j] = (lane & 8) ? w_ : u_; }
            { const int u_ = d[0] + dppi<0x141>(d[0]), w_ = d[1] + dppi<0x141>(d[1]); d[0] = (lane & 4) ? w_ : u_; }
            d[0] += dppi<0x4E>(d[0]); d[0] += dppi<0xB1>(d[0]);
            const float sxl = my_tk == 0 ? sx[0] : (my_tk == 1 ? sx[1] : (my_tk == 2 ? sx[2] : sx[3]));
            const float h_ = (float)d[0] * (my_su * sxl);
            const float a_ = 0.5f * h_ * (1.f + erff(h_ * 0.70710678118654752f)) * my_g * my_sv;
            if ((lane & 3) == 0) act[ch * 16 + (lane >> 2)] = a_;
        }
#undef GA_DOT
        asm volatile("s_waitcnt lgkmcnt(0)" ::: "memory");
        float y[4][16]; float yo[4];
#pragma unroll
        for (int tk = 0; tk < 4; ++tk) { yo[tk] = 0.f;
#pragma unroll
            for (int i = 0; i < 16; ++i) y[tk][i] = 0.f; }
#define GA_AXPY(V, A, TK) do { yo[TK] += (A) * 128.f; \
            _Pragma("unroll") for (int q_ = 0; q_ < 4; ++q_) { const unsigned w_ = (V)[q_]; \
                y[TK][4 * q_] += (A) * (float)(w_ & 255u); y[TK][4 * q_ + 1] += (A) * (float)((w_ >> 8) & 255u); y[TK][4 * q_ + 2] += (A) * (float)((w_ >> 16) & 255u); y[TK][4 * q_ + 3] += (A) * (float)(w_ >> 24); } } while (0)
        for (int ch = 0; ch < 8; ++ch) {
            const unsigned ent = *(const LAS unsigned*)(wl + (ch * 64 + lane) * 4);
            const float areg = act[ch * 64 + lane];
            v4u vb[2][8]; int eb[2][8];
#pragma unroll
            for (int q = 0; q < 8; ++q) { eb[0][q] = __builtin_amdgcn_readlane((int)ent, q); vb[0][q] = *(const GAS v4u*)(VQ + (size_t)(eb[0][q] & (NEXP - 1)) * DM + lane * 16); }
#pragma unroll
            for (int jb = 0; jb < 8; ++jb) {
                if (jb + 1 < 8) {
#pragma unroll
                    for (int q = 0; q < 8; ++q) { eb[(jb + 1) & 1][q] = __builtin_amdgcn_readlane((int)ent, 8 * (jb + 1) + q); vb[(jb + 1) & 1][q] = *(const GAS v4u*)(VQ + (size_t)(eb[(jb + 1) & 1][q] & (NEXP - 1)) * DM + lane * 16); } }
                __builtin_amdgcn_sched_barrier(0);
#pragma unroll
                for (int q = 0; q < 8; ++q) { const int tk_ = (eb[jb & 1][q] >> 14) & 3; const v4u v_ = vb[jb & 1][q]; const float a_ = rdlane(areg, 8 * jb + q);
                    if (tk_ == 0) GA_AXPY(v_, a_, 0); else if (tk_ == 1) GA_AXPY(v_, a_, 1); else if (tk_ == 2) GA_AXPY(v_, a_, 2); else GA_AXPY(v_, a_, 3); }
                __builtin_amdgcn_sched_barrier(0);
            }
        }
#undef GA_AXPY
#pragma unroll
        for (int tk = 0; tk < 4; ++tk) {
            float* hrow = F.out + (size_t)(4 * tg + tk) * DM + lane * 16;
            float hv[16]; float ss = 0.f;
#pragma unroll
            for (int q = 0; q < 4; ++q) { const f32x4 h4 = *(const GAS f32x4*)(hrow + 4 * q);
#pragma unroll
                for (int i = 0; i < 4; ++i) { const float v = h4[i] + (y[tk][4 * q + i] - yo[tk]); hv[4 * q + i] = v; ss += v * v; } }
            const float rstd = frsq(wave_sum(ss) * (1.f / DM) + RMS_EPS);
#pragma unroll
            for (int q = 0; q < 4; ++q) { const f32x4 n4 = *(const GAS f32x4*)(nf + lane * 16 + 4 * q);
                *(GAS f32x4*)(outp + (size_t)(4 * tg + tk) * DM + lane * 16 + 4 * q) = (f32x4){hv[4 * q] * rstd * n4[0], hv[4 * q + 1] * rstd * n4[1], hv[4 * q + 2] * rstd * n4[2], hv[4 * q + 3] * rstd * n4[3]}; }
        }
    }
}

struct Args { const float* in[21]; float* out; unsigned char* ws; int ph_lo, ph_hi; };
static_assert(sizeof(Args) == 21 * 8 + 8 + 8 + 8, "Args has no padding");

__global__ void __launch_bounds__(NTHREADS, 2) fwd_kernel(Args args) {
    extern __shared__ __attribute__((aligned(16))) unsigned char lds[];
    Frame F;
    F.lds = (LAS unsigned char*)lds;
    F.MISC = (volatile LAS unsigned*)(F.lds + MISC_OFF);
    F.tid = threadIdx.x; F.lane = F.tid & 63; F.wave = __builtin_amdgcn_readfirstlane(F.tid >> 6);
    F.G = gridDim.x; F.wg = blockIdx.x;
#pragma unroll
    for (int i = 0; i < 21; ++i) F.in[i] = args.in[i];
    F.out = args.out; F.ws = args.ws;
    F.ctl = (gu32*)(args.ws + WS_CTL);
    for (int u = F.tid; u < (LDS_BYTES - LDSCTL_OFF) / 4; u += NTHREADS) ((LAS unsigned*)(F.lds + LDSCTL_OFF))[u] = 0u;
    __syncthreads();
    const int lo = args.ph_lo, hi = args.ph_hi;
    const bool fused = (hi - lo) > 1;
    XcdBarrier bar; bar.bar = (unsigned*)(F.ctl + CW_BAR); bar.x = 0; bar.st = nullptr;
    if (fused) bar = xcd_barrier_post((unsigned*)(F.ctl + CW_BAR), F.MISC + 8);
#define IN(k) (lo <= (k) && (k) < hi)
#define REPS(k) (((REP_MASK >> (k)) & 1) ? 2 : 1)
#define REPLOOP(k) for (int rep_ = 0; rep_ < REPS(k); ++rep_, (rep_ < REPS(k) ? xcd_barrier(bar) : (void)0))
#define SEAM(k) do { if (IN(k) && IN((k) + 1)) xcd_barrier(bar); } while (0)

    if (IN(0)) { REPLOOP(0) { p0_prologue(F); p0_rope_table(F); } SEAM(0); }
    if (IN(1)) { REPLOOP(1) {
        pg8::Gemm g{(const bf16*)(F.ws + WS_XN), (const bf16*)(F.ws + WS_WIN), T, IN_COLS, DM}; pg8::StaticOrder S; S.init(T, IN_COLS, F.G, F.wg);
        pg8::EpiBf16 E{(bf16*)(F.ws + WS_Z), IN_COLS};
        pg8::gemm_phase<pg8::EpiBf16, pg8::StaticOrder, true, true>(F.lds + RING_OFF, g, S, E); }
        SEAM(1);
    }
    if (IN(2)) { p2_rope(F); REPLOOP(2) { const int cnt = r13_count(F.wg, F.G); R1Pre P;
            if (cnt > 0) rwkv_r1_prefetch(F, r13_item(F.wg, F.G, 0), F.tid, P);
            for (int i = 0; i < cnt; ++i) rwkv_r1_item(F, r13_item(F.wg, F.G, i), i + 1 < cnt ? r13_item(F.wg, F.G, i + 1) : -1, P); }
        SEAM(2); }
    if (IN(3)) { REPLOOP(3) p3_mixers(F); SEAM(3); }
    if (IN(4)) { REPLOOP(4) for (int item = F.wg; item < NB * NHR * 128; item += F.G) rwkv_r3_item(F, item); SEAM(4); }
    if (IN(5)) { REPLOOP(5) {
        pg8::Gemm g{(const bf16*)(F.ws + WS_YMIX), (const bf16*)(F.ws + WS_WOUT), T, DM, DM}; pg8::StaticOrder S; S.init(T, DM, F.G, F.wg);
        pg8::EpiF32Res E{F.in[0], F.out, DM};
        pg8::gemm_phase<pg8::EpiF32Res, pg8::StaticOrder, true, true>(F.lds + RING_OFF, g, S, E); }
        SEAM(5);
    }
    if (IN(6)) { REPLOOP(6) p5_xn2(F); SEAM(6); }
    if (IN(7)) { REPLOOP(7) {
        pg8::Gemm g{(const bf16*)(F.ws + WS_XN), (const bf16*)(F.ws + WS_WQ), T, PQ, DM}; pg8::StaticOrder S; S.init(T, PQ, F.G, F.wg);
        pg8::EpiBf16 E{(bf16*)(F.ws + WS_QP), PQ};
        pg8::gemm_phase<pg8::EpiBf16, pg8::StaticOrder, true, true>(F.lds + RING_OFF, g, S, E); }
        SEAM(7);
    }
    if (IN(8)) { REPLOOP(8) p7_topk(F); SEAM(8); }
    if (IN(9)) { if (REPS(9) > 1) { p8_gather(F, (float*)(F.ws + WS_Z)); xcd_barrier(bar); } p8_gather(F, F.out); }
#undef IN
#undef SEAM
}

extern "C" void kernel_launch(void* const* d_in, const int* in_sizes, int n_in, void* d_out, int out_size, void* d_ws, size_t ws_size, hipStream_t stream) {
    static int grid = 0;
    if (grid == 0) {
        if (n_in != 21 || in_sizes[0] != T * DM || out_size != T * DM || ws_size < WS_END) {
            fprintf(stderr, "kernel_launch: unexpected shapes: n_in %d in0 %d out %d ws %zu (need %zu); nothing launched\n", n_in, n_in > 0 ? in_sizes[0] : -1, out_size, ws_size, (size_t)WS_END); grid = -1; return; }
        int dev = 0, cus = 0, per_cu = 0;
        if (hipGetDevice(&dev) != hipSuccess || hipDeviceGetAttribute(&cus, hipDeviceAttributeMultiprocessorCount, dev) != hipSuccess) { grid = -1; return; }
        if (hipFuncSetAttribute((const void*)fwd_kernel, hipFuncAttributeMaxDynamicSharedMemorySize, LDS_BYTES) != hipSuccess) { fprintf(stderr, "kernel_launch: hipFuncSetAttribute failed\n"); grid = -1; return; }
        if (hipOccupancyMaxActiveBlocksPerMultiprocessor(&per_cu, (const void*)fwd_kernel, NTHREADS, LDS_BYTES) != hipSuccess || per_cu < 1) { fprintf(stderr, "kernel_launch: occupancy query says %d\n", per_cu); per_cu = 1; }
        (void)hipGetLastError();
        grid = cus;
    }
    if (grid < 0) return;
    (void)hipMemsetAsync((char*)d_ws + WS_CTL, 0, CTL_ZERO_BYTES, stream);
    Args a{};
    for (int i = 0; i < 21; ++i) a.in[i] = (const float*)d_in[i];
    a.out = (float*)d_out; a.ws = (unsigned char*)d_ws;
    if (MK_N_LAUNCHES == 1) {
        a.ph_lo = 0; a.ph_hi = NPHASE;
        void* kargs[] = {&a};
        hipError_t e = hipLaunchCooperativeKernel((const void*)fwd_kernel, dim3(grid), dim3(NTHREADS), kargs, LDS_BYTES, stream);
        if (e != hipSuccess) fprintf(stderr, "kernel_launch: cooperative launch failed: %s (grid %d)\n", hipGetErrorString(e), grid);
    } else {
        for (int p = 0; p < NPHASE; ++p) { a.ph_lo = p; a.ph_hi = p + 1;
            hipLaunchKernelGGL(fwd_kernel, dim3(grid), dim3(NTHREADS), LDS_BYTES, stream, a); }
    }
}
```

```cpp
#include <hip/hip_runtime.h>
#include <cstdio>
#include <cstdint>

#ifndef MK_N_LAUNCHES
#define MK_N_LAUNCHES 1
#endif

#ifndef REP_MASK
#define REP_MASK 0
#endif
#define GAS __attribute__((address_space(1)))
#define LAS __attribute__((address_space(3)))
typedef unsigned short bf16;
typedef unsigned v4u __attribute__((ext_vector_type(4)));
typedef unsigned v2u __attribute__((ext_vector_type(2)));
typedef float f32x4 __attribute__((ext_vector_type(4)));
typedef float f32x2 __attribute__((ext_vector_type(2)));
typedef short bf16x8 __attribute__((ext_vector_type(8)));
typedef GAS unsigned gu32;
#define RLX_AGENT __ATOMIC_RELAXED, __HIP_MEMORY_SCOPE_AGENT
#define LDS_WAIT() asm volatile("s_waitcnt lgkmcnt(0)" ::: "memory")
#define VM_WAIT() asm volatile("s_waitcnt vmcnt(0)" ::: "memory")
#define LDS_BARRIER() do { asm volatile("s_waitcnt lgkmcnt(0)" ::: "memory"); __builtin_amdgcn_s_barrier(); asm volatile("" ::: "memory"); } while (0)

constexpr int DM = 1024, NB = 4, SEQ = 8192, T = NB * SEQ;
constexpr int HD = 64, RWW = 512, NHR = 8, NHA = 8;
constexpr int IN_COLS = 3328;
constexpr int C_R = 0, C_K = 512, C_V = 1024, C_WD = 1536, C_AD = 1600, C_GD = 1664, C_AQ = 1792, C_AK = 2304, C_AV = 2816;
constexpr int PHEADS = 8, NKEYS = 128, PQ = 2048, TOPK = 16, NEXP = 16384;
constexpr float RMS_EPS = 1e-6f, GN_EPS = 64e-5f;
constexpr int NWAVES = 8, NTHREADS = 512;
constexpr int NPHASE = 10;

constexpr size_t MiB = 1u << 20;
constexpr size_t WS_CTL = 0, CTL_ZERO_BYTES = 1 * MiB;
constexpr size_t WS_WIN = 2 * MiB;
constexpr size_t WS_WOUT = 10 * MiB;
constexpr size_t WS_WQ = 12 * MiB;
constexpr size_t WS_XN = 16 * MiB;
constexpr size_t WS_Z = 80 * MiB;
constexpr size_t WS_QP = 80 * MiB;
constexpr size_t WS_G = 288 * MiB;
constexpr size_t WS_YMIX = 352 * MiB;
constexpr size_t WS_UQ = 416 * MiB;
constexpr size_t WS_VQ = 432 * MiB;
constexpr size_t WS_SU = 448 * MiB;
constexpr size_t WS_SV = 449 * MiB;
constexpr size_t WS_EID = 480 * MiB;
constexpr size_t WS_GATE = 496 * MiB;
constexpr size_t WS_END = 512 * MiB;
constexpr size_t WS_WUPT = 1 * MiB, WS_AUPT = WS_WUPT + 65536, WS_GUPT = WS_AUPT + 65536;
constexpr size_t WS_BONUS = 9 * MiB;
constexpr size_t WS_RWY0 = WS_XN;
constexpr size_t WS_RWSS = WS_G;
constexpr size_t WS_RWRH = WS_EID;

constexpr int CW_BAR = 4096;

typedef __bf16 hbf16x2_t __attribute__((ext_vector_type(2)));
__device__ __forceinline__ unsigned pk2(float lo, float hi) { const f32x2 v = {lo, hi}; const hbf16x2_t b = __builtin_convertvector(v, hbf16x2_t); return __builtin_bit_cast(unsigned, b); }
__device__ __forceinline__ unsigned f2bf(float f) { return pk2(f, 0.f) & 0xffffu; }
__device__ __forceinline__ float frcp(float x) { return __builtin_amdgcn_rcpf(x); }
__device__ __forceinline__ float frsq(float x) { return __builtin_amdgcn_rsqf(x); }
__device__ __forceinline__ float bflo(unsigned u) { return __builtin_bit_cast(float, u << 16); }
__device__ __forceinline__ float bfhi(unsigned u) { return __builtin_bit_cast(float, u & 0xffff0000u); }
__device__ __forceinline__ float bf2f(bf16 h) { return __builtin_bit_cast(float, (unsigned)h << 16); }

template <int CTRL> __device__ __forceinline__ float dppf(float x) { return __builtin_bit_cast(float, __builtin_amdgcn_update_dpp(0, __builtin_bit_cast(int, x), CTRL, 0xF, 0xF, true)); }
template <int CTRL> __device__ __forceinline__ int dppi(int x) { return __builtin_amdgcn_update_dpp(0, x, CTRL, 0xF, 0xF, true); }
__device__ __forceinline__ float rdlane(float v, int l) { return __builtin_bit_cast(float, __builtin_amdgcn_readlane(__builtin_bit_cast(int, v), l)); }
__device__ __forceinline__ float sum8(float v) { v += dppf<0xB1>(v); v += dppf<0x4E>(v); v += dppf<0x141>(v); return v; }
__device__ __forceinline__ float sum16(float v) { v = sum8(v); v += dppf<0x140>(v); return v; }
__device__ __forceinline__ float wave_sum(float v) { v = sum16(v);
    v += __builtin_bit_cast(float, __builtin_amdgcn_update_dpp(0, __builtin_bit_cast(int, v), 0x142, 0xA, 0xF, false));
    v += __builtin_bit_cast(float, __builtin_amdgcn_update_dpp(0, __builtin_bit_cast(int, v), 0x143, 0xC, 0xF, false));
    return rdlane(v, 63); }
__device__ __forceinline__ float wave_max(float v) {
    v = fmaxf(v, dppf<0xB1>(v)); v = fmaxf(v, dppf<0x4E>(v)); v = fmaxf(v, dppf<0x141>(v)); v = fmaxf(v, dppf<0x140>(v));
    return fmaxf(fmaxf(rdlane(v, 0), rdlane(v, 16)), fmaxf(rdlane(v, 32), rdlane(v, 48)));
}
__device__ __forceinline__ int wave_min_i(int v) {
    v = min(v, dppi<0xB1>(v)); v = min(v, dppi<0x4E>(v)); v = min(v, dppi<0x141>(v)); v = min(v, dppi<0x140>(v));
    return min(min(__builtin_amdgcn_readlane(v, 0), __builtin_amdgcn_readlane(v, 16)), min(__builtin_amdgcn_readlane(v, 32), __builtin_amdgcn_readlane(v, 48)));
}

namespace pg8 {
#define PG8_LAS __attribute__((address_space(3)))
typedef unsigned short bf16_t;
typedef unsigned u32x4 __attribute__((ext_vector_type(4)));
constexpr int BM = 256, BK = 64, HALF = 128, HTB = HALF * BK * 2, STAGE_BYTES = 8 * HTB, NXCD = 8, WGM = 8;
__host__ __device__ __forceinline__ int lds_byte(int r, int c) { const int st = (r >> 4) * 2 + (c >> 5), rr = r & 15, cc = c & 31, ob = rr * 64 + cc * 2; return st * 1024 + (ob ^ (((ob >> 9) & 1) << 5)); }
__host__ __device__ __forceinline__ void stage_rc(int b, int& R, int& C) { const int st = b / 1024, sb = b % 1024, swz = sb ^ (((sb >> 9) & 1) << 5); R = (st >> 1) * 16 + swz / 64; C = (st & 1) * 32 + (swz % 64) / 2; }
__host__ __device__ __forceinline__ int perm32(int rho) { const int n = rho >> 4, i = rho & 15; return 8 * (i >> 2) + 4 * n + (i & 3); }
struct Unit { int pm, pn; };
struct Gemm { const bf16_t* A; const bf16_t* Bt; int M, N, K; };
struct StaticOrder {
    int nM, nN, nwg, G, c;
    __host__ __device__ void init(int M, int N, int G_, int c_) { nM = M / BM; nN = N / BM; nwg = nM * nN; G = G_; c = c_; }
    __host__ __device__ bool next(int i, Unit& u) const {
        const long L = (long)i * G + c; if (L >= nwg) return false;
        int wgid = (int)L; { const int q = nwg / NXCD, r = nwg % NXCD, xcd = wgid % NXCD, off = wgid / NXCD; wgid = (xcd < r ? xcd * (q + 1) : r * (q + 1) + (xcd - r) * q) + off; }
        const int nig = WGM * nN, gid = wgid / nig, fm = gid * WGM, gsz = (nM - fm) < WGM ? (nM - fm) : WGM;
        u.pm = fm + ((wgid % nig) % gsz); u.pn = (wgid % nig) / gsz; return true;
    }
    __device__ __forceinline__ void a_ready(const Unit&) const {}
    __device__ __forceinline__ void done(const Unit&) const {}
};
__device__ __forceinline__ unsigned cvt_pk_bf16(float lo, float hi) { unsigned r; asm volatile("v_cvt_pk_bf16_f32 %0, %1, %2" : "=v"(r) : "v"(lo), "v"(hi)); return r; }
struct EpiBf16 {
    static constexpr bool PERM = true, AFTER_DRAIN = false;
    bf16_t* O; int ldc;
    __device__ __forceinline__ void operator()(const f32x4 (&acc)[2][2][4][2], const Unit& u, int wr, int wc, int fr, int fq) const {
        const int row0 = u.pm * BM + wr * 64 + fr; const int col0 = u.pn * BM + wc * 32 + 8 * fq;
#pragma unroll
        for (int ai = 0; ai < 2; ++ai)
#pragma unroll
            for (int m = 0; m < 4; ++m) { bf16_t* rowp = O + (size_t)(row0 + ai * HALF + m * 16) * ldc + col0;
#pragma unroll
                for (int bj = 0; bj < 2; ++bj) { const f32x4 v0 = acc[ai][bj][m][0], v1 = acc[ai][bj][m][1];
                    u32x4 w; w.x = cvt_pk_bf16(v0[0], v0[1]); w.y = cvt_pk_bf16(v0[2], v0[3]); w.z = cvt_pk_bf16(v1[0], v1[1]); w.w = cvt_pk_bf16(v1[2], v1[3]);
                    *(u32x4*)(rowp + bj * HALF) = w; } }
    }
};
struct EpiF32Res {
    static constexpr bool PERM = true, AFTER_DRAIN = false;
    const float* res; float* O; int ldc;
    __device__ __forceinline__ void operator()(const f32x4 (&acc)[2][2][4][2], const Unit& u, int wr, int wc, int fr, int fq) const {
        const int row0 = u.pm * BM + wr * 64 + fr; const int col0 = u.pn * BM + wc * 32 + 8 * fq;
#pragma unroll
        for (int ai = 0; ai < 2; ++ai)
#pragma unroll
            for (int m = 0; m < 4; ++m) { const size_t off = (size_t)(row0 + ai * HALF + m * 16) * ldc + col0;
#pragma unroll
                for (int bj = 0; bj < 2; ++bj) { const f32x4 r0 = *(const f32x4*)(res + off + bj * HALF), r1 = *(const f32x4*)(res + off + bj * HALF + 4);
                    *(f32x4*)(O + off + bj * HALF) = acc[ai][bj][m][0] + r0; *(f32x4*)(O + off + bj * HALF + 4) = acc[ai][bj][m][1] + r1; } }
    }
};

template <class Epi, class Sched, bool ALIGN_EPI = false, bool SP2 = false>
__device__ __forceinline__ void gemm_phase(PG8_LAS unsigned char* lds, const Gemm g, const Sched& S, const Epi& E) {
    const int tid = threadIdx.x, wid = __builtin_amdgcn_readfirstlane(tid >> 6), lane = tid & 63, wr = wid >> 2, wc = wid & 3, fr = lane & 15, fq = lane >> 4;
    const int K = g.K, nt = K / BK;
    unsigned voffA[2], voffB[2];
#pragma unroll
    for (int i = 0; i < 2; ++i) { int R, C; stage_rc(tid * 16 + i * 8192, R, C); const int Rb = Epi::PERM ? ((R & ~31) + perm32(R & 31)) : R;
        voffA[i] = (unsigned)(R * K + C) * 2u; voffB[i] = (unsigned)(Rb * K + C) * 2u; }
    const size_t kstep = (size_t)(BK * 2);
    const size_t hstep = (size_t)HALF * K * 2;
    const size_t tstep = 2 * hstep;
    const unsigned ldsw = (unsigned)wid * 1024u;
    const int aoff = lds_byte(wr * 64 + fr, fq * 8), boff = lds_byte(wc * 32 + fr, fq * 8);
#define PG8_SA(b, h) (((b) * 2 + (h)) * HTB)
#define PG8_SB(b, h) ((4 + (b) * 2 + (h)) * HTB)
#define PG8_STAGE(bufoff, gbase, voff) do { _Pragma("unroll") for (int _i = 0; _i < 2; ++_i) \
        __builtin_amdgcn_global_load_lds((const unsigned*)((const char*)(gbase) + (voff)[_i]), (PG8_LAS unsigned*)(lds + (bufoff) + ldsw + _i * 8192), 16, 0, 0); } while (0)
#define PG8_LDA(dst, b, h) do { _Pragma("unroll") for (int m = 0; m < 4; ++m) _Pragma("unroll") for (int k = 0; k < 2; ++k) dst[m][k] = *(const PG8_LAS bf16x8*)(lds + PG8_SA(b, h) + aoff + m * 2048 + k * 1024); } while (0)
#define PG8_LDB(dst, b, h) do { _Pragma("unroll") for (int n = 0; n < 2; ++n) _Pragma("unroll") for (int k = 0; k < 2; ++k) dst[n][k] = *(const PG8_LAS bf16x8*)(lds + PG8_SB(b, h) + boff + n * 2048 + k * 1024); } while (0)
#define PG8_MMA(ai, bj, At, Bt) do { __builtin_amdgcn_s_setprio(1); _Pragma("unroll") for (int m = 0; m < 4; ++m) _Pragma("unroll") for (int n = 0; n < 2; ++n) _Pragma("unroll") for (int k = 0; k < 2; ++k) \
        acc[ai][bj][m][n] = __builtin_amdgcn_mfma_f32_16x16x32_bf16(Bt[n][k], At[m][k], acc[ai][bj][m][n], 0, 0, 0); __builtin_amdgcn_s_setprio(0); } while (0)
#define PG8_WAIT_V(n) asm volatile("s_waitcnt vmcnt(" #n ")" ::: "memory")
#define PG8_WAIT_L(n) asm volatile("s_waitcnt lgkmcnt(" #n ")" ::: "memory")
#define PG8_BAR __builtin_amdgcn_s_barrier()
#define PG8_SCHED __builtin_amdgcn_sched_barrier(0)
    Unit cur, nxt; int ui = 0;
    if (!S.next(0, cur)) return;
    f32x4 acc[2][2][4][2];
#pragma unroll
    for (int a = 0; a < 2; ++a)
#pragma unroll
        for (int b = 0; b < 2; ++b)
#pragma unroll
            for (int m = 0; m < 4; ++m)
#pragma unroll
                for (int n = 0; n < 2; ++n) acc[a][b][m][n] = (f32x4){0.f, 0.f, 0.f, 0.f};
    bf16x8 At[4][2], B0[2][2], B1[2][2];
    const char* cA = (const char*)g.A + (size_t)cur.pm * tstep; const char* cB = (const char*)g.Bt + (size_t)cur.pn * tstep;
    S.a_ready(cur);
    if constexpr (SP2) {
        PG8_STAGE(PG8_SB(0, 0), cB, voffB); PG8_STAGE(PG8_SB(0, 1), cB + hstep, voffB); PG8_STAGE(PG8_SA(0, 0), cA, voffA); PG8_STAGE(PG8_SA(0, 1), cA + hstep, voffA);
        if (wr == 1) PG8_BAR;
        PG8_WAIT_V(2); PG8_BAR;
        PG8_STAGE(PG8_SB(1, 0), cB + kstep, voffB); PG8_STAGE(PG8_SA(1, 0), cA + kstep, voffA); PG8_STAGE(PG8_SB(1, 1), cB + hstep + kstep, voffB);
        PG8_WAIT_V(6); PG8_BAR;
    } else {
        PG8_STAGE(PG8_SB(0, 0), cB, voffB); PG8_STAGE(PG8_SA(0, 0), cA, voffA); PG8_STAGE(PG8_SB(0, 1), cB + hstep, voffB); PG8_STAGE(PG8_SA(0, 1), cA + hstep, voffA);
        if (wr == 1) PG8_BAR;
        PG8_WAIT_V(4); PG8_BAR;
        PG8_STAGE(PG8_SB(1, 0), cB + kstep, voffB); PG8_STAGE(PG8_SA(1, 0), cA + kstep, voffA); PG8_STAGE(PG8_SB(1, 1), cB + hstep + kstep, voffB);
        PG8_WAIT_V(6); PG8_BAR;
    }
    for (;;) {
        const bool has_next = S.next(ui + 1, nxt);
        const char* nA = has_next ? (const char*)g.A + (size_t)nxt.pm * tstep : cA; const char* nB = has_next ? (const char*)g.Bt + (size_t)nxt.pn * tstep : cB;
        for (int t = 0; t < nt; t += 2) {
            const bool last = (t == nt - 2);
            const char* a1 = cA + (size_t)(t + 1) * kstep;
            const char* a2 = last ? nA : cA + (size_t)(t + 2) * kstep; const char* b2 = last ? nB : cB + (size_t)(t + 2) * kstep;
            const char* a3 = a2 + kstep; const char* b3 = b2 + kstep;
            if (last && has_next) S.a_ready(nxt);
            if constexpr (SP2) {
            PG8_LDB(B0, 0, 0); PG8_LDB(B1, 0, 1); PG8_SCHED; PG8_LDA(At, 0, 0); PG8_STAGE(PG8_SA(1, 1), a1 + hstep, voffA);
            PG8_WAIT_V(8); PG8_WAIT_L(0); PG8_BAR; PG8_MMA(0, 0, At, B0); PG8_MMA(0, 1, At, B1); PG8_BAR; PG8_SCHED;
            PG8_LDA(At, 0, 1); PG8_STAGE(PG8_SB(0, 0), b2, voffB); PG8_STAGE(PG8_SB(0, 1), b2 + hstep, voffB); PG8_STAGE(PG8_SA(0, 0), a2, voffA);
            PG8_WAIT_V(8); PG8_WAIT_L(0); PG8_BAR; PG8_MMA(1, 0, At, B0); PG8_MMA(1, 1, At, B1); PG8_BAR; PG8_SCHED;
            PG8_LDB(B0, 1, 0); PG8_LDB(B1, 1, 1); PG8_SCHED; PG8_LDA(At, 1, 0); PG8_STAGE(PG8_SA(0, 1), a2 + hstep, voffA);
            PG8_WAIT_V(8); PG8_WAIT_L(0); PG8_BAR; PG8_MMA(0, 0, At, B0); PG8_MMA(0, 1, At, B1); PG8_BAR; PG8_SCHED;
            PG8_LDA(At, 1, 1); PG8_STAGE(PG8_SB(1, 0), b3, voffB); PG8_STAGE(PG8_SB(1, 1), b3 + hstep, voffB); PG8_STAGE(PG8_SA(1, 0), a3, voffA);
            PG8_WAIT_V(8); PG8_WAIT_L(0); PG8_BAR; PG8_MMA(1, 0, At, B0); PG8_MMA(1, 1, At, B1); PG8_BAR; PG8_SCHED;
            } else {
            PG8_LDB(B0, 0, 0); PG8_SCHED; PG8_LDA(At, 0, 0); PG8_STAGE(PG8_SA(1, 1), a1 + hstep, voffA);
            PG8_WAIT_L(8); PG8_BAR; PG8_WAIT_L(0); PG8_MMA(0, 0, At, B0); PG8_BAR; PG8_SCHED;
            PG8_LDB(B1, 0, 1); PG8_STAGE(PG8_SB(0, 0), b2, voffB);
            PG8_BAR; PG8_WAIT_L(0); PG8_MMA(0, 1, At, B1); PG8_BAR;
            PG8_LDA(At, 0, 1); PG8_STAGE(PG8_SA(0, 0), a2, voffA);
            PG8_BAR; PG8_WAIT_L(0); PG8_MMA(1, 0, At, B0); PG8_BAR; PG8_SCHED;
            PG8_STAGE(PG8_SB(0, 1), b2 + hstep, voffB);
            PG8_WAIT_V(6); PG8_BAR; PG8_MMA(1, 1, At, B1); PG8_BAR;
            PG8_LDB(B0, 1, 0); PG8_SCHED; PG8_LDA(At, 1, 0); PG8_STAGE(PG8_SA(0, 1), a2 + hstep, voffA);
            PG8_WAIT_L(8); PG8_BAR; PG8_WAIT_L(0); PG8_MMA(0, 0, At, B0); PG8_BAR; PG8_SCHED;
            PG8_LDB(B1, 1, 1); PG8_STAGE(PG8_SB(1, 0), b3, voffB);
            PG8_BAR; PG8_WAIT_L(0); PG8_MMA(0, 1, At, B1); PG8_BAR;
            PG8_LDA(At, 1, 1); PG8_STAGE(PG8_SA(1, 0), a3, voffA);
            PG8_BAR; PG8_WAIT_L(0); PG8_MMA(1, 0, At, B0); PG8_BAR; PG8_SCHED;
            PG8_STAGE(PG8_SB(1, 1), b3 + hstep, voffB);
            PG8_WAIT_V(6); PG8_BAR; PG8_MMA(1, 1, At, B1); PG8_BAR;
            }
        }
        if constexpr (ALIGN_EPI) { if (wr == 0) PG8_BAR; }
        if constexpr (!Epi::AFTER_DRAIN) { E(acc, cur, wr, wc, fr, fq); S.done(cur); }
        if (!has_next) break;
#pragma unroll
        for (int a = 0; a < 2; ++a)
#pragma unroll
            for (int b = 0; b < 2; ++b)
#pragma unroll
                for (int m = 0; m < 4; ++m)
#pragma unroll
                    for (int n = 0; n < 2; ++n) acc[a][b][m][n] = (f32x4){0.f, 0.f, 0.f, 0.f};
        cur = nxt; cA = nA; cB = nB; ++ui;
        if constexpr (ALIGN_EPI) { if (wr == 1) PG8_BAR; }
    }
    PG8_WAIT_V(0);
    if constexpr (!ALIGN_EPI) { if (wr == 0) PG8_BAR; }
    PG8_BAR;
#undef PG8_SA
#undef PG8_SB
#undef PG8_STAGE
#undef PG8_LDA
#undef PG8_LDB
#undef PG8_MMA
#undef PG8_WAIT_V
#undef PG8_WAIT_L
#undef PG8_BAR
#undef PG8_SCHED
}
}

#define XB_TMO      128
#define XB_XCNT(j)  (256  + 64 * (j))
#define XB_XSUB(j)  (1280 + 64 * (j))
#define XB_XGEN(j)  (2304 + 64 * (j))
#define XB_TOP      3328
#define XB_TOPGEN   3392
#define XCD_BAR_WORDS 3456
#define XB_SPIN_CAP (1u << 22)
__device__ __forceinline__ unsigned xb_ld(unsigned* p)              { return __hip_atomic_load(p, __ATOMIC_RELAXED, __HIP_MEMORY_SCOPE_AGENT); }
__device__ __forceinline__ unsigned xb_add(unsigned* p, unsigned v) { return __hip_atomic_fetch_add(p, v, __ATOMIC_RELAXED, __HIP_MEMORY_SCOPE_AGENT); }
__device__ __forceinline__ unsigned xb_xcc_id() { return (unsigned)__builtin_amdgcn_s_getreg((3 << 11) | 20) & 0xFu; }
#define XB_SPIN(cond, bar) do { unsigned _sp = 0; while (cond) { __builtin_amdgcn_s_sleep(1); \
    if ((++_sp & 255u) == 0u) { if (xb_ld(&(bar)[XB_TMO])) break; if (_sp > XB_SPIN_CAP) { atomicAdd(&(bar)[XB_TMO], 1u); break; } } } } while (0)
struct XcdBarrier { unsigned* bar; unsigned x; volatile LAS unsigned* st; };
__device__ __forceinline__ XcdBarrier xcd_barrier_post(unsigned* bar, volatile LAS unsigned* st) {
    XcdBarrier b; b.bar = bar; b.x = xb_xcc_id(); b.st = st;
    if (threadIdx.x == 0) (void)xb_add(&bar[XB_XCNT(b.x)], 1u);
    return b;
}
__device__ __forceinline__ void xcd_barrier_complete(unsigned* bar, unsigned x, unsigned& nloc, unsigned& nx) {
    const unsigned G = gridDim.x * gridDim.y * gridDim.z;
    unsigned sum, cnt, mine, sp = 0u;
    for (;;) {
        sum = 0u; cnt = 0u; mine = 0u;
#pragma unroll
        for (unsigned j = 0; j < 16; ++j) { const unsigned c = xb_ld(&bar[XB_XCNT(j)]); sum += c; cnt += (c > 0u) ? 1u : 0u; mine = (j == x) ? c : mine; }
        if (sum == G) break;
        __builtin_amdgcn_s_sleep(1);
        if ((++sp & 255u) == 0u) { if (xb_ld(&bar[XB_TMO])) break; if (sp > XB_SPIN_CAP) { atomicAdd(&bar[XB_TMO], 1u); break; } }
    }
    nloc = mine > 0u ? mine : 1u; nx = cnt > 0u ? cnt : 1u;
}
__device__ __forceinline__ void xcd_barrier(const XcdBarrier& b) {
    asm volatile("s_waitcnt vmcnt(0)" ::: "memory");
    __syncthreads();
    if (threadIdx.x == 0) {
        unsigned* bar = b.bar;
        __builtin_amdgcn_s_waitcnt(0);
        unsigned nloc = b.st[0], nx = b.st[1];
        if (nloc == 0u) { xcd_barrier_complete(bar, b.x, nloc, nx); b.st[0] = nloc; b.st[1] = nx; }
        const unsigned old = xb_add(&bar[XB_XSUB(b.x)], 1u);
        const unsigned gen = old / nloc;
        if (old + 1u == (gen + 1u) * nloc) {
            __builtin_amdgcn_fence(__ATOMIC_RELEASE, "agent");
            asm volatile("s_waitcnt vmcnt(0)" ::: "memory");
            const unsigned og = xb_add(&bar[XB_TOP], 1u);
            const unsigned tg = og / nx;
            if (og + 1u == (tg + 1u) * nx) xb_add(&bar[XB_TOPGEN], 1u);
            else XB_SPIN(xb_ld(&bar[XB_TOPGEN]) == tg, bar);
            __builtin_amdgcn_fence(__ATOMIC_ACQUIRE, "agent");
            xb_add(&bar[XB_XGEN(b.x)], 1u);
            asm volatile("s_waitcnt vmcnt(0)" ::: "memory");
        } else {
            XB_SPIN(xb_ld(&bar[XB_XGEN(b.x)]) == gen, bar);
            __builtin_amdgcn_fence(__ATOMIC_ACQUIRE, "agent");
            asm volatile("s_waitcnt vmcnt(0)" ::: "memory");
        }
    }
    __syncthreads();
}

constexpr int RING_OFF = 0, RING_BYTES = 131072;
constexpr int LDSCTL_OFF = 162816, MISC_OFF = LDSCTL_OFF + 320;
constexpr int LDS_BYTES = 163840;

struct Frame {
    LAS unsigned char* lds;
    volatile LAS unsigned* MISC;
    gu32* ctl;
    int tid, lane, wave, G, wg;
    const float* in[21];
    float* out;
    unsigned char* ws;
};

__device__ __forceinline__ void p0_transpose_item(const float* W, int K, int N, bf16* WT, LAS float* scr, int item, int lane) {
    const int nblk = N / 32, kb = item / nblk, nb = item % nblk, k0 = 64 * kb, n0 = 32 * nb;
#pragma unroll 8
    for (int i = 0; i < 32; ++i) { const int kk = 2 * i + (lane >> 5); scr[kk * 33 + (lane & 31)] = W[(size_t)(k0 + kk) * N + n0 + (lane & 31)]; }
    LDS_WAIT(); asm volatile("" ::: "memory");
    const int c = lane & 7;
#pragma unroll
    for (int j = 0; j < 4; ++j) { const int n = (lane >> 3) + 8 * j; const LAS float* s = scr + (8 * c) * 33 + n;
        v4u o; o.x = pk2(s[0 * 33], s[1 * 33]); o.y = pk2(s[2 * 33], s[3 * 33]); o.z = pk2(s[4 * 33], s[5 * 33]); o.w = pk2(s[6 * 33], s[7 * 33]);
        *(GAS v4u*)(WT + (size_t)(n0 + n) * K + k0 + 8 * c) = o; }
    LDS_WAIT(); asm volatile("" ::: "memory");
}
__device__ __forceinline__ void rms_row_to_bf16(int lane, const float* xrow, const float* gain, bf16* orow) {
    const GAS f32x4* xr = (const GAS f32x4*)xrow + lane;
    const GAS f32x4* gr = (const GAS f32x4*)gain + lane;
    f32x4 v[4]; float s = 0.f;
#pragma unroll
    for (int j = 0; j < 4; ++j) { v[j] = xr[64 * j]; s += (v[j].x * v[j].x + v[j].y * v[j].y) + (v[j].z * v[j].z + v[j].w * v[j].w); }
    const float rstd = frsq(wave_sum(s) * (1.f / DM) + RMS_EPS);
    GAS unsigned long long* o8 = (GAS unsigned long long*)orow + lane;
#pragma unroll
    for (int j = 0; j < 4; ++j) { const f32x4 gg = gr[64 * j];
        o8[64 * j] = (unsigned long long)pk2(v[j].x * rstd * gg.x, v[j].y * rstd * gg.y) | ((unsigned long long)pk2(v[j].z * rstd * gg.z, v[j].w * rstd * gg.w) << 32); }
}
__device__ __forceinline__ void cvt_row_to_bf16(int lane, const float* xrow, bf16* orow) {
    const GAS f32x4* xr = (const GAS f32x4*)xrow + lane;
    GAS unsigned long long* o8 = (GAS unsigned long long*)orow + lane;
#pragma unroll
    for (int j = 0; j < 4; ++j) { const f32x4 v = xr[64 * j]; o8[64 * j] = (unsigned long long)pk2(v.x, v.y) | ((unsigned long long)pk2(v.z, v.w) << 32); }
}
__device__ __forceinline__ void p0_prologue(Frame& F) {
    LAS float* scr = (LAS float*)(F.lds + RING_OFF + F.wave * 16384);
    const int gw = F.wg * NWAVES + F.wave, NGW = F.G * NWAVES;
    constexpr int I_IN = (DM / 64) * (IN_COLS / 32), I_OUT = (DM / 64) * (DM / 32), I_Q = (DM / 64) * (PQ / 32);
    constexpr int NITEMS = I_IN + I_OUT + I_Q;
    bf16* win_t = (bf16*)(F.ws + WS_WIN); bf16* wout_t = (bf16*)(F.ws + WS_WOUT); bf16* wq_t = (bf16*)(F.ws + WS_WQ);
    for (int it = gw; it < NITEMS; it += NGW) {
        int r = it;
        if (r < I_IN) { p0_transpose_item(F.in[2], DM, IN_COLS, win_t, scr, r, F.lane); continue; } r -= I_IN;
        if (r < I_OUT) { p0_transpose_item(F.in[14], DM, DM, wout_t, scr, r, F.lane); continue; } r -= I_OUT;
        p0_transpose_item(F.in[16], DM, PQ, wq_t, scr, r, F.lane);
    }
    {
        constexpr int I_W = (64 / 64) * (RWW / 32), I_G = (128 / 64) * (RWW / 32);
        for (int it = gw; it < 2 * I_W + I_G; it += NGW) {
            int r = it;
            if (r < I_W) { p0_transpose_item(F.in[5], 64, RWW, (bf16*)(F.ws + WS_WUPT), scr, r, F.lane); continue; } r -= I_W;
            if (r < I_W) { p0_transpose_item(F.in[7], 64, RWW, (bf16*)(F.ws + WS_AUPT), scr, r, F.lane); continue; } r -= I_W;
            p0_transpose_item(F.in[8], 128, RWW, (bf16*)(F.ws + WS_GUPT), scr, r, F.lane);
        }
    }
    bf16* XN = (bf16*)(F.ws + WS_XN);
    for (int m = gw; m < T; m += NGW) rms_row_to_bf16(F.lane, F.in[0] + (size_t)m * DM, F.in[1], XN + (size_t)m * DM);
    for (int m = gw; m < 2 * NEXP; m += NGW) {
        const int tab = m >= NEXP, row = tab ? m - NEXP : m;
        const GAS f32x4* xr = (const GAS f32x4*)(F.in[18 + tab] + (size_t)row * DM) + F.lane * 4;
        f32x4 v[4]; float am = 0.f;
#pragma unroll
        for (int j = 0; j < 4; ++j) { v[j] = xr[j]; am = fmaxf(am, fmaxf(fmaxf(fabsf(v[j].x), fabsf(v[j].y)), fmaxf(fabsf(v[j].z), fabsf(v[j].w)))); }
        am = wave_max(am);
        const float sc = am > 0.f ? am * (1.f / 127.f) : 1.f, inv = am > 0.f ? 127.f / am : 0.f;
        v4u o;
#pragma unroll
        for (int j = 0; j < 4; ++j) {
            const int bias = tab ? 128 : 0;
            const unsigned b0 = (unsigned)((int)rintf(v[j].x * inv) + bias) & 255u, b1 = (unsigned)((int)rintf(v[j].y * inv) + bias) & 255u,
                           b2 = (unsigned)((int)rintf(v[j].z * inv) + bias) & 255u, b3 = (unsigned)((int)rintf(v[j].w * inv) + bias) & 255u;
            o[j] = b0 | (b1 << 8) | (b2 << 16) | (b3 << 24); }
        *(GAS v4u*)(F.ws + (tab ? WS_VQ : WS_UQ) + (size_t)row * DM + F.lane * 16) = o;
        if (F.lane == 0) ((float*)(F.ws + (tab ? WS_SV : WS_SU)))[row] = sc;
    }
}

constexpr size_t WS_ROPE = WS_G;
__device__ __forceinline__ void p0_rope_table(Frame& F) {
    f32x2* tab = (f32x2*)(F.ws + WS_ROPE);
    for (int e = F.wg * NTHREADS + F.tid; e < SEQ * 32; e += F.G * NTHREADS) {
        const int sp = e >> 5, i = e & 31;
        const float inv_freq = powf(10000.0f, -(float)(2 * i) / 64.0f);
        const float ang = (float)sp * inv_freq;
        const double r = (double)ang - rint((double)ang * 0.15915494309189535) * 6.283185307179586;
        const float rf = (float)r;
        tab[e] = (f32x2){cosf(rf), sinf(rf)};
    }
}
__device__ __forceinline__ void p2_rope(Frame& F) {
    bf16* Z = (bf16*)(F.ws + WS_Z);
    const f32x2* tab = (const f32x2*)(F.ws + WS_ROPE);
    const int tid = F.tid, tk = tid >> 6, grp = (tid >> 2) & 15, i0 = (tid & 3) * 8;
    for (int blk = F.wg; blk < T / 8; blk += F.G) {
        const int g = blk * 8 + tk, sp = g & (SEQ - 1);
        bf16* p = Z + (size_t)g * IN_COLS + C_AQ + grp * 64 + i0;
        const v4u a = *(const GAS v4u*)p, b = *(const GAS v4u*)(p + 32);
        const GAS f32x4* tp = (const GAS f32x4*)(tab + sp * 32 + i0);
        float x1[8], x2[8];
        x1[0] = bflo(a.x); x1[1] = bfhi(a.x); x1[2] = bflo(a.y); x1[3] = bfhi(a.y); x1[4] = bflo(a.z); x1[5] = bfhi(a.z); x1[6] = bflo(a.w); x1[7] = bfhi(a.w);
        x2[0] = bflo(b.x); x2[1] = bfhi(b.x); x2[2] = bflo(b.y); x2[3] = bfhi(b.y); x2[4] = bflo(b.z); x2[5] = bfhi(b.z); x2[6] = bflo(b.w); x2[7] = bfhi(b.w);
        float o1[8], o2[8];
#pragma unroll
        for (int q = 0; q < 4; ++q) { const f32x4 cs = tp[q];
            o1[2 * q] = x1[2 * q] * cs[0] - x2[2 * q] * cs[1]; o2[2 * q] = x1[2 * q] * cs[1] + x2[2 * q] * cs[0];
            o1[2 * q + 1] = x1[2 * q + 1] * cs[2] - x2[2 * q + 1] * cs[3]; o2[2 * q + 1] = x1[2 * q + 1] * cs[3] + x2[2 * q + 1] * cs[2]; }
        v4u oa, ob; oa.x = pk2(o1[0], o1[1]); oa.y = pk2(o1[2], o1[3]); oa.z = pk2(o1[4], o1[5]); oa.w = pk2(o1[6], o1[7]);
        ob.x = pk2(o2[0], o2[1]); ob.y = pk2(o2[2], o2[3]); ob.z = pk2(o2[4], o2[5]); ob.w = pk2(o2[6], o2[7]);
        *(GAS v4u*)p = oa; *(GAS v4u*)(p + 32) = ob;
    }
}

typedef float f32x16 __attribute__((ext_vector_type(16)));
constexpr int SBS = 144;
constexpr int R1_EPRE = 0, R1_APRE = 16384, R1_AAB = 0, R1_X = 16384;
constexpr int R1_AT = 32768, R1_BT = 41984, R1_KT = 51200, R1_RT = 60416, R1_AHT = R1_BT, R1_U0T = R1_KT;
constexpr int R1_BBT = 69632, R1_KBT = 78848, R1_VT = 88064;
constexpr int R1_ACTW = 97280, R1_ACTA = 106496, R1_AAK = 97280, R1_ARB = 106496, R1_ARK = 115712;
constexpr int R1_BONUS = 124928, R1_WEND = 125184, R1_SEGS = 125440, R1_TII = 125440, R1_END = 129536;
static_assert(R1_END <= LDSCTL_OFF, "R1 LDS");
__device__ __forceinline__ int crow(int r, int hh) { return (r & 3) + 8 * (r >> 2) + 4 * hh; }
template <int KS> __device__ __forceinline__ f32x16 wtile(const LAS unsigned char* A, int sa, const LAS unsigned char* B, int sb, f32x16 acc, int lane) {
    const int row = lane & 31, hh = lane >> 5;
#pragma unroll
    for (int s = 0; s < KS; ++s) { const bf16x8 a = *(const LAS bf16x8*)(A + row * sa + 32 * s + 16 * hh); const bf16x8 b = *(const LAS bf16x8*)(B + row * sb + 32 * s + 16 * hh);
        acc = __builtin_amdgcn_mfma_f32_32x32x16_bf16(a, b, acc, 0, 0, 0); }
    return acc;
}
template <int KS> __device__ __forceinline__ f32x16 wtile_gb(const LAS unsigned char* A, int sa, const bf16* Bg, int ldb, f32x16 acc, int lane) {
    const int row = lane & 31, hh = lane >> 5;
#pragma unroll
    for (int s = 0; s < KS; ++s) { const bf16x8 a = *(const LAS bf16x8*)(A + row * sa + 32 * s + 16 * hh); const bf16x8 b = *(const GAS bf16x8*)(Bg + (size_t)row * ldb + 16 * s + 8 * hh);
        acc = __builtin_amdgcn_mfma_f32_32x32x16_bf16(a, b, acc, 0, 0, 0); }
    return acc;
}
__device__ __forceinline__ f32x16 zero16() { f32x16 z;
#pragma unroll
    for (int r = 0; r < 16; ++r) z[r] = 0.f;
    return z; }

struct R1Pre { v4u wd[2], ad[2], z[4]; };
__device__ __forceinline__ int r13_item(int wg, int G, int idx) { return G == 256 ? ((wg >> 3) * 128 + (wg & 7) + 8 * idx) : (wg + G * idx); }
__device__ __forceinline__ int r13_count(int wg, int G) { return G == 256 ? 16 : ((NB * NHR * 128 - wg + G - 1) / G); }
__device__ __forceinline__ void rwkv_r1_prefetch(Frame& F, int item, int tid, R1Pre& P) {
    const int chain = item >> 7, chunk = item & 127, b = chain >> 3, h = chain & 7, g0 = b * SEQ + chunk * 64;
    const bf16* Z = (const bf16*)(F.ws + WS_Z);
    const v4u z0 = (v4u){0u, 0u, 0u, 0u};
    { const int t = tid >> 3, cg = tid & 7; const bool first = (chunk == 0 && t == 0);
      const bf16* zr = Z + (size_t)(g0 + t) * IN_COLS;
      P.wd[0] = *(const GAS v4u*)(zr + C_WD + cg * 8); P.ad[0] = *(const GAS v4u*)(zr + C_AD + cg * 8);
      P.wd[1] = z0; P.ad[1] = z0;
      if (!first) { P.wd[1] = *(const GAS v4u*)(zr - IN_COLS + C_WD + cg * 8); P.ad[1] = *(const GAS v4u*)(zr - IN_COLS + C_AD + cg * 8); } }
#pragma unroll
    for (int q = 0; q < 4; ++q) { const int p = tid + 512 * q; P.z[q] = z0;
        if (p < 65 * 24) { const int row = p / 24, rem = p - row * 24, seg = rem >> 3, ch = rem & 7;
            if (!(chunk == 0 && row == 0)) P.z[q] = *(const GAS v4u*)(Z + (size_t)(g0 - 1 + row) * IN_COLS + seg * 512 + h * 64 + ch * 8); } }
}
constexpr int R1_ZS = R1_AT, R1_ZSS = 384;
static_assert(65 * R1_ZSS <= 4 * 9216, "ZS fits in the At..Rt region");
__device__ __forceinline__ void rwkv_r1_item(Frame& F, int item, int next_item, R1Pre& P) {
    const int chain = item >> 7, chunk = item & 127, b = chain >> 3, h = chain & 7;
    const int g0 = b * SEQ + chunk * 64;
    int tid_ = F.tid; asm volatile("" : "+v"(tid_));
    const int tid = tid_, lane = tid & 63, w = __builtin_amdgcn_readfirstlane(tid >> 6), hh = lane >> 5, cl = lane & 31;
    const bf16* Z = (const bf16*)(F.ws + WS_Z);
    LAS unsigned char* lds = F.lds + RING_OFF;
    const float* mu = F.in[3];
    {
        const int t = tid >> 3, cg = tid & 7;
        const v4u cw = P.wd[0], ca = P.ad[0], pw = P.wd[1], pa = P.ad[1];
        float fw[8], fa[8], qw[8], qa[8];
        fw[0] = bflo(cw.x); fw[1] = bfhi(cw.x); fw[2] = bflo(cw.y); fw[3] = bfhi(cw.y); fw[4] = bflo(cw.z); fw[5] = bfhi(cw.z); fw[6] = bflo(cw.w); fw[7] = bfhi(cw.w);
        fa[0] = bflo(ca.x); fa[1] = bfhi(ca.x); fa[2] = bflo(ca.y); fa[3] = bfhi(ca.y); fa[4] = bflo(ca.z); fa[5] = bfhi(ca.z); fa[6] = bflo(ca.w); fa[7] = bfhi(ca.w);
        qw[0] = bflo(pw.x); qw[1] = bfhi(pw.x); qw[2] = bflo(pw.y); qw[3] = bfhi(pw.y); qw[4] = bflo(pw.z); qw[5] = bfhi(pw.z); qw[6] = bflo(pw.w); qw[7] = bfhi(pw.w);
        qa[0] = bflo(pa.x); qa[1] = bfhi(pa.x); qa[2] = bflo(pa.y); qa[3] = bfhi(pa.y); qa[4] = bflo(pa.z); qa[5] = bfhi(pa.z); qa[6] = bflo(pa.w); qa[7] = bfhi(pa.w);
#pragma unroll
        for (int j = 0; j < 8; ++j) { const int c = cg * 8 + j; const float xw = fw[j] + (qw[j] - fw[j]) * mu[C_WD + c];
            const float ex = __expf(2.f * xw); fw[j] = 1.f - 2.f * frcp(ex + 1.f);
            fa[j] = fa[j] + (qa[j] - fa[j]) * mu[C_AD + c]; }
        v4u ow, oa; ow.x = pk2(fw[0], fw[1]); ow.y = pk2(fw[2], fw[3]); ow.z = pk2(fw[4], fw[5]); ow.w = pk2(fw[6], fw[7]);
        oa.x = pk2(fa[0], fa[1]); oa.y = pk2(fa[2], fa[3]); oa.z = pk2(fa[4], fa[5]); oa.w = pk2(fa[6], fa[7]);
        *(LAS v4u*)(lds + R1_ACTW + t * SBS + cg * 16) = ow; *(LAS v4u*)(lds + R1_ACTA + t * SBS + cg * 16) = oa;
#pragma unroll
        for (int q = 0; q < 4; ++q) { const int p = tid + 512 * q;
            if (p < 65 * 24) { const int row = p / 24, rem = p - row * 24; *(LAS v4u*)(lds + R1_ZS + row * R1_ZSS + rem * 16) = P.z[q]; } }
        if (next_item >= 0) rwkv_r1_prefetch(F, next_item, tid, P);
    }
    LDS_BARRIER();
    {
        const int p = w >> 2, mt = (w >> 1) & 1, nt = w & 1;
        const bf16* upt = (const bf16*)(F.ws + (p == 0 ? WS_WUPT : WS_AUPT)) + (size_t)(h * 64 + nt * 32) * 64;
        const f32x16 acc = wtile_gb<4>(lds + (p == 0 ? R1_ACTW : R1_ACTA) + mt * 32 * SBS, SBS, upt, 64, zero16(), lane);
        LAS float* O = (LAS float*)(lds + (p == 0 ? R1_EPRE : R1_APRE));
#pragma unroll
        for (int r = 0; r < 16; ++r) O[(mt * 32 + crow(r, hh)) * 64 + nt * 32 + cl] = acc[r];
    }
    LDS_BARRIER();
    {
        const int c = tid & 63, ts = tid >> 6, col = h * 64 + c;
        const float mu_r = mu[C_R + col], mu_k = mu[C_K + col], mu_v = mu[C_V + col], kkc = F.in[9][col], kac = F.in[10][col], rkc = F.in[11][col], w0c = F.in[4][col], a0c = F.in[6][col];
        const LAS float* EP = (const LAS float*)(lds + R1_EPRE); const LAS float* AP = (const LAS float*)(lds + R1_APRE);
        LAS float* SEGS = (LAS float*)(lds + R1_SEGS); LAS float* BON = (LAS float*)(lds + R1_BONUS);
        const LAS bf16* zb = (const LAS bf16*)(lds + R1_ZS + (8 * ts) * R1_ZSS) + c;
        float pr = bf2f(zb[0]), pk = bf2f(zb[64]), pv = bf2f(zb[128]);
        float rr[8], k2[8], ai[8], bi[8], vv[8], ee[8], cs[8]; float run = 0.f;
#pragma unroll
        for (int i = 0; i < 8; ++i) {
            const float zr = bf2f(zb[(i + 1) * (R1_ZSS / 2)]), zk = bf2f(zb[(i + 1) * (R1_ZSS / 2) + 64]), zv = bf2f(zb[(i + 1) * (R1_ZSS / 2) + 128]);
            const float r = zr + (pr - zr) * mu_r, k = zk + (pk - zk) * mu_k, v = zv + (pv - zv) * mu_v; pr = zr; pk = zk; pv = zv;
            const float e = 0.60653066f * frcp(1.f + __expf(-(w0c + EP[(8 * ts + i) * 64 + c])));
            const float a = frcp(1.f + __expf(-(a0c + AP[(8 * ts + i) * 64 + c])));
            float kk = k * kkc; const float n2 = wave_sum(kk * kk); kk = kk * frsq(fmaxf(n2, 1e-24f));
            const float kq = k * (1.f + (a - 1.f) * kac);
            const float bon = wave_sum(r * kq * rkc); if (c == 0) BON[8 * ts + i] = bon;
            rr[i] = r; k2[i] = kq; ai[i] = -kk; bi[i] = kk * a; vv[i] = v; ee[i] = e; run += e; cs[i] = run;
        }
        SEGS[ts * 64 + c] = run;
        LDS_BARRIER();
        float off = 0.f, tot = 0.f;
#pragma unroll
        for (int q = 0; q < 8; ++q) { const float sv = SEGS[q * 64 + c]; tot += sv; off += (q < ts) ? sv : 0.f; }
        float bb[8], kb[8];
#pragma unroll
        for (int i = 0; i < 8; ++i) { const float L = off + cs[i];
            const float Wm = __expf(-(L - ee[i])), Wi = __expf(-L), iW = __expf(L), We = __expf(-(tot - L));
            const int t = 8 * ts + i;
            *(LAS bf16*)(lds + R1_AT + t * SBS + c * 2) = (bf16)f2bf(ai[i] * Wm);
            *(LAS bf16*)(lds + R1_BT + t * SBS + c * 2) = (bf16)f2bf(bi[i] * iW);
            *(LAS bf16*)(lds + R1_KT + t * SBS + c * 2) = (bf16)f2bf(k2[i] * iW);
            *(LAS bf16*)(lds + R1_RT + t * SBS + c * 2) = (bf16)f2bf(rr[i] * Wi);
            bb[i] = bi[i] * We; kb[i] = k2[i] * We; }
        v4u o; o.x = pk2(bb[0], bb[1]); o.y = pk2(bb[2], bb[3]); o.z = pk2(bb[4], bb[5]); o.w = pk2(bb[6], bb[7]);
        *(LAS v4u*)(lds + R1_BBT + c * SBS + ts * 16) = o;
        o.x = pk2(kb[0], kb[1]); o.y = pk2(kb[2], kb[3]); o.z = pk2(kb[4], kb[5]); o.w = pk2(kb[6], kb[7]);
        *(LAS v4u*)(lds + R1_KBT + c * SBS + ts * 16) = o;
        o.x = pk2(vv[0], vv[1]); o.y = pk2(vv[2], vv[3]); o.z = pk2(vv[4], vv[5]); o.w = pk2(vv[6], vv[7]);
        *(LAS v4u*)(lds + R1_VT + c * SBS + ts * 16) = o;
        if (ts == 0) ((LAS float*)(lds + R1_WEND))[c] = __expf(-tot);
    }
    LDS_BARRIER();
#pragma unroll
    for (int u = 0; u < 2; ++u) {
        const int idx = w * 2 + u, p = idx >> 2, mt = (idx >> 1) & 1, nt = idx & 1;
        const LAS unsigned char* Aop = lds + ((p == 0 || p == 2) ? R1_BT : R1_KT) + mt * 32 * SBS;
        const LAS unsigned char* Bop = lds + (p < 2 ? R1_AT : R1_RT) + nt * 32 * SBS;
        f32x16 acc = wtile<4>(Aop, SBS, Bop, SBS, zero16(), lane);
        const int n = nt * 32 + cl;
#pragma unroll
        for (int r = 0; r < 16; ++r) { const int m = mt * 32 + crow(r, hh); const bool keep = (p < 2) ? (m < n) : (m <= n); acc[r] = keep ? acc[r] : 0.f; }
#pragma unroll
        for (int g4 = 0; g4 < 4; ++g4) { const int m0 = mt * 32 + 8 * g4 + 4 * hh;
            if (p == 0) *(LAS f32x4*)(lds + R1_AAB + (n * 64 + m0) * 4) = (f32x4){acc[4 * g4], acc[4 * g4 + 1], acc[4 * g4 + 2], acc[4 * g4 + 3]};
            else { v2u o; o.x = pk2(acc[4 * g4], acc[4 * g4 + 1]); o.y = pk2(acc[4 * g4 + 2], acc[4 * g4 + 3]);
                   *(LAS v2u*)(lds + (p == 1 ? R1_AAK : (p == 2 ? R1_ARB : R1_ARK)) + n * SBS + m0 * 2) = o; } }
    }
    LDS_BARRIER();
    if (w < 4) {
        const int mt = w >> 1, nt = w & 1;
        const f32x16 acc = wtile<4>(lds + R1_AAK + mt * 32 * SBS, SBS, lds + R1_VT + nt * 32 * SBS, SBS, zero16(), lane);
        LAS float* X = (LAS float*)(lds + R1_X);
#pragma unroll
        for (int r = 0; r < 16; ++r) X[(mt * 32 + crow(r, hh)) * 64 + nt * 32 + cl] = acc[r];
    } else if (w == 4) {
        const int bk = lane >> 4, c = lane & 15;
        const LAS float* AAB = (const LAS float*)(lds + R1_AAB);
        float Tc[16]; const float fc = (float)c;
#pragma unroll
        for (int s2 = 0; s2 < 16; ++s2) Tc[s2] = fmaxf(0.f, 1.f - fabsf((float)s2 - fc));
#pragma unroll
        for (int r = 0; r < 15; ++r)
#pragma unroll
            for (int s2 = r + 1; s2 < 16; ++s2) Tc[s2] += AAB[(16 * bk + s2) * 64 + 16 * bk + r] * Tc[r];
        LAS float* TII = (LAS float*)(lds + R1_TII);
#pragma unroll
        for (int s2 = 0; s2 < 16; ++s2) TII[(bk * 16 + s2) * 16 + c] = Tc[s2];
    }
    LDS_BARRIER();
    {
        const int c16 = lane & 15, g = lane >> 4;
        const LAS float* AAB = (const LAS float*)(lds + R1_AAB); const LAS float* TII = (const LAS float*)(lds + R1_TII); const LAS float* X = (const LAS float*)(lds + R1_X);
        f32x4 o[4];
#pragma unroll
        for (int i = 0; i < 4; ++i) {
            f32x4 acc;
            if (w < 4) {
#pragma unroll
                for (int q = 0; q < 4; ++q) acc[q] = bf2f(*(const LAS bf16*)(lds + R1_AT + (16 * i + 4 * g + q) * SBS + (16 * w + c16) * 2));
            } else {
#pragma unroll
                for (int q = 0; q < 4; ++q) acc[q] = X[(16 * i + 4 * g + q) * 64 + 16 * (w - 4) + c16];
            }
#pragma unroll
            for (int j = 0; j < i; ++j) { const f32x4 a4 = *(const LAS f32x4*)(AAB + (16 * i + c16) * 64 + 16 * j + 4 * g);
#pragma unroll
                for (int q = 0; q < 4; ++q) acc = __builtin_amdgcn_mfma_f32_16x16x4f32(a4[q], o[j][q], acc, 0, 0, 0); }
            const f32x4 t4 = *(const LAS f32x4*)(TII + (i * 16 + c16) * 16 + 4 * g);
            f32x4 res = (f32x4){0.f, 0.f, 0.f, 0.f};
#pragma unroll
            for (int q = 0; q < 4; ++q) res = __builtin_amdgcn_mfma_f32_16x16x4f32(t4[q], acc[q], res, 0, 0, 0);
            o[i] = res;
            v2u ov; ov.x = pk2(res[0], res[1]); ov.y = pk2(res[2], res[3]);
            *(LAS v2u*)(lds + (w < 4 ? R1_AHT : R1_U0T) + (16 * (w & 3) + c16) * SBS + (16 * i + 4 * g) * 2) = ov;
        }
    }
    LDS_BARRIER();
    {
        float* Mg = F.out + (size_t)item * 4096; float* NTg = F.out + (size_t)T * RWW + (size_t)item * 4096;
        float* Y0g = (float*)(F.ws + WS_RWY0) + (size_t)item * 4096; bf16* RHg = (bf16*)(F.ws + WS_RWRH) + (size_t)item * 4096;
#pragma unroll
        for (int u = 0; u < 2; ++u) {
            const int idx = w * 2 + u, p = idx >> 2, mt = (idx >> 1) & 1, nt = idx & 1; const int n = nt * 32 + cl;
            if (p == 0) {
                f32x16 acc = wtile<4>(lds + R1_AHT + mt * 32 * SBS, SBS, lds + R1_BBT + nt * 32 * SBS, SBS, zero16(), lane);
                const float we = ((const LAS float*)(lds + R1_WEND))[n];
#pragma unroll
                for (int g4 = 0; g4 < 4; ++g4) { const int m0 = mt * 32 + 8 * g4 + 4 * hh;
                    *(GAS f32x4*)(Mg + n * 64 + m0) = (f32x4){acc[4 * g4] + (m0 == n ? we : 0.f), acc[4 * g4 + 1] + (m0 + 1 == n ? we : 0.f), acc[4 * g4 + 2] + (m0 + 2 == n ? we : 0.f), acc[4 * g4 + 3] + (m0 + 3 == n ? we : 0.f)}; }
            } else if (p == 1) {
                f32x16 acc = wtile<4>(lds + R1_BBT + mt * 32 * SBS, SBS, lds + R1_U0T + nt * 32 * SBS, SBS, zero16(), lane);
                acc = wtile<4>(lds + R1_KBT + mt * 32 * SBS, SBS, lds + R1_VT + nt * 32 * SBS, SBS, acc, lane);
#pragma unroll
                for (int g4 = 0; g4 < 4; ++g4) *(GAS f32x4*)(NTg + n * 64 + mt * 32 + 8 * g4 + 4 * hh) = (f32x4){acc[4 * g4], acc[4 * g4 + 1], acc[4 * g4 + 2], acc[4 * g4 + 3]};
            } else if (p == 2) {
                f32x16 acc = wtile<4>(lds + R1_AHT + mt * 32 * SBS, SBS, lds + R1_ARB + nt * 32 * SBS, SBS, zero16(), lane);
#pragma unroll
                for (int g4 = 0; g4 < 4; ++g4) { const int m0 = mt * 32 + 8 * g4 + 4 * hh;
                    const v2u rt = *(const LAS v2u*)(lds + R1_RT + n * SBS + m0 * 2);
                    v2u ov; ov.x = pk2(acc[4 * g4] + bflo(rt.x), acc[4 * g4 + 1] + bfhi(rt.x)); ov.y = pk2(acc[4 * g4 + 2] + bflo(rt.y), acc[4 * g4 + 3] + bfhi(rt.y));
                    *(GAS v2u*)(RHg + n * 64 + m0) = ov; }
            } else {
                f32x16 acc = wtile<4>(lds + R1_U0T + mt * 32 * SBS, SBS, lds + R1_ARB + nt * 32 * SBS, SBS, zero16(), lane);
                acc = wtile<4>(lds + R1_VT + mt * 32 * SBS, SBS, lds + R1_ARK + nt * 32 * SBS, SBS, acc, lane);
#pragma unroll
                for (int g4 = 0; g4 < 4; ++g4) *(GAS f32x4*)(Y0g + n * 64 + mt * 32 + 8 * g4 + 4 * hh) = (f32x4){acc[4 * g4], acc[4 * g4 + 1], acc[4 * g4 + 2], acc[4 * g4 + 3]};
            }
        }
        if (tid < 64) ((float*)(F.ws + WS_BONUS))[(size_t)item * 64 + tid] = ((const LAS float*)(lds + R1_BONUS))[tid];
    }
    LDS_BARRIER();
}

constexpr int R2_RS = 272, R2_SLOT = 2 * 64 * R2_RS, R2_D = 6;
static_assert(2 * R2_SLOT <= LDSCTL_OFF, "R2 LDS");
__device__ __forceinline__ void rwkv_r2_chain(Frame& F, int chain) {
    int tid_ = F.tid; asm volatile("" : "+v"(tid_));
    const int lane = tid_ & 63, w = __builtin_amdgcn_readfirstlane(tid_ >> 6);
    LAS unsigned char* lds = F.lds + RING_OFF;
    const float* Mg = F.out + (size_t)chain * 128 * 4096; const float* NTg = F.out + (size_t)T * RWW + (size_t)chain * 128 * 4096;
    constexpr int NSTEP = 127;
    if (w >= 4) {
        const int L = w - 4, r = lane >> 2, f0 = (lane & 3) * 4;
        const size_t goff = (size_t)(16 * L + r) * 64 + f0 * 4;
        const int loff = (16 * L + r) * R2_RS + f0 * 16;
        f32x4 R[R2_D][8];
#define R2_ISSUE(slot_, step_) do { const int st_ = (step_) < NSTEP ? (step_) : NSTEP - 1; const float* mp_ = Mg + (size_t)st_ * 4096 + goff; const float* np_ = NTg + (size_t)st_ * 4096 + goff; \
            _Pragma("unroll") for (int k_ = 0; k_ < 4; ++k_) { R[slot_][k_] = *(const GAS f32x4*)(mp_ + 4 * k_); R[slot_][4 + k_] = *(const GAS f32x4*)(np_ + 4 * k_); } } while (0)
        const int q_ = lane & 3, froff = ((L * 2 + (q_ >> 1)) * 2) * 1024 + r * 16 + (q_ & 1) * 8;
#define R2_WRITE(slot_, buf_) do { LAS unsigned char* d_ = lds + (buf_) * R2_SLOT; \
            _Pragma("unroll") for (int k_ = 0; k_ < 4; ++k_) { const f32x4 a_ = R[slot_][k_]; \
                v2u h_; h_.x = pk2(a_[0], a_[1]); h_.y = pk2(a_[2], a_[3]); \
                v2u l_; l_.x = pk2(a_[0] - bflo(h_.x), a_[1] - bfhi(h_.x)); l_.y = pk2(a_[2] - bflo(h_.y), a_[3] - bfhi(h_.y)); \
                *(LAS v2u*)(d_ + froff + k_ * 256) = h_; *(LAS v2u*)(d_ + froff + 1024 + k_ * 256) = l_; \
                *(LAS f32x4*)(d_ + 64 * R2_RS + loff + 16 * k_) = R[slot_][4 + k_]; } } while (0)
#pragma unroll
        for (int u = 0; u < R2_D; ++u) R2_ISSUE(u, u);
        R2_WRITE(0, 0);
        R2_ISSUE(0, R2_D);
        LDS_BARRIER();
        static_assert(NSTEP % R2_D == 1, "main loop covers steps 0 .. NSTEP-2, one tail step");
        for (int c0 = 0; c0 < NSTEP - 1; c0 += R2_D) {
#pragma unroll
            for (int u = 0; u < R2_D; ++u) { const int c = c0 + u;
                R2_WRITE((u + 1) % R2_D, (c + 1) & 1);
                R2_ISSUE((u + 1) % R2_D, c + 1 + R2_D);
                LDS_BARRIER(); }
        }
        LDS_BARRIER();
#undef R2_ISSUE
#undef R2_WRITE
        return;
    }
    const int n16 = lane & 15, g = lane >> 4;
    float* SSg = (float*)(F.ws + WS_RWSS) + (size_t)chain * 128 * 4096;
    f32x4 st[4];
#pragma unroll
    for (int rt = 0; rt < 4; ++rt) st[rt] = (f32x4){0.f, 0.f, 0.f, 0.f};
    LDS_BARRIER();
    for (int c = 0; c < NSTEP; ++c) {
#pragma unroll
        for (int rt = 0; rt < 4; ++rt) *(GAS f32x4*)(SSg + (size_t)c * 4096 + (16 * w + n16) * 64 + 16 * rt + 4 * g) = st[rt];
        const LAS unsigned char* sl_ = lds + (c & 1) * R2_SLOT;
        bf16x8 sh[2], sl[2];
#pragma unroll
        for (int ks = 0; ks < 2; ++ks) { const f32x4 a = st[2 * ks], b = st[2 * ks + 1];
            v4u h; h.x = pk2(a[0], a[1]); h.y = pk2(a[2], a[3]); h.z = pk2(b[0], b[1]); h.w = pk2(b[2], b[3]);
            v4u l; l.x = pk2(a[0] - bflo(h.x), a[1] - bfhi(h.x)); l.y = pk2(a[2] - bflo(h.y), a[3] - bfhi(h.y)); l.z = pk2(b[0] - bflo(h.z), b[1] - bfhi(h.z)); l.w = pk2(b[2] - bflo(h.w), b[3] - bfhi(h.w));
            sh[ks] = __builtin_bit_cast(bf16x8, h); sl[ks] = __builtin_bit_cast(bf16x8, l); }
        f32x4 nw[4];
#pragma unroll
        for (int rt = 0; rt < 4; ++rt) { f32x4 acc = *(const LAS f32x4*)(sl_ + 64 * R2_RS + (16 * w + n16) * R2_RS + (16 * rt + 4 * g) * 4);
#pragma unroll
            for (int ks = 0; ks < 2; ++ks) {
                const bf16x8 mh = *(const LAS bf16x8*)(sl_ + ((rt * 2 + ks) * 2) * 1024 + lane * 16), ml = *(const LAS bf16x8*)(sl_ + ((rt * 2 + ks) * 2 + 1) * 1024 + lane * 16);
                acc = __builtin_amdgcn_mfma_f32_16x16x32_bf16(mh, sh[ks], acc, 0, 0, 0);
                acc = __builtin_amdgcn_mfma_f32_16x16x32_bf16(mh, sl[ks], acc, 0, 0, 0);
                acc = __builtin_amdgcn_mfma_f32_16x16x32_bf16(ml, sh[ks], acc, 0, 0, 0); }
            nw[rt] = acc; }
#pragma unroll
        for (int rt = 0; rt < 4; ++rt) st[rt] = nw[rt];
        LDS_BARRIER();
    }
#pragma unroll
    for (int rt = 0; rt < 4; ++rt) *(GAS f32x4*)(SSg + (size_t)NSTEP * 4096 + (16 * w + n16) * 64 + 16 * rt + 4 * g) = st[rt];
}

constexpr int R3_RH = 0, R3_S = 9216, R3_SG = 18432, R3_SGS = 272, R3_YL = R3_SG + 64 * R3_SGS, R3_GL = R3_YL + 16384, R3_END = R3_GL + 16384;
static_assert(R3_END <= LDSCTL_OFF, "R3 LDS");
__device__ __forceinline__ void rwkv_r3_item(Frame& F, int item) {
    const int chain = item >> 7, chunk = item & 127, b = chain >> 3, h = chain & 7;
    const int g0 = b * SEQ + chunk * 64;
    int tid_ = F.tid; asm volatile("" : "+v"(tid_));
    const int tid = tid_, lane = tid & 63, w = __builtin_amdgcn_readfirstlane(tid >> 6), hh = lane >> 5, cl = lane & 31;
    const bf16* Z = (const bf16*)(F.ws + WS_Z);
    LAS unsigned char* lds = F.lds + RING_OFF;
    const float* mu = F.in[3];
    {
        const int t = tid >> 3, cg = tid & 7;
        const bf16* RHg = (const bf16*)(F.ws + WS_RWRH) + (size_t)item * 4096;
        *(LAS v4u*)(lds + R3_RH + t * SBS + cg * 16) = *(const GAS v4u*)(RHg + t * 64 + cg * 8);
        const float* SSg = (const float*)(F.ws + WS_RWSS) + (size_t)item * 4096;
        const f32x4 s0 = *(const GAS f32x4*)(SSg + t * 64 + cg * 8), s1 = *(const GAS f32x4*)(SSg + t * 64 + cg * 8 + 4);
        v4u o; o.x = pk2(s0[0], s0[1]); o.y = pk2(s0[2], s0[3]); o.z = pk2(s1[0], s1[1]); o.w = pk2(s1[2], s1[3]);
        *(LAS v4u*)(lds + R3_S + t * SBS + cg * 16) = o;
        const bool first = (chunk == 0 && t == 0);
        const bf16* zr = Z + (size_t)(g0 + t) * IN_COLS + C_GD + cg * 16;
#pragma unroll
        for (int q = 0; q < 2; ++q) {
            const v4u cw = *(const GAS v4u*)(zr + q * 8); v4u pw = (v4u){0u, 0u, 0u, 0u};
            if (!first) pw = *(const GAS v4u*)(zr - IN_COLS + q * 8);
            float fw[8], qw[8];
            fw[0] = bflo(cw.x); fw[1] = bfhi(cw.x); fw[2] = bflo(cw.y); fw[3] = bfhi(cw.y); fw[4] = bflo(cw.z); fw[5] = bfhi(cw.z); fw[6] = bflo(cw.w); fw[7] = bfhi(cw.w);
            qw[0] = bflo(pw.x); qw[1] = bfhi(pw.x); qw[2] = bflo(pw.y); qw[3] = bfhi(pw.y); qw[4] = bflo(pw.z); qw[5] = bfhi(pw.z); qw[6] = bflo(pw.w); qw[7] = bfhi(pw.w);
#pragma unroll
            for (int j = 0; j < 8; ++j) { const float v = fw[j] + (qw[j] - fw[j]) * mu[C_GD + cg * 16 + q * 8 + j]; fw[j] = frcp(1.f + __expf(-v)); }
            v4u og; og.x = pk2(fw[0], fw[1]); og.y = pk2(fw[2], fw[3]); og.z = pk2(fw[4], fw[5]); og.w = pk2(fw[6], fw[7]);
            *(LAS v4u*)(lds + R3_SG + t * R3_SGS + (cg * 16 + q * 8) * 2) = og;
        }
    }
    LDS_BARRIER();
    {
        const int mt = (w >> 1) & 1, nt = w & 1; const int n = nt * 32 + cl;
        if (w < 4) {
            const float* Y0g = (const float*)(F.ws + WS_RWY0) + (size_t)item * 4096;
            f32x16 acc;
#pragma unroll
            for (int r = 0; r < 16; ++r) acc[r] = Y0g[(mt * 32 + crow(r, hh)) * 64 + n];
            acc = wtile<4>(lds + R3_RH + mt * 32 * SBS, SBS, lds + R3_S + nt * 32 * SBS, SBS, acc, lane);
            LAS float* YL = (LAS float*)(lds + R3_YL);
#pragma unroll
            for (int r = 0; r < 16; ++r) YL[(mt * 32 + crow(r, hh)) * 64 + n] = acc[r];
        } else {
            const bf16* gut = (const bf16*)(F.ws + WS_GUPT) + (size_t)(h * 64 + nt * 32) * 128;
            const f32x16 acc = wtile_gb<8>(lds + R3_SG + mt * 32 * R3_SGS, R3_SGS, gut, 128, zero16(), lane);
            LAS float* GL = (LAS float*)(lds + R3_GL);
#pragma unroll
            for (int r = 0; r < 16; ++r) GL[(mt * 32 + crow(r, hh)) * 64 + n] = acc[r];
        }
    }
    LDS_BARRIER();
    {
        const int c = tid & 63, ts = tid >> 6, col = h * 64 + c;
        const float mu_v = mu[C_V + col], gw = F.in[12][col], gb = F.in[13][col];
        const LAS float* YL = (const LAS float*)(lds + R3_YL); const LAS float* GL = (const LAS float*)(lds + R3_GL);
        const float* BON = (const float*)(F.ws + WS_BONUS) + (size_t)item * 64;
        bf16* Y = (bf16*)(F.ws + WS_YMIX);
        const bf16* zb = Z + (size_t)(g0 + 8 * ts) * IN_COLS + col;
        float pv = 0.f; if (!(chunk == 0 && ts == 0)) pv = bf2f(zb[C_V - IN_COLS]);
#pragma unroll
        for (int i = 0; i < 8; ++i) { const int t = 8 * ts + i;
            const float zv = bf2f(zb[(size_t)i * IN_COLS + C_V]); const float v = zv + (pv - zv) * mu_v; pv = zv;
            const float y = YL[t * 64 + c];
            const float mean = wave_sum(y) * (1.f / 64.f); const float d = y - mean; const float var = wave_sum(d * d) * (1.f / 64.f);
            const float yn = d * frsq(var + GN_EPS) * gw + gb;
            const float o = (yn + BON[t] * v) * GL[t * 64 + c];
            Y[(size_t)(g0 + t) * DM + col] = (bf16)f2bf(o); }
    }
    LDS_BARRIER();
}

typedef short s16x4 __attribute__((ext_vector_type(4)));
typedef short v4i16_t __attribute__((ext_vector_type(4)));
constexpr int AT_XO = 0, AT_XO_STRIDE = 136, AT_XM = 512 * AT_XO_STRIDE, AT_XL = AT_XM + 2048, AT_V = AT_XL + 2048, AT_LDS_END = AT_V + 8 * 4096;
static_assert(AT_LDS_END <= RING_BYTES, "attention LDS");
__device__ __forceinline__ float xhalf(float v) { return __shfl_xor(v, 32); }
__device__ __forceinline__ void attn_block(Frame& F, int item) {
    const int bh = item >> 4, blk = item & 15, b = bh >> 3, h = bh & 7, t0 = blk * 512;
    int tid_ = F.tid; asm volatile("" : "+v"(tid_));
    const int lane = tid_ & 63, w = __builtin_amdgcn_readfirstlane(tid_ >> 6), ql = lane & 31, hh = lane >> 5;
    const bf16* Zb = (const bf16*)(F.ws + WS_Z) + (size_t)b * SEQ * IN_COLS;
    bf16* Y = (bf16*)(F.ws + WS_YMIX);
    LAS unsigned char* lds = F.lds + RING_OFF;
    LAS unsigned char* Vw = lds + AT_V + w * 4096;
    LAS float* XM = (LAS float*)(lds + AT_XM); LAS float* XL = (LAS float*)(lds + AT_XL);
    constexpr float C2 = 0.125f * 1.4426950408889634f;
    for (int pass = 0; pass < 3; ++pass) {
        const int sh = pass == 0 ? 4 : (pass == 1 ? 2 : 0), d = 1 << sh;
        for (int uu = 0; uu < 2; ++uu) {
            const int u = w + 8 * uu, rho = u & (d - 1), tau = u >> sh;
            const int qoff = rho + (32 * tau + ql) * d;
            bf16x8 qf[4];
            { const bf16* qp = Zb + (size_t)(t0 + qoff) * IN_COLS + C_AQ + h * 64 + 8 * hh;
#pragma unroll
              for (int s = 0; s < 4; ++s) qf[s] = *(const GAS bf16x8*)(qp + 16 * s); }
            f32x16 sc[5];
            const int tkb = t0 + rho + (32 * tau - 128) * d;
            bf16x8 kf[5][4];
#pragma unroll
            for (int kt = 0; kt < 5; ++kt) { const int tk0 = tkb + 32 * kt * d, tkc = tk0 < 0 ? 0 : tk0;
                const bf16* kp = Zb + (size_t)(tkc + ql * d) * IN_COLS + C_AK + h * 64 + 8 * hh;
#pragma unroll
                for (int s = 0; s < 4; ++s) kf[kt][s] = *(const GAS bf16x8*)(kp + 16 * s); }
            v4u vr[4];
            { const int tkc = tkb < 0 ? 0 : tkb;
#pragma unroll
              for (int i = 0; i < 4; ++i) { const int kidx = i * 8 + (lane >> 3), ch = lane & 7;
                  vr[i] = *(const GAS v4u*)(Zb + (size_t)(tkc + kidx * d) * IN_COLS + C_AV + h * 64 + ch * 8); } }
#pragma unroll
            for (int kt = 0; kt < 5; ++kt) {
                const int tk0 = tkb + 32 * kt * d;
                f32x16 acc = zero16();
#pragma unroll
                for (int s = 0; s < 4; ++s) acc = __builtin_amdgcn_mfma_f32_32x32x16_bf16(kf[kt][s], qf[s], acc, 0, 0, 0);
                if (kt == 0 || kt == 4) {
#pragma unroll
                    for (int r = 0; r < 16; ++r) { const int kidx = (r & 3) + 8 * (r >> 2) + 4 * hh;
                        const bool ok = (kt == 0) ? (kidx >= ql) : (kidx <= ql);
                        acc[r] = ok ? acc[r] : -INFINITY; }
                }
                if (tk0 < 0) {
#pragma unroll
                    for (int r = 0; r < 16; ++r) acc[r] = -INFINITY;
                }
                sc[kt] = acc;
            }
            float m = -INFINITY;
#pragma unroll
            for (int kt = 0; kt < 5; ++kt)
#pragma unroll
                for (int r = 0; r < 16; ++r) m = fmaxf(m, sc[kt][r]);
            m = fmaxf(m, xhalf(m));
            const float ms = m * C2;
            float l = 0.f;
#pragma unroll
            for (int kt = 0; kt < 5; ++kt)
#pragma unroll
                for (int r = 0; r < 16; ++r) { const float p = __builtin_amdgcn_exp2f(sc[kt][r] * C2 - ms); sc[kt][r] = p; l += p; }
            l += xhalf(l);
            f32x16 O[2];
#pragma unroll
            for (int r = 0; r < 16; ++r) { O[0][r] = 0.f; O[1][r] = 0.f; }
#pragma unroll
            for (int kt = 0; kt < 5; ++kt) {
#pragma unroll
                for (int i = 0; i < 4; ++i) { const int kidx = i * 8 + (lane >> 3), ch = lane & 7;
                    *(LAS v4u*)(Vw + kidx * 128 + ((ch ^ (((kidx >> 1) & 1) << 2)) << 4)) = vr[i]; }
                if (kt < 4) { const int tk1 = tkb + 32 * (kt + 1) * d, tkc = tk1 < 0 ? 0 : tk1;
#pragma unroll
                    for (int i = 0; i < 4; ++i) { const int kidx = i * 8 + (lane >> 3), ch = lane & 7;
                        vr[i] = *(const GAS v4u*)(Zb + (size_t)(tkc + kidx * d) * IN_COLS + C_AV + h * 64 + ch * 8); } }
                asm volatile("s_waitcnt lgkmcnt(0)" ::: "memory");
#pragma unroll
                for (int s = 0; s < 2; ++s) {
                    v4u pw; pw.x = pk2(sc[kt][8 * s], sc[kt][8 * s + 1]); pw.y = pk2(sc[kt][8 * s + 2], sc[kt][8 * s + 3]); pw.z = pk2(sc[kt][8 * s + 4], sc[kt][8 * s + 5]); pw.w = pk2(sc[kt][8 * s + 6], sc[kt][8 * s + 7]);
                    const bf16x8 pf = __builtin_bit_cast(bf16x8, pw);
#pragma unroll
                    for (int dt = 0; dt < 2; ++dt) {
                        bf16x8 vf;
#pragma unroll
                        for (int pp = 0; pp < 2; ++pp) {
                            const int i16 = lane & 15, db = (lane >> 4) & 1;
                            const int row = 16 * s + 8 * pp + 4 * hh + (i16 >> 2);
                            const int byte = 64 * dt + 32 * db + 8 * (i16 & 3);
                            const int chunk = (byte >> 4) ^ (((row >> 1) & 1) << 2);
                            const s16x4 t4 = __builtin_bit_cast(s16x4, __builtin_amdgcn_ds_read_tr16_b64_v4i16((LAS v4i16_t*)(Vw + row * 128 + (chunk << 4) + (byte & 15))));
                            vf[4 * pp + 0] = t4[0]; vf[4 * pp + 1] = t4[1]; vf[4 * pp + 2] = t4[2]; vf[4 * pp + 3] = t4[3];
                        }
                        O[dt] = __builtin_amdgcn_mfma_f32_32x32x16_bf16(vf, pf, O[dt], 0, 0, 0);
                    }
                }
                asm volatile("s_waitcnt lgkmcnt(0)" ::: "memory");
            }
            LAS unsigned char* xo = lds + AT_XO + qoff * AT_XO_STRIDE + 8 * hh;
            float wa = 0.f, wb = 1.f, Mx = ms, ln = l;
            if (pass > 0) { const float msa = XM[qoff], la = XL[qoff]; Mx = fmaxf(msa, ms); wa = la * __builtin_amdgcn_exp2f(msa - Mx); wb = __builtin_amdgcn_exp2f(ms - Mx); ln = wa + wb * l; }
            const float inv = 1.f / ln;
#pragma unroll
            for (int dt = 0; dt < 2; ++dt)
#pragma unroll
                for (int g4 = 0; g4 < 4; ++g4) {
                    LAS v2u* p = (LAS v2u*)(xo + (32 * dt + 8 * g4) * 2);
                    float o0 = O[dt][4 * g4] * wb, o1 = O[dt][4 * g4 + 1] * wb, o2 = O[dt][4 * g4 + 2] * wb, o3 = O[dt][4 * g4 + 3] * wb;
                    if (pass > 0) { const v2u old = *p; o0 += bflo(old.x) * wa; o1 += bfhi(old.x) * wa; o2 += bflo(old.y) * wa; o3 += bfhi(old.y) * wa; }
                    v2u nw; nw.x = pk2(o0 * inv, o1 * inv); nw.y = pk2(o2 * inv, o3 * inv);
                    *p = nw;
                }
            if (hh == 0) { XM[qoff] = Mx; XL[qoff] = ln; }
        }
        LDS_BARRIER();
    }
#pragma unroll
    for (int i = 0; i < 8; ++i) { const int row = (tid_ >> 3) + 64 * i, ch = tid_ & 7;
        LAS v2u* p = (LAS v2u*)(lds + AT_XO + row * AT_XO_STRIDE + ch * 16);
        const v2u a = p[0], c = p[1];
        v4u o; o.x = a.x; o.y = a.y; o.z = c.x; o.w = c.y;
        *(GAS v4u*)(Y + ((size_t)b * SEQ + t0 + row) * DM + RWW + h * 64 + ch * 8) = o; }
    LDS_BARRIER();
}

__device__ __forceinline__ void p3_mixers(Frame& F) {
    const int nrw = (F.G >= 64) ? 32 : 0;
    if (nrw == 0) { for (int ch = 0; ch < NB * NHR; ++ch) rwkv_r2_chain(F, ch); }
#ifndef RW2_REPS
#define RW2_REPS 1
#endif
    else if (F.wg < nrw) { for (int rep = 0; rep < RW2_REPS; ++rep) { for (int ch = F.wg; ch < NB * NHR; ch += nrw) rwkv_r2_chain(F, ch); if (rep + 1 < RW2_REPS) __syncthreads(); } return; }
    const int na = F.G - nrw, wa = F.wg - nrw;
#ifndef ATTN_REPS
#define ATTN_REPS 1
#endif
    for (int rep = 0; rep < ATTN_REPS; ++rep)
    for (int item = wa; item < NB * NHA * (SEQ / 512); item += na) attn_block(F, item);
}

__device__ __forceinline__ void p5_xn2(Frame& F) {
    const int gw = F.wg * NWAVES + F.wave, NGW = F.G * NWAVES;
    bf16* XN = (bf16*)(F.ws + WS_XN);
    for (int m = gw; m < T; m += NGW) rms_row_to_bf16(F.lane, F.out + (size_t)m * DM, F.in[15], XN + (size_t)m * DM);
}

constexpr int TK_SKS = 272, TK_SKH = 0, TK_SKL = 2 * 128 * TK_SKS, TK_LUT = 2 * TK_SKL, TK_END = TK_LUT + 8 * 2048;
__device__ __forceinline__ unsigned f2ord(float f) { const unsigned u = __builtin_bit_cast(unsigned, f); return u ^ ((unsigned)((int)u >> 31) | 0x80000000u); }
__device__ __forceinline__ float ord2f(unsigned o) { const unsigned u = (o & 0x80000000u) ? (o ^ 0x80000000u) : ~o; return __builtin_bit_cast(float, u); }
__device__ __forceinline__ void ce_desc(unsigned& a, unsigned& b) { const unsigned mx = a > b ? a : b, mn = a > b ? b : a; a = mx; b = mn; }
template <int N, int OFF, int TOT> __device__ __forceinline__ void bitonic_sort_desc(unsigned (&v)[TOT]) {
#pragma unroll
    for (int k = 2; k <= N; k <<= 1)
#pragma unroll
        for (int j = k >> 1; j > 0; j >>= 1)
#pragma unroll
            for (int i = 0; i < N; ++i) { const int l = i ^ j; if (l > i) { if ((i & k) == 0) ce_desc(v[OFF + i], v[OFF + l]); else ce_desc(v[OFF + l], v[OFF + i]); } }
}
template <int OFFA, int OFFB, int TOT> __device__ __forceinline__ void merge_top16(unsigned (&v)[TOT]) {
#pragma unroll
    for (int i = 0; i < 16; ++i) { const unsigned x = v[OFFA + i], y = v[OFFB + 15 - i]; v[OFFA + i] = x > y ? x : y; }
#pragma unroll
    for (int j = 8; j > 0; j >>= 1)
#pragma unroll
        for (int i = 0; i < 16; ++i) { const int l = i ^ j; if (l > i) ce_desc(v[OFFA + i], v[OFFA + l]); }
}
__device__ __forceinline__ void top16_of_64(unsigned (&k)[64]) {
    bitonic_sort_desc<16, 0, 64>(k); bitonic_sort_desc<16, 16, 64>(k); bitonic_sort_desc<16, 32, 64>(k); bitonic_sort_desc<16, 48, 64>(k);
    merge_top16<0, 16, 64>(k); merge_top16<32, 48, 64>(k); merge_top16<0, 32, 64>(k);
}
__device__ __forceinline__ void p7_topk(Frame& F) {
    static_assert(TK_END <= LDSCTL_OFF, "topk LDS");
    const bf16* QP = (const bf16*)(F.ws + WS_QP);
    int* EID = (int*)(F.ws + WS_EID); float* GATE = (float*)(F.ws + WS_GATE);
    const float* sk = F.in[17];
    LAS unsigned char* lds = F.lds + RING_OFF;
    for (int e = F.tid; e < 2 * 128 * 64; e += NTHREADS) {
        const int c = e >> 13, k = (e >> 6) & 127, d2 = e & 63;
        const f32x2 v = *(const GAS f32x2*)(sk + (size_t)(c * 128 + k) * 128 + 2 * d2);
        const unsigned h0 = f2bf(v.x), h1 = f2bf(v.y);
        const float r0 = v.x - __builtin_bit_cast(float, h0 << 16), r1 = v.y - __builtin_bit_cast(float, h1 << 16);
        *(LAS unsigned*)(lds + TK_SKH + (c * 128 + k) * TK_SKS + d2 * 4) = h0 | (h1 << 16);
        *(LAS unsigned*)(lds + TK_SKL + (c * 128 + k) * TK_SKS + d2 * 4) = pk2(r0, r1);
    }
    __syncthreads();
    const int gw = F.wg * NWAVES + F.wave, NGW = F.G * NWAVES;
    for (int tile = gw; tile < T * PHEADS / 32; tile += NGW) {
        int lane_ = F.lane; asm volatile("" : "+v"(lane_));
        const int lane = lane_, hh = lane >> 5, cl = lane & 31;
        const int P = tile * 32 + cl, t = P >> 3, h = P & 7;
        unsigned kAB[2][16];
#pragma unroll
        for (int c = 0; c < 2; ++c) {
            bf16x8 qf[8];
            const bf16* qp = QP + (size_t)t * PQ + h * 256 + c * 128 + 8 * hh;
#pragma unroll
            for (int s2 = 0; s2 < 8; ++s2) qf[s2] = *(const GAS bf16x8*)(qp + 16 * s2);
            unsigned k[64];
#pragma unroll
            for (int mt = 0; mt < 4; ++mt) {
                f32x16 acc = zero16();
                const LAS unsigned char* ah = lds + TK_SKH + (c * 128 + mt * 32 + cl) * TK_SKS + 16 * hh;
                const LAS unsigned char* al = lds + TK_SKL + (c * 128 + mt * 32 + cl) * TK_SKS + 16 * hh;
#pragma unroll
                for (int s2 = 0; s2 < 8; ++s2) {
                    acc = __builtin_amdgcn_mfma_f32_32x32x16_bf16(*(const LAS bf16x8*)(ah + 32 * s2), qf[s2], acc, 0, 0, 0);
                    acc = __builtin_amdgcn_mfma_f32_32x32x16_bf16(*(const LAS bf16x8*)(al + 32 * s2), qf[s2], acc, 0, 0, 0); }
#pragma unroll
                for (int r = 0; r < 16; ++r) { const int idx = 32 * mt + (r & 3) + 8 * (r >> 2) + 4 * hh; k[mt * 16 + r] = (f2ord(acc[r]) & ~127u) | (unsigned)(127 - idx); }
            }
            top16_of_64(k);
            unsigned m[32];
#pragma unroll
            for (int i = 0; i < 16; ++i) { m[i] = k[i]; m[16 + i] = (unsigned)__shfl_xor((int)k[i], 32); }
            merge_top16<0, 16, 32>(m);
#pragma unroll
            for (int i = 0; i < 16; ++i) kAB[c][i] = m[i];
        }
        float fa[16], fb[16];
#pragma unroll
        for (int i = 0; i < 16; ++i) { fa[i] = ord2f(kAB[0][i] & ~127u); fb[i] = ord2f(kAB[1][i] & ~127u); }
        unsigned cd[64]; int n = 0;
#pragma unroll
        for (int i = 0; i < 16; ++i)
#pragma unroll
            for (int j = 0; j < 16; ++j) if ((i + 1) * (j + 1) <= 16) { cd[n] = (f2ord(fa[i] + fb[j]) & ~255u) | (unsigned)(255 - (i * 16 + j)); ++n; }
#pragma unroll
        for (int q = 50; q < 64; ++q) cd[q] = 0u;
        top16_of_64(cd);
        LAS unsigned char* lut = lds + TK_LUT + (F.wave * 64 + lane) * 32;
#pragma unroll
        for (int q = 0; q < 4; ++q) {
            unsigned wa = 0u, wb = 0u;
#pragma unroll
            for (int b4 = 0; b4 < 4; ++b4) { wa |= (127u - (kAB[0][4 * q + b4] & 127u)) << (8 * b4); wb |= (127u - (kAB[1][4 * q + b4] & 127u)) << (8 * b4); }
            *(LAS unsigned*)(lut + 4 * q) = wa; *(LAS unsigned*)(lut + 16 + 4 * q) = wb; }
        float gv[16]; float den = 0.f; const float mx = ord2f(cd[0] & ~255u);
#pragma unroll
        for (int q = 0; q < 16; ++q) { gv[q] = __expf(ord2f(cd[q] & ~255u) - mx); den += gv[q]; }
        const float inv = 1.f / den;
        asm volatile("s_waitcnt lgkmcnt(0)" ::: "memory");
        int ev[16];
#pragma unroll
        for (int q = 0; q < 16; ++q) { const unsigned pos = 255u - (cd[q] & 255u);
            const unsigned ia = *(const LAS unsigned char*)(lut + (pos >> 4)), ib = *(const LAS unsigned char*)(lut + 16 + (pos & 15u));
            ev[q] = (int)(ia * NKEYS + ib); }
        if (hh == 0) {
            int* ep = EID + (size_t)t * 128 + h * 16; float* gp = GATE + (size_t)t * 128 + h * 16;
#pragma unroll
            for (int q = 0; q < 4; ++q) {
                *(GAS v4u*)(ep + 4 * q) = (v4u){(unsigned)ev[4 * q], (unsigned)ev[4 * q + 1], (unsigned)ev[4 * q + 2], (unsigned)ev[4 * q + 3]};
                *(GAS f32x4*)(gp + 4 * q) = (f32x4){gv[4 * q] * inv, gv[4 * q + 1] * inv, gv[4 * q + 2] * inv, gv[4 * q + 3] * inv}; }
        }
        asm volatile("s_waitcnt lgkmcnt(0)" ::: "memory");
    }
}

constexpr int GA_WAVE_BYTES = 6656, GA_CNT = 4096, GA_OFF = 4096 + 128, GA_ACT = 4608;
__device__ __forceinline__ int wave_sum_i(int v) { v += dppi<0xB1>(v); v += dppi<0x4E>(v); v += dppi<0x141>(v); v += dppi<0x140>(v);
    return (__builtin_amdgcn_readlane(v, 0) + __builtin_amdgcn_readlane(v, 16)) + (__builtin_amdgcn_readlane(v, 32) + __builtin_amdgcn_readlane(v, 48)); }
struct PairBuf { v4u u, v; float su, sv; int e; float g; };
__device__ __forceinline__ void p8_gather(Frame& F, float* outp) {
    const bf16* XN = (const bf16*)(F.ws + WS_XN);
    const unsigned char* UQ = F.ws + WS_UQ; const unsigned char* VQ = F.ws + WS_VQ;
    const float* SU = (const float*)(F.ws + WS_SU); const float* SV = (const float*)(F.ws + WS_SV);
    const int* EID = (const int*)(F.ws + WS_EID); const float* GATE = (const float*)(F.ws + WS_GATE);
    const float* nf = F.in[20];
    const int gw = F.wg * NWAVES + F.wave, NGW = F.G * NWAVES;
    LAS unsigned char* wl = F.lds + RING_OFF + F.wave * GA_WAVE_BYTES;
    for (int tg = gw, sweep = 0; tg < T / 4; tg += NGW, ++sweep) {
        int lane_ = F.lane; asm volatile("" : "+v"(lane_));
        const int lane = lane_;
        int xq[4][4]; float sx[4];
#pragma unroll
        for (int tk = 0; tk < 4; ++tk) {
            const GAS v4u* xp = (const GAS v4u*)(XN + (size_t)(4 * tg + tk) * DM + lane * 16);
            const v4u a = xp[0], b = xp[1];
            float x[16]; x[0] = bflo(a.x); x[1] = bfhi(a.x); x[2] = bflo(a.y); x[3] = bfhi(a.y); x[4] = bflo(a.z); x[5] = bfhi(a.z); x[6] = bflo(a.w); x[7] = bfhi(a.w);
            x[8] = bflo(b.x); x[9] = bfhi(b.x); x[10] = bflo(b.y); x[11] = bfhi(b.y); x[12] = bflo(b.z); x[13] = bfhi(b.z); x[14] = bflo(b.w); x[15] = bfhi(b.w);
            float am = 0.f;
#pragma unroll
            for (int i = 0; i < 16; ++i) am = fmaxf(am, fabsf(x[i]));
            am = wave_max(am);
            sx[tk] = am > 0.f ? am * (1.f / 127.f) : 1.f; const float inv = am > 0.f ? 127.f / am : 0.f;
#pragma unroll
            for (int q = 0; q < 4; ++q) {
                const unsigned b0 = (unsigned)(int)rintf(x[4 * q] * inv) & 255u, b1 = (unsigned)(int)rintf(x[4 * q + 1] * inv) & 255u, b2 = (unsigned)(int)rintf(x[4 * q + 2] * inv) & 255u, b3 = (unsigned)(int)rintf(x[4 * q + 3] * inv) & 255u;
                xq[tk][q] = (int)(b0 | (b1 << 8) | (b2 << 16) | (b3 << 24)); }
        }
        LAS unsigned* cnt = (LAS unsigned*)(wl + GA_CNT); LAS unsigned* offs = (LAS unsigned*)(wl + GA_OFF);
        if (lane < 32) cnt[lane] = 0u;
        asm volatile("s_waitcnt lgkmcnt(0)" ::: "memory");
        int ee[8]; float gg[8]; unsigned pos[8];
#pragma unroll
        for (int tk = 0; tk < 4; ++tk) {
            const size_t base = (size_t)(4 * tg + tk) * 128;
            ee[2 * tk] = (EID[base + lane] & (NEXP - 1)) | (tk << 14); ee[2 * tk + 1] = (EID[base + 64 + lane] & (NEXP - 1)) | (tk << 14);
            gg[2 * tk] = GATE[base + lane]; gg[2 * tk + 1] = GATE[base + 64 + lane]; }
#pragma unroll
        for (int q = 0; q < 8; ++q) pos[q] = __hip_atomic_fetch_add(cnt + ((ee[q] >> 9) & 31), 1u, __ATOMIC_RELAXED, __HIP_MEMORY_SCOPE_WAVEFRONT);
        asm volatile("s_waitcnt lgkmcnt(0)" ::: "memory");
        if (lane < 32) {
            const int c0 = (int)cnt[lane]; int v = c0;
            v += __builtin_amdgcn_update_dpp(0, v, 0x111, 0xF, 0xF, true); v += __builtin_amdgcn_update_dpp(0, v, 0x112, 0xF, 0xF, true);
            v += __builtin_amdgcn_update_dpp(0, v, 0x114, 0xF, 0xF, true); v += __builtin_amdgcn_update_dpp(0, v, 0x118, 0xF, 0xF, true);
            const int row0 = __builtin_amdgcn_readlane(v, 15);
            offs[lane] = (unsigned)(v - c0 + (lane >= 16 ? row0 : 0));
        }
        asm volatile("s_waitcnt lgkmcnt(0)" ::: "memory");
#pragma unroll
        for (int q = 0; q < 8; ++q) { const unsigned idx = offs[(ee[q] >> 9) & 31] + pos[q];
            *(LAS unsigned*)(wl + idx * 4) = (unsigned)ee[q]; *(LAS float*)(wl + 2048 + idx * 4) = gg[q]; }
        asm volatile("s_waitcnt lgkmcnt(0)" ::: "memory");
#define GA_DOT(U, TK) (__builtin_amdgcn_sdot4(xq[TK][3], (int)(U).w, __builtin_amdgcn_sdot4(xq[TK][2], (int)(U).z, __builtin_amdgcn_sdot4(xq[TK][1], (int)(U).y, __builtin_amdgcn_sdot4(xq[TK][0], (int)(U).x, 0, false), false), false), false))
        LAS float* act = (LAS float*)(wl + GA_ACT);
        for (int ch = 0; ch < 32; ++ch) {
            const unsigned ent = *(const LAS unsigned*)(wl + (ch * 16 + (lane >> 2)) * 4);
            const float my_g = *(const LAS float*)(wl + 2048 + (ch * 16 + (lane >> 2)) * 4);
            const int my_e = (int)ent & (NEXP - 1), my_tk = ((int)ent >> 14) & 3;
            const float my_su = SU[my_e], my_sv = SV[my_e];
            int d[16];
            {
                v4u ub[2][8]; int eb[2][8];
#pragma unroll
                for (int q = 0; q < 8; ++q) { eb[0][q] = __builtin_amdgcn_readlane((int)ent, 4 * q); ub[0][q] = *(const GAS v4u*)(UQ + (size_t)(eb[0][q] & (NEXP - 1)) * DM + lane * 16); }
#pragma unroll
                for (int jb = 0; jb < 2; ++jb) {
                    if (jb == 0) {
#pragma unroll
                        for (int q = 0; q < 8; ++q) { eb[1][q] = __builtin_amdgcn_readlane((int)ent, 4 * (8 + q)); ub[1][q] = *(const GAS v4u*)(UQ + (size_t)(eb[1][q] & (NEXP - 1)) * DM + lane * 16); } }
                    __builtin_amdgcn_sched_barrier(0);
#pragma unroll
                    for (int q = 0; q < 8; ++q) { const int tk_ = (eb[jb][q] >> 14) & 3; const v4u u_ = ub[jb][q]; int r_;
                        if (tk_ == 0) r_ = GA_DOT(u_, 0); else if (tk_ == 1) r_ = GA_DOT(u_, 1); else if (tk_ == 2) r_ = GA_DOT(u_, 2); else r_ = GA_DOT(u_, 3);
                        d[8 * jb + q] = r_; }
                    __builtin_amdgcn_sched_barrier(0);
                }
            }
#pragma unroll
            for (int j = 0; j < 8; ++j) { const auto r = __builtin_amdgcn_permlane32_swap((unsigned)d[j], (unsigned)d[j + 8], false, false); d[j] = (int)r[0] + (int)r[1]; }
#pragma unroll
            for (int j = 0; j < 4; ++j) { const auto r = __builtin_amdgcn_permlane16_swap((unsigned)d[j], (unsigned)d[j + 4], false, false); d[j] = (int)r[0] + (int)r[1]; }
#pragma unroll
            for (int j = 0; j < 2; ++j) { const int u_ = d[j] + dppi<0x128>(d[j]), w_ = d[j + 2] + dppi<0x128>(d[j + 2]); d[j] = (lane & 8) ? w_ : u_; }
            { const int u_ = d[0] + dppi<0x141>(d[0]), w_ = d[1] + dppi<0x141>(d[1]); d[0] = (lane & 4) ? w_ : u_; }
            d[0] += dppi<0x4E>(d[0]); d[0] += dppi<0xB1>(d[0]);
            const float sxl = my_tk == 0 ? sx[0] : (my_tk == 1 ? sx[1] : (my_tk == 2 ? sx[2] : sx[3]));
            const float h_ = (float)d[0] * (my_su * sxl);
            const float a_ = 0.5f * h_ * (1.f + erff(h_ * 0.70710678118654752f)) * my_g * my_sv;
            if ((lane & 3) == 0) act[ch * 16 + (lane >> 2)] = a_;
        }
#undef GA_DOT
        asm volatile("s_waitcnt lgkmcnt(0)" ::: "memory");
        float y[4][16]; float yo[4];
#pragma unroll
        for (int tk = 0; tk < 4; ++tk) { yo[tk] = 0.f;
#pragma unroll
            for (int i = 0; i < 16; ++i) y[tk][i] = 0.f; }
#define GA_AXPY(V, A, TK) do { yo[TK] += (A) * 128.f; \
            _Pragma("unroll") for (int q_ = 0; q_ < 4; ++q_) { const unsigned w_ = (V)[q_]; \
                y[TK][4 * q_] += (A) * (float)(w_ & 255u); y[TK][4 * q_ + 1] += (A) * (float)((w_ >> 8) & 255u); y[TK][4 * q_ + 2] += (A) * (float)((w_ >> 16) & 255u); y[TK][4 * q_ + 3] += (A) * (float)(w_ >> 24); } } while (0)
        for (int ch = 0; ch < 8; ++ch) {
            const unsigned ent = *(const LAS unsigned*)(wl + (ch * 64 + lane) * 4);
            const float areg = act[ch * 64 + lane];
            v4u vb[2][8]; int eb[2][8];
#pragma unroll
            for (int q = 0; q < 8; ++q) { eb[0][q] = __builtin_amdgcn_readlane((int)ent, q); vb[0][q] = *(const GAS v4u*)(VQ + (size_t)(eb[0][q] & (NEXP - 1)) * DM + lane * 16); }
#pragma unroll
            for (int jb = 0; jb < 8; ++jb) {
                if (jb + 1 < 8) {
#pragma unroll
                    for (int q = 0; q < 8; ++q) { eb[(jb + 1) & 1][q] = __builtin_amdgcn_readlane((int)ent, 8 * (jb + 1) + q); vb[(jb + 1) & 1][q] = *(const GAS v4u*)(VQ + (size_t)(eb[(jb + 1) & 1][q] & (NEXP - 1)) * DM + lane * 16); } }
                __builtin_amdgcn_sched_barrier(0);
#pragma unroll
                for (int q = 0; q < 8; ++q) { const int tk_ = (eb[jb & 1][q] >> 14) & 3; const v4u v_ = vb[jb & 1][q]; const float a_ = rdlane(areg, 8 * jb + q);
                    if (tk_ == 0) GA_AXPY(v_, a_, 0); else if (tk_ == 1) GA_AXPY(v_, a_, 1); else if (tk_ == 2) GA_AXPY(v_, a_, 2); else GA_AXPY(v_, a_, 3); }
                __builtin_amdgcn_sched_barrier(0);
            }
        }
#undef GA_AXPY
#pragma unroll
        for (int tk = 0; tk < 4; ++tk) {
            float* hrow = F.out + (size_t)(4 * tg + tk) * DM + lane * 16;
            float hv[16]; float ss = 0.f;
#pragma unroll
            for (int q = 0; q < 4; ++q) { const f32x4 h4 = *(const GAS f32x4*)(hrow + 4 * q);
#pragma unroll
                for (int i = 0; i < 4; ++i) { const float v = h4[i] + (y[tk][4 * q + i] - yo[tk]); hv[4 * q + i] = v; ss += v * v; } }
            const float rstd = frsq(wave_sum(ss) * (1.f / DM) + RMS_EPS);
#pragma unroll
            for (int q = 0; q < 4; ++q) { const f32x4 n4 = *(const GAS f32x4*)(nf + lane * 16 + 4 * q);
                *(GAS f32x4*)(outp + (size_t)(4 * tg + tk) * DM + lane * 16 + 4 * q) = (f32x4){hv[4 * q] * rstd * n4[0], hv[4 * q + 1] * rstd * n4[1], hv[4 * q + 2] * rstd * n4[2], hv[4 * q + 3] * rstd * n4[3]}; }
        }
    }
}

struct Args { const float* in[21]; float* out; unsigned char* ws; int ph_lo, ph_hi; };
static_assert(sizeof(Args) == 21 * 8 + 8 + 8 + 8, "Args has no padding");

__global__ void __launch_bounds__(NTHREADS, 2) fwd_kernel(Args args) {
    extern __shared__ __attribute__((aligned(16))) unsigned char lds[];
    Frame F;
    F.lds = (LAS unsigned char*)lds;
    F.MISC = (volatile LAS unsigned*)(F.lds + MISC_OFF);
    F.tid = threadIdx.x; F.lane = F.tid & 63; F.wave = __builtin_amdgcn_readfirstlane(F.tid >> 6);
    F.G = gridDim.x; F.wg = blockIdx.x;
#pragma unroll
    for (int i = 0; i < 21; ++i) F.in[i] = args.in[i];
    F.out = args.out; F.ws = args.ws;
    F.ctl = (gu32*)(args.ws + WS_CTL);
    for (int u = F.tid; u < (LDS_BYTES - LDSCTL_OFF) / 4; u += NTHREADS) ((LAS unsigned*)(F.lds + LDSCTL_OFF))[u] = 0u;
    __syncthreads();
    const int lo = args.ph_lo, hi = args.ph_hi;
    const bool fused = (hi - lo) > 1;
    XcdBarrier bar; bar.bar = (unsigned*)(F.ctl + CW_BAR); bar.x = 0; bar.st = nullptr;
    if (fused) bar = xcd_barrier_post((unsigned*)(F.ctl + CW_BAR), F.MISC + 8);
#define IN(k) (lo <= (k) && (k) < hi)
#define REPS(k) (((REP_MASK >> (k)) & 1) ? 2 : 1)
#define REPLOOP(k) for (int rep_ = 0; rep_ < REPS(k); ++rep_, (rep_ < REPS(k) ? xcd_barrier(bar) : (void)0))
#define SEAM(k) do { if (IN(k) && IN((k) + 1)) xcd_barrier(bar); } while (0)

    if (IN(0)) { REPLOOP(0) { p0_prologue(F); p0_rope_table(F); } SEAM(0); }
    if (IN(1)) { REPLOOP(1) {
        pg8::Gemm g{(const bf16*)(F.ws + WS_XN), (const bf16*)(F.ws + WS_WIN), T, IN_COLS, DM}; pg8::StaticOrder S; S.init(T, IN_COLS, F.G, F.wg);
        pg8::EpiBf16 E{(bf16*)(F.ws + WS_Z), IN_COLS};
        pg8::gemm_phase<pg8::EpiBf16, pg8::StaticOrder, true, true>(F.lds + RING_OFF, g, S, E); }
        SEAM(1);
    }
    if (IN(2)) { p2_rope(F); REPLOOP(2) { const int cnt = r13_count(F.wg, F.G); R1Pre P;
            if (cnt > 0) rwkv_r1_prefetch(F, r13_item(F.wg, F.G, 0), F.tid, P);
            for (int i = 0; i < cnt; ++i) rwkv_r1_item(F, r13_item(F.wg, F.G, i), i + 1 < cnt ? r13_item(F.wg, F.G, i + 1) : -1, P); }
        SEAM(2); }
    if (IN(3)) { REPLOOP(3) p3_mixers(F); SEAM(3); }
    if (IN(4)) { REPLOOP(4) for (int item = F.wg; item < NB * NHR * 128; item += F.G) rwkv_r3_item(F, item); SEAM(4); }
    if (IN(5)) { REPLOOP(5) {
        pg8::Gemm g{(const bf16*)(F.ws + WS_YMIX), (const bf16*)(F.ws + WS_WOUT), T, DM, DM}; pg8::StaticOrder S; S.init(T, DM, F.G, F.wg);
        pg8::EpiF32Res E{F.in[0], F.out, DM};
        pg8::gemm_phase<pg8::EpiF32Res, pg8::StaticOrder, true, true>(F.lds + RING_OFF, g, S, E); }
        SEAM(5);
    }
    if (IN(6)) { REPLOOP(6) p5_xn2(F); SEAM(6); }
    if (IN(7)) { REPLOOP(7) {
        pg8::Gemm g{(const bf16*)(F.ws + WS_XN), (const bf16*)(F.ws + WS_WQ), T, PQ, DM}; pg8::StaticOrder S; S.init(T, PQ, F.G, F.wg);
        pg8::EpiBf16 E{(bf16*)(F.ws + WS_QP), PQ};
        pg8::gemm_phase<pg8::EpiBf16, pg8::StaticOrder, true, true>(F.lds + RING_OFF, g, S, E); }
        SEAM(7);
    }
    if (IN(8)) { REPLOOP(8) p7_topk(F); SEAM(8); }
    if (IN(9)) { if (REPS(9) > 1) { p8_gather(F, (float*)(F.ws + WS_Z)); xcd_barrier(bar); } p8_gather(F, F.out); }
#undef IN
#undef SEAM
}

extern "C" void kernel_launch(void* const* d_in, const int* in_sizes, int n_in, void* d_out, int out_size, void* d_ws, size_t ws_size, hipStream_t stream) {
    static int grid = 0;
    if (grid == 0) {
        if (n_in != 21 || in_sizes[0] != T * DM || out_size != T * DM || ws_size < WS_END) {
            fprintf(stderr, "kernel_launch: unexpected shapes: n_in %d in0 %d out %d ws %zu (need %zu); nothing launched\n", n_in, n_in > 0 ? in_sizes[0] : -1, out_size, ws_size, (size_t)WS_END); grid = -1; return; }
        int dev = 0, cus = 0, per_cu = 0;
        if (hipGetDevice(&dev) != hipSuccess || hipDeviceGetAttribute(&cus, hipDeviceAttributeMultiprocessorCount, dev) != hipSuccess) { grid = -1; return; }
        if (hipFuncSetAttribute((const void*)fwd_kernel, hipFuncAttributeMaxDynamicSharedMemorySize, LDS_BYTES) != hipSuccess) { fprintf(stderr, "kernel_launch: hipFuncSetAttribute failed\n"); grid = -1; return; }
        if (hipOccupancyMaxActiveBlocksPerMultiprocessor(&per_cu, (const void*)fwd_kernel, NTHREADS, LDS_BYTES) != hipSuccess || per_cu < 1) { fprintf(stderr, "kernel_launch: occupancy query says %d\n", per_cu); per_cu = 1; }
        (void)hipGetLastError();
        grid = cus;
    }
    if (grid < 0) return;
    (void)hipMemsetAsync((char*)d_ws + WS_CTL, 0, CTL_ZERO_BYTES, stream);
    Args a{};
    for (int i = 0; i < 21; ++i) a.in[i] = (const float*)d_in[i];
    a.out = (float*)d_out; a.ws = (unsigned char*)d_ws;
    if (MK_N_LAUNCHES == 1) {
        a.ph_lo = 0; a.ph_hi = NPHASE;
        void* kargs[] = {&a};
        hipError_t e = hipLaunchCooperativeKernel((const void*)fwd_kernel, dim3(grid), dim3(NTHREADS), kargs, LDS_BYTES, stream);
        if (e != hipSuccess) fprintf(stderr, "kernel_launch: cooperative launch failed: %s (grid %d)\n", hipGetErrorString(e), grid);
    } else {
        for (int p = 0; p < NPHASE; ++p) { a.ph_lo = p; a.ph_hi = p + 1;
            hipLaunchKernelGGL(fwd_kernel, dim3(grid), dim3(NTHREADS), LDS_BYTES, stream, a); }
    }
}
```

```cpp
#include <hip/hip_runtime.h>
#include <cstdio>
#include <cstdint>

#ifndef MK_N_LAUNCHES
#define MK_N_LAUNCHES 1
#endif

#ifndef REP_MASK
#define REP_MASK 0
#endif
#define GAS __attribute__((address_space(1)))
#define LAS __attribute__((address_space(3)))
typedef unsigned short bf16;
typedef unsigned v4u __attribute__((ext_vector_type(4)));
typedef unsigned v2u __attribute__((ext_vector_type(2)));
typedef float f32x4 __attribute__((ext_vector_type(4)));
typedef float f32x2 __attribute__((ext_vector_type(2)));
typedef short bf16x8 __attribute__((ext_vector_type(8)));
typedef GAS unsigned gu32;
#define RLX_AGENT __ATOMIC_RELAXED, __HIP_MEMORY_SCOPE_AGENT
#define LDS_WAIT() asm volatile("s_waitcnt lgkmcnt(0)" ::: "memory")
#define VM_WAIT() asm volatile("s_waitcnt vmcnt(0)" ::: "memory")
#define LDS_BARRIER() do { asm volatile("s_waitcnt lgkmcnt(0)" ::: "memory"); __builtin_amdgcn_s_barrier(); asm volatile("" ::: "memory"); } while (0)

constexpr int DM = 1024, NB = 4, SEQ = 8192, T = NB * SEQ;
constexpr int HD = 64, RWW = 512, NHR = 8, NHA = 8;
constexpr int IN_COLS = 3328;
constexpr int C_R = 0, C_K = 512, C_V = 1024, C_WD = 1536, C_AD = 1600, C_GD = 1664, C_AQ = 1792, C_AK = 2304, C_AV = 2816;
constexpr int PHEADS = 8, NKEYS = 128, PQ = 2048, TOPK = 16, NEXP = 16384;
constexpr float RMS_EPS = 1e-6f, GN_EPS = 64e-5f;
constexpr int NWAVES = 8, NTHREADS = 512;
constexpr int NPHASE = 9;

constexpr size_t MiB = 1u << 20;
constexpr size_t WS_CTL = 0, CTL_ZERO_BYTES = 1 * MiB;
constexpr size_t WS_WIN = 2 * MiB;
constexpr size_t WS_WOUT = 10 * MiB;
constexpr size_t WS_WQ = 12 * MiB;
constexpr size_t WS_XN = 16 * MiB;
constexpr size_t WS_Z = 80 * MiB;
constexpr size_t WS_QP = 80 * MiB;
constexpr size_t WS_G = 288 * MiB;
constexpr size_t WS_YMIX = 352 * MiB;
constexpr size_t WS_UQ = 416 * MiB;
constexpr size_t WS_VQ = 432 * MiB;
constexpr size_t WS_SU = 448 * MiB;
constexpr size_t WS_SV = 449 * MiB;
constexpr size_t WS_EID = 480 * MiB;
constexpr size_t WS_GATE = 496 * MiB;
constexpr size_t WS_END = 512 * MiB;
constexpr size_t WS_WUPT = 1 * MiB, WS_AUPT = WS_WUPT + 65536, WS_GUPT = WS_AUPT + 65536;
constexpr size_t WS_BONUS = 9 * MiB;
constexpr size_t WS_RWY0 = WS_XN;
constexpr size_t WS_RWSS = WS_G;
constexpr size_t WS_RWRH = WS_EID;

constexpr int CW_BAR = 4096;
constexpr size_t WS_SSQ = 256 * 1024;

typedef __bf16 hbf16x2_t __attribute__((ext_vector_type(2)));
__device__ __forceinline__ unsigned pk2(float lo, float hi) { const f32x2 v = {lo, hi}; const hbf16x2_t b = __builtin_convertvector(v, hbf16x2_t); return __builtin_bit_cast(unsigned, b); }
__device__ __forceinline__ unsigned f2bf(float f) { return pk2(f, 0.f) & 0xffffu; }
__device__ __forceinline__ float frcp(float x) { return __builtin_amdgcn_rcpf(x); }
__device__ __forceinline__ float frsq(float x) { return __builtin_amdgcn_rsqf(x); }
__device__ __forceinline__ float bflo(unsigned u) { return __builtin_bit_cast(float, u << 16); }
__device__ __forceinline__ float bfhi(unsigned u) { return __builtin_bit_cast(float, u & 0xffff0000u); }
__device__ __forceinline__ float bf2f(bf16 h) { return __builtin_bit_cast(float, (unsigned)h << 16); }

template <int CTRL> __device__ __forceinline__ float dppf(float x) { return __builtin_bit_cast(float, __builtin_amdgcn_update_dpp(0, __builtin_bit_cast(int, x), CTRL, 0xF, 0xF, true)); }
template <int CTRL> __device__ __forceinline__ int dppi(int x) { return __builtin_amdgcn_update_dpp(0, x, CTRL, 0xF, 0xF, true); }
__device__ __forceinline__ float rdlane(float v, int l) { return __builtin_bit_cast(float, __builtin_amdgcn_readlane(__builtin_bit_cast(int, v), l)); }
__device__ __forceinline__ float sum8(float v) { v += dppf<0xB1>(v); v += dppf<0x4E>(v); v += dppf<0x141>(v); return v; }
__device__ __forceinline__ float sum16(float v) { v = sum8(v); v += dppf<0x140>(v); return v; }
__device__ __forceinline__ float wave_sum(float v) { v = sum16(v);
    v += __builtin_bit_cast(float, __builtin_amdgcn_update_dpp(0, __builtin_bit_cast(int, v), 0x142, 0xA, 0xF, false));
    v += __builtin_bit_cast(float, __builtin_amdgcn_update_dpp(0, __builtin_bit_cast(int, v), 0x143, 0xC, 0xF, false));
    return rdlane(v, 63); }
__device__ __forceinline__ float wave_max(float v) {
    v = fmaxf(v, dppf<0xB1>(v)); v = fmaxf(v, dppf<0x4E>(v)); v = fmaxf(v, dppf<0x141>(v)); v = fmaxf(v, dppf<0x140>(v));
    return fmaxf(fmaxf(rdlane(v, 0), rdlane(v, 16)), fmaxf(rdlane(v, 32), rdlane(v, 48)));
}
__device__ __forceinline__ int wave_min_i(int v) {
    v = min(v, dppi<0xB1>(v)); v = min(v, dppi<0x4E>(v)); v = min(v, dppi<0x141>(v)); v = min(v, dppi<0x140>(v));
    return min(min(__builtin_amdgcn_readlane(v, 0), __builtin_amdgcn_readlane(v, 16)), min(__builtin_amdgcn_readlane(v, 32), __builtin_amdgcn_readlane(v, 48)));
}

namespace pg8 {
#define PG8_LAS __attribute__((address_space(3)))
typedef unsigned short bf16_t;
typedef unsigned u32x4 __attribute__((ext_vector_type(4)));
constexpr int BM = 256, BK = 64, HALF = 128, HTB = HALF * BK * 2, STAGE_BYTES = 8 * HTB, NXCD = 8, WGM = 8;
__host__ __device__ __forceinline__ int lds_byte(int r, int c) { const int st = (r >> 4) * 2 + (c >> 5), rr = r & 15, cc = c & 31, ob = rr * 64 + cc * 2; return st * 1024 + (ob ^ (((ob >> 9) & 1) << 5)); }
__host__ __device__ __forceinline__ void stage_rc(int b, int& R, int& C) { const int st = b / 1024, sb = b % 1024, swz = sb ^ (((sb >> 9) & 1) << 5); R = (st >> 1) * 16 + swz / 64; C = (st & 1) * 32 + (swz % 64) / 2; }
__host__ __device__ __forceinline__ int perm32(int rho) { const int n = rho >> 4, i = rho & 15; return 8 * (i >> 2) + 4 * n + (i & 3); }
struct Unit { int pm, pn; };
struct Gemm { const bf16_t* A; const bf16_t* Bt; int M, N, K; };
struct StaticOrder {
    int nM, nN, nwg, G, c;
    __host__ __device__ void init(int M, int N, int G_, int c_) { nM = M / BM; nN = N / BM; nwg = nM * nN; G = G_; c = c_; }
    __host__ __device__ bool next(int i, Unit& u) const {
        const long L = (long)i * G + c; if (L >= nwg) return false;
        int wgid = (int)L; { const int q = nwg / NXCD, r = nwg % NXCD, xcd = wgid % NXCD, off = wgid / NXCD; wgid = (xcd < r ? xcd * (q + 1) : r * (q + 1) + (xcd - r) * q) + off; }
        const int nig = WGM * nN, gid = wgid / nig, fm = gid * WGM, gsz = (nM - fm) < WGM ? (nM - fm) : WGM;
        u.pm = fm + ((wgid % nig) % gsz); u.pn = (wgid % nig) / gsz; return true;
    }
    __device__ __forceinline__ void a_ready(const Unit&) const {}
    __device__ __forceinline__ void done(const Unit&) const {}
};
__device__ __forceinline__ unsigned cvt_pk_bf16(float lo, float hi) { unsigned r; asm volatile("v_cvt_pk_bf16_f32 %0, %1, %2" : "=v"(r) : "v"(lo), "v"(hi)); return r; }
struct EpiBf16 {
    static constexpr bool PERM = true, AFTER_DRAIN = false;
    bf16_t* O; int ldc;
    __device__ __forceinline__ void operator()(const f32x4 (&acc)[2][2][4][2], const Unit& u, int wr, int wc, int fr, int fq) const {
        const int row0 = u.pm * BM + wr * 64 + fr; const int col0 = u.pn * BM + wc * 32 + 8 * fq;
#pragma unroll
        for (int ai = 0; ai < 2; ++ai)
#pragma unroll
            for (int m = 0; m < 4; ++m) { bf16_t* rowp = O + (size_t)(row0 + ai * HALF + m * 16) * ldc + col0;
#pragma unroll
                for (int bj = 0; bj < 2; ++bj) { const f32x4 v0 = acc[ai][bj][m][0], v1 = acc[ai][bj][m][1];
                    u32x4 w; w.x = cvt_pk_bf16(v0[0], v0[1]); w.y = cvt_pk_bf16(v0[2], v0[3]); w.z = cvt_pk_bf16(v1[0], v1[1]); w.w = cvt_pk_bf16(v1[2], v1[3]);
                    *(u32x4*)(rowp + bj * HALF) = w; } }
    }
};
struct EpiF32Res {
    static constexpr bool PERM = true, AFTER_DRAIN = false;
    const float* res; float* O; int ldc; bf16_t* HG; const float* gain; float* ssq;
    __device__ __forceinline__ void operator()(const f32x4 (&acc)[2][2][4][2], const Unit& u, int wr, int wc, int fr, int fq) const {
        const int row0 = u.pm * BM + wr * 64 + fr; const int col0 = u.pn * BM + wc * 32 + 8 * fq;
        f32x4 gv[2][2];
#pragma unroll
        for (int bj = 0; bj < 2; ++bj) { gv[bj][0] = *(const f32x4*)(gain + col0 + bj * HALF); gv[bj][1] = *(const f32x4*)(gain + col0 + bj * HALF + 4); }
#pragma unroll
        for (int ai = 0; ai < 2; ++ai)
#pragma unroll
            for (int m = 0; m < 4; ++m) { const int row = row0 + ai * HALF + m * 16; const size_t off = (size_t)row * ldc + col0; float sq = 0.f;
#pragma unroll
                for (int bj = 0; bj < 2; ++bj) { const f32x4 r0 = *(const f32x4*)(res + off + bj * HALF), r1 = *(const f32x4*)(res + off + bj * HALF + 4);
                    const f32x4 h0 = acc[ai][bj][m][0] + r0, h1 = acc[ai][bj][m][1] + r1;
                    *(f32x4*)(O + off + bj * HALF) = h0; *(f32x4*)(O + off + bj * HALF + 4) = h1;
                    sq += (h0[0] * h0[0] + h0[1] * h0[1]) + (h0[2] * h0[2] + h0[3] * h0[3]) + (h1[0] * h1[0] + h1[1] * h1[1]) + (h1[2] * h1[2] + h1[3] * h1[3]);
                    const f32x4 g0 = gv[bj][0], g1 = gv[bj][1];
                    u32x4 w; w.x = cvt_pk_bf16(h0[0] * g0[0], h0[1] * g0[1]); w.y = cvt_pk_bf16(h0[2] * g0[2], h0[3] * g0[3]); w.z = cvt_pk_bf16(h1[0] * g1[0], h1[1] * g1[1]); w.w = cvt_pk_bf16(h1[2] * g1[2], h1[3] * g1[3]);
                    *(u32x4*)(HG + off + bj * HALF) = w; }
                sq += __shfl_xor(sq, 16); sq += __shfl_xor(sq, 32);
                if (fq == 0) atomicAdd(ssq + row, sq); }
    }
};
struct EpiBf16Rs {
    static constexpr bool PERM = true, AFTER_DRAIN = false;
    bf16_t* O; int ldc; const float* ssq;
    __device__ __forceinline__ void operator()(const f32x4 (&acc)[2][2][4][2], const Unit& u, int wr, int wc, int fr, int fq) const {
        const int row0 = u.pm * BM + wr * 64 + fr; const int col0 = u.pn * BM + wc * 32 + 8 * fq;
#pragma unroll
        for (int ai = 0; ai < 2; ++ai)
#pragma unroll
            for (int m = 0; m < 4; ++m) { const int row = row0 + ai * HALF + m * 16; bf16_t* rowp = O + (size_t)row * ldc + col0;
                const float rs = __builtin_amdgcn_rsqf(ssq[row] * (1.f / 1024.f) + 1e-6f);
#pragma unroll
                for (int bj = 0; bj < 2; ++bj) { const f32x4 v0 = acc[ai][bj][m][0] * rs, v1 = acc[ai][bj][m][1] * rs;
                    u32x4 w; w.x = cvt_pk_bf16(v0[0], v0[1]); w.y = cvt_pk_bf16(v0[2], v0[3]); w.z = cvt_pk_bf16(v1[0], v1[1]); w.w = cvt_pk_bf16(v1[2], v1[3]);
                    *(u32x4*)(rowp + bj * HALF) = w; } }
    }
};

template <class Epi, class Sched, bool ALIGN_EPI = false, bool SP2 = false>
__device__ __forceinline__ void gemm_phase(PG8_LAS unsigned char* lds, const Gemm g, const Sched& S, const Epi& E) {
    const int tid = threadIdx.x, wid = __builtin_amdgcn_readfirstlane(tid >> 6), lane = tid & 63, wr = wid >> 2, wc = wid & 3, fr = lane & 15, fq = lane >> 4;
    const int K = g.K, nt = K / BK;
    unsigned voffA[2], voffB[2];
#pragma unroll
    for (int i = 0; i < 2; ++i) { int R, C; stage_rc(tid * 16 + i * 8192, R, C); const int Rb = Epi::PERM ? ((R & ~31) + perm32(R & 31)) : R;
        voffA[i] = (unsigned)(R * K + C) * 2u; voffB[i] = (unsigned)(Rb * K + C) * 2u; }
    const size_t kstep = (size_t)(BK * 2);
    const size_t hstep = (size_t)HALF * K * 2;
    const size_t tstep = 2 * hstep;
    const unsigned ldsw = (unsigned)wid * 1024u;
    const int aoff = lds_byte(wr * 64 + fr, fq * 8), boff = lds_byte(wc * 32 + fr, fq * 8);
#define PG8_SA(b, h) (((b) * 2 + (h)) * HTB)
#define PG8_SB(b, h) ((4 + (b) * 2 + (h)) * HTB)
#define PG8_STAGE(bufoff, gbase, voff) do { _Pragma("unroll") for (int _i = 0; _i < 2; ++_i) \
        __builtin_amdgcn_global_load_lds((const unsigned*)((const char*)(gbase) + (voff)[_i]), (PG8_LAS unsigned*)(lds + (bufoff) + ldsw + _i * 8192), 16, 0, 0); } while (0)
#define PG8_LDA(dst, b, h) do { _Pragma("unroll") for (int m = 0; m < 4; ++m) _Pragma("unroll") for (int k = 0; k < 2; ++k) dst[m][k] = *(const PG8_LAS bf16x8*)(lds + PG8_SA(b, h) + aoff + m * 2048 + k * 1024); } while (0)
#define PG8_LDB(dst, b, h) do { _Pragma("unroll") for (int n = 0; n < 2; ++n) _Pragma("unroll") for (int k = 0; k < 2; ++k) dst[n][k] = *(const PG8_LAS bf16x8*)(lds + PG8_SB(b, h) + boff + n * 2048 + k * 1024); } while (0)
#define PG8_MMA(ai, bj, At, Bt) do { __builtin_amdgcn_s_setprio(1); _Pragma("unroll") for (int m = 0; m < 4; ++m) _Pragma("unroll") for (int n = 0; n < 2; ++n) _Pragma("unroll") for (int k = 0; k < 2; ++k) \
        acc[ai][bj][m][n] = __builtin_amdgcn_mfma_f32_16x16x32_bf16(Bt[n][k], At[m][k], acc[ai][bj][m][n], 0, 0, 0); __builtin_amdgcn_s_setprio(0); } while (0)
#define PG8_WAIT_V(n) asm volatile("s_waitcnt vmcnt(" #n ")" ::: "memory")
#define PG8_WAIT_L(n) asm volatile("s_waitcnt lgkmcnt(" #n ")" ::: "memory")
#define PG8_BAR __builtin_amdgcn_s_barrier()
#define PG8_SCHED __builtin_amdgcn_sched_barrier(0)
    Unit cur, nxt; int ui = 0;
    if (!S.next(0, cur)) return;
    f32x4 acc[2][2][4][2];
#pragma unroll
    for (int a = 0; a < 2; ++a)
#pragma unroll
        for (int b = 0; b < 2; ++b)
#pragma unroll
            for (int m = 0; m < 4; ++m)
#pragma unroll
                for (int n = 0; n < 2; ++n) acc[a][b][m][n] = (f32x4){0.f, 0.f, 0.f, 0.f};
    bf16x8 At[4][2], B0[2][2], B1[2][2];
    const char* cA = (const char*)g.A + (size_t)cur.pm * tstep; const char* cB = (const char*)g.Bt + (size_t)cur.pn * tstep;
    S.a_ready(cur);
    if constexpr (SP2) {
        PG8_STAGE(PG8_SB(0, 0), cB, voffB); PG8_STAGE(PG8_SB(0, 1), cB + hstep, voffB); PG8_STAGE(PG8_SA(0, 0), cA, voffA); PG8_STAGE(PG8_SA(0, 1), cA + hstep, voffA);
        if (wr == 1) PG8_BAR;
        PG8_WAIT_V(2); PG8_BAR;
        PG8_STAGE(PG8_SB(1, 0), cB + kstep, voffB); PG8_STAGE(PG8_SA(1, 0), cA + kstep, voffA); PG8_STAGE(PG8_SB(1, 1), cB + hstep + kstep, voffB);
        PG8_WAIT_V(6); PG8_BAR;
    } else {
        PG8_STAGE(PG8_SB(0, 0), cB, voffB); PG8_STAGE(PG8_SA(0, 0), cA, voffA); PG8_STAGE(PG8_SB(0, 1), cB + hstep, voffB); PG8_STAGE(PG8_SA(0, 1), cA + hstep, voffA);
        if (wr == 1) PG8_BAR;
        PG8_WAIT_V(4); PG8_BAR;
        PG8_STAGE(PG8_SB(1, 0), cB + kstep, voffB); PG8_STAGE(PG8_SA(1, 0), cA + kstep, voffA); PG8_STAGE(PG8_SB(1, 1), cB + hstep + kstep, voffB);
        PG8_WAIT_V(6); PG8_BAR;
    }
    for (;;) {
        const bool has_next = S.next(ui + 1, nxt);
        const char* nA = has_next ? (const char*)g.A + (size_t)nxt.pm * tstep : cA; const char* nB = has_next ? (const char*)g.Bt + (size_t)nxt.pn * tstep : cB;
        for (int t = 0; t < nt; t += 2) {
            const bool last = (t == nt - 2);
            const char* a1 = cA + (size_t)(t + 1) * kstep;
            const char* a2 = last ? nA : cA + (size_t)(t + 2) * kstep; const char* b2 = last ? nB : cB + (size_t)(t + 2) * kstep;
            const char* a3 = a2 + kstep; const char* b3 = b2 + kstep;
            if (last && has_next) S.a_ready(nxt);
            if constexpr (SP2) {
            PG8_LDB(B0, 0, 0); PG8_LDB(B1, 0, 1); PG8_SCHED; PG8_LDA(At, 0, 0); PG8_STAGE(PG8_SA(1, 1), a1 + hstep, voffA);
            PG8_WAIT_V(8); PG8_WAIT_L(0); PG8_BAR; PG8_MMA(0, 0, At, B0); PG8_MMA(0, 1, At, B1); PG8_BAR; PG8_SCHED;
            PG8_LDA(At, 0, 1); PG8_STAGE(PG8_SB(0, 0), b2, voffB); PG8_STAGE(PG8_SB(0, 1), b2 + hstep, voffB); PG8_STAGE(PG8_SA(0, 0), a2, voffA);
            PG8_WAIT_V(8); PG8_WAIT_L(0); PG8_BAR; PG8_MMA(1, 0, At, B0); PG8_MMA(1, 1, At, B1); PG8_BAR; PG8_SCHED;
            PG8_LDB(B0, 1, 0); PG8_LDB(B1, 1, 1); PG8_SCHED; PG8_LDA(At, 1, 0); PG8_STAGE(PG8_SA(0, 1), a2 + hstep, voffA);
            PG8_WAIT_V(8); PG8_WAIT_L(0); PG8_BAR; PG8_MMA(0, 0, At, B0); PG8_MMA(0, 1, At, B1); PG8_BAR; PG8_SCHED;
            PG8_LDA(At, 1, 1); PG8_STAGE(PG8_SB(1, 0), b3, voffB); PG8_STAGE(PG8_SB(1, 1), b3 + hstep, voffB); PG8_STAGE(PG8_SA(1, 0), a3, voffA);
            PG8_WAIT_V(8); PG8_WAIT_L(0); PG8_BAR; PG8_MMA(1, 0, At, B0); PG8_MMA(1, 1, At, B1); PG8_BAR; PG8_SCHED;
            } else {
            PG8_LDB(B0, 0, 0); PG8_SCHED; PG8_LDA(At, 0, 0); PG8_STAGE(PG8_SA(1, 1), a1 + hstep, voffA);
            PG8_WAIT_L(8); PG8_BAR; PG8_WAIT_L(0); PG8_MMA(0, 0, At, B0); PG8_BAR; PG8_SCHED;
            PG8_LDB(B1, 0, 1); PG8_STAGE(PG8_SB(0, 0), b2, voffB);
            PG8_BAR; PG8_WAIT_L(0); PG8_MMA(0, 1, At, B1); PG8_BAR;
            PG8_LDA(At, 0, 1); PG8_STAGE(PG8_SA(0, 0), a2, voffA);
            PG8_BAR; PG8_WAIT_L(0); PG8_MMA(1, 0, At, B0); PG8_BAR; PG8_SCHED;
            PG8_STAGE(PG8_SB(0, 1), b2 + hstep, voffB);
            PG8_WAIT_V(6); PG8_BAR; PG8_MMA(1, 1, At, B1); PG8_BAR;
            PG8_LDB(B0, 1, 0); PG8_SCHED; PG8_LDA(At, 1, 0); PG8_STAGE(PG8_SA(0, 1), a2 + hstep, voffA);
            PG8_WAIT_L(8); PG8_BAR; PG8_WAIT_L(0); PG8_MMA(0, 0, At, B0); PG8_BAR; PG8_SCHED;
            PG8_LDB(B1, 1, 1); PG8_STAGE(PG8_SB(1, 0), b3, voffB);
            PG8_BAR; PG8_WAIT_L(0); PG8_MMA(0, 1, At, B1); PG8_BAR;
            PG8_LDA(At, 1, 1); PG8_STAGE(PG8_SA(1, 0), a3, voffA);
            PG8_BAR; PG8_WAIT_L(0); PG8_MMA(1, 0, At, B0); PG8_BAR; PG8_SCHED;
            PG8_STAGE(PG8_SB(1, 1), b3 + hstep, voffB);
            PG8_WAIT_V(6); PG8_BAR; PG8_MMA(1, 1, At, B1); PG8_BAR;
            }
        }
        if constexpr (ALIGN_EPI) { if (wr == 0) PG8_BAR; }
        if constexpr (!Epi::AFTER_DRAIN) { E(acc, cur, wr, wc, fr, fq); S.done(cur); }
        if (!has_next) break;
#pragma unroll
        for (int a = 0; a < 2; ++a)
#pragma unroll
            for (int b = 0; b < 2; ++b)
#pragma unroll
                for (int m = 0; m < 4; ++m)
#pragma unroll
                    for (int n = 0; n < 2; ++n) acc[a][b][m][n] = (f32x4){0.f, 0.f, 0.f, 0.f};
        cur = nxt; cA = nA; cB = nB; ++ui;
        if constexpr (ALIGN_EPI) { if (wr == 1) PG8_BAR; }
    }
    PG8_WAIT_V(0);
    if constexpr (!ALIGN_EPI) { if (wr == 0) PG8_BAR; }
    PG8_BAR;
#undef PG8_SA
#undef PG8_SB
#undef PG8_STAGE
#undef PG8_LDA
#undef PG8_LDB
#undef PG8_MMA
#undef PG8_WAIT_V
#undef PG8_WAIT_L
#undef PG8_BAR
#undef PG8_SCHED
}
}

#define XB_TMO      128
#define XB_XCNT(j)  (256  + 64 * (j))
#define XB_XSUB(j)  (1280 + 64 * (j))
#define XB_XGEN(j)  (2304 + 64 * (j))
#define XB_TOP      3328
#define XB_TOPGEN   3392
#define XCD_BAR_WORDS 3456
#define XB_SPIN_CAP (1u << 22)
__device__ __forceinline__ unsigned xb_ld(unsigned* p)              { return __hip_atomic_load(p, __ATOMIC_RELAXED, __HIP_MEMORY_SCOPE_AGENT); }
__device__ __forceinline__ unsigned xb_add(unsigned* p, unsigned v) { return __hip_atomic_fetch_add(p, v, __ATOMIC_RELAXED, __HIP_MEMORY_SCOPE_AGENT); }
__device__ __forceinline__ unsigned xb_xcc_id() { return (unsigned)__builtin_amdgcn_s_getreg((3 << 11) | 20) & 0xFu; }
#define XB_SPIN(cond, bar) do { unsigned _sp = 0; while (cond) { __builtin_amdgcn_s_sleep(1); \
    if ((++_sp & 255u) == 0u) { if (xb_ld(&(bar)[XB_TMO])) break; if (_sp > XB_SPIN_CAP) { atomicAdd(&(bar)[XB_TMO], 1u); break; } } } } while (0)
struct XcdBarrier { unsigned* bar; unsigned x; volatile LAS unsigned* st; };
__device__ __forceinline__ XcdBarrier xcd_barrier_post(unsigned* bar, volatile LAS unsigned* st) {
    XcdBarrier b; b.bar = bar; b.x = xb_xcc_id(); b.st = st;
    if (threadIdx.x == 0) (void)xb_add(&bar[XB_XCNT(b.x)], 1u);
    return b;
}
__device__ __forceinline__ void xcd_barrier_complete(unsigned* bar, unsigned x, unsigned& nloc, unsigned& nx) {
    const unsigned G = gridDim.x * gridDim.y * gridDim.z;
    unsigned sum, cnt, mine, sp = 0u;
    for (;;) {
        sum = 0u; cnt = 0u; mine = 0u;
#pragma unroll
        for (unsigned j = 0; j < 16; ++j) { const unsigned c = xb_ld(&bar[XB_XCNT(j)]); sum += c; cnt += (c > 0u) ? 1u : 0u; mine = (j == x) ? c : mine; }
        if (sum == G) break;
        __builtin_amdgcn_s_sleep(1);
        if ((++sp & 255u) == 0u) { if (xb_ld(&bar[XB_TMO])) break; if (sp > XB_SPIN_CAP) { atomicAdd(&bar[XB_TMO], 1u); break; } }
    }
    nloc = mine > 0u ? mine : 1u; nx = cnt > 0u ? cnt : 1u;
}
__device__ __forceinline__ void xcd_barrier(const XcdBarrier& b) {
    asm volatile("s_waitcnt vmcnt(0)" ::: "memory");
    __syncthreads();
    if (threadIdx.x == 0) {
        unsigned* bar = b.bar;
        __builtin_amdgcn_s_waitcnt(0);
        unsigned nloc = b.st[0], nx = b.st[1];
        if (nloc == 0u) { xcd_barrier_complete(bar, b.x, nloc, nx); b.st[0] = nloc; b.st[1] = nx; }
        const unsigned old = xb_add(&bar[XB_XSUB(b.x)], 1u);
        const unsigned gen = old / nloc;
        if (old + 1u == (gen + 1u) * nloc) {
            __builtin_amdgcn_fence(__ATOMIC_RELEASE, "agent");
            asm volatile("s_waitcnt vmcnt(0)" ::: "memory");
            const unsigned og = xb_add(&bar[XB_TOP], 1u);
            const unsigned tg = og / nx;
            if (og + 1u == (tg + 1u) * nx) xb_add(&bar[XB_TOPGEN], 1u);
            else XB_SPIN(xb_ld(&bar[XB_TOPGEN]) == tg, bar);
            __builtin_amdgcn_fence(__ATOMIC_ACQUIRE, "agent");
            xb_add(&bar[XB_XGEN(b.x)], 1u);
            asm volatile("s_waitcnt vmcnt(0)" ::: "memory");
        } else {
            XB_SPIN(xb_ld(&bar[XB_XGEN(b.x)]) == gen, bar);
            __builtin_amdgcn_fence(__ATOMIC_ACQUIRE, "agent");
            asm volatile("s_waitcnt vmcnt(0)" ::: "memory");
        }
    }
    __syncthreads();
}

constexpr int RING_OFF = 0, RING_BYTES = 131072;
constexpr int LDSCTL_OFF = 162816, MISC_OFF = LDSCTL_OFF + 320;
constexpr int LDS_BYTES = 163840;

struct Frame {
    LAS unsigned char* lds;
    volatile LAS unsigned* MISC;
    gu32* ctl;
    int tid, lane, wave, G, wg;
    const float* in[21];
    float* out;
    unsigned char* ws;
};

__device__ __forceinline__ void p0_transpose_item(const float* W, int K, int N, bf16* WT, LAS float* scr, int item, int lane) {
    const int nblk = N / 32, kb = item / nblk, nb = item % nblk, k0 = 64 * kb, n0 = 32 * nb;
#pragma unroll 8
    for (int i = 0; i < 32; ++i) { const int kk = 2 * i + (lane >> 5); scr[kk * 33 + (lane & 31)] = W[(size_t)(k0 + kk) * N + n0 + (lane & 31)]; }
    LDS_WAIT(); asm volatile("" ::: "memory");
    const int c = lane & 7;
#pragma unroll
    for (int j = 0; j < 4; ++j) { const int n = (lane >> 3) + 8 * j; const LAS float* s = scr + (8 * c) * 33 + n;
        v4u o; o.x = pk2(s[0 * 33], s[1 * 33]); o.y = pk2(s[2 * 33], s[3 * 33]); o.z = pk2(s[4 * 33], s[5 * 33]); o.w = pk2(s[6 * 33], s[7 * 33]);
        *(GAS v4u*)(WT + (size_t)(n0 + n) * K + k0 + 8 * c) = o; }
    LDS_WAIT(); asm volatile("" ::: "memory");
}
__device__ __forceinline__ void rms_row_to_bf16(int lane, const float* xrow, const float* gain, bf16* orow) {
    const GAS f32x4* xr = (const GAS f32x4*)xrow + lane;
    const GAS f32x4* gr = (const GAS f32x4*)gain + lane;
    f32x4 v[4]; float s = 0.f;
#pragma unroll
    for (int j = 0; j < 4; ++j) { v[j] = xr[64 * j]; s += (v[j].x * v[j].x + v[j].y * v[j].y) + (v[j].z * v[j].z + v[j].w * v[j].w); }
    const float rstd = frsq(wave_sum(s) * (1.f / DM) + RMS_EPS);
    GAS unsigned long long* o8 = (GAS unsigned long long*)orow + lane;
#pragma unroll
    for (int j = 0; j < 4; ++j) { const f32x4 gg = gr[64 * j];
        o8[64 * j] = (unsigned long long)pk2(v[j].x * rstd * gg.x, v[j].y * rstd * gg.y) | ((unsigned long long)pk2(v[j].z * rstd * gg.z, v[j].w * rstd * gg.w) << 32); }
}
__device__ __forceinline__ void cvt_row_to_bf16(int lane, const float* xrow, bf16* orow) {
    const GAS f32x4* xr = (const GAS f32x4*)xrow + lane;
    GAS unsigned long long* o8 = (GAS unsigned long long*)orow + lane;
#pragma unroll
    for (int j = 0; j < 4; ++j) { const f32x4 v = xr[64 * j]; o8[64 * j] = (unsigned long long)pk2(v.x, v.y) | ((unsigned long long)pk2(v.z, v.w) << 32); }
}
__device__ __forceinline__ void p0_prologue(Frame& F) {
    LAS float* scr = (LAS float*)(F.lds + RING_OFF + F.wave * 16384);
    const int gw = F.wg * NWAVES + F.wave, NGW = F.G * NWAVES;
    constexpr int I_IN = (DM / 64) * (IN_COLS / 32), I_OUT = (DM / 64) * (DM / 32), I_Q = (DM / 64) * (PQ / 32);
    constexpr int NITEMS = I_IN + I_OUT + I_Q;
    bf16* win_t = (bf16*)(F.ws + WS_WIN); bf16* wout_t = (bf16*)(F.ws + WS_WOUT); bf16* wq_t = (bf16*)(F.ws + WS_WQ);
    for (int it = gw; it < NITEMS; it += NGW) {
        int r = it;
        if (r < I_IN) { p0_transpose_item(F.in[2], DM, IN_COLS, win_t, scr, r, F.lane); continue; } r -= I_IN;
        if (r < I_OUT) { p0_transpose_item(F.in[14], DM, DM, wout_t, scr, r, F.lane); continue; } r -= I_OUT;
        p0_transpose_item(F.in[16], DM, PQ, wq_t, scr, r, F.lane);
    }
    {
        constexpr int I_W = (64 / 64) * (RWW / 32), I_G = (128 / 64) * (RWW / 32);
        for (int it = gw; it < 2 * I_W + I_G; it += NGW) {
            int r = it;
            if (r < I_W) { p0_transpose_item(F.in[5], 64, RWW, (bf16*)(F.ws + WS_WUPT), scr, r, F.lane); continue; } r -= I_W;
            if (r < I_W) { p0_transpose_item(F.in[7], 64, RWW, (bf16*)(F.ws + WS_AUPT), scr, r, F.lane); continue; } r -= I_W;
            p0_transpose_item(F.in[8], 128, RWW, (bf16*)(F.ws + WS_GUPT), scr, r, F.lane);
        }
    }
    bf16* XN = (bf16*)(F.ws + WS_XN);
    for (int m = gw; m < T; m += NGW) rms_row_to_bf16(F.lane, F.in[0] + (size_t)m * DM, F.in[1], XN + (size_t)m * DM);
}

constexpr size_t WS_ROPE = WS_G;
__device__ __forceinline__ void p0_rope_table(Frame& F) {
    f32x2* tab = (f32x2*)(F.ws + WS_ROPE);
    for (int e = F.wg * NTHREADS + F.tid; e < SEQ * 32; e += F.G * NTHREADS) {
        const int sp = e >> 5, i = e & 31;
        const float inv_freq = powf(10000.0f, -(float)(2 * i) / 64.0f);
        const float ang = (float)sp * inv_freq;
        const double r = (double)ang - rint((double)ang * 0.15915494309189535) * 6.283185307179586;
        const float rf = (float)r;
        tab[e] = (f32x2){cosf(rf), sinf(rf)};
    }
}
__device__ __forceinline__ void p2_rope(Frame& F) {
    bf16* Z = (bf16*)(F.ws + WS_Z);
    const f32x2* tab = (const f32x2*)(F.ws + WS_ROPE);
    const int tid = F.tid, tk = tid >> 6, grp = (tid >> 2) & 15, i0 = (tid & 3) * 8;
    for (int blk = F.wg; blk < T / 8; blk += F.G) {
        const int g = blk * 8 + tk, sp = g & (SEQ - 1);
        bf16* p = Z + (size_t)g * IN_COLS + C_AQ + grp * 64 + i0;
        const v4u a = *(const GAS v4u*)p, b = *(const GAS v4u*)(p + 32);
        const GAS f32x4* tp = (const GAS f32x4*)(tab + sp * 32 + i0);
        float x1[8], x2[8];
        x1[0] = bflo(a.x); x1[1] = bfhi(a.x); x1[2] = bflo(a.y); x1[3] = bfhi(a.y); x1[4] = bflo(a.z); x1[5] = bfhi(a.z); x1[6] = bflo(a.w); x1[7] = bfhi(a.w);
        x2[0] = bflo(b.x); x2[1] = bfhi(b.x); x2[2] = bflo(b.y); x2[3] = bfhi(b.y); x2[4] = bflo(b.z); x2[5] = bfhi(b.z); x2[6] = bflo(b.w); x2[7] = bfhi(b.w);
        float o1[8], o2[8];
#pragma unroll
        for (int q = 0; q < 4; ++q) { const f32x4 cs = tp[q];
            o1[2 * q] = x1[2 * q] * cs[0] - x2[2 * q] * cs[1]; o2[2 * q] = x1[2 * q] * cs[1] + x2[2 * q] * cs[0];
            o1[2 * q + 1] = x1[2 * q + 1] * cs[2] - x2[2 * q + 1] * cs[3]; o2[2 * q + 1] = x1[2 * q + 1] * cs[3] + x2[2 * q + 1] * cs[2]; }
        v4u oa, ob; oa.x = pk2(o1[0], o1[1]); oa.y = pk2(o1[2], o1[3]); oa.z = pk2(o1[4], o1[5]); oa.w = pk2(o1[6], o1[7]);
        ob.x = pk2(o2[0], o2[1]); ob.y = pk2(o2[2], o2[3]); ob.z = pk2(o2[4], o2[5]); ob.w = pk2(o2[6], o2[7]);
        *(GAS v4u*)p = oa; *(GAS v4u*)(p + 32) = ob;
    }
}

typedef float f32x16 __attribute__((ext_vector_type(16)));
constexpr int SBS = 144;
constexpr int R1_EPRE = 0, R1_APRE = 16384, R1_AAB = 0, R1_X = 16384;
constexpr int R1_AT = 32768, R1_BT = 41984, R1_KT = 51200, R1_RT = 60416, R1_AHT = R1_BT, R1_U0T = R1_KT;
constexpr int R1_BBT = 69632, R1_KBT = 78848, R1_VT = 88064;
constexpr int R1_ACTW = 97280, R1_ACTA = 106496, R1_AAK = 97280, R1_ARB = 106496, R1_ARK = 115712;
constexpr int R1_BONUS = 124928, R1_WEND = 125184, R1_SEGS = 125440, R1_TII = 125440, R1_END = 129536;
static_assert(R1_END <= LDSCTL_OFF, "R1 LDS");
__device__ __forceinline__ int crow(int r, int hh) { return (r & 3) + 8 * (r >> 2) + 4 * hh; }
template <int KS> __device__ __forceinline__ f32x16 wtile(const LAS unsigned char* A, int sa, const LAS unsigned char* B, int sb, f32x16 acc, int lane) {
    const int row = lane & 31, hh = lane >> 5;
#pragma unroll
    for (int s = 0; s < KS; ++s) { const bf16x8 a = *(const LAS bf16x8*)(A + row * sa + 32 * s + 16 * hh); const bf16x8 b = *(const LAS bf16x8*)(B + row * sb + 32 * s + 16 * hh);
        acc = __builtin_amdgcn_mfma_f32_32x32x16_bf16(a, b, acc, 0, 0, 0); }
    return acc;
}
template <int KS> __device__ __forceinline__ f32x16 wtile_gb(const LAS unsigned char* A, int sa, const bf16* Bg, int ldb, f32x16 acc, int lane) {
    const int row = lane & 31, hh = lane >> 5;
#pragma unroll
    for (int s = 0; s < KS; ++s) { const bf16x8 a = *(const LAS bf16x8*)(A + row * sa + 32 * s + 16 * hh); const bf16x8 b = *(const GAS bf16x8*)(Bg + (size_t)row * ldb + 16 * s + 8 * hh);
        acc = __builtin_amdgcn_mfma_f32_32x32x16_bf16(a, b, acc, 0, 0, 0); }
    return acc;
}
__device__ __forceinline__ f32x16 zero16() { f32x16 z;
#pragma unroll
    for (int r = 0; r < 16; ++r) z[r] = 0.f;
    return z; }

struct R1Pre { v4u wd[2], ad[2], z[4]; };
__device__ __forceinline__ int r13_item(int wg, int G, int idx) { return G == 256 ? ((wg >> 3) * 128 + (wg & 7) + 8 * idx) : (wg + G * idx); }
__device__ __forceinline__ int r13_count(int wg, int G) { return G == 256 ? 16 : ((NB * NHR * 128 - wg + G - 1) / G); }
__device__ __forceinline__ void rwkv_r1_prefetch(Frame& F, int item, int tid, R1Pre& P) {
    const int chain = item >> 7, chunk = item & 127, b = chain >> 3, h = chain & 7, g0 = b * SEQ + chunk * 64;
    const bf16* Z = (const bf16*)(F.ws + WS_Z);
    const v4u z0 = (v4u){0u, 0u, 0u, 0u};
    { const int t = tid >> 3, cg = tid & 7; const bool first = (chunk == 0 && t == 0);
      const bf16* zr = Z + (size_t)(g0 + t) * IN_COLS;
      P.wd[0] = *(const GAS v4u*)(zr + C_WD + cg * 8); P.ad[0] = *(const GAS v4u*)(zr + C_AD + cg * 8);
      P.wd[1] = z0; P.ad[1] = z0;
      if (!first) { P.wd[1] = *(const GAS v4u*)(zr - IN_COLS + C_WD + cg * 8); P.ad[1] = *(const GAS v4u*)(zr - IN_COLS + C_AD + cg * 8); } }
#pragma unroll
    for (int q = 0; q < 4; ++q) { const int p = tid + 512 * q; P.z[q] = z0;
        if (p < 65 * 24) { const int row = p / 24, rem = p - row * 24, seg = rem >> 3, ch = rem & 7;
            if (!(chunk == 0 && row == 0)) P.z[q] = *(const GAS v4u*)(Z + (size_t)(g0 - 1 + row) * IN_COLS + seg * 512 + h * 64 + ch * 8); } }
}
constexpr int R1_ZS = R1_AT, R1_ZSS = 384;
static_assert(65 * R1_ZSS <= 4 * 9216, "ZS fits in the At..Rt region");
__device__ __forceinline__ void rwkv_r1_item(Frame& F, int item, int next_item, R1Pre& P) {
    const int chain = item >> 7, chunk = item & 127, b = chain >> 3, h = chain & 7;
    const int g0 = b * SEQ + chunk * 64;
    int tid_ = F.tid; asm volatile("" : "+v"(tid_));
    const int tid = tid_, lane = tid & 63, w = __builtin_amdgcn_readfirstlane(tid >> 6), hh = lane >> 5, cl = lane & 31;
    const bf16* Z = (const bf16*)(F.ws + WS_Z);
    LAS unsigned char* lds = F.lds + RING_OFF;
    const float* mu = F.in[3];
    {
        const int t = tid >> 3, cg = tid & 7;
        const v4u cw = P.wd[0], ca = P.ad[0], pw = P.wd[1], pa = P.ad[1];
        float fw[8], fa[8], qw[8], qa[8];
        fw[0] = bflo(cw.x); fw[1] = bfhi(cw.x); fw[2] = bflo(cw.y); fw[3] = bfhi(cw.y); fw[4] = bflo(cw.z); fw[5] = bfhi(cw.z); fw[6] = bflo(cw.w); fw[7] = bfhi(cw.w);
        fa[0] = bflo(ca.x); fa[1] = bfhi(ca.x); fa[2] = bflo(ca.y); fa[3] = bfhi(ca.y); fa[4] = bflo(ca.z); fa[5] = bfhi(ca.z); fa[6] = bflo(ca.w); fa[7] = bfhi(ca.w);
        qw[0] = bflo(pw.x); qw[1] = bfhi(pw.x); qw[2] = bflo(pw.y); qw[3] = bfhi(pw.y); qw[4] = bflo(pw.z); qw[5] = bfhi(pw.z); qw[6] = bflo(pw.w); qw[7] = bfhi(pw.w);
        qa[0] = bflo(pa.x); qa[1] = bfhi(pa.x); qa[2] = bflo(pa.y); qa[3] = bfhi(pa.y); qa[4] = bflo(pa.z); qa[5] = bfhi(pa.z); qa[6] = bflo(pa.w); qa[7] = bfhi(pa.w);
#pragma unroll
        for (int j = 0; j < 8; ++j) { const int c = cg * 8 + j; const float xw = fw[j] + (qw[j] - fw[j]) * mu[C_WD + c];
            const float ex = __expf(2.f * xw); fw[j] = 1.f - 2.f * frcp(ex + 1.f);
            fa[j] = fa[j] + (qa[j] - fa[j]) * mu[C_AD + c]; }
        v4u ow, oa; ow.x = pk2(fw[0], fw[1]); ow.y = pk2(fw[2], fw[3]); ow.z = pk2(fw[4], fw[5]); ow.w = pk2(fw[6], fw[7]);
        oa.x = pk2(fa[0], fa[1]); oa.y = pk2(fa[2], fa[3]); oa.z = pk2(fa[4], fa[5]); oa.w = pk2(fa[6], fa[7]);
        *(LAS v4u*)(lds + R1_ACTW + t * SBS + cg * 16) = ow; *(LAS v4u*)(lds + R1_ACTA + t * SBS + cg * 16) = oa;
#pragma unroll
        for (int q = 0; q < 4; ++q) { const int p = tid + 512 * q;
            if (p < 65 * 24) { const int row = p / 24, rem = p - row * 24; *(LAS v4u*)(lds + R1_ZS + row * R1_ZSS + rem * 16) = P.z[q]; } }
        if (next_item >= 0) rwkv_r1_prefetch(F, next_item, tid, P);
    }
    LDS_BARRIER();
    {
        const int p = w >> 2, mt = (w >> 1) & 1, nt = w & 1;
        const bf16* upt = (const bf16*)(F.ws + (p == 0 ? WS_WUPT : WS_AUPT)) + (size_t)(h * 64 + nt * 32) * 64;
        const f32x16 acc = wtile_gb<4>(lds + (p == 0 ? R1_ACTW : R1_ACTA) + mt * 32 * SBS, SBS, upt, 64, zero16(), lane);
        LAS float* O = (LAS float*)(lds + (p == 0 ? R1_EPRE : R1_APRE));
#pragma unroll
        for (int r = 0; r < 16; ++r) O[(mt * 32 + crow(r, hh)) * 64 + nt * 32 + cl] = acc[r];
    }
    LDS_BARRIER();
    {
        const int c = tid & 63, ts = tid >> 6, col = h * 64 + c;
        const float mu_r = mu[C_R + col], mu_k = mu[C_K + col], mu_v = mu[C_V + col], kkc = F.in[9][col], kac = F.in[10][col], rkc = F.in[11][col], w0c = F.in[4][col], a0c = F.in[6][col];
        const LAS float* EP = (const LAS float*)(lds + R1_EPRE); const LAS float* AP = (const LAS float*)(lds + R1_APRE);
        LAS float* SEGS = (LAS float*)(lds + R1_SEGS); LAS float* BON = (LAS float*)(lds + R1_BONUS);
        const LAS bf16* zb = (const LAS bf16*)(lds + R1_ZS + (8 * ts) * R1_ZSS) + c;
        float pr = bf2f(zb[0]), pk = bf2f(zb[64]), pv = bf2f(zb[128]);
        float rr[8], k2[8], ai[8], bi[8], vv[8], ee[8], cs[8]; float run = 0.f;
#pragma unroll
        for (int i = 0; i < 8; ++i) {
            const float zr = bf2f(zb[(i + 1) * (R1_ZSS / 2)]), zk = bf2f(zb[(i + 1) * (R1_ZSS / 2) + 64]), zv = bf2f(zb[(i + 1) * (R1_ZSS / 2) + 128]);
            const float r = zr + (pr - zr) * mu_r, k = zk + (pk - zk) * mu_k, v = zv + (pv - zv) * mu_v; pr = zr; pk = zk; pv = zv;
            const float e = 0.60653066f * frcp(1.f + __expf(-(w0c + EP[(8 * ts + i) * 64 + c])));
            const float a = frcp(1.f + __expf(-(a0c + AP[(8 * ts + i) * 64 + c])));
            float kk = k * kkc; const float n2 = wave_sum(kk * kk); kk = kk * frsq(fmaxf(n2, 1e-24f));
            const float kq = k * (1.f + (a - 1.f) * kac);
            const float bon = wave_sum(r * kq * rkc); if (c == 0) BON[8 * ts + i] = bon;
            rr[i] = r; k2[i] = kq; ai[i] = -kk; bi[i] = kk * a; vv[i] = v; ee[i] = e; run += e; cs[i] = run;
        }
        SEGS[ts * 64 + c] = run;
        LDS_BARRIER();
        float off = 0.f, tot = 0.f;
#pragma unroll
        for (int q = 0; q < 8; ++q) { const float sv = SEGS[q * 64 + c]; tot += sv; off += (q < ts) ? sv : 0.f; }
        float bb[8], kb[8];
#pragma unroll
        for (int i = 0; i < 8; ++i) { const float L = off + cs[i];
            const float Wm = __expf(-(L - ee[i])), Wi = __expf(-L), iW = __expf(L), We = __expf(-(tot - L));
            const int t = 8 * ts + i;
            *(LAS bf16*)(lds + R1_AT + t * SBS + c * 2) = (bf16)f2bf(ai[i] * Wm);
            *(LAS bf16*)(lds + R1_BT + t * SBS + c * 2) = (bf16)f2bf(bi[i] * iW);
            *(LAS bf16*)(lds + R1_KT + t * SBS + c * 2) = (bf16)f2bf(k2[i] * iW);
            *(LAS bf16*)(lds + R1_RT + t * SBS + c * 2) = (bf16)f2bf(rr[i] * Wi);
            bb[i] = bi[i] * We; kb[i] = k2[i] * We; }
        v4u o; o.x = pk2(bb[0], bb[1]); o.y = pk2(bb[2], bb[3]); o.z = pk2(bb[4], bb[5]); o.w = pk2(bb[6], bb[7]);
        *(LAS v4u*)(lds + R1_BBT + c * SBS + ts * 16) = o;
        o.x = pk2(kb[0], kb[1]); o.y = pk2(kb[2], kb[3]); o.z = pk2(kb[4], kb[5]); o.w = pk2(kb[6], kb[7]);
        *(LAS v4u*)(lds + R1_KBT + c * SBS + ts * 16) = o;
        o.x = pk2(vv[0], vv[1]); o.y = pk2(vv[2], vv[3]); o.z = pk2(vv[4], vv[5]); o.w = pk2(vv[6], vv[7]);
        *(LAS v4u*)(lds + R1_VT + c * SBS + ts * 16) = o;
        if (ts == 0) ((LAS float*)(lds + R1_WEND))[c] = __expf(-tot);
    }
    LDS_BARRIER();
#pragma unroll
    for (int u = 0; u < 2; ++u) {
        const int idx = w * 2 + u, p = idx >> 2, mt = (idx >> 1) & 1, nt = idx & 1;
        const LAS unsigned char* Aop = lds + ((p == 0 || p == 2) ? R1_BT : R1_KT) + mt * 32 * SBS;
        const LAS unsigned char* Bop = lds + (p < 2 ? R1_AT : R1_RT) + nt * 32 * SBS;
        f32x16 acc = wtile<4>(Aop, SBS, Bop, SBS, zero16(), lane);
        const int n = nt * 32 + cl;
#pragma unroll
        for (int r = 0; r < 16; ++r) { const int m = mt * 32 + crow(r, hh); const bool keep = (p < 2) ? (m < n) : (m <= n); acc[r] = keep ? acc[r] : 0.f; }
#pragma unroll
        for (int g4 = 0; g4 < 4; ++g4) { const int m0 = mt * 32 + 8 * g4 + 4 * hh;
            if (p == 0) *(LAS f32x4*)(lds + R1_AAB + (n * 64 + m0) * 4) = (f32x4){acc[4 * g4], acc[4 * g4 + 1], acc[4 * g4 + 2], acc[4 * g4 + 3]};
            else { v2u o; o.x = pk2(acc[4 * g4], acc[4 * g4 + 1]); o.y = pk2(acc[4 * g4 + 2], acc[4 * g4 + 3]);
                   *(LAS v2u*)(lds + (p == 1 ? R1_AAK : (p == 2 ? R1_ARB : R1_ARK)) + n * SBS + m0 * 2) = o; } }
    }
    LDS_BARRIER();
    if (w < 4) {
        const int mt = w >> 1, nt = w & 1;
        const f32x16 acc = wtile<4>(lds + R1_AAK + mt * 32 * SBS, SBS, lds + R1_VT + nt * 32 * SBS, SBS, zero16(), lane);
        LAS float* X = (LAS float*)(lds + R1_X);
#pragma unroll
        for (int r = 0; r < 16; ++r) X[(mt * 32 + crow(r, hh)) * 64 + nt * 32 + cl] = acc[r];
    } else if (w == 4) {
        const int bk = lane >> 4, c = lane & 15;
        const LAS float* AAB = (const LAS float*)(lds + R1_AAB);
        float Tc[16]; const float fc = (float)c;
#pragma unroll
        for (int s2 = 0; s2 < 16; ++s2) Tc[s2] = fmaxf(0.f, 1.f - fabsf((float)s2 - fc));
#pragma unroll
        for (int r = 0; r < 15; ++r)
#pragma unroll
            for (int s2 = r + 1; s2 < 16; ++s2) Tc[s2] += AAB[(16 * bk + s2) * 64 + 16 * bk + r] * Tc[r];
        LAS float* TII = (LAS float*)(lds + R1_TII);
#pragma unroll
        for (int s2 = 0; s2 < 16; ++s2) TII[(bk * 16 + s2) * 16 + c] = Tc[s2];
    }
    LDS_BARRIER();
    {
        const int c16 = lane & 15, g = lane >> 4;
        const LAS float* AAB = (const LAS float*)(lds + R1_AAB); const LAS float* TII = (const LAS float*)(lds + R1_TII); const LAS float* X = (const LAS float*)(lds + R1_X);
        f32x4 o[4];
#pragma unroll
        for (int i = 0; i < 4; ++i) {
            f32x4 acc;
            if (w < 4) {
#pragma unroll
                for (int q = 0; q < 4; ++q) acc[q] = bf2f(*(const LAS bf16*)(lds + R1_AT + (16 * i + 4 * g + q) * SBS + (16 * w + c16) * 2));
            } else {
#pragma unroll
                for (int q = 0; q < 4; ++q) acc[q] = X[(16 * i + 4 * g + q) * 64 + 16 * (w - 4) + c16];
            }
#pragma unroll
            for (int j = 0; j < i; ++j) { const f32x4 a4 = *(const LAS f32x4*)(AAB + (16 * i + c16) * 64 + 16 * j + 4 * g);
#pragma unroll
                for (int q = 0; q < 4; ++q) acc = __builtin_amdgcn_mfma_f32_16x16x4f32(a4[q], o[j][q], acc, 0, 0, 0); }
            const f32x4 t4 = *(const LAS f32x4*)(TII + (i * 16 + c16) * 16 + 4 * g);
            f32x4 res = (f32x4){0.f, 0.f, 0.f, 0.f};
#pragma unroll
            for (int q = 0; q < 4; ++q) res = __builtin_amdgcn_mfma_f32_16x16x4f32(t4[q], acc[q], res, 0, 0, 0);
            o[i] = res;
            v2u ov; ov.x = pk2(res[0], res[1]); ov.y = pk2(res[2], res[3]);
            *(LAS v2u*)(lds + (w < 4 ? R1_AHT : R1_U0T) + (16 * (w & 3) + c16) * SBS + (16 * i + 4 * g) * 2) = ov;
        }
    }
    LDS_BARRIER();
    {
        float* Mg = F.out + (size_t)item * 4096; float* NTg = F.out + (size_t)T * RWW + (size_t)item * 4096;
        float* Y0g = (float*)(F.ws + WS_RWY0) + (size_t)item * 4096; bf16* RHg = (bf16*)(F.ws + WS_RWRH) + (size_t)item * 4096;
#pragma unroll
        for (int u = 0; u < 2; ++u) {
            const int idx = w * 2 + u, p = idx >> 2, mt = (idx >> 1) & 1, nt = idx & 1; const int n = nt * 32 + cl;
            if (p == 0) {
                f32x16 acc = wtile<4>(lds + R1_AHT + mt * 32 * SBS, SBS, lds + R1_BBT + nt * 32 * SBS, SBS, zero16(), lane);
                const float we = ((const LAS float*)(lds + R1_WEND))[n];
#pragma unroll
                for (int g4 = 0; g4 < 4; ++g4) { const int m0 = mt * 32 + 8 * g4 + 4 * hh;
                    *(GAS f32x4*)(Mg + n * 64 + m0) = (f32x4){acc[4 * g4] + (m0 == n ? we : 0.f), acc[4 * g4 + 1] + (m0 + 1 == n ? we : 0.f), acc[4 * g4 + 2] + (m0 + 2 == n ? we : 0.f), acc[4 * g4 + 3] + (m0 + 3 == n ? we : 0.f)}; }
            } else if (p == 1) {
                f32x16 acc = wtile<4>(lds + R1_BBT + mt * 32 * SBS, SBS, lds + R1_U0T + nt * 32 * SBS, SBS, zero16(), lane);
                acc = wtile<4>(lds + R1_KBT + mt * 32 * SBS, SBS, lds + R1_VT + nt * 32 * SBS, SBS, acc, lane);
#pragma unroll
                for (int g4 = 0; g4 < 4; ++g4) *(GAS f32x4*)(NTg + n * 64 + mt * 32 + 8 * g4 + 4 * hh) = (f32x4){acc[4 * g4], acc[4 * g4 + 1], acc[4 * g4 + 2], acc[4 * g4 + 3]};
            } else if (p == 2) {
                f32x16 acc = wtile<4>(lds + R1_AHT + mt * 32 * SBS, SBS, lds + R1_ARB + nt * 32 * SBS, SBS, zero16(), lane);
#pragma unroll
                for (int g4 = 0; g4 < 4; ++g4) { const int m0 = mt * 32 + 8 * g4 + 4 * hh;
                    const v2u rt = *(const LAS v2u*)(lds + R1_RT + n * SBS + m0 * 2);
                    v2u ov; ov.x = pk2(acc[4 * g4] + bflo(rt.x), acc[4 * g4 + 1] + bfhi(rt.x)); ov.y = pk2(acc[4 * g4 + 2] + bflo(rt.y), acc[4 * g4 + 3] + bfhi(rt.y));
                    *(GAS v2u*)(RHg + n * 64 + m0) = ov; }
            } else {
                f32x16 acc = wtile<4>(lds + R1_U0T + mt * 32 * SBS, SBS, lds + R1_ARB + nt * 32 * SBS, SBS, zero16(), lane);
                acc = wtile<4>(lds + R1_VT + mt * 32 * SBS, SBS, lds + R1_ARK + nt * 32 * SBS, SBS, acc, lane);
#pragma unroll
                for (int g4 = 0; g4 < 4; ++g4) *(GAS f32x4*)(Y0g + n * 64 + mt * 32 + 8 * g4 + 4 * hh) = (f32x4){acc[4 * g4], acc[4 * g4 + 1], acc[4 * g4 + 2], acc[4 * g4 + 3]};
            }
        }
        if (tid < 64) ((float*)(F.ws + WS_BONUS))[(size_t)item * 64 + tid] = ((const LAS float*)(lds + R1_BONUS))[tid];
    }
    LDS_BARRIER();
}

constexpr int R2_RS = 272, R2_SLOT = 2 * 64 * R2_RS, R2_D = 6;
static_assert(2 * R2_SLOT <= LDSCTL_OFF, "R2 LDS");
__device__ __forceinline__ void rwkv_r2_chain(Frame& F, int chain) {
    int tid_ = F.tid; asm volatile("" : "+v"(tid_));
    const int lane = tid_ & 63, w = __builtin_amdgcn_readfirstlane(tid_ >> 6);
    LAS unsigned char* lds = F.lds + RING_OFF;
    const float* Mg = F.out + (size_t)chain * 128 * 4096; const float* NTg = F.out + (size_t)T * RWW + (size_t)chain * 128 * 4096;
    constexpr int NSTEP = 127;
    if (w >= 4) {
        const int L = w - 4, r = lane >> 2, f0 = (lane & 3) * 4;
        const size_t goff = (size_t)(16 * L + r) * 64 + f0 * 4;
        const int loff = (16 * L + r) * R2_RS + f0 * 16;
        f32x4 R[R2_D][8];
#define R2_ISSUE(slot_, step_) do { const int st_ = (step_) < NSTEP ? (step_) : NSTEP - 1; const float* mp_ = Mg + (size_t)st_ * 4096 + goff; const float* np_ = NTg + (size_t)st_ * 4096 + goff; \
            _Pragma("unroll") for (int k_ = 0; k_ < 4; ++k_) { R[slot_][k_] = *(const GAS f32x4*)(mp_ + 4 * k_); R[slot_][4 + k_] = *(const GAS f32x4*)(np_ + 4 * k_); } } while (0)
        const int q_ = lane & 3, froff = ((L * 2 + (q_ >> 1)) * 2) * 1024 + r * 16 + (q_ & 1) * 8;
#define R2_WRITE(slot_, buf_) do { LAS unsigned char* d_ = lds + (buf_) * R2_SLOT; \
            _Pragma("unroll") for (int k_ = 0; k_ < 4; ++k_) { const f32x4 a_ = R[slot_][k_]; \
                v2u h_; h_.x = pk2(a_[0], a_[1]); h_.y = pk2(a_[2], a_[3]); \
                v2u l_; l_.x = pk2(a_[0] - bflo(h_.x), a_[1] - bfhi(h_.x)); l_.y = pk2(a_[2] - bflo(h_.y), a_[3] - bfhi(h_.y)); \
                *(LAS v2u*)(d_ + froff + k_ * 256) = h_; *(LAS v2u*)(d_ + froff + 1024 + k_ * 256) = l_; \
                *(LAS f32x4*)(d_ + 64 * R2_RS + loff + 16 * k_) = R[slot_][4 + k_]; } } while (0)
#pragma unroll
        for (int u = 0; u < R2_D; ++u) R2_ISSUE(u, u);
        R2_WRITE(0, 0);
        R2_ISSUE(0, R2_D);
        LDS_BARRIER();
        static_assert(NSTEP % R2_D == 1, "main loop covers steps 0 .. NSTEP-2, one tail step");
        for (int c0 = 0; c0 < NSTEP - 1; c0 += R2_D) {
#pragma unroll
            for (int u = 0; u < R2_D; ++u) { const int c = c0 + u;
                R2_WRITE((u + 1) % R2_D, (c + 1) & 1);
                R2_ISSUE((u + 1) % R2_D, c + 1 + R2_D);
                LDS_BARRIER(); }
        }
        LDS_BARRIER();
#undef R2_ISSUE
#undef R2_WRITE
        return;
    }
    const int n16 = lane & 15, g = lane >> 4;
    float* SSg = (float*)(F.ws + WS_RWSS) + (size_t)chain * 128 * 4096;
    f32x4 st[4];
#pragma unroll
    for (int rt = 0; rt < 4; ++rt) st[rt] = (f32x4){0.f, 0.f, 0.f, 0.f};
    LDS_BARRIER();
    for (int c = 0; c < NSTEP; ++c) {
#pragma unroll
        for (int rt = 0; rt < 4; ++rt) *(GAS f32x4*)(SSg + (size_t)c * 4096 + (16 * w + n16) * 64 + 16 * rt + 4 * g) = st[rt];
        const LAS unsigned char* sl_ = lds + (c & 1) * R2_SLOT;
        bf16x8 sh[2], sl[2];
#pragma unroll
        for (int ks = 0; ks < 2; ++ks) { const f32x4 a = st[2 * ks], b = st[2 * ks + 1];
            v4u h; h.x = pk2(a[0], a[1]); h.y = pk2(a[2], a[3]); h.z = pk2(b[0], b[1]); h.w = pk2(b[2], b[3]);
            v4u l; l.x = pk2(a[0] - bflo(h.x), a[1] - bfhi(h.x)); l.y = pk2(a[2] - bflo(h.y), a[3] - bfhi(h.y)); l.z = pk2(b[0] - bflo(h.z), b[1] - bfhi(h.z)); l.w = pk2(b[2] - bflo(h.w), b[3] - bfhi(h.w));
            sh[ks] = __builtin_bit_cast(bf16x8, h); sl[ks] = __builtin_bit_cast(bf16x8, l); }
        f32x4 nw[4];
#pragma unroll
        for (int rt = 0; rt < 4; ++rt) { f32x4 acc = *(const LAS f32x4*)(sl_ + 64 * R2_RS + (16 * w + n16) * R2_RS + (16 * rt + 4 * g) * 4);
#pragma unroll
            for (int ks = 0; ks < 2; ++ks) {
                const bf16x8 mh = *(const LAS bf16x8*)(sl_ + ((rt * 2 + ks) * 2) * 1024 + lane * 16), ml = *(const LAS bf16x8*)(sl_ + ((rt * 2 + ks) * 2 + 1) * 1024 + lane * 16);
                acc = __builtin_amdgcn_mfma_f32_16x16x32_bf16(mh, sh[ks], acc, 0, 0, 0);
                acc = __builtin_amdgcn_mfma_f32_16x16x32_bf16(mh, sl[ks], acc, 0, 0, 0);
                acc = __builtin_amdgcn_mfma_f32_16x16x32_bf16(ml, sh[ks], acc, 0, 0, 0); }
            nw[rt] = acc; }
#pragma unroll
        for (int rt = 0; rt < 4; ++rt) st[rt] = nw[rt];
        LDS_BARRIER();
    }
#pragma unroll
    for (int rt = 0; rt < 4; ++rt) *(GAS f32x4*)(SSg + (size_t)NSTEP * 4096 + (16 * w + n16) * 64 + 16 * rt + 4 * g) = st[rt];
}

constexpr int R3_RH = 0, R3_S = 9216, R3_SG = 18432, R3_SGS = 272, R3_YL = R3_SG + 64 * R3_SGS, R3_GL = R3_YL + 16384, R3_VS = R3_GL + 16384, R3_BON = R3_VS + 65 * 128, R3_END = R3_BON + 256;
static_assert(R3_END <= LDSCTL_OFF, "R3 LDS");
struct R3Pre { v4u rh; f32x4 ss[2]; v4u gd[2][2]; f32x4 y0[2]; v4u vv[2]; float bon; };
__device__ __forceinline__ void rwkv_r3_prefetch(Frame& F, int item, int tid, R3Pre& P) {
    const int chain = item >> 7, chunk = item & 127, b = chain >> 3, h = chain & 7, g0 = b * SEQ + chunk * 64;
    const bf16* Z = (const bf16*)(F.ws + WS_Z);
    const int t = tid >> 3, cg = tid & 7; const v4u z0 = (v4u){0u, 0u, 0u, 0u};
    P.rh = *(const GAS v4u*)((const bf16*)(F.ws + WS_RWRH) + (size_t)item * 4096 + t * 64 + cg * 8);
    const float* SSg = (const float*)(F.ws + WS_RWSS) + (size_t)item * 4096 + t * 64 + cg * 8;
    P.ss[0] = *(const GAS f32x4*)SSg; P.ss[1] = *(const GAS f32x4*)(SSg + 4);
    const bf16* zr = Z + (size_t)(g0 + t) * IN_COLS + C_GD + cg * 16; const bool first = (chunk == 0 && t == 0);
#pragma unroll
    for (int q = 0; q < 2; ++q) { P.gd[q][0] = *(const GAS v4u*)(zr + q * 8); P.gd[q][1] = z0; if (!first) P.gd[q][1] = *(const GAS v4u*)(zr - IN_COLS + q * 8); }
    const float* Y0g = (const float*)(F.ws + WS_RWY0) + (size_t)item * 4096;
    P.y0[0] = *(const GAS f32x4*)(Y0g + tid * 4); P.y0[1] = *(const GAS f32x4*)(Y0g + (tid + 512) * 4);
#pragma unroll
    for (int q = 0; q < 2; ++q) { const int p = tid + 512 * q; P.vv[q] = z0;
        if (p < 65 * 8) { const int row = p >> 3, ch = p & 7; if (!(chunk == 0 && row == 0)) P.vv[q] = *(const GAS v4u*)(Z + (size_t)(g0 - 1 + row) * IN_COLS + C_V + h * 64 + ch * 8); } }
    P.bon = tid < 64 ? ((const float*)(F.ws + WS_BONUS))[(size_t)item * 64 + tid] : 0.f;
}
__device__ __forceinline__ void rwkv_r3_item(Frame& F, int item, int next_item, R3Pre& P) {
    const int chain = item >> 7, chunk = item & 127, b = chain >> 3, h = chain & 7;
    const int g0 = b * SEQ + chunk * 64;
    int tid_ = F.tid; asm volatile("" : "+v"(tid_));
    const int tid = tid_, lane = tid & 63, w = __builtin_amdgcn_readfirstlane(tid >> 6), hh = lane >> 5, cl = lane & 31;
    LAS unsigned char* lds = F.lds + RING_OFF;
    const float* mu = F.in[3];
    {
        const int t = tid >> 3, cg = tid & 7;
        *(LAS v4u*)(lds + R3_RH + t * SBS + cg * 16) = P.rh;
        const f32x4 s0 = P.ss[0], s1 = P.ss[1];
        v4u o; o.x = pk2(s0[0], s0[1]); o.y = pk2(s0[2], s0[3]); o.z = pk2(s1[0], s1[1]); o.w = pk2(s1[2], s1[3]);
        *(LAS v4u*)(lds + R3_S + t * SBS + cg * 16) = o;
#pragma unroll
        for (int q = 0; q < 2; ++q) {
            const v4u cw = P.gd[q][0], pw = P.gd[q][1];
            float fw[8], qw[8];
            fw[0] = bflo(cw.x); fw[1] = bfhi(cw.x); fw[2] = bflo(cw.y); fw[3] = bfhi(cw.y); fw[4] = bflo(cw.z); fw[5] = bfhi(cw.z); fw[6] = bflo(cw.w); fw[7] = bfhi(cw.w);
            qw[0] = bflo(pw.x); qw[1] = bfhi(pw.x); qw[2] = bflo(pw.y); qw[3] = bfhi(pw.y); qw[4] = bflo(pw.z); qw[5] = bfhi(pw.z); qw[6] = bflo(pw.w); qw[7] = bfhi(pw.w);
#pragma unroll
            for (int j = 0; j < 8; ++j) { const float v = fw[j] + (qw[j] - fw[j]) * mu[C_GD + cg * 16 + q * 8 + j]; fw[j] = frcp(1.f + __expf(-v)); }
            v4u og; og.x = pk2(fw[0], fw[1]); og.y = pk2(fw[2], fw[3]); og.z = pk2(fw[4], fw[5]); og.w = pk2(fw[6], fw[7]);
            *(LAS v4u*)(lds + R3_SG + t * R3_SGS + (cg * 16 + q * 8) * 2) = og;
        }
        *(LAS f32x4*)(lds + R3_YL + tid * 16) = P.y0[0]; *(LAS f32x4*)(lds + R3_YL + (tid + 512) * 16) = P.y0[1];
#pragma unroll
        for (int q = 0; q < 2; ++q) { const int p = tid + 512 * q; if (p < 65 * 8) *(LAS v4u*)(lds + R3_VS + p * 16) = P.vv[q]; }
        if (tid < 64) ((LAS float*)(lds + R3_BON))[tid] = P.bon;
        if (next_item >= 0) rwkv_r3_prefetch(F, next_item, tid, P);
    }
    LDS_BARRIER();
    {
        const int mt = (w >> 1) & 1, nt = w & 1; const int n = nt * 32 + cl;
        if (w < 4) {
            LAS float* YL = (LAS float*)(lds + R3_YL);
            f32x16 acc;
#pragma unroll
            for (int r = 0; r < 16; ++r) acc[r] = YL[(mt * 32 + crow(r, hh)) * 64 + n];
            acc = wtile<4>(lds + R3_RH + mt * 32 * SBS, SBS, lds + R3_S + nt * 32 * SBS, SBS, acc, lane);
#pragma unroll
            for (int r = 0; r < 16; ++r) YL[(mt * 32 + crow(r, hh)) * 64 + n] = acc[r];
        } else {
            const bf16* gut = (const bf16*)(F.ws + WS_GUPT) + (size_t)(h * 64 + nt * 32) * 128;
            const f32x16 acc = wtile_gb<8>(lds + R3_SG + mt * 32 * R3_SGS, R3_SGS, gut, 128, zero16(), lane);
            LAS float* GL = (LAS float*)(lds + R3_GL);
#pragma unroll
            for (int r = 0; r < 16; ++r) GL[(mt * 32 + crow(r, hh)) * 64 + n] = acc[r];
        }
    }
    LDS_BARRIER();
    {
        const int c = tid & 63, ts = tid >> 6, col = h * 64 + c;
        const float mu_v = mu[C_V + col], gw = F.in[12][col], gb = F.in[13][col];
        const LAS float* YL = (const LAS float*)(lds + R3_YL); const LAS float* GL = (const LAS float*)(lds + R3_GL); const LAS float* BON = (const LAS float*)(lds + R3_BON);
        bf16* Y = (bf16*)(F.ws + WS_YMIX);
        const LAS bf16* vb = (const LAS bf16*)(lds + R3_VS) + (8 * ts) * 64 + c;
        float pv = bf2f(vb[0]);
#pragma unroll
        for (int i = 0; i < 8; ++i) { const int t = 8 * ts + i;
            const float zv = bf2f(vb[(i + 1) * 64]); const float v = zv + (pv - zv) * mu_v; pv = zv;
            const float y = YL[t * 64 + c];
            const float mean = wave_sum(y) * (1.f / 64.f); const float d = y - mean; const float var = wave_sum(d * d) * (1.f / 64.f);
            const float yn = d * frsq(var + GN_EPS) * gw + gb;
            const float o = (yn + BON[t] * v) * GL[t * 64 + c];
            Y[(size_t)(g0 + t) * DM + col] = (bf16)f2bf(o); }
    }
    LDS_BARRIER();
}

typedef short s16x4 __attribute__((ext_vector_type(4)));
typedef short v4i16_t __attribute__((ext_vector_type(4)));
constexpr int AT_XO = 0, AT_XO_STRIDE = 136, AT_XM = 512 * AT_XO_STRIDE, AT_XL = AT_XM + 2048, AT_V = AT_XL + 2048, AT_LDS_END = AT_V + 8 * 4096;
static_assert(AT_LDS_END <= RING_BYTES, "attention LDS");
__device__ __forceinline__ float xhalf(float v) { return __shfl_xor(v, 32); }
__device__ __forceinline__ void attn_block(Frame& F, int item) {
    const int bh = item >> 4, blk = item & 15, b = bh >> 3, h = bh & 7, t0 = blk * 512;
    int tid_ = F.tid; asm volatile("" : "+v"(tid_));
    const int lane = tid_ & 63, w = __builtin_amdgcn_readfirstlane(tid_ >> 6), ql = lane & 31, hh = lane >> 5;
    const bf16* Zb = (const bf16*)(F.ws + WS_Z) + (size_t)b * SEQ * IN_COLS;
    bf16* Y = (bf16*)(F.ws + WS_YMIX);
    LAS unsigned char* lds = F.lds + RING_OFF;
    LAS unsigned char* Vw = lds + AT_V + w * 4096;
    LAS float* XM = (LAS float*)(lds + AT_XM); LAS float* XL = (LAS float*)(lds + AT_XL);
    constexpr float C2 = 0.125f * 1.4426950408889634f;
    for (int pass = 0; pass < 3; ++pass) {
        const int sh = pass == 0 ? 4 : (pass == 1 ? 2 : 0), d = 1 << sh;
        for (int uu = 0; uu < 2; ++uu) {
            const int u = w + 8 * uu, rho = u & (d - 1), tau = u >> sh;
            const int qoff = rho + (32 * tau + ql) * d;
            bf16x8 qf[4];
            { const bf16* qp = Zb + (size_t)(t0 + qoff) * IN_COLS + C_AQ + h * 64 + 8 * hh;
#pragma unroll
              for (int s = 0; s < 4; ++s) qf[s] = *(const GAS bf16x8*)(qp + 16 * s); }
            f32x16 sc[5];
            const int tkb = t0 + rho + (32 * tau - 128) * d;
            bf16x8 kf[5][4];
#pragma unroll
            for (int kt = 0; kt < 5; ++kt) { const int tk0 = tkb + 32 * kt * d, tkc = tk0 < 0 ? 0 : tk0;
                const bf16* kp = Zb + (size_t)(tkc + ql * d) * IN_COLS + C_AK + h * 64 + 8 * hh;
#pragma unroll
                for (int s = 0; s < 4; ++s) kf[kt][s] = *(const GAS bf16x8*)(kp + 16 * s); }
            v4u vr[4];
            { const int tkc = tkb < 0 ? 0 : tkb;
#pragma unroll
              for (int i = 0; i < 4; ++i) { const int kidx = i * 8 + (lane >> 3), ch = lane & 7;
                  vr[i] = *(const GAS v4u*)(Zb + (size_t)(tkc + kidx * d) * IN_COLS + C_AV + h * 64 + ch * 8); } }
#pragma unroll
            for (int kt = 0; kt < 5; ++kt) {
                const int tk0 = tkb + 32 * kt * d;
                f32x16 acc = zero16();
#pragma unroll
                for (int s = 0; s < 4; ++s) acc = __builtin_amdgcn_mfma_f32_32x32x16_bf16(kf[kt][s], qf[s], acc, 0, 0, 0);
                if (kt == 0 || kt == 4) {
#pragma unroll
                    for (int r = 0; r < 16; ++r) { const int kidx = (r & 3) + 8 * (r >> 2) + 4 * hh;
                        const bool ok = (kt == 0) ? (kidx >= ql) : (kidx <= ql);
                        acc[r] = ok ? acc[r] : -INFINITY; }
                }
                if (tk0 < 0) {
#pragma unroll
                    for (int r = 0; r < 16; ++r) acc[r] = -INFINITY;
                }
                sc[kt] = acc;
            }
            float m = -INFINITY;
#pragma unroll
            for (int kt = 0; kt < 5; ++kt)
#pragma unroll
                for (int r = 0; r < 16; ++r) m = fmaxf(m, sc[kt][r]);
            m = fmaxf(m, xhalf(m));
            const float ms = m * C2;
            float l = 0.f;
#pragma unroll
            for (int kt = 0; kt < 5; ++kt)
#pragma unroll
                for (int r = 0; r < 16; ++r) { const float p = __builtin_amdgcn_exp2f(sc[kt][r] * C2 - ms); sc[kt][r] = p; l += p; }
            l += xhalf(l);
            f32x16 O[2];
#pragma unroll
            for (int r = 0; r < 16; ++r) { O[0][r] = 0.f; O[1][r] = 0.f; }
#pragma unroll
            for (int kt = 0; kt < 5; ++kt) {
#pragma unroll
                for (int i = 0; i < 4; ++i) { const int kidx = i * 8 + (lane >> 3), ch = lane & 7;
                    *(LAS v4u*)(Vw + kidx * 128 + ((ch ^ (((kidx >> 1) & 1) << 2)) << 4)) = vr[i]; }
                if (kt < 4) { const int tk1 = tkb + 32 * (kt + 1) * d, tkc = tk1 < 0 ? 0 : tk1;
#pragma unroll
                    for (int i = 0; i < 4; ++i) { const int kidx = i * 8 + (lane >> 3), ch = lane & 7;
                        vr[i] = *(const GAS v4u*)(Zb + (size_t)(tkc + kidx * d) * IN_COLS + C_AV + h * 64 + ch * 8); } }
                asm volatile("s_waitcnt lgkmcnt(0)" ::: "memory");
#pragma unroll
                for (int s = 0; s < 2; ++s) {
                    v4u pw; pw.x = pk2(sc[kt][8 * s], sc[kt][8 * s + 1]); pw.y = pk2(sc[kt][8 * s + 2], sc[kt][8 * s + 3]); pw.z = pk2(sc[kt][8 * s + 4], sc[kt][8 * s + 5]); pw.w = pk2(sc[kt][8 * s + 6], sc[kt][8 * s + 7]);
                    const bf16x8 pf = __builtin_bit_cast(bf16x8, pw);
#pragma unroll
                    for (int dt = 0; dt < 2; ++dt) {
                        bf16x8 vf;
#pragma unroll
                        for (int pp = 0; pp < 2; ++pp) {
                            const int i16 = lane & 15, db = (lane >> 4) & 1;
                            const int row = 16 * s + 8 * pp + 4 * hh + (i16 >> 2);
                            const int byte = 64 * dt + 32 * db + 8 * (i16 & 3);
                            const int chunk = (byte >> 4) ^ (((row >> 1) & 1) << 2);
                            const s16x4 t4 = __builtin_bit_cast(s16x4, __builtin_amdgcn_ds_read_tr16_b64_v4i16((LAS v4i16_t*)(Vw + row * 128 + (chunk << 4) + (byte & 15))));
                            vf[4 * pp + 0] = t4[0]; vf[4 * pp + 1] = t4[1]; vf[4 * pp + 2] = t4[2]; vf[4 * pp + 3] = t4[3];
                        }
                        O[dt] = __builtin_amdgcn_mfma_f32_32x32x16_bf16(vf, pf, O[dt], 0, 0, 0);
                    }
                }
                asm volatile("s_waitcnt lgkmcnt(0)" ::: "memory");
            }
            LAS unsigned char* xo = lds + AT_XO + qoff * AT_XO_STRIDE + 8 * hh;
            float wa = 0.f, wb = 1.f, Mx = ms, ln = l;
            if (pass > 0) { const float msa = XM[qoff], la = XL[qoff]; Mx = fmaxf(msa, ms); wa = la * __builtin_amdgcn_exp2f(msa - Mx); wb = __builtin_amdgcn_exp2f(ms - Mx); ln = wa + wb * l; }
            const float inv = 1.f / ln;
#pragma unroll
            for (int dt = 0; dt < 2; ++dt)
#pragma unroll
                for (int g4 = 0; g4 < 4; ++g4) {
                    LAS v2u* p = (LAS v2u*)(xo + (32 * dt + 8 * g4) * 2);
                    float o0 = O[dt][4 * g4] * wb, o1 = O[dt][4 * g4 + 1] * wb, o2 = O[dt][4 * g4 + 2] * wb, o3 = O[dt][4 * g4 + 3] * wb;
                    if (pass > 0) { const v2u old = *p; o0 += bflo(old.x) * wa; o1 += bfhi(old.x) * wa; o2 += bflo(old.y) * wa; o3 += bfhi(old.y) * wa; }
                    v2u nw; nw.x = pk2(o0 * inv, o1 * inv); nw.y = pk2(o2 * inv, o3 * inv);
                    *p = nw;
                }
            if (hh == 0) { XM[qoff] = Mx; XL[qoff] = ln; }
        }
        LDS_BARRIER();
    }
#pragma unroll
    for (int i = 0; i < 8; ++i) { const int row = (tid_ >> 3) + 64 * i, ch = tid_ & 7;
        LAS v2u* p = (LAS v2u*)(lds + AT_XO + row * AT_XO_STRIDE + ch * 16);
        const v2u a = p[0], c = p[1];
        v4u o; o.x = a.x; o.y = a.y; o.z = c.x; o.w = c.y;
        *(GAS v4u*)(Y + ((size_t)b * SEQ + t0 + row) * DM + RWW + h * 64 + ch * 8) = o; }
    LDS_BARRIER();
}

__device__ __forceinline__ void quantize_tables(Frame& F, int gw, int ngw) {
    for (int m = gw; m < 2 * NEXP; m += ngw) {
        const int tab = m >= NEXP, row = tab ? m - NEXP : m;
        const GAS f32x4* xr = (const GAS f32x4*)(F.in[18 + tab] + (size_t)row * DM) + F.lane * 4;
        f32x4 v[4]; float am = 0.f;
#pragma unroll
        for (int j = 0; j < 4; ++j) { v[j] = xr[j]; am = fmaxf(am, fmaxf(fmaxf(fabsf(v[j].x), fabsf(v[j].y)), fmaxf(fabsf(v[j].z), fabsf(v[j].w)))); }
        am = wave_max(am);
        const float sc = am > 0.f ? am * (1.f / 127.f) : 1.f, inv = am > 0.f ? 127.f / am : 0.f;
        v4u o;
#pragma unroll
        for (int j = 0; j < 4; ++j) {
            const int bias = tab ? 128 : 0;
            const unsigned b0 = (unsigned)((int)rintf(v[j].x * inv) + bias) & 255u, b1 = (unsigned)((int)rintf(v[j].y * inv) + bias) & 255u,
                           b2 = (unsigned)((int)rintf(v[j].z * inv) + bias) & 255u, b3 = (unsigned)((int)rintf(v[j].w * inv) + bias) & 255u;
            o[j] = b0 | (b1 << 8) | (b2 << 16) | (b3 << 24); }
        *(GAS v4u*)(F.ws + (tab ? WS_VQ : WS_UQ) + (size_t)row * DM + F.lane * 16) = o;
        if (F.lane == 0) ((float*)(F.ws + (tab ? WS_SV : WS_SU)))[row] = sc;
    }
}

__device__ __forceinline__ void p3_mixers(Frame& F) {
    const int nrw = (F.G >= 64) ? 32 : 0;
    if (nrw == 0) { for (int ch = 0; ch < NB * NHR; ++ch) rwkv_r2_chain(F, ch); }
#ifndef RW2_REPS
#define RW2_REPS 1
#endif
    else if (F.wg < nrw) { for (int rep = 0; rep < RW2_REPS; ++rep) { for (int ch = F.wg; ch < NB * NHR; ch += nrw) rwkv_r2_chain(F, ch); if (rep + 1 < RW2_REPS) __syncthreads(); } return; }
    const int na = F.G - nrw, wa = F.wg - nrw;
#ifndef ATTN_REPS
#define ATTN_REPS 1
#endif
    for (int rep = 0; rep < ATTN_REPS; ++rep)
    for (int item = wa; item < NB * NHA * (SEQ / 512); item += na) attn_block(F, item);
    quantize_tables(F, wa * NWAVES + F.wave, na * NWAVES);
}

__device__ __forceinline__ void p5_xn2(Frame& F) {
    const int gw = F.wg * NWAVES + F.wave, NGW = F.G * NWAVES;
    bf16* XN = (bf16*)(F.ws + WS_XN);
    for (int m = gw; m < T; m += NGW) rms_row_to_bf16(F.lane, F.out + (size_t)m * DM, F.in[15], XN + (size_t)m * DM);
}

constexpr int TK_SKS = 272, TK_SKH = 0, TK_SKL = 2 * 128 * TK_SKS, TK_LUT = 2 * TK_SKL, TK_END = TK_LUT + 8 * 2048;
__device__ __forceinline__ unsigned f2ord(float f) { const unsigned u = __builtin_bit_cast(unsigned, f); return u ^ ((unsigned)((int)u >> 31) | 0x80000000u); }
__device__ __forceinline__ float ord2f(unsigned o) { const unsigned u = (o & 0x80000000u) ? (o ^ 0x80000000u) : ~o; return __builtin_bit_cast(float, u); }
__device__ __forceinline__ void ce_desc(unsigned& a, unsigned& b) { const unsigned mx = a > b ? a : b, mn = a > b ? b : a; a = mx; b = mn; }
template <int N, int OFF, int TOT> __device__ __forceinline__ void bitonic_sort_desc(unsigned (&v)[TOT]) {
#pragma unroll
    for (int k = 2; k <= N; k <<= 1)
#pragma unroll
        for (int j = k >> 1; j > 0; j >>= 1)
#pragma unroll
            for (int i = 0; i < N; ++i) { const int l = i ^ j; if (l > i) { if ((i & k) == 0) ce_desc(v[OFF + i], v[OFF + l]); else ce_desc(v[OFF + l], v[OFF + i]); } }
}
template <int OFFA, int OFFB, int TOT> __device__ __forceinline__ void merge_top16(unsigned (&v)[TOT]) {
#pragma unroll
    for (int i = 0; i < 16; ++i) { const unsigned x = v[OFFA + i], y = v[OFFB + 15 - i]; v[OFFA + i] = x > y ? x : y; }
#pragma unroll
    for (int j = 8; j > 0; j >>= 1)
#pragma unroll
        for (int i = 0; i < 16; ++i) { const int l = i ^ j; if (l > i) ce_desc(v[OFFA + i], v[OFFA + l]); }
}
__device__ __forceinline__ void top16_of_64(unsigned (&k)[64]) {
    bitonic_sort_desc<16, 0, 64>(k); bitonic_sort_desc<16, 16, 64>(k); bitonic_sort_desc<16, 32, 64>(k); bitonic_sort_desc<16, 48, 64>(k);
    merge_top16<0, 16, 64>(k); merge_top16<32, 48, 64>(k); merge_top16<0, 32, 64>(k);
}
__device__ __forceinline__ void p7_topk(Frame& F) {
    static_assert(TK_END <= LDSCTL_OFF, "topk LDS");
    const bf16* QP = (const bf16*)(F.ws + WS_QP);
    int* EID = (int*)(F.ws + WS_EID); float* GATE = (float*)(F.ws + WS_GATE);
    const float* sk = F.in[17];
    LAS unsigned char* lds = F.lds + RING_OFF;
    for (int e = F.tid; e < 2 * 128 * 64; e += NTHREADS) {
        const int c = e >> 13, k = (e >> 6) & 127, d2 = e & 63;
        const f32x2 v = *(const GAS f32x2*)(sk + (size_t)(c * 128 + k) * 128 + 2 * d2);
        const unsigned h0 = f2bf(v.x), h1 = f2bf(v.y);
        const float r0 = v.x - __builtin_bit_cast(float, h0 << 16), r1 = v.y - __builtin_bit_cast(float, h1 << 16);
        *(LAS unsigned*)(lds + TK_SKH + (c * 128 + k) * TK_SKS + d2 * 4) = h0 | (h1 << 16);
        *(LAS unsigned*)(lds + TK_SKL + (c * 128 + k) * TK_SKS + d2 * 4) = pk2(r0, r1);
    }
    __syncthreads();
    const int gw = F.wg * NWAVES + F.wave, NGW = F.G * NWAVES;
    for (int tile = gw; tile < T * PHEADS / 32; tile += NGW) {
        int lane_ = F.lane; asm volatile("" : "+v"(lane_));
        const int lane = lane_, hh = lane >> 5, cl = lane & 31;
        const int P = tile * 32 + cl, t = P >> 3, h = P & 7;
        unsigned kAB[2][16];
#pragma unroll
        for (int c = 0; c < 2; ++c) {
            bf16x8 qf[8];
            const bf16* qp = QP + (size_t)t * PQ + h * 256 + c * 128 + 8 * hh;
#pragma unroll
            for (int s2 = 0; s2 < 8; ++s2) qf[s2] = *(const GAS bf16x8*)(qp + 16 * s2);
            unsigned k[64];
#pragma unroll
            for (int mt = 0; mt < 4; ++mt) {
                f32x16 acc = zero16();
                const LAS unsigned char* ah = lds + TK_SKH + (c * 128 + mt * 32 + cl) * TK_SKS + 16 * hh;
                const LAS unsigned char* al = lds + TK_SKL + (c * 128 + mt * 32 + cl) * TK_SKS + 16 * hh;
#pragma unroll
                for (int s2 = 0; s2 < 8; ++s2) {
                    acc = __builtin_amdgcn_mfma_f32_32x32x16_bf16(*(const LAS bf16x8*)(ah + 32 * s2), qf[s2], acc, 0, 0, 0);
                    acc = __builtin_amdgcn_mfma_f32_32x32x16_bf16(*(const LAS bf16x8*)(al + 32 * s2), qf[s2], acc, 0, 0, 0); }
#pragma unroll
                for (int r = 0; r < 16; ++r) { const int idx = 32 * mt + (r & 3) + 8 * (r >> 2) + 4 * hh; k[mt * 16 + r] = (f2ord(acc[r]) & ~127u) | (unsigned)(127 - idx); }
            }
            top16_of_64(k);
            unsigned m[32];
#pragma unroll
            for (int i = 0; i < 16; ++i) { m[i] = k[i]; m[16 + i] = (unsigned)__shfl_xor((int)k[i], 32); }
            merge_top16<0, 16, 32>(m);
#pragma unroll
            for (int i = 0; i < 16; ++i) kAB[c][i] = m[i];
        }
        float fa[16], fb[16];
#pragma unroll
        for (int i = 0; i < 16; ++i) { fa[i] = ord2f(kAB[0][i] & ~127u); fb[i] = ord2f(kAB[1][i] & ~127u); }
        unsigned cd[64]; int n = 0;
#pragma unroll
        for (int i = 0; i < 16; ++i)
#pragma unroll
            for (int j = 0; j < 16; ++j) if ((i + 1) * (j + 1) <= 16) { cd[n] = (f2ord(fa[i] + fb[j]) & ~255u) | (unsigned)(255 - (i * 16 + j)); ++n; }
#pragma unroll
        for (int q = 50; q < 64; ++q) cd[q] = 0u;
        top16_of_64(cd);
        LAS unsigned char* lut = lds + TK_LUT + (F.wave * 64 + lane) * 32;
#pragma unroll
        for (int q = 0; q < 4; ++q) {
            unsigned wa = 0u, wb = 0u;
#pragma unroll
            for (int b4 = 0; b4 < 4; ++b4) { wa |= (127u - (kAB[0][4 * q + b4] & 127u)) << (8 * b4); wb |= (127u - (kAB[1][4 * q + b4] & 127u)) << (8 * b4); }
            *(LAS unsigned*)(lut + 4 * q) = wa; *(LAS unsigned*)(lut + 16 + 4 * q) = wb; }
        float gv[16]; float den = 0.f; const float mx = ord2f(cd[0] & ~255u);
#pragma unroll
        for (int q = 0; q < 16; ++q) { gv[q] = __expf(ord2f(cd[q] & ~255u) - mx); den += gv[q]; }
        const float inv = 1.f / den;
        asm volatile("s_waitcnt lgkmcnt(0)" ::: "memory");
        int ev[16];
#pragma unroll
        for (int q = 0; q < 16; ++q) { const unsigned pos = 255u - (cd[q] & 255u);
            const unsigned ia = *(const LAS unsigned char*)(lut + (pos >> 4)), ib = *(const LAS unsigned char*)(lut + 16 + (pos & 15u));
            ev[q] = (int)(ia * NKEYS + ib); }
        if (hh == 0) {
            int* ep = EID + (size_t)t * 128 + h * 16; float* gp = GATE + (size_t)t * 128 + h * 16;
#pragma unroll
            for (int q = 0; q < 4; ++q) {
                *(GAS v4u*)(ep + 4 * q) = (v4u){(unsigned)ev[4 * q], (unsigned)ev[4 * q + 1], (unsigned)ev[4 * q + 2], (unsigned)ev[4 * q + 3]};
                *(GAS f32x4*)(gp + 4 * q) = (f32x4){gv[4 * q] * inv, gv[4 * q + 1] * inv, gv[4 * q + 2] * inv, gv[4 * q + 3] * inv}; }
        }
        asm volatile("s_waitcnt lgkmcnt(0)" ::: "memory");
    }
}

constexpr int GA_WAVE_BYTES = 6656, GA_CNT = 4096, GA_OFF = 4096 + 128, GA_ACT = 4608;
__device__ __forceinline__ int wave_sum_i(int v) { v += dppi<0xB1>(v); v += dppi<0x4E>(v); v += dppi<0x141>(v); v += dppi<0x140>(v);
    return (__builtin_amdgcn_readlane(v, 0) + __builtin_amdgcn_readlane(v, 16)) + (__builtin_amdgcn_readlane(v, 32) + __builtin_amdgcn_readlane(v, 48)); }
struct PairBuf { v4u u, v; float su, sv; int e; float g; };
__device__ __forceinline__ void p8_gather(Frame& F, float* outp) {
    const bf16* XN = (const bf16*)(F.ws + WS_XN);
    const unsigned char* UQ = F.ws + WS_UQ; const unsigned char* VQ = F.ws + WS_VQ;
    const float* SU = (const float*)(F.ws + WS_SU); const float* SV = (const float*)(F.ws + WS_SV);
    const int* EID = (const int*)(F.ws + WS_EID); const float* GATE = (const float*)(F.ws + WS_GATE);
    const float* nf = F.in[20];
    const int gw = F.wg * NWAVES + F.wave, NGW = F.G * NWAVES;
    LAS unsigned char* wl = F.lds + RING_OFF + F.wave * GA_WAVE_BYTES;
    for (int tg = gw, sweep = 0; tg < T / 4; tg += NGW, ++sweep) {
        int lane_ = F.lane; asm volatile("" : "+v"(lane_));
        const int lane = lane_;
        int xq[4][4]; float sx[4];
#pragma unroll
        for (int tk = 0; tk < 4; ++tk) {
            const GAS v4u* xp = (const GAS v4u*)(XN + (size_t)(4 * tg + tk) * DM + lane * 16);
            const v4u a = xp[0], b = xp[1];
            float x[16]; x[0] = bflo(a.x); x[1] = bfhi(a.x); x[2] = bflo(a.y); x[3] = bfhi(a.y); x[4] = bflo(a.z); x[5] = bfhi(a.z); x[6] = bflo(a.w); x[7] = bfhi(a.w);
            x[8] = bflo(b.x); x[9] = bfhi(b.x); x[10] = bflo(b.y); x[11] = bfhi(b.y); x[12] = bflo(b.z); x[13] = bfhi(b.z); x[14] = bflo(b.w); x[15] = bfhi(b.w);
            float am = 0.f;
#pragma unroll
            for (int i = 0; i < 16; ++i) am = fmaxf(am, fabsf(x[i]));
            am = wave_max(am);
            const float rs_ = frsq(((const float*)(F.ws + WS_SSQ))[4 * tg + tk] * (1.f / DM) + RMS_EPS);
            sx[tk] = (am > 0.f ? am * (1.f / 127.f) : 1.f) * rs_; const float inv = am > 0.f ? 127.f / am : 0.f;
#pragma unroll
            for (int q = 0; q < 4; ++q) {
                const unsigned b0 = (unsigned)(int)rintf(x[4 * q] * inv) & 255u, b1 = (unsigned)(int)rintf(x[4 * q + 1] * inv) & 255u, b2 = (unsigned)(int)rintf(x[4 * q + 2] * inv) & 255u, b3 = (unsigned)(int)rintf(x[4 * q + 3] * inv) & 255u;
                xq[tk][q] = (int)(b0 | (b1 << 8) | (b2 << 16) | (b3 << 24)); }
        }
        LAS unsigned* cnt = (LAS unsigned*)(wl + GA_CNT); LAS unsigned* offs = (LAS unsigned*)(wl + GA_OFF);
        if (lane < 32) cnt[lane] = 0u;
        asm volatile("s_waitcnt lgkmcnt(0)" ::: "memory");
        int ee[8]; float gg[8]; unsigned pos[8];
#pragma unroll
        for (int tk = 0; tk < 4; ++tk) {
            const size_t base = (size_t)(4 * tg + tk) * 128;
            ee[2 * tk] = (EID[base + lane] & (NEXP - 1)) | (tk << 14); ee[2 * tk + 1] = (EID[base + 64 + lane] & (NEXP - 1)) | (tk << 14);
            gg[2 * tk] = GATE[base + lane]; gg[2 * tk + 1] = GATE[base + 64 + lane]; }
#pragma unroll
        for (int q = 0; q < 8; ++q) pos[q] = __hip_atomic_fetch_add(cnt + ((ee[q] >> 9) & 31), 1u, __ATOMIC_RELAXED, __HIP_MEMORY_SCOPE_WAVEFRONT);
        asm volatile("s_waitcnt lgkmcnt(0)" ::: "memory");
        if (lane < 32) {
            const int c0 = (int)cnt[lane]; int v = c0;
            v += __builtin_amdgcn_update_dpp(0, v, 0x111, 0xF, 0xF, true); v += __builtin_amdgcn_update_dpp(0, v, 0x112, 0xF, 0xF, true);
            v += __builtin_amdgcn_update_dpp(0, v, 0x114, 0xF, 0xF, true); v += __builtin_amdgcn_update_dpp(0, v, 0x118, 0xF, 0xF, true);
            const int row0 = __builtin_amdgcn_readlane(v, 15);
            offs[lane] = (unsigned)(v - c0 + (lane >= 16 ? row0 : 0));
        }
        asm volatile("s_waitcnt lgkmcnt(0)" ::: "memory");
#pragma unroll
        for (int q = 0; q < 8; ++q) { const unsigned idx = offs[(ee[q] >> 9) & 31] + pos[q];
            *(LAS unsigned*)(wl + idx * 4) = (unsigned)ee[q]; *(LAS float*)(wl + 2048 + idx * 4) = gg[q]; }
        asm volatile("s_waitcnt lgkmcnt(0)" ::: "memory");
#define GA_DOT(U, TK) (__builtin_amdgcn_sdot4(xq[TK][3], (int)(U).w, __builtin_amdgcn_sdot4(xq[TK][2], (int)(U).z, __builtin_amdgcn_sdot4(xq[TK][1], (int)(U).y, __builtin_amdgcn_sdot4(xq[TK][0], (int)(U).x, 0, false), false), false), false))
        LAS float* act = (LAS float*)(wl + GA_ACT);
        for (int ch = 0; ch < 32; ++ch) {
            const unsigned ent = *(const LAS unsigned*)(wl + (ch * 16 + (lane >> 2)) * 4);
            const float my_g = *(const LAS float*)(wl + 2048 + (ch * 16 + (lane >> 2)) * 4);
            const int my_e = (int)ent & (NEXP - 1), my_tk = ((int)ent >> 14) & 3;
            const float my_su = SU[my_e], my_sv = SV[my_e];
            int d[16];
            {
                v4u ub[2][8]; int eb[2][8];
#pragma unroll
                for (int q = 0; q < 8; ++q) { eb[0][q] = __builtin_amdgcn_readlane((int)ent, 4 * q); ub[0][q] = *(const GAS v4u*)(UQ + (size_t)(eb[0][q] & (NEXP - 1)) * DM + lane * 16); }
#pragma unroll
                for (int jb = 0; jb < 2; ++jb) {
                    if (jb == 0) {
#pragma unroll
                        for (int q = 0; q < 8; ++q) { eb[1][q] = __builtin_amdgcn_readlane((int)ent, 4 * (8 + q)); ub[1][q] = *(const GAS v4u*)(UQ + (size_t)(eb[1][q] & (NEXP - 1)) * DM + lane * 16); } }
                    __builtin_amdgcn_sched_barrier(0);
#pragma unroll
                    for (int q = 0; q < 8; ++q) { const int tk_ = (eb[jb][q] >> 14) & 3; const v4u u_ = ub[jb][q]; int r_;
                        if (tk_ == 0) r_ = GA_DOT(u_, 0); else if (tk_ == 1) r_ = GA_DOT(u_, 1); else if (tk_ == 2) r_ = GA_DOT(u_, 2); else r_ = GA_DOT(u_, 3);
                        d[8 * jb + q] = r_; }
                    __builtin_amdgcn_sched_barrier(0);
                }
            }
#pragma unroll
            for (int j = 0; j < 8; ++j) { const auto r = __builtin_amdgcn_permlane32_swap((unsigned)d[j], (unsigned)d[j + 8], false, false); d[j] = (int)r[0] + (int)r[1]; }
#pragma unroll
            for (int j = 0; j < 4; ++j) { const auto r = __builtin_amdgcn_permlane16_swap((unsigned)d[j], (unsigned)d[j + 4], false, false); d[j] = (int)r[0] + (int)r[1]; }
#pragma unroll
            for (int j = 0; j < 2; ++j) { const int u_ = d[j] + dppi<0x128>(d[j]), w_ = d[j + 2] + dppi<0x128>(d[j + 2]); d[j] = (lane & 8) ? w_ : u_; }
            { const int u_ = d[0] + dppi<0x141>(d[0]), w_ = d[1] + dppi<0x141>(d[1]); d[0] = (lane & 4) ? w_ : u_; }
            d[0] += dppi<0x4E>(d[0]); d[0] += dppi<0xB1>(d[0]);
            const float sxl = my_tk == 0 ? sx[0] : (my_tk == 1 ? sx[1] : (my_tk == 2 ? sx[2] : sx[3]));
            const float h_ = (float)d[0] * (my_su * sxl);
            const float a_ = 0.5f * h_ * (1.f + erff(h_ * 0.70710678118654752f)) * my_g * my_sv;
            if ((lane & 3) == 0) act[ch * 16 + (lane >> 2)] = a_;
        }
#undef GA_DOT
        asm volatile("s_waitcnt lgkmcnt(0)" ::: "memory");
        float y[4][16]; float yo[4];
#pragma unroll
        for (int tk = 0; tk < 4; ++tk) { yo[tk] = 0.f;
#pragma unroll
            for (int i = 0; i < 16; ++i) y[tk][i] = 0.f; }
#define GA_AXPY(V, A, TK) do { yo[TK] += (A) * 128.f; \
            _Pragma("unroll") for (int q_ = 0; q_ < 4; ++q_) { const unsigned w_ = (V)[q_]; \
                y[TK][4 * q_] += (A) * (float)(w_ & 255u); y[TK][4 * q_ + 1] += (A) * (float)((w_ >> 8) & 255u); y[TK][4 * q_ + 2] += (A) * (float)((w_ >> 16) & 255u); y[TK][4 * q_ + 3] += (A) * (float)(w_ >> 24); } } while (0)
        for (int ch = 0; ch < 8; ++ch) {
            const unsigned ent = *(const LAS unsigned*)(wl + (ch * 64 + lane) * 4);
            const float areg = act[ch * 64 + lane];
            v4u vb[2][8]; int eb[2][8];
#pragma unroll
            for (int q = 0; q < 8; ++q) { eb[0][q] = __builtin_amdgcn_readlane((int)ent, q); vb[0][q] = *(const GAS v4u*)(VQ + (size_t)(eb[0][q] & (NEXP - 1)) * DM + lane * 16); }
#pragma unroll
            for (int jb = 0; jb < 8; ++jb) {
                if (jb + 1 < 8) {
#pragma unroll
                    for (int q = 0; q < 8; ++q) { eb[(jb + 1) & 1][q] = __builtin_amdgcn_readlane((int)ent, 8 * (jb + 1) + q); vb[(jb + 1) & 1][q] = *(const GAS v4u*)(VQ + (size_t)(eb[(jb + 1) & 1][q] & (NEXP - 1)) * DM + lane * 16); } }
                __builtin_amdgcn_sched_barrier(0);
#pragma unroll
                for (int q = 0; q < 8; ++q) { const int tk_ = (eb[jb & 1][q] >> 14) & 3; const v4u v_ = vb[jb & 1][q]; const float a_ = rdlane(areg, 8 * jb + q);
                    if (tk_ == 0) GA_AXPY(v_, a_, 0); else if (tk_ == 1) GA_AXPY(v_, a_, 1); else if (tk_ == 2) GA_AXPY(v_, a_, 2); else GA_AXPY(v_, a_, 3); }
                __builtin_amdgcn_sched_barrier(0);
            }
        }
#undef GA_AXPY
#pragma unroll
        for (int tk = 0; tk < 4; ++tk) {
            float* hrow = F.out + (size_t)(4 * tg + tk) * DM + lane * 16;
            float hv[16]; float ss = 0.f;
#pragma unroll
            for (int q = 0; q < 4; ++q) { const f32x4 h4 = *(const GAS f32x4*)(hrow + 4 * q);
#pragma unroll
                for (int i = 0; i < 4; ++i) { const float v = h4[i] + (y[tk][4 * q + i] - yo[tk]); hv[4 * q + i] = v; ss += v * v; } }
            const float rstd = frsq(wave_sum(ss) * (1.f / DM) + RMS_EPS);
#pragma unroll
            for (int q = 0; q < 4; ++q) { const f32x4 n4 = *(const GAS f32x4*)(nf + lane * 16 + 4 * q);
                *(GAS f32x4*)(outp + (size_t)(4 * tg + tk) * DM + lane * 16 + 4 * q) = (f32x4){hv[4 * q] * rstd * n4[0], hv[4 * q + 1] * rstd * n4[1], hv[4 * q + 2] * rstd * n4[2], hv[4 * q + 3] * rstd * n4[3]}; }
        }
    }
}

struct Args { const float* in[21]; float* out; unsigned char* ws; int ph_lo, ph_hi; };
static_assert(sizeof(Args) == 21 * 8 + 8 + 8 + 8, "Args has no padding");

__global__ void __launch_bounds__(NTHREADS, 2) fwd_kernel(Args args) {
    extern __shared__ __attribute__((aligned(16))) unsigned char lds[];
    Frame F;
    F.lds = (LAS unsigned char*)lds;
    F.MISC = (volatile LAS unsigned*)(F.lds + MISC_OFF);
    F.tid = threadIdx.x; F.lane = F.tid & 63; F.wave = __builtin_amdgcn_readfirstlane(F.tid >> 6);
    F.G = gridDim.x; F.wg = blockIdx.x;
#pragma unroll
    for (int i = 0; i < 21; ++i) F.in[i] = args.in[i];
    F.out = args.out; F.ws = args.ws;
    F.ctl = (gu32*)(args.ws + WS_CTL);
    for (int u = F.tid; u < (LDS_BYTES - LDSCTL_OFF) / 4; u += NTHREADS) ((LAS unsigned*)(F.lds + LDSCTL_OFF))[u] = 0u;
    __syncthreads();
    const int lo = args.ph_lo, hi = args.ph_hi;
    const bool fused = (hi - lo) > 1;
    XcdBarrier bar; bar.bar = (unsigned*)(F.ctl + CW_BAR); bar.x = 0; bar.st = nullptr;
    if (fused) bar = xcd_barrier_post((unsigned*)(F.ctl + CW_BAR), F.MISC + 8);
#define IN(k) (lo <= (k) && (k) < hi)
#define REPS(k) (((REP_MASK >> (k)) & 1) ? 2 : 1)
#define REPLOOP(k) for (int rep_ = 0; rep_ < REPS(k); ++rep_, (rep_ < REPS(k) ? xcd_barrier(bar) : (void)0))
#define SEAM(k) do { if (IN(k) && IN((k) + 1)) xcd_barrier(bar); } while (0)

    if (IN(0)) { REPLOOP(0) { p0_prologue(F); p0_rope_table(F); } SEAM(0); }
    if (IN(1)) { REPLOOP(1) {
        pg8::Gemm g{(const bf16*)(F.ws + WS_XN), (const bf16*)(F.ws + WS_WIN), T, IN_COLS, DM}; pg8::StaticOrder S; S.init(T, IN_COLS, F.G, F.wg);
        pg8::EpiBf16 E{(bf16*)(F.ws + WS_Z), IN_COLS};
        pg8::gemm_phase<pg8::EpiBf16, pg8::StaticOrder, true, true>(F.lds + RING_OFF, g, S, E); }
        SEAM(1);
    }
    if (IN(2)) { p2_rope(F); REPLOOP(2) { const int cnt = r13_count(F.wg, F.G); R1Pre P;
            if (cnt > 0) rwkv_r1_prefetch(F, r13_item(F.wg, F.G, 0), F.tid, P);
            for (int i = 0; i < cnt; ++i) rwkv_r1_item(F, r13_item(F.wg, F.G, i), i + 1 < cnt ? r13_item(F.wg, F.G, i + 1) : -1, P); }
        SEAM(2); }
    if (IN(3)) { REPLOOP(3) p3_mixers(F); SEAM(3); }
    if (IN(4)) { REPLOOP(4) { const int cnt = r13_count(F.wg, F.G); R3Pre P;
            if (cnt > 0) rwkv_r3_prefetch(F, r13_item(F.wg, F.G, 0), F.tid, P);
            for (int i = 0; i < cnt; ++i) rwkv_r3_item(F, r13_item(F.wg, F.G, i), i + 1 < cnt ? r13_item(F.wg, F.G, i + 1) : -1, P); }
        SEAM(4); }
    if (IN(5)) {
        pg8::Gemm g{(const bf16*)(F.ws + WS_YMIX), (const bf16*)(F.ws + WS_WOUT), T, DM, DM}; pg8::StaticOrder S; S.init(T, DM, F.G, F.wg);
        pg8::EpiF32Res E{F.in[0], F.out, DM, (bf16*)(F.ws + WS_XN), F.in[15], (float*)(F.ws + WS_SSQ)};
        pg8::gemm_phase<pg8::EpiF32Res, pg8::StaticOrder, true, true>(F.lds + RING_OFF, g, S, E);
        SEAM(5);
    }
    if (IN(6)) { REPLOOP(6) {
        pg8::Gemm g{(const bf16*)(F.ws + WS_XN), (const bf16*)(F.ws + WS_WQ), T, PQ, DM}; pg8::StaticOrder S; S.init(T, PQ, F.G, F.wg);
        pg8::EpiBf16Rs E{(bf16*)(F.ws + WS_QP), PQ, (const float*)(F.ws + WS_SSQ)};
        pg8::gemm_phase<pg8::EpiBf16Rs, pg8::StaticOrder, true, true>(F.lds + RING_OFF, g, S, E); }
        SEAM(6);
    }
    if (IN(7)) { REPLOOP(7) p7_topk(F); SEAM(7); }
    if (IN(8)) { if (REPS(8) > 1) { p8_gather(F, (float*)(F.ws + WS_Z)); xcd_barrier(bar); } p8_gather(F, F.out); }
#undef IN
#undef SEAM
}

extern "C" void kernel_launch(void* const* d_in, const int* in_sizes, int n_in, void* d_out, int out_size, void* d_ws, size_t ws_size, hipStream_t stream) {
    static int grid = 0;
    if (grid == 0) {
        if (n_in != 21 || in_sizes[0] != T * DM || out_size != T * DM || ws_size < WS_END) {
            fprintf(stderr, "kernel_launch: unexpected shapes: n_in %d in0 %d out %d ws %zu (need %zu); nothing launched\n", n_in, n_in > 0 ? in_sizes[0] : -1, out_size, ws_size, (size_t)WS_END); grid = -1; return; }
        int dev = 0, cus = 0, per_cu = 0;
        if (hipGetDevice(&dev) != hipSuccess || hipDeviceGetAttribute(&cus, hipDeviceAttributeMultiprocessorCount, dev) != hipSuccess) { grid = -1; return; }
        if (hipFuncSetAttribute((const void*)fwd_kernel, hipFuncAttributeMaxDynamicSharedMemorySize, LDS_BYTES) != hipSuccess) { fprintf(stderr, "kernel_launch: hipFuncSetAttribute failed\n"); grid = -1; return; }
        if (hipOccupancyMaxActiveBlocksPerMultiprocessor(&per_cu, (const void*)fwd_kernel, NTHREADS, LDS_BYTES) != hipSuccess || per_cu < 1) { fprintf(stderr, "kernel_launch: occupancy query says %d\n", per_cu); per_cu = 1; }
        (void)hipGetLastError();
        grid = cus;
    }
    if (grid < 0) return;
    (void)hipMemsetAsync((char*)d_ws + WS_CTL, 0, CTL_ZERO_BYTES, stream);
    Args a{};
    for (int i = 0; i < 21; ++i) a.in[i] = (const float*)d_in[i];
    a.out = (float*)d_out; a.ws = (unsigned char*)d_ws;
    if (MK_N_LAUNCHES == 1) {
        a.ph_lo = 0; a.ph_hi = NPHASE;
        void* kargs[] = {&a};
        hipError_t e = hipLaunchCooperativeKernel((const void*)fwd_kernel, dim3(grid), dim3(NTHREADS), kargs, LDS_BYTES, stream);
        if (e != hipSuccess) fprintf(stderr, "kernel_launch: cooperative launch failed: %s (grid %d)\n", hipGetErrorString(e), grid);
    } else {
        for (int p = 0; p < NPHASE; ++p) { a.ph_lo = p; a.ph_hi = p + 1;
            hipLaunchKernelGGL(fwd_kernel, dim3(grid), dim3(NTHREADS), LDS_BYTES, stream, a); }
    }
}
```

```cpp
#include <hip/hip_runtime.h>
#include <cstdio>
#include <cstdint>

#ifndef MK_N_LAUNCHES
#define MK_N_LAUNCHES 1
#endif

#ifndef REP_MASK
#define REP_MASK 0
#endif
#define GAS __attribute__((address_space(1)))
#define LAS __attribute__((address_space(3)))
typedef unsigned short bf16;
typedef unsigned v4u __attribute__((ext_vector_type(4)));
typedef unsigned v2u __attribute__((ext_vector_type(2)));
typedef float f32x4 __attribute__((ext_vector_type(4)));
typedef float f32x2 __attribute__((ext_vector_type(2)));
typedef short bf16x8 __attribute__((ext_vector_type(8)));
typedef GAS unsigned gu32;
#define RLX_AGENT __ATOMIC_RELAXED, __HIP_MEMORY_SCOPE_AGENT
#define LDS_WAIT() asm volatile("s_waitcnt lgkmcnt(0)" ::: "memory")
#define VM_WAIT() asm volatile("s_waitcnt vmcnt(0)" ::: "memory")
#define LDS_BARRIER() do { asm volatile("s_waitcnt lgkmcnt(0)" ::: "memory"); __builtin_amdgcn_s_barrier(); asm volatile("" ::: "memory"); } while (0)

constexpr int DM = 1024, NB = 4, SEQ = 8192, T = NB * SEQ;
constexpr int HD = 64, RWW = 512, NHR = 8, NHA = 8;
constexpr int IN_COLS = 3328;
constexpr int C_R = 0, C_K = 512, C_V = 1024, C_WD = 1536, C_AD = 1600, C_GD = 1664, C_AQ = 1792, C_AK = 2304, C_AV = 2816;
constexpr int PHEADS = 8, NKEYS = 128, PQ = 2048, TOPK = 16, NEXP = 16384;
constexpr float RMS_EPS = 1e-6f, GN_EPS = 64e-5f;
constexpr int NWAVES = 8, NTHREADS = 512;
constexpr int NPHASE = 9;

constexpr size_t MiB = 1u << 20;
constexpr size_t WS_CTL = 0, CTL_ZERO_BYTES = 1 * MiB;
constexpr size_t WS_WIN = 2 * MiB;
constexpr size_t WS_WOUT = 10 * MiB;
constexpr size_t WS_WQ = 12 * MiB;
constexpr size_t WS_XN = 16 * MiB;
constexpr size_t WS_Z = 80 * MiB;
constexpr size_t WS_QP = 80 * MiB;
constexpr size_t WS_G = 288 * MiB;
constexpr size_t WS_YMIX = 352 * MiB;
constexpr size_t WS_UQ = 416 * MiB;
constexpr size_t WS_VQ = 432 * MiB;
constexpr size_t WS_SU = 448 * MiB;
constexpr size_t WS_SV = 449 * MiB;
constexpr size_t WS_EID = 480 * MiB;
constexpr size_t WS_GATE = 496 * MiB;
constexpr size_t WS_END = 512 * MiB;
constexpr size_t WS_WUPT = 1 * MiB, WS_AUPT = WS_WUPT + 65536, WS_GUPT = WS_AUPT + 65536;
constexpr size_t WS_BONUS = 9 * MiB;
constexpr size_t WS_RWY0 = WS_XN;
constexpr size_t WS_RWSS = WS_G;
constexpr size_t WS_RWRH = WS_EID;

constexpr int CW_BAR = 4096;
constexpr size_t WS_SSQ = 256 * 1024;

typedef __bf16 hbf16x2_t __attribute__((ext_vector_type(2)));
__device__ __forceinline__ unsigned pk2(float lo, float hi) { const f32x2 v = {lo, hi}; const hbf16x2_t b = __builtin_convertvector(v, hbf16x2_t); return __builtin_bit_cast(unsigned, b); }
__device__ __forceinline__ unsigned f2bf(float f) { return pk2(f, 0.f) & 0xffffu; }
__device__ __forceinline__ float frcp(float x) { return __builtin_amdgcn_rcpf(x); }
__device__ __forceinline__ float frsq(float x) { return __builtin_amdgcn_rsqf(x); }
__device__ __forceinline__ float bflo(unsigned u) { return __builtin_bit_cast(float, u << 16); }
__device__ __forceinline__ float bfhi(unsigned u) { return __builtin_bit_cast(float, u & 0xffff0000u); }
__device__ __forceinline__ float bf2f(bf16 h) { return __builtin_bit_cast(float, (unsigned)h << 16); }

template <int CTRL> __device__ __forceinline__ float dppf(float x) { return __builtin_bit_cast(float, __builtin_amdgcn_update_dpp(0, __builtin_bit_cast(int, x), CTRL, 0xF, 0xF, true)); }
template <int CTRL> __device__ __forceinline__ int dppi(int x) { return __builtin_amdgcn_update_dpp(0, x, CTRL, 0xF, 0xF, true); }
__device__ __forceinline__ float rdlane(float v, int l) { return __builtin_bit_cast(float, __builtin_amdgcn_readlane(__builtin_bit_cast(int, v), l)); }
__device__ __forceinline__ float sum8(float v) { v += dppf<0xB1>(v); v += dppf<0x4E>(v); v += dppf<0x141>(v); return v; }
__device__ __forceinline__ float sum16(float v) { v = sum8(v); v += dppf<0x140>(v); return v; }
__device__ __forceinline__ float wave_sum(float v) { v = sum16(v);
    v += __builtin_bit_cast(float, __builtin_amdgcn_update_dpp(0, __builtin_bit_cast(int, v), 0x142, 0xA, 0xF, false));
    v += __builtin_bit_cast(float, __builtin_amdgcn_update_dpp(0, __builtin_bit_cast(int, v), 0x143, 0xC, 0xF, false));
    return rdlane(v, 63); }
__device__ __forceinline__ float wave_max(float v) {
    v = fmaxf(v, dppf<0xB1>(v)); v = fmaxf(v, dppf<0x4E>(v)); v = fmaxf(v, dppf<0x141>(v)); v = fmaxf(v, dppf<0x140>(v));
    return fmaxf(fmaxf(rdlane(v, 0), rdlane(v, 16)), fmaxf(rdlane(v, 32), rdlane(v, 48)));
}
__device__ __forceinline__ int wave_min_i(int v) {
    v = min(v, dppi<0xB1>(v)); v = min(v, dppi<0x4E>(v)); v = min(v, dppi<0x141>(v)); v = min(v, dppi<0x140>(v));
    return min(min(__builtin_amdgcn_readlane(v, 0), __builtin_amdgcn_readlane(v, 16)), min(__builtin_amdgcn_readlane(v, 32), __builtin_amdgcn_readlane(v, 48)));
}

namespace pg8 {
#define PG8_LAS __attribute__((address_space(3)))
typedef unsigned short bf16_t;
typedef unsigned u32x4 __attribute__((ext_vector_type(4)));
constexpr int BM = 256, BK = 64, HALF = 128, HTB = HALF * BK * 2, STAGE_BYTES = 8 * HTB, NXCD = 8, WGM = 8;
__host__ __device__ __forceinline__ int lds_byte(int r, int c) { const int st = (r >> 4) * 2 + (c >> 5), rr = r & 15, cc = c & 31, ob = rr * 64 + cc * 2; return st * 1024 + (ob ^ (((ob >> 9) & 1) << 5)); }
__host__ __device__ __forceinline__ void stage_rc(int b, int& R, int& C) { const int st = b / 1024, sb = b % 1024, swz = sb ^ (((sb >> 9) & 1) << 5); R = (st >> 1) * 16 + swz / 64; C = (st & 1) * 32 + (swz % 64) / 2; }
__host__ __device__ __forceinline__ int perm32(int rho) { const int n = rho >> 4, i = rho & 15; return 8 * (i >> 2) + 4 * n + (i & 3); }
struct Unit { int pm, pn; };
struct Gemm { const bf16_t* A; const bf16_t* Bt; int M, N, K; };
struct StaticOrder {
    int nM, nN, nwg, G, c;
    __host__ __device__ void init(int M, int N, int G_, int c_) { nM = M / BM; nN = N / BM; nwg = nM * nN; G = G_; c = c_; }
    __host__ __device__ bool next(int i, Unit& u) const {
        const long L = (long)i * G + c; if (L >= nwg) return false;
        int wgid = (int)L; { const int q = nwg / NXCD, r = nwg % NXCD, xcd = wgid % NXCD, off = wgid / NXCD; wgid = (xcd < r ? xcd * (q + 1) : r * (q + 1) + (xcd - r) * q) + off; }
        const int nig = WGM * nN, gid = wgid / nig, fm = gid * WGM, gsz = (nM - fm) < WGM ? (nM - fm) : WGM;
        u.pm = fm + ((wgid % nig) % gsz); u.pn = (wgid % nig) / gsz; return true;
    }
    __device__ __forceinline__ void a_ready(const Unit&) const {}
    __device__ __forceinline__ void done(const Unit&) const {}
};
__device__ __forceinline__ unsigned cvt_pk_bf16(float lo, float hi) { unsigned r; asm volatile("v_cvt_pk_bf16_f32 %0, %1, %2" : "=v"(r) : "v"(lo), "v"(hi)); return r; }
struct EpiBf16 {
    static constexpr bool PERM = true, AFTER_DRAIN = false;
    bf16_t* O; int ldc;
    __device__ __forceinline__ void operator()(const f32x4 (&acc)[2][2][4][2], const Unit& u, int wr, int wc, int fr, int fq) const {
        const int row0 = u.pm * BM + wr * 64 + fr; const int col0 = u.pn * BM + wc * 32 + 8 * fq;
#pragma unroll
        for (int ai = 0; ai < 2; ++ai)
#pragma unroll
            for (int m = 0; m < 4; ++m) { bf16_t* rowp = O + (size_t)(row0 + ai * HALF + m * 16) * ldc + col0;
#pragma unroll
                for (int bj = 0; bj < 2; ++bj) { const f32x4 v0 = acc[ai][bj][m][0], v1 = acc[ai][bj][m][1];
                    u32x4 w; w.x = cvt_pk_bf16(v0[0], v0[1]); w.y = cvt_pk_bf16(v0[2], v0[3]); w.z = cvt_pk_bf16(v1[0], v1[1]); w.w = cvt_pk_bf16(v1[2], v1[3]);
                    *(u32x4*)(rowp + bj * HALF) = w; } }
    }
};
struct EpiF32Res {
    static constexpr bool PERM = true, AFTER_DRAIN = false;
    const float* res; float* O; int ldc; bf16_t* HG; const float* gain; float* ssq;
    __device__ __forceinline__ void operator()(const f32x4 (&acc)[2][2][4][2], const Unit& u, int wr, int wc, int fr, int fq) const {
        const int row0 = u.pm * BM + wr * 64 + fr; const int col0 = u.pn * BM + wc * 32 + 8 * fq;
        f32x4 gv[2][2];
#pragma unroll
        for (int bj = 0; bj < 2; ++bj) { gv[bj][0] = *(const f32x4*)(gain + col0 + bj * HALF); gv[bj][1] = *(const f32x4*)(gain + col0 + bj * HALF + 4); }
#pragma unroll
        for (int ai = 0; ai < 2; ++ai)
#pragma unroll
            for (int m = 0; m < 4; ++m) { const int row = row0 + ai * HALF + m * 16; const size_t off = (size_t)row * ldc + col0; float sq = 0.f;
#pragma unroll
                for (int bj = 0; bj < 2; ++bj) { const f32x4 r0 = *(const f32x4*)(res + off + bj * HALF), r1 = *(const f32x4*)(res + off + bj * HALF + 4);
                    const f32x4 h0 = acc[ai][bj][m][0] + r0, h1 = acc[ai][bj][m][1] + r1;
                    *(f32x4*)(O + off + bj * HALF) = h0; *(f32x4*)(O + off + bj * HALF + 4) = h1;
                    sq += (h0[0] * h0[0] + h0[1] * h0[1]) + (h0[2] * h0[2] + h0[3] * h0[3]) + (h1[0] * h1[0] + h1[1] * h1[1]) + (h1[2] * h1[2] + h1[3] * h1[3]);
                    const f32x4 g0 = gv[bj][0], g1 = gv[bj][1];
                    u32x4 w; w.x = cvt_pk_bf16(h0[0] * g0[0], h0[1] * g0[1]); w.y = cvt_pk_bf16(h0[2] * g0[2], h0[3] * g0[3]); w.z = cvt_pk_bf16(h1[0] * g1[0], h1[1] * g1[1]); w.w = cvt_pk_bf16(h1[2] * g1[2], h1[3] * g1[3]);
                    *(u32x4*)(HG + off + bj * HALF) = w; }
                sq += __shfl_xor(sq, 16); sq += __shfl_xor(sq, 32);
                if (fq == 0) atomicAdd(ssq + row, sq); }
    }
};
struct EpiBf16Rs {
    static constexpr bool PERM = true, AFTER_DRAIN = false;
    bf16_t* O; int ldc; const float* ssq;
    __device__ __forceinline__ void operator()(const f32x4 (&acc)[2][2][4][2], const Unit& u, int wr, int wc, int fr, int fq) const {
        const int row0 = u.pm * BM + wr * 64 + fr; const int col0 = u.pn * BM + wc * 32 + 8 * fq;
#pragma unroll
        for (int ai = 0; ai < 2; ++ai)
#pragma unroll
            for (int m = 0; m < 4; ++m) { const int row = row0 + ai * HALF + m * 16; bf16_t* rowp = O + (size_t)row * ldc + col0;
                const float rs = __builtin_amdgcn_rsqf(ssq[row] * (1.f / 1024.f) + 1e-6f);
#pragma unroll
                for (int bj = 0; bj < 2; ++bj) { const f32x4 v0 = acc[ai][bj][m][0] * rs, v1 = acc[ai][bj][m][1] * rs;
                    u32x4 w; w.x = cvt_pk_bf16(v0[0], v0[1]); w.y = cvt_pk_bf16(v0[2], v0[3]); w.z = cvt_pk_bf16(v1[0], v1[1]); w.w = cvt_pk_bf16(v1[2], v1[3]);
                    *(u32x4*)(rowp + bj * HALF) = w; } }
    }
};

template <class Epi, class Sched, bool ALIGN_EPI = false, bool SP2 = false>
__device__ __forceinline__ void gemm_phase(PG8_LAS unsigned char* lds, const Gemm g, const Sched& S, const Epi& E) {
    const int tid = threadIdx.x, wid = __builtin_amdgcn_readfirstlane(tid >> 6), lane = tid & 63, wr = wid >> 2, wc = wid & 3, fr = lane & 15, fq = lane >> 4;
    const int K = g.K, nt = K / BK;
    unsigned voffA[2], voffB[2];
#pragma unroll
    for (int i = 0; i < 2; ++i) { int R, C; stage_rc(tid * 16 + i * 8192, R, C); const int Rb = Epi::PERM ? ((R & ~31) + perm32(R & 31)) : R;
        voffA[i] = (unsigned)(R * K + C) * 2u; voffB[i] = (unsigned)(Rb * K + C) * 2u; }
    const size_t kstep = (size_t)(BK * 2);
    const size_t hstep = (size_t)HALF * K * 2;
    const size_t tstep = 2 * hstep;
    const unsigned ldsw = (unsigned)wid * 1024u;
    const int aoff = lds_byte(wr * 64 + fr, fq * 8), boff = lds_byte(wc * 32 + fr, fq * 8);
#define PG8_SA(b, h) (((b) * 2 + (h)) * HTB)
#define PG8_SB(b, h) ((4 + (b) * 2 + (h)) * HTB)
#define PG8_STAGE(bufoff, gbase, voff) do { _Pragma("unroll") for (int _i = 0; _i < 2; ++_i) \
        __builtin_amdgcn_global_load_lds((const unsigned*)((const char*)(gbase) + (voff)[_i]), (PG8_LAS unsigned*)(lds + (bufoff) + ldsw + _i * 8192), 16, 0, 0); } while (0)
#define PG8_LDA(dst, b, h) do { _Pragma("unroll") for (int m = 0; m < 4; ++m) _Pragma("unroll") for (int k = 0; k < 2; ++k) dst[m][k] = *(const PG8_LAS bf16x8*)(lds + PG8_SA(b, h) + aoff + m * 2048 + k * 1024); } while (0)
#define PG8_LDB(dst, b, h) do { _Pragma("unroll") for (int n = 0; n < 2; ++n) _Pragma("unroll") for (int k = 0; k < 2; ++k) dst[n][k] = *(const PG8_LAS bf16x8*)(lds + PG8_SB(b, h) + boff + n * 2048 + k * 1024); } while (0)
#define PG8_MMA(ai, bj, At, Bt) do { __builtin_amdgcn_s_setprio(1); _Pragma("unroll") for (int m = 0; m < 4; ++m) _Pragma("unroll") for (int n = 0; n < 2; ++n) _Pragma("unroll") for (int k = 0; k < 2; ++k) \
        acc[ai][bj][m][n] = __builtin_amdgcn_mfma_f32_16x16x32_bf16(Bt[n][k], At[m][k], acc[ai][bj][m][n], 0, 0, 0); __builtin_amdgcn_s_setprio(0); } while (0)
#define PG8_WAIT_V(n) asm volatile("s_waitcnt vmcnt(" #n ")" ::: "memory")
#define PG8_WAIT_L(n) asm volatile("s_waitcnt lgkmcnt(" #n ")" ::: "memory")
#define PG8_BAR __builtin_amdgcn_s_barrier()
#define PG8_SCHED __builtin_amdgcn_sched_barrier(0)
    Unit cur, nxt; int ui = 0;
    if (!S.next(0, cur)) return;
    f32x4 acc[2][2][4][2];
#pragma unroll
    for (int a = 0; a < 2; ++a)
#pragma unroll
        for (int b = 0; b < 2; ++b)
#pragma unroll
            for (int m = 0; m < 4; ++m)
#pragma unroll
                for (int n = 0; n < 2; ++n) acc[a][b][m][n] = (f32x4){0.f, 0.f, 0.f, 0.f};
    bf16x8 At[4][2], B0[2][2], B1[2][2];
    const char* cA = (const char*)g.A + (size_t)cur.pm * tstep; const char* cB = (const char*)g.Bt + (size_t)cur.pn * tstep;
    S.a_ready(cur);
    if constexpr (SP2) {
        PG8_STAGE(PG8_SB(0, 0), cB, voffB); PG8_STAGE(PG8_SB(0, 1), cB + hstep, voffB); PG8_STAGE(PG8_SA(0, 0), cA, voffA); PG8_STAGE(PG8_SA(0, 1), cA + hstep, voffA);
        if (wr == 1) PG8_BAR;
        PG8_WAIT_V(2); PG8_BAR;
        PG8_STAGE(PG8_SB(1, 0), cB + kstep, voffB); PG8_STAGE(PG8_SA(1, 0), cA + kstep, voffA); PG8_STAGE(PG8_SB(1, 1), cB + hstep + kstep, voffB);
        PG8_WAIT_V(6); PG8_BAR;
    } else {
        PG8_STAGE(PG8_SB(0, 0), cB, voffB); PG8_STAGE(PG8_SA(0, 0), cA, voffA); PG8_STAGE(PG8_SB(0, 1), cB + hstep, voffB); PG8_STAGE(PG8_SA(0, 1), cA + hstep, voffA);
        if (wr == 1) PG8_BAR;
        PG8_WAIT_V(4); PG8_BAR;
        PG8_STAGE(PG8_SB(1, 0), cB + kstep, voffB); PG8_STAGE(PG8_SA(1, 0), cA + kstep, voffA); PG8_STAGE(PG8_SB(1, 1), cB + hstep + kstep, voffB);
        PG8_WAIT_V(6); PG8_BAR;
    }
    for (;;) {
        const bool has_next = S.next(ui + 1, nxt);
        const char* nA = has_next ? (const char*)g.A + (size_t)nxt.pm * tstep : cA; const char* nB = has_next ? (const char*)g.Bt + (size_t)nxt.pn * tstep : cB;
        for (int t = 0; t < nt; t += 2) {
            const bool last = (t == nt - 2);
            const char* a1 = cA + (size_t)(t + 1) * kstep;
            const char* a2 = last ? nA : cA + (size_t)(t + 2) * kstep; const char* b2 = last ? nB : cB + (size_t)(t + 2) * kstep;
            const char* a3 = a2 + kstep; const char* b3 = b2 + kstep;
            if (last && has_next) S.a_ready(nxt);
            if constexpr (SP2) {
            PG8_LDB(B0, 0, 0); PG8_LDB(B1, 0, 1); PG8_SCHED; PG8_LDA(At, 0, 0); PG8_STAGE(PG8_SA(1, 1), a1 + hstep, voffA);
            PG8_WAIT_V(8); PG8_WAIT_L(0); PG8_BAR; PG8_MMA(0, 0, At, B0); PG8_MMA(0, 1, At, B1); PG8_BAR; PG8_SCHED;
            PG8_LDA(At, 0, 1); PG8_STAGE(PG8_SB(0, 0), b2, voffB); PG8_STAGE(PG8_SB(0, 1), b2 + hstep, voffB); PG8_STAGE(PG8_SA(0, 0), a2, voffA);
            PG8_WAIT_V(8); PG8_WAIT_L(0); PG8_BAR; PG8_MMA(1, 0, At, B0); PG8_MMA(1, 1, At, B1); PG8_BAR; PG8_SCHED;
            PG8_LDB(B0, 1, 0); PG8_LDB(B1, 1, 1); PG8_SCHED; PG8_LDA(At, 1, 0); PG8_STAGE(PG8_SA(0, 1), a2 + hstep, voffA);
            PG8_WAIT_V(8); PG8_WAIT_L(0); PG8_BAR; PG8_MMA(0, 0, At, B0); PG8_MMA(0, 1, At, B1); PG8_BAR; PG8_SCHED;
            PG8_LDA(At, 1, 1); PG8_STAGE(PG8_SB(1, 0), b3, voffB); PG8_STAGE(PG8_SB(1, 1), b3 + hstep, voffB); PG8_STAGE(PG8_SA(1, 0), a3, voffA);
            PG8_WAIT_V(8); PG8_WAIT_L(0); PG8_BAR; PG8_MMA(1, 0, At, B0); PG8_MMA(1, 1, At, B1); PG8_BAR; PG8_SCHED;
            } else {
            PG8_LDB(B0, 0, 0); PG8_SCHED; PG8_LDA(At, 0, 0); PG8_STAGE(PG8_SA(1, 1), a1 + hstep, voffA);
            PG8_WAIT_L(8); PG8_BAR; PG8_WAIT_L(0); PG8_MMA(0, 0, At, B0); PG8_BAR; PG8_SCHED;
            PG8_LDB(B1, 0, 1); PG8_STAGE(PG8_SB(0, 0), b2, voffB);
            PG8_BAR; PG8_WAIT_L(0); PG8_MMA(0, 1, At, B1); PG8_BAR;
            PG8_LDA(At, 0, 1); PG8_STAGE(PG8_SA(0, 0), a2, voffA);
            PG8_BAR; PG8_WAIT_L(0); PG8_MMA(1, 0, At, B0); PG8_BAR; PG8_SCHED;
            PG8_STAGE(PG8_SB(0, 1), b2 + hstep, voffB);
            PG8_WAIT_V(6); PG8_BAR; PG8_MMA(1, 1, At, B1); PG8_BAR;
            PG8_LDB(B0, 1, 0); PG8_SCHED; PG8_LDA(At, 1, 0); PG8_STAGE(PG8_SA(0, 1), a2 + hstep, voffA);
            PG8_WAIT_L(8); PG8_BAR; PG8_WAIT_L(0); PG8_MMA(0, 0, At, B0); PG8_BAR; PG8_SCHED;
            PG8_LDB(B1, 1, 1); PG8_STAGE(PG8_SB(1, 0), b3, voffB);
            PG8_BAR; PG8_WAIT_L(0); PG8_MMA(0, 1, At, B1); PG8_BAR;
            PG8_LDA(At, 1, 1); PG8_STAGE(PG8_SA(1, 0), a3, voffA);
            PG8_BAR; PG8_WAIT_L(0); PG8_MMA(1, 0, At, B0); PG8_BAR; PG8_SCHED;
            PG8_STAGE(PG8_SB(1, 1), b3 + hstep, voffB);
            PG8_WAIT_V(6); PG8_BAR; PG8_MMA(1, 1, At, B1); PG8_BAR;
            }
        }
        if constexpr (ALIGN_EPI) { if (wr == 0) PG8_BAR; }
        if constexpr (!Epi::AFTER_DRAIN) { E(acc, cur, wr, wc, fr, fq); S.done(cur); }
        if (!has_next) break;
#pragma unroll
        for (int a = 0; a < 2; ++a)
#pragma unroll
            for (int b = 0; b < 2; ++b)
#pragma unroll
                for (int m = 0; m < 4; ++m)
#pragma unroll
                    for (int n = 0; n < 2; ++n) acc[a][b][m][n] = (f32x4){0.f, 0.f, 0.f, 0.f};
        cur = nxt; cA = nA; cB = nB; ++ui;
        if constexpr (ALIGN_EPI) { if (wr == 1) PG8_BAR; }
    }
    PG8_WAIT_V(0);
    if constexpr (!ALIGN_EPI) { if (wr == 0) PG8_BAR; }
    PG8_BAR;
#undef PG8_SA
#undef PG8_SB
#undef PG8_STAGE
#undef PG8_LDA
#undef PG8_LDB
#undef PG8_MMA
#undef PG8_WAIT_V
#undef PG8_WAIT_L
#undef PG8_BAR
#undef PG8_SCHED
}
}

#define XB_TMO      128
#define XB_XCNT(j)  (256  + 64 * (j))
#define XB_XSUB(j)  (1280 + 64 * (j))
#define XB_XGEN(j)  (2304 + 64 * (j))
#define XB_TOP      3328
#define XB_TOPGEN   3392
#define XCD_BAR_WORDS 3456
#define XB_SPIN_CAP (1u << 22)
__device__ __forceinline__ unsigned xb_ld(unsigned* p)              { return __hip_atomic_load(p, __ATOMIC_RELAXED, __HIP_MEMORY_SCOPE_AGENT); }
__device__ __forceinline__ unsigned xb_add(unsigned* p, unsigned v) { return __hip_atomic_fetch_add(p, v, __ATOMIC_RELAXED, __HIP_MEMORY_SCOPE_AGENT); }
__device__ __forceinline__ unsigned xb_xcc_id() { return (unsigned)__builtin_amdgcn_s_getreg((3 << 11) | 20) & 0xFu; }
#define XB_SPIN(cond, bar) do { unsigned _sp = 0; while (cond) { __builtin_amdgcn_s_sleep(1); \
    if ((++_sp & 255u) == 0u) { if (xb_ld(&(bar)[XB_TMO])) break; if (_sp > XB_SPIN_CAP) { atomicAdd(&(bar)[XB_TMO], 1u); break; } } } } while (0)
struct XcdBarrier { unsigned* bar; unsigned x; volatile LAS unsigned* st; };
__device__ __forceinline__ XcdBarrier xcd_barrier_post(unsigned* bar, volatile LAS unsigned* st) {
    XcdBarrier b; b.bar = bar; b.x = xb_xcc_id(); b.st = st;
    if (threadIdx.x == 0) (void)xb_add(&bar[XB_XCNT(b.x)], 1u);
    return b;
}
__device__ __forceinline__ void xcd_barrier_complete(unsigned* bar, unsigned x, unsigned& nloc, unsigned& nx) {
    const unsigned G = gridDim.x * gridDim.y * gridDim.z;
    unsigned sum, cnt, mine, sp = 0u;
    for (;;) {
        sum = 0u; cnt = 0u; mine = 0u;
#pragma unroll
        for (unsigned j = 0; j < 16; ++j) { const unsigned c = xb_ld(&bar[XB_XCNT(j)]); sum += c; cnt += (c > 0u) ? 1u : 0u; mine = (j == x) ? c : mine; }
        if (sum == G) break;
        __builtin_amdgcn_s_sleep(1);
        if ((++sp & 255u) == 0u) { if (xb_ld(&bar[XB_TMO])) break; if (sp > XB_SPIN_CAP) { atomicAdd(&bar[XB_TMO], 1u); break; } }
    }
    nloc = mine > 0u ? mine : 1u; nx = cnt > 0u ? cnt : 1u;
}
__device__ __forceinline__ void xcd_barrier(const XcdBarrier& b) {
    asm volatile("s_waitcnt vmcnt(0)" ::: "memory");
    __syncthreads();
    if (threadIdx.x == 0) {
        unsigned* bar = b.bar;
        __builtin_amdgcn_s_waitcnt(0);
        unsigned nloc = b.st[0], nx = b.st[1];
        if (nloc == 0u) { xcd_barrier_complete(bar, b.x, nloc, nx); b.st[0] = nloc; b.st[1] = nx; }
        const unsigned old = xb_add(&bar[XB_XSUB(b.x)], 1u);
        const unsigned gen = old / nloc;
        if (old + 1u == (gen + 1u) * nloc) {
            __builtin_amdgcn_fence(__ATOMIC_RELEASE, "agent");
            asm volatile("s_waitcnt vmcnt(0)" ::: "memory");
            const unsigned og = xb_add(&bar[XB_TOP], 1u);
            const unsigned tg = og / nx;
            if (og + 1u == (tg + 1u) * nx) xb_add(&bar[XB_TOPGEN], 1u);
            else XB_SPIN(xb_ld(&bar[XB_TOPGEN]) == tg, bar);
            __builtin_amdgcn_fence(__ATOMIC_ACQUIRE, "agent");
            xb_add(&bar[XB_XGEN(b.x)], 1u);
            asm volatile("s_waitcnt vmcnt(0)" ::: "memory");
        } else {
            XB_SPIN(xb_ld(&bar[XB_XGEN(b.x)]) == gen, bar);
            __builtin_amdgcn_fence(__ATOMIC_ACQUIRE, "agent");
            asm volatile("s_waitcnt vmcnt(0)" ::: "memory");
        }
    }
    __syncthreads();
}

constexpr int RING_OFF = 0, RING_BYTES = 131072;
constexpr int LDSCTL_OFF = 162816, MISC_OFF = LDSCTL_OFF + 320;
constexpr int LDS_BYTES = 163840;

struct Frame {
    LAS unsigned char* lds;
    volatile LAS unsigned* MISC;
    gu32* ctl;
    int tid, lane, wave, G, wg;
    const float* in[21];
    float* out;
    unsigned char* ws;
};

__device__ __forceinline__ void p0_transpose_item(const float* W, int K, int N, bf16* WT, LAS float* scr, int item, int lane) {
    const int nblk = N / 32, kb = item / nblk, nb = item % nblk, k0 = 64 * kb, n0 = 32 * nb;
#pragma unroll 8
    for (int i = 0; i < 32; ++i) { const int kk = 2 * i + (lane >> 5); scr[kk * 33 + (lane & 31)] = W[(size_t)(k0 + kk) * N + n0 + (lane & 31)]; }
    LDS_WAIT(); asm volatile("" ::: "memory");
    const int c = lane & 7;
#pragma unroll
    for (int j = 0; j < 4; ++j) { const int n = (lane >> 3) + 8 * j; const LAS float* s = scr + (8 * c) * 33 + n;
        v4u o; o.x = pk2(s[0 * 33], s[1 * 33]); o.y = pk2(s[2 * 33], s[3 * 33]); o.z = pk2(s[4 * 33], s[5 * 33]); o.w = pk2(s[6 * 33], s[7 * 33]);
        *(GAS v4u*)(WT + (size_t)(n0 + n) * K + k0 + 8 * c) = o; }
    LDS_WAIT(); asm volatile("" ::: "memory");
}
__device__ __forceinline__ void rms_row_to_bf16(int lane, const float* xrow, const float* gain, bf16* orow) {
    const GAS f32x4* xr = (const GAS f32x4*)xrow + lane;
    const GAS f32x4* gr = (const GAS f32x4*)gain + lane;
    f32x4 v[4]; float s = 0.f;
#pragma unroll
    for (int j = 0; j < 4; ++j) { v[j] = xr[64 * j]; s += (v[j].x * v[j].x + v[j].y * v[j].y) + (v[j].z * v[j].z + v[j].w * v[j].w); }
    const float rstd = frsq(wave_sum(s) * (1.f / DM) + RMS_EPS);
    GAS unsigned long long* o8 = (GAS unsigned long long*)orow + lane;
#pragma unroll
    for (int j = 0; j < 4; ++j) { const f32x4 gg = gr[64 * j];
        o8[64 * j] = (unsigned long long)pk2(v[j].x * rstd * gg.x, v[j].y * rstd * gg.y) | ((unsigned long long)pk2(v[j].z * rstd * gg.z, v[j].w * rstd * gg.w) << 32); }
}
__device__ __forceinline__ void cvt_row_to_bf16(int lane, const float* xrow, bf16* orow) {
    const GAS f32x4* xr = (const GAS f32x4*)xrow + lane;
    GAS unsigned long long* o8 = (GAS unsigned long long*)orow + lane;
#pragma unroll
    for (int j = 0; j < 4; ++j) { const f32x4 v = xr[64 * j]; o8[64 * j] = (unsigned long long)pk2(v.x, v.y) | ((unsigned long long)pk2(v.z, v.w) << 32); }
}
__device__ __forceinline__ void p0_prologue(Frame& F) {
    LAS float* scr = (LAS float*)(F.lds + RING_OFF + F.wave * 16384);
    const int gw = F.wg * NWAVES + F.wave, NGW = F.G * NWAVES;
    constexpr int I_IN = (DM / 64) * (IN_COLS / 32), I_OUT = (DM / 64) * (DM / 32), I_Q = (DM / 64) * (PQ / 32);
    constexpr int NITEMS = I_IN + I_OUT + I_Q;
    bf16* win_t = (bf16*)(F.ws + WS_WIN); bf16* wout_t = (bf16*)(F.ws + WS_WOUT); bf16* wq_t = (bf16*)(F.ws + WS_WQ);
    for (int it = gw; it < NITEMS; it += NGW) {
        int r = it;
        if (r < I_IN) { p0_transpose_item(F.in[2], DM, IN_COLS, win_t, scr, r, F.lane); continue; } r -= I_IN;
        if (r < I_OUT) { p0_transpose_item(F.in[14], DM, DM, wout_t, scr, r, F.lane); continue; } r -= I_OUT;
        p0_transpose_item(F.in[16], DM, PQ, wq_t, scr, r, F.lane);
    }
    {
        constexpr int I_W = (64 / 64) * (RWW / 32), I_G = (128 / 64) * (RWW / 32);
        for (int it = gw; it < 2 * I_W + I_G; it += NGW) {
            int r = it;
            if (r < I_W) { p0_transpose_item(F.in[5], 64, RWW, (bf16*)(F.ws + WS_WUPT), scr, r, F.lane); continue; } r -= I_W;
            if (r < I_W) { p0_transpose_item(F.in[7], 64, RWW, (bf16*)(F.ws + WS_AUPT), scr, r, F.lane); continue; } r -= I_W;
            p0_transpose_item(F.in[8], 128, RWW, (bf16*)(F.ws + WS_GUPT), scr, r, F.lane);
        }
    }
    bf16* XN = (bf16*)(F.ws + WS_XN);
    for (int m = gw; m < T; m += NGW) rms_row_to_bf16(F.lane, F.in[0] + (size_t)m * DM, F.in[1], XN + (size_t)m * DM);
}

constexpr size_t WS_ROPE = WS_G;
__device__ __forceinline__ void p0_rope_table(Frame& F) {
    f32x2* tab = (f32x2*)(F.ws + WS_ROPE);
    for (int e = F.wg * NTHREADS + F.tid; e < SEQ * 32; e += F.G * NTHREADS) {
        const int sp = e >> 5, i = e & 31;
        const float inv_freq = powf(10000.0f, -(float)(2 * i) / 64.0f);
        const float ang = (float)sp * inv_freq;
        const double r = (double)ang - rint((double)ang * 0.15915494309189535) * 6.283185307179586;
        const float rf = (float)r;
        tab[e] = (f32x2){cosf(rf), sinf(rf)};
    }
}
__device__ __forceinline__ void p2_rope(Frame& F) {
    bf16* Z = (bf16*)(F.ws + WS_Z);
    const f32x2* tab = (const f32x2*)(F.ws + WS_ROPE);
    const int tid = F.tid, tk = tid >> 6, grp = (tid >> 2) & 15, i0 = (tid & 3) * 8;
    for (int blk = F.wg; blk < T / 8; blk += F.G) {
        const int g = blk * 8 + tk, sp = g & (SEQ - 1);
        bf16* p = Z + (size_t)g * IN_COLS + C_AQ + grp * 64 + i0;
        const v4u a = *(const GAS v4u*)p, b = *(const GAS v4u*)(p + 32);
        const GAS f32x4* tp = (const GAS f32x4*)(tab + sp * 32 + i0);
        float x1[8], x2[8];
        x1[0] = bflo(a.x); x1[1] = bfhi(a.x); x1[2] = bflo(a.y); x1[3] = bfhi(a.y); x1[4] = bflo(a.z); x1[5] = bfhi(a.z); x1[6] = bflo(a.w); x1[7] = bfhi(a.w);
        x2[0] = bflo(b.x); x2[1] = bfhi(b.x); x2[2] = bflo(b.y); x2[3] = bfhi(b.y); x2[4] = bflo(b.z); x2[5] = bfhi(b.z); x2[6] = bflo(b.w); x2[7] = bfhi(b.w);
        float o1[8], o2[8];
#pragma unroll
        for (int q = 0; q < 4; ++q) { const f32x4 cs = tp[q];
            o1[2 * q] = x1[2 * q] * cs[0] - x2[2 * q] * cs[1]; o2[2 * q] = x1[2 * q] * cs[1] + x2[2 * q] * cs[0];
            o1[2 * q + 1] = x1[2 * q + 1] * cs[2] - x2[2 * q + 1] * cs[3]; o2[2 * q + 1] = x1[2 * q + 1] * cs[3] + x2[2 * q + 1] * cs[2]; }
        v4u oa, ob; oa.x = pk2(o1[0], o1[1]); oa.y = pk2(o1[2], o1[3]); oa.z = pk2(o1[4], o1[5]); oa.w = pk2(o1[6], o1[7]);
        ob.x = pk2(o2[0], o2[1]); ob.y = pk2(o2[2], o2[3]); ob.z = pk2(o2[4], o2[5]); ob.w = pk2(o2[6], o2[7]);
        *(GAS v4u*)p = oa; *(GAS v4u*)(p + 32) = ob;
    }
}

typedef float f32x16 __attribute__((ext_vector_type(16)));
constexpr int SBS = 144;
constexpr int R1_EPRE = 0, R1_APRE = 16384, R1_AAB = 0, R1_X = 16384;
constexpr int R1_AT = 32768, R1_BT = 41984, R1_KT = 51200, R1_RT = 60416, R1_AHT = R1_BT, R1_U0T = R1_KT;
constexpr int R1_BBT = 69632, R1_KBT = 78848, R1_VT = 88064;
constexpr int R1_ACTW = 97280, R1_ACTA = 106496, R1_AAK = 97280, R1_ARB = 106496, R1_ARK = 115712;
constexpr int R1_BONUS = 124928, R1_WEND = 125184, R1_SEGS = 125440, R1_TII = 125440, R1_END = 129536;
static_assert(R1_END <= LDSCTL_OFF, "R1 LDS");
__device__ __forceinline__ int crow(int r, int hh) { return (r & 3) + 8 * (r >> 2) + 4 * hh; }
template <int KS> __device__ __forceinline__ f32x16 wtile(const LAS unsigned char* A, int sa, const LAS unsigned char* B, int sb, f32x16 acc, int lane) {
    const int row = lane & 31, hh = lane >> 5;
#pragma unroll
    for (int s = 0; s < KS; ++s) { const bf16x8 a = *(const LAS bf16x8*)(A + row * sa + 32 * s + 16 * hh); const bf16x8 b = *(const LAS bf16x8*)(B + row * sb + 32 * s + 16 * hh);
        acc = __builtin_amdgcn_mfma_f32_32x32x16_bf16(a, b, acc, 0, 0, 0); }
    return acc;
}
template <int KS> __device__ __forceinline__ f32x16 wtile_gb(const LAS unsigned char* A, int sa, const bf16* Bg, int ldb, f32x16 acc, int lane) {
    const int row = lane & 31, hh = lane >> 5;
#pragma unroll
    for (int s = 0; s < KS; ++s) { const bf16x8 a = *(const LAS bf16x8*)(A + row * sa + 32 * s + 16 * hh); const bf16x8 b = *(const GAS bf16x8*)(Bg + (size_t)row * ldb + 16 * s + 8 * hh);
        acc = __builtin_amdgcn_mfma_f32_32x32x16_bf16(a, b, acc, 0, 0, 0); }
    return acc;
}
__device__ __forceinline__ f32x16 zero16() { f32x16 z;
#pragma unroll
    for (int r = 0; r < 16; ++r) z[r] = 0.f;
    return z; }

struct R1Pre { v4u wd[2], ad[2], z[4]; };
__device__ __forceinline__ int r13_item(int wg, int G, int idx) { return G == 256 ? ((wg >> 3) * 128 + (wg & 7) + 8 * idx) : (wg + G * idx); }
__device__ __forceinline__ int r13_count(int wg, int G) { return G == 256 ? 16 : ((NB * NHR * 128 - wg + G - 1) / G); }
__device__ __forceinline__ void rwkv_r1_prefetch(Frame& F, int item, int tid, R1Pre& P) {
    const int chain = item >> 7, chunk = item & 127, b = chain >> 3, h = chain & 7, g0 = b * SEQ + chunk * 64;
    const bf16* Z = (const bf16*)(F.ws + WS_Z);
    const v4u z0 = (v4u){0u, 0u, 0u, 0u};
    { const int t = tid >> 3, cg = tid & 7; const bool first = (chunk == 0 && t == 0);
      const bf16* zr = Z + (size_t)(g0 + t) * IN_COLS;
      P.wd[0] = *(const GAS v4u*)(zr + C_WD + cg * 8); P.ad[0] = *(const GAS v4u*)(zr + C_AD + cg * 8);
      P.wd[1] = z0; P.ad[1] = z0;
      if (!first) { P.wd[1] = *(const GAS v4u*)(zr - IN_COLS + C_WD + cg * 8); P.ad[1] = *(const GAS v4u*)(zr - IN_COLS + C_AD + cg * 8); } }
#pragma unroll
    for (int q = 0; q < 4; ++q) { const int p = tid + 512 * q; P.z[q] = z0;
        if (p < 65 * 24) { const int row = p / 24, rem = p - row * 24, seg = rem >> 3, ch = rem & 7;
            if (!(chunk == 0 && row == 0)) P.z[q] = *(const GAS v4u*)(Z + (size_t)(g0 - 1 + row) * IN_COLS + seg * 512 + h * 64 + ch * 8); } }
}
constexpr int R1_ZS = R1_AT, R1_ZSS = 384;
static_assert(65 * R1_ZSS <= 4 * 9216, "ZS fits in the At..Rt region");
__device__ __forceinline__ void rwkv_r1_item(Frame& F, int item, int next_item, R1Pre& P) {
    const int chain = item >> 7, chunk = item & 127, b = chain >> 3, h = chain & 7;
    const int g0 = b * SEQ + chunk * 64;
    int tid_ = F.tid; asm volatile("" : "+v"(tid_));
    const int tid = tid_, lane = tid & 63, w = __builtin_amdgcn_readfirstlane(tid >> 6), hh = lane >> 5, cl = lane & 31;
    const bf16* Z = (const bf16*)(F.ws + WS_Z);
    LAS unsigned char* lds = F.lds + RING_OFF;
    const float* mu = F.in[3];
    {
        const int t = tid >> 3, cg = tid & 7;
        const v4u cw = P.wd[0], ca = P.ad[0], pw = P.wd[1], pa = P.ad[1];
        float fw[8], fa[8], qw[8], qa[8];
        fw[0] = bflo(cw.x); fw[1] = bfhi(cw.x); fw[2] = bflo(cw.y); fw[3] = bfhi(cw.y); fw[4] = bflo(cw.z); fw[5] = bfhi(cw.z); fw[6] = bflo(cw.w); fw[7] = bfhi(cw.w);
        fa[0] = bflo(ca.x); fa[1] = bfhi(ca.x); fa[2] = bflo(ca.y); fa[3] = bfhi(ca.y); fa[4] = bflo(ca.z); fa[5] = bfhi(ca.z); fa[6] = bflo(ca.w); fa[7] = bfhi(ca.w);
        qw[0] = bflo(pw.x); qw[1] = bfhi(pw.x); qw[2] = bflo(pw.y); qw[3] = bfhi(pw.y); qw[4] = bflo(pw.z); qw[5] = bfhi(pw.z); qw[6] = bflo(pw.w); qw[7] = bfhi(pw.w);
        qa[0] = bflo(pa.x); qa[1] = bfhi(pa.x); qa[2] = bflo(pa.y); qa[3] = bfhi(pa.y); qa[4] = bflo(pa.z); qa[5] = bfhi(pa.z); qa[6] = bflo(pa.w); qa[7] = bfhi(pa.w);
#pragma unroll
        for (int j = 0; j < 8; ++j) { const int c = cg * 8 + j; const float xw = fw[j] + (qw[j] - fw[j]) * mu[C_WD + c];
            const float ex = __expf(2.f * xw); fw[j] = 1.f - 2.f * frcp(ex + 1.f);
            fa[j] = fa[j] + (qa[j] - fa[j]) * mu[C_AD + c]; }
        v4u ow, oa; ow.x = pk2(fw[0], fw[1]); ow.y = pk2(fw[2], fw[3]); ow.z = pk2(fw[4], fw[5]); ow.w = pk2(fw[6], fw[7]);
        oa.x = pk2(fa[0], fa[1]); oa.y = pk2(fa[2], fa[3]); oa.z = pk2(fa[4], fa[5]); oa.w = pk2(fa[6], fa[7]);
        *(LAS v4u*)(lds + R1_ACTW + t * SBS + cg * 16) = ow; *(LAS v4u*)(lds + R1_ACTA + t * SBS + cg * 16) = oa;
#pragma unroll
        for (int q = 0; q < 4; ++q) { const int p = tid + 512 * q;
            if (p < 65 * 24) { const int row = p / 24, rem = p - row * 24; *(LAS v4u*)(lds + R1_ZS + row * R1_ZSS + rem * 16) = P.z[q]; } }
        if (next_item >= 0) rwkv_r1_prefetch(F, next_item, tid, P);
    }
    LDS_BARRIER();
    {
        const int p = w >> 2, mt = (w >> 1) & 1, nt = w & 1;
        const bf16* upt = (const bf16*)(F.ws + (p == 0 ? WS_WUPT : WS_AUPT)) + (size_t)(h * 64 + nt * 32) * 64;
        const f32x16 acc = wtile_gb<4>(lds + (p == 0 ? R1_ACTW : R1_ACTA) + mt * 32 * SBS, SBS, upt, 64, zero16(), lane);
        LAS float* O = (LAS float*)(lds + (p == 0 ? R1_EPRE : R1_APRE));
#pragma unroll
        for (int r = 0; r < 16; ++r) O[(mt * 32 + crow(r, hh)) * 64 + nt * 32 + cl] = acc[r];
    }
    LDS_BARRIER();
    {
        const int c = tid & 63, ts = tid >> 6, col = h * 64 + c;
        const float mu_r = mu[C_R + col], mu_k = mu[C_K + col], mu_v = mu[C_V + col], kkc = F.in[9][col], kac = F.in[10][col], rkc = F.in[11][col], w0c = F.in[4][col], a0c = F.in[6][col];
        const LAS float* EP = (const LAS float*)(lds + R1_EPRE); const LAS float* AP = (const LAS float*)(lds + R1_APRE);
        LAS float* SEGS = (LAS float*)(lds + R1_SEGS); LAS float* BON = (LAS float*)(lds + R1_BONUS);
        const LAS bf16* zb = (const LAS bf16*)(lds + R1_ZS + (8 * ts) * R1_ZSS) + c;
        float pr = bf2f(zb[0]), pk = bf2f(zb[64]), pv = bf2f(zb[128]);
        float rr[8], k2[8], ai[8], bi[8], vv[8], ee[8], cs[8]; float run = 0.f;
#pragma unroll
        for (int i = 0; i < 8; ++i) {
            const float zr = bf2f(zb[(i + 1) * (R1_ZSS / 2)]), zk = bf2f(zb[(i + 1) * (R1_ZSS / 2) + 64]), zv = bf2f(zb[(i + 1) * (R1_ZSS / 2) + 128]);
            const float r = zr + (pr - zr) * mu_r, k = zk + (pk - zk) * mu_k, v = zv + (pv - zv) * mu_v; pr = zr; pk = zk; pv = zv;
            const float e = 0.60653066f * frcp(1.f + __expf(-(w0c + EP[(8 * ts + i) * 64 + c])));
            const float a = frcp(1.f + __expf(-(a0c + AP[(8 * ts + i) * 64 + c])));
            float kk = k * kkc; const float n2 = wave_sum(kk * kk); kk = kk * frsq(fmaxf(n2, 1e-24f));
            const float kq = k * (1.f + (a - 1.f) * kac);
            const float bon = wave_sum(r * kq * rkc); if (c == 0) BON[8 * ts + i] = bon;
            rr[i] = r; k2[i] = kq; ai[i] = -kk; bi[i] = kk * a; vv[i] = v; ee[i] = e; run += e; cs[i] = run;
        }
        SEGS[ts * 64 + c] = run;
        LDS_BARRIER();
        float off = 0.f, tot = 0.f;
#pragma unroll
        for (int q = 0; q < 8; ++q) { const float sv = SEGS[q * 64 + c]; tot += sv; off += (q < ts) ? sv : 0.f; }
        float bb[8], kb[8];
#pragma unroll
        for (int i = 0; i < 8; ++i) { const float L = off + cs[i];
            const float Wm = __expf(-(L - ee[i])), Wi = __expf(-L), iW = __expf(L), We = __expf(-(tot - L));
            const int t = 8 * ts + i;
            *(LAS bf16*)(lds + R1_AT + t * SBS + c * 2) = (bf16)f2bf(ai[i] * Wm);
            *(LAS bf16*)(lds + R1_BT + t * SBS + c * 2) = (bf16)f2bf(bi[i] * iW);
            *(LAS bf16*)(lds + R1_KT + t * SBS + c * 2) = (bf16)f2bf(k2[i] * iW);
            *(LAS bf16*)(lds + R1_RT + t * SBS + c * 2) = (bf16)f2bf(rr[i] * Wi);
            bb[i] = bi[i] * We; kb[i] = k2[i] * We; }
        v4u o; o.x = pk2(bb[0], bb[1]); o.y = pk2(bb[2], bb[3]); o.z = pk2(bb[4], bb[5]); o.w = pk2(bb[6], bb[7]);
        *(LAS v4u*)(lds + R1_BBT + c * SBS + ts * 16) = o;
        o.x = pk2(kb[0], kb[1]); o.y = pk2(kb[2], kb[3]); o.z = pk2(kb[4], kb[5]); o.w = pk2(kb[6], kb[7]);
        *(LAS v4u*)(lds + R1_KBT + c * SBS + ts * 16) = o;
        o.x = pk2(vv[0], vv[1]); o.y = pk2(vv[2], vv[3]); o.z = pk2(vv[4], vv[5]); o.w = pk2(vv[6], vv[7]);
        *(LAS v4u*)(lds + R1_VT + c * SBS + ts * 16) = o;
        if (ts == 0) ((LAS float*)(lds + R1_WEND))[c] = __expf(-tot);
    }
    LDS_BARRIER();
#pragma unroll
    for (int u = 0; u < 2; ++u) {
        const int idx = w * 2 + u, p = idx >> 2, mt = (idx >> 1) & 1, nt = idx & 1;
        const LAS unsigned char* Aop = lds + ((p == 0 || p == 2) ? R1_BT : R1_KT) + mt * 32 * SBS;
        const LAS unsigned char* Bop = lds + (p < 2 ? R1_AT : R1_RT) + nt * 32 * SBS;
        f32x16 acc = wtile<4>(Aop, SBS, Bop, SBS, zero16(), lane);
        const int n = nt * 32 + cl;
#pragma unroll
        for (int r = 0; r < 16; ++r) { const int m = mt * 32 + crow(r, hh); const bool keep = (p < 2) ? (m < n) : (m <= n); acc[r] = keep ? acc[r] : 0.f; }
#pragma unroll
        for (int g4 = 0; g4 < 4; ++g4) { const int m0 = mt * 32 + 8 * g4 + 4 * hh;
            if (p == 0) *(LAS f32x4*)(lds + R1_AAB + (n * 64 + m0) * 4) = (f32x4){acc[4 * g4], acc[4 * g4 + 1], acc[4 * g4 + 2], acc[4 * g4 + 3]};
            else { v2u o; o.x = pk2(acc[4 * g4], acc[4 * g4 + 1]); o.y = pk2(acc[4 * g4 + 2], acc[4 * g4 + 3]);
                   *(LAS v2u*)(lds + (p == 1 ? R1_AAK : (p == 2 ? R1_ARB : R1_ARK)) + n * SBS + m0 * 2) = o; } }
    }
    LDS_BARRIER();
    if (w < 4) {
        const int mt = w >> 1, nt = w & 1;
        const f32x16 acc = wtile<4>(lds + R1_AAK + mt * 32 * SBS, SBS, lds + R1_VT + nt * 32 * SBS, SBS, zero16(), lane);
        LAS float* X = (LAS float*)(lds + R1_X);
#pragma unroll
        for (int r = 0; r < 16; ++r) X[(mt * 32 + crow(r, hh)) * 64 + nt * 32 + cl] = acc[r];
    } else if (w == 4) {
        const int bk = lane >> 4, c = lane & 15;
        const LAS float* AAB = (const LAS float*)(lds + R1_AAB);
        float Tc[16]; const float fc = (float)c;
#pragma unroll
        for (int s2 = 0; s2 < 16; ++s2) Tc[s2] = fmaxf(0.f, 1.f - fabsf((float)s2 - fc));
#pragma unroll
        for (int r = 0; r < 15; ++r)
#pragma unroll
            for (int s2 = r + 1; s2 < 16; ++s2) Tc[s2] += AAB[(16 * bk + s2) * 64 + 16 * bk + r] * Tc[r];
        LAS float* TII = (LAS float*)(lds + R1_TII);
#pragma unroll
        for (int s2 = 0; s2 < 16; ++s2) TII[(bk * 16 + s2) * 16 + c] = Tc[s2];
    }
    LDS_BARRIER();
    {
        const int c16 = lane & 15, g = lane >> 4;
        const LAS float* AAB = (const LAS float*)(lds + R1_AAB); const LAS float* TII = (const LAS float*)(lds + R1_TII); const LAS float* X = (const LAS float*)(lds + R1_X);
        f32x4 o[4];
#pragma unroll
        for (int i = 0; i < 4; ++i) {
            f32x4 acc;
            if (w < 4) {
#pragma unroll
                for (int q = 0; q < 4; ++q) acc[q] = bf2f(*(const LAS bf16*)(lds + R1_AT + (16 * i + 4 * g + q) * SBS + (16 * w + c16) * 2));
            } else {
#pragma unroll
                for (int q = 0; q < 4; ++q) acc[q] = X[(16 * i + 4 * g + q) * 64 + 16 * (w - 4) + c16];
            }
#pragma unroll
            for (int j = 0; j < i; ++j) { const f32x4 a4 = *(const LAS f32x4*)(AAB + (16 * i + c16) * 64 + 16 * j + 4 * g);
#pragma unroll
                for (int q = 0; q < 4; ++q) acc = __builtin_amdgcn_mfma_f32_16x16x4f32(a4[q], o[j][q], acc, 0, 0, 0); }
            const f32x4 t4 = *(const LAS f32x4*)(TII + (i * 16 + c16) * 16 + 4 * g);
            f32x4 res = (f32x4){0.f, 0.f, 0.f, 0.f};
#pragma unroll
            for (int q = 0; q < 4; ++q) res = __builtin_amdgcn_mfma_f32_16x16x4f32(t4[q], acc[q], res, 0, 0, 0);
            o[i] = res;
            v2u ov; ov.x = pk2(res[0], res[1]); ov.y = pk2(res[2], res[3]);
            *(LAS v2u*)(lds + (w < 4 ? R1_AHT : R1_U0T) + (16 * (w & 3) + c16) * SBS + (16 * i + 4 * g) * 2) = ov;
        }
    }
    LDS_BARRIER();
    {
        float* Mg = F.out + (size_t)item * 4096; float* NTg = F.out + (size_t)T * RWW + (size_t)item * 4096;
        float* Y0g = (float*)(F.ws + WS_RWY0) + (size_t)item * 4096; bf16* RHg = (bf16*)(F.ws + WS_RWRH) + (size_t)item * 4096;
#pragma unroll
        for (int u = 0; u < 2; ++u) {
            const int idx = w * 2 + u, p = idx >> 2, mt = (idx >> 1) & 1, nt = idx & 1; const int n = nt * 32 + cl;
            if (p == 0) {
                f32x16 acc = wtile<4>(lds + R1_AHT + mt * 32 * SBS, SBS, lds + R1_BBT + nt * 32 * SBS, SBS, zero16(), lane);
                const float we = ((const LAS float*)(lds + R1_WEND))[n];
#pragma unroll
                for (int g4 = 0; g4 < 4; ++g4) { const int m0 = mt * 32 + 8 * g4 + 4 * hh;
                    *(GAS f32x4*)(Mg + n * 64 + m0) = (f32x4){acc[4 * g4] + (m0 == n ? we : 0.f), acc[4 * g4 + 1] + (m0 + 1 == n ? we : 0.f), acc[4 * g4 + 2] + (m0 + 2 == n ? we : 0.f), acc[4 * g4 + 3] + (m0 + 3 == n ? we : 0.f)}; }
            } else if (p == 1) {
                f32x16 acc = wtile<4>(lds + R1_BBT + mt * 32 * SBS, SBS, lds + R1_U0T + nt * 32 * SBS, SBS, zero16(), lane);
                acc = wtile<4>(lds + R1_KBT + mt * 32 * SBS, SBS, lds + R1_VT + nt * 32 * SBS, SBS, acc, lane);
#pragma unroll
                for (int g4 = 0; g4 < 4; ++g4) *(GAS f32x4*)(NTg + n * 64 + mt * 32 + 8 * g4 + 4 * hh) = (f32x4){acc[4 * g4], acc[4 * g4 + 1], acc[4 * g4 + 2], acc[4 * g4 + 3]};
            } else if (p == 2) {
                f32x16 acc = wtile<4>(lds + R1_AHT + mt * 32 * SBS, SBS, lds + R1_ARB + nt * 32 * SBS, SBS, zero16(), lane);
#pragma unroll
                for (int g4 = 0; g4 < 4; ++g4) { const int m0 = mt * 32 + 8 * g4 + 4 * hh;
                    const v2u rt = *(const LAS v2u*)(lds + R1_RT + n * SBS + m0 * 2);
                    v2u ov; ov.x = pk2(acc[4 * g4] + bflo(rt.x), acc[4 * g4 + 1] + bfhi(rt.x)); ov.y = pk2(acc[4 * g4 + 2] + bflo(rt.y), acc[4 * g4 + 3] + bfhi(rt.y));
                    *(GAS v2u*)(RHg + n * 64 + m0) = ov; }
            } else {
                f32x16 acc = wtile<4>(lds + R1_U0T + mt * 32 * SBS, SBS, lds + R1_ARB + nt * 32 * SBS, SBS, zero16(), lane);
                acc = wtile<4>(lds + R1_VT + mt * 32 * SBS, SBS, lds + R1_ARK + nt * 32 * SBS, SBS, acc, lane);
#pragma unroll
                for (int g4 = 0; g4 < 4; ++g4) *(GAS f32x4*)(Y0g + n * 64 + mt * 32 + 8 * g4 + 4 * hh) = (f32x4){acc[4 * g4], acc[4 * g4 + 1], acc[4 * g4 + 2], acc[4 * g4 + 3]};
            }
        }
        if (tid < 64) ((float*)(F.ws + WS_BONUS))[(size_t)item * 64 + tid] = ((const LAS float*)(lds + R1_BONUS))[tid];
    }
    LDS_BARRIER();
}

constexpr int R2_RS = 272, R2_SLOT = 2 * 64 * R2_RS, R2_D = 6;
static_assert(2 * R2_SLOT <= LDSCTL_OFF, "R2 LDS");
__device__ __forceinline__ void rwkv_r2_chain(Frame& F, int chain) {
    int tid_ = F.tid; asm volatile("" : "+v"(tid_));
    const int lane = tid_ & 63, w = __builtin_amdgcn_readfirstlane(tid_ >> 6);
    LAS unsigned char* lds = F.lds + RING_OFF;
    const float* Mg = F.out + (size_t)chain * 128 * 4096; const float* NTg = F.out + (size_t)T * RWW + (size_t)chain * 128 * 4096;
    constexpr int NSTEP = 127;
    if (w >= 4) {
        const int L = w - 4, r = lane >> 2, f0 = (lane & 3) * 4;
        const size_t goff = (size_t)(16 * L + r) * 64 + f0 * 4;
        const int loff = (16 * L + r) * R2_RS + f0 * 16;
        f32x4 R[R2_D][8];
#define R2_ISSUE(slot_, step_) do { const int st_ = (step_) < NSTEP ? (step_) : NSTEP - 1; const float* mp_ = Mg + (size_t)st_ * 4096 + goff; const float* np_ = NTg + (size_t)st_ * 4096 + goff; \
            _Pragma("unroll") for (int k_ = 0; k_ < 4; ++k_) { R[slot_][k_] = *(const GAS f32x4*)(mp_ + 4 * k_); R[slot_][4 + k_] = *(const GAS f32x4*)(np_ + 4 * k_); } } while (0)
        const int q_ = lane & 3, froff = ((L * 2 + (q_ >> 1)) * 2) * 1024 + r * 16 + (q_ & 1) * 8;
#define R2_WRITE(slot_, buf_) do { LAS unsigned char* d_ = lds + (buf_) * R2_SLOT; \
            _Pragma("unroll") for (int k_ = 0; k_ < 4; ++k_) { const f32x4 a_ = R[slot_][k_]; \
                v2u h_; h_.x = pk2(a_[0], a_[1]); h_.y = pk2(a_[2], a_[3]); \
                v2u l_; l_.x = pk2(a_[0] - bflo(h_.x), a_[1] - bfhi(h_.x)); l_.y = pk2(a_[2] - bflo(h_.y), a_[3] - bfhi(h_.y)); \
                *(LAS v2u*)(d_ + froff + k_ * 256) = h_; *(LAS v2u*)(d_ + froff + 1024 + k_ * 256) = l_; \
                *(LAS f32x4*)(d_ + 64 * R2_RS + loff + 16 * k_) = R[slot_][4 + k_]; } } while (0)
#pragma unroll
        for (int u = 0; u < R2_D; ++u) R2_ISSUE(u, u);
        R2_WRITE(0, 0);
        R2_ISSUE(0, R2_D);
        LDS_BARRIER();
        static_assert(NSTEP % R2_D == 1, "main loop covers steps 0 .. NSTEP-2, one tail step");
        for (int c0 = 0; c0 < NSTEP - 1; c0 += R2_D) {
#pragma unroll
            for (int u = 0; u < R2_D; ++u) { const int c = c0 + u;
                R2_WRITE((u + 1) % R2_D, (c + 1) & 1);
                R2_ISSUE((u + 1) % R2_D, c + 1 + R2_D);
                LDS_BARRIER(); }
        }
        LDS_BARRIER();
#undef R2_ISSUE
#undef R2_WRITE
        return;
    }
    const int n16 = lane & 15, g = lane >> 4;
    float* SSg = (float*)(F.ws + WS_RWSS) + (size_t)chain * 128 * 4096;
    f32x4 st[4];
#pragma unroll
    for (int rt = 0; rt < 4; ++rt) st[rt] = (f32x4){0.f, 0.f, 0.f, 0.f};
    LDS_BARRIER();
    for (int c = 0; c < NSTEP; ++c) {
#pragma unroll
        for (int rt = 0; rt < 4; ++rt) *(GAS f32x4*)(SSg + (size_t)c * 4096 + (16 * w + n16) * 64 + 16 * rt + 4 * g) = st[rt];
        const LAS unsigned char* sl_ = lds + (c & 1) * R2_SLOT;
        bf16x8 sh[2], sl[2];
#pragma unroll
        for (int ks = 0; ks < 2; ++ks) { const f32x4 a = st[2 * ks], b = st[2 * ks + 1];
            v4u h; h.x = pk2(a[0], a[1]); h.y = pk2(a[2], a[3]); h.z = pk2(b[0], b[1]); h.w = pk2(b[2], b[3]);
            v4u l; l.x = pk2(a[0] - bflo(h.x), a[1] - bfhi(h.x)); l.y = pk2(a[2] - bflo(h.y), a[3] - bfhi(h.y)); l.z = pk2(b[0] - bflo(h.z), b[1] - bfhi(h.z)); l.w = pk2(b[2] - bflo(h.w), b[3] - bfhi(h.w));
            sh[ks] = __builtin_bit_cast(bf16x8, h); sl[ks] = __builtin_bit_cast(bf16x8, l); }
        f32x4 nw[4];
#pragma unroll
        for (int rt = 0; rt < 4; ++rt) { f32x4 acc = *(const LAS f32x4*)(sl_ + 64 * R2_RS + (16 * w + n16) * R2_RS + (16 * rt + 4 * g) * 4);
#pragma unroll
            for (int ks = 0; ks < 2; ++ks) {
                const bf16x8 mh = *(const LAS bf16x8*)(sl_ + ((rt * 2 + ks) * 2) * 1024 + lane * 16), ml = *(const LAS bf16x8*)(sl_ + ((rt * 2 + ks) * 2 + 1) * 1024 + lane * 16);
                acc = __builtin_amdgcn_mfma_f32_16x16x32_bf16(mh, sh[ks], acc, 0, 0, 0);
                acc = __builtin_amdgcn_mfma_f32_16x16x32_bf16(mh, sl[ks], acc, 0, 0, 0);
                acc = __builtin_amdgcn_mfma_f32_16x16x32_bf16(ml, sh[ks], acc, 0, 0, 0); }
            nw[rt] = acc; }
#pragma unroll
        for (int rt = 0; rt < 4; ++rt) st[rt] = nw[rt];
        LDS_BARRIER();
    }
#pragma unroll
    for (int rt = 0; rt < 4; ++rt) *(GAS f32x4*)(SSg + (size_t)NSTEP * 4096 + (16 * w + n16) * 64 + 16 * rt + 4 * g) = st[rt];
}

constexpr int R3_RH = 0, R3_S = 9216, R3_SG = 18432, R3_SGS = 272, R3_YL = R3_SG + 64 * R3_SGS, R3_GL = R3_YL + 16384, R3_VS = R3_GL + 16384, R3_BON = R3_VS + 65 * 128, R3_END = R3_BON + 256;
static_assert(R3_END <= LDSCTL_OFF, "R3 LDS");
struct R3Pre { v4u rh; f32x4 ss[2]; v4u gd[2][2]; f32x4 y0[2]; v4u vv[2]; float bon; };
__device__ __forceinline__ void rwkv_r3_prefetch(Frame& F, int item, int tid, R3Pre& P) {
    const int chain = item >> 7, chunk = item & 127, b = chain >> 3, h = chain & 7, g0 = b * SEQ + chunk * 64;
    const bf16* Z = (const bf16*)(F.ws + WS_Z);
    const int t = tid >> 3, cg = tid & 7; const v4u z0 = (v4u){0u, 0u, 0u, 0u};
    P.rh = *(const GAS v4u*)((const bf16*)(F.ws + WS_RWRH) + (size_t)item * 4096 + t * 64 + cg * 8);
    const float* SSg = (const float*)(F.ws + WS_RWSS) + (size_t)item * 4096 + t * 64 + cg * 8;
    P.ss[0] = *(const GAS f32x4*)SSg; P.ss[1] = *(const GAS f32x4*)(SSg + 4);
    const bf16* zr = Z + (size_t)(g0 + t) * IN_COLS + C_GD + cg * 16; const bool first = (chunk == 0 && t == 0);
#pragma unroll
    for (int q = 0; q < 2; ++q) { P.gd[q][0] = *(const GAS v4u*)(zr + q * 8); P.gd[q][1] = z0; if (!first) P.gd[q][1] = *(const GAS v4u*)(zr - IN_COLS + q * 8); }
    const float* Y0g = (const float*)(F.ws + WS_RWY0) + (size_t)item * 4096;
    P.y0[0] = *(const GAS f32x4*)(Y0g + tid * 4); P.y0[1] = *(const GAS f32x4*)(Y0g + (tid + 512) * 4);
#pragma unroll
    for (int q = 0; q < 2; ++q) { const int p = tid + 512 * q; P.vv[q] = z0;
        if (p < 65 * 8) { const int row = p >> 3, ch = p & 7; if (!(chunk == 0 && row == 0)) P.vv[q] = *(const GAS v4u*)(Z + (size_t)(g0 - 1 + row) * IN_COLS + C_V + h * 64 + ch * 8); } }
    P.bon = tid < 64 ? ((const float*)(F.ws + WS_BONUS))[(size_t)item * 64 + tid] : 0.f;
}
__device__ __forceinline__ void rwkv_r3_item(Frame& F, int item, int next_item, R3Pre& P) {
    const int chain = item >> 7, chunk = item & 127, b = chain >> 3, h = chain & 7;
    const int g0 = b * SEQ + chunk * 64;
    int tid_ = F.tid; asm volatile("" : "+v"(tid_));
    const int tid = tid_, lane = tid & 63, w = __builtin_amdgcn_readfirstlane(tid >> 6), hh = lane >> 5, cl = lane & 31;
    LAS unsigned char* lds = F.lds + RING_OFF;
    const float* mu = F.in[3];
    {
        const int t = tid >> 3, cg = tid & 7;
        *(LAS v4u*)(lds + R3_RH + t * SBS + cg * 16) = P.rh;
        const f32x4 s0 = P.ss[0], s1 = P.ss[1];
        v4u o; o.x = pk2(s0[0], s0[1]); o.y = pk2(s0[2], s0[3]); o.z = pk2(s1[0], s1[1]); o.w = pk2(s1[2], s1[3]);
        *(LAS v4u*)(lds + R3_S + t * SBS + cg * 16) = o;
#pragma unroll
        for (int q = 0; q < 2; ++q) {
            const v4u cw = P.gd[q][0], pw = P.gd[q][1];
            float fw[8], qw[8];
            fw[0] = bflo(cw.x); fw[1] = bfhi(cw.x); fw[2] = bflo(cw.y); fw[3] = bfhi(cw.y); fw[4] = bflo(cw.z); fw[5] = bfhi(cw.z); fw[6] = bflo(cw.w); fw[7] = bfhi(cw.w);
            qw[0] = bflo(pw.x); qw[1] = bfhi(pw.x); qw[2] = bflo(pw.y); qw[3] = bfhi(pw.y); qw[4] = bflo(pw.z); qw[5] = bfhi(pw.z); qw[6] = bflo(pw.w); qw[7] = bfhi(pw.w);
#pragma unroll
            for (int j = 0; j < 8; ++j) { const float v = fw[j] + (qw[j] - fw[j]) * mu[C_GD + cg * 16 + q * 8 + j]; fw[j] = frcp(1.f + __expf(-v)); }
            v4u og; og.x = pk2(fw[0], fw[1]); og.y = pk2(fw[2], fw[3]); og.z = pk2(fw[4], fw[5]); og.w = pk2(fw[6], fw[7]);
            *(LAS v4u*)(lds + R3_SG + t * R3_SGS + (cg * 16 + q * 8) * 2) = og;
        }
        *(LAS f32x4*)(lds + R3_YL + tid * 16) = P.y0[0]; *(LAS f32x4*)(lds + R3_YL + (tid + 512) * 16) = P.y0[1];
#pragma unroll
        for (int q = 0; q < 2; ++q) { const int p = tid + 512 * q; if (p < 65 * 8) *(LAS v4u*)(lds + R3_VS + p * 16) = P.vv[q]; }
        if (tid < 64) ((LAS float*)(lds + R3_BON))[tid] = P.bon;
        if (next_item >= 0) rwkv_r3_prefetch(F, next_item, tid, P);
    }
    LDS_BARRIER();
    {
        const int mt = (w >> 1) & 1, nt = w & 1; const int n = nt * 32 + cl;
        if (w < 4) {
            LAS float* YL = (LAS float*)(lds + R3_YL);
            f32x16 acc;
#pragma unroll
            for (int r = 0; r < 16; ++r) acc[r] = YL[(mt * 32 + crow(r, hh)) * 64 + n];
            acc = wtile<4>(lds + R3_RH + mt * 32 * SBS, SBS, lds + R3_S + nt * 32 * SBS, SBS, acc, lane);
#pragma unroll
            for (int r = 0; r < 16; ++r) YL[(mt * 32 + crow(r, hh)) * 64 + n] = acc[r];
        } else {
            const bf16* gut = (const bf16*)(F.ws + WS_GUPT) + (size_t)(h * 64 + nt * 32) * 128;
            const f32x16 acc = wtile_gb<8>(lds + R3_SG + mt * 32 * R3_SGS, R3_SGS, gut, 128, zero16(), lane);
            LAS float* GL = (LAS float*)(lds + R3_GL);
#pragma unroll
            for (int r = 0; r < 16; ++r) GL[(mt * 32 + crow(r, hh)) * 64 + n] = acc[r];
        }
    }
    LDS_BARRIER();
    {
        const int c = tid & 63, ts = tid >> 6, col = h * 64 + c;
        const float mu_v = mu[C_V + col], gw = F.in[12][col], gb = F.in[13][col];
        const LAS float* YL = (const LAS float*)(lds + R3_YL); const LAS float* GL = (const LAS float*)(lds + R3_GL); const LAS float* BON = (const LAS float*)(lds + R3_BON);
        bf16* Y = (bf16*)(F.ws + WS_YMIX);
        const LAS bf16* vb = (const LAS bf16*)(lds + R3_VS) + (8 * ts) * 64 + c;
        float pv = bf2f(vb[0]);
#pragma unroll
        for (int i = 0; i < 8; ++i) { const int t = 8 * ts + i;
            const float zv = bf2f(vb[(i + 1) * 64]); const float v = zv + (pv - zv) * mu_v; pv = zv;
            const float y = YL[t * 64 + c];
            const float mean = wave_sum(y) * (1.f / 64.f); const float d = y - mean; const float var = wave_sum(d * d) * (1.f / 64.f);
            const float yn = d * frsq(var + GN_EPS) * gw + gb;
            const float o = (yn + BON[t] * v) * GL[t * 64 + c];
            Y[(size_t)(g0 + t) * DM + col] = (bf16)f2bf(o); }
    }
    LDS_BARRIER();
}

typedef short s16x4 __attribute__((ext_vector_type(4)));
typedef short v4i16_t __attribute__((ext_vector_type(4)));
constexpr int AT_XO = 0, AT_XO_STRIDE = 136, AT_XM = 512 * AT_XO_STRIDE, AT_XL = AT_XM + 2048, AT_V = AT_XL + 2048, AT_LDS_END = AT_V + 8 * 4096;
static_assert(AT_LDS_END <= RING_BYTES, "attention LDS");
__device__ __forceinline__ float xhalf(float v) { return __shfl_xor(v, 32); }
__device__ __forceinline__ void attn_block(Frame& F, int item) {
    const int bh = item >> 4, blk = item & 15, b = bh >> 3, h = bh & 7, t0 = blk * 512;
    int tid_ = F.tid; asm volatile("" : "+v"(tid_));
    const int lane = tid_ & 63, w = __builtin_amdgcn_readfirstlane(tid_ >> 6), ql = lane & 31, hh = lane >> 5;
    const bf16* Zb = (const bf16*)(F.ws + WS_Z) + (size_t)b * SEQ * IN_COLS;
    bf16* Y = (bf16*)(F.ws + WS_YMIX);
    LAS unsigned char* lds = F.lds + RING_OFF;
    LAS unsigned char* Vw = lds + AT_V + w * 4096;
    LAS float* XM = (LAS float*)(lds + AT_XM); LAS float* XL = (LAS float*)(lds + AT_XL);
    constexpr float C2 = 0.125f * 1.4426950408889634f;
    for (int pass = 0; pass < 3; ++pass) {
        const int sh = pass == 0 ? 4 : (pass == 1 ? 2 : 0), d = 1 << sh;
        for (int uu = 0; uu < 2; ++uu) {
            const int u = w + 8 * uu, rho = u & (d - 1), tau = u >> sh;
            const int qoff = rho + (32 * tau + ql) * d;
            bf16x8 qf[4];
            { const bf16* qp = Zb + (size_t)(t0 + qoff) * IN_COLS + C_AQ + h * 64 + 8 * hh;
#pragma unroll
              for (int s = 0; s < 4; ++s) qf[s] = *(const GAS bf16x8*)(qp + 16 * s); }
            f32x16 sc[5];
            const int tkb = t0 + rho + (32 * tau - 128) * d;
            bf16x8 kf[5][4];
#pragma unroll
            for (int kt = 0; kt < 5; ++kt) { const int tk0 = tkb + 32 * kt * d, tkc = tk0 < 0 ? 0 : tk0;
                const bf16* kp = Zb + (size_t)(tkc + ql * d) * IN_COLS + C_AK + h * 64 + 8 * hh;
#pragma unroll
                for (int s = 0; s < 4; ++s) kf[kt][s] = *(const GAS bf16x8*)(kp + 16 * s); }
            v4u vr[4];
            { const int tkc = tkb < 0 ? 0 : tkb;
#pragma unroll
              for (int i = 0; i < 4; ++i) { const int kidx = i * 8 + (lane >> 3), ch = lane & 7;
                  vr[i] = *(const GAS v4u*)(Zb + (size_t)(tkc + kidx * d) * IN_COLS + C_AV + h * 64 + ch * 8); } }
#pragma unroll
            for (int kt = 0; kt < 5; ++kt) {
                const int tk0 = tkb + 32 * kt * d;
                f32x16 acc = zero16();
#pragma unroll
                for (int s = 0; s < 4; ++s) acc = __builtin_amdgcn_mfma_f32_32x32x16_bf16(kf[kt][s], qf[s], acc, 0, 0, 0);
                if (kt == 0 || kt == 4) {
#pragma unroll
                    for (int r = 0; r < 16; ++r) { const int kidx = (r & 3) + 8 * (r >> 2) + 4 * hh;
                        const bool ok = (kt == 0) ? (kidx >= ql) : (kidx <= ql);
                        acc[r] = ok ? acc[r] : -INFINITY; }
                }
                if (tk0 < 0) {
#pragma unroll
                    for (int r = 0; r < 16; ++r) acc[r] = -INFINITY;
                }
                sc[kt] = acc;
            }
            float m = -INFINITY;
#pragma unroll
            for (int kt = 0; kt < 5; ++kt)
#pragma unroll
                for (int r = 0; r < 16; ++r) m = fmaxf(m, sc[kt][r]);
            m = fmaxf(m, xhalf(m));
            const float ms = m * C2;
            float l = 0.f;
#pragma unroll
            for (int kt = 0; kt < 5; ++kt)
#pragma unroll
                for (int r = 0; r < 16; ++r) { const float p = __builtin_amdgcn_exp2f(sc[kt][r] * C2 - ms); sc[kt][r] = p; l += p; }
            l += xhalf(l);
            f32x16 O[2];
#pragma unroll
            for (int r = 0; r < 16; ++r) { O[0][r] = 0.f; O[1][r] = 0.f; }
#pragma unroll
            for (int kt = 0; kt < 5; ++kt) {
#pragma unroll
                for (int i = 0; i < 4; ++i) { const int kidx = i * 8 + (lane >> 3), ch = lane & 7;
                    *(LAS v4u*)(Vw + kidx * 128 + ((ch ^ (((kidx >> 1) & 1) << 2)) << 4)) = vr[i]; }
                if (kt < 4) { const int tk1 = tkb + 32 * (kt + 1) * d, tkc = tk1 < 0 ? 0 : tk1;
#pragma unroll
                    for (int i = 0; i < 4; ++i) { const int kidx = i * 8 + (lane >> 3), ch = lane & 7;
                        vr[i] = *(const GAS v4u*)(Zb + (size_t)(tkc + kidx * d) * IN_COLS + C_AV + h * 64 + ch * 8); } }
                asm volatile("s_waitcnt lgkmcnt(0)" ::: "memory");
#pragma unroll
                for (int s = 0; s < 2; ++s) {
                    v4u pw; pw.x = pk2(sc[kt][8 * s], sc[kt][8 * s + 1]); pw.y = pk2(sc[kt][8 * s + 2], sc[kt][8 * s + 3]); pw.z = pk2(sc[kt][8 * s + 4], sc[kt][8 * s + 5]); pw.w = pk2(sc[kt][8 * s + 6], sc[kt][8 * s + 7]);
                    const bf16x8 pf = __builtin_bit_cast(bf16x8, pw);
#pragma unroll
                    for (int dt = 0; dt < 2; ++dt) {
                        bf16x8 vf;
#pragma unroll
                        for (int pp = 0; pp < 2; ++pp) {
                            const int i16 = lane & 15, db = (lane >> 4) & 1;
                            const int row = 16 * s + 8 * pp + 4 * hh + (i16 >> 2);
                            const int byte = 64 * dt + 32 * db + 8 * (i16 & 3);
                            const int chunk = (byte >> 4) ^ (((row >> 1) & 1) << 2);
                            const s16x4 t4 = __builtin_bit_cast(s16x4, __builtin_amdgcn_ds_read_tr16_b64_v4i16((LAS v4i16_t*)(Vw + row * 128 + (chunk << 4) + (byte & 15))));
                            vf[4 * pp + 0] = t4[0]; vf[4 * pp + 1] = t4[1]; vf[4 * pp + 2] = t4[2]; vf[4 * pp + 3] = t4[3];
                        }
                        O[dt] = __builtin_amdgcn_mfma_f32_32x32x16_bf16(vf, pf, O[dt], 0, 0, 0);
                    }
                }
                asm volatile("s_waitcnt lgkmcnt(0)" ::: "memory");
            }
            LAS unsigned char* xo = lds + AT_XO + qoff * AT_XO_STRIDE + 8 * hh;
            float wa = 0.f, wb = 1.f, Mx = ms, ln = l;
            if (pass > 0) { const float msa = XM[qoff], la = XL[qoff]; Mx = fmaxf(msa, ms); wa = la * __builtin_amdgcn_exp2f(msa - Mx); wb = __builtin_amdgcn_exp2f(ms - Mx); ln = wa + wb * l; }
            const float inv = 1.f / ln;
#pragma unroll
            for (int dt = 0; dt < 2; ++dt)
#pragma unroll
                for (int g4 = 0; g4 < 4; ++g4) {
                    LAS v2u* p = (LAS v2u*)(xo + (32 * dt + 8 * g4) * 2);
                    float o0 = O[dt][4 * g4] * wb, o1 = O[dt][4 * g4 + 1] * wb, o2 = O[dt][4 * g4 + 2] * wb, o3 = O[dt][4 * g4 + 3] * wb;
                    if (pass > 0) { const v2u old = *p; o0 += bflo(old.x) * wa; o1 += bfhi(old.x) * wa; o2 += bflo(old.y) * wa; o3 += bfhi(old.y) * wa; }
                    v2u nw; nw.x = pk2(o0 * inv, o1 * inv); nw.y = pk2(o2 * inv, o3 * inv);
                    *p = nw;
                }
            if (hh == 0) { XM[qoff] = Mx; XL[qoff] = ln; }
        }
        LDS_BARRIER();
    }
#pragma unroll
    for (int i = 0; i < 8; ++i) { const int row = (tid_ >> 3) + 64 * i, ch = tid_ & 7;
        LAS v2u* p = (LAS v2u*)(lds + AT_XO + row * AT_XO_STRIDE + ch * 16);
        const v2u a = p[0], c = p[1];
        v4u o; o.x = a.x; o.y = a.y; o.z = c.x; o.w = c.y;
        *(GAS v4u*)(Y + ((size_t)b * SEQ + t0 + row) * DM + RWW + h * 64 + ch * 8) = o; }
    LDS_BARRIER();
}

__device__ __forceinline__ void quantize_tables(Frame& F, int gw, int ngw) {
    for (int m = gw; m < 2 * NEXP; m += ngw) {
        const int tab = m >= NEXP, row = tab ? m - NEXP : m;
        const GAS f32x4* xr = (const GAS f32x4*)(F.in[18 + tab] + (size_t)row * DM) + F.lane * 4;
        f32x4 v[4]; float am = 0.f;
#pragma unroll
        for (int j = 0; j < 4; ++j) { v[j] = xr[j]; am = fmaxf(am, fmaxf(fmaxf(fabsf(v[j].x), fabsf(v[j].y)), fmaxf(fabsf(v[j].z), fabsf(v[j].w)))); }
        am = wave_max(am);
        const float qmax = tab ? 224.f : 127.f;
        const float sc = am > 0.f ? am / qmax : 1.f, inv = am > 0.f ? qmax / am : 0.f;
        v4u o;
#pragma unroll
        for (int j = 0; j < 4; ++j) {
            if (tab) { int w = __builtin_amdgcn_cvt_pk_fp8_f32(v[j].x * inv, v[j].y * inv, 0, false); w = __builtin_amdgcn_cvt_pk_fp8_f32(v[j].z * inv, v[j].w * inv, w, true); o[j] = (unsigned)w; }
            else {
            const unsigned b0 = (unsigned)(int)rintf(v[j].x * inv) & 255u, b1 = (unsigned)(int)rintf(v[j].y * inv) & 255u,
                           b2 = (unsigned)(int)rintf(v[j].z * inv) & 255u, b3 = (unsigned)(int)rintf(v[j].w * inv) & 255u;
            o[j] = b0 | (b1 << 8) | (b2 << 16) | (b3 << 24); } }
        *(GAS v4u*)(F.ws + (tab ? WS_VQ : WS_UQ) + (size_t)row * DM + F.lane * 16) = o;
        if (F.lane == 0) ((float*)(F.ws + (tab ? WS_SV : WS_SU)))[row] = sc;
    }
}

__device__ __forceinline__ void p3_mixers(Frame& F) {
    const int nrw = (F.G >= 64) ? 32 : 0;
    if (nrw == 0) { for (int ch = 0; ch < NB * NHR; ++ch) rwkv_r2_chain(F, ch); }
#ifndef RW2_REPS
#define RW2_REPS 1
#endif
    else if (F.wg < nrw) { for (int rep = 0; rep < RW2_REPS; ++rep) { for (int ch = F.wg; ch < NB * NHR; ch += nrw) rwkv_r2_chain(F, ch); if (rep + 1 < RW2_REPS) __syncthreads(); } return; }
    const int na = F.G - nrw, wa = F.wg - nrw;
#ifndef ATTN_REPS
#define ATTN_REPS 1
#endif
    for (int rep = 0; rep < ATTN_REPS; ++rep)
    for (int item = wa; item < NB * NHA * (SEQ / 512); item += na) attn_block(F, item);
    quantize_tables(F, wa * NWAVES + F.wave, na * NWAVES);
}

__device__ __forceinline__ void p5_xn2(Frame& F) {
    const int gw = F.wg * NWAVES + F.wave, NGW = F.G * NWAVES;
    bf16* XN = (bf16*)(F.ws + WS_XN);
    for (int m = gw; m < T; m += NGW) rms_row_to_bf16(F.lane, F.out + (size_t)m * DM, F.in[15], XN + (size_t)m * DM);
}

constexpr int TK_SKS = 272, TK_SKH = 0, TK_SKL = 2 * 128 * TK_SKS, TK_LUT = 2 * TK_SKL, TK_END = TK_LUT + 8 * 2048;
__device__ __forceinline__ unsigned f2ord(float f) { const unsigned u = __builtin_bit_cast(unsigned, f); return u ^ ((unsigned)((int)u >> 31) | 0x80000000u); }
__device__ __forceinline__ float ord2f(unsigned o) { const unsigned u = (o & 0x80000000u) ? (o ^ 0x80000000u) : ~o; return __builtin_bit_cast(float, u); }
__device__ __forceinline__ void ce_desc(unsigned& a, unsigned& b) { const unsigned mx = a > b ? a : b, mn = a > b ? b : a; a = mx; b = mn; }
template <int N, int OFF, int TOT> __device__ __forceinline__ void bitonic_sort_desc(unsigned (&v)[TOT]) {
#pragma unroll
    for (int k = 2; k <= N; k <<= 1)
#pragma unroll
        for (int j = k >> 1; j > 0; j >>= 1)
#pragma unroll
            for (int i = 0; i < N; ++i) { const int l = i ^ j; if (l > i) { if ((i & k) == 0) ce_desc(v[OFF + i], v[OFF + l]); else ce_desc(v[OFF + l], v[OFF + i]); } }
}
template <int OFFA, int OFFB, int TOT> __device__ __forceinline__ void merge_top16(unsigned (&v)[TOT]) {
#pragma unroll
    for (int i = 0; i < 16; ++i) { const unsigned x = v[OFFA + i], y = v[OFFB + 15 - i]; v[OFFA + i] = x > y ? x : y; }
#pragma unroll
    for (int j = 8; j > 0; j >>= 1)
#pragma unroll
        for (int i = 0; i < 16; ++i) { const int l = i ^ j; if (l > i) ce_desc(v[OFFA + i], v[OFFA + l]); }
}
__device__ __forceinline__ void top16_of_64(unsigned (&k)[64]) {
    bitonic_sort_desc<16, 0, 64>(k); bitonic_sort_desc<16, 16, 64>(k); bitonic_sort_desc<16, 32, 64>(k); bitonic_sort_desc<16, 48, 64>(k);
    merge_top16<0, 16, 64>(k); merge_top16<32, 48, 64>(k); merge_top16<0, 32, 64>(k);
}
__device__ __forceinline__ void p7_topk(Frame& F) {
    static_assert(TK_END <= LDSCTL_OFF, "topk LDS");
    const bf16* QP = (const bf16*)(F.ws + WS_QP);
    int* EID = (int*)(F.ws + WS_EID); float* GATE = (float*)(F.ws + WS_GATE);
    const float* sk = F.in[17];
    LAS unsigned char* lds = F.lds + RING_OFF;
    for (int e = F.tid; e < 2 * 128 * 64; e += NTHREADS) {
        const int c = e >> 13, k = (e >> 6) & 127, d2 = e & 63;
        const f32x2 v = *(const GAS f32x2*)(sk + (size_t)(c * 128 + k) * 128 + 2 * d2);
        const unsigned h0 = f2bf(v.x), h1 = f2bf(v.y);
        const float r0 = v.x - __builtin_bit_cast(float, h0 << 16), r1 = v.y - __builtin_bit_cast(float, h1 << 16);
        *(LAS unsigned*)(lds + TK_SKH + (c * 128 + k) * TK_SKS + d2 * 4) = h0 | (h1 << 16);
        *(LAS unsigned*)(lds + TK_SKL + (c * 128 + k) * TK_SKS + d2 * 4) = pk2(r0, r1);
    }
    __syncthreads();
    const int gw = F.wg * NWAVES + F.wave, NGW = F.G * NWAVES;
    for (int tile = gw; tile < T * PHEADS / 32; tile += NGW) {
        int lane_ = F.lane; asm volatile("" : "+v"(lane_));
        const int lane = lane_, hh = lane >> 5, cl = lane & 31;
        const int P = tile * 32 + cl, t = P >> 3, h = P & 7;
        unsigned kAB[2][16];
#pragma unroll
        for (int c = 0; c < 2; ++c) {
            bf16x8 qf[8];
            const bf16* qp = QP + (size_t)t * PQ + h * 256 + c * 128 + 8 * hh;
#pragma unroll
            for (int s2 = 0; s2 < 8; ++s2) qf[s2] = *(const GAS bf16x8*)(qp + 16 * s2);
            unsigned k[64];
#pragma unroll
            for (int mt = 0; mt < 4; ++mt) {
                f32x16 acc = zero16();
                const LAS unsigned char* ah = lds + TK_SKH + (c * 128 + mt * 32 + cl) * TK_SKS + 16 * hh;
                const LAS unsigned char* al = lds + TK_SKL + (c * 128 + mt * 32 + cl) * TK_SKS + 16 * hh;
#pragma unroll
                for (int s2 = 0; s2 < 8; ++s2) {
                    acc = __builtin_amdgcn_mfma_f32_32x32x16_bf16(*(const LAS bf16x8*)(ah + 32 * s2), qf[s2], acc, 0, 0, 0);
                    acc = __builtin_amdgcn_mfma_f32_32x32x16_bf16(*(const LAS bf16x8*)(al + 32 * s2), qf[s2], acc, 0, 0, 0); }
#pragma unroll
                for (int r = 0; r < 16; ++r) { const int idx = 32 * mt + (r & 3) + 8 * (r >> 2) + 4 * hh; k[mt * 16 + r] = (f2ord(acc[r]) & ~127u) | (unsigned)(127 - idx); }
            }
            top16_of_64(k);
            unsigned m[32];
#pragma unroll
            for (int i = 0; i < 16; ++i) { m[i] = k[i]; m[16 + i] = (unsigned)__shfl_xor((int)k[i], 32); }
            merge_top16<0, 16, 32>(m);
#pragma unroll
            for (int i = 0; i < 16; ++i) kAB[c][i] = m[i];
        }
        float fa[16], fb[16];
#pragma unroll
        for (int i = 0; i < 16; ++i) { fa[i] = ord2f(kAB[0][i] & ~127u); fb[i] = ord2f(kAB[1][i] & ~127u); }
        unsigned cd[64]; int n = 0;
#pragma unroll
        for (int i = 0; i < 16; ++i)
#pragma unroll
            for (int j = 0; j < 16; ++j) if ((i + 1) * (j + 1) <= 16) { cd[n] = (f2ord(fa[i] + fb[j]) & ~255u) | (unsigned)(255 - (i * 16 + j)); ++n; }
#pragma unroll
        for (int q = 50; q < 64; ++q) cd[q] = 0u;
        top16_of_64(cd);
        LAS unsigned char* lut = lds + TK_LUT + (F.wave * 64 + lane) * 32;
#pragma unroll
        for (int q = 0; q < 4; ++q) {
            unsigned wa = 0u, wb = 0u;
#pragma unroll
            for (int b4 = 0; b4 < 4; ++b4) { wa |= (127u - (kAB[0][4 * q + b4] & 127u)) << (8 * b4); wb |= (127u - (kAB[1][4 * q + b4] & 127u)) << (8 * b4); }
            *(LAS unsigned*)(lut + 4 * q) = wa; *(LAS unsigned*)(lut + 16 + 4 * q) = wb; }
        float gv[16]; float den = 0.f; const float mx = ord2f(cd[0] & ~255u);
#pragma unroll
        for (int q = 0; q < 16; ++q) { gv[q] = __expf(ord2f(cd[q] & ~255u) - mx); den += gv[q]; }
        const float inv = 1.f / den;
        asm volatile("s_waitcnt lgkmcnt(0)" ::: "memory");
        int ev[16];
#pragma unroll
        for (int q = 0; q < 16; ++q) { const unsigned pos = 255u - (cd[q] & 255u);
            const unsigned ia = *(const LAS unsigned char*)(lut + (pos >> 4)), ib = *(const LAS unsigned char*)(lut + 16 + (pos & 15u));
            ev[q] = (int)(ia * NKEYS + ib); }
        if (hh == 0) {
            int* ep = EID + (size_t)t * 128 + h * 16; float* gp = GATE + (size_t)t * 128 + h * 16;
#pragma unroll
            for (int q = 0; q < 4; ++q) {
                *(GAS v4u*)(ep + 4 * q) = (v4u){(unsigned)ev[4 * q], (unsigned)ev[4 * q + 1], (unsigned)ev[4 * q + 2], (unsigned)ev[4 * q + 3]};
                *(GAS f32x4*)(gp + 4 * q) = (f32x4){gv[4 * q] * inv, gv[4 * q + 1] * inv, gv[4 * q + 2] * inv, gv[4 * q + 3] * inv}; }
        }
        asm volatile("s_waitcnt lgkmcnt(0)" ::: "memory");
    }
}

constexpr int GA_WAVE_BYTES = 6656, GA_CNT = 4096, GA_OFF = 4096 + 128, GA_ACT = 4608;
__device__ __forceinline__ int wave_sum_i(int v) { v += dppi<0xB1>(v); v += dppi<0x4E>(v); v += dppi<0x141>(v); v += dppi<0x140>(v);
    return (__builtin_amdgcn_readlane(v, 0) + __builtin_amdgcn_readlane(v, 16)) + (__builtin_amdgcn_readlane(v, 32) + __builtin_amdgcn_readlane(v, 48)); }
struct PairBuf { v4u u, v; float su, sv; int e; float g; };
__device__ __forceinline__ void p8_gather(Frame& F, float* outp) {
    const bf16* XN = (const bf16*)(F.ws + WS_XN);
    const unsigned char* UQ = F.ws + WS_UQ; const unsigned char* VQ = F.ws + WS_VQ;
    const float* SU = (const float*)(F.ws + WS_SU); const float* SV = (const float*)(F.ws + WS_SV);
    const int* EID = (const int*)(F.ws + WS_EID); const float* GATE = (const float*)(F.ws + WS_GATE);
    const float* nf = F.in[20];
    const int gw = F.wg * NWAVES + F.wave, NGW = F.G * NWAVES;
    LAS unsigned char* wl = F.lds + RING_OFF + F.wave * GA_WAVE_BYTES;
    for (int tg = gw, sweep = 0; tg < T / 4; tg += NGW, ++sweep) {
        int lane_ = F.lane; asm volatile("" : "+v"(lane_));
        const int lane = lane_;
        int xq[4][4]; float sx[4];
#pragma unroll
        for (int tk = 0; tk < 4; ++tk) {
            const GAS v4u* xp = (const GAS v4u*)(XN + (size_t)(4 * tg + tk) * DM + lane * 16);
            const v4u a = xp[0], b = xp[1];
            float x[16]; x[0] = bflo(a.x); x[1] = bfhi(a.x); x[2] = bflo(a.y); x[3] = bfhi(a.y); x[4] = bflo(a.z); x[5] = bfhi(a.z); x[6] = bflo(a.w); x[7] = bfhi(a.w);
            x[8] = bflo(b.x); x[9] = bfhi(b.x); x[10] = bflo(b.y); x[11] = bfhi(b.y); x[12] = bflo(b.z); x[13] = bfhi(b.z); x[14] = bflo(b.w); x[15] = bfhi(b.w);
            float am = 0.f;
#pragma unroll
            for (int i = 0; i < 16; ++i) am = fmaxf(am, fabsf(x[i]));
            am = wave_max(am);
            const float rs_ = frsq(((const float*)(F.ws + WS_SSQ))[4 * tg + tk] * (1.f / DM) + RMS_EPS);
            sx[tk] = (am > 0.f ? am * (1.f / 127.f) : 1.f) * rs_; const float inv = am > 0.f ? 127.f / am : 0.f;
#pragma unroll
            for (int q = 0; q < 4; ++q) {
                const unsigned b0 = (unsigned)(int)rintf(x[4 * q] * inv) & 255u, b1 = (unsigned)(int)rintf(x[4 * q + 1] * inv) & 255u, b2 = (unsigned)(int)rintf(x[4 * q + 2] * inv) & 255u, b3 = (unsigned)(int)rintf(x[4 * q + 3] * inv) & 255u;
                xq[tk][q] = (int)(b0 | (b1 << 8) | (b2 << 16) | (b3 << 24)); }
        }
        LAS unsigned* cnt = (LAS unsigned*)(wl + GA_CNT); LAS unsigned* offs = (LAS unsigned*)(wl + GA_OFF);
        if (lane < 32) cnt[lane] = 0u;
        asm volatile("s_waitcnt lgkmcnt(0)" ::: "memory");
        int ee[8]; float gg[8]; unsigned pos[8];
#pragma unroll
        for (int tk = 0; tk < 4; ++tk) {
            const size_t base = (size_t)(4 * tg + tk) * 128;
            ee[2 * tk] = (EID[base + lane] & (NEXP - 1)) | (tk << 14); ee[2 * tk + 1] = (EID[base + 64 + lane] & (NEXP - 1)) | (tk << 14);
            gg[2 * tk] = GATE[base + lane]; gg[2 * tk + 1] = GATE[base + 64 + lane]; }
#pragma unroll
        for (int q = 0; q < 8; ++q) pos[q] = __hip_atomic_fetch_add(cnt + ((ee[q] >> 9) & 31), 1u, __ATOMIC_RELAXED, __HIP_MEMORY_SCOPE_WAVEFRONT);
        asm volatile("s_waitcnt lgkmcnt(0)" ::: "memory");
        if (lane < 32) {
            const int c0 = (int)cnt[lane]; int v = c0;
            v += __builtin_amdgcn_update_dpp(0, v, 0x111, 0xF, 0xF, true); v += __builtin_amdgcn_update_dpp(0, v, 0x112, 0xF, 0xF, true);
            v += __builtin_amdgcn_update_dpp(0, v, 0x114, 0xF, 0xF, true); v += __builtin_amdgcn_update_dpp(0, v, 0x118, 0xF, 0xF, true);
            const int row0 = __builtin_amdgcn_readlane(v, 15);
            offs[lane] = (unsigned)(v - c0 + (lane >= 16 ? row0 : 0));
        }
        asm volatile("s_waitcnt lgkmcnt(0)" ::: "memory");
#pragma unroll
        for (int q = 0; q < 8; ++q) { const unsigned idx = offs[(ee[q] >> 9) & 31] + pos[q];
            *(LAS unsigned*)(wl + idx * 4) = (unsigned)ee[q]; *(LAS float*)(wl + 2048 + idx * 4) = gg[q]; }
        asm volatile("s_waitcnt lgkmcnt(0)" ::: "memory");
#define GA_DOT(U, TK) (__builtin_amdgcn_sdot4(xq[TK][3], (int)(U).w, __builtin_amdgcn_sdot4(xq[TK][2], (int)(U).z, __builtin_amdgcn_sdot4(xq[TK][1], (int)(U).y, __builtin_amdgcn_sdot4(xq[TK][0], (int)(U).x, 0, false), false), false), false))
        LAS float* act = (LAS float*)(wl + GA_ACT);
        for (int ch = 0; ch < 32; ++ch) {
            const unsigned ent = *(const LAS unsigned*)(wl + (ch * 16 + (lane >> 2)) * 4);
            const float my_g = *(const LAS float*)(wl + 2048 + (ch * 16 + (lane >> 2)) * 4);
            const int my_e = (int)ent & (NEXP - 1), my_tk = ((int)ent >> 14) & 3;
            const float my_su = SU[my_e], my_sv = SV[my_e];
            int d[16];
            {
                v4u ub[2][8]; int eb[2][8];
#pragma unroll
                for (int q = 0; q < 8; ++q) { eb[0][q] = __builtin_amdgcn_readlane((int)ent, 4 * q); ub[0][q] = *(const GAS v4u*)(UQ + (size_t)(eb[0][q] & (NEXP - 1)) * DM + lane * 16); }
#pragma unroll
                for (int jb = 0; jb < 2; ++jb) {
                    if (jb == 0) {
#pragma unroll
                        for (int q = 0; q < 8; ++q) { eb[1][q] = __builtin_amdgcn_readlane((int)ent, 4 * (8 + q)); ub[1][q] = *(const GAS v4u*)(UQ + (size_t)(eb[1][q] & (NEXP - 1)) * DM + lane * 16); } }
                    __builtin_amdgcn_sched_barrier(0);
#pragma unroll
                    for (int q = 0; q < 8; ++q) { const int tk_ = (eb[jb][q] >> 14) & 3; const v4u u_ = ub[jb][q]; int r_;
                        if (tk_ == 0) r_ = GA_DOT(u_, 0); else if (tk_ == 1) r_ = GA_DOT(u_, 1); else if (tk_ == 2) r_ = GA_DOT(u_, 2); else r_ = GA_DOT(u_, 3);
                        d[8 * jb + q] = r_; }
                    __builtin_amdgcn_sched_barrier(0);
                }
            }
#pragma unroll
            for (int j = 0; j < 8; ++j) { const auto r = __builtin_amdgcn_permlane32_swap((unsigned)d[j], (unsigned)d[j + 8], false, false); d[j] = (int)r[0] + (int)r[1]; }
#pragma unroll
            for (int j = 0; j < 4; ++j) { const auto r = __builtin_amdgcn_permlane16_swap((unsigned)d[j], (unsigned)d[j + 4], false, false); d[j] = (int)r[0] + (int)r[1]; }
#pragma unroll
            for (int j = 0; j < 2; ++j) { const int u_ = d[j] + dppi<0x128>(d[j]), w_ = d[j + 2] + dppi<0x128>(d[j + 2]); d[j] = (lane & 8) ? w_ : u_; }
            { const int u_ = d[0] + dppi<0x141>(d[0]), w_ = d[1] + dppi<0x141>(d[1]); d[0] = (lane & 4) ? w_ : u_; }
            d[0] += dppi<0x4E>(d[0]); d[0] += dppi<0xB1>(d[0]);
            const float sxl = my_tk == 0 ? sx[0] : (my_tk == 1 ? sx[1] : (my_tk == 2 ? sx[2] : sx[3]));
            const float h_ = (float)d[0] * (my_su * sxl);
            const float a_ = 0.5f * h_ * (1.f + erff(h_ * 0.70710678118654752f)) * my_g * my_sv;
            if ((lane & 3) == 0) act[ch * 16 + (lane >> 2)] = a_;
        }
#undef GA_DOT
        asm volatile("s_waitcnt lgkmcnt(0)" ::: "memory");
        float y[4][16];
#pragma unroll
        for (int tk = 0; tk < 4; ++tk) {
#pragma unroll
            for (int i = 0; i < 16; ++i) y[tk][i] = 0.f; }
#define GA_AXPY(V, A, TK) do { \
            _Pragma("unroll") for (int q_ = 0; q_ < 4; ++q_) { const int w_ = (int)(V)[q_]; const f32x2 lo_ = __builtin_amdgcn_cvt_pk_f32_fp8(w_, false), hi_ = __builtin_amdgcn_cvt_pk_f32_fp8(w_, true); \
                y[TK][4 * q_] += (A) * lo_.x; y[TK][4 * q_ + 1] += (A) * lo_.y; y[TK][4 * q_ + 2] += (A) * hi_.x; y[TK][4 * q_ + 3] += (A) * hi_.y; } } while (0)
        for (int ch = 0; ch < 8; ++ch) {
            const unsigned ent = *(const LAS unsigned*)(wl + (ch * 64 + lane) * 4);
            const float areg = act[ch * 64 + lane];
            v4u vb[2][8]; int eb[2][8];
#pragma unroll
            for (int q = 0; q < 8; ++q) { eb[0][q] = __builtin_amdgcn_readlane((int)ent, q); vb[0][q] = *(const GAS v4u*)(VQ + (size_t)(eb[0][q] & (NEXP - 1)) * DM + lane * 16); }
#pragma unroll
            for (int jb = 0; jb < 8; ++jb) {
                if (jb + 1 < 8) {
#pragma unroll
                    for (int q = 0; q < 8; ++q) { eb[(jb + 1) & 1][q] = __builtin_amdgcn_readlane((int)ent, 8 * (jb + 1) + q); vb[(jb + 1) & 1][q] = *(const GAS v4u*)(VQ + (size_t)(eb[(jb + 1) & 1][q] & (NEXP - 1)) * DM + lane * 16); } }
                __builtin_amdgcn_sched_barrier(0);
#pragma unroll
                for (int q = 0; q < 8; ++q) { const int tk_ = (eb[jb & 1][q] >> 14) & 3; const v4u v_ = vb[jb & 1][q]; const float a_ = rdlane(areg, 8 * jb + q);
                    if (tk_ == 0) GA_AXPY(v_, a_, 0); else if (tk_ == 1) GA_AXPY(v_, a_, 1); else if (tk_ == 2) GA_AXPY(v_, a_, 2); else GA_AXPY(v_, a_, 3); }
                __builtin_amdgcn_sched_barrier(0);
            }
        }
#undef GA_AXPY
#pragma unroll
        for (int tk = 0; tk < 4; ++tk) {
            float* hrow = F.out + (size_t)(4 * tg + tk) * DM + lane * 16;
            float hv[16]; float ss = 0.f;
#pragma unroll
            for (int q = 0; q < 4; ++q) { const f32x4 h4 = *(const GAS f32x4*)(hrow + 4 * q);
#pragma unroll
                for (int i = 0; i < 4; ++i) { const float v = h4[i] + y[tk][4 * q + i]; hv[4 * q + i] = v; ss += v * v; } }
            const float rstd = frsq(wave_sum(ss) * (1.f / DM) + RMS_EPS);
#pragma unroll
            for (int q = 0; q < 4; ++q) { const f32x4 n4 = *(const GAS f32x4*)(nf + lane * 16 + 4 * q);
                *(GAS f32x4*)(outp + (size_t)(4 * tg + tk) * DM + lane * 16 + 4 * q) = (f32x4){hv[4 * q] * rstd * n4[0], hv[4 * q + 1] * rstd * n4[1], hv[4 * q + 2] * rstd * n4[2], hv[4 * q + 3] * rstd * n4[3]}; }
        }
    }
}

struct Args { const float* in[21]; float* out; unsigned char* ws; int ph_lo, ph_hi; };
static_assert(sizeof(Args) == 21 * 8 + 8 + 8 + 8, "Args has no padding");

__global__ void __launch_bounds__(NTHREADS, 2) fwd_kernel(Args args) {
    extern __shared__ __attribute__((aligned(16))) unsigned char lds[];
    Frame F;
    F.lds = (LAS unsigned char*)lds;
    F.MISC = (volatile LAS unsigned*)(F.lds + MISC_OFF);
    F.tid = threadIdx.x; F.lane = F.tid & 63; F.wave = __builtin_amdgcn_readfirstlane(F.tid >> 6);
    F.G = gridDim.x; F.wg = blockIdx.x;
#pragma unroll
    for (int i = 0; i < 21; ++i) F.in[i] = args.in[i];
    F.out = args.out; F.ws = args.ws;
    F.ctl = (gu32*)(args.ws + WS_CTL);
    for (int u = F.tid; u < (LDS_BYTES - LDSCTL_OFF) / 4; u += NTHREADS) ((LAS unsigned*)(F.lds + LDSCTL_OFF))[u] = 0u;
    __syncthreads();
    const int lo = args.ph_lo, hi = args.ph_hi;
    const bool fused = (hi - lo) > 1;
    XcdBarrier bar; bar.bar = (unsigned*)(F.ctl + CW_BAR); bar.x = 0; bar.st = nullptr;
    if (fused) bar = xcd_barrier_post((unsigned*)(F.ctl + CW_BAR), F.MISC + 8);
#define IN(k) (lo <= (k) && (k) < hi)
#define REPS(k) (((REP_MASK >> (k)) & 1) ? 2 : 1)
#define REPLOOP(k) for (int rep_ = 0; rep_ < REPS(k); ++rep_, (rep_ < REPS(k) ? xcd_barrier(bar) : (void)0))
#define SEAM(k) do { if (IN(k) && IN((k) + 1)) xcd_barrier(bar); } while (0)

    if (IN(0)) { REPLOOP(0) { p0_prologue(F); p0_rope_table(F); } SEAM(0); }
    if (IN(1)) { REPLOOP(1) {
        pg8::Gemm g{(const bf16*)(F.ws + WS_XN), (const bf16*)(F.ws + WS_WIN), T, IN_COLS, DM}; pg8::StaticOrder S; S.init(T, IN_COLS, F.G, F.wg);
        pg8::EpiBf16 E{(bf16*)(F.ws + WS_Z), IN_COLS};
        pg8::gemm_phase<pg8::EpiBf16, pg8::StaticOrder, true, true>(F.lds + RING_OFF, g, S, E); }
        SEAM(1);
    }
    if (IN(2)) { p2_rope(F); REPLOOP(2) { const int cnt = r13_count(F.wg, F.G); R1Pre P;
            if (cnt > 0) rwkv_r1_prefetch(F, r13_item(F.wg, F.G, 0), F.tid, P);
            for (int i = 0; i < cnt; ++i) rwkv_r1_item(F, r13_item(F.wg, F.G, i), i + 1 < cnt ? r13_item(F.wg, F.G, i + 1) : -1, P); }
        SEAM(2); }
    if (IN(3)) { REPLOOP(3) p3_mixers(F); SEAM(3); }
    if (IN(4)) { REPLOOP(4) { const int cnt = r13_count(F.wg, F.G); R3Pre P;
            if (cnt > 0) rwkv_r3_prefetch(F, r13_item(F.wg, F.G, 0), F.tid, P);
            for (int i = 0; i < cnt; ++i) rwkv_r3_item(F, r13_item(F.wg, F.G, i), i + 1 < cnt ? r13_item(F.wg, F.G, i + 1) : -1, P); }
        SEAM(4); }
    if (IN(5)) {
        pg8::Gemm g{(const bf16*)(F.ws + WS_YMIX), (const bf16*)(F.ws + WS_WOUT), T, DM, DM}; pg8::StaticOrder S; S.init(T, DM, F.G, F.wg);
        pg8::EpiF32Res E{F.in[0], F.out, DM, (bf16*)(F.ws + WS_XN), F.in[15], (float*)(F.ws + WS_SSQ)};
        pg8::gemm_phase<pg8::EpiF32Res, pg8::StaticOrder, true, true>(F.lds + RING_OFF, g, S, E);
        SEAM(5);
    }
    if (IN(6)) { REPLOOP(6) {
        pg8::Gemm g{(const bf16*)(F.ws + WS_XN), (const bf16*)(F.ws + WS_WQ), T, PQ, DM}; pg8::StaticOrder S; S.init(T, PQ, F.G, F.wg);
        pg8::EpiBf16Rs E{(bf16*)(F.ws + WS_QP), PQ, (const float*)(F.ws + WS_SSQ)};
        pg8::gemm_phase<pg8::EpiBf16Rs, pg8::StaticOrder, true, true>(F.lds + RING_OFF, g, S, E); }
        SEAM(6);
    }
    if (IN(7)) { REPLOOP(7) p7_topk(F); SEAM(7); }
    if (IN(8)) { if (REPS(8) > 1) { p8_gather(F, (float*)(F.ws + WS_Z)); xcd_barrier(bar); } p8_gather(F, F.out); }
#undef IN
#undef SEAM
}

extern "C" void kernel_launch(void* const* d_in, const int* in_sizes, int n_in, void* d_out, int out_size, void* d_ws, size_t ws_size, hipStream_t stream) {
    static int grid = 0;
    if (grid == 0) {
        if (n_in != 21 || in_sizes[0] != T * DM || out_size != T * DM || ws_size < WS_END) {
            fprintf(stderr, "kernel_launch: unexpected shapes: n_in %d in0 %d out %d ws %zu (need %zu); nothing launched\n", n_in, n_in > 0 ? in_sizes[0] : -1, out_size, ws_size, (size_t)WS_END); grid = -1; return; }
        int dev = 0, cus = 0, per_cu = 0;
        if (hipGetDevice(&dev) != hipSuccess || hipDeviceGetAttribute(&cus, hipDeviceAttributeMultiprocessorCount, dev) != hipSuccess) { grid = -1; return; }
        if (hipFuncSetAttribute((const void*)fwd_kernel, hipFuncAttributeMaxDynamicSharedMemorySize, LDS_BYTES) != hipSuccess) { fprintf(stderr, "kernel_launch: hipFuncSetAttribute failed\n"); grid = -1; return; }
        if (hipOccupancyMaxActiveBlocksPerMultiprocessor(&per_cu, (const void*)fwd_kernel, NTHREADS, LDS_BYTES) != hipSuccess || per_cu < 1) { fprintf(stderr, "kernel_launch: occupancy query says %d\n", per_cu); per_cu = 1; }
        (void)hipGetLastError();
        grid = cus;
    }
    if (grid < 0) return;
    (void)hipMemsetAsync((char*)d_ws + WS_CTL, 0, CTL_ZERO_BYTES, stream);
    Args a{};
    for (int i = 0; i < 21; ++i) a.in[i] = (const float*)d_in[i];
    a.out = (float*)d_out; a.ws = (unsigned char*)d_ws;
    if (MK_N_LAUNCHES == 1) {
        a.ph_lo = 0; a.ph_hi = NPHASE;
        void* kargs[] = {&a};
        hipError_t e = hipLaunchCooperativeKernel((const void*)fwd_kernel, dim3(grid), dim3(NTHREADS), kargs, LDS_BYTES, stream);
        if (e != hipSuccess) fprintf(stderr, "kernel_launch: cooperative launch failed: %s (grid %d)\n", hipGetErrorString(e), grid);
    } else {
        for (int p = 0; p < NPHASE; ++p) { a.ph_lo = p; a.ph_hi = p + 1;
            hipLaunchKernelGGL(fwd_kernel, dim3(grid), dim3(NTHREADS), LDS_BYTES, stream, a); }
    }
}
```

```cpp
#include <hip/hip_runtime.h>
#include <cstdio>
#include <cstdint>

#ifndef MK_N_LAUNCHES
#define MK_N_LAUNCHES 1
#endif

#ifndef REP_MASK
#define REP_MASK 0
#endif
#define GAS __attribute__((address_space(1)))
#define LAS __attribute__((address_space(3)))
typedef unsigned short bf16;
typedef unsigned v4u __attribute__((ext_vector_type(4)));
typedef unsigned v2u __attribute__((ext_vector_type(2)));
typedef float f32x4 __attribute__((ext_vector_type(4)));
typedef float f32x2 __attribute__((ext_vector_type(2)));
typedef short bf16x8 __attribute__((ext_vector_type(8)));
typedef GAS unsigned gu32;
#define RLX_AGENT __ATOMIC_RELAXED, __HIP_MEMORY_SCOPE_AGENT
#define LDS_WAIT() asm volatile("s_waitcnt lgkmcnt(0)" ::: "memory")
#define VM_WAIT() asm volatile("s_waitcnt vmcnt(0)" ::: "memory")
#define LDS_BARRIER() do { asm volatile("s_waitcnt lgkmcnt(0)" ::: "memory"); __builtin_amdgcn_s_barrier(); asm volatile("" ::: "memory"); } while (0)

constexpr int DM = 1024, NB = 4, SEQ = 8192, T = NB * SEQ;
constexpr int HD = 64, RWW = 512, NHR = 8, NHA = 8;
constexpr int IN_COLS = 3328;
constexpr int C_R = 0, C_K = 512, C_V = 1024, C_WD = 1536, C_AD = 1600, C_GD = 1664, C_AQ = 1792, C_AK = 2304, C_AV = 2816;
constexpr int PHEADS = 8, NKEYS = 128, PQ = 2048, TOPK = 16, NEXP = 16384;
constexpr float RMS_EPS = 1e-6f, GN_EPS = 64e-5f;
constexpr int NWAVES = 8, NTHREADS = 512;
constexpr int NPHASE = 9;

constexpr size_t MiB = 1u << 20;
constexpr size_t WS_CTL = 0, CTL_ZERO_BYTES = 1 * MiB;
constexpr size_t WS_WIN = 2 * MiB;
constexpr size_t WS_WOUT = 10 * MiB;
constexpr size_t WS_WQ = 12 * MiB;
constexpr size_t WS_XN = 16 * MiB;
constexpr size_t WS_Z = 80 * MiB;
constexpr size_t WS_QP = 80 * MiB;
constexpr size_t WS_G = 288 * MiB;
constexpr size_t WS_YMIX = 352 * MiB;
constexpr size_t WS_UQ = 416 * MiB;
constexpr size_t WS_VQ = 432 * MiB;
constexpr size_t WS_SU = 448 * MiB;
constexpr size_t WS_SV = 449 * MiB;
constexpr size_t WS_EID = 480 * MiB;
constexpr size_t WS_GATE = 496 * MiB;
constexpr size_t WS_END = 512 * MiB;
constexpr size_t WS_WUPT = 1 * MiB, WS_AUPT = WS_WUPT + 65536, WS_GUPT = WS_AUPT + 65536;
constexpr size_t WS_BONUS = 9 * MiB;
constexpr size_t WS_RWY0 = WS_XN;
constexpr size_t WS_RWSS = WS_G;
constexpr size_t WS_RWRH = WS_EID;

constexpr int CW_BAR = 4096;
constexpr size_t WS_SSQ = 256 * 1024;

typedef __bf16 hbf16x2_t __attribute__((ext_vector_type(2)));
__device__ __forceinline__ unsigned pk2(float lo, float hi) { const f32x2 v = {lo, hi}; const hbf16x2_t b = __builtin_convertvector(v, hbf16x2_t); return __builtin_bit_cast(unsigned, b); }
__device__ __forceinline__ unsigned f2bf(float f) { return pk2(f, 0.f) & 0xffffu; }
__device__ __forceinline__ float frcp(float x) { return __builtin_amdgcn_rcpf(x); }
__device__ __forceinline__ float frsq(float x) { return __builtin_amdgcn_rsqf(x); }
__device__ __forceinline__ float bflo(unsigned u) { return __builtin_bit_cast(float, u << 16); }
__device__ __forceinline__ float bfhi(unsigned u) { return __builtin_bit_cast(float, u & 0xffff0000u); }
__device__ __forceinline__ float bf2f(bf16 h) { return __builtin_bit_cast(float, (unsigned)h << 16); }

template <int CTRL> __device__ __forceinline__ float dppf(float x) { return __builtin_bit_cast(float, __builtin_amdgcn_update_dpp(0, __builtin_bit_cast(int, x), CTRL, 0xF, 0xF, true)); }
template <int CTRL> __device__ __forceinline__ int dppi(int x) { return __builtin_amdgcn_update_dpp(0, x, CTRL, 0xF, 0xF, true); }
__device__ __forceinline__ float rdlane(float v, int l) { return __builtin_bit_cast(float, __builtin_amdgcn_readlane(__builtin_bit_cast(int, v), l)); }
__device__ __forceinline__ float sum8(float v) { v += dppf<0xB1>(v); v += dppf<0x4E>(v); v += dppf<0x141>(v); return v; }
__device__ __forceinline__ float sum16(float v) { v = sum8(v); v += dppf<0x140>(v); return v; }
__device__ __forceinline__ float wave_sum(float v) { v = sum16(v);
    v += __builtin_bit_cast(float, __builtin_amdgcn_update_dpp(0, __builtin_bit_cast(int, v), 0x142, 0xA, 0xF, false));
    v += __builtin_bit_cast(float, __builtin_amdgcn_update_dpp(0, __builtin_bit_cast(int, v), 0x143, 0xC, 0xF, false));
    return rdlane(v, 63); }
__device__ __forceinline__ float wave_max(float v) {
    v = fmaxf(v, dppf<0xB1>(v)); v = fmaxf(v, dppf<0x4E>(v)); v = fmaxf(v, dppf<0x141>(v)); v = fmaxf(v, dppf<0x140>(v));
    return fmaxf(fmaxf(rdlane(v, 0), rdlane(v, 16)), fmaxf(rdlane(v, 32), rdlane(v, 48)));
}
__device__ __forceinline__ int wave_min_i(int v) {
    v = min(v, dppi<0xB1>(v)); v = min(v, dppi<0x4E>(v)); v = min(v, dppi<0x141>(v)); v = min(v, dppi<0x140>(v));
    return min(min(__builtin_amdgcn_readlane(v, 0), __builtin_amdgcn_readlane(v, 16)), min(__builtin_amdgcn_readlane(v, 32), __builtin_amdgcn_readlane(v, 48)));
}

namespace pg8 {
#define PG8_LAS __attribute__((address_space(3)))
typedef unsigned short bf16_t;
typedef unsigned u32x4 __attribute__((ext_vector_type(4)));
constexpr int BM = 256, BK = 64, HALF = 128, HTB = HALF * BK * 2, STAGE_BYTES = 8 * HTB, NXCD = 8, WGM = 8;
__host__ __device__ __forceinline__ int lds_byte(int r, int c) { const int st = (r >> 4) * 2 + (c >> 5), rr = r & 15, cc = c & 31, ob = rr * 64 + cc * 2; return st * 1024 + (ob ^ (((ob >> 9) & 1) << 5)); }
__host__ __device__ __forceinline__ void stage_rc(int b, int& R, int& C) { const int st = b / 1024, sb = b % 1024, swz = sb ^ (((sb >> 9) & 1) << 5); R = (st >> 1) * 16 + swz / 64; C = (st & 1) * 32 + (swz % 64) / 2; }
__host__ __device__ __forceinline__ int perm32(int rho) { const int n = rho >> 4, i = rho & 15; return 8 * (i >> 2) + 4 * n + (i & 3); }
struct Unit { int pm, pn; };
struct Gemm { const bf16_t* A; const bf16_t* Bt; int M, N, K; };
struct StaticOrder {
    int nM, nN, nwg, G, c;
    __host__ __device__ void init(int M, int N, int G_, int c_) { nM = M / BM; nN = N / BM; nwg = nM * nN; G = G_; c = c_; }
    __host__ __device__ bool next(int i, Unit& u) const {
        const long L = (long)i * G + c; if (L >= nwg) return false;
        int wgid = (int)L; { const int q = nwg / NXCD, r = nwg % NXCD, xcd = wgid % NXCD, off = wgid / NXCD; wgid = (xcd < r ? xcd * (q + 1) : r * (q + 1) + (xcd - r) * q) + off; }
        const int nig = WGM * nN, gid = wgid / nig, fm = gid * WGM, gsz = (nM - fm) < WGM ? (nM - fm) : WGM;
        u.pm = fm + ((wgid % nig) % gsz); u.pn = (wgid % nig) / gsz; return true;
    }
    __device__ __forceinline__ void a_ready(const Unit&) const {}
    __device__ __forceinline__ void done(const Unit&) const {}
};
__device__ __forceinline__ unsigned cvt_pk_bf16(float lo, float hi) { unsigned r; asm volatile("v_cvt_pk_bf16_f32 %0, %1, %2" : "=v"(r) : "v"(lo), "v"(hi)); return r; }
struct EpiBf16 {
    static constexpr bool PERM = true, AFTER_DRAIN = false;
    bf16_t* O; int ldc;
    __device__ __forceinline__ void operator()(const f32x4 (&acc)[2][2][4][2], const Unit& u, int wr, int wc, int fr, int fq) const {
        const int row0 = u.pm * BM + wr * 64 + fr; const int col0 = u.pn * BM + wc * 32 + 8 * fq;
#pragma unroll
        for (int ai = 0; ai < 2; ++ai)
#pragma unroll
            for (int m = 0; m < 4; ++m) { bf16_t* rowp = O + (size_t)(row0 + ai * HALF + m * 16) * ldc + col0;
#pragma unroll
                for (int bj = 0; bj < 2; ++bj) { const f32x4 v0 = acc[ai][bj][m][0], v1 = acc[ai][bj][m][1];
                    u32x4 w; w.x = cvt_pk_bf16(v0[0], v0[1]); w.y = cvt_pk_bf16(v0[2], v0[3]); w.z = cvt_pk_bf16(v1[0], v1[1]); w.w = cvt_pk_bf16(v1[2], v1[3]);
                    *(u32x4*)(rowp + bj * HALF) = w; } }
    }
};
struct EpiF32Res {
    static constexpr bool PERM = true, AFTER_DRAIN = false;
    const float* res; float* O; int ldc; bf16_t* HG; const float* gain; float* ssq;
    __device__ __forceinline__ void operator()(const f32x4 (&acc)[2][2][4][2], const Unit& u, int wr, int wc, int fr, int fq) const {
        const int row0 = u.pm * BM + wr * 64 + fr; const int col0 = u.pn * BM + wc * 32 + 8 * fq;
        f32x4 gv[2][2];
#pragma unroll
        for (int bj = 0; bj < 2; ++bj) { gv[bj][0] = *(const f32x4*)(gain + col0 + bj * HALF); gv[bj][1] = *(const f32x4*)(gain + col0 + bj * HALF + 4); }
#pragma unroll
        for (int ai = 0; ai < 2; ++ai)
#pragma unroll
            for (int m = 0; m < 4; ++m) { const int row = row0 + ai * HALF + m * 16; const size_t off = (size_t)row * ldc + col0; float sq = 0.f;
#pragma unroll
                for (int bj = 0; bj < 2; ++bj) { const f32x4 r0 = *(const f32x4*)(res + off + bj * HALF), r1 = *(const f32x4*)(res + off + bj * HALF + 4);
                    const f32x4 h0 = acc[ai][bj][m][0] + r0, h1 = acc[ai][bj][m][1] + r1;
                    *(f32x4*)(O + off + bj * HALF) = h0; *(f32x4*)(O + off + bj * HALF + 4) = h1;
                    sq += (h0[0] * h0[0] + h0[1] * h0[1]) + (h0[2] * h0[2] + h0[3] * h0[3]) + (h1[0] * h1[0] + h1[1] * h1[1]) + (h1[2] * h1[2] + h1[3] * h1[3]);
                    const f32x4 g0 = gv[bj][0], g1 = gv[bj][1];
                    u32x4 w; w.x = cvt_pk_bf16(h0[0] * g0[0], h0[1] * g0[1]); w.y = cvt_pk_bf16(h0[2] * g0[2], h0[3] * g0[3]); w.z = cvt_pk_bf16(h1[0] * g1[0], h1[1] * g1[1]); w.w = cvt_pk_bf16(h1[2] * g1[2], h1[3] * g1[3]);
                    *(u32x4*)(HG + off + bj * HALF) = w; }
                sq += __shfl_xor(sq, 16); sq += __shfl_xor(sq, 32);
                if (fq == 0) atomicAdd(ssq + row, sq); }
    }
};
struct EpiBf16Rs {
    static constexpr bool PERM = true, AFTER_DRAIN = false;
    bf16_t* O; int ldc; const float* ssq;
    __device__ __forceinline__ void operator()(const f32x4 (&acc)[2][2][4][2], const Unit& u, int wr, int wc, int fr, int fq) const {
        const int row0 = u.pm * BM + wr * 64 + fr; const int col0 = u.pn * BM + wc * 32 + 8 * fq;
#pragma unroll
        for (int ai = 0; ai < 2; ++ai)
#pragma unroll
            for (int m = 0; m < 4; ++m) { const int row = row0 + ai * HALF + m * 16; bf16_t* rowp = O + (size_t)row * ldc + col0;
                const float rs = __builtin_amdgcn_rsqf(ssq[row] * (1.f / 1024.f) + 1e-6f);
#pragma unroll
                for (int bj = 0; bj < 2; ++bj) { const f32x4 v0 = acc[ai][bj][m][0] * rs, v1 = acc[ai][bj][m][1] * rs;
                    u32x4 w; w.x = cvt_pk_bf16(v0[0], v0[1]); w.y = cvt_pk_bf16(v0[2], v0[3]); w.z = cvt_pk_bf16(v1[0], v1[1]); w.w = cvt_pk_bf16(v1[2], v1[3]);
                    *(u32x4*)(rowp + bj * HALF) = w; } }
    }
};

template <class Epi, class Sched, bool ALIGN_EPI = false, bool SP2 = false>
__device__ __forceinline__ void gemm_phase(PG8_LAS unsigned char* lds, const Gemm g, const Sched& S, const Epi& E) {
    const int tid = threadIdx.x, wid = __builtin_amdgcn_readfirstlane(tid >> 6), lane = tid & 63, wr = wid >> 2, wc = wid & 3, fr = lane & 15, fq = lane >> 4;
    const int K = g.K, nt = K / BK;
    unsigned voffA[2], voffB[2];
#pragma unroll
    for (int i = 0; i < 2; ++i) { int R, C; stage_rc(tid * 16 + i * 8192, R, C); const int Rb = Epi::PERM ? ((R & ~31) + perm32(R & 31)) : R;
        voffA[i] = (unsigned)(R * K + C) * 2u; voffB[i] = (unsigned)(Rb * K + C) * 2u; }
    const size_t kstep = (size_t)(BK * 2);
    const size_t hstep = (size_t)HALF * K * 2;
    const size_t tstep = 2 * hstep;
    const unsigned ldsw = (unsigned)wid * 1024u;
    const int aoff = lds_byte(wr * 64 + fr, fq * 8), boff = lds_byte(wc * 32 + fr, fq * 8);
#define PG8_SA(b, h) (((b) * 2 + (h)) * HTB)
#define PG8_SB(b, h) ((4 + (b) * 2 + (h)) * HTB)
#define PG8_STAGE(bufoff, gbase, voff) do { _Pragma("unroll") for (int _i = 0; _i < 2; ++_i) \
        __builtin_amdgcn_global_load_lds((const unsigned*)((const char*)(gbase) + (voff)[_i]), (PG8_LAS unsigned*)(lds + (bufoff) + ldsw + _i * 8192), 16, 0, 0); } while (0)
#define PG8_LDA(dst, b, h) do { _Pragma("unroll") for (int m = 0; m < 4; ++m) _Pragma("unroll") for (int k = 0; k < 2; ++k) dst[m][k] = *(const PG8_LAS bf16x8*)(lds + PG8_SA(b, h) + aoff + m * 2048 + k * 1024); } while (0)
#define PG8_LDB(dst, b, h) do { _Pragma("unroll") for (int n = 0; n < 2; ++n) _Pragma("unroll") for (int k = 0; k < 2; ++k) dst[n][k] = *(const PG8_LAS bf16x8*)(lds + PG8_SB(b, h) + boff + n * 2048 + k * 1024); } while (0)
#define PG8_MMA(ai, bj, At, Bt) do { __builtin_amdgcn_s_setprio(1); _Pragma("unroll") for (int m = 0; m < 4; ++m) _Pragma("unroll") for (int n = 0; n < 2; ++n) _Pragma("unroll") for (int k = 0; k < 2; ++k) \
        acc[ai][bj][m][n] = __builtin_amdgcn_mfma_f32_16x16x32_bf16(Bt[n][k], At[m][k], acc[ai][bj][m][n], 0, 0, 0); __builtin_amdgcn_s_setprio(0); } while (0)
#define PG8_WAIT_V(n) asm volatile("s_waitcnt vmcnt(" #n ")" ::: "memory")
#define PG8_WAIT_L(n) asm volatile("s_waitcnt lgkmcnt(" #n ")" ::: "memory")
#define PG8_BAR __builtin_amdgcn_s_barrier()
#define PG8_SCHED __builtin_amdgcn_sched_barrier(0)
    Unit cur, nxt; int ui = 0;
    if (!S.next(0, cur)) return;
    f32x4 acc[2][2][4][2];
#pragma unroll
    for (int a = 0; a < 2; ++a)
#pragma unroll
        for (int b = 0; b < 2; ++b)
#pragma unroll
            for (int m = 0; m < 4; ++m)
#pragma unroll
                for (int n = 0; n < 2; ++n) acc[a][b][m][n] = (f32x4){0.f, 0.f, 0.f, 0.f};
    bf16x8 At[4][2], B0[2][2], B1[2][2];
    const char* cA = (const char*)g.A + (size_t)cur.pm * tstep; const char* cB = (const char*)g.Bt + (size_t)cur.pn * tstep;
    S.a_ready(cur);
    if constexpr (SP2) {
        PG8_STAGE(PG8_SB(0, 0), cB, voffB); PG8_STAGE(PG8_SB(0, 1), cB + hstep, voffB); PG8_STAGE(PG8_SA(0, 0), cA, voffA); PG8_STAGE(PG8_SA(0, 1), cA + hstep, voffA);
        if (wr == 1) PG8_BAR;
        PG8_WAIT_V(2); PG8_BAR;
        PG8_STAGE(PG8_SB(1, 0), cB + kstep, voffB); PG8_STAGE(PG8_SA(1, 0), cA + kstep, voffA); PG8_STAGE(PG8_SB(1, 1), cB + hstep + kstep, voffB);
        PG8_WAIT_V(6); PG8_BAR;
    } else {
        PG8_STAGE(PG8_SB(0, 0), cB, voffB); PG8_STAGE(PG8_SA(0, 0), cA, voffA); PG8_STAGE(PG8_SB(0, 1), cB + hstep, voffB); PG8_STAGE(PG8_SA(0, 1), cA + hstep, voffA);
        if (wr == 1) PG8_BAR;
        PG8_WAIT_V(4); PG8_BAR;
        PG8_STAGE(PG8_SB(1, 0), cB + kstep, voffB); PG8_STAGE(PG8_SA(1, 0), cA + kstep, voffA); PG8_STAGE(PG8_SB(1, 1), cB + hstep + kstep, voffB);
        PG8_WAIT_V(6); PG8_BAR;
    }
    for (;;) {
        const bool has_next = S.next(ui + 1, nxt);
        const char* nA = has_next ? (const char*)g.A + (size_t)nxt.pm * tstep : cA; const char* nB = has_next ? (const char*)g.Bt + (size_t)nxt.pn * tstep : cB;
        for (int t = 0; t < nt; t += 2) {
            const bool last = (t == nt - 2);
            const char* a1 = cA + (size_t)(t + 1) * kstep;
            const char* a2 = last ? nA : cA + (size_t)(t + 2) * kstep; const char* b2 = last ? nB : cB + (size_t)(t + 2) * kstep;
            const char* a3 = a2 + kstep; const char* b3 = b2 + kstep;
            if (last && has_next) S.a_ready(nxt);
            if constexpr (SP2) {
            PG8_LDB(B0, 0, 0); PG8_LDB(B1, 0, 1); PG8_SCHED; PG8_LDA(At, 0, 0); PG8_STAGE(PG8_SA(1, 1), a1 + hstep, voffA);
            PG8_WAIT_V(8); PG8_WAIT_L(0); PG8_BAR; PG8_MMA(0, 0, At, B0); PG8_MMA(0, 1, At, B1); PG8_BAR; PG8_SCHED;
            PG8_LDA(At, 0, 1); PG8_STAGE(PG8_SB(0, 0), b2, voffB); PG8_STAGE(PG8_SB(0, 1), b2 + hstep, voffB); PG8_STAGE(PG8_SA(0, 0), a2, voffA);
            PG8_WAIT_V(8); PG8_WAIT_L(0); PG8_BAR; PG8_MMA(1, 0, At, B0); PG8_MMA(1, 1, At, B1); PG8_BAR; PG8_SCHED;
            PG8_LDB(B0, 1, 0); PG8_LDB(B1, 1, 1); PG8_SCHED; PG8_LDA(At, 1, 0); PG8_STAGE(PG8_SA(0, 1), a2 + hstep, voffA);
            PG8_WAIT_V(8); PG8_WAIT_L(0); PG8_BAR; PG8_MMA(0, 0, At, B0); PG8_MMA(0, 1, At, B1); PG8_BAR; PG8_SCHED;
            PG8_LDA(At, 1, 1); PG8_STAGE(PG8_SB(1, 0), b3, voffB); PG8_STAGE(PG8_SB(1, 1), b3 + hstep, voffB); PG8_STAGE(PG8_SA(1, 0), a3, voffA);
            PG8_WAIT_V(8); PG8_WAIT_L(0); PG8_BAR; PG8_MMA(1, 0, At, B0); PG8_MMA(1, 1, At, B1); PG8_BAR; PG8_SCHED;
            } else {
            PG8_LDB(B0, 0, 0); PG8_SCHED; PG8_LDA(At, 0, 0); PG8_STAGE(PG8_SA(1, 1), a1 + hstep, voffA);
            PG8_WAIT_L(8); PG8_BAR; PG8_WAIT_L(0); PG8_MMA(0, 0, At, B0); PG8_BAR; PG8_SCHED;
            PG8_LDB(B1, 0, 1); PG8_STAGE(PG8_SB(0, 0), b2, voffB);
            PG8_BAR; PG8_WAIT_L(0); PG8_MMA(0, 1, At, B1); PG8_BAR;
            PG8_LDA(At, 0, 1); PG8_STAGE(PG8_SA(0, 0), a2, voffA);
            PG8_BAR; PG8_WAIT_L(0); PG8_MMA(1, 0, At, B0); PG8_BAR; PG8_SCHED;
            PG8_STAGE(PG8_SB(0, 1), b2 + hstep, voffB);
            PG8_WAIT_V(6); PG8_BAR; PG8_MMA(1, 1, At, B1); PG8_BAR;
            PG8_LDB(B0, 1, 0); PG8_SCHED; PG8_LDA(At, 1, 0); PG8_STAGE(PG8_SA(0, 1), a2 + hstep, voffA);
            PG8_WAIT_L(8); PG8_BAR; PG8_WAIT_L(0); PG8_MMA(0, 0, At, B0); PG8_BAR; PG8_SCHED;
            PG8_LDB(B1, 1, 1); PG8_STAGE(PG8_SB(1, 0), b3, voffB);
            PG8_BAR; PG8_WAIT_L(0); PG8_MMA(0, 1, At, B1); PG8_BAR;
            PG8_LDA(At, 1, 1); PG8_STAGE(PG8_SA(1, 0), a3, voffA);
            PG8_BAR; PG8_WAIT_L(0); PG8_MMA(1, 0, At, B0); PG8_BAR; PG8_SCHED;
            PG8_STAGE(PG8_SB(1, 1), b3 + hstep, voffB);
            PG8_WAIT_V(6); PG8_BAR; PG8_MMA(1, 1, At, B1); PG8_BAR;
            }
        }
        if constexpr (ALIGN_EPI) { if (wr == 0) PG8_BAR; }
        if constexpr (!Epi::AFTER_DRAIN) { E(acc, cur, wr, wc, fr, fq); S.done(cur); }
        if (!has_next) break;
#pragma unroll
        for (int a = 0; a < 2; ++a)
#pragma unroll
            for (int b = 0; b < 2; ++b)
#pragma unroll
                for (int m = 0; m < 4; ++m)
#pragma unroll
                    for (int n = 0; n < 2; ++n) acc[a][b][m][n] = (f32x4){0.f, 0.f, 0.f, 0.f};
        cur = nxt; cA = nA; cB = nB; ++ui;
        if constexpr (ALIGN_EPI) { if (wr == 1) PG8_BAR; }
    }
    PG8_WAIT_V(0);
    if constexpr (!ALIGN_EPI) { if (wr == 0) PG8_BAR; }
    PG8_BAR;
#undef PG8_SA
#undef PG8_SB
#undef PG8_STAGE
#undef PG8_LDA
#undef PG8_LDB
#undef PG8_MMA
#undef PG8_WAIT_V
#undef PG8_WAIT_L
#undef PG8_BAR
#undef PG8_SCHED
}
}

#define XB_TMO      128
#define XB_XCNT(j)  (256  + 64 * (j))
#define XB_XSUB(j)  (1280 + 64 * (j))
#define XB_XGEN(j)  (2304 + 64 * (j))
#define XB_TOP      3328
#define XB_TOPGEN   3392
#define XCD_BAR_WORDS 3456
#define XB_SPIN_CAP (1u << 22)
__device__ __forceinline__ unsigned xb_ld(unsigned* p)              { return __hip_atomic_load(p, __ATOMIC_RELAXED, __HIP_MEMORY_SCOPE_AGENT); }
__device__ __forceinline__ unsigned xb_add(unsigned* p, unsigned v) { return __hip_atomic_fetch_add(p, v, __ATOMIC_RELAXED, __HIP_MEMORY_SCOPE_AGENT); }
__device__ __forceinline__ unsigned xb_xcc_id() { return (unsigned)__builtin_amdgcn_s_getreg((3 << 11) | 20) & 0xFu; }
#define XB_SPIN(cond, bar) do { unsigned _sp = 0; while (cond) { __builtin_amdgcn_s_sleep(1); \
    if ((++_sp & 255u) == 0u) { if (xb_ld(&(bar)[XB_TMO])) break; if (_sp > XB_SPIN_CAP) { atomicAdd(&(bar)[XB_TMO], 1u); break; } } } } while (0)
struct XcdBarrier { unsigned* bar; unsigned x; volatile LAS unsigned* st; };
__device__ __forceinline__ XcdBarrier xcd_barrier_post(unsigned* bar, volatile LAS unsigned* st) {
    XcdBarrier b; b.bar = bar; b.x = xb_xcc_id(); b.st = st;
    if (threadIdx.x == 0) (void)xb_add(&bar[XB_XCNT(b.x)], 1u);
    return b;
}
__device__ __forceinline__ void xcd_barrier_complete(unsigned* bar, unsigned x, unsigned& nloc, unsigned& nx) {
    const unsigned G = gridDim.x * gridDim.y * gridDim.z;
    unsigned sum, cnt, mine, sp = 0u;
    for (;;) {
        sum = 0u; cnt = 0u; mine = 0u;
#pragma unroll
        for (unsigned j = 0; j < 16; ++j) { const unsigned c = xb_ld(&bar[XB_XCNT(j)]); sum += c; cnt += (c > 0u) ? 1u : 0u; mine = (j == x) ? c : mine; }
        if (sum == G) break;
        __builtin_amdgcn_s_sleep(1);
        if ((++sp & 255u) == 0u) { if (xb_ld(&bar[XB_TMO])) break; if (sp > XB_SPIN_CAP) { atomicAdd(&bar[XB_TMO], 1u); break; } }
    }
    nloc = mine > 0u ? mine : 1u; nx = cnt > 0u ? cnt : 1u;
}
__device__ __forceinline__ void xcd_barrier(const XcdBarrier& b) {
    asm volatile("s_waitcnt vmcnt(0)" ::: "memory");
    __syncthreads();
    if (threadIdx.x == 0) {
        unsigned* bar = b.bar;
        __builtin_amdgcn_s_waitcnt(0);
        unsigned nloc = b.st[0], nx = b.st[1];
        if (nloc == 0u) { xcd_barrier_complete(bar, b.x, nloc, nx); b.st[0] = nloc; b.st[1] = nx; }
        const unsigned old = xb_add(&bar[XB_XSUB(b.x)], 1u);
        const unsigned gen = old / nloc;
        if (old + 1u == (gen + 1u) * nloc) {
            __builtin_amdgcn_fence(__ATOMIC_RELEASE, "agent");
            asm volatile("s_waitcnt vmcnt(0)" ::: "memory");
            const unsigned og = xb_add(&bar[XB_TOP], 1u);
            const unsigned tg = og / nx;
            if (og + 1u == (tg + 1u) * nx) xb_add(&bar[XB_TOPGEN], 1u);
            else XB_SPIN(xb_ld(&bar[XB_TOPGEN]) == tg, bar);
            __builtin_amdgcn_fence(__ATOMIC_ACQUIRE, "agent");
            xb_add(&bar[XB_XGEN(b.x)], 1u);
            asm volatile("s_waitcnt vmcnt(0)" ::: "memory");
        } else {
            XB_SPIN(xb_ld(&bar[XB_XGEN(b.x)]) == gen, bar);
            __builtin_amdgcn_fence(__ATOMIC_ACQUIRE, "agent");
            asm volatile("s_waitcnt vmcnt(0)" ::: "memory");
        }
    }
    __syncthreads();
}

constexpr int RING_OFF = 0, RING_BYTES = 131072;
constexpr int LDSCTL_OFF = 162816, MISC_OFF = LDSCTL_OFF + 320;
constexpr int LDS_BYTES = 163840;

struct Frame {
    LAS unsigned char* lds;
    volatile LAS unsigned* MISC;
    gu32* ctl;
    int tid, lane, wave, G, wg;
    const float* in[21];
    float* out;
    unsigned char* ws;
};

__device__ __forceinline__ void p0_transpose_item(const float* W, int K, int N, bf16* WT, LAS float* scr, int item, int lane) {
    const int nblk = N / 32, kb = item / nblk, nb = item % nblk, k0 = 64 * kb, n0 = 32 * nb;
#pragma unroll 8
    for (int i = 0; i < 32; ++i) { const int kk = 2 * i + (lane >> 5); scr[kk * 33 + (lane & 31)] = W[(size_t)(k0 + kk) * N + n0 + (lane & 31)]; }
    LDS_WAIT(); asm volatile("" ::: "memory");
    const int c = lane & 7;
#pragma unroll
    for (int j = 0; j < 4; ++j) { const int n = (lane >> 3) + 8 * j; const LAS float* s = scr + (8 * c) * 33 + n;
        v4u o; o.x = pk2(s[0 * 33], s[1 * 33]); o.y = pk2(s[2 * 33], s[3 * 33]); o.z = pk2(s[4 * 33], s[5 * 33]); o.w = pk2(s[6 * 33], s[7 * 33]);
        *(GAS v4u*)(WT + (size_t)(n0 + n) * K + k0 + 8 * c) = o; }
    LDS_WAIT(); asm volatile("" ::: "memory");
}
__device__ __forceinline__ void rms_row_to_bf16(int lane, const float* xrow, const float* gain, bf16* orow) {
    const GAS f32x4* xr = (const GAS f32x4*)xrow + lane;
    const GAS f32x4* gr = (const GAS f32x4*)gain + lane;
    f32x4 v[4]; float s = 0.f;
#pragma unroll
    for (int j = 0; j < 4; ++j) { v[j] = xr[64 * j]; s += (v[j].x * v[j].x + v[j].y * v[j].y) + (v[j].z * v[j].z + v[j].w * v[j].w); }
    const float rstd = frsq(wave_sum(s) * (1.f / DM) + RMS_EPS);
    GAS unsigned long long* o8 = (GAS unsigned long long*)orow + lane;
#pragma unroll
    for (int j = 0; j < 4; ++j) { const f32x4 gg = gr[64 * j];
        o8[64 * j] = (unsigned long long)pk2(v[j].x * rstd * gg.x, v[j].y * rstd * gg.y) | ((unsigned long long)pk2(v[j].z * rstd * gg.z, v[j].w * rstd * gg.w) << 32); }
}
__device__ __forceinline__ void cvt_row_to_bf16(int lane, const float* xrow, bf16* orow) {
    const GAS f32x4* xr = (const GAS f32x4*)xrow + lane;
    GAS unsigned long long* o8 = (GAS unsigned long long*)orow + lane;
#pragma unroll
    for (int j = 0; j < 4; ++j) { const f32x4 v = xr[64 * j]; o8[64 * j] = (unsigned long long)pk2(v.x, v.y) | ((unsigned long long)pk2(v.z, v.w) << 32); }
}
__device__ __forceinline__ void p0_prologue(Frame& F) {
    LAS float* scr = (LAS float*)(F.lds + RING_OFF + F.wave * 16384);
    const int gw = F.wg * NWAVES + F.wave, NGW = F.G * NWAVES;
    constexpr int I_IN = (DM / 64) * (IN_COLS / 32), I_OUT = (DM / 64) * (DM / 32), I_Q = (DM / 64) * (PQ / 32);
    constexpr int NITEMS = I_IN + I_OUT + I_Q;
    bf16* win_t = (bf16*)(F.ws + WS_WIN); bf16* wout_t = (bf16*)(F.ws + WS_WOUT); bf16* wq_t = (bf16*)(F.ws + WS_WQ);
    for (int it = gw; it < NITEMS; it += NGW) {
        int r = it;
        if (r < I_IN) { p0_transpose_item(F.in[2], DM, IN_COLS, win_t, scr, r, F.lane); continue; } r -= I_IN;
        if (r < I_OUT) { p0_transpose_item(F.in[14], DM, DM, wout_t, scr, r, F.lane); continue; } r -= I_OUT;
        p0_transpose_item(F.in[16], DM, PQ, wq_t, scr, r, F.lane);
    }
    {
        constexpr int I_W = (64 / 64) * (RWW / 32), I_G = (128 / 64) * (RWW / 32);
        for (int it = gw; it < 2 * I_W + I_G; it += NGW) {
            int r = it;
            if (r < I_W) { p0_transpose_item(F.in[5], 64, RWW, (bf16*)(F.ws + WS_WUPT), scr, r, F.lane); continue; } r -= I_W;
            if (r < I_W) { p0_transpose_item(F.in[7], 64, RWW, (bf16*)(F.ws + WS_AUPT), scr, r, F.lane); continue; } r -= I_W;
            p0_transpose_item(F.in[8], 128, RWW, (bf16*)(F.ws + WS_GUPT), scr, r, F.lane);
        }
    }
    bf16* XN = (bf16*)(F.ws + WS_XN);
    for (int m = gw; m < T; m += NGW) rms_row_to_bf16(F.lane, F.in[0] + (size_t)m * DM, F.in[1], XN + (size_t)m * DM);
}

constexpr size_t WS_ROPE = WS_G;
__device__ __forceinline__ void p0_rope_table(Frame& F) {
    f32x2* tab = (f32x2*)(F.ws + WS_ROPE);
    for (int e = F.wg * NTHREADS + F.tid; e < SEQ * 32; e += F.G * NTHREADS) {
        const int sp = e >> 5, i = e & 31;
        const float inv_freq = powf(10000.0f, -(float)(2 * i) / 64.0f);
        const float ang = (float)sp * inv_freq;
        const double r = (double)ang - rint((double)ang * 0.15915494309189535) * 6.283185307179586;
        const float rf = (float)r;
        tab[e] = (f32x2){cosf(rf), sinf(rf)};
    }
}
__device__ __forceinline__ void p2_rope(Frame& F) {
    bf16* Z = (bf16*)(F.ws + WS_Z);
    const f32x2* tab = (const f32x2*)(F.ws + WS_ROPE);
    const int tid = F.tid, tk = tid >> 6, grp = (tid >> 2) & 15, i0 = (tid & 3) * 8;
    for (int blk = F.wg; blk < T / 8; blk += F.G) {
        const int g = blk * 8 + tk, sp = g & (SEQ - 1);
        bf16* p = Z + (size_t)g * IN_COLS + C_AQ + grp * 64 + i0;
        const v4u a = *(const GAS v4u*)p, b = *(const GAS v4u*)(p + 32);
        const GAS f32x4* tp = (const GAS f32x4*)(tab + sp * 32 + i0);
        float x1[8], x2[8];
        x1[0] = bflo(a.x); x1[1] = bfhi(a.x); x1[2] = bflo(a.y); x1[3] = bfhi(a.y); x1[4] = bflo(a.z); x1[5] = bfhi(a.z); x1[6] = bflo(a.w); x1[7] = bfhi(a.w);
        x2[0] = bflo(b.x); x2[1] = bfhi(b.x); x2[2] = bflo(b.y); x2[3] = bfhi(b.y); x2[4] = bflo(b.z); x2[5] = bfhi(b.z); x2[6] = bflo(b.w); x2[7] = bfhi(b.w);
        float o1[8], o2[8];
#pragma unroll
        for (int q = 0; q < 4; ++q) { const f32x4 cs = tp[q];
            o1[2 * q] = x1[2 * q] * cs[0] - x2[2 * q] * cs[1]; o2[2 * q] = x1[2 * q] * cs[1] + x2[2 * q] * cs[0];
            o1[2 * q + 1] = x1[2 * q + 1] * cs[2] - x2[2 * q + 1] * cs[3]; o2[2 * q + 1] = x1[2 * q + 1] * cs[3] + x2[2 * q + 1] * cs[2]; }
        v4u oa, ob; oa.x = pk2(o1[0], o1[1]); oa.y = pk2(o1[2], o1[3]); oa.z = pk2(o1[4], o1[5]); oa.w = pk2(o1[6], o1[7]);
        ob.x = pk2(o2[0], o2[1]); ob.y = pk2(o2[2], o2[3]); ob.z = pk2(o2[4], o2[5]); ob.w = pk2(o2[6], o2[7]);
        *(GAS v4u*)p = oa; *(GAS v4u*)(p + 32) = ob;
    }
}

typedef float f32x16 __attribute__((ext_vector_type(16)));
constexpr int SBS = 144;
constexpr int R1_EPRE = 0, R1_APRE = 16384, R1_AAB = 0, R1_X = 16384;
constexpr int R1_AT = 32768, R1_BT = 41984, R1_KT = 51200, R1_RT = 60416, R1_AHT = R1_BT, R1_U0T = R1_KT;
constexpr int R1_BBT = 69632, R1_KBT = 78848, R1_VT = 88064;
constexpr int R1_ACTW = 97280, R1_ACTA = 106496, R1_AAK = 97280, R1_ARB = 106496, R1_ARK = 115712;
constexpr int R1_BONUS = 124928, R1_WEND = 125184, R1_SEGS = 125440, R1_TII = 125440, R1_END = 129536;
static_assert(R1_END <= LDSCTL_OFF, "R1 LDS");
__device__ __forceinline__ int crow(int r, int hh) { return (r & 3) + 8 * (r >> 2) + 4 * hh; }
template <int KS> __device__ __forceinline__ f32x16 wtile(const LAS unsigned char* A, int sa, const LAS unsigned char* B, int sb, f32x16 acc, int lane) {
    const int row = lane & 31, hh = lane >> 5;
#pragma unroll
    for (int s = 0; s < KS; ++s) { const bf16x8 a = *(const LAS bf16x8*)(A + row * sa + 32 * s + 16 * hh); const bf16x8 b = *(const LAS bf16x8*)(B + row * sb + 32 * s + 16 * hh);
        acc = __builtin_amdgcn_mfma_f32_32x32x16_bf16(a, b, acc, 0, 0, 0); }
    return acc;
}
template <int KS> __device__ __forceinline__ f32x16 wtile_gb(const LAS unsigned char* A, int sa, const bf16* Bg, int ldb, f32x16 acc, int lane) {
    const int row = lane & 31, hh = lane >> 5;
#pragma unroll
    for (int s = 0; s < KS; ++s) { const bf16x8 a = *(const LAS bf16x8*)(A + row * sa + 32 * s + 16 * hh); const bf16x8 b = *(const GAS bf16x8*)(Bg + (size_t)row * ldb + 16 * s + 8 * hh);
        acc = __builtin_amdgcn_mfma_f32_32x32x16_bf16(a, b, acc, 0, 0, 0); }
    return acc;
}
__device__ __forceinline__ f32x16 zero16() { f32x16 z;
#pragma unroll
    for (int r = 0; r < 16; ++r) z[r] = 0.f;
    return z; }

struct R1Pre { v4u wd[2], ad[2], z[4]; };
__device__ __forceinline__ int r13_item(int wg, int G, int idx) { return G == 256 ? ((wg >> 3) * 128 + (wg & 7) + 8 * idx) : (wg + G * idx); }
__device__ __forceinline__ int r13_count(int wg, int G) { return G == 256 ? 16 : ((NB * NHR * 128 - wg + G - 1) / G); }
__device__ __forceinline__ void rwkv_r1_prefetch(Frame& F, int item, int tid, R1Pre& P) {
    const int chain = item >> 7, chunk = item & 127, b = chain >> 3, h = chain & 7, g0 = b * SEQ + chunk * 64;
    const bf16* Z = (const bf16*)(F.ws + WS_Z);
    const v4u z0 = (v4u){0u, 0u, 0u, 0u};
    { const int t = tid >> 3, cg = tid & 7; const bool first = (chunk == 0 && t == 0);
      const bf16* zr = Z + (size_t)(g0 + t) * IN_COLS;
      P.wd[0] = *(const GAS v4u*)(zr + C_WD + cg * 8); P.ad[0] = *(const GAS v4u*)(zr + C_AD + cg * 8);
      P.wd[1] = z0; P.ad[1] = z0;
      if (!first) { P.wd[1] = *(const GAS v4u*)(zr - IN_COLS + C_WD + cg * 8); P.ad[1] = *(const GAS v4u*)(zr - IN_COLS + C_AD + cg * 8); } }
#pragma unroll
    for (int q = 0; q < 4; ++q) { const int p = tid + 512 * q; P.z[q] = z0;
        if (p < 65 * 24) { const int row = p / 24, rem = p - row * 24, seg = rem >> 3, ch = rem & 7;
            if (!(chunk == 0 && row == 0)) P.z[q] = *(const GAS v4u*)(Z + (size_t)(g0 - 1 + row) * IN_COLS + seg * 512 + h * 64 + ch * 8); } }
}
constexpr int R1_ZS = R1_AT, R1_ZSS = 384;
static_assert(65 * R1_ZSS <= 4 * 9216, "ZS fits in the At..Rt region");
__device__ __forceinline__ void r1_load_bfrag(Frame& F, int h, int w, int lane, bf16x8 (&bf)[4]) {
    const int p = w >> 2, nt = w & 1; const bf16* upt = (const bf16*)(F.ws + (p == 0 ? WS_WUPT : WS_AUPT)) + (size_t)(h * 64 + nt * 32 + (lane & 31)) * 64 + 8 * (lane >> 5);
#pragma unroll
    for (int s2 = 0; s2 < 4; ++s2) bf[s2] = *(const GAS bf16x8*)(upt + 16 * s2);
}
__device__ __forceinline__ void rwkv_r1_item(Frame& F, int item, int next_item, R1Pre& P, const bf16x8 (&bfr)[4]) {
    const int chain = item >> 7, chunk = item & 127, b = chain >> 3, h = chain & 7;
    const int g0 = b * SEQ + chunk * 64;
    int tid_ = F.tid; asm volatile("" : "+v"(tid_));
    const int tid = tid_, lane = tid & 63, w = __builtin_amdgcn_readfirstlane(tid >> 6), hh = lane >> 5, cl = lane & 31;
    const bf16* Z = (const bf16*)(F.ws + WS_Z);
    LAS unsigned char* lds = F.lds + RING_OFF;
    const float* mu = F.in[3];
    {
        const int t = tid >> 3, cg = tid & 7;
        const v4u cw = P.wd[0], ca = P.ad[0], pw = P.wd[1], pa = P.ad[1];
        float fw[8], fa[8], qw[8], qa[8];
        fw[0] = bflo(cw.x); fw[1] = bfhi(cw.x); fw[2] = bflo(cw.y); fw[3] = bfhi(cw.y); fw[4] = bflo(cw.z); fw[5] = bfhi(cw.z); fw[6] = bflo(cw.w); fw[7] = bfhi(cw.w);
        fa[0] = bflo(ca.x); fa[1] = bfhi(ca.x); fa[2] = bflo(ca.y); fa[3] = bfhi(ca.y); fa[4] = bflo(ca.z); fa[5] = bfhi(ca.z); fa[6] = bflo(ca.w); fa[7] = bfhi(ca.w);
        qw[0] = bflo(pw.x); qw[1] = bfhi(pw.x); qw[2] = bflo(pw.y); qw[3] = bfhi(pw.y); qw[4] = bflo(pw.z); qw[5] = bfhi(pw.z); qw[6] = bflo(pw.w); qw[7] = bfhi(pw.w);
        qa[0] = bflo(pa.x); qa[1] = bfhi(pa.x); qa[2] = bflo(pa.y); qa[3] = bfhi(pa.y); qa[4] = bflo(pa.z); qa[5] = bfhi(pa.z); qa[6] = bflo(pa.w); qa[7] = bfhi(pa.w);
#pragma unroll
        for (int j = 0; j < 8; ++j) { const int c = cg * 8 + j; const float xw = fw[j] + (qw[j] - fw[j]) * mu[C_WD + c];
            const float ex = __expf(2.f * xw); fw[j] = 1.f - 2.f * frcp(ex + 1.f);
            fa[j] = fa[j] + (qa[j] - fa[j]) * mu[C_AD + c]; }
        v4u ow, oa; ow.x = pk2(fw[0], fw[1]); ow.y = pk2(fw[2], fw[3]); ow.z = pk2(fw[4], fw[5]); ow.w = pk2(fw[6], fw[7]);
        oa.x = pk2(fa[0], fa[1]); oa.y = pk2(fa[2], fa[3]); oa.z = pk2(fa[4], fa[5]); oa.w = pk2(fa[6], fa[7]);
        *(LAS v4u*)(lds + R1_ACTW + t * SBS + cg * 16) = ow; *(LAS v4u*)(lds + R1_ACTA + t * SBS + cg * 16) = oa;
#pragma unroll
        for (int q = 0; q < 4; ++q) { const int p = tid + 512 * q;
            if (p < 65 * 24) { const int row = p / 24, rem = p - row * 24; *(LAS v4u*)(lds + R1_ZS + row * R1_ZSS + rem * 16) = P.z[q]; } }
        if (next_item >= 0) rwkv_r1_prefetch(F, next_item, tid, P);
    }
    LDS_BARRIER();
    {
        const int p = w >> 2, mt = (w >> 1) & 1, nt = w & 1;
        f32x16 acc = zero16();
        { const LAS unsigned char* A_ = lds + (p == 0 ? R1_ACTW : R1_ACTA) + mt * 32 * SBS + (lane & 31) * SBS + 16 * hh;
#pragma unroll
          for (int s2 = 0; s2 < 4; ++s2) acc = __builtin_amdgcn_mfma_f32_32x32x16_bf16(*(const LAS bf16x8*)(A_ + 32 * s2), bfr[s2], acc, 0, 0, 0); }
        LAS float* O = (LAS float*)(lds + (p == 0 ? R1_EPRE : R1_APRE));
#pragma unroll
        for (int r = 0; r < 16; ++r) O[(mt * 32 + crow(r, hh)) * 64 + nt * 32 + cl] = acc[r];
    }
    LDS_BARRIER();
    {
        const int c = tid & 63, ts = tid >> 6, col = h * 64 + c;
        const float mu_r = mu[C_R + col], mu_k = mu[C_K + col], mu_v = mu[C_V + col], kkc = F.in[9][col], kac = F.in[10][col], rkc = F.in[11][col], w0c = F.in[4][col], a0c = F.in[6][col];
        const LAS float* EP = (const LAS float*)(lds + R1_EPRE); const LAS float* AP = (const LAS float*)(lds + R1_APRE);
        LAS float* SEGS = (LAS float*)(lds + R1_SEGS); LAS float* BON = (LAS float*)(lds + R1_BONUS);
        const LAS bf16* zb = (const LAS bf16*)(lds + R1_ZS + (8 * ts) * R1_ZSS) + c;
        float pr = bf2f(zb[0]), pk = bf2f(zb[64]), pv = bf2f(zb[128]);
        float rr[8], k2[8], ai[8], bi[8], vv[8], ee[8], cs[8]; float run = 0.f;
#pragma unroll
        for (int i = 0; i < 8; ++i) {
            const float zr = bf2f(zb[(i + 1) * (R1_ZSS / 2)]), zk = bf2f(zb[(i + 1) * (R1_ZSS / 2) + 64]), zv = bf2f(zb[(i + 1) * (R1_ZSS / 2) + 128]);
            const float r = zr + (pr - zr) * mu_r, k = zk + (pk - zk) * mu_k, v = zv + (pv - zv) * mu_v; pr = zr; pk = zk; pv = zv;
            const float e = 0.60653066f * frcp(1.f + __expf(-(w0c + EP[(8 * ts + i) * 64 + c])));
            const float a = frcp(1.f + __expf(-(a0c + AP[(8 * ts + i) * 64 + c])));
            float kk = k * kkc; const float n2 = wave_sum(kk * kk); kk = kk * frsq(fmaxf(n2, 1e-24f));
            const float kq = k * (1.f + (a - 1.f) * kac);
            const float bon = wave_sum(r * kq * rkc); if (c == 0) BON[8 * ts + i] = bon;
            rr[i] = r; k2[i] = kq; ai[i] = -kk; bi[i] = kk * a; vv[i] = v; ee[i] = e; run += e; cs[i] = run;
        }
        SEGS[ts * 64 + c] = run;
        LDS_BARRIER();
        float off = 0.f, tot = 0.f;
#pragma unroll
        for (int q = 0; q < 8; ++q) { const float sv = SEGS[q * 64 + c]; tot += sv; off += (q < ts) ? sv : 0.f; }
        float bb[8], kb[8];
#pragma unroll
        for (int i = 0; i < 8; ++i) { const float L = off + cs[i];
            const float Wm = __expf(-(L - ee[i])), Wi = __expf(-L), iW = __expf(L), We = __expf(-(tot - L));
            const int t = 8 * ts + i;
            *(LAS bf16*)(lds + R1_AT + t * SBS + c * 2) = (bf16)f2bf(ai[i] * Wm);
            *(LAS bf16*)(lds + R1_BT + t * SBS + c * 2) = (bf16)f2bf(bi[i] * iW);
            *(LAS bf16*)(lds + R1_KT + t * SBS + c * 2) = (bf16)f2bf(k2[i] * iW);
            *(LAS bf16*)(lds + R1_RT + t * SBS + c * 2) = (bf16)f2bf(rr[i] * Wi);
            bb[i] = bi[i] * We; kb[i] = k2[i] * We; }
        v4u o; o.x = pk2(bb[0], bb[1]); o.y = pk2(bb[2], bb[3]); o.z = pk2(bb[4], bb[5]); o.w = pk2(bb[6], bb[7]);
        *(LAS v4u*)(lds + R1_BBT + c * SBS + ts * 16) = o;
        o.x = pk2(kb[0], kb[1]); o.y = pk2(kb[2], kb[3]); o.z = pk2(kb[4], kb[5]); o.w = pk2(kb[6], kb[7]);
        *(LAS v4u*)(lds + R1_KBT + c * SBS + ts * 16) = o;
        o.x = pk2(vv[0], vv[1]); o.y = pk2(vv[2], vv[3]); o.z = pk2(vv[4], vv[5]); o.w = pk2(vv[6], vv[7]);
        *(LAS v4u*)(lds + R1_VT + c * SBS + ts * 16) = o;
        if (ts == 0) ((LAS float*)(lds + R1_WEND))[c] = __expf(-tot);
    }
    LDS_BARRIER();
#pragma unroll
    for (int u = 0; u < 2; ++u) {
        const int idx = w * 2 + u, p = idx >> 2, mt = (idx >> 1) & 1, nt = idx & 1;
        const LAS unsigned char* Aop = lds + ((p == 0 || p == 2) ? R1_BT : R1_KT) + mt * 32 * SBS;
        const LAS unsigned char* Bop = lds + (p < 2 ? R1_AT : R1_RT) + nt * 32 * SBS;
        f32x16 acc = wtile<4>(Aop, SBS, Bop, SBS, zero16(), lane);
        const int n = nt * 32 + cl;
#pragma unroll
        for (int r = 0; r < 16; ++r) { const int m = mt * 32 + crow(r, hh); const bool keep = (p < 2) ? (m < n) : (m <= n); acc[r] = keep ? acc[r] : 0.f; }
#pragma unroll
        for (int g4 = 0; g4 < 4; ++g4) { const int m0 = mt * 32 + 8 * g4 + 4 * hh;
            if (p == 0) *(LAS f32x4*)(lds + R1_AAB + (n * 64 + m0) * 4) = (f32x4){acc[4 * g4], acc[4 * g4 + 1], acc[4 * g4 + 2], acc[4 * g4 + 3]};
            else { v2u o; o.x = pk2(acc[4 * g4], acc[4 * g4 + 1]); o.y = pk2(acc[4 * g4 + 2], acc[4 * g4 + 3]);
                   *(LAS v2u*)(lds + (p == 1 ? R1_AAK : (p == 2 ? R1_ARB : R1_ARK)) + n * SBS + m0 * 2) = o; } }
    }
    LDS_BARRIER();
    if (w < 4) {
        const int mt = w >> 1, nt = w & 1;
        const f32x16 acc = wtile<4>(lds + R1_AAK + mt * 32 * SBS, SBS, lds + R1_VT + nt * 32 * SBS, SBS, zero16(), lane);
        LAS float* X = (LAS float*)(lds + R1_X);
#pragma unroll
        for (int r = 0; r < 16; ++r) X[(mt * 32 + crow(r, hh)) * 64 + nt * 32 + cl] = acc[r];
    } else if (w == 4) {
        const int bk = lane >> 4, c = lane & 15;
        const LAS float* AAB = (const LAS float*)(lds + R1_AAB);
        float Tc[16]; const float fc = (float)c;
#pragma unroll
        for (int s2 = 0; s2 < 16; ++s2) Tc[s2] = fmaxf(0.f, 1.f - fabsf((float)s2 - fc));
#pragma unroll
        for (int r = 0; r < 15; ++r)
#pragma unroll
            for (int s2 = r + 1; s2 < 16; ++s2) Tc[s2] += AAB[(16 * bk + s2) * 64 + 16 * bk + r] * Tc[r];
        LAS float* TII = (LAS float*)(lds + R1_TII);
#pragma unroll
        for (int s2 = 0; s2 < 16; ++s2) TII[(bk * 16 + s2) * 16 + c] = Tc[s2];
    }
    LDS_BARRIER();
    {
        const int c16 = lane & 15, g = lane >> 4;
        const LAS float* AAB = (const LAS float*)(lds + R1_AAB); const LAS float* TII = (const LAS float*)(lds + R1_TII); const LAS float* X = (const LAS float*)(lds + R1_X);
        f32x4 o[4];
#pragma unroll
        for (int i = 0; i < 4; ++i) {
            f32x4 acc;
            if (w < 4) {
#pragma unroll
                for (int q = 0; q < 4; ++q) acc[q] = bf2f(*(const LAS bf16*)(lds + R1_AT + (16 * i + 4 * g + q) * SBS + (16 * w + c16) * 2));
            } else {
#pragma unroll
                for (int q = 0; q < 4; ++q) acc[q] = X[(16 * i + 4 * g + q) * 64 + 16 * (w - 4) + c16];
            }
#pragma unroll
            for (int j = 0; j < i; ++j) { const f32x4 a4 = *(const LAS f32x4*)(AAB + (16 * i + c16) * 64 + 16 * j + 4 * g);
#pragma unroll
                for (int q = 0; q < 4; ++q) acc = __builtin_amdgcn_mfma_f32_16x16x4f32(a4[q], o[j][q], acc, 0, 0, 0); }
            const f32x4 t4 = *(const LAS f32x4*)(TII + (i * 16 + c16) * 16 + 4 * g);
            f32x4 res = (f32x4){0.f, 0.f, 0.f, 0.f};
#pragma unroll
            for (int q = 0; q < 4; ++q) res = __builtin_amdgcn_mfma_f32_16x16x4f32(t4[q], acc[q], res, 0, 0, 0);
            o[i] = res;
            v2u ov; ov.x = pk2(res[0], res[1]); ov.y = pk2(res[2], res[3]);
            *(LAS v2u*)(lds + (w < 4 ? R1_AHT : R1_U0T) + (16 * (w & 3) + c16) * SBS + (16 * i + 4 * g) * 2) = ov;
        }
    }
    LDS_BARRIER();
    {
        float* Mg = F.out + (size_t)item * 4096; float* NTg = F.out + (size_t)T * RWW + (size_t)item * 4096;
        float* Y0g = (float*)(F.ws + WS_RWY0) + (size_t)item * 4096; bf16* RHg = (bf16*)(F.ws + WS_RWRH) + (size_t)item * 4096;
#pragma unroll
        for (int u = 0; u < 2; ++u) {
            const int idx = w * 2 + u, p = idx >> 2, mt = (idx >> 1) & 1, nt = idx & 1; const int n = nt * 32 + cl;
            if (p == 0) {
                f32x16 acc = wtile<4>(lds + R1_AHT + mt * 32 * SBS, SBS, lds + R1_BBT + nt * 32 * SBS, SBS, zero16(), lane);
                const float we = ((const LAS float*)(lds + R1_WEND))[n];
#pragma unroll
                for (int g4 = 0; g4 < 4; ++g4) { const int m0 = mt * 32 + 8 * g4 + 4 * hh;
                    *(GAS f32x4*)(Mg + n * 64 + m0) = (f32x4){acc[4 * g4] + (m0 == n ? we : 0.f), acc[4 * g4 + 1] + (m0 + 1 == n ? we : 0.f), acc[4 * g4 + 2] + (m0 + 2 == n ? we : 0.f), acc[4 * g4 + 3] + (m0 + 3 == n ? we : 0.f)}; }
            } else if (p == 1) {
                f32x16 acc = wtile<4>(lds + R1_BBT + mt * 32 * SBS, SBS, lds + R1_U0T + nt * 32 * SBS, SBS, zero16(), lane);
                acc = wtile<4>(lds + R1_KBT + mt * 32 * SBS, SBS, lds + R1_VT + nt * 32 * SBS, SBS, acc, lane);
#pragma unroll
                for (int g4 = 0; g4 < 4; ++g4) *(GAS f32x4*)(NTg + n * 64 + mt * 32 + 8 * g4 + 4 * hh) = (f32x4){acc[4 * g4], acc[4 * g4 + 1], acc[4 * g4 + 2], acc[4 * g4 + 3]};
            } else if (p == 2) {
                f32x16 acc = wtile<4>(lds + R1_AHT + mt * 32 * SBS, SBS, lds + R1_ARB + nt * 32 * SBS, SBS, zero16(), lane);
#pragma unroll
                for (int g4 = 0; g4 < 4; ++g4) { const int m0 = mt * 32 + 8 * g4 + 4 * hh;
                    const v2u rt = *(const LAS v2u*)(lds + R1_RT + n * SBS + m0 * 2);
                    v2u ov; ov.x = pk2(acc[4 * g4] + bflo(rt.x), acc[4 * g4 + 1] + bfhi(rt.x)); ov.y = pk2(acc[4 * g4 + 2] + bflo(rt.y), acc[4 * g4 + 3] + bfhi(rt.y));
                    *(GAS v2u*)(RHg + n * 64 + m0) = ov; }
            } else {
                f32x16 acc = wtile<4>(lds + R1_U0T + mt * 32 * SBS, SBS, lds + R1_ARB + nt * 32 * SBS, SBS, zero16(), lane);
                acc = wtile<4>(lds + R1_VT + mt * 32 * SBS, SBS, lds + R1_ARK + nt * 32 * SBS, SBS, acc, lane);
#pragma unroll
                for (int g4 = 0; g4 < 4; ++g4) *(GAS f32x4*)(Y0g + n * 64 + mt * 32 + 8 * g4 + 4 * hh) = (f32x4){acc[4 * g4], acc[4 * g4 + 1], acc[4 * g4 + 2], acc[4 * g4 + 3]};
            }
        }
        if (tid < 64) ((float*)(F.ws + WS_BONUS))[(size_t)item * 64 + tid] = ((const LAS float*)(lds + R1_BONUS))[tid];
    }
    LDS_BARRIER();
}

constexpr int R2_RS = 272, R2_SLOT = 2 * 64 * R2_RS, R2_D = 7;
static_assert(2 * R2_SLOT <= LDSCTL_OFF, "R2 LDS");
__device__ __forceinline__ void rwkv_r2_chain(Frame& F, int chain) {
    int tid_ = F.tid; asm volatile("" : "+v"(tid_));
    const int lane = tid_ & 63, w = __builtin_amdgcn_readfirstlane(tid_ >> 6);
    LAS unsigned char* lds = F.lds + RING_OFF;
    const float* Mg = F.out + (size_t)chain * 128 * 4096; const float* NTg = F.out + (size_t)T * RWW + (size_t)chain * 128 * 4096;
    constexpr int NSTEP = 127;
    if (w >= 4) {
        const int L = w - 4, r = lane >> 2, f0 = (lane & 3) * 4;
        const size_t goff = (size_t)(16 * L + r) * 64 + f0 * 4;
        const int loff = (16 * L + r) * R2_RS + f0 * 16;
        f32x4 R[R2_D][8];
#define R2_ISSUE(slot_, step_) do { const int st_ = (step_) < NSTEP ? (step_) : NSTEP - 1; const float* mp_ = Mg + (size_t)st_ * 4096 + goff; const float* np_ = NTg + (size_t)st_ * 4096 + goff; \
            _Pragma("unroll") for (int k_ = 0; k_ < 4; ++k_) { R[slot_][k_] = *(const GAS f32x4*)(mp_ + 4 * k_); R[slot_][4 + k_] = *(const GAS f32x4*)(np_ + 4 * k_); } } while (0)
        const int q_ = lane & 3, froff = ((L * 2 + (q_ >> 1)) * 2) * 1024 + r * 16 + (q_ & 1) * 8;
#define R2_WRITE(slot_, buf_) do { LAS unsigned char* d_ = lds + (buf_) * R2_SLOT; \
            _Pragma("unroll") for (int k_ = 0; k_ < 4; ++k_) { const f32x4 a_ = R[slot_][k_]; \
                v2u h_; h_.x = pk2(a_[0], a_[1]); h_.y = pk2(a_[2], a_[3]); \
                v2u l_; l_.x = pk2(a_[0] - bflo(h_.x), a_[1] - bfhi(h_.x)); l_.y = pk2(a_[2] - bflo(h_.y), a_[3] - bfhi(h_.y)); \
                *(LAS v2u*)(d_ + froff + k_ * 256) = h_; *(LAS v2u*)(d_ + froff + 1024 + k_ * 256) = l_; \
                *(LAS f32x4*)(d_ + 64 * R2_RS + loff + 16 * k_) = R[slot_][4 + k_]; } } while (0)
#pragma unroll
        for (int u = 0; u < R2_D; ++u) R2_ISSUE(u, u);
        R2_WRITE(0, 0);
        R2_ISSUE(0, R2_D);
        LDS_BARRIER();
        static_assert((NSTEP - 1) % R2_D == 0, "main loop covers steps 0 .. NSTEP-2, one tail step");
        for (int c0 = 0; c0 < NSTEP - 1; c0 += R2_D) {
#pragma unroll
            for (int u = 0; u < R2_D; ++u) { const int c = c0 + u;
                R2_WRITE((u + 1) % R2_D, (c + 1) & 1);
                R2_ISSUE((u + 1) % R2_D, c + 1 + R2_D);
                LDS_BARRIER(); }
        }
        LDS_BARRIER();
#undef R2_ISSUE
#undef R2_WRITE
        return;
    }
    const int n16 = lane & 15, g = lane >> 4;
    float* SSg = (float*)(F.ws + WS_RWSS) + (size_t)chain * 128 * 4096;
    f32x4 st[4];
#pragma unroll
    for (int rt = 0; rt < 4; ++rt) st[rt] = (f32x4){0.f, 0.f, 0.f, 0.f};
    LDS_BARRIER();
    for (int c = 0; c < NSTEP; ++c) {
#pragma unroll
        for (int rt = 0; rt < 4; ++rt) *(GAS f32x4*)(SSg + (size_t)c * 4096 + (16 * w + n16) * 64 + 16 * rt + 4 * g) = st[rt];
        const LAS unsigned char* sl_ = lds + (c & 1) * R2_SLOT;
        bf16x8 sh[2], sl[2];
#pragma unroll
        for (int ks = 0; ks < 2; ++ks) { const f32x4 a = st[2 * ks], b = st[2 * ks + 1];
            v4u h; h.x = pk2(a[0], a[1]); h.y = pk2(a[2], a[3]); h.z = pk2(b[0], b[1]); h.w = pk2(b[2], b[3]);
            v4u l; l.x = pk2(a[0] - bflo(h.x), a[1] - bfhi(h.x)); l.y = pk2(a[2] - bflo(h.y), a[3] - bfhi(h.y)); l.z = pk2(b[0] - bflo(h.z), b[1] - bfhi(h.z)); l.w = pk2(b[2] - bflo(h.w), b[3] - bfhi(h.w));
            sh[ks] = __builtin_bit_cast(bf16x8, h); sl[ks] = __builtin_bit_cast(bf16x8, l); }
        f32x4 nw[4];
#pragma unroll
        for (int rt = 0; rt < 4; ++rt) { f32x4 acc = *(const LAS f32x4*)(sl_ + 64 * R2_RS + (16 * w + n16) * R2_RS + (16 * rt + 4 * g) * 4);
#pragma unroll
            for (int ks = 0; ks < 2; ++ks) {
                const bf16x8 mh = *(const LAS bf16x8*)(sl_ + ((rt * 2 + ks) * 2) * 1024 + lane * 16), ml = *(const LAS bf16x8*)(sl_ + ((rt * 2 + ks) * 2 + 1) * 1024 + lane * 16);
                acc = __builtin_amdgcn_mfma_f32_16x16x32_bf16(mh, sh[ks], acc, 0, 0, 0);
                acc = __builtin_amdgcn_mfma_f32_16x16x32_bf16(mh, sl[ks], acc, 0, 0, 0);
                acc = __builtin_amdgcn_mfma_f32_16x16x32_bf16(ml, sh[ks], acc, 0, 0, 0); }
            nw[rt] = acc; }
#pragma unroll
        for (int rt = 0; rt < 4; ++rt) st[rt] = nw[rt];
        LDS_BARRIER();
    }
#pragma unroll
    for (int rt = 0; rt < 4; ++rt) *(GAS f32x4*)(SSg + (size_t)NSTEP * 4096 + (16 * w + n16) * 64 + 16 * rt + 4 * g) = st[rt];
}

constexpr int R3_RH = 0, R3_S = 9216, R3_SG = 18432, R3_SGS = 272, R3_YL = R3_SG + 64 * R3_SGS, R3_GL = R3_YL + 16384, R3_VS = R3_GL + 16384, R3_BON = R3_VS + 65 * 128, R3_END = R3_BON + 256;
static_assert(R3_END <= LDSCTL_OFF, "R3 LDS");
struct R3Pre { v4u rh; f32x4 ss[2]; v4u gd[2][2]; f32x4 y0[2]; v4u vv[2]; float bon; };
__device__ __forceinline__ void rwkv_r3_prefetch(Frame& F, int item, int tid, R3Pre& P) {
    const int chain = item >> 7, chunk = item & 127, b = chain >> 3, h = chain & 7, g0 = b * SEQ + chunk * 64;
    const bf16* Z = (const bf16*)(F.ws + WS_Z);
    const int t = tid >> 3, cg = tid & 7; const v4u z0 = (v4u){0u, 0u, 0u, 0u};
    P.rh = *(const GAS v4u*)((const bf16*)(F.ws + WS_RWRH) + (size_t)item * 4096 + t * 64 + cg * 8);
    const float* SSg = (const float*)(F.ws + WS_RWSS) + (size_t)item * 4096 + t * 64 + cg * 8;
    P.ss[0] = *(const GAS f32x4*)SSg; P.ss[1] = *(const GAS f32x4*)(SSg + 4);
    const bf16* zr = Z + (size_t)(g0 + t) * IN_COLS + C_GD + cg * 16; const bool first = (chunk == 0 && t == 0);
#pragma unroll
    for (int q = 0; q < 2; ++q) { P.gd[q][0] = *(const GAS v4u*)(zr + q * 8); P.gd[q][1] = z0; if (!first) P.gd[q][1] = *(const GAS v4u*)(zr - IN_COLS + q * 8); }
    const float* Y0g = (const float*)(F.ws + WS_RWY0) + (size_t)item * 4096;
    P.y0[0] = *(const GAS f32x4*)(Y0g + tid * 4); P.y0[1] = *(const GAS f32x4*)(Y0g + (tid + 512) * 4);
#pragma unroll
    for (int q = 0; q < 2; ++q) { const int p = tid + 512 * q; P.vv[q] = z0;
        if (p < 65 * 8) { const int row = p >> 3, ch = p & 7; if (!(chunk == 0 && row == 0)) P.vv[q] = *(const GAS v4u*)(Z + (size_t)(g0 - 1 + row) * IN_COLS + C_V + h * 64 + ch * 8); } }
    P.bon = tid < 64 ? ((const float*)(F.ws + WS_BONUS))[(size_t)item * 64 + tid] : 0.f;
}
__device__ __forceinline__ void r3_load_bfrag(Frame& F, int h, int w, int lane, bf16x8 (&bf)[8]) {
    const int nt = w & 1; const bf16* gut = (const bf16*)(F.ws + WS_GUPT) + (size_t)(h * 64 + nt * 32 + (lane & 31)) * 128 + 8 * (lane >> 5);
#pragma unroll
    for (int s2 = 0; s2 < 8; ++s2) bf[s2] = *(const GAS bf16x8*)(gut + 16 * s2);
}
__device__ __forceinline__ void rwkv_r3_item(Frame& F, int item, int next_item, R3Pre& P, const bf16x8 (&bfr)[8]) {
    const int chain = item >> 7, chunk = item & 127, b = chain >> 3, h = chain & 7;
    const int g0 = b * SEQ + chunk * 64;
    int tid_ = F.tid; asm volatile("" : "+v"(tid_));
    const int tid = tid_, lane = tid & 63, w = __builtin_amdgcn_readfirstlane(tid >> 6), hh = lane >> 5, cl = lane & 31;
    LAS unsigned char* lds = F.lds + RING_OFF;
    const float* mu = F.in[3];
    {
        const int t = tid >> 3, cg = tid & 7;
        *(LAS v4u*)(lds + R3_RH + t * SBS + cg * 16) = P.rh;
        const f32x4 s0 = P.ss[0], s1 = P.ss[1];
        v4u o; o.x = pk2(s0[0], s0[1]); o.y = pk2(s0[2], s0[3]); o.z = pk2(s1[0], s1[1]); o.w = pk2(s1[2], s1[3]);
        *(LAS v4u*)(lds + R3_S + t * SBS + cg * 16) = o;
#pragma unroll
        for (int q = 0; q < 2; ++q) {
            const v4u cw = P.gd[q][0], pw = P.gd[q][1];
            float fw[8], qw[8];
            fw[0] = bflo(cw.x); fw[1] = bfhi(cw.x); fw[2] = bflo(cw.y); fw[3] = bfhi(cw.y); fw[4] = bflo(cw.z); fw[5] = bfhi(cw.z); fw[6] = bflo(cw.w); fw[7] = bfhi(cw.w);
            qw[0] = bflo(pw.x); qw[1] = bfhi(pw.x); qw[2] = bflo(pw.y); qw[3] = bfhi(pw.y); qw[4] = bflo(pw.z); qw[5] = bfhi(pw.z); qw[6] = bflo(pw.w); qw[7] = bfhi(pw.w);
#pragma unroll
            for (int j = 0; j < 8; ++j) { const float v = fw[j] + (qw[j] - fw[j]) * mu[C_GD + cg * 16 + q * 8 + j]; fw[j] = frcp(1.f + __expf(-v)); }
            v4u og; og.x = pk2(fw[0], fw[1]); og.y = pk2(fw[2], fw[3]); og.z = pk2(fw[4], fw[5]); og.w = pk2(fw[6], fw[7]);
            *(LAS v4u*)(lds + R3_SG + t * R3_SGS + (cg * 16 + q * 8) * 2) = og;
        }
        *(LAS f32x4*)(lds + R3_YL + tid * 16) = P.y0[0]; *(LAS f32x4*)(lds + R3_YL + (tid + 512) * 16) = P.y0[1];
#pragma unroll
        for (int q = 0; q < 2; ++q) { const int p = tid + 512 * q; if (p < 65 * 8) *(LAS v4u*)(lds + R3_VS + p * 16) = P.vv[q]; }
        if (tid < 64) ((LAS float*)(lds + R3_BON))[tid] = P.bon;
        if (next_item >= 0) rwkv_r3_prefetch(F, next_item, tid, P);
    }
    LDS_BARRIER();
    {
        const int mt = (w >> 1) & 1, nt = w & 1; const int n = nt * 32 + cl;
        if (w < 4) {
            LAS float* YL = (LAS float*)(lds + R3_YL);
            f32x16 acc;
#pragma unroll
            for (int r = 0; r < 16; ++r) acc[r] = YL[(mt * 32 + crow(r, hh)) * 64 + n];
            acc = wtile<4>(lds + R3_RH + mt * 32 * SBS, SBS, lds + R3_S + nt * 32 * SBS, SBS, acc, lane);
#pragma unroll
            for (int r = 0; r < 16; ++r) YL[(mt * 32 + crow(r, hh)) * 64 + n] = acc[r];
        } else {
            f32x16 acc = zero16();
            { const LAS unsigned char* A_ = lds + R3_SG + mt * 32 * R3_SGS + (lane & 31) * R3_SGS + 16 * hh;
#pragma unroll
              for (int s2 = 0; s2 < 8; ++s2) acc = __builtin_amdgcn_mfma_f32_32x32x16_bf16(*(const LAS bf16x8*)(A_ + 32 * s2), bfr[s2], acc, 0, 0, 0); }
            LAS float* GL = (LAS float*)(lds + R3_GL);
#pragma unroll
            for (int r = 0; r < 16; ++r) GL[(mt * 32 + crow(r, hh)) * 64 + n] = acc[r];
        }
    }
    LDS_BARRIER();
    {
        const int c = tid & 63, ts = tid >> 6, col = h * 64 + c;
        const float mu_v = mu[C_V + col], gw = F.in[12][col], gb = F.in[13][col];
        const LAS float* YL = (const LAS float*)(lds + R3_YL); const LAS float* GL = (const LAS float*)(lds + R3_GL); const LAS float* BON = (const LAS float*)(lds + R3_BON);
        bf16* Y = (bf16*)(F.ws + WS_YMIX);
        const LAS bf16* vb = (const LAS bf16*)(lds + R3_VS) + (8 * ts) * 64 + c;
        float pv = bf2f(vb[0]);
#pragma unroll
        for (int i = 0; i < 8; ++i) { const int t = 8 * ts + i;
            const float zv = bf2f(vb[(i + 1) * 64]); const float v = zv + (pv - zv) * mu_v; pv = zv;
            const float y = YL[t * 64 + c];
            const float mean = wave_sum(y) * (1.f / 64.f); const float d = y - mean; const float var = wave_sum(d * d) * (1.f / 64.f);
            const float yn = d * frsq(var + GN_EPS) * gw + gb;
            const float o = (yn + BON[t] * v) * GL[t * 64 + c];
            Y[(size_t)(g0 + t) * DM + col] = (bf16)f2bf(o); }
    }
    LDS_BARRIER();
}

typedef short s16x4 __attribute__((ext_vector_type(4)));
typedef short v4i16_t __attribute__((ext_vector_type(4)));
constexpr int AT_XO = 0, AT_XO_STRIDE = 136, AT_XM = 512 * AT_XO_STRIDE, AT_XL = AT_XM + 2048, AT_V = AT_XL + 2048, AT_LDS_END = AT_V + 8 * 4096;
static_assert(AT_LDS_END <= RING_BYTES, "attention LDS");
__device__ __forceinline__ float xhalf(float v) { return __shfl_xor(v, 32); }
__device__ __forceinline__ void attn_block(Frame& F, int item) {
    const int bh = item >> 4, blk = item & 15, b = bh >> 3, h = bh & 7, t0 = blk * 512;
    int tid_ = F.tid; asm volatile("" : "+v"(tid_));
    const int lane = tid_ & 63, w = __builtin_amdgcn_readfirstlane(tid_ >> 6), ql = lane & 31, hh = lane >> 5;
    const bf16* Zb = (const bf16*)(F.ws + WS_Z) + (size_t)b * SEQ * IN_COLS;
    bf16* Y = (bf16*)(F.ws + WS_YMIX);
    LAS unsigned char* lds = F.lds + RING_OFF;
    LAS unsigned char* Vw = lds + AT_V + w * 4096;
    LAS float* XM = (LAS float*)(lds + AT_XM); LAS float* XL = (LAS float*)(lds + AT_XL);
    constexpr float C2 = 0.125f * 1.4426950408889634f;
    for (int pass = 0; pass < 3; ++pass) {
        const int sh = pass == 0 ? 4 : (pass == 1 ? 2 : 0), d = 1 << sh;
        for (int uu = 0; uu < 2; ++uu) {
            const int u = w + 8 * uu, rho = u & (d - 1), tau = u >> sh;
            const int qoff = rho + (32 * tau + ql) * d;
            bf16x8 qf[4];
            { const bf16* qp = Zb + (size_t)(t0 + qoff) * IN_COLS + C_AQ + h * 64 + 8 * hh;
#pragma unroll
              for (int s = 0; s < 4; ++s) qf[s] = *(const GAS bf16x8*)(qp + 16 * s); }
            f32x16 sc[5];
            const int tkb = t0 + rho + (32 * tau - 128) * d;
            bf16x8 kf[5][4];
#pragma unroll
            for (int kt = 0; kt < 5; ++kt) { const int tk0 = tkb + 32 * kt * d, tkc = tk0 < 0 ? 0 : tk0;
                const bf16* kp = Zb + (size_t)(tkc + ql * d) * IN_COLS + C_AK + h * 64 + 8 * hh;
#pragma unroll
                for (int s = 0; s < 4; ++s) kf[kt][s] = *(const GAS bf16x8*)(kp + 16 * s); }
            v4u vr[4];
            { const int tkc = tkb < 0 ? 0 : tkb;
#pragma unroll
              for (int i = 0; i < 4; ++i) { const int kidx = i * 8 + (lane >> 3), ch = lane & 7;
                  vr[i] = *(const GAS v4u*)(Zb + (size_t)(tkc + kidx * d) * IN_COLS + C_AV + h * 64 + ch * 8); } }
#pragma unroll
            for (int kt = 0; kt < 5; ++kt) {
                const int tk0 = tkb + 32 * kt * d;
                f32x16 acc = zero16();
#pragma unroll
                for (int s = 0; s < 4; ++s) acc = __builtin_amdgcn_mfma_f32_32x32x16_bf16(kf[kt][s], qf[s], acc, 0, 0, 0);
                if (kt == 0 || kt == 4) {
#pragma unroll
                    for (int r = 0; r < 16; ++r) { const int kidx = (r & 3) + 8 * (r >> 2) + 4 * hh;
                        const bool ok = (kt == 0) ? (kidx >= ql) : (kidx <= ql);
                        acc[r] = ok ? acc[r] : -INFINITY; }
                }
                if (tk0 < 0) {
#pragma unroll
                    for (int r = 0; r < 16; ++r) acc[r] = -INFINITY;
                }
                sc[kt] = acc;
            }
            float m = -INFINITY;
#pragma unroll
            for (int kt = 0; kt < 5; ++kt)
#pragma unroll
                for (int r = 0; r < 16; ++r) m = fmaxf(m, sc[kt][r]);
            m = fmaxf(m, xhalf(m));
            const float ms = m * C2;
            float l = 0.f;
#pragma unroll
            for (int kt = 0; kt < 5; ++kt)
#pragma unroll
                for (int r = 0; r < 16; ++r) { const float p = __builtin_amdgcn_exp2f(sc[kt][r] * C2 - ms); sc[kt][r] = p; l += p; }
            l += xhalf(l);
            f32x16 O[2];
#pragma unroll
            for (int r = 0; r < 16; ++r) { O[0][r] = 0.f; O[1][r] = 0.f; }
#pragma unroll
            for (int kt = 0; kt < 5; ++kt) {
#pragma unroll
                for (int i = 0; i < 4; ++i) { const int kidx = i * 8 + (lane >> 3), ch = lane & 7;
                    *(LAS v4u*)(Vw + kidx * 128 + ((ch ^ (((kidx >> 1) & 1) << 2)) << 4)) = vr[i]; }
                if (kt < 4) { const int tk1 = tkb + 32 * (kt + 1) * d, tkc = tk1 < 0 ? 0 : tk1;
#pragma unroll
                    for (int i = 0; i < 4; ++i) { const int kidx = i * 8 + (lane >> 3), ch = lane & 7;
                        vr[i] = *(const GAS v4u*)(Zb + (size_t)(tkc + kidx * d) * IN_COLS + C_AV + h * 64 + ch * 8); } }
                asm volatile("s_waitcnt lgkmcnt(0)" ::: "memory");
#pragma unroll
                for (int s = 0; s < 2; ++s) {
                    v4u pw; pw.x = pk2(sc[kt][8 * s], sc[kt][8 * s + 1]); pw.y = pk2(sc[kt][8 * s + 2], sc[kt][8 * s + 3]); pw.z = pk2(sc[kt][8 * s + 4], sc[kt][8 * s + 5]); pw.w = pk2(sc[kt][8 * s + 6], sc[kt][8 * s + 7]);
                    const bf16x8 pf = __builtin_bit_cast(bf16x8, pw);
#pragma unroll
                    for (int dt = 0; dt < 2; ++dt) {
                        bf16x8 vf;
#pragma unroll
                        for (int pp = 0; pp < 2; ++pp) {
                            const int i16 = lane & 15, db = (lane >> 4) & 1;
                            const int row = 16 * s + 8 * pp + 4 * hh + (i16 >> 2);
                            const int byte = 64 * dt + 32 * db + 8 * (i16 & 3);
                            const int chunk = (byte >> 4) ^ (((row >> 1) & 1) << 2);
                            const s16x4 t4 = __builtin_bit_cast(s16x4, __builtin_amdgcn_ds_read_tr16_b64_v4i16((LAS v4i16_t*)(Vw + row * 128 + (chunk << 4) + (byte & 15))));
                            vf[4 * pp + 0] = t4[0]; vf[4 * pp + 1] = t4[1]; vf[4 * pp + 2] = t4[2]; vf[4 * pp + 3] = t4[3];
                        }
                        O[dt] = __builtin_amdgcn_mfma_f32_32x32x16_bf16(vf, pf, O[dt], 0, 0, 0);
                    }
                }
                asm volatile("s_waitcnt lgkmcnt(0)" ::: "memory");
            }
            LAS unsigned char* xo = lds + AT_XO + qoff * AT_XO_STRIDE + 8 * hh;
            float wa = 0.f, wb = 1.f, Mx = ms, ln = l;
            if (pass > 0) { const float msa = XM[qoff], la = XL[qoff]; Mx = fmaxf(msa, ms); wa = la * __builtin_amdgcn_exp2f(msa - Mx); wb = __builtin_amdgcn_exp2f(ms - Mx); ln = wa + wb * l; }
            const float inv = 1.f / ln;
#pragma unroll
            for (int dt = 0; dt < 2; ++dt)
#pragma unroll
                for (int g4 = 0; g4 < 4; ++g4) {
                    LAS v2u* p = (LAS v2u*)(xo + (32 * dt + 8 * g4) * 2);
                    float o0 = O[dt][4 * g4] * wb, o1 = O[dt][4 * g4 + 1] * wb, o2 = O[dt][4 * g4 + 2] * wb, o3 = O[dt][4 * g4 + 3] * wb;
                    if (pass > 0) { const v2u old = *p; o0 += bflo(old.x) * wa; o1 += bfhi(old.x) * wa; o2 += bflo(old.y) * wa; o3 += bfhi(old.y) * wa; }
                    v2u nw; nw.x = pk2(o0 * inv, o1 * inv); nw.y = pk2(o2 * inv, o3 * inv);
                    *p = nw;
                }
            if (hh == 0) { XM[qoff] = Mx; XL[qoff] = ln; }
        }
        LDS_BARRIER();
    }
#pragma unroll
    for (int i = 0; i < 8; ++i) { const int row = (tid_ >> 3) + 64 * i, ch = tid_ & 7;
        LAS v2u* p = (LAS v2u*)(lds + AT_XO + row * AT_XO_STRIDE + ch * 16);
        const v2u a = p[0], c = p[1];
        v4u o; o.x = a.x; o.y = a.y; o.z = c.x; o.w = c.y;
        *(GAS v4u*)(Y + ((size_t)b * SEQ + t0 + row) * DM + RWW + h * 64 + ch * 8) = o; }
    LDS_BARRIER();
}

__device__ __forceinline__ void quantize_tables(Frame& F, int gw, int ngw) {
    for (int m = gw; m < 2 * NEXP; m += ngw) {
        const int tab = m >= NEXP, row = tab ? m - NEXP : m;
        const GAS f32x4* xr = (const GAS f32x4*)(F.in[18 + tab] + (size_t)row * DM) + F.lane * 4;
        f32x4 v[4]; float am = 0.f;
#pragma unroll
        for (int j = 0; j < 4; ++j) { v[j] = xr[j]; am = fmaxf(am, fmaxf(fmaxf(fabsf(v[j].x), fabsf(v[j].y)), fmaxf(fabsf(v[j].z), fabsf(v[j].w)))); }
        am = wave_max(am);
        const float qmax = tab ? 224.f : 127.f;
        const float sc = am > 0.f ? am / qmax : 1.f, inv = am > 0.f ? qmax / am : 0.f;
        v4u o;
#pragma unroll
        for (int j = 0; j < 4; ++j) {
            if (tab) { int w = __builtin_amdgcn_cvt_pk_fp8_f32(v[j].x * inv, v[j].y * inv, 0, false); w = __builtin_amdgcn_cvt_pk_fp8_f32(v[j].z * inv, v[j].w * inv, w, true); o[j] = (unsigned)w; }
            else {
            const unsigned b0 = (unsigned)(int)rintf(v[j].x * inv) & 255u, b1 = (unsigned)(int)rintf(v[j].y * inv) & 255u,
                           b2 = (unsigned)(int)rintf(v[j].z * inv) & 255u, b3 = (unsigned)(int)rintf(v[j].w * inv) & 255u;
            o[j] = b0 | (b1 << 8) | (b2 << 16) | (b3 << 24); } }
        *(GAS v4u*)(F.ws + (tab ? WS_VQ : WS_UQ) + (size_t)row * DM + F.lane * 16) = o;
        if (F.lane == 0) ((float*)(F.ws + (tab ? WS_SV : WS_SU)))[row] = sc;
    }
}

__device__ __forceinline__ void p3_mixers(Frame& F) {
    const int nrw = (F.G >= 64) ? 32 : 0;
    if (nrw == 0) { for (int ch = 0; ch < NB * NHR; ++ch) rwkv_r2_chain(F, ch); }
#ifndef RW2_REPS
#define RW2_REPS 1
#endif
    else if (F.wg < nrw) { for (int rep = 0; rep < RW2_REPS; ++rep) { for (int ch = F.wg; ch < NB * NHR; ch += nrw) rwkv_r2_chain(F, ch); if (rep + 1 < RW2_REPS) __syncthreads(); } return; }
    const int na = F.G - nrw, wa = F.wg - nrw;
#ifndef ATTN_REPS
#define ATTN_REPS 1
#endif
    for (int rep = 0; rep < ATTN_REPS; ++rep)
    for (int item = wa; item < NB * NHA * (SEQ / 512); item += na) attn_block(F, item);
    quantize_tables(F, wa * NWAVES + F.wave, na * NWAVES);
}

__device__ __forceinline__ void p5_xn2(Frame& F) {
    const int gw = F.wg * NWAVES + F.wave, NGW = F.G * NWAVES;
    bf16* XN = (bf16*)(F.ws + WS_XN);
    for (int m = gw; m < T; m += NGW) rms_row_to_bf16(F.lane, F.out + (size_t)m * DM, F.in[15], XN + (size_t)m * DM);
}

constexpr int TK_SKS = 272, TK_SKH = 0, TK_SKL = 2 * 128 * TK_SKS, TK_LUT = 2 * TK_SKL, TK_END = TK_LUT + 8 * 2048;
__device__ __forceinline__ unsigned f2ord(float f) { const unsigned u = __builtin_bit_cast(unsigned, f); return u ^ ((unsigned)((int)u >> 31) | 0x80000000u); }
__device__ __forceinline__ float ord2f(unsigned o) { const unsigned u = (o & 0x80000000u) ? (o ^ 0x80000000u) : ~o; return __builtin_bit_cast(float, u); }
__device__ __forceinline__ void ce_desc(unsigned& a, unsigned& b) { const unsigned mx = a > b ? a : b, mn = a > b ? b : a; a = mx; b = mn; }
template <int N, int OFF, int TOT> __device__ __forceinline__ void bitonic_sort_desc(unsigned (&v)[TOT]) {
#pragma unroll
    for (int k = 2; k <= N; k <<= 1)
#pragma unroll
        for (int j = k >> 1; j > 0; j >>= 1)
#pragma unroll
            for (int i = 0; i < N; ++i) { const int l = i ^ j; if (l > i) { if ((i & k) == 0) ce_desc(v[OFF + i], v[OFF + l]); else ce_desc(v[OFF + l], v[OFF + i]); } }
}
template <int OFFA, int OFFB, int TOT> __device__ __forceinline__ void merge_top16(unsigned (&v)[TOT]) {
#pragma unroll
    for (int i = 0; i < 16; ++i) { const unsigned x = v[OFFA + i], y = v[OFFB + 15 - i]; v[OFFA + i] = x > y ? x : y; }
#pragma unroll
    for (int j = 8; j > 0; j >>= 1)
#pragma unroll
        for (int i = 0; i < 16; ++i) { const int l = i ^ j; if (l > i) ce_desc(v[OFFA + i], v[OFFA + l]); }
}
__device__ __forceinline__ void top16_of_64(unsigned (&k)[64]) {
    bitonic_sort_desc<16, 0, 64>(k); bitonic_sort_desc<16, 16, 64>(k); bitonic_sort_desc<16, 32, 64>(k); bitonic_sort_desc<16, 48, 64>(k);
    merge_top16<0, 16, 64>(k); merge_top16<32, 48, 64>(k); merge_top16<0, 32, 64>(k);
}
__device__ __forceinline__ void p7_topk(Frame& F) {
    static_assert(TK_END <= LDSCTL_OFF, "topk LDS");
    const bf16* QP = (const bf16*)(F.ws + WS_QP);
    int* EID = (int*)(F.ws + WS_EID); float* GATE = (float*)(F.ws + WS_GATE);
    const float* sk = F.in[17];
    LAS unsigned char* lds = F.lds + RING_OFF;
    for (int e = F.tid; e < 2 * 128 * 64; e += NTHREADS) {
        const int c = e >> 13, k = (e >> 6) & 127, d2 = e & 63;
        const f32x2 v = *(const GAS f32x2*)(sk + (size_t)(c * 128 + k) * 128 + 2 * d2);
        const unsigned h0 = f2bf(v.x), h1 = f2bf(v.y);
        const float r0 = v.x - __builtin_bit_cast(float, h0 << 16), r1 = v.y - __builtin_bit_cast(float, h1 << 16);
        *(LAS unsigned*)(lds + TK_SKH + (c * 128 + k) * TK_SKS + d2 * 4) = h0 | (h1 << 16);
        *(LAS unsigned*)(lds + TK_SKL + (c * 128 + k) * TK_SKS + d2 * 4) = pk2(r0, r1);
    }
    __syncthreads();
    const int gw = F.wg * NWAVES + F.wave, NGW = F.G * NWAVES;
    for (int tile = gw; tile < T * PHEADS / 32; tile += NGW) {
        int lane_ = F.lane; asm volatile("" : "+v"(lane_));
        const int lane = lane_, hh = lane >> 5, cl = lane & 31;
        const int P = tile * 32 + cl, t = P >> 3, h = P & 7;
        unsigned kAB[2][16];
#pragma unroll
        for (int c = 0; c < 2; ++c) {
            bf16x8 qf[8];
            const bf16* qp = QP + (size_t)t * PQ + h * 256 + c * 128 + 8 * hh;
#pragma unroll
            for (int s2 = 0; s2 < 8; ++s2) qf[s2] = *(const GAS bf16x8*)(qp + 16 * s2);
            unsigned k[64];
#pragma unroll
            for (int mt = 0; mt < 4; ++mt) {
                f32x16 acc = zero16();
                const LAS unsigned char* ah = lds + TK_SKH + (c * 128 + mt * 32 + cl) * TK_SKS + 16 * hh;
                const LAS unsigned char* al = lds + TK_SKL + (c * 128 + mt * 32 + cl) * TK_SKS + 16 * hh;
#pragma unroll
                for (int s2 = 0; s2 < 8; ++s2) {
                    acc = __builtin_amdgcn_mfma_f32_32x32x16_bf16(*(const LAS bf16x8*)(ah + 32 * s2), qf[s2], acc, 0, 0, 0);
                    acc = __builtin_amdgcn_mfma_f32_32x32x16_bf16(*(const LAS bf16x8*)(al + 32 * s2), qf[s2], acc, 0, 0, 0); }
#pragma unroll
                for (int r = 0; r < 16; ++r) { const int idx = 32 * mt + (r & 3) + 8 * (r >> 2) + 4 * hh; k[mt * 16 + r] = (f2ord(acc[r]) & ~127u) | (unsigned)(127 - idx); }
            }
            top16_of_64(k);
            unsigned m[32];
#pragma unroll
            for (int i = 0; i < 16; ++i) { m[i] = k[i]; m[16 + i] = (unsigned)__shfl_xor((int)k[i], 32); }
            merge_top16<0, 16, 32>(m);
#pragma unroll
            for (int i = 0; i < 16; ++i) kAB[c][i] = m[i];
        }
        float fa[16], fb[16];
#pragma unroll
        for (int i = 0; i < 16; ++i) { fa[i] = ord2f(kAB[0][i] & ~127u); fb[i] = ord2f(kAB[1][i] & ~127u); }
        unsigned cd[64]; int n = 0;
#pragma unroll
        for (int i = 0; i < 16; ++i)
#pragma unroll
            for (int j = 0; j < 16; ++j) if ((i + 1) * (j + 1) <= 16) { cd[n] = (f2ord(fa[i] + fb[j]) & ~255u) | (unsigned)(255 - (i * 16 + j)); ++n; }
#pragma unroll
        for (int q = 50; q < 64; ++q) cd[q] = 0u;
        top16_of_64(cd);
        LAS unsigned char* lut = lds + TK_LUT + (F.wave * 64 + lane) * 32;
#pragma unroll
        for (int q = 0; q < 4; ++q) {
            unsigned wa = 0u, wb = 0u;
#pragma unroll
            for (int b4 = 0; b4 < 4; ++b4) { wa |= (127u - (kAB[0][4 * q + b4] & 127u)) << (8 * b4); wb |= (127u - (kAB[1][4 * q + b4] & 127u)) << (8 * b4); }
            *(LAS unsigned*)(lut + 4 * q) = wa; *(LAS unsigned*)(lut + 16 + 4 * q) = wb; }
        float gv[16]; float den = 0.f; const float mx = ord2f(cd[0] & ~255u);
#pragma unroll
        for (int q = 0; q < 16; ++q) { gv[q] = __expf(ord2f(cd[q] & ~255u) - mx); den += gv[q]; }
        const float inv = 1.f / den;
        asm volatile("s_waitcnt lgkmcnt(0)" ::: "memory");
        int ev[16];
#pragma unroll
        for (int q = 0; q < 16; ++q) { const unsigned pos = 255u - (cd[q] & 255u);
            const unsigned ia = *(const LAS unsigned char*)(lut + (pos >> 4)), ib = *(const LAS unsigned char*)(lut + 16 + (pos & 15u));
            ev[q] = (int)(ia * NKEYS + ib); }
        if (hh == 0) {
            int* ep = EID + (size_t)t * 128 + h * 16; float* gp = GATE + (size_t)t * 128 + h * 16;
#pragma unroll
            for (int q = 0; q < 4; ++q) {
                *(GAS v4u*)(ep + 4 * q) = (v4u){(unsigned)ev[4 * q], (unsigned)ev[4 * q + 1], (unsigned)ev[4 * q + 2], (unsigned)ev[4 * q + 3]};
                *(GAS f32x4*)(gp + 4 * q) = (f32x4){gv[4 * q] * inv, gv[4 * q + 1] * inv, gv[4 * q + 2] * inv, gv[4 * q + 3] * inv}; }
        }
        asm volatile("s_waitcnt lgkmcnt(0)" ::: "memory");
    }
}

constexpr int GA_WAVE_BYTES = 10752, GA_CNT = 4096, GA_OFF = 4096 + 128, GA_ACT = 4608, GA_XQ = 6656;
__device__ __forceinline__ int wave_sum_i(int v) { v += dppi<0xB1>(v); v += dppi<0x4E>(v); v += dppi<0x141>(v); v += dppi<0x140>(v);
    return (__builtin_amdgcn_readlane(v, 0) + __builtin_amdgcn_readlane(v, 16)) + (__builtin_amdgcn_readlane(v, 32) + __builtin_amdgcn_readlane(v, 48)); }
struct PairBuf { v4u u, v; float su, sv; int e; float g; };
__device__ __forceinline__ void p8_gather(Frame& F, float* outp) {
    const bf16* XN = (const bf16*)(F.ws + WS_XN);
    const unsigned char* UQ = F.ws + WS_UQ; const unsigned char* VQ = F.ws + WS_VQ;
    const float* SU = (const float*)(F.ws + WS_SU); const float* SV = (const float*)(F.ws + WS_SV);
    const int* EID = (const int*)(F.ws + WS_EID); const float* GATE = (const float*)(F.ws + WS_GATE);
    const float* nf = F.in[20];
    const int gw = F.wg * NWAVES + F.wave, NGW = F.G * NWAVES;
    LAS unsigned char* wl = F.lds + RING_OFF + F.wave * GA_WAVE_BYTES;
    for (int tg = gw, sweep = 0; tg < T / 4; tg += NGW, ++sweep) {
        int lane_ = F.lane; asm volatile("" : "+v"(lane_));
        const int lane = lane_;
        int xq[4][4]; float sx[4];
#pragma unroll
        for (int tk = 0; tk < 4; ++tk) {
            const GAS v4u* xp = (const GAS v4u*)(XN + (size_t)(4 * tg + tk) * DM + lane * 16);
            const v4u a = xp[0], b = xp[1];
            float x[16]; x[0] = bflo(a.x); x[1] = bfhi(a.x); x[2] = bflo(a.y); x[3] = bfhi(a.y); x[4] = bflo(a.z); x[5] = bfhi(a.z); x[6] = bflo(a.w); x[7] = bfhi(a.w);
            x[8] = bflo(b.x); x[9] = bfhi(b.x); x[10] = bflo(b.y); x[11] = bfhi(b.y); x[12] = bflo(b.z); x[13] = bfhi(b.z); x[14] = bflo(b.w); x[15] = bfhi(b.w);
            float am = 0.f;
#pragma unroll
            for (int i = 0; i < 16; ++i) am = fmaxf(am, fabsf(x[i]));
            am = wave_max(am);
            const float rs_ = frsq(((const float*)(F.ws + WS_SSQ))[4 * tg + tk] * (1.f / DM) + RMS_EPS);
            sx[tk] = (am > 0.f ? am * (1.f / 127.f) : 1.f) * rs_; const float inv = am > 0.f ? 127.f / am : 0.f;
#pragma unroll
            for (int q = 0; q < 4; ++q) {
                const unsigned b0 = (unsigned)(int)rintf(x[4 * q] * inv) & 255u, b1 = (unsigned)(int)rintf(x[4 * q + 1] * inv) & 255u, b2 = (unsigned)(int)rintf(x[4 * q + 2] * inv) & 255u, b3 = (unsigned)(int)rintf(x[4 * q + 3] * inv) & 255u;
                xq[tk][q] = (int)(b0 | (b1 << 8) | (b2 << 16) | (b3 << 24)); }
            *(LAS v4u*)(wl + GA_XQ + tk * 1024 + lane * 16) = (v4u){(unsigned)xq[tk][0], (unsigned)xq[tk][1], (unsigned)xq[tk][2], (unsigned)xq[tk][3]};
        }
        LAS unsigned* cnt = (LAS unsigned*)(wl + GA_CNT); LAS unsigned* offs = (LAS unsigned*)(wl + GA_OFF);
        if (lane < 32) cnt[lane] = 0u;
        asm volatile("s_waitcnt lgkmcnt(0)" ::: "memory");
        int ee[8]; float gg[8]; unsigned pos[8];
#pragma unroll
        for (int tk = 0; tk < 4; ++tk) {
            const size_t base = (size_t)(4 * tg + tk) * 128;
            ee[2 * tk] = (EID[base + lane] & (NEXP - 1)) | (tk << 14); ee[2 * tk + 1] = (EID[base + 64 + lane] & (NEXP - 1)) | (tk << 14);
            gg[2 * tk] = GATE[base + lane]; gg[2 * tk + 1] = GATE[base + 64 + lane]; }
#pragma unroll
        for (int q = 0; q < 8; ++q) pos[q] = __hip_atomic_fetch_add(cnt + ((ee[q] >> 9) & 31), 1u, __ATOMIC_RELAXED, __HIP_MEMORY_SCOPE_WAVEFRONT);
        asm volatile("s_waitcnt lgkmcnt(0)" ::: "memory");
        if (lane < 32) {
            const int c0 = (int)cnt[lane]; int v = c0;
            v += __builtin_amdgcn_update_dpp(0, v, 0x111, 0xF, 0xF, true); v += __builtin_amdgcn_update_dpp(0, v, 0x112, 0xF, 0xF, true);
            v += __builtin_amdgcn_update_dpp(0, v, 0x114, 0xF, 0xF, true); v += __builtin_amdgcn_update_dpp(0, v, 0x118, 0xF, 0xF, true);
            const int row0 = __builtin_amdgcn_readlane(v, 15);
            offs[lane] = (unsigned)(v - c0 + (lane >= 16 ? row0 : 0));
        }
        asm volatile("s_waitcnt lgkmcnt(0)" ::: "memory");
#pragma unroll
        for (int q = 0; q < 8; ++q) { const unsigned idx = offs[(ee[q] >> 9) & 31] + pos[q];
            *(LAS unsigned*)(wl + idx * 4) = (unsigned)ee[q]; *(LAS float*)(wl + 2048 + idx * 4) = gg[q]; }
        asm volatile("s_waitcnt lgkmcnt(0)" ::: "memory");
        LAS float* act = (LAS float*)(wl + GA_ACT);
        {
            const int grp = lane >> 4, l16 = lane & 15;
            const LAS unsigned* ents = (const LAS unsigned*)wl;
            LAS int* hbuf = (LAS int*)(wl + GA_ACT);
            v4u rb[2][2][4]; unsigned eb[2][2];
#define GA_ULOAD(ST, QD, Q_) do { const unsigned e_ = ents[(Q_) * 4 + grp]; eb[ST][QD] = e_; const GAS v4u* rp_ = (const GAS v4u*)(UQ + (size_t)(e_ & (NEXP - 1)) * DM + l16 * 64); \
                rb[ST][QD][0] = rp_[0]; rb[ST][QD][1] = rp_[1]; rb[ST][QD][2] = rp_[2]; rb[ST][QD][3] = rp_[3]; } while (0)
#define GA_UDOT(ST, QD, Q_) do { const LAS v4u* xp_ = (const LAS v4u*)(wl + GA_XQ + ((eb[ST][QD] >> 14) & 3u) * 1024 + l16 * 64); int d_ = 0; \
                _Pragma("unroll") for (int k_ = 0; k_ < 4; ++k_) { const v4u x_ = xp_[k_], r_ = rb[ST][QD][k_]; \
                    d_ = __builtin_amdgcn_sdot4((int)x_.x, (int)r_.x, d_, false); d_ = __builtin_amdgcn_sdot4((int)x_.y, (int)r_.y, d_, false); \
                    d_ = __builtin_amdgcn_sdot4((int)x_.z, (int)r_.z, d_, false); d_ = __builtin_amdgcn_sdot4((int)x_.w, (int)r_.w, d_, false); } \
                d_ += dppi<0xB1>(d_); d_ += dppi<0x4E>(d_); d_ += dppi<0x141>(d_); d_ += dppi<0x140>(d_); \
                if (l16 == 0) hbuf[(Q_) * 4 + grp] = d_; } while (0)
            GA_ULOAD(0, 0, 0); GA_ULOAD(0, 1, 1);
            for (int q2 = 0; q2 < 128; q2 += 4) {
                GA_ULOAD(1, 0, q2 + 2); GA_ULOAD(1, 1, q2 + 3);
                __builtin_amdgcn_sched_barrier(0);
                GA_UDOT(0, 0, q2); GA_UDOT(0, 1, q2 + 1);
                __builtin_amdgcn_sched_barrier(0);
                if (q2 + 4 < 128) { GA_ULOAD(0, 0, q2 + 4); GA_ULOAD(0, 1, q2 + 5); }
                __builtin_amdgcn_sched_barrier(0);
                GA_UDOT(1, 0, q2 + 2); GA_UDOT(1, 1, q2 + 3);
                __builtin_amdgcn_sched_barrier(0);
            }
#undef GA_ULOAD
#undef GA_UDOT
            asm volatile("s_waitcnt lgkmcnt(0)" ::: "memory");
#pragma unroll 2
            for (int it = 0; it < 8; ++it) { const int p = it * 64 + lane;
                const unsigned e_ = ents[p]; const float g_ = *(const LAS float*)(wl + 2048 + p * 4); const int hs = hbuf[p];
                const int ex_ = (int)(e_ & (NEXP - 1)), tk_ = (int)(e_ >> 14) & 3;
                const float sxl = tk_ == 0 ? sx[0] : (tk_ == 1 ? sx[1] : (tk_ == 2 ? sx[2] : sx[3]));
                const float h_ = (float)hs * (SU[ex_] * sxl);
                act[p] = 0.5f * h_ * (1.f + erff(h_ * 0.70710678118654752f)) * g_ * SV[ex_]; }
        }
        asm volatile("s_waitcnt lgkmcnt(0)" ::: "memory");
        float y[4][16];
#pragma unroll
        for (int tk = 0; tk < 4; ++tk) {
#pragma unroll
            for (int i = 0; i < 16; ++i) y[tk][i] = 0.f; }
#define GA_AXPY(V, A, TK) do { \
            _Pragma("unroll") for (int q_ = 0; q_ < 4; ++q_) { const int w_ = (int)(V)[q_]; const f32x2 lo_ = __builtin_amdgcn_cvt_pk_f32_fp8(w_, false), hi_ = __builtin_amdgcn_cvt_pk_f32_fp8(w_, true); \
                y[TK][4 * q_] += (A) * lo_.x; y[TK][4 * q_ + 1] += (A) * lo_.y; y[TK][4 * q_ + 2] += (A) * hi_.x; y[TK][4 * q_ + 3] += (A) * hi_.y; } } while (0)
        for (int ch = 0; ch < 8; ++ch) {
            const unsigned ent = *(const LAS unsigned*)(wl + (ch * 64 + lane) * 4);
            const float areg = act[ch * 64 + lane];
            v4u vb[2][8]; int eb[2][8];
#pragma unroll
            for (int q = 0; q < 8; ++q) { eb[0][q] = __builtin_amdgcn_readlane((int)ent, q); vb[0][q] = *(const GAS v4u*)(VQ + (size_t)(eb[0][q] & (NEXP - 1)) * DM + lane * 16); }
#pragma unroll
            for (int jb = 0; jb < 8; ++jb) {
                if (jb + 1 < 8) {
#pragma unroll
                    for (int q = 0; q < 8; ++q) { eb[(jb + 1) & 1][q] = __builtin_amdgcn_readlane((int)ent, 8 * (jb + 1) + q); vb[(jb + 1) & 1][q] = *(const GAS v4u*)(VQ + (size_t)(eb[(jb + 1) & 1][q] & (NEXP - 1)) * DM + lane * 16); } }
                __builtin_amdgcn_sched_barrier(0);
#pragma unroll
                for (int q = 0; q < 8; ++q) { const int tk_ = (eb[jb & 1][q] >> 14) & 3; const v4u v_ = vb[jb & 1][q]; const float a_ = rdlane(areg, 8 * jb + q);
                    if (tk_ == 0) GA_AXPY(v_, a_, 0); else if (tk_ == 1) GA_AXPY(v_, a_, 1); else if (tk_ == 2) GA_AXPY(v_, a_, 2); else GA_AXPY(v_, a_, 3); }
                __builtin_amdgcn_sched_barrier(0);
            }
        }
#undef GA_AXPY
#pragma unroll
        for (int tk = 0; tk < 4; ++tk) {
            float* hrow = F.out + (size_t)(4 * tg + tk) * DM + lane * 16;
            float hv[16]; float ss = 0.f;
#pragma unroll
            for (int q = 0; q < 4; ++q) { const f32x4 h4 = *(const GAS f32x4*)(hrow + 4 * q);
#pragma unroll
                for (int i = 0; i < 4; ++i) { const float v = h4[i] + y[tk][4 * q + i]; hv[4 * q + i] = v; ss += v * v; } }
            const float rstd = frsq(wave_sum(ss) * (1.f / DM) + RMS_EPS);
#pragma unroll
            for (int q = 0; q < 4; ++q) { const f32x4 n4 = *(const GAS f32x4*)(nf + lane * 16 + 4 * q);
                *(GAS f32x4*)(outp + (size_t)(4 * tg + tk) * DM + lane * 16 + 4 * q) = (f32x4){hv[4 * q] * rstd * n4[0], hv[4 * q + 1] * rstd * n4[1], hv[4 * q + 2] * rstd * n4[2], hv[4 * q + 3] * rstd * n4[3]}; }
        }
    }
}

struct Args { const float* in[21]; float* out; unsigned char* ws; int ph_lo, ph_hi; };
static_assert(sizeof(Args) == 21 * 8 + 8 + 8 + 8, "Args has no padding");

__global__ void __launch_bounds__(NTHREADS, 2) fwd_kernel(Args args) {
    extern __shared__ __attribute__((aligned(16))) unsigned char lds[];
    Frame F;
    F.lds = (LAS unsigned char*)lds;
    F.MISC = (volatile LAS unsigned*)(F.lds + MISC_OFF);
    F.tid = threadIdx.x; F.lane = F.tid & 63; F.wave = __builtin_amdgcn_readfirstlane(F.tid >> 6);
    F.G = gridDim.x; F.wg = blockIdx.x;
#pragma unroll
    for (int i = 0; i < 21; ++i) F.in[i] = args.in[i];
    F.out = args.out; F.ws = args.ws;
    F.ctl = (gu32*)(args.ws + WS_CTL);
    for (int u = F.tid; u < (LDS_BYTES - LDSCTL_OFF) / 4; u += NTHREADS) ((LAS unsigned*)(F.lds + LDSCTL_OFF))[u] = 0u;
    __syncthreads();
    const int lo = args.ph_lo, hi = args.ph_hi;
    const bool fused = (hi - lo) > 1;
    XcdBarrier bar; bar.bar = (unsigned*)(F.ctl + CW_BAR); bar.x = 0; bar.st = nullptr;
    if (fused) bar = xcd_barrier_post((unsigned*)(F.ctl + CW_BAR), F.MISC + 8);
#define IN(k) (lo <= (k) && (k) < hi)
#define REPS(k) (((REP_MASK >> (k)) & 1) ? 2 : 1)
#define REPLOOP(k) for (int rep_ = 0; rep_ < REPS(k); ++rep_, (rep_ < REPS(k) ? xcd_barrier(bar) : (void)0))
#define SEAM(k) do { if (IN(k) && IN((k) + 1)) xcd_barrier(bar); } while (0)

    if (IN(0)) { REPLOOP(0) { p0_prologue(F); p0_rope_table(F); } SEAM(0); }
    if (IN(1)) { REPLOOP(1) {
        pg8::Gemm g{(const bf16*)(F.ws + WS_XN), (const bf16*)(F.ws + WS_WIN), T, IN_COLS, DM}; pg8::StaticOrder S; S.init(T, IN_COLS, F.G, F.wg);
        pg8::EpiBf16 E{(bf16*)(F.ws + WS_Z), IN_COLS};
        pg8::gemm_phase<pg8::EpiBf16, pg8::StaticOrder, true, true>(F.lds + RING_OFF, g, S, E); }
        SEAM(1);
    }
    if (IN(2)) { p2_rope(F); REPLOOP(2) { const int cnt = r13_count(F.wg, F.G); R1Pre P;
            if (cnt > 0) rwkv_r1_prefetch(F, r13_item(F.wg, F.G, 0), F.tid, P);
            bf16x8 bfr[4]; int hcur = -1;
            for (int i = 0; i < cnt; ++i) { const int it = r13_item(F.wg, F.G, i), hh_ = (it >> 7) & 7;
                if (hh_ != hcur) { r1_load_bfrag(F, hh_, F.wave, F.lane, bfr); hcur = hh_; }
                rwkv_r1_item(F, it, i + 1 < cnt ? r13_item(F.wg, F.G, i + 1) : -1, P, bfr); } }
        SEAM(2); }
    if (IN(3)) { REPLOOP(3) p3_mixers(F); SEAM(3); }
    if (IN(4)) { REPLOOP(4) { const int cnt = r13_count(F.wg, F.G); R3Pre P;
            if (cnt > 0) rwkv_r3_prefetch(F, r13_item(F.wg, F.G, 0), F.tid, P);
            bf16x8 bfr[8]; int hcur = -1;
            for (int i = 0; i < cnt; ++i) { const int it = r13_item(F.wg, F.G, i), hh_ = (it >> 7) & 7;
                if (hh_ != hcur) { r3_load_bfrag(F, hh_, F.wave, F.lane, bfr); hcur = hh_; }
                rwkv_r3_item(F, it, i + 1 < cnt ? r13_item(F.wg, F.G, i + 1) : -1, P, bfr); } }
        SEAM(4); }
    if (IN(5)) {
        pg8::Gemm g{(const bf16*)(F.ws + WS_YMIX), (const bf16*)(F.ws + WS_WOUT), T, DM, DM}; pg8::StaticOrder S; S.init(T, DM, F.G, F.wg);
        pg8::EpiF32Res E{F.in[0], F.out, DM, (bf16*)(F.ws + WS_XN), F.in[15], (float*)(F.ws + WS_SSQ)};
        pg8::gemm_phase<pg8::EpiF32Res, pg8::StaticOrder, true, true>(F.lds + RING_OFF, g, S, E);
        SEAM(5);
    }
    if (IN(6)) { REPLOOP(6) {
        pg8::Gemm g{(const bf16*)(F.ws + WS_XN), (const bf16*)(F.ws + WS_WQ), T, PQ, DM}; pg8::StaticOrder S; S.init(T, PQ, F.G, F.wg);
        pg8::EpiBf16Rs E{(bf16*)(F.ws + WS_QP), PQ, (const float*)(F.ws + WS_SSQ)};
        pg8::gemm_phase<pg8::EpiBf16Rs, pg8::StaticOrder, true, true>(F.lds + RING_OFF, g, S, E); }
        SEAM(6);
    }
    if (IN(7)) { REPLOOP(7) p7_topk(F); SEAM(7); }
    if (IN(8)) { if (REPS(8) > 1) { p8_gather(F, (float*)(F.ws + WS_Z)); xcd_barrier(bar); } p8_gather(F, F.out); }
#undef IN
#undef SEAM
}

extern "C" void kernel_launch(void* const* d_in, const int* in_sizes, int n_in, void* d_out, int out_size, void* d_ws, size_t ws_size, hipStream_t stream) {
    static int grid = 0;
    if (grid == 0) {
        if (n_in != 21 || in_sizes[0] != T * DM || out_size != T * DM || ws_size < WS_END) {
            fprintf(stderr, "kernel_launch: unexpected shapes: n_in %d in0 %d out %d ws %zu (need %zu); nothing launched\n", n_in, n_in > 0 ? in_sizes[0] : -1, out_size, ws_size, (size_t)WS_END); grid = -1; return; }
        int dev = 0, cus = 0, per_cu = 0;
        if (hipGetDevice(&dev) != hipSuccess || hipDeviceGetAttribute(&cus, hipDeviceAttributeMultiprocessorCount, dev) != hipSuccess) { grid = -1; return; }
        if (hipFuncSetAttribute((const void*)fwd_kernel, hipFuncAttributeMaxDynamicSharedMemorySize, LDS_BYTES) != hipSuccess) { fprintf(stderr, "kernel_launch: hipFuncSetAttribute failed\n"); grid = -1; return; }
        if (hipOccupancyMaxActiveBlocksPerMultiprocessor(&per_cu, (const void*)fwd_kernel, NTHREADS, LDS_BYTES) != hipSuccess || per_cu < 1) { fprintf(stderr, "kernel_launch: occupancy query says %d\n", per_cu); per_cu = 1; }
        (void)hipGetLastError();
        grid = cus;
    }
    if (grid < 0) return;
    (void)hipMemsetAsync((char*)d_ws + WS_CTL, 0, CTL_ZERO_BYTES, stream);
    Args a{};
    for (int i = 0; i < 21; ++i) a.in[i] = (const float*)d_in[i];
    a.out = (float*)d_out; a.ws = (unsigned char*)d_ws;
    if (MK_N_LAUNCHES == 1) {
        a.ph_lo = 0; a.ph_hi = NPHASE;
        void* kargs[] = {&a};
        hipError_t e = hipLaunchCooperativeKernel((const void*)fwd_kernel, dim3(grid), dim3(NTHREADS), kargs, LDS_BYTES, stream);
        if (e != hipSuccess) fprintf(stderr, "kernel_launch: cooperative launch failed: %s (grid %d)\n", hipGetErrorString(e), grid);
    } else {
        for (int p = 0; p < NPHASE; ++p) { a.ph_lo = p; a.ph_hi = p + 1;
            hipLaunchKernelGGL(fwd_kernel, dim3(grid), dim3(NTHREADS), LDS_BYTES, stream, a); }
    }
}
```

```cpp
#include <hip/hip_runtime.h>
#include <cstdio>
#include <cstdint>

#ifndef MK_N_LAUNCHES
#define MK_N_LAUNCHES 1
#endif

#ifndef REP_MASK
#define REP_MASK 0
#endif
#define GAS __attribute__((address_space(1)))
#define LAS __attribute__((address_space(3)))
typedef unsigned short bf16;
typedef unsigned v4u __attribute__((ext_vector_type(4)));
typedef unsigned v2u __attribute__((ext_vector_type(2)));
typedef float f32x4 __attribute__((ext_vector_type(4)));
typedef float f32x2 __attribute__((ext_vector_type(2)));
typedef short bf16x8 __attribute__((ext_vector_type(8)));
typedef GAS unsigned gu32;
#define RLX_AGENT __ATOMIC_RELAXED, __HIP_MEMORY_SCOPE_AGENT
#define LDS_WAIT() asm volatile("s_waitcnt lgkmcnt(0)" ::: "memory")
#define VM_WAIT() asm volatile("s_waitcnt vmcnt(0)" ::: "memory")
#define LDS_BARRIER() do { asm volatile("s_waitcnt lgkmcnt(0)" ::: "memory"); __builtin_amdgcn_s_barrier(); asm volatile("" ::: "memory"); } while (0)

constexpr int DM = 1024, NB = 4, SEQ = 8192, T = NB * SEQ;
constexpr int HD = 64, RWW = 512, NHR = 8, NHA = 8;
constexpr int IN_COLS = 3328;
constexpr int C_R = 0, C_K = 512, C_V = 1024, C_WD = 1536, C_AD = 1600, C_GD = 1664, C_AQ = 1792, C_AK = 2304, C_AV = 2816;
constexpr int PHEADS = 8, NKEYS = 128, PQ = 2048, TOPK = 16, NEXP = 16384;
constexpr float RMS_EPS = 1e-6f, GN_EPS = 64e-5f;
constexpr int NWAVES = 8, NTHREADS = 512;
constexpr int NPHASE = 9;

constexpr size_t MiB = 1u << 20;
constexpr size_t WS_CTL = 0, CTL_ZERO_BYTES = 1 * MiB;
constexpr size_t WS_WIN = 2 * MiB;
constexpr size_t WS_WOUT = 10 * MiB;
constexpr size_t WS_WQ = 12 * MiB;
constexpr size_t WS_XN = 16 * MiB;
constexpr size_t WS_Z = 80 * MiB;
constexpr size_t WS_QP = 80 * MiB;
constexpr size_t WS_G = 288 * MiB;
constexpr size_t WS_YMIX = 352 * MiB;
constexpr size_t WS_UQ = 416 * MiB;
constexpr size_t WS_VQ = 432 * MiB;
constexpr size_t WS_SU = 448 * MiB;
constexpr size_t WS_SV = 449 * MiB;
constexpr size_t WS_EID = 480 * MiB;
constexpr size_t WS_GATE = 496 * MiB;
constexpr size_t WS_SSEG = 450 * MiB;
constexpr size_t WS_PQ = 456 * MiB;
constexpr size_t WS_END = 512 * MiB;
constexpr size_t WS_WUPT = 1 * MiB, WS_AUPT = WS_WUPT + 65536, WS_GUPT = WS_AUPT + 65536;
constexpr size_t WS_BONUS = 9 * MiB;
constexpr size_t WS_RWY0 = WS_XN;
constexpr size_t WS_RWSS = WS_G;
constexpr size_t WS_RWRH = WS_EID;

constexpr int CW_BAR = 4096;
constexpr size_t WS_SSQ = 256 * 1024;

typedef __bf16 hbf16x2_t __attribute__((ext_vector_type(2)));
__device__ __forceinline__ unsigned pk2(float lo, float hi) { const f32x2 v = {lo, hi}; const hbf16x2_t b = __builtin_convertvector(v, hbf16x2_t); return __builtin_bit_cast(unsigned, b); }
__device__ __forceinline__ unsigned f2bf(float f) { return pk2(f, 0.f) & 0xffffu; }
__device__ __forceinline__ float frcp(float x) { return __builtin_amdgcn_rcpf(x); }
__device__ __forceinline__ float frsq(float x) { return __builtin_amdgcn_rsqf(x); }
__device__ __forceinline__ float bflo(unsigned u) { return __builtin_bit_cast(float, u << 16); }
__device__ __forceinline__ float bfhi(unsigned u) { return __builtin_bit_cast(float, u & 0xffff0000u); }
__device__ __forceinline__ float bf2f(bf16 h) { return __builtin_bit_cast(float, (unsigned)h << 16); }

template <int CTRL> __device__ __forceinline__ float dppf(float x) { return __builtin_bit_cast(float, __builtin_amdgcn_update_dpp(0, __builtin_bit_cast(int, x), CTRL, 0xF, 0xF, true)); }
template <int CTRL> __device__ __forceinline__ int dppi(int x) { return __builtin_amdgcn_update_dpp(0, x, CTRL, 0xF, 0xF, true); }
__device__ __forceinline__ float rdlane(float v, int l) { return __builtin_bit_cast(float, __builtin_amdgcn_readlane(__builtin_bit_cast(int, v), l)); }
__device__ __forceinline__ float sum8(float v) { v += dppf<0xB1>(v); v += dppf<0x4E>(v); v += dppf<0x141>(v); return v; }
__device__ __forceinline__ float sum16(float v) { v = sum8(v); v += dppf<0x140>(v); return v; }
__device__ __forceinline__ float wave_sum(float v) { v = sum16(v);
    v += __builtin_bit_cast(float, __builtin_amdgcn_update_dpp(0, __builtin_bit_cast(int, v), 0x142, 0xA, 0xF, false));
    v += __builtin_bit_cast(float, __builtin_amdgcn_update_dpp(0, __builtin_bit_cast(int, v), 0x143, 0xC, 0xF, false));
    return rdlane(v, 63); }
__device__ __forceinline__ float wave_max(float v) {
    v = fmaxf(v, dppf<0xB1>(v)); v = fmaxf(v, dppf<0x4E>(v)); v = fmaxf(v, dppf<0x141>(v)); v = fmaxf(v, dppf<0x140>(v));
    return fmaxf(fmaxf(rdlane(v, 0), rdlane(v, 16)), fmaxf(rdlane(v, 32), rdlane(v, 48)));
}
__device__ __forceinline__ int wave_min_i(int v) {
    v = min(v, dppi<0xB1>(v)); v = min(v, dppi<0x4E>(v)); v = min(v, dppi<0x141>(v)); v = min(v, dppi<0x140>(v));
    return min(min(__builtin_amdgcn_readlane(v, 0), __builtin_amdgcn_readlane(v, 16)), min(__builtin_amdgcn_readlane(v, 32), __builtin_amdgcn_readlane(v, 48)));
}

namespace pg8 {
#define PG8_LAS __attribute__((address_space(3)))
typedef unsigned short bf16_t;
typedef unsigned u32x4 __attribute__((ext_vector_type(4)));
constexpr int BM = 256, BK = 64, HALF = 128, HTB = HALF * BK * 2, STAGE_BYTES = 8 * HTB, NXCD = 8, WGM = 8;
__host__ __device__ __forceinline__ int lds_byte(int r, int c) { const int st = (r >> 4) * 2 + (c >> 5), rr = r & 15, cc = c & 31, ob = rr * 64 + cc * 2; return st * 1024 + (ob ^ (((ob >> 9) & 1) << 5)); }
__host__ __device__ __forceinline__ void stage_rc(int b, int& R, int& C) { const int st = b / 1024, sb = b % 1024, swz = sb ^ (((sb >> 9) & 1) << 5); R = (st >> 1) * 16 + swz / 64; C = (st & 1) * 32 + (swz % 64) / 2; }
__host__ __device__ __forceinline__ int perm32(int rho) { const int n = rho >> 4, i = rho & 15; return 8 * (i >> 2) + 4 * n + (i & 3); }
struct Unit { int pm, pn; };
struct Gemm { const bf16_t* A; const bf16_t* Bt; int M, N, K; };
struct StaticOrder {
    int nM, nN, nwg, G, c;
    __host__ __device__ void init(int M, int N, int G_, int c_) { nM = M / BM; nN = N / BM; nwg = nM * nN; G = G_; c = c_; }
    __host__ __device__ bool next(int i, Unit& u) const {
        const long L = (long)i * G + c; if (L >= nwg) return false;
        int wgid = (int)L; { const int q = nwg / NXCD, r = nwg % NXCD, xcd = wgid % NXCD, off = wgid / NXCD; wgid = (xcd < r ? xcd * (q + 1) : r * (q + 1) + (xcd - r) * q) + off; }
        const int nig = WGM * nN, gid = wgid / nig, fm = gid * WGM, gsz = (nM - fm) < WGM ? (nM - fm) : WGM;
        u.pm = fm + ((wgid % nig) % gsz); u.pn = (wgid % nig) / gsz; return true;
    }
    __device__ __forceinline__ void a_ready(const Unit&) const {}
    __device__ __forceinline__ void done(const Unit&) const {}
};
__device__ __forceinline__ unsigned cvt_pk_bf16(float lo, float hi) { unsigned r; asm volatile("v_cvt_pk_bf16_f32 %0, %1, %2" : "=v"(r) : "v"(lo), "v"(hi)); return r; }
struct EpiBf16 {
    static constexpr bool PERM = true, AFTER_DRAIN = false;
    bf16_t* O; int ldc;
    __device__ __forceinline__ void operator()(const f32x4 (&acc)[2][2][4][2], const Unit& u, int wr, int wc, int fr, int fq) const {
        const int row0 = u.pm * BM + wr * 64 + fr; const int col0 = u.pn * BM + wc * 32 + 8 * fq;
#pragma unroll
        for (int ai = 0; ai < 2; ++ai)
#pragma unroll
            for (int m = 0; m < 4; ++m) { bf16_t* rowp = O + (size_t)(row0 + ai * HALF + m * 16) * ldc + col0;
#pragma unroll
                for (int bj = 0; bj < 2; ++bj) { const f32x4 v0 = acc[ai][bj][m][0], v1 = acc[ai][bj][m][1];
                    u32x4 w; w.x = cvt_pk_bf16(v0[0], v0[1]); w.y = cvt_pk_bf16(v0[2], v0[3]); w.z = cvt_pk_bf16(v1[0], v1[1]); w.w = cvt_pk_bf16(v1[2], v1[3]);
                    *(u32x4*)(rowp + bj * HALF) = w; } }
    }
};
struct EpiF32Res {
    static constexpr bool PERM = true, AFTER_DRAIN = false;
    const float* res; float* O; int ldc; bf16_t* HG; const float* gain; float* ssq;
    __device__ __forceinline__ void operator()(const f32x4 (&acc)[2][2][4][2], const Unit& u, int wr, int wc, int fr, int fq) const {
        const int row0 = u.pm * BM + wr * 64 + fr; const int col0 = u.pn * BM + wc * 32 + 8 * fq;
        f32x4 gv[2][2];
#pragma unroll
        for (int bj = 0; bj < 2; ++bj) { gv[bj][0] = *(const f32x4*)(gain + col0 + bj * HALF); gv[bj][1] = *(const f32x4*)(gain + col0 + bj * HALF + 4); }
#pragma unroll
        for (int ai = 0; ai < 2; ++ai)
#pragma unroll
            for (int m = 0; m < 4; ++m) { const int row = row0 + ai * HALF + m * 16; const size_t off = (size_t)row * ldc + col0; float sq = 0.f;
#pragma unroll
                for (int bj = 0; bj < 2; ++bj) { const f32x4 r0 = *(const f32x4*)(res + off + bj * HALF), r1 = *(const f32x4*)(res + off + bj * HALF + 4);
                    const f32x4 h0 = acc[ai][bj][m][0] + r0, h1 = acc[ai][bj][m][1] + r1;
                    *(f32x4*)(O + off + bj * HALF) = h0; *(f32x4*)(O + off + bj * HALF + 4) = h1;
                    sq += (h0[0] * h0[0] + h0[1] * h0[1]) + (h0[2] * h0[2] + h0[3] * h0[3]) + (h1[0] * h1[0] + h1[1] * h1[1]) + (h1[2] * h1[2] + h1[3] * h1[3]);
                    const f32x4 g0 = gv[bj][0], g1 = gv[bj][1];
                    u32x4 w; w.x = cvt_pk_bf16(h0[0] * g0[0], h0[1] * g0[1]); w.y = cvt_pk_bf16(h0[2] * g0[2], h0[3] * g0[3]); w.z = cvt_pk_bf16(h1[0] * g1[0], h1[1] * g1[1]); w.w = cvt_pk_bf16(h1[2] * g1[2], h1[3] * g1[3]);
                    *(u32x4*)(HG + off + bj * HALF) = w; }
                sq += __shfl_xor(sq, 16); sq += __shfl_xor(sq, 32);
                if (fq == 0) atomicAdd(ssq + row, sq); }
    }
};
struct EpiBf16Rs {
    static constexpr bool PERM = true, AFTER_DRAIN = false;
    bf16_t* O; int ldc; const float* ssq;
    __device__ __forceinline__ void operator()(const f32x4 (&acc)[2][2][4][2], const Unit& u, int wr, int wc, int fr, int fq) const {
        const int row0 = u.pm * BM + wr * 64 + fr; const int col0 = u.pn * BM + wc * 32 + 8 * fq;
#pragma unroll
        for (int ai = 0; ai < 2; ++ai)
#pragma unroll
            for (int m = 0; m < 4; ++m) { const int row = row0 + ai * HALF + m * 16; bf16_t* rowp = O + (size_t)row * ldc + col0;
                const float rs = __builtin_amdgcn_rsqf(ssq[row] * (1.f / 1024.f) + 1e-6f);
#pragma unroll
                for (int bj = 0; bj < 2; ++bj) { const f32x4 v0 = acc[ai][bj][m][0] * rs, v1 = acc[ai][bj][m][1] * rs;
                    u32x4 w; w.x = cvt_pk_bf16(v0[0], v0[1]); w.y = cvt_pk_bf16(v0[2], v0[3]); w.z = cvt_pk_bf16(v1[0], v1[1]); w.w = cvt_pk_bf16(v1[2], v1[3]);
                    *(u32x4*)(rowp + bj * HALF) = w; } }
    }
};

template <class Epi, class Sched, bool ALIGN_EPI = false, bool SP2 = false>
__device__ __forceinline__ void gemm_phase(PG8_LAS unsigned char* lds, const Gemm g, const Sched& S, const Epi& E) {
    const int tid = threadIdx.x, wid = __builtin_amdgcn_readfirstlane(tid >> 6), lane = tid & 63, wr = wid >> 2, wc = wid & 3, fr = lane & 15, fq = lane >> 4;
    const int K = g.K, nt = K / BK;
    unsigned voffA[2], voffB[2];
#pragma unroll
    for (int i = 0; i < 2; ++i) { int R, C; stage_rc(tid * 16 + i * 8192, R, C); const int Rb = Epi::PERM ? ((R & ~31) + perm32(R & 31)) : R;
        voffA[i] = (unsigned)(R * K + C) * 2u; voffB[i] = (unsigned)(Rb * K + C) * 2u; }
    const size_t kstep = (size_t)(BK * 2);
    const size_t hstep = (size_t)HALF * K * 2;
    const size_t tstep = 2 * hstep;
    const unsigned ldsw = (unsigned)wid * 1024u;
    const int aoff = lds_byte(wr * 64 + fr, fq * 8), boff = lds_byte(wc * 32 + fr, fq * 8);
#define PG8_SA(b, h) (((b) * 2 + (h)) * HTB)
#define PG8_SB(b, h) ((4 + (b) * 2 + (h)) * HTB)
#define PG8_STAGE(bufoff, gbase, voff) do { _Pragma("unroll") for (int _i = 0; _i < 2; ++_i) \
        __builtin_amdgcn_global_load_lds((const unsigned*)((const char*)(gbase) + (voff)[_i]), (PG8_LAS unsigned*)(lds + (bufoff) + ldsw + _i * 8192), 16, 0, 0); } while (0)
#define PG8_LDA(dst, b, h) do { _Pragma("unroll") for (int m = 0; m < 4; ++m) _Pragma("unroll") for (int k = 0; k < 2; ++k) dst[m][k] = *(const PG8_LAS bf16x8*)(lds + PG8_SA(b, h) + aoff + m * 2048 + k * 1024); } while (0)
#define PG8_LDB(dst, b, h) do { _Pragma("unroll") for (int n = 0; n < 2; ++n) _Pragma("unroll") for (int k = 0; k < 2; ++k) dst[n][k] = *(const PG8_LAS bf16x8*)(lds + PG8_SB(b, h) + boff + n * 2048 + k * 1024); } while (0)
#define PG8_MMA(ai, bj, At, Bt) do { __builtin_amdgcn_s_setprio(1); _Pragma("unroll") for (int m = 0; m < 4; ++m) _Pragma("unroll") for (int n = 0; n < 2; ++n) _Pragma("unroll") for (int k = 0; k < 2; ++k) \
        acc[ai][bj][m][n] = __builtin_amdgcn_mfma_f32_16x16x32_bf16(Bt[n][k], At[m][k], acc[ai][bj][m][n], 0, 0, 0); __builtin_amdgcn_s_setprio(0); } while (0)
#define PG8_WAIT_V(n) asm volatile("s_waitcnt vmcnt(" #n ")" ::: "memory")
#define PG8_WAIT_L(n) asm volatile("s_waitcnt lgkmcnt(" #n ")" ::: "memory")
#define PG8_BAR __builtin_amdgcn_s_barrier()
#define PG8_SCHED __builtin_amdgcn_sched_barrier(0)
    Unit cur, nxt; int ui = 0;
    if (!S.next(0, cur)) return;
    f32x4 acc[2][2][4][2];
#pragma unroll
    for (int a = 0; a < 2; ++a)
#pragma unroll
        for (int b = 0; b < 2; ++b)
#pragma unroll
            for (int m = 0; m < 4; ++m)
#pragma unroll
                for (int n = 0; n < 2; ++n) acc[a][b][m][n] = (f32x4){0.f, 0.f, 0.f, 0.f};
    bf16x8 At[4][2], B0[2][2], B1[2][2];
    const char* cA = (const char*)g.A + (size_t)cur.pm * tstep; const char* cB = (const char*)g.Bt + (size_t)cur.pn * tstep;
    S.a_ready(cur);
    if constexpr (SP2) {
        PG8_STAGE(PG8_SB(0, 0), cB, voffB); PG8_STAGE(PG8_SB(0, 1), cB + hstep, voffB); PG8_STAGE(PG8_SA(0, 0), cA, voffA); PG8_STAGE(PG8_SA(0, 1), cA + hstep, voffA);
        if (wr == 1) PG8_BAR;
        PG8_WAIT_V(2); PG8_BAR;
        PG8_STAGE(PG8_SB(1, 0), cB + kstep, voffB); PG8_STAGE(PG8_SA(1, 0), cA + kstep, voffA); PG8_STAGE(PG8_SB(1, 1), cB + hstep + kstep, voffB);
        PG8_WAIT_V(6); PG8_BAR;
    } else {
        PG8_STAGE(PG8_SB(0, 0), cB, voffB); PG8_STAGE(PG8_SA(0, 0), cA, voffA); PG8_STAGE(PG8_SB(0, 1), cB + hstep, voffB); PG8_STAGE(PG8_SA(0, 1), cA + hstep, voffA);
        if (wr == 1) PG8_BAR;
        PG8_WAIT_V(4); PG8_BAR;
        PG8_STAGE(PG8_SB(1, 0), cB + kstep, voffB); PG8_STAGE(PG8_SA(1, 0), cA + kstep, voffA); PG8_STAGE(PG8_SB(1, 1), cB + hstep + kstep, voffB);
        PG8_WAIT_V(6); PG8_BAR;
    }
    for (;;) {
        const bool has_next = S.next(ui + 1, nxt);
        const char* nA = has_next ? (const char*)g.A + (size_t)nxt.pm * tstep : cA; const char* nB = has_next ? (const char*)g.Bt + (size_t)nxt.pn * tstep : cB;
        for (int t = 0; t < nt; t += 2) {
            const bool last = (t == nt - 2);
            const char* a1 = cA + (size_t)(t + 1) * kstep;
            const char* a2 = last ? nA : cA + (size_t)(t + 2) * kstep; const char* b2 = last ? nB : cB + (size_t)(t + 2) * kstep;
            const char* a3 = a2 + kstep; const char* b3 = b2 + kstep;
            if (last && has_next) S.a_ready(nxt);
            if constexpr (SP2) {
            PG8_LDB(B0, 0, 0); PG8_LDB(B1, 0, 1); PG8_SCHED; PG8_LDA(At, 0, 0); PG8_STAGE(PG8_SA(1, 1), a1 + hstep, voffA);
            PG8_WAIT_V(8); PG8_WAIT_L(0); PG8_BAR; PG8_MMA(0, 0, At, B0); PG8_MMA(0, 1, At, B1); PG8_BAR; PG8_SCHED;
            PG8_LDA(At, 0, 1); PG8_STAGE(PG8_SB(0, 0), b2, voffB); PG8_STAGE(PG8_SB(0, 1), b2 + hstep, voffB); PG8_STAGE(PG8_SA(0, 0), a2, voffA);
            PG8_WAIT_V(8); PG8_WAIT_L(0); PG8_BAR; PG8_MMA(1, 0, At, B0); PG8_MMA(1, 1, At, B1); PG8_BAR; PG8_SCHED;
            PG8_LDB(B0, 1, 0); PG8_LDB(B1, 1, 1); PG8_SCHED; PG8_LDA(At, 1, 0); PG8_STAGE(PG8_SA(0, 1), a2 + hstep, voffA);
            PG8_WAIT_V(8); PG8_WAIT_L(0); PG8_BAR; PG8_MMA(0, 0, At, B0); PG8_MMA(0, 1, At, B1); PG8_BAR; PG8_SCHED;
            PG8_LDA(At, 1, 1); PG8_STAGE(PG8_SB(1, 0), b3, voffB); PG8_STAGE(PG8_SB(1, 1), b3 + hstep, voffB); PG8_STAGE(PG8_SA(1, 0), a3, voffA);
            PG8_WAIT_V(8); PG8_WAIT_L(0); PG8_BAR; PG8_MMA(1, 0, At, B0); PG8_MMA(1, 1, At, B1); PG8_BAR; PG8_SCHED;
            } else {
            PG8_LDB(B0, 0, 0); PG8_SCHED; PG8_LDA(At, 0, 0); PG8_STAGE(PG8_SA(1, 1), a1 + hstep, voffA);
            PG8_WAIT_L(8); PG8_BAR; PG8_WAIT_L(0); PG8_MMA(0, 0, At, B0); PG8_BAR; PG8_SCHED;
            PG8_LDB(B1, 0, 1); PG8_STAGE(PG8_SB(0, 0), b2, voffB);
            PG8_BAR; PG8_WAIT_L(0); PG8_MMA(0, 1, At, B1); PG8_BAR;
            PG8_LDA(At, 0, 1); PG8_STAGE(PG8_SA(0, 0), a2, voffA);
            PG8_BAR; PG8_WAIT_L(0); PG8_MMA(1, 0, At, B0); PG8_BAR; PG8_SCHED;
            PG8_STAGE(PG8_SB(0, 1), b2 + hstep, voffB);
            PG8_WAIT_V(6); PG8_BAR; PG8_MMA(1, 1, At, B1); PG8_BAR;
            PG8_LDB(B0, 1, 0); PG8_SCHED; PG8_LDA(At, 1, 0); PG8_STAGE(PG8_SA(0, 1), a2 + hstep, voffA);
            PG8_WAIT_L(8); PG8_BAR; PG8_WAIT_L(0); PG8_MMA(0, 0, At, B0); PG8_BAR; PG8_SCHED;
            PG8_LDB(B1, 1, 1); PG8_STAGE(PG8_SB(1, 0), b3, voffB);
            PG8_BAR; PG8_WAIT_L(0); PG8_MMA(0, 1, At, B1); PG8_BAR;
            PG8_LDA(At, 1, 1); PG8_STAGE(PG8_SA(1, 0), a3, voffA);
            PG8_BAR; PG8_WAIT_L(0); PG8_MMA(1, 0, At, B0); PG8_BAR; PG8_SCHED;
            PG8_STAGE(PG8_SB(1, 1), b3 + hstep, voffB);
            PG8_WAIT_V(6); PG8_BAR; PG8_MMA(1, 1, At, B1); PG8_BAR;
            }
        }
        if constexpr (ALIGN_EPI) { if (wr == 0) PG8_BAR; }
        if constexpr (!Epi::AFTER_DRAIN) { E(acc, cur, wr, wc, fr, fq); S.done(cur); }
        if (!has_next) break;
#pragma unroll
        for (int a = 0; a < 2; ++a)
#pragma unroll
            for (int b = 0; b < 2; ++b)
#pragma unroll
                for (int m = 0; m < 4; ++m)
#pragma unroll
                    for (int n = 0; n < 2; ++n) acc[a][b][m][n] = (f32x4){0.f, 0.f, 0.f, 0.f};
        cur = nxt; cA = nA; cB = nB; ++ui;
        if constexpr (ALIGN_EPI) { if (wr == 1) PG8_BAR; }
    }
    PG8_WAIT_V(0);
    if constexpr (!ALIGN_EPI) { if (wr == 0) PG8_BAR; }
    PG8_BAR;
#undef PG8_SA
#undef PG8_SB
#undef PG8_STAGE
#undef PG8_LDA
#undef PG8_LDB
#undef PG8_MMA
#undef PG8_WAIT_V
#undef PG8_WAIT_L
#undef PG8_BAR
#undef PG8_SCHED
}
}

#define XB_TMO      128
#define XB_XCNT(j)  (256  + 64 * (j))
#define XB_XSUB(j)  (1280 + 64 * (j))
#define XB_XGEN(j)  (2304 + 64 * (j))
#define XB_TOP      3328
#define XB_TOPGEN   3392
#define XCD_BAR_WORDS 3456
#define XB_SPIN_CAP (1u << 22)
__device__ __forceinline__ unsigned xb_ld(unsigned* p)              { return __hip_atomic_load(p, __ATOMIC_RELAXED, __HIP_MEMORY_SCOPE_AGENT); }
__device__ __forceinline__ unsigned xb_add(unsigned* p, unsigned v) { return __hip_atomic_fetch_add(p, v, __ATOMIC_RELAXED, __HIP_MEMORY_SCOPE_AGENT); }
__device__ __forceinline__ unsigned xb_xcc_id() { return (unsigned)__builtin_amdgcn_s_getreg((3 << 11) | 20) & 0xFu; }
#define XB_SPIN(cond, bar) do { unsigned _sp = 0; while (cond) { __builtin_amdgcn_s_sleep(1); \
    if ((++_sp & 255u) == 0u) { if (xb_ld(&(bar)[XB_TMO])) break; if (_sp > XB_SPIN_CAP) { atomicAdd(&(bar)[XB_TMO], 1u); break; } } } } while (0)
struct XcdBarrier { unsigned* bar; unsigned x; volatile LAS unsigned* st; };
__device__ __forceinline__ XcdBarrier xcd_barrier_post(unsigned* bar, volatile LAS unsigned* st) {
    XcdBarrier b; b.bar = bar; b.x = xb_xcc_id(); b.st = st;
    if (threadIdx.x == 0) (void)xb_add(&bar[XB_XCNT(b.x)], 1u);
    return b;
}
__device__ __forceinline__ void xcd_barrier_complete(unsigned* bar, unsigned x, unsigned& nloc, unsigned& nx) {
    const unsigned G = gridDim.x * gridDim.y * gridDim.z;
    unsigned sum, cnt, mine, sp = 0u;
    for (;;) {
        sum = 0u; cnt = 0u; mine = 0u;
#pragma unroll
        for (unsigned j = 0; j < 16; ++j) { const unsigned c = xb_ld(&bar[XB_XCNT(j)]); sum += c; cnt += (c > 0u) ? 1u : 0u; mine = (j == x) ? c : mine; }
        if (sum == G) break;
        __builtin_amdgcn_s_sleep(1);
        if ((++sp & 255u) == 0u) { if (xb_ld(&bar[XB_TMO])) break; if (sp > XB_SPIN_CAP) { atomicAdd(&bar[XB_TMO], 1u); break; } }
    }
    nloc = mine > 0u ? mine : 1u; nx = cnt > 0u ? cnt : 1u;
}
__device__ __forceinline__ void xcd_barrier(const XcdBarrier& b) {
    asm volatile("s_waitcnt vmcnt(0)" ::: "memory");
    __syncthreads();
    if (threadIdx.x == 0) {
        unsigned* bar = b.bar;
        __builtin_amdgcn_s_waitcnt(0);
        unsigned nloc = b.st[0], nx = b.st[1];
        if (nloc == 0u) { xcd_barrier_complete(bar, b.x, nloc, nx); b.st[0] = nloc; b.st[1] = nx; }
        const unsigned old = xb_add(&bar[XB_XSUB(b.x)], 1u);
        const unsigned gen = old / nloc;
        if (old + 1u == (gen + 1u) * nloc) {
            __builtin_amdgcn_fence(__ATOMIC_RELEASE, "agent");
            asm volatile("s_waitcnt vmcnt(0)" ::: "memory");
            const unsigned og = xb_add(&bar[XB_TOP], 1u);
            const unsigned tg = og / nx;
            if (og + 1u == (tg + 1u) * nx) xb_add(&bar[XB_TOPGEN], 1u);
            else XB_SPIN(xb_ld(&bar[XB_TOPGEN]) == tg, bar);
            __builtin_amdgcn_fence(__ATOMIC_ACQUIRE, "agent");
            xb_add(&bar[XB_XGEN(b.x)], 1u);
            asm volatile("s_waitcnt vmcnt(0)" ::: "memory");
        } else {
            XB_SPIN(xb_ld(&bar[XB_XGEN(b.x)]) == gen, bar);
            __builtin_amdgcn_fence(__ATOMIC_ACQUIRE, "agent");
            asm volatile("s_waitcnt vmcnt(0)" ::: "memory");
        }
    }
    __syncthreads();
}

constexpr int RING_OFF = 0, RING_BYTES = 131072;
constexpr int LDSCTL_OFF = 162816, MISC_OFF = LDSCTL_OFF + 320;
constexpr int LDS_BYTES = 163840;

struct Frame {
    LAS unsigned char* lds;
    volatile LAS unsigned* MISC;
    gu32* ctl;
    int tid, lane, wave, G, wg;
    const float* in[21];
    float* out;
    unsigned char* ws;
};

__device__ __forceinline__ void p0_transpose_item(const float* W, int K, int N, bf16* WT, LAS float* scr, int item, int lane) {
    const int nblk = N / 32, kb = item / nblk, nb = item % nblk, k0 = 64 * kb, n0 = 32 * nb;
#pragma unroll 8
    for (int i = 0; i < 32; ++i) { const int kk = 2 * i + (lane >> 5); scr[kk * 33 + (lane & 31)] = W[(size_t)(k0 + kk) * N + n0 + (lane & 31)]; }
    LDS_WAIT(); asm volatile("" ::: "memory");
    const int c = lane & 7;
#pragma unroll
    for (int j = 0; j < 4; ++j) { const int n = (lane >> 3) + 8 * j; const LAS float* s = scr + (8 * c) * 33 + n;
        v4u o; o.x = pk2(s[0 * 33], s[1 * 33]); o.y = pk2(s[2 * 33], s[3 * 33]); o.z = pk2(s[4 * 33], s[5 * 33]); o.w = pk2(s[6 * 33], s[7 * 33]);
        *(GAS v4u*)(WT + (size_t)(n0 + n) * K + k0 + 8 * c) = o; }
    LDS_WAIT(); asm volatile("" ::: "memory");
}
__device__ __forceinline__ void rms_row_to_bf16(int lane, const float* xrow, const float* gain, bf16* orow) {
    const GAS f32x4* xr = (const GAS f32x4*)xrow + lane;
    const GAS f32x4* gr = (const GAS f32x4*)gain + lane;
    f32x4 v[4]; float s = 0.f;
#pragma unroll
    for (int j = 0; j < 4; ++j) { v[j] = xr[64 * j]; s += (v[j].x * v[j].x + v[j].y * v[j].y) + (v[j].z * v[j].z + v[j].w * v[j].w); }
    const float rstd = frsq(wave_sum(s) * (1.f / DM) + RMS_EPS);
    GAS unsigned long long* o8 = (GAS unsigned long long*)orow + lane;
#pragma unroll
    for (int j = 0; j < 4; ++j) { const f32x4 gg = gr[64 * j];
        o8[64 * j] = (unsigned long long)pk2(v[j].x * rstd * gg.x, v[j].y * rstd * gg.y) | ((unsigned long long)pk2(v[j].z * rstd * gg.z, v[j].w * rstd * gg.w) << 32); }
}
__device__ __forceinline__ void cvt_row_to_bf16(int lane, const float* xrow, bf16* orow) {
    const GAS f32x4* xr = (const GAS f32x4*)xrow + lane;
    GAS unsigned long long* o8 = (GAS unsigned long long*)orow + lane;
#pragma unroll
    for (int j = 0; j < 4; ++j) { const f32x4 v = xr[64 * j]; o8[64 * j] = (unsigned long long)pk2(v.x, v.y) | ((unsigned long long)pk2(v.z, v.w) << 32); }
}
__device__ __forceinline__ void quantize_tables(Frame& F, int gw, int ngw);
__device__ __forceinline__ void p0_prologue(Frame& F) {
    LAS float* scr = (LAS float*)(F.lds + RING_OFF + F.wave * 16384);
    const int gw = F.wg * NWAVES + F.wave, NGW = F.G * NWAVES;
    constexpr int I_IN = (DM / 64) * (IN_COLS / 32), I_OUT = (DM / 64) * (DM / 32), I_Q = (DM / 64) * (PQ / 32);
    constexpr int NITEMS = I_IN + I_OUT + I_Q;
    bf16* win_t = (bf16*)(F.ws + WS_WIN); bf16* wout_t = (bf16*)(F.ws + WS_WOUT); bf16* wq_t = (bf16*)(F.ws + WS_WQ);
    for (int it = gw; it < NITEMS; it += NGW) {
        int r = it;
        if (r < I_IN) { p0_transpose_item(F.in[2], DM, IN_COLS, win_t, scr, r, F.lane); continue; } r -= I_IN;
        if (r < I_OUT) { p0_transpose_item(F.in[14], DM, DM, wout_t, scr, r, F.lane); continue; } r -= I_OUT;
        p0_transpose_item(F.in[16], DM, PQ, wq_t, scr, r, F.lane);
    }
    {
        constexpr int I_W = (64 / 64) * (RWW / 32), I_G = (128 / 64) * (RWW / 32);
        for (int it = gw; it < 2 * I_W + I_G; it += NGW) {
            int r = it;
            if (r < I_W) { p0_transpose_item(F.in[5], 64, RWW, (bf16*)(F.ws + WS_WUPT), scr, r, F.lane); continue; } r -= I_W;
            if (r < I_W) { p0_transpose_item(F.in[7], 64, RWW, (bf16*)(F.ws + WS_AUPT), scr, r, F.lane); continue; } r -= I_W;
            p0_transpose_item(F.in[8], 128, RWW, (bf16*)(F.ws + WS_GUPT), scr, r, F.lane);
        }
    }
    bf16* XN = (bf16*)(F.ws + WS_XN);
    for (int m = gw; m < T; m += NGW) rms_row_to_bf16(F.lane, F.in[0] + (size_t)m * DM, F.in[1], XN + (size_t)m * DM);
}

constexpr size_t WS_ROPE = WS_G;
__device__ __forceinline__ void p0_rope_table(Frame& F) {
    f32x2* tab = (f32x2*)(F.ws + WS_ROPE);
    for (int e = F.wg * NTHREADS + F.tid; e < SEQ * 32; e += F.G * NTHREADS) {
        const int sp = e >> 5, i = e & 31;
        const float inv_freq = powf(10000.0f, -(float)(2 * i) / 64.0f);
        const float ang = (float)sp * inv_freq;
        const double r = (double)ang - rint((double)ang * 0.15915494309189535) * 6.283185307179586;
        const float rf = (float)r;
        tab[e] = (f32x2){cosf(rf), sinf(rf)};
    }
}
__device__ __forceinline__ void p2_rope(Frame& F) {
    bf16* Z = (bf16*)(F.ws + WS_Z);
    const f32x2* tab = (const f32x2*)(F.ws + WS_ROPE);
    const int tid = F.tid, tk = tid >> 6, grp = (tid >> 2) & 15, i0 = (tid & 3) * 8;
    for (int blk = F.wg; blk < T / 8; blk += F.G) {
        const int g = blk * 8 + tk, sp = g & (SEQ - 1);
        bf16* p = Z + (size_t)g * IN_COLS + C_AQ + grp * 64 + i0;
        const v4u a = *(const GAS v4u*)p, b = *(const GAS v4u*)(p + 32);
        const GAS f32x4* tp = (const GAS f32x4*)(tab + sp * 32 + i0);
        float x1[8], x2[8];
        x1[0] = bflo(a.x); x1[1] = bfhi(a.x); x1[2] = bflo(a.y); x1[3] = bfhi(a.y); x1[4] = bflo(a.z); x1[5] = bfhi(a.z); x1[6] = bflo(a.w); x1[7] = bfhi(a.w);
        x2[0] = bflo(b.x); x2[1] = bfhi(b.x); x2[2] = bflo(b.y); x2[3] = bfhi(b.y); x2[4] = bflo(b.z); x2[5] = bfhi(b.z); x2[6] = bflo(b.w); x2[7] = bfhi(b.w);
        float o1[8], o2[8];
#pragma unroll
        for (int q = 0; q < 4; ++q) { const f32x4 cs = tp[q];
            o1[2 * q] = x1[2 * q] * cs[0] - x2[2 * q] * cs[1]; o2[2 * q] = x1[2 * q] * cs[1] + x2[2 * q] * cs[0];
            o1[2 * q + 1] = x1[2 * q + 1] * cs[2] - x2[2 * q + 1] * cs[3]; o2[2 * q + 1] = x1[2 * q + 1] * cs[3] + x2[2 * q + 1] * cs[2]; }
        v4u oa, ob; oa.x = pk2(o1[0], o1[1]); oa.y = pk2(o1[2], o1[3]); oa.z = pk2(o1[4], o1[5]); oa.w = pk2(o1[6], o1[7]);
        ob.x = pk2(o2[0], o2[1]); ob.y = pk2(o2[2], o2[3]); ob.z = pk2(o2[4], o2[5]); ob.w = pk2(o2[6], o2[7]);
        *(GAS v4u*)p = oa; *(GAS v4u*)(p + 32) = ob;
    }
}

typedef float f32x16 __attribute__((ext_vector_type(16)));
constexpr int SBS = 144;
constexpr int R1_EPRE = 0, R1_APRE = 16384, R1_AAB = 0, R1_X = 16384;
constexpr int R1_AT = 32768, R1_BT = 41984, R1_KT = 51200, R1_RT = 60416, R1_AHT = R1_BT, R1_U0T = R1_KT;
constexpr int R1_BBT = 69632, R1_KBT = 78848, R1_VT = 88064;
constexpr int R1_ACTW = 97280, R1_ACTA = 106496, R1_AAK = 97280, R1_ARB = 106496, R1_ARK = 115712;
constexpr int R1_BONUS = 124928, R1_WEND = 125184, R1_SEGS = 125440, R1_TII = 125440, R1_END = 129536;
static_assert(R1_END <= LDSCTL_OFF, "R1 LDS");
__device__ __forceinline__ int crow(int r, int hh) { return (r & 3) + 8 * (r >> 2) + 4 * hh; }
template <int KS> __device__ __forceinline__ f32x16 wtile(const LAS unsigned char* A, int sa, const LAS unsigned char* B, int sb, f32x16 acc, int lane) {
    const int row = lane & 31, hh = lane >> 5;
#pragma unroll
    for (int s = 0; s < KS; ++s) { const bf16x8 a = *(const LAS bf16x8*)(A + row * sa + 32 * s + 16 * hh); const bf16x8 b = *(const LAS bf16x8*)(B + row * sb + 32 * s + 16 * hh);
        acc = __builtin_amdgcn_mfma_f32_32x32x16_bf16(a, b, acc, 0, 0, 0); }
    return acc;
}
template <int KS> __device__ __forceinline__ f32x16 wtile_gb(const LAS unsigned char* A, int sa, const bf16* Bg, int ldb, f32x16 acc, int lane) {
    const int row = lane & 31, hh = lane >> 5;
#pragma unroll
    for (int s = 0; s < KS; ++s) { const bf16x8 a = *(const LAS bf16x8*)(A + row * sa + 32 * s + 16 * hh); const bf16x8 b = *(const GAS bf16x8*)(Bg + (size_t)row * ldb + 16 * s + 8 * hh);
        acc = __builtin_amdgcn_mfma_f32_32x32x16_bf16(a, b, acc, 0, 0, 0); }
    return acc;
}
__device__ __forceinline__ f32x16 zero16() { f32x16 z;
#pragma unroll
    for (int r = 0; r < 16; ++r) z[r] = 0.f;
    return z; }

struct R1Pre { v4u wd[2], ad[2], z[4]; };
__device__ __forceinline__ int r13_item(int wg, int G, int idx) { return (wg >> 3) * 128 + (wg & 7) * 16 + idx; }
__device__ __forceinline__ int r13_count(int wg, int G) { return 16; }
__device__ __forceinline__ void rwkv_r1_prefetch(Frame& F, int item, int tid, R1Pre& P) {
    const int chain = item >> 7, chunk = item & 127, b = chain >> 3, h = chain & 7, g0 = b * SEQ + chunk * 64;
    const bf16* Z = (const bf16*)(F.ws + WS_Z);
    const v4u z0 = (v4u){0u, 0u, 0u, 0u};
    { const int t = tid >> 3, cg = tid & 7; const bool first = (chunk == 0 && t == 0);
      const bf16* zr = Z + (size_t)(g0 + t) * IN_COLS;
      P.wd[0] = *(const GAS v4u*)(zr + C_WD + cg * 8); P.ad[0] = *(const GAS v4u*)(zr + C_AD + cg * 8);
      P.wd[1] = z0; P.ad[1] = z0;
      if (!first) { P.wd[1] = *(const GAS v4u*)(zr - IN_COLS + C_WD + cg * 8); P.ad[1] = *(const GAS v4u*)(zr - IN_COLS + C_AD + cg * 8); } }
#pragma unroll
    for (int q = 0; q < 4; ++q) { const int p = tid + 512 * q; P.z[q] = z0;
        if (p < 65 * 24) { const int row = p / 24, rem = p - row * 24, seg = rem >> 3, ch = rem & 7;
            if (!(chunk == 0 && row == 0)) P.z[q] = *(const GAS v4u*)(Z + (size_t)(g0 - 1 + row) * IN_COLS + seg * 512 + h * 64 + ch * 8); } }
}
constexpr int R1_ZS = R1_AT, R1_ZSS = 384;
static_assert(65 * R1_ZSS <= 4 * 9216, "ZS fits in the At..Rt region");
__device__ __forceinline__ void r1_load_bfrag(Frame& F, int h, int w, int lane, bf16x8 (&bf)[4]) {
    const int p = w >> 2, nt = w & 1; const bf16* upt = (const bf16*)(F.ws + (p == 0 ? WS_WUPT : WS_AUPT)) + (size_t)(h * 64 + nt * 32 + (lane & 31)) * 64 + 8 * (lane >> 5);
#pragma unroll
    for (int s2 = 0; s2 < 4; ++s2) bf[s2] = *(const GAS bf16x8*)(upt + 16 * s2);
}
constexpr int R1_CF = R1_AAB, R1_CN = R1_X;
__device__ __forceinline__ void rwkv_r1_item(Frame& F, int item, int next_item, R1Pre& P, const bf16x8 (&bfr)[4], f32x4 (&cst)[4]) {
    const int chain = item >> 7, chunk = item & 127, b = chain >> 3, h = chain & 7;
    const int g0 = b * SEQ + chunk * 64;
    int tid_ = F.tid; asm volatile("" : "+v"(tid_));
    const int tid = tid_, lane = tid & 63, w = __builtin_amdgcn_readfirstlane(tid >> 6), hh = lane >> 5, cl = lane & 31;
    const bf16* Z = (const bf16*)(F.ws + WS_Z);
    LAS unsigned char* lds = F.lds + RING_OFF;
    const float* mu = F.in[3];
    {
        const int t = tid >> 3, cg = tid & 7;
        const v4u cw = P.wd[0], ca = P.ad[0], pw = P.wd[1], pa = P.ad[1];
        float fw[8], fa[8], qw[8], qa[8];
        fw[0] = bflo(cw.x); fw[1] = bfhi(cw.x); fw[2] = bflo(cw.y); fw[3] = bfhi(cw.y); fw[4] = bflo(cw.z); fw[5] = bfhi(cw.z); fw[6] = bflo(cw.w); fw[7] = bfhi(cw.w);
        fa[0] = bflo(ca.x); fa[1] = bfhi(ca.x); fa[2] = bflo(ca.y); fa[3] = bfhi(ca.y); fa[4] = bflo(ca.z); fa[5] = bfhi(ca.z); fa[6] = bflo(ca.w); fa[7] = bfhi(ca.w);
        qw[0] = bflo(pw.x); qw[1] = bfhi(pw.x); qw[2] = bflo(pw.y); qw[3] = bfhi(pw.y); qw[4] = bflo(pw.z); qw[5] = bfhi(pw.z); qw[6] = bflo(pw.w); qw[7] = bfhi(pw.w);
        qa[0] = bflo(pa.x); qa[1] = bfhi(pa.x); qa[2] = bflo(pa.y); qa[3] = bfhi(pa.y); qa[4] = bflo(pa.z); qa[5] = bfhi(pa.z); qa[6] = bflo(pa.w); qa[7] = bfhi(pa.w);
#pragma unroll
        for (int j = 0; j < 8; ++j) { const int c = cg * 8 + j; const float xw = fw[j] + (qw[j] - fw[j]) * mu[C_WD + c];
            const float ex = __expf(2.f * xw); fw[j] = 1.f - 2.f * frcp(ex + 1.f);
            fa[j] = fa[j] + (qa[j] - fa[j]) * mu[C_AD + c]; }
        v4u ow, oa; ow.x = pk2(fw[0], fw[1]); ow.y = pk2(fw[2], fw[3]); ow.z = pk2(fw[4], fw[5]); ow.w = pk2(fw[6], fw[7]);
        oa.x = pk2(fa[0], fa[1]); oa.y = pk2(fa[2], fa[3]); oa.z = pk2(fa[4], fa[5]); oa.w = pk2(fa[6], fa[7]);
        *(LAS v4u*)(lds + R1_ACTW + t * SBS + cg * 16) = ow; *(LAS v4u*)(lds + R1_ACTA + t * SBS + cg * 16) = oa;
#pragma unroll
        for (int q = 0; q < 4; ++q) { const int p = tid + 512 * q;
            if (p < 65 * 24) { const int row = p / 24, rem = p - row * 24; *(LAS v4u*)(lds + R1_ZS + row * R1_ZSS + rem * 16) = P.z[q]; } }
        if (next_item >= 0) rwkv_r1_prefetch(F, next_item, tid, P);
    }
    LDS_BARRIER();
    {
        const int p = w >> 2, mt = (w >> 1) & 1, nt = w & 1;
        f32x16 acc = zero16();
        { const LAS unsigned char* A_ = lds + (p == 0 ? R1_ACTW : R1_ACTA) + mt * 32 * SBS + (lane & 31) * SBS + 16 * hh;
#pragma unroll
          for (int s2 = 0; s2 < 4; ++s2) acc = __builtin_amdgcn_mfma_f32_32x32x16_bf16(*(const LAS bf16x8*)(A_ + 32 * s2), bfr[s2], acc, 0, 0, 0); }
        LAS float* O = (LAS float*)(lds + (p == 0 ? R1_EPRE : R1_APRE));
#pragma unroll
        for (int r = 0; r < 16; ++r) O[(mt * 32 + crow(r, hh)) * 64 + nt * 32 + cl] = acc[r];
    }
    LDS_BARRIER();
    {
        const int c = tid & 63, ts = tid >> 6, col = h * 64 + c;
        const float mu_r = mu[C_R + col], mu_k = mu[C_K + col], mu_v = mu[C_V + col], kkc = F.in[9][col], kac = F.in[10][col], rkc = F.in[11][col], w0c = F.in[4][col], a0c = F.in[6][col];
        const LAS float* EP = (const LAS float*)(lds + R1_EPRE); const LAS float* AP = (const LAS float*)(lds + R1_APRE);
        LAS float* SEGS = (LAS float*)(lds + R1_SEGS); LAS float* BON = (LAS float*)(lds + R1_BONUS);
        const LAS bf16* zb = (const LAS bf16*)(lds + R1_ZS + (8 * ts) * R1_ZSS) + c;
        float pr = bf2f(zb[0]), pk = bf2f(zb[64]), pv = bf2f(zb[128]);
        float rr[8], k2[8], ai[8], bi[8], vv[8], ee[8], cs[8]; float run = 0.f;
#pragma unroll
        for (int i = 0; i < 8; ++i) {
            const float zr = bf2f(zb[(i + 1) * (R1_ZSS / 2)]), zk = bf2f(zb[(i + 1) * (R1_ZSS / 2) + 64]), zv = bf2f(zb[(i + 1) * (R1_ZSS / 2) + 128]);
            const float r = zr + (pr - zr) * mu_r, k = zk + (pk - zk) * mu_k, v = zv + (pv - zv) * mu_v; pr = zr; pk = zk; pv = zv;
            const float e = 0.60653066f * frcp(1.f + __expf(-(w0c + EP[(8 * ts + i) * 64 + c])));
            const float a = frcp(1.f + __expf(-(a0c + AP[(8 * ts + i) * 64 + c])));
            float kk = k * kkc; const float n2 = wave_sum(kk * kk); kk = kk * frsq(fmaxf(n2, 1e-24f));
            const float kq = k * (1.f + (a - 1.f) * kac);
            const float bon = wave_sum(r * kq * rkc); if (c == 0) BON[8 * ts + i] = bon;
            rr[i] = r; k2[i] = kq; ai[i] = -kk; bi[i] = kk * a; vv[i] = v; ee[i] = e; run += e; cs[i] = run;
        }
        SEGS[ts * 64 + c] = run;
        LDS_BARRIER();
        float off = 0.f, tot = 0.f;
#pragma unroll
        for (int q = 0; q < 8; ++q) { const float sv = SEGS[q * 64 + c]; tot += sv; off += (q < ts) ? sv : 0.f; }
        float bb[8], kb[8];
#pragma unroll
        for (int i = 0; i < 8; ++i) { const float L = off + cs[i];
            const float Wm = __expf(-(L - ee[i])), Wi = __expf(-L), iW = __expf(L), We = __expf(-(tot - L));
            const int t = 8 * ts + i;
            *(LAS bf16*)(lds + R1_AT + t * SBS + c * 2) = (bf16)f2bf(ai[i] * Wm);
            *(LAS bf16*)(lds + R1_BT + t * SBS + c * 2) = (bf16)f2bf(bi[i] * iW);
            *(LAS bf16*)(lds + R1_KT + t * SBS + c * 2) = (bf16)f2bf(k2[i] * iW);
            *(LAS bf16*)(lds + R1_RT + t * SBS + c * 2) = (bf16)f2bf(rr[i] * Wi);
            bb[i] = bi[i] * We; kb[i] = k2[i] * We; }
        v4u o; o.x = pk2(bb[0], bb[1]); o.y = pk2(bb[2], bb[3]); o.z = pk2(bb[4], bb[5]); o.w = pk2(bb[6], bb[7]);
        *(LAS v4u*)(lds + R1_BBT + c * SBS + ts * 16) = o;
        o.x = pk2(kb[0], kb[1]); o.y = pk2(kb[2], kb[3]); o.z = pk2(kb[4], kb[5]); o.w = pk2(kb[6], kb[7]);
        *(LAS v4u*)(lds + R1_KBT + c * SBS + ts * 16) = o;
        o.x = pk2(vv[0], vv[1]); o.y = pk2(vv[2], vv[3]); o.z = pk2(vv[4], vv[5]); o.w = pk2(vv[6], vv[7]);
        *(LAS v4u*)(lds + R1_VT + c * SBS + ts * 16) = o;
        if (ts == 0) ((LAS float*)(lds + R1_WEND))[c] = __expf(-tot);
    }
    LDS_BARRIER();
#pragma unroll
    for (int u = 0; u < 2; ++u) {
        const int idx = w * 2 + u, p = idx >> 2, mt = (idx >> 1) & 1, nt = idx & 1;
        const LAS unsigned char* Aop = lds + ((p == 0 || p == 2) ? R1_BT : R1_KT) + mt * 32 * SBS;
        const LAS unsigned char* Bop = lds + (p < 2 ? R1_AT : R1_RT) + nt * 32 * SBS;
        f32x16 acc = wtile<4>(Aop, SBS, Bop, SBS, zero16(), lane);
        const int n = nt * 32 + cl;
#pragma unroll
        for (int r = 0; r < 16; ++r) { const int m = mt * 32 + crow(r, hh); const bool keep = (p < 2) ? (m < n) : (m <= n); acc[r] = keep ? acc[r] : 0.f; }
#pragma unroll
        for (int g4 = 0; g4 < 4; ++g4) { const int m0 = mt * 32 + 8 * g4 + 4 * hh;
            if (p == 0) *(LAS f32x4*)(lds + R1_AAB + (n * 64 + m0) * 4) = (f32x4){acc[4 * g4], acc[4 * g4 + 1], acc[4 * g4 + 2], acc[4 * g4 + 3]};
            else { v2u o; o.x = pk2(acc[4 * g4], acc[4 * g4 + 1]); o.y = pk2(acc[4 * g4 + 2], acc[4 * g4 + 3]);
                   *(LAS v2u*)(lds + (p == 1 ? R1_AAK : (p == 2 ? R1_ARB : R1_ARK)) + n * SBS + m0 * 2) = o; } }
    }
    LDS_BARRIER();
    if (w < 4) {
        const int mt = w >> 1, nt = w & 1;
        const f32x16 acc = wtile<4>(lds + R1_AAK + mt * 32 * SBS, SBS, lds + R1_VT + nt * 32 * SBS, SBS, zero16(), lane);
        LAS float* X = (LAS float*)(lds + R1_X);
#pragma unroll
        for (int r = 0; r < 16; ++r) X[(mt * 32 + crow(r, hh)) * 64 + nt * 32 + cl] = acc[r];
    } else if (w == 4) {
        const int bk = lane >> 4, c = lane & 15;
        const LAS float* AAB = (const LAS float*)(lds + R1_AAB);
        float Tc[16]; const float fc = (float)c;
#pragma unroll
        for (int s2 = 0; s2 < 16; ++s2) Tc[s2] = fmaxf(0.f, 1.f - fabsf((float)s2 - fc));
#pragma unroll
        for (int r = 0; r < 15; ++r)
#pragma unroll
            for (int s2 = r + 1; s2 < 16; ++s2) Tc[s2] += AAB[(16 * bk + s2) * 64 + 16 * bk + r] * Tc[r];
        LAS float* TII = (LAS float*)(lds + R1_TII);
#pragma unroll
        for (int s2 = 0; s2 < 16; ++s2) TII[(bk * 16 + s2) * 16 + c] = Tc[s2];
    }
    LDS_BARRIER();
    {
        const int c16 = lane & 15, g = lane >> 4;
        const LAS float* AAB = (const LAS float*)(lds + R1_AAB); const LAS float* TII = (const LAS float*)(lds + R1_TII); const LAS float* X = (const LAS float*)(lds + R1_X);
        f32x4 o[4];
#pragma unroll
        for (int i = 0; i < 4; ++i) {
            f32x4 acc;
            if (w < 4) {
#pragma unroll
                for (int q = 0; q < 4; ++q) acc[q] = bf2f(*(const LAS bf16*)(lds + R1_AT + (16 * i + 4 * g + q) * SBS + (16 * w + c16) * 2));
            } else {
#pragma unroll
                for (int q = 0; q < 4; ++q) acc[q] = X[(16 * i + 4 * g + q) * 64 + 16 * (w - 4) + c16];
            }
#pragma unroll
            for (int j = 0; j < i; ++j) { const f32x4 a4 = *(const LAS f32x4*)(AAB + (16 * i + c16) * 64 + 16 * j + 4 * g);
#pragma unroll
                for (int q = 0; q < 4; ++q) acc = __builtin_amdgcn_mfma_f32_16x16x4f32(a4[q], o[j][q], acc, 0, 0, 0); }
            const f32x4 t4 = *(const LAS f32x4*)(TII + (i * 16 + c16) * 16 + 4 * g);
            f32x4 res = (f32x4){0.f, 0.f, 0.f, 0.f};
#pragma unroll
            for (int q = 0; q < 4; ++q) res = __builtin_amdgcn_mfma_f32_16x16x4f32(t4[q], acc[q], res, 0, 0, 0);
            o[i] = res;
            v2u ov; ov.x = pk2(res[0], res[1]); ov.y = pk2(res[2], res[3]);
            *(LAS v2u*)(lds + (w < 4 ? R1_AHT : R1_U0T) + (16 * (w & 3) + c16) * SBS + (16 * i + 4 * g) * 2) = ov;
        }
    }
    LDS_BARRIER();
    {
        float* Mg = F.out + (size_t)item * 4096; float* NTg = F.out + (size_t)T * RWW + (size_t)item * 4096;
        float* Y0g = (float*)(F.ws + WS_RWY0) + (size_t)item * 4096; bf16* RHg = (bf16*)(F.ws + WS_RWRH) + (size_t)item * 4096;
#pragma unroll
        for (int u = 0; u < 2; ++u) {
            const int idx = w * 2 + u, p = idx >> 2, mt = (idx >> 1) & 1, nt = idx & 1; const int n = nt * 32 + cl;
            if (p == 0) {
                f32x16 acc = wtile<4>(lds + R1_AHT + mt * 32 * SBS, SBS, lds + R1_BBT + nt * 32 * SBS, SBS, zero16(), lane);
                const float we = ((const LAS float*)(lds + R1_WEND))[n];
#pragma unroll
                for (int g4 = 0; g4 < 4; ++g4) { const int m0 = mt * 32 + 8 * g4 + 4 * hh;
                    const f32x4 mv = (f32x4){acc[4 * g4] + (m0 == n ? we : 0.f), acc[4 * g4 + 1] + (m0 + 1 == n ? we : 0.f), acc[4 * g4 + 2] + (m0 + 2 == n ? we : 0.f), acc[4 * g4 + 3] + (m0 + 3 == n ? we : 0.f)};
                    *(GAS f32x4*)(Mg + n * 64 + m0) = mv;
                    v2u h_; h_.x = pk2(mv[0], mv[1]); h_.y = pk2(mv[2], mv[3]);
                    v2u l_; l_.x = pk2(mv[0] - bflo(h_.x), mv[1] - bfhi(h_.x)); l_.y = pk2(mv[2] - bflo(h_.y), mv[3] - bfhi(h_.y));
                    LAS unsigned char* fp_ = lds + R1_CF + (((n >> 4) * 2 + (m0 >> 5)) * 2) * 1024 + ((((m0 >> 2) & 3) * 16) + (n & 15)) * 16 + ((m0 >> 4) & 1) * 8;
                    *(LAS v2u*)fp_ = h_; *(LAS v2u*)(fp_ + 1024) = l_; }
            } else if (p == 1) {
                f32x16 acc = wtile<4>(lds + R1_BBT + mt * 32 * SBS, SBS, lds + R1_U0T + nt * 32 * SBS, SBS, zero16(), lane);
                acc = wtile<4>(lds + R1_KBT + mt * 32 * SBS, SBS, lds + R1_VT + nt * 32 * SBS, SBS, acc, lane);
#pragma unroll
                for (int g4 = 0; g4 < 4; ++g4) { const f32x4 nv_ = (f32x4){acc[4 * g4], acc[4 * g4 + 1], acc[4 * g4 + 2], acc[4 * g4 + 3]};
                    *(GAS f32x4*)(NTg + n * 64 + mt * 32 + 8 * g4 + 4 * hh) = nv_; *(LAS f32x4*)(lds + R1_CN + (n * 64 + mt * 32 + 8 * g4 + 4 * hh) * 4) = nv_; }
            } else if (p == 2) {
                f32x16 acc = wtile<4>(lds + R1_AHT + mt * 32 * SBS, SBS, lds + R1_ARB + nt * 32 * SBS, SBS, zero16(), lane);
#pragma unroll
                for (int g4 = 0; g4 < 4; ++g4) { const int m0 = mt * 32 + 8 * g4 + 4 * hh;
                    const v2u rt = *(const LAS v2u*)(lds + R1_RT + n * SBS + m0 * 2);
                    v2u ov; ov.x = pk2(acc[4 * g4] + bflo(rt.x), acc[4 * g4 + 1] + bfhi(rt.x)); ov.y = pk2(acc[4 * g4 + 2] + bflo(rt.y), acc[4 * g4 + 3] + bfhi(rt.y));
                    *(GAS v2u*)(RHg + n * 64 + m0) = ov; }
            } else {
                f32x16 acc = wtile<4>(lds + R1_U0T + mt * 32 * SBS, SBS, lds + R1_ARB + nt * 32 * SBS, SBS, zero16(), lane);
                acc = wtile<4>(lds + R1_VT + mt * 32 * SBS, SBS, lds + R1_ARK + nt * 32 * SBS, SBS, acc, lane);
#pragma unroll
                for (int g4 = 0; g4 < 4; ++g4) *(GAS f32x4*)(Y0g + n * 64 + mt * 32 + 8 * g4 + 4 * hh) = (f32x4){acc[4 * g4], acc[4 * g4 + 1], acc[4 * g4 + 2], acc[4 * g4 + 3]};
            }
        }
        if (tid < 64) ((float*)(F.ws + WS_BONUS))[(size_t)item * 64 + tid] = ((const LAS float*)(lds + R1_BONUS))[tid];
    }
    LDS_BARRIER();
    {
        const int n16 = lane & 15, g = lane >> 4;
        bf16x8 sh[2], sl[2];
#pragma unroll
        for (int ks = 0; ks < 2; ++ks) { const f32x4 a = cst[2 * ks], b = cst[2 * ks + 1];
            v4u h_; h_.x = pk2(a[0], a[1]); h_.y = pk2(a[2], a[3]); h_.z = pk2(b[0], b[1]); h_.w = pk2(b[2], b[3]);
            v4u l_; l_.x = pk2(a[0] - bflo(h_.x), a[1] - bfhi(h_.x)); l_.y = pk2(a[2] - bflo(h_.y), a[3] - bfhi(h_.y)); l_.z = pk2(b[0] - bflo(h_.z), b[1] - bfhi(h_.z)); l_.w = pk2(b[2] - bflo(h_.w), b[3] - bfhi(h_.w));
            sh[ks] = __builtin_bit_cast(bf16x8, h_); sl[ks] = __builtin_bit_cast(bf16x8, l_); }
        f32x4 nw[4];
#pragma unroll
        for (int rt = 0; rt < 4; ++rt) { f32x4 acc = (f32x4){0.f, 0.f, 0.f, 0.f};
            if (w >= 4) acc = *(const LAS f32x4*)(lds + R1_CN + ((16 * (w - 4) + n16) * 64 + 16 * rt + 4 * g) * 4);
#pragma unroll
            for (int ks = 0; ks < 2; ++ks) {
                const bf16x8 mh = *(const LAS bf16x8*)(lds + R1_CF + ((rt * 2 + ks) * 2) * 1024 + lane * 16), ml = *(const LAS bf16x8*)(lds + R1_CF + ((rt * 2 + ks) * 2 + 1) * 1024 + lane * 16);
                acc = __builtin_amdgcn_mfma_f32_16x16x32_bf16(mh, sh[ks], acc, 0, 0, 0);
                acc = __builtin_amdgcn_mfma_f32_16x16x32_bf16(mh, sl[ks], acc, 0, 0, 0);
                acc = __builtin_amdgcn_mfma_f32_16x16x32_bf16(ml, sh[ks], acc, 0, 0, 0); }
            nw[rt] = acc; }
#pragma unroll
        for (int rt = 0; rt < 4; ++rt) cst[rt] = nw[rt];
    }
    LDS_BARRIER();
}

constexpr int R2_RS = 272, R2_SLOT = 2 * 64 * R2_RS, R2_D = 7;
static_assert(2 * R2_SLOT <= LDSCTL_OFF, "R2 LDS");
template <int NSTEP> __device__ __forceinline__ void rwkv_scan(Frame& F, const float* Mg, const float* NTg, float* SSg, const float* S0g) {
    int tid_ = F.tid; asm volatile("" : "+v"(tid_));
    const int lane = tid_ & 63, w = __builtin_amdgcn_readfirstlane(tid_ >> 6);
    LAS unsigned char* lds = F.lds + RING_OFF;
    if (w >= 4) {
        const int L = w - 4, r = lane >> 2, f0 = (lane & 3) * 4;
        const size_t goff = (size_t)(16 * L + r) * 64 + f0 * 4;
        const int loff = (16 * L + r) * R2_RS + f0 * 16;
        f32x4 R[R2_D][8];
#define R2_ISSUE(slot_, step_) do { const int st_ = (step_) < NSTEP ? (step_) : NSTEP - 1; const float* mp_ = Mg + (size_t)st_ * 4096 + goff; const float* np_ = NTg + (size_t)st_ * 4096 + goff; \
            _Pragma("unroll") for (int k_ = 0; k_ < 4; ++k_) { R[slot_][k_] = *(const GAS f32x4*)(mp_ + 4 * k_); R[slot_][4 + k_] = *(const GAS f32x4*)(np_ + 4 * k_); } } while (0)
        const int q_ = lane & 3, froff = ((L * 2 + (q_ >> 1)) * 2) * 1024 + r * 16 + (q_ & 1) * 8;
#define R2_WRITE(slot_, buf_) do { LAS unsigned char* d_ = lds + (buf_) * R2_SLOT; \
            _Pragma("unroll") for (int k_ = 0; k_ < 4; ++k_) { const f32x4 a_ = R[slot_][k_]; \
                v2u h_; h_.x = pk2(a_[0], a_[1]); h_.y = pk2(a_[2], a_[3]); \
                v2u l_; l_.x = pk2(a_[0] - bflo(h_.x), a_[1] - bfhi(h_.x)); l_.y = pk2(a_[2] - bflo(h_.y), a_[3] - bfhi(h_.y)); \
                *(LAS v2u*)(d_ + froff + k_ * 256) = h_; *(LAS v2u*)(d_ + froff + 1024 + k_ * 256) = l_; \
                *(LAS f32x4*)(d_ + 64 * R2_RS + loff + 16 * k_) = R[slot_][4 + k_]; } } while (0)
#pragma unroll
        for (int u = 0; u < R2_D; ++u) R2_ISSUE(u, u);
        R2_WRITE(0, 0);
        R2_ISSUE(0, R2_D);
        LDS_BARRIER();
        int c0 = 0;
        for (; c0 + R2_D <= NSTEP - 1; c0 += R2_D) {
#pragma unroll
            for (int u = 0; u < R2_D; ++u) { const int c = c0 + u;
                R2_WRITE((u + 1) % R2_D, (c + 1) & 1);
                R2_ISSUE((u + 1) % R2_D, c + 1 + R2_D);
                LDS_BARRIER(); }
        }
#pragma unroll
        for (int u = 0; u < R2_D; ++u) { const int c = c0 + u;
            if (c < NSTEP - 1) { R2_WRITE((u + 1) % R2_D, (c + 1) & 1); LDS_BARRIER(); } }
        LDS_BARRIER();
#undef R2_ISSUE
#undef R2_WRITE
        return;
    }
    const int n16 = lane & 15, g = lane >> 4;
    f32x4 st[4];
#pragma unroll
    for (int rt = 0; rt < 4; ++rt) st[rt] = S0g ? *(const GAS f32x4*)(S0g + (16 * w + n16) * 64 + 16 * rt + 4 * g) : (f32x4){0.f, 0.f, 0.f, 0.f};
    LDS_BARRIER();
    for (int c = 0; c < NSTEP; ++c) {
#pragma unroll
        for (int rt = 0; rt < 4; ++rt) *(GAS f32x4*)(SSg + (size_t)c * 4096 + (16 * w + n16) * 64 + 16 * rt + 4 * g) = st[rt];
        const LAS unsigned char* sl_ = lds + (c & 1) * R2_SLOT;
        bf16x8 sh[2], sl[2];
#pragma unroll
        for (int ks = 0; ks < 2; ++ks) { const f32x4 a = st[2 * ks], b = st[2 * ks + 1];
            v4u h; h.x = pk2(a[0], a[1]); h.y = pk2(a[2], a[3]); h.z = pk2(b[0], b[1]); h.w = pk2(b[2], b[3]);
            v4u l; l.x = pk2(a[0] - bflo(h.x), a[1] - bfhi(h.x)); l.y = pk2(a[2] - bflo(h.y), a[3] - bfhi(h.y)); l.z = pk2(b[0] - bflo(h.z), b[1] - bfhi(h.z)); l.w = pk2(b[2] - bflo(h.w), b[3] - bfhi(h.w));
            sh[ks] = __builtin_bit_cast(bf16x8, h); sl[ks] = __builtin_bit_cast(bf16x8, l); }
        f32x4 nw[4];
#pragma unroll
        for (int rt = 0; rt < 4; ++rt) { f32x4 acc = *(const LAS f32x4*)(sl_ + 64 * R2_RS + (16 * w + n16) * R2_RS + (16 * rt + 4 * g) * 4);
#pragma unroll
            for (int ks = 0; ks < 2; ++ks) {
                const bf16x8 mh = *(const LAS bf16x8*)(sl_ + ((rt * 2 + ks) * 2) * 1024 + lane * 16), ml = *(const LAS bf16x8*)(sl_ + ((rt * 2 + ks) * 2 + 1) * 1024 + lane * 16);
                acc = __builtin_amdgcn_mfma_f32_16x16x32_bf16(mh, sh[ks], acc, 0, 0, 0);
                acc = __builtin_amdgcn_mfma_f32_16x16x32_bf16(mh, sl[ks], acc, 0, 0, 0);
                acc = __builtin_amdgcn_mfma_f32_16x16x32_bf16(ml, sh[ks], acc, 0, 0, 0); }
            nw[rt] = acc; }
#pragma unroll
        for (int rt = 0; rt < 4; ++rt) st[rt] = nw[rt];
        LDS_BARRIER();
    }
#pragma unroll
    for (int rt = 0; rt < 4; ++rt) *(GAS f32x4*)(SSg + (size_t)NSTEP * 4096 + (16 * w + n16) * 64 + 16 * rt + 4 * g) = st[rt];
}

constexpr int R3_RH = 0, R3_S = 9216, R3_SG = 18432, R3_SGS = 272, R3_YL = R3_SG + 64 * R3_SGS, R3_GL = R3_YL + 16384, R3_VS = R3_GL + 16384, R3_BON = R3_VS + 65 * 128, R3_END = R3_BON + 256;
static_assert(R3_END <= LDSCTL_OFF, "R3 LDS");
struct R3Pre { v4u rh; f32x4 ss[2]; v4u gd[2][2]; f32x4 y0[2]; v4u vv[2]; float bon; };
__device__ __forceinline__ void rwkv_r3_prefetch(Frame& F, int item, int tid, R3Pre& P) {
    const int chain = item >> 7, chunk = item & 127, b = chain >> 3, h = chain & 7, g0 = b * SEQ + chunk * 64;
    const bf16* Z = (const bf16*)(F.ws + WS_Z);
    const int t = tid >> 3, cg = tid & 7; const v4u z0 = (v4u){0u, 0u, 0u, 0u};
    P.rh = *(const GAS v4u*)((const bf16*)(F.ws + WS_RWRH) + (size_t)item * 4096 + t * 64 + cg * 8);
    const float* SSg = (const float*)(F.ws + WS_RWSS) + (size_t)item * 4096 + t * 64 + cg * 8;
    P.ss[0] = *(const GAS f32x4*)SSg; P.ss[1] = *(const GAS f32x4*)(SSg + 4);
    const bf16* zr = Z + (size_t)(g0 + t) * IN_COLS + C_GD + cg * 16; const bool first = (chunk == 0 && t == 0);
#pragma unroll
    for (int q = 0; q < 2; ++q) { P.gd[q][0] = *(const GAS v4u*)(zr + q * 8); P.gd[q][1] = z0; if (!first) P.gd[q][1] = *(const GAS v4u*)(zr - IN_COLS + q * 8); }
    const float* Y0g = (const float*)(F.ws + WS_RWY0) + (size_t)item * 4096;
    P.y0[0] = *(const GAS f32x4*)(Y0g + tid * 4); P.y0[1] = *(const GAS f32x4*)(Y0g + (tid + 512) * 4);
#pragma unroll
    for (int q = 0; q < 2; ++q) { const int p = tid + 512 * q; P.vv[q] = z0;
        if (p < 65 * 8) { const int row = p >> 3, ch = p & 7; if (!(chunk == 0 && row == 0)) P.vv[q] = *(const GAS v4u*)(Z + (size_t)(g0 - 1 + row) * IN_COLS + C_V + h * 64 + ch * 8); } }
    P.bon = tid < 64 ? ((const float*)(F.ws + WS_BONUS))[(size_t)item * 64 + tid] : 0.f;
}
__device__ __forceinline__ void r3_load_bfrag(Frame& F, int h, int w, int lane, bf16x8 (&bf)[8]) {
    const int nt = w & 1; const bf16* gut = (const bf16*)(F.ws + WS_GUPT) + (size_t)(h * 64 + nt * 32 + (lane & 31)) * 128 + 8 * (lane >> 5);
#pragma unroll
    for (int s2 = 0; s2 < 8; ++s2) bf[s2] = *(const GAS bf16x8*)(gut + 16 * s2);
}
__device__ __forceinline__ void rwkv_r3_item(Frame& F, int item, int next_item, R3Pre& P, const bf16x8 (&bfr)[8]) {
    const int chain = item >> 7, chunk = item & 127, b = chain >> 3, h = chain & 7;
    const int g0 = b * SEQ + chunk * 64;
    int tid_ = F.tid; asm volatile("" : "+v"(tid_));
    const int tid = tid_, lane = tid & 63, w = __builtin_amdgcn_readfirstlane(tid >> 6), hh = lane >> 5, cl = lane & 31;
    LAS unsigned char* lds = F.lds + RING_OFF;
    const float* mu = F.in[3];
    {
        const int t = tid >> 3, cg = tid & 7;
        *(LAS v4u*)(lds + R3_RH + t * SBS + cg * 16) = P.rh;
        const f32x4 s0 = P.ss[0], s1 = P.ss[1];
        v4u o; o.x = pk2(s0[0], s0[1]); o.y = pk2(s0[2], s0[3]); o.z = pk2(s1[0], s1[1]); o.w = pk2(s1[2], s1[3]);
        *(LAS v4u*)(lds + R3_S + t * SBS + cg * 16) = o;
#pragma unroll
        for (int q = 0; q < 2; ++q) {
            const v4u cw = P.gd[q][0], pw = P.gd[q][1];
            float fw[8], qw[8];
            fw[0] = bflo(cw.x); fw[1] = bfhi(cw.x); fw[2] = bflo(cw.y); fw[3] = bfhi(cw.y); fw[4] = bflo(cw.z); fw[5] = bfhi(cw.z); fw[6] = bflo(cw.w); fw[7] = bfhi(cw.w);
            qw[0] = bflo(pw.x); qw[1] = bfhi(pw.x); qw[2] = bflo(pw.y); qw[3] = bfhi(pw.y); qw[4] = bflo(pw.z); qw[5] = bfhi(pw.z); qw[6] = bflo(pw.w); qw[7] = bfhi(pw.w);
#pragma unroll
            for (int j = 0; j < 8; ++j) { const float v = fw[j] + (qw[j] - fw[j]) * mu[C_GD + cg * 16 + q * 8 + j]; fw[j] = frcp(1.f + __expf(-v)); }
            v4u og; og.x = pk2(fw[0], fw[1]); og.y = pk2(fw[2], fw[3]); og.z = pk2(fw[4], fw[5]); og.w = pk2(fw[6], fw[7]);
            *(LAS v4u*)(lds + R3_SG + t * R3_SGS + (cg * 16 + q * 8) * 2) = og;
        }
        *(LAS f32x4*)(lds + R3_YL + tid * 16) = P.y0[0]; *(LAS f32x4*)(lds + R3_YL + (tid + 512) * 16) = P.y0[1];
#pragma unroll
        for (int q = 0; q < 2; ++q) { const int p = tid + 512 * q; if (p < 65 * 8) *(LAS v4u*)(lds + R3_VS + p * 16) = P.vv[q]; }
        if (tid < 64) ((LAS float*)(lds + R3_BON))[tid] = P.bon;
        if (next_item >= 0) rwkv_r3_prefetch(F, next_item, tid, P);
    }
    LDS_BARRIER();
    {
        const int mt = (w >> 1) & 1, nt = w & 1; const int n = nt * 32 + cl;
        if (w < 4) {
            LAS float* YL = (LAS float*)(lds + R3_YL);
            f32x16 acc;
#pragma unroll
            for (int r = 0; r < 16; ++r) acc[r] = YL[(mt * 32 + crow(r, hh)) * 64 + n];
            acc = wtile<4>(lds + R3_RH + mt * 32 * SBS, SBS, lds + R3_S + nt * 32 * SBS, SBS, acc, lane);
#pragma unroll
            for (int r = 0; r < 16; ++r) YL[(mt * 32 + crow(r, hh)) * 64 + n] = acc[r];
        } else {
            f32x16 acc = zero16();
            { const LAS unsigned char* A_ = lds + R3_SG + mt * 32 * R3_SGS + (lane & 31) * R3_SGS + 16 * hh;
#pragma unroll
              for (int s2 = 0; s2 < 8; ++s2) acc = __builtin_amdgcn_mfma_f32_32x32x16_bf16(*(const LAS bf16x8*)(A_ + 32 * s2), bfr[s2], acc, 0, 0, 0); }
            LAS float* GL = (LAS float*)(lds + R3_GL);
#pragma unroll
            for (int r = 0; r < 16; ++r) GL[(mt * 32 + crow(r, hh)) * 64 + n] = acc[r];
        }
    }
    LDS_BARRIER();
    {
        const int c = tid & 63, ts = tid >> 6, col = h * 64 + c;
        const float mu_v = mu[C_V + col], gw = F.in[12][col], gb = F.in[13][col];
        const LAS float* YL = (const LAS float*)(lds + R3_YL); const LAS float* GL = (const LAS float*)(lds + R3_GL); const LAS float* BON = (const LAS float*)(lds + R3_BON);
        bf16* Y = (bf16*)(F.ws + WS_YMIX);
        const LAS bf16* vb = (const LAS bf16*)(lds + R3_VS) + (8 * ts) * 64 + c;
        float pv = bf2f(vb[0]);
#pragma unroll
        for (int i = 0; i < 8; ++i) { const int t = 8 * ts + i;
            const float zv = bf2f(vb[(i + 1) * 64]); const float v = zv + (pv - zv) * mu_v; pv = zv;
            const float y = YL[t * 64 + c];
            const float mean = wave_sum(y) * (1.f / 64.f); const float d = y - mean; const float var = wave_sum(d * d) * (1.f / 64.f);
            const float yn = d * frsq(var + GN_EPS) * gw + gb;
            const float o = (yn + BON[t] * v) * GL[t * 64 + c];
            Y[(size_t)(g0 + t) * DM + col] = (bf16)f2bf(o); }
    }
    LDS_BARRIER();
}

typedef short s16x4 __attribute__((ext_vector_type(4)));
typedef short v4i16_t __attribute__((ext_vector_type(4)));
constexpr int AT_XO = 0, AT_XO_STRIDE = 136, AT_XM = 512 * AT_XO_STRIDE, AT_XL = AT_XM + 2048, AT_V = AT_XL + 2048, AT_LDS_END = AT_V + 8 * 4096;
static_assert(AT_LDS_END <= RING_BYTES, "attention LDS");
__device__ __forceinline__ float xhalf(float v) { return __shfl_xor(v, 32); }
__device__ __forceinline__ void attn_block(Frame& F, int item) {
    const int bh = item >> 4, blk = item & 15, b = bh >> 3, h = bh & 7, t0 = blk * 512;
    int tid_ = F.tid; asm volatile("" : "+v"(tid_));
    const int lane = tid_ & 63, w = __builtin_amdgcn_readfirstlane(tid_ >> 6), ql = lane & 31, hh = lane >> 5;
    const bf16* Zb = (const bf16*)(F.ws + WS_Z) + (size_t)b * SEQ * IN_COLS;
    bf16* Y = (bf16*)(F.ws + WS_YMIX);
    LAS unsigned char* lds = F.lds + RING_OFF;
    LAS unsigned char* Vw = lds + AT_V + w * 4096;
    LAS float* XM = (LAS float*)(lds + AT_XM); LAS float* XL = (LAS float*)(lds + AT_XL);
    constexpr float C2 = 0.125f * 1.4426950408889634f;
    for (int pass = 0; pass < 3; ++pass) {
        const int sh = pass == 0 ? 4 : (pass == 1 ? 2 : 0), d = 1 << sh;
        for (int uu = 0; uu < 2; ++uu) {
            const int u = w + 8 * uu, rho = u & (d - 1), tau = u >> sh;
            const int qoff = rho + (32 * tau + ql) * d;
            bf16x8 qf[4];
            { const bf16* qp = Zb + (size_t)(t0 + qoff) * IN_COLS + C_AQ + h * 64 + 8 * hh;
#pragma unroll
              for (int s = 0; s < 4; ++s) qf[s] = *(const GAS bf16x8*)(qp + 16 * s); }
            f32x16 sc[5];
            const int tkb = t0 + rho + (32 * tau - 128) * d;
            bf16x8 kf[5][4];
#pragma unroll
            for (int kt = 0; kt < 5; ++kt) { const int tk0 = tkb + 32 * kt * d, tkc = tk0 < 0 ? 0 : tk0;
                const bf16* kp = Zb + (size_t)(tkc + ql * d) * IN_COLS + C_AK + h * 64 + 8 * hh;
#pragma unroll
                for (int s = 0; s < 4; ++s) kf[kt][s] = *(const GAS bf16x8*)(kp + 16 * s); }
            v4u vr[4];
            { const int tkc = tkb < 0 ? 0 : tkb;
#pragma unroll
              for (int i = 0; i < 4; ++i) { const int kidx = i * 8 + (lane >> 3), ch = lane & 7;
                  vr[i] = *(const GAS v4u*)(Zb + (size_t)(tkc + kidx * d) * IN_COLS + C_AV + h * 64 + ch * 8); } }
#pragma unroll
            for (int kt = 0; kt < 5; ++kt) {
                const int tk0 = tkb + 32 * kt * d;
                f32x16 acc = zero16();
#pragma unroll
                for (int s = 0; s < 4; ++s) acc = __builtin_amdgcn_mfma_f32_32x32x16_bf16(kf[kt][s], qf[s], acc, 0, 0, 0);
                if (kt == 0 || kt == 4) {
#pragma unroll
                    for (int r = 0; r < 16; ++r) { const int kidx = (r & 3) + 8 * (r >> 2) + 4 * hh;
                        const bool ok = (kt == 0) ? (kidx >= ql) : (kidx <= ql);
                        acc[r] = ok ? acc[r] : -INFINITY; }
                }
                if (tk0 < 0) {
#pragma unroll
                    for (int r = 0; r < 16; ++r) acc[r] = -INFINITY;
                }
                sc[kt] = acc;
            }
            float m = -INFINITY;
#pragma unroll
            for (int kt = 0; kt < 5; ++kt)
#pragma unroll
                for (int r = 0; r < 16; ++r) m = fmaxf(m, sc[kt][r]);
            m = fmaxf(m, xhalf(m));
            const float ms = m * C2;
            float l = 0.f;
#pragma unroll
            for (int kt = 0; kt < 5; ++kt)
#pragma unroll
                for (int r = 0; r < 16; ++r) { const float p = __builtin_amdgcn_exp2f(sc[kt][r] * C2 - ms); sc[kt][r] = p; l += p; }
            l += xhalf(l);
            f32x16 O[2];
#pragma unroll
            for (int r = 0; r < 16; ++r) { O[0][r] = 0.f; O[1][r] = 0.f; }
#pragma unroll
            for (int kt = 0; kt < 5; ++kt) {
#pragma unroll
                for (int i = 0; i < 4; ++i) { const int kidx = i * 8 + (lane >> 3), ch = lane & 7;
                    *(LAS v4u*)(Vw + kidx * 128 + ((ch ^ (((kidx >> 1) & 1) << 2)) << 4)) = vr[i]; }
                if (kt < 4) { const int tk1 = tkb + 32 * (kt + 1) * d, tkc = tk1 < 0 ? 0 : tk1;
#pragma unroll
                    for (int i = 0; i < 4; ++i) { const int kidx = i * 8 + (lane >> 3), ch = lane & 7;
                        vr[i] = *(const GAS v4u*)(Zb + (size_t)(tkc + kidx * d) * IN_COLS + C_AV + h * 64 + ch * 8); } }
                asm volatile("s_waitcnt lgkmcnt(0)" ::: "memory");
#pragma unroll
                for (int s = 0; s < 2; ++s) {
                    v4u pw; pw.x = pk2(sc[kt][8 * s], sc[kt][8 * s + 1]); pw.y = pk2(sc[kt][8 * s + 2], sc[kt][8 * s + 3]); pw.z = pk2(sc[kt][8 * s + 4], sc[kt][8 * s + 5]); pw.w = pk2(sc[kt][8 * s + 6], sc[kt][8 * s + 7]);
                    const bf16x8 pf = __builtin_bit_cast(bf16x8, pw);
#pragma unroll
                    for (int dt = 0; dt < 2; ++dt) {
                        bf16x8 vf;
#pragma unroll
                        for (int pp = 0; pp < 2; ++pp) {
                            const int i16 = lane & 15, db = (lane >> 4) & 1;
                            const int row = 16 * s + 8 * pp + 4 * hh + (i16 >> 2);
                            const int byte = 64 * dt + 32 * db + 8 * (i16 & 3);
                            const int chunk = (byte >> 4) ^ (((row >> 1) & 1) << 2);
                            const s16x4 t4 = __builtin_bit_cast(s16x4, __builtin_amdgcn_ds_read_tr16_b64_v4i16((LAS v4i16_t*)(Vw + row * 128 + (chunk << 4) + (byte & 15))));
                            vf[4 * pp + 0] = t4[0]; vf[4 * pp + 1] = t4[1]; vf[4 * pp + 2] = t4[2]; vf[4 * pp + 3] = t4[3];
                        }
                        O[dt] = __builtin_amdgcn_mfma_f32_32x32x16_bf16(vf, pf, O[dt], 0, 0, 0);
                    }
                }
                asm volatile("s_waitcnt lgkmcnt(0)" ::: "memory");
            }
            LAS unsigned char* xo = lds + AT_XO + qoff * AT_XO_STRIDE + 8 * hh;
            float wa = 0.f, wb = 1.f, Mx = ms, ln = l;
            if (pass > 0) { const float msa = XM[qoff], la = XL[qoff]; Mx = fmaxf(msa, ms); wa = la * __builtin_amdgcn_exp2f(msa - Mx); wb = __builtin_amdgcn_exp2f(ms - Mx); ln = wa + wb * l; }
            const float inv = 1.f / ln;
#pragma unroll
            for (int dt = 0; dt < 2; ++dt)
#pragma unroll
                for (int g4 = 0; g4 < 4; ++g4) {
                    LAS v2u* p = (LAS v2u*)(xo + (32 * dt + 8 * g4) * 2);
                    float o0 = O[dt][4 * g4] * wb, o1 = O[dt][4 * g4 + 1] * wb, o2 = O[dt][4 * g4 + 2] * wb, o3 = O[dt][4 * g4 + 3] * wb;
                    if (pass > 0) { const v2u old = *p; o0 += bflo(old.x) * wa; o1 += bfhi(old.x) * wa; o2 += bflo(old.y) * wa; o3 += bfhi(old.y) * wa; }
                    v2u nw; nw.x = pk2(o0 * inv, o1 * inv); nw.y = pk2(o2 * inv, o3 * inv);
                    *p = nw;
                }
            if (hh == 0) { XM[qoff] = Mx; XL[qoff] = ln; }
        }
        LDS_BARRIER();
    }
#pragma unroll
    for (int i = 0; i < 8; ++i) { const int row = (tid_ >> 3) + 64 * i, ch = tid_ & 7;
        LAS v2u* p = (LAS v2u*)(lds + AT_XO + row * AT_XO_STRIDE + ch * 16);
        const v2u a = p[0], c = p[1];
        v4u o; o.x = a.x; o.y = a.y; o.z = c.x; o.w = c.y;
        *(GAS v4u*)(Y + ((size_t)b * SEQ + t0 + row) * DM + RWW + h * 64 + ch * 8) = o; }
    LDS_BARRIER();
}

__device__ __forceinline__ void quantize_tables(Frame& F, int gw, int ngw) {
    for (int m = gw; m < 2 * NEXP; m += ngw) {
        const int tab = m >= NEXP, row = tab ? m - NEXP : m;
        const GAS f32x4* xr = (const GAS f32x4*)(F.in[18 + tab] + (size_t)row * DM) + F.lane * 4;
        f32x4 v[4]; float am = 0.f;
#pragma unroll
        for (int j = 0; j < 4; ++j) { v[j] = xr[j]; am = fmaxf(am, fmaxf(fmaxf(fabsf(v[j].x), fabsf(v[j].y)), fmaxf(fabsf(v[j].z), fabsf(v[j].w)))); }
        am = wave_max(am);
        const float qmax = tab ? 224.f : 127.f;
        const float sc = am > 0.f ? am / qmax : 1.f, inv = am > 0.f ? qmax / am : 0.f;
        v4u o;
#pragma unroll
        for (int j = 0; j < 4; ++j) {
            if (tab) { int w = __builtin_amdgcn_cvt_pk_fp8_f32(v[j].x * inv, v[j].y * inv, 0, false); w = __builtin_amdgcn_cvt_pk_fp8_f32(v[j].z * inv, v[j].w * inv, w, true); o[j] = (unsigned)w; }
            else {
            const unsigned b0 = (unsigned)(int)rintf(v[j].x * inv) & 255u, b1 = (unsigned)(int)rintf(v[j].y * inv) & 255u,
                           b2 = (unsigned)(int)rintf(v[j].z * inv) & 255u, b3 = (unsigned)(int)rintf(v[j].w * inv) & 255u;
            o[j] = b0 | (b1 << 8) | (b2 << 16) | (b3 << 24); } }
        *(GAS v4u*)(F.ws + (tab ? WS_VQ : WS_UQ) + (size_t)row * DM + F.lane * 16) = o;
        if (F.lane == 0) ((float*)(F.ws + (tab ? WS_SV : WS_SU)))[row] = sc;
    }
}

__device__ __forceinline__ void p3_mixers(Frame& F) {
    if (F.wg < NB * NHR) {
        const int chain = F.wg;
        const float* Pg = (const float*)(F.ws + WS_PQ) + (size_t)chain * 8 * 4096; const float* Qg = Pg + (size_t)256 * 4096;
        rwkv_scan<7>(F, Pg, Qg, (float*)(F.ws + WS_SSEG) + (size_t)chain * 8 * 4096, nullptr);
        __syncthreads();
    }
#ifndef ATTN_REPS
#define ATTN_REPS 1
#endif
    for (int rep = 0; rep < ATTN_REPS; ++rep)
    for (int item = F.wg; item < NB * NHA * (SEQ / 512); item += F.G) attn_block(F, item);
}

constexpr int TK_SKS = 272, TK_SKH = 0, TK_SKL = 2 * 128 * TK_SKS, TK_LUT = 2 * TK_SKL, TK_END = TK_LUT + 8 * 2048;
__device__ __forceinline__ unsigned f2ord(float f) { const unsigned u = __builtin_bit_cast(unsigned, f); return u ^ ((unsigned)((int)u >> 31) | 0x80000000u); }
__device__ __forceinline__ float ord2f(unsigned o) { const unsigned u = (o & 0x80000000u) ? (o ^ 0x80000000u) : ~o; return __builtin_bit_cast(float, u); }
__device__ __forceinline__ void ce_desc(unsigned& a, unsigned& b) { const unsigned mx = a > b ? a : b, mn = a > b ? b : a; a = mx; b = mn; }
template <int N, int OFF, int TOT> __device__ __forceinline__ void bitonic_sort_desc(unsigned (&v)[TOT]) {
#pragma unroll
    for (int k = 2; k <= N; k <<= 1)
#pragma unroll
        for (int j = k >> 1; j > 0; j >>= 1)
#pragma unroll
            for (int i = 0; i < N; ++i) { const int l = i ^ j; if (l > i) { if ((i & k) == 0) ce_desc(v[OFF + i], v[OFF + l]); else ce_desc(v[OFF + l], v[OFF + i]); } }
}
template <int OFFA, int OFFB, int TOT> __device__ __forceinline__ void merge_top16(unsigned (&v)[TOT]) {
#pragma unroll
    for (int i = 0; i < 16; ++i) { const unsigned x = v[OFFA + i], y = v[OFFB + 15 - i]; v[OFFA + i] = x > y ? x : y; }
#pragma unroll
    for (int j = 8; j > 0; j >>= 1)
#pragma unroll
        for (int i = 0; i < 16; ++i) { const int l = i ^ j; if (l > i) ce_desc(v[OFFA + i], v[OFFA + l]); }
}
__device__ __forceinline__ void top16_of_64(unsigned (&k)[64]) {
    bitonic_sort_desc<16, 0, 64>(k); bitonic_sort_desc<16, 16, 64>(k); bitonic_sort_desc<16, 32, 64>(k); bitonic_sort_desc<16, 48, 64>(k);
    merge_top16<0, 16, 64>(k); merge_top16<32, 48, 64>(k); merge_top16<0, 32, 64>(k);
}
__device__ __forceinline__ void p7_topk(Frame& F) {
    static_assert(TK_END <= LDSCTL_OFF, "topk LDS");
    const bf16* QP = (const bf16*)(F.ws + WS_QP);
    int* EID = (int*)(F.ws + WS_EID); float* GATE = (float*)(F.ws + WS_GATE);
    const float* sk = F.in[17];
    LAS unsigned char* lds = F.lds + RING_OFF;
    for (int e = F.tid; e < 2 * 128 * 64; e += NTHREADS) {
        const int c = e >> 13, k = (e >> 6) & 127, d2 = e & 63;
        const f32x2 v = *(const GAS f32x2*)(sk + (size_t)(c * 128 + k) * 128 + 2 * d2);
        const unsigned h0 = f2bf(v.x), h1 = f2bf(v.y);
        const float r0 = v.x - __builtin_bit_cast(float, h0 << 16), r1 = v.y - __builtin_bit_cast(float, h1 << 16);
        *(LAS unsigned*)(lds + TK_SKH + (c * 128 + k) * TK_SKS + d2 * 4) = h0 | (h1 << 16);
        *(LAS unsigned*)(lds + TK_SKL + (c * 128 + k) * TK_SKS + d2 * 4) = pk2(r0, r1);
    }
    __syncthreads();
    const int gw = F.wg * NWAVES + F.wave, NGW = F.G * NWAVES;
    for (int tile = gw; tile < T * PHEADS / 32; tile += NGW) {
        int lane_ = F.lane; asm volatile("" : "+v"(lane_));
        const int lane = lane_, hh = lane >> 5, cl = lane & 31;
        const int P = tile * 32 + cl, t = P >> 3, h = P & 7;
        unsigned kAB[2][16];
#pragma unroll
        for (int c = 0; c < 2; ++c) {
            bf16x8 qf[8];
            const bf16* qp = QP + (size_t)t * PQ + h * 256 + c * 128 + 8 * hh;
#pragma unroll
            for (int s2 = 0; s2 < 8; ++s2) qf[s2] = *(const GAS bf16x8*)(qp + 16 * s2);
            unsigned k[64];
#pragma unroll
            for (int mt = 0; mt < 4; ++mt) {
                f32x16 acc = zero16();
                const LAS unsigned char* ah = lds + TK_SKH + (c * 128 + mt * 32 + cl) * TK_SKS + 16 * hh;
                const LAS unsigned char* al = lds + TK_SKL + (c * 128 + mt * 32 + cl) * TK_SKS + 16 * hh;
#pragma unroll
                for (int s2 = 0; s2 < 8; ++s2) {
                    acc = __builtin_amdgcn_mfma_f32_32x32x16_bf16(*(const LAS bf16x8*)(ah + 32 * s2), qf[s2], acc, 0, 0, 0);
                    acc = __builtin_amdgcn_mfma_f32_32x32x16_bf16(*(const LAS bf16x8*)(al + 32 * s2), qf[s2], acc, 0, 0, 0); }
#pragma unroll
                for (int r = 0; r < 16; ++r) { const int idx = 32 * mt + (r & 3) + 8 * (r >> 2) + 4 * hh; k[mt * 16 + r] = (f2ord(acc[r]) & ~127u) | (unsigned)(127 - idx); }
            }
            top16_of_64(k);
            unsigned m[32];
#pragma unroll
            for (int i = 0; i < 16; ++i) { m[i] = k[i]; m[16 + i] = (unsigned)__shfl_xor((int)k[i], 32); }
            merge_top16<0, 16, 32>(m);
#pragma unroll
            for (int i = 0; i < 16; ++i) kAB[c][i] = m[i];
        }
        float fa[16], fb[16];
#pragma unroll
        for (int i = 0; i < 16; ++i) { fa[i] = ord2f(kAB[0][i] & ~127u); fb[i] = ord2f(kAB[1][i] & ~127u); }
        unsigned cd[64]; int n = 0;
#pragma unroll
        for (int i = 0; i < 16; ++i)
#pragma unroll
            for (int j = 0; j < 16; ++j) if ((i + 1) * (j + 1) <= 16) { cd[n] = (f2ord(fa[i] + fb[j]) & ~255u) | (unsigned)(255 - (i * 16 + j)); ++n; }
#pragma unroll
        for (int q = 50; q < 64; ++q) cd[q] = 0u;
        top16_of_64(cd);
        LAS unsigned char* lut = lds + TK_LUT + (F.wave * 64 + lane) * 32;
#pragma unroll
        for (int q = 0; q < 4; ++q) {
            unsigned wa = 0u, wb = 0u;
#pragma unroll
            for (int b4 = 0; b4 < 4; ++b4) { wa |= (127u - (kAB[0][4 * q + b4] & 127u)) << (8 * b4); wb |= (127u - (kAB[1][4 * q + b4] & 127u)) << (8 * b4); }
            *(LAS unsigned*)(lut + 4 * q) = wa; *(LAS unsigned*)(lut + 16 + 4 * q) = wb; }
        float gv[16]; float den = 0.f; const float mx = ord2f(cd[0] & ~255u);
#pragma unroll
        for (int q = 0; q < 16; ++q) { gv[q] = __expf(ord2f(cd[q] & ~255u) - mx); den += gv[q]; }
        const float inv = 1.f / den;
        asm volatile("s_waitcnt lgkmcnt(0)" ::: "memory");
        int ev[16];
#pragma unroll
        for (int q = 0; q < 16; ++q) { const unsigned pos = 255u - (cd[q] & 255u);
            const unsigned ia = *(const LAS unsigned char*)(lut + (pos >> 4)), ib = *(const LAS unsigned char*)(lut + 16 + (pos & 15u));
            ev[q] = (int)(ia * NKEYS + ib); }
        if (hh == 0) {
            int* ep = EID + (size_t)t * 128 + h * 16; float* gp = GATE + (size_t)t * 128 + h * 16;
#pragma unroll
            for (int q = 0; q < 4; ++q) {
                *(GAS v4u*)(ep + 4 * q) = (v4u){(unsigned)ev[4 * q], (unsigned)ev[4 * q + 1], (unsigned)ev[4 * q + 2], (unsigned)ev[4 * q + 3]};
                *(GAS f32x4*)(gp + 4 * q) = (f32x4){gv[4 * q] * inv, gv[4 * q + 1] * inv, gv[4 * q + 2] * inv, gv[4 * q + 3] * inv}; }
        }
        asm volatile("s_waitcnt lgkmcnt(0)" ::: "memory");
    }
}

constexpr int GA_WAVE_BYTES = 10752, GA_CNT = 4096, GA_OFF = 4096 + 128, GA_ACT = 4608, GA_XQ = 6656;
__device__ __forceinline__ int wave_sum_i(int v) { v += dppi<0xB1>(v); v += dppi<0x4E>(v); v += dppi<0x141>(v); v += dppi<0x140>(v);
    return (__builtin_amdgcn_readlane(v, 0) + __builtin_amdgcn_readlane(v, 16)) + (__builtin_amdgcn_readlane(v, 32) + __builtin_amdgcn_readlane(v, 48)); }
struct PairBuf { v4u u, v; float su, sv; int e; float g; };
__device__ __forceinline__ void p8_gather(Frame& F, float* outp) {
    const bf16* XN = (const bf16*)(F.ws + WS_XN);
    const unsigned char* UQ = F.ws + WS_UQ; const unsigned char* VQ = F.ws + WS_VQ;
    const float* SU = (const float*)(F.ws + WS_SU); const float* SV = (const float*)(F.ws + WS_SV);
    const int* EID = (const int*)(F.ws + WS_EID); const float* GATE = (const float*)(F.ws + WS_GATE);
    const float* nf = F.in[20];
    const int gw = F.wg * NWAVES + F.wave, NGW = F.G * NWAVES;
    LAS unsigned char* wl = F.lds + RING_OFF + F.wave * GA_WAVE_BYTES;
    for (int tg = gw, sweep = 0; tg < T / 4; tg += NGW, ++sweep) {
        int lane_ = F.lane; asm volatile("" : "+v"(lane_));
        const int lane = lane_;
        int xq[4][4]; float sx[4];
#pragma unroll
        for (int tk = 0; tk < 4; ++tk) {
            const GAS v4u* xp = (const GAS v4u*)(XN + (size_t)(4 * tg + tk) * DM + lane * 16);
            const v4u a = xp[0], b = xp[1];
            float x[16]; x[0] = bflo(a.x); x[1] = bfhi(a.x); x[2] = bflo(a.y); x[3] = bfhi(a.y); x[4] = bflo(a.z); x[5] = bfhi(a.z); x[6] = bflo(a.w); x[7] = bfhi(a.w);
            x[8] = bflo(b.x); x[9] = bfhi(b.x); x[10] = bflo(b.y); x[11] = bfhi(b.y); x[12] = bflo(b.z); x[13] = bfhi(b.z); x[14] = bflo(b.w); x[15] = bfhi(b.w);
            float am = 0.f;
#pragma unroll
            for (int i = 0; i < 16; ++i) am = fmaxf(am, fabsf(x[i]));
            am = wave_max(am);
            const float rs_ = frsq(((const float*)(F.ws + WS_SSQ))[4 * tg + tk] * (1.f / DM) + RMS_EPS);
            sx[tk] = (am > 0.f ? am * (1.f / 127.f) : 1.f) * rs_; const float inv = am > 0.f ? 127.f / am : 0.f;
#pragma unroll
            for (int q = 0; q < 4; ++q) {
                const unsigned b0 = (unsigned)(int)rintf(x[4 * q] * inv) & 255u, b1 = (unsigned)(int)rintf(x[4 * q + 1] * inv) & 255u, b2 = (unsigned)(int)rintf(x[4 * q + 2] * inv) & 255u, b3 = (unsigned)(int)rintf(x[4 * q + 3] * inv) & 255u;
                xq[tk][q] = (int)(b0 | (b1 << 8) | (b2 << 16) | (b3 << 24)); }
            *(LAS v4u*)(wl + GA_XQ + tk * 1024 + lane * 16) = (v4u){(unsigned)xq[tk][0], (unsigned)xq[tk][1], (unsigned)xq[tk][2], (unsigned)xq[tk][3]};
        }
        LAS unsigned* cnt = (LAS unsigned*)(wl + GA_CNT); LAS unsigned* offs = (LAS unsigned*)(wl + GA_OFF);
        if (lane < 32) cnt[lane] = 0u;
        asm volatile("s_waitcnt lgkmcnt(0)" ::: "memory");
        int ee[8]; float gg[8]; unsigned pos[8];
#pragma unroll
        for (int tk = 0; tk < 4; ++tk) {
            const size_t base = (size_t)(4 * tg + tk) * 128;
            ee[2 * tk] = (EID[base + lane] & (NEXP - 1)) | (tk << 14); ee[2 * tk + 1] = (EID[base + 64 + lane] & (NEXP - 1)) | (tk << 14);
            gg[2 * tk] = GATE[base + lane]; gg[2 * tk + 1] = GATE[base + 64 + lane]; }
#pragma unroll
        for (int q = 0; q < 8; ++q) pos[q] = __hip_atomic_fetch_add(cnt + ((ee[q] >> 9) & 31), 1u, __ATOMIC_RELAXED, __HIP_MEMORY_SCOPE_WAVEFRONT);
        asm volatile("s_waitcnt lgkmcnt(0)" ::: "memory");
        if (lane < 32) {
            const int c0 = (int)cnt[lane]; int v = c0;
            v += __builtin_amdgcn_update_dpp(0, v, 0x111, 0xF, 0xF, true); v += __builtin_amdgcn_update_dpp(0, v, 0x112, 0xF, 0xF, true);
            v += __builtin_amdgcn_update_dpp(0, v, 0x114, 0xF, 0xF, true); v += __builtin_amdgcn_update_dpp(0, v, 0x118, 0xF, 0xF, true);
            const int row0 = __builtin_amdgcn_readlane(v, 15);
            offs[lane] = (unsigned)(v - c0 + (lane >= 16 ? row0 : 0));
        }
        asm volatile("s_waitcnt lgkmcnt(0)" ::: "memory");
#pragma unroll
        for (int q = 0; q < 8; ++q) { const unsigned idx = offs[(ee[q] >> 9) & 31] + pos[q];
            *(LAS unsigned*)(wl + idx * 4) = (unsigned)ee[q]; *(LAS float*)(wl + 2048 + idx * 4) = gg[q]; }
        asm volatile("s_waitcnt lgkmcnt(0)" ::: "memory");
        LAS float* act = (LAS float*)(wl + GA_ACT);
        {
            const int grp = lane >> 4, l16 = lane & 15;
            const LAS unsigned* ents = (const LAS unsigned*)wl;
            LAS int* hbuf = (LAS int*)(wl + GA_ACT);
            v4u rb[2][2][4]; unsigned eb[2][2];
#define GA_ULOAD(ST, QD, Q_) do { const unsigned e_ = ents[(Q_) * 4 + grp]; eb[ST][QD] = e_; const GAS v4u* rp_ = (const GAS v4u*)(UQ + (size_t)(e_ & (NEXP - 1)) * DM + l16 * 64); \
                rb[ST][QD][0] = rp_[0]; rb[ST][QD][1] = rp_[1]; rb[ST][QD][2] = rp_[2]; rb[ST][QD][3] = rp_[3]; } while (0)
#define GA_UDOT(ST, QD, Q_) do { const LAS v4u* xp_ = (const LAS v4u*)(wl + GA_XQ + ((eb[ST][QD] >> 14) & 3u) * 1024 + l16 * 64); int d_ = 0; \
                _Pragma("unroll") for (int k_ = 0; k_ < 4; ++k_) { const v4u x_ = xp_[k_], r_ = rb[ST][QD][k_]; \
                    d_ = __builtin_amdgcn_sdot4((int)x_.x, (int)r_.x, d_, false); d_ = __builtin_amdgcn_sdot4((int)x_.y, (int)r_.y, d_, false); \
                    d_ = __builtin_amdgcn_sdot4((int)x_.z, (int)r_.z, d_, false); d_ = __builtin_amdgcn_sdot4((int)x_.w, (int)r_.w, d_, false); } \
                d_ += dppi<0xB1>(d_); d_ += dppi<0x4E>(d_); d_ += dppi<0x141>(d_); d_ += dppi<0x140>(d_); \
                if (l16 == 0) hbuf[(Q_) * 4 + grp] = d_; } while (0)
            GA_ULOAD(0, 0, 0); GA_ULOAD(0, 1, 1);
            for (int q2 = 0; q2 < 128; q2 += 4) {
                GA_ULOAD(1, 0, q2 + 2); GA_ULOAD(1, 1, q2 + 3);
                __builtin_amdgcn_sched_barrier(0);
                GA_UDOT(0, 0, q2); GA_UDOT(0, 1, q2 + 1);
                __builtin_amdgcn_sched_barrier(0);
                if (q2 + 4 < 128) { GA_ULOAD(0, 0, q2 + 4); GA_ULOAD(0, 1, q2 + 5); }
                __builtin_amdgcn_sched_barrier(0);
                GA_UDOT(1, 0, q2 + 2); GA_UDOT(1, 1, q2 + 3);
                __builtin_amdgcn_sched_barrier(0);
            }
#undef GA_ULOAD
#undef GA_UDOT
            asm volatile("s_waitcnt lgkmcnt(0)" ::: "memory");
#pragma unroll 2
            for (int it = 0; it < 8; ++it) { const int p = it * 64 + lane;
                const unsigned e_ = ents[p]; const float g_ = *(const LAS float*)(wl + 2048 + p * 4); const int hs = hbuf[p];
                const int ex_ = (int)(e_ & (NEXP - 1)), tk_ = (int)(e_ >> 14) & 3;
                const float sxl = tk_ == 0 ? sx[0] : (tk_ == 1 ? sx[1] : (tk_ == 2 ? sx[2] : sx[3]));
                const float h_ = (float)hs * (SU[ex_] * sxl);
                act[p] = 0.5f * h_ * (1.f + erff(h_ * 0.70710678118654752f)) * g_ * SV[ex_]; }
        }
        asm volatile("s_waitcnt lgkmcnt(0)" ::: "memory");
        float y[4][16];
#pragma unroll
        for (int tk = 0; tk < 4; ++tk) {
#pragma unroll
            for (int i = 0; i < 16; ++i) y[tk][i] = 0.f; }
#define GA_AXPY(V, A, TK) do { \
            _Pragma("unroll") for (int q_ = 0; q_ < 4; ++q_) { const int w_ = (int)(V)[q_]; const f32x2 lo_ = __builtin_amdgcn_cvt_pk_f32_fp8(w_, false), hi_ = __builtin_amdgcn_cvt_pk_f32_fp8(w_, true); \
                y[TK][4 * q_] += (A) * lo_.x; y[TK][4 * q_ + 1] += (A) * lo_.y; y[TK][4 * q_ + 2] += (A) * hi_.x; y[TK][4 * q_ + 3] += (A) * hi_.y; } } while (0)
        for (int ch = 0; ch < 8; ++ch) {
            const unsigned ent = *(const LAS unsigned*)(wl + (ch * 64 + lane) * 4);
            const float areg = act[ch * 64 + lane];
            v4u vb[2][8]; int eb[2][8];
#pragma unroll
            for (int q = 0; q < 8; ++q) { eb[0][q] = __builtin_amdgcn_readlane((int)ent, q); vb[0][q] = *(const GAS v4u*)(VQ + (size_t)(eb[0][q] & (NEXP - 1)) * DM + lane * 16); }
#pragma unroll
            for (int jb = 0; jb < 8; ++jb) {
                if (jb + 1 < 8) {
#pragma unroll
                    for (int q = 0; q < 8; ++q) { eb[(jb + 1) & 1][q] = __builtin_amdgcn_readlane((int)ent, 8 * (jb + 1) + q); vb[(jb + 1) & 1][q] = *(const GAS v4u*)(VQ + (size_t)(eb[(jb + 1) & 1][q] & (NEXP - 1)) * DM + lane * 16); } }
                __builtin_amdgcn_sched_barrier(0);
#pragma unroll
                for (int q = 0; q < 8; ++q) { const int tk_ = (eb[jb & 1][q] >> 14) & 3; const v4u v_ = vb[jb & 1][q]; const float a_ = rdlane(areg, 8 * jb + q);
                    if (tk_ == 0) GA_AXPY(v_, a_, 0); else if (tk_ == 1) GA_AXPY(v_, a_, 1); else if (tk_ == 2) GA_AXPY(v_, a_, 2); else GA_AXPY(v_, a_, 3); }
                __builtin_amdgcn_sched_barrier(0);
            }
        }
#undef GA_AXPY
#pragma unroll
        for (int tk = 0; tk < 4; ++tk) {
            float* hrow = F.out + (size_t)(4 * tg + tk) * DM + lane * 16;
            float hv[16]; float ss = 0.f;
#pragma unroll
            for (int q = 0; q < 4; ++q) { const f32x4 h4 = *(const GAS f32x4*)(hrow + 4 * q);
#pragma unroll
                for (int i = 0; i < 4; ++i) { const float v = h4[i] + y[tk][4 * q + i]; hv[4 * q + i] = v; ss += v * v; } }
            const float rstd = frsq(wave_sum(ss) * (1.f / DM) + RMS_EPS);
#pragma unroll
            for (int q = 0; q < 4; ++q) { const f32x4 n4 = *(const GAS f32x4*)(nf + lane * 16 + 4 * q);
                *(GAS f32x4*)(outp + (size_t)(4 * tg + tk) * DM + lane * 16 + 4 * q) = (f32x4){hv[4 * q] * rstd * n4[0], hv[4 * q + 1] * rstd * n4[1], hv[4 * q + 2] * rstd * n4[2], hv[4 * q + 3] * rstd * n4[3]}; }
        }
    }
}

struct Args { const float* in[21]; float* out; unsigned char* ws; int ph_lo, ph_hi; };
static_assert(sizeof(Args) == 21 * 8 + 8 + 8 + 8, "Args has no padding");

__global__ void __launch_bounds__(NTHREADS, 2) fwd_kernel(Args args) {
    extern __shared__ __attribute__((aligned(16))) unsigned char lds[];
    Frame F;
    F.lds = (LAS unsigned char*)lds;
    F.MISC = (volatile LAS unsigned*)(F.lds + MISC_OFF);
    F.tid = threadIdx.x; F.lane = F.tid & 63; F.wave = __builtin_amdgcn_readfirstlane(F.tid >> 6);
    F.G = gridDim.x; F.wg = blockIdx.x;
#pragma unroll
    for (int i = 0; i < 21; ++i) F.in[i] = args.in[i];
    F.out = args.out; F.ws = args.ws;
    F.ctl = (gu32*)(args.ws + WS_CTL);
    for (int u = F.tid; u < (LDS_BYTES - LDSCTL_OFF) / 4; u += NTHREADS) ((LAS unsigned*)(F.lds + LDSCTL_OFF))[u] = 0u;
    __syncthreads();
    const int lo = args.ph_lo, hi = args.ph_hi;
    const bool fused = (hi - lo) > 1;
    XcdBarrier bar; bar.bar = (unsigned*)(F.ctl + CW_BAR); bar.x = 0; bar.st = nullptr;
    if (fused) bar = xcd_barrier_post((unsigned*)(F.ctl + CW_BAR), F.MISC + 8);
#define IN(k) (lo <= (k) && (k) < hi)
#define REPS(k) (((REP_MASK >> (k)) & 1) ? 2 : 1)
#define REPLOOP(k) for (int rep_ = 0; rep_ < REPS(k); ++rep_, (rep_ < REPS(k) ? xcd_barrier(bar) : (void)0))
#define SEAM(k) do { if (IN(k) && IN((k) + 1)) xcd_barrier(bar); } while (0)

    if (IN(0)) { REPLOOP(0) { p0_prologue(F); p0_rope_table(F); } SEAM(0); }
    if (IN(1)) { REPLOOP(1) {
        pg8::Gemm g{(const bf16*)(F.ws + WS_XN), (const bf16*)(F.ws + WS_WIN), T, IN_COLS, DM}; pg8::StaticOrder S; S.init(T, IN_COLS, F.G, F.wg);
        pg8::EpiBf16 E{(bf16*)(F.ws + WS_Z), IN_COLS};
        pg8::gemm_phase<pg8::EpiBf16, pg8::StaticOrder, true, true>(F.lds + RING_OFF, g, S, E); }
        {
            const int nwg = (T / 256) * (IN_COLS / 256), rem = nwg % F.G;
            if (rem == 0) quantize_tables(F, F.wg * NWAVES + F.wave, F.G * NWAVES);
            else if (F.wg >= rem) quantize_tables(F, (F.wg - rem) * NWAVES + F.wave, (F.G - rem) * NWAVES);
        }
        SEAM(1);
    }
    if (IN(2)) { p2_rope(F); REPLOOP(2) { const int cnt = r13_count(F.wg, F.G); R1Pre P;
            if (cnt > 0) rwkv_r1_prefetch(F, r13_item(F.wg, F.G, 0), F.tid, P);
            bf16x8 bfr[4]; int hcur = -1;
            f32x4 cst[4];
            { const int n16 = F.lane & 15, g = F.lane >> 4;
#pragma unroll
              for (int rt = 0; rt < 4; ++rt)
#pragma unroll
                  for (int q = 0; q < 4; ++q) cst[rt][q] = (F.wave < 4 && 16 * rt + 4 * g + q == 16 * F.wave + n16) ? 1.f : 0.f; }
            for (int i = 0; i < cnt; ++i) { const int it = r13_item(F.wg, F.G, i), hh_ = (it >> 7) & 7;
                if (hh_ != hcur) { r1_load_bfrag(F, hh_, F.wave, F.lane, bfr); hcur = hh_; }
                rwkv_r1_item(F, it, i + 1 < cnt ? r13_item(F.wg, F.G, i + 1) : -1, P, bfr, cst); }
            { const int n16 = F.lane & 15, g = F.lane >> 4; float* Pg = (float*)(F.ws + WS_PQ) + (size_t)F.wg * 4096; float* Qg = Pg + (size_t)256 * 4096;
              if (F.wave < 4) {
#pragma unroll
                  for (int rt = 0; rt < 4; ++rt)
#pragma unroll
                      for (int q = 0; q < 4; ++q) Pg[(16 * rt + 4 * g + q) * 64 + 16 * F.wave + n16] = cst[rt][q];
              } else {
#pragma unroll
                  for (int rt = 0; rt < 4; ++rt) *(GAS f32x4*)(Qg + (16 * (F.wave - 4) + n16) * 64 + 16 * rt + 4 * g) = cst[rt];
              } } }
        SEAM(2); }
    if (IN(3)) { REPLOOP(3) p3_mixers(F); SEAM(3); }
    if (IN(4)) { REPLOOP(4) { const int cnt = r13_count(F.wg, F.G); R3Pre P;
            {
                const int item0 = r13_item(F.wg, F.G, 0);
                rwkv_scan<15>(F, F.out + (size_t)item0 * 4096, F.out + (size_t)T * RWW + (size_t)item0 * 4096, (float*)(F.ws + WS_RWSS) + (size_t)item0 * 4096, (const float*)(F.ws + WS_SSEG) + (size_t)F.wg * 4096);
                asm volatile("s_waitcnt vmcnt(0)" ::: "memory"); __syncthreads();
            }
            if (cnt > 0) rwkv_r3_prefetch(F, r13_item(F.wg, F.G, 0), F.tid, P);
            bf16x8 bfr[8]; int hcur = -1;
            for (int i = 0; i < cnt; ++i) { const int it = r13_item(F.wg, F.G, i), hh_ = (it >> 7) & 7;
                if (hh_ != hcur) { r3_load_bfrag(F, hh_, F.wave, F.lane, bfr); hcur = hh_; }
                rwkv_r3_item(F, it, i + 1 < cnt ? r13_item(F.wg, F.G, i + 1) : -1, P, bfr); } }
        SEAM(4); }
    if (IN(5)) {
        pg8::Gemm g{(const bf16*)(F.ws + WS_YMIX), (const bf16*)(F.ws + WS_WOUT), T, DM, DM}; pg8::StaticOrder S; S.init(T, DM, F.G, F.wg);
        pg8::EpiF32Res E{F.in[0], F.out, DM, (bf16*)(F.ws + WS_XN), F.in[15], (float*)(F.ws + WS_SSQ)};
        pg8::gemm_phase<pg8::EpiF32Res, pg8::StaticOrder, true, true>(F.lds + RING_OFF, g, S, E);
        SEAM(5);
    }
    if (IN(6)) { REPLOOP(6) {
        pg8::Gemm g{(const bf16*)(F.ws + WS_XN), (const bf16*)(F.ws + WS_WQ), T, PQ, DM}; pg8::StaticOrder S; S.init(T, PQ, F.G, F.wg);
        pg8::EpiBf16Rs E{(bf16*)(F.ws + WS_QP), PQ, (const float*)(F.ws + WS_SSQ)};
        pg8::gemm_phase<pg8::EpiBf16Rs, pg8::StaticOrder, true, true>(F.lds + RING_OFF, g, S, E); }
        SEAM(6);
    }
    if (IN(7)) { REPLOOP(7) p7_topk(F); SEAM(7); }
    if (IN(8)) { if (REPS(8) > 1) { p8_gather(F, (float*)(F.ws + WS_Z)); xcd_barrier(bar); } p8_gather(F, F.out); }
#undef IN
#undef SEAM
}

extern "C" void kernel_launch(void* const* d_in, const int* in_sizes, int n_in, void* d_out, int out_size, void* d_ws, size_t ws_size, hipStream_t stream) {
    static int grid = 0;
    if (grid == 0) {
        if (n_in != 21 || in_sizes[0] != T * DM || out_size != T * DM || ws_size < WS_END) {
            fprintf(stderr, "kernel_launch: unexpected shapes: n_in %d in0 %d out %d ws %zu (need %zu); nothing launched\n", n_in, n_in > 0 ? in_sizes[0] : -1, out_size, ws_size, (size_t)WS_END); grid = -1; return; }
        int dev = 0, cus = 0, per_cu = 0;
        if (hipGetDevice(&dev) != hipSuccess || hipDeviceGetAttribute(&cus, hipDeviceAttributeMultiprocessorCount, dev) != hipSuccess) { grid = -1; return; }
        if (hipFuncSetAttribute((const void*)fwd_kernel, hipFuncAttributeMaxDynamicSharedMemorySize, LDS_BYTES) != hipSuccess) { fprintf(stderr, "kernel_launch: hipFuncSetAttribute failed\n"); grid = -1; return; }
        if (hipOccupancyMaxActiveBlocksPerMultiprocessor(&per_cu, (const void*)fwd_kernel, NTHREADS, LDS_BYTES) != hipSuccess || per_cu < 1) { fprintf(stderr, "kernel_launch: occupancy query says %d\n", per_cu); per_cu = 1; }
        (void)hipGetLastError();
        grid = cus;
        if (cus != 256) { fprintf(stderr, "kernel_launch: the RWKV segment mapping assumes 256 CUs (got %d); nothing launched\n", cus); grid = -1; return; }
    }
    if (grid < 0) return;
    (void)hipMemsetAsync((char*)d_ws + WS_CTL, 0, CTL_ZERO_BYTES, stream);
    Args a{};
    for (int i = 0; i < 21; ++i) a.in[i] = (const float*)d_in[i];
    a.out = (float*)d_out; a.ws = (unsigned char*)d_ws;
    if (MK_N_LAUNCHES == 1) {
        a.ph_lo = 0; a.ph_hi = NPHASE;
        void* kargs[] = {&a};
        hipError_t e = hipLaunchCooperativeKernel((const void*)fwd_kernel, dim3(grid), dim3(NTHREADS), kargs, LDS_BYTES, stream);
        if (e != hipSuccess) fprintf(stderr, "kernel_launch: cooperative launch failed: %s (grid %d)\n", hipGetErrorString(e), grid);
    } else {
        for (int p = 0; p < NPHASE; ++p) { a.ph_lo = p; a.ph_hi = p + 1;
            hipLaunchKernelGGL(fwd_kernel, dim3(grid), dim3(NTHREADS), LDS_BYTES, stream, a); }
    }
}
```

```cpp
#include <hip/hip_runtime.h>
#include <cstdio>
#include <cstdint>

#ifndef MK_N_LAUNCHES
#define MK_N_LAUNCHES 1
#endif

#ifndef REP_MASK
#define REP_MASK 0
#endif
#define GAS __attribute__((address_space(1)))
#define LAS __attribute__((address_space(3)))
typedef unsigned short bf16;
typedef unsigned v4u __attribute__((ext_vector_type(4)));
typedef unsigned v2u __attribute__((ext_vector_type(2)));
typedef float f32x4 __attribute__((ext_vector_type(4)));
typedef float f32x2 __attribute__((ext_vector_type(2)));
typedef short bf16x8 __attribute__((ext_vector_type(8)));
typedef GAS unsigned gu32;
#define RLX_AGENT __ATOMIC_RELAXED, __HIP_MEMORY_SCOPE_AGENT
#define LDS_WAIT() asm volatile("s_waitcnt lgkmcnt(0)" ::: "memory")
#define VM_WAIT() asm volatile("s_waitcnt vmcnt(0)" ::: "memory")
#define LDS_BARRIER() do { asm volatile("s_waitcnt lgkmcnt(0)" ::: "memory"); __builtin_amdgcn_s_barrier(); asm volatile("" ::: "memory"); } while (0)

constexpr int DM = 1024, NB = 4, SEQ = 8192, T = NB * SEQ;
constexpr int HD = 64, RWW = 512, NHR = 8, NHA = 8;
constexpr int IN_COLS = 3328;
constexpr int C_R = 0, C_K = 512, C_V = 1024, C_WD = 1536, C_AD = 1600, C_GD = 1664, C_AQ = 1792, C_AK = 2304, C_AV = 2816;
constexpr int PHEADS = 8, NKEYS = 128, PQ = 2048, TOPK = 16, NEXP = 16384;
constexpr float RMS_EPS = 1e-6f, GN_EPS = 64e-5f;
constexpr int NWAVES = 8, NTHREADS = 512;
constexpr int NPHASE = 9;

constexpr size_t MiB = 1u << 20;
constexpr size_t WS_CTL = 0, CTL_ZERO_BYTES = 1 * MiB;
constexpr size_t WS_WIN = 2 * MiB;
constexpr size_t WS_WOUT = 10 * MiB;
constexpr size_t WS_WQ = 12 * MiB;
constexpr size_t WS_XN = 16 * MiB;
constexpr size_t WS_Z = 80 * MiB;
constexpr size_t WS_QP = 80 * MiB;
constexpr size_t WS_G = 288 * MiB;
constexpr size_t WS_YMIX = 352 * MiB;
constexpr size_t WS_UQ = 416 * MiB;
constexpr size_t WS_VQ = 432 * MiB;
constexpr size_t WS_SU = 448 * MiB;
constexpr size_t WS_SV = 449 * MiB;
constexpr size_t WS_EID = 480 * MiB;
constexpr size_t WS_GATE = 496 * MiB;
constexpr size_t WS_SSEG = 450 * MiB;
constexpr size_t WS_PQ = 456 * MiB;
constexpr size_t WS_END = 512 * MiB;
constexpr size_t WS_WUPT = 1 * MiB, WS_AUPT = WS_WUPT + 65536, WS_GUPT = WS_AUPT + 65536;
constexpr size_t WS_BONUS = 9 * MiB;
constexpr size_t WS_RWY0 = WS_XN;
constexpr size_t WS_RWSS = WS_G;
constexpr size_t WS_RWRH = WS_EID;

constexpr int CW_BAR = 4096;
constexpr size_t WS_SSQ = 256 * 1024;

typedef __bf16 hbf16x2_t __attribute__((ext_vector_type(2)));
__device__ __forceinline__ unsigned pk2(float lo, float hi) { const f32x2 v = {lo, hi}; const hbf16x2_t b = __builtin_convertvector(v, hbf16x2_t); return __builtin_bit_cast(unsigned, b); }
__device__ __forceinline__ unsigned f2bf(float f) { return pk2(f, 0.f) & 0xffffu; }
__device__ __forceinline__ float frcp(float x) { return __builtin_amdgcn_rcpf(x); }
__device__ __forceinline__ float frsq(float x) { return __builtin_amdgcn_rsqf(x); }
__device__ __forceinline__ float bflo(unsigned u) { return __builtin_bit_cast(float, u << 16); }
__device__ __forceinline__ float bfhi(unsigned u) { return __builtin_bit_cast(float, u & 0xffff0000u); }
__device__ __forceinline__ float bf2f(bf16 h) { return __builtin_bit_cast(float, (unsigned)h << 16); }

template <int CTRL> __device__ __forceinline__ float dppf(float x) { return __builtin_bit_cast(float, __builtin_amdgcn_update_dpp(0, __builtin_bit_cast(int, x), CTRL, 0xF, 0xF, true)); }
template <int CTRL> __device__ __forceinline__ int dppi(int x) { return __builtin_amdgcn_update_dpp(0, x, CTRL, 0xF, 0xF, true); }
__device__ __forceinline__ float rdlane(float v, int l) { return __builtin_bit_cast(float, __builtin_amdgcn_readlane(__builtin_bit_cast(int, v), l)); }
__device__ __forceinline__ float sum8(float v) { v += dppf<0xB1>(v); v += dppf<0x4E>(v); v += dppf<0x141>(v); return v; }
__device__ __forceinline__ float sum16(float v) { v = sum8(v); v += dppf<0x140>(v); return v; }
__device__ __forceinline__ float wave_sum(float v) { v = sum16(v);
    v += __builtin_bit_cast(float, __builtin_amdgcn_update_dpp(0, __builtin_bit_cast(int, v), 0x142, 0xA, 0xF, false));
    v += __builtin_bit_cast(float, __builtin_amdgcn_update_dpp(0, __builtin_bit_cast(int, v), 0x143, 0xC, 0xF, false));
    return rdlane(v, 63); }
__device__ __forceinline__ float wave_max(float v) {
    v = fmaxf(v, dppf<0xB1>(v)); v = fmaxf(v, dppf<0x4E>(v)); v = fmaxf(v, dppf<0x141>(v)); v = fmaxf(v, dppf<0x140>(v));
    return fmaxf(fmaxf(rdlane(v, 0), rdlane(v, 16)), fmaxf(rdlane(v, 32), rdlane(v, 48)));
}
__device__ __forceinline__ int wave_min_i(int v) {
    v = min(v, dppi<0xB1>(v)); v = min(v, dppi<0x4E>(v)); v = min(v, dppi<0x141>(v)); v = min(v, dppi<0x140>(v));
    return min(min(__builtin_amdgcn_readlane(v, 0), __builtin_amdgcn_readlane(v, 16)), min(__builtin_amdgcn_readlane(v, 32), __builtin_amdgcn_readlane(v, 48)));
}

namespace pg8 {
#define PG8_LAS __attribute__((address_space(3)))
typedef unsigned short bf16_t;
typedef unsigned u32x4 __attribute__((ext_vector_type(4)));
constexpr int BM = 256, BK = 64, HALF = 128, HTB = HALF * BK * 2, STAGE_BYTES = 8 * HTB, NXCD = 8, WGM = 8;
__host__ __device__ __forceinline__ int lds_byte(int r, int c) { const int st = (r >> 4) * 2 + (c >> 5), rr = r & 15, cc = c & 31, ob = rr * 64 + cc * 2; return st * 1024 + (ob ^ (((ob >> 9) & 1) << 5)); }
__host__ __device__ __forceinline__ void stage_rc(int b, int& R, int& C) { const int st = b / 1024, sb = b % 1024, swz = sb ^ (((sb >> 9) & 1) << 5); R = (st >> 1) * 16 + swz / 64; C = (st & 1) * 32 + (swz % 64) / 2; }
__host__ __device__ __forceinline__ int perm32(int rho) { const int n = rho >> 4, i = rho & 15; return 8 * (i >> 2) + 4 * n + (i & 3); }
struct Unit { int pm, pn; };
struct Gemm { const bf16_t* A; const bf16_t* Bt; int M, N, K; };
struct StaticOrder {
    int nM, nN, nwg, G, c;
    __host__ __device__ void init(int M, int N, int G_, int c_) { nM = M / BM; nN = N / BM; nwg = nM * nN; G = G_; c = c_; }
    __host__ __device__ bool next(int i, Unit& u) const {
        const long L = (long)i * G + c; if (L >= nwg) return false;
        int wgid = (int)L; { const int q = nwg / NXCD, r = nwg % NXCD, xcd = wgid % NXCD, off = wgid / NXCD; wgid = (xcd < r ? xcd * (q + 1) : r * (q + 1) + (xcd - r) * q) + off; }
        const int nig = WGM * nN, gid = wgid / nig, fm = gid * WGM, gsz = (nM - fm) < WGM ? (nM - fm) : WGM;
        u.pm = fm + ((wgid % nig) % gsz); u.pn = (wgid % nig) / gsz; return true;
    }
    __device__ __forceinline__ void a_ready(const Unit&) const {}
    __device__ __forceinline__ void done(const Unit&) const {}
};
__device__ __forceinline__ unsigned cvt_pk_bf16(float lo, float hi) { unsigned r; asm volatile("v_cvt_pk_bf16_f32 %0, %1, %2" : "=v"(r) : "v"(lo), "v"(hi)); return r; }
struct EpiBf16 {
    static constexpr bool PERM = true, AFTER_DRAIN = false;
    bf16_t* O; int ldc;
    __device__ __forceinline__ void operator()(const f32x4 (&acc)[2][2][4][2], const Unit& u, int wr, int wc, int fr, int fq) const {
        const int row0 = u.pm * BM + wr * 64 + fr; const int col0 = u.pn * BM + wc * 32 + 8 * fq;
#pragma unroll
        for (int ai = 0; ai < 2; ++ai)
#pragma unroll
            for (int m = 0; m < 4; ++m) { bf16_t* rowp = O + (size_t)(row0 + ai * HALF + m * 16) * ldc + col0;
#pragma unroll
                for (int bj = 0; bj < 2; ++bj) { const f32x4 v0 = acc[ai][bj][m][0], v1 = acc[ai][bj][m][1];
                    u32x4 w; w.x = cvt_pk_bf16(v0[0], v0[1]); w.y = cvt_pk_bf16(v0[2], v0[3]); w.z = cvt_pk_bf16(v1[0], v1[1]); w.w = cvt_pk_bf16(v1[2], v1[3]);
                    *(u32x4*)(rowp + bj * HALF) = w; } }
    }
};
struct EpiF32Res {
    static constexpr bool PERM = true, AFTER_DRAIN = false;
    const float* res; float* O; int ldc; bf16_t* HG; const float* gain; float* ssq;
    __device__ __forceinline__ void operator()(const f32x4 (&acc)[2][2][4][2], const Unit& u, int wr, int wc, int fr, int fq) const {
        const int row0 = u.pm * BM + wr * 64 + fr; const int col0 = u.pn * BM + wc * 32 + 8 * fq;
        f32x4 gv[2][2];
#pragma unroll
        for (int bj = 0; bj < 2; ++bj) { gv[bj][0] = *(const f32x4*)(gain + col0 + bj * HALF); gv[bj][1] = *(const f32x4*)(gain + col0 + bj * HALF + 4); }
#pragma unroll
        for (int ai = 0; ai < 2; ++ai)
#pragma unroll
            for (int m = 0; m < 4; ++m) { const int row = row0 + ai * HALF + m * 16; const size_t off = (size_t)row * ldc + col0; float sq = 0.f;
#pragma unroll
                for (int bj = 0; bj < 2; ++bj) { const f32x4 r0 = *(const f32x4*)(res + off + bj * HALF), r1 = *(const f32x4*)(res + off + bj * HALF + 4);
                    const f32x4 h0 = acc[ai][bj][m][0] + r0, h1 = acc[ai][bj][m][1] + r1;
                    *(f32x4*)(O + off + bj * HALF) = h0; *(f32x4*)(O + off + bj * HALF + 4) = h1;
                    sq += (h0[0] * h0[0] + h0[1] * h0[1]) + (h0[2] * h0[2] + h0[3] * h0[3]) + (h1[0] * h1[0] + h1[1] * h1[1]) + (h1[2] * h1[2] + h1[3] * h1[3]);
                    const f32x4 g0 = gv[bj][0], g1 = gv[bj][1];
                    u32x4 w; w.x = cvt_pk_bf16(h0[0] * g0[0], h0[1] * g0[1]); w.y = cvt_pk_bf16(h0[2] * g0[2], h0[3] * g0[3]); w.z = cvt_pk_bf16(h1[0] * g1[0], h1[1] * g1[1]); w.w = cvt_pk_bf16(h1[2] * g1[2], h1[3] * g1[3]);
                    *(u32x4*)(HG + off + bj * HALF) = w; }
                sq += __shfl_xor(sq, 16); sq += __shfl_xor(sq, 32);
                if (fq == 0) atomicAdd(ssq + row, sq); }
    }
};
struct EpiBf16Rs {
    static constexpr bool PERM = true, AFTER_DRAIN = false;
    bf16_t* O; int ldc; const float* ssq;
    __device__ __forceinline__ void operator()(const f32x4 (&acc)[2][2][4][2], const Unit& u, int wr, int wc, int fr, int fq) const {
        const int row0 = u.pm * BM + wr * 64 + fr; const int col0 = u.pn * BM + wc * 32 + 8 * fq;
#pragma unroll
        for (int ai = 0; ai < 2; ++ai)
#pragma unroll
            for (int m = 0; m < 4; ++m) { const int row = row0 + ai * HALF + m * 16; bf16_t* rowp = O + (size_t)row * ldc + col0;
                const float rs = __builtin_amdgcn_rsqf(ssq[row] * (1.f / 1024.f) + 1e-6f);
#pragma unroll
                for (int bj = 0; bj < 2; ++bj) { const f32x4 v0 = acc[ai][bj][m][0] * rs, v1 = acc[ai][bj][m][1] * rs;
                    u32x4 w; w.x = cvt_pk_bf16(v0[0], v0[1]); w.y = cvt_pk_bf16(v0[2], v0[3]); w.z = cvt_pk_bf16(v1[0], v1[1]); w.w = cvt_pk_bf16(v1[2], v1[3]);
                    *(u32x4*)(rowp + bj * HALF) = w; } }
    }
};

template <class Epi, class Sched, bool ALIGN_EPI = false, bool SP2 = false>
__device__ __forceinline__ void gemm_phase(PG8_LAS unsigned char* lds, const Gemm g, const Sched& S, const Epi& E) {
    const int tid = threadIdx.x, wid = __builtin_amdgcn_readfirstlane(tid >> 6), lane = tid & 63, wr = wid >> 2, wc = wid & 3, fr = lane & 15, fq = lane >> 4;
    const int K = g.K, nt = K / BK;
    unsigned voffA[2], voffB[2];
#pragma unroll
    for (int i = 0; i < 2; ++i) { int R, C; stage_rc(tid * 16 + i * 8192, R, C); const int Rb = Epi::PERM ? ((R & ~31) + perm32(R & 31)) : R;
        voffA[i] = (unsigned)(R * K + C) * 2u; voffB[i] = (unsigned)(Rb * K + C) * 2u; }
    const size_t kstep = (size_t)(BK * 2);
    const size_t hstep = (size_t)HALF * K * 2;
    const size_t tstep = 2 * hstep;
    const unsigned ldsw = (unsigned)wid * 1024u;
    const int aoff = lds_byte(wr * 64 + fr, fq * 8), boff = lds_byte(wc * 32 + fr, fq * 8);
#define PG8_SA(b, h) (((b) * 2 + (h)) * HTB)
#define PG8_SB(b, h) ((4 + (b) * 2 + (h)) * HTB)
#define PG8_STAGE(bufoff, gbase, voff) do { _Pragma("unroll") for (int _i = 0; _i < 2; ++_i) \
        __builtin_amdgcn_global_load_lds((const unsigned*)((const char*)(gbase) + (voff)[_i]), (PG8_LAS unsigned*)(lds + (bufoff) + ldsw + _i * 8192), 16, 0, 0); } while (0)
#define PG8_LDA(dst, b, h) do { _Pragma("unroll") for (int m = 0; m < 4; ++m) _Pragma("unroll") for (int k = 0; k < 2; ++k) dst[m][k] = *(const PG8_LAS bf16x8*)(lds + PG8_SA(b, h) + aoff + m * 2048 + k * 1024); } while (0)
#define PG8_LDB(dst, b, h) do { _Pragma("unroll") for (int n = 0; n < 2; ++n) _Pragma("unroll") for (int k = 0; k < 2; ++k) dst[n][k] = *(const PG8_LAS bf16x8*)(lds + PG8_SB(b, h) + boff + n * 2048 + k * 1024); } while (0)
#define PG8_MMA(ai, bj, At, Bt) do { __builtin_amdgcn_s_setprio(1); _Pragma("unroll") for (int m = 0; m < 4; ++m) _Pragma("unroll") for (int n = 0; n < 2; ++n) _Pragma("unroll") for (int k = 0; k < 2; ++k) \
        acc[ai][bj][m][n] = __builtin_amdgcn_mfma_f32_16x16x32_bf16(Bt[n][k], At[m][k], acc[ai][bj][m][n], 0, 0, 0); __builtin_amdgcn_s_setprio(0); } while (0)
#define PG8_WAIT_V(n) asm volatile("s_waitcnt vmcnt(" #n ")" ::: "memory")
#define PG8_WAIT_L(n) asm volatile("s_waitcnt lgkmcnt(" #n ")" ::: "memory")
#define PG8_BAR __builtin_amdgcn_s_barrier()
#define PG8_SCHED __builtin_amdgcn_sched_barrier(0)
    Unit cur, nxt; int ui = 0;
    if (!S.next(0, cur)) return;
    f32x4 acc[2][2][4][2];
#pragma unroll
    for (int a = 0; a < 2; ++a)
#pragma unroll
        for (int b = 0; b < 2; ++b)
#pragma unroll
            for (int m = 0; m < 4; ++m)
#pragma unroll
                for (int n = 0; n < 2; ++n) acc[a][b][m][n] = (f32x4){0.f, 0.f, 0.f, 0.f};
    bf16x8 At[4][2], B0[2][2], B1[2][2];
    const char* cA = (const char*)g.A + (size_t)cur.pm * tstep; const char* cB = (const char*)g.Bt + (size_t)cur.pn * tstep;
    S.a_ready(cur);
    if constexpr (SP2) {
        PG8_STAGE(PG8_SB(0, 0), cB, voffB); PG8_STAGE(PG8_SB(0, 1), cB + hstep, voffB); PG8_STAGE(PG8_SA(0, 0), cA, voffA); PG8_STAGE(PG8_SA(0, 1), cA + hstep, voffA);
        if (wr == 1) PG8_BAR;
        PG8_WAIT_V(2); PG8_BAR;
        PG8_STAGE(PG8_SB(1, 0), cB + kstep, voffB); PG8_STAGE(PG8_SA(1, 0), cA + kstep, voffA); PG8_STAGE(PG8_SB(1, 1), cB + hstep + kstep, voffB);
        PG8_WAIT_V(6); PG8_BAR;
    } else {
        PG8_STAGE(PG8_SB(0, 0), cB, voffB); PG8_STAGE(PG8_SA(0, 0), cA, voffA); PG8_STAGE(PG8_SB(0, 1), cB + hstep, voffB); PG8_STAGE(PG8_SA(0, 1), cA + hstep, voffA);
        if (wr == 1) PG8_BAR;
        PG8_WAIT_V(4); PG8_BAR;
        PG8_STAGE(PG8_SB(1, 0), cB + kstep, voffB); PG8_STAGE(PG8_SA(1, 0), cA + kstep, voffA); PG8_STAGE(PG8_SB(1, 1), cB + hstep + kstep, voffB);
        PG8_WAIT_V(6); PG8_BAR;
    }
    for (;;) {
        const bool has_next = S.next(ui + 1, nxt);
        const char* nA = has_next ? (const char*)g.A + (size_t)nxt.pm * tstep : cA; const char* nB = has_next ? (const char*)g.Bt + (size_t)nxt.pn * tstep : cB;
        for (int t = 0; t < nt; t += 2) {
            const bool last = (t == nt - 2);
            const char* a1 = cA + (size_t)(t + 1) * kstep;
            const char* a2 = last ? nA : cA + (size_t)(t + 2) * kstep; const char* b2 = last ? nB : cB + (size_t)(t + 2) * kstep;
            const char* a3 = a2 + kstep; const char* b3 = b2 + kstep;
            if (last && has_next) S.a_ready(nxt);
            if constexpr (SP2) {
            PG8_LDB(B0, 0, 0); PG8_LDB(B1, 0, 1); PG8_SCHED; PG8_LDA(At, 0, 0); PG8_STAGE(PG8_SA(1, 1), a1 + hstep, voffA);
            PG8_WAIT_V(8); PG8_WAIT_L(0); PG8_BAR; PG8_MMA(0, 0, At, B0); PG8_MMA(0, 1, At, B1); PG8_BAR; PG8_SCHED;
            PG8_LDA(At, 0, 1); PG8_STAGE(PG8_SB(0, 0), b2, voffB); PG8_STAGE(PG8_SB(0, 1), b2 + hstep, voffB); PG8_STAGE(PG8_SA(0, 0), a2, voffA);
            PG8_WAIT_V(8); PG8_WAIT_L(0); PG8_BAR; PG8_MMA(1, 0, At, B0); PG8_MMA(1, 1, At, B1); PG8_BAR; PG8_SCHED;
            PG8_LDB(B0, 1, 0); PG8_LDB(B1, 1, 1); PG8_SCHED; PG8_LDA(At, 1, 0); PG8_STAGE(PG8_SA(0, 1), a2 + hstep, voffA);
            PG8_WAIT_V(8); PG8_WAIT_L(0); PG8_BAR; PG8_MMA(0, 0, At, B0); PG8_MMA(0, 1, At, B1); PG8_BAR; PG8_SCHED;
            PG8_LDA(At, 1, 1); PG8_STAGE(PG8_SB(1, 0), b3, voffB); PG8_STAGE(PG8_SB(1, 1), b3 + hstep, voffB); PG8_STAGE(PG8_SA(1, 0), a3, voffA);
            PG8_WAIT_V(8); PG8_WAIT_L(0); PG8_BAR; PG8_MMA(1, 0, At, B0); PG8_MMA(1, 1, At, B1); PG8_BAR; PG8_SCHED;
            } else {
            PG8_LDB(B0, 0, 0); PG8_SCHED; PG8_LDA(At, 0, 0); PG8_STAGE(PG8_SA(1, 1), a1 + hstep, voffA);
            PG8_WAIT_L(8); PG8_BAR; PG8_WAIT_L(0); PG8_MMA(0, 0, At, B0); PG8_BAR; PG8_SCHED;
            PG8_LDB(B1, 0, 1); PG8_STAGE(PG8_SB(0, 0), b2, voffB);
            PG8_BAR; PG8_WAIT_L(0); PG8_MMA(0, 1, At, B1); PG8_BAR;
            PG8_LDA(At, 0, 1); PG8_STAGE(PG8_SA(0, 0), a2, voffA);
            PG8_BAR; PG8_WAIT_L(0); PG8_MMA(1, 0, At, B0); PG8_BAR; PG8_SCHED;
            PG8_STAGE(PG8_SB(0, 1), b2 + hstep, voffB);
            PG8_WAIT_V(6); PG8_BAR; PG8_MMA(1, 1, At, B1); PG8_BAR;
            PG8_LDB(B0, 1, 0); PG8_SCHED; PG8_LDA(At, 1, 0); PG8_STAGE(PG8_SA(0, 1), a2 + hstep, voffA);
            PG8_WAIT_L(8); PG8_BAR; PG8_WAIT_L(0); PG8_MMA(0, 0, At, B0); PG8_BAR; PG8_SCHED;
            PG8_LDB(B1, 1, 1); PG8_STAGE(PG8_SB(1, 0), b3, voffB);
            PG8_BAR; PG8_WAIT_L(0); PG8_MMA(0, 1, At, B1); PG8_BAR;
            PG8_LDA(At, 1, 1); PG8_STAGE(PG8_SA(1, 0), a3, voffA);
            PG8_BAR; PG8_WAIT_L(0); PG8_MMA(1, 0, At, B0); PG8_BAR; PG8_SCHED;
            PG8_STAGE(PG8_SB(1, 1), b3 + hstep, voffB);
            PG8_WAIT_V(6); PG8_BAR; PG8_MMA(1, 1, At, B1); PG8_BAR;
            }
        }
        if constexpr (ALIGN_EPI) { if (wr == 0) PG8_BAR; }
        if constexpr (!Epi::AFTER_DRAIN) { E(acc, cur, wr, wc, fr, fq); S.done(cur); }
        if (!has_next) break;
#pragma unroll
        for (int a = 0; a < 2; ++a)
#pragma unroll
            for (int b = 0; b < 2; ++b)
#pragma unroll
                for (int m = 0; m < 4; ++m)
#pragma unroll
                    for (int n = 0; n < 2; ++n) acc[a][b][m][n] = (f32x4){0.f, 0.f, 0.f, 0.f};
        cur = nxt; cA = nA; cB = nB; ++ui;
        if constexpr (ALIGN_EPI) { if (wr == 1) PG8_BAR; }
    }
    PG8_WAIT_V(0);
    if constexpr (!ALIGN_EPI) { if (wr == 0) PG8_BAR; }
    PG8_BAR;
#undef PG8_SA
#undef PG8_SB
#undef PG8_STAGE
#undef PG8_LDA
#undef PG8_LDB
#undef PG8_MMA
#undef PG8_WAIT_V
#undef PG8_WAIT_L
#undef PG8_BAR
#undef PG8_SCHED
}
}

#define XB_TMO      128
#define XB_XCNT(j)  (256  + 64 * (j))
#define XB_XSUB(j)  (1280 + 64 * (j))
#define XB_XGEN(j)  (2304 + 64 * (j))
#define XB_TOP      3328
#define XB_TOPGEN   3392
#define XCD_BAR_WORDS 3456
#define XB_SPIN_CAP (1u << 22)
__device__ __forceinline__ unsigned xb_ld(unsigned* p)              { return __hip_atomic_load(p, __ATOMIC_RELAXED, __HIP_MEMORY_SCOPE_AGENT); }
__device__ __forceinline__ unsigned xb_add(unsigned* p, unsigned v) { return __hip_atomic_fetch_add(p, v, __ATOMIC_RELAXED, __HIP_MEMORY_SCOPE_AGENT); }
__device__ __forceinline__ unsigned xb_xcc_id() { return (unsigned)__builtin_amdgcn_s_getreg((3 << 11) | 20) & 0xFu; }
#define XB_SPIN(cond, bar) do { unsigned _sp = 0; while (cond) { __builtin_amdgcn_s_sleep(1); \
    if ((++_sp & 255u) == 0u) { if (xb_ld(&(bar)[XB_TMO])) break; if (_sp > XB_SPIN_CAP) { atomicAdd(&(bar)[XB_TMO], 1u); break; } } } } while (0)
struct XcdBarrier { unsigned* bar; unsigned x; volatile LAS unsigned* st; };
__device__ __forceinline__ XcdBarrier xcd_barrier_post(unsigned* bar, volatile LAS unsigned* st) {
    XcdBarrier b; b.bar = bar; b.x = xb_xcc_id(); b.st = st;
    if (threadIdx.x == 0) (void)xb_add(&bar[XB_XCNT(b.x)], 1u);
    return b;
}
__device__ __forceinline__ void xcd_barrier_complete(unsigned* bar, unsigned x, unsigned& nloc, unsigned& nx) {
    const unsigned G = gridDim.x * gridDim.y * gridDim.z;
    unsigned sum, cnt, mine, sp = 0u;
    for (;;) {
        sum = 0u; cnt = 0u; mine = 0u;
#pragma unroll
        for (unsigned j = 0; j < 16; ++j) { const unsigned c = xb_ld(&bar[XB_XCNT(j)]); sum += c; cnt += (c > 0u) ? 1u : 0u; mine = (j == x) ? c : mine; }
        if (sum == G) break;
        __builtin_amdgcn_s_sleep(1);
        if ((++sp & 255u) == 0u) { if (xb_ld(&bar[XB_TMO])) break; if (sp > XB_SPIN_CAP) { atomicAdd(&bar[XB_TMO], 1u); break; } }
    }
    nloc = mine > 0u ? mine : 1u; nx = cnt > 0u ? cnt : 1u;
}
__device__ __forceinline__ void xcd_barrier(const XcdBarrier& b) {
    asm volatile("s_waitcnt vmcnt(0)" ::: "memory");
    __syncthreads();
    if (threadIdx.x == 0) {
        unsigned* bar = b.bar;
        __builtin_amdgcn_s_waitcnt(0);
        unsigned nloc = b.st[0], nx = b.st[1];
        if (nloc == 0u) { xcd_barrier_complete(bar, b.x, nloc, nx); b.st[0] = nloc; b.st[1] = nx; }
        const unsigned old = xb_add(&bar[XB_XSUB(b.x)], 1u);
        const unsigned gen = old / nloc;
        if (old + 1u == (gen + 1u) * nloc) {
            __builtin_amdgcn_fence(__ATOMIC_RELEASE, "agent");
            asm volatile("s_waitcnt vmcnt(0)" ::: "memory");
            const unsigned og = xb_add(&bar[XB_TOP], 1u);
            const unsigned tg = og / nx;
            if (og + 1u == (tg + 1u) * nx) xb_add(&bar[XB_TOPGEN], 1u);
            else XB_SPIN(xb_ld(&bar[XB_TOPGEN]) == tg, bar);
            __builtin_amdgcn_fence(__ATOMIC_ACQUIRE, "agent");
            xb_add(&bar[XB_XGEN(b.x)], 1u);
            asm volatile("s_waitcnt vmcnt(0)" ::: "memory");
        } else {
            XB_SPIN(xb_ld(&bar[XB_XGEN(b.x)]) == gen, bar);
            __builtin_amdgcn_fence(__ATOMIC_ACQUIRE, "agent");
            asm volatile("s_waitcnt vmcnt(0)" ::: "memory");
        }
    }
    __syncthreads();
}

constexpr int RING_OFF = 0, RING_BYTES = 131072;
constexpr int LDSCTL_OFF = 162816, MISC_OFF = LDSCTL_OFF + 320;
constexpr int LDS_BYTES = 163840;

struct Frame {
    LAS unsigned char* lds;
    volatile LAS unsigned* MISC;
    gu32* ctl;
    int tid, lane, wave, G, wg;
    const float* in[21];
    float* out;
    unsigned char* ws;
};

__device__ __forceinline__ void p0_transpose_item(const float* W, int K, int N, bf16* WT, LAS float* scr, int item, int lane) {
    const int nblk = N / 32, kb = item / nblk, nb = item % nblk, k0 = 64 * kb, n0 = 32 * nb;
#pragma unroll 8
    for (int i = 0; i < 32; ++i) { const int kk = 2 * i + (lane >> 5); scr[kk * 33 + (lane & 31)] = W[(size_t)(k0 + kk) * N + n0 + (lane & 31)]; }
    LDS_WAIT(); asm volatile("" ::: "memory");
    const int c = lane & 7;
#pragma unroll
    for (int j = 0; j < 4; ++j) { const int n = (lane >> 3) + 8 * j; const LAS float* s = scr + (8 * c) * 33 + n;
        v4u o; o.x = pk2(s[0 * 33], s[1 * 33]); o.y = pk2(s[2 * 33], s[3 * 33]); o.z = pk2(s[4 * 33], s[5 * 33]); o.w = pk2(s[6 * 33], s[7 * 33]);
        *(GAS v4u*)(WT + (size_t)(n0 + n) * K + k0 + 8 * c) = o; }
    LDS_WAIT(); asm volatile("" ::: "memory");
}
__device__ __forceinline__ void rms_row_to_bf16(int lane, const float* xrow, const float* gain, bf16* orow) {
    const GAS f32x4* xr = (const GAS f32x4*)xrow + lane;
    const GAS f32x4* gr = (const GAS f32x4*)gain + lane;
    f32x4 v[4]; float s = 0.f;
#pragma unroll
    for (int j = 0; j < 4; ++j) { v[j] = xr[64 * j]; s += (v[j].x * v[j].x + v[j].y * v[j].y) + (v[j].z * v[j].z + v[j].w * v[j].w); }
    const float rstd = frsq(wave_sum(s) * (1.f / DM) + RMS_EPS);
    GAS unsigned long long* o8 = (GAS unsigned long long*)orow + lane;
#pragma unroll
    for (int j = 0; j < 4; ++j) { const f32x4 gg = gr[64 * j];
        o8[64 * j] = (unsigned long long)pk2(v[j].x * rstd * gg.x, v[j].y * rstd * gg.y) | ((unsigned long long)pk2(v[j].z * rstd * gg.z, v[j].w * rstd * gg.w) << 32); }
}
__device__ __forceinline__ void cvt_row_to_bf16(int lane, const float* xrow, bf16* orow) {
    const GAS f32x4* xr = (const GAS f32x4*)xrow + lane;
    GAS unsigned long long* o8 = (GAS unsigned long long*)orow + lane;
#pragma unroll
    for (int j = 0; j < 4; ++j) { const f32x4 v = xr[64 * j]; o8[64 * j] = (unsigned long long)pk2(v.x, v.y) | ((unsigned long long)pk2(v.z, v.w) << 32); }
}
__device__ __forceinline__ void quantize_tables(Frame& F, int gw, int ngw);
__device__ __forceinline__ void p0_prologue(Frame& F) {
    LAS float* scr = (LAS float*)(F.lds + RING_OFF + F.wave * 16384);
    const int gw = F.wg * NWAVES + F.wave, NGW = F.G * NWAVES;
    constexpr int I_IN = (DM / 64) * (IN_COLS / 32), I_OUT = (DM / 64) * (DM / 32), I_Q = (DM / 64) * (PQ / 32);
    constexpr int NITEMS = I_IN + I_OUT + I_Q;
    bf16* win_t = (bf16*)(F.ws + WS_WIN); bf16* wout_t = (bf16*)(F.ws + WS_WOUT); bf16* wq_t = (bf16*)(F.ws + WS_WQ);
    for (int it = gw; it < NITEMS; it += NGW) {
        int r = it;
        if (r < I_IN) { p0_transpose_item(F.in[2], DM, IN_COLS, win_t, scr, r, F.lane); continue; } r -= I_IN;
        if (r < I_OUT) { p0_transpose_item(F.in[14], DM, DM, wout_t, scr, r, F.lane); continue; } r -= I_OUT;
        p0_transpose_item(F.in[16], DM, PQ, wq_t, scr, r, F.lane);
    }
    {
        constexpr int I_W = (64 / 64) * (RWW / 32), I_G = (128 / 64) * (RWW / 32);
        for (int it = gw; it < 2 * I_W + I_G; it += NGW) {
            int r = it;
            if (r < I_W) { p0_transpose_item(F.in[5], 64, RWW, (bf16*)(F.ws + WS_WUPT), scr, r, F.lane); continue; } r -= I_W;
            if (r < I_W) { p0_transpose_item(F.in[7], 64, RWW, (bf16*)(F.ws + WS_AUPT), scr, r, F.lane); continue; } r -= I_W;
            p0_transpose_item(F.in[8], 128, RWW, (bf16*)(F.ws + WS_GUPT), scr, r, F.lane);
        }
    }
    bf16* XN = (bf16*)(F.ws + WS_XN);
    for (int m = gw; m < T; m += NGW) rms_row_to_bf16(F.lane, F.in[0] + (size_t)m * DM, F.in[1], XN + (size_t)m * DM);
}

constexpr size_t WS_ROPE = WS_G;
__device__ __forceinline__ void p0_rope_table(Frame& F) {
    f32x2* tab = (f32x2*)(F.ws + WS_ROPE);
    for (int e = F.wg * NTHREADS + F.tid; e < SEQ * 32; e += F.G * NTHREADS) {
        const int sp = e >> 5, i = e & 31;
        const float inv_freq = powf(10000.0f, -(float)(2 * i) / 64.0f);
        const float ang = (float)sp * inv_freq;
        const double r = (double)ang - rint((double)ang * 0.15915494309189535) * 6.283185307179586;
        const float rf = (float)r;
        tab[e] = (f32x2){cosf(rf), sinf(rf)};
    }
}
__device__ __forceinline__ void p2_rope(Frame& F) {
    bf16* Z = (bf16*)(F.ws + WS_Z);
    const f32x2* tab = (const f32x2*)(F.ws + WS_ROPE);
    const int tid = F.tid, tk = tid >> 6, grp = (tid >> 2) & 15, i0 = (tid & 3) * 8;
    for (int blk = F.wg; blk < T / 8; blk += F.G) {
        const int g = blk * 8 + tk, sp = g & (SEQ - 1);
        bf16* p = Z + (size_t)g * IN_COLS + C_AQ + grp * 64 + i0;
        const v4u a = *(const GAS v4u*)p, b = *(const GAS v4u*)(p + 32);
        const GAS f32x4* tp = (const GAS f32x4*)(tab + sp * 32 + i0);
        float x1[8], x2[8];
        x1[0] = bflo(a.x); x1[1] = bfhi(a.x); x1[2] = bflo(a.y); x1[3] = bfhi(a.y); x1[4] = bflo(a.z); x1[5] = bfhi(a.z); x1[6] = bflo(a.w); x1[7] = bfhi(a.w);
        x2[0] = bflo(b.x); x2[1] = bfhi(b.x); x2[2] = bflo(b.y); x2[3] = bfhi(b.y); x2[4] = bflo(b.z); x2[5] = bfhi(b.z); x2[6] = bflo(b.w); x2[7] = bfhi(b.w);
        float o1[8], o2[8];
#pragma unroll
        for (int q = 0; q < 4; ++q) { const f32x4 cs = tp[q];
            o1[2 * q] = x1[2 * q] * cs[0] - x2[2 * q] * cs[1]; o2[2 * q] = x1[2 * q] * cs[1] + x2[2 * q] * cs[0];
            o1[2 * q + 1] = x1[2 * q + 1] * cs[2] - x2[2 * q + 1] * cs[3]; o2[2 * q + 1] = x1[2 * q + 1] * cs[3] + x2[2 * q + 1] * cs[2]; }
        v4u oa, ob; oa.x = pk2(o1[0], o1[1]); oa.y = pk2(o1[2], o1[3]); oa.z = pk2(o1[4], o1[5]); oa.w = pk2(o1[6], o1[7]);
        ob.x = pk2(o2[0], o2[1]); ob.y = pk2(o2[2], o2[3]); ob.z = pk2(o2[4], o2[5]); ob.w = pk2(o2[6], o2[7]);
        *(GAS v4u*)p = oa; *(GAS v4u*)(p + 32) = ob;
    }
}

typedef float f32x16 __attribute__((ext_vector_type(16)));
constexpr int SBS = 144;
constexpr int R1_EPRE = 0, R1_APRE = 16384, R1_AAB = 0, R1_X = 16384;
constexpr int R1_AT = 32768, R1_BT = 41984, R1_KT = 51200, R1_RT = 60416, R1_AHT = R1_BT, R1_U0T = R1_KT;
constexpr int R1_BBT = 69632, R1_KBT = 78848, R1_VT = 88064;
constexpr int R1_ACTW = 97280, R1_ACTA = 106496, R1_AAK = 97280, R1_ARB = 106496, R1_ARK = 115712;
constexpr int R1_BONUS = 124928, R1_WEND = 125184, R1_SEGS = 125440, R1_TII = 125440, R1_END = 129536;
static_assert(R1_END <= LDSCTL_OFF, "R1 LDS");
__device__ __forceinline__ int crow(int r, int hh) { return (r & 3) + 8 * (r >> 2) + 4 * hh; }
template <int KS> __device__ __forceinline__ f32x16 wtile(const LAS unsigned char* A, int sa, const LAS unsigned char* B, int sb, f32x16 acc, int lane) {
    const int row = lane & 31, hh = lane >> 5;
#pragma unroll
    for (int s = 0; s < KS; ++s) { const bf16x8 a = *(const LAS bf16x8*)(A + row * sa + 32 * s + 16 * hh); const bf16x8 b = *(const LAS bf16x8*)(B + row * sb + 32 * s + 16 * hh);
        acc = __builtin_amdgcn_mfma_f32_32x32x16_bf16(a, b, acc, 0, 0, 0); }
    return acc;
}
template <int KS> __device__ __forceinline__ f32x16 wtile_gb(const LAS unsigned char* A, int sa, const bf16* Bg, int ldb, f32x16 acc, int lane) {
    const int row = lane & 31, hh = lane >> 5;
#pragma unroll
    for (int s = 0; s < KS; ++s) { const bf16x8 a = *(const LAS bf16x8*)(A + row * sa + 32 * s + 16 * hh); const bf16x8 b = *(const GAS bf16x8*)(Bg + (size_t)row * ldb + 16 * s + 8 * hh);
        acc = __builtin_amdgcn_mfma_f32_32x32x16_bf16(a, b, acc, 0, 0, 0); }
    return acc;
}
__device__ __forceinline__ f32x16 zero16() { f32x16 z;
#pragma unroll
    for (int r = 0; r < 16; ++r) z[r] = 0.f;
    return z; }

struct R1Pre { v4u wd[2], ad[2], z[4]; };
__device__ __forceinline__ int r13_item(int wg, int G, int idx) { return (wg >> 3) * 128 + (wg & 7) * 16 + idx; }
__device__ __forceinline__ int r13_count(int wg, int G) { return 16; }
__device__ __forceinline__ void rwkv_r1_prefetch(Frame& F, int item, int tid, R1Pre& P) {
    const int chain = item >> 7, chunk = item & 127, b = chain >> 3, h = chain & 7, g0 = b * SEQ + chunk * 64;
    const bf16* Z = (const bf16*)(F.ws + WS_Z);
    const v4u z0 = (v4u){0u, 0u, 0u, 0u};
    { const int t = tid >> 3, cg = tid & 7; const bool first = (chunk == 0 && t == 0);
      const bf16* zr = Z + (size_t)(g0 + t) * IN_COLS;
      P.wd[0] = *(const GAS v4u*)(zr + C_WD + cg * 8); P.ad[0] = *(const GAS v4u*)(zr + C_AD + cg * 8);
      P.wd[1] = z0; P.ad[1] = z0;
      if (!first) { P.wd[1] = *(const GAS v4u*)(zr - IN_COLS + C_WD + cg * 8); P.ad[1] = *(const GAS v4u*)(zr - IN_COLS + C_AD + cg * 8); } }
#pragma unroll
    for (int q = 0; q < 4; ++q) { const int p = tid + 512 * q; P.z[q] = z0;
        if (p < 65 * 24) { const int row = p / 24, rem = p - row * 24, seg = rem >> 3, ch = rem & 7;
            if (!(chunk == 0 && row == 0)) P.z[q] = *(const GAS v4u*)(Z + (size_t)(g0 - 1 + row) * IN_COLS + seg * 512 + h * 64 + ch * 8); } }
}
constexpr int R1_ZS = R1_AT, R1_ZSS = 384;
static_assert(65 * R1_ZSS <= 4 * 9216, "ZS fits in the At..Rt region");
__device__ __forceinline__ void r1_load_bfrag(Frame& F, int h, int w, int lane, bf16x8 (&bf)[4]) {
    const int p = w >> 2, nt = w & 1; const bf16* upt = (const bf16*)(F.ws + (p == 0 ? WS_WUPT : WS_AUPT)) + (size_t)(h * 64 + nt * 32 + (lane & 31)) * 64 + 8 * (lane >> 5);
#pragma unroll
    for (int s2 = 0; s2 < 4; ++s2) bf[s2] = *(const GAS bf16x8*)(upt + 16 * s2);
}
constexpr int R1_CF = R1_AAB, R1_CN = R1_X;
__device__ __forceinline__ void rwkv_r1_item(Frame& F, int item, int next_item, R1Pre& P, const bf16x8 (&bfr)[4], f32x4 (&cst)[4]) {
    const int chain = item >> 7, chunk = item & 127, b = chain >> 3, h = chain & 7;
    const int g0 = b * SEQ + chunk * 64;
    int tid_ = F.tid; asm volatile("" : "+v"(tid_));
    const int tid = tid_, lane = tid & 63, w = __builtin_amdgcn_readfirstlane(tid >> 6), hh = lane >> 5, cl = lane & 31;
    const bf16* Z = (const bf16*)(F.ws + WS_Z);
    LAS unsigned char* lds = F.lds + RING_OFF;
    const float* mu = F.in[3];
    {
        const int t = tid >> 3, cg = tid & 7;
        const v4u cw = P.wd[0], ca = P.ad[0], pw = P.wd[1], pa = P.ad[1];
        float fw[8], fa[8], qw[8], qa[8];
        fw[0] = bflo(cw.x); fw[1] = bfhi(cw.x); fw[2] = bflo(cw.y); fw[3] = bfhi(cw.y); fw[4] = bflo(cw.z); fw[5] = bfhi(cw.z); fw[6] = bflo(cw.w); fw[7] = bfhi(cw.w);
        fa[0] = bflo(ca.x); fa[1] = bfhi(ca.x); fa[2] = bflo(ca.y); fa[3] = bfhi(ca.y); fa[4] = bflo(ca.z); fa[5] = bfhi(ca.z); fa[6] = bflo(ca.w); fa[7] = bfhi(ca.w);
        qw[0] = bflo(pw.x); qw[1] = bfhi(pw.x); qw[2] = bflo(pw.y); qw[3] = bfhi(pw.y); qw[4] = bflo(pw.z); qw[5] = bfhi(pw.z); qw[6] = bflo(pw.w); qw[7] = bfhi(pw.w);
        qa[0] = bflo(pa.x); qa[1] = bfhi(pa.x); qa[2] = bflo(pa.y); qa[3] = bfhi(pa.y); qa[4] = bflo(pa.z); qa[5] = bfhi(pa.z); qa[6] = bflo(pa.w); qa[7] = bfhi(pa.w);
#pragma unroll
        for (int j = 0; j < 8; ++j) { const int c = cg * 8 + j; const float xw = fw[j] + (qw[j] - fw[j]) * mu[C_WD + c];
            const float ex = __expf(2.f * xw); fw[j] = 1.f - 2.f * frcp(ex + 1.f);
            fa[j] = fa[j] + (qa[j] - fa[j]) * mu[C_AD + c]; }
        v4u ow, oa; ow.x = pk2(fw[0], fw[1]); ow.y = pk2(fw[2], fw[3]); ow.z = pk2(fw[4], fw[5]); ow.w = pk2(fw[6], fw[7]);
        oa.x = pk2(fa[0], fa[1]); oa.y = pk2(fa[2], fa[3]); oa.z = pk2(fa[4], fa[5]); oa.w = pk2(fa[6], fa[7]);
        *(LAS v4u*)(lds + R1_ACTW + t * SBS + cg * 16) = ow; *(LAS v4u*)(lds + R1_ACTA + t * SBS + cg * 16) = oa;
#pragma unroll
        for (int q = 0; q < 4; ++q) { const int p = tid + 512 * q;
            if (p < 65 * 24) { const int row = p / 24, rem = p - row * 24; *(LAS v4u*)(lds + R1_ZS + row * R1_ZSS + rem * 16) = P.z[q]; } }
        if (next_item >= 0) rwkv_r1_prefetch(F, next_item, tid, P);
    }
    LDS_BARRIER();
    {
        const int p = w >> 2, mt = (w >> 1) & 1, nt = w & 1;
        f32x16 acc = zero16();
        { const LAS unsigned char* A_ = lds + (p == 0 ? R1_ACTW : R1_ACTA) + mt * 32 * SBS + (lane & 31) * SBS + 16 * hh;
#pragma unroll
          for (int s2 = 0; s2 < 4; ++s2) acc = __builtin_amdgcn_mfma_f32_32x32x16_bf16(*(const LAS bf16x8*)(A_ + 32 * s2), bfr[s2], acc, 0, 0, 0); }
        LAS float* O = (LAS float*)(lds + (p == 0 ? R1_EPRE : R1_APRE));
#pragma unroll
        for (int r = 0; r < 16; ++r) O[(mt * 32 + crow(r, hh)) * 64 + nt * 32 + cl] = acc[r];
    }
    LDS_BARRIER();
    {
        const int c = tid & 63, ts = tid >> 6, col = h * 64 + c;
        const float mu_r = mu[C_R + col], mu_k = mu[C_K + col], mu_v = mu[C_V + col], kkc = F.in[9][col], kac = F.in[10][col], rkc = F.in[11][col], w0c = F.in[4][col], a0c = F.in[6][col];
        const LAS float* EP = (const LAS float*)(lds + R1_EPRE); const LAS float* AP = (const LAS float*)(lds + R1_APRE);
        LAS float* SEGS = (LAS float*)(lds + R1_SEGS); LAS float* BON = (LAS float*)(lds + R1_BONUS);
        const LAS bf16* zb = (const LAS bf16*)(lds + R1_ZS + (8 * ts) * R1_ZSS) + c;
        float pr = bf2f(zb[0]), pk = bf2f(zb[64]), pv = bf2f(zb[128]);
        float rr[8], k2[8], ai[8], bi[8], vv[8], ee[8], cs[8]; float run = 0.f;
#pragma unroll
        for (int i = 0; i < 8; ++i) {
            const float zr = bf2f(zb[(i + 1) * (R1_ZSS / 2)]), zk = bf2f(zb[(i + 1) * (R1_ZSS / 2) + 64]), zv = bf2f(zb[(i + 1) * (R1_ZSS / 2) + 128]);
            const float r = zr + (pr - zr) * mu_r, k = zk + (pk - zk) * mu_k, v = zv + (pv - zv) * mu_v; pr = zr; pk = zk; pv = zv;
            const float e = 0.60653066f * frcp(1.f + __expf(-(w0c + EP[(8 * ts + i) * 64 + c])));
            const float a = frcp(1.f + __expf(-(a0c + AP[(8 * ts + i) * 64 + c])));
            float kk = k * kkc; const float n2 = wave_sum(kk * kk); kk = kk * frsq(fmaxf(n2, 1e-24f));
            const float kq = k * (1.f + (a - 1.f) * kac);
            const float bon = wave_sum(r * kq * rkc); if (c == 0) BON[8 * ts + i] = bon;
            rr[i] = r; k2[i] = kq; ai[i] = -kk; bi[i] = kk * a; vv[i] = v; ee[i] = e; run += e; cs[i] = run;
        }
        SEGS[ts * 64 + c] = run;
        LDS_BARRIER();
        float off = 0.f, tot = 0.f;
#pragma unroll
        for (int q = 0; q < 8; ++q) { const float sv = SEGS[q * 64 + c]; tot += sv; off += (q < ts) ? sv : 0.f; }
        float bb[8], kb[8];
#pragma unroll
        for (int i = 0; i < 8; ++i) { const float L = off + cs[i];
            const float Wm = __expf(-(L - ee[i])), Wi = __expf(-L), iW = __expf(L), We = __expf(-(tot - L));
            const int t = 8 * ts + i;
            *(LAS bf16*)(lds + R1_AT + t * SBS + c * 2) = (bf16)f2bf(ai[i] * Wm);
            *(LAS bf16*)(lds + R1_BT + t * SBS + c * 2) = (bf16)f2bf(bi[i] * iW);
            *(LAS bf16*)(lds + R1_KT + t * SBS + c * 2) = (bf16)f2bf(k2[i] * iW);
            *(LAS bf16*)(lds + R1_RT + t * SBS + c * 2) = (bf16)f2bf(rr[i] * Wi);
            bb[i] = bi[i] * We; kb[i] = k2[i] * We; }
        v4u o; o.x = pk2(bb[0], bb[1]); o.y = pk2(bb[2], bb[3]); o.z = pk2(bb[4], bb[5]); o.w = pk2(bb[6], bb[7]);
        *(LAS v4u*)(lds + R1_BBT + c * SBS + ts * 16) = o;
        o.x = pk2(kb[0], kb[1]); o.y = pk2(kb[2], kb[3]); o.z = pk2(kb[4], kb[5]); o.w = pk2(kb[6], kb[7]);
        *(LAS v4u*)(lds + R1_KBT + c * SBS + ts * 16) = o;
        o.x = pk2(vv[0], vv[1]); o.y = pk2(vv[2], vv[3]); o.z = pk2(vv[4], vv[5]); o.w = pk2(vv[6], vv[7]);
        *(LAS v4u*)(lds + R1_VT + c * SBS + ts * 16) = o;
        if (ts == 0) ((LAS float*)(lds + R1_WEND))[c] = __expf(-tot);
    }
    LDS_BARRIER();
#pragma unroll
    for (int u = 0; u < 2; ++u) {
        const int idx = w * 2 + u, p = idx >> 2, mt = (idx >> 1) & 1, nt = idx & 1;
        const LAS unsigned char* Aop = lds + ((p == 0 || p == 2) ? R1_BT : R1_KT) + mt * 32 * SBS;
        const LAS unsigned char* Bop = lds + (p < 2 ? R1_AT : R1_RT) + nt * 32 * SBS;
        f32x16 acc = wtile<4>(Aop, SBS, Bop, SBS, zero16(), lane);
        const int n = nt * 32 + cl;
#pragma unroll
        for (int r = 0; r < 16; ++r) { const int m = mt * 32 + crow(r, hh); const bool keep = (p < 2) ? (m < n) : (m <= n); acc[r] = keep ? acc[r] : 0.f; }
#pragma unroll
        for (int g4 = 0; g4 < 4; ++g4) { const int m0 = mt * 32 + 8 * g4 + 4 * hh;
            if (p == 0) *(LAS f32x4*)(lds + R1_AAB + (n * 64 + m0) * 4) = (f32x4){acc[4 * g4], acc[4 * g4 + 1], acc[4 * g4 + 2], acc[4 * g4 + 3]};
            else { v2u o; o.x = pk2(acc[4 * g4], acc[4 * g4 + 1]); o.y = pk2(acc[4 * g4 + 2], acc[4 * g4 + 3]);
                   *(LAS v2u*)(lds + (p == 1 ? R1_AAK : (p == 2 ? R1_ARB : R1_ARK)) + n * SBS + m0 * 2) = o; } }
    }
    LDS_BARRIER();
    if (w < 4) {
        const int mt = w >> 1, nt = w & 1;
        const f32x16 acc = wtile<4>(lds + R1_AAK + mt * 32 * SBS, SBS, lds + R1_VT + nt * 32 * SBS, SBS, zero16(), lane);
        LAS float* X = (LAS float*)(lds + R1_X);
#pragma unroll
        for (int r = 0; r < 16; ++r) X[(mt * 32 + crow(r, hh)) * 64 + nt * 32 + cl] = acc[r];
    } else if (w == 4) {
        const int bk = lane >> 4, c = lane & 15;
        const LAS float* AAB = (const LAS float*)(lds + R1_AAB);
        float Tc[16]; const float fc = (float)c;
#pragma unroll
        for (int s2 = 0; s2 < 16; ++s2) Tc[s2] = fmaxf(0.f, 1.f - fabsf((float)s2 - fc));
#pragma unroll
        for (int r = 0; r < 15; ++r)
#pragma unroll
            for (int s2 = r + 1; s2 < 16; ++s2) Tc[s2] += AAB[(16 * bk + s2) * 64 + 16 * bk + r] * Tc[r];
        LAS float* TII = (LAS float*)(lds + R1_TII);
#pragma unroll
        for (int s2 = 0; s2 < 16; ++s2) TII[(bk * 16 + s2) * 16 + c] = Tc[s2];
    }
    LDS_BARRIER();
    {
        const int c16 = lane & 15, g = lane >> 4;
        const LAS float* AAB = (const LAS float*)(lds + R1_AAB); const LAS float* TII = (const LAS float*)(lds + R1_TII); const LAS float* X = (const LAS float*)(lds + R1_X);
        f32x4 o[4];
#pragma unroll
        for (int i = 0; i < 4; ++i) {
            f32x4 acc;
            if (w < 4) {
#pragma unroll
                for (int q = 0; q < 4; ++q) acc[q] = bf2f(*(const LAS bf16*)(lds + R1_AT + (16 * i + 4 * g + q) * SBS + (16 * w + c16) * 2));
            } else {
#pragma unroll
                for (int q = 0; q < 4; ++q) acc[q] = X[(16 * i + 4 * g + q) * 64 + 16 * (w - 4) + c16];
            }
#pragma unroll
            for (int j = 0; j < i; ++j) { const f32x4 a4 = *(const LAS f32x4*)(AAB + (16 * i + c16) * 64 + 16 * j + 4 * g);
#pragma unroll
                for (int q = 0; q < 4; ++q) acc = __builtin_amdgcn_mfma_f32_16x16x4f32(a4[q], o[j][q], acc, 0, 0, 0); }
            const f32x4 t4 = *(const LAS f32x4*)(TII + (i * 16 + c16) * 16 + 4 * g);
            f32x4 res = (f32x4){0.f, 0.f, 0.f, 0.f};
#pragma unroll
            for (int q = 0; q < 4; ++q) res = __builtin_amdgcn_mfma_f32_16x16x4f32(t4[q], acc[q], res, 0, 0, 0);
            o[i] = res;
            v2u ov; ov.x = pk2(res[0], res[1]); ov.y = pk2(res[2], res[3]);
            *(LAS v2u*)(lds + (w < 4 ? R1_AHT : R1_U0T) + (16 * (w & 3) + c16) * SBS + (16 * i + 4 * g) * 2) = ov;
        }
    }
    LDS_BARRIER();
    {
        float* Mg = F.out + (size_t)item * 4096; float* NTg = F.out + (size_t)T * RWW + (size_t)item * 4096;
        float* Y0g = (float*)(F.ws + WS_RWY0) + (size_t)item * 4096; bf16* RHg = (bf16*)(F.ws + WS_RWRH) + (size_t)item * 4096;
#pragma unroll
        for (int u = 0; u < 2; ++u) {
            const int idx = w * 2 + u, p = idx >> 2, mt = (idx >> 1) & 1, nt = idx & 1; const int n = nt * 32 + cl;
            if (p == 0) {
                f32x16 acc = wtile<4>(lds + R1_AHT + mt * 32 * SBS, SBS, lds + R1_BBT + nt * 32 * SBS, SBS, zero16(), lane);
                const float we = ((const LAS float*)(lds + R1_WEND))[n];
#pragma unroll
                for (int g4 = 0; g4 < 4; ++g4) { const int m0 = mt * 32 + 8 * g4 + 4 * hh;
                    const f32x4 mv = (f32x4){acc[4 * g4] + (m0 == n ? we : 0.f), acc[4 * g4 + 1] + (m0 + 1 == n ? we : 0.f), acc[4 * g4 + 2] + (m0 + 2 == n ? we : 0.f), acc[4 * g4 + 3] + (m0 + 3 == n ? we : 0.f)};
                    *(GAS f32x4*)(Mg + n * 64 + m0) = mv;
                    v2u h_; h_.x = pk2(mv[0], mv[1]); h_.y = pk2(mv[2], mv[3]);
                    v2u l_; l_.x = pk2(mv[0] - bflo(h_.x), mv[1] - bfhi(h_.x)); l_.y = pk2(mv[2] - bflo(h_.y), mv[3] - bfhi(h_.y));
                    LAS unsigned char* fp_ = lds + R1_CF + (((n >> 4) * 2 + (m0 >> 5)) * 2) * 1024 + ((((m0 >> 2) & 3) * 16) + (n & 15)) * 16 + ((m0 >> 4) & 1) * 8;
                    *(LAS v2u*)fp_ = h_; *(LAS v2u*)(fp_ + 1024) = l_; }
            } else if (p == 1) {
                f32x16 acc = wtile<4>(lds + R1_BBT + mt * 32 * SBS, SBS, lds + R1_U0T + nt * 32 * SBS, SBS, zero16(), lane);
                acc = wtile<4>(lds + R1_KBT + mt * 32 * SBS, SBS, lds + R1_VT + nt * 32 * SBS, SBS, acc, lane);
#pragma unroll
                for (int g4 = 0; g4 < 4; ++g4) { const f32x4 nv_ = (f32x4){acc[4 * g4], acc[4 * g4 + 1], acc[4 * g4 + 2], acc[4 * g4 + 3]};
                    *(GAS f32x4*)(NTg + n * 64 + mt * 32 + 8 * g4 + 4 * hh) = nv_; *(LAS f32x4*)(lds + R1_CN + (n * 64 + mt * 32 + 8 * g4 + 4 * hh) * 4) = nv_; }
            } else if (p == 2) {
                f32x16 acc = wtile<4>(lds + R1_AHT + mt * 32 * SBS, SBS, lds + R1_ARB + nt * 32 * SBS, SBS, zero16(), lane);
#pragma unroll
                for (int g4 = 0; g4 < 4; ++g4) { const int m0 = mt * 32 + 8 * g4 + 4 * hh;
                    const v2u rt = *(const LAS v2u*)(lds + R1_RT + n * SBS + m0 * 2);
                    v2u ov; ov.x = pk2(acc[4 * g4] + bflo(rt.x), acc[4 * g4 + 1] + bfhi(rt.x)); ov.y = pk2(acc[4 * g4 + 2] + bflo(rt.y), acc[4 * g4 + 3] + bfhi(rt.y));
                    *(GAS v2u*)(RHg + n * 64 + m0) = ov; }
            } else {
                f32x16 acc = wtile<4>(lds + R1_U0T + mt * 32 * SBS, SBS, lds + R1_ARB + nt * 32 * SBS, SBS, zero16(), lane);
                acc = wtile<4>(lds + R1_VT + mt * 32 * SBS, SBS, lds + R1_ARK + nt * 32 * SBS, SBS, acc, lane);
#pragma unroll
                for (int g4 = 0; g4 < 4; ++g4) *(GAS f32x4*)(Y0g + n * 64 + mt * 32 + 8 * g4 + 4 * hh) = (f32x4){acc[4 * g4], acc[4 * g4 + 1], acc[4 * g4 + 2], acc[4 * g4 + 3]};
            }
        }
        if (tid < 64) ((float*)(F.ws + WS_BONUS))[(size_t)item * 64 + tid] = ((const LAS float*)(lds + R1_BONUS))[tid];
    }
    LDS_BARRIER();
    {
        const int n16 = lane & 15, g = lane >> 4;
        bf16x8 sh[2], sl[2];
#pragma unroll
        for (int ks = 0; ks < 2; ++ks) { const f32x4 a = cst[2 * ks], b = cst[2 * ks + 1];
            v4u h_; h_.x = pk2(a[0], a[1]); h_.y = pk2(a[2], a[3]); h_.z = pk2(b[0], b[1]); h_.w = pk2(b[2], b[3]);
            v4u l_; l_.x = pk2(a[0] - bflo(h_.x), a[1] - bfhi(h_.x)); l_.y = pk2(a[2] - bflo(h_.y), a[3] - bfhi(h_.y)); l_.z = pk2(b[0] - bflo(h_.z), b[1] - bfhi(h_.z)); l_.w = pk2(b[2] - bflo(h_.w), b[3] - bfhi(h_.w));
            sh[ks] = __builtin_bit_cast(bf16x8, h_); sl[ks] = __builtin_bit_cast(bf16x8, l_); }
        f32x4 nw[4];
#pragma unroll
        for (int rt = 0; rt < 4; ++rt) { f32x4 acc = (f32x4){0.f, 0.f, 0.f, 0.f};
            if (w >= 4) acc = *(const LAS f32x4*)(lds + R1_CN + ((16 * (w - 4) + n16) * 64 + 16 * rt + 4 * g) * 4);
#pragma unroll
            for (int ks = 0; ks < 2; ++ks) {
                const bf16x8 mh = *(const LAS bf16x8*)(lds + R1_CF + ((rt * 2 + ks) * 2) * 1024 + lane * 16), ml = *(const LAS bf16x8*)(lds + R1_CF + ((rt * 2 + ks) * 2 + 1) * 1024 + lane * 16);
                acc = __builtin_amdgcn_mfma_f32_16x16x32_bf16(mh, sh[ks], acc, 0, 0, 0);
                acc = __builtin_amdgcn_mfma_f32_16x16x32_bf16(mh, sl[ks], acc, 0, 0, 0);
                acc = __builtin_amdgcn_mfma_f32_16x16x32_bf16(ml, sh[ks], acc, 0, 0, 0); }
            nw[rt] = acc; }
#pragma unroll
        for (int rt = 0; rt < 4; ++rt) cst[rt] = nw[rt];
    }
    LDS_BARRIER();
}

constexpr int R2_RS = 272, R2_SLOT = 2 * 64 * R2_RS;
static_assert(2 * R2_SLOT <= LDSCTL_OFF, "R2 LDS");
template <int NSTEP, int R2_D> __device__ __forceinline__ void rwkv_scan(Frame& F, const float* Mg, const float* NTg, float* SSg, const float* S0g) {
    int tid_ = F.tid; asm volatile("" : "+v"(tid_));
    const int lane = tid_ & 63, w = __builtin_amdgcn_readfirstlane(tid_ >> 6);
    LAS unsigned char* lds = F.lds + RING_OFF;
    if (w >= 4) {
        const int L = w - 4, r = lane >> 2, f0 = (lane & 3) * 4;
        const size_t goff = (size_t)(16 * L + r) * 64 + f0 * 4;
        const int loff = (16 * L + r) * R2_RS + f0 * 16;
        f32x4 R[R2_D][8];
#define R2_ISSUE(slot_, step_) do { const int st_ = (step_) < NSTEP ? (step_) : NSTEP - 1; const float* mp_ = Mg + (size_t)st_ * 4096 + goff; const float* np_ = NTg + (size_t)st_ * 4096 + goff; \
            _Pragma("unroll") for (int k_ = 0; k_ < 4; ++k_) { R[slot_][k_] = *(const GAS f32x4*)(mp_ + 4 * k_); R[slot_][4 + k_] = *(const GAS f32x4*)(np_ + 4 * k_); } } while (0)
        const int q_ = lane & 3, froff = ((L * 2 + (q_ >> 1)) * 2) * 1024 + r * 16 + (q_ & 1) * 8;
#define R2_WRITE(slot_, buf_) do { LAS unsigned char* d_ = lds + (buf_) * R2_SLOT; \
            _Pragma("unroll") for (int k_ = 0; k_ < 4; ++k_) { const f32x4 a_ = R[slot_][k_]; \
                v2u h_; h_.x = pk2(a_[0], a_[1]); h_.y = pk2(a_[2], a_[3]); \
                v2u l_; l_.x = pk2(a_[0] - bflo(h_.x), a_[1] - bfhi(h_.x)); l_.y = pk2(a_[2] - bflo(h_.y), a_[3] - bfhi(h_.y)); \
                *(LAS v2u*)(d_ + froff + k_ * 256) = h_; *(LAS v2u*)(d_ + froff + 1024 + k_ * 256) = l_; \
                *(LAS f32x4*)(d_ + 64 * R2_RS + loff + 16 * k_) = R[slot_][4 + k_]; } } while (0)
#pragma unroll
        for (int u = 0; u < R2_D; ++u) R2_ISSUE(u, u);
        R2_WRITE(0, 0);
        R2_ISSUE(0, R2_D);
        LDS_BARRIER();
        int c0 = 0;
        for (; c0 + R2_D <= NSTEP - 1; c0 += R2_D) {
#pragma unroll
            for (int u = 0; u < R2_D; ++u) { const int c = c0 + u;
                R2_WRITE((u + 1) % R2_D, (c + 1) & 1);
                R2_ISSUE((u + 1) % R2_D, c + 1 + R2_D);
                LDS_BARRIER(); }
        }
#pragma unroll
        for (int u = 0; u < R2_D; ++u) { const int c = c0 + u;
            if (c < NSTEP - 1) { R2_WRITE((u + 1) % R2_D, (c + 1) & 1); LDS_BARRIER(); } }
        LDS_BARRIER();
#undef R2_ISSUE
#undef R2_WRITE
        return;
    }
    const int n16 = lane & 15, g = lane >> 4;
    f32x4 st[4];
#pragma unroll
    for (int rt = 0; rt < 4; ++rt) st[rt] = S0g ? *(const GAS f32x4*)(S0g + (16 * w + n16) * 64 + 16 * rt + 4 * g) : (f32x4){0.f, 0.f, 0.f, 0.f};
    LDS_BARRIER();
    for (int c = 0; c < NSTEP; ++c) {
#pragma unroll
        for (int rt = 0; rt < 4; ++rt) *(GAS f32x4*)(SSg + (size_t)c * 4096 + (16 * w + n16) * 64 + 16 * rt + 4 * g) = st[rt];
        const LAS unsigned char* sl_ = lds + (c & 1) * R2_SLOT;
        bf16x8 sh[2], sl[2];
#pragma unroll
        for (int ks = 0; ks < 2; ++ks) { const f32x4 a = st[2 * ks], b = st[2 * ks + 1];
            v4u h; h.x = pk2(a[0], a[1]); h.y = pk2(a[2], a[3]); h.z = pk2(b[0], b[1]); h.w = pk2(b[2], b[3]);
            v4u l; l.x = pk2(a[0] - bflo(h.x), a[1] - bfhi(h.x)); l.y = pk2(a[2] - bflo(h.y), a[3] - bfhi(h.y)); l.z = pk2(b[0] - bflo(h.z), b[1] - bfhi(h.z)); l.w = pk2(b[2] - bflo(h.w), b[3] - bfhi(h.w));
            sh[ks] = __builtin_bit_cast(bf16x8, h); sl[ks] = __builtin_bit_cast(bf16x8, l); }
        f32x4 nw[4];
#pragma unroll
        for (int rt = 0; rt < 4; ++rt) { f32x4 acc = *(const LAS f32x4*)(sl_ + 64 * R2_RS + (16 * w + n16) * R2_RS + (16 * rt + 4 * g) * 4);
#pragma unroll
            for (int ks = 0; ks < 2; ++ks) {
                const bf16x8 mh = *(const LAS bf16x8*)(sl_ + ((rt * 2 + ks) * 2) * 1024 + lane * 16), ml = *(const LAS bf16x8*)(sl_ + ((rt * 2 + ks) * 2 + 1) * 1024 + lane * 16);
                acc = __builtin_amdgcn_mfma_f32_16x16x32_bf16(mh, sh[ks], acc, 0, 0, 0);
                acc = __builtin_amdgcn_mfma_f32_16x16x32_bf16(mh, sl[ks], acc, 0, 0, 0);
                acc = __builtin_amdgcn_mfma_f32_16x16x32_bf16(ml, sh[ks], acc, 0, 0, 0); }
            nw[rt] = acc; }
#pragma unroll
        for (int rt = 0; rt < 4; ++rt) st[rt] = nw[rt];
        LDS_BARRIER();
    }
#pragma unroll
    for (int rt = 0; rt < 4; ++rt) *(GAS f32x4*)(SSg + (size_t)NSTEP * 4096 + (16 * w + n16) * 64 + 16 * rt + 4 * g) = st[rt];
}

constexpr int R3_RH = 0, R3_S = 9216, R3_SG = 18432, R3_SGS = 272, R3_YL = R3_SG + 64 * R3_SGS, R3_GL = R3_YL + 16384, R3_VS = R3_GL + 16384, R3_BON = R3_VS + 65 * 128, R3_END = R3_BON + 256;
static_assert(R3_END <= LDSCTL_OFF, "R3 LDS");
struct R3Pre { v4u rh; f32x4 ss[2]; v4u gd[2][2]; f32x4 y0[2]; v4u vv[2]; float bon; };
__device__ __forceinline__ void rwkv_r3_prefetch(Frame& F, int item, int tid, R3Pre& P) {
    const int chain = item >> 7, chunk = item & 127, b = chain >> 3, h = chain & 7, g0 = b * SEQ + chunk * 64;
    const bf16* Z = (const bf16*)(F.ws + WS_Z);
    const int t = tid >> 3, cg = tid & 7; const v4u z0 = (v4u){0u, 0u, 0u, 0u};
    P.rh = *(const GAS v4u*)((const bf16*)(F.ws + WS_RWRH) + (size_t)item * 4096 + t * 64 + cg * 8);
    const float* SSg = (const float*)(F.ws + WS_RWSS) + (size_t)item * 4096 + t * 64 + cg * 8;
    P.ss[0] = *(const GAS f32x4*)SSg; P.ss[1] = *(const GAS f32x4*)(SSg + 4);
    const bf16* zr = Z + (size_t)(g0 + t) * IN_COLS + C_GD + cg * 16; const bool first = (chunk == 0 && t == 0);
#pragma unroll
    for (int q = 0; q < 2; ++q) { P.gd[q][0] = *(const GAS v4u*)(zr + q * 8); P.gd[q][1] = z0; if (!first) P.gd[q][1] = *(const GAS v4u*)(zr - IN_COLS + q * 8); }
    const float* Y0g = (const float*)(F.ws + WS_RWY0) + (size_t)item * 4096;
    P.y0[0] = *(const GAS f32x4*)(Y0g + tid * 4); P.y0[1] = *(const GAS f32x4*)(Y0g + (tid + 512) * 4);
#pragma unroll
    for (int q = 0; q < 2; ++q) { const int p = tid + 512 * q; P.vv[q] = z0;
        if (p < 65 * 8) { const int row = p >> 3, ch = p & 7; if (!(chunk == 0 && row == 0)) P.vv[q] = *(const GAS v4u*)(Z + (size_t)(g0 - 1 + row) * IN_COLS + C_V + h * 64 + ch * 8); } }
    P.bon = tid < 64 ? ((const float*)(F.ws + WS_BONUS))[(size_t)item * 64 + tid] : 0.f;
}
__device__ __forceinline__ void r3_load_bfrag(Frame& F, int h, int w, int lane, bf16x8 (&bf)[8]) {
    const int nt = w & 1; const bf16* gut = (const bf16*)(F.ws + WS_GUPT) + (size_t)(h * 64 + nt * 32 + (lane & 31)) * 128 + 8 * (lane >> 5);
#pragma unroll
    for (int s2 = 0; s2 < 8; ++s2) bf[s2] = *(const GAS bf16x8*)(gut + 16 * s2);
}
__device__ __forceinline__ void rwkv_r3_item(Frame& F, int item, int next_item, R3Pre& P, const bf16x8 (&bfr)[8]) {
    const int chain = item >> 7, chunk = item & 127, b = chain >> 3, h = chain & 7;
    const int g0 = b * SEQ + chunk * 64;
    int tid_ = F.tid; asm volatile("" : "+v"(tid_));
    const int tid = tid_, lane = tid & 63, w = __builtin_amdgcn_readfirstlane(tid >> 6), hh = lane >> 5, cl = lane & 31;
    LAS unsigned char* lds = F.lds + RING_OFF;
    const float* mu = F.in[3];
    {
        const int t = tid >> 3, cg = tid & 7;
        *(LAS v4u*)(lds + R3_RH + t * SBS + cg * 16) = P.rh;
        const f32x4 s0 = P.ss[0], s1 = P.ss[1];
        v4u o; o.x = pk2(s0[0], s0[1]); o.y = pk2(s0[2], s0[3]); o.z = pk2(s1[0], s1[1]); o.w = pk2(s1[2], s1[3]);
        *(LAS v4u*)(lds + R3_S + t * SBS + cg * 16) = o;
#pragma unroll
        for (int q = 0; q < 2; ++q) {
            const v4u cw = P.gd[q][0], pw = P.gd[q][1];
            float fw[8], qw[8];
            fw[0] = bflo(cw.x); fw[1] = bfhi(cw.x); fw[2] = bflo(cw.y); fw[3] = bfhi(cw.y); fw[4] = bflo(cw.z); fw[5] = bfhi(cw.z); fw[6] = bflo(cw.w); fw[7] = bfhi(cw.w);
            qw[0] = bflo(pw.x); qw[1] = bfhi(pw.x); qw[2] = bflo(pw.y); qw[3] = bfhi(pw.y); qw[4] = bflo(pw.z); qw[5] = bfhi(pw.z); qw[6] = bflo(pw.w); qw[7] = bfhi(pw.w);
#pragma unroll
            for (int j = 0; j < 8; ++j) { const float v = fw[j] + (qw[j] - fw[j]) * mu[C_GD + cg * 16 + q * 8 + j]; fw[j] = frcp(1.f + __expf(-v)); }
            v4u og; og.x = pk2(fw[0], fw[1]); og.y = pk2(fw[2], fw[3]); og.z = pk2(fw[4], fw[5]); og.w = pk2(fw[6], fw[7]);
            *(LAS v4u*)(lds + R3_SG + t * R3_SGS + (cg * 16 + q * 8) * 2) = og;
        }
        *(LAS f32x4*)(lds + R3_YL + tid * 16) = P.y0[0]; *(LAS f32x4*)(lds + R3_YL + (tid + 512) * 16) = P.y0[1];
#pragma unroll
        for (int q = 0; q < 2; ++q) { const int p = tid + 512 * q; if (p < 65 * 8) *(LAS v4u*)(lds + R3_VS + p * 16) = P.vv[q]; }
        if (tid < 64) ((LAS float*)(lds + R3_BON))[tid] = P.bon;
        if (next_item >= 0) rwkv_r3_prefetch(F, next_item, tid, P);
    }
    LDS_BARRIER();
    {
        const int mt = (w >> 1) & 1, nt = w & 1; const int n = nt * 32 + cl;
        if (w < 4) {
            LAS float* YL = (LAS float*)(lds + R3_YL);
            f32x16 acc;
#pragma unroll
            for (int r = 0; r < 16; ++r) acc[r] = YL[(mt * 32 + crow(r, hh)) * 64 + n];
            acc = wtile<4>(lds + R3_RH + mt * 32 * SBS, SBS, lds + R3_S + nt * 32 * SBS, SBS, acc, lane);
#pragma unroll
            for (int r = 0; r < 16; ++r) YL[(mt * 32 + crow(r, hh)) * 64 + n] = acc[r];
        } else {
            f32x16 acc = zero16();
            { const LAS unsigned char* A_ = lds + R3_SG + mt * 32 * R3_SGS + (lane & 31) * R3_SGS + 16 * hh;
#pragma unroll
              for (int s2 = 0; s2 < 8; ++s2) acc = __builtin_amdgcn_mfma_f32_32x32x16_bf16(*(const LAS bf16x8*)(A_ + 32 * s2), bfr[s2], acc, 0, 0, 0); }
            LAS float* GL = (LAS float*)(lds + R3_GL);
#pragma unroll
            for (int r = 0; r < 16; ++r) GL[(mt * 32 + crow(r, hh)) * 64 + n] = acc[r];
        }
    }
    LDS_BARRIER();
    {
        const int c = tid & 63, ts = tid >> 6, col = h * 64 + c;
        const float mu_v = mu[C_V + col], gw = F.in[12][col], gb = F.in[13][col];
        const LAS float* YL = (const LAS float*)(lds + R3_YL); const LAS float* GL = (const LAS float*)(lds + R3_GL); const LAS float* BON = (const LAS float*)(lds + R3_BON);
        bf16* Y = (bf16*)(F.ws + WS_YMIX);
        const LAS bf16* vb = (const LAS bf16*)(lds + R3_VS) + (8 * ts) * 64 + c;
        float pv = bf2f(vb[0]);
#pragma unroll
        for (int i = 0; i < 8; ++i) { const int t = 8 * ts + i;
            const float zv = bf2f(vb[(i + 1) * 64]); const float v = zv + (pv - zv) * mu_v; pv = zv;
            const float y = YL[t * 64 + c];
            const float mean = wave_sum(y) * (1.f / 64.f); const float d = y - mean; const float var = wave_sum(d * d) * (1.f / 64.f);
            const float yn = d * frsq(var + GN_EPS) * gw + gb;
            const float o = (yn + BON[t] * v) * GL[t * 64 + c];
            Y[(size_t)(g0 + t) * DM + col] = (bf16)f2bf(o); }
    }
    LDS_BARRIER();
}

typedef short s16x4 __attribute__((ext_vector_type(4)));
typedef short v4i16_t __attribute__((ext_vector_type(4)));
constexpr int AT_XO = 0, AT_XO_STRIDE = 136, AT_XM = 512 * AT_XO_STRIDE, AT_XL = AT_XM + 2048, AT_V = AT_XL + 2048, AT_LDS_END = AT_V + 8 * 4096;
static_assert(AT_LDS_END <= RING_BYTES, "attention LDS");
__device__ __forceinline__ float xhalf(float v) { return __shfl_xor(v, 32); }
__device__ __forceinline__ void attn_block(Frame& F, int item) {
    const int bh = item >> 4, blk = item & 15, b = bh >> 3, h = bh & 7, t0 = blk * 512;
    int tid_ = F.tid; asm volatile("" : "+v"(tid_));
    const int lane = tid_ & 63, w = __builtin_amdgcn_readfirstlane(tid_ >> 6), ql = lane & 31, hh = lane >> 5;
    const bf16* Zb = (const bf16*)(F.ws + WS_Z) + (size_t)b * SEQ * IN_COLS;
    bf16* Y = (bf16*)(F.ws + WS_YMIX);
    LAS unsigned char* lds = F.lds + RING_OFF;
    LAS unsigned char* Vw = lds + AT_V + w * 4096;
    LAS float* XM = (LAS float*)(lds + AT_XM); LAS float* XL = (LAS float*)(lds + AT_XL);
    constexpr float C2 = 0.125f * 1.4426950408889634f;
    for (int pass = 0; pass < 3; ++pass) {
        const int sh = pass == 0 ? 4 : (pass == 1 ? 2 : 0), d = 1 << sh;
        for (int uu = 0; uu < 2; ++uu) {
            const int u = w + 8 * uu, rho = u & (d - 1), tau = u >> sh;
            const int qoff = rho + (32 * tau + ql) * d;
            bf16x8 qf[4];
            { const bf16* qp = Zb + (size_t)(t0 + qoff) * IN_COLS + C_AQ + h * 64 + 8 * hh;
#pragma unroll
              for (int s = 0; s < 4; ++s) qf[s] = *(const GAS bf16x8*)(qp + 16 * s); }
            f32x16 sc[5];
            const int tkb = t0 + rho + (32 * tau - 128) * d;
            bf16x8 kf[5][4];
#pragma unroll
            for (int kt = 0; kt < 5; ++kt) { const int tk0 = tkb + 32 * kt * d, tkc = tk0 < 0 ? 0 : tk0;
                const bf16* kp = Zb + (size_t)(tkc + ql * d) * IN_COLS + C_AK + h * 64 + 8 * hh;
#pragma unroll
                for (int s = 0; s < 4; ++s) kf[kt][s] = *(const GAS bf16x8*)(kp + 16 * s); }
            v4u vr[2][4];
#pragma unroll
            for (int kt = 0; kt < 2; ++kt) { const int tk1 = tkb + 32 * kt * d, tkc = tk1 < 0 ? 0 : tk1;
#pragma unroll
              for (int i = 0; i < 4; ++i) { const int kidx = i * 8 + (lane >> 3), ch = lane & 7;
                  vr[kt][i] = *(const GAS v4u*)(Zb + (size_t)(tkc + kidx * d) * IN_COLS + C_AV + h * 64 + ch * 8); } }
#pragma unroll
            for (int kt = 0; kt < 5; ++kt) {
                const int tk0 = tkb + 32 * kt * d;
                f32x16 acc = zero16();
#pragma unroll
                for (int s = 0; s < 4; ++s) acc = __builtin_amdgcn_mfma_f32_32x32x16_bf16(kf[kt][s], qf[s], acc, 0, 0, 0);
                if (kt == 0 || kt == 4) {
#pragma unroll
                    for (int r = 0; r < 16; ++r) { const int kidx = (r & 3) + 8 * (r >> 2) + 4 * hh;
                        const bool ok = (kt == 0) ? (kidx >= ql) : (kidx <= ql);
                        acc[r] = ok ? acc[r] : -INFINITY; }
                }
                if (tk0 < 0) {
#pragma unroll
                    for (int r = 0; r < 16; ++r) acc[r] = -INFINITY;
                }
                sc[kt] = acc;
            }
            float m = -INFINITY;
#pragma unroll
            for (int kt = 0; kt < 5; ++kt)
#pragma unroll
                for (int r = 0; r < 16; ++r) m = fmaxf(m, sc[kt][r]);
            m = fmaxf(m, xhalf(m));
            const float ms = m * C2;
            float l = 0.f;
#pragma unroll
            for (int kt = 0; kt < 5; ++kt)
#pragma unroll
                for (int r = 0; r < 16; ++r) { const float p = __builtin_amdgcn_exp2f(sc[kt][r] * C2 - ms); sc[kt][r] = p; l += p; }
            l += xhalf(l);
            f32x16 O[2];
#pragma unroll
            for (int r = 0; r < 16; ++r) { O[0][r] = 0.f; O[1][r] = 0.f; }
#pragma unroll
            for (int kt = 0; kt < 5; ++kt) {
#pragma unroll
                for (int i = 0; i < 4; ++i) { const int kidx = i * 8 + (lane >> 3), ch = lane & 7;
                    *(LAS v4u*)(Vw + kidx * 128 + ((ch ^ (((kidx >> 1) & 1) << 2)) << 4)) = vr[kt & 1][i]; }
                if (kt < 3) { const int tk1 = tkb + 32 * (kt + 2) * d, tkc = tk1 < 0 ? 0 : tk1;
#pragma unroll
                    for (int i = 0; i < 4; ++i) { const int kidx = i * 8 + (lane >> 3), ch = lane & 7;
                        vr[kt & 1][i] = *(const GAS v4u*)(Zb + (size_t)(tkc + kidx * d) * IN_COLS + C_AV + h * 64 + ch * 8); } }
                asm volatile("s_waitcnt lgkmcnt(0)" ::: "memory");
#pragma unroll
                for (int s = 0; s < 2; ++s) {
                    v4u pw; pw.x = pk2(sc[kt][8 * s], sc[kt][8 * s + 1]); pw.y = pk2(sc[kt][8 * s + 2], sc[kt][8 * s + 3]); pw.z = pk2(sc[kt][8 * s + 4], sc[kt][8 * s + 5]); pw.w = pk2(sc[kt][8 * s + 6], sc[kt][8 * s + 7]);
                    const bf16x8 pf = __builtin_bit_cast(bf16x8, pw);
#pragma unroll
                    for (int dt = 0; dt < 2; ++dt) {
                        bf16x8 vf;
#pragma unroll
                        for (int pp = 0; pp < 2; ++pp) {
                            const int i16 = lane & 15, db = (lane >> 4) & 1;
                            const int row = 16 * s + 8 * pp + 4 * hh + (i16 >> 2);
                            const int byte = 64 * dt + 32 * db + 8 * (i16 & 3);
                            const int chunk = (byte >> 4) ^ (((row >> 1) & 1) << 2);
                            const s16x4 t4 = __builtin_bit_cast(s16x4, __builtin_amdgcn_ds_read_tr16_b64_v4i16((LAS v4i16_t*)(Vw + row * 128 + (chunk << 4) + (byte & 15))));
                            vf[4 * pp + 0] = t4[0]; vf[4 * pp + 1] = t4[1]; vf[4 * pp + 2] = t4[2]; vf[4 * pp + 3] = t4[3];
                        }
                        O[dt] = __builtin_amdgcn_mfma_f32_32x32x16_bf16(vf, pf, O[dt], 0, 0, 0);
                    }
                }
                asm volatile("s_waitcnt lgkmcnt(0)" ::: "memory");
            }
            LAS unsigned char* xo = lds + AT_XO + qoff * AT_XO_STRIDE + 8 * hh;
            float wa = 0.f, wb = 1.f, Mx = ms, ln = l;
            if (pass > 0) { const float msa = XM[qoff], la = XL[qoff]; Mx = fmaxf(msa, ms); wa = la * __builtin_amdgcn_exp2f(msa - Mx); wb = __builtin_amdgcn_exp2f(ms - Mx); ln = wa + wb * l; }
            const float inv = 1.f / ln;
#pragma unroll
            for (int dt = 0; dt < 2; ++dt)
#pragma unroll
                for (int g4 = 0; g4 < 4; ++g4) {
                    LAS v2u* p = (LAS v2u*)(xo + (32 * dt + 8 * g4) * 2);
                    float o0 = O[dt][4 * g4] * wb, o1 = O[dt][4 * g4 + 1] * wb, o2 = O[dt][4 * g4 + 2] * wb, o3 = O[dt][4 * g4 + 3] * wb;
                    if (pass > 0) { const v2u old = *p; o0 += bflo(old.x) * wa; o1 += bfhi(old.x) * wa; o2 += bflo(old.y) * wa; o3 += bfhi(old.y) * wa; }
                    v2u nw; nw.x = pk2(o0 * inv, o1 * inv); nw.y = pk2(o2 * inv, o3 * inv);
                    *p = nw;
                }
            if (hh == 0) { XM[qoff] = Mx; XL[qoff] = ln; }
        }
        LDS_BARRIER();
    }
#pragma unroll
    for (int i = 0; i < 8; ++i) { const int row = (tid_ >> 3) + 64 * i, ch = tid_ & 7;
        LAS v2u* p = (LAS v2u*)(lds + AT_XO + row * AT_XO_STRIDE + ch * 16);
        const v2u a = p[0], c = p[1];
        v4u o; o.x = a.x; o.y = a.y; o.z = c.x; o.w = c.y;
        *(GAS v4u*)(Y + ((size_t)b * SEQ + t0 + row) * DM + RWW + h * 64 + ch * 8) = o; }
    LDS_BARRIER();
}

__device__ __forceinline__ void quantize_tables(Frame& F, int gw, int ngw) {
    for (int m = gw; m < 2 * NEXP; m += ngw) {
        const int tab = m >= NEXP, row = tab ? m - NEXP : m;
        const GAS f32x4* xr = (const GAS f32x4*)(F.in[18 + tab] + (size_t)row * DM) + F.lane * 4;
        f32x4 v[4]; float am = 0.f;
#pragma unroll
        for (int j = 0; j < 4; ++j) { v[j] = xr[j]; am = fmaxf(am, fmaxf(fmaxf(fabsf(v[j].x), fabsf(v[j].y)), fmaxf(fabsf(v[j].z), fabsf(v[j].w)))); }
        am = wave_max(am);
        const float qmax = tab ? 224.f : 127.f;
        const float sc = am > 0.f ? am / qmax : 1.f, inv = am > 0.f ? qmax / am : 0.f;
        v4u o;
#pragma unroll
        for (int j = 0; j < 4; ++j) {
            if (tab) { int w = __builtin_amdgcn_cvt_pk_fp8_f32(v[j].x * inv, v[j].y * inv, 0, false); w = __builtin_amdgcn_cvt_pk_fp8_f32(v[j].z * inv, v[j].w * inv, w, true); o[j] = (unsigned)w; }
            else {
            const unsigned b0 = (unsigned)(int)rintf(v[j].x * inv) & 255u, b1 = (unsigned)(int)rintf(v[j].y * inv) & 255u,
                           b2 = (unsigned)(int)rintf(v[j].z * inv) & 255u, b3 = (unsigned)(int)rintf(v[j].w * inv) & 255u;
            o[j] = b0 | (b1 << 8) | (b2 << 16) | (b3 << 24); } }
        *(GAS v4u*)(F.ws + (tab ? WS_VQ : WS_UQ) + (size_t)row * DM + F.lane * 16) = o;
        if (F.lane == 0) ((float*)(F.ws + (tab ? WS_SV : WS_SU)))[row] = sc;
    }
}

__device__ __forceinline__ void p3_mixers(Frame& F) {
    if (F.wg < NB * NHR) {
        const int chain = F.wg;
        const float* Pg = (const float*)(F.ws + WS_PQ) + (size_t)chain * 8 * 4096; const float* Qg = Pg + (size_t)256 * 4096;
        rwkv_scan<7, 3>(F, Pg, Qg, (float*)(F.ws + WS_SSEG) + (size_t)chain * 8 * 4096, nullptr);
        __syncthreads();
    }
#ifndef ATTN_REPS
#define ATTN_REPS 1
#endif
    for (int rep = 0; rep < ATTN_REPS; ++rep)
    for (int item = F.wg; item < NB * NHA * (SEQ / 512); item += F.G) attn_block(F, item);
}

constexpr int TK_SKS = 272, TK_SKH = 0, TK_SKL = 2 * 128 * TK_SKS, TK_LUT = 2 * TK_SKL, TK_END = TK_LUT + 8 * 2048;
__device__ __forceinline__ unsigned f2ord(float f) { const unsigned u = __builtin_bit_cast(unsigned, f); return u ^ ((unsigned)((int)u >> 31) | 0x80000000u); }
__device__ __forceinline__ float ord2f(unsigned o) { const unsigned u = (o & 0x80000000u) ? (o ^ 0x80000000u) : ~o; return __builtin_bit_cast(float, u); }
__device__ __forceinline__ void ce_desc(unsigned& a, unsigned& b) { const unsigned mx = a > b ? a : b, mn = a > b ? b : a; a = mx; b = mn; }
template <int N, int OFF, int TOT> __device__ __forceinline__ void bitonic_sort_desc(unsigned (&v)[TOT]) {
#pragma unroll
    for (int k = 2; k <= N; k <<= 1)
#pragma unroll
        for (int j = k >> 1; j > 0; j >>= 1)
#pragma unroll
            for (int i = 0; i < N; ++i) { const int l = i ^ j; if (l > i) { if ((i & k) == 0) ce_desc(v[OFF + i], v[OFF + l]); else ce_desc(v[OFF + l], v[OFF + i]); } }
}
template <int OFFA, int OFFB, int TOT> __device__ __forceinline__ void merge_top16(unsigned (&v)[TOT]) {
#pragma unroll
    for (int i = 0; i < 16; ++i) { const unsigned x = v[OFFA + i], y = v[OFFB + 15 - i]; v[OFFA + i] = x > y ? x : y; }
#pragma unroll
    for (int j = 8; j > 0; j >>= 1)
#pragma unroll
        for (int i = 0; i < 16; ++i) { const int l = i ^ j; if (l > i) ce_desc(v[OFFA + i], v[OFFA + l]); }
}
__device__ __forceinline__ void top16_of_64(unsigned (&k)[64]) {
    bitonic_sort_desc<16, 0, 64>(k); bitonic_sort_desc<16, 16, 64>(k); bitonic_sort_desc<16, 32, 64>(k); bitonic_sort_desc<16, 48, 64>(k);
    merge_top16<0, 16, 64>(k); merge_top16<32, 48, 64>(k); merge_top16<0, 32, 64>(k);
}
__device__ __forceinline__ void p7_topk(Frame& F) {
    static_assert(TK_END <= LDSCTL_OFF, "topk LDS");
    const bf16* QP = (const bf16*)(F.ws + WS_QP);
    int* EID = (int*)(F.ws + WS_EID); float* GATE = (float*)(F.ws + WS_GATE);
    const float* sk = F.in[17];
    LAS unsigned char* lds = F.lds + RING_OFF;
    for (int e = F.tid; e < 2 * 128 * 64; e += NTHREADS) {
        const int c = e >> 13, k = (e >> 6) & 127, d2 = e & 63;
        const f32x2 v = *(const GAS f32x2*)(sk + (size_t)(c * 128 + k) * 128 + 2 * d2);
        const unsigned h0 = f2bf(v.x), h1 = f2bf(v.y);
        const float r0 = v.x - __builtin_bit_cast(float, h0 << 16), r1 = v.y - __builtin_bit_cast(float, h1 << 16);
        *(LAS unsigned*)(lds + TK_SKH + (c * 128 + k) * TK_SKS + d2 * 4) = h0 | (h1 << 16);
        *(LAS unsigned*)(lds + TK_SKL + (c * 128 + k) * TK_SKS + d2 * 4) = pk2(r0, r1);
    }
    __syncthreads();
    const int gw = F.wg * NWAVES + F.wave, NGW = F.G * NWAVES;
    for (int tile = gw; tile < T * PHEADS / 32; tile += NGW) {
        int lane_ = F.lane; asm volatile("" : "+v"(lane_));
        const int lane = lane_, hh = lane >> 5, cl = lane & 31;
        const int P = tile * 32 + cl, t = P >> 3, h = P & 7;
        unsigned kAB[2][16];
#pragma unroll
        for (int c = 0; c < 2; ++c) {
            bf16x8 qf[8];
            const bf16* qp = QP + (size_t)t * PQ + h * 256 + c * 128 + 8 * hh;
#pragma unroll
            for (int s2 = 0; s2 < 8; ++s2) qf[s2] = *(const GAS bf16x8*)(qp + 16 * s2);
            unsigned k[64];
#pragma unroll
            for (int mt = 0; mt < 4; ++mt) {
                f32x16 acc = zero16();
                const LAS unsigned char* ah = lds + TK_SKH + (c * 128 + mt * 32 + cl) * TK_SKS + 16 * hh;
                const LAS unsigned char* al = lds + TK_SKL + (c * 128 + mt * 32 + cl) * TK_SKS + 16 * hh;
#pragma unroll
                for (int s2 = 0; s2 < 8; ++s2) {
                    acc = __builtin_amdgcn_mfma_f32_32x32x16_bf16(*(const LAS bf16x8*)(ah + 32 * s2), qf[s2], acc, 0, 0, 0);
                    acc = __builtin_amdgcn_mfma_f32_32x32x16_bf16(*(const LAS bf16x8*)(al + 32 * s2), qf[s2], acc, 0, 0, 0); }
#pragma unroll
                for (int r = 0; r < 16; ++r) { const int idx = 32 * mt + (r & 3) + 8 * (r >> 2) + 4 * hh; k[mt * 16 + r] = (f2ord(acc[r]) & ~127u) | (unsigned)(127 - idx); }
            }
            top16_of_64(k);
            unsigned m[32];
#pragma unroll
            for (int i = 0; i < 16; ++i) { m[i] = k[i]; m[16 + i] = (unsigned)__shfl_xor((int)k[i], 32); }
            merge_top16<0, 16, 32>(m);
#pragma unroll
            for (int i = 0; i < 16; ++i) kAB[c][i] = m[i];
        }
        float fa[16], fb[16];
#pragma unroll
        for (int i = 0; i < 16; ++i) { fa[i] = ord2f(kAB[0][i] & ~127u); fb[i] = ord2f(kAB[1][i] & ~127u); }
        unsigned cd[64]; int n = 0;
#pragma unroll
        for (int i = 0; i < 16; ++i)
#pragma unroll
            for (int j = 0; j < 16; ++j) if ((i + 1) * (j + 1) <= 16) { cd[n] = (f2ord(fa[i] + fb[j]) & ~255u) | (unsigned)(255 - (i * 16 + j)); ++n; }
#pragma unroll
        for (int q = 50; q < 64; ++q) cd[q] = 0u;
        top16_of_64(cd);
        LAS unsigned char* lut = lds + TK_LUT + (F.wave * 64 + lane) * 32;
#pragma unroll
        for (int q = 0; q < 4; ++q) {
            unsigned wa = 0u, wb = 0u;
#pragma unroll
            for (int b4 = 0; b4 < 4; ++b4) { wa |= (127u - (kAB[0][4 * q + b4] & 127u)) << (8 * b4); wb |= (127u - (kAB[1][4 * q + b4] & 127u)) << (8 * b4); }
            *(LAS unsigned*)(lut + 4 * q) = wa; *(LAS unsigned*)(lut + 16 + 4 * q) = wb; }
        float gv[16]; float den = 0.f; const float mx = ord2f(cd[0] & ~255u);
#pragma unroll
        for (int q = 0; q < 16; ++q) { gv[q] = __expf(ord2f(cd[q] & ~255u) - mx); den += gv[q]; }
        const float inv = 1.f / den;
        asm volatile("s_waitcnt lgkmcnt(0)" ::: "memory");
        int ev[16];
#pragma unroll
        for (int q = 0; q < 16; ++q) { const unsigned pos = 255u - (cd[q] & 255u);
            const unsigned ia = *(const LAS unsigned char*)(lut + (pos >> 4)), ib = *(const LAS unsigned char*)(lut + 16 + (pos & 15u));
            ev[q] = (int)(ia * NKEYS + ib); }
        if (hh == 0) {
            int* ep = EID + (size_t)t * 128 + h * 16; float* gp = GATE + (size_t)t * 128 + h * 16;
#pragma unroll
            for (int q = 0; q < 4; ++q) {
                *(GAS v4u*)(ep + 4 * q) = (v4u){(unsigned)ev[4 * q], (unsigned)ev[4 * q + 1], (unsigned)ev[4 * q + 2], (unsigned)ev[4 * q + 3]};
                *(GAS f32x4*)(gp + 4 * q) = (f32x4){gv[4 * q] * inv, gv[4 * q + 1] * inv, gv[4 * q + 2] * inv, gv[4 * q + 3] * inv}; }
        }
        asm volatile("s_waitcnt lgkmcnt(0)" ::: "memory");
    }
}

constexpr int GA_WAVE_BYTES = 10752, GA_CNT = 4096, GA_OFF = 4096 + 128, GA_ACT = 4608, GA_XQ = 6656;
__device__ __forceinline__ int wave_sum_i(int v) { v += dppi<0xB1>(v); v += dppi<0x4E>(v); v += dppi<0x141>(v); v += dppi<0x140>(v);
    return (__builtin_amdgcn_readlane(v, 0) + __builtin_amdgcn_readlane(v, 16)) + (__builtin_amdgcn_readlane(v, 32) + __builtin_amdgcn_readlane(v, 48)); }
struct PairBuf { v4u u, v; float su, sv; int e; float g; };
__device__ __forceinline__ void p8_gather(Frame& F, float* outp) {
    const bf16* XN = (const bf16*)(F.ws + WS_XN);
    const unsigned char* UQ = F.ws + WS_UQ; const unsigned char* VQ = F.ws + WS_VQ;
    const float* SU = (const float*)(F.ws + WS_SU); const float* SV = (const float*)(F.ws + WS_SV);
    const int* EID = (const int*)(F.ws + WS_EID); const float* GATE = (const float*)(F.ws + WS_GATE);
    const float* nf = F.in[20];
    const int gw = F.wg * NWAVES + F.wave, NGW = F.G * NWAVES;
    LAS unsigned char* wl = F.lds + RING_OFF + F.wave * GA_WAVE_BYTES;
    for (int tg = gw, sweep = 0; tg < T / 4; tg += NGW, ++sweep) {
        int lane_ = F.lane; asm volatile("" : "+v"(lane_));
        const int lane = lane_;
        int xq[4][4]; float sx[4];
#pragma unroll
        for (int tk = 0; tk < 4; ++tk) {
            const GAS v4u* xp = (const GAS v4u*)(XN + (size_t)(4 * tg + tk) * DM + lane * 16);
            const v4u a = xp[0], b = xp[1];
            float x[16]; x[0] = bflo(a.x); x[1] = bfhi(a.x); x[2] = bflo(a.y); x[3] = bfhi(a.y); x[4] = bflo(a.z); x[5] = bfhi(a.z); x[6] = bflo(a.w); x[7] = bfhi(a.w);
            x[8] = bflo(b.x); x[9] = bfhi(b.x); x[10] = bflo(b.y); x[11] = bfhi(b.y); x[12] = bflo(b.z); x[13] = bfhi(b.z); x[14] = bflo(b.w); x[15] = bfhi(b.w);
            float am = 0.f;
#pragma unroll
            for (int i = 0; i < 16; ++i) am = fmaxf(am, fabsf(x[i]));
            am = wave_max(am);
            const float rs_ = frsq(((const float*)(F.ws + WS_SSQ))[4 * tg + tk] * (1.f / DM) + RMS_EPS);
            sx[tk] = (am > 0.f ? am * (1.f / 127.f) : 1.f) * rs_; const float inv = am > 0.f ? 127.f / am : 0.f;
#pragma unroll
            for (int q = 0; q < 4; ++q) {
                const unsigned b0 = (unsigned)(int)rintf(x[4 * q] * inv) & 255u, b1 = (unsigned)(int)rintf(x[4 * q + 1] * inv) & 255u, b2 = (unsigned)(int)rintf(x[4 * q + 2] * inv) & 255u, b3 = (unsigned)(int)rintf(x[4 * q + 3] * inv) & 255u;
                xq[tk][q] = (int)(b0 | (b1 << 8) | (b2 << 16) | (b3 << 24)); }
            *(LAS v4u*)(wl + GA_XQ + tk * 1024 + lane * 16) = (v4u){(unsigned)xq[tk][0], (unsigned)xq[tk][1], (unsigned)xq[tk][2], (unsigned)xq[tk][3]};
        }
        LAS unsigned* cnt = (LAS unsigned*)(wl + GA_CNT); LAS unsigned* offs = (LAS unsigned*)(wl + GA_OFF);
        if (lane < 32) cnt[lane] = 0u;
        asm volatile("s_waitcnt lgkmcnt(0)" ::: "memory");
        int ee[8]; float gg[8]; unsigned pos[8];
#pragma unroll
        for (int tk = 0; tk < 4; ++tk) {
            const size_t base = (size_t)(4 * tg + tk) * 128;
            ee[2 * tk] = (EID[base + lane] & (NEXP - 1)) | (tk << 14); ee[2 * tk + 1] = (EID[base + 64 + lane] & (NEXP - 1)) | (tk << 14);
            gg[2 * tk] = GATE[base + lane]; gg[2 * tk + 1] = GATE[base + 64 + lane]; }
#pragma unroll
        for (int q = 0; q < 8; ++q) pos[q] = __hip_atomic_fetch_add(cnt + ((ee[q] >> 9) & 31), 1u, __ATOMIC_RELAXED, __HIP_MEMORY_SCOPE_WAVEFRONT);
        asm volatile("s_waitcnt lgkmcnt(0)" ::: "memory");
        if (lane < 32) {
            const int c0 = (int)cnt[lane]; int v = c0;
            v += __builtin_amdgcn_update_dpp(0, v, 0x111, 0xF, 0xF, true); v += __builtin_amdgcn_update_dpp(0, v, 0x112, 0xF, 0xF, true);
            v += __builtin_amdgcn_update_dpp(0, v, 0x114, 0xF, 0xF, true); v += __builtin_amdgcn_update_dpp(0, v, 0x118, 0xF, 0xF, true);
            const int row0 = __builtin_amdgcn_readlane(v, 15);
            offs[lane] = (unsigned)(v - c0 + (lane >= 16 ? row0 : 0));
        }
        asm volatile("s_waitcnt lgkmcnt(0)" ::: "memory");
#pragma unroll
        for (int q = 0; q < 8; ++q) { const unsigned idx = offs[(ee[q] >> 9) & 31] + pos[q];
            *(LAS unsigned*)(wl + idx * 4) = (unsigned)ee[q]; *(LAS float*)(wl + 2048 + idx * 4) = gg[q]; }
        asm volatile("s_waitcnt lgkmcnt(0)" ::: "memory");
        LAS float* act = (LAS float*)(wl + GA_ACT);
#ifndef UPASS_REPS
#define UPASS_REPS 1
#endif
        for (int urep = 0; urep < UPASS_REPS; ++urep)
        {
            const int grp = lane >> 4, l16 = lane & 15;
            const LAS unsigned* ents = (const LAS unsigned*)wl;
            LAS int* hbuf = (LAS int*)(wl + GA_ACT);
            v4u rb[2][2][4]; unsigned eb[2][2];
#define GA_ULOAD(ST, QD, Q_) do { const unsigned e_ = ents[(Q_) * 4 + grp]; eb[ST][QD] = e_; const GAS v4u* rp_ = (const GAS v4u*)(UQ + (size_t)(e_ & (NEXP - 1)) * DM + l16 * 64); \
                rb[ST][QD][0] = rp_[0]; rb[ST][QD][1] = rp_[1]; rb[ST][QD][2] = rp_[2]; rb[ST][QD][3] = rp_[3]; } while (0)
#define GA_UDOT(ST, QD, Q_) do { const LAS v4u* xp_ = (const LAS v4u*)(wl + GA_XQ + ((eb[ST][QD] >> 14) & 3u) * 1024 + l16 * 64); int d_ = 0; \
                _Pragma("unroll") for (int k_ = 0; k_ < 4; ++k_) { const v4u x_ = xp_[k_], r_ = rb[ST][QD][k_]; \
                    d_ = __builtin_amdgcn_sdot4((int)x_.x, (int)r_.x, d_, false); d_ = __builtin_amdgcn_sdot4((int)x_.y, (int)r_.y, d_, false); \
                    d_ = __builtin_amdgcn_sdot4((int)x_.z, (int)r_.z, d_, false); d_ = __builtin_amdgcn_sdot4((int)x_.w, (int)r_.w, d_, false); } \
                d_ += dppi<0xB1>(d_); d_ += dppi<0x4E>(d_); d_ += dppi<0x141>(d_); d_ += dppi<0x140>(d_); \
                if (l16 == 0) hbuf[(Q_) * 4 + grp] = d_; } while (0)
            GA_ULOAD(0, 0, 0); GA_ULOAD(0, 1, 1);
            for (int q2 = 0; q2 < 128; q2 += 4) {
                GA_ULOAD(1, 0, q2 + 2); GA_ULOAD(1, 1, q2 + 3);
                __builtin_amdgcn_sched_barrier(0);
                GA_UDOT(0, 0, q2); GA_UDOT(0, 1, q2 + 1);
                __builtin_amdgcn_sched_barrier(0);
                if (q2 + 4 < 128) { GA_ULOAD(0, 0, q2 + 4); GA_ULOAD(0, 1, q2 + 5); }
                __builtin_amdgcn_sched_barrier(0);
                GA_UDOT(1, 0, q2 + 2); GA_UDOT(1, 1, q2 + 3);
                __builtin_amdgcn_sched_barrier(0);
            }
#undef GA_ULOAD
#undef GA_UDOT
            asm volatile("s_waitcnt lgkmcnt(0)" ::: "memory");
#pragma unroll 2
            for (int it = 0; it < 8; ++it) { const int p = it * 64 + lane;
                const unsigned e_ = ents[p]; const float g_ = *(const LAS float*)(wl + 2048 + p * 4); const int hs = hbuf[p];
                const int ex_ = (int)(e_ & (NEXP - 1)), tk_ = (int)(e_ >> 14) & 3;
                const float sxl = tk_ == 0 ? sx[0] : (tk_ == 1 ? sx[1] : (tk_ == 2 ? sx[2] : sx[3]));
                const float h_ = (float)hs * (SU[ex_] * sxl);
                act[p] = 0.5f * h_ * (1.f + erff(h_ * 0.70710678118654752f)) * g_ * SV[ex_]; }
        }
        asm volatile("s_waitcnt lgkmcnt(0)" ::: "memory");
        float y[4][16];
#pragma unroll
        for (int tk = 0; tk < 4; ++tk) {
#pragma unroll
            for (int i = 0; i < 16; ++i) y[tk][i] = 0.f; }
#define GA_AXPY(V, A, TK) do { \
            _Pragma("unroll") for (int q_ = 0; q_ < 4; ++q_) { const int w_ = (int)(V)[q_]; const f32x2 lo_ = __builtin_amdgcn_cvt_pk_f32_fp8(w_, false), hi_ = __builtin_amdgcn_cvt_pk_f32_fp8(w_, true); \
                y[TK][4 * q_] += (A) * lo_.x; y[TK][4 * q_ + 1] += (A) * lo_.y; y[TK][4 * q_ + 2] += (A) * hi_.x; y[TK][4 * q_ + 3] += (A) * hi_.y; } } while (0)
        for (int ch = 0; ch < 8; ++ch) {
            const unsigned ent = *(const LAS unsigned*)(wl + (ch * 64 + lane) * 4);
            const float areg = act[ch * 64 + lane];
            v4u vb[2][8]; int eb[2][8];
#pragma unroll
            for (int q = 0; q < 8; ++q) { eb[0][q] = __builtin_amdgcn_readlane((int)ent, q); vb[0][q] = *(const GAS v4u*)(VQ + (size_t)(eb[0][q] & (NEXP - 1)) * DM + lane * 16); }
#pragma unroll
            for (int jb = 0; jb < 8; ++jb) {
                if (jb + 1 < 8) {
#pragma unroll
                    for (int q = 0; q < 8; ++q) { eb[(jb + 1) & 1][q] = __builtin_amdgcn_readlane((int)ent, 8 * (jb + 1) + q); vb[(jb + 1) & 1][q] = *(const GAS v4u*)(VQ + (size_t)(eb[(jb + 1) & 1][q] & (NEXP - 1)) * DM + lane * 16); } }
                __builtin_amdgcn_sched_barrier(0);
#pragma unroll
                for (int q = 0; q < 8; ++q) { const int tk_ = (eb[jb & 1][q] >> 14) & 3; const v4u v_ = vb[jb & 1][q]; const float a_ = rdlane(areg, 8 * jb + q);
                    if (tk_ == 0) GA_AXPY(v_, a_, 0); else if (tk_ == 1) GA_AXPY(v_, a_, 1); else if (tk_ == 2) GA_AXPY(v_, a_, 2); else GA_AXPY(v_, a_, 3); }
                __builtin_amdgcn_sched_barrier(0);
            }
        }
#undef GA_AXPY
#pragma unroll
        for (int tk = 0; tk < 4; ++tk) {
            float* hrow = F.out + (size_t)(4 * tg + tk) * DM + lane * 16;
            float hv[16]; float ss = 0.f;
#pragma unroll
            for (int q = 0; q < 4; ++q) { const f32x4 h4 = *(const GAS f32x4*)(hrow + 4 * q);
#pragma unroll
                for (int i = 0; i < 4; ++i) { const float v = h4[i] + y[tk][4 * q + i]; hv[4 * q + i] = v; ss += v * v; } }
            const float rstd = frsq(wave_sum(ss) * (1.f / DM) + RMS_EPS);
#pragma unroll
            for (int q = 0; q < 4; ++q) { const f32x4 n4 = *(const GAS f32x4*)(nf + lane * 16 + 4 * q);
                *(GAS f32x4*)(outp + (size_t)(4 * tg + tk) * DM + lane * 16 + 4 * q) = (f32x4){hv[4 * q] * rstd * n4[0], hv[4 * q + 1] * rstd * n4[1], hv[4 * q + 2] * rstd * n4[2], hv[4 * q + 3] * rstd * n4[3]}; }
        }
    }
}

struct Args { const float* in[21]; float* out; unsigned char* ws; int ph_lo, ph_hi; };
static_assert(sizeof(Args) == 21 * 8 + 8 + 8 + 8, "Args has no padding");

__global__ void __launch_bounds__(NTHREADS, 2) fwd_kernel(Args args) {
    extern __shared__ __attribute__((aligned(16))) unsigned char lds[];
    Frame F;
    F.lds = (LAS unsigned char*)lds;
    F.MISC = (volatile LAS unsigned*)(F.lds + MISC_OFF);
    F.tid = threadIdx.x; F.lane = F.tid & 63; F.wave = __builtin_amdgcn_readfirstlane(F.tid >> 6);
    F.G = gridDim.x; F.wg = blockIdx.x;
#pragma unroll
    for (int i = 0; i < 21; ++i) F.in[i] = args.in[i];
    F.out = args.out; F.ws = args.ws;
    F.ctl = (gu32*)(args.ws + WS_CTL);
    for (int u = F.tid; u < (LDS_BYTES - LDSCTL_OFF) / 4; u += NTHREADS) ((LAS unsigned*)(F.lds + LDSCTL_OFF))[u] = 0u;
    __syncthreads();
    const int lo = args.ph_lo, hi = args.ph_hi;
    const bool fused = (hi - lo) > 1;
    XcdBarrier bar; bar.bar = (unsigned*)(F.ctl + CW_BAR); bar.x = 0; bar.st = nullptr;
    if (fused) bar = xcd_barrier_post((unsigned*)(F.ctl + CW_BAR), F.MISC + 8);
#define IN(k) (lo <= (k) && (k) < hi)
#define REPS(k) (((REP_MASK >> (k)) & 1) ? 2 : 1)
#define REPLOOP(k) for (int rep_ = 0; rep_ < REPS(k); ++rep_, (rep_ < REPS(k) ? xcd_barrier(bar) : (void)0))
#define SEAM(k) do { if (IN(k) && IN((k) + 1)) xcd_barrier(bar); } while (0)

    if (IN(0)) { REPLOOP(0) { p0_prologue(F); p0_rope_table(F); } SEAM(0); }
    if (IN(1)) { REPLOOP(1) {
        pg8::Gemm g{(const bf16*)(F.ws + WS_XN), (const bf16*)(F.ws + WS_WIN), T, IN_COLS, DM}; pg8::StaticOrder S; S.init(T, IN_COLS, F.G, F.wg);
        pg8::EpiBf16 E{(bf16*)(F.ws + WS_Z), IN_COLS};
        pg8::gemm_phase<pg8::EpiBf16, pg8::StaticOrder, true, true>(F.lds + RING_OFF, g, S, E); }
        {
            const int nwg = (T / 256) * (IN_COLS / 256), rem = nwg % F.G;
            if (rem == 0) quantize_tables(F, F.wg * NWAVES + F.wave, F.G * NWAVES);
            else if (F.wg >= rem) quantize_tables(F, (F.wg - rem) * NWAVES + F.wave, (F.G - rem) * NWAVES);
        }
        SEAM(1);
    }
    if (IN(2)) { p2_rope(F); REPLOOP(2) { const int cnt = r13_count(F.wg, F.G); R1Pre P;
            if (cnt > 0) rwkv_r1_prefetch(F, r13_item(F.wg, F.G, 0), F.tid, P);
            bf16x8 bfr[4]; int hcur = -1;
            f32x4 cst[4];
            { const int n16 = F.lane & 15, g = F.lane >> 4;
#pragma unroll
              for (int rt = 0; rt < 4; ++rt)
#pragma unroll
                  for (int q = 0; q < 4; ++q) cst[rt][q] = (F.wave < 4 && 16 * rt + 4 * g + q == 16 * F.wave + n16) ? 1.f : 0.f; }
            for (int i = 0; i < cnt; ++i) { const int it = r13_item(F.wg, F.G, i), hh_ = (it >> 7) & 7;
                if (hh_ != hcur) { r1_load_bfrag(F, hh_, F.wave, F.lane, bfr); hcur = hh_; }
                rwkv_r1_item(F, it, i + 1 < cnt ? r13_item(F.wg, F.G, i + 1) : -1, P, bfr, cst); }
            { const int n16 = F.lane & 15, g = F.lane >> 4; float* Pg = (float*)(F.ws + WS_PQ) + (size_t)F.wg * 4096; float* Qg = Pg + (size_t)256 * 4096;
              if (F.wave < 4) {
#pragma unroll
                  for (int rt = 0; rt < 4; ++rt)
#pragma unroll
                      for (int q = 0; q < 4; ++q) Pg[(16 * rt + 4 * g + q) * 64 + 16 * F.wave + n16] = cst[rt][q];
              } else {
#pragma unroll
                  for (int rt = 0; rt < 4; ++rt) *(GAS f32x4*)(Qg + (16 * (F.wave - 4) + n16) * 64 + 16 * rt + 4 * g) = cst[rt];
              } } }
        SEAM(2); }
    if (IN(3)) { REPLOOP(3) p3_mixers(F); SEAM(3); }
    if (IN(4)) { REPLOOP(4) { const int cnt = r13_count(F.wg, F.G); R3Pre P;
            {
                const int item0 = r13_item(F.wg, F.G, 0);
                rwkv_scan<15, 7>(F, F.out + (size_t)item0 * 4096, F.out + (size_t)T * RWW + (size_t)item0 * 4096, (float*)(F.ws + WS_RWSS) + (size_t)item0 * 4096, (const float*)(F.ws + WS_SSEG) + (size_t)F.wg * 4096);
                asm volatile("s_waitcnt vmcnt(0)" ::: "memory"); __syncthreads();
            }
            if (cnt > 0) rwkv_r3_prefetch(F, r13_item(F.wg, F.G, 0), F.tid, P);
            bf16x8 bfr[8]; int hcur = -1;
            for (int i = 0; i < cnt; ++i) { const int it = r13_item(F.wg, F.G, i), hh_ = (it >> 7) & 7;
                if (hh_ != hcur) { r3_load_bfrag(F, hh_, F.wave, F.lane, bfr); hcur = hh_; }
                rwkv_r3_item(F, it, i + 1 < cnt ? r13_item(F.wg, F.G, i + 1) : -1, P, bfr); } }
        SEAM(4); }
    if (IN(5)) {
        pg8::Gemm g{(const bf16*)(F.ws + WS_YMIX), (const bf16*)(F.ws + WS_WOUT), T, DM, DM}; pg8::StaticOrder S; S.init(T, DM, F.G, F.wg);
        pg8::EpiF32Res E{F.in[0], F.out, DM, (bf16*)(F.ws + WS_XN), F.in[15], (float*)(F.ws + WS_SSQ)};
        pg8::gemm_phase<pg8::EpiF32Res, pg8::StaticOrder, true, true>(F.lds + RING_OFF, g, S, E);
        SEAM(5);
    }
    if (IN(6)) { REPLOOP(6) {
        pg8::Gemm g{(const bf16*)(F.ws + WS_XN), (const bf16*)(F.ws + WS_WQ), T, PQ, DM}; pg8::StaticOrder S; S.init(T, PQ, F.G, F.wg);
        pg8::EpiBf16Rs E{(bf16*)(F.ws + WS_QP), PQ, (const float*)(F.ws + WS_SSQ)};
        pg8::gemm_phase<pg8::EpiBf16Rs, pg8::StaticOrder, true, true>(F.lds + RING_OFF, g, S, E); }
        SEAM(6);
    }
    if (IN(7)) { REPLOOP(7) p7_topk(F); SEAM(7); }
    if (IN(8)) { if (REPS(8) > 1) { p8_gather(F, (float*)(F.ws + WS_Z)); xcd_barrier(bar); } p8_gather(F, F.out); }
#undef IN
#undef SEAM
}

extern "C" void kernel_launch(void* const* d_in, const int* in_sizes, int n_in, void* d_out, int out_size, void* d_ws, size_t ws_size, hipStream_t stream) {
    static int grid = 0;
    if (grid == 0) {
        if (n_in != 21 || in_sizes[0] != T * DM || out_size != T * DM || ws_size < WS_END) {
            fprintf(stderr, "kernel_launch: unexpected shapes: n_in %d in0 %d out %d ws %zu (need %zu); nothing launched\n", n_in, n_in > 0 ? in_sizes[0] : -1, out_size, ws_size, (size_t)WS_END); grid = -1; return; }
        int dev = 0, cus = 0, per_cu = 0;
        if (hipGetDevice(&dev) != hipSuccess || hipDeviceGetAttribute(&cus, hipDeviceAttributeMultiprocessorCount, dev) != hipSuccess) { grid = -1; return; }
        if (hipFuncSetAttribute((const void*)fwd_kernel, hipFuncAttributeMaxDynamicSharedMemorySize, LDS_BYTES) != hipSuccess) { fprintf(stderr, "kernel_launch: hipFuncSetAttribute failed\n"); grid = -1; return; }
        if (hipOccupancyMaxActiveBlocksPerMultiprocessor(&per_cu, (const void*)fwd_kernel, NTHREADS, LDS_BYTES) != hipSuccess || per_cu < 1) { fprintf(stderr, "kernel_launch: occupancy query says %d\n", per_cu); per_cu = 1; }
        (void)hipGetLastError();
        grid = cus;
        if (cus != 256) { fprintf(stderr, "kernel_launch: the RWKV segment mapping assumes 256 CUs (got %d); nothing launched\n", cus); grid = -1; return; }
    }
    if (grid < 0) return;
    (void)hipMemsetAsync((char*)d_ws + WS_CTL, 0, CTL_ZERO_BYTES, stream);
    Args a{};
    for (int i = 0; i < 21; ++i) a.in[i] = (const float*)d_in[i];
    a.out = (float*)d_out; a.ws = (unsigned char*)d_ws;
    if (MK_N_LAUNCHES == 1) {
        a.ph_lo = 0; a.ph_hi = NPHASE;
        void* kargs[] = {&a};
        hipError_t e = hipLaunchCooperativeKernel((const void*)fwd_kernel, dim3(grid), dim3(NTHREADS), kargs, LDS_BYTES, stream);
        if (e != hipSuccess) fprintf(stderr, "kernel_launch: cooperative launch failed: %s (grid %d)\n", hipGetErrorString(e), grid);
    } else {
        for (int p = 0; p < NPHASE; ++p) { a.ph_lo = p; a.ph_hi = p + 1;
            hipLaunchKernelGGL(fwd_kernel, dim3(grid), dim3(NTHREADS), LDS_BYTES, stream, a); }
    }
}
```

```cpp
#include <hip/hip_runtime.h>
#include <cstdio>
#include <cstdint>

#ifndef MK_N_LAUNCHES
#define MK_N_LAUNCHES 1
#endif

#ifndef REP_MASK
#define REP_MASK 0
#endif
#define GAS __attribute__((address_space(1)))
#define LAS __attribute__((address_space(3)))
typedef unsigned short bf16;
typedef unsigned v4u __attribute__((ext_vector_type(4)));
typedef unsigned v2u __attribute__((ext_vector_type(2)));
typedef float f32x4 __attribute__((ext_vector_type(4)));
typedef float f32x2 __attribute__((ext_vector_type(2)));
typedef short bf16x8 __attribute__((ext_vector_type(8)));
typedef GAS unsigned gu32;
#define RLX_AGENT __ATOMIC_RELAXED, __HIP_MEMORY_SCOPE_AGENT
#define LDS_WAIT() asm volatile("s_waitcnt lgkmcnt(0)" ::: "memory")
#define VM_WAIT() asm volatile("s_waitcnt vmcnt(0)" ::: "memory")
#define LDS_BARRIER() do { asm volatile("s_waitcnt lgkmcnt(0)" ::: "memory"); __builtin_amdgcn_s_barrier(); asm volatile("" ::: "memory"); } while (0)

constexpr int DM = 1024, NB = 4, SEQ = 8192, T = NB * SEQ;
constexpr int HD = 64, RWW = 512, NHR = 8, NHA = 8;
constexpr int IN_COLS = 3328;
constexpr int C_R = 0, C_K = 512, C_V = 1024, C_WD = 1536, C_AD = 1600, C_GD = 1664, C_AQ = 1792, C_AK = 2304, C_AV = 2816;
constexpr int PHEADS = 8, NKEYS = 128, PQ = 2048, TOPK = 16, NEXP = 16384;
constexpr float RMS_EPS = 1e-6f, GN_EPS = 64e-5f;
constexpr int NWAVES = 8, NTHREADS = 512;
constexpr int NPHASE = 9;

constexpr size_t MiB = 1u << 20;
constexpr size_t WS_CTL = 0, CTL_ZERO_BYTES = 1 * MiB;
constexpr size_t WS_WIN = 2 * MiB;
constexpr size_t WS_WOUT = 10 * MiB;
constexpr size_t WS_WQ = 12 * MiB;
constexpr size_t WS_XN = 16 * MiB;
constexpr size_t WS_Z = 80 * MiB;
constexpr size_t WS_QP = 80 * MiB;
constexpr size_t WS_G = 288 * MiB;
constexpr size_t WS_YMIX = 352 * MiB;
constexpr size_t WS_UQ = 416 * MiB;
constexpr size_t WS_VQ = 432 * MiB;
constexpr size_t WS_SU = 448 * MiB;
constexpr size_t WS_SV = 449 * MiB;
constexpr size_t WS_EID = 480 * MiB;
constexpr size_t WS_GATE = 496 * MiB;
constexpr size_t WS_SSEG = 450 * MiB;
constexpr size_t WS_PQ = 456 * MiB;
constexpr size_t WS_END = 512 * MiB;
constexpr size_t WS_WUPT = 1 * MiB, WS_AUPT = WS_WUPT + 65536, WS_GUPT = WS_AUPT + 65536;
constexpr size_t WS_BONUS = 9 * MiB;
constexpr size_t WS_RWY0 = WS_XN;
constexpr size_t WS_RWSS = WS_G;
constexpr size_t WS_RWRH = WS_EID;

constexpr int CW_BAR = 4096;
constexpr size_t WS_SSQ = 256 * 1024;

typedef __bf16 hbf16x2_t __attribute__((ext_vector_type(2)));
__device__ __forceinline__ unsigned pk2(float lo, float hi) { const f32x2 v = {lo, hi}; const hbf16x2_t b = __builtin_convertvector(v, hbf16x2_t); return __builtin_bit_cast(unsigned, b); }
__device__ __forceinline__ unsigned f2bf(float f) { return pk2(f, 0.f) & 0xffffu; }
__device__ __forceinline__ float frcp(float x) { return __builtin_amdgcn_rcpf(x); }
__device__ __forceinline__ float frsq(float x) { return __builtin_amdgcn_rsqf(x); }
__device__ __forceinline__ float bflo(unsigned u) { return __builtin_bit_cast(float, u << 16); }
__device__ __forceinline__ float bfhi(unsigned u) { return __builtin_bit_cast(float, u & 0xffff0000u); }
__device__ __forceinline__ float bf2f(bf16 h) { return __builtin_bit_cast(float, (unsigned)h << 16); }

template <int CTRL> __device__ __forceinline__ float dppf(float x) { return __builtin_bit_cast(float, __builtin_amdgcn_update_dpp(0, __builtin_bit_cast(int, x), CTRL, 0xF, 0xF, true)); }
template <int CTRL> __device__ __forceinline__ int dppi(int x) { return __builtin_amdgcn_update_dpp(0, x, CTRL, 0xF, 0xF, true); }
__device__ __forceinline__ float rdlane(float v, int l) { return __builtin_bit_cast(float, __builtin_amdgcn_readlane(__builtin_bit_cast(int, v), l)); }
__device__ __forceinline__ float sum8(float v) { v += dppf<0xB1>(v); v += dppf<0x4E>(v); v += dppf<0x141>(v); return v; }
__device__ __forceinline__ float sum16(float v) { v = sum8(v); v += dppf<0x140>(v); return v; }
__device__ __forceinline__ float wave_sum(float v) { v = sum16(v);
    v += __builtin_bit_cast(float, __builtin_amdgcn_update_dpp(0, __builtin_bit_cast(int, v), 0x142, 0xA, 0xF, false));
    v += __builtin_bit_cast(float, __builtin_amdgcn_update_dpp(0, __builtin_bit_cast(int, v), 0x143, 0xC, 0xF, false));
    return rdlane(v, 63); }
__device__ __forceinline__ float wave_max(float v) {
    v = fmaxf(v, dppf<0xB1>(v)); v = fmaxf(v, dppf<0x4E>(v)); v = fmaxf(v, dppf<0x141>(v)); v = fmaxf(v, dppf<0x140>(v));
    return fmaxf(fmaxf(rdlane(v, 0), rdlane(v, 16)), fmaxf(rdlane(v, 32), rdlane(v, 48)));
}
__device__ __forceinline__ int wave_min_i(int v) {
    v = min(v, dppi<0xB1>(v)); v = min(v, dppi<0x4E>(v)); v = min(v, dppi<0x141>(v)); v = min(v, dppi<0x140>(v));
    return min(min(__builtin_amdgcn_readlane(v, 0), __builtin_amdgcn_readlane(v, 16)), min(__builtin_amdgcn_readlane(v, 32), __builtin_amdgcn_readlane(v, 48)));
}

namespace pg8 {
#define PG8_LAS __attribute__((address_space(3)))
typedef unsigned short bf16_t;
typedef unsigned u32x4 __attribute__((ext_vector_type(4)));
constexpr int BM = 256, BK = 64, HALF = 128, HTB = HALF * BK * 2, STAGE_BYTES = 8 * HTB, NXCD = 8, WGM = 8;
__host__ __device__ __forceinline__ int lds_byte(int r, int c) { const int st = (r >> 4) * 2 + (c >> 5), rr = r & 15, cc = c & 31, ob = rr * 64 + cc * 2; return st * 1024 + (ob ^ (((ob >> 9) & 1) << 5)); }
__host__ __device__ __forceinline__ void stage_rc(int b, int& R, int& C) { const int st = b / 1024, sb = b % 1024, swz = sb ^ (((sb >> 9) & 1) << 5); R = (st >> 1) * 16 + swz / 64; C = (st & 1) * 32 + (swz % 64) / 2; }
__host__ __device__ __forceinline__ int perm32(int rho) { const int n = rho >> 4, i = rho & 15; return 8 * (i >> 2) + 4 * n + (i & 3); }
struct Unit { int pm, pn; };
struct Gemm { const bf16_t* A; const bf16_t* Bt; int M, N, K; };
struct StaticOrder {
    int nM, nN, nwg, G, c;
    __host__ __device__ void init(int M, int N, int G_, int c_) { nM = M / BM; nN = N / BM; nwg = nM * nN; G = G_; c = c_; }
    __host__ __device__ bool next(int i, Unit& u) const {
        const long L = (long)i * G + c; if (L >= nwg) return false;
        int wgid = (int)L; { const int q = nwg / NXCD, r = nwg % NXCD, xcd = wgid % NXCD, off = wgid / NXCD; wgid = (xcd < r ? xcd * (q + 1) : r * (q + 1) + (xcd - r) * q) + off; }
        const int nig = WGM * nN, gid = wgid / nig, fm = gid * WGM, gsz = (nM - fm) < WGM ? (nM - fm) : WGM;
        u.pm = fm + ((wgid % nig) % gsz); u.pn = (wgid % nig) / gsz; return true;
    }
    __device__ __forceinline__ void a_ready(const Unit&) const {}
    __device__ __forceinline__ void done(const Unit&) const {}
};
__device__ __forceinline__ unsigned cvt_pk_bf16(float lo, float hi) { unsigned r; asm volatile("v_cvt_pk_bf16_f32 %0, %1, %2" : "=v"(r) : "v"(lo), "v"(hi)); return r; }
struct EpiBf16 {
    static constexpr bool PERM = true, AFTER_DRAIN = false;
    bf16_t* O; int ldc;
    __device__ __forceinline__ void operator()(const f32x4 (&acc)[2][2][4][2], const Unit& u, int wr, int wc, int fr, int fq) const {
        const int row0 = u.pm * BM + wr * 64 + fr; const int col0 = u.pn * BM + wc * 32 + 8 * fq;
#pragma unroll
        for (int ai = 0; ai < 2; ++ai)
#pragma unroll
            for (int m = 0; m < 4; ++m) { bf16_t* rowp = O + (size_t)(row0 + ai * HALF + m * 16) * ldc + col0;
#pragma unroll
                for (int bj = 0; bj < 2; ++bj) { const f32x4 v0 = acc[ai][bj][m][0], v1 = acc[ai][bj][m][1];
                    u32x4 w; w.x = cvt_pk_bf16(v0[0], v0[1]); w.y = cvt_pk_bf16(v0[2], v0[3]); w.z = cvt_pk_bf16(v1[0], v1[1]); w.w = cvt_pk_bf16(v1[2], v1[3]);
                    *(u32x4*)(rowp + bj * HALF) = w; } }
    }
};
struct EpiF32Res {
    static constexpr bool PERM = true, AFTER_DRAIN = false;
    const float* res; float* O; int ldc; bf16_t* HG; const float* gain; float* ssq;
    __device__ __forceinline__ void operator()(const f32x4 (&acc)[2][2][4][2], const Unit& u, int wr, int wc, int fr, int fq) const {
        const int row0 = u.pm * BM + wr * 64 + fr; const int col0 = u.pn * BM + wc * 32 + 8 * fq;
        f32x4 gv[2][2];
#pragma unroll
        for (int bj = 0; bj < 2; ++bj) { gv[bj][0] = *(const f32x4*)(gain + col0 + bj * HALF); gv[bj][1] = *(const f32x4*)(gain + col0 + bj * HALF + 4); }
#pragma unroll
        for (int ai = 0; ai < 2; ++ai)
#pragma unroll
            for (int m = 0; m < 4; ++m) { const int row = row0 + ai * HALF + m * 16; const size_t off = (size_t)row * ldc + col0; float sq = 0.f;
#pragma unroll
                for (int bj = 0; bj < 2; ++bj) { const f32x4 r0 = *(const f32x4*)(res + off + bj * HALF), r1 = *(const f32x4*)(res + off + bj * HALF + 4);
                    const f32x4 h0 = acc[ai][bj][m][0] + r0, h1 = acc[ai][bj][m][1] + r1;
                    *(f32x4*)(O + off + bj * HALF) = h0; *(f32x4*)(O + off + bj * HALF + 4) = h1;
                    sq += (h0[0] * h0[0] + h0[1] * h0[1]) + (h0[2] * h0[2] + h0[3] * h0[3]) + (h1[0] * h1[0] + h1[1] * h1[1]) + (h1[2] * h1[2] + h1[3] * h1[3]);
                    const f32x4 g0 = gv[bj][0], g1 = gv[bj][1];
                    u32x4 w; w.x = cvt_pk_bf16(h0[0] * g0[0], h0[1] * g0[1]); w.y = cvt_pk_bf16(h0[2] * g0[2], h0[3] * g0[3]); w.z = cvt_pk_bf16(h1[0] * g1[0], h1[1] * g1[1]); w.w = cvt_pk_bf16(h1[2] * g1[2], h1[3] * g1[3]);
                    *(u32x4*)(HG + off + bj * HALF) = w; }
                sq += __shfl_xor(sq, 16); sq += __shfl_xor(sq, 32);
                if (fq == 0) atomicAdd(ssq + row, sq); }
    }
};
struct EpiBf16Rs {
    static constexpr bool PERM = true, AFTER_DRAIN = false;
    bf16_t* O; int ldc; const float* ssq;
    __device__ __forceinline__ void operator()(const f32x4 (&acc)[2][2][4][2], const Unit& u, int wr, int wc, int fr, int fq) const {
        const int row0 = u.pm * BM + wr * 64 + fr; const int col0 = u.pn * BM + wc * 32 + 8 * fq;
#pragma unroll
        for (int ai = 0; ai < 2; ++ai)
#pragma unroll
            for (int m = 0; m < 4; ++m) { const int row = row0 + ai * HALF + m * 16; bf16_t* rowp = O + (size_t)row * ldc + col0;
                const float rs = __builtin_amdgcn_rsqf(ssq[row] * (1.f / 1024.f) + 1e-6f);
#pragma unroll
                for (int bj = 0; bj < 2; ++bj) { const f32x4 v0 = acc[ai][bj][m][0] * rs, v1 = acc[ai][bj][m][1] * rs;
                    u32x4 w; w.x = cvt_pk_bf16(v0[0], v0[1]); w.y = cvt_pk_bf16(v0[2], v0[3]); w.z = cvt_pk_bf16(v1[0], v1[1]); w.w = cvt_pk_bf16(v1[2], v1[3]);
                    *(u32x4*)(rowp + bj * HALF) = w; } }
    }
};

template <class Epi, class Sched, bool ALIGN_EPI = false, bool SP2 = false>
__device__ __forceinline__ void gemm_phase(PG8_LAS unsigned char* lds, const Gemm g, const Sched& S, const Epi& E) {
    const int tid = threadIdx.x, wid = __builtin_amdgcn_readfirstlane(tid >> 6), lane = tid & 63, wr = wid >> 2, wc = wid & 3, fr = lane & 15, fq = lane >> 4;
    const int K = g.K, nt = K / BK;
    unsigned voffA[2], voffB[2];
#pragma unroll
    for (int i = 0; i < 2; ++i) { int R, C; stage_rc(tid * 16 + i * 8192, R, C); const int Rb = Epi::PERM ? ((R & ~31) + perm32(R & 31)) : R;
        voffA[i] = (unsigned)(R * K + C) * 2u; voffB[i] = (unsigned)(Rb * K + C) * 2u; }
    const size_t kstep = (size_t)(BK * 2);
    const size_t hstep = (size_t)HALF * K * 2;
    const size_t tstep = 2 * hstep;
    const unsigned ldsw = (unsigned)wid * 1024u;
    const int aoff = lds_byte(wr * 64 + fr, fq * 8), boff = lds_byte(wc * 32 + fr, fq * 8);
#define PG8_SA(b, h) (((b) * 2 + (h)) * HTB)
#define PG8_SB(b, h) ((4 + (b) * 2 + (h)) * HTB)
#define PG8_STAGE(bufoff, gbase, voff) do { _Pragma("unroll") for (int _i = 0; _i < 2; ++_i) \
        __builtin_amdgcn_global_load_lds((const unsigned*)((const char*)(gbase) + (voff)[_i]), (PG8_LAS unsigned*)(lds + (bufoff) + ldsw + _i * 8192), 16, 0, 0); } while (0)
#define PG8_LDA(dst, b, h) do { _Pragma("unroll") for (int m = 0; m < 4; ++m) _Pragma("unroll") for (int k = 0; k < 2; ++k) dst[m][k] = *(const PG8_LAS bf16x8*)(lds + PG8_SA(b, h) + aoff + m * 2048 + k * 1024); } while (0)
#define PG8_LDB(dst, b, h) do { _Pragma("unroll") for (int n = 0; n < 2; ++n) _Pragma("unroll") for (int k = 0; k < 2; ++k) dst[n][k] = *(const PG8_LAS bf16x8*)(lds + PG8_SB(b, h) + boff + n * 2048 + k * 1024); } while (0)
#define PG8_MMA(ai, bj, At, Bt) do { __builtin_amdgcn_s_setprio(1); _Pragma("unroll") for (int m = 0; m < 4; ++m) _Pragma("unroll") for (int n = 0; n < 2; ++n) _Pragma("unroll") for (int k = 0; k < 2; ++k) \
        acc[ai][bj][m][n] = __builtin_amdgcn_mfma_f32_16x16x32_bf16(Bt[n][k], At[m][k], acc[ai][bj][m][n], 0, 0, 0); __builtin_amdgcn_s_setprio(0); } while (0)
#define PG8_WAIT_V(n) asm volatile("s_waitcnt vmcnt(" #n ")" ::: "memory")
#define PG8_WAIT_L(n) asm volatile("s_waitcnt lgkmcnt(" #n ")" ::: "memory")
#define PG8_BAR __builtin_amdgcn_s_barrier()
#define PG8_SCHED __builtin_amdgcn_sched_barrier(0)
    Unit cur, nxt; int ui = 0;
    if (!S.next(0, cur)) return;
    f32x4 acc[2][2][4][2];
#pragma unroll
    for (int a = 0; a < 2; ++a)
#pragma unroll
        for (int b = 0; b < 2; ++b)
#pragma unroll
            for (int m = 0; m < 4; ++m)
#pragma unroll
                for (int n = 0; n < 2; ++n) acc[a][b][m][n] = (f32x4){0.f, 0.f, 0.f, 0.f};
    bf16x8 At[4][2], B0[2][2], B1[2][2];
    const char* cA = (const char*)g.A + (size_t)cur.pm * tstep; const char* cB = (const char*)g.Bt + (size_t)cur.pn * tstep;
    S.a_ready(cur);
    if constexpr (SP2) {
        PG8_STAGE(PG8_SB(0, 0), cB, voffB); PG8_STAGE(PG8_SB(0, 1), cB + hstep, voffB); PG8_STAGE(PG8_SA(0, 0), cA, voffA); PG8_STAGE(PG8_SA(0, 1), cA + hstep, voffA);
        if (wr == 1) PG8_BAR;
        PG8_WAIT_V(2); PG8_BAR;
        PG8_STAGE(PG8_SB(1, 0), cB + kstep, voffB); PG8_STAGE(PG8_SA(1, 0), cA + kstep, voffA); PG8_STAGE(PG8_SB(1, 1), cB + hstep + kstep, voffB);
        PG8_WAIT_V(6); PG8_BAR;
    } else {
        PG8_STAGE(PG8_SB(0, 0), cB, voffB); PG8_STAGE(PG8_SA(0, 0), cA, voffA); PG8_STAGE(PG8_SB(0, 1), cB + hstep, voffB); PG8_STAGE(PG8_SA(0, 1), cA + hstep, voffA);
        if (wr == 1) PG8_BAR;
        PG8_WAIT_V(4); PG8_BAR;
        PG8_STAGE(PG8_SB(1, 0), cB + kstep, voffB); PG8_STAGE(PG8_SA(1, 0), cA + kstep, voffA); PG8_STAGE(PG8_SB(1, 1), cB + hstep + kstep, voffB);
        PG8_WAIT_V(6); PG8_BAR;
    }
    for (;;) {
        const bool has_next = S.next(ui + 1, nxt);
        const char* nA = has_next ? (const char*)g.A + (size_t)nxt.pm * tstep : cA; const char* nB = has_next ? (const char*)g.Bt + (size_t)nxt.pn * tstep : cB;
        for (int t = 0; t < nt; t += 2) {
            const bool last = (t == nt - 2);
            const char* a1 = cA + (size_t)(t + 1) * kstep;
            const char* a2 = last ? nA : cA + (size_t)(t + 2) * kstep; const char* b2 = last ? nB : cB + (size_t)(t + 2) * kstep;
            const char* a3 = a2 + kstep; const char* b3 = b2 + kstep;
            if (last && has_next) S.a_ready(nxt);
            if constexpr (SP2) {
            PG8_LDB(B0, 0, 0); PG8_LDB(B1, 0, 1); PG8_SCHED; PG8_LDA(At, 0, 0); PG8_STAGE(PG8_SA(1, 1), a1 + hstep, voffA);
            PG8_WAIT_V(8); PG8_WAIT_L(0); PG8_BAR; PG8_MMA(0, 0, At, B0); PG8_MMA(0, 1, At, B1); PG8_BAR; PG8_SCHED;
            PG8_LDA(At, 0, 1); PG8_STAGE(PG8_SB(0, 0), b2, voffB); PG8_STAGE(PG8_SB(0, 1), b2 + hstep, voffB); PG8_STAGE(PG8_SA(0, 0), a2, voffA);
            PG8_WAIT_V(8); PG8_WAIT_L(0); PG8_BAR; PG8_MMA(1, 0, At, B0); PG8_MMA(1, 1, At, B1); PG8_BAR; PG8_SCHED;
            PG8_LDB(B0, 1, 0); PG8_LDB(B1, 1, 1); PG8_SCHED; PG8_LDA(At, 1, 0); PG8_STAGE(PG8_SA(0, 1), a2 + hstep, voffA);
            PG8_WAIT_V(8); PG8_WAIT_L(0); PG8_BAR; PG8_MMA(0, 0, At, B0); PG8_MMA(0, 1, At, B1); PG8_BAR; PG8_SCHED;
            PG8_LDA(At, 1, 1); PG8_STAGE(PG8_SB(1, 0), b3, voffB); PG8_STAGE(PG8_SB(1, 1), b3 + hstep, voffB); PG8_STAGE(PG8_SA(1, 0), a3, voffA);
            PG8_WAIT_V(8); PG8_WAIT_L(0); PG8_BAR; PG8_MMA(1, 0, At, B0); PG8_MMA(1, 1, At, B1); PG8_BAR; PG8_SCHED;
            } else {
            PG8_LDB(B0, 0, 0); PG8_SCHED; PG8_LDA(At, 0, 0); PG8_STAGE(PG8_SA(1, 1), a1 + hstep, voffA);
            PG8_WAIT_L(8); PG8_BAR; PG8_WAIT_L(0); PG8_MMA(0, 0, At, B0); PG8_BAR; PG8_SCHED;
            PG8_LDB(B1, 0, 1); PG8_STAGE(PG8_SB(0, 0), b2, voffB);
            PG8_BAR; PG8_WAIT_L(0); PG8_MMA(0, 1, At, B1); PG8_BAR;
            PG8_LDA(At, 0, 1); PG8_STAGE(PG8_SA(0, 0), a2, voffA);
            PG8_BAR; PG8_WAIT_L(0); PG8_MMA(1, 0, At, B0); PG8_BAR; PG8_SCHED;
            PG8_STAGE(PG8_SB(0, 1), b2 + hstep, voffB);
            PG8_WAIT_V(6); PG8_BAR; PG8_MMA(1, 1, At, B1); PG8_BAR;
            PG8_LDB(B0, 1, 0); PG8_SCHED; PG8_LDA(At, 1, 0); PG8_STAGE(PG8_SA(0, 1), a2 + hstep, voffA);
            PG8_WAIT_L(8); PG8_BAR; PG8_WAIT_L(0); PG8_MMA(0, 0, At, B0); PG8_BAR; PG8_SCHED;
            PG8_LDB(B1, 1, 1); PG8_STAGE(PG8_SB(1, 0), b3, voffB);
            PG8_BAR; PG8_WAIT_L(0); PG8_MMA(0, 1, At, B1); PG8_BAR;
            PG8_LDA(At, 1, 1); PG8_STAGE(PG8_SA(1, 0), a3, voffA);
            PG8_BAR; PG8_WAIT_L(0); PG8_MMA(1, 0, At, B0); PG8_BAR; PG8_SCHED;
            PG8_STAGE(PG8_SB(1, 1), b3 + hstep, voffB);
            PG8_WAIT_V(6); PG8_BAR; PG8_MMA(1, 1, At, B1); PG8_BAR;
            }
        }
        if constexpr (ALIGN_EPI) { if (wr == 0) PG8_BAR; }
        if constexpr (!Epi::AFTER_DRAIN) { E(acc, cur, wr, wc, fr, fq); S.done(cur); }
        if (!has_next) break;
#pragma unroll
        for (int a = 0; a < 2; ++a)
#pragma unroll
            for (int b = 0; b < 2; ++b)
#pragma unroll
                for (int m = 0; m < 4; ++m)
#pragma unroll
                    for (int n = 0; n < 2; ++n) acc[a][b][m][n] = (f32x4){0.f, 0.f, 0.f, 0.f};
        cur = nxt; cA = nA; cB = nB; ++ui;
        if constexpr (ALIGN_EPI) { if (wr == 1) PG8_BAR; }
    }
    PG8_WAIT_V(0);
    if constexpr (!ALIGN_EPI) { if (wr == 0) PG8_BAR; }
    PG8_BAR;
#undef PG8_SA
#undef PG8_SB
#undef PG8_STAGE
#undef PG8_LDA
#undef PG8_LDB
#undef PG8_MMA
#undef PG8_WAIT_V
#undef PG8_WAIT_L
#undef PG8_BAR
#undef PG8_SCHED
}
}

#define XB_TMO      128
#define XB_XCNT(j)  (256  + 64 * (j))
#define XB_XSUB(j)  (1280 + 64 * (j))
#define XB_XGEN(j)  (2304 + 64 * (j))
#define XB_TOP      3328
#define XB_TOPGEN   3392
#define XCD_BAR_WORDS 3456
#define XB_SPIN_CAP (1u << 22)
__device__ __forceinline__ unsigned xb_ld(unsigned* p)              { return __hip_atomic_load(p, __ATOMIC_RELAXED, __HIP_MEMORY_SCOPE_AGENT); }
__device__ __forceinline__ unsigned xb_add(unsigned* p, unsigned v) { return __hip_atomic_fetch_add(p, v, __ATOMIC_RELAXED, __HIP_MEMORY_SCOPE_AGENT); }
__device__ __forceinline__ unsigned xb_xcc_id() { return (unsigned)__builtin_amdgcn_s_getreg((3 << 11) | 20) & 0xFu; }
#define XB_SPIN(cond, bar) do { unsigned _sp = 0; while (cond) { __builtin_amdgcn_s_sleep(1); \
    if ((++_sp & 255u) == 0u) { if (xb_ld(&(bar)[XB_TMO])) break; if (_sp > XB_SPIN_CAP) { atomicAdd(&(bar)[XB_TMO], 1u); break; } } } } while (0)
struct XcdBarrier { unsigned* bar; unsigned x; volatile LAS unsigned* st; };
__device__ __forceinline__ XcdBarrier xcd_barrier_post(unsigned* bar, volatile LAS unsigned* st) {
    XcdBarrier b; b.bar = bar; b.x = xb_xcc_id(); b.st = st;
    if (threadIdx.x == 0) (void)xb_add(&bar[XB_XCNT(b.x)], 1u);
    return b;
}
__device__ __forceinline__ void xcd_barrier_complete(unsigned* bar, unsigned x, unsigned& nloc, unsigned& nx) {
    const unsigned G = gridDim.x * gridDim.y * gridDim.z;
    unsigned sum, cnt, mine, sp = 0u;
    for (;;) {
        sum = 0u; cnt = 0u; mine = 0u;
#pragma unroll
        for (unsigned j = 0; j < 16; ++j) { const unsigned c = xb_ld(&bar[XB_XCNT(j)]); sum += c; cnt += (c > 0u) ? 1u : 0u; mine = (j == x) ? c : mine; }
        if (sum == G) break;
        __builtin_amdgcn_s_sleep(1);
        if ((++sp & 255u) == 0u) { if (xb_ld(&bar[XB_TMO])) break; if (sp > XB_SPIN_CAP) { atomicAdd(&bar[XB_TMO], 1u); break; } }
    }
    nloc = mine > 0u ? mine : 1u; nx = cnt > 0u ? cnt : 1u;
}
__device__ __forceinline__ void xcd_barrier(const XcdBarrier& b) {
    asm volatile("s_waitcnt vmcnt(0)" ::: "memory");
    __syncthreads();
    if (threadIdx.x == 0) {
        unsigned* bar = b.bar;
        __builtin_amdgcn_s_waitcnt(0);
        unsigned nloc = b.st[0], nx = b.st[1];
        if (nloc == 0u) { xcd_barrier_complete(bar, b.x, nloc, nx); b.st[0] = nloc; b.st[1] = nx; }
        const unsigned old = xb_add(&bar[XB_XSUB(b.x)], 1u);
        const unsigned gen = old / nloc;
        if (old + 1u == (gen + 1u) * nloc) {
            __builtin_amdgcn_fence(__ATOMIC_RELEASE, "agent");
            asm volatile("s_waitcnt vmcnt(0)" ::: "memory");
            const unsigned og = xb_add(&bar[XB_TOP], 1u);
            const unsigned tg = og / nx;
            if (og + 1u == (tg + 1u) * nx) xb_add(&bar[XB_TOPGEN], 1u);
            else XB_SPIN(xb_ld(&bar[XB_TOPGEN]) == tg, bar);
            __builtin_amdgcn_fence(__ATOMIC_ACQUIRE, "agent");
            xb_add(&bar[XB_XGEN(b.x)], 1u);
            asm volatile("s_waitcnt vmcnt(0)" ::: "memory");
        } else {
            XB_SPIN(xb_ld(&bar[XB_XGEN(b.x)]) == gen, bar);
            __builtin_amdgcn_fence(__ATOMIC_ACQUIRE, "agent");
            asm volatile("s_waitcnt vmcnt(0)" ::: "memory");
        }
    }
    __syncthreads();
}

constexpr int RING_OFF = 0, RING_BYTES = 131072;
constexpr int LDSCTL_OFF = 162816, MISC_OFF = LDSCTL_OFF + 320;
constexpr int LDS_BYTES = 163840;

struct Frame {
    LAS unsigned char* lds;
    volatile LAS unsigned* MISC;
    gu32* ctl;
    int tid, lane, wave, G, wg;
    const float* in[21];
    float* out;
    unsigned char* ws;
};

__device__ __forceinline__ void p0_transpose_item(const float* W, int K, int N, bf16* WT, LAS float* scr, int item, int lane) {
    const int nblk = N / 32, kb = item / nblk, nb = item % nblk, k0 = 64 * kb, n0 = 32 * nb;
#pragma unroll 8
    for (int i = 0; i < 32; ++i) { const int kk = 2 * i + (lane >> 5); scr[kk * 33 + (lane & 31)] = W[(size_t)(k0 + kk) * N + n0 + (lane & 31)]; }
    LDS_WAIT(); asm volatile("" ::: "memory");
    const int c = lane & 7;
#pragma unroll
    for (int j = 0; j < 4; ++j) { const int n = (lane >> 3) + 8 * j; const LAS float* s = scr + (8 * c) * 33 + n;
        v4u o; o.x = pk2(s[0 * 33], s[1 * 33]); o.y = pk2(s[2 * 33], s[3 * 33]); o.z = pk2(s[4 * 33], s[5 * 33]); o.w = pk2(s[6 * 33], s[7 * 33]);
        *(GAS v4u*)(WT + (size_t)(n0 + n) * K + k0 + 8 * c) = o; }
    LDS_WAIT(); asm volatile("" ::: "memory");
}
__device__ __forceinline__ void rms_row_to_bf16(int lane, const float* xrow, const float* gain, bf16* orow) {
    const GAS f32x4* xr = (const GAS f32x4*)xrow + lane;
    const GAS f32x4* gr = (const GAS f32x4*)gain + lane;
    f32x4 v[4]; float s = 0.f;
#pragma unroll
    for (int j = 0; j < 4; ++j) { v[j] = xr[64 * j]; s += (v[j].x * v[j].x + v[j].y * v[j].y) + (v[j].z * v[j].z + v[j].w * v[j].w); }
    const float rstd = frsq(wave_sum(s) * (1.f / DM) + RMS_EPS);
    GAS unsigned long long* o8 = (GAS unsigned long long*)orow + lane;
#pragma unroll
    for (int j = 0; j < 4; ++j) { const f32x4 gg = gr[64 * j];
        o8[64 * j] = (unsigned long long)pk2(v[j].x * rstd * gg.x, v[j].y * rstd * gg.y) | ((unsigned long long)pk2(v[j].z * rstd * gg.z, v[j].w * rstd * gg.w) << 32); }
}
__device__ __forceinline__ void cvt_row_to_bf16(int lane, const float* xrow, bf16* orow) {
    const GAS f32x4* xr = (const GAS f32x4*)xrow + lane;
    GAS unsigned long long* o8 = (GAS unsigned long long*)orow + lane;
#pragma unroll
    for (int j = 0; j < 4; ++j) { const f32x4 v = xr[64 * j]; o8[64 * j] = (unsigned long long)pk2(v.x, v.y) | ((unsigned long long)pk2(v.z, v.w) << 32); }
}
__device__ __forceinline__ void quantize_tables(Frame& F, int gw, int ngw);
__device__ __forceinline__ void p0_prologue(Frame& F) {
    LAS float* scr = (LAS float*)(F.lds + RING_OFF + F.wave * 16384);
    const int gw = F.wg * NWAVES + F.wave, NGW = F.G * NWAVES;
    constexpr int I_IN = (DM / 64) * (IN_COLS / 32), I_OUT = (DM / 64) * (DM / 32), I_Q = (DM / 64) * (PQ / 32);
    constexpr int NITEMS = I_IN + I_OUT + I_Q;
    bf16* win_t = (bf16*)(F.ws + WS_WIN); bf16* wout_t = (bf16*)(F.ws + WS_WOUT); bf16* wq_t = (bf16*)(F.ws + WS_WQ);
    for (int it = gw; it < NITEMS; it += NGW) {
        int r = it;
        if (r < I_IN) { p0_transpose_item(F.in[2], DM, IN_COLS, win_t, scr, r, F.lane); continue; } r -= I_IN;
        if (r < I_OUT) { p0_transpose_item(F.in[14], DM, DM, wout_t, scr, r, F.lane); continue; } r -= I_OUT;
        p0_transpose_item(F.in[16], DM, PQ, wq_t, scr, r, F.lane);
    }
    {
        constexpr int I_W = (64 / 64) * (RWW / 32), I_G = (128 / 64) * (RWW / 32);
        for (int it = gw; it < 2 * I_W + I_G; it += NGW) {
            int r = it;
            if (r < I_W) { p0_transpose_item(F.in[5], 64, RWW, (bf16*)(F.ws + WS_WUPT), scr, r, F.lane); continue; } r -= I_W;
            if (r < I_W) { p0_transpose_item(F.in[7], 64, RWW, (bf16*)(F.ws + WS_AUPT), scr, r, F.lane); continue; } r -= I_W;
            p0_transpose_item(F.in[8], 128, RWW, (bf16*)(F.ws + WS_GUPT), scr, r, F.lane);
        }
    }
    bf16* XN = (bf16*)(F.ws + WS_XN);
    for (int m = gw; m < T; m += NGW) rms_row_to_bf16(F.lane, F.in[0] + (size_t)m * DM, F.in[1], XN + (size_t)m * DM);
}

constexpr size_t WS_ROPE = WS_G;
__device__ __forceinline__ void p0_rope_table(Frame& F) {
    f32x2* tab = (f32x2*)(F.ws + WS_ROPE);
    for (int e = F.wg * NTHREADS + F.tid; e < SEQ * 32; e += F.G * NTHREADS) {
        const int sp = e >> 5, i = e & 31;
        const float inv_freq = powf(10000.0f, -(float)(2 * i) / 64.0f);
        const float ang = (float)sp * inv_freq;
        const double r = (double)ang - rint((double)ang * 0.15915494309189535) * 6.283185307179586;
        const float rf = (float)r;
        tab[e] = (f32x2){cosf(rf), sinf(rf)};
    }
}
__device__ __forceinline__ void p2_rope(Frame& F) {
    bf16* Z = (bf16*)(F.ws + WS_Z);
    const f32x2* tab = (const f32x2*)(F.ws + WS_ROPE);
    const int tid = F.tid, tk = tid >> 6, grp = (tid >> 2) & 15, i0 = (tid & 3) * 8;
    for (int blk = F.wg; blk < T / 8; blk += F.G) {
        const int g = blk * 8 + tk, sp = g & (SEQ - 1);
        bf16* p = Z + (size_t)g * IN_COLS + C_AQ + grp * 64 + i0;
        const v4u a = *(const GAS v4u*)p, b = *(const GAS v4u*)(p + 32);
        const GAS f32x4* tp = (const GAS f32x4*)(tab + sp * 32 + i0);
        float x1[8], x2[8];
        x1[0] = bflo(a.x); x1[1] = bfhi(a.x); x1[2] = bflo(a.y); x1[3] = bfhi(a.y); x1[4] = bflo(a.z); x1[5] = bfhi(a.z); x1[6] = bflo(a.w); x1[7] = bfhi(a.w);
        x2[0] = bflo(b.x); x2[1] = bfhi(b.x); x2[2] = bflo(b.y); x2[3] = bfhi(b.y); x2[4] = bflo(b.z); x2[5] = bfhi(b.z); x2[6] = bflo(b.w); x2[7] = bfhi(b.w);
        float o1[8], o2[8];
#pragma unroll
        for (int q = 0; q < 4; ++q) { const f32x4 cs = tp[q];
            o1[2 * q] = x1[2 * q] * cs[0] - x2[2 * q] * cs[1]; o2[2 * q] = x1[2 * q] * cs[1] + x2[2 * q] * cs[0];
            o1[2 * q + 1] = x1[2 * q + 1] * cs[2] - x2[2 * q + 1] * cs[3]; o2[2 * q + 1] = x1[2 * q + 1] * cs[3] + x2[2 * q + 1] * cs[2]; }
        v4u oa, ob; oa.x = pk2(o1[0], o1[1]); oa.y = pk2(o1[2], o1[3]); oa.z = pk2(o1[4], o1[5]); oa.w = pk2(o1[6], o1[7]);
        ob.x = pk2(o2[0], o2[1]); ob.y = pk2(o2[2], o2[3]); ob.z = pk2(o2[4], o2[5]); ob.w = pk2(o2[6], o2[7]);
        *(GAS v4u*)p = oa; *(GAS v4u*)(p + 32) = ob;
    }
}

typedef float f32x16 __attribute__((ext_vector_type(16)));
constexpr int SBS = 144;
constexpr int R1_EPRE = 0, R1_APRE = 16384, R1_AAB = 0, R1_X = 16384;
constexpr int R1_AT = 32768, R1_BT = 41984, R1_KT = 51200, R1_RT = 60416, R1_AHT = R1_BT, R1_U0T = R1_KT;
constexpr int R1_BBT = 69632, R1_KBT = 78848, R1_VT = 88064;
constexpr int R1_ACTW = 97280, R1_ACTA = 106496, R1_AAK = 97280, R1_ARB = 106496, R1_ARK = 115712;
constexpr int R1_BONUS = 124928, R1_WEND = 125184, R1_SEGS = 125440, R1_TII = 125440, R1_END = 129536;
static_assert(R1_END <= LDSCTL_OFF, "R1 LDS");
__device__ __forceinline__ int crow(int r, int hh) { return (r & 3) + 8 * (r >> 2) + 4 * hh; }
template <int KS> __device__ __forceinline__ f32x16 wtile(const LAS unsigned char* A, int sa, const LAS unsigned char* B, int sb, f32x16 acc, int lane) {
    const int row = lane & 31, hh = lane >> 5;
#pragma unroll
    for (int s = 0; s < KS; ++s) { const bf16x8 a = *(const LAS bf16x8*)(A + row * sa + 32 * s + 16 * hh); const bf16x8 b = *(const LAS bf16x8*)(B + row * sb + 32 * s + 16 * hh);
        acc = __builtin_amdgcn_mfma_f32_32x32x16_bf16(a, b, acc, 0, 0, 0); }
    return acc;
}
template <int KS> __device__ __forceinline__ f32x16 wtile_gb(const LAS unsigned char* A, int sa, const bf16* Bg, int ldb, f32x16 acc, int lane) {
    const int row = lane & 31, hh = lane >> 5;
#pragma unroll
    for (int s = 0; s < KS; ++s) { const bf16x8 a = *(const LAS bf16x8*)(A + row * sa + 32 * s + 16 * hh); const bf16x8 b = *(const GAS bf16x8*)(Bg + (size_t)row * ldb + 16 * s + 8 * hh);
        acc = __builtin_amdgcn_mfma_f32_32x32x16_bf16(a, b, acc, 0, 0, 0); }
    return acc;
}
__device__ __forceinline__ f32x16 zero16() { f32x16 z;
#pragma unroll
    for (int r = 0; r < 16; ++r) z[r] = 0.f;
    return z; }

struct R1Pre { v4u wd[2], ad[2], z[4]; };
__device__ __forceinline__ int r13_item(int wg, int G, int idx) { return (wg >> 3) * 128 + (wg & 7) * 16 + idx; }
__device__ __forceinline__ int r13_count(int wg, int G) { return 16; }
__device__ __forceinline__ void rwkv_r1_prefetch(Frame& F, int item, int tid, R1Pre& P) {
    const int chain = item >> 7, chunk = item & 127, b = chain >> 3, h = chain & 7, g0 = b * SEQ + chunk * 64;
    const bf16* Z = (const bf16*)(F.ws + WS_Z);
    const v4u z0 = (v4u){0u, 0u, 0u, 0u};
    { const int t = tid >> 3, cg = tid & 7; const bool first = (chunk == 0 && t == 0);
      const bf16* zr = Z + (size_t)(g0 + t) * IN_COLS;
      P.wd[0] = *(const GAS v4u*)(zr + C_WD + cg * 8); P.ad[0] = *(const GAS v4u*)(zr + C_AD + cg * 8);
      P.wd[1] = z0; P.ad[1] = z0;
      if (!first) { P.wd[1] = *(const GAS v4u*)(zr - IN_COLS + C_WD + cg * 8); P.ad[1] = *(const GAS v4u*)(zr - IN_COLS + C_AD + cg * 8); } }
#pragma unroll
    for (int q = 0; q < 4; ++q) { const int p = tid + 512 * q; P.z[q] = z0;
        if (p < 65 * 24) { const int row = p / 24, rem = p - row * 24, seg = rem >> 3, ch = rem & 7;
            if (!(chunk == 0 && row == 0)) P.z[q] = *(const GAS v4u*)(Z + (size_t)(g0 - 1 + row) * IN_COLS + seg * 512 + h * 64 + ch * 8); } }
}
constexpr int R1_ZS = R1_AT, R1_ZSS = 384;
static_assert(65 * R1_ZSS <= 4 * 9216, "ZS fits in the At..Rt region");
__device__ __forceinline__ void r1_load_bfrag(Frame& F, int h, int w, int lane, bf16x8 (&bf)[4]) {
    const int p = w >> 2, nt = w & 1; const bf16* upt = (const bf16*)(F.ws + (p == 0 ? WS_WUPT : WS_AUPT)) + (size_t)(h * 64 + nt * 32 + (lane & 31)) * 64 + 8 * (lane >> 5);
#pragma unroll
    for (int s2 = 0; s2 < 4; ++s2) bf[s2] = *(const GAS bf16x8*)(upt + 16 * s2);
}
constexpr int R1_CF = R1_AAB, R1_CN = R1_X;
__device__ __forceinline__ void rwkv_r1_item(Frame& F, int item, int next_item, R1Pre& P, const bf16x8 (&bfr)[4], f32x4 (&cst)[4]) {
    const int chain = item >> 7, chunk = item & 127, b = chain >> 3, h = chain & 7;
    const int g0 = b * SEQ + chunk * 64;
    int tid_ = F.tid; asm volatile("" : "+v"(tid_));
    const int tid = tid_, lane = tid & 63, w = __builtin_amdgcn_readfirstlane(tid >> 6), hh = lane >> 5, cl = lane & 31;
    const bf16* Z = (const bf16*)(F.ws + WS_Z);
    LAS unsigned char* lds = F.lds + RING_OFF;
    const float* mu = F.in[3];
    {
        const int t = tid >> 3, cg = tid & 7;
        const v4u cw = P.wd[0], ca = P.ad[0], pw = P.wd[1], pa = P.ad[1];
        float fw[8], fa[8], qw[8], qa[8];
        fw[0] = bflo(cw.x); fw[1] = bfhi(cw.x); fw[2] = bflo(cw.y); fw[3] = bfhi(cw.y); fw[4] = bflo(cw.z); fw[5] = bfhi(cw.z); fw[6] = bflo(cw.w); fw[7] = bfhi(cw.w);
        fa[0] = bflo(ca.x); fa[1] = bfhi(ca.x); fa[2] = bflo(ca.y); fa[3] = bfhi(ca.y); fa[4] = bflo(ca.z); fa[5] = bfhi(ca.z); fa[6] = bflo(ca.w); fa[7] = bfhi(ca.w);
        qw[0] = bflo(pw.x); qw[1] = bfhi(pw.x); qw[2] = bflo(pw.y); qw[3] = bfhi(pw.y); qw[4] = bflo(pw.z); qw[5] = bfhi(pw.z); qw[6] = bflo(pw.w); qw[7] = bfhi(pw.w);
        qa[0] = bflo(pa.x); qa[1] = bfhi(pa.x); qa[2] = bflo(pa.y); qa[3] = bfhi(pa.y); qa[4] = bflo(pa.z); qa[5] = bfhi(pa.z); qa[6] = bflo(pa.w); qa[7] = bfhi(pa.w);
#pragma unroll
        for (int j = 0; j < 8; ++j) { const int c = cg * 8 + j; const float xw = fw[j] + (qw[j] - fw[j]) * mu[C_WD + c];
            const float ex = __expf(2.f * xw); fw[j] = 1.f - 2.f * frcp(ex + 1.f);
            fa[j] = fa[j] + (qa[j] - fa[j]) * mu[C_AD + c]; }
        v4u ow, oa; ow.x = pk2(fw[0], fw[1]); ow.y = pk2(fw[2], fw[3]); ow.z = pk2(fw[4], fw[5]); ow.w = pk2(fw[6], fw[7]);
        oa.x = pk2(fa[0], fa[1]); oa.y = pk2(fa[2], fa[3]); oa.z = pk2(fa[4], fa[5]); oa.w = pk2(fa[6], fa[7]);
        *(LAS v4u*)(lds + R1_ACTW + t * SBS + cg * 16) = ow; *(LAS v4u*)(lds + R1_ACTA + t * SBS + cg * 16) = oa;
#pragma unroll
        for (int q = 0; q < 4; ++q) { const int p = tid + 512 * q;
            if (p < 65 * 24) { const int row = p / 24, rem = p - row * 24; *(LAS v4u*)(lds + R1_ZS + row * R1_ZSS + rem * 16) = P.z[q]; } }
        if (next_item >= 0) rwkv_r1_prefetch(F, next_item, tid, P);
    }
    LDS_BARRIER();
    {
        const int p = w >> 2, mt = (w >> 1) & 1, nt = w & 1;
        f32x16 acc = zero16();
        { const LAS unsigned char* A_ = lds + (p == 0 ? R1_ACTW : R1_ACTA) + mt * 32 * SBS + (lane & 31) * SBS + 16 * hh;
#pragma unroll
          for (int s2 = 0; s2 < 4; ++s2) acc = __builtin_amdgcn_mfma_f32_32x32x16_bf16(*(const LAS bf16x8*)(A_ + 32 * s2), bfr[s2], acc, 0, 0, 0); }
        LAS float* O = (LAS float*)(lds + (p == 0 ? R1_EPRE : R1_APRE));
#pragma unroll
        for (int r = 0; r < 16; ++r) O[(mt * 32 + crow(r, hh)) * 64 + nt * 32 + cl] = acc[r];
    }
    LDS_BARRIER();
    {
        const int c = tid & 63, ts = tid >> 6, col = h * 64 + c;
        const float mu_r = mu[C_R + col], mu_k = mu[C_K + col], mu_v = mu[C_V + col], kkc = F.in[9][col], kac = F.in[10][col], rkc = F.in[11][col], w0c = F.in[4][col], a0c = F.in[6][col];
        const LAS float* EP = (const LAS float*)(lds + R1_EPRE); const LAS float* AP = (const LAS float*)(lds + R1_APRE);
        LAS float* SEGS = (LAS float*)(lds + R1_SEGS); LAS float* BON = (LAS float*)(lds + R1_BONUS);
        const LAS bf16* zb = (const LAS bf16*)(lds + R1_ZS + (8 * ts) * R1_ZSS) + c;
        float pr = bf2f(zb[0]), pk = bf2f(zb[64]), pv = bf2f(zb[128]);
        float rr[8], k2[8], ai[8], bi[8], vv[8], ee[8], cs[8]; float run = 0.f;
#pragma unroll
        for (int i = 0; i < 8; ++i) {
            const float zr = bf2f(zb[(i + 1) * (R1_ZSS / 2)]), zk = bf2f(zb[(i + 1) * (R1_ZSS / 2) + 64]), zv = bf2f(zb[(i + 1) * (R1_ZSS / 2) + 128]);
            const float r = zr + (pr - zr) * mu_r, k = zk + (pk - zk) * mu_k, v = zv + (pv - zv) * mu_v; pr = zr; pk = zk; pv = zv;
            const float e = 0.60653066f * frcp(1.f + __expf(-(w0c + EP[(8 * ts + i) * 64 + c])));
            const float a = frcp(1.f + __expf(-(a0c + AP[(8 * ts + i) * 64 + c])));
            float kk = k * kkc; const float n2 = wave_sum(kk * kk); kk = kk * frsq(fmaxf(n2, 1e-24f));
            const float kq = k * (1.f + (a - 1.f) * kac);
            const float bon = wave_sum(r * kq * rkc); if (c == 0) BON[8 * ts + i] = bon;
            rr[i] = r; k2[i] = kq; ai[i] = -kk; bi[i] = kk * a; vv[i] = v; ee[i] = e; run += e; cs[i] = run;
        }
        SEGS[ts * 64 + c] = run;
        LDS_BARRIER();
        float off = 0.f, tot = 0.f;
#pragma unroll
        for (int q = 0; q < 8; ++q) { const float sv = SEGS[q * 64 + c]; tot += sv; off += (q < ts) ? sv : 0.f; }
        float bb[8], kb[8];
#pragma unroll
        for (int i = 0; i < 8; ++i) { const float L = off + cs[i];
            const float Wm = __expf(-(L - ee[i])), Wi = __expf(-L), iW = __expf(L), We = __expf(-(tot - L));
            const int t = 8 * ts + i;
            *(LAS bf16*)(lds + R1_AT + t * SBS + c * 2) = (bf16)f2bf(ai[i] * Wm);
            *(LAS bf16*)(lds + R1_BT + t * SBS + c * 2) = (bf16)f2bf(bi[i] * iW);
            *(LAS bf16*)(lds + R1_KT + t * SBS + c * 2) = (bf16)f2bf(k2[i] * iW);
            *(LAS bf16*)(lds + R1_RT + t * SBS + c * 2) = (bf16)f2bf(rr[i] * Wi);
            bb[i] = bi[i] * We; kb[i] = k2[i] * We; }
        v4u o; o.x = pk2(bb[0], bb[1]); o.y = pk2(bb[2], bb[3]); o.z = pk2(bb[4], bb[5]); o.w = pk2(bb[6], bb[7]);
        *(LAS v4u*)(lds + R1_BBT + c * SBS + ts * 16) = o;
        o.x = pk2(kb[0], kb[1]); o.y = pk2(kb[2], kb[3]); o.z = pk2(kb[4], kb[5]); o.w = pk2(kb[6], kb[7]);
        *(LAS v4u*)(lds + R1_KBT + c * SBS + ts * 16) = o;
        o.x = pk2(vv[0], vv[1]); o.y = pk2(vv[2], vv[3]); o.z = pk2(vv[4], vv[5]); o.w = pk2(vv[6], vv[7]);
        *(LAS v4u*)(lds + R1_VT + c * SBS + ts * 16) = o;
        if (ts == 0) ((LAS float*)(lds + R1_WEND))[c] = __expf(-tot);
    }
    LDS_BARRIER();
#pragma unroll
    for (int u = 0; u < 2; ++u) {
        const int idx = w * 2 + u, p = idx >> 2, mt = (idx >> 1) & 1, nt = idx & 1;
        const LAS unsigned char* Aop = lds + ((p == 0 || p == 2) ? R1_BT : R1_KT) + mt * 32 * SBS;
        const LAS unsigned char* Bop = lds + (p < 2 ? R1_AT : R1_RT) + nt * 32 * SBS;
        f32x16 acc = wtile<4>(Aop, SBS, Bop, SBS, zero16(), lane);
        const int n = nt * 32 + cl;
#pragma unroll
        for (int r = 0; r < 16; ++r) { const int m = mt * 32 + crow(r, hh); const bool keep = (p < 2) ? (m < n) : (m <= n); acc[r] = keep ? acc[r] : 0.f; }
#pragma unroll
        for (int g4 = 0; g4 < 4; ++g4) { const int m0 = mt * 32 + 8 * g4 + 4 * hh;
            if (p == 0) *(LAS f32x4*)(lds + R1_AAB + (n * 64 + m0) * 4) = (f32x4){acc[4 * g4], acc[4 * g4 + 1], acc[4 * g4 + 2], acc[4 * g4 + 3]};
            else { v2u o; o.x = pk2(acc[4 * g4], acc[4 * g4 + 1]); o.y = pk2(acc[4 * g4 + 2], acc[4 * g4 + 3]);
                   *(LAS v2u*)(lds + (p == 1 ? R1_AAK : (p == 2 ? R1_ARB : R1_ARK)) + n * SBS + m0 * 2) = o; } }
    }
    LDS_BARRIER();
    if (w < 4) {
        const int mt = w >> 1, nt = w & 1;
        const f32x16 acc = wtile<4>(lds + R1_AAK + mt * 32 * SBS, SBS, lds + R1_VT + nt * 32 * SBS, SBS, zero16(), lane);
        LAS float* X = (LAS float*)(lds + R1_X);
#pragma unroll
        for (int r = 0; r < 16; ++r) X[(mt * 32 + crow(r, hh)) * 64 + nt * 32 + cl] = acc[r];
    } else if (w == 4) {
        const int bk = lane >> 4, c = lane & 15;
        const LAS float* AAB = (const LAS float*)(lds + R1_AAB);
        float Tc[16]; const float fc = (float)c;
#pragma unroll
        for (int s2 = 0; s2 < 16; ++s2) Tc[s2] = fmaxf(0.f, 1.f - fabsf((float)s2 - fc));
#pragma unroll
        for (int r = 0; r < 15; ++r)
#pragma unroll
            for (int s2 = r + 1; s2 < 16; ++s2) Tc[s2] += AAB[(16 * bk + s2) * 64 + 16 * bk + r] * Tc[r];
        LAS float* TII = (LAS float*)(lds + R1_TII);
#pragma unroll
        for (int s2 = 0; s2 < 16; ++s2) TII[(bk * 16 + s2) * 16 + c] = Tc[s2];
    }
    LDS_BARRIER();
    {
        const int c16 = lane & 15, g = lane >> 4;
        const LAS float* AAB = (const LAS float*)(lds + R1_AAB); const LAS float* TII = (const LAS float*)(lds + R1_TII); const LAS float* X = (const LAS float*)(lds + R1_X);
        f32x4 o[4];
#pragma unroll
        for (int i = 0; i < 4; ++i) {
            f32x4 acc;
            if (w < 4) {
#pragma unroll
                for (int q = 0; q < 4; ++q) acc[q] = bf2f(*(const LAS bf16*)(lds + R1_AT + (16 * i + 4 * g + q) * SBS + (16 * w + c16) * 2));
            } else {
#pragma unroll
                for (int q = 0; q < 4; ++q) acc[q] = X[(16 * i + 4 * g + q) * 64 + 16 * (w - 4) + c16];
            }
#pragma unroll
            for (int j = 0; j < i; ++j) { const f32x4 a4 = *(const LAS f32x4*)(AAB + (16 * i + c16) * 64 + 16 * j + 4 * g);
#pragma unroll
                for (int q = 0; q < 4; ++q) acc = __builtin_amdgcn_mfma_f32_16x16x4f32(a4[q], o[j][q], acc, 0, 0, 0); }
            const f32x4 t4 = *(const LAS f32x4*)(TII + (i * 16 + c16) * 16 + 4 * g);
            f32x4 res = (f32x4){0.f, 0.f, 0.f, 0.f};
#pragma unroll
            for (int q = 0; q < 4; ++q) res = __builtin_amdgcn_mfma_f32_16x16x4f32(t4[q], acc[q], res, 0, 0, 0);
            o[i] = res;
            v2u ov; ov.x = pk2(res[0], res[1]); ov.y = pk2(res[2], res[3]);
            *(LAS v2u*)(lds + (w < 4 ? R1_AHT : R1_U0T) + (16 * (w & 3) + c16) * SBS + (16 * i + 4 * g) * 2) = ov;
        }
    }
    LDS_BARRIER();
    {
        float* Mg = F.out + (size_t)item * 4096; float* NTg = F.out + (size_t)T * RWW + (size_t)item * 4096;
        float* Y0g = (float*)(F.ws + WS_RWY0) + (size_t)item * 4096; bf16* RHg = (bf16*)(F.ws + WS_RWRH) + (size_t)item * 4096;
#pragma unroll
        for (int u = 0; u < 2; ++u) {
            const int idx = w * 2 + u, p = idx >> 2, mt = (idx >> 1) & 1, nt = idx & 1; const int n = nt * 32 + cl;
            if (p == 0) {
                f32x16 acc = wtile<4>(lds + R1_AHT + mt * 32 * SBS, SBS, lds + R1_BBT + nt * 32 * SBS, SBS, zero16(), lane);
                const float we = ((const LAS float*)(lds + R1_WEND))[n];
#pragma unroll
                for (int g4 = 0; g4 < 4; ++g4) { const int m0 = mt * 32 + 8 * g4 + 4 * hh;
                    const f32x4 mv = (f32x4){acc[4 * g4] + (m0 == n ? we : 0.f), acc[4 * g4 + 1] + (m0 + 1 == n ? we : 0.f), acc[4 * g4 + 2] + (m0 + 2 == n ? we : 0.f), acc[4 * g4 + 3] + (m0 + 3 == n ? we : 0.f)};
                    *(GAS f32x4*)(Mg + n * 64 + m0) = mv;
                    v2u h_; h_.x = pk2(mv[0], mv[1]); h_.y = pk2(mv[2], mv[3]);
                    v2u l_; l_.x = pk2(mv[0] - bflo(h_.x), mv[1] - bfhi(h_.x)); l_.y = pk2(mv[2] - bflo(h_.y), mv[3] - bfhi(h_.y));
                    LAS unsigned char* fp_ = lds + R1_CF + (((n >> 4) * 2 + (m0 >> 5)) * 2) * 1024 + ((((m0 >> 2) & 3) * 16) + (n & 15)) * 16 + ((m0 >> 4) & 1) * 8;
                    *(LAS v2u*)fp_ = h_; *(LAS v2u*)(fp_ + 1024) = l_; }
            } else if (p == 1) {
                f32x16 acc = wtile<4>(lds + R1_BBT + mt * 32 * SBS, SBS, lds + R1_U0T + nt * 32 * SBS, SBS, zero16(), lane);
                acc = wtile<4>(lds + R1_KBT + mt * 32 * SBS, SBS, lds + R1_VT + nt * 32 * SBS, SBS, acc, lane);
#pragma unroll
                for (int g4 = 0; g4 < 4; ++g4) { const f32x4 nv_ = (f32x4){acc[4 * g4], acc[4 * g4 + 1], acc[4 * g4 + 2], acc[4 * g4 + 3]};
                    *(GAS f32x4*)(NTg + n * 64 + mt * 32 + 8 * g4 + 4 * hh) = nv_; *(LAS f32x4*)(lds + R1_CN + (n * 64 + mt * 32 + 8 * g4 + 4 * hh) * 4) = nv_; }
            } else if (p == 2) {
                f32x16 acc = wtile<4>(lds + R1_AHT + mt * 32 * SBS, SBS, lds + R1_ARB + nt * 32 * SBS, SBS, zero16(), lane);
#pragma unroll
                for (int g4 = 0; g4 < 4; ++g4) { const int m0 = mt * 32 + 8 * g4 + 4 * hh;
                    const v2u rt = *(const LAS v2u*)(lds + R1_RT + n * SBS + m0 * 2);
                    v2u ov; ov.x = pk2(acc[4 * g4] + bflo(rt.x), acc[4 * g4 + 1] + bfhi(rt.x)); ov.y = pk2(acc[4 * g4 + 2] + bflo(rt.y), acc[4 * g4 + 3] + bfhi(rt.y));
                    *(GAS v2u*)(RHg + n * 64 + m0) = ov; }
            } else {
                f32x16 acc = wtile<4>(lds + R1_U0T + mt * 32 * SBS, SBS, lds + R1_ARB + nt * 32 * SBS, SBS, zero16(), lane);
                acc = wtile<4>(lds + R1_VT + mt * 32 * SBS, SBS, lds + R1_ARK + nt * 32 * SBS, SBS, acc, lane);
#pragma unroll
                for (int g4 = 0; g4 < 4; ++g4) *(GAS f32x4*)(Y0g + n * 64 + mt * 32 + 8 * g4 + 4 * hh) = (f32x4){acc[4 * g4], acc[4 * g4 + 1], acc[4 * g4 + 2], acc[4 * g4 + 3]};
            }
        }
        if (tid < 64) ((float*)(F.ws + WS_BONUS))[(size_t)item * 64 + tid] = ((const LAS float*)(lds + R1_BONUS))[tid];
    }
    LDS_BARRIER();
    {
        const int n16 = lane & 15, g = lane >> 4;
        bf16x8 sh[2], sl[2];
#pragma unroll
        for (int ks = 0; ks < 2; ++ks) { const f32x4 a = cst[2 * ks], b = cst[2 * ks + 1];
            v4u h_; h_.x = pk2(a[0], a[1]); h_.y = pk2(a[2], a[3]); h_.z = pk2(b[0], b[1]); h_.w = pk2(b[2], b[3]);
            v4u l_; l_.x = pk2(a[0] - bflo(h_.x), a[1] - bfhi(h_.x)); l_.y = pk2(a[2] - bflo(h_.y), a[3] - bfhi(h_.y)); l_.z = pk2(b[0] - bflo(h_.z), b[1] - bfhi(h_.z)); l_.w = pk2(b[2] - bflo(h_.w), b[3] - bfhi(h_.w));
            sh[ks] = __builtin_bit_cast(bf16x8, h_); sl[ks] = __builtin_bit_cast(bf16x8, l_); }
        f32x4 nw[4];
#pragma unroll
        for (int rt = 0; rt < 4; ++rt) { f32x4 acc = (f32x4){0.f, 0.f, 0.f, 0.f};
            if (w >= 4) acc = *(const LAS f32x4*)(lds + R1_CN + ((16 * (w - 4) + n16) * 64 + 16 * rt + 4 * g) * 4);
#pragma unroll
            for (int ks = 0; ks < 2; ++ks) {
                const bf16x8 mh = *(const LAS bf16x8*)(lds + R1_CF + ((rt * 2 + ks) * 2) * 1024 + lane * 16), ml = *(const LAS bf16x8*)(lds + R1_CF + ((rt * 2 + ks) * 2 + 1) * 1024 + lane * 16);
                acc = __builtin_amdgcn_mfma_f32_16x16x32_bf16(mh, sh[ks], acc, 0, 0, 0);
                acc = __builtin_amdgcn_mfma_f32_16x16x32_bf16(mh, sl[ks], acc, 0, 0, 0);
                acc = __builtin_amdgcn_mfma_f32_16x16x32_bf16(ml, sh[ks], acc, 0, 0, 0); }
            nw[rt] = acc; }
#pragma unroll
        for (int rt = 0; rt < 4; ++rt) cst[rt] = nw[rt];
    }
    LDS_BARRIER();
}

constexpr int R2_RS = 272, R2_SLOT = 2 * 64 * R2_RS;
static_assert(2 * R2_SLOT <= LDSCTL_OFF, "R2 LDS");
template <int NSTEP, int R2_D> __device__ __forceinline__ void rwkv_scan(Frame& F, const float* Mg, const float* NTg, float* SSg, const float* S0g) {
    int tid_ = F.tid; asm volatile("" : "+v"(tid_));
    const int lane = tid_ & 63, w = __builtin_amdgcn_readfirstlane(tid_ >> 6);
    LAS unsigned char* lds = F.lds + RING_OFF;
    if (w >= 4) {
        const int L = w - 4, r = lane >> 2, f0 = (lane & 3) * 4;
        const size_t goff = (size_t)(16 * L + r) * 64 + f0 * 4;
        const int loff = (16 * L + r) * R2_RS + f0 * 16;
        f32x4 R[R2_D][8];
#define R2_ISSUE(slot_, step_) do { const int st_ = (step_) < NSTEP ? (step_) : NSTEP - 1; const float* mp_ = Mg + (size_t)st_ * 4096 + goff; const float* np_ = NTg + (size_t)st_ * 4096 + goff; \
            _Pragma("unroll") for (int k_ = 0; k_ < 4; ++k_) { R[slot_][k_] = *(const GAS f32x4*)(mp_ + 4 * k_); R[slot_][4 + k_] = *(const GAS f32x4*)(np_ + 4 * k_); } } while (0)
        const int q_ = lane & 3, froff = ((L * 2 + (q_ >> 1)) * 2) * 1024 + r * 16 + (q_ & 1) * 8;
#define R2_WRITE(slot_, buf_) do { LAS unsigned char* d_ = lds + (buf_) * R2_SLOT; \
            _Pragma("unroll") for (int k_ = 0; k_ < 4; ++k_) { const f32x4 a_ = R[slot_][k_]; \
                v2u h_; h_.x = pk2(a_[0], a_[1]); h_.y = pk2(a_[2], a_[3]); \
                v2u l_; l_.x = pk2(a_[0] - bflo(h_.x), a_[1] - bfhi(h_.x)); l_.y = pk2(a_[2] - bflo(h_.y), a_[3] - bfhi(h_.y)); \
                *(LAS v2u*)(d_ + froff + k_ * 256) = h_; *(LAS v2u*)(d_ + froff + 1024 + k_ * 256) = l_; \
                *(LAS f32x4*)(d_ + 64 * R2_RS + loff + 16 * k_) = R[slot_][4 + k_]; } } while (0)
#pragma unroll
        for (int u = 0; u < R2_D; ++u) R2_ISSUE(u, u);
        R2_WRITE(0, 0);
        R2_ISSUE(0, R2_D);
        LDS_BARRIER();
        int c0 = 0;
        for (; c0 + R2_D <= NSTEP - 1; c0 += R2_D) {
#pragma unroll
            for (int u = 0; u < R2_D; ++u) { const int c = c0 + u;
                R2_WRITE((u + 1) % R2_D, (c + 1) & 1);
                R2_ISSUE((u + 1) % R2_D, c + 1 + R2_D);
                LDS_BARRIER(); }
        }
#pragma unroll
        for (int u = 0; u < R2_D; ++u) { const int c = c0 + u;
            if (c < NSTEP - 1) { R2_WRITE((u + 1) % R2_D, (c + 1) & 1); LDS_BARRIER(); } }
        LDS_BARRIER();
#undef R2_ISSUE
#undef R2_WRITE
        return;
    }
    const int n16 = lane & 15, g = lane >> 4;
    f32x4 st[4];
#pragma unroll
    for (int rt = 0; rt < 4; ++rt) st[rt] = S0g ? *(const GAS f32x4*)(S0g + (16 * w + n16) * 64 + 16 * rt + 4 * g) : (f32x4){0.f, 0.f, 0.f, 0.f};
    LDS_BARRIER();
    for (int c = 0; c < NSTEP; ++c) {
#pragma unroll
        for (int rt = 0; rt < 4; ++rt) *(GAS f32x4*)(SSg + (size_t)c * 4096 + (16 * w + n16) * 64 + 16 * rt + 4 * g) = st[rt];
        const LAS unsigned char* sl_ = lds + (c & 1) * R2_SLOT;
        bf16x8 sh[2], sl[2];
#pragma unroll
        for (int ks = 0; ks < 2; ++ks) { const f32x4 a = st[2 * ks], b = st[2 * ks + 1];
            v4u h; h.x = pk2(a[0], a[1]); h.y = pk2(a[2], a[3]); h.z = pk2(b[0], b[1]); h.w = pk2(b[2], b[3]);
            v4u l; l.x = pk2(a[0] - bflo(h.x), a[1] - bfhi(h.x)); l.y = pk2(a[2] - bflo(h.y), a[3] - bfhi(h.y)); l.z = pk2(b[0] - bflo(h.z), b[1] - bfhi(h.z)); l.w = pk2(b[2] - bflo(h.w), b[3] - bfhi(h.w));
            sh[ks] = __builtin_bit_cast(bf16x8, h); sl[ks] = __builtin_bit_cast(bf16x8, l); }
        f32x4 nw[4];
#pragma unroll
        for (int rt = 0; rt < 4; ++rt) { f32x4 acc = *(const LAS f32x4*)(sl_ + 64 * R2_RS + (16 * w + n16) * R2_RS + (16 * rt + 4 * g) * 4);
#pragma unroll
            for (int ks = 0; ks < 2; ++ks) {
                const bf16x8 mh = *(const LAS bf16x8*)(sl_ + ((rt * 2 + ks) * 2) * 1024 + lane * 16), ml = *(const LAS bf16x8*)(sl_ + ((rt * 2 + ks) * 2 + 1) * 1024 + lane * 16);
                acc = __builtin_amdgcn_mfma_f32_16x16x32_bf16(mh, sh[ks], acc, 0, 0, 0);
                acc = __builtin_amdgcn_mfma_f32_16x16x32_bf16(mh, sl[ks], acc, 0, 0, 0);
                acc = __builtin_amdgcn_mfma_f32_16x16x32_bf16(ml, sh[ks], acc, 0, 0, 0); }
            nw[rt] = acc; }
#pragma unroll
        for (int rt = 0; rt < 4; ++rt) st[rt] = nw[rt];
        LDS_BARRIER();
    }
#pragma unroll
    for (int rt = 0; rt < 4; ++rt) *(GAS f32x4*)(SSg + (size_t)NSTEP * 4096 + (16 * w + n16) * 64 + 16 * rt + 4 * g) = st[rt];
}

constexpr int R3_RH = 0, R3_S = 9216, R3_SG = 18432, R3_SGS = 272, R3_YL = R3_SG + 64 * R3_SGS, R3_GL = R3_YL + 16384, R3_VS = R3_GL + 16384, R3_BON = R3_VS + 65 * 128, R3_END = R3_BON + 256;
static_assert(R3_END <= LDSCTL_OFF, "R3 LDS");
struct R3Pre { v4u rh; f32x4 ss[2]; v4u gd[2][2]; f32x4 y0[2]; v4u vv[2]; float bon; };
__device__ __forceinline__ void rwkv_r3_prefetch(Frame& F, int item, int tid, R3Pre& P) {
    const int chain = item >> 7, chunk = item & 127, b = chain >> 3, h = chain & 7, g0 = b * SEQ + chunk * 64;
    const bf16* Z = (const bf16*)(F.ws + WS_Z);
    const int t = tid >> 3, cg = tid & 7; const v4u z0 = (v4u){0u, 0u, 0u, 0u};
    P.rh = *(const GAS v4u*)((const bf16*)(F.ws + WS_RWRH) + (size_t)item * 4096 + t * 64 + cg * 8);
    const float* SSg = (const float*)(F.ws + WS_RWSS) + (size_t)item * 4096 + t * 64 + cg * 8;
    P.ss[0] = *(const GAS f32x4*)SSg; P.ss[1] = *(const GAS f32x4*)(SSg + 4);
    const bf16* zr = Z + (size_t)(g0 + t) * IN_COLS + C_GD + cg * 16; const bool first = (chunk == 0 && t == 0);
#pragma unroll
    for (int q = 0; q < 2; ++q) { P.gd[q][0] = *(const GAS v4u*)(zr + q * 8); P.gd[q][1] = z0; if (!first) P.gd[q][1] = *(const GAS v4u*)(zr - IN_COLS + q * 8); }
    const float* Y0g = (const float*)(F.ws + WS_RWY0) + (size_t)item * 4096;
    P.y0[0] = *(const GAS f32x4*)(Y0g + tid * 4); P.y0[1] = *(const GAS f32x4*)(Y0g + (tid + 512) * 4);
#pragma unroll
    for (int q = 0; q < 2; ++q) { const int p = tid + 512 * q; P.vv[q] = z0;
        if (p < 65 * 8) { const int row = p >> 3, ch = p & 7; if (!(chunk == 0 && row == 0)) P.vv[q] = *(const GAS v4u*)(Z + (size_t)(g0 - 1 + row) * IN_COLS + C_V + h * 64 + ch * 8); } }
    P.bon = tid < 64 ? ((const float*)(F.ws + WS_BONUS))[(size_t)item * 64 + tid] : 0.f;
}
__device__ __forceinline__ void r3_load_bfrag(Frame& F, int h, int w, int lane, bf16x8 (&bf)[8]) {
    const int nt = w & 1; const bf16* gut = (const bf16*)(F.ws + WS_GUPT) + (size_t)(h * 64 + nt * 32 + (lane & 31)) * 128 + 8 * (lane >> 5);
#pragma unroll
    for (int s2 = 0; s2 < 8; ++s2) bf[s2] = *(const GAS bf16x8*)(gut + 16 * s2);
}
__device__ __forceinline__ void rwkv_r3_item(Frame& F, int item, int next_item, R3Pre& P, const bf16x8 (&bfr)[8]) {
    const int chain = item >> 7, chunk = item & 127, b = chain >> 3, h = chain & 7;
    const int g0 = b * SEQ + chunk * 64;
    int tid_ = F.tid; asm volatile("" : "+v"(tid_));
    const int tid = tid_, lane = tid & 63, w = __builtin_amdgcn_readfirstlane(tid >> 6), hh = lane >> 5, cl = lane & 31;
    LAS unsigned char* lds = F.lds + RING_OFF;
    const float* mu = F.in[3];
    {
        const int t = tid >> 3, cg = tid & 7;
        *(LAS v4u*)(lds + R3_RH + t * SBS + cg * 16) = P.rh;
        const f32x4 s0 = P.ss[0], s1 = P.ss[1];
        v4u o; o.x = pk2(s0[0], s0[1]); o.y = pk2(s0[2], s0[3]); o.z = pk2(s1[0], s1[1]); o.w = pk2(s1[2], s1[3]);
        *(LAS v4u*)(lds + R3_S + t * SBS + cg * 16) = o;
#pragma unroll
        for (int q = 0; q < 2; ++q) {
            const v4u cw = P.gd[q][0], pw = P.gd[q][1];
            float fw[8], qw[8];
            fw[0] = bflo(cw.x); fw[1] = bfhi(cw.x); fw[2] = bflo(cw.y); fw[3] = bfhi(cw.y); fw[4] = bflo(cw.z); fw[5] = bfhi(cw.z); fw[6] = bflo(cw.w); fw[7] = bfhi(cw.w);
            qw[0] = bflo(pw.x); qw[1] = bfhi(pw.x); qw[2] = bflo(pw.y); qw[3] = bfhi(pw.y); qw[4] = bflo(pw.z); qw[5] = bfhi(pw.z); qw[6] = bflo(pw.w); qw[7] = bfhi(pw.w);
#pragma unroll
            for (int j = 0; j < 8; ++j) { const float v = fw[j] + (qw[j] - fw[j]) * mu[C_GD + cg * 16 + q * 8 + j]; fw[j] = frcp(1.f + __expf(-v)); }
            v4u og; og.x = pk2(fw[0], fw[1]); og.y = pk2(fw[2], fw[3]); og.z = pk2(fw[4], fw[5]); og.w = pk2(fw[6], fw[7]);
            *(LAS v4u*)(lds + R3_SG + t * R3_SGS + (cg * 16 + q * 8) * 2) = og;
        }
        *(LAS f32x4*)(lds + R3_YL + tid * 16) = P.y0[0]; *(LAS f32x4*)(lds + R3_YL + (tid + 512) * 16) = P.y0[1];
#pragma unroll
        for (int q = 0; q < 2; ++q) { const int p = tid + 512 * q; if (p < 65 * 8) *(LAS v4u*)(lds + R3_VS + p * 16) = P.vv[q]; }
        if (tid < 64) ((LAS float*)(lds + R3_BON))[tid] = P.bon;
        if (next_item >= 0) rwkv_r3_prefetch(F, next_item, tid, P);
    }
    LDS_BARRIER();
    {
        const int mt = (w >> 1) & 1, nt = w & 1; const int n = nt * 32 + cl;
        if (w < 4) {
            LAS float* YL = (LAS float*)(lds + R3_YL);
            f32x16 acc;
#pragma unroll
            for (int r = 0; r < 16; ++r) acc[r] = YL[(mt * 32 + crow(r, hh)) * 64 + n];
            acc = wtile<4>(lds + R3_RH + mt * 32 * SBS, SBS, lds + R3_S + nt * 32 * SBS, SBS, acc, lane);
#pragma unroll
            for (int r = 0; r < 16; ++r) YL[(mt * 32 + crow(r, hh)) * 64 + n] = acc[r];
        } else {
            f32x16 acc = zero16();
            { const LAS unsigned char* A_ = lds + R3_SG + mt * 32 * R3_SGS + (lane & 31) * R3_SGS + 16 * hh;
#pragma unroll
              for (int s2 = 0; s2 < 8; ++s2) acc = __builtin_amdgcn_mfma_f32_32x32x16_bf16(*(const LAS bf16x8*)(A_ + 32 * s2), bfr[s2], acc, 0, 0, 0); }
            LAS float* GL = (LAS float*)(lds + R3_GL);
#pragma unroll
            for (int r = 0; r < 16; ++r) GL[(mt * 32 + crow(r, hh)) * 64 + n] = acc[r];
        }
    }
    LDS_BARRIER();
    {
        const int c = tid & 63, ts = tid >> 6, col = h * 64 + c;
        const float mu_v = mu[C_V + col], gw = F.in[12][col], gb = F.in[13][col];
        const LAS float* YL = (const LAS float*)(lds + R3_YL); const LAS float* GL = (const LAS float*)(lds + R3_GL); const LAS float* BON = (const LAS float*)(lds + R3_BON);
        bf16* Y = (bf16*)(F.ws + WS_YMIX);
        const LAS bf16* vb = (const LAS bf16*)(lds + R3_VS) + (8 * ts) * 64 + c;
        float pv = bf2f(vb[0]);
#pragma unroll
        for (int i = 0; i < 8; ++i) { const int t = 8 * ts + i;
            const float zv = bf2f(vb[(i + 1) * 64]); const float v = zv + (pv - zv) * mu_v; pv = zv;
            const float y = YL[t * 64 + c];
            const float mean = wave_sum(y) * (1.f / 64.f); const float d = y - mean; const float var = wave_sum(d * d) * (1.f / 64.f);
            const float yn = d * frsq(var + GN_EPS) * gw + gb;
            const float o = (yn + BON[t] * v) * GL[t * 64 + c];
            Y[(size_t)(g0 + t) * DM + col] = (bf16)f2bf(o); }
    }
    LDS_BARRIER();
}

typedef short s16x4 __attribute__((ext_vector_type(4)));
typedef short v4i16_t __attribute__((ext_vector_type(4)));
constexpr int AT_XO = 0, AT_XO_STRIDE = 136, AT_XM = 512 * AT_XO_STRIDE, AT_XL = AT_XM + 2048, AT_V = AT_XL + 2048, AT_K = AT_V + 8 * 4096, AT_KS = 144, AT_LDS_END = AT_K + 8 * 32 * AT_KS;
static_assert(AT_LDS_END <= LDSCTL_OFF, "attention LDS");
__device__ __forceinline__ float xhalf(float v) { return __shfl_xor(v, 32); }
__device__ __forceinline__ void attn_block(Frame& F, int item) {
    const int bh = item >> 4, blk = item & 15, b = bh >> 3, h = bh & 7, t0 = blk * 512;
    int tid_ = F.tid; asm volatile("" : "+v"(tid_));
    const int lane = tid_ & 63, w = __builtin_amdgcn_readfirstlane(tid_ >> 6), ql = lane & 31, hh = lane >> 5;
    const bf16* Zb = (const bf16*)(F.ws + WS_Z) + (size_t)b * SEQ * IN_COLS;
    bf16* Y = (bf16*)(F.ws + WS_YMIX);
    LAS unsigned char* lds = F.lds + RING_OFF;
    LAS unsigned char* Vw = lds + AT_V + w * 4096;
    LAS unsigned char* Kw = lds + AT_K + w * 32 * AT_KS;
    LAS float* XM = (LAS float*)(lds + AT_XM); LAS float* XL = (LAS float*)(lds + AT_XL);
    constexpr float C2 = 0.125f * 1.4426950408889634f;
    for (int pass = 0; pass < 3; ++pass) {
        const int sh = pass == 0 ? 4 : (pass == 1 ? 2 : 0), d = 1 << sh;
        for (int uu = 0; uu < 2; ++uu) {
            const int u = w + 8 * uu, rho = u & (d - 1), tau = u >> sh;
            const int qoff = rho + (32 * tau + ql) * d;
            v4u qr[4];
#pragma unroll
            for (int i = 0; i < 4; ++i) { const int kidx = i * 8 + (lane >> 3), ch = lane & 7;
                qr[i] = *(const GAS v4u*)(Zb + (size_t)(t0 + rho + (32 * tau + kidx) * d) * IN_COLS + C_AQ + h * 64 + ch * 8); }
            f32x16 sc[5];
            const int tkb = t0 + rho + (32 * tau - 128) * d;
            v4u kr[5][4];
#pragma unroll
            for (int kt = 0; kt < 5; ++kt) { const int tk0 = tkb + 32 * kt * d, tkc = tk0 < 0 ? 0 : tk0;
#pragma unroll
                for (int i = 0; i < 4; ++i) { const int kidx = i * 8 + (lane >> 3), ch = lane & 7;
                    kr[kt][i] = *(const GAS v4u*)(Zb + (size_t)(tkc + kidx * d) * IN_COLS + C_AK + h * 64 + ch * 8); } }
            v4u vr[2][4];
#pragma unroll
            for (int kt = 0; kt < 2; ++kt) { const int tk1 = tkb + 32 * kt * d, tkc = tk1 < 0 ? 0 : tk1;
#pragma unroll
              for (int i = 0; i < 4; ++i) { const int kidx = i * 8 + (lane >> 3), ch = lane & 7;
                  vr[kt][i] = *(const GAS v4u*)(Zb + (size_t)(tkc + kidx * d) * IN_COLS + C_AV + h * 64 + ch * 8); } }
            bf16x8 qf[4];
#pragma unroll
            for (int i = 0; i < 4; ++i) *(LAS v4u*)(Kw + (i * 8 + (lane >> 3)) * AT_KS + (lane & 7) * 16) = qr[i];
#pragma unroll
            for (int s = 0; s < 4; ++s) qf[s] = *(const LAS bf16x8*)(Kw + ql * AT_KS + 32 * s + 16 * hh);
#pragma unroll
            for (int kt = 0; kt < 5; ++kt) {
                const int tk0 = tkb + 32 * kt * d;
                bf16x8 kf[4];
#pragma unroll
                for (int i = 0; i < 4; ++i) *(LAS v4u*)(Kw + (i * 8 + (lane >> 3)) * AT_KS + (lane & 7) * 16) = kr[kt][i];
#pragma unroll
                for (int s = 0; s < 4; ++s) kf[s] = *(const LAS bf16x8*)(Kw + ql * AT_KS + 32 * s + 16 * hh);
                f32x16 acc = zero16();
#pragma unroll
                for (int s = 0; s < 4; ++s) acc = __builtin_amdgcn_mfma_f32_32x32x16_bf16(kf[s], qf[s], acc, 0, 0, 0);
                if (kt == 0 || kt == 4) {
#pragma unroll
                    for (int r = 0; r < 16; ++r) { const int kidx = (r & 3) + 8 * (r >> 2) + 4 * hh;
                        const bool ok = (kt == 0) ? (kidx >= ql) : (kidx <= ql);
                        acc[r] = ok ? acc[r] : -INFINITY; }
                }
                if (tk0 < 0) {
#pragma unroll
                    for (int r = 0; r < 16; ++r) acc[r] = -INFINITY;
                }
                sc[kt] = acc;
            }
            float m = -INFINITY;
#pragma unroll
            for (int kt = 0; kt < 5; ++kt)
#pragma unroll
                for (int r = 0; r < 16; ++r) m = fmaxf(m, sc[kt][r]);
            m = fmaxf(m, xhalf(m));
            const float ms = m * C2;
            float l = 0.f;
#pragma unroll
            for (int kt = 0; kt < 5; ++kt)
#pragma unroll
                for (int r = 0; r < 16; ++r) { const float p = __builtin_amdgcn_exp2f(sc[kt][r] * C2 - ms); sc[kt][r] = p; l += p; }
            l += xhalf(l);
            f32x16 O[2];
#pragma unroll
            for (int r = 0; r < 16; ++r) { O[0][r] = 0.f; O[1][r] = 0.f; }
#pragma unroll
            for (int kt = 0; kt < 5; ++kt) {
#pragma unroll
                for (int i = 0; i < 4; ++i) { const int kidx = i * 8 + (lane >> 3), ch = lane & 7;
                    *(LAS v4u*)(Vw + kidx * 128 + ((ch ^ (((kidx >> 1) & 1) << 2)) << 4)) = vr[kt & 1][i]; }
                if (kt < 3) { const int tk1 = tkb + 32 * (kt + 2) * d, tkc = tk1 < 0 ? 0 : tk1;
#pragma unroll
                    for (int i = 0; i < 4; ++i) { const int kidx = i * 8 + (lane >> 3), ch = lane & 7;
                        vr[kt & 1][i] = *(const GAS v4u*)(Zb + (size_t)(tkc + kidx * d) * IN_COLS + C_AV + h * 64 + ch * 8); } }
                asm volatile("s_waitcnt lgkmcnt(0)" ::: "memory");
#pragma unroll
                for (int s = 0; s < 2; ++s) {
                    v4u pw; pw.x = pk2(sc[kt][8 * s], sc[kt][8 * s + 1]); pw.y = pk2(sc[kt][8 * s + 2], sc[kt][8 * s + 3]); pw.z = pk2(sc[kt][8 * s + 4], sc[kt][8 * s + 5]); pw.w = pk2(sc[kt][8 * s + 6], sc[kt][8 * s + 7]);
                    const bf16x8 pf = __builtin_bit_cast(bf16x8, pw);
#pragma unroll
                    for (int dt = 0; dt < 2; ++dt) {
                        bf16x8 vf;
#pragma unroll
                        for (int pp = 0; pp < 2; ++pp) {
                            const int i16 = lane & 15, db = (lane >> 4) & 1;
                            const int row = 16 * s + 8 * pp + 4 * hh + (i16 >> 2);
                            const int byte = 64 * dt + 32 * db + 8 * (i16 & 3);
                            const int chunk = (byte >> 4) ^ (((row >> 1) & 1) << 2);
                            const s16x4 t4 = __builtin_bit_cast(s16x4, __builtin_amdgcn_ds_read_tr16_b64_v4i16((LAS v4i16_t*)(Vw + row * 128 + (chunk << 4) + (byte & 15))));
                            vf[4 * pp + 0] = t4[0]; vf[4 * pp + 1] = t4[1]; vf[4 * pp + 2] = t4[2]; vf[4 * pp + 3] = t4[3];
                        }
                        O[dt] = __builtin_amdgcn_mfma_f32_32x32x16_bf16(vf, pf, O[dt], 0, 0, 0);
                    }
                }
                asm volatile("s_waitcnt lgkmcnt(0)" ::: "memory");
            }
            LAS unsigned char* xo = lds + AT_XO + qoff * AT_XO_STRIDE + 8 * hh;
            float wa = 0.f, wb = 1.f, Mx = ms, ln = l;
            if (pass > 0) { const float msa = XM[qoff], la = XL[qoff]; Mx = fmaxf(msa, ms); wa = la * __builtin_amdgcn_exp2f(msa - Mx); wb = __builtin_amdgcn_exp2f(ms - Mx); ln = wa + wb * l; }
            const float inv = 1.f / ln;
#pragma unroll
            for (int dt = 0; dt < 2; ++dt)
#pragma unroll
                for (int g4 = 0; g4 < 4; ++g4) {
                    LAS v2u* p = (LAS v2u*)(xo + (32 * dt + 8 * g4) * 2);
                    float o0 = O[dt][4 * g4] * wb, o1 = O[dt][4 * g4 + 1] * wb, o2 = O[dt][4 * g4 + 2] * wb, o3 = O[dt][4 * g4 + 3] * wb;
                    if (pass > 0) { const v2u old = *p; o0 += bflo(old.x) * wa; o1 += bfhi(old.x) * wa; o2 += bflo(old.y) * wa; o3 += bfhi(old.y) * wa; }
                    v2u nw; nw.x = pk2(o0 * inv, o1 * inv); nw.y = pk2(o2 * inv, o3 * inv);
                    *p = nw;
                }
            if (hh == 0) { XM[qoff] = Mx; XL[qoff] = ln; }
        }
        LDS_BARRIER();
    }
#pragma unroll
    for (int i = 0; i < 8; ++i) { const int row = (tid_ >> 3) + 64 * i, ch = tid_ & 7;
        LAS v2u* p = (LAS v2u*)(lds + AT_XO + row * AT_XO_STRIDE + ch * 16);
        const v2u a = p[0], c = p[1];
        v4u o; o.x = a.x; o.y = a.y; o.z = c.x; o.w = c.y;
        *(GAS v4u*)(Y + ((size_t)b * SEQ + t0 + row) * DM + RWW + h * 64 + ch * 8) = o; }
    LDS_BARRIER();
}

__device__ __forceinline__ void quantize_tables(Frame& F, int gw, int ngw) {
    for (int m = gw; m < 2 * NEXP; m += ngw) {
        const int tab = m >= NEXP, row = tab ? m - NEXP : m;
        const GAS f32x4* xr = (const GAS f32x4*)(F.in[18 + tab] + (size_t)row * DM) + F.lane * 4;
        f32x4 v[4]; float am = 0.f;
#pragma unroll
        for (int j = 0; j < 4; ++j) { v[j] = xr[j]; am = fmaxf(am, fmaxf(fmaxf(fabsf(v[j].x), fabsf(v[j].y)), fmaxf(fabsf(v[j].z), fabsf(v[j].w)))); }
        am = wave_max(am);
        const float qmax = tab ? 224.f : 127.f;
        const float sc = am > 0.f ? am / qmax : 1.f, inv = am > 0.f ? qmax / am : 0.f;
        v4u o;
#pragma unroll
        for (int j = 0; j < 4; ++j) {
            if (tab) { int w = __builtin_amdgcn_cvt_pk_fp8_f32(v[j].x * inv, v[j].y * inv, 0, false); w = __builtin_amdgcn_cvt_pk_fp8_f32(v[j].z * inv, v[j].w * inv, w, true); o[j] = (unsigned)w; }
            else {
            const unsigned b0 = (unsigned)(int)rintf(v[j].x * inv) & 255u, b1 = (unsigned)(int)rintf(v[j].y * inv) & 255u,
                           b2 = (unsigned)(int)rintf(v[j].z * inv) & 255u, b3 = (unsigned)(int)rintf(v[j].w * inv) & 255u;
            o[j] = b0 | (b1 << 8) | (b2 << 16) | (b3 << 24); } }
        *(GAS v4u*)(F.ws + (tab ? WS_VQ : WS_UQ) + (size_t)row * DM + F.lane * 16) = o;
        if (F.lane == 0) ((float*)(F.ws + (tab ? WS_SV : WS_SU)))[row] = sc;
    }
}

__device__ __forceinline__ void p3_mixers(Frame& F) {
    if (F.wg < NB * NHR) {
        const int chain = F.wg;
        const float* Pg = (const float*)(F.ws + WS_PQ) + (size_t)chain * 8 * 4096; const float* Qg = Pg + (size_t)256 * 4096;
        rwkv_scan<7, 3>(F, Pg, Qg, (float*)(F.ws + WS_SSEG) + (size_t)chain * 8 * 4096, nullptr);
        __syncthreads();
    }
#ifndef ATTN_REPS
#define ATTN_REPS 1
#endif
    for (int rep = 0; rep < ATTN_REPS; ++rep)
    for (int item = F.wg; item < NB * NHA * (SEQ / 512); item += F.G) attn_block(F, item);
}

constexpr int TK_SKS = 272, TK_SKH = 0, TK_SKL = 2 * 128 * TK_SKS, TK_LUT = 2 * TK_SKL, TK_END = TK_LUT + 8 * 2048;
__device__ __forceinline__ unsigned f2ord(float f) { const unsigned u = __builtin_bit_cast(unsigned, f); return u ^ ((unsigned)((int)u >> 31) | 0x80000000u); }
__device__ __forceinline__ float ord2f(unsigned o) { const unsigned u = (o & 0x80000000u) ? (o ^ 0x80000000u) : ~o; return __builtin_bit_cast(float, u); }
__device__ __forceinline__ void ce_desc(unsigned& a, unsigned& b) { const unsigned mx = a > b ? a : b, mn = a > b ? b : a; a = mx; b = mn; }
template <int N, int OFF, int TOT> __device__ __forceinline__ void bitonic_sort_desc(unsigned (&v)[TOT]) {
#pragma unroll
    for (int k = 2; k <= N; k <<= 1)
#pragma unroll
        for (int j = k >> 1; j > 0; j >>= 1)
#pragma unroll
            for (int i = 0; i < N; ++i) { const int l = i ^ j; if (l > i) { if ((i & k) == 0) ce_desc(v[OFF + i], v[OFF + l]); else ce_desc(v[OFF + l], v[OFF + i]); } }
}
template <int OFFA, int OFFB, int TOT> __device__ __forceinline__ void merge_top16(unsigned (&v)[TOT]) {
#pragma unroll
    for (int i = 0; i < 16; ++i) { const unsigned x = v[OFFA + i], y = v[OFFB + 15 - i]; v[OFFA + i] = x > y ? x : y; }
#pragma unroll
    for (int j = 8; j > 0; j >>= 1)
#pragma unroll
        for (int i = 0; i < 16; ++i) { const int l = i ^ j; if (l > i) ce_desc(v[OFFA + i], v[OFFA + l]); }
}
__device__ __forceinline__ void top16_of_64(unsigned (&k)[64]) {
    bitonic_sort_desc<16, 0, 64>(k); bitonic_sort_desc<16, 16, 64>(k); bitonic_sort_desc<16, 32, 64>(k); bitonic_sort_desc<16, 48, 64>(k);
    merge_top16<0, 16, 64>(k); merge_top16<32, 48, 64>(k); merge_top16<0, 32, 64>(k);
}
__device__ __forceinline__ void p7_topk(Frame& F) {
    static_assert(TK_END <= LDSCTL_OFF, "topk LDS");
    const bf16* QP = (const bf16*)(F.ws + WS_QP);
    int* EID = (int*)(F.ws + WS_EID); float* GATE = (float*)(F.ws + WS_GATE);
    const float* sk = F.in[17];
    LAS unsigned char* lds = F.lds + RING_OFF;
    for (int e = F.tid; e < 2 * 128 * 64; e += NTHREADS) {
        const int c = e >> 13, k = (e >> 6) & 127, d2 = e & 63;
        const f32x2 v = *(const GAS f32x2*)(sk + (size_t)(c * 128 + k) * 128 + 2 * d2);
        const unsigned h0 = f2bf(v.x), h1 = f2bf(v.y);
        const float r0 = v.x - __builtin_bit_cast(float, h0 << 16), r1 = v.y - __builtin_bit_cast(float, h1 << 16);
        *(LAS unsigned*)(lds + TK_SKH + (c * 128 + k) * TK_SKS + d2 * 4) = h0 | (h1 << 16);
        *(LAS unsigned*)(lds + TK_SKL + (c * 128 + k) * TK_SKS + d2 * 4) = pk2(r0, r1);
    }
    __syncthreads();
    const int gw = F.wg * NWAVES + F.wave, NGW = F.G * NWAVES;
    for (int tile = gw; tile < T * PHEADS / 32; tile += NGW) {
        int lane_ = F.lane; asm volatile("" : "+v"(lane_));
        const int lane = lane_, hh = lane >> 5, cl = lane & 31;
        const int P = tile * 32 + cl, t = P >> 3, h = P & 7;
        unsigned kAB[2][16];
#pragma unroll
        for (int c = 0; c < 2; ++c) {
            bf16x8 qf[8];
            const bf16* qp = QP + (size_t)t * PQ + h * 256 + c * 128 + 8 * hh;
#pragma unroll
            for (int s2 = 0; s2 < 8; ++s2) qf[s2] = *(const GAS bf16x8*)(qp + 16 * s2);
            unsigned k[64];
#pragma unroll
            for (int mt = 0; mt < 4; ++mt) {
                f32x16 acc = zero16();
                const LAS unsigned char* ah = lds + TK_SKH + (c * 128 + mt * 32 + cl) * TK_SKS + 16 * hh;
                const LAS unsigned char* al = lds + TK_SKL + (c * 128 + mt * 32 + cl) * TK_SKS + 16 * hh;
#pragma unroll
                for (int s2 = 0; s2 < 8; ++s2) {
                    acc = __builtin_amdgcn_mfma_f32_32x32x16_bf16(*(const LAS bf16x8*)(ah + 32 * s2), qf[s2], acc, 0, 0, 0);
                    acc = __builtin_amdgcn_mfma_f32_32x32x16_bf16(*(const LAS bf16x8*)(al + 32 * s2), qf[s2], acc, 0, 0, 0); }
#pragma unroll
                for (int r = 0; r < 16; ++r) { const int idx = 32 * mt + (r & 3) + 8 * (r >> 2) + 4 * hh; k[mt * 16 + r] = (f2ord(acc[r]) & ~127u) | (unsigned)(127 - idx); }
            }
            top16_of_64(k);
            unsigned m[32];
#pragma unroll
            for (int i = 0; i < 16; ++i) { m[i] = k[i]; m[16 + i] = (unsigned)__shfl_xor((int)k[i], 32); }
            merge_top16<0, 16, 32>(m);
#pragma unroll
            for (int i = 0; i < 16; ++i) kAB[c][i] = m[i];
        }
        float fa[16], fb[16];
#pragma unroll
        for (int i = 0; i < 16; ++i) { fa[i] = ord2f(kAB[0][i] & ~127u); fb[i] = ord2f(kAB[1][i] & ~127u); }
        unsigned cd[64]; int n = 0;
#pragma unroll
        for (int i = 0; i < 16; ++i)
#pragma unroll
            for (int j = 0; j < 16; ++j) if ((i + 1) * (j + 1) <= 16) { cd[n] = (f2ord(fa[i] + fb[j]) & ~255u) | (unsigned)(255 - (i * 16 + j)); ++n; }
#pragma unroll
        for (int q = 50; q < 64; ++q) cd[q] = 0u;
        top16_of_64(cd);
        LAS unsigned char* lut = lds + TK_LUT + (F.wave * 64 + lane) * 32;
#pragma unroll
        for (int q = 0; q < 4; ++q) {
            unsigned wa = 0u, wb = 0u;
#pragma unroll
            for (int b4 = 0; b4 < 4; ++b4) { wa |= (127u - (kAB[0][4 * q + b4] & 127u)) << (8 * b4); wb |= (127u - (kAB[1][4 * q + b4] & 127u)) << (8 * b4); }
            *(LAS unsigned*)(lut + 4 * q) = wa; *(LAS unsigned*)(lut + 16 + 4 * q) = wb; }
        float gv[16]; float den = 0.f; const float mx = ord2f(cd[0] & ~255u);
#pragma unroll
        for (int q = 0; q < 16; ++q) { gv[q] = __expf(ord2f(cd[q] & ~255u) - mx); den += gv[q]; }
        const float inv = 1.f / den;
        asm volatile("s_waitcnt lgkmcnt(0)" ::: "memory");
        int ev[16];
#pragma unroll
        for (int q = 0; q < 16; ++q) { const unsigned pos = 255u - (cd[q] & 255u);
            const unsigned ia = *(const LAS unsigned char*)(lut + (pos >> 4)), ib = *(const LAS unsigned char*)(lut + 16 + (pos & 15u));
            ev[q] = (int)(ia * NKEYS + ib); }
        if (hh == 0) {
            int* ep = EID + (size_t)t * 128 + h * 16; float* gp = GATE + (size_t)t * 128 + h * 16;
#pragma unroll
            for (int q = 0; q < 4; ++q) {
                *(GAS v4u*)(ep + 4 * q) = (v4u){(unsigned)ev[4 * q], (unsigned)ev[4 * q + 1], (unsigned)ev[4 * q + 2], (unsigned)ev[4 * q + 3]};
                *(GAS f32x4*)(gp + 4 * q) = (f32x4){gv[4 * q] * inv, gv[4 * q + 1] * inv, gv[4 * q + 2] * inv, gv[4 * q + 3] * inv}; }
        }
        asm volatile("s_waitcnt lgkmcnt(0)" ::: "memory");
    }
}

constexpr int GA_WAVE_BYTES = 10752, GA_CNT = 4096, GA_OFF = 4096 + 128, GA_ACT = 4608, GA_XQ = 6656;
__device__ __forceinline__ int wave_sum_i(int v) { v += dppi<0xB1>(v); v += dppi<0x4E>(v); v += dppi<0x141>(v); v += dppi<0x140>(v);
    return (__builtin_amdgcn_readlane(v, 0) + __builtin_amdgcn_readlane(v, 16)) + (__builtin_amdgcn_readlane(v, 32) + __builtin_amdgcn_readlane(v, 48)); }
struct PairBuf { v4u u, v; float su, sv; int e; float g; };
__device__ __forceinline__ void p8_gather(Frame& F, float* outp) {
    const bf16* XN = (const bf16*)(F.ws + WS_XN);
    const unsigned char* UQ = F.ws + WS_UQ; const unsigned char* VQ = F.ws + WS_VQ;
    const float* SU = (const float*)(F.ws + WS_SU); const float* SV = (const float*)(F.ws + WS_SV);
    const int* EID = (const int*)(F.ws + WS_EID); const float* GATE = (const float*)(F.ws + WS_GATE);
    const float* nf = F.in[20];
    const int gw = F.wg * NWAVES + F.wave, NGW = F.G * NWAVES;
    LAS unsigned char* wl = F.lds + RING_OFF + F.wave * GA_WAVE_BYTES;
    for (int tg = gw, sweep = 0; tg < T / 4; tg += NGW, ++sweep) {
        int lane_ = F.lane; asm volatile("" : "+v"(lane_));
        const int lane = lane_;
        int xq[4][4]; float sx[4];
#pragma unroll
        for (int tk = 0; tk < 4; ++tk) {
            const GAS v4u* xp = (const GAS v4u*)(XN + (size_t)(4 * tg + tk) * DM + lane * 16);
            const v4u a = xp[0], b = xp[1];
            float x[16]; x[0] = bflo(a.x); x[1] = bfhi(a.x); x[2] = bflo(a.y); x[3] = bfhi(a.y); x[4] = bflo(a.z); x[5] = bfhi(a.z); x[6] = bflo(a.w); x[7] = bfhi(a.w);
            x[8] = bflo(b.x); x[9] = bfhi(b.x); x[10] = bflo(b.y); x[11] = bfhi(b.y); x[12] = bflo(b.z); x[13] = bfhi(b.z); x[14] = bflo(b.w); x[15] = bfhi(b.w);
            float am = 0.f;
#pragma unroll
            for (int i = 0; i < 16; ++i) am = fmaxf(am, fabsf(x[i]));
            am = wave_max(am);
            const float rs_ = frsq(((const float*)(F.ws + WS_SSQ))[4 * tg + tk] * (1.f / DM) + RMS_EPS);
            sx[tk] = (am > 0.f ? am * (1.f / 127.f) : 1.f) * rs_; const float inv = am > 0.f ? 127.f / am : 0.f;
#pragma unroll
            for (int q = 0; q < 4; ++q) {
                const unsigned b0 = (unsigned)(int)rintf(x[4 * q] * inv) & 255u, b1 = (unsigned)(int)rintf(x[4 * q + 1] * inv) & 255u, b2 = (unsigned)(int)rintf(x[4 * q + 2] * inv) & 255u, b3 = (unsigned)(int)rintf(x[4 * q + 3] * inv) & 255u;
                xq[tk][q] = (int)(b0 | (b1 << 8) | (b2 << 16) | (b3 << 24)); }
            *(LAS v4u*)(wl + GA_XQ + tk * 1024 + lane * 16) = (v4u){(unsigned)xq[tk][0], (unsigned)xq[tk][1], (unsigned)xq[tk][2], (unsigned)xq[tk][3]};
        }
        LAS unsigned* cnt = (LAS unsigned*)(wl + GA_CNT); LAS unsigned* offs = (LAS unsigned*)(wl + GA_OFF);
        if (lane < 32) cnt[lane] = 0u;
        asm volatile("s_waitcnt lgkmcnt(0)" ::: "memory");
        int ee[8]; float gg[8]; unsigned pos[8];
#pragma unroll
        for (int tk = 0; tk < 4; ++tk) {
            const size_t base = (size_t)(4 * tg + tk) * 128;
            ee[2 * tk] = (EID[base + lane] & (NEXP - 1)) | (tk << 14); ee[2 * tk + 1] = (EID[base + 64 + lane] & (NEXP - 1)) | (tk << 14);
            gg[2 * tk] = GATE[base + lane]; gg[2 * tk + 1] = GATE[base + 64 + lane]; }
#pragma unroll
        for (int q = 0; q < 8; ++q) pos[q] = __hip_atomic_fetch_add(cnt + ((ee[q] >> 9) & 31), 1u, __ATOMIC_RELAXED, __HIP_MEMORY_SCOPE_WAVEFRONT);
        asm volatile("s_waitcnt lgkmcnt(0)" ::: "memory");
        if (lane < 32) {
            const int c0 = (int)cnt[lane]; int v = c0;
            v += __builtin_amdgcn_update_dpp(0, v, 0x111, 0xF, 0xF, true); v += __builtin_amdgcn_update_dpp(0, v, 0x112, 0xF, 0xF, true);
            v += __builtin_amdgcn_update_dpp(0, v, 0x114, 0xF, 0xF, true); v += __builtin_amdgcn_update_dpp(0, v, 0x118, 0xF, 0xF, true);
            const int row0 = __builtin_amdgcn_readlane(v, 15);
            offs[lane] = (unsigned)(v - c0 + (lane >= 16 ? row0 : 0));
        }
        asm volatile("s_waitcnt lgkmcnt(0)" ::: "memory");
#pragma unroll
        for (int q = 0; q < 8; ++q) { const unsigned idx = offs[(ee[q] >> 9) & 31] + pos[q];
            *(LAS unsigned*)(wl + idx * 4) = (unsigned)ee[q]; *(LAS float*)(wl + 2048 + idx * 4) = gg[q]; }
        asm volatile("s_waitcnt lgkmcnt(0)" ::: "memory");
        LAS float* act = (LAS float*)(wl + GA_ACT);
#ifndef UPASS_REPS
#define UPASS_REPS 1
#endif
        for (int urep = 0; urep < UPASS_REPS; ++urep)
        {
            const int grp = lane >> 4, l16 = lane & 15;
            const LAS unsigned* ents = (const LAS unsigned*)wl;
            LAS int* hbuf = (LAS int*)(wl + GA_ACT);
            v4u rb[2][2][4]; unsigned eb[2][2];
#define GA_ULOAD(ST, QD, Q_) do { const unsigned e_ = ents[(Q_) * 4 + grp]; eb[ST][QD] = e_; const GAS v4u* rp_ = (const GAS v4u*)(UQ + (size_t)(e_ & (NEXP - 1)) * DM + l16 * 64); \
                rb[ST][QD][0] = rp_[0]; rb[ST][QD][1] = rp_[1]; rb[ST][QD][2] = rp_[2]; rb[ST][QD][3] = rp_[3]; } while (0)
#define GA_UDOT(ST, QD, Q_) do { const LAS v4u* xp_ = (const LAS v4u*)(wl + GA_XQ + ((eb[ST][QD] >> 14) & 3u) * 1024 + l16 * 64); int d_ = 0; \
                _Pragma("unroll") for (int k_ = 0; k_ < 4; ++k_) { const v4u x_ = xp_[k_], r_ = rb[ST][QD][k_]; \
                    d_ = __builtin_amdgcn_sdot4((int)x_.x, (int)r_.x, d_, false); d_ = __builtin_amdgcn_sdot4((int)x_.y, (int)r_.y, d_, false); \
                    d_ = __builtin_amdgcn_sdot4((int)x_.z, (int)r_.z, d_, false); d_ = __builtin_amdgcn_sdot4((int)x_.w, (int)r_.w, d_, false); } \
                d_ += dppi<0xB1>(d_); d_ += dppi<0x4E>(d_); d_ += dppi<0x141>(d_); d_ += dppi<0x140>(d_); \
                if (l16 == 0) hbuf[(Q_) * 4 + grp] = d_; } while (0)
            GA_ULOAD(0, 0, 0); GA_ULOAD(0, 1, 1);
            for (int q2 = 0; q2 < 128; q2 += 4) {
                GA_ULOAD(1, 0, q2 + 2); GA_ULOAD(1, 1, q2 + 3);
                __builtin_amdgcn_sched_barrier(0);
                GA_UDOT(0, 0, q2); GA_UDOT(0, 1, q2 + 1);
                __builtin_amdgcn_sched_barrier(0);
                if (q2 + 4 < 128) { GA_ULOAD(0, 0, q2 + 4); GA_ULOAD(0, 1, q2 + 5); }
                __builtin_amdgcn_sched_barrier(0);
                GA_UDOT(1, 0, q2 + 2); GA_UDOT(1, 1, q2 + 3);
                __builtin_amdgcn_sched_barrier(0);
            }
#undef GA_ULOAD
#undef GA_UDOT
            asm volatile("s_waitcnt lgkmcnt(0)" ::: "memory");
#pragma unroll 2
            for (int it = 0; it < 8; ++it) { const int p = it * 64 + lane;
                const unsigned e_ = ents[p]; const float g_ = *(const LAS float*)(wl + 2048 + p * 4); const int hs = hbuf[p];
                const int ex_ = (int)(e_ & (NEXP - 1)), tk_ = (int)(e_ >> 14) & 3;
                const float sxl = tk_ == 0 ? sx[0] : (tk_ == 1 ? sx[1] : (tk_ == 2 ? sx[2] : sx[3]));
                const float h_ = (float)hs * (SU[ex_] * sxl);
                act[p] = 0.5f * h_ * (1.f + erff(h_ * 0.70710678118654752f)) * g_ * SV[ex_]; }
        }
        asm volatile("s_waitcnt lgkmcnt(0)" ::: "memory");
        float y[4][16];
#pragma unroll
        for (int tk = 0; tk < 4; ++tk) {
#pragma unroll
            for (int i = 0; i < 16; ++i) y[tk][i] = 0.f; }
#define GA_AXPY(V, A, TK) do { \
            _Pragma("unroll") for (int q_ = 0; q_ < 4; ++q_) { const int w_ = (int)(V)[q_]; const f32x2 lo_ = __builtin_amdgcn_cvt_pk_f32_fp8(w_, false), hi_ = __builtin_amdgcn_cvt_pk_f32_fp8(w_, true); \
                y[TK][4 * q_] += (A) * lo_.x; y[TK][4 * q_ + 1] += (A) * lo_.y; y[TK][4 * q_ + 2] += (A) * hi_.x; y[TK][4 * q_ + 3] += (A) * hi_.y; } } while (0)
        for (int ch = 0; ch < 8; ++ch) {
            const unsigned ent = *(const LAS unsigned*)(wl + (ch * 64 + lane) * 4);
            const float areg = act[ch * 64 + lane];
            v4u vb[2][8]; int eb[2][8];
#pragma unroll
            for (int q = 0; q < 8; ++q) { eb[0][q] = __builtin_amdgcn_readlane((int)ent, q); vb[0][q] = *(const GAS v4u*)(VQ + (size_t)(eb[0][q] & (NEXP - 1)) * DM + lane * 16); }
#pragma unroll
            for (int jb = 0; jb < 8; ++jb) {
                if (jb + 1 < 8) {
#pragma unroll
                    for (int q = 0; q < 8; ++q) { eb[(jb + 1) & 1][q] = __builtin_amdgcn_readlane((int)ent, 8 * (jb + 1) + q); vb[(jb + 1) & 1][q] = *(const GAS v4u*)(VQ + (size_t)(eb[(jb + 1) & 1][q] & (NEXP - 1)) * DM + lane * 16); } }
                __builtin_amdgcn_sched_barrier(0);
#pragma unroll
                for (int q = 0; q < 8; ++q) { const int tk_ = (eb[jb & 1][q] >> 14) & 3; const v4u v_ = vb[jb & 1][q]; const float a_ = rdlane(areg, 8 * jb + q);
                    if (tk_ == 0) GA_AXPY(v_, a_, 0); else if (tk_ == 1) GA_AXPY(v_, a_, 1); else if (tk_ == 2) GA_AXPY(v_, a_, 2); else GA_AXPY(v_, a_, 3); }
                __builtin_amdgcn_sched_barrier(0);
            }
        }
#undef GA_AXPY
#pragma unroll
        for (int tk = 0; tk < 4; ++tk) {
            float* hrow = F.out + (size_t)(4 * tg + tk) * DM + lane * 16;
            float hv[16]; float ss = 0.f;
#pragma unroll
            for (int q = 0; q < 4; ++q) { const f32x4 h4 = *(const GAS f32x4*)(hrow + 4 * q);
#pragma unroll
                for (int i = 0; i < 4; ++i) { const float v = h4[i] + y[tk][4 * q + i]; hv[4 * q + i] = v; ss += v * v; } }
            const float rstd = frsq(wave_sum(ss) * (1.f / DM) + RMS_EPS);
#pragma unroll
            for (int q = 0; q < 4; ++q) { const f32x4 n4 = *(const GAS f32x4*)(nf + lane * 16 + 4 * q);
                *(GAS f32x4*)(outp + (size_t)(4 * tg + tk) * DM + lane * 16 + 4 * q) = (f32x4){hv[4 * q] * rstd * n4[0], hv[4 * q + 1] * rstd * n4[1], hv[4 * q + 2] * rstd * n4[2], hv[4 * q + 3] * rstd * n4[3]}; }
        }
    }
}

struct Args { const float* in[21]; float* out; unsigned char* ws; int ph_lo, ph_hi; };
static_assert(sizeof(Args) == 21 * 8 + 8 + 8 + 8, "Args has no padding");

__global__ void __launch_bounds__(NTHREADS, 2) fwd_kernel(Args args) {
    extern __shared__ __attribute__((aligned(16))) unsigned char lds[];
    Frame F;
    F.lds = (LAS unsigned char*)lds;
    F.MISC = (volatile LAS unsigned*)(F.lds + MISC_OFF);
    F.tid = threadIdx.x; F.lane = F.tid & 63; F.wave = __builtin_amdgcn_readfirstlane(F.tid >> 6);
    F.G = gridDim.x; F.wg = blockIdx.x;
#pragma unroll
    for (int i = 0; i < 21; ++i) F.in[i] = args.in[i];
    F.out = args.out; F.ws = args.ws;
    F.ctl = (gu32*)(args.ws + WS_CTL);
    for (int u = F.tid; u < (LDS_BYTES - LDSCTL_OFF) / 4; u += NTHREADS) ((LAS unsigned*)(F.lds + LDSCTL_OFF))[u] = 0u;
    __syncthreads();
    const int lo = args.ph_lo, hi = args.ph_hi;
    const bool fused = (hi - lo) > 1;
    XcdBarrier bar; bar.bar = (unsigned*)(F.ctl + CW_BAR); bar.x = 0; bar.st = nullptr;
    if (fused) bar = xcd_barrier_post((unsigned*)(F.ctl + CW_BAR), F.MISC + 8);
#define IN(k) (lo <= (k) && (k) < hi)
#define REPS(k) (((REP_MASK >> (k)) & 1) ? 2 : 1)
#define REPLOOP(k) for (int rep_ = 0; rep_ < REPS(k); ++rep_, (rep_ < REPS(k) ? xcd_barrier(bar) : (void)0))
#define SEAM(k) do { if (IN(k) && IN((k) + 1)) xcd_barrier(bar); } while (0)

    if (IN(0)) { REPLOOP(0) { p0_prologue(F); p0_rope_table(F); } SEAM(0); }
    if (IN(1)) { REPLOOP(1) {
        pg8::Gemm g{(const bf16*)(F.ws + WS_XN), (const bf16*)(F.ws + WS_WIN), T, IN_COLS, DM}; pg8::StaticOrder S; S.init(T, IN_COLS, F.G, F.wg);
        pg8::EpiBf16 E{(bf16*)(F.ws + WS_Z), IN_COLS};
        pg8::gemm_phase<pg8::EpiBf16, pg8::StaticOrder, true, true>(F.lds + RING_OFF, g, S, E); }
        {
            const int nwg = (T / 256) * (IN_COLS / 256), rem = nwg % F.G;
            if (rem == 0) quantize_tables(F, F.wg * NWAVES + F.wave, F.G * NWAVES);
            else if (F.wg >= rem) quantize_tables(F, (F.wg - rem) * NWAVES + F.wave, (F.G - rem) * NWAVES);
        }
        SEAM(1);
    }
    if (IN(2)) { p2_rope(F); REPLOOP(2) { const int cnt = r13_count(F.wg, F.G); R1Pre P;
            if (cnt > 0) rwkv_r1_prefetch(F, r13_item(F.wg, F.G, 0), F.tid, P);
            bf16x8 bfr[4]; int hcur = -1;
            f32x4 cst[4];
            { const int n16 = F.lane & 15, g = F.lane >> 4;
#pragma unroll
              for (int rt = 0; rt < 4; ++rt)
#pragma unroll
                  for (int q = 0; q < 4; ++q) cst[rt][q] = (F.wave < 4 && 16 * rt + 4 * g + q == 16 * F.wave + n16) ? 1.f : 0.f; }
            for (int i = 0; i < cnt; ++i) { const int it = r13_item(F.wg, F.G, i), hh_ = (it >> 7) & 7;
                if (hh_ != hcur) { r1_load_bfrag(F, hh_, F.wave, F.lane, bfr); hcur = hh_; }
                rwkv_r1_item(F, it, i + 1 < cnt ? r13_item(F.wg, F.G, i + 1) : -1, P, bfr, cst); }
            { const int n16 = F.lane & 15, g = F.lane >> 4; float* Pg = (float*)(F.ws + WS_PQ) + (size_t)F.wg * 4096; float* Qg = Pg + (size_t)256 * 4096;
              if (F.wave < 4) {
#pragma unroll
                  for (int rt = 0; rt < 4; ++rt)
#pragma unroll
                      for (int q = 0; q < 4; ++q) Pg[(16 * rt + 4 * g + q) * 64 + 16 * F.wave + n16] = cst[rt][q];
              } else {
#pragma unroll
                  for (int rt = 0; rt < 4; ++rt) *(GAS f32x4*)(Qg + (16 * (F.wave - 4) + n16) * 64 + 16 * rt + 4 * g) = cst[rt];
              } } }
        SEAM(2); }
    if (IN(3)) { REPLOOP(3) p3_mixers(F); SEAM(3); }
    if (IN(4)) { REPLOOP(4) { const int cnt = r13_count(F.wg, F.G); R3Pre P;
            {
                const int item0 = r13_item(F.wg, F.G, 0);
                rwkv_scan<15, 7>(F, F.out + (size_t)item0 * 4096, F.out + (size_t)T * RWW + (size_t)item0 * 4096, (float*)(F.ws + WS_RWSS) + (size_t)item0 * 4096, (const float*)(F.ws + WS_SSEG) + (size_t)F.wg * 4096);
                asm volatile("s_waitcnt vmcnt(0)" ::: "memory"); __syncthreads();
            }
            if (cnt > 0) rwkv_r3_prefetch(F, r13_item(F.wg, F.G, 0), F.tid, P);
            bf16x8 bfr[8]; int hcur = -1;
            for (int i = 0; i < cnt; ++i) { const int it = r13_item(F.wg, F.G, i), hh_ = (it >> 7) & 7;
                if (hh_ != hcur) { r3_load_bfrag(F, hh_, F.wave, F.lane, bfr); hcur = hh_; }
                rwkv_r3_item(F, it, i + 1 < cnt ? r13_item(F.wg, F.G, i + 1) : -1, P, bfr); } }
        SEAM(4); }
    if (IN(5)) {
        pg8::Gemm g{(const bf16*)(F.ws + WS_YMIX), (const bf16*)(F.ws + WS_WOUT), T, DM, DM}; pg8::StaticOrder S; S.init(T, DM, F.G, F.wg);
        pg8::EpiF32Res E{F.in[0], F.out, DM, (bf16*)(F.ws + WS_XN), F.in[15], (float*)(F.ws + WS_SSQ)};
        pg8::gemm_phase<pg8::EpiF32Res, pg8::StaticOrder, true, true>(F.lds + RING_OFF, g, S, E);
        SEAM(5);
    }
    if (IN(6)) { REPLOOP(6) {
        pg8::Gemm g{(const bf16*)(F.ws + WS_XN), (const bf16*)(F.ws + WS_WQ), T, PQ, DM}; pg8::StaticOrder S; S.init(T, PQ, F.G, F.wg);
        pg8::EpiBf16Rs E{(bf16*)(F.ws + WS_QP), PQ, (const float*)(F.ws + WS_SSQ)};
        pg8::gemm_phase<pg8::EpiBf16Rs, pg8::StaticOrder, true, true>(F.lds + RING_OFF, g, S, E); }
        SEAM(6);
    }
    if (IN(7)) { REPLOOP(7) p7_topk(F); SEAM(7); }
    if (IN(8)) { if (REPS(8) > 1) { p8_gather(F, (float*)(F.ws + WS_Z)); xcd_barrier(bar); } p8_gather(F, F.out); }
#undef IN
#undef SEAM
}

extern "C" void kernel_launch(void* const* d_in, const int* in_sizes, int n_in, void* d_out, int out_size, void* d_ws, size_t ws_size, hipStream_t stream) {
    static int grid = 0;
    if (grid == 0) {
        if (n_in != 21 || in_sizes[0] != T * DM || out_size != T * DM || ws_size < WS_END) {
            fprintf(stderr, "kernel_launch: unexpected shapes: n_in %d in0 %d out %d ws %zu (need %zu); nothing launched\n", n_in, n_in > 0 ? in_sizes[0] : -1, out_size, ws_size, (size_t)WS_END); grid = -1; return; }
        int dev = 0, cus = 0, per_cu = 0;
        if (hipGetDevice(&dev) != hipSuccess || hipDeviceGetAttribute(&cus, hipDeviceAttributeMultiprocessorCount, dev) != hipSuccess) { grid = -1; return; }
        if (hipFuncSetAttribute((const void*)fwd_kernel, hipFuncAttributeMaxDynamicSharedMemorySize, LDS_BYTES) != hipSuccess) { fprintf(stderr, "kernel_launch: hipFuncSetAttribute failed\n"); grid = -1; return; }
        if (hipOccupancyMaxActiveBlocksPerMultiprocessor(&per_cu, (const void*)fwd_kernel, NTHREADS, LDS_BYTES) != hipSuccess || per_cu < 1) { fprintf(stderr, "kernel_launch: occupancy query says %d\n", per_cu); per_cu = 1; }
        (void)hipGetLastError();
        grid = cus;
        if (cus != 256) { fprintf(stderr, "kernel_launch: the RWKV segment mapping assumes 256 CUs (got %d); nothing launched\n", cus); grid = -1; return; }
    }
    if (grid < 0) return;
    (void)hipMemsetAsync((char*)d_ws + WS_CTL, 0, CTL_ZERO_BYTES, stream);
    Args a{};
    for (int i = 0; i < 21; ++i) a.in[i] = (const float*)d_in[i];
    a.out = (float*)d_out; a.ws = (unsigned char*)d_ws;
    if (MK_N_LAUNCHES == 1) {
        a.ph_lo = 0; a.ph_hi = NPHASE;
        void* kargs[] = {&a};
        hipError_t e = hipLaunchCooperativeKernel((const void*)fwd_kernel, dim3(grid), dim3(NTHREADS), kargs, LDS_BYTES, stream);
        if (e != hipSuccess) fprintf(stderr, "kernel_launch: cooperative launch failed: %s (grid %d)\n", hipGetErrorString(e), grid);
    } else {
        for (int p = 0; p < NPHASE; ++p) { a.ph_lo = p; a.ph_hi = p + 1;
            hipLaunchKernelGGL(fwd_kernel, dim3(grid), dim3(NTHREADS), LDS_BYTES, stream, a); }
    }
}
```

```cpp
#include <hip/hip_runtime.h>
#include <cstdio>
#include <cstdint>

#ifndef MK_N_LAUNCHES
#define MK_N_LAUNCHES 1
#endif

#ifndef REP_MASK
#define REP_MASK 0
#endif
#define GAS __attribute__((address_space(1)))
#define LAS __attribute__((address_space(3)))
typedef unsigned short bf16;
typedef unsigned v4u __attribute__((ext_vector_type(4)));
typedef unsigned v2u __attribute__((ext_vector_type(2)));
typedef float f32x4 __attribute__((ext_vector_type(4)));
typedef float f32x2 __attribute__((ext_vector_type(2)));
typedef short bf16x8 __attribute__((ext_vector_type(8)));
typedef GAS unsigned gu32;
#define RLX_AGENT __ATOMIC_RELAXED, __HIP_MEMORY_SCOPE_AGENT
#define LDS_WAIT() asm volatile("s_waitcnt lgkmcnt(0)" ::: "memory")
#define VM_WAIT() asm volatile("s_waitcnt vmcnt(0)" ::: "memory")
#define LDS_BARRIER() do { asm volatile("s_waitcnt lgkmcnt(0)" ::: "memory"); __builtin_amdgcn_s_barrier(); asm volatile("" ::: "memory"); } while (0)

constexpr int DM = 1024, NB = 4, SEQ = 8192, T = NB * SEQ;
constexpr int HD = 64, RWW = 512, NHR = 8, NHA = 8;
constexpr int IN_COLS = 3328;
constexpr int C_R = 0, C_K = 512, C_V = 1024, C_WD = 1536, C_AD = 1600, C_GD = 1664, C_AQ = 1792, C_AK = 2304, C_AV = 2816;
constexpr int PHEADS = 8, NKEYS = 128, PQ = 2048, TOPK = 16, NEXP = 16384;
constexpr float RMS_EPS = 1e-6f, GN_EPS = 64e-5f;
constexpr int NWAVES = 8, NTHREADS = 512;
constexpr int NPHASE = 9;

constexpr size_t MiB = 1u << 20;
constexpr size_t WS_CTL = 0, CTL_ZERO_BYTES = 1 * MiB;
constexpr size_t WS_WIN = 2 * MiB;
constexpr size_t WS_WOUT = 10 * MiB;
constexpr size_t WS_WQ = 12 * MiB;
constexpr size_t WS_XN = 16 * MiB;
constexpr size_t WS_Z = 80 * MiB;
constexpr size_t WS_QP = 80 * MiB;
constexpr size_t WS_G = 288 * MiB;
constexpr size_t WS_YMIX = 352 * MiB;
constexpr size_t WS_UQ = 416 * MiB;
constexpr size_t WS_VQ = 432 * MiB;
constexpr size_t WS_SU = 448 * MiB;
constexpr size_t WS_SV = 449 * MiB;
constexpr size_t WS_EID = 480 * MiB;
constexpr size_t WS_GATE = 496 * MiB;
constexpr size_t WS_SSEG = 450 * MiB;
constexpr size_t WS_PQ = 456 * MiB;
constexpr size_t WS_END = 512 * MiB;
constexpr size_t WS_WUPT = 1 * MiB, WS_AUPT = WS_WUPT + 65536, WS_GUPT = WS_AUPT + 65536;
constexpr size_t WS_BONUS = 9 * MiB;
constexpr size_t WS_RWY0 = WS_XN;
constexpr size_t WS_RWSS = WS_G;
constexpr size_t WS_RWRH = WS_EID;

constexpr int CW_BAR = 4096;
constexpr size_t WS_SSQ = 256 * 1024;

typedef __bf16 hbf16x2_t __attribute__((ext_vector_type(2)));
__device__ __forceinline__ unsigned pk2(float lo, float hi) { const f32x2 v = {lo, hi}; const hbf16x2_t b = __builtin_convertvector(v, hbf16x2_t); return __builtin_bit_cast(unsigned, b); }
__device__ __forceinline__ unsigned f2bf(float f) { return pk2(f, 0.f) & 0xffffu; }
__device__ __forceinline__ float frcp(float x) { return __builtin_amdgcn_rcpf(x); }
__device__ __forceinline__ float frsq(float x) { return __builtin_amdgcn_rsqf(x); }
__device__ __forceinline__ float bflo(unsigned u) { return __builtin_bit_cast(float, u << 16); }
__device__ __forceinline__ float bfhi(unsigned u) { return __builtin_bit_cast(float, u & 0xffff0000u); }
__device__ __forceinline__ float bf2f(bf16 h) { return __builtin_bit_cast(float, (unsigned)h << 16); }

template <int CTRL> __device__ __forceinline__ float dppf(float x) { return __builtin_bit_cast(float, __builtin_amdgcn_update_dpp(0, __builtin_bit_cast(int, x), CTRL, 0xF, 0xF, true)); }
template <int CTRL> __device__ __forceinline__ int dppi(int x) { return __builtin_amdgcn_update_dpp(0, x, CTRL, 0xF, 0xF, true); }
__device__ __forceinline__ float rdlane(float v, int l) { return __builtin_bit_cast(float, __builtin_amdgcn_readlane(__builtin_bit_cast(int, v), l)); }
__device__ __forceinline__ float sum8(float v) { v += dppf<0xB1>(v); v += dppf<0x4E>(v); v += dppf<0x141>(v); return v; }
__device__ __forceinline__ float sum16(float v) { v = sum8(v); v += dppf<0x140>(v); return v; }
__device__ __forceinline__ float wave_sum(float v) { v = sum16(v);
    v += __builtin_bit_cast(float, __builtin_amdgcn_update_dpp(0, __builtin_bit_cast(int, v), 0x142, 0xA, 0xF, false));
    v += __builtin_bit_cast(float, __builtin_amdgcn_update_dpp(0, __builtin_bit_cast(int, v), 0x143, 0xC, 0xF, false));
    return rdlane(v, 63); }
__device__ __forceinline__ float wave_max(float v) {
    v = fmaxf(v, dppf<0xB1>(v)); v = fmaxf(v, dppf<0x4E>(v)); v = fmaxf(v, dppf<0x141>(v)); v = fmaxf(v, dppf<0x140>(v));
    return fmaxf(fmaxf(rdlane(v, 0), rdlane(v, 16)), fmaxf(rdlane(v, 32), rdlane(v, 48)));
}
__device__ __forceinline__ int wave_min_i(int v) {
    v = min(v, dppi<0xB1>(v)); v = min(v, dppi<0x4E>(v)); v = min(v, dppi<0x141>(v)); v = min(v, dppi<0x140>(v));
    return min(min(__builtin_amdgcn_readlane(v, 0), __builtin_amdgcn_readlane(v, 16)), min(__builtin_amdgcn_readlane(v, 32), __builtin_amdgcn_readlane(v, 48)));
}

namespace pg8 {
#define PG8_LAS __attribute__((address_space(3)))
typedef unsigned short bf16_t;
typedef unsigned u32x4 __attribute__((ext_vector_type(4)));
constexpr int BM = 256, BK = 64, HALF = 128, HTB = HALF * BK * 2, STAGE_BYTES = 8 * HTB, NXCD = 8, WGM = 8;
__host__ __device__ __forceinline__ int lds_byte(int r, int c) { const int st = (r >> 4) * 2 + (c >> 5), rr = r & 15, cc = c & 31, ob = rr * 64 + cc * 2; return st * 1024 + (ob ^ (((ob >> 9) & 1) << 5)); }
__host__ __device__ __forceinline__ void stage_rc(int b, int& R, int& C) { const int st = b / 1024, sb = b % 1024, swz = sb ^ (((sb >> 9) & 1) << 5); R = (st >> 1) * 16 + swz / 64; C = (st & 1) * 32 + (swz % 64) / 2; }
__host__ __device__ __forceinline__ int perm32(int rho) { const int n = rho >> 4, i = rho & 15; return 8 * (i >> 2) + 4 * n + (i & 3); }
struct Unit { int pm, pn; };
struct Gemm { const bf16_t* A; const bf16_t* Bt; int M, N, K; };
struct StaticOrder {
    int nM, nN, nwg, G, c;
    __host__ __device__ void init(int M, int N, int G_, int c_) { nM = M / BM; nN = N / BM; nwg = nM * nN; G = G_; c = c_; }
    __host__ __device__ bool next(int i, Unit& u) const {
        const long L = (long)i * G + c; if (L >= nwg) return false;
        int wgid = (int)L; { const int q = nwg / NXCD, r = nwg % NXCD, xcd = wgid % NXCD, off = wgid / NXCD; wgid = (xcd < r ? xcd * (q + 1) : r * (q + 1) + (xcd - r) * q) + off; }
        const int nig = WGM * nN, gid = wgid / nig, fm = gid * WGM, gsz = (nM - fm) < WGM ? (nM - fm) : WGM;
        u.pm = fm + ((wgid % nig) % gsz); u.pn = (wgid % nig) / gsz; return true;
    }
    __device__ __forceinline__ void a_ready(const Unit&) const {}
    __device__ __forceinline__ void done(const Unit&) const {}
};
__device__ __forceinline__ unsigned cvt_pk_bf16(float lo, float hi) { unsigned r; asm volatile("v_cvt_pk_bf16_f32 %0, %1, %2" : "=v"(r) : "v"(lo), "v"(hi)); return r; }
struct EpiBf16 {
    static constexpr bool PERM = true, AFTER_DRAIN = false;
    bf16_t* O; int ldc;
    __device__ __forceinline__ void operator()(const f32x4 (&acc)[2][2][4][2], const Unit& u, int wr, int wc, int fr, int fq) const {
        const int row0 = u.pm * BM + wr * 64 + fr; const int col0 = u.pn * BM + wc * 32 + 8 * fq;
#pragma unroll
        for (int ai = 0; ai < 2; ++ai)
#pragma unroll
            for (int m = 0; m < 4; ++m) { bf16_t* rowp = O + (size_t)(row0 + ai * HALF + m * 16) * ldc + col0;
#pragma unroll
                for (int bj = 0; bj < 2; ++bj) { const f32x4 v0 = acc[ai][bj][m][0], v1 = acc[ai][bj][m][1];
                    u32x4 w; w.x = cvt_pk_bf16(v0[0], v0[1]); w.y = cvt_pk_bf16(v0[2], v0[3]); w.z = cvt_pk_bf16(v1[0], v1[1]); w.w = cvt_pk_bf16(v1[2], v1[3]);
                    *(u32x4*)(rowp + bj * HALF) = w; } }
    }
};
struct EpiF32Res {
    static constexpr bool PERM = true, AFTER_DRAIN = false;
    const float* res; float* O; int ldc; bf16_t* HG; const float* gain; float* ssq;
    __device__ __forceinline__ void operator()(const f32x4 (&acc)[2][2][4][2], const Unit& u, int wr, int wc, int fr, int fq) const {
        const int row0 = u.pm * BM + wr * 64 + fr; const int col0 = u.pn * BM + wc * 32 + 8 * fq;
        f32x4 gv[2][2];
#pragma unroll
        for (int bj = 0; bj < 2; ++bj) { gv[bj][0] = *(const f32x4*)(gain + col0 + bj * HALF); gv[bj][1] = *(const f32x4*)(gain + col0 + bj * HALF + 4); }
#pragma unroll
        for (int ai = 0; ai < 2; ++ai)
#pragma unroll
            for (int m = 0; m < 4; ++m) { const int row = row0 + ai * HALF + m * 16; const size_t off = (size_t)row * ldc + col0; float sq = 0.f;
#pragma unroll
                for (int bj = 0; bj < 2; ++bj) { const f32x4 r0 = *(const f32x4*)(res + off + bj * HALF), r1 = *(const f32x4*)(res + off + bj * HALF + 4);
                    const f32x4 h0 = acc[ai][bj][m][0] + r0, h1 = acc[ai][bj][m][1] + r1;
                    *(f32x4*)(O + off + bj * HALF) = h0; *(f32x4*)(O + off + bj * HALF + 4) = h1;
                    sq += (h0[0] * h0[0] + h0[1] * h0[1]) + (h0[2] * h0[2] + h0[3] * h0[3]) + (h1[0] * h1[0] + h1[1] * h1[1]) + (h1[2] * h1[2] + h1[3] * h1[3]);
                    const f32x4 g0 = gv[bj][0], g1 = gv[bj][1];
                    u32x4 w; w.x = cvt_pk_bf16(h0[0] * g0[0], h0[1] * g0[1]); w.y = cvt_pk_bf16(h0[2] * g0[2], h0[3] * g0[3]); w.z = cvt_pk_bf16(h1[0] * g1[0], h1[1] * g1[1]); w.w = cvt_pk_bf16(h1[2] * g1[2], h1[3] * g1[3]);
                    *(u32x4*)(HG + off + bj * HALF) = w; }
                sq += __shfl_xor(sq, 16); sq += __shfl_xor(sq, 32);
                if (fq == 0) atomicAdd(ssq + row, sq); }
    }
};
struct EpiBf16Rs {
    static constexpr bool PERM = true, AFTER_DRAIN = false;
    bf16_t* O; int ldc; const float* ssq;
    __device__ __forceinline__ void operator()(const f32x4 (&acc)[2][2][4][2], const Unit& u, int wr, int wc, int fr, int fq) const {
        const int row0 = u.pm * BM + wr * 64 + fr; const int col0 = u.pn * BM + wc * 32 + 8 * fq;
#pragma unroll
        for (int ai = 0; ai < 2; ++ai)
#pragma unroll
            for (int m = 0; m < 4; ++m) { const int row = row0 + ai * HALF + m * 16; bf16_t* rowp = O + (size_t)row * ldc + col0;
                const float rs = __builtin_amdgcn_rsqf(ssq[row] * (1.f / 1024.f) + 1e-6f);
#pragma unroll
                for (int bj = 0; bj < 2; ++bj) { const f32x4 v0 = acc[ai][bj][m][0] * rs, v1 = acc[ai][bj][m][1] * rs;
                    u32x4 w; w.x = cvt_pk_bf16(v0[0], v0[1]); w.y = cvt_pk_bf16(v0[2], v0[3]); w.z = cvt_pk_bf16(v1[0], v1[1]); w.w = cvt_pk_bf16(v1[2], v1[3]);
                    *(u32x4*)(rowp + bj * HALF) = w; } }
    }
};

template <class Epi, class Sched, bool ALIGN_EPI = false, bool SP2 = false>
__device__ __forceinline__ void gemm_phase(PG8_LAS unsigned char* lds, const Gemm g, const Sched& S, const Epi& E) {
    const int tid = threadIdx.x, wid = __builtin_amdgcn_readfirstlane(tid >> 6), lane = tid & 63, wr = wid >> 2, wc = wid & 3, fr = lane & 15, fq = lane >> 4;
    const int K = g.K, nt = K / BK;
    unsigned voffA[2], voffB[2];
#pragma unroll
    for (int i = 0; i < 2; ++i) { int R, C; stage_rc(tid * 16 + i * 8192, R, C); const int Rb = Epi::PERM ? ((R & ~31) + perm32(R & 31)) : R;
        voffA[i] = (unsigned)(R * K + C) * 2u; voffB[i] = (unsigned)(Rb * K + C) * 2u; }
    const size_t kstep = (size_t)(BK * 2);
    const size_t hstep = (size_t)HALF * K * 2;
    const size_t tstep = 2 * hstep;
    const unsigned ldsw = (unsigned)wid * 1024u;
    const int aoff = lds_byte(wr * 64 + fr, fq * 8), boff = lds_byte(wc * 32 + fr, fq * 8);
#define PG8_SA(b, h) (((b) * 2 + (h)) * HTB)
#define PG8_SB(b, h) ((4 + (b) * 2 + (h)) * HTB)
#define PG8_STAGE(bufoff, gbase, voff) do { _Pragma("unroll") for (int _i = 0; _i < 2; ++_i) \
        __builtin_amdgcn_global_load_lds((const unsigned*)((const char*)(gbase) + (voff)[_i]), (PG8_LAS unsigned*)(lds + (bufoff) + ldsw + _i * 8192), 16, 0, 0); } while (0)
#define PG8_LDA(dst, b, h) do { _Pragma("unroll") for (int m = 0; m < 4; ++m) _Pragma("unroll") for (int k = 0; k < 2; ++k) dst[m][k] = *(const PG8_LAS bf16x8*)(lds + PG8_SA(b, h) + aoff + m * 2048 + k * 1024); } while (0)
#define PG8_LDB(dst, b, h) do { _Pragma("unroll") for (int n = 0; n < 2; ++n) _Pragma("unroll") for (int k = 0; k < 2; ++k) dst[n][k] = *(const PG8_LAS bf16x8*)(lds + PG8_SB(b, h) + boff + n * 2048 + k * 1024); } while (0)
#define PG8_MMA(ai, bj, At, Bt) do { __builtin_amdgcn_s_setprio(1); _Pragma("unroll") for (int m = 0; m < 4; ++m) _Pragma("unroll") for (int n = 0; n < 2; ++n) _Pragma("unroll") for (int k = 0; k < 2; ++k) \
        acc[ai][bj][m][n] = __builtin_amdgcn_mfma_f32_16x16x32_bf16(Bt[n][k], At[m][k], acc[ai][bj][m][n], 0, 0, 0); __builtin_amdgcn_s_setprio(0); } while (0)
#define PG8_WAIT_V(n) asm volatile("s_waitcnt vmcnt(" #n ")" ::: "memory")
#define PG8_WAIT_L(n) asm volatile("s_waitcnt lgkmcnt(" #n ")" ::: "memory")
#define PG8_BAR __builtin_amdgcn_s_barrier()
#define PG8_SCHED __builtin_amdgcn_sched_barrier(0)
    Unit cur, nxt; int ui = 0;
    if (!S.next(0, cur)) return;
    f32x4 acc[2][2][4][2];
#pragma unroll
    for (int a = 0; a < 2; ++a)
#pragma unroll
        for (int b = 0; b < 2; ++b)
#pragma unroll
            for (int m = 0; m < 4; ++m)
#pragma unroll
                for (int n = 0; n < 2; ++n) acc[a][b][m][n] = (f32x4){0.f, 0.f, 0.f, 0.f};
    bf16x8 At[4][2], B0[2][2], B1[2][2];
    const char* cA = (const char*)g.A + (size_t)cur.pm * tstep; const char* cB = (const char*)g.Bt + (size_t)cur.pn * tstep;
    S.a_ready(cur);
    if constexpr (SP2) {
        PG8_STAGE(PG8_SB(0, 0), cB, voffB); PG8_STAGE(PG8_SB(0, 1), cB + hstep, voffB); PG8_STAGE(PG8_SA(0, 0), cA, voffA); PG8_STAGE(PG8_SA(0, 1), cA + hstep, voffA);
        if (wr == 1) PG8_BAR;
        PG8_WAIT_V(2); PG8_BAR;
        PG8_STAGE(PG8_SB(1, 0), cB + kstep, voffB); PG8_STAGE(PG8_SA(1, 0), cA + kstep, voffA); PG8_STAGE(PG8_SB(1, 1), cB + hstep + kstep, voffB);
        PG8_WAIT_V(6); PG8_BAR;
    } else {
        PG8_STAGE(PG8_SB(0, 0), cB, voffB); PG8_STAGE(PG8_SA(0, 0), cA, voffA); PG8_STAGE(PG8_SB(0, 1), cB + hstep, voffB); PG8_STAGE(PG8_SA(0, 1), cA + hstep, voffA);
        if (wr == 1) PG8_BAR;
        PG8_WAIT_V(4); PG8_BAR;
        PG8_STAGE(PG8_SB(1, 0), cB + kstep, voffB); PG8_STAGE(PG8_SA(1, 0), cA + kstep, voffA); PG8_STAGE(PG8_SB(1, 1), cB + hstep + kstep, voffB);
        PG8_WAIT_V(6); PG8_BAR;
    }
    for (;;) {
        const bool has_next = S.next(ui + 1, nxt);
        const char* nA = has_next ? (const char*)g.A + (size_t)nxt.pm * tstep : cA; const char* nB = has_next ? (const char*)g.Bt + (size_t)nxt.pn * tstep : cB;
        for (int t = 0; t < nt; t += 2) {
            const bool last = (t == nt - 2);
            const char* a1 = cA + (size_t)(t + 1) * kstep;
            const char* a2 = last ? nA : cA + (size_t)(t + 2) * kstep; const char* b2 = last ? nB : cB + (size_t)(t + 2) * kstep;
            const char* a3 = a2 + kstep; const char* b3 = b2 + kstep;
            if (last && has_next) S.a_ready(nxt);
            if constexpr (SP2) {
            PG8_LDB(B0, 0, 0); PG8_LDB(B1, 0, 1); PG8_SCHED; PG8_LDA(At, 0, 0); PG8_STAGE(PG8_SA(1, 1), a1 + hstep, voffA);
            PG8_WAIT_V(8); PG8_WAIT_L(0); PG8_BAR; PG8_MMA(0, 0, At, B0); PG8_MMA(0, 1, At, B1); PG8_BAR; PG8_SCHED;
            PG8_LDA(At, 0, 1); PG8_STAGE(PG8_SB(0, 0), b2, voffB); PG8_STAGE(PG8_SB(0, 1), b2 + hstep, voffB); PG8_STAGE(PG8_SA(0, 0), a2, voffA);
            PG8_WAIT_V(8); PG8_WAIT_L(0); PG8_BAR; PG8_MMA(1, 0, At, B0); PG8_MMA(1, 1, At, B1); PG8_BAR; PG8_SCHED;
            PG8_LDB(B0, 1, 0); PG8_LDB(B1, 1, 1); PG8_SCHED; PG8_LDA(At, 1, 0); PG8_STAGE(PG8_SA(0, 1), a2 + hstep, voffA);
            PG8_WAIT_V(8); PG8_WAIT_L(0); PG8_BAR; PG8_MMA(0, 0, At, B0); PG8_MMA(0, 1, At, B1); PG8_BAR; PG8_SCHED;
            PG8_LDA(At, 1, 1); PG8_STAGE(PG8_SB(1, 0), b3, voffB); PG8_STAGE(PG8_SB(1, 1), b3 + hstep, voffB); PG8_STAGE(PG8_SA(1, 0), a3, voffA);
            PG8_WAIT_V(8); PG8_WAIT_L(0); PG8_BAR; PG8_MMA(1, 0, At, B0); PG8_MMA(1, 1, At, B1); PG8_BAR; PG8_SCHED;
            } else {
            PG8_LDB(B0, 0, 0); PG8_SCHED; PG8_LDA(At, 0, 0); PG8_STAGE(PG8_SA(1, 1), a1 + hstep, voffA);
            PG8_WAIT_L(8); PG8_BAR; PG8_WAIT_L(0); PG8_MMA(0, 0, At, B0); PG8_BAR; PG8_SCHED;
            PG8_LDB(B1, 0, 1); PG8_STAGE(PG8_SB(0, 0), b2, voffB);
            PG8_BAR; PG8_WAIT_L(0); PG8_MMA(0, 1, At, B1); PG8_BAR;
            PG8_LDA(At, 0, 1); PG8_STAGE(PG8_SA(0, 0), a2, voffA);
            PG8_BAR; PG8_WAIT_L(0); PG8_MMA(1, 0, At, B0); PG8_BAR; PG8_SCHED;
            PG8_STAGE(PG8_SB(0, 1), b2 + hstep, voffB);
            PG8_WAIT_V(6); PG8_BAR; PG8_MMA(1, 1, At, B1); PG8_BAR;
            PG8_LDB(B0, 1, 0); PG8_SCHED; PG8_LDA(At, 1, 0); PG8_STAGE(PG8_SA(0, 1), a2 + hstep, voffA);
            PG8_WAIT_L(8); PG8_BAR; PG8_WAIT_L(0); PG8_MMA(0, 0, At, B0); PG8_BAR; PG8_SCHED;
            PG8_LDB(B1, 1, 1); PG8_STAGE(PG8_SB(1, 0), b3, voffB);
            PG8_BAR; PG8_WAIT_L(0); PG8_MMA(0, 1, At, B1); PG8_BAR;
            PG8_LDA(At, 1, 1); PG8_STAGE(PG8_SA(1, 0), a3, voffA);
            PG8_BAR; PG8_WAIT_L(0); PG8_MMA(1, 0, At, B0); PG8_BAR; PG8_SCHED;
            PG8_STAGE(PG8_SB(1, 1), b3 + hstep, voffB);
            PG8_WAIT_V(6); PG8_BAR; PG8_MMA(1, 1, At, B1); PG8_BAR;
            }
        }
        if constexpr (ALIGN_EPI) { if (wr == 0) PG8_BAR; }
        if constexpr (!Epi::AFTER_DRAIN) { E(acc, cur, wr, wc, fr, fq); S.done(cur); }
        if (!has_next) break;
#pragma unroll
        for (int a = 0; a < 2; ++a)
#pragma unroll
            for (int b = 0; b < 2; ++b)
#pragma unroll
                for (int m = 0; m < 4; ++m)
#pragma unroll
                    for (int n = 0; n < 2; ++n) acc[a][b][m][n] = (f32x4){0.f, 0.f, 0.f, 0.f};
        cur = nxt; cA = nA; cB = nB; ++ui;
        if constexpr (ALIGN_EPI) { if (wr == 1) PG8_BAR; }
    }
    PG8_WAIT_V(0);
    if constexpr (!ALIGN_EPI) { if (wr == 0) PG8_BAR; }
    PG8_BAR;
#undef PG8_SA
#undef PG8_SB
#undef PG8_STAGE
#undef PG8_LDA
#undef PG8_LDB
#undef PG8_MMA
#undef PG8_WAIT_V
#undef PG8_WAIT_L
#undef PG8_BAR
#undef PG8_SCHED
}
}

#define XB_TMO      128
#define XB_XCNT(j)  (256  + 64 * (j))
#define XB_XSUB(j)  (1280 + 64 * (j))
#define XB_XGEN(j)  (2304 + 64 * (j))
#define XB_TOP      3328
#define XB_TOPGEN   3392
#define XCD_BAR_WORDS 3456
#define XB_SPIN_CAP (1u << 22)
__device__ __forceinline__ unsigned xb_ld(unsigned* p)              { return __hip_atomic_load(p, __ATOMIC_RELAXED, __HIP_MEMORY_SCOPE_AGENT); }
__device__ __forceinline__ unsigned xb_add(unsigned* p, unsigned v) { return __hip_atomic_fetch_add(p, v, __ATOMIC_RELAXED, __HIP_MEMORY_SCOPE_AGENT); }
__device__ __forceinline__ unsigned xb_xcc_id() { return (unsigned)__builtin_amdgcn_s_getreg((3 << 11) | 20) & 0xFu; }
#define XB_SPIN(cond, bar) do { unsigned _sp = 0; while (cond) { __builtin_amdgcn_s_sleep(1); \
    if ((++_sp & 255u) == 0u) { if (xb_ld(&(bar)[XB_TMO])) break; if (_sp > XB_SPIN_CAP) { atomicAdd(&(bar)[XB_TMO], 1u); break; } } } } while (0)
struct XcdBarrier { unsigned* bar; unsigned x; volatile LAS unsigned* st; };
__device__ __forceinline__ XcdBarrier xcd_barrier_post(unsigned* bar, volatile LAS unsigned* st) {
    XcdBarrier b; b.bar = bar; b.x = xb_xcc_id(); b.st = st;
    if (threadIdx.x == 0) (void)xb_add(&bar[XB_XCNT(b.x)], 1u);
    return b;
}
__device__ __forceinline__ void xcd_barrier_complete(unsigned* bar, unsigned x, unsigned& nloc, unsigned& nx) {
    const unsigned G = gridDim.x * gridDim.y * gridDim.z;
    unsigned sum, cnt, mine, sp = 0u;
    for (;;) {
        sum = 0u; cnt = 0u; mine = 0u;
#pragma unroll
        for (unsigned j = 0; j < 16; ++j) { const unsigned c = xb_ld(&bar[XB_XCNT(j)]); sum += c; cnt += (c > 0u) ? 1u : 0u; mine = (j == x) ? c : mine; }
        if (sum == G) break;
        __builtin_amdgcn_s_sleep(1);
        if ((++sp & 255u) == 0u) { if (xb_ld(&bar[XB_TMO])) break; if (sp > XB_SPIN_CAP) { atomicAdd(&bar[XB_TMO], 1u); break; } }
    }
    nloc = mine > 0u ? mine : 1u; nx = cnt > 0u ? cnt : 1u;
}
__device__ __forceinline__ void xcd_barrier(const XcdBarrier& b) {
    asm volatile("s_waitcnt vmcnt(0)" ::: "memory");
    __syncthreads();
    if (threadIdx.x == 0) {
        unsigned* bar = b.bar;
        __builtin_amdgcn_s_waitcnt(0);
        unsigned nloc = b.st[0], nx = b.st[1];
        if (nloc == 0u) { xcd_barrier_complete(bar, b.x, nloc, nx); b.st[0] = nloc; b.st[1] = nx; }
        const unsigned old = xb_add(&bar[XB_XSUB(b.x)], 1u);
        const unsigned gen = old / nloc;
        if (old + 1u == (gen + 1u) * nloc) {
            __builtin_amdgcn_fence(__ATOMIC_RELEASE, "agent");
            asm volatile("s_waitcnt vmcnt(0)" ::: "memory");
            const unsigned og = xb_add(&bar[XB_TOP], 1u);
            const unsigned tg = og / nx;
            if (og + 1u == (tg + 1u) * nx) xb_add(&bar[XB_TOPGEN], 1u);
            else XB_SPIN(xb_ld(&bar[XB_TOPGEN]) == tg, bar);
            __builtin_amdgcn_fence(__ATOMIC_ACQUIRE, "agent");
            xb_add(&bar[XB_XGEN(b.x)], 1u);
            asm volatile("s_waitcnt vmcnt(0)" ::: "memory");
        } else {
            XB_SPIN(xb_ld(&bar[XB_XGEN(b.x)]) == gen, bar);
            __builtin_amdgcn_fence(__ATOMIC_ACQUIRE, "agent");
            asm volatile("s_waitcnt vmcnt(0)" ::: "memory");
        }
    }
    __syncthreads();
}

constexpr int RING_OFF = 0, RING_BYTES = 131072;
constexpr int LDSCTL_OFF = 162816, MISC_OFF = LDSCTL_OFF + 320;
constexpr int LDS_BYTES = 163840;

struct Frame {
    LAS unsigned char* lds;
    volatile LAS unsigned* MISC;
    gu32* ctl;
    int tid, lane, wave, G, wg;
    const float* in[21];
    float* out;
    unsigned char* ws;
};

__device__ __forceinline__ void p0_transpose_item(const float* W, int K, int N, bf16* WT, LAS float* scr, int item, int lane) {
    const int nblk = N / 32, kb = item / nblk, nb = item % nblk, k0 = 64 * kb, n0 = 32 * nb;
#pragma unroll 8
    for (int i = 0; i < 32; ++i) { const int kk = 2 * i + (lane >> 5); scr[kk * 33 + (lane & 31)] = W[(size_t)(k0 + kk) * N + n0 + (lane & 31)]; }
    LDS_WAIT(); asm volatile("" ::: "memory");
    const int c = lane & 7;
#pragma unroll
    for (int j = 0; j < 4; ++j) { const int n = (lane >> 3) + 8 * j; const LAS float* s = scr + (8 * c) * 33 + n;
        v4u o; o.x = pk2(s[0 * 33], s[1 * 33]); o.y = pk2(s[2 * 33], s[3 * 33]); o.z = pk2(s[4 * 33], s[5 * 33]); o.w = pk2(s[6 * 33], s[7 * 33]);
        *(GAS v4u*)(WT + (size_t)(n0 + n) * K + k0 + 8 * c) = o; }
    LDS_WAIT(); asm volatile("" ::: "memory");
}
__device__ __forceinline__ void rms_row_to_bf16(int lane, const float* xrow, const float* gain, bf16* orow) {
    const GAS f32x4* xr = (const GAS f32x4*)xrow + lane;
    const GAS f32x4* gr = (const GAS f32x4*)gain + lane;
    f32x4 v[4]; float s = 0.f;
#pragma unroll
    for (int j = 0; j < 4; ++j) { v[j] = xr[64 * j]; s += (v[j].x * v[j].x + v[j].y * v[j].y) + (v[j].z * v[j].z + v[j].w * v[j].w); }
    const float rstd = frsq(wave_sum(s) * (1.f / DM) + RMS_EPS);
    GAS unsigned long long* o8 = (GAS unsigned long long*)orow + lane;
#pragma unroll
    for (int j = 0; j < 4; ++j) { const f32x4 gg = gr[64 * j];
        o8[64 * j] = (unsigned long long)pk2(v[j].x * rstd * gg.x, v[j].y * rstd * gg.y) | ((unsigned long long)pk2(v[j].z * rstd * gg.z, v[j].w * rstd * gg.w) << 32); }
}
__device__ __forceinline__ void cvt_row_to_bf16(int lane, const float* xrow, bf16* orow) {
    const GAS f32x4* xr = (const GAS f32x4*)xrow + lane;
    GAS unsigned long long* o8 = (GAS unsigned long long*)orow + lane;
#pragma unroll
    for (int j = 0; j < 4; ++j) { const f32x4 v = xr[64 * j]; o8[64 * j] = (unsigned long long)pk2(v.x, v.y) | ((unsigned long long)pk2(v.z, v.w) << 32); }
}
__device__ __forceinline__ void quantize_tables(Frame& F, int gw, int ngw);
__device__ __forceinline__ void p0_prologue(Frame& F) {
    LAS float* scr = (LAS float*)(F.lds + RING_OFF + F.wave * 16384);
    const int gw = F.wg * NWAVES + F.wave, NGW = F.G * NWAVES;
    constexpr int I_IN = (DM / 64) * (IN_COLS / 32), I_OUT = (DM / 64) * (DM / 32), I_Q = (DM / 64) * (PQ / 32);
    constexpr int NITEMS = I_IN + I_OUT + I_Q;
    bf16* win_t = (bf16*)(F.ws + WS_WIN); bf16* wout_t = (bf16*)(F.ws + WS_WOUT); bf16* wq_t = (bf16*)(F.ws + WS_WQ);
    for (int it = gw; it < NITEMS; it += NGW) {
        int r = it;
        if (r < I_IN) { p0_transpose_item(F.in[2], DM, IN_COLS, win_t, scr, r, F.lane); continue; } r -= I_IN;
        if (r < I_OUT) { p0_transpose_item(F.in[14], DM, DM, wout_t, scr, r, F.lane); continue; } r -= I_OUT;
        p0_transpose_item(F.in[16], DM, PQ, wq_t, scr, r, F.lane);
    }
    {
        constexpr int I_W = (64 / 64) * (RWW / 32), I_G = (128 / 64) * (RWW / 32);
        for (int it = gw; it < 2 * I_W + I_G; it += NGW) {
            int r = it;
            if (r < I_W) { p0_transpose_item(F.in[5], 64, RWW, (bf16*)(F.ws + WS_WUPT), scr, r, F.lane); continue; } r -= I_W;
            if (r < I_W) { p0_transpose_item(F.in[7], 64, RWW, (bf16*)(F.ws + WS_AUPT), scr, r, F.lane); continue; } r -= I_W;
            p0_transpose_item(F.in[8], 128, RWW, (bf16*)(F.ws + WS_GUPT), scr, r, F.lane);
        }
    }
    bf16* XN = (bf16*)(F.ws + WS_XN);
    for (int m = gw; m < T; m += NGW) rms_row_to_bf16(F.lane, F.in[0] + (size_t)m * DM, F.in[1], XN + (size_t)m * DM);
}

constexpr size_t WS_ROPE = WS_G;
__device__ __forceinline__ void p0_rope_table(Frame& F) {
    f32x2* tab = (f32x2*)(F.ws + WS_ROPE);
    for (int e = F.wg * NTHREADS + F.tid; e < SEQ * 32; e += F.G * NTHREADS) {
        const int sp = e >> 5, i = e & 31;
        const float inv_freq = powf(10000.0f, -(float)(2 * i) / 64.0f);
        const float ang = (float)sp * inv_freq;
        const double r = (double)ang - rint((double)ang * 0.15915494309189535) * 6.283185307179586;
        const float rf = (float)r;
        tab[e] = (f32x2){cosf(rf), sinf(rf)};
    }
}
__device__ __forceinline__ void p2_rope(Frame& F) {
    bf16* Z = (bf16*)(F.ws + WS_Z);
    const f32x2* tab = (const f32x2*)(F.ws + WS_ROPE);
    const int tid = F.tid, tk = tid >> 6, grp = (tid >> 2) & 15, i0 = (tid & 3) * 8;
    for (int blk = F.wg; blk < T / 8; blk += F.G) {
        const int g = blk * 8 + tk, sp = g & (SEQ - 1);
        bf16* p = Z + (size_t)g * IN_COLS + C_AQ + grp * 64 + i0;
        const v4u a = *(const GAS v4u*)p, b = *(const GAS v4u*)(p + 32);
        const GAS f32x4* tp = (const GAS f32x4*)(tab + sp * 32 + i0);
        float x1[8], x2[8];
        x1[0] = bflo(a.x); x1[1] = bfhi(a.x); x1[2] = bflo(a.y); x1[3] = bfhi(a.y); x1[4] = bflo(a.z); x1[5] = bfhi(a.z); x1[6] = bflo(a.w); x1[7] = bfhi(a.w);
        x2[0] = bflo(b.x); x2[1] = bfhi(b.x); x2[2] = bflo(b.y); x2[3] = bfhi(b.y); x2[4] = bflo(b.z); x2[5] = bfhi(b.z); x2[6] = bflo(b.w); x2[7] = bfhi(b.w);
        float o1[8], o2[8];
#pragma unroll
        for (int q = 0; q < 4; ++q) { const f32x4 cs = tp[q];
            o1[2 * q] = x1[2 * q] * cs[0] - x2[2 * q] * cs[1]; o2[2 * q] = x1[2 * q] * cs[1] + x2[2 * q] * cs[0];
            o1[2 * q + 1] = x1[2 * q + 1] * cs[2] - x2[2 * q + 1] * cs[3]; o2[2 * q + 1] = x1[2 * q + 1] * cs[3] + x2[2 * q + 1] * cs[2]; }
        v4u oa, ob; oa.x = pk2(o1[0], o1[1]); oa.y = pk2(o1[2], o1[3]); oa.z = pk2(o1[4], o1[5]); oa.w = pk2(o1[6], o1[7]);
        ob.x = pk2(o2[0], o2[1]); ob.y = pk2(o2[2], o2[3]); ob.z = pk2(o2[4], o2[5]); ob.w = pk2(o2[6], o2[7]);
        *(GAS v4u*)p = oa; *(GAS v4u*)(p + 32) = ob;
    }
}

typedef float f32x16 __attribute__((ext_vector_type(16)));
constexpr int SBS = 144;
constexpr int R1_EPRE = 0, R1_APRE = 16384, R1_AAB = 0, R1_X = 16384;
constexpr int R1_AT = 32768, R1_BT = 41984, R1_KT = 51200, R1_RT = 60416, R1_AHT = R1_BT, R1_U0T = R1_KT;
constexpr int R1_BBT = 69632, R1_KBT = 78848, R1_VT = 88064;
constexpr int R1_ACTW = 97280, R1_ACTA = 106496, R1_AAK = 97280, R1_ARB = 106496, R1_ARK = 115712;
constexpr int R1_BONUS = 124928, R1_WEND = 125184, R1_SEGS = 125440, R1_TII = 125440, R1_END = 129536;
static_assert(R1_END <= LDSCTL_OFF, "R1 LDS");
__device__ __forceinline__ int crow(int r, int hh) { return (r & 3) + 8 * (r >> 2) + 4 * hh; }
template <int KS> __device__ __forceinline__ f32x16 wtile(const LAS unsigned char* A, int sa, const LAS unsigned char* B, int sb, f32x16 acc, int lane) {
    const int row = lane & 31, hh = lane >> 5;
#pragma unroll
    for (int s = 0; s < KS; ++s) { const bf16x8 a = *(const LAS bf16x8*)(A + row * sa + 32 * s + 16 * hh); const bf16x8 b = *(const LAS bf16x8*)(B + row * sb + 32 * s + 16 * hh);
        acc = __builtin_amdgcn_mfma_f32_32x32x16_bf16(a, b, acc, 0, 0, 0); }
    return acc;
}
template <int KS> __device__ __forceinline__ f32x16 wtile_gb(const LAS unsigned char* A, int sa, const bf16* Bg, int ldb, f32x16 acc, int lane) {
    const int row = lane & 31, hh = lane >> 5;
#pragma unroll
    for (int s = 0; s < KS; ++s) { const bf16x8 a = *(const LAS bf16x8*)(A + row * sa + 32 * s + 16 * hh); const bf16x8 b = *(const GAS bf16x8*)(Bg + (size_t)row * ldb + 16 * s + 8 * hh);
        acc = __builtin_amdgcn_mfma_f32_32x32x16_bf16(a, b, acc, 0, 0, 0); }
    return acc;
}
__device__ __forceinline__ f32x16 zero16() { f32x16 z;
#pragma unroll
    for (int r = 0; r < 16; ++r) z[r] = 0.f;
    return z; }

struct R1Pre { v4u wd[2], ad[2], z[4]; };
__device__ __forceinline__ int r13_item(int wg, int G, int idx) { return (wg >> 3) * 128 + (wg & 7) * 16 + idx; }
__device__ __forceinline__ int r13_count(int wg, int G) { return 16; }
__device__ __forceinline__ void rwkv_r1_prefetch(Frame& F, int item, int tid, R1Pre& P) {
    const int chain = item >> 7, chunk = item & 127, b = chain >> 3, h = chain & 7, g0 = b * SEQ + chunk * 64;
    const bf16* Z = (const bf16*)(F.ws + WS_Z);
    const v4u z0 = (v4u){0u, 0u, 0u, 0u};
    { const int t = tid >> 3, cg = tid & 7; const bool first = (chunk == 0 && t == 0);
      const bf16* zr = Z + (size_t)(g0 + t) * IN_COLS;
      P.wd[0] = *(const GAS v4u*)(zr + C_WD + cg * 8); P.ad[0] = *(const GAS v4u*)(zr + C_AD + cg * 8);
      P.wd[1] = z0; P.ad[1] = z0;
      if (!first) { P.wd[1] = *(const GAS v4u*)(zr - IN_COLS + C_WD + cg * 8); P.ad[1] = *(const GAS v4u*)(zr - IN_COLS + C_AD + cg * 8); } }
#pragma unroll
    for (int q = 0; q < 4; ++q) { const int p = tid + 512 * q; P.z[q] = z0;
        if (p < 65 * 24) { const int row = p / 24, rem = p - row * 24, seg = rem >> 3, ch = rem & 7;
            if (!(chunk == 0 && row == 0)) P.z[q] = *(const GAS v4u*)(Z + (size_t)(g0 - 1 + row) * IN_COLS + seg * 512 + h * 64 + ch * 8); } }
}
constexpr int R1_ZS = R1_AT, R1_ZSS = 384;
static_assert(65 * R1_ZSS <= 4 * 9216, "ZS fits in the At..Rt region");
__device__ __forceinline__ void r1_load_bfrag(Frame& F, int h, int w, int lane, bf16x8 (&bf)[4]) {
    const int p = w >> 2, nt = w & 1; const bf16* upt = (const bf16*)(F.ws + (p == 0 ? WS_WUPT : WS_AUPT)) + (size_t)(h * 64 + nt * 32 + (lane & 31)) * 64 + 8 * (lane >> 5);
#pragma unroll
    for (int s2 = 0; s2 < 4; ++s2) bf[s2] = *(const GAS bf16x8*)(upt + 16 * s2);
}
constexpr int R1_CF = R1_AAB, R1_CN = R1_X;
__device__ __forceinline__ void rwkv_r1_item(Frame& F, int item, int next_item, R1Pre& P, const bf16x8 (&bfr)[4], f32x4 (&cst)[4]) {
    const int chain = item >> 7, chunk = item & 127, b = chain >> 3, h = chain & 7;
    const int g0 = b * SEQ + chunk * 64;
    int tid_ = F.tid; asm volatile("" : "+v"(tid_));
    const int tid = tid_, lane = tid & 63, w = __builtin_amdgcn_readfirstlane(tid >> 6), hh = lane >> 5, cl = lane & 31;
    const bf16* Z = (const bf16*)(F.ws + WS_Z);
    LAS unsigned char* lds = F.lds + RING_OFF;
    const float* mu = F.in[3];
    {
        const int t = tid >> 3, cg = tid & 7;
        const v4u cw = P.wd[0], ca = P.ad[0], pw = P.wd[1], pa = P.ad[1];
        float fw[8], fa[8], qw[8], qa[8];
        fw[0] = bflo(cw.x); fw[1] = bfhi(cw.x); fw[2] = bflo(cw.y); fw[3] = bfhi(cw.y); fw[4] = bflo(cw.z); fw[5] = bfhi(cw.z); fw[6] = bflo(cw.w); fw[7] = bfhi(cw.w);
        fa[0] = bflo(ca.x); fa[1] = bfhi(ca.x); fa[2] = bflo(ca.y); fa[3] = bfhi(ca.y); fa[4] = bflo(ca.z); fa[5] = bfhi(ca.z); fa[6] = bflo(ca.w); fa[7] = bfhi(ca.w);
        qw[0] = bflo(pw.x); qw[1] = bfhi(pw.x); qw[2] = bflo(pw.y); qw[3] = bfhi(pw.y); qw[4] = bflo(pw.z); qw[5] = bfhi(pw.z); qw[6] = bflo(pw.w); qw[7] = bfhi(pw.w);
        qa[0] = bflo(pa.x); qa[1] = bfhi(pa.x); qa[2] = bflo(pa.y); qa[3] = bfhi(pa.y); qa[4] = bflo(pa.z); qa[5] = bfhi(pa.z); qa[6] = bflo(pa.w); qa[7] = bfhi(pa.w);
#pragma unroll
        for (int j = 0; j < 8; ++j) { const int c = cg * 8 + j; const float xw = fw[j] + (qw[j] - fw[j]) * mu[C_WD + c];
            const float ex = __expf(2.f * xw); fw[j] = 1.f - 2.f * frcp(ex + 1.f);
            fa[j] = fa[j] + (qa[j] - fa[j]) * mu[C_AD + c]; }
        v4u ow, oa; ow.x = pk2(fw[0], fw[1]); ow.y = pk2(fw[2], fw[3]); ow.z = pk2(fw[4], fw[5]); ow.w = pk2(fw[6], fw[7]);
        oa.x = pk2(fa[0], fa[1]); oa.y = pk2(fa[2], fa[3]); oa.z = pk2(fa[4], fa[5]); oa.w = pk2(fa[6], fa[7]);
        *(LAS v4u*)(lds + R1_ACTW + t * SBS + cg * 16) = ow; *(LAS v4u*)(lds + R1_ACTA + t * SBS + cg * 16) = oa;
#pragma unroll
        for (int q = 0; q < 4; ++q) { const int p = tid + 512 * q;
            if (p < 65 * 24) { const int row = p / 24, rem = p - row * 24; *(LAS v4u*)(lds + R1_ZS + row * R1_ZSS + rem * 16) = P.z[q]; } }
        if (next_item >= 0) rwkv_r1_prefetch(F, next_item, tid, P);
    }
    LDS_BARRIER();
    {
        const int p = w >> 2, mt = (w >> 1) & 1, nt = w & 1;
        f32x16 acc = zero16();
        { const LAS unsigned char* A_ = lds + (p == 0 ? R1_ACTW : R1_ACTA) + mt * 32 * SBS + (lane & 31) * SBS + 16 * hh;
#pragma unroll
          for (int s2 = 0; s2 < 4; ++s2) acc = __builtin_amdgcn_mfma_f32_32x32x16_bf16(*(const LAS bf16x8*)(A_ + 32 * s2), bfr[s2], acc, 0, 0, 0); }
        LAS float* O = (LAS float*)(lds + (p == 0 ? R1_EPRE : R1_APRE));
#pragma unroll
        for (int r = 0; r < 16; ++r) O[(mt * 32 + crow(r, hh)) * 64 + nt * 32 + cl] = acc[r];
    }
    LDS_BARRIER();
    {
        const int c = tid & 63, ts = tid >> 6, col = h * 64 + c;
        const float mu_r = mu[C_R + col], mu_k = mu[C_K + col], mu_v = mu[C_V + col], kkc = F.in[9][col], kac = F.in[10][col], rkc = F.in[11][col], w0c = F.in[4][col], a0c = F.in[6][col];
        const LAS float* EP = (const LAS float*)(lds + R1_EPRE); const LAS float* AP = (const LAS float*)(lds + R1_APRE);
        LAS float* SEGS = (LAS float*)(lds + R1_SEGS); LAS float* BON = (LAS float*)(lds + R1_BONUS);
        const LAS bf16* zb = (const LAS bf16*)(lds + R1_ZS + (8 * ts) * R1_ZSS) + c;
        float pr = bf2f(zb[0]), pk = bf2f(zb[64]), pv = bf2f(zb[128]);
        float rr[8], k2[8], ai[8], bi[8], vv[8], ee[8], cs[8]; float run = 0.f;
#pragma unroll
        for (int i = 0; i < 8; ++i) {
            const float zr = bf2f(zb[(i + 1) * (R1_ZSS / 2)]), zk = bf2f(zb[(i + 1) * (R1_ZSS / 2) + 64]), zv = bf2f(zb[(i + 1) * (R1_ZSS / 2) + 128]);
            const float r = zr + (pr - zr) * mu_r, k = zk + (pk - zk) * mu_k, v = zv + (pv - zv) * mu_v; pr = zr; pk = zk; pv = zv;
            const float e = 0.60653066f * frcp(1.f + __expf(-(w0c + EP[(8 * ts + i) * 64 + c])));
            const float a = frcp(1.f + __expf(-(a0c + AP[(8 * ts + i) * 64 + c])));
            float kk = k * kkc; const float n2 = wave_sum(kk * kk); kk = kk * frsq(fmaxf(n2, 1e-24f));
            const float kq = k * (1.f + (a - 1.f) * kac);
            const float bon = wave_sum(r * kq * rkc); if (c == 0) BON[8 * ts + i] = bon;
            rr[i] = r; k2[i] = kq; ai[i] = -kk; bi[i] = kk * a; vv[i] = v; ee[i] = e; run += e; cs[i] = run;
        }
        SEGS[ts * 64 + c] = run;
        LDS_BARRIER();
        float off = 0.f, tot = 0.f;
#pragma unroll
        for (int q = 0; q < 8; ++q) { const float sv = SEGS[q * 64 + c]; tot += sv; off += (q < ts) ? sv : 0.f; }
        float bb[8], kb[8];
#pragma unroll
        for (int i = 0; i < 8; ++i) { const float L = off + cs[i];
            const float Wm = __expf(-(L - ee[i])), Wi = __expf(-L), iW = __expf(L), We = __expf(-(tot - L));
            const int t = 8 * ts + i;
            *(LAS bf16*)(lds + R1_AT + t * SBS + c * 2) = (bf16)f2bf(ai[i] * Wm);
            *(LAS bf16*)(lds + R1_BT + t * SBS + c * 2) = (bf16)f2bf(bi[i] * iW);
            *(LAS bf16*)(lds + R1_KT + t * SBS + c * 2) = (bf16)f2bf(k2[i] * iW);
            *(LAS bf16*)(lds + R1_RT + t * SBS + c * 2) = (bf16)f2bf(rr[i] * Wi);
            bb[i] = bi[i] * We; kb[i] = k2[i] * We; }
        v4u o; o.x = pk2(bb[0], bb[1]); o.y = pk2(bb[2], bb[3]); o.z = pk2(bb[4], bb[5]); o.w = pk2(bb[6], bb[7]);
        *(LAS v4u*)(lds + R1_BBT + c * SBS + ts * 16) = o;
        o.x = pk2(kb[0], kb[1]); o.y = pk2(kb[2], kb[3]); o.z = pk2(kb[4], kb[5]); o.w = pk2(kb[6], kb[7]);
        *(LAS v4u*)(lds + R1_KBT + c * SBS + ts * 16) = o;
        o.x = pk2(vv[0], vv[1]); o.y = pk2(vv[2], vv[3]); o.z = pk2(vv[4], vv[5]); o.w = pk2(vv[6], vv[7]);
        *(LAS v4u*)(lds + R1_VT + c * SBS + ts * 16) = o;
        if (ts == 0) ((LAS float*)(lds + R1_WEND))[c] = __expf(-tot);
    }
    LDS_BARRIER();
#pragma unroll
    for (int u = 0; u < 2; ++u) {
        const int idx = w * 2 + u, p = idx >> 2, mt = (idx >> 1) & 1, nt = idx & 1;
        const LAS unsigned char* Aop = lds + ((p == 0 || p == 2) ? R1_BT : R1_KT) + mt * 32 * SBS;
        const LAS unsigned char* Bop = lds + (p < 2 ? R1_AT : R1_RT) + nt * 32 * SBS;
        f32x16 acc = wtile<4>(Aop, SBS, Bop, SBS, zero16(), lane);
        const int n = nt * 32 + cl;
#pragma unroll
        for (int r = 0; r < 16; ++r) { const int m = mt * 32 + crow(r, hh); const bool keep = (p < 2) ? (m < n) : (m <= n); acc[r] = keep ? acc[r] : 0.f; }
#pragma unroll
        for (int g4 = 0; g4 < 4; ++g4) { const int m0 = mt * 32 + 8 * g4 + 4 * hh;
            if (p == 0) *(LAS f32x4*)(lds + R1_AAB + (n * 64 + m0) * 4) = (f32x4){acc[4 * g4], acc[4 * g4 + 1], acc[4 * g4 + 2], acc[4 * g4 + 3]};
            else { v2u o; o.x = pk2(acc[4 * g4], acc[4 * g4 + 1]); o.y = pk2(acc[4 * g4 + 2], acc[4 * g4 + 3]);
                   *(LAS v2u*)(lds + (p == 1 ? R1_AAK : (p == 2 ? R1_ARB : R1_ARK)) + n * SBS + m0 * 2) = o; } }
    }
    LDS_BARRIER();
    if (w < 4) {
        const int mt = w >> 1, nt = w & 1;
        const f32x16 acc = wtile<4>(lds + R1_AAK + mt * 32 * SBS, SBS, lds + R1_VT + nt * 32 * SBS, SBS, zero16(), lane);
        LAS float* X = (LAS float*)(lds + R1_X);
#pragma unroll
        for (int r = 0; r < 16; ++r) X[(mt * 32 + crow(r, hh)) * 64 + nt * 32 + cl] = acc[r];
    } else if (w == 4) {
        const int bk = lane >> 4, c = lane & 15;
        const LAS float* AAB = (const LAS float*)(lds + R1_AAB);
        float Tc[16]; const float fc = (float)c;
#pragma unroll
        for (int s2 = 0; s2 < 16; ++s2) Tc[s2] = fmaxf(0.f, 1.f - fabsf((float)s2 - fc));
#pragma unroll
        for (int r = 0; r < 15; ++r)
#pragma unroll
            for (int s2 = r + 1; s2 < 16; ++s2) Tc[s2] += AAB[(16 * bk + s2) * 64 + 16 * bk + r] * Tc[r];
        LAS float* TII = (LAS float*)(lds + R1_TII);
#pragma unroll
        for (int s2 = 0; s2 < 16; ++s2) TII[(bk * 16 + s2) * 16 + c] = Tc[s2];
    }
    LDS_BARRIER();
    {
        const int c16 = lane & 15, g = lane >> 4;
        const LAS float* AAB = (const LAS float*)(lds + R1_AAB); const LAS float* TII = (const LAS float*)(lds + R1_TII); const LAS float* X = (const LAS float*)(lds + R1_X);
        f32x4 o[4];
#pragma unroll
        for (int i = 0; i < 4; ++i) {
            f32x4 acc;
            if (w < 4) {
#pragma unroll
                for (int q = 0; q < 4; ++q) acc[q] = bf2f(*(const LAS bf16*)(lds + R1_AT + (16 * i + 4 * g + q) * SBS + (16 * w + c16) * 2));
            } else {
#pragma unroll
                for (int q = 0; q < 4; ++q) acc[q] = X[(16 * i + 4 * g + q) * 64 + 16 * (w - 4) + c16];
            }
#pragma unroll
            for (int j = 0; j < i; ++j) { const f32x4 a4 = *(const LAS f32x4*)(AAB + (16 * i + c16) * 64 + 16 * j + 4 * g);
#pragma unroll
                for (int q = 0; q < 4; ++q) acc = __builtin_amdgcn_mfma_f32_16x16x4f32(a4[q], o[j][q], acc, 0, 0, 0); }
            const f32x4 t4 = *(const LAS f32x4*)(TII + (i * 16 + c16) * 16 + 4 * g);
            f32x4 res = (f32x4){0.f, 0.f, 0.f, 0.f};
#pragma unroll
            for (int q = 0; q < 4; ++q) res = __builtin_amdgcn_mfma_f32_16x16x4f32(t4[q], acc[q], res, 0, 0, 0);
            o[i] = res;
            v2u ov; ov.x = pk2(res[0], res[1]); ov.y = pk2(res[2], res[3]);
            *(LAS v2u*)(lds + (w < 4 ? R1_AHT : R1_U0T) + (16 * (w & 3) + c16) * SBS + (16 * i + 4 * g) * 2) = ov;
        }
    }
    LDS_BARRIER();
    {
        float* Mg = F.out + (size_t)item * 4096; float* NTg = F.out + (size_t)T * RWW + (size_t)item * 4096;
        float* Y0g = (float*)(F.ws + WS_RWY0) + (size_t)item * 4096; bf16* RHg = (bf16*)(F.ws + WS_RWRH) + (size_t)item * 4096;
#pragma unroll
        for (int u = 0; u < 2; ++u) {
            const int idx = w * 2 + u, p = idx >> 2, mt = (idx >> 1) & 1, nt = idx & 1; const int n = nt * 32 + cl;
            if (p == 0) {
                f32x16 acc = wtile<4>(lds + R1_AHT + mt * 32 * SBS, SBS, lds + R1_BBT + nt * 32 * SBS, SBS, zero16(), lane);
                const float we = ((const LAS float*)(lds + R1_WEND))[n];
#pragma unroll
                for (int g4 = 0; g4 < 4; ++g4) { const int m0 = mt * 32 + 8 * g4 + 4 * hh;
                    const f32x4 mv = (f32x4){acc[4 * g4] + (m0 == n ? we : 0.f), acc[4 * g4 + 1] + (m0 + 1 == n ? we : 0.f), acc[4 * g4 + 2] + (m0 + 2 == n ? we : 0.f), acc[4 * g4 + 3] + (m0 + 3 == n ? we : 0.f)};
                    *(GAS f32x4*)(Mg + n * 64 + m0) = mv;
                    v2u h_; h_.x = pk2(mv[0], mv[1]); h_.y = pk2(mv[2], mv[3]);
                    v2u l_; l_.x = pk2(mv[0] - bflo(h_.x), mv[1] - bfhi(h_.x)); l_.y = pk2(mv[2] - bflo(h_.y), mv[3] - bfhi(h_.y));
                    LAS unsigned char* fp_ = lds + R1_CF + (((n >> 4) * 2 + (m0 >> 5)) * 2) * 1024 + ((((m0 >> 2) & 3) * 16) + (n & 15)) * 16 + ((m0 >> 4) & 1) * 8;
                    *(LAS v2u*)fp_ = h_; *(LAS v2u*)(fp_ + 1024) = l_; }
            } else if (p == 1) {
                f32x16 acc = wtile<4>(lds + R1_BBT + mt * 32 * SBS, SBS, lds + R1_U0T + nt * 32 * SBS, SBS, zero16(), lane);
                acc = wtile<4>(lds + R1_KBT + mt * 32 * SBS, SBS, lds + R1_VT + nt * 32 * SBS, SBS, acc, lane);
#pragma unroll
                for (int g4 = 0; g4 < 4; ++g4) { const f32x4 nv_ = (f32x4){acc[4 * g4], acc[4 * g4 + 1], acc[4 * g4 + 2], acc[4 * g4 + 3]};
                    *(GAS f32x4*)(NTg + n * 64 + mt * 32 + 8 * g4 + 4 * hh) = nv_; *(LAS f32x4*)(lds + R1_CN + (n * 64 + mt * 32 + 8 * g4 + 4 * hh) * 4) = nv_; }
            } else if (p == 2) {
                f32x16 acc = wtile<4>(lds + R1_AHT + mt * 32 * SBS, SBS, lds + R1_ARB + nt * 32 * SBS, SBS, zero16(), lane);
#pragma unroll
                for (int g4 = 0; g4 < 4; ++g4) { const int m0 = mt * 32 + 8 * g4 + 4 * hh;
                    const v2u rt = *(const LAS v2u*)(lds + R1_RT + n * SBS + m0 * 2);
                    v2u ov; ov.x = pk2(acc[4 * g4] + bflo(rt.x), acc[4 * g4 + 1] + bfhi(rt.x)); ov.y = pk2(acc[4 * g4 + 2] + bflo(rt.y), acc[4 * g4 + 3] + bfhi(rt.y));
                    *(GAS v2u*)(RHg + n * 64 + m0) = ov; }
            } else {
                f32x16 acc = wtile<4>(lds + R1_U0T + mt * 32 * SBS, SBS, lds + R1_ARB + nt * 32 * SBS, SBS, zero16(), lane);
                acc = wtile<4>(lds + R1_VT + mt * 32 * SBS, SBS, lds + R1_ARK + nt * 32 * SBS, SBS, acc, lane);
#pragma unroll
                for (int g4 = 0; g4 < 4; ++g4) *(GAS f32x4*)(Y0g + n * 64 + mt * 32 + 8 * g4 + 4 * hh) = (f32x4){acc[4 * g4], acc[4 * g4 + 1], acc[4 * g4 + 2], acc[4 * g4 + 3]};
            }
        }
        if (tid < 64) ((float*)(F.ws + WS_BONUS))[(size_t)item * 64 + tid] = ((const LAS float*)(lds + R1_BONUS))[tid];
    }
    LDS_BARRIER();
    {
        const int n16 = lane & 15, g = lane >> 4;
        bf16x8 sh[2], sl[2];
#pragma unroll
        for (int ks = 0; ks < 2; ++ks) { const f32x4 a = cst[2 * ks], b = cst[2 * ks + 1];
            v4u h_; h_.x = pk2(a[0], a[1]); h_.y = pk2(a[2], a[3]); h_.z = pk2(b[0], b[1]); h_.w = pk2(b[2], b[3]);
            v4u l_; l_.x = pk2(a[0] - bflo(h_.x), a[1] - bfhi(h_.x)); l_.y = pk2(a[2] - bflo(h_.y), a[3] - bfhi(h_.y)); l_.z = pk2(b[0] - bflo(h_.z), b[1] - bfhi(h_.z)); l_.w = pk2(b[2] - bflo(h_.w), b[3] - bfhi(h_.w));
            sh[ks] = __builtin_bit_cast(bf16x8, h_); sl[ks] = __builtin_bit_cast(bf16x8, l_); }
        f32x4 nw[4];
#pragma unroll
        for (int rt = 0; rt < 4; ++rt) { f32x4 acc = (f32x4){0.f, 0.f, 0.f, 0.f};
            if (w >= 4) acc = *(const LAS f32x4*)(lds + R1_CN + ((16 * (w - 4) + n16) * 64 + 16 * rt + 4 * g) * 4);
#pragma unroll
            for (int ks = 0; ks < 2; ++ks) {
                const bf16x8 mh = *(const LAS bf16x8*)(lds + R1_CF + ((rt * 2 + ks) * 2) * 1024 + lane * 16), ml = *(const LAS bf16x8*)(lds + R1_CF + ((rt * 2 + ks) * 2 + 1) * 1024 + lane * 16);
                acc = __builtin_amdgcn_mfma_f32_16x16x32_bf16(mh, sh[ks], acc, 0, 0, 0);
                acc = __builtin_amdgcn_mfma_f32_16x16x32_bf16(mh, sl[ks], acc, 0, 0, 0);
                acc = __builtin_amdgcn_mfma_f32_16x16x32_bf16(ml, sh[ks], acc, 0, 0, 0); }
            nw[rt] = acc; }
#pragma unroll
        for (int rt = 0; rt < 4; ++rt) cst[rt] = nw[rt];
    }
    LDS_BARRIER();
}

constexpr int R2_RS = 272, R2_SLOT = 2 * 64 * R2_RS;
static_assert(2 * R2_SLOT <= LDSCTL_OFF, "R2 LDS");
template <int NSTEP, int R2_D> __device__ __forceinline__ void rwkv_scan(Frame& F, const float* Mg, const float* NTg, float* SSg, const float* S0g) {
    int tid_ = F.tid; asm volatile("" : "+v"(tid_));
    const int lane = tid_ & 63, w = __builtin_amdgcn_readfirstlane(tid_ >> 6);
    LAS unsigned char* lds = F.lds + RING_OFF;
    if (w >= 4) {
        const int L = w - 4, r = lane >> 2, f0 = (lane & 3) * 4;
        const size_t goff = (size_t)(16 * L + r) * 64 + f0 * 4;
        const int loff = (16 * L + r) * R2_RS + f0 * 16;
        f32x4 R[R2_D][8];
#define R2_ISSUE(slot_, step_) do { const int st_ = (step_) < NSTEP ? (step_) : NSTEP - 1; const float* mp_ = Mg + (size_t)st_ * 4096 + goff; const float* np_ = NTg + (size_t)st_ * 4096 + goff; \
            _Pragma("unroll") for (int k_ = 0; k_ < 4; ++k_) { R[slot_][k_] = *(const GAS f32x4*)(mp_ + 4 * k_); R[slot_][4 + k_] = *(const GAS f32x4*)(np_ + 4 * k_); } } while (0)
        const int q_ = lane & 3, froff = ((L * 2 + (q_ >> 1)) * 2) * 1024 + r * 16 + (q_ & 1) * 8;
#define R2_WRITE(slot_, buf_) do { LAS unsigned char* d_ = lds + (buf_) * R2_SLOT; \
            _Pragma("unroll") for (int k_ = 0; k_ < 4; ++k_) { const f32x4 a_ = R[slot_][k_]; \
                v2u h_; h_.x = pk2(a_[0], a_[1]); h_.y = pk2(a_[2], a_[3]); \
                v2u l_; l_.x = pk2(a_[0] - bflo(h_.x), a_[1] - bfhi(h_.x)); l_.y = pk2(a_[2] - bflo(h_.y), a_[3] - bfhi(h_.y)); \
                *(LAS v2u*)(d_ + froff + k_ * 256) = h_; *(LAS v2u*)(d_ + froff + 1024 + k_ * 256) = l_; \
                *(LAS f32x4*)(d_ + 64 * R2_RS + loff + 16 * k_) = R[slot_][4 + k_]; } } while (0)
#pragma unroll
        for (int u = 0; u < R2_D; ++u) R2_ISSUE(u, u);
        R2_WRITE(0, 0);
        R2_ISSUE(0, R2_D);
        LDS_BARRIER();
        int c0 = 0;
        for (; c0 + R2_D <= NSTEP - 1; c0 += R2_D) {
#pragma unroll
            for (int u = 0; u < R2_D; ++u) { const int c = c0 + u;
                R2_WRITE((u + 1) % R2_D, (c + 1) & 1);
                R2_ISSUE((u + 1) % R2_D, c + 1 + R2_D);
                LDS_BARRIER(); }
        }
#pragma unroll
        for (int u = 0; u < R2_D; ++u) { const int c = c0 + u;
            if (c < NSTEP - 1) { R2_WRITE((u + 1) % R2_D, (c + 1) & 1); LDS_BARRIER(); } }
        LDS_BARRIER();
#undef R2_ISSUE
#undef R2_WRITE
        return;
    }
    const int n16 = lane & 15, g = lane >> 4;
    f32x4 st[4];
#pragma unroll
    for (int rt = 0; rt < 4; ++rt) st[rt] = S0g ? *(const GAS f32x4*)(S0g + (16 * w + n16) * 64 + 16 * rt + 4 * g) : (f32x4){0.f, 0.f, 0.f, 0.f};
    LDS_BARRIER();
    for (int c = 0; c < NSTEP; ++c) {
#pragma unroll
        for (int rt = 0; rt < 4; ++rt) *(GAS f32x4*)(SSg + (size_t)c * 4096 + (16 * w + n16) * 64 + 16 * rt + 4 * g) = st[rt];
        const LAS unsigned char* sl_ = lds + (c & 1) * R2_SLOT;
        bf16x8 sh[2], sl[2];
#pragma unroll
        for (int ks = 0; ks < 2; ++ks) { const f32x4 a = st[2 * ks], b = st[2 * ks + 1];
            v4u h; h.x = pk2(a[0], a[1]); h.y = pk2(a[2], a[3]); h.z = pk2(b[0], b[1]); h.w = pk2(b[2], b[3]);
            v4u l; l.x = pk2(a[0] - bflo(h.x), a[1] - bfhi(h.x)); l.y = pk2(a[2] - bflo(h.y), a[3] - bfhi(h.y)); l.z = pk2(b[0] - bflo(h.z), b[1] - bfhi(h.z)); l.w = pk2(b[2] - bflo(h.w), b[3] - bfhi(h.w));
            sh[ks] = __builtin_bit_cast(bf16x8, h); sl[ks] = __builtin_bit_cast(bf16x8, l); }
        f32x4 nw[4];
#pragma unroll
        for (int rt = 0; rt < 4; ++rt) { f32x4 acc = *(const LAS f32x4*)(sl_ + 64 * R2_RS + (16 * w + n16) * R2_RS + (16 * rt + 4 * g) * 4);
#pragma unroll
            for (int ks = 0; ks < 2; ++ks) {
                const bf16x8 mh = *(const LAS bf16x8*)(sl_ + ((rt * 2 + ks) * 2) * 1024 + lane * 16), ml = *(const LAS bf16x8*)(sl_ + ((rt * 2 + ks) * 2 + 1) * 1024 + lane * 16);
                acc = __builtin_amdgcn_mfma_f32_16x16x32_bf16(mh, sh[ks], acc, 0, 0, 0);
                acc = __builtin_amdgcn_mfma_f32_16x16x32_bf16(mh, sl[ks], acc, 0, 0, 0);
                acc = __builtin_amdgcn_mfma_f32_16x16x32_bf16(ml, sh[ks], acc, 0, 0, 0); }
            nw[rt] = acc; }
#pragma unroll
        for (int rt = 0; rt < 4; ++rt) st[rt] = nw[rt];
        LDS_BARRIER();
    }
#pragma unroll
    for (int rt = 0; rt < 4; ++rt) *(GAS f32x4*)(SSg + (size_t)NSTEP * 4096 + (16 * w + n16) * 64 + 16 * rt + 4 * g) = st[rt];
}

constexpr int R3_RH = 0, R3_S = 9216, R3_SG = 18432, R3_SGS = 272, R3_YL = R3_SG + 64 * R3_SGS, R3_GL = R3_YL + 16384, R3_VS = R3_GL + 16384, R3_BON = R3_VS + 65 * 128, R3_END = R3_BON + 256;
static_assert(R3_END <= LDSCTL_OFF, "R3 LDS");
struct R3Pre { v4u rh; f32x4 ss[2]; v4u gd[2][2]; f32x4 y0[2]; v4u vv[2]; float bon; };
__device__ __forceinline__ void rwkv_r3_prefetch(Frame& F, int item, int tid, R3Pre& P) {
    const int chain = item >> 7, chunk = item & 127, b = chain >> 3, h = chain & 7, g0 = b * SEQ + chunk * 64;
    const bf16* Z = (const bf16*)(F.ws + WS_Z);
    const int t = tid >> 3, cg = tid & 7; const v4u z0 = (v4u){0u, 0u, 0u, 0u};
    P.rh = *(const GAS v4u*)((const bf16*)(F.ws + WS_RWRH) + (size_t)item * 4096 + t * 64 + cg * 8);
    const float* SSg = (const float*)(F.ws + WS_RWSS) + (size_t)item * 4096 + t * 64 + cg * 8;
    P.ss[0] = *(const GAS f32x4*)SSg; P.ss[1] = *(const GAS f32x4*)(SSg + 4);
    const bf16* zr = Z + (size_t)(g0 + t) * IN_COLS + C_GD + cg * 16; const bool first = (chunk == 0 && t == 0);
#pragma unroll
    for (int q = 0; q < 2; ++q) { P.gd[q][0] = *(const GAS v4u*)(zr + q * 8); P.gd[q][1] = z0; if (!first) P.gd[q][1] = *(const GAS v4u*)(zr - IN_COLS + q * 8); }
    const float* Y0g = (const float*)(F.ws + WS_RWY0) + (size_t)item * 4096;
    P.y0[0] = *(const GAS f32x4*)(Y0g + tid * 4); P.y0[1] = *(const GAS f32x4*)(Y0g + (tid + 512) * 4);
#pragma unroll
    for (int q = 0; q < 2; ++q) { const int p = tid + 512 * q; P.vv[q] = z0;
        if (p < 65 * 8) { const int row = p >> 3, ch = p & 7; if (!(chunk == 0 && row == 0)) P.vv[q] = *(const GAS v4u*)(Z + (size_t)(g0 - 1 + row) * IN_COLS + C_V + h * 64 + ch * 8); } }
    P.bon = tid < 64 ? ((const float*)(F.ws + WS_BONUS))[(size_t)item * 64 + tid] : 0.f;
}
__device__ __forceinline__ void r3_load_bfrag(Frame& F, int h, int w, int lane, bf16x8 (&bf)[8]) {
    const int nt = w & 1; const bf16* gut = (const bf16*)(F.ws + WS_GUPT) + (size_t)(h * 64 + nt * 32 + (lane & 31)) * 128 + 8 * (lane >> 5);
#pragma unroll
    for (int s2 = 0; s2 < 8; ++s2) bf[s2] = *(const GAS bf16x8*)(gut + 16 * s2);
}
__device__ __forceinline__ void rwkv_r3_item(Frame& F, int item, int next_item, R3Pre& P, const bf16x8 (&bfr)[8]) {
    const int chain = item >> 7, chunk = item & 127, b = chain >> 3, h = chain & 7;
    const int g0 = b * SEQ + chunk * 64;
    int tid_ = F.tid; asm volatile("" : "+v"(tid_));
    const int tid = tid_, lane = tid & 63, w = __builtin_amdgcn_readfirstlane(tid >> 6), hh = lane >> 5, cl = lane & 31;
    LAS unsigned char* lds = F.lds + RING_OFF;
    const float* mu = F.in[3];
    {
        const int t = tid >> 3, cg = tid & 7;
        *(LAS v4u*)(lds + R3_RH + t * SBS + cg * 16) = P.rh;
        const f32x4 s0 = P.ss[0], s1 = P.ss[1];
        v4u o; o.x = pk2(s0[0], s0[1]); o.y = pk2(s0[2], s0[3]); o.z = pk2(s1[0], s1[1]); o.w = pk2(s1[2], s1[3]);
        *(LAS v4u*)(lds + R3_S + t * SBS + cg * 16) = o;
#pragma unroll
        for (int q = 0; q < 2; ++q) {
            const v4u cw = P.gd[q][0], pw = P.gd[q][1];
            float fw[8], qw[8];
            fw[0] = bflo(cw.x); fw[1] = bfhi(cw.x); fw[2] = bflo(cw.y); fw[3] = bfhi(cw.y); fw[4] = bflo(cw.z); fw[5] = bfhi(cw.z); fw[6] = bflo(cw.w); fw[7] = bfhi(cw.w);
            qw[0] = bflo(pw.x); qw[1] = bfhi(pw.x); qw[2] = bflo(pw.y); qw[3] = bfhi(pw.y); qw[4] = bflo(pw.z); qw[5] = bfhi(pw.z); qw[6] = bflo(pw.w); qw[7] = bfhi(pw.w);
#pragma unroll
            for (int j = 0; j < 8; ++j) { const float v = fw[j] + (qw[j] - fw[j]) * mu[C_GD + cg * 16 + q * 8 + j]; fw[j] = frcp(1.f + __expf(-v)); }
            v4u og; og.x = pk2(fw[0], fw[1]); og.y = pk2(fw[2], fw[3]); og.z = pk2(fw[4], fw[5]); og.w = pk2(fw[6], fw[7]);
            *(LAS v4u*)(lds + R3_SG + t * R3_SGS + (cg * 16 + q * 8) * 2) = og;
        }
        *(LAS f32x4*)(lds + R3_YL + tid * 16) = P.y0[0]; *(LAS f32x4*)(lds + R3_YL + (tid + 512) * 16) = P.y0[1];
#pragma unroll
        for (int q = 0; q < 2; ++q) { const int p = tid + 512 * q; if (p < 65 * 8) *(LAS v4u*)(lds + R3_VS + p * 16) = P.vv[q]; }
        if (tid < 64) ((LAS float*)(lds + R3_BON))[tid] = P.bon;
        if (next_item >= 0) rwkv_r3_prefetch(F, next_item, tid, P);
    }
    LDS_BARRIER();
    {
        const int mt = (w >> 1) & 1, nt = w & 1; const int n = nt * 32 + cl;
        if (w < 4) {
            LAS float* YL = (LAS float*)(lds + R3_YL);
            f32x16 acc;
#pragma unroll
            for (int r = 0; r < 16; ++r) acc[r] = YL[(mt * 32 + crow(r, hh)) * 64 + n];
            acc = wtile<4>(lds + R3_RH + mt * 32 * SBS, SBS, lds + R3_S + nt * 32 * SBS, SBS, acc, lane);
#pragma unroll
            for (int r = 0; r < 16; ++r) YL[(mt * 32 + crow(r, hh)) * 64 + n] = acc[r];
        } else {
            f32x16 acc = zero16();
            { const LAS unsigned char* A_ = lds + R3_SG + mt * 32 * R3_SGS + (lane & 31) * R3_SGS + 16 * hh;
#pragma unroll
              for (int s2 = 0; s2 < 8; ++s2) acc = __builtin_amdgcn_mfma_f32_32x32x16_bf16(*(const LAS bf16x8*)(A_ + 32 * s2), bfr[s2], acc, 0, 0, 0); }
            LAS float* GL = (LAS float*)(lds + R3_GL);
#pragma unroll
            for (int r = 0; r < 16; ++r) GL[(mt * 32 + crow(r, hh)) * 64 + n] = acc[r];
        }
    }
    LDS_BARRIER();
    {
        const int c = tid & 63, ts = tid >> 6, col = h * 64 + c;
        const float mu_v = mu[C_V + col], gw = F.in[12][col], gb = F.in[13][col];
        const LAS float* YL = (const LAS float*)(lds + R3_YL); const LAS float* GL = (const LAS float*)(lds + R3_GL); const LAS float* BON = (const LAS float*)(lds + R3_BON);
        bf16* Y = (bf16*)(F.ws + WS_YMIX);
        const LAS bf16* vb = (const LAS bf16*)(lds + R3_VS) + (8 * ts) * 64 + c;
        float pv = bf2f(vb[0]);
#pragma unroll
        for (int i = 0; i < 8; ++i) { const int t = 8 * ts + i;
            const float zv = bf2f(vb[(i + 1) * 64]); const float v = zv + (pv - zv) * mu_v; pv = zv;
            const float y = YL[t * 64 + c];
            const float mean = wave_sum(y) * (1.f / 64.f); const float d = y - mean; const float var = wave_sum(d * d) * (1.f / 64.f);
            const float yn = d * frsq(var + GN_EPS) * gw + gb;
            const float o = (yn + BON[t] * v) * GL[t * 64 + c];
            Y[(size_t)(g0 + t) * DM + col] = (bf16)f2bf(o); }
    }
    LDS_BARRIER();
}

typedef short s16x4 __attribute__((ext_vector_type(4)));
typedef short v4i16_t __attribute__((ext_vector_type(4)));
constexpr int AT_XO = 0, AT_XO_STRIDE = 136, AT_XM = 512 * AT_XO_STRIDE, AT_XL = AT_XM + 2048, AT_V = AT_XL + 2048, AT_K = AT_V + 8 * 4096, AT_KS = 144, AT_LDS_END = AT_K + 8 * 32 * AT_KS;
static_assert(AT_LDS_END <= LDSCTL_OFF, "attention LDS");
__device__ __forceinline__ float xhalf(float v) { return __shfl_xor(v, 32); }
__device__ __forceinline__ void attn_block(Frame& F, int item) {
    const int bh = item >> 4, blk = item & 15, b = bh >> 3, h = bh & 7, t0 = blk * 512;
    int tid_ = F.tid; asm volatile("" : "+v"(tid_));
    const int lane = tid_ & 63, w = __builtin_amdgcn_readfirstlane(tid_ >> 6), ql = lane & 31, hh = lane >> 5;
    const bf16* Zb = (const bf16*)(F.ws + WS_Z) + (size_t)b * SEQ * IN_COLS;
    bf16* Y = (bf16*)(F.ws + WS_YMIX);
    LAS unsigned char* lds = F.lds + RING_OFF;
    LAS unsigned char* Vw = lds + AT_V + w * 4096;
    LAS unsigned char* Kw = lds + AT_K + w * 32 * AT_KS;
    LAS float* XM = (LAS float*)(lds + AT_XM); LAS float* XL = (LAS float*)(lds + AT_XL);
    constexpr float C2 = 0.125f * 1.4426950408889634f;
    for (int pass = 0; pass < 3; ++pass) {
        const int sh = pass == 0 ? 4 : (pass == 1 ? 2 : 0), d = 1 << sh;
        for (int uu = 0; uu < 2; ++uu) {
            const int u = w + 8 * uu, rho = u & (d - 1), tau = u >> sh;
            const int qoff = rho + (32 * tau + ql) * d;
            v4u qr[4];
#pragma unroll
            for (int i = 0; i < 4; ++i) { const int kidx = i * 8 + (lane >> 3), ch = lane & 7;
                qr[i] = *(const GAS v4u*)(Zb + (size_t)(t0 + rho + (32 * tau + kidx) * d) * IN_COLS + C_AQ + h * 64 + ch * 8); }
            f32x16 sc[5];
            const int tkb = t0 + rho + (32 * tau - 128) * d;
            v4u kr[5][4];
#pragma unroll
            for (int kt = 0; kt < 5; ++kt) { const int tk0 = tkb + 32 * kt * d, tkc = tk0 < 0 ? 0 : tk0;
#pragma unroll
                for (int i = 0; i < 4; ++i) { const int kidx = i * 8 + (lane >> 3), ch = lane & 7;
                    kr[kt][i] = *(const GAS v4u*)(Zb + (size_t)(tkc + kidx * d) * IN_COLS + C_AK + h * 64 + ch * 8); } }
            v4u vr[2][4];
#pragma unroll
            for (int kt = 0; kt < 2; ++kt) { const int tk1 = tkb + 32 * kt * d, tkc = tk1 < 0 ? 0 : tk1;
#pragma unroll
              for (int i = 0; i < 4; ++i) { const int kidx = i * 8 + (lane >> 3), ch = lane & 7;
                  vr[kt][i] = *(const GAS v4u*)(Zb + (size_t)(tkc + kidx * d) * IN_COLS + C_AV + h * 64 + ch * 8); } }
            bf16x8 qf[4];
#pragma unroll
            for (int i = 0; i < 4; ++i) *(LAS v4u*)(Kw + (i * 8 + (lane >> 3)) * AT_KS + (lane & 7) * 16) = qr[i];
#pragma unroll
            for (int s = 0; s < 4; ++s) qf[s] = *(const LAS bf16x8*)(Kw + ql * AT_KS + 32 * s + 16 * hh);
#pragma unroll
            for (int kt = 0; kt < 5; ++kt) {
                const int tk0 = tkb + 32 * kt * d;
                bf16x8 kf[4];
#pragma unroll
                for (int i = 0; i < 4; ++i) *(LAS v4u*)(Kw + (i * 8 + (lane >> 3)) * AT_KS + (lane & 7) * 16) = kr[kt][i];
#pragma unroll
                for (int s = 0; s < 4; ++s) kf[s] = *(const LAS bf16x8*)(Kw + ql * AT_KS + 32 * s + 16 * hh);
                f32x16 acc = zero16();
#pragma unroll
                for (int s = 0; s < 4; ++s) acc = __builtin_amdgcn_mfma_f32_32x32x16_bf16(kf[s], qf[s], acc, 0, 0, 0);
                if (kt == 0 || kt == 4) {
#pragma unroll
                    for (int r = 0; r < 16; ++r) { const int kidx = (r & 3) + 8 * (r >> 2) + 4 * hh;
                        const bool ok = (kt == 0) ? (kidx >= ql) : (kidx <= ql);
                        acc[r] = ok ? acc[r] : -INFINITY; }
                }
                if (tk0 < 0) {
#pragma unroll
                    for (int r = 0; r < 16; ++r) acc[r] = -INFINITY;
                }
                sc[kt] = acc;
            }
            float m = -INFINITY;
#pragma unroll
            for (int kt = 0; kt < 5; ++kt)
#pragma unroll
                for (int r = 0; r < 16; ++r) m = fmaxf(m, sc[kt][r]);
            m = fmaxf(m, xhalf(m));
            const float ms = m * C2;
            float l = 0.f;
#pragma unroll
            for (int kt = 0; kt < 5; ++kt)
#pragma unroll
                for (int r = 0; r < 16; ++r) { const float p = __builtin_amdgcn_exp2f(sc[kt][r] * C2 - ms); sc[kt][r] = p; l += p; }
            l += xhalf(l);
            f32x16 O[2];
#pragma unroll
            for (int r = 0; r < 16; ++r) { O[0][r] = 0.f; O[1][r] = 0.f; }
#pragma unroll
            for (int kt = 0; kt < 5; ++kt) {
#pragma unroll
                for (int i = 0; i < 4; ++i) { const int kidx = i * 8 + (lane >> 3), ch = lane & 7;
                    *(LAS v4u*)(Vw + kidx * 128 + ((ch ^ (((kidx >> 1) & 1) << 2)) << 4)) = vr[kt & 1][i]; }
                if (kt < 3) { const int tk1 = tkb + 32 * (kt + 2) * d, tkc = tk1 < 0 ? 0 : tk1;
#pragma unroll
                    for (int i = 0; i < 4; ++i) { const int kidx = i * 8 + (lane >> 3), ch = lane & 7;
                        vr[kt & 1][i] = *(const GAS v4u*)(Zb + (size_t)(tkc + kidx * d) * IN_COLS + C_AV + h * 64 + ch * 8); } }
                asm volatile("s_waitcnt lgkmcnt(0)" ::: "memory");
#pragma unroll
                for (int s = 0; s < 2; ++s) {
                    v4u pw; pw.x = pk2(sc[kt][8 * s], sc[kt][8 * s + 1]); pw.y = pk2(sc[kt][8 * s + 2], sc[kt][8 * s + 3]); pw.z = pk2(sc[kt][8 * s + 4], sc[kt][8 * s + 5]); pw.w = pk2(sc[kt][8 * s + 6], sc[kt][8 * s + 7]);
                    const bf16x8 pf = __builtin_bit_cast(bf16x8, pw);
#pragma unroll
                    for (int dt = 0; dt < 2; ++dt) {
                        bf16x8 vf;
#pragma unroll
                        for (int pp = 0; pp < 2; ++pp) {
                            const int i16 = lane & 15, db = (lane >> 4) & 1;
                            const int row = 16 * s + 8 * pp + 4 * hh + (i16 >> 2);
                            const int byte = 64 * dt + 32 * db + 8 * (i16 & 3);
                            const int chunk = (byte >> 4) ^ (((row >> 1) & 1) << 2);
                            const s16x4 t4 = __builtin_bit_cast(s16x4, __builtin_amdgcn_ds_read_tr16_b64_v4i16((LAS v4i16_t*)(Vw + row * 128 + (chunk << 4) + (byte & 15))));
                            vf[4 * pp + 0] = t4[0]; vf[4 * pp + 1] = t4[1]; vf[4 * pp + 2] = t4[2]; vf[4 * pp + 3] = t4[3];
                        }
                        O[dt] = __builtin_amdgcn_mfma_f32_32x32x16_bf16(vf, pf, O[dt], 0, 0, 0);
                    }
                }
                asm volatile("s_waitcnt lgkmcnt(0)" ::: "memory");
            }
            LAS unsigned char* xo = lds + AT_XO + qoff * AT_XO_STRIDE + 8 * hh;
            float wa = 0.f, wb = 1.f, Mx = ms, ln = l;
            if (pass > 0) { const float msa = XM[qoff], la = XL[qoff]; Mx = fmaxf(msa, ms); wa = la * __builtin_amdgcn_exp2f(msa - Mx); wb = __builtin_amdgcn_exp2f(ms - Mx); ln = wa + wb * l; }
            const float inv = 1.f / ln;
#pragma unroll
            for (int dt = 0; dt < 2; ++dt)
#pragma unroll
                for (int g4 = 0; g4 < 4; ++g4) {
                    LAS v2u* p = (LAS v2u*)(xo + (32 * dt + 8 * g4) * 2);
                    float o0 = O[dt][4 * g4] * wb, o1 = O[dt][4 * g4 + 1] * wb, o2 = O[dt][4 * g4 + 2] * wb, o3 = O[dt][4 * g4 + 3] * wb;
                    if (pass > 0) { const v2u old = *p; o0 += bflo(old.x) * wa; o1 += bfhi(old.x) * wa; o2 += bflo(old.y) * wa; o3 += bfhi(old.y) * wa; }
                    v2u nw; nw.x = pk2(o0 * inv, o1 * inv); nw.y = pk2(o2 * inv, o3 * inv);
                    *p = nw;
                }
            if (hh == 0) { XM[qoff] = Mx; XL[qoff] = ln; }
        }
        LDS_BARRIER();
    }
#pragma unroll
    for (int i = 0; i < 8; ++i) { const int row = (tid_ >> 3) + 64 * i, ch = tid_ & 7;
        LAS v2u* p = (LAS v2u*)(lds + AT_XO + row * AT_XO_STRIDE + ch * 16);
        const v2u a = p[0], c = p[1];
        v4u o; o.x = a.x; o.y = a.y; o.z = c.x; o.w = c.y;
        *(GAS v4u*)(Y + ((size_t)b * SEQ + t0 + row) * DM + RWW + h * 64 + ch * 8) = o; }
    LDS_BARRIER();
}

__device__ __forceinline__ void quantize_tables(Frame& F, int gw, int ngw) {
    for (int m = gw; m < 2 * NEXP; m += ngw) {
        const int tab = m >= NEXP, row = tab ? m - NEXP : m;
        const GAS f32x4* xr = (const GAS f32x4*)(F.in[18 + tab] + (size_t)row * DM) + F.lane * 4;
        f32x4 v[4]; float am = 0.f;
#pragma unroll
        for (int j = 0; j < 4; ++j) { v[j] = xr[j]; am = fmaxf(am, fmaxf(fmaxf(fabsf(v[j].x), fabsf(v[j].y)), fmaxf(fabsf(v[j].z), fabsf(v[j].w)))); }
        am = wave_max(am);
        const float qmax = tab ? 224.f : 127.f;
        const float sc = am > 0.f ? am / qmax : 1.f, inv = am > 0.f ? qmax / am : 0.f;
        v4u o;
#pragma unroll
        for (int j = 0; j < 4; ++j) {
            if (tab) { int w = __builtin_amdgcn_cvt_pk_fp8_f32(v[j].x * inv, v[j].y * inv, 0, false); w = __builtin_amdgcn_cvt_pk_fp8_f32(v[j].z * inv, v[j].w * inv, w, true); o[j] = (unsigned)w; }
            else {
            const unsigned b0 = (unsigned)(int)rintf(v[j].x * inv) & 255u, b1 = (unsigned)(int)rintf(v[j].y * inv) & 255u,
                           b2 = (unsigned)(int)rintf(v[j].z * inv) & 255u, b3 = (unsigned)(int)rintf(v[j].w * inv) & 255u;
            o[j] = b0 | (b1 << 8) | (b2 << 16) | (b3 << 24); } }
        *(GAS v4u*)(F.ws + (tab ? WS_VQ : WS_UQ) + (size_t)row * DM + F.lane * 16) = o;
        if (F.lane == 0) ((float*)(F.ws + (tab ? WS_SV : WS_SU)))[row] = sc;
    }
}

__device__ __forceinline__ void p3_mixers(Frame& F) {
    if (F.wg < NB * NHR) {
        const int chain = F.wg;
        const float* Pg = (const float*)(F.ws + WS_PQ) + (size_t)chain * 8 * 4096; const float* Qg = Pg + (size_t)256 * 4096;
        rwkv_scan<7, 3>(F, Pg, Qg, (float*)(F.ws + WS_SSEG) + (size_t)chain * 8 * 4096, nullptr);
        __syncthreads();
    }
#ifndef ATTN_REPS
#define ATTN_REPS 1
#endif
    for (int rep = 0; rep < ATTN_REPS; ++rep)
    if (F.G == 256) { for (int r = 0; r < 2; ++r) { const int v = r * 32 + (F.wg >> 3); attn_block(F, (((F.wg & 7) * 4 + (v >> 4)) << 4) | (v & 15)); } }
    else for (int item = F.wg; item < NB * NHA * (SEQ / 512); item += F.G) attn_block(F, item);
}

constexpr int TK_SKS = 272, TK_SKH = 0, TK_SKL = 2 * 128 * TK_SKS, TK_LUT = 2 * TK_SKL, TK_END = TK_LUT + 8 * 2048;
__device__ __forceinline__ unsigned f2ord(float f) { const unsigned u = __builtin_bit_cast(unsigned, f); return u ^ ((unsigned)((int)u >> 31) | 0x80000000u); }
__device__ __forceinline__ float ord2f(unsigned o) { const unsigned u = (o & 0x80000000u) ? (o ^ 0x80000000u) : ~o; return __builtin_bit_cast(float, u); }
__device__ __forceinline__ void ce_desc(unsigned& a, unsigned& b) { const unsigned mx = a > b ? a : b, mn = a > b ? b : a; a = mx; b = mn; }
template <int N, int OFF, int TOT> __device__ __forceinline__ void bitonic_sort_desc(unsigned (&v)[TOT]) {
#pragma unroll
    for (int k = 2; k <= N; k <<= 1)
#pragma unroll
        for (int j = k >> 1; j > 0; j >>= 1)
#pragma unroll
            for (int i = 0; i < N; ++i) { const int l = i ^ j; if (l > i) { if ((i & k) == 0) ce_desc(v[OFF + i], v[OFF + l]); else ce_desc(v[OFF + l], v[OFF + i]); } }
}
template <int OFFA, int OFFB, int TOT> __device__ __forceinline__ void merge_top16(unsigned (&v)[TOT]) {
#pragma unroll
    for (int i = 0; i < 16; ++i) { const unsigned x = v[OFFA + i], y = v[OFFB + 15 - i]; v[OFFA + i] = x > y ? x : y; }
#pragma unroll
    for (int j = 8; j > 0; j >>= 1)
#pragma unroll
        for (int i = 0; i < 16; ++i) { const int l = i ^ j; if (l > i) ce_desc(v[OFFA + i], v[OFFA + l]); }
}
__device__ __forceinline__ void top16_of_64(unsigned (&k)[64]) {
    bitonic_sort_desc<16, 0, 64>(k); bitonic_sort_desc<16, 16, 64>(k); bitonic_sort_desc<16, 32, 64>(k); bitonic_sort_desc<16, 48, 64>(k);
    merge_top16<0, 16, 64>(k); merge_top16<32, 48, 64>(k); merge_top16<0, 32, 64>(k);
}
__device__ __forceinline__ void p7_topk(Frame& F) {
    static_assert(TK_END <= LDSCTL_OFF, "topk LDS");
    const bf16* QP = (const bf16*)(F.ws + WS_QP);
    int* EID = (int*)(F.ws + WS_EID); float* GATE = (float*)(F.ws + WS_GATE);
    const float* sk = F.in[17];
    LAS unsigned char* lds = F.lds + RING_OFF;
    for (int e = F.tid; e < 2 * 128 * 64; e += NTHREADS) {
        const int c = e >> 13, k = (e >> 6) & 127, d2 = e & 63;
        const f32x2 v = *(const GAS f32x2*)(sk + (size_t)(c * 128 + k) * 128 + 2 * d2);
        const unsigned h0 = f2bf(v.x), h1 = f2bf(v.y);
        const float r0 = v.x - __builtin_bit_cast(float, h0 << 16), r1 = v.y - __builtin_bit_cast(float, h1 << 16);
        *(LAS unsigned*)(lds + TK_SKH + (c * 128 + k) * TK_SKS + d2 * 4) = h0 | (h1 << 16);
        *(LAS unsigned*)(lds + TK_SKL + (c * 128 + k) * TK_SKS + d2 * 4) = pk2(r0, r1);
    }
    __syncthreads();
    const int gw = F.wg * NWAVES + F.wave, NGW = F.G * NWAVES;
    for (int tile = gw; tile < T * PHEADS / 32; tile += NGW) {
        int lane_ = F.lane; asm volatile("" : "+v"(lane_));
        const int lane = lane_, hh = lane >> 5, cl = lane & 31;
        const int P = tile * 32 + cl, t = P >> 3, h = P & 7;
        unsigned kAB[2][16];
#pragma unroll
        for (int c = 0; c < 2; ++c) {
            bf16x8 qf[8];
            const bf16* qp = QP + (size_t)t * PQ + h * 256 + c * 128 + 8 * hh;
#pragma unroll
            for (int s2 = 0; s2 < 8; ++s2) qf[s2] = *(const GAS bf16x8*)(qp + 16 * s2);
            unsigned k[64];
#pragma unroll
            for (int mt = 0; mt < 4; ++mt) {
                f32x16 acc = zero16();
                const LAS unsigned char* ah = lds + TK_SKH + (c * 128 + mt * 32 + cl) * TK_SKS + 16 * hh;
                const LAS unsigned char* al = lds + TK_SKL + (c * 128 + mt * 32 + cl) * TK_SKS + 16 * hh;
#pragma unroll
                for (int s2 = 0; s2 < 8; ++s2) {
                    acc = __builtin_amdgcn_mfma_f32_32x32x16_bf16(*(const LAS bf16x8*)(ah + 32 * s2), qf[s2], acc, 0, 0, 0);
                    acc = __builtin_amdgcn_mfma_f32_32x32x16_bf16(*(const LAS bf16x8*)(al + 32 * s2), qf[s2], acc, 0, 0, 0); }
#pragma unroll
                for (int r = 0; r < 16; ++r) { const int idx = 32 * mt + (r & 3) + 8 * (r >> 2) + 4 * hh; k[mt * 16 + r] = (f2ord(acc[r]) & ~127u) | (unsigned)(127 - idx); }
            }
            top16_of_64(k);
            unsigned m[32];
#pragma unroll
            for (int i = 0; i < 16; ++i) { m[i] = k[i]; m[16 + i] = (unsigned)__shfl_xor((int)k[i], 32); }
            merge_top16<0, 16, 32>(m);
#pragma unroll
            for (int i = 0; i < 16; ++i) kAB[c][i] = m[i];
        }
        float fa[16], fb[16];
#pragma unroll
        for (int i = 0; i < 16; ++i) { fa[i] = ord2f(kAB[0][i] & ~127u); fb[i] = ord2f(kAB[1][i] & ~127u); }
        unsigned cd[64]; int n = 0;
#pragma unroll
        for (int i = 0; i < 16; ++i)
#pragma unroll
            for (int j = 0; j < 16; ++j) if ((i + 1) * (j + 1) <= 16) { cd[n] = (f2ord(fa[i] + fb[j]) & ~255u) | (unsigned)(255 - (i * 16 + j)); ++n; }
#pragma unroll
        for (int q = 50; q < 64; ++q) cd[q] = 0u;
        top16_of_64(cd);
        LAS unsigned char* lut = lds + TK_LUT + (F.wave * 64 + lane) * 32;
#pragma unroll
        for (int q = 0; q < 4; ++q) {
            unsigned wa = 0u, wb = 0u;
#pragma unroll
            for (int b4 = 0; b4 < 4; ++b4) { wa |= (127u - (kAB[0][4 * q + b4] & 127u)) << (8 * b4); wb |= (127u - (kAB[1][4 * q + b4] & 127u)) << (8 * b4); }
            *(LAS unsigned*)(lut + 4 * q) = wa; *(LAS unsigned*)(lut + 16 + 4 * q) = wb; }
        float gv[16]; float den = 0.f; const float mx = ord2f(cd[0] & ~255u);
#pragma unroll
        for (int q = 0; q < 16; ++q) { gv[q] = __expf(ord2f(cd[q] & ~255u) - mx); den += gv[q]; }
        const float inv = 1.f / den;
        asm volatile("s_waitcnt lgkmcnt(0)" ::: "memory");
        int ev[16];
#pragma unroll
        for (int q = 0; q < 16; ++q) { const unsigned pos = 255u - (cd[q] & 255u);
            const unsigned ia = *(const LAS unsigned char*)(lut + (pos >> 4)), ib = *(const LAS unsigned char*)(lut + 16 + (pos & 15u));
            ev[q] = (int)(ia * NKEYS + ib); }
        if (hh == 0) {
            int* ep = EID + (size_t)t * 128 + h * 16; float* gp = GATE + (size_t)t * 128 + h * 16;
#pragma unroll
            for (int q = 0; q < 4; ++q) {
                *(GAS v4u*)(ep + 4 * q) = (v4u){(unsigned)ev[4 * q], (unsigned)ev[4 * q + 1], (unsigned)ev[4 * q + 2], (unsigned)ev[4 * q + 3]};
                *(GAS f32x4*)(gp + 4 * q) = (f32x4){gv[4 * q] * inv, gv[4 * q + 1] * inv, gv[4 * q + 2] * inv, gv[4 * q + 3] * inv}; }
        }
        asm volatile("s_waitcnt lgkmcnt(0)" ::: "memory");
    }
}

constexpr int GA_WAVE_BYTES = 10752, GA_CNT = 4096, GA_OFF = 4096 + 128, GA_ACT = 4608, GA_XQ = 6656;
__device__ __forceinline__ int wave_sum_i(int v) { v += dppi<0xB1>(v); v += dppi<0x4E>(v); v += dppi<0x141>(v); v += dppi<0x140>(v);
    return (__builtin_amdgcn_readlane(v, 0) + __builtin_amdgcn_readlane(v, 16)) + (__builtin_amdgcn_readlane(v, 32) + __builtin_amdgcn_readlane(v, 48)); }
struct PairBuf { v4u u, v; float su, sv; int e; float g; };
__device__ __forceinline__ void p8_gather(Frame& F, float* outp) {
    const bf16* XN = (const bf16*)(F.ws + WS_XN);
    const unsigned char* UQ = F.ws + WS_UQ; const unsigned char* VQ = F.ws + WS_VQ;
    const float* SU = (const float*)(F.ws + WS_SU); const float* SV = (const float*)(F.ws + WS_SV);
    const int* EID = (const int*)(F.ws + WS_EID); const float* GATE = (const float*)(F.ws + WS_GATE);
    const float* nf = F.in[20];
    const int gw = F.wg * NWAVES + F.wave, NGW = F.G * NWAVES;
    LAS unsigned char* wl = F.lds + RING_OFF + F.wave * GA_WAVE_BYTES;
    for (int tg = gw, sweep = 0; tg < T / 4; tg += NGW, ++sweep) {
        int lane_ = F.lane; asm volatile("" : "+v"(lane_));
        const int lane = lane_;
        int xq[4][4]; float sx[4];
#pragma unroll
        for (int tk = 0; tk < 4; ++tk) {
            const GAS v4u* xp = (const GAS v4u*)(XN + (size_t)(4 * tg + tk) * DM + lane * 16);
            const v4u a = xp[0], b = xp[1];
            float x[16]; x[0] = bflo(a.x); x[1] = bfhi(a.x); x[2] = bflo(a.y); x[3] = bfhi(a.y); x[4] = bflo(a.z); x[5] = bfhi(a.z); x[6] = bflo(a.w); x[7] = bfhi(a.w);
            x[8] = bflo(b.x); x[9] = bfhi(b.x); x[10] = bflo(b.y); x[11] = bfhi(b.y); x[12] = bflo(b.z); x[13] = bfhi(b.z); x[14] = bflo(b.w); x[15] = bfhi(b.w);
            float am = 0.f;
#pragma unroll
            for (int i = 0; i < 16; ++i) am = fmaxf(am, fabsf(x[i]));
            am = wave_max(am);
            const float rs_ = frsq(((const float*)(F.ws + WS_SSQ))[4 * tg + tk] * (1.f / DM) + RMS_EPS);
            sx[tk] = (am > 0.f ? am * (1.f / 127.f) : 1.f) * rs_; const float inv = am > 0.f ? 127.f / am : 0.f;
#pragma unroll
            for (int q = 0; q < 4; ++q) {
                const unsigned b0 = (unsigned)(int)rintf(x[4 * q] * inv) & 255u, b1 = (unsigned)(int)rintf(x[4 * q + 1] * inv) & 255u, b2 = (unsigned)(int)rintf(x[4 * q + 2] * inv) & 255u, b3 = (unsigned)(int)rintf(x[4 * q + 3] * inv) & 255u;
                xq[tk][q] = (int)(b0 | (b1 << 8) | (b2 << 16) | (b3 << 24)); }
            *(LAS v4u*)(wl + GA_XQ + tk * 1024 + lane * 16) = (v4u){(unsigned)xq[tk][0], (unsigned)xq[tk][1], (unsigned)xq[tk][2], (unsigned)xq[tk][3]};
        }
        LAS unsigned* cnt = (LAS unsigned*)(wl + GA_CNT); LAS unsigned* offs = (LAS unsigned*)(wl + GA_OFF);
        if (lane < 32) cnt[lane] = 0u;
        asm volatile("s_waitcnt lgkmcnt(0)" ::: "memory");
        int ee[8]; float gg[8]; unsigned pos[8];
#pragma unroll
        for (int tk = 0; tk < 4; ++tk) {
            const size_t base = (size_t)(4 * tg + tk) * 128;
            ee[2 * tk] = (EID[base + lane] & (NEXP - 1)) | (tk << 14); ee[2 * tk + 1] = (EID[base + 64 + lane] & (NEXP - 1)) | (tk << 14);
            gg[2 * tk] = GATE[base + lane]; gg[2 * tk + 1] = GATE[base + 64 + lane]; }
#pragma unroll
        for (int q = 0; q < 8; ++q) pos[q] = __hip_atomic_fetch_add(cnt + ((ee[q] >> 9) & 31), 1u, __ATOMIC_RELAXED, __HIP_MEMORY_SCOPE_WAVEFRONT);
        asm volatile("s_waitcnt lgkmcnt(0)" ::: "memory");
        if (lane < 32) {
            const int c0 = (int)cnt[lane]; int v = c0;
            v += __builtin_amdgcn_update_dpp(0, v, 0x111, 0xF, 0xF, true); v += __builtin_amdgcn_update_dpp(0, v, 0x112, 0xF, 0xF, true);
            v += __builtin_amdgcn_update_dpp(0, v, 0x114, 0xF, 0xF, true); v += __builtin_amdgcn_update_dpp(0, v, 0x118, 0xF, 0xF, true);
            const int row0 = __builtin_amdgcn_readlane(v, 15);
            offs[lane] = (unsigned)(v - c0 + (lane >= 16 ? row0 : 0));
        }
        asm volatile("s_waitcnt lgkmcnt(0)" ::: "memory");
#pragma unroll
        for (int q = 0; q < 8; ++q) { const unsigned idx = offs[(ee[q] >> 9) & 31] + pos[q];
            *(LAS unsigned*)(wl + idx * 4) = (unsigned)ee[q]; *(LAS float*)(wl + 2048 + idx * 4) = gg[q]; }
        asm volatile("s_waitcnt lgkmcnt(0)" ::: "memory");
        LAS float* act = (LAS float*)(wl + GA_ACT);
#ifndef UPASS_REPS
#define UPASS_REPS 1
#endif
        for (int urep = 0; urep < UPASS_REPS; ++urep)
        {
            const int grp = lane >> 4, l16 = lane & 15;
            const LAS unsigned* ents = (const LAS unsigned*)wl;
            LAS int* hbuf = (LAS int*)(wl + GA_ACT);
            v4u rb[2][2][4]; unsigned eb[2][2];
#define GA_ULOAD(ST, QD, Q_) do { const unsigned e_ = ents[(Q_) * 4 + grp]; eb[ST][QD] = e_; const GAS v4u* rp_ = (const GAS v4u*)(UQ + (size_t)(e_ & (NEXP - 1)) * DM + l16 * 64); \
                rb[ST][QD][0] = rp_[0]; rb[ST][QD][1] = rp_[1]; rb[ST][QD][2] = rp_[2]; rb[ST][QD][3] = rp_[3]; } while (0)
#define GA_UDOT(ST, QD, Q_) do { const LAS v4u* xp_ = (const LAS v4u*)(wl + GA_XQ + ((eb[ST][QD] >> 14) & 3u) * 1024 + l16 * 64); int d_ = 0; \
                _Pragma("unroll") for (int k_ = 0; k_ < 4; ++k_) { const v4u x_ = xp_[k_], r_ = rb[ST][QD][k_]; \
                    d_ = __builtin_amdgcn_sdot4((int)x_.x, (int)r_.x, d_, false); d_ = __builtin_amdgcn_sdot4((int)x_.y, (int)r_.y, d_, false); \
                    d_ = __builtin_amdgcn_sdot4((int)x_.z, (int)r_.z, d_, false); d_ = __builtin_amdgcn_sdot4((int)x_.w, (int)r_.w, d_, false); } \
                d_ += dppi<0xB1>(d_); d_ += dppi<0x4E>(d_); d_ += dppi<0x141>(d_); d_ += dppi<0x140>(d_); \
                if (l16 == 0) hbuf[(Q_) * 4 + grp] = d_; } while (0)
            GA_ULOAD(0, 0, 0); GA_ULOAD(0, 1, 1);
            for (int q2 = 0; q2 < 128; q2 += 4) {
                GA_ULOAD(1, 0, q2 + 2); GA_ULOAD(1, 1, q2 + 3);
                __builtin_amdgcn_sched_barrier(0);
                GA_UDOT(0, 0, q2); GA_UDOT(0, 1, q2 + 1);
                __builtin_amdgcn_sched_barrier(0);
                if (q2 + 4 < 128) { GA_ULOAD(0, 0, q2 + 4); GA_ULOAD(0, 1, q2 + 5); }
                __builtin_amdgcn_sched_barrier(0);
                GA_UDOT(1, 0, q2 + 2); GA_UDOT(1, 1, q2 + 3);
                __builtin_amdgcn_sched_barrier(0);
            }
#undef GA_ULOAD
#undef GA_UDOT
            asm volatile("s_waitcnt lgkmcnt(0)" ::: "memory");
#pragma unroll 2
            for (int it = 0; it < 8; ++it) { const int p = it * 64 + lane;
                const unsigned e_ = ents[p]; const float g_ = *(const LAS float*)(wl + 2048 + p * 4); const int hs = hbuf[p];
                const int ex_ = (int)(e_ & (NEXP - 1)), tk_ = (int)(e_ >> 14) & 3;
                const float sxl = tk_ == 0 ? sx[0] : (tk_ == 1 ? sx[1] : (tk_ == 2 ? sx[2] : sx[3]));
                const float h_ = (float)hs * (SU[ex_] * sxl);
                act[p] = 0.5f * h_ * (1.f + erff(h_ * 0.70710678118654752f)) * g_ * SV[ex_]; }
        }
        asm volatile("s_waitcnt lgkmcnt(0)" ::: "memory");
        float y[4][16];
#pragma unroll
        for (int tk = 0; tk < 4; ++tk) {
#pragma unroll
            for (int i = 0; i < 16; ++i) y[tk][i] = 0.f; }
#define GA_AXPY(V, A, TK) do { \
            _Pragma("unroll") for (int q_ = 0; q_ < 4; ++q_) { const int w_ = (int)(V)[q_]; const f32x2 lo_ = __builtin_amdgcn_cvt_pk_f32_fp8(w_, false), hi_ = __builtin_amdgcn_cvt_pk_f32_fp8(w_, true); \
                y[TK][4 * q_] += (A) * lo_.x; y[TK][4 * q_ + 1] += (A) * lo_.y; y[TK][4 * q_ + 2] += (A) * hi_.x; y[TK][4 * q_ + 3] += (A) * hi_.y; } } while (0)
        for (int ch = 0; ch < 8; ++ch) {
            const unsigned ent = *(const LAS unsigned*)(wl + (ch * 64 + lane) * 4);
            const float areg = act[ch * 64 + lane];
            v4u vb[2][8]; int eb[2][8];
#pragma unroll
            for (int q = 0; q < 8; ++q) { eb[0][q] = __builtin_amdgcn_readlane((int)ent, q); vb[0][q] = *(const GAS v4u*)(VQ + (size_t)(eb[0][q] & (NEXP - 1)) * DM + lane * 16); }
#pragma unroll
            for (int jb = 0; jb < 8; ++jb) {
                if (jb + 1 < 8) {
#pragma unroll
                    for (int q = 0; q < 8; ++q) { eb[(jb + 1) & 1][q] = __builtin_amdgcn_readlane((int)ent, 8 * (jb + 1) + q); vb[(jb + 1) & 1][q] = *(const GAS v4u*)(VQ + (size_t)(eb[(jb + 1) & 1][q] & (NEXP - 1)) * DM + lane * 16); } }
                __builtin_amdgcn_sched_barrier(0);
#pragma unroll
                for (int q = 0; q < 8; ++q) { const int tk_ = (eb[jb & 1][q] >> 14) & 3; const v4u v_ = vb[jb & 1][q]; const float a_ = rdlane(areg, 8 * jb + q);
                    if (tk_ == 0) GA_AXPY(v_, a_, 0); else if (tk_ == 1) GA_AXPY(v_, a_, 1); else if (tk_ == 2) GA_AXPY(v_, a_, 2); else GA_AXPY(v_, a_, 3); }
                __builtin_amdgcn_sched_barrier(0);
            }
        }
#undef GA_AXPY
#pragma unroll
        for (int tk = 0; tk < 4; ++tk) {
            float* hrow = F.out + (size_t)(4 * tg + tk) * DM + lane * 16;
            float hv[16]; float ss = 0.f;
#pragma unroll
            for (int q = 0; q < 4; ++q) { const f32x4 h4 = *(const GAS f32x4*)(hrow + 4 * q);
#pragma unroll
                for (int i = 0; i < 4; ++i) { const float v = h4[i] + y[tk][4 * q + i]; hv[4 * q + i] = v; ss += v * v; } }
            const float rstd = frsq(wave_sum(ss) * (1.f / DM) + RMS_EPS);
#pragma unroll
            for (int q = 0; q < 4; ++q) { const f32x4 n4 = *(const GAS f32x4*)(nf + lane * 16 + 4 * q);
                *(GAS f32x4*)(outp + (size_t)(4 * tg + tk) * DM + lane * 16 + 4 * q) = (f32x4){hv[4 * q] * rstd * n4[0], hv[4 * q + 1] * rstd * n4[1], hv[4 * q + 2] * rstd * n4[2], hv[4 * q + 3] * rstd * n4[3]}; }
        }
    }
}

struct Args { const float* in[21]; float* out; unsigned char* ws; int ph_lo, ph_hi; };
static_assert(sizeof(Args) == 21 * 8 + 8 + 8 + 8, "Args has no padding");

__global__ void __launch_bounds__(NTHREADS, 2) fwd_kernel(Args args) {
    extern __shared__ __attribute__((aligned(16))) unsigned char lds[];
    Frame F;
    F.lds = (LAS unsigned char*)lds;
    F.MISC = (volatile LAS unsigned*)(F.lds + MISC_OFF);
    F.tid = threadIdx.x; F.lane = F.tid & 63; F.wave = __builtin_amdgcn_readfirstlane(F.tid >> 6);
    F.G = gridDim.x; F.wg = blockIdx.x;
#pragma unroll
    for (int i = 0; i < 21; ++i) F.in[i] = args.in[i];
    F.out = args.out; F.ws = args.ws;
    F.ctl = (gu32*)(args.ws + WS_CTL);
    for (int u = F.tid; u < (LDS_BYTES - LDSCTL_OFF) / 4; u += NTHREADS) ((LAS unsigned*)(F.lds + LDSCTL_OFF))[u] = 0u;
    __syncthreads();
    const int lo = args.ph_lo, hi = args.ph_hi;
    const bool fused = (hi - lo) > 1;
    XcdBarrier bar; bar.bar = (unsigned*)(F.ctl + CW_BAR); bar.x = 0; bar.st = nullptr;
    if (fused) bar = xcd_barrier_post((unsigned*)(F.ctl + CW_BAR), F.MISC + 8);
#define IN(k) (lo <= (k) && (k) < hi)
#define REPS(k) (((REP_MASK >> (k)) & 1) ? 2 : 1)
#define REPLOOP(k) for (int rep_ = 0; rep_ < REPS(k); ++rep_, (rep_ < REPS(k) ? xcd_barrier(bar) : (void)0))
#define SEAM(k) do { if (IN(k) && IN((k) + 1)) xcd_barrier(bar); } while (0)

    if (IN(0)) { REPLOOP(0) { p0_prologue(F); p0_rope_table(F); } SEAM(0); }
    if (IN(1)) { REPLOOP(1) {
        pg8::Gemm g{(const bf16*)(F.ws + WS_XN), (const bf16*)(F.ws + WS_WIN), T, IN_COLS, DM}; pg8::StaticOrder S; S.init(T, IN_COLS, F.G, F.wg);
        pg8::EpiBf16 E{(bf16*)(F.ws + WS_Z), IN_COLS};
        pg8::gemm_phase<pg8::EpiBf16, pg8::StaticOrder, true, true>(F.lds + RING_OFF, g, S, E); }
        {
            const int nwg = (T / 256) * (IN_COLS / 256), rem = nwg % F.G;
            if (rem == 0) quantize_tables(F, F.wg * NWAVES + F.wave, F.G * NWAVES);
            else if (F.wg >= rem) quantize_tables(F, (F.wg - rem) * NWAVES + F.wave, (F.G - rem) * NWAVES);
        }
        SEAM(1);
    }
    if (IN(2)) { p2_rope(F); REPLOOP(2) { const int cnt = r13_count(F.wg, F.G); R1Pre P;
            if (cnt > 0) rwkv_r1_prefetch(F, r13_item(F.wg, F.G, 0), F.tid, P);
            bf16x8 bfr[4]; int hcur = -1;
            f32x4 cst[4];
            { const int n16 = F.lane & 15, g = F.lane >> 4;
#pragma unroll
              for (int rt = 0; rt < 4; ++rt)
#pragma unroll
                  for (int q = 0; q < 4; ++q) cst[rt][q] = (F.wave < 4 && 16 * rt + 4 * g + q == 16 * F.wave + n16) ? 1.f : 0.f; }
            for (int i = 0; i < cnt; ++i) { const int it = r13_item(F.wg, F.G, i), hh_ = (it >> 7) & 7;
                if (hh_ != hcur) { r1_load_bfrag(F, hh_, F.wave, F.lane, bfr); hcur = hh_; }
                rwkv_r1_item(F, it, i + 1 < cnt ? r13_item(F.wg, F.G, i + 1) : -1, P, bfr, cst); }
            { const int n16 = F.lane & 15, g = F.lane >> 4; float* Pg = (float*)(F.ws + WS_PQ) + (size_t)F.wg * 4096; float* Qg = Pg + (size_t)256 * 4096;
              if (F.wave < 4) {
#pragma unroll
                  for (int rt = 0; rt < 4; ++rt)
#pragma unroll
                      for (int q = 0; q < 4; ++q) Pg[(16 * rt + 4 * g + q) * 64 + 16 * F.wave + n16] = cst[rt][q];
              } else {
#pragma unroll
                  for (int rt = 0; rt < 4; ++rt) *(GAS f32x4*)(Qg + (16 * (F.wave - 4) + n16) * 64 + 16 * rt + 4 * g) = cst[rt];
              } } }
        SEAM(2); }
    if (IN(3)) { REPLOOP(3) p3_mixers(F); SEAM(3); }
    if (IN(4)) { REPLOOP(4) { const int cnt = r13_count(F.wg, F.G); R3Pre P;
            {
                const int item0 = r13_item(F.wg, F.G, 0);
                rwkv_scan<15, 7>(F, F.out + (size_t)item0 * 4096, F.out + (size_t)T * RWW + (size_t)item0 * 4096, (float*)(F.ws + WS_RWSS) + (size_t)item0 * 4096, (const float*)(F.ws + WS_SSEG) + (size_t)F.wg * 4096);
                asm volatile("s_waitcnt vmcnt(0)" ::: "memory"); __syncthreads();
            }
            if (cnt > 0) rwkv_r3_prefetch(F, r13_item(F.wg, F.G, 0), F.tid, P);
            bf16x8 bfr[8]; int hcur = -1;
            for (int i = 0; i < cnt; ++i) { const int it = r13_item(F.wg, F.G, i), hh_ = (it >> 7) & 7;
                if (hh_ != hcur) { r3_load_bfrag(F, hh_, F.wave, F.lane, bfr); hcur = hh_; }
                rwkv_r3_item(F, it, i + 1 < cnt ? r13_item(F.wg, F.G, i + 1) : -1, P, bfr); } }
        SEAM(4); }
    if (IN(5)) {
        pg8::Gemm g{(const bf16*)(F.ws + WS_YMIX), (const bf16*)(F.ws + WS_WOUT), T, DM, DM}; pg8::StaticOrder S; S.init(T, DM, F.G, F.wg);
        pg8::EpiF32Res E{F.in[0], F.out, DM, (bf16*)(F.ws + WS_XN), F.in[15], (float*)(F.ws + WS_SSQ)};
        pg8::gemm_phase<pg8::EpiF32Res, pg8::StaticOrder, true, true>(F.lds + RING_OFF, g, S, E);
        SEAM(5);
    }
    if (IN(6)) { REPLOOP(6) {
        pg8::Gemm g{(const bf16*)(F.ws + WS_XN), (const bf16*)(F.ws + WS_WQ), T, PQ, DM}; pg8::StaticOrder S; S.init(T, PQ, F.G, F.wg);
        pg8::EpiBf16Rs E{(bf16*)(F.ws + WS_QP), PQ, (const float*)(F.ws + WS_SSQ)};
        pg8::gemm_phase<pg8::EpiBf16Rs, pg8::StaticOrder, true, true>(F.lds + RING_OFF, g, S, E); }
        SEAM(6);
    }
    if (IN(7)) { REPLOOP(7) p7_topk(F); SEAM(7); }
    if (IN(8)) { if (REPS(8) > 1) { p8_gather(F, (float*)(F.ws + WS_Z)); xcd_barrier(bar); } p8_gather(F, F.out); }
#undef IN
#undef SEAM
}

extern "C" void kernel_launch(void* const* d_in, const int* in_sizes, int n_in, void* d_out, int out_size, void* d_ws, size_t ws_size, hipStream_t stream) {
    static int grid = 0;
    if (grid == 0) {
        if (n_in != 21 || in_sizes[0] != T * DM || out_size != T * DM || ws_size < WS_END) {
            fprintf(stderr, "kernel_launch: unexpected shapes: n_in %d in0 %d out %d ws %zu (need %zu); nothing launched\n", n_in, n_in > 0 ? in_sizes[0] : -1, out_size, ws_size, (size_t)WS_END); grid = -1; return; }
        int dev = 0, cus = 0, per_cu = 0;
        if (hipGetDevice(&dev) != hipSuccess || hipDeviceGetAttribute(&cus, hipDeviceAttributeMultiprocessorCount, dev) != hipSuccess) { grid = -1; return; }
        if (hipFuncSetAttribute((const void*)fwd_kernel, hipFuncAttributeMaxDynamicSharedMemorySize, LDS_BYTES) != hipSuccess) { fprintf(stderr, "kernel_launch: hipFuncSetAttribute failed\n"); grid = -1; return; }
        if (hipOccupancyMaxActiveBlocksPerMultiprocessor(&per_cu, (const void*)fwd_kernel, NTHREADS, LDS_BYTES) != hipSuccess || per_cu < 1) { fprintf(stderr, "kernel_launch: occupancy query says %d\n", per_cu); per_cu = 1; }
        (void)hipGetLastError();
        grid = cus;
        if (cus != 256) { fprintf(stderr, "kernel_launch: the RWKV segment mapping assumes 256 CUs (got %d); nothing launched\n", cus); grid = -1; return; }
    }
    if (grid < 0) return;
    (void)hipMemsetAsync((char*)d_ws + WS_CTL, 0, CTL_ZERO_BYTES, stream);
    Args a{};
    for (int i = 0; i < 21; ++i) a.in[i] = (const float*)d_in[i];
    a.out = (float*)d_out; a.ws = (unsigned char*)d_ws;
    if (MK_N_LAUNCHES == 1) {
        a.ph_lo = 0; a.ph_hi = NPHASE;
        void* kargs[] = {&a};
        hipError_t e = hipLaunchCooperativeKernel((const void*)fwd_kernel, dim3(grid), dim3(NTHREADS), kargs, LDS_BYTES, stream);
        if (e != hipSuccess) fprintf(stderr, "kernel_launch: cooperative launch failed: %s (grid %d)\n", hipGetErrorString(e), grid);
    } else {
        for (int p = 0; p < NPHASE; ++p) { a.ph_lo = p; a.ph_hi = p + 1;
            hipLaunchKernelGGL(fwd_kernel, dim3(grid), dim3(NTHREADS), LDS_BYTES, stream, a); }
    }
}
```

```cpp
#include <hip/hip_runtime.h>
#include <cstdio>
#include <cstdint>

#ifndef MK_N_LAUNCHES
#define MK_N_LAUNCHES 1
#endif

#ifndef REP_MASK
#define REP_MASK 0
#endif
#define GAS __attribute__((address_space(1)))
#define LAS __attribute__((address_space(3)))
typedef unsigned short bf16;
typedef unsigned v4u __attribute__((ext_vector_type(4)));
typedef unsigned v2u __attribute__((ext_vector_type(2)));
typedef float f32x4 __attribute__((ext_vector_type(4)));
typedef float f32x2 __attribute__((ext_vector_type(2)));
typedef short bf16x8 __attribute__((ext_vector_type(8)));
typedef GAS unsigned gu32;
#define RLX_AGENT __ATOMIC_RELAXED, __HIP_MEMORY_SCOPE_AGENT
#define LDS_WAIT() asm volatile("s_waitcnt lgkmcnt(0)" ::: "memory")
#define VM_WAIT() asm volatile("s_waitcnt vmcnt(0)" ::: "memory")
#define LDS_BARRIER() do { asm volatile("s_waitcnt lgkmcnt(0)" ::: "memory"); __builtin_amdgcn_s_barrier(); asm volatile("" ::: "memory"); } while (0)

constexpr int DM = 1024, NB = 4, SEQ = 8192, T = NB * SEQ;
constexpr int HD = 64, RWW = 512, NHR = 8, NHA = 8;
constexpr int IN_COLS = 3328;
constexpr int C_R = 0, C_K = 512, C_V = 1024, C_WD = 1536, C_AD = 1600, C_GD = 1664, C_AQ = 1792, C_AK = 2304, C_AV = 2816;
constexpr int PHEADS = 8, NKEYS = 128, PQ = 2048, TOPK = 16, NEXP = 16384;
constexpr float RMS_EPS = 1e-6f, GN_EPS = 64e-5f;
constexpr int NWAVES = 8, NTHREADS = 512;
constexpr int NPHASE = 9;

constexpr size_t MiB = 1u << 20;
constexpr size_t WS_CTL = 0, CTL_ZERO_BYTES = 1 * MiB;
constexpr size_t WS_WIN = 2 * MiB;
constexpr size_t WS_WOUT = 10 * MiB;
constexpr size_t WS_WQ = 12 * MiB;
constexpr size_t WS_XN = 16 * MiB;
constexpr size_t WS_Z = 80 * MiB;
constexpr size_t WS_QP = 80 * MiB;
constexpr size_t WS_G = 288 * MiB;
constexpr size_t WS_YMIX = 352 * MiB;
constexpr size_t WS_UQ = 416 * MiB;
constexpr size_t WS_VQ = 432 * MiB;
constexpr size_t WS_SU = 448 * MiB;
constexpr size_t WS_SV = 449 * MiB;
constexpr size_t WS_EID = 480 * MiB;
constexpr size_t WS_GATE = 496 * MiB;
constexpr size_t WS_SSEG = 450 * MiB;
constexpr size_t WS_PQ = 456 * MiB;
constexpr size_t WS_END = 512 * MiB;
constexpr size_t WS_WUPT = 1 * MiB, WS_AUPT = WS_WUPT + 65536, WS_GUPT = WS_AUPT + 65536;
constexpr size_t WS_BONUS = 9 * MiB;
constexpr size_t WS_RWY0 = WS_XN;
constexpr size_t WS_RWSS = WS_G;
constexpr size_t WS_RWRH = WS_EID;

constexpr int CW_BAR = 4096;
constexpr size_t WS_SSQ = 256 * 1024;

typedef __bf16 hbf16x2_t __attribute__((ext_vector_type(2)));
__device__ __forceinline__ unsigned pk2(float lo, float hi) { const f32x2 v = {lo, hi}; const hbf16x2_t b = __builtin_convertvector(v, hbf16x2_t); return __builtin_bit_cast(unsigned, b); }
__device__ __forceinline__ unsigned f2bf(float f) { return pk2(f, 0.f) & 0xffffu; }
__device__ __forceinline__ float frcp(float x) { return __builtin_amdgcn_rcpf(x); }
__device__ __forceinline__ float frsq(float x) { return __builtin_amdgcn_rsqf(x); }
__device__ __forceinline__ float bflo(unsigned u) { return __builtin_bit_cast(float, u << 16); }
__device__ __forceinline__ float bfhi(unsigned u) { return __builtin_bit_cast(float, u & 0xffff0000u); }
__device__ __forceinline__ float bf2f(bf16 h) { return __builtin_bit_cast(float, (unsigned)h << 16); }

template <int CTRL> __device__ __forceinline__ float dppf(float x) { return __builtin_bit_cast(float, __builtin_amdgcn_update_dpp(0, __builtin_bit_cast(int, x), CTRL, 0xF, 0xF, true)); }
template <int CTRL> __device__ __forceinline__ int dppi(int x) { return __builtin_amdgcn_update_dpp(0, x, CTRL, 0xF, 0xF, true); }
__device__ __forceinline__ float rdlane(float v, int l) { return __builtin_bit_cast(float, __builtin_amdgcn_readlane(__builtin_bit_cast(int, v), l)); }
__device__ __forceinline__ float sum8(float v) { v += dppf<0xB1>(v); v += dppf<0x4E>(v); v += dppf<0x141>(v); return v; }
__device__ __forceinline__ float sum16(float v) { v = sum8(v); v += dppf<0x140>(v); return v; }
__device__ __forceinline__ float wave_sum(float v) { v = sum16(v);
    v += __builtin_bit_cast(float, __builtin_amdgcn_update_dpp(0, __builtin_bit_cast(int, v), 0x142, 0xA, 0xF, false));
    v += __builtin_bit_cast(float, __builtin_amdgcn_update_dpp(0, __builtin_bit_cast(int, v), 0x143, 0xC, 0xF, false));
    return rdlane(v, 63); }
__device__ __forceinline__ float wave_max(float v) {
    v = fmaxf(v, dppf<0xB1>(v)); v = fmaxf(v, dppf<0x4E>(v)); v = fmaxf(v, dppf<0x141>(v)); v = fmaxf(v, dppf<0x140>(v));
    return fmaxf(fmaxf(rdlane(v, 0), rdlane(v, 16)), fmaxf(rdlane(v, 32), rdlane(v, 48)));
}
__device__ __forceinline__ int wave_min_i(int v) {
    v = min(v, dppi<0xB1>(v)); v = min(v, dppi<0x4E>(v)); v = min(v, dppi<0x141>(v)); v = min(v, dppi<0x140>(v));
    return min(min(__builtin_amdgcn_readlane(v, 0), __builtin_amdgcn_readlane(v, 16)), min(__builtin_amdgcn_readlane(v, 32), __builtin_amdgcn_readlane(v, 48)));
}

namespace pg8 {
#define PG8_LAS __attribute__((address_space(3)))
typedef unsigned short bf16_t;
typedef unsigned u32x4 __attribute__((ext_vector_type(4)));
constexpr int BM = 256, BK = 64, HALF = 128, HTB = HALF * BK * 2, STAGE_BYTES = 8 * HTB, NXCD = 8, WGM = 8;
__host__ __device__ __forceinline__ int lds_byte(int r, int c) { const int st = (r >> 4) * 2 + (c >> 5), rr = r & 15, cc = c & 31, ob = rr * 64 + cc * 2; return st * 1024 + (ob ^ (((ob >> 9) & 1) << 5)); }
__host__ __device__ __forceinline__ void stage_rc(int b, int& R, int& C) { const int st = b / 1024, sb = b % 1024, swz = sb ^ (((sb >> 9) & 1) << 5); R = (st >> 1) * 16 + swz / 64; C = (st & 1) * 32 + (swz % 64) / 2; }
__host__ __device__ __forceinline__ int perm32(int rho) { const int n = rho >> 4, i = rho & 15; return 8 * (i >> 2) + 4 * n + (i & 3); }
struct Unit { int pm, pn; };
struct Gemm { const bf16_t* A; const bf16_t* Bt; int M, N, K; };
struct StaticOrder {
    int nM, nN, nwg, G, c;
    __host__ __device__ void init(int M, int N, int G_, int c_) { nM = M / BM; nN = N / BM; nwg = nM * nN; G = G_; c = c_; }
    __host__ __device__ bool next(int i, Unit& u) const {
        const long L = (long)i * G + c; if (L >= nwg) return false;
        int wgid = (int)L; { const int q = nwg / NXCD, r = nwg % NXCD, xcd = wgid % NXCD, off = wgid / NXCD; wgid = (xcd < r ? xcd * (q + 1) : r * (q + 1) + (xcd - r) * q) + off; }
        const int nig = WGM * nN, gid = wgid / nig, fm = gid * WGM, gsz = (nM - fm) < WGM ? (nM - fm) : WGM;
        u.pm = fm + ((wgid % nig) % gsz); u.pn = (wgid % nig) / gsz; return true;
    }
    __device__ __forceinline__ void a_ready(const Unit&) const {}
    __device__ __forceinline__ void done(const Unit&) const {}
};
__device__ __forceinline__ unsigned cvt_pk_bf16(float lo, float hi) { unsigned r; asm volatile("v_cvt_pk_bf16_f32 %0, %1, %2" : "=v"(r) : "v"(lo), "v"(hi)); return r; }
struct EpiBf16 {
    static constexpr bool PERM = true, AFTER_DRAIN = false;
    bf16_t* O; int ldc;
    __device__ __forceinline__ void operator()(const f32x4 (&acc)[2][2][4][2], const Unit& u, int wr, int wc, int fr, int fq) const {
        const int row0 = u.pm * BM + wr * 64 + fr; const int col0 = u.pn * BM + wc * 32 + 8 * fq;
#pragma unroll
        for (int ai = 0; ai < 2; ++ai)
#pragma unroll
            for (int m = 0; m < 4; ++m) { bf16_t* rowp = O + (size_t)(row0 + ai * HALF + m * 16) * ldc + col0;
#pragma unroll
                for (int bj = 0; bj < 2; ++bj) { const f32x4 v0 = acc[ai][bj][m][0], v1 = acc[ai][bj][m][1];
                    u32x4 w; w.x = cvt_pk_bf16(v0[0], v0[1]); w.y = cvt_pk_bf16(v0[2], v0[3]); w.z = cvt_pk_bf16(v1[0], v1[1]); w.w = cvt_pk_bf16(v1[2], v1[3]);
                    *(u32x4*)(rowp + bj * HALF) = w; } }
    }
};
struct EpiF32Res {
    static constexpr bool PERM = true, AFTER_DRAIN = false;
    const float* res; float* O; int ldc; bf16_t* HG; const float* gain; float* ssq;
    __device__ __forceinline__ void operator()(const f32x4 (&acc)[2][2][4][2], const Unit& u, int wr, int wc, int fr, int fq) const {
        const int row0 = u.pm * BM + wr * 64 + fr; const int col0 = u.pn * BM + wc * 32 + 8 * fq;
        f32x4 gv[2][2];
#pragma unroll
        for (int bj = 0; bj < 2; ++bj) { gv[bj][0] = *(const f32x4*)(gain + col0 + bj * HALF); gv[bj][1] = *(const f32x4*)(gain + col0 + bj * HALF + 4); }
#pragma unroll
        for (int ai = 0; ai < 2; ++ai)
#pragma unroll
            for (int m = 0; m < 4; ++m) { const int row = row0 + ai * HALF + m * 16; const size_t off = (size_t)row * ldc + col0; float sq = 0.f;
#pragma unroll
                for (int bj = 0; bj < 2; ++bj) { const f32x4 r0 = *(const f32x4*)(res + off + bj * HALF), r1 = *(const f32x4*)(res + off + bj * HALF + 4);
                    const f32x4 h0 = acc[ai][bj][m][0] + r0, h1 = acc[ai][bj][m][1] + r1;
                    *(f32x4*)(O + off + bj * HALF) = h0; *(f32x4*)(O + off + bj * HALF + 4) = h1;
                    sq += (h0[0] * h0[0] + h0[1] * h0[1]) + (h0[2] * h0[2] + h0[3] * h0[3]) + (h1[0] * h1[0] + h1[1] * h1[1]) + (h1[2] * h1[2] + h1[3] * h1[3]);
                    const f32x4 g0 = gv[bj][0], g1 = gv[bj][1];
                    u32x4 w; w.x = cvt_pk_bf16(h0[0] * g0[0], h0[1] * g0[1]); w.y = cvt_pk_bf16(h0[2] * g0[2], h0[3] * g0[3]); w.z = cvt_pk_bf16(h1[0] * g1[0], h1[1] * g1[1]); w.w = cvt_pk_bf16(h1[2] * g1[2], h1[3] * g1[3]);
                    *(u32x4*)(HG + off + bj * HALF) = w; }
                sq += __shfl_xor(sq, 16); sq += __shfl_xor(sq, 32);
                if (fq == 0) atomicAdd(ssq + row, sq); }
    }
};
struct EpiBf16Rs {
    static constexpr bool PERM = true, AFTER_DRAIN = false;
    bf16_t* O; int ldc; const float* ssq;
    __device__ __forceinline__ void operator()(const f32x4 (&acc)[2][2][4][2], const Unit& u, int wr, int wc, int fr, int fq) const {
        const int row0 = u.pm * BM + wr * 64 + fr; const int col0 = u.pn * BM + wc * 32 + 8 * fq;
#pragma unroll
        for (int ai = 0; ai < 2; ++ai)
#pragma unroll
            for (int m = 0; m < 4; ++m) { const int row = row0 + ai * HALF + m * 16; bf16_t* rowp = O + (size_t)row * ldc + col0;
                const float rs = __builtin_amdgcn_rsqf(ssq[row] * (1.f / 1024.f) + 1e-6f);
#pragma unroll
                for (int bj = 0; bj < 2; ++bj) { const f32x4 v0 = acc[ai][bj][m][0] * rs, v1 = acc[ai][bj][m][1] * rs;
                    u32x4 w; w.x = cvt_pk_bf16(v0[0], v0[1]); w.y = cvt_pk_bf16(v0[2], v0[3]); w.z = cvt_pk_bf16(v1[0], v1[1]); w.w = cvt_pk_bf16(v1[2], v1[3]);
                    *(u32x4*)(rowp + bj * HALF) = w; } }
    }
};

template <class Epi, class Sched, bool ALIGN_EPI = false, bool SP2 = false>
__device__ __forceinline__ void gemm_phase(PG8_LAS unsigned char* lds, const Gemm g, const Sched& S, const Epi& E) {
    const int tid = threadIdx.x, wid = __builtin_amdgcn_readfirstlane(tid >> 6), lane = tid & 63, wr = wid >> 2, wc = wid & 3, fr = lane & 15, fq = lane >> 4;
    const int K = g.K, nt = K / BK;
    unsigned voffA[2], voffB[2];
#pragma unroll
    for (int i = 0; i < 2; ++i) { int R, C; stage_rc(tid * 16 + i * 8192, R, C); const int Rb = Epi::PERM ? ((R & ~31) + perm32(R & 31)) : R;
        voffA[i] = (unsigned)(R * K + C) * 2u; voffB[i] = (unsigned)(Rb * K + C) * 2u; }
    const size_t kstep = (size_t)(BK * 2);
    const size_t hstep = (size_t)HALF * K * 2;
    const size_t tstep = 2 * hstep;
    const unsigned ldsw = (unsigned)wid * 1024u;
    const int aoff = lds_byte(wr * 64 + fr, fq * 8), boff = lds_byte(wc * 32 + fr, fq * 8);
#define PG8_SA(b, h) (((b) * 2 + (h)) * HTB)
#define PG8_SB(b, h) ((4 + (b) * 2 + (h)) * HTB)
#define PG8_STAGE(bufoff, gbase, voff) do { _Pragma("unroll") for (int _i = 0; _i < 2; ++_i) \
        __builtin_amdgcn_global_load_lds((const unsigned*)((const char*)(gbase) + (voff)[_i]), (PG8_LAS unsigned*)(lds + (bufoff) + ldsw + _i * 8192), 16, 0, 0); } while (0)
#define PG8_LDA(dst, b, h) do { _Pragma("unroll") for (int m = 0; m < 4; ++m) _Pragma("unroll") for (int k = 0; k < 2; ++k) dst[m][k] = *(const PG8_LAS bf16x8*)(lds + PG8_SA(b, h) + aoff + m * 2048 + k * 1024); } while (0)
#define PG8_LDB(dst, b, h) do { _Pragma("unroll") for (int n = 0; n < 2; ++n) _Pragma("unroll") for (int k = 0; k < 2; ++k) dst[n][k] = *(const PG8_LAS bf16x8*)(lds + PG8_SB(b, h) + boff + n * 2048 + k * 1024); } while (0)
#define PG8_MMA(ai, bj, At, Bt) do { __builtin_amdgcn_s_setprio(1); _Pragma("unroll") for (int m = 0; m < 4; ++m) _Pragma("unroll") for (int n = 0; n < 2; ++n) _Pragma("unroll") for (int k = 0; k < 2; ++k) \
        acc[ai][bj][m][n] = __builtin_amdgcn_mfma_f32_16x16x32_bf16(Bt[n][k], At[m][k], acc[ai][bj][m][n], 0, 0, 0); __builtin_amdgcn_s_setprio(0); } while (0)
#define PG8_WAIT_V(n) asm volatile("s_waitcnt vmcnt(" #n ")" ::: "memory")
#define PG8_WAIT_L(n) asm volatile("s_waitcnt lgkmcnt(" #n ")" ::: "memory")
#define PG8_BAR __builtin_amdgcn_s_barrier()
#define PG8_SCHED __builtin_amdgcn_sched_barrier(0)
    Unit cur, nxt; int ui = 0;
    if (!S.next(0, cur)) return;
    f32x4 acc[2][2][4][2];
#pragma unroll
    for (int a = 0; a < 2; ++a)
#pragma unroll
        for (int b = 0; b < 2; ++b)
#pragma unroll
            for (int m = 0; m < 4; ++m)
#pragma unroll
                for (int n = 0; n < 2; ++n) acc[a][b][m][n] = (f32x4){0.f, 0.f, 0.f, 0.f};
    bf16x8 At[4][2], B0[2][2], B1[2][2];
    const char* cA = (const char*)g.A + (size_t)cur.pm * tstep; const char* cB = (const char*)g.Bt + (size_t)cur.pn * tstep;
    S.a_ready(cur);
    if constexpr (SP2) {
        PG8_STAGE(PG8_SB(0, 0), cB, voffB); PG8_STAGE(PG8_SB(0, 1), cB + hstep, voffB); PG8_STAGE(PG8_SA(0, 0), cA, voffA); PG8_STAGE(PG8_SA(0, 1), cA + hstep, voffA);
        if (wr == 1) PG8_BAR;
        PG8_WAIT_V(2); PG8_BAR;
        PG8_STAGE(PG8_SB(1, 0), cB + kstep, voffB); PG8_STAGE(PG8_SA(1, 0), cA + kstep, voffA); PG8_STAGE(PG8_SB(1, 1), cB + hstep + kstep, voffB);
        PG8_WAIT_V(6); PG8_BAR;
    } else {
        PG8_STAGE(PG8_SB(0, 0), cB, voffB); PG8_STAGE(PG8_SA(0, 0), cA, voffA); PG8_STAGE(PG8_SB(0, 1), cB + hstep, voffB); PG8_STAGE(PG8_SA(0, 1), cA + hstep, voffA);
        if (wr == 1) PG8_BAR;
        PG8_WAIT_V(4); PG8_BAR;
        PG8_STAGE(PG8_SB(1, 0), cB + kstep, voffB); PG8_STAGE(PG8_SA(1, 0), cA + kstep, voffA); PG8_STAGE(PG8_SB(1, 1), cB + hstep + kstep, voffB);
        PG8_WAIT_V(6); PG8_BAR;
    }
    for (;;) {
        const bool has_next = S.next(ui + 1, nxt);
        const char* nA = has_next ? (const char*)g.A + (size_t)nxt.pm * tstep : cA; const char* nB = has_next ? (const char*)g.Bt + (size_t)nxt.pn * tstep : cB;
        for (int t = 0; t < nt; t += 2) {
            const bool last = (t == nt - 2);
            const char* a1 = cA + (size_t)(t + 1) * kstep;
            const char* a2 = last ? nA : cA + (size_t)(t + 2) * kstep; const char* b2 = last ? nB : cB + (size_t)(t + 2) * kstep;
            const char* a3 = a2 + kstep; const char* b3 = b2 + kstep;
            if (last && has_next) S.a_ready(nxt);
            if constexpr (SP2) {
            PG8_LDB(B0, 0, 0); PG8_LDB(B1, 0, 1); PG8_SCHED; PG8_LDA(At, 0, 0); PG8_STAGE(PG8_SA(1, 1), a1 + hstep, voffA);
            PG8_WAIT_V(8); PG8_WAIT_L(0); PG8_BAR; PG8_MMA(0, 0, At, B0); PG8_MMA(0, 1, At, B1); PG8_BAR; PG8_SCHED;
            PG8_LDA(At, 0, 1); PG8_STAGE(PG8_SB(0, 0), b2, voffB); PG8_STAGE(PG8_SB(0, 1), b2 + hstep, voffB); PG8_STAGE(PG8_SA(0, 0), a2, voffA);
            PG8_WAIT_V(8); PG8_WAIT_L(0); PG8_BAR; PG8_MMA(1, 0, At, B0); PG8_MMA(1, 1, At, B1); PG8_BAR; PG8_SCHED;
            PG8_LDB(B0, 1, 0); PG8_LDB(B1, 1, 1); PG8_SCHED; PG8_LDA(At, 1, 0); PG8_STAGE(PG8_SA(0, 1), a2 + hstep, voffA);
            PG8_WAIT_V(8); PG8_WAIT_L(0); PG8_BAR; PG8_MMA(0, 0, At, B0); PG8_MMA(0, 1, At, B1); PG8_BAR; PG8_SCHED;
            PG8_LDA(At, 1, 1); PG8_STAGE(PG8_SB(1, 0), b3, voffB); PG8_STAGE(PG8_SB(1, 1), b3 + hstep, voffB); PG8_STAGE(PG8_SA(1, 0), a3, voffA);
            PG8_WAIT_V(8); PG8_WAIT_L(0); PG8_BAR; PG8_MMA(1, 0, At, B0); PG8_MMA(1, 1, At, B1); PG8_BAR; PG8_SCHED;
            } else {
            PG8_LDB(B0, 0, 0); PG8_SCHED; PG8_LDA(At, 0, 0); PG8_STAGE(PG8_SA(1, 1), a1 + hstep, voffA);
            PG8_WAIT_L(8); PG8_BAR; PG8_WAIT_L(0); PG8_MMA(0, 0, At, B0); PG8_BAR; PG8_SCHED;
            PG8_LDB(B1, 0, 1); PG8_STAGE(PG8_SB(0, 0), b2, voffB);
            PG8_BAR; PG8_WAIT_L(0); PG8_MMA(0, 1, At, B1); PG8_BAR;
            PG8_LDA(At, 0, 1); PG8_STAGE(PG8_SA(0, 0), a2, voffA);
            PG8_BAR; PG8_WAIT_L(0); PG8_MMA(1, 0, At, B0); PG8_BAR; PG8_SCHED;
            PG8_STAGE(PG8_SB(0, 1), b2 + hstep, voffB);
            PG8_WAIT_V(6); PG8_BAR; PG8_MMA(1, 1, At, B1); PG8_BAR;
            PG8_LDB(B0, 1, 0); PG8_SCHED; PG8_LDA(At, 1, 0); PG8_STAGE(PG8_SA(0, 1), a2 + hstep, voffA);
            PG8_WAIT_L(8); PG8_BAR; PG8_WAIT_L(0); PG8_MMA(0, 0, At, B0); PG8_BAR; PG8_SCHED;
            PG8_LDB(B1, 1, 1); PG8_STAGE(PG8_SB(1, 0), b3, voffB);
            PG8_BAR; PG8_WAIT_L(0); PG8_MMA(0, 1, At, B1); PG8_BAR;
            PG8_LDA(At, 1, 1); PG8_STAGE(PG8_SA(1, 0), a3, voffA);
            PG8_BAR; PG8_WAIT_L(0); PG8_MMA(1, 0, At, B0); PG8_BAR; PG8_SCHED;
            PG8_STAGE(PG8_SB(1, 1), b3 + hstep, voffB);
            PG8_WAIT_V(6); PG8_BAR; PG8_MMA(1, 1, At, B1); PG8_BAR;
            }
        }
        if constexpr (ALIGN_EPI) { if (wr == 0) PG8_BAR; }
        if constexpr (!Epi::AFTER_DRAIN) { E(acc, cur, wr, wc, fr, fq); S.done(cur); }
        if (!has_next) break;
#pragma unroll
        for (int a = 0; a < 2; ++a)
#pragma unroll
            for (int b = 0; b < 2; ++b)
#pragma unroll
                for (int m = 0; m < 4; ++m)
#pragma unroll
                    for (int n = 0; n < 2; ++n) acc[a][b][m][n] = (f32x4){0.f, 0.f, 0.f, 0.f};
        cur = nxt; cA = nA; cB = nB; ++ui;
        if constexpr (ALIGN_EPI) { if (wr == 1) PG8_BAR; }
    }
    PG8_WAIT_V(0);
    if constexpr (!ALIGN_EPI) { if (wr == 0) PG8_BAR; }
    PG8_BAR;
#undef PG8_SA
#undef PG8_SB
#undef PG8_STAGE
#undef PG8_LDA
#undef PG8_LDB
#undef PG8_MMA
#undef PG8_WAIT_V
#undef PG8_WAIT_L
#undef PG8_BAR
#undef PG8_SCHED
}
}

#define XB_TMO      128
#define XB_XCNT(j)  (256  + 64 * (j))
#define XB_XSUB(j)  (1280 + 64 * (j))
#define XB_XGEN(j)  (2304 + 64 * (j))
#define XB_TOP      3328
#define XB_TOPGEN   3392
#define XCD_BAR_WORDS 3456
#define XB_SPIN_CAP (1u << 22)
__device__ __forceinline__ unsigned xb_ld(unsigned* p)              { return __hip_atomic_load(p, __ATOMIC_RELAXED, __HIP_MEMORY_SCOPE_AGENT); }
__device__ __forceinline__ unsigned xb_add(unsigned* p, unsigned v) { return __hip_atomic_fetch_add(p, v, __ATOMIC_RELAXED, __HIP_MEMORY_SCOPE_AGENT); }
__device__ __forceinline__ unsigned xb_xcc_id() { return (unsigned)__builtin_amdgcn_s_getreg((3 << 11) | 20) & 0xFu; }
#define XB_SPIN(cond, bar) do { unsigned _sp = 0; while (cond) { __builtin_amdgcn_s_sleep(1); \
    if ((++_sp & 255u) == 0u) { if (xb_ld(&(bar)[XB_TMO])) break; if (_sp > XB_SPIN_CAP) { atomicAdd(&(bar)[XB_TMO], 1u); break; } } } } while (0)
struct XcdBarrier { unsigned* bar; unsigned x; volatile LAS unsigned* st; };
__device__ __forceinline__ XcdBarrier xcd_barrier_post(unsigned* bar, volatile LAS unsigned* st) {
    XcdBarrier b; b.bar = bar; b.x = xb_xcc_id(); b.st = st;
    if (threadIdx.x == 0) (void)xb_add(&bar[XB_XCNT(b.x)], 1u);
    return b;
}
__device__ __forceinline__ void xcd_barrier_complete(unsigned* bar, unsigned x, unsigned& nloc, unsigned& nx) {
    const unsigned G = gridDim.x * gridDim.y * gridDim.z;
    unsigned sum, cnt, mine, sp = 0u;
    for (;;) {
        sum = 0u; cnt = 0u; mine = 0u;
#pragma unroll
        for (unsigned j = 0; j < 16; ++j) { const unsigned c = xb_ld(&bar[XB_XCNT(j)]); sum += c; cnt += (c > 0u) ? 1u : 0u; mine = (j == x) ? c : mine; }
        if (sum == G) break;
        __builtin_amdgcn_s_sleep(1);
        if ((++sp & 255u) == 0u) { if (xb_ld(&bar[XB_TMO])) break; if (sp > XB_SPIN_CAP) { atomicAdd(&bar[XB_TMO], 1u); break; } }
    }
    nloc = mine > 0u ? mine : 1u; nx = cnt > 0u ? cnt : 1u;
}
__device__ __forceinline__ void xcd_barrier(const XcdBarrier& b) {
    asm volatile("s_waitcnt vmcnt(0)" ::: "memory");
    __syncthreads();
    if (threadIdx.x == 0) {
        unsigned* bar = b.bar;
        __builtin_amdgcn_s_waitcnt(0);
        unsigned nloc = b.st[0], nx = b.st[1];
        if (nloc == 0u) { xcd_barrier_complete(bar, b.x, nloc, nx); b.st[0] = nloc; b.st[1] = nx; }
        const unsigned old = xb_add(&bar[XB_XSUB(b.x)], 1u);
        const unsigned gen = old / nloc;
        if (old + 1u == (gen + 1u) * nloc) {
            __builtin_amdgcn_fence(__ATOMIC_RELEASE, "agent");
            asm volatile("s_waitcnt vmcnt(0)" ::: "memory");
            const unsigned og = xb_add(&bar[XB_TOP], 1u);
            const unsigned tg = og / nx;
            if (og + 1u == (tg + 1u) * nx) xb_add(&bar[XB_TOPGEN], 1u);
            else XB_SPIN(xb_ld(&bar[XB_TOPGEN]) == tg, bar);
            __builtin_amdgcn_fence(__ATOMIC_ACQUIRE, "agent");
            xb_add(&bar[XB_XGEN(b.x)], 1u);
            asm volatile("s_waitcnt vmcnt(0)" ::: "memory");
        } else {
            XB_SPIN(xb_ld(&bar[XB_XGEN(b.x)]) == gen, bar);
            __builtin_amdgcn_fence(__ATOMIC_ACQUIRE, "agent");
            asm volatile("s_waitcnt vmcnt(0)" ::: "memory");
        }
    }
    __syncthreads();
}

constexpr int RING_OFF = 0, RING_BYTES = 131072;
constexpr int LDSCTL_OFF = 162816, MISC_OFF = LDSCTL_OFF + 320;
constexpr int LDS_BYTES = 163840;

struct Frame {
    LAS unsigned char* lds;
    volatile LAS unsigned* MISC;
    gu32* ctl;
    int tid, lane, wave, G, wg;
    const float* in[21];
    float* out;
    unsigned char* ws;
};

__device__ __forceinline__ void p0_transpose_item(const float* W, int K, int N, bf16* WT, LAS float* scr, int item, int lane) {
    const int nblk = N / 32, kb = item / nblk, nb = item % nblk, k0 = 64 * kb, n0 = 32 * nb;
#pragma unroll 8
    for (int i = 0; i < 32; ++i) { const int kk = 2 * i + (lane >> 5); scr[kk * 33 + (lane & 31)] = W[(size_t)(k0 + kk) * N + n0 + (lane & 31)]; }
    LDS_WAIT(); asm volatile("" ::: "memory");
    const int c = lane & 7;
#pragma unroll
    for (int j = 0; j < 4; ++j) { const int n = (lane >> 3) + 8 * j; const LAS float* s = scr + (8 * c) * 33 + n;
        v4u o; o.x = pk2(s[0 * 33], s[1 * 33]); o.y = pk2(s[2 * 33], s[3 * 33]); o.z = pk2(s[4 * 33], s[5 * 33]); o.w = pk2(s[6 * 33], s[7 * 33]);
        *(GAS v4u*)(WT + (size_t)(n0 + n) * K + k0 + 8 * c) = o; }
    LDS_WAIT(); asm volatile("" ::: "memory");
}
__device__ __forceinline__ void rms_row_to_bf16(int lane, const float* xrow, const float* gain, bf16* orow) {
    const GAS f32x4* xr = (const GAS f32x4*)xrow + lane;
    const GAS f32x4* gr = (const GAS f32x4*)gain + lane;
    f32x4 v[4]; float s = 0.f;
#pragma unroll
    for (int j = 0; j < 4; ++j) { v[j] = xr[64 * j]; s += (v[j].x * v[j].x + v[j].y * v[j].y) + (v[j].z * v[j].z + v[j].w * v[j].w); }
    const float rstd = frsq(wave_sum(s) * (1.f / DM) + RMS_EPS);
    GAS unsigned long long* o8 = (GAS unsigned long long*)orow + lane;
#pragma unroll
    for (int j = 0; j < 4; ++j) { const f32x4 gg = gr[64 * j];
        o8[64 * j] = (unsigned long long)pk2(v[j].x * rstd * gg.x, v[j].y * rstd * gg.y) | ((unsigned long long)pk2(v[j].z * rstd * gg.z, v[j].w * rstd * gg.w) << 32); }
}
__device__ __forceinline__ void cvt_row_to_bf16(int lane, const float* xrow, bf16* orow) {
    const GAS f32x4* xr = (const GAS f32x4*)xrow + lane;
    GAS unsigned long long* o8 = (GAS unsigned long long*)orow + lane;
#pragma unroll
    for (int j = 0; j < 4; ++j) { const f32x4 v = xr[64 * j]; o8[64 * j] = (unsigned long long)pk2(v.x, v.y) | ((unsigned long long)pk2(v.z, v.w) << 32); }
}
__device__ __forceinline__ void quantize_tables(Frame& F, int gw, int ngw);
__device__ __forceinline__ void p0_prologue(Frame& F) {
    LAS float* scr = (LAS float*)(F.lds + RING_OFF + F.wave * 16384);
    const int gw = F.wg * NWAVES + F.wave, NGW = F.G * NWAVES;
    constexpr int I_IN = (DM / 64) * (IN_COLS / 32), I_OUT = (DM / 64) * (DM / 32), I_Q = (DM / 64) * (PQ / 32);
    constexpr int NITEMS = I_IN + I_OUT + I_Q;
    bf16* win_t = (bf16*)(F.ws + WS_WIN); bf16* wout_t = (bf16*)(F.ws + WS_WOUT); bf16* wq_t = (bf16*)(F.ws + WS_WQ);
    for (int it = gw; it < NITEMS; it += NGW) {
        int r = it;
        if (r < I_IN) { p0_transpose_item(F.in[2], DM, IN_COLS, win_t, scr, r, F.lane); continue; } r -= I_IN;
        if (r < I_OUT) { p0_transpose_item(F.in[14], DM, DM, wout_t, scr, r, F.lane); continue; } r -= I_OUT;
        p0_transpose_item(F.in[16], DM, PQ, wq_t, scr, r, F.lane);
    }
    {
        constexpr int I_W = (64 / 64) * (RWW / 32), I_G = (128 / 64) * (RWW / 32);
        for (int it = gw; it < 2 * I_W + I_G; it += NGW) {
            int r = it;
            if (r < I_W) { p0_transpose_item(F.in[5], 64, RWW, (bf16*)(F.ws + WS_WUPT), scr, r, F.lane); continue; } r -= I_W;
            if (r < I_W) { p0_transpose_item(F.in[7], 64, RWW, (bf16*)(F.ws + WS_AUPT), scr, r, F.lane); continue; } r -= I_W;
            p0_transpose_item(F.in[8], 128, RWW, (bf16*)(F.ws + WS_GUPT), scr, r, F.lane);
        }
    }
    bf16* XN = (bf16*)(F.ws + WS_XN);
    for (int m = gw; m < T; m += NGW) rms_row_to_bf16(F.lane, F.in[0] + (size_t)m * DM, F.in[1], XN + (size_t)m * DM);
}

constexpr size_t WS_ROPE = WS_G;
__device__ __forceinline__ void p0_rope_table(Frame& F) {
    f32x2* tab = (f32x2*)(F.ws + WS_ROPE);
    for (int e = F.wg * NTHREADS + F.tid; e < SEQ * 32; e += F.G * NTHREADS) {
        const int sp = e >> 5, i = e & 31;
        const float inv_freq = powf(10000.0f, -(float)(2 * i) / 64.0f);
        const float ang = (float)sp * inv_freq;
        const double r = (double)ang - rint((double)ang * 0.15915494309189535) * 6.283185307179586;
        const float rf = (float)r;
        tab[e] = (f32x2){cosf(rf), sinf(rf)};
    }
}
__device__ __forceinline__ void p2_rope(Frame& F) {
    bf16* Z = (bf16*)(F.ws + WS_Z);
    const f32x2* tab = (const f32x2*)(F.ws + WS_ROPE);
    const int tid = F.tid, tk = tid >> 6, grp = (tid >> 2) & 15, i0 = (tid & 3) * 8;
    for (int blk = F.wg; blk < T / 8; blk += F.G) {
        const int g = blk * 8 + tk, sp = g & (SEQ - 1);
        bf16* p = Z + (size_t)g * IN_COLS + C_AQ + grp * 64 + i0;
        const v4u a = *(const GAS v4u*)p, b = *(const GAS v4u*)(p + 32);
        const GAS f32x4* tp = (const GAS f32x4*)(tab + sp * 32 + i0);
        float x1[8], x2[8];
        x1[0] = bflo(a.x); x1[1] = bfhi(a.x); x1[2] = bflo(a.y); x1[3] = bfhi(a.y); x1[4] = bflo(a.z); x1[5] = bfhi(a.z); x1[6] = bflo(a.w); x1[7] = bfhi(a.w);
        x2[0] = bflo(b.x); x2[1] = bfhi(b.x); x2[2] = bflo(b.y); x2[3] = bfhi(b.y); x2[4] = bflo(b.z); x2[5] = bfhi(b.z); x2[6] = bflo(b.w); x2[7] = bfhi(b.w);
        float o1[8], o2[8];
#pragma unroll
        for (int q = 0; q < 4; ++q) { const f32x4 cs = tp[q];
            o1[2 * q] = x1[2 * q] * cs[0] - x2[2 * q] * cs[1]; o2[2 * q] = x1[2 * q] * cs[1] + x2[2 * q] * cs[0];
            o1[2 * q + 1] = x1[2 * q + 1] * cs[2] - x2[2 * q + 1] * cs[3]; o2[2 * q + 1] = x1[2 * q + 1] * cs[3] + x2[2 * q + 1] * cs[2]; }
        v4u oa, ob; oa.x = pk2(o1[0], o1[1]); oa.y = pk2(o1[2], o1[3]); oa.z = pk2(o1[4], o1[5]); oa.w = pk2(o1[6], o1[7]);
        ob.x = pk2(o2[0], o2[1]); ob.y = pk2(o2[2], o2[3]); ob.z = pk2(o2[4], o2[5]); ob.w = pk2(o2[6], o2[7]);
        *(GAS v4u*)p = oa; *(GAS v4u*)(p + 32) = ob;
    }
}

typedef float f32x16 __attribute__((ext_vector_type(16)));
constexpr int SBS = 144;
constexpr int R1_EPRE = 0, R1_APRE = 16384, R1_AAB = 0, R1_X = 16384;
constexpr int R1_AT = 32768, R1_BT = 41984, R1_KT = 51200, R1_RT = 60416, R1_AHT = R1_BT, R1_U0T = R1_KT;
constexpr int R1_BBT = 69632, R1_KBT = 78848, R1_VT = 88064;
constexpr int R1_ACTW = 97280, R1_ACTA = 106496, R1_AAK = 97280, R1_ARB = 106496, R1_ARK = 115712;
constexpr int R1_BONUS = 124928, R1_WEND = 125184, R1_SEGS = 125440, R1_TII = 125440, R1_END = 129536;
static_assert(R1_END <= LDSCTL_OFF, "R1 LDS");
__device__ __forceinline__ int crow(int r, int hh) { return (r & 3) + 8 * (r >> 2) + 4 * hh; }
template <int KS> __device__ __forceinline__ f32x16 wtile(const LAS unsigned char* A, int sa, const LAS unsigned char* B, int sb, f32x16 acc, int lane) {
    const int row = lane & 31, hh = lane >> 5;
#pragma unroll
    for (int s = 0; s < KS; ++s) { const bf16x8 a = *(const LAS bf16x8*)(A + row * sa + 32 * s + 16 * hh); const bf16x8 b = *(const LAS bf16x8*)(B + row * sb + 32 * s + 16 * hh);
        acc = __builtin_amdgcn_mfma_f32_32x32x16_bf16(a, b, acc, 0, 0, 0); }
    return acc;
}
template <int KS> __device__ __forceinline__ f32x16 wtile_gb(const LAS unsigned char* A, int sa, const bf16* Bg, int ldb, f32x16 acc, int lane) {
    const int row = lane & 31, hh = lane >> 5;
#pragma unroll
    for (int s = 0; s < KS; ++s) { const bf16x8 a = *(const LAS bf16x8*)(A + row * sa + 32 * s + 16 * hh); const bf16x8 b = *(const GAS bf16x8*)(Bg + (size_t)row * ldb + 16 * s + 8 * hh);
        acc = __builtin_amdgcn_mfma_f32_32x32x16_bf16(a, b, acc, 0, 0, 0); }
    return acc;
}
__device__ __forceinline__ f32x16 zero16() { f32x16 z;
#pragma unroll
    for (int r = 0; r < 16; ++r) z[r] = 0.f;
    return z; }

struct R1Pre { v4u wd[2], ad[2], z[4]; };
__device__ __forceinline__ int r13_item(int wg, int G, int idx) { return (wg >> 3) * 128 + (wg & 7) * 16 + idx; }
__device__ __forceinline__ int r13_count(int wg, int G) { return 16; }
__device__ __forceinline__ void rwkv_r1_prefetch(Frame& F, int item, int tid, R1Pre& P) {
    const int chain = item >> 7, chunk = item & 127, b = chain >> 3, h = chain & 7, g0 = b * SEQ + chunk * 64;
    const bf16* Z = (const bf16*)(F.ws + WS_Z);
    const v4u z0 = (v4u){0u, 0u, 0u, 0u};
    { const int t = tid >> 3, cg = tid & 7; const bool first = (chunk == 0 && t == 0);
      const bf16* zr = Z + (size_t)(g0 + t) * IN_COLS;
      P.wd[0] = *(const GAS v4u*)(zr + C_WD + cg * 8); P.ad[0] = *(const GAS v4u*)(zr + C_AD + cg * 8);
      P.wd[1] = z0; P.ad[1] = z0;
      if (!first) { P.wd[1] = *(const GAS v4u*)(zr - IN_COLS + C_WD + cg * 8); P.ad[1] = *(const GAS v4u*)(zr - IN_COLS + C_AD + cg * 8); } }
#pragma unroll
    for (int q = 0; q < 4; ++q) { const int p = tid + 512 * q; P.z[q] = z0;
        if (p < 65 * 24) { const int row = p / 24, rem = p - row * 24, seg = rem >> 3, ch = rem & 7;
            if (!(chunk == 0 && row == 0)) P.z[q] = *(const GAS v4u*)(Z + (size_t)(g0 - 1 + row) * IN_COLS + seg * 512 + h * 64 + ch * 8); } }
}
constexpr int R1_ZS = R1_AT, R1_ZSS = 384;
static_assert(65 * R1_ZSS <= 4 * 9216, "ZS fits in the At..Rt region");
__device__ __forceinline__ void r1_load_bfrag(Frame& F, int h, int w, int lane, bf16x8 (&bf)[4]) {
    const int p = w >> 2, nt = w & 1; const bf16* upt = (const bf16*)(F.ws + (p == 0 ? WS_WUPT : WS_AUPT)) + (size_t)(h * 64 + nt * 32 + (lane & 31)) * 64 + 8 * (lane >> 5);
#pragma unroll
    for (int s2 = 0; s2 < 4; ++s2) bf[s2] = *(const GAS bf16x8*)(upt + 16 * s2);
}
constexpr int R1_CF = R1_AAB, R1_CN = R1_X;
__device__ __forceinline__ void rwkv_r1_item(Frame& F, int item, int next_item, R1Pre& P, const bf16x8 (&bfr)[4], f32x4 (&cst)[4]) {
    const int chain = item >> 7, chunk = item & 127, b = chain >> 3, h = chain & 7;
    const int g0 = b * SEQ + chunk * 64;
    int tid_ = F.tid; asm volatile("" : "+v"(tid_));
    const int tid = tid_, lane = tid & 63, w = __builtin_amdgcn_readfirstlane(tid >> 6), hh = lane >> 5, cl = lane & 31;
    const bf16* Z = (const bf16*)(F.ws + WS_Z);
    LAS unsigned char* lds = F.lds + RING_OFF;
    const float* mu = F.in[3];
    {
        const int t = tid >> 3, cg = tid & 7;
        const v4u cw = P.wd[0], ca = P.ad[0], pw = P.wd[1], pa = P.ad[1];
        float fw[8], fa[8], qw[8], qa[8];
        fw[0] = bflo(cw.x); fw[1] = bfhi(cw.x); fw[2] = bflo(cw.y); fw[3] = bfhi(cw.y); fw[4] = bflo(cw.z); fw[5] = bfhi(cw.z); fw[6] = bflo(cw.w); fw[7] = bfhi(cw.w);
        fa[0] = bflo(ca.x); fa[1] = bfhi(ca.x); fa[2] = bflo(ca.y); fa[3] = bfhi(ca.y); fa[4] = bflo(ca.z); fa[5] = bfhi(ca.z); fa[6] = bflo(ca.w); fa[7] = bfhi(ca.w);
        qw[0] = bflo(pw.x); qw[1] = bfhi(pw.x); qw[2] = bflo(pw.y); qw[3] = bfhi(pw.y); qw[4] = bflo(pw.z); qw[5] = bfhi(pw.z); qw[6] = bflo(pw.w); qw[7] = bfhi(pw.w);
        qa[0] = bflo(pa.x); qa[1] = bfhi(pa.x); qa[2] = bflo(pa.y); qa[3] = bfhi(pa.y); qa[4] = bflo(pa.z); qa[5] = bfhi(pa.z); qa[6] = bflo(pa.w); qa[7] = bfhi(pa.w);
#pragma unroll
        for (int j = 0; j < 8; ++j) { const int c = cg * 8 + j; const float xw = fw[j] + (qw[j] - fw[j]) * mu[C_WD + c];
            const float ex = __expf(2.f * xw); fw[j] = 1.f - 2.f * frcp(ex + 1.f);
            fa[j] = fa[j] + (qa[j] - fa[j]) * mu[C_AD + c]; }
        v4u ow, oa; ow.x = pk2(fw[0], fw[1]); ow.y = pk2(fw[2], fw[3]); ow.z = pk2(fw[4], fw[5]); ow.w = pk2(fw[6], fw[7]);
        oa.x = pk2(fa[0], fa[1]); oa.y = pk2(fa[2], fa[3]); oa.z = pk2(fa[4], fa[5]); oa.w = pk2(fa[6], fa[7]);
        *(LAS v4u*)(lds + R1_ACTW + t * SBS + cg * 16) = ow; *(LAS v4u*)(lds + R1_ACTA + t * SBS + cg * 16) = oa;
#pragma unroll
        for (int q = 0; q < 4; ++q) { const int p = tid + 512 * q;
            if (p < 65 * 24) { const int row = p / 24, rem = p - row * 24; *(LAS v4u*)(lds + R1_ZS + row * R1_ZSS + rem * 16) = P.z[q]; } }
        if (next_item >= 0) rwkv_r1_prefetch(F, next_item, tid, P);
    }
    LDS_BARRIER();
    {
        const int p = w >> 2, mt = (w >> 1) & 1, nt = w & 1;
        f32x16 acc = zero16();
        { const LAS unsigned char* A_ = lds + (p == 0 ? R1_ACTW : R1_ACTA) + mt * 32 * SBS + (lane & 31) * SBS + 16 * hh;
#pragma unroll
          for (int s2 = 0; s2 < 4; ++s2) acc = __builtin_amdgcn_mfma_f32_32x32x16_bf16(*(const LAS bf16x8*)(A_ + 32 * s2), bfr[s2], acc, 0, 0, 0); }
        LAS float* O = (LAS float*)(lds + (p == 0 ? R1_EPRE : R1_APRE));
#pragma unroll
        for (int r = 0; r < 16; ++r) O[(mt * 32 + crow(r, hh)) * 64 + nt * 32 + cl] = acc[r];
    }
    LDS_BARRIER();
    {
        const int c = tid & 63, ts = tid >> 6, col = h * 64 + c;
        const float mu_r = mu[C_R + col], mu_k = mu[C_K + col], mu_v = mu[C_V + col], kkc = F.in[9][col], kac = F.in[10][col], rkc = F.in[11][col], w0c = F.in[4][col], a0c = F.in[6][col];
        const LAS float* EP = (const LAS float*)(lds + R1_EPRE); const LAS float* AP = (const LAS float*)(lds + R1_APRE);
        LAS float* SEGS = (LAS float*)(lds + R1_SEGS); LAS float* BON = (LAS float*)(lds + R1_BONUS);
        const LAS bf16* zb = (const LAS bf16*)(lds + R1_ZS + (8 * ts) * R1_ZSS) + c;
        float pr = bf2f(zb[0]), pk = bf2f(zb[64]), pv = bf2f(zb[128]);
        float rr[8], k2[8], ai[8], bi[8], vv[8], ee[8], cs[8]; float run = 0.f;
#pragma unroll
        for (int i = 0; i < 8; ++i) {
            const float zr = bf2f(zb[(i + 1) * (R1_ZSS / 2)]), zk = bf2f(zb[(i + 1) * (R1_ZSS / 2) + 64]), zv = bf2f(zb[(i + 1) * (R1_ZSS / 2) + 128]);
            const float r = zr + (pr - zr) * mu_r, k = zk + (pk - zk) * mu_k, v = zv + (pv - zv) * mu_v; pr = zr; pk = zk; pv = zv;
            const float e = 0.60653066f * frcp(1.f + __expf(-(w0c + EP[(8 * ts + i) * 64 + c])));
            const float a = frcp(1.f + __expf(-(a0c + AP[(8 * ts + i) * 64 + c])));
            float kk = k * kkc; const float n2 = wave_sum(kk * kk); kk = kk * frsq(fmaxf(n2, 1e-24f));
            const float kq = k * (1.f + (a - 1.f) * kac);
            const float bon = wave_sum(r * kq * rkc); if (c == 0) BON[8 * ts + i] = bon;
            rr[i] = r; k2[i] = kq; ai[i] = -kk; bi[i] = kk * a; vv[i] = v; ee[i] = e; run += e; cs[i] = run;
        }
        SEGS[ts * 64 + c] = run;
        LDS_BARRIER();
        float off = 0.f, tot = 0.f;
#pragma unroll
        for (int q = 0; q < 8; ++q) { const float sv = SEGS[q * 64 + c]; tot += sv; off += (q < ts) ? sv : 0.f; }
        float bb[8], kb[8];
#pragma unroll
        for (int i = 0; i < 8; ++i) { const float L = off + cs[i];
            const float Wm = __expf(-(L - ee[i])), Wi = __expf(-L), iW = __expf(L), We = __expf(-(tot - L));
            const int t = 8 * ts + i;
            *(LAS bf16*)(lds + R1_AT + t * SBS + c * 2) = (bf16)f2bf(ai[i] * Wm);
            *(LAS bf16*)(lds + R1_BT + t * SBS + c * 2) = (bf16)f2bf(bi[i] * iW);
            *(LAS bf16*)(lds + R1_KT + t * SBS + c * 2) = (bf16)f2bf(k2[i] * iW);
            *(LAS bf16*)(lds + R1_RT + t * SBS + c * 2) = (bf16)f2bf(rr[i] * Wi);
            bb[i] = bi[i] * We; kb[i] = k2[i] * We; }
        v4u o; o.x = pk2(bb[0], bb[1]); o.y = pk2(bb[2], bb[3]); o.z = pk2(bb[4], bb[5]); o.w = pk2(bb[6], bb[7]);
        *(LAS v4u*)(lds + R1_BBT + c * SBS + ts * 16) = o;
        o.x = pk2(kb[0], kb[1]); o.y = pk2(kb[2], kb[3]); o.z = pk2(kb[4], kb[5]); o.w = pk2(kb[6], kb[7]);
        *(LAS v4u*)(lds + R1_KBT + c * SBS + ts * 16) = o;
        o.x = pk2(vv[0], vv[1]); o.y = pk2(vv[2], vv[3]); o.z = pk2(vv[4], vv[5]); o.w = pk2(vv[6], vv[7]);
        *(LAS v4u*)(lds + R1_VT + c * SBS + ts * 16) = o;
        if (ts == 0) ((LAS float*)(lds + R1_WEND))[c] = __expf(-tot);
    }
    LDS_BARRIER();
#pragma unroll
    for (int u = 0; u < 2; ++u) {
        const int idx = w * 2 + u, p = idx >> 2, mt = (idx >> 1) & 1, nt = idx & 1;
        const LAS unsigned char* Aop = lds + ((p == 0 || p == 2) ? R1_BT : R1_KT) + mt * 32 * SBS;
        const LAS unsigned char* Bop = lds + (p < 2 ? R1_AT : R1_RT) + nt * 32 * SBS;
        f32x16 acc = wtile<4>(Aop, SBS, Bop, SBS, zero16(), lane);
        const int n = nt * 32 + cl;
#pragma unroll
        for (int r = 0; r < 16; ++r) { const int m = mt * 32 + crow(r, hh); const bool keep = (p < 2) ? (m < n) : (m <= n); acc[r] = keep ? acc[r] : 0.f; }
#pragma unroll
        for (int g4 = 0; g4 < 4; ++g4) { const int m0 = mt * 32 + 8 * g4 + 4 * hh;
            if (p == 0) *(LAS f32x4*)(lds + R1_AAB + (n * 64 + m0) * 4) = (f32x4){acc[4 * g4], acc[4 * g4 + 1], acc[4 * g4 + 2], acc[4 * g4 + 3]};
            else { v2u o; o.x = pk2(acc[4 * g4], acc[4 * g4 + 1]); o.y = pk2(acc[4 * g4 + 2], acc[4 * g4 + 3]);
                   *(LAS v2u*)(lds + (p == 1 ? R1_AAK : (p == 2 ? R1_ARB : R1_ARK)) + n * SBS + m0 * 2) = o; } }
    }
    LDS_BARRIER();
    if (w < 4) {
        const int mt = w >> 1, nt = w & 1;
        const f32x16 acc = wtile<4>(lds + R1_AAK + mt * 32 * SBS, SBS, lds + R1_VT + nt * 32 * SBS, SBS, zero16(), lane);
        LAS float* X = (LAS float*)(lds + R1_X);
#pragma unroll
        for (int r = 0; r < 16; ++r) X[(mt * 32 + crow(r, hh)) * 64 + nt * 32 + cl] = acc[r];
    } else if (w == 4) {
        const int bk = lane >> 4, c = lane & 15;
        const LAS float* AAB = (const LAS float*)(lds + R1_AAB);
        float Tc[16]; const float fc = (float)c;
#pragma unroll
        for (int s2 = 0; s2 < 16; ++s2) Tc[s2] = fmaxf(0.f, 1.f - fabsf((float)s2 - fc));
#pragma unroll
        for (int r = 0; r < 15; ++r)
#pragma unroll
            for (int s2 = r + 1; s2 < 16; ++s2) Tc[s2] += AAB[(16 * bk + s2) * 64 + 16 * bk + r] * Tc[r];
        LAS float* TII = (LAS float*)(lds + R1_TII);
#pragma unroll
        for (int s2 = 0; s2 < 16; ++s2) TII[(bk * 16 + s2) * 16 + c] = Tc[s2];
    }
    LDS_BARRIER();
    {
        const int c16 = lane & 15, g = lane >> 4;
        const LAS float* AAB = (const LAS float*)(lds + R1_AAB); const LAS float* TII = (const LAS float*)(lds + R1_TII); const LAS float* X = (const LAS float*)(lds + R1_X);
        f32x4 o[4];
#pragma unroll
        for (int i = 0; i < 4; ++i) {
            f32x4 acc;
            if (w < 4) {
#pragma unroll
                for (int q = 0; q < 4; ++q) acc[q] = bf2f(*(const LAS bf16*)(lds + R1_AT + (16 * i + 4 * g + q) * SBS + (16 * w + c16) * 2));
            } else {
#pragma unroll
                for (int q = 0; q < 4; ++q) acc[q] = X[(16 * i + 4 * g + q) * 64 + 16 * (w - 4) + c16];
            }
#pragma unroll
            for (int j = 0; j < i; ++j) { const f32x4 a4 = *(const LAS f32x4*)(AAB + (16 * i + c16) * 64 + 16 * j + 4 * g);
#pragma unroll
                for (int q = 0; q < 4; ++q) acc = __builtin_amdgcn_mfma_f32_16x16x4f32(a4[q], o[j][q], acc, 0, 0, 0); }
            const f32x4 t4 = *(const LAS f32x4*)(TII + (i * 16 + c16) * 16 + 4 * g);
            f32x4 res = (f32x4){0.f, 0.f, 0.f, 0.f};
#pragma unroll
            for (int q = 0; q < 4; ++q) res = __builtin_amdgcn_mfma_f32_16x16x4f32(t4[q], acc[q], res, 0, 0, 0);
            o[i] = res;
            v2u ov; ov.x = pk2(res[0], res[1]); ov.y = pk2(res[2], res[3]);
            *(LAS v2u*)(lds + (w < 4 ? R1_AHT : R1_U0T) + (16 * (w & 3) + c16) * SBS + (16 * i + 4 * g) * 2) = ov;
        }
    }
    LDS_BARRIER();
    {
        float* Mg = F.out + (size_t)item * 4096; float* NTg = F.out + (size_t)T * RWW + (size_t)item * 4096;
        float* Y0g = (float*)(F.ws + WS_RWY0) + (size_t)item * 4096; bf16* RHg = (bf16*)(F.ws + WS_RWRH) + (size_t)item * 4096;
#pragma unroll
        for (int u = 0; u < 2; ++u) {
            const int idx = w * 2 + u, p = idx >> 2, mt = (idx >> 1) & 1, nt = idx & 1; const int n = nt * 32 + cl;
            if (p == 0) {
                f32x16 acc = wtile<4>(lds + R1_AHT + mt * 32 * SBS, SBS, lds + R1_BBT + nt * 32 * SBS, SBS, zero16(), lane);
                const float we = ((const LAS float*)(lds + R1_WEND))[n];
#pragma unroll
                for (int g4 = 0; g4 < 4; ++g4) { const int m0 = mt * 32 + 8 * g4 + 4 * hh;
                    const f32x4 mv = (f32x4){acc[4 * g4] + (m0 == n ? we : 0.f), acc[4 * g4 + 1] + (m0 + 1 == n ? we : 0.f), acc[4 * g4 + 2] + (m0 + 2 == n ? we : 0.f), acc[4 * g4 + 3] + (m0 + 3 == n ? we : 0.f)};
                    *(GAS f32x4*)(Mg + n * 64 + m0) = mv;
                    v2u h_; h_.x = pk2(mv[0], mv[1]); h_.y = pk2(mv[2], mv[3]);
                    v2u l_; l_.x = pk2(mv[0] - bflo(h_.x), mv[1] - bfhi(h_.x)); l_.y = pk2(mv[2] - bflo(h_.y), mv[3] - bfhi(h_.y));
                    LAS unsigned char* fp_ = lds + R1_CF + (((n >> 4) * 2 + (m0 >> 5)) * 2) * 1024 + ((((m0 >> 2) & 3) * 16) + (n & 15)) * 16 + ((m0 >> 4) & 1) * 8;
                    *(LAS v2u*)fp_ = h_; *(LAS v2u*)(fp_ + 1024) = l_; }
            } else if (p == 1) {
                f32x16 acc = wtile<4>(lds + R1_BBT + mt * 32 * SBS, SBS, lds + R1_U0T + nt * 32 * SBS, SBS, zero16(), lane);
                acc = wtile<4>(lds + R1_KBT + mt * 32 * SBS, SBS, lds + R1_VT + nt * 32 * SBS, SBS, acc, lane);
#pragma unroll
                for (int g4 = 0; g4 < 4; ++g4) { const f32x4 nv_ = (f32x4){acc[4 * g4], acc[4 * g4 + 1], acc[4 * g4 + 2], acc[4 * g4 + 3]};
                    *(GAS f32x4*)(NTg + n * 64 + mt * 32 + 8 * g4 + 4 * hh) = nv_; *(LAS f32x4*)(lds + R1_CN + (n * 64 + mt * 32 + 8 * g4 + 4 * hh) * 4) = nv_; }
            } else if (p == 2) {
                f32x16 acc = wtile<4>(lds + R1_AHT + mt * 32 * SBS, SBS, lds + R1_ARB + nt * 32 * SBS, SBS, zero16(), lane);
#pragma unroll
                for (int g4 = 0; g4 < 4; ++g4) { const int m0 = mt * 32 + 8 * g4 + 4 * hh;
                    const v2u rt = *(const LAS v2u*)(lds + R1_RT + n * SBS + m0 * 2);
                    v2u ov; ov.x = pk2(acc[4 * g4] + bflo(rt.x), acc[4 * g4 + 1] + bfhi(rt.x)); ov.y = pk2(acc[4 * g4 + 2] + bflo(rt.y), acc[4 * g4 + 3] + bfhi(rt.y));
                    *(GAS v2u*)(RHg + n * 64 + m0) = ov; }
            } else {
                f32x16 acc = wtile<4>(lds + R1_U0T + mt * 32 * SBS, SBS, lds + R1_ARB + nt * 32 * SBS, SBS, zero16(), lane);
                acc = wtile<4>(lds + R1_VT + mt * 32 * SBS, SBS, lds + R1_ARK + nt * 32 * SBS, SBS, acc, lane);
#pragma unroll
                for (int g4 = 0; g4 < 4; ++g4) *(GAS f32x4*)(Y0g + n * 64 + mt * 32 + 8 * g4 + 4 * hh) = (f32x4){acc[4 * g4], acc[4 * g4 + 1], acc[4 * g4 + 2], acc[4 * g4 + 3]};
            }
        }
        if (tid < 64) ((float*)(F.ws + WS_BONUS))[(size_t)item * 64 + tid] = ((const LAS float*)(lds + R1_BONUS))[tid];
    }
    LDS_BARRIER();
    {
        const int n16 = lane & 15, g = lane >> 4;
        bf16x8 sh[2], sl[2];
#pragma unroll
        for (int ks = 0; ks < 2; ++ks) { const f32x4 a = cst[2 * ks], b = cst[2 * ks + 1];
            v4u h_; h_.x = pk2(a[0], a[1]); h_.y = pk2(a[2], a[3]); h_.z = pk2(b[0], b[1]); h_.w = pk2(b[2], b[3]);
            v4u l_; l_.x = pk2(a[0] - bflo(h_.x), a[1] - bfhi(h_.x)); l_.y = pk2(a[2] - bflo(h_.y), a[3] - bfhi(h_.y)); l_.z = pk2(b[0] - bflo(h_.z), b[1] - bfhi(h_.z)); l_.w = pk2(b[2] - bflo(h_.w), b[3] - bfhi(h_.w));
            sh[ks] = __builtin_bit_cast(bf16x8, h_); sl[ks] = __builtin_bit_cast(bf16x8, l_); }
        f32x4 nw[4];
#pragma unroll
        for (int rt = 0; rt < 4; ++rt) { f32x4 acc = (f32x4){0.f, 0.f, 0.f, 0.f};
            if (w >= 4) acc = *(const LAS f32x4*)(lds + R1_CN + ((16 * (w - 4) + n16) * 64 + 16 * rt + 4 * g) * 4);
#pragma unroll
            for (int ks = 0; ks < 2; ++ks) {
                const bf16x8 mh = *(const LAS bf16x8*)(lds + R1_CF + ((rt * 2 + ks) * 2) * 1024 + lane * 16), ml = *(const LAS bf16x8*)(lds + R1_CF + ((rt * 2 + ks) * 2 + 1) * 1024 + lane * 16);
                acc = __builtin_amdgcn_mfma_f32_16x16x32_bf16(mh, sh[ks], acc, 0, 0, 0);
                acc = __builtin_amdgcn_mfma_f32_16x16x32_bf16(mh, sl[ks], acc, 0, 0, 0);
                acc = __builtin_amdgcn_mfma_f32_16x16x32_bf16(ml, sh[ks], acc, 0, 0, 0); }
            nw[rt] = acc; }
#pragma unroll
        for (int rt = 0; rt < 4; ++rt) cst[rt] = nw[rt];
    }
    LDS_BARRIER();
}

constexpr int R2_RS = 272, R2_SLOT = 2 * 64 * R2_RS;
static_assert(2 * R2_SLOT <= LDSCTL_OFF, "R2 LDS");
template <int NSTEP, int R2_D> __device__ __forceinline__ void rwkv_scan(Frame& F, const float* Mg, const float* NTg, float* SSg, const float* S0g) {
    int tid_ = F.tid; asm volatile("" : "+v"(tid_));
    const int lane = tid_ & 63, w = __builtin_amdgcn_readfirstlane(tid_ >> 6);
    LAS unsigned char* lds = F.lds + RING_OFF;
    if (w >= 4) {
        const int L = w - 4, r = lane >> 2, f0 = (lane & 3) * 4;
        const size_t goff = (size_t)(16 * L + r) * 64 + f0 * 4;
        const int loff = (16 * L + r) * R2_RS + f0 * 16;
        f32x4 R[R2_D][8];
#define R2_ISSUE(slot_, step_) do { const int st_ = (step_) < NSTEP ? (step_) : NSTEP - 1; const float* mp_ = Mg + (size_t)st_ * 4096 + goff; const float* np_ = NTg + (size_t)st_ * 4096 + goff; \
            _Pragma("unroll") for (int k_ = 0; k_ < 4; ++k_) { R[slot_][k_] = *(const GAS f32x4*)(mp_ + 4 * k_); R[slot_][4 + k_] = *(const GAS f32x4*)(np_ + 4 * k_); } } while (0)
        const int q_ = lane & 3, froff = ((L * 2 + (q_ >> 1)) * 2) * 1024 + r * 16 + (q_ & 1) * 8;
#define R2_WRITE(slot_, buf_) do { LAS unsigned char* d_ = lds + (buf_) * R2_SLOT; \
            _Pragma("unroll") for (int k_ = 0; k_ < 4; ++k_) { const f32x4 a_ = R[slot_][k_]; \
                v2u h_; h_.x = pk2(a_[0], a_[1]); h_.y = pk2(a_[2], a_[3]); \
                v2u l_; l_.x = pk2(a_[0] - bflo(h_.x), a_[1] - bfhi(h_.x)); l_.y = pk2(a_[2] - bflo(h_.y), a_[3] - bfhi(h_.y)); \
                *(LAS v2u*)(d_ + froff + k_ * 256) = h_; *(LAS v2u*)(d_ + froff + 1024 + k_ * 256) = l_; \
                *(LAS f32x4*)(d_ + 64 * R2_RS + loff + 16 * k_) = R[slot_][4 + k_]; } } while (0)
#pragma unroll
        for (int u = 0; u < R2_D; ++u) R2_ISSUE(u, u);
        R2_WRITE(0, 0);
        R2_ISSUE(0, R2_D);
        LDS_BARRIER();
        int c0 = 0;
        for (; c0 + R2_D <= NSTEP - 1; c0 += R2_D) {
#pragma unroll
            for (int u = 0; u < R2_D; ++u) { const int c = c0 + u;
                R2_WRITE((u + 1) % R2_D, (c + 1) & 1);
                R2_ISSUE((u + 1) % R2_D, c + 1 + R2_D);
                LDS_BARRIER(); }
        }
#pragma unroll
        for (int u = 0; u < R2_D; ++u) { const int c = c0 + u;
            if (c < NSTEP - 1) { R2_WRITE((u + 1) % R2_D, (c + 1) & 1); LDS_BARRIER(); } }
        LDS_BARRIER();
#undef R2_ISSUE
#undef R2_WRITE
        return;
    }
    const int n16 = lane & 15, g = lane >> 4;
    f32x4 st[4];
#pragma unroll
    for (int rt = 0; rt < 4; ++rt) st[rt] = S0g ? *(const GAS f32x4*)(S0g + (16 * w + n16) * 64 + 16 * rt + 4 * g) : (f32x4){0.f, 0.f, 0.f, 0.f};
    LDS_BARRIER();
    for (int c = 0; c < NSTEP; ++c) {
#pragma unroll
        for (int rt = 0; rt < 4; ++rt) *(GAS f32x4*)(SSg + (size_t)c * 4096 + (16 * w + n16) * 64 + 16 * rt + 4 * g) = st[rt];
        const LAS unsigned char* sl_ = lds + (c & 1) * R2_SLOT;
        bf16x8 sh[2], sl[2];
#pragma unroll
        for (int ks = 0; ks < 2; ++ks) { const f32x4 a = st[2 * ks], b = st[2 * ks + 1];
            v4u h; h.x = pk2(a[0], a[1]); h.y = pk2(a[2], a[3]); h.z = pk2(b[0], b[1]); h.w = pk2(b[2], b[3]);
            v4u l; l.x = pk2(a[0] - bflo(h.x), a[1] - bfhi(h.x)); l.y = pk2(a[2] - bflo(h.y), a[3] - bfhi(h.y)); l.z = pk2(b[0] - bflo(h.z), b[1] - bfhi(h.z)); l.w = pk2(b[2] - bflo(h.w), b[3] - bfhi(h.w));
            sh[ks] = __builtin_bit_cast(bf16x8, h); sl[ks] = __builtin_bit_cast(bf16x8, l); }
        f32x4 nw[4];
#pragma unroll
        for (int rt = 0; rt < 4; ++rt) { f32x4 acc = *(const LAS f32x4*)(sl_ + 64 * R2_RS + (16 * w + n16) * R2_RS + (16 * rt + 4 * g) * 4);
#pragma unroll
            for (int ks = 0; ks < 2; ++ks) {
                const bf16x8 mh = *(const LAS bf16x8*)(sl_ + ((rt * 2 + ks) * 2) * 1024 + lane * 16), ml = *(const LAS bf16x8*)(sl_ + ((rt * 2 + ks) * 2 + 1) * 1024 + lane * 16);
                acc = __builtin_amdgcn_mfma_f32_16x16x32_bf16(mh, sh[ks], acc, 0, 0, 0);
                acc = __builtin_amdgcn_mfma_f32_16x16x32_bf16(mh, sl[ks], acc, 0, 0, 0);
                acc = __builtin_amdgcn_mfma_f32_16x16x32_bf16(ml, sh[ks], acc, 0, 0, 0); }
            nw[rt] = acc; }
#pragma unroll
        for (int rt = 0; rt < 4; ++rt) st[rt] = nw[rt];
        LDS_BARRIER();
    }
#pragma unroll
    for (int rt = 0; rt < 4; ++rt) *(GAS f32x4*)(SSg + (size_t)NSTEP * 4096 + (16 * w + n16) * 64 + 16 * rt + 4 * g) = st[rt];
}

constexpr int R3_RH = 0, R3_S = 9216, R3_SG = 18432, R3_SGS = 272, R3_YL = R3_SG + 64 * R3_SGS, R3_GL = R3_YL + 16384, R3_VS = R3_GL + 16384, R3_BON = R3_VS + 65 * 128, R3_END = R3_BON + 256;
static_assert(R3_END <= LDSCTL_OFF, "R3 LDS");
struct R3Pre { v4u rh; f32x4 ss[2]; v4u gd[2][2]; f32x4 y0[2]; v4u vv[2]; float bon; };
__device__ __forceinline__ void rwkv_r3_prefetch(Frame& F, int item, int tid, R3Pre& P) {
    const int chain = item >> 7, chunk = item & 127, b = chain >> 3, h = chain & 7, g0 = b * SEQ + chunk * 64;
    const bf16* Z = (const bf16*)(F.ws + WS_Z);
    const int t = tid >> 3, cg = tid & 7; const v4u z0 = (v4u){0u, 0u, 0u, 0u};
    P.rh = *(const GAS v4u*)((const bf16*)(F.ws + WS_RWRH) + (size_t)item * 4096 + t * 64 + cg * 8);
    const float* SSg = (const float*)(F.ws + WS_RWSS) + (size_t)item * 4096 + t * 64 + cg * 8;
    P.ss[0] = *(const GAS f32x4*)SSg; P.ss[1] = *(const GAS f32x4*)(SSg + 4);
    const bf16* zr = Z + (size_t)(g0 + t) * IN_COLS + C_GD + cg * 16; const bool first = (chunk == 0 && t == 0);
#pragma unroll
    for (int q = 0; q < 2; ++q) { P.gd[q][0] = *(const GAS v4u*)(zr + q * 8); P.gd[q][1] = z0; if (!first) P.gd[q][1] = *(const GAS v4u*)(zr - IN_COLS + q * 8); }
    const float* Y0g = (const float*)(F.ws + WS_RWY0) + (size_t)item * 4096;
    P.y0[0] = *(const GAS f32x4*)(Y0g + tid * 4); P.y0[1] = *(const GAS f32x4*)(Y0g + (tid + 512) * 4);
#pragma unroll
    for (int q = 0; q < 2; ++q) { const int p = tid + 512 * q; P.vv[q] = z0;
        if (p < 65 * 8) { const int row = p >> 3, ch = p & 7; if (!(chunk == 0 && row == 0)) P.vv[q] = *(const GAS v4u*)(Z + (size_t)(g0 - 1 + row) * IN_COLS + C_V + h * 64 + ch * 8); } }
    P.bon = tid < 64 ? ((const float*)(F.ws + WS_BONUS))[(size_t)item * 64 + tid] : 0.f;
}
__device__ __forceinline__ void r3_load_bfrag(Frame& F, int h, int w, int lane, bf16x8 (&bf)[8]) {
    const int nt = w & 1; const bf16* gut = (const bf16*)(F.ws + WS_GUPT) + (size_t)(h * 64 + nt * 32 + (lane & 31)) * 128 + 8 * (lane >> 5);
#pragma unroll
    for (int s2 = 0; s2 < 8; ++s2) bf[s2] = *(const GAS bf16x8*)(gut + 16 * s2);
}
__device__ __forceinline__ void rwkv_r3_item(Frame& F, int item, int next_item, R3Pre& P, const bf16x8 (&bfr)[8]) {
    const int chain = item >> 7, chunk = item & 127, b = chain >> 3, h = chain & 7;
    const int g0 = b * SEQ + chunk * 64;
    int tid_ = F.tid; asm volatile("" : "+v"(tid_));
    const int tid = tid_, lane = tid & 63, w = __builtin_amdgcn_readfirstlane(tid >> 6), hh = lane >> 5, cl = lane & 31;
    LAS unsigned char* lds = F.lds + RING_OFF;
    const float* mu = F.in[3];
    {
        const int t = tid >> 3, cg = tid & 7;
        *(LAS v4u*)(lds + R3_RH + t * SBS + cg * 16) = P.rh;
        const f32x4 s0 = P.ss[0], s1 = P.ss[1];
        v4u o; o.x = pk2(s0[0], s0[1]); o.y = pk2(s0[2], s0[3]); o.z = pk2(s1[0], s1[1]); o.w = pk2(s1[2], s1[3]);
        *(LAS v4u*)(lds + R3_S + t * SBS + cg * 16) = o;
#pragma unroll
        for (int q = 0; q < 2; ++q) {
            const v4u cw = P.gd[q][0], pw = P.gd[q][1];
            float fw[8], qw[8];
            fw[0] = bflo(cw.x); fw[1] = bfhi(cw.x); fw[2] = bflo(cw.y); fw[3] = bfhi(cw.y); fw[4] = bflo(cw.z); fw[5] = bfhi(cw.z); fw[6] = bflo(cw.w); fw[7] = bfhi(cw.w);
            qw[0] = bflo(pw.x); qw[1] = bfhi(pw.x); qw[2] = bflo(pw.y); qw[3] = bfhi(pw.y); qw[4] = bflo(pw.z); qw[5] = bfhi(pw.z); qw[6] = bflo(pw.w); qw[7] = bfhi(pw.w);
#pragma unroll
            for (int j = 0; j < 8; ++j) { const float v = fw[j] + (qw[j] - fw[j]) * mu[C_GD + cg * 16 + q * 8 + j]; fw[j] = frcp(1.f + __expf(-v)); }
            v4u og; og.x = pk2(fw[0], fw[1]); og.y = pk2(fw[2], fw[3]); og.z = pk2(fw[4], fw[5]); og.w = pk2(fw[6], fw[7]);
            *(LAS v4u*)(lds + R3_SG + t * R3_SGS + (cg * 16 + q * 8) * 2) = og;
        }
        *(LAS f32x4*)(lds + R3_YL + tid * 16) = P.y0[0]; *(LAS f32x4*)(lds + R3_YL + (tid + 512) * 16) = P.y0[1];
#pragma unroll
        for (int q = 0; q < 2; ++q) { const int p = tid + 512 * q; if (p < 65 * 8) *(LAS v4u*)(lds + R3_VS + p * 16) = P.vv[q]; }
        if (tid < 64) ((LAS float*)(lds + R3_BON))[tid] = P.bon;
        if (next_item >= 0) rwkv_r3_prefetch(F, next_item, tid, P);
    }
    LDS_BARRIER();
    {
        const int mt = (w >> 1) & 1, nt = w & 1; const int n = nt * 32 + cl;
        if (w < 4) {
            LAS float* YL = (LAS float*)(lds + R3_YL);
            f32x16 acc;
#pragma unroll
            for (int r = 0; r < 16; ++r) acc[r] = YL[(mt * 32 + crow(r, hh)) * 64 + n];
            acc = wtile<4>(lds + R3_RH + mt * 32 * SBS, SBS, lds + R3_S + nt * 32 * SBS, SBS, acc, lane);
#pragma unroll
            for (int r = 0; r < 16; ++r) YL[(mt * 32 + crow(r, hh)) * 64 + n] = acc[r];
        } else {
            f32x16 acc = zero16();
            { const LAS unsigned char* A_ = lds + R3_SG + mt * 32 * R3_SGS + (lane & 31) * R3_SGS + 16 * hh;
#pragma unroll
              for (int s2 = 0; s2 < 8; ++s2) acc = __builtin_amdgcn_mfma_f32_32x32x16_bf16(*(const LAS bf16x8*)(A_ + 32 * s2), bfr[s2], acc, 0, 0, 0); }
            LAS float* GL = (LAS float*)(lds + R3_GL);
#pragma unroll
            for (int r = 0; r < 16; ++r) GL[(mt * 32 + crow(r, hh)) * 64 + n] = acc[r];
        }
    }
    LDS_BARRIER();
    {
        const int c = tid & 63, ts = tid >> 6, col = h * 64 + c;
        const float mu_v = mu[C_V + col], gw = F.in[12][col], gb = F.in[13][col];
        const LAS float* YL = (const LAS float*)(lds + R3_YL); const LAS float* GL = (const LAS float*)(lds + R3_GL); const LAS float* BON = (const LAS float*)(lds + R3_BON);
        bf16* Y = (bf16*)(F.ws + WS_YMIX);
        const LAS bf16* vb = (const LAS bf16*)(lds + R3_VS) + (8 * ts) * 64 + c;
        float pv = bf2f(vb[0]);
#pragma unroll
        for (int i = 0; i < 8; ++i) { const int t = 8 * ts + i;
            const float zv = bf2f(vb[(i + 1) * 64]); const float v = zv + (pv - zv) * mu_v; pv = zv;
            const float y = YL[t * 64 + c];
            const float mean = wave_sum(y) * (1.f / 64.f); const float d = y - mean; const float var = wave_sum(d * d) * (1.f / 64.f);
            const float yn = d * frsq(var + GN_EPS) * gw + gb;
            const float o = (yn + BON[t] * v) * GL[t * 64 + c];
            Y[(size_t)(g0 + t) * DM + col] = (bf16)f2bf(o); }
    }
    LDS_BARRIER();
}

typedef short s16x4 __attribute__((ext_vector_type(4)));
typedef short v4i16_t __attribute__((ext_vector_type(4)));
constexpr int AT_XO = 0, AT_XO_STRIDE = 136, AT_XM = 512 * AT_XO_STRIDE, AT_XL = AT_XM + 2048, AT_V = AT_XL + 2048, AT_K = AT_V + 8 * 4096, AT_KS = 144, AT_LDS_END = AT_K + 8 * 32 * AT_KS;
static_assert(AT_LDS_END <= LDSCTL_OFF, "attention LDS");
__device__ __forceinline__ float xhalf(float v) { return __shfl_xor(v, 32); }
__device__ __forceinline__ void attn_block(Frame& F, int item) {
    const int bh = item >> 4, blk = item & 15, b = bh >> 3, h = bh & 7, t0 = blk * 512;
    int tid_ = F.tid; asm volatile("" : "+v"(tid_));
    const int lane = tid_ & 63, w = __builtin_amdgcn_readfirstlane(tid_ >> 6), ql = lane & 31, hh = lane >> 5;
    const bf16* Zb = (const bf16*)(F.ws + WS_Z) + (size_t)b * SEQ * IN_COLS;
    bf16* Y = (bf16*)(F.ws + WS_YMIX);
    LAS unsigned char* lds = F.lds + RING_OFF;
    LAS unsigned char* Vw = lds + AT_V + w * 4096;
    LAS unsigned char* Kw = lds + AT_K + w * 32 * AT_KS;
    LAS float* XM = (LAS float*)(lds + AT_XM); LAS float* XL = (LAS float*)(lds + AT_XL);
    constexpr float C2 = 0.125f * 1.4426950408889634f;
    const int lrow = lane >> 3, lch = lane & 7;
    __builtin_amdgcn_s_waitcnt(0x0F70);
#define AT_PARAMS(SI, sh_, d_, rho_, tau_, tkb_) do { const int ps_ = (SI) >> 1; sh_ = ps_ == 0 ? 4 : (ps_ == 1 ? 2 : 0); d_ = 1 << sh_; \
        const int u_ = w + 8 * ((SI) & 1); rho_ = u_ & (d_ - 1); tau_ = u_ >> sh_; tkb_ = t0 + rho_ + (32 * tau_ - 128) * d_; } while (0)
    const GAS char* zb8 = (const GAS char*)Zb;
#define AT_VOFF(d_) ((unsigned)(lrow * (d_)) * (unsigned)(IN_COLS * 2) + (unsigned)(lch * 16))
#define AT_LOADQ(d_, rho_, tau_, vo_) do { const GAS char* sb_ = zb8 + ((size_t)(t0 + rho_ + 32 * tau_ * d_) * IN_COLS + C_AQ + h * 64) * 2; \
        _Pragma("unroll") for (int i_ = 0; i_ < 4; ++i_) qr[i_] = *(const GAS v4u*)(sb_ + (size_t)(i_ * 8 * d_) * (IN_COLS * 2) + vo_); } while (0)
#define AT_LOADT(KT, COL, d_, tkb_, vo_) do { const int tk_ = tkb_ + 32 * (KT) * d_, tc_ = tk_ < 0 ? 0 : tk_; const GAS char* sb_ = zb8 + ((size_t)tc_ * IN_COLS + (COL) + h * 64) * 2; \
        _Pragma("unroll") for (int i_ = 0; i_ < 4; ++i_) R[KT][i_] = *(const GAS v4u*)(sb_ + (size_t)(i_ * 8 * d_) * (IN_COLS * 2) + vo_); } while (0)
    v4u R[5][4], qr[4];
    { int sh, d, rho, tau, tkb; AT_PARAMS(0, sh, d, rho, tau, tkb);
      const unsigned vo = AT_VOFF(d);
      AT_LOADQ(d, rho, tau, vo);
#pragma unroll
      for (int kt = 0; kt < 5; ++kt) AT_LOADT(kt, C_AK, d, tkb, vo); }
#pragma unroll 1
    for (int si = 0; si < 6; ++si) {
        int sh, d, rho, tau, tkb; AT_PARAMS(si, sh, d, rho, tau, tkb);
        const int sn = si < 5 ? si + 1 : 5;
        int sh2, d2, rho2, tau2, tkb2; AT_PARAMS(sn, sh2, d2, rho2, tau2, tkb2);
        const int qoff = rho + (32 * tau + ql) * d;
        const unsigned vo = AT_VOFF(d), vo2 = AT_VOFF(d2);
        bf16x8 qf[4];
#pragma unroll
        for (int i = 0; i < 4; ++i) *(LAS v4u*)(Kw + (i * 8 + lrow) * AT_KS + lch * 16) = qr[i];
#pragma unroll
        for (int s = 0; s < 4; ++s) qf[s] = *(const LAS bf16x8*)(Kw + ql * AT_KS + 32 * s + 16 * hh);
        f32x16 sc[5];
        float m = -INFINITY;
#pragma unroll
        for (int kt = 0; kt < 5; ++kt) {
            const int tk0 = tkb + 32 * kt * d;
            bf16x8 kf[4];
#pragma unroll
            for (int i = 0; i < 4; ++i) *(LAS v4u*)(Kw + (i * 8 + lrow) * AT_KS + lch * 16) = R[kt][i];
            AT_LOADT(kt, C_AV, d, tkb, vo);
#pragma unroll
            for (int s = 0; s < 4; ++s) kf[s] = *(const LAS bf16x8*)(Kw + ql * AT_KS + 32 * s + 16 * hh);
            f32x16 acc = zero16();
#pragma unroll
            for (int s = 0; s < 4; ++s) acc = __builtin_amdgcn_mfma_f32_32x32x16_bf16(kf[s], qf[s], acc, 0, 0, 0);
            if (kt == 0 || kt == 4) {
#pragma unroll
                for (int r = 0; r < 16; ++r) { const int kidx = (r & 3) + 8 * (r >> 2) + 4 * hh;
                    const bool ok = (kt == 0) ? (kidx >= ql) : (kidx <= ql);
                    acc[r] = ok ? acc[r] : -INFINITY; }
            }
            float mt = acc[0];
#pragma unroll
            for (int r = 1; r < 16; ++r) mt = fmaxf(mt, acc[r]);
            m = tk0 < 0 ? m : fmaxf(m, mt);
            sc[kt] = acc;
        }
        m = fmaxf(m, xhalf(m));
        const float ms = m * C2;
        f32x2 l2 = (f32x2){0.f, 0.f};
        unsigned pw[5][8];
#pragma unroll
        for (int kt = 0; kt < 5; ++kt) {
            const float mk = (tkb + 32 * kt * d) < 0 ? INFINITY : ms;
#pragma unroll
            for (int r = 0; r < 8; ++r) {
                const f32x2 t2 = __builtin_elementwise_fma((f32x2){sc[kt][2 * r], sc[kt][2 * r + 1]}, (f32x2){C2, C2}, (f32x2){-mk, -mk});
                const f32x2 p2 = (f32x2){__builtin_amdgcn_exp2f(t2[0]), __builtin_amdgcn_exp2f(t2[1])};
                l2 += p2; pw[kt][r] = pk2(p2[0], p2[1]); }
        }
        float l = l2[0] + l2[1];
        l += xhalf(l);
        AT_LOADQ(d2, rho2, tau2, vo2);
        f32x16 O[2];
#pragma unroll
        for (int r = 0; r < 16; ++r) { O[0][r] = 0.f; O[1][r] = 0.f; }
#pragma unroll
        for (int kt = 0; kt < 5; ++kt) {
#pragma unroll
            for (int i = 0; i < 4; ++i) { const int kidx = i * 8 + lrow;
                *(LAS v4u*)(Vw + kidx * 128 + ((lch ^ (((kidx >> 1) & 1) << 2)) << 4)) = R[kt][i]; }
            AT_LOADT(kt, C_AK, d2, tkb2, vo2);
#pragma unroll
            for (int s = 0; s < 2; ++s) {
                v4u pq; pq.x = pw[kt][4 * s]; pq.y = pw[kt][4 * s + 1]; pq.z = pw[kt][4 * s + 2]; pq.w = pw[kt][4 * s + 3];
                const bf16x8 pf = __builtin_bit_cast(bf16x8, pq);
#pragma unroll
                for (int dt = 0; dt < 2; ++dt) {
                    bf16x8 vf;
#pragma unroll
                    for (int pp = 0; pp < 2; ++pp) {
                        const int i16 = lane & 15, db = (lane >> 4) & 1;
                        const int row = 16 * s + 8 * pp + 4 * hh + (i16 >> 2);
                        const int byte = 64 * dt + 32 * db + 8 * (i16 & 3);
                        const int chunk = (byte >> 4) ^ (((row >> 1) & 1) << 2);
                        const s16x4 t4 = __builtin_bit_cast(s16x4, __builtin_amdgcn_ds_read_tr16_b64_v4i16((LAS v4i16_t*)(Vw + row * 128 + (chunk << 4) + (byte & 15))));
                        vf[4 * pp + 0] = t4[0]; vf[4 * pp + 1] = t4[1]; vf[4 * pp + 2] = t4[2]; vf[4 * pp + 3] = t4[3];
                    }
                    O[dt] = __builtin_amdgcn_mfma_f32_32x32x16_bf16(vf, pf, O[dt], 0, 0, 0);
                }
            }
        }
        LAS unsigned char* xo = lds + AT_XO + qoff * AT_XO_STRIDE + 8 * hh;
        float wa = 0.f, wb = 1.f, Mx = ms, ln = l;
        if (si >= 2) { const float msa = XM[qoff], la = XL[qoff]; Mx = fmaxf(msa, ms); wa = la * __builtin_amdgcn_exp2f(msa - Mx); wb = __builtin_amdgcn_exp2f(ms - Mx); ln = wa + wb * l; }
        const float inv = 1.f / ln;
#pragma unroll
        for (int dt = 0; dt < 2; ++dt)
#pragma unroll
            for (int g4 = 0; g4 < 4; ++g4) {
                LAS v2u* p = (LAS v2u*)(xo + (32 * dt + 8 * g4) * 2);
                float o0 = O[dt][4 * g4] * wb, o1 = O[dt][4 * g4 + 1] * wb, o2 = O[dt][4 * g4 + 2] * wb, o3 = O[dt][4 * g4 + 3] * wb;
                if (si >= 2) { const v2u old = *p; o0 += bflo(old.x) * wa; o1 += bfhi(old.x) * wa; o2 += bflo(old.y) * wa; o3 += bfhi(old.y) * wa; }
                v2u nw; nw.x = pk2(o0 * inv, o1 * inv); nw.y = pk2(o2 * inv, o3 * inv);
                *p = nw;
            }
        if (hh == 0) { XM[qoff] = Mx; XL[qoff] = ln; }
        if (si & 1) LDS_BARRIER();
    }
#undef AT_PARAMS
#undef AT_LOADQ
#undef AT_VOFF
#undef AT_LOADT
#pragma unroll
    for (int i = 0; i < 8; ++i) { const int row = (tid_ >> 3) + 64 * i, ch = tid_ & 7;
        LAS v2u* p = (LAS v2u*)(lds + AT_XO + row * AT_XO_STRIDE + ch * 16);
        const v2u a = p[0], c = p[1];
        v4u o; o.x = a.x; o.y = a.y; o.z = c.x; o.w = c.y;
        *(GAS v4u*)(Y + ((size_t)b * SEQ + t0 + row) * DM + RWW + h * 64 + ch * 8) = o; }
    LDS_BARRIER();
}

__device__ __forceinline__ void quantize_tables(Frame& F, int gw, int ngw) {
    for (int m = gw; m < 2 * NEXP; m += ngw) {
        const int tab = m >= NEXP, row = tab ? m - NEXP : m;
        const GAS f32x4* xr = (const GAS f32x4*)(F.in[18 + tab] + (size_t)row * DM) + F.lane * 4;
        f32x4 v[4]; float am = 0.f;
#pragma unroll
        for (int j = 0; j < 4; ++j) { v[j] = xr[j]; am = fmaxf(am, fmaxf(fmaxf(fabsf(v[j].x), fabsf(v[j].y)), fmaxf(fabsf(v[j].z), fabsf(v[j].w)))); }
        am = wave_max(am);
        const float qmax = tab ? 224.f : 127.f;
        const float sc = am > 0.f ? am / qmax : 1.f, inv = am > 0.f ? qmax / am : 0.f;
        v4u o;
#pragma unroll
        for (int j = 0; j < 4; ++j) {
            if (tab) { int w = __builtin_amdgcn_cvt_pk_fp8_f32(v[j].x * inv, v[j].y * inv, 0, false); w = __builtin_amdgcn_cvt_pk_fp8_f32(v[j].z * inv, v[j].w * inv, w, true); o[j] = (unsigned)w; }
            else {
            const unsigned b0 = (unsigned)(int)rintf(v[j].x * inv) & 255u, b1 = (unsigned)(int)rintf(v[j].y * inv) & 255u,
                           b2 = (unsigned)(int)rintf(v[j].z * inv) & 255u, b3 = (unsigned)(int)rintf(v[j].w * inv) & 255u;
            o[j] = b0 | (b1 << 8) | (b2 << 16) | (b3 << 24); } }
        *(GAS v4u*)(F.ws + (tab ? WS_VQ : WS_UQ) + (size_t)row * DM + F.lane * 16) = o;
        if (F.lane == 0) ((float*)(F.ws + (tab ? WS_SV : WS_SU)))[row] = sc;
    }
}

__device__ __forceinline__ void p3_mixers(Frame& F) {
    if (F.wg < NB * NHR) {
        const int chain = F.wg;
        const float* Pg = (const float*)(F.ws + WS_PQ) + (size_t)chain * 8 * 4096; const float* Qg = Pg + (size_t)256 * 4096;
        rwkv_scan<7, 3>(F, Pg, Qg, (float*)(F.ws + WS_SSEG) + (size_t)chain * 8 * 4096, nullptr);
        __syncthreads();
    }
#ifndef ATTN_REPS
#define ATTN_REPS 1
#endif
    for (int rep = 0; rep < ATTN_REPS; ++rep)
    if (F.G == 256) { for (int r = 0; r < 2; ++r) { const int v = r * 32 + (F.wg >> 3); attn_block(F, (((F.wg & 7) * 4 + (v >> 4)) << 4) | (v & 15)); } }
    else for (int item = F.wg; item < NB * NHA * (SEQ / 512); item += F.G) attn_block(F, item);
}

constexpr int TK_SKS = 272, TK_SKH = 0, TK_SKL = 2 * 128 * TK_SKS, TK_LUT = 2 * TK_SKL, TK_END = TK_LUT + 8 * 2048;
__device__ __forceinline__ unsigned f2ord(float f) { const unsigned u = __builtin_bit_cast(unsigned, f); return u ^ ((unsigned)((int)u >> 31) | 0x80000000u); }
__device__ __forceinline__ float ord2f(unsigned o) { const unsigned u = (o & 0x80000000u) ? (o ^ 0x80000000u) : ~o; return __builtin_bit_cast(float, u); }
__device__ __forceinline__ void ce_desc(unsigned& a, unsigned& b) { const unsigned mx = a > b ? a : b, mn = a > b ? b : a; a = mx; b = mn; }
template <int N, int OFF, int TOT> __device__ __forceinline__ void bitonic_sort_desc(unsigned (&v)[TOT]) {
#pragma unroll
    for (int k = 2; k <= N; k <<= 1)
#pragma unroll
        for (int j = k >> 1; j > 0; j >>= 1)
#pragma unroll
            for (int i = 0; i < N; ++i) { const int l = i ^ j; if (l > i) { if ((i & k) == 0) ce_desc(v[OFF + i], v[OFF + l]); else ce_desc(v[OFF + l], v[OFF + i]); } }
}
template <int OFFA, int OFFB, int TOT> __device__ __forceinline__ void merge_top16(unsigned (&v)[TOT]) {
#pragma unroll
    for (int i = 0; i < 16; ++i) { const unsigned x = v[OFFA + i], y = v[OFFB + 15 - i]; v[OFFA + i] = x > y ? x : y; }
#pragma unroll
    for (int j = 8; j > 0; j >>= 1)
#pragma unroll
        for (int i = 0; i < 16; ++i) { const int l = i ^ j; if (l > i) ce_desc(v[OFFA + i], v[OFFA + l]); }
}
__device__ __forceinline__ void top16_of_64(unsigned (&k)[64]) {
    bitonic_sort_desc<16, 0, 64>(k); bitonic_sort_desc<16, 16, 64>(k); bitonic_sort_desc<16, 32, 64>(k); bitonic_sort_desc<16, 48, 64>(k);
    merge_top16<0, 16, 64>(k); merge_top16<32, 48, 64>(k); merge_top16<0, 32, 64>(k);
}
__device__ __forceinline__ void p7_topk(Frame& F) {
    static_assert(TK_END <= LDSCTL_OFF, "topk LDS");
    const bf16* QP = (const bf16*)(F.ws + WS_QP);
    int* EID = (int*)(F.ws + WS_EID); float* GATE = (float*)(F.ws + WS_GATE);
    const float* sk = F.in[17];
    LAS unsigned char* lds = F.lds + RING_OFF;
    for (int e = F.tid; e < 2 * 128 * 64; e += NTHREADS) {
        const int c = e >> 13, k = (e >> 6) & 127, d2 = e & 63;
        const f32x2 v = *(const GAS f32x2*)(sk + (size_t)(c * 128 + k) * 128 + 2 * d2);
        const unsigned h0 = f2bf(v.x), h1 = f2bf(v.y);
        const float r0 = v.x - __builtin_bit_cast(float, h0 << 16), r1 = v.y - __builtin_bit_cast(float, h1 << 16);
        *(LAS unsigned*)(lds + TK_SKH + (c * 128 + k) * TK_SKS + d2 * 4) = h0 | (h1 << 16);
        *(LAS unsigned*)(lds + TK_SKL + (c * 128 + k) * TK_SKS + d2 * 4) = pk2(r0, r1);
    }
    __syncthreads();
    const int gw = F.wg * NWAVES + F.wave, NGW = F.G * NWAVES;
    for (int tile = gw; tile < T * PHEADS / 32; tile += NGW) {
        int lane_ = F.lane; asm volatile("" : "+v"(lane_));
        const int lane = lane_, hh = lane >> 5, cl = lane & 31;
        const int P = tile * 32 + cl, t = P >> 3, h = P & 7;
        unsigned kAB[2][16];
#pragma unroll
        for (int c = 0; c < 2; ++c) {
            bf16x8 qf[8];
            const bf16* qp = QP + (size_t)t * PQ + h * 256 + c * 128 + 8 * hh;
#pragma unroll
            for (int s2 = 0; s2 < 8; ++s2) qf[s2] = *(const GAS bf16x8*)(qp + 16 * s2);
            unsigned k[64];
#pragma unroll
            for (int mt = 0; mt < 4; ++mt) {
                f32x16 acc = zero16();
                const LAS unsigned char* ah = lds + TK_SKH + (c * 128 + mt * 32 + cl) * TK_SKS + 16 * hh;
                const LAS unsigned char* al = lds + TK_SKL + (c * 128 + mt * 32 + cl) * TK_SKS + 16 * hh;
#pragma unroll
                for (int s2 = 0; s2 < 8; ++s2) {
                    acc = __builtin_amdgcn_mfma_f32_32x32x16_bf16(*(const LAS bf16x8*)(ah + 32 * s2), qf[s2], acc, 0, 0, 0);
                    acc = __builtin_amdgcn_mfma_f32_32x32x16_bf16(*(const LAS bf16x8*)(al + 32 * s2), qf[s2], acc, 0, 0, 0); }
#pragma unroll
                for (int r = 0; r < 16; ++r) { const int idx = 32 * mt + (r & 3) + 8 * (r >> 2) + 4 * hh; k[mt * 16 + r] = (f2ord(acc[r]) & ~127u) | (unsigned)(127 - idx); }
            }
            top16_of_64(k);
            unsigned m[32];
#pragma unroll
            for (int i = 0; i < 16; ++i) { m[i] = k[i]; m[16 + i] = (unsigned)__shfl_xor((int)k[i], 32); }
            merge_top16<0, 16, 32>(m);
#pragma unroll
            for (int i = 0; i < 16; ++i) kAB[c][i] = m[i];
        }
        float fa[16], fb[16];
#pragma unroll
        for (int i = 0; i < 16; ++i) { fa[i] = ord2f(kAB[0][i] & ~127u); fb[i] = ord2f(kAB[1][i] & ~127u); }
        unsigned cd[64]; int n = 0;
#pragma unroll
        for (int i = 0; i < 16; ++i)
#pragma unroll
            for (int j = 0; j < 16; ++j) if ((i + 1) * (j + 1) <= 16) { cd[n] = (f2ord(fa[i] + fb[j]) & ~255u) | (unsigned)(255 - (i * 16 + j)); ++n; }
#pragma unroll
        for (int q = 50; q < 64; ++q) cd[q] = 0u;
        top16_of_64(cd);
        LAS unsigned char* lut = lds + TK_LUT + (F.wave * 64 + lane) * 32;
#pragma unroll
        for (int q = 0; q < 4; ++q) {
            unsigned wa = 0u, wb = 0u;
#pragma unroll
            for (int b4 = 0; b4 < 4; ++b4) { wa |= (127u - (kAB[0][4 * q + b4] & 127u)) << (8 * b4); wb |= (127u - (kAB[1][4 * q + b4] & 127u)) << (8 * b4); }
            *(LAS unsigned*)(lut + 4 * q) = wa; *(LAS unsigned*)(lut + 16 + 4 * q) = wb; }
        float gv[16]; float den = 0.f; const float mx = ord2f(cd[0] & ~255u);
#pragma unroll
        for (int q = 0; q < 16; ++q) { gv[q] = __expf(ord2f(cd[q] & ~255u) - mx); den += gv[q]; }
        const float inv = 1.f / den;
        asm volatile("s_waitcnt lgkmcnt(0)" ::: "memory");
        int ev[16];
#pragma unroll
        for (int q = 0; q < 16; ++q) { const unsigned pos = 255u - (cd[q] & 255u);
            const unsigned ia = *(const LAS unsigned char*)(lut + (pos >> 4)), ib = *(const LAS unsigned char*)(lut + 16 + (pos & 15u));
            ev[q] = (int)(ia * NKEYS + ib); }
        if (hh == 0) {
            int* ep = EID + (size_t)t * 128 + h * 16; float* gp = GATE + (size_t)t * 128 + h * 16;
#pragma unroll
            for (int q = 0; q < 4; ++q) {
                *(GAS v4u*)(ep + 4 * q) = (v4u){(unsigned)ev[4 * q], (unsigned)ev[4 * q + 1], (unsigned)ev[4 * q + 2], (unsigned)ev[4 * q + 3]};
                *(GAS f32x4*)(gp + 4 * q) = (f32x4){gv[4 * q] * inv, gv[4 * q + 1] * inv, gv[4 * q + 2] * inv, gv[4 * q + 3] * inv}; }
        }
        asm volatile("s_waitcnt lgkmcnt(0)" ::: "memory");
    }
}

constexpr int GA_WAVE_BYTES = 10752, GA_CNT = 4096, GA_OFF = 4096 + 128, GA_ACT = 4608, GA_XQ = 6656;
__device__ __forceinline__ int wave_sum_i(int v) { v += dppi<0xB1>(v); v += dppi<0x4E>(v); v += dppi<0x141>(v); v += dppi<0x140>(v);
    return (__builtin_amdgcn_readlane(v, 0) + __builtin_amdgcn_readlane(v, 16)) + (__builtin_amdgcn_readlane(v, 32) + __builtin_amdgcn_readlane(v, 48)); }
struct PairBuf { v4u u, v; float su, sv; int e; float g; };
__device__ __forceinline__ void p8_gather(Frame& F, float* outp) {
    const bf16* XN = (const bf16*)(F.ws + WS_XN);
    const unsigned char* UQ = F.ws + WS_UQ; const unsigned char* VQ = F.ws + WS_VQ;
    const float* SU = (const float*)(F.ws + WS_SU); const float* SV = (const float*)(F.ws + WS_SV);
    const int* EID = (const int*)(F.ws + WS_EID); const float* GATE = (const float*)(F.ws + WS_GATE);
    const float* nf = F.in[20];
    const int gw = F.wg * NWAVES + F.wave, NGW = F.G * NWAVES;
    LAS unsigned char* wl = F.lds + RING_OFF + F.wave * GA_WAVE_BYTES;
    for (int tg = gw, sweep = 0; tg < T / 4; tg += NGW, ++sweep) {
        int lane_ = F.lane; asm volatile("" : "+v"(lane_));
        const int lane = lane_;
        int xq[4][4]; float sx[4];
#pragma unroll
        for (int tk = 0; tk < 4; ++tk) {
            const GAS v4u* xp = (const GAS v4u*)(XN + (size_t)(4 * tg + tk) * DM + lane * 16);
            const v4u a = xp[0], b = xp[1];
            float x[16]; x[0] = bflo(a.x); x[1] = bfhi(a.x); x[2] = bflo(a.y); x[3] = bfhi(a.y); x[4] = bflo(a.z); x[5] = bfhi(a.z); x[6] = bflo(a.w); x[7] = bfhi(a.w);
            x[8] = bflo(b.x); x[9] = bfhi(b.x); x[10] = bflo(b.y); x[11] = bfhi(b.y); x[12] = bflo(b.z); x[13] = bfhi(b.z); x[14] = bflo(b.w); x[15] = bfhi(b.w);
            float am = 0.f;
#pragma unroll
            for (int i = 0; i < 16; ++i) am = fmaxf(am, fabsf(x[i]));
            am = wave_max(am);
            const float rs_ = frsq(((const float*)(F.ws + WS_SSQ))[4 * tg + tk] * (1.f / DM) + RMS_EPS);
            sx[tk] = (am > 0.f ? am * (1.f / 127.f) : 1.f) * rs_; const float inv = am > 0.f ? 127.f / am : 0.f;
#pragma unroll
            for (int q = 0; q < 4; ++q) {
                const unsigned b0 = (unsigned)(int)rintf(x[4 * q] * inv) & 255u, b1 = (unsigned)(int)rintf(x[4 * q + 1] * inv) & 255u, b2 = (unsigned)(int)rintf(x[4 * q + 2] * inv) & 255u, b3 = (unsigned)(int)rintf(x[4 * q + 3] * inv) & 255u;
                xq[tk][q] = (int)(b0 | (b1 << 8) | (b2 << 16) | (b3 << 24)); }
            *(LAS v4u*)(wl + GA_XQ + tk * 1024 + lane * 16) = (v4u){(unsigned)xq[tk][0], (unsigned)xq[tk][1], (unsigned)xq[tk][2], (unsigned)xq[tk][3]};
        }
        LAS unsigned* cnt = (LAS unsigned*)(wl + GA_CNT); LAS unsigned* offs = (LAS unsigned*)(wl + GA_OFF);
        if (lane < 32) cnt[lane] = 0u;
        asm volatile("s_waitcnt lgkmcnt(0)" ::: "memory");
        int ee[8]; float gg[8]; unsigned pos[8];
#pragma unroll
        for (int tk = 0; tk < 4; ++tk) {
            const size_t base = (size_t)(4 * tg + tk) * 128;
            ee[2 * tk] = (EID[base + lane] & (NEXP - 1)) | (tk << 14); ee[2 * tk + 1] = (EID[base + 64 + lane] & (NEXP - 1)) | (tk << 14);
            gg[2 * tk] = GATE[base + lane]; gg[2 * tk + 1] = GATE[base + 64 + lane]; }
#pragma unroll
        for (int q = 0; q < 8; ++q) pos[q] = __hip_atomic_fetch_add(cnt + ((ee[q] >> 9) & 31), 1u, __ATOMIC_RELAXED, __HIP_MEMORY_SCOPE_WAVEFRONT);
        asm volatile("s_waitcnt lgkmcnt(0)" ::: "memory");
        if (lane < 32) {
            const int c0 = (int)cnt[lane]; int v = c0;
            v += __builtin_amdgcn_update_dpp(0, v, 0x111, 0xF, 0xF, true); v += __builtin_amdgcn_update_dpp(0, v, 0x112, 0xF, 0xF, true);
            v += __builtin_amdgcn_update_dpp(0, v, 0x114, 0xF, 0xF, true); v += __builtin_amdgcn_update_dpp(0, v, 0x118, 0xF, 0xF, true);
            const int row0 = __builtin_amdgcn_readlane(v, 15);
            offs[lane] = (unsigned)(v - c0 + (lane >= 16 ? row0 : 0));
        }
        asm volatile("s_waitcnt lgkmcnt(0)" ::: "memory");
#pragma unroll
        for (int q = 0; q < 8; ++q) { const unsigned idx = offs[(ee[q] >> 9) & 31] + pos[q];
            *(LAS unsigned*)(wl + idx * 4) = (unsigned)ee[q]; *(LAS float*)(wl + 2048 + idx * 4) = gg[q]; }
        asm volatile("s_waitcnt lgkmcnt(0)" ::: "memory");
        LAS float* act = (LAS float*)(wl + GA_ACT);
#ifndef UPASS_REPS
#define UPASS_REPS 1
#endif
        for (int urep = 0; urep < UPASS_REPS; ++urep)
        {
            const int grp = lane >> 4, l16 = lane & 15;
            const LAS unsigned* ents = (const LAS unsigned*)wl;
            LAS int* hbuf = (LAS int*)(wl + GA_ACT);
            v4u rb[2][2][4]; unsigned eb[2][2];
#define GA_ULOAD(ST, QD, Q_) do { const unsigned e_ = ents[(Q_) * 4 + grp]; eb[ST][QD] = e_; const GAS v4u* rp_ = (const GAS v4u*)(UQ + (size_t)(e_ & (NEXP - 1)) * DM + l16 * 64); \
                rb[ST][QD][0] = rp_[0]; rb[ST][QD][1] = rp_[1]; rb[ST][QD][2] = rp_[2]; rb[ST][QD][3] = rp_[3]; } while (0)
#define GA_UDOT(ST, QD, Q_) do { const LAS v4u* xp_ = (const LAS v4u*)(wl + GA_XQ + ((eb[ST][QD] >> 14) & 3u) * 1024 + l16 * 64); int d_ = 0; \
                _Pragma("unroll") for (int k_ = 0; k_ < 4; ++k_) { const v4u x_ = xp_[k_], r_ = rb[ST][QD][k_]; \
                    d_ = __builtin_amdgcn_sdot4((int)x_.x, (int)r_.x, d_, false); d_ = __builtin_amdgcn_sdot4((int)x_.y, (int)r_.y, d_, false); \
                    d_ = __builtin_amdgcn_sdot4((int)x_.z, (int)r_.z, d_, false); d_ = __builtin_amdgcn_sdot4((int)x_.w, (int)r_.w, d_, false); } \
                d_ += dppi<0xB1>(d_); d_ += dppi<0x4E>(d_); d_ += dppi<0x141>(d_); d_ += dppi<0x140>(d_); \
                if (l16 == 0) hbuf[(Q_) * 4 + grp] = d_; } while (0)
            GA_ULOAD(0, 0, 0); GA_ULOAD(0, 1, 1);
            for (int q2 = 0; q2 < 128; q2 += 4) {
                GA_ULOAD(1, 0, q2 + 2); GA_ULOAD(1, 1, q2 + 3);
                __builtin_amdgcn_sched_barrier(0);
                GA_UDOT(0, 0, q2); GA_UDOT(0, 1, q2 + 1);
                __builtin_amdgcn_sched_barrier(0);
                if (q2 + 4 < 128) { GA_ULOAD(0, 0, q2 + 4); GA_ULOAD(0, 1, q2 + 5); }
                __builtin_amdgcn_sched_barrier(0);
                GA_UDOT(1, 0, q2 + 2); GA_UDOT(1, 1, q2 + 3);
                __builtin_amdgcn_sched_barrier(0);
            }
#undef GA_ULOAD
#undef GA_UDOT
            asm volatile("s_waitcnt lgkmcnt(0)" ::: "memory");
#pragma unroll 2
            for (int it = 0; it < 8; ++it) { const int p = it * 64 + lane;
                const unsigned e_ = ents[p]; const float g_ = *(const LAS float*)(wl + 2048 + p * 4); const int hs = hbuf[p];
                const int ex_ = (int)(e_ & (NEXP - 1)), tk_ = (int)(e_ >> 14) & 3;
                const float sxl = tk_ == 0 ? sx[0] : (tk_ == 1 ? sx[1] : (tk_ == 2 ? sx[2] : sx[3]));
                const float h_ = (float)hs * (SU[ex_] * sxl);
                act[p] = 0.5f * h_ * (1.f + erff(h_ * 0.70710678118654752f)) * g_ * SV[ex_]; }
        }
        asm volatile("s_waitcnt lgkmcnt(0)" ::: "memory");
        float y[4][16];
#pragma unroll
        for (int tk = 0; tk < 4; ++tk) {
#pragma unroll
            for (int i = 0; i < 16; ++i) y[tk][i] = 0.f; }
#define GA_AXPY(V, A, TK) do { \
            _Pragma("unroll") for (int q_ = 0; q_ < 4; ++q_) { const int w_ = (int)(V)[q_]; const f32x2 lo_ = __builtin_amdgcn_cvt_pk_f32_fp8(w_, false), hi_ = __builtin_amdgcn_cvt_pk_f32_fp8(w_, true); \
                y[TK][4 * q_] += (A) * lo_.x; y[TK][4 * q_ + 1] += (A) * lo_.y; y[TK][4 * q_ + 2] += (A) * hi_.x; y[TK][4 * q_ + 3] += (A) * hi_.y; } } while (0)
        for (int ch = 0; ch < 8; ++ch) {
            const unsigned ent = *(const LAS unsigned*)(wl + (ch * 64 + lane) * 4);
            const float areg = act[ch * 64 + lane];
            v4u vb[2][8]; int eb[2][8];
#pragma unroll
            for (int q = 0; q < 8; ++q) { eb[0][q] = __builtin_amdgcn_readlane((int)ent, q); vb[0][q] = *(const GAS v4u*)(VQ + (size_t)(eb[0][q] & (NEXP - 1)) * DM + lane * 16); }
#pragma unroll
            for (int jb = 0; jb < 8; ++jb) {
                if (jb + 1 < 8) {
#pragma unroll
                    for (int q = 0; q < 8; ++q) { eb[(jb + 1) & 1][q] = __builtin_amdgcn_readlane((int)ent, 8 * (jb + 1) + q); vb[(jb + 1) & 1][q] = *(const GAS v4u*)(VQ + (size_t)(eb[(jb + 1) & 1][q] & (NEXP - 1)) * DM + lane * 16); } }
                __builtin_amdgcn_sched_barrier(0);
#pragma unroll
                for (int q = 0; q < 8; ++q) { const int tk_ = (eb[jb & 1][q] >> 14) & 3; const v4u v_ = vb[jb & 1][q]; const float a_ = rdlane(areg, 8 * jb + q);
                    if (tk_ == 0) GA_AXPY(v_, a_, 0); else if (tk_ == 1) GA_AXPY(v_, a_, 1); else if (tk_ == 2) GA_AXPY(v_, a_, 2); else GA_AXPY(v_, a_, 3); }
                __builtin_amdgcn_sched_barrier(0);
            }
        }
#undef GA_AXPY
#pragma unroll
        for (int tk = 0; tk < 4; ++tk) {
            float* hrow = F.out + (size_t)(4 * tg + tk) * DM + lane * 16;
            float hv[16]; float ss = 0.f;
#pragma unroll
            for (int q = 0; q < 4; ++q) { const f32x4 h4 = *(const GAS f32x4*)(hrow + 4 * q);
#pragma unroll
                for (int i = 0; i < 4; ++i) { const float v = h4[i] + y[tk][4 * q + i]; hv[4 * q + i] = v; ss += v * v; } }
            const float rstd = frsq(wave_sum(ss) * (1.f / DM) + RMS_EPS);
#pragma unroll
            for (int q = 0; q < 4; ++q) { const f32x4 n4 = *(const GAS f32x4*)(nf + lane * 16 + 4 * q);
                *(GAS f32x4*)(outp + (size_t)(4 * tg + tk) * DM + lane * 16 + 4 * q) = (f32x4){hv[4 * q] * rstd * n4[0], hv[4 * q + 1] * rstd * n4[1], hv[4 * q + 2] * rstd * n4[2], hv[4 * q + 3] * rstd * n4[3]}; }
        }
    }
}

struct Args { const float* in[21]; float* out; unsigned char* ws; int ph_lo, ph_hi; };
static_assert(sizeof(Args) == 21 * 8 + 8 + 8 + 8, "Args has no padding");

__global__ void __launch_bounds__(NTHREADS, 2) fwd_kernel(Args args) {
    extern __shared__ __attribute__((aligned(16))) unsigned char lds[];
    Frame F;
    F.lds = (LAS unsigned char*)lds;
    F.MISC = (volatile LAS unsigned*)(F.lds + MISC_OFF);
    F.tid = threadIdx.x; F.lane = F.tid & 63; F.wave = __builtin_amdgcn_readfirstlane(F.tid >> 6);
    F.G = gridDim.x; F.wg = blockIdx.x;
#pragma unroll
    for (int i = 0; i < 21; ++i) F.in[i] = args.in[i];
    F.out = args.out; F.ws = args.ws;
    F.ctl = (gu32*)(args.ws + WS_CTL);
    for (int u = F.tid; u < (LDS_BYTES - LDSCTL_OFF) / 4; u += NTHREADS) ((LAS unsigned*)(F.lds + LDSCTL_OFF))[u] = 0u;
    __syncthreads();
    const int lo = args.ph_lo, hi = args.ph_hi;
    const bool fused = (hi - lo) > 1;
    XcdBarrier bar; bar.bar = (unsigned*)(F.ctl + CW_BAR); bar.x = 0; bar.st = nullptr;
    if (fused) bar = xcd_barrier_post((unsigned*)(F.ctl + CW_BAR), F.MISC + 8);
#define IN(k) (lo <= (k) && (k) < hi)
#define REPS(k) (((REP_MASK >> (k)) & 1) ? 2 : 1)
#define REPLOOP(k) for (int rep_ = 0; rep_ < REPS(k); ++rep_, (rep_ < REPS(k) ? xcd_barrier(bar) : (void)0))
#define SEAM(k) do { if (IN(k) && IN((k) + 1)) xcd_barrier(bar); } while (0)

    if (IN(0)) { REPLOOP(0) { p0_prologue(F); p0_rope_table(F); } SEAM(0); }
    if (IN(1)) { REPLOOP(1) {
        pg8::Gemm g{(const bf16*)(F.ws + WS_XN), (const bf16*)(F.ws + WS_WIN), T, IN_COLS, DM}; pg8::StaticOrder S; S.init(T, IN_COLS, F.G, F.wg);
        pg8::EpiBf16 E{(bf16*)(F.ws + WS_Z), IN_COLS};
        pg8::gemm_phase<pg8::EpiBf16, pg8::StaticOrder, true, true>(F.lds + RING_OFF, g, S, E); }
        {
            const int nwg = (T / 256) * (IN_COLS / 256), rem = nwg % F.G;
            if (rem == 0) quantize_tables(F, F.wg * NWAVES + F.wave, F.G * NWAVES);
            else if (F.wg >= rem) quantize_tables(F, (F.wg - rem) * NWAVES + F.wave, (F.G - rem) * NWAVES);
        }
        SEAM(1);
    }
    if (IN(2)) { p2_rope(F); REPLOOP(2) { const int cnt = r13_count(F.wg, F.G); R1Pre P;
            if (cnt > 0) rwkv_r1_prefetch(F, r13_item(F.wg, F.G, 0), F.tid, P);
            bf16x8 bfr[4]; int hcur = -1;
            f32x4 cst[4];
            { const int n16 = F.lane & 15, g = F.lane >> 4;
#pragma unroll
              for (int rt = 0; rt < 4; ++rt)
#pragma unroll
                  for (int q = 0; q < 4; ++q) cst[rt][q] = (F.wave < 4 && 16 * rt + 4 * g + q == 16 * F.wave + n16) ? 1.f : 0.f; }
            for (int i = 0; i < cnt; ++i) { const int it = r13_item(F.wg, F.G, i), hh_ = (it >> 7) & 7;
                if (hh_ != hcur) { r1_load_bfrag(F, hh_, F.wave, F.lane, bfr); hcur = hh_; }
                rwkv_r1_item(F, it, i + 1 < cnt ? r13_item(F.wg, F.G, i + 1) : -1, P, bfr, cst); }
            { const int n16 = F.lane & 15, g = F.lane >> 4; float* Pg = (float*)(F.ws + WS_PQ) + (size_t)F.wg * 4096; float* Qg = Pg + (size_t)256 * 4096;
              if (F.wave < 4) {
#pragma unroll
                  for (int rt = 0; rt < 4; ++rt)
#pragma unroll
                      for (int q = 0; q < 4; ++q) Pg[(16 * rt + 4 * g + q) * 64 + 16 * F.wave + n16] = cst[rt][q];
              } else {
#pragma unroll
                  for (int rt = 0; rt < 4; ++rt) *(GAS f32x4*)(Qg + (16 * (F.wave - 4) + n16) * 64 + 16 * rt + 4 * g) = cst[rt];
              } } }
        SEAM(2); }
    if (IN(3)) { REPLOOP(3) p3_mixers(F); SEAM(3); }
    if (IN(4)) { REPLOOP(4) { const int cnt = r13_count(F.wg, F.G); R3Pre P;
            {
                const int item0 = r13_item(F.wg, F.G, 0);
                rwkv_scan<15, 7>(F, F.out + (size_t)item0 * 4096, F.out + (size_t)T * RWW + (size_t)item0 * 4096, (float*)(F.ws + WS_RWSS) + (size_t)item0 * 4096, (const float*)(F.ws + WS_SSEG) + (size_t)F.wg * 4096);
                asm volatile("s_waitcnt vmcnt(0)" ::: "memory"); __syncthreads();
            }
            if (cnt > 0) rwkv_r3_prefetch(F, r13_item(F.wg, F.G, 0), F.tid, P);
            bf16x8 bfr[8]; int hcur = -1;
            for (int i = 0; i < cnt; ++i) { const int it = r13_item(F.wg, F.G, i), hh_ = (it >> 7) & 7;
                if (hh_ != hcur) { r3_load_bfrag(F, hh_, F.wave, F.lane, bfr); hcur = hh_; }
                rwkv_r3_item(F, it, i + 1 < cnt ? r13_item(F.wg, F.G, i + 1) : -1, P, bfr); } }
        SEAM(4); }
    if (IN(5)) {
        pg8::Gemm g{(const bf16*)(F.ws + WS_YMIX), (const bf16*)(F.ws + WS_WOUT), T, DM, DM}; pg8::StaticOrder S; S.init(T, DM, F.G, F.wg);
        pg8::EpiF32Res E{F.in[0], F.out, DM, (bf16*)(F.ws + WS_XN), F.in[15], (float*)(F.ws + WS_SSQ)};
        pg8::gemm_phase<pg8::EpiF32Res, pg8::StaticOrder, true, true>(F.lds + RING_OFF, g, S, E);
        SEAM(5);
    }
    if (IN(6)) { REPLOOP(6) {
        pg8::Gemm g{(const bf16*)(F.ws + WS_XN), (const bf16*)(F.ws + WS_WQ), T, PQ, DM}; pg8::StaticOrder S; S.init(T, PQ, F.G, F.wg);
        pg8::EpiBf16Rs E{(bf16*)(F.ws + WS_QP), PQ, (const float*)(F.ws + WS_SSQ)};
        pg8::gemm_phase<pg8::EpiBf16Rs, pg8::StaticOrder, true, true>(F.lds + RING_OFF, g, S, E); }
        SEAM(6);
    }
    if (IN(7)) { REPLOOP(7) p7_topk(F); SEAM(7); }
    if (IN(8)) { if (REPS(8) > 1) { p8_gather(F, (float*)(F.ws + WS_Z)); xcd_barrier(bar); } p8_gather(F, F.out); }
#undef IN
#undef SEAM
}

extern "C" void kernel_launch(void* const* d_in, const int* in_sizes, int n_in, void* d_out, int out_size, void* d_ws, size_t ws_size, hipStream_t stream) {
    static int grid = 0;
    if (grid == 0) {
        if (n_in != 21 || in_sizes[0] != T * DM || out_size != T * DM || ws_size < WS_END) {
            fprintf(stderr, "kernel_launch: unexpected shapes: n_in %d in0 %d out %d ws %zu (need %zu); nothing launched\n", n_in, n_in > 0 ? in_sizes[0] : -1, out_size, ws_size, (size_t)WS_END); grid = -1; return; }
        int dev = 0, cus = 0, per_cu = 0;
        if (hipGetDevice(&dev) != hipSuccess || hipDeviceGetAttribute(&cus, hipDeviceAttributeMultiprocessorCount, dev) != hipSuccess) { grid = -1; return; }
        if (hipFuncSetAttribute((const void*)fwd_kernel, hipFuncAttributeMaxDynamicSharedMemorySize, LDS_BYTES) != hipSuccess) { fprintf(stderr, "kernel_launch: hipFuncSetAttribute failed\n"); grid = -1; return; }
        if (hipOccupancyMaxActiveBlocksPerMultiprocessor(&per_cu, (const void*)fwd_kernel, NTHREADS, LDS_BYTES) != hipSuccess || per_cu < 1) { fprintf(stderr, "kernel_launch: occupancy query says %d\n", per_cu); per_cu = 1; }
        (void)hipGetLastError();
        grid = cus;
        if (cus != 256) { fprintf(stderr, "kernel_launch: the RWKV segment mapping assumes 256 CUs (got %d); nothing launched\n", cus); grid = -1; return; }
    }
    if (grid < 0) return;
    (void)hipMemsetAsync((char*)d_ws + WS_CTL, 0, CTL_ZERO_BYTES, stream);
    Args a{};
    for (int i = 0; i < 21; ++i) a.in[i] = (const float*)d_in[i];
    a.out = (float*)d_out; a.ws = (unsigned char*)d_ws;
    if (MK_N_LAUNCHES == 1) {
        a.ph_lo = 0; a.ph_hi = NPHASE;
        void* kargs[] = {&a};
        hipError_t e = hipLaunchCooperativeKernel((const void*)fwd_kernel, dim3(grid), dim3(NTHREADS), kargs, LDS_BYTES, stream);
        if (e != hipSuccess) fprintf(stderr, "kernel_launch: cooperative launch failed: %s (grid %d)\n", hipGetErrorString(e), grid);
    } else {
        for (int p = 0; p < NPHASE; ++p) { a.ph_lo = p; a.ph_hi = p + 1;
            hipLaunchKernelGGL(fwd_kernel, dim3(grid), dim3(NTHREADS), LDS_BYTES, stream, a); }
    }
}
```

```cpp
#include <hip/hip_runtime.h>
#include <cstdio>
#include <cstdint>

#ifndef MK_N_LAUNCHES
#define MK_N_LAUNCHES 1
#endif

#ifndef REP_MASK
#define REP_MASK 0
#endif
#define GAS __attribute__((address_space(1)))
#define LAS __attribute__((address_space(3)))
typedef unsigned short bf16;
typedef unsigned v4u __attribute__((ext_vector_type(4)));
typedef unsigned v2u __attribute__((ext_vector_type(2)));
typedef float f32x4 __attribute__((ext_vector_type(4)));
typedef float f32x2 __attribute__((ext_vector_type(2)));
typedef short bf16x8 __attribute__((ext_vector_type(8)));
typedef GAS unsigned gu32;
#define RLX_AGENT __ATOMIC_RELAXED, __HIP_MEMORY_SCOPE_AGENT
#define LDS_WAIT() asm volatile("s_waitcnt lgkmcnt(0)" ::: "memory")
#define VM_WAIT() asm volatile("s_waitcnt vmcnt(0)" ::: "memory")
#define LDS_BARRIER() do { asm volatile("s_waitcnt lgkmcnt(0)" ::: "memory"); __builtin_amdgcn_s_barrier(); asm volatile("" ::: "memory"); } while (0)

constexpr int DM = 1024, NB = 4, SEQ = 8192, T = NB * SEQ;
constexpr int HD = 64, RWW = 512, NHR = 8, NHA = 8;
constexpr int IN_COLS = 3328;
constexpr int C_R = 0, C_K = 512, C_V = 1024, C_WD = 1536, C_AD = 1600, C_GD = 1664, C_AQ = 1792, C_AK = 2304, C_AV = 2816;
constexpr int PHEADS = 8, NKEYS = 128, PQ = 2048, TOPK = 16, NEXP = 16384;
constexpr float RMS_EPS = 1e-6f, GN_EPS = 64e-5f;
constexpr int NWAVES = 8, NTHREADS = 512;
constexpr int NPHASE = 9;

constexpr size_t MiB = 1u << 20;
constexpr size_t WS_CTL = 0, CTL_ZERO_BYTES = 1 * MiB;
constexpr size_t WS_WIN = 2 * MiB;
constexpr size_t WS_WOUT = 10 * MiB;
constexpr size_t WS_WQ = 12 * MiB;
constexpr size_t WS_XN = 16 * MiB;
constexpr size_t WS_Z = 80 * MiB;
constexpr size_t WS_QP = 80 * MiB;
constexpr size_t WS_G = 288 * MiB;
constexpr size_t WS_YMIX = 352 * MiB;
constexpr size_t WS_UQ = 416 * MiB;
constexpr size_t WS_VQ = 432 * MiB;
constexpr size_t WS_SU = 448 * MiB;
constexpr size_t WS_SV = 449 * MiB;
constexpr size_t WS_EID = 480 * MiB;
constexpr size_t WS_GATE = 496 * MiB;
constexpr size_t WS_SSEG = 450 * MiB;
constexpr size_t WS_PQ = 456 * MiB;
constexpr size_t WS_END = 512 * MiB;
constexpr size_t WS_WUPT = 1 * MiB, WS_AUPT = WS_WUPT + 65536, WS_GUPT = WS_AUPT + 65536;
constexpr size_t WS_BONUS = 9 * MiB;
constexpr size_t WS_RWY0 = WS_XN;
constexpr size_t WS_RWSS = WS_G;
constexpr size_t WS_RWRH = WS_EID;

constexpr int CW_BAR = 4096;
constexpr size_t WS_SSQ = 256 * 1024;

typedef __bf16 hbf16x2_t __attribute__((ext_vector_type(2)));
__device__ __forceinline__ unsigned pk2(float lo, float hi) { const f32x2 v = {lo, hi}; const hbf16x2_t b = __builtin_convertvector(v, hbf16x2_t); return __builtin_bit_cast(unsigned, b); }
__device__ __forceinline__ unsigned f2bf(float f) { return pk2(f, 0.f) & 0xffffu; }
__device__ __forceinline__ float frcp(float x) { return __builtin_amdgcn_rcpf(x); }
__device__ __forceinline__ float frsq(float x) { return __builtin_amdgcn_rsqf(x); }
__device__ __forceinline__ float bflo(unsigned u) { return __builtin_bit_cast(float, u << 16); }
__device__ __forceinline__ float bfhi(unsigned u) { return __builtin_bit_cast(float, u & 0xffff0000u); }
__device__ __forceinline__ float bf2f(bf16 h) { return __builtin_bit_cast(float, (unsigned)h << 16); }

template <int CTRL> __device__ __forceinline__ float dppf(float x) { return __builtin_bit_cast(float, __builtin_amdgcn_update_dpp(0, __builtin_bit_cast(int, x), CTRL, 0xF, 0xF, true)); }
template <int CTRL> __device__ __forceinline__ int dppi(int x) { return __builtin_amdgcn_update_dpp(0, x, CTRL, 0xF, 0xF, true); }
__device__ __forceinline__ float rdlane(float v, int l) { return __builtin_bit_cast(float, __builtin_amdgcn_readlane(__builtin_bit_cast(int, v), l)); }
__device__ __forceinline__ float sum8(float v) { v += dppf<0xB1>(v); v += dppf<0x4E>(v); v += dppf<0x141>(v); return v; }
__device__ __forceinline__ float sum16(float v) { v = sum8(v); v += dppf<0x140>(v); return v; }
__device__ __forceinline__ float wave_sum(float v) { v = sum16(v);
    v += __builtin_bit_cast(float, __builtin_amdgcn_update_dpp(0, __builtin_bit_cast(int, v), 0x142, 0xA, 0xF, false));
    v += __builtin_bit_cast(float, __builtin_amdgcn_update_dpp(0, __builtin_bit_cast(int, v), 0x143, 0xC, 0xF, false));
    return rdlane(v, 63); }
__device__ __forceinline__ float wave_max(float v) {
    v = fmaxf(v, dppf<0xB1>(v)); v = fmaxf(v, dppf<0x4E>(v)); v = fmaxf(v, dppf<0x141>(v)); v = fmaxf(v, dppf<0x140>(v));
    return fmaxf(fmaxf(rdlane(v, 0), rdlane(v, 16)), fmaxf(rdlane(v, 32), rdlane(v, 48)));
}

namespace pg8 {
#define PG8_LAS __attribute__((address_space(3)))
typedef unsigned short bf16_t;
typedef unsigned u32x4 __attribute__((ext_vector_type(4)));
constexpr int BM = 256, BK = 64, HALF = 128, HTB = HALF * BK * 2, STAGE_BYTES = 8 * HTB, NXCD = 8, WGM = 8;
__host__ __device__ __forceinline__ int lds_byte(int r, int c) { const int st = (r >> 4) * 2 + (c >> 5), rr = r & 15, cc = c & 31, ob = rr * 64 + cc * 2; return st * 1024 + (ob ^ (((ob >> 9) & 1) << 5)); }
__host__ __device__ __forceinline__ void stage_rc(int b, int& R, int& C) { const int st = b / 1024, sb = b % 1024, swz = sb ^ (((sb >> 9) & 1) << 5); R = (st >> 1) * 16 + swz / 64; C = (st & 1) * 32 + (swz % 64) / 2; }
__host__ __device__ __forceinline__ int perm32(int rho) { const int n = rho >> 4, i = rho & 15; return 8 * (i >> 2) + 4 * n + (i & 3); }
struct Unit { int pm, pn; };
struct Gemm { const bf16_t* A; const bf16_t* Bt; int M, N, K; };
struct StaticOrder {
    int nM, nN, nwg, G, c;
    __host__ __device__ void init(int M, int N, int G_, int c_) { nM = M / BM; nN = N / BM; nwg = nM * nN; G = G_; c = c_; }
    __host__ __device__ bool next(int i, Unit& u) const {
        const long L = (long)i * G + c; if (L >= nwg) return false;
        int wgid = (int)L; { const int q = nwg / NXCD, r = nwg % NXCD, xcd = wgid % NXCD, off = wgid / NXCD; wgid = (xcd < r ? xcd * (q + 1) : r * (q + 1) + (xcd - r) * q) + off; }
        const int nig = WGM * nN, gid = wgid / nig, fm = gid * WGM, gsz = (nM - fm) < WGM ? (nM - fm) : WGM;
        u.pm = fm + ((wgid % nig) % gsz); u.pn = (wgid % nig) / gsz; return true;
    }
    __device__ __forceinline__ void a_ready(const Unit&) const {}
    __device__ __forceinline__ void done(const Unit&) const {}
};
__device__ __forceinline__ unsigned cvt_pk_bf16(float lo, float hi) { unsigned r; asm volatile("v_cvt_pk_bf16_f32 %0, %1, %2" : "=v"(r) : "v"(lo), "v"(hi)); return r; }
struct EpiBf16 {
    static constexpr bool PERM = true, AFTER_DRAIN = false;
    bf16_t* O; int ldc;
    __device__ __forceinline__ void operator()(const f32x4 (&acc)[2][2][4][2], const Unit& u, int wr, int wc, int fr, int fq) const {
        const int row0 = u.pm * BM + wr * 64 + fr; const int col0 = u.pn * BM + wc * 32 + 8 * fq;
#pragma unroll
        for (int ai = 0; ai < 2; ++ai)
#pragma unroll
            for (int m = 0; m < 4; ++m) { bf16_t* rowp = O + (size_t)(row0 + ai * HALF + m * 16) * ldc + col0;
#pragma unroll
                for (int bj = 0; bj < 2; ++bj) { const f32x4 v0 = acc[ai][bj][m][0], v1 = acc[ai][bj][m][1];
                    u32x4 w; w.x = cvt_pk_bf16(v0[0], v0[1]); w.y = cvt_pk_bf16(v0[2], v0[3]); w.z = cvt_pk_bf16(v1[0], v1[1]); w.w = cvt_pk_bf16(v1[2], v1[3]);
                    *(u32x4*)(rowp + bj * HALF) = w; } }
    }
};
struct EpiF32Res {
    static constexpr bool PERM = true, AFTER_DRAIN = false;
    const float* res; float* O; int ldc; bf16_t* HG; const float* gain; float* ssq;
    __device__ __forceinline__ void operator()(const f32x4 (&acc)[2][2][4][2], const Unit& u, int wr, int wc, int fr, int fq) const {
        const int row0 = u.pm * BM + wr * 64 + fr; const int col0 = u.pn * BM + wc * 32 + 8 * fq;
        f32x4 gv[2][2];
#pragma unroll
        for (int bj = 0; bj < 2; ++bj) { gv[bj][0] = *(const f32x4*)(gain + col0 + bj * HALF); gv[bj][1] = *(const f32x4*)(gain + col0 + bj * HALF + 4); }
#pragma unroll
        for (int ai = 0; ai < 2; ++ai)
#pragma unroll
            for (int m = 0; m < 4; ++m) { const int row = row0 + ai * HALF + m * 16; const size_t off = (size_t)row * ldc + col0; float sq = 0.f;
#pragma unroll
                for (int bj = 0; bj < 2; ++bj) { const f32x4 r0 = *(const f32x4*)(res + off + bj * HALF), r1 = *(const f32x4*)(res + off + bj * HALF + 4);
                    const f32x4 h0 = acc[ai][bj][m][0] + r0, h1 = acc[ai][bj][m][1] + r1;
                    *(f32x4*)(O + off + bj * HALF) = h0; *(f32x4*)(O + off + bj * HALF + 4) = h1;
                    sq += (h0[0] * h0[0] + h0[1] * h0[1]) + (h0[2] * h0[2] + h0[3] * h0[3]) + (h1[0] * h1[0] + h1[1] * h1[1]) + (h1[2] * h1[2] + h1[3] * h1[3]);
                    const f32x4 g0 = gv[bj][0], g1 = gv[bj][1];
                    u32x4 w; w.x = cvt_pk_bf16(h0[0] * g0[0], h0[1] * g0[1]); w.y = cvt_pk_bf16(h0[2] * g0[2], h0[3] * g0[3]); w.z = cvt_pk_bf16(h1[0] * g1[0], h1[1] * g1[1]); w.w = cvt_pk_bf16(h1[2] * g1[2], h1[3] * g1[3]);
                    *(u32x4*)(HG + off + bj * HALF) = w; }
                sq += __shfl_xor(sq, 16); sq += __shfl_xor(sq, 32);
                if (fq == 0) atomicAdd(ssq + row, sq); }
    }
};
struct EpiBf16Rs {
    static constexpr bool PERM = true, AFTER_DRAIN = false;
    bf16_t* O; int ldc; const float* ssq;
    __device__ __forceinline__ void operator()(const f32x4 (&acc)[2][2][4][2], const Unit& u, int wr, int wc, int fr, int fq) const {
        const int row0 = u.pm * BM + wr * 64 + fr; const int col0 = u.pn * BM + wc * 32 + 8 * fq;
#pragma unroll
        for (int ai = 0; ai < 2; ++ai)
#pragma unroll
            for (int m = 0; m < 4; ++m) { const int row = row0 + ai * HALF + m * 16; bf16_t* rowp = O + (size_t)row * ldc + col0;
                const float rs = __builtin_amdgcn_rsqf(ssq[row] * (1.f / 1024.f) + 1e-6f);
#pragma unroll
                for (int bj = 0; bj < 2; ++bj) { const f32x4 v0 = acc[ai][bj][m][0] * rs, v1 = acc[ai][bj][m][1] * rs;
                    u32x4 w; w.x = cvt_pk_bf16(v0[0], v0[1]); w.y = cvt_pk_bf16(v0[2], v0[3]); w.z = cvt_pk_bf16(v1[0], v1[1]); w.w = cvt_pk_bf16(v1[2], v1[3]);
                    *(u32x4*)(rowp + bj * HALF) = w; } }
    }
};

template <class Epi, class Sched, bool ALIGN_EPI = false, bool SP2 = false>
__device__ __forceinline__ void gemm_phase(PG8_LAS unsigned char* lds, const Gemm g, const Sched& S, const Epi& E) {
    const int tid = threadIdx.x, wid = __builtin_amdgcn_readfirstlane(tid >> 6), lane = tid & 63, wr = wid >> 2, wc = wid & 3, fr = lane & 15, fq = lane >> 4;
    const int K = g.K, nt = K / BK;
    unsigned voffA[2], voffB[2];
#pragma unroll
    for (int i = 0; i < 2; ++i) { int R, C; stage_rc(tid * 16 + i * 8192, R, C); const int Rb = Epi::PERM ? ((R & ~31) + perm32(R & 31)) : R;
        voffA[i] = (unsigned)(R * K + C) * 2u; voffB[i] = (unsigned)(Rb * K + C) * 2u; }
    const size_t kstep = (size_t)(BK * 2);
    const size_t hstep = (size_t)HALF * K * 2;
    const size_t tstep = 2 * hstep;
    const unsigned ldsw = (unsigned)wid * 1024u;
    const int aoff = lds_byte(wr * 64 + fr, fq * 8), boff = lds_byte(wc * 32 + fr, fq * 8);
#define PG8_SA(b, h) (((b) * 2 + (h)) * HTB)
#define PG8_SB(b, h) ((4 + (b) * 2 + (h)) * HTB)
#define PG8_STAGE(bufoff, gbase, voff) do { _Pragma("unroll") for (int _i = 0; _i < 2; ++_i) \
        __builtin_amdgcn_global_load_lds((const unsigned*)((const char*)(gbase) + (voff)[_i]), (PG8_LAS unsigned*)(lds + (bufoff) + ldsw + _i * 8192), 16, 0, 0); } while (0)
#define PG8_LDA(dst, b, h) do { _Pragma("unroll") for (int m = 0; m < 4; ++m) _Pragma("unroll") for (int k = 0; k < 2; ++k) dst[m][k] = *(const PG8_LAS bf16x8*)(lds + PG8_SA(b, h) + aoff + m * 2048 + k * 1024); } while (0)
#define PG8_LDB(dst, b, h) do { _Pragma("unroll") for (int n = 0; n < 2; ++n) _Pragma("unroll") for (int k = 0; k < 2; ++k) dst[n][k] = *(const PG8_LAS bf16x8*)(lds + PG8_SB(b, h) + boff + n * 2048 + k * 1024); } while (0)
#define PG8_MMA(ai, bj, At, Bt) do { __builtin_amdgcn_s_setprio(1); _Pragma("unroll") for (int m = 0; m < 4; ++m) _Pragma("unroll") for (int n = 0; n < 2; ++n) _Pragma("unroll") for (int k = 0; k < 2; ++k) \
        acc[ai][bj][m][n] = __builtin_amdgcn_mfma_f32_16x16x32_bf16(Bt[n][k], At[m][k], acc[ai][bj][m][n], 0, 0, 0); __builtin_amdgcn_s_setprio(0); } while (0)
#define PG8_WAIT_V(n) asm volatile("s_waitcnt vmcnt(" #n ")" ::: "memory")
#define PG8_WAIT_L(n) asm volatile("s_waitcnt lgkmcnt(" #n ")" ::: "memory")
#define PG8_BAR __builtin_amdgcn_s_barrier()
#define PG8_SCHED __builtin_amdgcn_sched_barrier(0)
    Unit cur, nxt; int ui = 0;
    if (!S.next(0, cur)) return;
    f32x4 acc[2][2][4][2];
#pragma unroll
    for (int a = 0; a < 2; ++a)
#pragma unroll
        for (int b = 0; b < 2; ++b)
#pragma unroll
            for (int m = 0; m < 4; ++m)
#pragma unroll
                for (int n = 0; n < 2; ++n) acc[a][b][m][n] = (f32x4){0.f, 0.f, 0.f, 0.f};
    bf16x8 At[4][2], B0[2][2], B1[2][2];
    const char* cA = (const char*)g.A + (size_t)cur.pm * tstep; const char* cB = (const char*)g.Bt + (size_t)cur.pn * tstep;
    S.a_ready(cur);
    if constexpr (SP2) {
        PG8_STAGE(PG8_SB(0, 0), cB, voffB); PG8_STAGE(PG8_SB(0, 1), cB + hstep, voffB); PG8_STAGE(PG8_SA(0, 0), cA, voffA); PG8_STAGE(PG8_SA(0, 1), cA + hstep, voffA);
        if (wr == 1) PG8_BAR;
        PG8_WAIT_V(2); PG8_BAR;
        PG8_STAGE(PG8_SB(1, 0), cB + kstep, voffB); PG8_STAGE(PG8_SA(1, 0), cA + kstep, voffA); PG8_STAGE(PG8_SB(1, 1), cB + hstep + kstep, voffB);
        PG8_WAIT_V(6); PG8_BAR;
    } else {
        PG8_STAGE(PG8_SB(0, 0), cB, voffB); PG8_STAGE(PG8_SA(0, 0), cA, voffA); PG8_STAGE(PG8_SB(0, 1), cB + hstep, voffB); PG8_STAGE(PG8_SA(0, 1), cA + hstep, voffA);
        if (wr == 1) PG8_BAR;
        PG8_WAIT_V(4); PG8_BAR;
        PG8_STAGE(PG8_SB(1, 0), cB + kstep, voffB); PG8_STAGE(PG8_SA(1, 0), cA + kstep, voffA); PG8_STAGE(PG8_SB(1, 1), cB + hstep + kstep, voffB);
        PG8_WAIT_V(6); PG8_BAR;
    }
    for (;;) {
        const bool has_next = S.next(ui + 1, nxt);
        const char* nA = has_next ? (const char*)g.A + (size_t)nxt.pm * tstep : cA; const char* nB = has_next ? (const char*)g.Bt + (size_t)nxt.pn * tstep : cB;
        for (int t = 0; t < nt; t += 2) {
            const bool last = (t == nt - 2);
            const char* a1 = cA + (size_t)(t + 1) * kstep;
            const char* a2 = last ? nA : cA + (size_t)(t + 2) * kstep; const char* b2 = last ? nB : cB + (size_t)(t + 2) * kstep;
            const char* a3 = a2 + kstep; const char* b3 = b2 + kstep;
            if (last && has_next) S.a_ready(nxt);
            if constexpr (SP2) {
            PG8_LDB(B0, 0, 0); PG8_LDB(B1, 0, 1); PG8_SCHED; PG8_LDA(At, 0, 0); PG8_STAGE(PG8_SA(1, 1), a1 + hstep, voffA);
            PG8_WAIT_V(8); PG8_WAIT_L(0); PG8_BAR; PG8_MMA(0, 0, At, B0); PG8_MMA(0, 1, At, B1); PG8_BAR; PG8_SCHED;
            PG8_LDA(At, 0, 1); PG8_STAGE(PG8_SB(0, 0), b2, voffB); PG8_STAGE(PG8_SB(0, 1), b2 + hstep, voffB); PG8_STAGE(PG8_SA(0, 0), a2, voffA);
            PG8_WAIT_V(8); PG8_WAIT_L(0); PG8_BAR; PG8_MMA(1, 0, At, B0); PG8_MMA(1, 1, At, B1); PG8_BAR; PG8_SCHED;
            PG8_LDB(B0, 1, 0); PG8_LDB(B1, 1, 1); PG8_SCHED; PG8_LDA(At, 1, 0); PG8_STAGE(PG8_SA(0, 1), a2 + hstep, voffA);
            PG8_WAIT_V(8); PG8_WAIT_L(0); PG8_BAR; PG8_MMA(0, 0, At, B0); PG8_MMA(0, 1, At, B1); PG8_BAR; PG8_SCHED;
            PG8_LDA(At, 1, 1); PG8_STAGE(PG8_SB(1, 0), b3, voffB); PG8_STAGE(PG8_SB(1, 1), b3 + hstep, voffB); PG8_STAGE(PG8_SA(1, 0), a3, voffA);
            PG8_WAIT_V(8); PG8_WAIT_L(0); PG8_BAR; PG8_MMA(1, 0, At, B0); PG8_MMA(1, 1, At, B1); PG8_BAR; PG8_SCHED;
            } else {
            PG8_LDB(B0, 0, 0); PG8_SCHED; PG8_LDA(At, 0, 0); PG8_STAGE(PG8_SA(1, 1), a1 + hstep, voffA);
            PG8_WAIT_L(8); PG8_BAR; PG8_WAIT_L(0); PG8_MMA(0, 0, At, B0); PG8_BAR; PG8_SCHED;
            PG8_LDB(B1, 0, 1); PG8_STAGE(PG8_SB(0, 0), b2, voffB);
            PG8_BAR; PG8_WAIT_L(0); PG8_MMA(0, 1, At, B1); PG8_BAR;
            PG8_LDA(At, 0, 1); PG8_STAGE(PG8_SA(0, 0), a2, voffA);
            PG8_BAR; PG8_WAIT_L(0); PG8_MMA(1, 0, At, B0); PG8_BAR; PG8_SCHED;
            PG8_STAGE(PG8_SB(0, 1), b2 + hstep, voffB);
            PG8_WAIT_V(6); PG8_BAR; PG8_MMA(1, 1, At, B1); PG8_BAR;
            PG8_LDB(B0, 1, 0); PG8_SCHED; PG8_LDA(At, 1, 0); PG8_STAGE(PG8_SA(0, 1), a2 + hstep, voffA);
            PG8_WAIT_L(8); PG8_BAR; PG8_WAIT_L(0); PG8_MMA(0, 0, At, B0); PG8_BAR; PG8_SCHED;
            PG8_LDB(B1, 1, 1); PG8_STAGE(PG8_SB(1, 0), b3, voffB);
            PG8_BAR; PG8_WAIT_L(0); PG8_MMA(0, 1, At, B1); PG8_BAR;
            PG8_LDA(At, 1, 1); PG8_STAGE(PG8_SA(1, 0), a3, voffA);
            PG8_BAR; PG8_WAIT_L(0); PG8_MMA(1, 0, At, B0); PG8_BAR; PG8_SCHED;
            PG8_STAGE(PG8_SB(1, 1), b3 + hstep, voffB);
            PG8_WAIT_V(6); PG8_BAR; PG8_MMA(1, 1, At, B1); PG8_BAR;
            }
        }
        if constexpr (ALIGN_EPI) { if (wr == 0) PG8_BAR; }
        if constexpr (!Epi::AFTER_DRAIN) { E(acc, cur, wr, wc, fr, fq); S.done(cur); }
        if (!has_next) break;
#pragma unroll
        for (int a = 0; a < 2; ++a)
#pragma unroll
            for (int b = 0; b < 2; ++b)
#pragma unroll
                for (int m = 0; m < 4; ++m)
#pragma unroll
                    for (int n = 0; n < 2; ++n) acc[a][b][m][n] = (f32x4){0.f, 0.f, 0.f, 0.f};
        cur = nxt; cA = nA; cB = nB; ++ui;
        if constexpr (ALIGN_EPI) { if (wr == 1) PG8_BAR; }
    }
    PG8_WAIT_V(0);
    if constexpr (!ALIGN_EPI) { if (wr == 0) PG8_BAR; }
    PG8_BAR;
#undef PG8_SA
#undef PG8_SB
#undef PG8_STAGE
#undef PG8_LDA
#undef PG8_LDB
#undef PG8_MMA
#undef PG8_WAIT_V
#undef PG8_WAIT_L
#undef PG8_BAR
#undef PG8_SCHED
}
}

#define XB_TMO      128
#define XB_XCNT(j)  (256  + 64 * (j))
#define XB_XSUB(j)  (1280 + 64 * (j))
#define XB_XGEN(j)  (2304 + 64 * (j))
#define XB_TOP      3328
#define XB_TOPGEN   3392
#define XCD_BAR_WORDS 3456
#define XB_SPIN_CAP (1u << 22)
__device__ __forceinline__ unsigned xb_ld(unsigned* p)              { return __hip_atomic_load(p, __ATOMIC_RELAXED, __HIP_MEMORY_SCOPE_AGENT); }
__device__ __forceinline__ unsigned xb_add(unsigned* p, unsigned v) { return __hip_atomic_fetch_add(p, v, __ATOMIC_RELAXED, __HIP_MEMORY_SCOPE_AGENT); }
__device__ __forceinline__ unsigned xb_xcc_id() { return (unsigned)__builtin_amdgcn_s_getreg((3 << 11) | 20) & 0xFu; }
#define XB_SPIN(cond, bar) do { unsigned _sp = 0; while (cond) { __builtin_amdgcn_s_sleep(1); \
    if ((++_sp & 255u) == 0u) { if (xb_ld(&(bar)[XB_TMO])) break; if (_sp > XB_SPIN_CAP) { atomicAdd(&(bar)[XB_TMO], 1u); break; } } } } while (0)
struct XcdBarrier { unsigned* bar; unsigned x; volatile LAS unsigned* st; };
__device__ __forceinline__ XcdBarrier xcd_barrier_post(unsigned* bar, volatile LAS unsigned* st) {
    XcdBarrier b; b.bar = bar; b.x = xb_xcc_id(); b.st = st;
    if (threadIdx.x == 0) (void)xb_add(&bar[XB_XCNT(b.x)], 1u);
    return b;
}
__device__ __forceinline__ void xcd_barrier_complete(unsigned* bar, unsigned x, unsigned& nloc, unsigned& nx) {
    const unsigned G = gridDim.x * gridDim.y * gridDim.z;
    unsigned sum, cnt, mine, sp = 0u;
    for (;;) {
        sum = 0u; cnt = 0u; mine = 0u;
#pragma unroll
        for (unsigned j = 0; j < 16; ++j) { const unsigned c = xb_ld(&bar[XB_XCNT(j)]); sum += c; cnt += (c > 0u) ? 1u : 0u; mine = (j == x) ? c : mine; }
        if (sum == G) break;
        __builtin_amdgcn_s_sleep(1);
        if ((++sp & 255u) == 0u) { if (xb_ld(&bar[XB_TMO])) break; if (sp > XB_SPIN_CAP) { atomicAdd(&bar[XB_TMO], 1u); break; } }
    }
    nloc = mine > 0u ? mine : 1u; nx = cnt > 0u ? cnt : 1u;
}
__device__ __forceinline__ void xcd_barrier(const XcdBarrier& b) {
    asm volatile("s_waitcnt vmcnt(0)" ::: "memory");
    __syncthreads();
    if (threadIdx.x == 0) {
        unsigned* bar = b.bar;
        __builtin_amdgcn_s_waitcnt(0);
        unsigned nloc = b.st[0], nx = b.st[1];
        if (nloc == 0u) { xcd_barrier_complete(bar, b.x, nloc, nx); b.st[0] = nloc; b.st[1] = nx; }
        const unsigned old = xb_add(&bar[XB_XSUB(b.x)], 1u);
        const unsigned gen = old / nloc;
        if (old + 1u == (gen + 1u) * nloc) {
            __builtin_amdgcn_fence(__ATOMIC_RELEASE, "agent");
            asm volatile("s_waitcnt vmcnt(0)" ::: "memory");
            const unsigned og = xb_add(&bar[XB_TOP], 1u);
            const unsigned tg = og / nx;
            if (og + 1u == (tg + 1u) * nx) xb_add(&bar[XB_TOPGEN], 1u);
            else XB_SPIN(xb_ld(&bar[XB_TOPGEN]) == tg, bar);
            __builtin_amdgcn_fence(__ATOMIC_ACQUIRE, "agent");
            xb_add(&bar[XB_XGEN(b.x)], 1u);
            asm volatile("s_waitcnt vmcnt(0)" ::: "memory");
        } else {
            XB_SPIN(xb_ld(&bar[XB_XGEN(b.x)]) == gen, bar);
            __builtin_amdgcn_fence(__ATOMIC_ACQUIRE, "agent");
            asm volatile("s_waitcnt vmcnt(0)" ::: "memory");
        }
    }
    __syncthreads();
}

constexpr int RING_OFF = 0, RING_BYTES = 131072;
constexpr int LDSCTL_OFF = 162816, MISC_OFF = LDSCTL_OFF + 320;
constexpr int LDS_BYTES = 163840;

struct Frame {
    LAS unsigned char* lds;
    volatile LAS unsigned* MISC;
    gu32* ctl;
    int tid, lane, wave, G, wg;
    const float* in[21];
    float* out;
    unsigned char* ws;
};

__device__ __forceinline__ void p0_transpose_item(const float* W, int K, int N, bf16* WT, LAS float* scr, int item, int lane) {
    const int nblk = N / 32, kb = item / nblk, nb = item % nblk, k0 = 64 * kb, n0 = 32 * nb;
#pragma unroll 8
    for (int i = 0; i < 32; ++i) { const int kk = 2 * i + (lane >> 5); scr[kk * 33 + (lane & 31)] = W[(size_t)(k0 + kk) * N + n0 + (lane & 31)]; }
    LDS_WAIT(); asm volatile("" ::: "memory");
    const int c = lane & 7;
#pragma unroll
    for (int j = 0; j < 4; ++j) { const int n = (lane >> 3) + 8 * j; const LAS float* s = scr + (8 * c) * 33 + n;
        v4u o; o.x = pk2(s[0 * 33], s[1 * 33]); o.y = pk2(s[2 * 33], s[3 * 33]); o.z = pk2(s[4 * 33], s[5 * 33]); o.w = pk2(s[6 * 33], s[7 * 33]);
        *(GAS v4u*)(WT + (size_t)(n0 + n) * K + k0 + 8 * c) = o; }
    LDS_WAIT(); asm volatile("" ::: "memory");
}
__device__ __forceinline__ void rms_row_to_bf16(int lane, const float* xrow, const float* gain, bf16* orow) {
    const GAS f32x4* xr = (const GAS f32x4*)xrow + lane;
    const GAS f32x4* gr = (const GAS f32x4*)gain + lane;
    f32x4 v[4]; float s = 0.f;
#pragma unroll
    for (int j = 0; j < 4; ++j) { v[j] = xr[64 * j]; s += (v[j].x * v[j].x + v[j].y * v[j].y) + (v[j].z * v[j].z + v[j].w * v[j].w); }
    const float rstd = frsq(wave_sum(s) * (1.f / DM) + RMS_EPS);
    GAS unsigned long long* o8 = (GAS unsigned long long*)orow + lane;
#pragma unroll
    for (int j = 0; j < 4; ++j) { const f32x4 gg = gr[64 * j];
        o8[64 * j] = (unsigned long long)pk2(v[j].x * rstd * gg.x, v[j].y * rstd * gg.y) | ((unsigned long long)pk2(v[j].z * rstd * gg.z, v[j].w * rstd * gg.w) << 32); }
}
__device__ __forceinline__ void quantize_tables(Frame& F, int gw, int ngw);
__device__ __forceinline__ void p0_prologue(Frame& F) {
    LAS float* scr = (LAS float*)(F.lds + RING_OFF + F.wave * 16384);
    const int gw = F.wg * NWAVES + F.wave, NGW = F.G * NWAVES;
    constexpr int I_IN = (DM / 64) * (IN_COLS / 32), I_OUT = (DM / 64) * (DM / 32), I_Q = (DM / 64) * (PQ / 32);
    constexpr int NITEMS = I_IN + I_OUT + I_Q;
    bf16* win_t = (bf16*)(F.ws + WS_WIN); bf16* wout_t = (bf16*)(F.ws + WS_WOUT); bf16* wq_t = (bf16*)(F.ws + WS_WQ);
    for (int it = gw; it < NITEMS; it += NGW) {
        int r = it;
        if (r < I_IN) { p0_transpose_item(F.in[2], DM, IN_COLS, win_t, scr, r, F.lane); continue; } r -= I_IN;
        if (r < I_OUT) { p0_transpose_item(F.in[14], DM, DM, wout_t, scr, r, F.lane); continue; } r -= I_OUT;
        p0_transpose_item(F.in[16], DM, PQ, wq_t, scr, r, F.lane);
    }
    {
        constexpr int I_W = (64 / 64) * (RWW / 32), I_G = (128 / 64) * (RWW / 32);
        for (int it = gw; it < 2 * I_W + I_G; it += NGW) {
            int r = it;
            if (r < I_W) { p0_transpose_item(F.in[5], 64, RWW, (bf16*)(F.ws + WS_WUPT), scr, r, F.lane); continue; } r -= I_W;
            if (r < I_W) { p0_transpose_item(F.in[7], 64, RWW, (bf16*)(F.ws + WS_AUPT), scr, r, F.lane); continue; } r -= I_W;
            p0_transpose_item(F.in[8], 128, RWW, (bf16*)(F.ws + WS_GUPT), scr, r, F.lane);
        }
    }
    bf16* XN = (bf16*)(F.ws + WS_XN);
    for (int m = gw; m < T; m += NGW) rms_row_to_bf16(F.lane, F.in[0] + (size_t)m * DM, F.in[1], XN + (size_t)m * DM);
}

constexpr size_t WS_ROPE = WS_G;
__device__ __forceinline__ void p0_rope_table(Frame& F) {
    f32x2* tab = (f32x2*)(F.ws + WS_ROPE);
    for (int e = F.wg * NTHREADS + F.tid; e < SEQ * 32; e += F.G * NTHREADS) {
        const int sp = e >> 5, i = e & 31;
        const float inv_freq = powf(10000.0f, -(float)(2 * i) / 64.0f);
        const float ang = (float)sp * inv_freq;
        const double r = (double)ang - rint((double)ang * 0.15915494309189535) * 6.283185307179586;
        const float rf = (float)r;
        tab[e] = (f32x2){cosf(rf), sinf(rf)};
    }
}
__device__ __forceinline__ void p2_rope(Frame& F) {
    bf16* Z = (bf16*)(F.ws + WS_Z);
    const f32x2* tab = (const f32x2*)(F.ws + WS_ROPE);
    const int tid = F.tid, tk = tid >> 6, grp = (tid >> 2) & 15, i0 = (tid & 3) * 8;
    for (int blk = F.wg; blk < T / 8; blk += F.G) {
        const int g = blk * 8 + tk, sp = g & (SEQ - 1);
        bf16* p = Z + (size_t)g * IN_COLS + C_AQ + grp * 64 + i0;
        const v4u a = *(const GAS v4u*)p, b = *(const GAS v4u*)(p + 32);
        const GAS f32x4* tp = (const GAS f32x4*)(tab + sp * 32 + i0);
        float x1[8], x2[8];
        x1[0] = bflo(a.x); x1[1] = bfhi(a.x); x1[2] = bflo(a.y); x1[3] = bfhi(a.y); x1[4] = bflo(a.z); x1[5] = bfhi(a.z); x1[6] = bflo(a.w); x1[7] = bfhi(a.w);
        x2[0] = bflo(b.x); x2[1] = bfhi(b.x); x2[2] = bflo(b.y); x2[3] = bfhi(b.y); x2[4] = bflo(b.z); x2[5] = bfhi(b.z); x2[6] = bflo(b.w); x2[7] = bfhi(b.w);
        float o1[8], o2[8];
#pragma unroll
        for (int q = 0; q < 4; ++q) { const f32x4 cs = tp[q];
            o1[2 * q] = x1[2 * q] * cs[0] - x2[2 * q] * cs[1]; o2[2 * q] = x1[2 * q] * cs[1] + x2[2 * q] * cs[0];
            o1[2 * q + 1] = x1[2 * q + 1] * cs[2] - x2[2 * q + 1] * cs[3]; o2[2 * q + 1] = x1[2 * q + 1] * cs[3] + x2[2 * q + 1] * cs[2]; }
        v4u oa, ob; oa.x = pk2(o1[0], o1[1]); oa.y = pk2(o1[2], o1[3]); oa.z = pk2(o1[4], o1[5]); oa.w = pk2(o1[6], o1[7]);
        ob.x = pk2(o2[0], o2[1]); ob.y = pk2(o2[2], o2[3]); ob.z = pk2(o2[4], o2[5]); ob.w = pk2(o2[6], o2[7]);
        *(GAS v4u*)p = oa; *(GAS v4u*)(p + 32) = ob;
    }
}

typedef float f32x16 __attribute__((ext_vector_type(16)));
constexpr int SBS = 144;
constexpr int R1_EPRE = 0, R1_APRE = 16384, R1_AAB = 0, R1_X = 16384;
constexpr int R1_AT = 32768, R1_BT = 41984, R1_KT = 51200, R1_RT = 60416, R1_AHT = R1_BT, R1_U0T = R1_KT;
constexpr int R1_BBT = 69632, R1_KBT = 78848, R1_VT = 88064;
constexpr int R1_ACTW = 97280, R1_ACTA = 106496, R1_AAK = 97280, R1_ARB = 106496, R1_ARK = 115712;
constexpr int R1_BONUS = 124928, R1_WEND = 125184, R1_SEGS = 125440, R1_TII = 125440, R1_END = 129536;
constexpr int R1_PAR = R1_END;
static_assert(R1_PAR + 640 * 4 <= LDSCTL_OFF, "R1 LDS");
__device__ __forceinline__ int crow(int r, int hh) { return (r & 3) + 8 * (r >> 2) + 4 * hh; }
template <int KS> __device__ __forceinline__ f32x16 wtile(const LAS unsigned char* A, int sa, const LAS unsigned char* B, int sb, f32x16 acc, int lane) {
    const int row = lane & 31, hh = lane >> 5;
#pragma unroll
    for (int s = 0; s < KS; ++s) { const bf16x8 a = *(const LAS bf16x8*)(A + row * sa + 32 * s + 16 * hh); const bf16x8 b = *(const LAS bf16x8*)(B + row * sb + 32 * s + 16 * hh);
        acc = __builtin_amdgcn_mfma_f32_32x32x16_bf16(a, b, acc, 0, 0, 0); }
    return acc;
}
__device__ __forceinline__ f32x16 zero16() { f32x16 z;
#pragma unroll
    for (int r = 0; r < 16; ++r) z[r] = 0.f;
    return z; }

struct R1Pre { v4u wd[2], ad[2], z[4]; };
__device__ __forceinline__ int r13_item(int wg, int G, int idx) { return (wg >> 3) * 128 + (wg & 7) * 16 + idx; }
__device__ __forceinline__ int r13_count(int wg, int G) { return 16; }
__device__ __forceinline__ void rwkv_r1_prefetch(Frame& F, int item, int tid, R1Pre& P) {
    const int chain = item >> 7, chunk = item & 127, b = chain >> 3, h = chain & 7, g0 = b * SEQ + chunk * 64;
    const bf16* Z = (const bf16*)(F.ws + WS_Z);
    const v4u z0 = (v4u){0u, 0u, 0u, 0u};
    { const int t = tid >> 3, cg = tid & 7; const bool first = (chunk == 0 && t == 0);
      const bf16* zr = Z + (size_t)(g0 + t) * IN_COLS;
      P.wd[0] = *(const GAS v4u*)(zr + C_WD + cg * 8); P.ad[0] = *(const GAS v4u*)(zr + C_AD + cg * 8);
      P.wd[1] = z0; P.ad[1] = z0;
      if (!first) { P.wd[1] = *(const GAS v4u*)(zr - IN_COLS + C_WD + cg * 8); P.ad[1] = *(const GAS v4u*)(zr - IN_COLS + C_AD + cg * 8); } }
#pragma unroll
    for (int q = 0; q < 4; ++q) { const int p = tid + 512 * q; P.z[q] = z0;
        if (p < 65 * 24) { const int row = p / 24, rem = p - row * 24, seg = rem >> 3, ch = rem & 7;
            if (!(chunk == 0 && row == 0)) P.z[q] = *(const GAS v4u*)(Z + (size_t)(g0 - 1 + row) * IN_COLS + seg * 512 + h * 64 + ch * 8); } }
}
constexpr int R1_ZS = R1_AT, R1_ZSS = 384;
static_assert(65 * R1_ZSS <= 4 * 9216, "ZS fits in the At..Rt region");
__device__ __forceinline__ void r1_load_bfrag(Frame& F, int h, int w, int lane, bf16x8 (&bf)[4]) {
    const int p = w >> 2, nt = w & 1; const bf16* upt = (const bf16*)(F.ws + (p == 0 ? WS_WUPT : WS_AUPT)) + (size_t)(h * 64 + nt * 32 + (lane & 31)) * 64 + 8 * (lane >> 5);
#pragma unroll
    for (int s2 = 0; s2 < 4; ++s2) bf[s2] = *(const GAS bf16x8*)(upt + 16 * s2);
}
__device__ __forceinline__ void r1_load_params(Frame& F, int h) {
    LAS float* PAR = (LAS float*)(F.lds + RING_OFF + R1_PAR); const float* mu = F.in[3];
    const int k = F.wave, c = F.lane, col = h * 64 + c;
    const float* src = k == 0 ? mu + C_R : (k == 1 ? mu + C_K : (k == 2 ? mu + C_V : (k == 3 ? F.in[9] : (k == 4 ? F.in[10] : (k == 5 ? F.in[11] : (k == 6 ? F.in[4] : F.in[6]))))));
    PAR[128 + k * 64 + c] = src[col];
    if (k < 2) PAR[k * 64 + c] = mu[(k == 0 ? C_WD : C_AD) + c];
}
constexpr int R1_CF = R1_AAB, R1_CN = R1_X;
__device__ __forceinline__ void rwkv_r1_item(Frame& F, int item, int next_item, R1Pre& P, const bf16x8 (&bfr)[4], f32x4 (&cst)[4]) {
    const int chain = item >> 7, chunk = item & 127, b = chain >> 3, h = chain & 7;
    const int g0 = b * SEQ + chunk * 64;
    int tid_ = F.tid; asm volatile("" : "+v"(tid_));
    const int tid = tid_, lane = tid & 63, w = __builtin_amdgcn_readfirstlane(tid >> 6), hh = lane >> 5, cl = lane & 31;
    const bf16* Z = (const bf16*)(F.ws + WS_Z);
    LAS unsigned char* lds = F.lds + RING_OFF;
    const float* mu = F.in[3];
    {
        const int t = tid >> 3, cg = tid & 7;
        const v4u cw = P.wd[0], ca = P.ad[0], pw = P.wd[1], pa = P.ad[1];
        float fw[8], fa[8], qw[8], qa[8];
        fw[0] = bflo(cw.x); fw[1] = bfhi(cw.x); fw[2] = bflo(cw.y); fw[3] = bfhi(cw.y); fw[4] = bflo(cw.z); fw[5] = bfhi(cw.z); fw[6] = bflo(cw.w); fw[7] = bfhi(cw.w);
        fa[0] = bflo(ca.x); fa[1] = bfhi(ca.x); fa[2] = bflo(ca.y); fa[3] = bfhi(ca.y); fa[4] = bflo(ca.z); fa[5] = bfhi(ca.z); fa[6] = bflo(ca.w); fa[7] = bfhi(ca.w);
        qw[0] = bflo(pw.x); qw[1] = bfhi(pw.x); qw[2] = bflo(pw.y); qw[3] = bfhi(pw.y); qw[4] = bflo(pw.z); qw[5] = bfhi(pw.z); qw[6] = bflo(pw.w); qw[7] = bfhi(pw.w);
        qa[0] = bflo(pa.x); qa[1] = bfhi(pa.x); qa[2] = bflo(pa.y); qa[3] = bfhi(pa.y); qa[4] = bflo(pa.z); qa[5] = bfhi(pa.z); qa[6] = bflo(pa.w); qa[7] = bfhi(pa.w);
        const LAS float* PAR = (const LAS float*)(lds + R1_PAR);
        const f32x4 mw0 = *(const LAS f32x4*)(PAR + cg * 8), mw1 = *(const LAS f32x4*)(PAR + cg * 8 + 4), ma0 = *(const LAS f32x4*)(PAR + 64 + cg * 8), ma1 = *(const LAS f32x4*)(PAR + 64 + cg * 8 + 4);
#pragma unroll
        for (int j = 0; j < 8; ++j) { const float xw = fw[j] + (qw[j] - fw[j]) * (j < 4 ? mw0[j & 3] : mw1[j & 3]);
            const float ex = __expf(2.f * xw); fw[j] = 1.f - 2.f * frcp(ex + 1.f);
            fa[j] = fa[j] + (qa[j] - fa[j]) * (j < 4 ? ma0[j & 3] : ma1[j & 3]); }
        v4u ow, oa; ow.x = pk2(fw[0], fw[1]); ow.y = pk2(fw[2], fw[3]); ow.z = pk2(fw[4], fw[5]); ow.w = pk2(fw[6], fw[7]);
        oa.x = pk2(fa[0], fa[1]); oa.y = pk2(fa[2], fa[3]); oa.z = pk2(fa[4], fa[5]); oa.w = pk2(fa[6], fa[7]);
        *(LAS v4u*)(lds + R1_ACTW + t * SBS + cg * 16) = ow; *(LAS v4u*)(lds + R1_ACTA + t * SBS + cg * 16) = oa;
#pragma unroll
        for (int q = 0; q < 4; ++q) { const int p = tid + 512 * q;
            if (p < 65 * 24) { const int row = p / 24, rem = p - row * 24; *(LAS v4u*)(lds + R1_ZS + row * R1_ZSS + rem * 16) = P.z[q]; } }
        if (next_item >= 0) rwkv_r1_prefetch(F, next_item, tid, P);
    }
    LDS_BARRIER();
    {
        const int p = w >> 2, mt = (w >> 1) & 1, nt = w & 1;
        f32x16 acc = zero16();
        { const LAS unsigned char* A_ = lds + (p == 0 ? R1_ACTW : R1_ACTA) + mt * 32 * SBS + (lane & 31) * SBS + 16 * hh;
#pragma unroll
          for (int s2 = 0; s2 < 4; ++s2) acc = __builtin_amdgcn_mfma_f32_32x32x16_bf16(*(const LAS bf16x8*)(A_ + 32 * s2), bfr[s2], acc, 0, 0, 0); }
        LAS float* O = (LAS float*)(lds + (p == 0 ? R1_EPRE : R1_APRE));
#pragma unroll
        for (int r = 0; r < 16; ++r) O[(mt * 32 + crow(r, hh)) * 64 + nt * 32 + cl] = acc[r];
    }
    LDS_BARRIER();
    {
        const int c = tid & 63, ts = tid >> 6, col = h * 64 + c;
        const LAS float* PAR = (const LAS float*)(lds + R1_PAR) + 128 + c;
        const float mu_r = PAR[0], mu_k = PAR[64], mu_v = PAR[128], kkc = PAR[192], kac = PAR[256], rkc = PAR[320], w0c = PAR[384], a0c = PAR[448];
        const LAS float* EP = (const LAS float*)(lds + R1_EPRE); const LAS float* AP = (const LAS float*)(lds + R1_APRE);
        LAS float* SEGS = (LAS float*)(lds + R1_SEGS); LAS float* BON = (LAS float*)(lds + R1_BONUS);
        const LAS bf16* zb = (const LAS bf16*)(lds + R1_ZS + (8 * ts) * R1_ZSS) + c;
        float pr = bf2f(zb[0]), pk = bf2f(zb[64]), pv = bf2f(zb[128]);
        float rr[8], k2[8], ai[8], bi[8], vv[8], ee[8], cs[8]; float run = 0.f;
#pragma unroll
        for (int i = 0; i < 8; ++i) {
            const float zr = bf2f(zb[(i + 1) * (R1_ZSS / 2)]), zk = bf2f(zb[(i + 1) * (R1_ZSS / 2) + 64]), zv = bf2f(zb[(i + 1) * (R1_ZSS / 2) + 128]);
            const float r = zr + (pr - zr) * mu_r, k = zk + (pk - zk) * mu_k, v = zv + (pv - zv) * mu_v; pr = zr; pk = zk; pv = zv;
            const float e = 0.60653066f * frcp(1.f + __expf(-(w0c + EP[(8 * ts + i) * 64 + c])));
            const float a = frcp(1.f + __expf(-(a0c + AP[(8 * ts + i) * 64 + c])));
            float kk = k * kkc; const float n2 = wave_sum(kk * kk); kk = kk * frsq(fmaxf(n2, 1e-24f));
            const float kq = k * (1.f + (a - 1.f) * kac);
            const float bon = wave_sum(r * kq * rkc); if (c == 0) BON[8 * ts + i] = bon;
            rr[i] = r; k2[i] = kq; ai[i] = -kk; bi[i] = kk * a; vv[i] = v; ee[i] = e; run += e; cs[i] = run;
        }
        SEGS[ts * 64 + c] = run;
        LDS_BARRIER();
        float off = 0.f, tot = 0.f;
#pragma unroll
        for (int q = 0; q < 8; ++q) { const float sv = SEGS[q * 64 + c]; tot += sv; off += (q < ts) ? sv : 0.f; }
        float bb[8], kb[8];
#pragma unroll
        for (int i = 0; i < 8; ++i) { const float L = off + cs[i];
            const float Wm = __expf(-(L - ee[i])), Wi = __expf(-L), iW = __expf(L), We = __expf(-(tot - L));
            const int t = 8 * ts + i;
            *(LAS bf16*)(lds + R1_AT + t * SBS + c * 2) = (bf16)f2bf(ai[i] * Wm);
            *(LAS bf16*)(lds + R1_BT + t * SBS + c * 2) = (bf16)f2bf(bi[i] * iW);
            *(LAS bf16*)(lds + R1_KT + t * SBS + c * 2) = (bf16)f2bf(k2[i] * iW);
            *(LAS bf16*)(lds + R1_RT + t * SBS + c * 2) = (bf16)f2bf(rr[i] * Wi);
            bb[i] = bi[i] * We; kb[i] = k2[i] * We; }
        v4u o; o.x = pk2(bb[0], bb[1]); o.y = pk2(bb[2], bb[3]); o.z = pk2(bb[4], bb[5]); o.w = pk2(bb[6], bb[7]);
        *(LAS v4u*)(lds + R1_BBT + c * SBS + ts * 16) = o;
        o.x = pk2(kb[0], kb[1]); o.y = pk2(kb[2], kb[3]); o.z = pk2(kb[4], kb[5]); o.w = pk2(kb[6], kb[7]);
        *(LAS v4u*)(lds + R1_KBT + c * SBS + ts * 16) = o;
        o.x = pk2(vv[0], vv[1]); o.y = pk2(vv[2], vv[3]); o.z = pk2(vv[4], vv[5]); o.w = pk2(vv[6], vv[7]);
        *(LAS v4u*)(lds + R1_VT + c * SBS + ts * 16) = o;
        if (ts == 0) ((LAS float*)(lds + R1_WEND))[c] = __expf(-tot);
    }
    LDS_BARRIER();
#pragma unroll
    for (int u = 0; u < 2; ++u) {
        const int idx = w * 2 + u, p = idx >> 2, mt = (idx >> 1) & 1, nt = idx & 1;
        const LAS unsigned char* Aop = lds + ((p == 0 || p == 2) ? R1_BT : R1_KT) + mt * 32 * SBS;
        const LAS unsigned char* Bop = lds + (p < 2 ? R1_AT : R1_RT) + nt * 32 * SBS;
        f32x16 acc = wtile<4>(Aop, SBS, Bop, SBS, zero16(), lane);
        const int n = nt * 32 + cl;
#pragma unroll
        for (int r = 0; r < 16; ++r) { const int m = mt * 32 + crow(r, hh); const bool keep = (p < 2) ? (m < n) : (m <= n); acc[r] = keep ? acc[r] : 0.f; }
#pragma unroll
        for (int g4 = 0; g4 < 4; ++g4) { const int m0 = mt * 32 + 8 * g4 + 4 * hh;
            if (p == 0) *(LAS f32x4*)(lds + R1_AAB + (n * 64 + m0) * 4) = (f32x4){acc[4 * g4], acc[4 * g4 + 1], acc[4 * g4 + 2], acc[4 * g4 + 3]};
            else { v2u o; o.x = pk2(acc[4 * g4], acc[4 * g4 + 1]); o.y = pk2(acc[4 * g4 + 2], acc[4 * g4 + 3]);
                   *(LAS v2u*)(lds + (p == 1 ? R1_AAK : (p == 2 ? R1_ARB : R1_ARK)) + n * SBS + m0 * 2) = o; } }
    }
    LDS_BARRIER();
    if (w < 4) {
        const int mt = w >> 1, nt = w & 1;
        const f32x16 acc = wtile<4>(lds + R1_AAK + mt * 32 * SBS, SBS, lds + R1_VT + nt * 32 * SBS, SBS, zero16(), lane);
        LAS float* X = (LAS float*)(lds + R1_X);
#pragma unroll
        for (int r = 0; r < 16; ++r) X[(mt * 32 + crow(r, hh)) * 64 + nt * 32 + cl] = acc[r];
    } else if (w == 4) {
        const int bk = lane >> 4, c = lane & 15;
        const LAS float* AAB = (const LAS float*)(lds + R1_AAB);
        float Tc[16]; const float fc = (float)c;
#pragma unroll
        for (int s2 = 0; s2 < 16; ++s2) Tc[s2] = fmaxf(0.f, 1.f - fabsf((float)s2 - fc));
#pragma unroll
        for (int r = 0; r < 15; ++r)
#pragma unroll
            for (int s2 = r + 1; s2 < 16; ++s2) Tc[s2] += AAB[(16 * bk + s2) * 64 + 16 * bk + r] * Tc[r];
        LAS float* TII = (LAS float*)(lds + R1_TII);
#pragma unroll
        for (int s2 = 0; s2 < 16; ++s2) TII[(bk * 16 + s2) * 16 + c] = Tc[s2];
    }
    LDS_BARRIER();
    {
        const int c16 = lane & 15, g = lane >> 4;
        const LAS float* AAB = (const LAS float*)(lds + R1_AAB); const LAS float* TII = (const LAS float*)(lds + R1_TII); const LAS float* X = (const LAS float*)(lds + R1_X);
        f32x4 o[4];
#pragma unroll
        for (int i = 0; i < 4; ++i) {
            f32x4 acc;
            if (w < 4) {
#pragma unroll
                for (int q = 0; q < 4; ++q) acc[q] = bf2f(*(const LAS bf16*)(lds + R1_AT + (16 * i + 4 * g + q) * SBS + (16 * w + c16) * 2));
            } else {
#pragma unroll
                for (int q = 0; q < 4; ++q) acc[q] = X[(16 * i + 4 * g + q) * 64 + 16 * (w - 4) + c16];
            }
#pragma unroll
            for (int j = 0; j < i; ++j) { const f32x4 a4 = *(const LAS f32x4*)(AAB + (16 * i + c16) * 64 + 16 * j + 4 * g);
#pragma unroll
                for (int q = 0; q < 4; ++q) acc = __builtin_amdgcn_mfma_f32_16x16x4f32(a4[q], o[j][q], acc, 0, 0, 0); }
            const f32x4 t4 = *(const LAS f32x4*)(TII + (i * 16 + c16) * 16 + 4 * g);
            f32x4 res = (f32x4){0.f, 0.f, 0.f, 0.f};
#pragma unroll
            for (int q = 0; q < 4; ++q) res = __builtin_amdgcn_mfma_f32_16x16x4f32(t4[q], acc[q], res, 0, 0, 0);
            o[i] = res;
            v2u ov; ov.x = pk2(res[0], res[1]); ov.y = pk2(res[2], res[3]);
            *(LAS v2u*)(lds + (w < 4 ? R1_AHT : R1_U0T) + (16 * (w & 3) + c16) * SBS + (16 * i + 4 * g) * 2) = ov;
        }
    }
    LDS_BARRIER();
    {
        float* Mg = F.out + (size_t)item * 4096; float* NTg = F.out + (size_t)T * RWW + (size_t)item * 4096;
        float* Y0g = (float*)(F.ws + WS_RWY0) + (size_t)item * 4096; bf16* RHg = (bf16*)(F.ws + WS_RWRH) + (size_t)item * 4096;
#pragma unroll
        for (int u = 0; u < 2; ++u) {
            const int idx = w * 2 + u, p = idx >> 2, mt = (idx >> 1) & 1, nt = idx & 1; const int n = nt * 32 + cl;
            if (p == 0) {
                f32x16 acc = wtile<4>(lds + R1_AHT + mt * 32 * SBS, SBS, lds + R1_BBT + nt * 32 * SBS, SBS, zero16(), lane);
                const float we = ((const LAS float*)(lds + R1_WEND))[n];
#pragma unroll
                for (int g4 = 0; g4 < 4; ++g4) { const int m0 = mt * 32 + 8 * g4 + 4 * hh;
                    const f32x4 mv = (f32x4){acc[4 * g4] + (m0 == n ? we : 0.f), acc[4 * g4 + 1] + (m0 + 1 == n ? we : 0.f), acc[4 * g4 + 2] + (m0 + 2 == n ? we : 0.f), acc[4 * g4 + 3] + (m0 + 3 == n ? we : 0.f)};
                    *(GAS f32x4*)(Mg + n * 64 + m0) = mv;
                    v2u h_; h_.x = pk2(mv[0], mv[1]); h_.y = pk2(mv[2], mv[3]);
                    v2u l_; l_.x = pk2(mv[0] - bflo(h_.x), mv[1] - bfhi(h_.x)); l_.y = pk2(mv[2] - bflo(h_.y), mv[3] - bfhi(h_.y));
                    LAS unsigned char* fp_ = lds + R1_CF + (((n >> 4) * 2 + (m0 >> 5)) * 2) * 1024 + ((((m0 >> 2) & 3) * 16) + (n & 15)) * 16 + ((m0 >> 4) & 1) * 8;
                    *(LAS v2u*)fp_ = h_; *(LAS v2u*)(fp_ + 1024) = l_; }
            } else if (p == 1) {
                f32x16 acc = wtile<4>(lds + R1_BBT + mt * 32 * SBS, SBS, lds + R1_U0T + nt * 32 * SBS, SBS, zero16(), lane);
                acc = wtile<4>(lds + R1_KBT + mt * 32 * SBS, SBS, lds + R1_VT + nt * 32 * SBS, SBS, acc, lane);
#pragma unroll
                for (int g4 = 0; g4 < 4; ++g4) { const f32x4 nv_ = (f32x4){acc[4 * g4], acc[4 * g4 + 1], acc[4 * g4 + 2], acc[4 * g4 + 3]};
                    *(GAS f32x4*)(NTg + n * 64 + mt * 32 + 8 * g4 + 4 * hh) = nv_; *(LAS f32x4*)(lds + R1_CN + (n * 64 + mt * 32 + 8 * g4 + 4 * hh) * 4) = nv_; }
            } else if (p == 2) {
                f32x16 acc = wtile<4>(lds + R1_AHT + mt * 32 * SBS, SBS, lds + R1_ARB + nt * 32 * SBS, SBS, zero16(), lane);
#pragma unroll
                for (int g4 = 0; g4 < 4; ++g4) { const int m0 = mt * 32 + 8 * g4 + 4 * hh;
                    const v2u rt = *(const LAS v2u*)(lds + R1_RT + n * SBS + m0 * 2);
                    v2u ov; ov.x = pk2(acc[4 * g4] + bflo(rt.x), acc[4 * g4 + 1] + bfhi(rt.x)); ov.y = pk2(acc[4 * g4 + 2] + bflo(rt.y), acc[4 * g4 + 3] + bfhi(rt.y));
                    *(GAS v2u*)(RHg + n * 64 + m0) = ov; }
            } else {
                f32x16 acc = wtile<4>(lds + R1_U0T + mt * 32 * SBS, SBS, lds + R1_ARB + nt * 32 * SBS, SBS, zero16(), lane);
                acc = wtile<4>(lds + R1_VT + mt * 32 * SBS, SBS, lds + R1_ARK + nt * 32 * SBS, SBS, acc, lane);
#pragma unroll
                for (int g4 = 0; g4 < 4; ++g4) *(GAS f32x4*)(Y0g + n * 64 + mt * 32 + 8 * g4 + 4 * hh) = (f32x4){acc[4 * g4], acc[4 * g4 + 1], acc[4 * g4 + 2], acc[4 * g4 + 3]};
            }
        }
        if (tid < 64) ((float*)(F.ws + WS_BONUS))[(size_t)item * 64 + tid] = ((const LAS float*)(lds + R1_BONUS))[tid];
    }
    LDS_BARRIER();
    {
        const int n16 = lane & 15, g = lane >> 4;
        bf16x8 sh[2], sl[2];
#pragma unroll
        for (int ks = 0; ks < 2; ++ks) { const f32x4 a = cst[2 * ks], b = cst[2 * ks + 1];
            v4u h_; h_.x = pk2(a[0], a[1]); h_.y = pk2(a[2], a[3]); h_.z = pk2(b[0], b[1]); h_.w = pk2(b[2], b[3]);
            v4u l_; l_.x = pk2(a[0] - bflo(h_.x), a[1] - bfhi(h_.x)); l_.y = pk2(a[2] - bflo(h_.y), a[3] - bfhi(h_.y)); l_.z = pk2(b[0] - bflo(h_.z), b[1] - bfhi(h_.z)); l_.w = pk2(b[2] - bflo(h_.w), b[3] - bfhi(h_.w));
            sh[ks] = __builtin_bit_cast(bf16x8, h_); sl[ks] = __builtin_bit_cast(bf16x8, l_); }
        f32x4 nw[4];
#pragma unroll
        for (int rt = 0; rt < 4; ++rt) { f32x4 acc = (f32x4){0.f, 0.f, 0.f, 0.f};
            if (w >= 4) acc = *(const LAS f32x4*)(lds + R1_CN + ((16 * (w - 4) + n16) * 64 + 16 * rt + 4 * g) * 4);
#pragma unroll
            for (int ks = 0; ks < 2; ++ks) {
                const bf16x8 mh = *(const LAS bf16x8*)(lds + R1_CF + ((rt * 2 + ks) * 2) * 1024 + lane * 16), ml = *(const LAS bf16x8*)(lds + R1_CF + ((rt * 2 + ks) * 2 + 1) * 1024 + lane * 16);
                acc = __builtin_amdgcn_mfma_f32_16x16x32_bf16(mh, sh[ks], acc, 0, 0, 0);
                acc = __builtin_amdgcn_mfma_f32_16x16x32_bf16(mh, sl[ks], acc, 0, 0, 0);
                acc = __builtin_amdgcn_mfma_f32_16x16x32_bf16(ml, sh[ks], acc, 0, 0, 0); }
            nw[rt] = acc; }
#pragma unroll
        for (int rt = 0; rt < 4; ++rt) cst[rt] = nw[rt];
    }
    LDS_BARRIER();
}

constexpr int R2_RS = 272, R2_SLOT = 2 * 64 * R2_RS;
static_assert(2 * R2_SLOT <= LDSCTL_OFF, "R2 LDS");
template <int NSTEP, int R2_D> __device__ __forceinline__ void rwkv_scan(Frame& F, const float* Mg, const float* NTg, float* SSg, const float* S0g) {
    int tid_ = F.tid; asm volatile("" : "+v"(tid_));
    const int lane = tid_ & 63, w = __builtin_amdgcn_readfirstlane(tid_ >> 6);
    LAS unsigned char* lds = F.lds + RING_OFF;
    if (w >= 4) {
        const int L = w - 4, r = lane >> 2, f0 = (lane & 3) * 4;
        const size_t goff = (size_t)(16 * L + r) * 64 + f0 * 4;
        const int loff = (16 * L + r) * R2_RS + f0 * 16;
        f32x4 R[R2_D][8];
#define R2_ISSUE(slot_, step_) do { const int st_ = (step_) < NSTEP ? (step_) : NSTEP - 1; const float* mp_ = Mg + (size_t)st_ * 4096 + goff; const float* np_ = NTg + (size_t)st_ * 4096 + goff; \
            _Pragma("unroll") for (int k_ = 0; k_ < 4; ++k_) { R[slot_][k_] = *(const GAS f32x4*)(mp_ + 4 * k_); R[slot_][4 + k_] = *(const GAS f32x4*)(np_ + 4 * k_); } } while (0)
        const int q_ = lane & 3, froff = ((L * 2 + (q_ >> 1)) * 2) * 1024 + r * 16 + (q_ & 1) * 8;
#define R2_WRITE(slot_, buf_) do { LAS unsigned char* d_ = lds + (buf_) * R2_SLOT; \
            _Pragma("unroll") for (int k_ = 0; k_ < 4; ++k_) { const f32x4 a_ = R[slot_][k_]; \
                v2u h_; h_.x = pk2(a_[0], a_[1]); h_.y = pk2(a_[2], a_[3]); \
                v2u l_; l_.x = pk2(a_[0] - bflo(h_.x), a_[1] - bfhi(h_.x)); l_.y = pk2(a_[2] - bflo(h_.y), a_[3] - bfhi(h_.y)); \
                *(LAS v2u*)(d_ + froff + k_ * 256) = h_; *(LAS v2u*)(d_ + froff + 1024 + k_ * 256) = l_; \
                *(LAS f32x4*)(d_ + 64 * R2_RS + loff + 16 * k_) = R[slot_][4 + k_]; } } while (0)
#pragma unroll
        for (int u = 0; u < R2_D; ++u) R2_ISSUE(u, u);
        R2_WRITE(0, 0);
        R2_ISSUE(0, R2_D);
        LDS_BARRIER();
        int c0 = 0;
        for (; c0 + R2_D <= NSTEP - 1; c0 += R2_D) {
#pragma unroll
            for (int u = 0; u < R2_D; ++u) { const int c = c0 + u;
                R2_WRITE((u + 1) % R2_D, (c + 1) & 1);
                R2_ISSUE((u + 1) % R2_D, c + 1 + R2_D);
                LDS_BARRIER(); }
        }
#pragma unroll
        for (int u = 0; u < R2_D; ++u) { const int c = c0 + u;
            if (c < NSTEP - 1) { R2_WRITE((u + 1) % R2_D, (c + 1) & 1); LDS_BARRIER(); } }
        LDS_BARRIER();
#undef R2_ISSUE
#undef R2_WRITE
        return;
    }
    const int n16 = lane & 15, g = lane >> 4;
    f32x4 st[4];
#pragma unroll
    for (int rt = 0; rt < 4; ++rt) st[rt] = S0g ? *(const GAS f32x4*)(S0g + (16 * w + n16) * 64 + 16 * rt + 4 * g) : (f32x4){0.f, 0.f, 0.f, 0.f};
    LDS_BARRIER();
    for (int c = 0; c < NSTEP; ++c) {
#pragma unroll
        for (int rt = 0; rt < 4; ++rt) *(GAS f32x4*)(SSg + (size_t)c * 4096 + (16 * w + n16) * 64 + 16 * rt + 4 * g) = st[rt];
        const LAS unsigned char* sl_ = lds + (c & 1) * R2_SLOT;
        bf16x8 sh[2], sl[2];
#pragma unroll
        for (int ks = 0; ks < 2; ++ks) { const f32x4 a = st[2 * ks], b = st[2 * ks + 1];
            v4u h; h.x = pk2(a[0], a[1]); h.y = pk2(a[2], a[3]); h.z = pk2(b[0], b[1]); h.w = pk2(b[2], b[3]);
            v4u l; l.x = pk2(a[0] - bflo(h.x), a[1] - bfhi(h.x)); l.y = pk2(a[2] - bflo(h.y), a[3] - bfhi(h.y)); l.z = pk2(b[0] - bflo(h.z), b[1] - bfhi(h.z)); l.w = pk2(b[2] - bflo(h.w), b[3] - bfhi(h.w));
            sh[ks] = __builtin_bit_cast(bf16x8, h); sl[ks] = __builtin_bit_cast(bf16x8, l); }
        f32x4 nw[4];
#pragma unroll
        for (int rt = 0; rt < 4; ++rt) { f32x4 acc = *(const LAS f32x4*)(sl_ + 64 * R2_RS + (16 * w + n16) * R2_RS + (16 * rt + 4 * g) * 4);
#pragma unroll
            for (int ks = 0; ks < 2; ++ks) {
                const bf16x8 mh = *(const LAS bf16x8*)(sl_ + ((rt * 2 + ks) * 2) * 1024 + lane * 16), ml = *(const LAS bf16x8*)(sl_ + ((rt * 2 + ks) * 2 + 1) * 1024 + lane * 16);
                acc = __builtin_amdgcn_mfma_f32_16x16x32_bf16(mh, sh[ks], acc, 0, 0, 0);
                acc = __builtin_amdgcn_mfma_f32_16x16x32_bf16(mh, sl[ks], acc, 0, 0, 0);
                acc = __builtin_amdgcn_mfma_f32_16x16x32_bf16(ml, sh[ks], acc, 0, 0, 0); }
            nw[rt] = acc; }
#pragma unroll
        for (int rt = 0; rt < 4; ++rt) st[rt] = nw[rt];
        LDS_BARRIER();
    }
#pragma unroll
    for (int rt = 0; rt < 4; ++rt) *(GAS f32x4*)(SSg + (size_t)NSTEP * 4096 + (16 * w + n16) * 64 + 16 * rt + 4 * g) = st[rt];
}

constexpr int R3_RH = 0, R3_S = 9216, R3_SG = 18432, R3_SGS = 272, R3_YL = R3_SG + 64 * R3_SGS, R3_GL = R3_YL + 16384, R3_VS = R3_GL + 16384, R3_BON = R3_VS + 65 * 128, R3_END = R3_BON + 256;
constexpr int R3_PAR = R3_END;
static_assert(R3_PAR + 320 * 4 <= LDSCTL_OFF, "R3 LDS");
struct R3Pre { v4u rh; f32x4 ss[2]; v4u gd[2][2]; f32x4 y0[2]; v4u vv[2]; float bon; };
__device__ __forceinline__ void rwkv_r3_prefetch(Frame& F, int item, int tid, R3Pre& P) {
    const int chain = item >> 7, chunk = item & 127, b = chain >> 3, h = chain & 7, g0 = b * SEQ + chunk * 64;
    const bf16* Z = (const bf16*)(F.ws + WS_Z);
    const int t = tid >> 3, cg = tid & 7; const v4u z0 = (v4u){0u, 0u, 0u, 0u};
    P.rh = *(const GAS v4u*)((const bf16*)(F.ws + WS_RWRH) + (size_t)item * 4096 + t * 64 + cg * 8);
    const float* SSg = (const float*)(F.ws + WS_RWSS) + (size_t)item * 4096 + t * 64 + cg * 8;
    P.ss[0] = *(const GAS f32x4*)SSg; P.ss[1] = *(const GAS f32x4*)(SSg + 4);
    const bf16* zr = Z + (size_t)(g0 + t) * IN_COLS + C_GD + cg * 16; const bool first = (chunk == 0 && t == 0);
#pragma unroll
    for (int q = 0; q < 2; ++q) { P.gd[q][0] = *(const GAS v4u*)(zr + q * 8); P.gd[q][1] = z0; if (!first) P.gd[q][1] = *(const GAS v4u*)(zr - IN_COLS + q * 8); }
    const float* Y0g = (const float*)(F.ws + WS_RWY0) + (size_t)item * 4096;
    P.y0[0] = *(const GAS f32x4*)(Y0g + tid * 4); P.y0[1] = *(const GAS f32x4*)(Y0g + (tid + 512) * 4);
#pragma unroll
    for (int q = 0; q < 2; ++q) { const int p = tid + 512 * q; P.vv[q] = z0;
        if (p < 65 * 8) { const int row = p >> 3, ch = p & 7; if (!(chunk == 0 && row == 0)) P.vv[q] = *(const GAS v4u*)(Z + (size_t)(g0 - 1 + row) * IN_COLS + C_V + h * 64 + ch * 8); } }
    P.bon = tid < 64 ? ((const float*)(F.ws + WS_BONUS))[(size_t)item * 64 + tid] : 0.f;
}
__device__ __forceinline__ void r3_load_bfrag(Frame& F, int h, int w, int lane, bf16x8 (&bf)[8]) {
    const int nt = w & 1; const bf16* gut = (const bf16*)(F.ws + WS_GUPT) + (size_t)(h * 64 + nt * 32 + (lane & 31)) * 128 + 8 * (lane >> 5);
#pragma unroll
    for (int s2 = 0; s2 < 8; ++s2) bf[s2] = *(const GAS bf16x8*)(gut + 16 * s2);
}
__device__ __forceinline__ void r3_load_params(Frame& F, int h) {
    LAS float* PAR = (LAS float*)(F.lds + RING_OFF + R3_PAR); const float* mu = F.in[3];
    const int k = F.wave, c = F.lane, col = h * 64 + c;
    if (k < 2) PAR[k * 64 + c] = mu[C_GD + k * 64 + c];
    else if (k < 5) PAR[128 + (k - 2) * 64 + c] = (k == 2 ? mu + C_V : (k == 3 ? F.in[12] : F.in[13]))[col];
}
__device__ __forceinline__ void rwkv_r3_item(Frame& F, int item, int next_item, R3Pre& P, const bf16x8 (&bfr)[8]) {
    const int chain = item >> 7, chunk = item & 127, b = chain >> 3, h = chain & 7;
    const int g0 = b * SEQ + chunk * 64;
    int tid_ = F.tid; asm volatile("" : "+v"(tid_));
    const int tid = tid_, lane = tid & 63, w = __builtin_amdgcn_readfirstlane(tid >> 6), hh = lane >> 5, cl = lane & 31;
    LAS unsigned char* lds = F.lds + RING_OFF;
    const float* mu = F.in[3];
    {
        const int t = tid >> 3, cg = tid & 7;
        *(LAS v4u*)(lds + R3_RH + t * SBS + cg * 16) = P.rh;
        const f32x4 s0 = P.ss[0], s1 = P.ss[1];
        v4u o; o.x = pk2(s0[0], s0[1]); o.y = pk2(s0[2], s0[3]); o.z = pk2(s1[0], s1[1]); o.w = pk2(s1[2], s1[3]);
        *(LAS v4u*)(lds + R3_S + t * SBS + cg * 16) = o;
#pragma unroll
        for (int q = 0; q < 2; ++q) {
            const v4u cw = P.gd[q][0], pw = P.gd[q][1];
            float fw[8], qw[8];
            fw[0] = bflo(cw.x); fw[1] = bfhi(cw.x); fw[2] = bflo(cw.y); fw[3] = bfhi(cw.y); fw[4] = bflo(cw.z); fw[5] = bfhi(cw.z); fw[6] = bflo(cw.w); fw[7] = bfhi(cw.w);
            qw[0] = bflo(pw.x); qw[1] = bfhi(pw.x); qw[2] = bflo(pw.y); qw[3] = bfhi(pw.y); qw[4] = bflo(pw.z); qw[5] = bfhi(pw.z); qw[6] = bflo(pw.w); qw[7] = bfhi(pw.w);
            const f32x4 mg0 = *(const LAS f32x4*)(lds + R3_PAR + (cg * 16 + q * 8) * 4), mg1 = *(const LAS f32x4*)(lds + R3_PAR + (cg * 16 + q * 8 + 4) * 4);
#pragma unroll
            for (int j = 0; j < 8; ++j) { const float v = fw[j] + (qw[j] - fw[j]) * (j < 4 ? mg0[j & 3] : mg1[j & 3]); fw[j] = frcp(1.f + __expf(-v)); }
            v4u og; og.x = pk2(fw[0], fw[1]); og.y = pk2(fw[2], fw[3]); og.z = pk2(fw[4], fw[5]); og.w = pk2(fw[6], fw[7]);
            *(LAS v4u*)(lds + R3_SG + t * R3_SGS + (cg * 16 + q * 8) * 2) = og;
        }
        *(LAS f32x4*)(lds + R3_YL + tid * 16) = P.y0[0]; *(LAS f32x4*)(lds + R3_YL + (tid + 512) * 16) = P.y0[1];
#pragma unroll
        for (int q = 0; q < 2; ++q) { const int p = tid + 512 * q; if (p < 65 * 8) *(LAS v4u*)(lds + R3_VS + p * 16) = P.vv[q]; }
        if (tid < 64) ((LAS float*)(lds + R3_BON))[tid] = P.bon;
        if (next_item >= 0) rwkv_r3_prefetch(F, next_item, tid, P);
    }
    LDS_BARRIER();
    {
        const int mt = (w >> 1) & 1, nt = w & 1; const int n = nt * 32 + cl;
        if (w < 4) {
            LAS float* YL = (LAS float*)(lds + R3_YL);
            f32x16 acc;
#pragma unroll
            for (int r = 0; r < 16; ++r) acc[r] = YL[(mt * 32 + crow(r, hh)) * 64 + n];
            acc = wtile<4>(lds + R3_RH + mt * 32 * SBS, SBS, lds + R3_S + nt * 32 * SBS, SBS, acc, lane);
#pragma unroll
            for (int r = 0; r < 16; ++r) YL[(mt * 32 + crow(r, hh)) * 64 + n] = acc[r];
        } else {
            f32x16 acc = zero16();
            { const LAS unsigned char* A_ = lds + R3_SG + mt * 32 * R3_SGS + (lane & 31) * R3_SGS + 16 * hh;
#pragma unroll
              for (int s2 = 0; s2 < 8; ++s2) acc = __builtin_amdgcn_mfma_f32_32x32x16_bf16(*(const LAS bf16x8*)(A_ + 32 * s2), bfr[s2], acc, 0, 0, 0); }
            LAS float* GL = (LAS float*)(lds + R3_GL);
#pragma unroll
            for (int r = 0; r < 16; ++r) GL[(mt * 32 + crow(r, hh)) * 64 + n] = acc[r];
        }
    }
    LDS_BARRIER();
    {
        const int c = tid & 63, ts = tid >> 6, col = h * 64 + c;
        const LAS float* PAR = (const LAS float*)(lds + R3_PAR) + 128 + c;
        const float mu_v = PAR[0], gw = PAR[64], gb = PAR[128];
        const LAS float* YL = (const LAS float*)(lds + R3_YL); const LAS float* GL = (const LAS float*)(lds + R3_GL); const LAS float* BON = (const LAS float*)(lds + R3_BON);
        bf16* Y = (bf16*)(F.ws + WS_YMIX);
        const LAS bf16* vb = (const LAS bf16*)(lds + R3_VS) + (8 * ts) * 64 + c;
        float pv = bf2f(vb[0]);
#pragma unroll
        for (int i = 0; i < 8; ++i) { const int t = 8 * ts + i;
            const float zv = bf2f(vb[(i + 1) * 64]); const float v = zv + (pv - zv) * mu_v; pv = zv;
            const float y = YL[t * 64 + c];
            const float mean = wave_sum(y) * (1.f / 64.f); const float d = y - mean; const float var = wave_sum(d * d) * (1.f / 64.f);
            const float yn = d * frsq(var + GN_EPS) * gw + gb;
            const float o = (yn + BON[t] * v) * GL[t * 64 + c];
            Y[(size_t)(g0 + t) * DM + col] = (bf16)f2bf(o); }
    }
    LDS_BARRIER();
}

typedef short s16x4 __attribute__((ext_vector_type(4)));
typedef short v4i16_t __attribute__((ext_vector_type(4)));
constexpr int AT_XO = 0, AT_XO_STRIDE = 136, AT_XM = 512 * AT_XO_STRIDE, AT_XL = AT_XM + 2048, AT_V = AT_XL + 2048, AT_K = AT_V + 8 * 4096, AT_KS = 144, AT_LDS_END = AT_K + 8 * 32 * AT_KS;
static_assert(AT_LDS_END <= LDSCTL_OFF, "attention LDS");
__device__ __forceinline__ float xhalf(float v) { return __shfl_xor(v, 32); }
__device__ __forceinline__ void attn_block(Frame& F, int item) {
    const int bh = item >> 4, blk = item & 15, b = bh >> 3, h = bh & 7, t0 = blk * 512;
    int tid_ = F.tid; asm volatile("" : "+v"(tid_));
    const int lane = tid_ & 63, w = __builtin_amdgcn_readfirstlane(tid_ >> 6), ql = lane & 31, hh = lane >> 5;
    const bf16* Zb = (const bf16*)(F.ws + WS_Z) + (size_t)b * SEQ * IN_COLS;
    bf16* Y = (bf16*)(F.ws + WS_YMIX);
    LAS unsigned char* lds = F.lds + RING_OFF;
    LAS unsigned char* Vw = lds + AT_V + w * 4096;
    LAS unsigned char* Kw = lds + AT_K + w * 32 * AT_KS;
    LAS float* XM = (LAS float*)(lds + AT_XM); LAS float* XL = (LAS float*)(lds + AT_XL);
    constexpr float C2 = 0.125f * 1.4426950408889634f;
    const int lrow = lane >> 3, lch = lane & 7;
    __builtin_amdgcn_s_waitcnt(0x0F70);
#define AT_PARAMS(SI, sh_, d_, rho_, tau_, tkb_) do { const int ps_ = (SI) >> 1; sh_ = ps_ == 0 ? 4 : (ps_ == 1 ? 2 : 0); d_ = 1 << sh_; \
        const int u_ = w + 8 * ((SI) & 1); rho_ = u_ & (d_ - 1); tau_ = u_ >> sh_; tkb_ = t0 + rho_ + (32 * tau_ - 128) * d_; } while (0)
    const GAS char* zb8 = (const GAS char*)Zb;
#define AT_VOFF(d_) ((unsigned)(lrow * (d_)) * (unsigned)(IN_COLS * 2) + (unsigned)(lch * 16))
#define AT_LOADQ(d_, rho_, tau_, vo_) do { const GAS char* sb_ = zb8 + ((size_t)(t0 + rho_ + 32 * tau_ * d_) * IN_COLS + C_AQ + h * 64) * 2; \
        _Pragma("unroll") for (int i_ = 0; i_ < 4; ++i_) qr[i_] = *(const GAS v4u*)(sb_ + (size_t)(i_ * 8 * d_) * (IN_COLS * 2) + vo_); } while (0)
#define AT_LOADT(KT, COL, d_, tkb_, vo_) do { const int tk_ = tkb_ + 32 * (KT) * d_, tc_ = tk_ < 0 ? 0 : tk_; const GAS char* sb_ = zb8 + ((size_t)tc_ * IN_COLS + (COL) + h * 64) * 2; \
        _Pragma("unroll") for (int i_ = 0; i_ < 4; ++i_) R[KT][i_] = *(const GAS v4u*)(sb_ + (size_t)(i_ * 8 * d_) * (IN_COLS * 2) + vo_); } while (0)
    v4u R[5][4], qr[4];
    { int sh, d, rho, tau, tkb; AT_PARAMS(0, sh, d, rho, tau, tkb);
      const unsigned vo = AT_VOFF(d);
      AT_LOADQ(d, rho, tau, vo);
#pragma unroll
      for (int kt = 0; kt < 5; ++kt) AT_LOADT(kt, C_AK, d, tkb, vo); }
#pragma unroll 1
    for (int si = 0; si < 6; ++si) {
        int sh, d, rho, tau, tkb; AT_PARAMS(si, sh, d, rho, tau, tkb);
        const int sn = si < 5 ? si + 1 : 5;
        int sh2, d2, rho2, tau2, tkb2; AT_PARAMS(sn, sh2, d2, rho2, tau2, tkb2);
        const int qoff = rho + (32 * tau + ql) * d;
        const unsigned vo = AT_VOFF(d), vo2 = AT_VOFF(d2);
        bf16x8 qf[4];
#pragma unroll
        for (int i = 0; i < 4; ++i) *(LAS v4u*)(Kw + (i * 8 + lrow) * AT_KS + lch * 16) = qr[i];
#pragma unroll
        for (int s = 0; s < 4; ++s) qf[s] = *(const LAS bf16x8*)(Kw + ql * AT_KS + 32 * s + 16 * hh);
        f32x16 sc[5];
        float m = -INFINITY;
#pragma unroll
        for (int kt = 0; kt < 5; ++kt) {
            const int tk0 = tkb + 32 * kt * d;
            bf16x8 kf[4];
#pragma unroll
            for (int i = 0; i < 4; ++i) *(LAS v4u*)(Kw + (i * 8 + lrow) * AT_KS + lch * 16) = R[kt][i];
            AT_LOADT(kt, C_AV, d, tkb, vo);
#pragma unroll
            for (int s = 0; s < 4; ++s) kf[s] = *(const LAS bf16x8*)(Kw + ql * AT_KS + 32 * s + 16 * hh);
            f32x16 acc = zero16();
#pragma unroll
            for (int s = 0; s < 4; ++s) acc = __builtin_amdgcn_mfma_f32_32x32x16_bf16(kf[s], qf[s], acc, 0, 0, 0);
            if (kt == 0 || kt == 4) {
#pragma unroll
                for (int r = 0; r < 16; ++r) { const int kidx = (r & 3) + 8 * (r >> 2) + 4 * hh;
                    const bool ok = (kt == 0) ? (kidx >= ql) : (kidx <= ql);
                    acc[r] = ok ? acc[r] : -INFINITY; }
            }
            float mt = acc[0];
#pragma unroll
            for (int r = 1; r < 16; ++r) mt = fmaxf(mt, acc[r]);
            m = tk0 < 0 ? m : fmaxf(m, mt);
            sc[kt] = acc;
        }
        m = fmaxf(m, xhalf(m));
        const float ms = m * C2;
        f32x2 l2 = (f32x2){0.f, 0.f};
        unsigned pw[5][8];
#pragma unroll
        for (int kt = 0; kt < 5; ++kt) {
            const float mk = (tkb + 32 * kt * d) < 0 ? INFINITY : ms;
#pragma unroll
            for (int r = 0; r < 8; ++r) {
                const f32x2 t2 = __builtin_elementwise_fma((f32x2){sc[kt][2 * r], sc[kt][2 * r + 1]}, (f32x2){C2, C2}, (f32x2){-mk, -mk});
                const f32x2 p2 = (f32x2){__builtin_amdgcn_exp2f(t2[0]), __builtin_amdgcn_exp2f(t2[1])};
                l2 += p2; pw[kt][r] = pk2(p2[0], p2[1]); }
        }
        float l = l2[0] + l2[1];
        l += xhalf(l);
        AT_LOADQ(d2, rho2, tau2, vo2);
        f32x16 O[2];
#pragma unroll
        for (int r = 0; r < 16; ++r) { O[0][r] = 0.f; O[1][r] = 0.f; }
#pragma unroll
        for (int kt = 0; kt < 5; ++kt) {
#pragma unroll
            for (int i = 0; i < 4; ++i) { const int kidx = i * 8 + lrow;
                *(LAS v4u*)(Vw + kidx * 128 + ((lch ^ (((kidx >> 1) & 1) << 2)) << 4)) = R[kt][i]; }
            AT_LOADT(kt, C_AK, d2, tkb2, vo2);
#pragma unroll
            for (int s = 0; s < 2; ++s) {
                v4u pq; pq.x = pw[kt][4 * s]; pq.y = pw[kt][4 * s + 1]; pq.z = pw[kt][4 * s + 2]; pq.w = pw[kt][4 * s + 3];
                const bf16x8 pf = __builtin_bit_cast(bf16x8, pq);
#pragma unroll
                for (int dt = 0; dt < 2; ++dt) {
                    bf16x8 vf;
#pragma unroll
                    for (int pp = 0; pp < 2; ++pp) {
                        const int i16 = lane & 15, db = (lane >> 4) & 1;
                        const int row = 16 * s + 8 * pp + 4 * hh + (i16 >> 2);
                        const int byte = 64 * dt + 32 * db + 8 * (i16 & 3);
                        const int chunk = (byte >> 4) ^ (((row >> 1) & 1) << 2);
                        const s16x4 t4 = __builtin_bit_cast(s16x4, __builtin_amdgcn_ds_read_tr16_b64_v4i16((LAS v4i16_t*)(Vw + row * 128 + (chunk << 4) + (byte & 15))));
                        vf[4 * pp + 0] = t4[0]; vf[4 * pp + 1] = t4[1]; vf[4 * pp + 2] = t4[2]; vf[4 * pp + 3] = t4[3];
                    }
                    O[dt] = __builtin_amdgcn_mfma_f32_32x32x16_bf16(vf, pf, O[dt], 0, 0, 0);
                }
            }
        }
        LAS unsigned char* xo = lds + AT_XO + qoff * AT_XO_STRIDE + 8 * hh;
        float wa = 0.f, wb = 1.f, Mx = ms, ln = l;
        if (si >= 2) { const float msa = XM[qoff], la = XL[qoff]; Mx = fmaxf(msa, ms); wa = la * __builtin_amdgcn_exp2f(msa - Mx); wb = __builtin_amdgcn_exp2f(ms - Mx); ln = wa + wb * l; }
        const float inv = 1.f / ln;
#pragma unroll
        for (int dt = 0; dt < 2; ++dt)
#pragma unroll
            for (int g4 = 0; g4 < 4; ++g4) {
                LAS v2u* p = (LAS v2u*)(xo + (32 * dt + 8 * g4) * 2);
                float o0 = O[dt][4 * g4] * wb, o1 = O[dt][4 * g4 + 1] * wb, o2 = O[dt][4 * g4 + 2] * wb, o3 = O[dt][4 * g4 + 3] * wb;
                if (si >= 2) { const v2u old = *p; o0 += bflo(old.x) * wa; o1 += bfhi(old.x) * wa; o2 += bflo(old.y) * wa; o3 += bfhi(old.y) * wa; }
                v2u nw; nw.x = pk2(o0 * inv, o1 * inv); nw.y = pk2(o2 * inv, o3 * inv);
                *p = nw;
            }
        if (hh == 0) { XM[qoff] = Mx; XL[qoff] = ln; }
        if (si & 1) LDS_BARRIER();
    }
#undef AT_PARAMS
#undef AT_LOADQ
#undef AT_VOFF
#undef AT_LOADT
#pragma unroll
    for (int i = 0; i < 8; ++i) { const int row = (tid_ >> 3) + 64 * i, ch = tid_ & 7;
        LAS v2u* p = (LAS v2u*)(lds + AT_XO + row * AT_XO_STRIDE + ch * 16);
        const v2u a = p[0], c = p[1];
        v4u o; o.x = a.x; o.y = a.y; o.z = c.x; o.w = c.y;
        *(GAS v4u*)(Y + ((size_t)b * SEQ + t0 + row) * DM + RWW + h * 64 + ch * 8) = o; }
    LDS_BARRIER();
}

__device__ __forceinline__ void quantize_tables(Frame& F, int gw, int ngw) {
    for (int m = gw; m < 2 * NEXP; m += ngw) {
        const int tab = m >= NEXP, row = tab ? m - NEXP : m;
        const GAS f32x4* xr = (const GAS f32x4*)(F.in[18 + tab] + (size_t)row * DM) + F.lane * 4;
        f32x4 v[4]; float am = 0.f;
#pragma unroll
        for (int j = 0; j < 4; ++j) { v[j] = xr[j]; am = fmaxf(am, fmaxf(fmaxf(fabsf(v[j].x), fabsf(v[j].y)), fmaxf(fabsf(v[j].z), fabsf(v[j].w)))); }
        am = wave_max(am);
        const float qmax = tab ? 224.f : 127.f;
        const float sc = am > 0.f ? am / qmax : 1.f, inv = am > 0.f ? qmax / am : 0.f;
        v4u o;
#pragma unroll
        for (int j = 0; j < 4; ++j) {
            if (tab) { int w = __builtin_amdgcn_cvt_pk_fp8_f32(v[j].x * inv, v[j].y * inv, 0, false); w = __builtin_amdgcn_cvt_pk_fp8_f32(v[j].z * inv, v[j].w * inv, w, true); o[j] = (unsigned)w; }
            else {
            const unsigned b0 = (unsigned)(int)rintf(v[j].x * inv) & 255u, b1 = (unsigned)(int)rintf(v[j].y * inv) & 255u,
                           b2 = (unsigned)(int)rintf(v[j].z * inv) & 255u, b3 = (unsigned)(int)rintf(v[j].w * inv) & 255u;
            o[j] = b0 | (b1 << 8) | (b2 << 16) | (b3 << 24); } }
        *(GAS v4u*)(F.ws + (tab ? WS_VQ : WS_UQ) + (size_t)row * DM + F.lane * 16) = o;
        if (F.lane == 0) ((float*)(F.ws + (tab ? WS_SV : WS_SU)))[row] = sc;
    }
}

__device__ __forceinline__ void p3_mixers(Frame& F) {
    if (F.wg < NB * NHR) {
        const int chain = F.wg;
        const float* Pg = (const float*)(F.ws + WS_PQ) + (size_t)chain * 8 * 4096; const float* Qg = Pg + (size_t)256 * 4096;
        rwkv_scan<7, 3>(F, Pg, Qg, (float*)(F.ws + WS_SSEG) + (size_t)chain * 8 * 4096, nullptr);
        __syncthreads();
    }
#ifndef ATTN_REPS
#define ATTN_REPS 1
#endif
    for (int rep = 0; rep < ATTN_REPS; ++rep)
    if (F.G == 256) { for (int r = 0; r < 2; ++r) { const int v = r * 32 + (F.wg >> 3); attn_block(F, (((F.wg & 7) * 4 + (v >> 4)) << 4) | (v & 15)); } }
    else for (int item = F.wg; item < NB * NHA * (SEQ / 512); item += F.G) attn_block(F, item);
}

constexpr int TK_SKS = 272, TK_SKH = 0, TK_SKL = 2 * 128 * TK_SKS, TK_LUT = 2 * TK_SKL, TK_END = TK_LUT + 8 * 2048;
__device__ __forceinline__ unsigned f2ord(float f) { const unsigned u = __builtin_bit_cast(unsigned, f); return u ^ ((unsigned)((int)u >> 31) | 0x80000000u); }
__device__ __forceinline__ float ord2f(unsigned o) { const unsigned u = (o & 0x80000000u) ? (o ^ 0x80000000u) : ~o; return __builtin_bit_cast(float, u); }
__device__ __forceinline__ void ce_desc(unsigned& a, unsigned& b) { const unsigned mx = a > b ? a : b, mn = a > b ? b : a; a = mx; b = mn; }
template <int N, int OFF, int TOT> __device__ __forceinline__ void bitonic_sort_desc(unsigned (&v)[TOT]) {
#pragma unroll
    for (int k = 2; k <= N; k <<= 1)
#pragma unroll
        for (int j = k >> 1; j > 0; j >>= 1)
#pragma unroll
            for (int i = 0; i < N; ++i) { const int l = i ^ j; if (l > i) { if ((i & k) == 0) ce_desc(v[OFF + i], v[OFF + l]); else ce_desc(v[OFF + l], v[OFF + i]); } }
}
template <int OFFA, int OFFB, int TOT> __device__ __forceinline__ void merge_top16(unsigned (&v)[TOT]) {
#pragma unroll
    for (int i = 0; i < 16; ++i) { const unsigned x = v[OFFA + i], y = v[OFFB + 15 - i]; v[OFFA + i] = x > y ? x : y; }
#pragma unroll
    for (int j = 8; j > 0; j >>= 1)
#pragma unroll
        for (int i = 0; i < 16; ++i) { const int l = i ^ j; if (l > i) ce_desc(v[OFFA + i], v[OFFA + l]); }
}
__device__ __forceinline__ void top16_of_64(unsigned (&k)[64]) {
    bitonic_sort_desc<16, 0, 64>(k); bitonic_sort_desc<16, 16, 64>(k); bitonic_sort_desc<16, 32, 64>(k); bitonic_sort_desc<16, 48, 64>(k);
    merge_top16<0, 16, 64>(k); merge_top16<32, 48, 64>(k); merge_top16<0, 32, 64>(k);
}
__device__ __forceinline__ void p7_topk(Frame& F) {
    static_assert(TK_END <= LDSCTL_OFF, "topk LDS");
    const bf16* QP = (const bf16*)(F.ws + WS_QP);
    int* EID = (int*)(F.ws + WS_EID); float* GATE = (float*)(F.ws + WS_GATE);
    const float* sk = F.in[17];
    LAS unsigned char* lds = F.lds + RING_OFF;
    for (int e = F.tid; e < 2 * 128 * 64; e += NTHREADS) {
        const int c = e >> 13, k = (e >> 6) & 127, d2 = e & 63;
        const f32x2 v = *(const GAS f32x2*)(sk + (size_t)(c * 128 + k) * 128 + 2 * d2);
        const unsigned h0 = f2bf(v.x), h1 = f2bf(v.y);
        const float r0 = v.x - __builtin_bit_cast(float, h0 << 16), r1 = v.y - __builtin_bit_cast(float, h1 << 16);
        *(LAS unsigned*)(lds + TK_SKH + (c * 128 + k) * TK_SKS + d2 * 4) = h0 | (h1 << 16);
        *(LAS unsigned*)(lds + TK_SKL + (c * 128 + k) * TK_SKS + d2 * 4) = pk2(r0, r1);
    }
    __syncthreads();
    const int gw = F.wg * NWAVES + F.wave, NGW = F.G * NWAVES;
    for (int tile = gw; tile < T * PHEADS / 32; tile += NGW) {
        int lane_ = F.lane; asm volatile("" : "+v"(lane_));
        const int lane = lane_, hh = lane >> 5, cl = lane & 31;
        const int P = tile * 32 + cl, t = P >> 3, h = P & 7;
        unsigned kAB[2][16];
#pragma unroll
        for (int c = 0; c < 2; ++c) {
            bf16x8 qf[8];
            const bf16* qp = QP + (size_t)t * PQ + h * 256 + c * 128 + 8 * hh;
#pragma unroll
            for (int s2 = 0; s2 < 8; ++s2) qf[s2] = *(const GAS bf16x8*)(qp + 16 * s2);
            unsigned k[64];
#pragma unroll
            for (int mt = 0; mt < 4; ++mt) {
                f32x16 acc = zero16();
                const LAS unsigned char* ah = lds + TK_SKH + (c * 128 + mt * 32 + cl) * TK_SKS + 16 * hh;
                const LAS unsigned char* al = lds + TK_SKL + (c * 128 + mt * 32 + cl) * TK_SKS + 16 * hh;
#pragma unroll
                for (int s2 = 0; s2 < 8; ++s2) {
                    acc = __builtin_amdgcn_mfma_f32_32x32x16_bf16(*(const LAS bf16x8*)(ah + 32 * s2), qf[s2], acc, 0, 0, 0);
                    acc = __builtin_amdgcn_mfma_f32_32x32x16_bf16(*(const LAS bf16x8*)(al + 32 * s2), qf[s2], acc, 0, 0, 0); }
#pragma unroll
                for (int r = 0; r < 16; ++r) { const int idx = 32 * mt + (r & 3) + 8 * (r >> 2) + 4 * hh; k[mt * 16 + r] = (f2ord(acc[r]) & ~127u) | (unsigned)(127 - idx); }
            }
            top16_of_64(k);
            unsigned m[32];
#pragma unroll
            for (int i = 0; i < 16; ++i) { m[i] = k[i]; m[16 + i] = (unsigned)__shfl_xor((int)k[i], 32); }
            merge_top16<0, 16, 32>(m);
#pragma unroll
            for (int i = 0; i < 16; ++i) kAB[c][i] = m[i];
        }
        float fa[16], fb[16];
#pragma unroll
        for (int i = 0; i < 16; ++i) { fa[i] = ord2f(kAB[0][i] & ~127u); fb[i] = ord2f(kAB[1][i] & ~127u); }
        unsigned cd[64]; int n = 0;
#pragma unroll
        for (int i = 0; i < 16; ++i)
#pragma unroll
            for (int j = 0; j < 16; ++j) if ((i + 1) * (j + 1) <= 16) { cd[n] = (f2ord(fa[i] + fb[j]) & ~255u) | (unsigned)(255 - (i * 16 + j)); ++n; }
#pragma unroll
        for (int q = 50; q < 64; ++q) cd[q] = 0u;
        top16_of_64(cd);
        LAS unsigned char* lut = lds + TK_LUT + (F.wave * 64 + lane) * 32;
#pragma unroll
        for (int q = 0; q < 4; ++q) {
            unsigned wa = 0u, wb = 0u;
#pragma unroll
            for (int b4 = 0; b4 < 4; ++b4) { wa |= (127u - (kAB[0][4 * q + b4] & 127u)) << (8 * b4); wb |= (127u - (kAB[1][4 * q + b4] & 127u)) << (8 * b4); }
            *(LAS unsigned*)(lut + 4 * q) = wa; *(LAS unsigned*)(lut + 16 + 4 * q) = wb; }
        float gv[16]; float den = 0.f; const float mx = ord2f(cd[0] & ~255u);
#pragma unroll
        for (int q = 0; q < 16; ++q) { gv[q] = __expf(ord2f(cd[q] & ~255u) - mx); den += gv[q]; }
        const float inv = 1.f / den;
        asm volatile("s_waitcnt lgkmcnt(0)" ::: "memory");
        int ev[16];
#pragma unroll
        for (int q = 0; q < 16; ++q) { const unsigned pos = 255u - (cd[q] & 255u);
            const unsigned ia = *(const LAS unsigned char*)(lut + (pos >> 4)), ib = *(const LAS unsigned char*)(lut + 16 + (pos & 15u));
            ev[q] = (int)(ia * NKEYS + ib); }
        if (hh == 0) {
            int* ep = EID + (size_t)t * 128 + h * 16; float* gp = GATE + (size_t)t * 128 + h * 16;
#pragma unroll
            for (int q = 0; q < 4; ++q) {
                *(GAS v4u*)(ep + 4 * q) = (v4u){(unsigned)ev[4 * q], (unsigned)ev[4 * q + 1], (unsigned)ev[4 * q + 2], (unsigned)ev[4 * q + 3]};
                *(GAS f32x4*)(gp + 4 * q) = (f32x4){gv[4 * q] * inv, gv[4 * q + 1] * inv, gv[4 * q + 2] * inv, gv[4 * q + 3] * inv}; }
        }
        asm volatile("s_waitcnt lgkmcnt(0)" ::: "memory");
    }
}

constexpr int GA_WAVE_BYTES = 10752, GA_CNT = 4096, GA_OFF = 4096 + 128, GA_ACT = 4608, GA_XQ = 6656;
__device__ __forceinline__ int wave_sum_i(int v) { v += dppi<0xB1>(v); v += dppi<0x4E>(v); v += dppi<0x141>(v); v += dppi<0x140>(v);
    return (__builtin_amdgcn_readlane(v, 0) + __builtin_amdgcn_readlane(v, 16)) + (__builtin_amdgcn_readlane(v, 32) + __builtin_amdgcn_readlane(v, 48)); }
__device__ __forceinline__ void p8_gather(Frame& F, float* outp) {
    const bf16* XN = (const bf16*)(F.ws + WS_XN);
    const unsigned char* UQ = F.ws + WS_UQ; const unsigned char* VQ = F.ws + WS_VQ;
    const float* SU = (const float*)(F.ws + WS_SU); const float* SV = (const float*)(F.ws + WS_SV);
    const int* EID = (const int*)(F.ws + WS_EID); const float* GATE = (const float*)(F.ws + WS_GATE);
    const float* nf = F.in[20];
    const int gw = F.wg * NWAVES + F.wave, NGW = F.G * NWAVES;
    LAS unsigned char* wl = F.lds + RING_OFF + F.wave * GA_WAVE_BYTES;
    for (int tg = gw, sweep = 0; tg < T / 4; tg += NGW, ++sweep) {
        int lane_ = F.lane; asm volatile("" : "+v"(lane_));
        const int lane = lane_;
        int xq[4][4]; float sx[4];
#pragma unroll
        for (int tk = 0; tk < 4; ++tk) {
            const GAS v4u* xp = (const GAS v4u*)(XN + (size_t)(4 * tg + tk) * DM + lane * 16);
            const v4u a = xp[0], b = xp[1];
            float x[16]; x[0] = bflo(a.x); x[1] = bfhi(a.x); x[2] = bflo(a.y); x[3] = bfhi(a.y); x[4] = bflo(a.z); x[5] = bfhi(a.z); x[6] = bflo(a.w); x[7] = bfhi(a.w);
            x[8] = bflo(b.x); x[9] = bfhi(b.x); x[10] = bflo(b.y); x[11] = bfhi(b.y); x[12] = bflo(b.z); x[13] = bfhi(b.z); x[14] = bflo(b.w); x[15] = bfhi(b.w);
            float am = 0.f;
#pragma unroll
            for (int i = 0; i < 16; ++i) am = fmaxf(am, fabsf(x[i]));
            am = wave_max(am);
            const float rs_ = frsq(((const float*)(F.ws + WS_SSQ))[4 * tg + tk] * (1.f / DM) + RMS_EPS);
            sx[tk] = (am > 0.f ? am * (1.f / 127.f) : 1.f) * rs_; const float inv = am > 0.f ? 127.f / am : 0.f;
#pragma unroll
            for (int q = 0; q < 4; ++q) {
                const unsigned b0 = (unsigned)(int)rintf(x[4 * q] * inv) & 255u, b1 = (unsigned)(int)rintf(x[4 * q + 1] * inv) & 255u, b2 = (unsigned)(int)rintf(x[4 * q + 2] * inv) & 255u, b3 = (unsigned)(int)rintf(x[4 * q + 3] * inv) & 255u;
                xq[tk][q] = (int)(b0 | (b1 << 8) | (b2 << 16) | (b3 << 24)); }
            *(LAS v4u*)(wl + GA_XQ + tk * 1024 + lane * 16) = (v4u){(unsigned)xq[tk][0], (unsigned)xq[tk][1], (unsigned)xq[tk][2], (unsigned)xq[tk][3]};
        }
        LAS unsigned* cnt = (LAS unsigned*)(wl + GA_CNT); LAS unsigned* offs = (LAS unsigned*)(wl + GA_OFF);
        if (lane < 32) cnt[lane] = 0u;
        asm volatile("s_waitcnt lgkmcnt(0)" ::: "memory");
        int ee[8]; float gg[8]; unsigned pos[8];
#pragma unroll
        for (int tk = 0; tk < 4; ++tk) {
            const size_t base = (size_t)(4 * tg + tk) * 128;
            ee[2 * tk] = (EID[base + lane] & (NEXP - 1)) | (tk << 14); ee[2 * tk + 1] = (EID[base + 64 + lane] & (NEXP - 1)) | (tk << 14);
            gg[2 * tk] = GATE[base + lane]; gg[2 * tk + 1] = GATE[base + 64 + lane]; }
#pragma unroll
        for (int q = 0; q < 8; ++q) pos[q] = __hip_atomic_fetch_add(cnt + ((ee[q] >> 9) & 31), 1u, __ATOMIC_RELAXED, __HIP_MEMORY_SCOPE_WAVEFRONT);
        asm volatile("s_waitcnt lgkmcnt(0)" ::: "memory");
        if (lane < 32) {
            const int c0 = (int)cnt[lane]; int v = c0;
            v += __builtin_amdgcn_update_dpp(0, v, 0x111, 0xF, 0xF, true); v += __builtin_amdgcn_update_dpp(0, v, 0x112, 0xF, 0xF, true);
            v += __builtin_amdgcn_update_dpp(0, v, 0x114, 0xF, 0xF, true); v += __builtin_amdgcn_update_dpp(0, v, 0x118, 0xF, 0xF, true);
            const int row0 = __builtin_amdgcn_readlane(v, 15);
            offs[lane] = (unsigned)(v - c0 + (lane >= 16 ? row0 : 0));
        }
        asm volatile("s_waitcnt lgkmcnt(0)" ::: "memory");
#pragma unroll
        for (int q = 0; q < 8; ++q) { const unsigned idx = offs[(ee[q] >> 9) & 31] + pos[q];
            *(LAS unsigned*)(wl + idx * 4) = (unsigned)ee[q]; *(LAS float*)(wl + 2048 + idx * 4) = gg[q]; }
        asm volatile("s_waitcnt lgkmcnt(0)" ::: "memory");
        LAS float* act = (LAS float*)(wl + GA_ACT);
#ifndef UPASS_REPS
#define UPASS_REPS 1
#endif
        for (int urep = 0; urep < UPASS_REPS; ++urep)
        {
            const int grp = lane >> 4, l16 = lane & 15;
            const LAS unsigned* ents = (const LAS unsigned*)wl;
            LAS int* hbuf = (LAS int*)(wl + GA_ACT);
            v4u rb[2][2][4]; unsigned eb[2][2];
#define GA_ULOAD(ST, QD, Q_) do { const unsigned e_ = ents[(Q_) * 4 + grp]; eb[ST][QD] = e_; const GAS v4u* rp_ = (const GAS v4u*)(UQ + (size_t)(e_ & (NEXP - 1)) * DM + l16 * 64); \
                rb[ST][QD][0] = rp_[0]; rb[ST][QD][1] = rp_[1]; rb[ST][QD][2] = rp_[2]; rb[ST][QD][3] = rp_[3]; } while (0)
#define GA_UDOT(ST, QD, Q_) do { const LAS v4u* xp_ = (const LAS v4u*)(wl + GA_XQ + ((eb[ST][QD] >> 14) & 3u) * 1024 + l16 * 64); int d_ = 0; \
                _Pragma("unroll") for (int k_ = 0; k_ < 4; ++k_) { const v4u x_ = xp_[k_], r_ = rb[ST][QD][k_]; \
                    d_ = __builtin_amdgcn_sdot4((int)x_.x, (int)r_.x, d_, false); d_ = __builtin_amdgcn_sdot4((int)x_.y, (int)r_.y, d_, false); \
                    d_ = __builtin_amdgcn_sdot4((int)x_.z, (int)r_.z, d_, false); d_ = __builtin_amdgcn_sdot4((int)x_.w, (int)r_.w, d_, false); } \
                d_ += dppi<0xB1>(d_); d_ += dppi<0x4E>(d_); d_ += dppi<0x141>(d_); d_ += dppi<0x140>(d_); \
                if (l16 == 0) hbuf[(Q_) * 4 + grp] = d_; } while (0)
            GA_ULOAD(0, 0, 0); GA_ULOAD(0, 1, 1);
            for (int q2 = 0; q2 < 128; q2 += 4) {
                GA_ULOAD(1, 0, q2 + 2); GA_ULOAD(1, 1, q2 + 3);
                __builtin_amdgcn_sched_barrier(0);
                GA_UDOT(0, 0, q2); GA_UDOT(0, 1, q2 + 1);
                __builtin_amdgcn_sched_barrier(0);
                if (q2 + 4 < 128) { GA_ULOAD(0, 0, q2 + 4); GA_ULOAD(0, 1, q2 + 5); }
                __builtin_amdgcn_sched_barrier(0);
                GA_UDOT(1, 0, q2 + 2); GA_UDOT(1, 1, q2 + 3);
                __builtin_amdgcn_sched_barrier(0);
            }
#undef GA_ULOAD
#undef GA_UDOT
            asm volatile("s_waitcnt lgkmcnt(0)" ::: "memory");
#pragma unroll 2
            for (int it = 0; it < 8; ++it) { const int p = it * 64 + lane;
                const unsigned e_ = ents[p]; const float g_ = *(const LAS float*)(wl + 2048 + p * 4); const int hs = hbuf[p];
                const int ex_ = (int)(e_ & (NEXP - 1)), tk_ = (int)(e_ >> 14) & 3;
                const float sxl = tk_ == 0 ? sx[0] : (tk_ == 1 ? sx[1] : (tk_ == 2 ? sx[2] : sx[3]));
                const float h_ = (float)hs * (SU[ex_] * sxl);
                act[p] = 0.5f * h_ * (1.f + erff(h_ * 0.70710678118654752f)) * g_ * SV[ex_]; }
        }
        asm volatile("s_waitcnt lgkmcnt(0)" ::: "memory");
        float y[4][16];
#pragma unroll
        for (int tk = 0; tk < 4; ++tk) {
#pragma unroll
            for (int i = 0; i < 16; ++i) y[tk][i] = 0.f; }
#define GA_AXPY(V, A, TK) do { \
            _Pragma("unroll") for (int q_ = 0; q_ < 4; ++q_) { const int w_ = (int)(V)[q_]; const f32x2 lo_ = __builtin_amdgcn_cvt_pk_f32_fp8(w_, false), hi_ = __builtin_amdgcn_cvt_pk_f32_fp8(w_, true); \
                y[TK][4 * q_] += (A) * lo_.x; y[TK][4 * q_ + 1] += (A) * lo_.y; y[TK][4 * q_ + 2] += (A) * hi_.x; y[TK][4 * q_ + 3] += (A) * hi_.y; } } while (0)
        for (int ch = 0; ch < 8; ++ch) {
            const unsigned ent = *(const LAS unsigned*)(wl + (ch * 64 + lane) * 4);
            const float areg = act[ch * 64 + lane];
            v4u vb[2][8]; int eb[2][8];
#pragma unroll
            for (int q = 0; q < 8; ++q) { eb[0][q] = __builtin_amdgcn_readlane((int)ent, q); vb[0][q] = *(const GAS v4u*)(VQ + (size_t)(eb[0][q] & (NEXP - 1)) * DM + lane * 16); }
#pragma unroll
            for (int jb = 0; jb < 8; ++jb) {
                if (jb + 1 < 8) {
#pragma unroll
                    for (int q = 0; q < 8; ++q) { eb[(jb + 1) & 1][q] = __builtin_amdgcn_readlane((int)ent, 8 * (jb + 1) + q); vb[(jb + 1) & 1][q] = *(const GAS v4u*)(VQ + (size_t)(eb[(jb + 1) & 1][q] & (NEXP - 1)) * DM + lane * 16); } }
                __builtin_amdgcn_sched_barrier(0);
#pragma unroll
                for (int q = 0; q < 8; ++q) { const int tk_ = (eb[jb & 1][q] >> 14) & 3; const v4u v_ = vb[jb & 1][q]; const float a_ = rdlane(areg, 8 * jb + q);
                    if (tk_ == 0) GA_AXPY(v_, a_, 0); else if (tk_ == 1) GA_AXPY(v_, a_, 1); else if (tk_ == 2) GA_AXPY(v_, a_, 2); else GA_AXPY(v_, a_, 3); }
                __builtin_amdgcn_sched_barrier(0);
            }
        }
#undef GA_AXPY
#pragma unroll
        for (int tk = 0; tk < 4; ++tk) {
            float* hrow = F.out + (size_t)(4 * tg + tk) * DM + lane * 16;
            float hv[16]; float ss = 0.f;
#pragma unroll
            for (int q = 0; q < 4; ++q) { const f32x4 h4 = *(const GAS f32x4*)(hrow + 4 * q);
#pragma unroll
                for (int i = 0; i < 4; ++i) { const float v = h4[i] + y[tk][4 * q + i]; hv[4 * q + i] = v; ss += v * v; } }
            const float rstd = frsq(wave_sum(ss) * (1.f / DM) + RMS_EPS);
#pragma unroll
            for (int q = 0; q < 4; ++q) { const f32x4 n4 = *(const GAS f32x4*)(nf + lane * 16 + 4 * q);
                *(GAS f32x4*)(outp + (size_t)(4 * tg + tk) * DM + lane * 16 + 4 * q) = (f32x4){hv[4 * q] * rstd * n4[0], hv[4 * q + 1] * rstd * n4[1], hv[4 * q + 2] * rstd * n4[2], hv[4 * q + 3] * rstd * n4[3]}; }
        }
    }
}

struct Args { const float* in[21]; float* out; unsigned char* ws; int ph_lo, ph_hi; };
static_assert(sizeof(Args) == 21 * 8 + 8 + 8 + 8, "Args has no padding");

__global__ void __launch_bounds__(NTHREADS, 2) fwd_kernel(Args args) {
    extern __shared__ __attribute__((aligned(16))) unsigned char lds[];
    Frame F;
    F.lds = (LAS unsigned char*)lds;
    F.MISC = (volatile LAS unsigned*)(F.lds + MISC_OFF);
    F.tid = threadIdx.x; F.lane = F.tid & 63; F.wave = __builtin_amdgcn_readfirstlane(F.tid >> 6);
    F.G = gridDim.x; F.wg = blockIdx.x;
#pragma unroll
    for (int i = 0; i < 21; ++i) F.in[i] = args.in[i];
    F.out = args.out; F.ws = args.ws;
    F.ctl = (gu32*)(args.ws + WS_CTL);
    for (int u = F.tid; u < (LDS_BYTES - LDSCTL_OFF) / 4; u += NTHREADS) ((LAS unsigned*)(F.lds + LDSCTL_OFF))[u] = 0u;
    __syncthreads();
    const int lo = args.ph_lo, hi = args.ph_hi;
    const bool fused = (hi - lo) > 1;
    XcdBarrier bar; bar.bar = (unsigned*)(F.ctl + CW_BAR); bar.x = 0; bar.st = nullptr;
    if (fused) bar = xcd_barrier_post((unsigned*)(F.ctl + CW_BAR), F.MISC + 8);
#define IN(k) (lo <= (k) && (k) < hi)
#define REPS(k) (((REP_MASK >> (k)) & 1) ? 2 : 1)
#define REPLOOP(k) for (int rep_ = 0; rep_ < REPS(k); ++rep_, (rep_ < REPS(k) ? xcd_barrier(bar) : (void)0))
#define SEAM(k) do { if (IN(k) && IN((k) + 1)) xcd_barrier(bar); } while (0)

    if (IN(0)) { REPLOOP(0) { p0_prologue(F); p0_rope_table(F); } SEAM(0); }
    if (IN(1)) { REPLOOP(1) {
        pg8::Gemm g{(const bf16*)(F.ws + WS_XN), (const bf16*)(F.ws + WS_WIN), T, IN_COLS, DM}; pg8::StaticOrder S; S.init(T, IN_COLS, F.G, F.wg);
        pg8::EpiBf16 E{(bf16*)(F.ws + WS_Z), IN_COLS};
        pg8::gemm_phase<pg8::EpiBf16, pg8::StaticOrder, true, true>(F.lds + RING_OFF, g, S, E); }
        {
            const int nwg = (T / 256) * (IN_COLS / 256), rem = nwg % F.G;
            if (rem == 0) quantize_tables(F, F.wg * NWAVES + F.wave, F.G * NWAVES);
            else if (F.wg >= rem) quantize_tables(F, (F.wg - rem) * NWAVES + F.wave, (F.G - rem) * NWAVES);
        }
        SEAM(1);
    }
    if (IN(2)) { p2_rope(F); REPLOOP(2) { const int cnt = r13_count(F.wg, F.G); R1Pre P;
            if (cnt > 0) rwkv_r1_prefetch(F, r13_item(F.wg, F.G, 0), F.tid, P);
            bf16x8 bfr[4]; int hcur = -1;
            f32x4 cst[4];
            { const int n16 = F.lane & 15, g = F.lane >> 4;
#pragma unroll
              for (int rt = 0; rt < 4; ++rt)
#pragma unroll
                  for (int q = 0; q < 4; ++q) cst[rt][q] = (F.wave < 4 && 16 * rt + 4 * g + q == 16 * F.wave + n16) ? 1.f : 0.f; }
            for (int i = 0; i < cnt; ++i) { const int it = r13_item(F.wg, F.G, i), hh_ = (it >> 7) & 7;
                if (hh_ != hcur) { r1_load_bfrag(F, hh_, F.wave, F.lane, bfr); __syncthreads(); r1_load_params(F, hh_); __syncthreads(); hcur = hh_; }
                rwkv_r1_item(F, it, i + 1 < cnt ? r13_item(F.wg, F.G, i + 1) : -1, P, bfr, cst); }
            { const int n16 = F.lane & 15, g = F.lane >> 4; float* Pg = (float*)(F.ws + WS_PQ) + (size_t)F.wg * 4096; float* Qg = Pg + (size_t)256 * 4096;
              if (F.wave < 4) {
#pragma unroll
                  for (int rt = 0; rt < 4; ++rt)
#pragma unroll
                      for (int q = 0; q < 4; ++q) Pg[(16 * rt + 4 * g + q) * 64 + 16 * F.wave + n16] = cst[rt][q];
              } else {
#pragma unroll
                  for (int rt = 0; rt < 4; ++rt) *(GAS f32x4*)(Qg + (16 * (F.wave - 4) + n16) * 64 + 16 * rt + 4 * g) = cst[rt];
              } } }
        SEAM(2); }
    if (IN(3)) { REPLOOP(3) p3_mixers(F); SEAM(3); }
    if (IN(4)) { REPLOOP(4) { const int cnt = r13_count(F.wg, F.G); R3Pre P;
            {
                const int item0 = r13_item(F.wg, F.G, 0);
                rwkv_scan<15, 7>(F, F.out + (size_t)item0 * 4096, F.out + (size_t)T * RWW + (size_t)item0 * 4096, (float*)(F.ws + WS_RWSS) + (size_t)item0 * 4096, (const float*)(F.ws + WS_SSEG) + (size_t)F.wg * 4096);
                asm volatile("s_waitcnt vmcnt(0)" ::: "memory"); __syncthreads();
            }
            if (cnt > 0) rwkv_r3_prefetch(F, r13_item(F.wg, F.G, 0), F.tid, P);
            bf16x8 bfr[8]; int hcur = -1;
            for (int i = 0; i < cnt; ++i) { const int it = r13_item(F.wg, F.G, i), hh_ = (it >> 7) & 7;
                if (hh_ != hcur) { r3_load_bfrag(F, hh_, F.wave, F.lane, bfr); __syncthreads(); r3_load_params(F, hh_); __syncthreads(); hcur = hh_; }
                rwkv_r3_item(F, it, i + 1 < cnt ? r13_item(F.wg, F.G, i + 1) : -1, P, bfr); } }
        SEAM(4); }
    if (IN(5)) {
        pg8::Gemm g{(const bf16*)(F.ws + WS_YMIX), (const bf16*)(F.ws + WS_WOUT), T, DM, DM}; pg8::StaticOrder S; S.init(T, DM, F.G, F.wg);
        pg8::EpiF32Res E{F.in[0], F.out, DM, (bf16*)(F.ws + WS_XN), F.in[15], (float*)(F.ws + WS_SSQ)};
        pg8::gemm_phase<pg8::EpiF32Res, pg8::StaticOrder, true, true>(F.lds + RING_OFF, g, S, E);
        SEAM(5);
    }
    if (IN(6)) { REPLOOP(6) {
        pg8::Gemm g{(const bf16*)(F.ws + WS_XN), (const bf16*)(F.ws + WS_WQ), T, PQ, DM}; pg8::StaticOrder S; S.init(T, PQ, F.G, F.wg);
        pg8::EpiBf16Rs E{(bf16*)(F.ws + WS_QP), PQ, (const float*)(F.ws + WS_SSQ)};
        pg8::gemm_phase<pg8::EpiBf16Rs, pg8::StaticOrder, true, true>(F.lds + RING_OFF, g, S, E); }
        SEAM(6);
    }
    if (IN(7)) { REPLOOP(7) p7_topk(F); if (IN(8)) { asm volatile("s_waitcnt vmcnt(0)" ::: "memory"); __syncthreads(); } }
    if (IN(8)) { if (REPS(8) > 1) { p8_gather(F, (float*)(F.ws + WS_Z)); xcd_barrier(bar); } p8_gather(F, F.out); }
#undef IN
#undef SEAM
}

extern "C" void kernel_launch(void* const* d_in, const int* in_sizes, int n_in, void* d_out, int out_size, void* d_ws, size_t ws_size, hipStream_t stream) {
    static int grid = 0;
    if (grid == 0) {
        if (n_in != 21 || in_sizes[0] != T * DM || out_size != T * DM || ws_size < WS_END) {
            fprintf(stderr, "kernel_launch: unexpected shapes: n_in %d in0 %d out %d ws %zu (need %zu); nothing launched\n", n_in, n_in > 0 ? in_sizes[0] : -1, out_size, ws_size, (size_t)WS_END); grid = -1; return; }
        int dev = 0, cus = 0, per_cu = 0;
        if (hipGetDevice(&dev) != hipSuccess || hipDeviceGetAttribute(&cus, hipDeviceAttributeMultiprocessorCount, dev) != hipSuccess) { grid = -1; return; }
        if (hipFuncSetAttribute((const void*)fwd_kernel, hipFuncAttributeMaxDynamicSharedMemorySize, LDS_BYTES) != hipSuccess) { fprintf(stderr, "kernel_launch: hipFuncSetAttribute failed\n"); grid = -1; return; }
        if (hipOccupancyMaxActiveBlocksPerMultiprocessor(&per_cu, (const void*)fwd_kernel, NTHREADS, LDS_BYTES) != hipSuccess || per_cu < 1) { fprintf(stderr, "kernel_launch: occupancy query says %d\n", per_cu); per_cu = 1; }
        (void)hipGetLastError();
        grid = cus;
        if (cus != 256) { fprintf(stderr, "kernel_launch: the RWKV segment mapping assumes 256 CUs (got %d); nothing launched\n", cus); grid = -1; return; }
    }
    if (grid < 0) return;
    (void)hipMemsetAsync((char*)d_ws + WS_CTL, 0, CTL_ZERO_BYTES, stream);
    Args a{};
    for (int i = 0; i < 21; ++i) a.in[i] = (const float*)d_in[i];
    a.out = (float*)d_out; a.ws = (unsigned char*)d_ws;
    if (MK_N_LAUNCHES == 1) {
        a.ph_lo = 0; a.ph_hi = NPHASE;
        void* kargs[] = {&a};
        hipError_t e = hipLaunchCooperativeKernel((const void*)fwd_kernel, dim3(grid), dim3(NTHREADS), kargs, LDS_BYTES, stream);
        if (e != hipSuccess) fprintf(stderr, "kernel_launch: cooperative launch failed: %s (grid %d)\n", hipGetErrorString(e), grid);
    } else {
        for (int p = 0; p < NPHASE; ++p) { a.ph_lo = p; a.ph_hi = p + 1;
            hipLaunchKernelGGL(fwd_kernel, dim3(grid), dim3(NTHREADS), LDS_BYTES, stream, a); }
    }
}
```

```cpp
#include <hip/hip_runtime.h>
#include <cstdio>
#include <cstdint>

#ifndef MK_N_LAUNCHES
#define MK_N_LAUNCHES 1
#endif

#ifndef REP_MASK
#define REP_MASK 0
#endif
#define GAS __attribute__((address_space(1)))
#define LAS __attribute__((address_space(3)))
typedef unsigned short bf16;
typedef unsigned v4u __attribute__((ext_vector_type(4)));
typedef unsigned v2u __attribute__((ext_vector_type(2)));
typedef float f32x4 __attribute__((ext_vector_type(4)));
typedef float f32x2 __attribute__((ext_vector_type(2)));
typedef short bf16x8 __attribute__((ext_vector_type(8)));
typedef GAS unsigned gu32;
#define RLX_AGENT __ATOMIC_RELAXED, __HIP_MEMORY_SCOPE_AGENT
#define LDS_WAIT() asm volatile("s_waitcnt lgkmcnt(0)" ::: "memory")
#define VM_WAIT() asm volatile("s_waitcnt vmcnt(0)" ::: "memory")
#define LDS_BARRIER() do { asm volatile("s_waitcnt lgkmcnt(0)" ::: "memory"); __builtin_amdgcn_s_barrier(); asm volatile("" ::: "memory"); } while (0)

constexpr int DM = 1024, NB = 4, SEQ = 8192, T = NB * SEQ;
constexpr int HD = 64, RWW = 512, NHR = 8, NHA = 8;
constexpr int IN_COLS = 3328;
constexpr int C_R = 0, C_K = 512, C_V = 1024, C_WD = 1536, C_AD = 1600, C_GD = 1664, C_AQ = 1792, C_AK = 2304, C_AV = 2816;
constexpr int PHEADS = 8, NKEYS = 128, PQ = 2048, TOPK = 16, NEXP = 16384;
constexpr float RMS_EPS = 1e-6f, GN_EPS = 64e-5f;
constexpr int NWAVES = 8, NTHREADS = 512;
constexpr int NPHASE = 9;

constexpr size_t MiB = 1u << 20;
constexpr size_t WS_CTL = 0, CTL_ZERO_BYTES = 1 * MiB;
constexpr size_t WS_WIN = 2 * MiB;
constexpr size_t WS_WOUT = 10 * MiB;
constexpr size_t WS_WQ = 12 * MiB;
constexpr size_t WS_XN = 16 * MiB;
constexpr size_t WS_Z = 80 * MiB;
constexpr size_t WS_QP = 80 * MiB;
constexpr size_t WS_G = 288 * MiB;
constexpr size_t WS_YMIX = 352 * MiB;
constexpr size_t WS_UQ = 416 * MiB;
constexpr size_t WS_VQ = 432 * MiB;
constexpr size_t WS_SU = 448 * MiB;
constexpr size_t WS_SV = 449 * MiB;
constexpr size_t WS_EID = 480 * MiB;
constexpr size_t WS_GATE = 496 * MiB;
constexpr size_t WS_SSEG = 450 * MiB;
constexpr size_t WS_PQ = 456 * MiB;
constexpr size_t WS_END = 512 * MiB;
constexpr size_t WS_WUPT = 1 * MiB, WS_AUPT = WS_WUPT + 65536, WS_GUPT = WS_AUPT + 65536;
constexpr size_t WS_BONUS = 9 * MiB;
constexpr size_t WS_RWY0 = WS_XN;
constexpr size_t WS_RWSS = WS_G;
constexpr size_t WS_RWRH = WS_EID;

constexpr int CW_BAR = 4096;
constexpr int CW_SCAN = 16384;
constexpr size_t WS_SSQ = 256 * 1024;

typedef __bf16 hbf16x2_t __attribute__((ext_vector_type(2)));
__device__ __forceinline__ unsigned pk2(float lo, float hi) { const f32x2 v = {lo, hi}; const hbf16x2_t b = __builtin_convertvector(v, hbf16x2_t); return __builtin_bit_cast(unsigned, b); }
__device__ __forceinline__ unsigned f2bf(float f) { return pk2(f, 0.f) & 0xffffu; }
__device__ __forceinline__ float frcp(float x) { return __builtin_amdgcn_rcpf(x); }
__device__ __forceinline__ float frsq(float x) { return __builtin_amdgcn_rsqf(x); }
__device__ __forceinline__ float bflo(unsigned u) { return __builtin_bit_cast(float, u << 16); }
__device__ __forceinline__ float bfhi(unsigned u) { return __builtin_bit_cast(float, u & 0xffff0000u); }
__device__ __forceinline__ float bf2f(bf16 h) { return __builtin_bit_cast(float, (unsigned)h << 16); }

template <int CTRL> __device__ __forceinline__ float dppf(float x) { return __builtin_bit_cast(float, __builtin_amdgcn_update_dpp(0, __builtin_bit_cast(int, x), CTRL, 0xF, 0xF, true)); }
template <int CTRL> __device__ __forceinline__ int dppi(int x) { return __builtin_amdgcn_update_dpp(0, x, CTRL, 0xF, 0xF, true); }
__device__ __forceinline__ float rdlane(float v, int l) { return __builtin_bit_cast(float, __builtin_amdgcn_readlane(__builtin_bit_cast(int, v), l)); }
__device__ __forceinline__ float sum8(float v) { v += dppf<0xB1>(v); v += dppf<0x4E>(v); v += dppf<0x141>(v); return v; }
__device__ __forceinline__ float sum16(float v) { v = sum8(v); v += dppf<0x140>(v); return v; }
__device__ __forceinline__ float wave_sum(float v) { v = sum16(v);
    v += __builtin_bit_cast(float, __builtin_amdgcn_update_dpp(0, __builtin_bit_cast(int, v), 0x142, 0xA, 0xF, false));
    v += __builtin_bit_cast(float, __builtin_amdgcn_update_dpp(0, __builtin_bit_cast(int, v), 0x143, 0xC, 0xF, false));
    return rdlane(v, 63); }
__device__ __forceinline__ float wave_max(float v) {
    v = fmaxf(v, dppf<0xB1>(v)); v = fmaxf(v, dppf<0x4E>(v)); v = fmaxf(v, dppf<0x141>(v)); v = fmaxf(v, dppf<0x140>(v));
    return fmaxf(fmaxf(rdlane(v, 0), rdlane(v, 16)), fmaxf(rdlane(v, 32), rdlane(v, 48)));
}

namespace pg8 {
#define PG8_LAS __attribute__((address_space(3)))
typedef unsigned short bf16_t;
typedef unsigned u32x4 __attribute__((ext_vector_type(4)));
constexpr int BM = 256, BK = 64, HALF = 128, HTB = HALF * BK * 2, STAGE_BYTES = 8 * HTB, NXCD = 8, WGM = 8;
__host__ __device__ __forceinline__ int lds_byte(int r, int c) { const int st = (r >> 4) * 2 + (c >> 5), rr = r & 15, cc = c & 31, ob = rr * 64 + cc * 2; return st * 1024 + (ob ^ (((ob >> 9) & 1) << 5)); }
__host__ __device__ __forceinline__ void stage_rc(int b, int& R, int& C) { const int st = b / 1024, sb = b % 1024, swz = sb ^ (((sb >> 9) & 1) << 5); R = (st >> 1) * 16 + swz / 64; C = (st & 1) * 32 + (swz % 64) / 2; }
__host__ __device__ __forceinline__ int perm32(int rho) { const int n = rho >> 4, i = rho & 15; return 8 * (i >> 2) + 4 * n + (i & 3); }
struct Unit { int pm, pn; };
struct Gemm { const bf16_t* A; const bf16_t* Bt; int M, N, K; };
struct StaticOrder {
    int nM, nN, nwg, G, c;
    __host__ __device__ void init(int M, int N, int G_, int c_) { nM = M / BM; nN = N / BM; nwg = nM * nN; G = G_; c = c_; }
    __host__ __device__ bool next(int i, Unit& u) const {
        const long L = (long)i * G + c; if (L >= nwg) return false;
        int wgid = (int)L; { const int q = nwg / NXCD, r = nwg % NXCD, xcd = wgid % NXCD, off = wgid / NXCD; wgid = (xcd < r ? xcd * (q + 1) : r * (q + 1) + (xcd - r) * q) + off; }
        const int nig = WGM * nN, gid = wgid / nig, fm = gid * WGM, gsz = (nM - fm) < WGM ? (nM - fm) : WGM;
        u.pm = fm + ((wgid % nig) % gsz); u.pn = (wgid % nig) / gsz; return true;
    }
    __device__ __forceinline__ void a_ready(const Unit&) const {}
    __device__ __forceinline__ void done(const Unit&) const {}
};
__device__ __forceinline__ unsigned cvt_pk_bf16(float lo, float hi) { unsigned r; asm volatile("v_cvt_pk_bf16_f32 %0, %1, %2" : "=v"(r) : "v"(lo), "v"(hi)); return r; }
struct EpiBf16 {
    static constexpr bool PERM = true, AFTER_DRAIN = false;
    bf16_t* O; int ldc;
    __device__ __forceinline__ void operator()(const f32x4 (&acc)[2][2][4][2], const Unit& u, int wr, int wc, int fr, int fq) const {
        const int row0 = u.pm * BM + wr * 64 + fr; const int col0 = u.pn * BM + wc * 32 + 8 * fq;
#pragma unroll
        for (int ai = 0; ai < 2; ++ai)
#pragma unroll
            for (int m = 0; m < 4; ++m) { bf16_t* rowp = O + (size_t)(row0 + ai * HALF + m * 16) * ldc + col0;
#pragma unroll
                for (int bj = 0; bj < 2; ++bj) { const f32x4 v0 = acc[ai][bj][m][0], v1 = acc[ai][bj][m][1];
                    u32x4 w; w.x = cvt_pk_bf16(v0[0], v0[1]); w.y = cvt_pk_bf16(v0[2], v0[3]); w.z = cvt_pk_bf16(v1[0], v1[1]); w.w = cvt_pk_bf16(v1[2], v1[3]);
                    *(u32x4*)(rowp + bj * HALF) = w; } }
    }
};
struct EpiF32Res {
    static constexpr bool PERM = true, AFTER_DRAIN = false;
    const float* res; float* O; int ldc; bf16_t* HG; const float* gain; float* ssq;
    __device__ __forceinline__ void operator()(const f32x4 (&acc)[2][2][4][2], const Unit& u, int wr, int wc, int fr, int fq) const {
        const int row0 = u.pm * BM + wr * 64 + fr; const int col0 = u.pn * BM + wc * 32 + 8 * fq;
        f32x4 gv[2][2];
#pragma unroll
        for (int bj = 0; bj < 2; ++bj) { gv[bj][0] = *(const f32x4*)(gain + col0 + bj * HALF); gv[bj][1] = *(const f32x4*)(gain + col0 + bj * HALF + 4); }
#pragma unroll
        for (int ai = 0; ai < 2; ++ai)
#pragma unroll
            for (int m = 0; m < 4; ++m) { const int row = row0 + ai * HALF + m * 16; const size_t off = (size_t)row * ldc + col0; float sq = 0.f;
#pragma unroll
                for (int bj = 0; bj < 2; ++bj) { const f32x4 r0 = *(const f32x4*)(res + off + bj * HALF), r1 = *(const f32x4*)(res + off + bj * HALF + 4);
                    const f32x4 h0 = acc[ai][bj][m][0] + r0, h1 = acc[ai][bj][m][1] + r1;
                    *(f32x4*)(O + off + bj * HALF) = h0; *(f32x4*)(O + off + bj * HALF + 4) = h1;
                    sq += (h0[0] * h0[0] + h0[1] * h0[1]) + (h0[2] * h0[2] + h0[3] * h0[3]) + (h1[0] * h1[0] + h1[1] * h1[1]) + (h1[2] * h1[2] + h1[3] * h1[3]);
                    const f32x4 g0 = gv[bj][0], g1 = gv[bj][1];
                    u32x4 w; w.x = cvt_pk_bf16(h0[0] * g0[0], h0[1] * g0[1]); w.y = cvt_pk_bf16(h0[2] * g0[2], h0[3] * g0[3]); w.z = cvt_pk_bf16(h1[0] * g1[0], h1[1] * g1[1]); w.w = cvt_pk_bf16(h1[2] * g1[2], h1[3] * g1[3]);
                    *(u32x4*)(HG + off + bj * HALF) = w; }
                sq += __shfl_xor(sq, 16); sq += __shfl_xor(sq, 32);
                if (fq == 0) atomicAdd(ssq + row, sq); }
    }
};
struct EpiBf16Rs {
    static constexpr bool PERM = true, AFTER_DRAIN = false;
    bf16_t* O; int ldc; const float* ssq;
    __device__ __forceinline__ void operator()(const f32x4 (&acc)[2][2][4][2], const Unit& u, int wr, int wc, int fr, int fq) const {
        const int row0 = u.pm * BM + wr * 64 + fr; const int col0 = u.pn * BM + wc * 32 + 8 * fq;
#pragma unroll
        for (int ai = 0; ai < 2; ++ai)
#pragma unroll
            for (int m = 0; m < 4; ++m) { const int row = row0 + ai * HALF + m * 16; bf16_t* rowp = O + (size_t)row * ldc + col0;
                const float rs = __builtin_amdgcn_rsqf(ssq[row] * (1.f / 1024.f) + 1e-6f);
#pragma unroll
                for (int bj = 0; bj < 2; ++bj) { const f32x4 v0 = acc[ai][bj][m][0] * rs, v1 = acc[ai][bj][m][1] * rs;
                    u32x4 w; w.x = cvt_pk_bf16(v0[0], v0[1]); w.y = cvt_pk_bf16(v0[2], v0[3]); w.z = cvt_pk_bf16(v1[0], v1[1]); w.w = cvt_pk_bf16(v1[2], v1[3]);
                    *(u32x4*)(rowp + bj * HALF) = w; } }
    }
};

template <class Epi, class Sched, bool ALIGN_EPI = false, bool SP2 = false>
__device__ __forceinline__ void gemm_phase(PG8_LAS unsigned char* lds, const Gemm g, const Sched& S, const Epi& E) {
    const int tid = threadIdx.x, wid = __builtin_amdgcn_readfirstlane(tid >> 6), lane = tid & 63, wr = wid >> 2, wc = wid & 3, fr = lane & 15, fq = lane >> 4;
    const int K = g.K, nt = K / BK;
    unsigned voffA[2], voffB[2];
#pragma unroll
    for (int i = 0; i < 2; ++i) { int R, C; stage_rc(tid * 16 + i * 8192, R, C); const int Rb = Epi::PERM ? ((R & ~31) + perm32(R & 31)) : R;
        voffA[i] = (unsigned)(R * K + C) * 2u; voffB[i] = (unsigned)(Rb * K + C) * 2u; }
    const size_t kstep = (size_t)(BK * 2);
    const size_t hstep = (size_t)HALF * K * 2;
    const size_t tstep = 2 * hstep;
    const unsigned ldsw = (unsigned)wid * 1024u;
    const int aoff = lds_byte(wr * 64 + fr, fq * 8), boff = lds_byte(wc * 32 + fr, fq * 8);
#define PG8_SA(b, h) (((b) * 2 + (h)) * HTB)
#define PG8_SB(b, h) ((4 + (b) * 2 + (h)) * HTB)
#define PG8_STAGE(bufoff, gbase, voff) do { _Pragma("unroll") for (int _i = 0; _i < 2; ++_i) \
        __builtin_amdgcn_global_load_lds((const unsigned*)((const char*)(gbase) + (voff)[_i]), (PG8_LAS unsigned*)(lds + (bufoff) + ldsw + _i * 8192), 16, 0, 0); } while (0)
#define PG8_LDA(dst, b, h) do { _Pragma("unroll") for (int m = 0; m < 4; ++m) _Pragma("unroll") for (int k = 0; k < 2; ++k) dst[m][k] = *(const PG8_LAS bf16x8*)(lds + PG8_SA(b, h) + aoff + m * 2048 + k * 1024); } while (0)
#define PG8_LDB(dst, b, h) do { _Pragma("unroll") for (int n = 0; n < 2; ++n) _Pragma("unroll") for (int k = 0; k < 2; ++k) dst[n][k] = *(const PG8_LAS bf16x8*)(lds + PG8_SB(b, h) + boff + n * 2048 + k * 1024); } while (0)
#define PG8_MMA(ai, bj, At, Bt) do { __builtin_amdgcn_s_setprio(1); _Pragma("unroll") for (int m = 0; m < 4; ++m) _Pragma("unroll") for (int n = 0; n < 2; ++n) _Pragma("unroll") for (int k = 0; k < 2; ++k) \
        acc[ai][bj][m][n] = __builtin_amdgcn_mfma_f32_16x16x32_bf16(Bt[n][k], At[m][k], acc[ai][bj][m][n], 0, 0, 0); __builtin_amdgcn_s_setprio(0); } while (0)
#define PG8_WAIT_V(n) asm volatile("s_waitcnt vmcnt(" #n ")" ::: "memory")
#define PG8_WAIT_L(n) asm volatile("s_waitcnt lgkmcnt(" #n ")" ::: "memory")
#define PG8_BAR __builtin_amdgcn_s_barrier()
#define PG8_SCHED __builtin_amdgcn_sched_barrier(0)
    Unit cur, nxt; int ui = 0;
    if (!S.next(0, cur)) return;
    f32x4 acc[2][2][4][2];
#pragma unroll
    for (int a = 0; a < 2; ++a)
#pragma unroll
        for (int b = 0; b < 2; ++b)
#pragma unroll
            for (int m = 0; m < 4; ++m)
#pragma unroll
                for (int n = 0; n < 2; ++n) acc[a][b][m][n] = (f32x4){0.f, 0.f, 0.f, 0.f};
    bf16x8 At[4][2], B0[2][2], B1[2][2];
    const char* cA = (const char*)g.A + (size_t)cur.pm * tstep; const char* cB = (const char*)g.Bt + (size_t)cur.pn * tstep;
    S.a_ready(cur);
    if constexpr (SP2) {
        PG8_STAGE(PG8_SB(0, 0), cB, voffB); PG8_STAGE(PG8_SB(0, 1), cB + hstep, voffB); PG8_STAGE(PG8_SA(0, 0), cA, voffA); PG8_STAGE(PG8_SA(0, 1), cA + hstep, voffA);
        if (wr == 1) PG8_BAR;
        PG8_WAIT_V(2); PG8_BAR;
        PG8_STAGE(PG8_SB(1, 0), cB + kstep, voffB); PG8_STAGE(PG8_SA(1, 0), cA + kstep, voffA); PG8_STAGE(PG8_SB(1, 1), cB + hstep + kstep, voffB);
        PG8_WAIT_V(6); PG8_BAR;
    } else {
        PG8_STAGE(PG8_SB(0, 0), cB, voffB); PG8_STAGE(PG8_SA(0, 0), cA, voffA); PG8_STAGE(PG8_SB(0, 1), cB + hstep, voffB); PG8_STAGE(PG8_SA(0, 1), cA + hstep, voffA);
        if (wr == 1) PG8_BAR;
        PG8_WAIT_V(4); PG8_BAR;
        PG8_STAGE(PG8_SB(1, 0), cB + kstep, voffB); PG8_STAGE(PG8_SA(1, 0), cA + kstep, voffA); PG8_STAGE(PG8_SB(1, 1), cB + hstep + kstep, voffB);
        PG8_WAIT_V(6); PG8_BAR;
    }
    for (;;) {
        const bool has_next = S.next(ui + 1, nxt);
        const char* nA = has_next ? (const char*)g.A + (size_t)nxt.pm * tstep : cA; const char* nB = has_next ? (const char*)g.Bt + (size_t)nxt.pn * tstep : cB;
        for (int t = 0; t < nt; t += 2) {
            const bool last = (t == nt - 2);
            const char* a1 = cA + (size_t)(t + 1) * kstep;
            const char* a2 = last ? nA : cA + (size_t)(t + 2) * kstep; const char* b2 = last ? nB : cB + (size_t)(t + 2) * kstep;
            const char* a3 = a2 + kstep; const char* b3 = b2 + kstep;
            if (last && has_next) S.a_ready(nxt);
            if constexpr (SP2) {
            PG8_LDB(B0, 0, 0); PG8_LDB(B1, 0, 1); PG8_SCHED; PG8_LDA(At, 0, 0); PG8_STAGE(PG8_SA(1, 1), a1 + hstep, voffA);
            PG8_WAIT_V(8); PG8_WAIT_L(0); PG8_BAR; PG8_MMA(0, 0, At, B0); PG8_MMA(0, 1, At, B1); PG8_BAR; PG8_SCHED;
            PG8_LDA(At, 0, 1); PG8_STAGE(PG8_SB(0, 0), b2, voffB); PG8_STAGE(PG8_SB(0, 1), b2 + hstep, voffB); PG8_STAGE(PG8_SA(0, 0), a2, voffA);
            PG8_WAIT_V(8); PG8_WAIT_L(0); PG8_BAR; PG8_MMA(1, 0, At, B0); PG8_MMA(1, 1, At, B1); PG8_BAR; PG8_SCHED;
            PG8_LDB(B0, 1, 0); PG8_LDB(B1, 1, 1); PG8_SCHED; PG8_LDA(At, 1, 0); PG8_STAGE(PG8_SA(0, 1), a2 + hstep, voffA);
            PG8_WAIT_V(8); PG8_WAIT_L(0); PG8_BAR; PG8_MMA(0, 0, At, B0); PG8_MMA(0, 1, At, B1); PG8_BAR; PG8_SCHED;
            PG8_LDA(At, 1, 1); PG8_STAGE(PG8_SB(1, 0), b3, voffB); PG8_STAGE(PG8_SB(1, 1), b3 + hstep, voffB); PG8_STAGE(PG8_SA(1, 0), a3, voffA);
            PG8_WAIT_V(8); PG8_WAIT_L(0); PG8_BAR; PG8_MMA(1, 0, At, B0); PG8_MMA(1, 1, At, B1); PG8_BAR; PG8_SCHED;
            } else {
            PG8_LDB(B0, 0, 0); PG8_SCHED; PG8_LDA(At, 0, 0); PG8_STAGE(PG8_SA(1, 1), a1 + hstep, voffA);
            PG8_WAIT_L(8); PG8_BAR; PG8_WAIT_L(0); PG8_MMA(0, 0, At, B0); PG8_BAR; PG8_SCHED;
            PG8_LDB(B1, 0, 1); PG8_STAGE(PG8_SB(0, 0), b2, voffB);
            PG8_BAR; PG8_WAIT_L(0); PG8_MMA(0, 1, At, B1); PG8_BAR;
            PG8_LDA(At, 0, 1); PG8_STAGE(PG8_SA(0, 0), a2, voffA);
            PG8_BAR; PG8_WAIT_L(0); PG8_MMA(1, 0, At, B0); PG8_BAR; PG8_SCHED;
            PG8_STAGE(PG8_SB(0, 1), b2 + hstep, voffB);
            PG8_WAIT_V(6); PG8_BAR; PG8_MMA(1, 1, At, B1); PG8_BAR;
            PG8_LDB(B0, 1, 0); PG8_SCHED; PG8_LDA(At, 1, 0); PG8_STAGE(PG8_SA(0, 1), a2 + hstep, voffA);
            PG8_WAIT_L(8); PG8_BAR; PG8_WAIT_L(0); PG8_MMA(0, 0, At, B0); PG8_BAR; PG8_SCHED;
            PG8_LDB(B1, 1, 1); PG8_STAGE(PG8_SB(1, 0), b3, voffB);
            PG8_BAR; PG8_WAIT_L(0); PG8_MMA(0, 1, At, B1); PG8_BAR;
            PG8_LDA(At, 1, 1); PG8_STAGE(PG8_SA(1, 0), a3, voffA);
            PG8_BAR; PG8_WAIT_L(0); PG8_MMA(1, 0, At, B0); PG8_BAR; PG8_SCHED;
            PG8_STAGE(PG8_SB(1, 1), b3 + hstep, voffB);
            PG8_WAIT_V(6); PG8_BAR; PG8_MMA(1, 1, At, B1); PG8_BAR;
            }
        }
        if constexpr (ALIGN_EPI) { if (wr == 0) PG8_BAR; }
        if constexpr (!Epi::AFTER_DRAIN) { E(acc, cur, wr, wc, fr, fq); S.done(cur); }
        if (!has_next) break;
#pragma unroll
        for (int a = 0; a < 2; ++a)
#pragma unroll
            for (int b = 0; b < 2; ++b)
#pragma unroll
                for (int m = 0; m < 4; ++m)
#pragma unroll
                    for (int n = 0; n < 2; ++n) acc[a][b][m][n] = (f32x4){0.f, 0.f, 0.f, 0.f};
        cur = nxt; cA = nA; cB = nB; ++ui;
        if constexpr (ALIGN_EPI) { if (wr == 1) PG8_BAR; }
    }
    PG8_WAIT_V(0);
    if constexpr (!ALIGN_EPI) { if (wr == 0) PG8_BAR; }
    PG8_BAR;
#undef PG8_SA
#undef PG8_SB
#undef PG8_STAGE
#undef PG8_LDA
#undef PG8_LDB
#undef PG8_MMA
#undef PG8_WAIT_V
#undef PG8_WAIT_L
#undef PG8_BAR
#undef PG8_SCHED
}
}

#define XB_TMO      128
#define XB_XCNT(j)  (256  + 64 * (j))
#define XB_XSUB(j)  (1280 + 64 * (j))
#define XB_XGEN(j)  (2304 + 64 * (j))
#define XB_TOP      3328
#define XB_TOPGEN   3392
#define XCD_BAR_WORDS 3456
#define XB_SPIN_CAP (1u << 22)
__device__ __forceinline__ unsigned xb_ld(unsigned* p)              { return __hip_atomic_load(p, __ATOMIC_RELAXED, __HIP_MEMORY_SCOPE_AGENT); }
__device__ __forceinline__ unsigned xb_add(unsigned* p, unsigned v) { return __hip_atomic_fetch_add(p, v, __ATOMIC_RELAXED, __HIP_MEMORY_SCOPE_AGENT); }
__device__ __forceinline__ unsigned xb_xcc_id() { return (unsigned)__builtin_amdgcn_s_getreg((3 << 11) | 20) & 0xFu; }
#define XB_SPIN(cond, bar) do { unsigned _sp = 0; while (cond) { __builtin_amdgcn_s_sleep(1); \
    if ((++_sp & 255u) == 0u) { if (xb_ld(&(bar)[XB_TMO])) break; if (_sp > XB_SPIN_CAP) { atomicAdd(&(bar)[XB_TMO], 1u); break; } } } } while (0)
struct XcdBarrier { unsigned* bar; unsigned x; volatile LAS unsigned* st; };
__device__ __forceinline__ XcdBarrier xcd_barrier_post(unsigned* bar, volatile LAS unsigned* st) {
    XcdBarrier b; b.bar = bar; b.x = xb_xcc_id(); b.st = st;
    if (threadIdx.x == 0) (void)xb_add(&bar[XB_XCNT(b.x)], 1u);
    return b;
}
__device__ __forceinline__ void xcd_barrier_complete(unsigned* bar, unsigned x, unsigned& nloc, unsigned& nx) {
    const unsigned G = gridDim.x * gridDim.y * gridDim.z;
    unsigned sum, cnt, mine, sp = 0u;
    for (;;) {
        sum = 0u; cnt = 0u; mine = 0u;
#pragma unroll
        for (unsigned j = 0; j < 16; ++j) { const unsigned c = xb_ld(&bar[XB_XCNT(j)]); sum += c; cnt += (c > 0u) ? 1u : 0u; mine = (j == x) ? c : mine; }
        if (sum == G) break;
        __builtin_amdgcn_s_sleep(1);
        if ((++sp & 255u) == 0u) { if (xb_ld(&bar[XB_TMO])) break; if (sp > XB_SPIN_CAP) { atomicAdd(&bar[XB_TMO], 1u); break; } }
    }
    nloc = mine > 0u ? mine : 1u; nx = cnt > 0u ? cnt : 1u;
}
__device__ __forceinline__ void xcd_barrier(const XcdBarrier& b) {
    asm volatile("s_waitcnt vmcnt(0)" ::: "memory");
    __syncthreads();
    if (threadIdx.x == 0) {
        unsigned* bar = b.bar;
        __builtin_amdgcn_s_waitcnt(0);
        unsigned nloc = b.st[0], nx = b.st[1];
        if (nloc == 0u) { xcd_barrier_complete(bar, b.x, nloc, nx); b.st[0] = nloc; b.st[1] = nx; }
        const unsigned old = xb_add(&bar[XB_XSUB(b.x)], 1u);
        const unsigned gen = old / nloc;
        if (old + 1u == (gen + 1u) * nloc) {
            __builtin_amdgcn_fence(__ATOMIC_RELEASE, "agent");
            asm volatile("s_waitcnt vmcnt(0)" ::: "memory");
            const unsigned og = xb_add(&bar[XB_TOP], 1u);
            const unsigned tg = og / nx;
            if (og + 1u == (tg + 1u) * nx) xb_add(&bar[XB_TOPGEN], 1u);
            else XB_SPIN(xb_ld(&bar[XB_TOPGEN]) == tg, bar);
            __builtin_amdgcn_fence(__ATOMIC_ACQUIRE, "agent");
            xb_add(&bar[XB_XGEN(b.x)], 1u);
            asm volatile("s_waitcnt vmcnt(0)" ::: "memory");
        } else {
            XB_SPIN(xb_ld(&bar[XB_XGEN(b.x)]) == gen, bar);
            __builtin_amdgcn_fence(__ATOMIC_ACQUIRE, "agent");
            asm volatile("s_waitcnt vmcnt(0)" ::: "memory");
        }
    }
    __syncthreads();
}

constexpr int RING_OFF = 0, RING_BYTES = 131072;
constexpr int LDSCTL_OFF = 162816, MISC_OFF = LDSCTL_OFF + 320;
constexpr int LDS_BYTES = 163840;

struct Frame {
    LAS unsigned char* lds;
    volatile LAS unsigned* MISC;
    gu32* ctl;
    int tid, lane, wave, G, wg;
    const float* in[21];
    float* out;
    unsigned char* ws;
};

__device__ __forceinline__ void p0_transpose_item(const float* W, int K, int N, bf16* WT, LAS float* scr, int item, int lane) {
    const int nblk = N / 32, kb = item / nblk, nb = item % nblk, k0 = 64 * kb, n0 = 32 * nb;
#pragma unroll 8
    for (int i = 0; i < 32; ++i) { const int kk = 2 * i + (lane >> 5); scr[kk * 33 + (lane & 31)] = W[(size_t)(k0 + kk) * N + n0 + (lane & 31)]; }
    LDS_WAIT(); asm volatile("" ::: "memory");
    const int c = lane & 7;
#pragma unroll
    for (int j = 0; j < 4; ++j) { const int n = (lane >> 3) + 8 * j; const LAS float* s = scr + (8 * c) * 33 + n;
        v4u o; o.x = pk2(s[0 * 33], s[1 * 33]); o.y = pk2(s[2 * 33], s[3 * 33]); o.z = pk2(s[4 * 33], s[5 * 33]); o.w = pk2(s[6 * 33], s[7 * 33]);
        *(GAS v4u*)(WT + (size_t)(n0 + n) * K + k0 + 8 * c) = o; }
    LDS_WAIT(); asm volatile("" ::: "memory");
}
__device__ __forceinline__ void rms_row_to_bf16(int lane, const float* xrow, const float* gain, bf16* orow) {
    const GAS f32x4* xr = (const GAS f32x4*)xrow + lane;
    const GAS f32x4* gr = (const GAS f32x4*)gain + lane;
    f32x4 v[4]; float s = 0.f;
#pragma unroll
    for (int j = 0; j < 4; ++j) { v[j] = xr[64 * j]; s += (v[j].x * v[j].x + v[j].y * v[j].y) + (v[j].z * v[j].z + v[j].w * v[j].w); }
    const float rstd = frsq(wave_sum(s) * (1.f / DM) + RMS_EPS);
    GAS unsigned long long* o8 = (GAS unsigned long long*)orow + lane;
#pragma unroll
    for (int j = 0; j < 4; ++j) { const f32x4 gg = gr[64 * j];
        o8[64 * j] = (unsigned long long)pk2(v[j].x * rstd * gg.x, v[j].y * rstd * gg.y) | ((unsigned long long)pk2(v[j].z * rstd * gg.z, v[j].w * rstd * gg.w) << 32); }
}
__device__ __forceinline__ void quantize_tables(Frame& F, int gw, int ngw);
__device__ __forceinline__ void p0_prologue(Frame& F) {
    LAS float* scr = (LAS float*)(F.lds + RING_OFF + F.wave * 16384);
    const int gw = F.wg * NWAVES + F.wave, NGW = F.G * NWAVES;
    constexpr int I_IN = (DM / 64) * (IN_COLS / 32), I_OUT = (DM / 64) * (DM / 32), I_Q = (DM / 64) * (PQ / 32);
    constexpr int NITEMS = I_IN + I_OUT + I_Q;
    bf16* win_t = (bf16*)(F.ws + WS_WIN); bf16* wout_t = (bf16*)(F.ws + WS_WOUT); bf16* wq_t = (bf16*)(F.ws + WS_WQ);
    for (int it = gw; it < NITEMS; it += NGW) {
        int r = it;
        if (r < I_IN) { p0_transpose_item(F.in[2], DM, IN_COLS, win_t, scr, r, F.lane); continue; } r -= I_IN;
        if (r < I_OUT) { p0_transpose_item(F.in[14], DM, DM, wout_t, scr, r, F.lane); continue; } r -= I_OUT;
        p0_transpose_item(F.in[16], DM, PQ, wq_t, scr, r, F.lane);
    }
    {
        constexpr int I_W = (64 / 64) * (RWW / 32), I_G = (128 / 64) * (RWW / 32);
        for (int it = gw; it < 2 * I_W + I_G; it += NGW) {
            int r = it;
            if (r < I_W) { p0_transpose_item(F.in[5], 64, RWW, (bf16*)(F.ws + WS_WUPT), scr, r, F.lane); continue; } r -= I_W;
            if (r < I_W) { p0_transpose_item(F.in[7], 64, RWW, (bf16*)(F.ws + WS_AUPT), scr, r, F.lane); continue; } r -= I_W;
            p0_transpose_item(F.in[8], 128, RWW, (bf16*)(F.ws + WS_GUPT), scr, r, F.lane);
        }
    }
    bf16* XN = (bf16*)(F.ws + WS_XN);
    for (int m = gw; m < T; m += NGW) rms_row_to_bf16(F.lane, F.in[0] + (size_t)m * DM, F.in[1], XN + (size_t)m * DM);
}

constexpr size_t WS_ROPE = WS_G;
__device__ __forceinline__ void p0_rope_table(Frame& F) {
    f32x2* tab = (f32x2*)(F.ws + WS_ROPE);
    for (int e = F.wg * NTHREADS + F.tid; e < SEQ * 32; e += F.G * NTHREADS) {
        const int sp = e >> 5, i = e & 31;
        const float inv_freq = powf(10000.0f, -(float)(2 * i) / 64.0f);
        const float ang = (float)sp * inv_freq;
        const double r = (double)ang - rint((double)ang * 0.15915494309189535) * 6.283185307179586;
        const float rf = (float)r;
        tab[e] = (f32x2){cosf(rf), sinf(rf)};
    }
}
__device__ __forceinline__ void p2_rope(Frame& F) {
    bf16* Z = (bf16*)(F.ws + WS_Z);
    const f32x2* tab = (const f32x2*)(F.ws + WS_ROPE);
    const int tid = F.tid, tk = tid >> 6, grp = (tid >> 2) & 15, i0 = (tid & 3) * 8;
    for (int blk = F.wg; blk < T / 8; blk += F.G) {
        const int g = blk * 8 + tk, sp = g & (SEQ - 1);
        bf16* p = Z + (size_t)g * IN_COLS + C_AQ + grp * 64 + i0;
        const v4u a = *(const GAS v4u*)p, b = *(const GAS v4u*)(p + 32);
        const GAS f32x4* tp = (const GAS f32x4*)(tab + sp * 32 + i0);
        float x1[8], x2[8];
        x1[0] = bflo(a.x); x1[1] = bfhi(a.x); x1[2] = bflo(a.y); x1[3] = bfhi(a.y); x1[4] = bflo(a.z); x1[5] = bfhi(a.z); x1[6] = bflo(a.w); x1[7] = bfhi(a.w);
        x2[0] = bflo(b.x); x2[1] = bfhi(b.x); x2[2] = bflo(b.y); x2[3] = bfhi(b.y); x2[4] = bflo(b.z); x2[5] = bfhi(b.z); x2[6] = bflo(b.w); x2[7] = bfhi(b.w);
        float o1[8], o2[8];
#pragma unroll
        for (int q = 0; q < 4; ++q) { const f32x4 cs = tp[q];
            o1[2 * q] = x1[2 * q] * cs[0] - x2[2 * q] * cs[1]; o2[2 * q] = x1[2 * q] * cs[1] + x2[2 * q] * cs[0];
            o1[2 * q + 1] = x1[2 * q + 1] * cs[2] - x2[2 * q + 1] * cs[3]; o2[2 * q + 1] = x1[2 * q + 1] * cs[3] + x2[2 * q + 1] * cs[2]; }
        v4u oa, ob; oa.x = pk2(o1[0], o1[1]); oa.y = pk2(o1[2], o1[3]); oa.z = pk2(o1[4], o1[5]); oa.w = pk2(o1[6], o1[7]);
        ob.x = pk2(o2[0], o2[1]); ob.y = pk2(o2[2], o2[3]); ob.z = pk2(o2[4], o2[5]); ob.w = pk2(o2[6], o2[7]);
        *(GAS v4u*)p = oa; *(GAS v4u*)(p + 32) = ob;
    }
}

typedef float f32x16 __attribute__((ext_vector_type(16)));
constexpr int SBS = 144;
constexpr int R1_EPRE = 0, R1_APRE = 16384, R1_AAB = 0, R1_X = 16384;
constexpr int R1_AT = 32768, R1_BT = 41984, R1_KT = 51200, R1_RT = 60416, R1_AHT = R1_BT, R1_U0T = R1_KT;
constexpr int R1_BBT = 69632, R1_KBT = 78848, R1_VT = 88064;
constexpr int R1_ACTW = 97280, R1_ACTA = 106496, R1_AAK = 97280, R1_ARB = 106496, R1_ARK = 115712;
constexpr int R1_BONUS = 124928, R1_WEND = 125184, R1_SEGS = 125440, R1_TII = 125440, R1_END = 129536;
constexpr int R1_PAR = R1_END;
static_assert(R1_PAR + 640 * 4 <= LDSCTL_OFF, "R1 LDS");
__device__ __forceinline__ int crow(int r, int hh) { return (r & 3) + 8 * (r >> 2) + 4 * hh; }
template <int KS> __device__ __forceinline__ f32x16 wtile(const LAS unsigned char* A, int sa, const LAS unsigned char* B, int sb, f32x16 acc, int lane) {
    const int row = lane & 31, hh = lane >> 5;
#pragma unroll
    for (int s = 0; s < KS; ++s) { const bf16x8 a = *(const LAS bf16x8*)(A + row * sa + 32 * s + 16 * hh); const bf16x8 b = *(const LAS bf16x8*)(B + row * sb + 32 * s + 16 * hh);
        acc = __builtin_amdgcn_mfma_f32_32x32x16_bf16(a, b, acc, 0, 0, 0); }
    return acc;
}
__device__ __forceinline__ f32x16 zero16() { f32x16 z;
#pragma unroll
    for (int r = 0; r < 16; ++r) z[r] = 0.f;
    return z; }

struct R1Pre { v4u wd[2], ad[2], z[4]; };
__device__ __forceinline__ int r13_item(int wg, int G, int idx) { return (wg >> 3) * 128 + (wg & 7) * 16 + idx; }
__device__ __forceinline__ int r13_count(int wg, int G) { return 16; }
__device__ __forceinline__ void rwkv_r1_prefetch(Frame& F, int item, int tid, R1Pre& P) {
    const int chain = item >> 7, chunk = item & 127, b = chain >> 3, h = chain & 7, g0 = b * SEQ + chunk * 64;
    const bf16* Z = (const bf16*)(F.ws + WS_Z);
    const v4u z0 = (v4u){0u, 0u, 0u, 0u};
    { const int t = tid >> 3, cg = tid & 7; const bool first = (chunk == 0 && t == 0);
      const bf16* zr = Z + (size_t)(g0 + t) * IN_COLS;
      P.wd[0] = *(const GAS v4u*)(zr + C_WD + cg * 8); P.ad[0] = *(const GAS v4u*)(zr + C_AD + cg * 8);
      P.wd[1] = z0; P.ad[1] = z0;
      if (!first) { P.wd[1] = *(const GAS v4u*)(zr - IN_COLS + C_WD + cg * 8); P.ad[1] = *(const GAS v4u*)(zr - IN_COLS + C_AD + cg * 8); } }
#pragma unroll
    for (int q = 0; q < 4; ++q) { const int p = tid + 512 * q; P.z[q] = z0;
        if (p < 65 * 24) { const int row = p / 24, rem = p - row * 24, seg = rem >> 3, ch = rem & 7;
            if (!(chunk == 0 && row == 0)) P.z[q] = *(const GAS v4u*)(Z + (size_t)(g0 - 1 + row) * IN_COLS + seg * 512 + h * 64 + ch * 8); } }
}
constexpr int R1_ZS = R1_AT, R1_ZSS = 384;
static_assert(65 * R1_ZSS <= 4 * 9216, "ZS fits in the At..Rt region");
__device__ __forceinline__ void r1_load_bfrag(Frame& F, int h, int w, int lane, bf16x8 (&bf)[4]) {
    const int p = w >> 2, nt = w & 1; const bf16* upt = (const bf16*)(F.ws + (p == 0 ? WS_WUPT : WS_AUPT)) + (size_t)(h * 64 + nt * 32 + (lane & 31)) * 64 + 8 * (lane >> 5);
#pragma unroll
    for (int s2 = 0; s2 < 4; ++s2) bf[s2] = *(const GAS bf16x8*)(upt + 16 * s2);
}
__device__ __forceinline__ void r1_load_params(Frame& F, int h) {
    LAS float* PAR = (LAS float*)(F.lds + RING_OFF + R1_PAR); const float* mu = F.in[3];
    const int k = F.wave, c = F.lane, col = h * 64 + c;
    const float* src = k == 0 ? mu + C_R : (k == 1 ? mu + C_K : (k == 2 ? mu + C_V : (k == 3 ? F.in[9] : (k == 4 ? F.in[10] : (k == 5 ? F.in[11] : (k == 6 ? F.in[4] : F.in[6]))))));
    PAR[128 + k * 64 + c] = src[col];
    if (k < 2) PAR[k * 64 + c] = mu[(k == 0 ? C_WD : C_AD) + c];
}
constexpr int R1_CF = R1_AAB, R1_CN = R1_X;
__device__ __forceinline__ void rwkv_r1_item(Frame& F, int item, int next_item, R1Pre& P, const bf16x8 (&bfr)[4], f32x4 (&cst)[4]) {
    const int chain = item >> 7, chunk = item & 127, b = chain >> 3, h = chain & 7;
    const int g0 = b * SEQ + chunk * 64;
    int tid_ = F.tid; asm volatile("" : "+v"(tid_));
    const int tid = tid_, lane = tid & 63, w = __builtin_amdgcn_readfirstlane(tid >> 6), hh = lane >> 5, cl = lane & 31;
    const bf16* Z = (const bf16*)(F.ws + WS_Z);
    LAS unsigned char* lds = F.lds + RING_OFF;
    const float* mu = F.in[3];
    {
        const int t = tid >> 3, cg = tid & 7;
        const v4u cw = P.wd[0], ca = P.ad[0], pw = P.wd[1], pa = P.ad[1];
        float fw[8], fa[8], qw[8], qa[8];
        fw[0] = bflo(cw.x); fw[1] = bfhi(cw.x); fw[2] = bflo(cw.y); fw[3] = bfhi(cw.y); fw[4] = bflo(cw.z); fw[5] = bfhi(cw.z); fw[6] = bflo(cw.w); fw[7] = bfhi(cw.w);
        fa[0] = bflo(ca.x); fa[1] = bfhi(ca.x); fa[2] = bflo(ca.y); fa[3] = bfhi(ca.y); fa[4] = bflo(ca.z); fa[5] = bfhi(ca.z); fa[6] = bflo(ca.w); fa[7] = bfhi(ca.w);
        qw[0] = bflo(pw.x); qw[1] = bfhi(pw.x); qw[2] = bflo(pw.y); qw[3] = bfhi(pw.y); qw[4] = bflo(pw.z); qw[5] = bfhi(pw.z); qw[6] = bflo(pw.w); qw[7] = bfhi(pw.w);
        qa[0] = bflo(pa.x); qa[1] = bfhi(pa.x); qa[2] = bflo(pa.y); qa[3] = bfhi(pa.y); qa[4] = bflo(pa.z); qa[5] = bfhi(pa.z); qa[6] = bflo(pa.w); qa[7] = bfhi(pa.w);
        const LAS float* PAR = (const LAS float*)(lds + R1_PAR);
        const f32x4 mw0 = *(const LAS f32x4*)(PAR + cg * 8), mw1 = *(const LAS f32x4*)(PAR + cg * 8 + 4), ma0 = *(const LAS f32x4*)(PAR + 64 + cg * 8), ma1 = *(const LAS f32x4*)(PAR + 64 + cg * 8 + 4);
#pragma unroll
        for (int j = 0; j < 8; ++j) { const float xw = fw[j] + (qw[j] - fw[j]) * (j < 4 ? mw0[j & 3] : mw1[j & 3]);
            const float ex = __expf(2.f * xw); fw[j] = 1.f - 2.f * frcp(ex + 1.f);
            fa[j] = fa[j] + (qa[j] - fa[j]) * (j < 4 ? ma0[j & 3] : ma1[j & 3]); }
        v4u ow, oa; ow.x = pk2(fw[0], fw[1]); ow.y = pk2(fw[2], fw[3]); ow.z = pk2(fw[4], fw[5]); ow.w = pk2(fw[6], fw[7]);
        oa.x = pk2(fa[0], fa[1]); oa.y = pk2(fa[2], fa[3]); oa.z = pk2(fa[4], fa[5]); oa.w = pk2(fa[6], fa[7]);
        *(LAS v4u*)(lds + R1_ACTW + t * SBS + cg * 16) = ow; *(LAS v4u*)(lds + R1_ACTA + t * SBS + cg * 16) = oa;
#pragma unroll
        for (int q = 0; q < 4; ++q) { const int p = tid + 512 * q;
            if (p < 65 * 24) { const int row = p / 24, rem = p - row * 24; *(LAS v4u*)(lds + R1_ZS + row * R1_ZSS + rem * 16) = P.z[q]; } }
        if (next_item >= 0) rwkv_r1_prefetch(F, next_item, tid, P);
    }
    LDS_BARRIER();
    {
        const int p = w >> 2, mt = (w >> 1) & 1, nt = w & 1;
        f32x16 acc = zero16();
        { const LAS unsigned char* A_ = lds + (p == 0 ? R1_ACTW : R1_ACTA) + mt * 32 * SBS + (lane & 31) * SBS + 16 * hh;
#pragma unroll
          for (int s2 = 0; s2 < 4; ++s2) acc = __builtin_amdgcn_mfma_f32_32x32x16_bf16(*(const LAS bf16x8*)(A_ + 32 * s2), bfr[s2], acc, 0, 0, 0); }
        LAS float* O = (LAS float*)(lds + (p == 0 ? R1_EPRE : R1_APRE));
#pragma unroll
        for (int r = 0; r < 16; ++r) O[(mt * 32 + crow(r, hh)) * 64 + nt * 32 + cl] = acc[r];
    }
    LDS_BARRIER();
    {
        const int c = tid & 63, ts = tid >> 6, col = h * 64 + c;
        const LAS float* PAR = (const LAS float*)(lds + R1_PAR) + 128 + c;
        const float mu_r = PAR[0], mu_k = PAR[64], mu_v = PAR[128], kkc = PAR[192], kac = PAR[256], rkc = PAR[320], w0c = PAR[384], a0c = PAR[448];
        const LAS float* EP = (const LAS float*)(lds + R1_EPRE); const LAS float* AP = (const LAS float*)(lds + R1_APRE);
        LAS float* SEGS = (LAS float*)(lds + R1_SEGS); LAS float* BON = (LAS float*)(lds + R1_BONUS);
        const LAS bf16* zb = (const LAS bf16*)(lds + R1_ZS + (8 * ts) * R1_ZSS) + c;
        float pr = bf2f(zb[0]), pk = bf2f(zb[64]), pv = bf2f(zb[128]);
        float rr[8], k2[8], ai[8], bi[8], vv[8], ee[8], cs[8]; float run = 0.f;
#pragma unroll
        for (int i = 0; i < 8; ++i) {
            const float zr = bf2f(zb[(i + 1) * (R1_ZSS / 2)]), zk = bf2f(zb[(i + 1) * (R1_ZSS / 2) + 64]), zv = bf2f(zb[(i + 1) * (R1_ZSS / 2) + 128]);
            const float r = zr + (pr - zr) * mu_r, k = zk + (pk - zk) * mu_k, v = zv + (pv - zv) * mu_v; pr = zr; pk = zk; pv = zv;
            const float e = 0.60653066f * frcp(1.f + __expf(-(w0c + EP[(8 * ts + i) * 64 + c])));
            const float a = frcp(1.f + __expf(-(a0c + AP[(8 * ts + i) * 64 + c])));
            float kk = k * kkc; const float n2 = wave_sum(kk * kk); kk = kk * frsq(fmaxf(n2, 1e-24f));
            const float kq = k * (1.f + (a - 1.f) * kac);
            const float bon = wave_sum(r * kq * rkc); if (c == 0) BON[8 * ts + i] = bon;
            rr[i] = r; k2[i] = kq; ai[i] = -kk; bi[i] = kk * a; vv[i] = v; ee[i] = e; run += e; cs[i] = run;
        }
        SEGS[ts * 64 + c] = run;
        LDS_BARRIER();
        float off = 0.f, tot = 0.f;
#pragma unroll
        for (int q = 0; q < 8; ++q) { const float sv = SEGS[q * 64 + c]; tot += sv; off += (q < ts) ? sv : 0.f; }
        float bb[8], kb[8];
#pragma unroll
        for (int i = 0; i < 8; ++i) { const float L = off + cs[i];
            const float Wm = __expf(-(L - ee[i])), Wi = __expf(-L), iW = __expf(L), We = __expf(-(tot - L));
            const int t = 8 * ts + i;
            *(LAS bf16*)(lds + R1_AT + t * SBS + c * 2) = (bf16)f2bf(ai[i] * Wm);
            *(LAS bf16*)(lds + R1_BT + t * SBS + c * 2) = (bf16)f2bf(bi[i] * iW);
            *(LAS bf16*)(lds + R1_KT + t * SBS + c * 2) = (bf16)f2bf(k2[i] * iW);
            *(LAS bf16*)(lds + R1_RT + t * SBS + c * 2) = (bf16)f2bf(rr[i] * Wi);
            bb[i] = bi[i] * We; kb[i] = k2[i] * We; }
        v4u o; o.x = pk2(bb[0], bb[1]); o.y = pk2(bb[2], bb[3]); o.z = pk2(bb[4], bb[5]); o.w = pk2(bb[6], bb[7]);
        *(LAS v4u*)(lds + R1_BBT + c * SBS + ts * 16) = o;
        o.x = pk2(kb[0], kb[1]); o.y = pk2(kb[2], kb[3]); o.z = pk2(kb[4], kb[5]); o.w = pk2(kb[6], kb[7]);
        *(LAS v4u*)(lds + R1_KBT + c * SBS + ts * 16) = o;
        o.x = pk2(vv[0], vv[1]); o.y = pk2(vv[2], vv[3]); o.z = pk2(vv[4], vv[5]); o.w = pk2(vv[6], vv[7]);
        *(LAS v4u*)(lds + R1_VT + c * SBS + ts * 16) = o;
        if (ts == 0) ((LAS float*)(lds + R1_WEND))[c] = __expf(-tot);
    }
    LDS_BARRIER();
#pragma unroll
    for (int u = 0; u < 2; ++u) {
        const int idx = w * 2 + u, p = idx >> 2, mt = (idx >> 1) & 1, nt = idx & 1;
        const LAS unsigned char* Aop = lds + ((p == 0 || p == 2) ? R1_BT : R1_KT) + mt * 32 * SBS;
        const LAS unsigned char* Bop = lds + (p < 2 ? R1_AT : R1_RT) + nt * 32 * SBS;
        f32x16 acc = wtile<4>(Aop, SBS, Bop, SBS, zero16(), lane);
        const int n = nt * 32 + cl;
#pragma unroll
        for (int r = 0; r < 16; ++r) { const int m = mt * 32 + crow(r, hh); const bool keep = (p < 2) ? (m < n) : (m <= n); acc[r] = keep ? acc[r] : 0.f; }
#pragma unroll
        for (int g4 = 0; g4 < 4; ++g4) { const int m0 = mt * 32 + 8 * g4 + 4 * hh;
            if (p == 0) *(LAS f32x4*)(lds + R1_AAB + (n * 64 + m0) * 4) = (f32x4){acc[4 * g4], acc[4 * g4 + 1], acc[4 * g4 + 2], acc[4 * g4 + 3]};
            else { v2u o; o.x = pk2(acc[4 * g4], acc[4 * g4 + 1]); o.y = pk2(acc[4 * g4 + 2], acc[4 * g4 + 3]);
                   *(LAS v2u*)(lds + (p == 1 ? R1_AAK : (p == 2 ? R1_ARB : R1_ARK)) + n * SBS + m0 * 2) = o; } }
    }
    LDS_BARRIER();
    if (w < 4) {
        const int mt = w >> 1, nt = w & 1;
        const f32x16 acc = wtile<4>(lds + R1_AAK + mt * 32 * SBS, SBS, lds + R1_VT + nt * 32 * SBS, SBS, zero16(), lane);
        LAS float* X = (LAS float*)(lds + R1_X);
#pragma unroll
        for (int r = 0; r < 16; ++r) X[(mt * 32 + crow(r, hh)) * 64 + nt * 32 + cl] = acc[r];
    } else if (w == 4) {
        const int bk = lane >> 4, c = lane & 15;
        const LAS float* AAB = (const LAS float*)(lds + R1_AAB);
        float Tc[16]; const float fc = (float)c;
#pragma unroll
        for (int s2 = 0; s2 < 16; ++s2) Tc[s2] = fmaxf(0.f, 1.f - fabsf((float)s2 - fc));
#pragma unroll
        for (int r = 0; r < 15; ++r)
#pragma unroll
            for (int s2 = r + 1; s2 < 16; ++s2) Tc[s2] += AAB[(16 * bk + s2) * 64 + 16 * bk + r] * Tc[r];
        LAS float* TII = (LAS float*)(lds + R1_TII);
#pragma unroll
        for (int s2 = 0; s2 < 16; ++s2) TII[(bk * 16 + s2) * 16 + c] = Tc[s2];
    }
    LDS_BARRIER();
    {
        const int c16 = lane & 15, g = lane >> 4;
        const LAS float* AAB = (const LAS float*)(lds + R1_AAB); const LAS float* TII = (const LAS float*)(lds + R1_TII); const LAS float* X = (const LAS float*)(lds + R1_X);
        f32x4 o[4];
#pragma unroll
        for (int i = 0; i < 4; ++i) {
            f32x4 acc;
            if (w < 4) {
#pragma unroll
                for (int q = 0; q < 4; ++q) acc[q] = bf2f(*(const LAS bf16*)(lds + R1_AT + (16 * i + 4 * g + q) * SBS + (16 * w + c16) * 2));
            } else {
#pragma unroll
                for (int q = 0; q < 4; ++q) acc[q] = X[(16 * i + 4 * g + q) * 64 + 16 * (w - 4) + c16];
            }
#pragma unroll
            for (int j = 0; j < i; ++j) { const f32x4 a4 = *(const LAS f32x4*)(AAB + (16 * i + c16) * 64 + 16 * j + 4 * g);
#pragma unroll
                for (int q = 0; q < 4; ++q) acc = __builtin_amdgcn_mfma_f32_16x16x4f32(a4[q], o[j][q], acc, 0, 0, 0); }
            const f32x4 t4 = *(const LAS f32x4*)(TII + (i * 16 + c16) * 16 + 4 * g);
            f32x4 res = (f32x4){0.f, 0.f, 0.f, 0.f};
#pragma unroll
            for (int q = 0; q < 4; ++q) res = __builtin_amdgcn_mfma_f32_16x16x4f32(t4[q], acc[q], res, 0, 0, 0);
            o[i] = res;
            v2u ov; ov.x = pk2(res[0], res[1]); ov.y = pk2(res[2], res[3]);
            *(LAS v2u*)(lds + (w < 4 ? R1_AHT : R1_U0T) + (16 * (w & 3) + c16) * SBS + (16 * i + 4 * g) * 2) = ov;
        }
    }
    LDS_BARRIER();
    {
        float* Mg = F.out + (size_t)item * 4096; float* NTg = F.out + (size_t)T * RWW + (size_t)item * 4096;
        float* Y0g = (float*)(F.ws + WS_RWY0) + (size_t)item * 4096; bf16* RHg = (bf16*)(F.ws + WS_RWRH) + (size_t)item * 4096;
#pragma unroll
        for (int u = 0; u < 2; ++u) {
            const int idx = w * 2 + u, p = idx >> 2, mt = (idx >> 1) & 1, nt = idx & 1; const int n = nt * 32 + cl;
            if (p == 0) {
                f32x16 acc = wtile<4>(lds + R1_AHT + mt * 32 * SBS, SBS, lds + R1_BBT + nt * 32 * SBS, SBS, zero16(), lane);
                const float we = ((const LAS float*)(lds + R1_WEND))[n];
#pragma unroll
                for (int g4 = 0; g4 < 4; ++g4) { const int m0 = mt * 32 + 8 * g4 + 4 * hh;
                    const f32x4 mv = (f32x4){acc[4 * g4] + (m0 == n ? we : 0.f), acc[4 * g4 + 1] + (m0 + 1 == n ? we : 0.f), acc[4 * g4 + 2] + (m0 + 2 == n ? we : 0.f), acc[4 * g4 + 3] + (m0 + 3 == n ? we : 0.f)};
                    *(GAS f32x4*)(Mg + n * 64 + m0) = mv;
                    v2u h_; h_.x = pk2(mv[0], mv[1]); h_.y = pk2(mv[2], mv[3]);
                    v2u l_; l_.x = pk2(mv[0] - bflo(h_.x), mv[1] - bfhi(h_.x)); l_.y = pk2(mv[2] - bflo(h_.y), mv[3] - bfhi(h_.y));
                    LAS unsigned char* fp_ = lds + R1_CF + (((n >> 4) * 2 + (m0 >> 5)) * 2) * 1024 + ((((m0 >> 2) & 3) * 16) + (n & 15)) * 16 + ((m0 >> 4) & 1) * 8;
                    *(LAS v2u*)fp_ = h_; *(LAS v2u*)(fp_ + 1024) = l_; }
            } else if (p == 1) {
                f32x16 acc = wtile<4>(lds + R1_BBT + mt * 32 * SBS, SBS, lds + R1_U0T + nt * 32 * SBS, SBS, zero16(), lane);
                acc = wtile<4>(lds + R1_KBT + mt * 32 * SBS, SBS, lds + R1_VT + nt * 32 * SBS, SBS, acc, lane);
#pragma unroll
                for (int g4 = 0; g4 < 4; ++g4) { const f32x4 nv_ = (f32x4){acc[4 * g4], acc[4 * g4 + 1], acc[4 * g4 + 2], acc[4 * g4 + 3]};
                    *(GAS f32x4*)(NTg + n * 64 + mt * 32 + 8 * g4 + 4 * hh) = nv_; *(LAS f32x4*)(lds + R1_CN + (n * 64 + mt * 32 + 8 * g4 + 4 * hh) * 4) = nv_; }
            } else if (p == 2) {
                f32x16 acc = wtile<4>(lds + R1_AHT + mt * 32 * SBS, SBS, lds + R1_ARB + nt * 32 * SBS, SBS, zero16(), lane);
#pragma unroll
                for (int g4 = 0; g4 < 4; ++g4) { const int m0 = mt * 32 + 8 * g4 + 4 * hh;
                    const v2u rt = *(const LAS v2u*)(lds + R1_RT + n * SBS + m0 * 2);
                    v2u ov; ov.x = pk2(acc[4 * g4] + bflo(rt.x), acc[4 * g4 + 1] + bfhi(rt.x)); ov.y = pk2(acc[4 * g4 + 2] + bflo(rt.y), acc[4 * g4 + 3] + bfhi(rt.y));
                    *(GAS v2u*)(RHg + n * 64 + m0) = ov; }
            } else {
                f32x16 acc = wtile<4>(lds + R1_U0T + mt * 32 * SBS, SBS, lds + R1_ARB + nt * 32 * SBS, SBS, zero16(), lane);
                acc = wtile<4>(lds + R1_VT + mt * 32 * SBS, SBS, lds + R1_ARK + nt * 32 * SBS, SBS, acc, lane);
#pragma unroll
                for (int g4 = 0; g4 < 4; ++g4) *(GAS f32x4*)(Y0g + n * 64 + mt * 32 + 8 * g4 + 4 * hh) = (f32x4){acc[4 * g4], acc[4 * g4 + 1], acc[4 * g4 + 2], acc[4 * g4 + 3]};
            }
        }
        if (tid < 64) ((float*)(F.ws + WS_BONUS))[(size_t)item * 64 + tid] = ((const LAS float*)(lds + R1_BONUS))[tid];
    }
    LDS_BARRIER();
    {
        const int n16 = lane & 15, g = lane >> 4;
        bf16x8 sh[2], sl[2];
#pragma unroll
        for (int ks = 0; ks < 2; ++ks) { const f32x4 a = cst[2 * ks], b = cst[2 * ks + 1];
            v4u h_; h_.x = pk2(a[0], a[1]); h_.y = pk2(a[2], a[3]); h_.z = pk2(b[0], b[1]); h_.w = pk2(b[2], b[3]);
            v4u l_; l_.x = pk2(a[0] - bflo(h_.x), a[1] - bfhi(h_.x)); l_.y = pk2(a[2] - bflo(h_.y), a[3] - bfhi(h_.y)); l_.z = pk2(b[0] - bflo(h_.z), b[1] - bfhi(h_.z)); l_.w = pk2(b[2] - bflo(h_.w), b[3] - bfhi(h_.w));
            sh[ks] = __builtin_bit_cast(bf16x8, h_); sl[ks] = __builtin_bit_cast(bf16x8, l_); }
        f32x4 nw[4];
#pragma unroll
        for (int rt = 0; rt < 4; ++rt) { f32x4 acc = (f32x4){0.f, 0.f, 0.f, 0.f};
            if (w >= 4) acc = *(const LAS f32x4*)(lds + R1_CN + ((16 * (w - 4) + n16) * 64 + 16 * rt + 4 * g) * 4);
#pragma unroll
            for (int ks = 0; ks < 2; ++ks) {
                const bf16x8 mh = *(const LAS bf16x8*)(lds + R1_CF + ((rt * 2 + ks) * 2) * 1024 + lane * 16), ml = *(const LAS bf16x8*)(lds + R1_CF + ((rt * 2 + ks) * 2 + 1) * 1024 + lane * 16);
                acc = __builtin_amdgcn_mfma_f32_16x16x32_bf16(mh, sh[ks], acc, 0, 0, 0);
                acc = __builtin_amdgcn_mfma_f32_16x16x32_bf16(mh, sl[ks], acc, 0, 0, 0);
                acc = __builtin_amdgcn_mfma_f32_16x16x32_bf16(ml, sh[ks], acc, 0, 0, 0); }
            nw[rt] = acc; }
#pragma unroll
        for (int rt = 0; rt < 4; ++rt) cst[rt] = nw[rt];
    }
    LDS_BARRIER();
}

constexpr int R2_RS = 272, R2_SLOT = 2 * 64 * R2_RS;
static_assert(2 * R2_SLOT <= LDSCTL_OFF, "R2 LDS");
template <int NSTEP, int R2_D> __device__ __forceinline__ void rwkv_scan(Frame& F, const float* Mg, const float* NTg, float* SSg, const float* S0g) {
    int tid_ = F.tid; asm volatile("" : "+v"(tid_));
    const int lane = tid_ & 63, w = __builtin_amdgcn_readfirstlane(tid_ >> 6);
    LAS unsigned char* lds = F.lds + RING_OFF;
    if (w >= 4) {
        const int L = w - 4, r = lane >> 2, f0 = (lane & 3) * 4;
        const size_t goff = (size_t)(16 * L + r) * 64 + f0 * 4;
        const int loff = (16 * L + r) * R2_RS + f0 * 16;
        f32x4 R[R2_D][8];
#define R2_ISSUE(slot_, step_) do { const int st_ = (step_) < NSTEP ? (step_) : NSTEP - 1; const float* mp_ = Mg + (size_t)st_ * 4096 + goff; const float* np_ = NTg + (size_t)st_ * 4096 + goff; \
            _Pragma("unroll") for (int k_ = 0; k_ < 4; ++k_) { R[slot_][k_] = *(const GAS f32x4*)(mp_ + 4 * k_); R[slot_][4 + k_] = *(const GAS f32x4*)(np_ + 4 * k_); } } while (0)
        const int q_ = lane & 3, froff = ((L * 2 + (q_ >> 1)) * 2) * 1024 + r * 16 + (q_ & 1) * 8;
#define R2_WRITE(slot_, buf_) do { LAS unsigned char* d_ = lds + (buf_) * R2_SLOT; \
            _Pragma("unroll") for (int k_ = 0; k_ < 4; ++k_) { const f32x4 a_ = R[slot_][k_]; \
                v2u h_; h_.x = pk2(a_[0], a_[1]); h_.y = pk2(a_[2], a_[3]); \
                v2u l_; l_.x = pk2(a_[0] - bflo(h_.x), a_[1] - bfhi(h_.x)); l_.y = pk2(a_[2] - bflo(h_.y), a_[3] - bfhi(h_.y)); \
                *(LAS v2u*)(d_ + froff + k_ * 256) = h_; *(LAS v2u*)(d_ + froff + 1024 + k_ * 256) = l_; \
                *(LAS f32x4*)(d_ + 64 * R2_RS + loff + 16 * k_) = R[slot_][4 + k_]; } } while (0)
#pragma unroll
        for (int u = 0; u < R2_D; ++u) R2_ISSUE(u, u);
        R2_WRITE(0, 0);
        R2_ISSUE(0, R2_D);
        LDS_BARRIER();
        int c0 = 0;
        for (; c0 + R2_D <= NSTEP - 1; c0 += R2_D) {
#pragma unroll
            for (int u = 0; u < R2_D; ++u) { const int c = c0 + u;
                R2_WRITE((u + 1) % R2_D, (c + 1) & 1);
                R2_ISSUE((u + 1) % R2_D, c + 1 + R2_D);
                LDS_BARRIER(); }
        }
#pragma unroll
        for (int u = 0; u < R2_D; ++u) { const int c = c0 + u;
            if (c < NSTEP - 1) { R2_WRITE((u + 1) % R2_D, (c + 1) & 1); LDS_BARRIER(); } }
        LDS_BARRIER();
#undef R2_ISSUE
#undef R2_WRITE
        return;
    }
    const int n16 = lane & 15, g = lane >> 4;
    f32x4 st[4];
#pragma unroll
    for (int rt = 0; rt < 4; ++rt) st[rt] = S0g ? *(const GAS f32x4*)(S0g + (16 * w + n16) * 64 + 16 * rt + 4 * g) : (f32x4){0.f, 0.f, 0.f, 0.f};
    LDS_BARRIER();
    for (int c = 0; c < NSTEP; ++c) {
#pragma unroll
        for (int rt = 0; rt < 4; ++rt) *(GAS f32x4*)(SSg + (size_t)c * 4096 + (16 * w + n16) * 64 + 16 * rt + 4 * g) = st[rt];
        const LAS unsigned char* sl_ = lds + (c & 1) * R2_SLOT;
        bf16x8 sh[2], sl[2];
#pragma unroll
        for (int ks = 0; ks < 2; ++ks) { const f32x4 a = st[2 * ks], b = st[2 * ks + 1];
            v4u h; h.x = pk2(a[0], a[1]); h.y = pk2(a[2], a[3]); h.z = pk2(b[0], b[1]); h.w = pk2(b[2], b[3]);
            v4u l; l.x = pk2(a[0] - bflo(h.x), a[1] - bfhi(h.x)); l.y = pk2(a[2] - bflo(h.y), a[3] - bfhi(h.y)); l.z = pk2(b[0] - bflo(h.z), b[1] - bfhi(h.z)); l.w = pk2(b[2] - bflo(h.w), b[3] - bfhi(h.w));
            sh[ks] = __builtin_bit_cast(bf16x8, h); sl[ks] = __builtin_bit_cast(bf16x8, l); }
        f32x4 nw[4];
#pragma unroll
        for (int rt = 0; rt < 4; ++rt) { f32x4 acc = *(const LAS f32x4*)(sl_ + 64 * R2_RS + (16 * w + n16) * R2_RS + (16 * rt + 4 * g) * 4);
#pragma unroll
            for (int ks = 0; ks < 2; ++ks) {
                const bf16x8 mh = *(const LAS bf16x8*)(sl_ + ((rt * 2 + ks) * 2) * 1024 + lane * 16), ml = *(const LAS bf16x8*)(sl_ + ((rt * 2 + ks) * 2 + 1) * 1024 + lane * 16);
                acc = __builtin_amdgcn_mfma_f32_16x16x32_bf16(mh, sh[ks], acc, 0, 0, 0);
                acc = __builtin_amdgcn_mfma_f32_16x16x32_bf16(mh, sl[ks], acc, 0, 0, 0);
                acc = __builtin_amdgcn_mfma_f32_16x16x32_bf16(ml, sh[ks], acc, 0, 0, 0); }
            nw[rt] = acc; }
#pragma unroll
        for (int rt = 0; rt < 4; ++rt) st[rt] = nw[rt];
        LDS_BARRIER();
    }
#pragma unroll
    for (int rt = 0; rt < 4; ++rt) *(GAS f32x4*)(SSg + (size_t)NSTEP * 4096 + (16 * w + n16) * 64 + 16 * rt + 4 * g) = st[rt];
}

constexpr int R3_RH = 0, R3_S = 9216, R3_SG = 18432, R3_SGS = 272, R3_YL = R3_SG + 64 * R3_SGS, R3_GL = R3_YL + 16384, R3_VS = R3_GL + 16384, R3_BON = R3_VS + 65 * 128, R3_END = R3_BON + 256;
constexpr int R3_PAR = R3_END;
static_assert(R3_PAR + 320 * 4 <= LDSCTL_OFF, "R3 LDS");
struct R3Pre { v4u rh; f32x4 ss[2]; v4u gd[2][2]; f32x4 y0[2]; v4u vv[2]; float bon; };
__device__ __forceinline__ void rwkv_r3_prefetch(Frame& F, int item, int tid, R3Pre& P) {
    const int chain = item >> 7, chunk = item & 127, b = chain >> 3, h = chain & 7, g0 = b * SEQ + chunk * 64;
    const bf16* Z = (const bf16*)(F.ws + WS_Z);
    const int t = tid >> 3, cg = tid & 7; const v4u z0 = (v4u){0u, 0u, 0u, 0u};
    P.rh = *(const GAS v4u*)((const bf16*)(F.ws + WS_RWRH) + (size_t)item * 4096 + t * 64 + cg * 8);
    const float* SSg = (const float*)(F.ws + WS_RWSS) + (size_t)item * 4096 + t * 64 + cg * 8;
    P.ss[0] = *(const GAS f32x4*)SSg; P.ss[1] = *(const GAS f32x4*)(SSg + 4);
    const bf16* zr = Z + (size_t)(g0 + t) * IN_COLS + C_GD + cg * 16; const bool first = (chunk == 0 && t == 0);
#pragma unroll
    for (int q = 0; q < 2; ++q) { P.gd[q][0] = *(const GAS v4u*)(zr + q * 8); P.gd[q][1] = z0; if (!first) P.gd[q][1] = *(const GAS v4u*)(zr - IN_COLS + q * 8); }
    const float* Y0g = (const float*)(F.ws + WS_RWY0) + (size_t)item * 4096;
    P.y0[0] = *(const GAS f32x4*)(Y0g + tid * 4); P.y0[1] = *(const GAS f32x4*)(Y0g + (tid + 512) * 4);
#pragma unroll
    for (int q = 0; q < 2; ++q) { const int p = tid + 512 * q; P.vv[q] = z0;
        if (p < 65 * 8) { const int row = p >> 3, ch = p & 7; if (!(chunk == 0 && row == 0)) P.vv[q] = *(const GAS v4u*)(Z + (size_t)(g0 - 1 + row) * IN_COLS + C_V + h * 64 + ch * 8); } }
    P.bon = tid < 64 ? ((const float*)(F.ws + WS_BONUS))[(size_t)item * 64 + tid] : 0.f;
}
__device__ __forceinline__ void r3_load_bfrag(Frame& F, int h, int w, int lane, bf16x8 (&bf)[8]) {
    const int nt = w & 1; const bf16* gut = (const bf16*)(F.ws + WS_GUPT) + (size_t)(h * 64 + nt * 32 + (lane & 31)) * 128 + 8 * (lane >> 5);
#pragma unroll
    for (int s2 = 0; s2 < 8; ++s2) bf[s2] = *(const GAS bf16x8*)(gut + 16 * s2);
}
__device__ __forceinline__ void r3_load_params(Frame& F, int h) {
    LAS float* PAR = (LAS float*)(F.lds + RING_OFF + R3_PAR); const float* mu = F.in[3];
    const int k = F.wave, c = F.lane, col = h * 64 + c;
    if (k < 2) PAR[k * 64 + c] = mu[C_GD + k * 64 + c];
    else if (k < 5) PAR[128 + (k - 2) * 64 + c] = (k == 2 ? mu + C_V : (k == 3 ? F.in[12] : F.in[13]))[col];
}
__device__ __forceinline__ void rwkv_r3_item(Frame& F, int item, int next_item, R3Pre& P, const bf16x8 (&bfr)[8]) {
    const int chain = item >> 7, chunk = item & 127, b = chain >> 3, h = chain & 7;
    const int g0 = b * SEQ + chunk * 64;
    int tid_ = F.tid; asm volatile("" : "+v"(tid_));
    const int tid = tid_, lane = tid & 63, w = __builtin_amdgcn_readfirstlane(tid >> 6), hh = lane >> 5, cl = lane & 31;
    LAS unsigned char* lds = F.lds + RING_OFF;
    const float* mu = F.in[3];
    {
        const int t = tid >> 3, cg = tid & 7;
        *(LAS v4u*)(lds + R3_RH + t * SBS + cg * 16) = P.rh;
        const f32x4 s0 = P.ss[0], s1 = P.ss[1];
        v4u o; o.x = pk2(s0[0], s0[1]); o.y = pk2(s0[2], s0[3]); o.z = pk2(s1[0], s1[1]); o.w = pk2(s1[2], s1[3]);
        *(LAS v4u*)(lds + R3_S + t * SBS + cg * 16) = o;
#pragma unroll
        for (int q = 0; q < 2; ++q) {
            const v4u cw = P.gd[q][0], pw = P.gd[q][1];
            float fw[8], qw[8];
            fw[0] = bflo(cw.x); fw[1] = bfhi(cw.x); fw[2] = bflo(cw.y); fw[3] = bfhi(cw.y); fw[4] = bflo(cw.z); fw[5] = bfhi(cw.z); fw[6] = bflo(cw.w); fw[7] = bfhi(cw.w);
            qw[0] = bflo(pw.x); qw[1] = bfhi(pw.x); qw[2] = bflo(pw.y); qw[3] = bfhi(pw.y); qw[4] = bflo(pw.z); qw[5] = bfhi(pw.z); qw[6] = bflo(pw.w); qw[7] = bfhi(pw.w);
            const f32x4 mg0 = *(const LAS f32x4*)(lds + R3_PAR + (cg * 16 + q * 8) * 4), mg1 = *(const LAS f32x4*)(lds + R3_PAR + (cg * 16 + q * 8 + 4) * 4);
#pragma unroll
            for (int j = 0; j < 8; ++j) { const float v = fw[j] + (qw[j] - fw[j]) * (j < 4 ? mg0[j & 3] : mg1[j & 3]); fw[j] = frcp(1.f + __expf(-v)); }
            v4u og; og.x = pk2(fw[0], fw[1]); og.y = pk2(fw[2], fw[3]); og.z = pk2(fw[4], fw[5]); og.w = pk2(fw[6], fw[7]);
            *(LAS v4u*)(lds + R3_SG + t * R3_SGS + (cg * 16 + q * 8) * 2) = og;
        }
        *(LAS f32x4*)(lds + R3_YL + tid * 16) = P.y0[0]; *(LAS f32x4*)(lds + R3_YL + (tid + 512) * 16) = P.y0[1];
#pragma unroll
        for (int q = 0; q < 2; ++q) { const int p = tid + 512 * q; if (p < 65 * 8) *(LAS v4u*)(lds + R3_VS + p * 16) = P.vv[q]; }
        if (tid < 64) ((LAS float*)(lds + R3_BON))[tid] = P.bon;
        if (next_item >= 0) rwkv_r3_prefetch(F, next_item, tid, P);
    }
    LDS_BARRIER();
    {
        const int mt = (w >> 1) & 1, nt = w & 1; const int n = nt * 32 + cl;
        if (w < 4) {
            LAS float* YL = (LAS float*)(lds + R3_YL);
            f32x16 acc;
#pragma unroll
            for (int r = 0; r < 16; ++r) acc[r] = YL[(mt * 32 + crow(r, hh)) * 64 + n];
            acc = wtile<4>(lds + R3_RH + mt * 32 * SBS, SBS, lds + R3_S + nt * 32 * SBS, SBS, acc, lane);
#pragma unroll
            for (int r = 0; r < 16; ++r) YL[(mt * 32 + crow(r, hh)) * 64 + n] = acc[r];
        } else {
            f32x16 acc = zero16();
            { const LAS unsigned char* A_ = lds + R3_SG + mt * 32 * R3_SGS + (lane & 31) * R3_SGS + 16 * hh;
#pragma unroll
              for (int s2 = 0; s2 < 8; ++s2) acc = __builtin_amdgcn_mfma_f32_32x32x16_bf16(*(const LAS bf16x8*)(A_ + 32 * s2), bfr[s2], acc, 0, 0, 0); }
            LAS float* GL = (LAS float*)(lds + R3_GL);
#pragma unroll
            for (int r = 0; r < 16; ++r) GL[(mt * 32 + crow(r, hh)) * 64 + n] = acc[r];
        }
    }
    LDS_BARRIER();
    {
        const int c = tid & 63, ts = tid >> 6, col = h * 64 + c;
        const LAS float* PAR = (const LAS float*)(lds + R3_PAR) + 128 + c;
        const float mu_v = PAR[0], gw = PAR[64], gb = PAR[128];
        const LAS float* YL = (const LAS float*)(lds + R3_YL); const LAS float* GL = (const LAS float*)(lds + R3_GL); const LAS float* BON = (const LAS float*)(lds + R3_BON);
        bf16* Y = (bf16*)(F.ws + WS_YMIX);
        const LAS bf16* vb = (const LAS bf16*)(lds + R3_VS) + (8 * ts) * 64 + c;
        float pv = bf2f(vb[0]);
#pragma unroll
        for (int i = 0; i < 8; ++i) { const int t = 8 * ts + i;
            const float zv = bf2f(vb[(i + 1) * 64]); const float v = zv + (pv - zv) * mu_v; pv = zv;
            const float y = YL[t * 64 + c];
            const float mean = wave_sum(y) * (1.f / 64.f); const float d = y - mean; const float var = wave_sum(d * d) * (1.f / 64.f);
            const float yn = d * frsq(var + GN_EPS) * gw + gb;
            const float o = (yn + BON[t] * v) * GL[t * 64 + c];
            Y[(size_t)(g0 + t) * DM + col] = (bf16)f2bf(o); }
    }
    LDS_BARRIER();
}

typedef short s16x4 __attribute__((ext_vector_type(4)));
typedef short v4i16_t __attribute__((ext_vector_type(4)));
constexpr int AT_XO = 0, AT_XO_STRIDE = 136, AT_XM = 512 * AT_XO_STRIDE, AT_XL = AT_XM + 2048, AT_V = AT_XL + 2048, AT_K = AT_V + 8 * 4096, AT_KS = 144, AT_LDS_END = AT_K + 8 * 32 * AT_KS;
static_assert(AT_LDS_END <= LDSCTL_OFF, "attention LDS");
__device__ __forceinline__ float xhalf(float v) { return __shfl_xor(v, 32); }
__device__ __forceinline__ void attn_block(Frame& F, int item) {
    const int bh = item >> 4, blk = item & 15, b = bh >> 3, h = bh & 7, t0 = blk * 512;
    int tid_ = F.tid; asm volatile("" : "+v"(tid_));
    const int lane = tid_ & 63, w = __builtin_amdgcn_readfirstlane(tid_ >> 6), ql = lane & 31, hh = lane >> 5;
    const bf16* Zb = (const bf16*)(F.ws + WS_Z) + (size_t)b * SEQ * IN_COLS;
    bf16* Y = (bf16*)(F.ws + WS_YMIX);
    LAS unsigned char* lds = F.lds + RING_OFF;
    LAS unsigned char* Vw = lds + AT_V + w * 4096;
    LAS unsigned char* Kw = lds + AT_K + w * 32 * AT_KS;
    LAS float* XM = (LAS float*)(lds + AT_XM); LAS float* XL = (LAS float*)(lds + AT_XL);
    constexpr float C2 = 0.125f * 1.4426950408889634f;
    const int lrow = lane >> 3, lch = lane & 7;
    __builtin_amdgcn_s_waitcnt(0x0F70);
#define AT_PARAMS(SI, sh_, d_, rho_, tau_, tkb_) do { const int ps_ = (SI) >> 1; sh_ = ps_ == 0 ? 4 : (ps_ == 1 ? 2 : 0); d_ = 1 << sh_; \
        const int u_ = w + 8 * ((SI) & 1); rho_ = u_ & (d_ - 1); tau_ = u_ >> sh_; tkb_ = t0 + rho_ + (32 * tau_ - 128) * d_; } while (0)
    const GAS char* zb8 = (const GAS char*)Zb;
#define AT_VOFF(d_) ((unsigned)(lrow * (d_)) * (unsigned)(IN_COLS * 2) + (unsigned)(lch * 16))
#define AT_LOADQ(d_, rho_, tau_, vo_) do { const GAS char* sb_ = zb8 + ((size_t)(t0 + rho_ + 32 * tau_ * d_) * IN_COLS + C_AQ + h * 64) * 2; \
        _Pragma("unroll") for (int i_ = 0; i_ < 4; ++i_) qr[i_] = *(const GAS v4u*)(sb_ + (size_t)(i_ * 8 * d_) * (IN_COLS * 2) + vo_); } while (0)
#define AT_LOADT(KT, COL, d_, tkb_, vo_) do { const int tk_ = tkb_ + 32 * (KT) * d_, tc_ = tk_ < 0 ? 0 : tk_; const GAS char* sb_ = zb8 + ((size_t)tc_ * IN_COLS + (COL) + h * 64) * 2; \
        _Pragma("unroll") for (int i_ = 0; i_ < 4; ++i_) R[KT][i_] = *(const GAS v4u*)(sb_ + (size_t)(i_ * 8 * d_) * (IN_COLS * 2) + vo_); } while (0)
    v4u R[5][4], qr[4];
    { int sh, d, rho, tau, tkb; AT_PARAMS(0, sh, d, rho, tau, tkb);
      const unsigned vo = AT_VOFF(d);
      AT_LOADQ(d, rho, tau, vo);
#pragma unroll
      for (int kt = 0; kt < 5; ++kt) AT_LOADT(kt, C_AK, d, tkb, vo); }
#pragma unroll 1
    for (int si = 0; si < 6; ++si) {
        int sh, d, rho, tau, tkb; AT_PARAMS(si, sh, d, rho, tau, tkb);
        const int sn = si < 5 ? si + 1 : 5;
        int sh2, d2, rho2, tau2, tkb2; AT_PARAMS(sn, sh2, d2, rho2, tau2, tkb2);
        const int qoff = rho + (32 * tau + ql) * d;
        const unsigned vo = AT_VOFF(d), vo2 = AT_VOFF(d2);
        bf16x8 qf[4];
#pragma unroll
        for (int i = 0; i < 4; ++i) *(LAS v4u*)(Kw + (i * 8 + lrow) * AT_KS + lch * 16) = qr[i];
#pragma unroll
        for (int s = 0; s < 4; ++s) qf[s] = *(const LAS bf16x8*)(Kw + ql * AT_KS + 32 * s + 16 * hh);
        f32x16 sc[5];
        float m = -INFINITY;
#pragma unroll
        for (int kt = 0; kt < 5; ++kt) {
            const int tk0 = tkb + 32 * kt * d;
            bf16x8 kf[4];
#pragma unroll
            for (int i = 0; i < 4; ++i) *(LAS v4u*)(Kw + (i * 8 + lrow) * AT_KS + lch * 16) = R[kt][i];
            AT_LOADT(kt, C_AV, d, tkb, vo);
#pragma unroll
            for (int s = 0; s < 4; ++s) kf[s] = *(const LAS bf16x8*)(Kw + ql * AT_KS + 32 * s + 16 * hh);
            f32x16 acc = zero16();
#pragma unroll
            for (int s = 0; s < 4; ++s) acc = __builtin_amdgcn_mfma_f32_32x32x16_bf16(kf[s], qf[s], acc, 0, 0, 0);
            if (kt == 0 || kt == 4) {
#pragma unroll
                for (int r = 0; r < 16; ++r) { const int kidx = (r & 3) + 8 * (r >> 2) + 4 * hh;
                    const bool ok = (kt == 0) ? (kidx >= ql) : (kidx <= ql);
                    acc[r] = ok ? acc[r] : -INFINITY; }
            }
            float mt = acc[0];
#pragma unroll
            for (int r = 1; r < 16; ++r) mt = fmaxf(mt, acc[r]);
            m = tk0 < 0 ? m : fmaxf(m, mt);
            sc[kt] = acc;
        }
        m = fmaxf(m, xhalf(m));
        const float ms = m * C2;
        f32x2 l2 = (f32x2){0.f, 0.f};
        unsigned pw[5][8];
#pragma unroll
        for (int kt = 0; kt < 5; ++kt) {
            const float mk = (tkb + 32 * kt * d) < 0 ? INFINITY : ms;
#pragma unroll
            for (int r = 0; r < 8; ++r) {
                const f32x2 t2 = __builtin_elementwise_fma((f32x2){sc[kt][2 * r], sc[kt][2 * r + 1]}, (f32x2){C2, C2}, (f32x2){-mk, -mk});
                const f32x2 p2 = (f32x2){__builtin_amdgcn_exp2f(t2[0]), __builtin_amdgcn_exp2f(t2[1])};
                l2 += p2; pw[kt][r] = pk2(p2[0], p2[1]); }
        }
        float l = l2[0] + l2[1];
        l += xhalf(l);
        AT_LOADQ(d2, rho2, tau2, vo2);
        f32x16 O[2];
#pragma unroll
        for (int r = 0; r < 16; ++r) { O[0][r] = 0.f; O[1][r] = 0.f; }
#pragma unroll
        for (int kt = 0; kt < 5; ++kt) {
#pragma unroll
            for (int i = 0; i < 4; ++i) { const int kidx = i * 8 + lrow;
                *(LAS v4u*)(Vw + kidx * 128 + ((lch ^ (((kidx >> 1) & 1) << 2)) << 4)) = R[kt][i]; }
            AT_LOADT(kt, C_AK, d2, tkb2, vo2);
#pragma unroll
            for (int s = 0; s < 2; ++s) {
                v4u pq; pq.x = pw[kt][4 * s]; pq.y = pw[kt][4 * s + 1]; pq.z = pw[kt][4 * s + 2]; pq.w = pw[kt][4 * s + 3];
                const bf16x8 pf = __builtin_bit_cast(bf16x8, pq);
#pragma unroll
                for (int dt = 0; dt < 2; ++dt) {
                    bf16x8 vf;
#pragma unroll
                    for (int pp = 0; pp < 2; ++pp) {
                        const int i16 = lane & 15, db = (lane >> 4) & 1;
                        const int row = 16 * s + 8 * pp + 4 * hh + (i16 >> 2);
                        const int byte = 64 * dt + 32 * db + 8 * (i16 & 3);
                        const int chunk = (byte >> 4) ^ (((row >> 1) & 1) << 2);
                        const s16x4 t4 = __builtin_bit_cast(s16x4, __builtin_amdgcn_ds_read_tr16_b64_v4i16((LAS v4i16_t*)(Vw + row * 128 + (chunk << 4) + (byte & 15))));
                        vf[4 * pp + 0] = t4[0]; vf[4 * pp + 1] = t4[1]; vf[4 * pp + 2] = t4[2]; vf[4 * pp + 3] = t4[3];
                    }
                    O[dt] = __builtin_amdgcn_mfma_f32_32x32x16_bf16(vf, pf, O[dt], 0, 0, 0);
                }
            }
        }
        LAS unsigned char* xo = lds + AT_XO + qoff * AT_XO_STRIDE + 8 * hh;
        float wa = 0.f, wb = 1.f, Mx = ms, ln = l;
        if (si >= 2) { const float msa = XM[qoff], la = XL[qoff]; Mx = fmaxf(msa, ms); wa = la * __builtin_amdgcn_exp2f(msa - Mx); wb = __builtin_amdgcn_exp2f(ms - Mx); ln = wa + wb * l; }
        const float inv = 1.f / ln;
#pragma unroll
        for (int dt = 0; dt < 2; ++dt)
#pragma unroll
            for (int g4 = 0; g4 < 4; ++g4) {
                LAS v2u* p = (LAS v2u*)(xo + (32 * dt + 8 * g4) * 2);
                float o0 = O[dt][4 * g4] * wb, o1 = O[dt][4 * g4 + 1] * wb, o2 = O[dt][4 * g4 + 2] * wb, o3 = O[dt][4 * g4 + 3] * wb;
                if (si >= 2) { const v2u old = *p; o0 += bflo(old.x) * wa; o1 += bfhi(old.x) * wa; o2 += bflo(old.y) * wa; o3 += bfhi(old.y) * wa; }
                v2u nw; nw.x = pk2(o0 * inv, o1 * inv); nw.y = pk2(o2 * inv, o3 * inv);
                *p = nw;
            }
        if (hh == 0) { XM[qoff] = Mx; XL[qoff] = ln; }
        if (si & 1) LDS_BARRIER();
    }
#undef AT_PARAMS
#undef AT_LOADQ
#undef AT_VOFF
#undef AT_LOADT
#pragma unroll
    for (int i = 0; i < 8; ++i) { const int row = (tid_ >> 3) + 64 * i, ch = tid_ & 7;
        LAS v2u* p = (LAS v2u*)(lds + AT_XO + row * AT_XO_STRIDE + ch * 16);
        const v2u a = p[0], c = p[1];
        v4u o; o.x = a.x; o.y = a.y; o.z = c.x; o.w = c.y;
        *(GAS v4u*)(Y + ((size_t)b * SEQ + t0 + row) * DM + RWW + h * 64 + ch * 8) = o; }
    LDS_BARRIER();
}

__device__ __forceinline__ void quantize_tables(Frame& F, int gw, int ngw) {
    for (int m = gw; m < 2 * NEXP; m += ngw) {
        const int tab = m >= NEXP, row = tab ? m - NEXP : m;
        const GAS f32x4* xr = (const GAS f32x4*)(F.in[18 + tab] + (size_t)row * DM) + F.lane * 4;
        f32x4 v[4]; float am = 0.f;
#pragma unroll
        for (int j = 0; j < 4; ++j) { v[j] = xr[j]; am = fmaxf(am, fmaxf(fmaxf(fabsf(v[j].x), fabsf(v[j].y)), fmaxf(fabsf(v[j].z), fabsf(v[j].w)))); }
        am = wave_max(am);
        const float qmax = tab ? 224.f : 127.f;
        const float sc = am > 0.f ? am / qmax : 1.f, inv = am > 0.f ? qmax / am : 0.f;
        v4u o;
#pragma unroll
        for (int j = 0; j < 4; ++j) {
            if (tab) { int w = __builtin_amdgcn_cvt_pk_fp8_f32(v[j].x * inv, v[j].y * inv, 0, false); w = __builtin_amdgcn_cvt_pk_fp8_f32(v[j].z * inv, v[j].w * inv, w, true); o[j] = (unsigned)w; }
            else {
            const unsigned b0 = (unsigned)(int)rintf(v[j].x * inv) & 255u, b1 = (unsigned)(int)rintf(v[j].y * inv) & 255u,
                           b2 = (unsigned)(int)rintf(v[j].z * inv) & 255u, b3 = (unsigned)(int)rintf(v[j].w * inv) & 255u;
            o[j] = b0 | (b1 << 8) | (b2 << 16) | (b3 << 24); } }
        *(GAS v4u*)(F.ws + (tab ? WS_VQ : WS_UQ) + (size_t)row * DM + F.lane * 16) = o;
        if (F.lane == 0) ((float*)(F.ws + (tab ? WS_SV : WS_SU)))[row] = sc;
    }
}

__device__ __forceinline__ void p3_mixers(Frame& F) {
    if (F.wg < NB * NHR) {
        const int chain = F.wg;
        const float* Pg = (const float*)(F.ws + WS_PQ) + (size_t)chain * 8 * 4096; const float* Qg = Pg + (size_t)256 * 4096;
        rwkv_scan<7, 3>(F, Pg, Qg, (float*)(F.ws + WS_SSEG) + (size_t)chain * 8 * 4096, nullptr);
        asm volatile("s_waitcnt vmcnt(0)" ::: "memory");
        __syncthreads();
        if (F.tid == 0) {
            __builtin_amdgcn_fence(__ATOMIC_RELEASE, "agent");
            asm volatile("s_waitcnt vmcnt(0)" ::: "memory");
            (void)xb_add((unsigned*)F.ctl + CW_SCAN + 16 * chain, 1u);
        }
    }
#ifndef ATTN_REPS
#define ATTN_REPS 1
#endif
    for (int rep = 0; rep < ATTN_REPS; ++rep)
    if (F.G == 256) { for (int r = 0; r < 2; ++r) { const int v = r * 32 + (F.wg >> 3); attn_block(F, (((F.wg & 7) * 4 + (v >> 4)) << 4) | (v & 15)); } }
    else for (int item = F.wg; item < NB * NHA * (SEQ / 512); item += F.G) attn_block(F, item);
}

constexpr int TK_SKS = 272, TK_SKH = 0, TK_SKL = 2 * 128 * TK_SKS, TK_LUT = 2 * TK_SKL, TK_END = TK_LUT + 8 * 2048;
__device__ __forceinline__ unsigned f2ord(float f) { const unsigned u = __builtin_bit_cast(unsigned, f); return u ^ ((unsigned)((int)u >> 31) | 0x80000000u); }
__device__ __forceinline__ float ord2f(unsigned o) { const unsigned u = (o & 0x80000000u) ? (o ^ 0x80000000u) : ~o; return __builtin_bit_cast(float, u); }
__device__ __forceinline__ void ce_desc(unsigned& a, unsigned& b) { const unsigned mx = a > b ? a : b, mn = a > b ? b : a; a = mx; b = mn; }
template <int N, int OFF, int TOT> __device__ __forceinline__ void bitonic_sort_desc(unsigned (&v)[TOT]) {
#pragma unroll
    for (int k = 2; k <= N; k <<= 1)
#pragma unroll
        for (int j = k >> 1; j > 0; j >>= 1)
#pragma unroll
            for (int i = 0; i < N; ++i) { const int l = i ^ j; if (l > i) { if ((i & k) == 0) ce_desc(v[OFF + i], v[OFF + l]); else ce_desc(v[OFF + l], v[OFF + i]); } }
}
template <int OFFA, int OFFB, int TOT> __device__ __forceinline__ void merge_top16(unsigned (&v)[TOT]) {
#pragma unroll
    for (int i = 0; i < 16; ++i) { const unsigned x = v[OFFA + i], y = v[OFFB + 15 - i]; v[OFFA + i] = x > y ? x : y; }
#pragma unroll
    for (int j = 8; j > 0; j >>= 1)
#pragma unroll
        for (int i = 0; i < 16; ++i) { const int l = i ^ j; if (l > i) ce_desc(v[OFFA + i], v[OFFA + l]); }
}
__device__ __forceinline__ void top16_of_64(unsigned (&k)[64]) {
    bitonic_sort_desc<16, 0, 64>(k); bitonic_sort_desc<16, 16, 64>(k); bitonic_sort_desc<16, 32, 64>(k); bitonic_sort_desc<16, 48, 64>(k);
    merge_top16<0, 16, 64>(k); merge_top16<32, 48, 64>(k); merge_top16<0, 32, 64>(k);
}
__device__ __forceinline__ void p7_topk(Frame& F) {
    static_assert(TK_END <= LDSCTL_OFF, "topk LDS");
    const bf16* QP = (const bf16*)(F.ws + WS_QP);
    int* EID = (int*)(F.ws + WS_EID); float* GATE = (float*)(F.ws + WS_GATE);
    const float* sk = F.in[17];
    LAS unsigned char* lds = F.lds + RING_OFF;
    for (int e = F.tid; e < 2 * 128 * 64; e += NTHREADS) {
        const int c = e >> 13, k = (e >> 6) & 127, d2 = e & 63;
        const f32x2 v = *(const GAS f32x2*)(sk + (size_t)(c * 128 + k) * 128 + 2 * d2);
        const unsigned h0 = f2bf(v.x), h1 = f2bf(v.y);
        const float r0 = v.x - __builtin_bit_cast(float, h0 << 16), r1 = v.y - __builtin_bit_cast(float, h1 << 16);
        *(LAS unsigned*)(lds + TK_SKH + (c * 128 + k) * TK_SKS + d2 * 4) = h0 | (h1 << 16);
        *(LAS unsigned*)(lds + TK_SKL + (c * 128 + k) * TK_SKS + d2 * 4) = pk2(r0, r1);
    }
    __syncthreads();
    const int gw = F.wg * NWAVES + F.wave, NGW = F.G * NWAVES;
    for (int tile = gw; tile < T * PHEADS / 32; tile += NGW) {
        int lane_ = F.lane; asm volatile("" : "+v"(lane_));
        const int lane = lane_, hh = lane >> 5, cl = lane & 31;
        const int P = tile * 32 + cl, t = P >> 3, h = P & 7;
        unsigned kAB[2][16];
#pragma unroll
        for (int c = 0; c < 2; ++c) {
            bf16x8 qf[8];
            const bf16* qp = QP + (size_t)t * PQ + h * 256 + c * 128 + 8 * hh;
#pragma unroll
            for (int s2 = 0; s2 < 8; ++s2) qf[s2] = *(const GAS bf16x8*)(qp + 16 * s2);
            unsigned k[64];
#pragma unroll
            for (int mt = 0; mt < 4; ++mt) {
                f32x16 acc = zero16();
                const LAS unsigned char* ah = lds + TK_SKH + (c * 128 + mt * 32 + cl) * TK_SKS + 16 * hh;
                const LAS unsigned char* al = lds + TK_SKL + (c * 128 + mt * 32 + cl) * TK_SKS + 16 * hh;
#pragma unroll
                for (int s2 = 0; s2 < 8; ++s2) {
                    acc = __builtin_amdgcn_mfma_f32_32x32x16_bf16(*(const LAS bf16x8*)(ah + 32 * s2), qf[s2], acc, 0, 0, 0);
                    acc = __builtin_amdgcn_mfma_f32_32x32x16_bf16(*(const LAS bf16x8*)(al + 32 * s2), qf[s2], acc, 0, 0, 0); }
#pragma unroll
                for (int r = 0; r < 16; ++r) { const int idx = 32 * mt + (r & 3) + 8 * (r >> 2) + 4 * hh; k[mt * 16 + r] = (f2ord(acc[r]) & ~127u) | (unsigned)(127 - idx); }
            }
            top16_of_64(k);
            unsigned m[32];
#pragma unroll
            for (int i = 0; i < 16; ++i) { m[i] = k[i]; m[16 + i] = (unsigned)__shfl_xor((int)k[i], 32); }
            merge_top16<0, 16, 32>(m);
#pragma unroll
            for (int i = 0; i < 16; ++i) kAB[c][i] = m[i];
        }
        float fa[16], fb[16];
#pragma unroll
        for (int i = 0; i < 16; ++i) { fa[i] = ord2f(kAB[0][i] & ~127u); fb[i] = ord2f(kAB[1][i] & ~127u); }
        unsigned cd[64]; int n = 0;
#pragma unroll
        for (int i = 0; i < 16; ++i)
#pragma unroll
            for (int j = 0; j < 16; ++j) if ((i + 1) * (j + 1) <= 16) { cd[n] = (f2ord(fa[i] + fb[j]) & ~255u) | (unsigned)(255 - (i * 16 + j)); ++n; }
#pragma unroll
        for (int q = 50; q < 64; ++q) cd[q] = 0u;
        top16_of_64(cd);
        LAS unsigned char* lut = lds + TK_LUT + (F.wave * 64 + lane) * 32;
#pragma unroll
        for (int q = 0; q < 4; ++q) {
            unsigned wa = 0u, wb = 0u;
#pragma unroll
            for (int b4 = 0; b4 < 4; ++b4) { wa |= (127u - (kAB[0][4 * q + b4] & 127u)) << (8 * b4); wb |= (127u - (kAB[1][4 * q + b4] & 127u)) << (8 * b4); }
            *(LAS unsigned*)(lut + 4 * q) = wa; *(LAS unsigned*)(lut + 16 + 4 * q) = wb; }
        float gv[16]; float den = 0.f; const float mx = ord2f(cd[0] & ~255u);
#pragma unroll
        for (int q = 0; q < 16; ++q) { gv[q] = __expf(ord2f(cd[q] & ~255u) - mx); den += gv[q]; }
        const float inv = 1.f / den;
        asm volatile("s_waitcnt lgkmcnt(0)" ::: "memory");
        int ev[16];
#pragma unroll
        for (int q = 0; q < 16; ++q) { const unsigned pos = 255u - (cd[q] & 255u);
            const unsigned ia = *(const LAS unsigned char*)(lut + (pos >> 4)), ib = *(const LAS unsigned char*)(lut + 16 + (pos & 15u));
            ev[q] = (int)(ia * NKEYS + ib); }
        if (hh == 0) {
            int* ep = EID + (size_t)t * 128 + h * 16; float* gp = GATE + (size_t)t * 128 + h * 16;
#pragma unroll
            for (int q = 0; q < 4; ++q) {
                *(GAS v4u*)(ep + 4 * q) = (v4u){(unsigned)ev[4 * q], (unsigned)ev[4 * q + 1], (unsigned)ev[4 * q + 2], (unsigned)ev[4 * q + 3]};
                *(GAS f32x4*)(gp + 4 * q) = (f32x4){gv[4 * q] * inv, gv[4 * q + 1] * inv, gv[4 * q + 2] * inv, gv[4 * q + 3] * inv}; }
        }
        asm volatile("s_waitcnt lgkmcnt(0)" ::: "memory");
    }
}

constexpr int GA_WAVE_BYTES = 10752, GA_CNT = 4096, GA_OFF = 4096 + 128, GA_ACT = 4608, GA_XQ = 6656;
__device__ __forceinline__ int wave_sum_i(int v) { v += dppi<0xB1>(v); v += dppi<0x4E>(v); v += dppi<0x141>(v); v += dppi<0x140>(v);
    return (__builtin_amdgcn_readlane(v, 0) + __builtin_amdgcn_readlane(v, 16)) + (__builtin_amdgcn_readlane(v, 32) + __builtin_amdgcn_readlane(v, 48)); }
__device__ __forceinline__ void p8_gather(Frame& F, float* outp) {
    const bf16* XN = (const bf16*)(F.ws + WS_XN);
    const unsigned char* UQ = F.ws + WS_UQ; const unsigned char* VQ = F.ws + WS_VQ;
    const float* SU = (const float*)(F.ws + WS_SU); const float* SV = (const float*)(F.ws + WS_SV);
    const int* EID = (const int*)(F.ws + WS_EID); const float* GATE = (const float*)(F.ws + WS_GATE);
    const float* nf = F.in[20];
    const int gw = F.wg * NWAVES + F.wave, NGW = F.G * NWAVES;
    LAS unsigned char* wl = F.lds + RING_OFF + F.wave * GA_WAVE_BYTES;
    for (int tg = gw, sweep = 0; tg < T / 4; tg += NGW, ++sweep) {
        int lane_ = F.lane; asm volatile("" : "+v"(lane_));
        const int lane = lane_;
        int xq[4][4]; float sx[4];
#pragma unroll
        for (int tk = 0; tk < 4; ++tk) {
            const GAS v4u* xp = (const GAS v4u*)(XN + (size_t)(4 * tg + tk) * DM + lane * 16);
            const v4u a = xp[0], b = xp[1];
            float x[16]; x[0] = bflo(a.x); x[1] = bfhi(a.x); x[2] = bflo(a.y); x[3] = bfhi(a.y); x[4] = bflo(a.z); x[5] = bfhi(a.z); x[6] = bflo(a.w); x[7] = bfhi(a.w);
            x[8] = bflo(b.x); x[9] = bfhi(b.x); x[10] = bflo(b.y); x[11] = bfhi(b.y); x[12] = bflo(b.z); x[13] = bfhi(b.z); x[14] = bflo(b.w); x[15] = bfhi(b.w);
            float am = 0.f;
#pragma unroll
            for (int i = 0; i < 16; ++i) am = fmaxf(am, fabsf(x[i]));
            am = wave_max(am);
            const float rs_ = frsq(((const float*)(F.ws + WS_SSQ))[4 * tg + tk] * (1.f / DM) + RMS_EPS);
            sx[tk] = (am > 0.f ? am * (1.f / 127.f) : 1.f) * rs_; const float inv = am > 0.f ? 127.f / am : 0.f;
#pragma unroll
            for (int q = 0; q < 4; ++q) {
                const unsigned b0 = (unsigned)(int)rintf(x[4 * q] * inv) & 255u, b1 = (unsigned)(int)rintf(x[4 * q + 1] * inv) & 255u, b2 = (unsigned)(int)rintf(x[4 * q + 2] * inv) & 255u, b3 = (unsigned)(int)rintf(x[4 * q + 3] * inv) & 255u;
                xq[tk][q] = (int)(b0 | (b1 << 8) | (b2 << 16) | (b3 << 24)); }
            *(LAS v4u*)(wl + GA_XQ + tk * 1024 + lane * 16) = (v4u){(unsigned)xq[tk][0], (unsigned)xq[tk][1], (unsigned)xq[tk][2], (unsigned)xq[tk][3]};
        }
        LAS unsigned* cnt = (LAS unsigned*)(wl + GA_CNT); LAS unsigned* offs = (LAS unsigned*)(wl + GA_OFF);
        if (lane < 32) cnt[lane] = 0u;
        asm volatile("s_waitcnt lgkmcnt(0)" ::: "memory");
        int ee[8]; float gg[8]; unsigned pos[8];
#pragma unroll
        for (int tk = 0; tk < 4; ++tk) {
            const size_t base = (size_t)(4 * tg + tk) * 128;
            ee[2 * tk] = (EID[base + lane] & (NEXP - 1)) | (tk << 14); ee[2 * tk + 1] = (EID[base + 64 + lane] & (NEXP - 1)) | (tk << 14);
            gg[2 * tk] = GATE[base + lane]; gg[2 * tk + 1] = GATE[base + 64 + lane]; }
#pragma unroll
        for (int q = 0; q < 8; ++q) pos[q] = __hip_atomic_fetch_add(cnt + ((ee[q] >> 9) & 31), 1u, __ATOMIC_RELAXED, __HIP_MEMORY_SCOPE_WAVEFRONT);
        asm volatile("s_waitcnt lgkmcnt(0)" ::: "memory");
        if (lane < 32) {
            const int c0 = (int)cnt[lane]; int v = c0;
            v += __builtin_amdgcn_update_dpp(0, v, 0x111, 0xF, 0xF, true); v += __builtin_amdgcn_update_dpp(0, v, 0x112, 0xF, 0xF, true);
            v += __builtin_amdgcn_update_dpp(0, v, 0x114, 0xF, 0xF, true); v += __builtin_amdgcn_update_dpp(0, v, 0x118, 0xF, 0xF, true);
            const int row0 = __builtin_amdgcn_readlane(v, 15);
            offs[lane] = (unsigned)(v - c0 + (lane >= 16 ? row0 : 0));
        }
        asm volatile("s_waitcnt lgkmcnt(0)" ::: "memory");
#pragma unroll
        for (int q = 0; q < 8; ++q) { const unsigned idx = offs[(ee[q] >> 9) & 31] + pos[q];
            *(LAS unsigned*)(wl + idx * 4) = (unsigned)ee[q]; *(LAS float*)(wl + 2048 + idx * 4) = gg[q]; }
        asm volatile("s_waitcnt lgkmcnt(0)" ::: "memory");
        LAS float* act = (LAS float*)(wl + GA_ACT);
#ifndef UPASS_REPS
#define UPASS_REPS 1
#endif
        for (int urep = 0; urep < UPASS_REPS; ++urep)
        {
            const int grp = lane >> 4, l16 = lane & 15;
            const LAS unsigned* ents = (const LAS unsigned*)wl;
            LAS int* hbuf = (LAS int*)(wl + GA_ACT);
            v4u rb[2][2][4]; unsigned eb[2][2];
#define GA_ULOAD(ST, QD, Q_) do { const unsigned e_ = ents[(Q_) * 4 + grp]; eb[ST][QD] = e_; const GAS v4u* rp_ = (const GAS v4u*)(UQ + (size_t)(e_ & (NEXP - 1)) * DM + l16 * 64); \
                rb[ST][QD][0] = rp_[0]; rb[ST][QD][1] = rp_[1]; rb[ST][QD][2] = rp_[2]; rb[ST][QD][3] = rp_[3]; } while (0)
#define GA_UDOT(ST, QD, Q_) do { const LAS v4u* xp_ = (const LAS v4u*)(wl + GA_XQ + ((eb[ST][QD] >> 14) & 3u) * 1024 + l16 * 64); int d_ = 0; \
                _Pragma("unroll") for (int k_ = 0; k_ < 4; ++k_) { const v4u x_ = xp_[k_], r_ = rb[ST][QD][k_]; \
                    d_ = __builtin_amdgcn_sdot4((int)x_.x, (int)r_.x, d_, false); d_ = __builtin_amdgcn_sdot4((int)x_.y, (int)r_.y, d_, false); \
                    d_ = __builtin_amdgcn_sdot4((int)x_.z, (int)r_.z, d_, false); d_ = __builtin_amdgcn_sdot4((int)x_.w, (int)r_.w, d_, false); } \
                d_ += dppi<0xB1>(d_); d_ += dppi<0x4E>(d_); d_ += dppi<0x141>(d_); d_ += dppi<0x140>(d_); \
                if (l16 == 0) hbuf[(Q_) * 4 + grp] = d_; } while (0)
            GA_ULOAD(0, 0, 0); GA_ULOAD(0, 1, 1);
            for (int q2 = 0; q2 < 128; q2 += 4) {
                GA_ULOAD(1, 0, q2 + 2); GA_ULOAD(1, 1, q2 + 3);
                __builtin_amdgcn_sched_barrier(0);
                GA_UDOT(0, 0, q2); GA_UDOT(0, 1, q2 + 1);
                __builtin_amdgcn_sched_barrier(0);
                if (q2 + 4 < 128) { GA_ULOAD(0, 0, q2 + 4); GA_ULOAD(0, 1, q2 + 5); }
                __builtin_amdgcn_sched_barrier(0);
                GA_UDOT(1, 0, q2 + 2); GA_UDOT(1, 1, q2 + 3);
                __builtin_amdgcn_sched_barrier(0);
            }
#undef GA_ULOAD
#undef GA_UDOT
            asm volatile("s_waitcnt lgkmcnt(0)" ::: "memory");
#pragma unroll 2
            for (int it = 0; it < 8; ++it) { const int p = it * 64 + lane;
                const unsigned e_ = ents[p]; const float g_ = *(const LAS float*)(wl + 2048 + p * 4); const int hs = hbuf[p];
                const int ex_ = (int)(e_ & (NEXP - 1)), tk_ = (int)(e_ >> 14) & 3;
                const float sxl = tk_ == 0 ? sx[0] : (tk_ == 1 ? sx[1] : (tk_ == 2 ? sx[2] : sx[3]));
                const float h_ = (float)hs * (SU[ex_] * sxl);
                act[p] = 0.5f * h_ * (1.f + erff(h_ * 0.70710678118654752f)) * g_ * SV[ex_]; }
        }
        asm volatile("s_waitcnt lgkmcnt(0)" ::: "memory");
        float y[4][16];
#pragma unroll
        for (int tk = 0; tk < 4; ++tk) {
#pragma unroll
            for (int i = 0; i < 16; ++i) y[tk][i] = 0.f; }
#define GA_AXPY(V, A, TK) do { \
            _Pragma("unroll") for (int q_ = 0; q_ < 4; ++q_) { const int w_ = (int)(V)[q_]; const f32x2 lo_ = __builtin_amdgcn_cvt_pk_f32_fp8(w_, false), hi_ = __builtin_amdgcn_cvt_pk_f32_fp8(w_, true); \
                y[TK][4 * q_] += (A) * lo_.x; y[TK][4 * q_ + 1] += (A) * lo_.y; y[TK][4 * q_ + 2] += (A) * hi_.x; y[TK][4 * q_ + 3] += (A) * hi_.y; } } while (0)
        for (int ch = 0; ch < 8; ++ch) {
            const unsigned ent = *(const LAS unsigned*)(wl + (ch * 64 + lane) * 4);
            const float areg = act[ch * 64 + lane];
            v4u vb[2][8]; int eb[2][8];
#pragma unroll
            for (int q = 0; q < 8; ++q) { eb[0][q] = __builtin_amdgcn_readlane((int)ent, q); vb[0][q] = *(const GAS v4u*)(VQ + (size_t)(eb[0][q] & (NEXP - 1)) * DM + lane * 16); }
#pragma unroll
            for (int jb = 0; jb < 8; ++jb) {
                if (jb + 1 < 8) {
#pragma unroll
                    for (int q = 0; q < 8; ++q) { eb[(jb + 1) & 1][q] = __builtin_amdgcn_readlane((int)ent, 8 * (jb + 1) + q); vb[(jb + 1) & 1][q] = *(const GAS v4u*)(VQ + (size_t)(eb[(jb + 1) & 1][q] & (NEXP - 1)) * DM + lane * 16); } }
                __builtin_amdgcn_sched_barrier(0);
#pragma unroll
                for (int q = 0; q < 8; ++q) { const int tk_ = (eb[jb & 1][q] >> 14) & 3; const v4u v_ = vb[jb & 1][q]; const float a_ = rdlane(areg, 8 * jb + q);
                    if (tk_ == 0) GA_AXPY(v_, a_, 0); else if (tk_ == 1) GA_AXPY(v_, a_, 1); else if (tk_ == 2) GA_AXPY(v_, a_, 2); else GA_AXPY(v_, a_, 3); }
                __builtin_amdgcn_sched_barrier(0);
            }
        }
#undef GA_AXPY
#pragma unroll
        for (int tk = 0; tk < 4; ++tk) {
            float* hrow = F.out + (size_t)(4 * tg + tk) * DM + lane * 16;
            float hv[16]; float ss = 0.f;
#pragma unroll
            for (int q = 0; q < 4; ++q) { const f32x4 h4 = *(const GAS f32x4*)(hrow + 4 * q);
#pragma unroll
                for (int i = 0; i < 4; ++i) { const float v = h4[i] + y[tk][4 * q + i]; hv[4 * q + i] = v; ss += v * v; } }
            const float rstd = frsq(wave_sum(ss) * (1.f / DM) + RMS_EPS);
#pragma unroll
            for (int q = 0; q < 4; ++q) { const f32x4 n4 = *(const GAS f32x4*)(nf + lane * 16 + 4 * q);
                *(GAS f32x4*)(outp + (size_t)(4 * tg + tk) * DM + lane * 16 + 4 * q) = (f32x4){hv[4 * q] * rstd * n4[0], hv[4 * q + 1] * rstd * n4[1], hv[4 * q + 2] * rstd * n4[2], hv[4 * q + 3] * rstd * n4[3]}; }
        }
    }
}

struct Args { const float* in[21]; float* out; unsigned char* ws; int ph_lo, ph_hi; };
static_assert(sizeof(Args) == 21 * 8 + 8 + 8 + 8, "Args has no padding");

__global__ void __launch_bounds__(NTHREADS, 2) fwd_kernel(Args args) {
    extern __shared__ __attribute__((aligned(16))) unsigned char lds[];
    Frame F;
    F.lds = (LAS unsigned char*)lds;
    F.MISC = (volatile LAS unsigned*)(F.lds + MISC_OFF);
    F.tid = threadIdx.x; F.lane = F.tid & 63; F.wave = __builtin_amdgcn_readfirstlane(F.tid >> 6);
    F.G = gridDim.x; F.wg = blockIdx.x;
#pragma unroll
    for (int i = 0; i < 21; ++i) F.in[i] = args.in[i];
    F.out = args.out; F.ws = args.ws;
    F.ctl = (gu32*)(args.ws + WS_CTL);
    for (int u = F.tid; u < (LDS_BYTES - LDSCTL_OFF) / 4; u += NTHREADS) ((LAS unsigned*)(F.lds + LDSCTL_OFF))[u] = 0u;
    __syncthreads();
    const int lo = args.ph_lo, hi = args.ph_hi;
    const bool fused = (hi - lo) > 1;
    XcdBarrier bar; bar.bar = (unsigned*)(F.ctl + CW_BAR); bar.x = 0; bar.st = nullptr;
    if (fused) bar = xcd_barrier_post((unsigned*)(F.ctl + CW_BAR), F.MISC + 8);
#define IN(k) (lo <= (k) && (k) < hi)
#define REPS(k) (((REP_MASK >> (k)) & 1) ? 2 : 1)
#define REPLOOP(k) for (int rep_ = 0; rep_ < REPS(k); ++rep_, (rep_ < REPS(k) ? xcd_barrier(bar) : (void)0))
#define SEAM(k) do { if (IN(k) && IN((k) + 1)) xcd_barrier(bar); } while (0)

    if (IN(0)) { REPLOOP(0) { p0_prologue(F); p0_rope_table(F); } SEAM(0); }
    if (IN(1)) { REPLOOP(1) {
        pg8::Gemm g{(const bf16*)(F.ws + WS_XN), (const bf16*)(F.ws + WS_WIN), T, IN_COLS, DM}; pg8::StaticOrder S; S.init(T, IN_COLS, F.G, F.wg);
        pg8::EpiBf16 E{(bf16*)(F.ws + WS_Z), IN_COLS};
        pg8::gemm_phase<pg8::EpiBf16, pg8::StaticOrder, true, true>(F.lds + RING_OFF, g, S, E); }
        {
            const int nwg = (T / 256) * (IN_COLS / 256), rem = nwg % F.G;
            if (rem == 0) quantize_tables(F, F.wg * NWAVES + F.wave, F.G * NWAVES);
            else if (F.wg >= rem) quantize_tables(F, (F.wg - rem) * NWAVES + F.wave, (F.G - rem) * NWAVES);
        }
        SEAM(1);
    }
    if (IN(2)) { p2_rope(F); REPLOOP(2) { const int cnt = r13_count(F.wg, F.G); R1Pre P;
            if (cnt > 0) rwkv_r1_prefetch(F, r13_item(F.wg, F.G, 0), F.tid, P);
            bf16x8 bfr[4]; int hcur = -1;
            f32x4 cst[4];
            { const int n16 = F.lane & 15, g = F.lane >> 4;
#pragma unroll
              for (int rt = 0; rt < 4; ++rt)
#pragma unroll
                  for (int q = 0; q < 4; ++q) cst[rt][q] = (F.wave < 4 && 16 * rt + 4 * g + q == 16 * F.wave + n16) ? 1.f : 0.f; }
            for (int i = 0; i < cnt; ++i) { const int it = r13_item(F.wg, F.G, i), hh_ = (it >> 7) & 7;
                if (hh_ != hcur) { r1_load_bfrag(F, hh_, F.wave, F.lane, bfr); __syncthreads(); r1_load_params(F, hh_); __syncthreads(); hcur = hh_; }
                rwkv_r1_item(F, it, i + 1 < cnt ? r13_item(F.wg, F.G, i + 1) : -1, P, bfr, cst); }
            { const int n16 = F.lane & 15, g = F.lane >> 4; float* Pg = (float*)(F.ws + WS_PQ) + (size_t)F.wg * 4096; float* Qg = Pg + (size_t)256 * 4096;
              if (F.wave < 4) {
#pragma unroll
                  for (int rt = 0; rt < 4; ++rt)
#pragma unroll
                      for (int q = 0; q < 4; ++q) Pg[(16 * rt + 4 * g + q) * 64 + 16 * F.wave + n16] = cst[rt][q];
              } else {
#pragma unroll
                  for (int rt = 0; rt < 4; ++rt) *(GAS f32x4*)(Qg + (16 * (F.wave - 4) + n16) * 64 + 16 * rt + 4 * g) = cst[rt];
              } } }
        SEAM(2); }
    if (IN(3)) { REPLOOP(3) p3_mixers(F); }
    if (IN(4)) { REPLOOP(4) { const int cnt = r13_count(F.wg, F.G); R3Pre P;
            asm volatile("s_waitcnt vmcnt(0)" ::: "memory");
            __syncthreads();
            if (F.tid == 0) { unsigned* fl = (unsigned*)F.ctl + CW_SCAN + 16 * (F.wg >> 3); XB_SPIN(xb_ld(fl) == 0u, (unsigned*)(F.ctl + CW_BAR)); __builtin_amdgcn_fence(__ATOMIC_ACQUIRE, "agent"); }
            __syncthreads();
            {
                const int item0 = r13_item(F.wg, F.G, 0);
                rwkv_scan<15, 7>(F, F.out + (size_t)item0 * 4096, F.out + (size_t)T * RWW + (size_t)item0 * 4096, (float*)(F.ws + WS_RWSS) + (size_t)item0 * 4096, (const float*)(F.ws + WS_SSEG) + (size_t)F.wg * 4096);
                asm volatile("s_waitcnt vmcnt(0)" ::: "memory"); __syncthreads();
            }
            if (cnt > 0) rwkv_r3_prefetch(F, r13_item(F.wg, F.G, 0), F.tid, P);
            bf16x8 bfr[8]; int hcur = -1;
            for (int i = 0; i < cnt; ++i) { const int it = r13_item(F.wg, F.G, i), hh_ = (it >> 7) & 7;
                if (hh_ != hcur) { r3_load_bfrag(F, hh_, F.wave, F.lane, bfr); __syncthreads(); r3_load_params(F, hh_); __syncthreads(); hcur = hh_; }
                rwkv_r3_item(F, it, i + 1 < cnt ? r13_item(F.wg, F.G, i + 1) : -1, P, bfr); } }
        SEAM(4); }
    if (IN(5)) {
        pg8::Gemm g{(const bf16*)(F.ws + WS_YMIX), (const bf16*)(F.ws + WS_WOUT), T, DM, DM}; pg8::StaticOrder S; S.init(T, DM, F.G, F.wg);
        pg8::EpiF32Res E{F.in[0], F.out, DM, (bf16*)(F.ws + WS_XN), F.in[15], (float*)(F.ws + WS_SSQ)};
        pg8::gemm_phase<pg8::EpiF32Res, pg8::StaticOrder, true, true>(F.lds + RING_OFF, g, S, E);
        SEAM(5);
    }
    if (IN(6)) { REPLOOP(6) {
        pg8::Gemm g{(const bf16*)(F.ws + WS_XN), (const bf16*)(F.ws + WS_WQ), T, PQ, DM}; pg8::StaticOrder S; S.init(T, PQ, F.G, F.wg);
        pg8::EpiBf16Rs E{(bf16*)(F.ws + WS_QP), PQ, (const float*)(F.ws + WS_SSQ)};
        pg8::gemm_phase<pg8::EpiBf16Rs, pg8::StaticOrder, true, true>(F.lds + RING_OFF, g, S, E); }
        SEAM(6);
    }
    if (IN(7)) { REPLOOP(7) p7_topk(F); if (IN(8)) { asm volatile("s_waitcnt vmcnt(0)" ::: "memory"); __syncthreads(); } }
    if (IN(8)) { if (REPS(8) > 1) { p8_gather(F, (float*)(F.ws + WS_Z)); xcd_barrier(bar); } p8_gather(F, F.out); }
#undef IN
#undef SEAM
}

extern "C" void kernel_launch(void* const* d_in, const int* in_sizes, int n_in, void* d_out, int out_size, void* d_ws, size_t ws_size, hipStream_t stream) {
    static int grid = 0;
    if (grid == 0) {
        if (n_in != 21 || in_sizes[0] != T * DM || out_size != T * DM || ws_size < WS_END) {
            fprintf(stderr, "kernel_launch: unexpected shapes: n_in %d in0 %d out %d ws %zu (need %zu); nothing launched\n", n_in, n_in > 0 ? in_sizes[0] : -1, out_size, ws_size, (size_t)WS_END); grid = -1; return; }
        int dev = 0, cus = 0, per_cu = 0;
        if (hipGetDevice(&dev) != hipSuccess || hipDeviceGetAttribute(&cus, hipDeviceAttributeMultiprocessorCount, dev) != hipSuccess) { grid = -1; return; }
        if (hipFuncSetAttribute((const void*)fwd_kernel, hipFuncAttributeMaxDynamicSharedMemorySize, LDS_BYTES) != hipSuccess) { fprintf(stderr, "kernel_launch: hipFuncSetAttribute failed\n"); grid = -1; return; }
        if (hipOccupancyMaxActiveBlocksPerMultiprocessor(&per_cu, (const void*)fwd_kernel, NTHREADS, LDS_BYTES) != hipSuccess || per_cu < 1) { fprintf(stderr, "kernel_launch: occupancy query says %d\n", per_cu); per_cu = 1; }
        (void)hipGetLastError();
        grid = cus;
        if (cus != 256) { fprintf(stderr, "kernel_launch: the RWKV segment mapping assumes 256 CUs (got %d); nothing launched\n", cus); grid = -1; return; }
    }
    if (grid < 0) return;
    (void)hipMemsetAsync((char*)d_ws + WS_CTL, 0, CTL_ZERO_BYTES, stream);
    Args a{};
    for (int i = 0; i < 21; ++i) a.in[i] = (const float*)d_in[i];
    a.out = (float*)d_out; a.ws = (unsigned char*)d_ws;
    if (MK_N_LAUNCHES == 1) {
        a.ph_lo = 0; a.ph_hi = NPHASE;
        void* kargs[] = {&a};
        hipError_t e = hipLaunchCooperativeKernel((const void*)fwd_kernel, dim3(grid), dim3(NTHREADS), kargs, LDS_BYTES, stream);
        if (e != hipSuccess) fprintf(stderr, "kernel_launch: cooperative launch failed: %s (grid %d)\n", hipGetErrorString(e), grid);
    } else {
        for (int p = 0; p < NPHASE; ++p) { a.ph_lo = p; a.ph_hi = p + 1;
            hipLaunchKernelGGL(fwd_kernel, dim3(grid), dim3(NTHREADS), LDS_BYTES, stream, a); }
    }
}
```

```cpp
#include <hip/hip_runtime.h>
#include <cstdio>
#include <cstdint>

#ifndef MK_N_LAUNCHES
#define MK_N_LAUNCHES 1
#endif

#ifndef REP_MASK
#define REP_MASK 0
#endif
#define GAS __attribute__((address_space(1)))
#define LAS __attribute__((address_space(3)))
typedef unsigned short bf16;
typedef unsigned v4u __attribute__((ext_vector_type(4)));
typedef unsigned v2u __attribute__((ext_vector_type(2)));
typedef float f32x4 __attribute__((ext_vector_type(4)));
typedef float f32x2 __attribute__((ext_vector_type(2)));
typedef short bf16x8 __attribute__((ext_vector_type(8)));
typedef GAS unsigned gu32;
#define RLX_AGENT __ATOMIC_RELAXED, __HIP_MEMORY_SCOPE_AGENT
#define LDS_WAIT() asm volatile("s_waitcnt lgkmcnt(0)" ::: "memory")
#define VM_WAIT() asm volatile("s_waitcnt vmcnt(0)" ::: "memory")
#define LDS_BARRIER() do { asm volatile("s_waitcnt lgkmcnt(0)" ::: "memory"); __builtin_amdgcn_s_barrier(); asm volatile("" ::: "memory"); } while (0)

constexpr int DM = 1024, NB = 4, SEQ = 8192, T = NB * SEQ;
constexpr int HD = 64, RWW = 512, NHR = 8, NHA = 8;
constexpr int IN_COLS = 3328;
constexpr int C_R = 0, C_K = 512, C_V = 1024, C_WD = 1536, C_AD = 1600, C_GD = 1664, C_AQ = 1792, C_AK = 2304, C_AV = 2816;
constexpr int PHEADS = 8, NKEYS = 128, PQ = 2048, TOPK = 16, NEXP = 16384;
constexpr float RMS_EPS = 1e-6f, GN_EPS = 64e-5f;
constexpr int NWAVES = 8, NTHREADS = 512;
constexpr int NPHASE = 9;

constexpr size_t MiB = 1u << 20;
constexpr size_t WS_CTL = 0, CTL_ZERO_BYTES = 1 * MiB;
constexpr size_t WS_WIN = 2 * MiB;
constexpr size_t WS_WOUT = 10 * MiB;
constexpr size_t WS_WQ = 12 * MiB;
constexpr size_t WS_XN = 16 * MiB;
constexpr size_t WS_Z = 80 * MiB;
constexpr size_t WS_QP = 80 * MiB;
constexpr size_t WS_G = 288 * MiB;
constexpr size_t WS_YMIX = 352 * MiB;
constexpr size_t WS_UQ = 416 * MiB;
constexpr size_t WS_VQ = 432 * MiB;
constexpr size_t WS_SU = 448 * MiB;
constexpr size_t WS_SV = 449 * MiB;
constexpr size_t WS_EID = 480 * MiB;
constexpr size_t WS_GATE = 496 * MiB;
constexpr size_t WS_SSEG = 450 * MiB;
constexpr size_t WS_PQ = 456 * MiB;
constexpr size_t WS_END = 512 * MiB;
constexpr size_t WS_WUPT = 1 * MiB, WS_AUPT = WS_WUPT + 65536, WS_GUPT = WS_AUPT + 65536;
constexpr size_t WS_BONUS = 9 * MiB;
constexpr size_t WS_RWY0 = WS_XN;
constexpr size_t WS_RWSS = WS_G;
constexpr size_t WS_RWRH = WS_EID;

constexpr int CW_BAR = 4096;
constexpr int CW_SCAN = 16384;
constexpr size_t WS_SSQ = 256 * 1024;

typedef __bf16 hbf16x2_t __attribute__((ext_vector_type(2)));
__device__ __forceinline__ unsigned pk2(float lo, float hi) { const f32x2 v = {lo, hi}; const hbf16x2_t b = __builtin_convertvector(v, hbf16x2_t); return __builtin_bit_cast(unsigned, b); }
__device__ __forceinline__ unsigned f2bf(float f) { return pk2(f, 0.f) & 0xffffu; }
__device__ __forceinline__ float frcp(float x) { return __builtin_amdgcn_rcpf(x); }
__device__ __forceinline__ float frsq(float x) { return __builtin_amdgcn_rsqf(x); }
__device__ __forceinline__ float bflo(unsigned u) { return __builtin_bit_cast(float, u << 16); }
__device__ __forceinline__ float bfhi(unsigned u) { return __builtin_bit_cast(float, u & 0xffff0000u); }
__device__ __forceinline__ float bf2f(bf16 h) { return __builtin_bit_cast(float, (unsigned)h << 16); }

template <int CTRL> __device__ __forceinline__ float dppf(float x) { return __builtin_bit_cast(float, __builtin_amdgcn_update_dpp(0, __builtin_bit_cast(int, x), CTRL, 0xF, 0xF, true)); }
template <int CTRL> __device__ __forceinline__ int dppi(int x) { return __builtin_amdgcn_update_dpp(0, x, CTRL, 0xF, 0xF, true); }
__device__ __forceinline__ float rdlane(float v, int l) { return __builtin_bit_cast(float, __builtin_amdgcn_readlane(__builtin_bit_cast(int, v), l)); }
__device__ __forceinline__ float sum8(float v) { v += dppf<0xB1>(v); v += dppf<0x4E>(v); v += dppf<0x141>(v); return v; }
__device__ __forceinline__ float sum16(float v) { v = sum8(v); v += dppf<0x140>(v); return v; }
__device__ __forceinline__ float wave_sum(float v) { v = sum16(v);
    v += __builtin_bit_cast(float, __builtin_amdgcn_update_dpp(0, __builtin_bit_cast(int, v), 0x142, 0xA, 0xF, false));
    v += __builtin_bit_cast(float, __builtin_amdgcn_update_dpp(0, __builtin_bit_cast(int, v), 0x143, 0xC, 0xF, false));
    return rdlane(v, 63); }
__device__ __forceinline__ float wave_max(float v) {
    v = fmaxf(v, dppf<0xB1>(v)); v = fmaxf(v, dppf<0x4E>(v)); v = fmaxf(v, dppf<0x141>(v)); v = fmaxf(v, dppf<0x140>(v));
    return fmaxf(fmaxf(rdlane(v, 0), rdlane(v, 16)), fmaxf(rdlane(v, 32), rdlane(v, 48)));
}

namespace pg8 {
#define PG8_LAS __attribute__((address_space(3)))
typedef unsigned short bf16_t;
typedef unsigned u32x4 __attribute__((ext_vector_type(4)));
constexpr int BM = 256, BK = 64, HALF = 128, HTB = HALF * BK * 2, STAGE_BYTES = 8 * HTB, NXCD = 8, WGM = 8;
__host__ __device__ __forceinline__ int lds_byte(int r, int c) { const int st = (r >> 4) * 2 + (c >> 5), rr = r & 15, cc = c & 31, ob = rr * 64 + cc * 2; return st * 1024 + (ob ^ (((ob >> 9) & 1) << 5)); }
__host__ __device__ __forceinline__ void stage_rc(int b, int& R, int& C) { const int st = b / 1024, sb = b % 1024, swz = sb ^ (((sb >> 9) & 1) << 5); R = (st >> 1) * 16 + swz / 64; C = (st & 1) * 32 + (swz % 64) / 2; }
__host__ __device__ __forceinline__ int perm32(int rho) { const int n = rho >> 4, i = rho & 15; return 8 * (i >> 2) + 4 * n + (i & 3); }
struct Unit { int pm, pn; };
struct Gemm { const bf16_t* A; const bf16_t* Bt; int M, N, K; };
struct StaticOrder {
    int nM, nN, nwg, G, c;
    __host__ __device__ void init(int M, int N, int G_, int c_) { nM = M / BM; nN = N / BM; nwg = nM * nN; G = G_; c = c_; }
    __host__ __device__ bool next(int i, Unit& u) const {
        const long L = (long)i * G + c; if (L >= nwg) return false;
        int wgid = (int)L; { const int q = nwg / NXCD, r = nwg % NXCD, xcd = wgid % NXCD, off = wgid / NXCD; wgid = (xcd < r ? xcd * (q + 1) : r * (q + 1) + (xcd - r) * q) + off; }
        const int nig = WGM * nN, gid = wgid / nig, fm = gid * WGM, gsz = (nM - fm) < WGM ? (nM - fm) : WGM;
        u.pm = fm + ((wgid % nig) % gsz); u.pn = (wgid % nig) / gsz; return true;
    }
    __device__ __forceinline__ void a_ready(const Unit&) const {}
    __device__ __forceinline__ void done(const Unit&) const {}
};
__device__ __forceinline__ unsigned cvt_pk_bf16(float lo, float hi) { unsigned r; asm volatile("v_cvt_pk_bf16_f32 %0, %1, %2" : "=v"(r) : "v"(lo), "v"(hi)); return r; }
struct EpiBf16 {
    static constexpr bool PERM = true, AFTER_DRAIN = false;
    bf16_t* O; int ldc;
    __device__ __forceinline__ void operator()(const f32x4 (&acc)[2][2][4][2], const Unit& u, int wr, int wc, int fr, int fq) const {
        const int row0 = u.pm * BM + wr * 64 + fr; const int col0 = u.pn * BM + wc * 32 + 8 * fq;
#pragma unroll
        for (int ai = 0; ai < 2; ++ai)
#pragma unroll
            for (int m = 0; m < 4; ++m) { bf16_t* rowp = O + (size_t)(row0 + ai * HALF + m * 16) * ldc + col0;
#pragma unroll
                for (int bj = 0; bj < 2; ++bj) { const f32x4 v0 = acc[ai][bj][m][0], v1 = acc[ai][bj][m][1];
                    u32x4 w; w.x = cvt_pk_bf16(v0[0], v0[1]); w.y = cvt_pk_bf16(v0[2], v0[3]); w.z = cvt_pk_bf16(v1[0], v1[1]); w.w = cvt_pk_bf16(v1[2], v1[3]);
                    *(u32x4*)(rowp + bj * HALF) = w; } }
    }
};
struct EpiF32Res {
    static constexpr bool PERM = true, AFTER_DRAIN = false;
    const float* res; float* O; int ldc; bf16_t* HG; const float* gain; float* ssq;
    __device__ __forceinline__ void operator()(const f32x4 (&acc)[2][2][4][2], const Unit& u, int wr, int wc, int fr, int fq) const {
        const int row0 = u.pm * BM + wr * 64 + fr; const int col0 = u.pn * BM + wc * 32 + 8 * fq;
        f32x4 gv[2][2];
#pragma unroll
        for (int bj = 0; bj < 2; ++bj) { gv[bj][0] = *(const f32x4*)(gain + col0 + bj * HALF); gv[bj][1] = *(const f32x4*)(gain + col0 + bj * HALF + 4); }
#pragma unroll
        for (int ai = 0; ai < 2; ++ai)
#pragma unroll
            for (int m = 0; m < 4; ++m) { const int row = row0 + ai * HALF + m * 16; const size_t off = (size_t)row * ldc + col0; float sq = 0.f;
#pragma unroll
                for (int bj = 0; bj < 2; ++bj) { const f32x4 r0 = *(const f32x4*)(res + off + bj * HALF), r1 = *(const f32x4*)(res + off + bj * HALF + 4);
                    const f32x4 h0 = acc[ai][bj][m][0] + r0, h1 = acc[ai][bj][m][1] + r1;
                    *(f32x4*)(O + off + bj * HALF) = h0; *(f32x4*)(O + off + bj * HALF + 4) = h1;
                    sq += (h0[0] * h0[0] + h0[1] * h0[1]) + (h0[2] * h0[2] + h0[3] * h0[3]) + (h1[0] * h1[0] + h1[1] * h1[1]) + (h1[2] * h1[2] + h1[3] * h1[3]);
                    const f32x4 g0 = gv[bj][0], g1 = gv[bj][1];
                    u32x4 w; w.x = cvt_pk_bf16(h0[0] * g0[0], h0[1] * g0[1]); w.y = cvt_pk_bf16(h0[2] * g0[2], h0[3] * g0[3]); w.z = cvt_pk_bf16(h1[0] * g1[0], h1[1] * g1[1]); w.w = cvt_pk_bf16(h1[2] * g1[2], h1[3] * g1[3]);
                    *(u32x4*)(HG + off + bj * HALF) = w; }
                sq += __shfl_xor(sq, 16); sq += __shfl_xor(sq, 32);
                if (fq == 0) atomicAdd(ssq + row, sq); }
    }
};
struct EpiBf16Rs {
    static constexpr bool PERM = true, AFTER_DRAIN = false;
    bf16_t* O; int ldc; const float* ssq;
    __device__ __forceinline__ void operator()(const f32x4 (&acc)[2][2][4][2], const Unit& u, int wr, int wc, int fr, int fq) const {
        const int row0 = u.pm * BM + wr * 64 + fr; const int col0 = u.pn * BM + wc * 32 + 8 * fq;
#pragma unroll
        for (int ai = 0; ai < 2; ++ai)
#pragma unroll
            for (int m = 0; m < 4; ++m) { const int row = row0 + ai * HALF + m * 16; bf16_t* rowp = O + (size_t)row * ldc + col0;
                const float rs = __builtin_amdgcn_rsqf(ssq[row] * (1.f / 1024.f) + 1e-6f);
#pragma unroll
                for (int bj = 0; bj < 2; ++bj) { const f32x4 v0 = acc[ai][bj][m][0] * rs, v1 = acc[ai][bj][m][1] * rs;
                    u32x4 w; w.x = cvt_pk_bf16(v0[0], v0[1]); w.y = cvt_pk_bf16(v0[2], v0[3]); w.z = cvt_pk_bf16(v1[0], v1[1]); w.w = cvt_pk_bf16(v1[2], v1[3]);
                    *(u32x4*)(rowp + bj * HALF) = w; } }
    }
};

template <class Epi, class Sched, bool ALIGN_EPI = false, bool SP2 = false>
__device__ __forceinline__ void gemm_phase(PG8_LAS unsigned char* lds, const Gemm g, const Sched& S, const Epi& E) {
    const int tid = threadIdx.x, wid = __builtin_amdgcn_readfirstlane(tid >> 6), lane = tid & 63, wr = wid >> 2, wc = wid & 3, fr = lane & 15, fq = lane >> 4;
    const int K = g.K, nt = K / BK;
    unsigned voffA[2], voffB[2];
#pragma unroll
    for (int i = 0; i < 2; ++i) { int R, C; stage_rc(tid * 16 + i * 8192, R, C); const int Rb = Epi::PERM ? ((R & ~31) + perm32(R & 31)) : R;
        voffA[i] = (unsigned)(R * K + C) * 2u; voffB[i] = (unsigned)(Rb * K + C) * 2u; }
    const size_t kstep = (size_t)(BK * 2);
    const size_t hstep = (size_t)HALF * K * 2;
    const size_t tstep = 2 * hstep;
    const unsigned ldsw = (unsigned)wid * 1024u;
    const int aoff = lds_byte(wr * 64 + fr, fq * 8), boff = lds_byte(wc * 32 + fr, fq * 8);
#define PG8_SA(b, h) (((b) * 2 + (h)) * HTB)
#define PG8_SB(b, h) ((4 + (b) * 2 + (h)) * HTB)
#define PG8_STAGE(bufoff, gbase, voff) do { _Pragma("unroll") for (int _i = 0; _i < 2; ++_i) \
        __builtin_amdgcn_global_load_lds((const unsigned*)((const char*)(gbase) + (voff)[_i]), (PG8_LAS unsigned*)(lds + (bufoff) + ldsw + _i * 8192), 16, 0, 0); } while (0)
#define PG8_LDA(dst, b, h) do { _Pragma("unroll") for (int m = 0; m < 4; ++m) _Pragma("unroll") for (int k = 0; k < 2; ++k) dst[m][k] = *(const PG8_LAS bf16x8*)(lds + PG8_SA(b, h) + aoff + m * 2048 + k * 1024); } while (0)
#define PG8_LDB(dst, b, h) do { _Pragma("unroll") for (int n = 0; n < 2; ++n) _Pragma("unroll") for (int k = 0; k < 2; ++k) dst[n][k] = *(const PG8_LAS bf16x8*)(lds + PG8_SB(b, h) + boff + n * 2048 + k * 1024); } while (0)
#define PG8_MMA(ai, bj, At, Bt) do { __builtin_amdgcn_s_setprio(1); _Pragma("unroll") for (int m = 0; m < 4; ++m) _Pragma("unroll") for (int n = 0; n < 2; ++n) _Pragma("unroll") for (int k = 0; k < 2; ++k) \
        acc[ai][bj][m][n] = __builtin_amdgcn_mfma_f32_16x16x32_bf16(Bt[n][k], At[m][k], acc[ai][bj][m][n], 0, 0, 0); __builtin_amdgcn_s_setprio(0); } while (0)
#define PG8_WAIT_V(n) asm volatile("s_waitcnt vmcnt(" #n ")" ::: "memory")
#define PG8_WAIT_L(n) asm volatile("s_waitcnt lgkmcnt(" #n ")" ::: "memory")
#define PG8_BAR __builtin_amdgcn_s_barrier()
#define PG8_SCHED __builtin_amdgcn_sched_barrier(0)
    Unit cur, nxt; int ui = 0;
    if (!S.next(0, cur)) return;
    f32x4 acc[2][2][4][2];
#pragma unroll
    for (int a = 0; a < 2; ++a)
#pragma unroll
        for (int b = 0; b < 2; ++b)
#pragma unroll
            for (int m = 0; m < 4; ++m)
#pragma unroll
                for (int n = 0; n < 2; ++n) acc[a][b][m][n] = (f32x4){0.f, 0.f, 0.f, 0.f};
    bf16x8 At[4][2], B0[2][2], B1[2][2];
    const char* cA = (const char*)g.A + (size_t)cur.pm * tstep; const char* cB = (const char*)g.Bt + (size_t)cur.pn * tstep;
    S.a_ready(cur);
    if constexpr (SP2) {
        PG8_STAGE(PG8_SB(0, 0), cB, voffB); PG8_STAGE(PG8_SB(0, 1), cB + hstep, voffB); PG8_STAGE(PG8_SA(0, 0), cA, voffA); PG8_STAGE(PG8_SA(0, 1), cA + hstep, voffA);
        if (wr == 1) PG8_BAR;
        PG8_WAIT_V(2); PG8_BAR;
        PG8_STAGE(PG8_SB(1, 0), cB + kstep, voffB); PG8_STAGE(PG8_SA(1, 0), cA + kstep, voffA); PG8_STAGE(PG8_SB(1, 1), cB + hstep + kstep, voffB);
        PG8_WAIT_V(6); PG8_BAR;
    } else {
        PG8_STAGE(PG8_SB(0, 0), cB, voffB); PG8_STAGE(PG8_SA(0, 0), cA, voffA); PG8_STAGE(PG8_SB(0, 1), cB + hstep, voffB); PG8_STAGE(PG8_SA(0, 1), cA + hstep, voffA);
        if (wr == 1) PG8_BAR;
        PG8_WAIT_V(4); PG8_BAR;
        PG8_STAGE(PG8_SB(1, 0), cB + kstep, voffB); PG8_STAGE(PG8_SA(1, 0), cA + kstep, voffA); PG8_STAGE(PG8_SB(1, 1), cB + hstep + kstep, voffB);
        PG8_WAIT_V(6); PG8_BAR;
    }
    for (;;) {
        const bool has_next = S.next(ui + 1, nxt);
        const char* nA = has_next ? (const char*)g.A + (size_t)nxt.pm * tstep : cA; const char* nB = has_next ? (const char*)g.Bt + (size_t)nxt.pn * tstep : cB;
        for (int t = 0; t < nt; t += 2) {
            const bool last = (t == nt - 2);
            const char* a1 = cA + (size_t)(t + 1) * kstep;
            const char* a2 = last ? nA : cA + (size_t)(t + 2) * kstep; const char* b2 = last ? nB : cB + (size_t)(t + 2) * kstep;
            const char* a3 = a2 + kstep; const char* b3 = b2 + kstep;
            if (last && has_next) S.a_ready(nxt);
            if constexpr (SP2) {
            PG8_LDB(B0, 0, 0); PG8_LDB(B1, 0, 1); PG8_SCHED; PG8_LDA(At, 0, 0); PG8_STAGE(PG8_SA(1, 1), a1 + hstep, voffA);
            PG8_WAIT_V(8); PG8_WAIT_L(0); PG8_BAR; PG8_MMA(0, 0, At, B0); PG8_MMA(0, 1, At, B1); PG8_BAR; PG8_SCHED;
            PG8_LDA(At, 0, 1); PG8_STAGE(PG8_SB(0, 0), b2, voffB); PG8_STAGE(PG8_SB(0, 1), b2 + hstep, voffB); PG8_STAGE(PG8_SA(0, 0), a2, voffA);
            PG8_WAIT_V(8); PG8_WAIT_L(0); PG8_BAR; PG8_MMA(1, 0, At, B0); PG8_MMA(1, 1, At, B1); PG8_BAR; PG8_SCHED;
            PG8_LDB(B0, 1, 0); PG8_LDB(B1, 1, 1); PG8_SCHED; PG8_LDA(At, 1, 0); PG8_STAGE(PG8_SA(0, 1), a2 + hstep, voffA);
            PG8_WAIT_V(8); PG8_WAIT_L(0); PG8_BAR; PG8_MMA(0, 0, At, B0); PG8_MMA(0, 1, At, B1); PG8_BAR; PG8_SCHED;
            PG8_LDA(At, 1, 1); PG8_STAGE(PG8_SB(1, 0), b3, voffB); PG8_STAGE(PG8_SB(1, 1), b3 + hstep, voffB); PG8_STAGE(PG8_SA(1, 0), a3, voffA);
            PG8_WAIT_V(8); PG8_WAIT_L(0); PG8_BAR; PG8_MMA(1, 0, At, B0); PG8_MMA(1, 1, At, B1); PG8_BAR; PG8_SCHED;
            } else {
            PG8_LDB(B0, 0, 0); PG8_SCHED; PG8_LDA(At, 0, 0); PG8_STAGE(PG8_SA(1, 1), a1 + hstep, voffA);
            PG8_WAIT_L(8); PG8_BAR; PG8_WAIT_L(0); PG8_MMA(0, 0, At, B0); PG8_BAR; PG8_SCHED;
            PG8_LDB(B1, 0, 1); PG8_STAGE(PG8_SB(0, 0), b2, voffB);
            PG8_BAR; PG8_WAIT_L(0); PG8_MMA(0, 1, At, B1); PG8_BAR;
            PG8_LDA(At, 0, 1); PG8_STAGE(PG8_SA(0, 0), a2, voffA);
            PG8_BAR; PG8_WAIT_L(0); PG8_MMA(1, 0, At, B0); PG8_BAR; PG8_SCHED;
            PG8_STAGE(PG8_SB(0, 1), b2 + hstep, voffB);
            PG8_WAIT_V(6); PG8_BAR; PG8_MMA(1, 1, At, B1); PG8_BAR;
            PG8_LDB(B0, 1, 0); PG8_SCHED; PG8_LDA(At, 1, 0); PG8_STAGE(PG8_SA(0, 1), a2 + hstep, voffA);
            PG8_WAIT_L(8); PG8_BAR; PG8_WAIT_L(0); PG8_MMA(0, 0, At, B0); PG8_BAR; PG8_SCHED;
            PG8_LDB(B1, 1, 1); PG8_STAGE(PG8_SB(1, 0), b3, voffB);
            PG8_BAR; PG8_WAIT_L(0); PG8_MMA(0, 1, At, B1); PG8_BAR;
            PG8_LDA(At, 1, 1); PG8_STAGE(PG8_SA(1, 0), a3, voffA);
            PG8_BAR; PG8_WAIT_L(0); PG8_MMA(1, 0, At, B0); PG8_BAR; PG8_SCHED;
            PG8_STAGE(PG8_SB(1, 1), b3 + hstep, voffB);
            PG8_WAIT_V(6); PG8_BAR; PG8_MMA(1, 1, At, B1); PG8_BAR;
            }
        }
        if constexpr (ALIGN_EPI) { if (wr == 0) PG8_BAR; }
        if constexpr (!Epi::AFTER_DRAIN) { E(acc, cur, wr, wc, fr, fq); S.done(cur); }
        if (!has_next) break;
#pragma unroll
        for (int a = 0; a < 2; ++a)
#pragma unroll
            for (int b = 0; b < 2; ++b)
#pragma unroll
                for (int m = 0; m < 4; ++m)
#pragma unroll
                    for (int n = 0; n < 2; ++n) acc[a][b][m][n] = (f32x4){0.f, 0.f, 0.f, 0.f};
        cur = nxt; cA = nA; cB = nB; ++ui;
        if constexpr (ALIGN_EPI) { if (wr == 1) PG8_BAR; }
    }
    PG8_WAIT_V(0);
    if constexpr (!ALIGN_EPI) { if (wr == 0) PG8_BAR; }
    PG8_BAR;
#undef PG8_SA
#undef PG8_SB
#undef PG8_STAGE
#undef PG8_LDA
#undef PG8_LDB
#undef PG8_MMA
#undef PG8_WAIT_V
#undef PG8_WAIT_L
#undef PG8_BAR
#undef PG8_SCHED
}
}

#define XB_TMO      128
#define XB_XCNT(j)  (256  + 64 * (j))
#define XB_XSUB(j)  (1280 + 64 * (j))
#define XB_XGEN(j)  (2304 + 64 * (j))
#define XB_TOP      3328
#define XB_TOPGEN   3392
#define XCD_BAR_WORDS 3456
#define XB_SPIN_CAP (1u << 22)
__device__ __forceinline__ unsigned xb_ld(unsigned* p)              { return __hip_atomic_load(p, __ATOMIC_RELAXED, __HIP_MEMORY_SCOPE_AGENT); }
__device__ __forceinline__ unsigned xb_add(unsigned* p, unsigned v) { return __hip_atomic_fetch_add(p, v, __ATOMIC_RELAXED, __HIP_MEMORY_SCOPE_AGENT); }
__device__ __forceinline__ unsigned xb_xcc_id() { return (unsigned)__builtin_amdgcn_s_getreg((3 << 11) | 20) & 0xFu; }
#define XB_SPIN(cond, bar) do { unsigned _sp = 0; while (cond) { __builtin_amdgcn_s_sleep(1); \
    if ((++_sp & 255u) == 0u) { if (xb_ld(&(bar)[XB_TMO])) break; if (_sp > XB_SPIN_CAP) { atomicAdd(&(bar)[XB_TMO], 1u); break; } } } } while (0)
struct XcdBarrier { unsigned* bar; unsigned x; volatile LAS unsigned* st; };
__device__ __forceinline__ XcdBarrier xcd_barrier_post(unsigned* bar, volatile LAS unsigned* st) {
    XcdBarrier b; b.bar = bar; b.x = xb_xcc_id(); b.st = st;
    if (threadIdx.x == 0) (void)xb_add(&bar[XB_XCNT(b.x)], 1u);
    return b;
}
__device__ __forceinline__ void xcd_barrier_complete(unsigned* bar, unsigned x, unsigned& nloc, unsigned& nx) {
    const unsigned G = gridDim.x * gridDim.y * gridDim.z;
    unsigned sum, cnt, mine, sp = 0u;
    for (;;) {
        sum = 0u; cnt = 0u; mine = 0u;
#pragma unroll
        for (unsigned j = 0; j < 16; ++j) { const unsigned c = xb_ld(&bar[XB_XCNT(j)]); sum += c; cnt += (c > 0u) ? 1u : 0u; mine = (j == x) ? c : mine; }
        if (sum == G) break;
        __builtin_amdgcn_s_sleep(1);
        if ((++sp & 255u) == 0u) { if (xb_ld(&bar[XB_TMO])) break; if (sp > XB_SPIN_CAP) { atomicAdd(&bar[XB_TMO], 1u); break; } }
    }
    nloc = mine > 0u ? mine : 1u; nx = cnt > 0u ? cnt : 1u;
}
__device__ __forceinline__ void xcd_barrier(const XcdBarrier& b) {
    asm volatile("s_waitcnt vmcnt(0)" ::: "memory");
    __syncthreads();
    if (threadIdx.x == 0) {
        unsigned* bar = b.bar;
        __builtin_amdgcn_s_waitcnt(0);
        unsigned nloc = b.st[0], nx = b.st[1];
        if (nloc == 0u) { xcd_barrier_complete(bar, b.x, nloc, nx); b.st[0] = nloc; b.st[1] = nx; }
        const unsigned old = xb_add(&bar[XB_XSUB(b.x)], 1u);
        const unsigned gen = old / nloc;
        if (old + 1u == (gen + 1u) * nloc) {
            __builtin_amdgcn_fence(__ATOMIC_RELEASE, "agent");
            asm volatile("s_waitcnt vmcnt(0)" ::: "memory");
            const unsigned og = xb_add(&bar[XB_TOP], 1u);
            const unsigned tg = og / nx;
            if (og + 1u == (tg + 1u) * nx) xb_add(&bar[XB_TOPGEN], 1u);
            else XB_SPIN(xb_ld(&bar[XB_TOPGEN]) == tg, bar);
            __builtin_amdgcn_fence(__ATOMIC_ACQUIRE, "agent");
            xb_add(&bar[XB_XGEN(b.x)], 1u);
            asm volatile("s_waitcnt vmcnt(0)" ::: "memory");
        } else {
            XB_SPIN(xb_ld(&bar[XB_XGEN(b.x)]) == gen, bar);
            __builtin_amdgcn_fence(__ATOMIC_ACQUIRE, "agent");
            asm volatile("s_waitcnt vmcnt(0)" ::: "memory");
        }
    }
    __syncthreads();
}

constexpr int RING_OFF = 0, RING_BYTES = 131072;
constexpr int LDSCTL_OFF = 162816, MISC_OFF = LDSCTL_OFF + 320;
constexpr int LDS_BYTES = 163840;

struct Frame {
    LAS unsigned char* lds;
    volatile LAS unsigned* MISC;
    gu32* ctl;
    int tid, lane, wave, G, wg;
    const float* in[21];
    float* out;
    unsigned char* ws;
};

__device__ __forceinline__ void p0_transpose_item(const float* W, int K, int N, bf16* WT, LAS float* scr, int item, int lane) {
    const int nblk = N / 32, kb = item / nblk, nb = item % nblk, k0 = 64 * kb, n0 = 32 * nb;
#pragma unroll 8
    for (int i = 0; i < 32; ++i) { const int kk = 2 * i + (lane >> 5); scr[kk * 33 + (lane & 31)] = W[(size_t)(k0 + kk) * N + n0 + (lane & 31)]; }
    LDS_WAIT(); asm volatile("" ::: "memory");
    const int c = lane & 7;
#pragma unroll
    for (int j = 0; j < 4; ++j) { const int n = (lane >> 3) + 8 * j; const LAS float* s = scr + (8 * c) * 33 + n;
        v4u o; o.x = pk2(s[0 * 33], s[1 * 33]); o.y = pk2(s[2 * 33], s[3 * 33]); o.z = pk2(s[4 * 33], s[5 * 33]); o.w = pk2(s[6 * 33], s[7 * 33]);
        *(GAS v4u*)(WT + (size_t)(n0 + n) * K + k0 + 8 * c) = o; }
    LDS_WAIT(); asm volatile("" ::: "memory");
}
__device__ __forceinline__ void rms_row_to_bf16(int lane, const float* xrow, const float* gain, bf16* orow) {
    const GAS f32x4* xr = (const GAS f32x4*)xrow + lane;
    const GAS f32x4* gr = (const GAS f32x4*)gain + lane;
    f32x4 v[4]; float s = 0.f;
#pragma unroll
    for (int j = 0; j < 4; ++j) { v[j] = xr[64 * j]; s += (v[j].x * v[j].x + v[j].y * v[j].y) + (v[j].z * v[j].z + v[j].w * v[j].w); }
    const float rstd = frsq(wave_sum(s) * (1.f / DM) + RMS_EPS);
    GAS unsigned long long* o8 = (GAS unsigned long long*)orow + lane;
#pragma unroll
    for (int j = 0; j < 4; ++j) { const f32x4 gg = gr[64 * j];
        o8[64 * j] = (unsigned long long)pk2(v[j].x * rstd * gg.x, v[j].y * rstd * gg.y) | ((unsigned long long)pk2(v[j].z * rstd * gg.z, v[j].w * rstd * gg.w) << 32); }
}
__device__ __forceinline__ void quantize_tables(Frame& F, int gw, int ngw);
__device__ __forceinline__ void p0_prologue(Frame& F) {
    LAS float* scr = (LAS float*)(F.lds + RING_OFF + F.wave * 16384);
    const int gw = F.wg * NWAVES + F.wave, NGW = F.G * NWAVES;
    constexpr int I_IN = (DM / 64) * (IN_COLS / 32), I_OUT = (DM / 64) * (DM / 32), I_Q = (DM / 64) * (PQ / 32);
    constexpr int NITEMS = I_IN + I_OUT + I_Q;
    bf16* win_t = (bf16*)(F.ws + WS_WIN); bf16* wout_t = (bf16*)(F.ws + WS_WOUT); bf16* wq_t = (bf16*)(F.ws + WS_WQ);
    for (int it = gw; it < NITEMS; it += NGW) {
        int r = it;
        if (r < I_IN) { p0_transpose_item(F.in[2], DM, IN_COLS, win_t, scr, r, F.lane); continue; } r -= I_IN;
        if (r < I_OUT) { p0_transpose_item(F.in[14], DM, DM, wout_t, scr, r, F.lane); continue; } r -= I_OUT;
        p0_transpose_item(F.in[16], DM, PQ, wq_t, scr, r, F.lane);
    }
    {
        constexpr int I_W = (64 / 64) * (RWW / 32), I_G = (128 / 64) * (RWW / 32);
        for (int it = gw; it < 2 * I_W + I_G; it += NGW) {
            int r = it;
            if (r < I_W) { p0_transpose_item(F.in[5], 64, RWW, (bf16*)(F.ws + WS_WUPT), scr, r, F.lane); continue; } r -= I_W;
            if (r < I_W) { p0_transpose_item(F.in[7], 64, RWW, (bf16*)(F.ws + WS_AUPT), scr, r, F.lane); continue; } r -= I_W;
            p0_transpose_item(F.in[8], 128, RWW, (bf16*)(F.ws + WS_GUPT), scr, r, F.lane);
        }
    }
    bf16* XN = (bf16*)(F.ws + WS_XN);
    {
        const GAS f32x4* gr = (const GAS f32x4*)F.in[1] + F.lane;
        f32x4 gg[4];
#pragma unroll
        for (int j = 0; j < 4; ++j) gg[j] = gr[64 * j];
#define P0_LD(V, ROW) do { const GAS f32x4* xr_ = (const GAS f32x4*)(F.in[0] + (size_t)(ROW) * DM) + F.lane; _Pragma("unroll") for (int j_ = 0; j_ < 4; ++j_) V[j_] = xr_[64 * j_]; } while (0)
#define P0_ST(V, ROW) do { float s_ = 0.f; _Pragma("unroll") for (int j_ = 0; j_ < 4; ++j_) s_ += (V[j_].x * V[j_].x + V[j_].y * V[j_].y) + (V[j_].z * V[j_].z + V[j_].w * V[j_].w); \
            const float rstd_ = frsq(wave_sum(s_) * (1.f / DM) + RMS_EPS); GAS unsigned long long* o8_ = (GAS unsigned long long*)(XN + (size_t)(ROW) * DM) + F.lane; \
            _Pragma("unroll") for (int j_ = 0; j_ < 4; ++j_) o8_[64 * j_] = (unsigned long long)pk2(V[j_].x * rstd_ * gg[j_].x, V[j_].y * rstd_ * gg[j_].y) | ((unsigned long long)pk2(V[j_].z * rstd_ * gg[j_].z, V[j_].w * rstd_ * gg[j_].w) << 32); } while (0)
        if (gw < T) {
            f32x4 A[4], B[4], NA[4], NB[4];
            int m = gw, ra = m, rb = m + NGW < T ? m + NGW : T - 1;
            P0_LD(A, ra); P0_LD(B, rb);
            for (;;) {
                const int m2 = m + 2 * NGW; const bool more = m2 < T;
                const int na = more ? m2 : ra, nb = more ? (m2 + NGW < T ? m2 + NGW : T - 1) : rb;
                P0_LD(NA, na); P0_LD(NB, nb);
                __builtin_amdgcn_sched_barrier(0);
                P0_ST(A, ra); P0_ST(B, rb);
                __builtin_amdgcn_sched_barrier(0);
                if (!more) break;
#pragma unroll
                for (int j = 0; j < 4; ++j) { A[j] = NA[j]; B[j] = NB[j]; }
                ra = na; rb = nb; m = m2;
            }
        }
#undef P0_LD
#undef P0_ST
    }
}

constexpr size_t WS_ROPE = WS_G;
__device__ __forceinline__ void p0_rope_table(Frame& F) {
    f32x2* tab = (f32x2*)(F.ws + WS_ROPE);
    for (int e = F.wg * NTHREADS + F.tid; e < SEQ * 32; e += F.G * NTHREADS) {
        const int sp = e >> 5, i = e & 31;
        const float inv_freq = powf(10000.0f, -(float)(2 * i) / 64.0f);
        const float ang = (float)sp * inv_freq;
        const double r = (double)ang - rint((double)ang * 0.15915494309189535) * 6.283185307179586;
        const float rf = (float)r;
        tab[e] = (f32x2){cosf(rf), sinf(rf)};
    }
}
__device__ __forceinline__ void p2_rope(Frame& F) {
    bf16* Z = (bf16*)(F.ws + WS_Z);
    const f32x2* tab = (const f32x2*)(F.ws + WS_ROPE);
    const int tid = F.tid, tk = tid >> 6, grp = (tid >> 2) & 15, i0 = (tid & 3) * 8;
    for (int blk = F.wg; blk < T / 8; blk += F.G) {
        const int g = blk * 8 + tk, sp = g & (SEQ - 1);
        bf16* p = Z + (size_t)g * IN_COLS + C_AQ + grp * 64 + i0;
        const v4u a = *(const GAS v4u*)p, b = *(const GAS v4u*)(p + 32);
        const GAS f32x4* tp = (const GAS f32x4*)(tab + sp * 32 + i0);
        float x1[8], x2[8];
        x1[0] = bflo(a.x); x1[1] = bfhi(a.x); x1[2] = bflo(a.y); x1[3] = bfhi(a.y); x1[4] = bflo(a.z); x1[5] = bfhi(a.z); x1[6] = bflo(a.w); x1[7] = bfhi(a.w);
        x2[0] = bflo(b.x); x2[1] = bfhi(b.x); x2[2] = bflo(b.y); x2[3] = bfhi(b.y); x2[4] = bflo(b.z); x2[5] = bfhi(b.z); x2[6] = bflo(b.w); x2[7] = bfhi(b.w);
        float o1[8], o2[8];
#pragma unroll
        for (int q = 0; q < 4; ++q) { const f32x4 cs = tp[q];
            o1[2 * q] = x1[2 * q] * cs[0] - x2[2 * q] * cs[1]; o2[2 * q] = x1[2 * q] * cs[1] + x2[2 * q] * cs[0];
            o1[2 * q + 1] = x1[2 * q + 1] * cs[2] - x2[2 * q + 1] * cs[3]; o2[2 * q + 1] = x1[2 * q + 1] * cs[3] + x2[2 * q + 1] * cs[2]; }
        v4u oa, ob; oa.x = pk2(o1[0], o1[1]); oa.y = pk2(o1[2], o1[3]); oa.z = pk2(o1[4], o1[5]); oa.w = pk2(o1[6], o1[7]);
        ob.x = pk2(o2[0], o2[1]); ob.y = pk2(o2[2], o2[3]); ob.z = pk2(o2[4], o2[5]); ob.w = pk2(o2[6], o2[7]);
        *(GAS v4u*)p = oa; *(GAS v4u*)(p + 32) = ob;
    }
}

typedef float f32x16 __attribute__((ext_vector_type(16)));
constexpr int SBS = 144;
constexpr int R1_EPRE = 0, R1_APRE = 16384, R1_AAB = 0, R1_X = 16384;
constexpr int R1_AT = 32768, R1_BT = 41984, R1_KT = 51200, R1_RT = 60416, R1_AHT = R1_BT, R1_U0T = R1_KT;
constexpr int R1_BBT = 69632, R1_KBT = 78848, R1_VT = 88064;
constexpr int R1_ACTW = 97280, R1_ACTA = 106496, R1_AAK = 97280, R1_ARB = 106496, R1_ARK = 115712;
constexpr int R1_BONUS = 124928, R1_WEND = 125184, R1_SEGS = 125440, R1_TII = 125440, R1_END = 129536;
constexpr int R1_PAR = R1_END;
static_assert(R1_PAR + 640 * 4 <= LDSCTL_OFF, "R1 LDS");
__device__ __forceinline__ int crow(int r, int hh) { return (r & 3) + 8 * (r >> 2) + 4 * hh; }
template <int KS> __device__ __forceinline__ f32x16 wtile(const LAS unsigned char* A, int sa, const LAS unsigned char* B, int sb, f32x16 acc, int lane) {
    const int row = lane & 31, hh = lane >> 5;
#pragma unroll
    for (int s = 0; s < KS; ++s) { const bf16x8 a = *(const LAS bf16x8*)(A + row * sa + 32 * s + 16 * hh); const bf16x8 b = *(const LAS bf16x8*)(B + row * sb + 32 * s + 16 * hh);
        acc = __builtin_amdgcn_mfma_f32_32x32x16_bf16(a, b, acc, 0, 0, 0); }
    return acc;
}
__device__ __forceinline__ f32x16 zero16() { f32x16 z;
#pragma unroll
    for (int r = 0; r < 16; ++r) z[r] = 0.f;
    return z; }

struct R1Pre { v4u wd[2], ad[2], z[4]; };
__device__ __forceinline__ int r13_item(int wg, int G, int idx) { return (wg >> 3) * 128 + (wg & 7) * 16 + idx; }
__device__ __forceinline__ int r13_count(int wg, int G) { return 16; }
__device__ __forceinline__ void rwkv_r1_prefetch(Frame& F, int item, int tid, R1Pre& P) {
    const int chain = item >> 7, chunk = item & 127, b = chain >> 3, h = chain & 7, g0 = b * SEQ + chunk * 64;
    const bf16* Z = (const bf16*)(F.ws + WS_Z);
    const v4u z0 = (v4u){0u, 0u, 0u, 0u};
    { const int t = tid >> 3, cg = tid & 7; const bool first = (chunk == 0 && t == 0);
      const bf16* zr = Z + (size_t)(g0 + t) * IN_COLS;
      P.wd[0] = *(const GAS v4u*)(zr + C_WD + cg * 8); P.ad[0] = *(const GAS v4u*)(zr + C_AD + cg * 8);
      P.wd[1] = z0; P.ad[1] = z0;
      if (!first) { P.wd[1] = *(const GAS v4u*)(zr - IN_COLS + C_WD + cg * 8); P.ad[1] = *(const GAS v4u*)(zr - IN_COLS + C_AD + cg * 8); } }
#pragma unroll
    for (int q = 0; q < 4; ++q) { const int p = tid + 512 * q; P.z[q] = z0;
        if (p < 65 * 24) { const int row = p / 24, rem = p - row * 24, seg = rem >> 3, ch = rem & 7;
            if (!(chunk == 0 && row == 0)) P.z[q] = *(const GAS v4u*)(Z + (size_t)(g0 - 1 + row) * IN_COLS + seg * 512 + h * 64 + ch * 8); } }
}
constexpr int R1_ZS = R1_AT, R1_ZSS = 384;
static_assert(65 * R1_ZSS <= 4 * 9216, "ZS fits in the At..Rt region");
__device__ __forceinline__ void r1_load_bfrag(Frame& F, int h, int w, int lane, bf16x8 (&bf)[4]) {
    const int p = w >> 2, nt = w & 1; const bf16* upt = (const bf16*)(F.ws + (p == 0 ? WS_WUPT : WS_AUPT)) + (size_t)(h * 64 + nt * 32 + (lane & 31)) * 64 + 8 * (lane >> 5);
#pragma unroll
    for (int s2 = 0; s2 < 4; ++s2) bf[s2] = *(const GAS bf16x8*)(upt + 16 * s2);
}
__device__ __forceinline__ void r1_load_params(Frame& F, int h) {
    LAS float* PAR = (LAS float*)(F.lds + RING_OFF + R1_PAR); const float* mu = F.in[3];
    const int k = F.wave, c = F.lane, col = h * 64 + c;
    const float* src = k == 0 ? mu + C_R : (k == 1 ? mu + C_K : (k == 2 ? mu + C_V : (k == 3 ? F.in[9] : (k == 4 ? F.in[10] : (k == 5 ? F.in[11] : (k == 6 ? F.in[4] : F.in[6]))))));
    PAR[128 + k * 64 + c] = src[col];
    if (k < 2) PAR[k * 64 + c] = mu[(k == 0 ? C_WD : C_AD) + c];
}
constexpr int R1_CF = R1_AAB, R1_CN = R1_X;
__device__ __forceinline__ void rwkv_r1_item(Frame& F, int item, int next_item, R1Pre& P, const bf16x8 (&bfr)[4], f32x4 (&cst)[4]) {
    const int chain = item >> 7, chunk = item & 127, b = chain >> 3, h = chain & 7;
    const int g0 = b * SEQ + chunk * 64;
    int tid_ = F.tid; asm volatile("" : "+v"(tid_));
    const int tid = tid_, lane = tid & 63, w = __builtin_amdgcn_readfirstlane(tid >> 6), hh = lane >> 5, cl = lane & 31;
    const bf16* Z = (const bf16*)(F.ws + WS_Z);
    LAS unsigned char* lds = F.lds + RING_OFF;
    const float* mu = F.in[3];
    {
        const int t = tid >> 3, cg = tid & 7;
        const v4u cw = P.wd[0], ca = P.ad[0], pw = P.wd[1], pa = P.ad[1];
        float fw[8], fa[8], qw[8], qa[8];
        fw[0] = bflo(cw.x); fw[1] = bfhi(cw.x); fw[2] = bflo(cw.y); fw[3] = bfhi(cw.y); fw[4] = bflo(cw.z); fw[5] = bfhi(cw.z); fw[6] = bflo(cw.w); fw[7] = bfhi(cw.w);
        fa[0] = bflo(ca.x); fa[1] = bfhi(ca.x); fa[2] = bflo(ca.y); fa[3] = bfhi(ca.y); fa[4] = bflo(ca.z); fa[5] = bfhi(ca.z); fa[6] = bflo(ca.w); fa[7] = bfhi(ca.w);
        qw[0] = bflo(pw.x); qw[1] = bfhi(pw.x); qw[2] = bflo(pw.y); qw[3] = bfhi(pw.y); qw[4] = bflo(pw.z); qw[5] = bfhi(pw.z); qw[6] = bflo(pw.w); qw[7] = bfhi(pw.w);
        qa[0] = bflo(pa.x); qa[1] = bfhi(pa.x); qa[2] = bflo(pa.y); qa[3] = bfhi(pa.y); qa[4] = bflo(pa.z); qa[5] = bfhi(pa.z); qa[6] = bflo(pa.w); qa[7] = bfhi(pa.w);
        const LAS float* PAR = (const LAS float*)(lds + R1_PAR);
        const f32x4 mw0 = *(const LAS f32x4*)(PAR + cg * 8), mw1 = *(const LAS f32x4*)(PAR + cg * 8 + 4), ma0 = *(const LAS f32x4*)(PAR + 64 + cg * 8), ma1 = *(const LAS f32x4*)(PAR + 64 + cg * 8 + 4);
#pragma unroll
        for (int j = 0; j < 8; ++j) { const float xw = fw[j] + (qw[j] - fw[j]) * (j < 4 ? mw0[j & 3] : mw1[j & 3]);
            const float ex = __expf(2.f * xw); fw[j] = 1.f - 2.f * frcp(ex + 1.f);
            fa[j] = fa[j] + (qa[j] - fa[j]) * (j < 4 ? ma0[j & 3] : ma1[j & 3]); }
        v4u ow, oa; ow.x = pk2(fw[0], fw[1]); ow.y = pk2(fw[2], fw[3]); ow.z = pk2(fw[4], fw[5]); ow.w = pk2(fw[6], fw[7]);
        oa.x = pk2(fa[0], fa[1]); oa.y = pk2(fa[2], fa[3]); oa.z = pk2(fa[4], fa[5]); oa.w = pk2(fa[6], fa[7]);
        *(LAS v4u*)(lds + R1_ACTW + t * SBS + cg * 16) = ow; *(LAS v4u*)(lds + R1_ACTA + t * SBS + cg * 16) = oa;
#pragma unroll
        for (int q = 0; q < 4; ++q) { const int p = tid + 512 * q;
            if (p < 65 * 24) { const int row = p / 24, rem = p - row * 24; *(LAS v4u*)(lds + R1_ZS + row * R1_ZSS + rem * 16) = P.z[q]; } }
        if (next_item >= 0) rwkv_r1_prefetch(F, next_item, tid, P);
    }
    LDS_BARRIER();
    {
        const int p = w >> 2, mt = (w >> 1) & 1, nt = w & 1;
        f32x16 acc = zero16();
        { const LAS unsigned char* A_ = lds + (p == 0 ? R1_ACTW : R1_ACTA) + mt * 32 * SBS + (lane & 31) * SBS + 16 * hh;
#pragma unroll
          for (int s2 = 0; s2 < 4; ++s2) acc = __builtin_amdgcn_mfma_f32_32x32x16_bf16(*(const LAS bf16x8*)(A_ + 32 * s2), bfr[s2], acc, 0, 0, 0); }
        LAS float* O = (LAS float*)(lds + (p == 0 ? R1_EPRE : R1_APRE));
#pragma unroll
        for (int r = 0; r < 16; ++r) O[(mt * 32 + crow(r, hh)) * 64 + nt * 32 + cl] = acc[r];
    }
    LDS_BARRIER();
    {
        const int c = tid & 63, ts = tid >> 6, col = h * 64 + c;
        const LAS float* PAR = (const LAS float*)(lds + R1_PAR) + 128 + c;
        const float mu_r = PAR[0], mu_k = PAR[64], mu_v = PAR[128], kkc = PAR[192], kac = PAR[256], rkc = PAR[320], w0c = PAR[384], a0c = PAR[448];
        const LAS float* EP = (const LAS float*)(lds + R1_EPRE); const LAS float* AP = (const LAS float*)(lds + R1_APRE);
        LAS float* SEGS = (LAS float*)(lds + R1_SEGS); LAS float* BON = (LAS float*)(lds + R1_BONUS);
        const LAS bf16* zb = (const LAS bf16*)(lds + R1_ZS + (8 * ts) * R1_ZSS) + c;
        float pr = bf2f(zb[0]), pk = bf2f(zb[64]), pv = bf2f(zb[128]);
        float rr[8], k2[8], ai[8], bi[8], vv[8], ee[8], cs[8]; float run = 0.f;
#pragma unroll
        for (int i = 0; i < 8; ++i) {
            const float zr = bf2f(zb[(i + 1) * (R1_ZSS / 2)]), zk = bf2f(zb[(i + 1) * (R1_ZSS / 2) + 64]), zv = bf2f(zb[(i + 1) * (R1_ZSS / 2) + 128]);
            const float r = zr + (pr - zr) * mu_r, k = zk + (pk - zk) * mu_k, v = zv + (pv - zv) * mu_v; pr = zr; pk = zk; pv = zv;
            const float e = 0.60653066f * frcp(1.f + __expf(-(w0c + EP[(8 * ts + i) * 64 + c])));
            const float a = frcp(1.f + __expf(-(a0c + AP[(8 * ts + i) * 64 + c])));
            float kk = k * kkc; const float n2 = wave_sum(kk * kk); kk = kk * frsq(fmaxf(n2, 1e-24f));
            const float kq = k * (1.f + (a - 1.f) * kac);
            const float bon = wave_sum(r * kq * rkc); if (c == 0) BON[8 * ts + i] = bon;
            rr[i] = r; k2[i] = kq; ai[i] = -kk; bi[i] = kk * a; vv[i] = v; ee[i] = e; run += e; cs[i] = run;
        }
        SEGS[ts * 64 + c] = run;
        LDS_BARRIER();
        float off = 0.f, tot = 0.f;
#pragma unroll
        for (int q = 0; q < 8; ++q) { const float sv = SEGS[q * 64 + c]; tot += sv; off += (q < ts) ? sv : 0.f; }
        float bb[8], kb[8];
#pragma unroll
        for (int i = 0; i < 8; ++i) { const float L = off + cs[i];
            const float Wm = __expf(-(L - ee[i])), Wi = __expf(-L), iW = __expf(L), We = __expf(-(tot - L));
            const int t = 8 * ts + i;
            *(LAS bf16*)(lds + R1_AT + t * SBS + c * 2) = (bf16)f2bf(ai[i] * Wm);
            *(LAS bf16*)(lds + R1_BT + t * SBS + c * 2) = (bf16)f2bf(bi[i] * iW);
            *(LAS bf16*)(lds + R1_KT + t * SBS + c * 2) = (bf16)f2bf(k2[i] * iW);
            *(LAS bf16*)(lds + R1_RT + t * SBS + c * 2) = (bf16)f2bf(rr[i] * Wi);
            bb[i] = bi[i] * We; kb[i] = k2[i] * We; }
        v4u o; o.x = pk2(bb[0], bb[1]); o.y = pk2(bb[2], bb[3]); o.z = pk2(bb[4], bb[5]); o.w = pk2(bb[6], bb[7]);
        *(LAS v4u*)(lds + R1_BBT + c * SBS + ts * 16) = o;
        o.x = pk2(kb[0], kb[1]); o.y = pk2(kb[2], kb[3]); o.z = pk2(kb[4], kb[5]); o.w = pk2(kb[6], kb[7]);
        *(LAS v4u*)(lds + R1_KBT + c * SBS + ts * 16) = o;
        o.x = pk2(vv[0], vv[1]); o.y = pk2(vv[2], vv[3]); o.z = pk2(vv[4], vv[5]); o.w = pk2(vv[6], vv[7]);
        *(LAS v4u*)(lds + R1_VT + c * SBS + ts * 16) = o;
        if (ts == 0) ((LAS float*)(lds + R1_WEND))[c] = __expf(-tot);
    }
    LDS_BARRIER();
#pragma unroll
    for (int u = 0; u < 2; ++u) {
        const int idx = w * 2 + u, p = idx >> 2, mt = (idx >> 1) & 1, nt = idx & 1;
        const LAS unsigned char* Aop = lds + ((p == 0 || p == 2) ? R1_BT : R1_KT) + mt * 32 * SBS;
        const LAS unsigned char* Bop = lds + (p < 2 ? R1_AT : R1_RT) + nt * 32 * SBS;
        f32x16 acc = wtile<4>(Aop, SBS, Bop, SBS, zero16(), lane);
        const int n = nt * 32 + cl;
#pragma unroll
        for (int r = 0; r < 16; ++r) { const int m = mt * 32 + crow(r, hh); const bool keep = (p < 2) ? (m < n) : (m <= n); acc[r] = keep ? acc[r] : 0.f; }
#pragma unroll
        for (int g4 = 0; g4 < 4; ++g4) { const int m0 = mt * 32 + 8 * g4 + 4 * hh;
            if (p == 0) *(LAS f32x4*)(lds + R1_AAB + (n * 64 + m0) * 4) = (f32x4){acc[4 * g4], acc[4 * g4 + 1], acc[4 * g4 + 2], acc[4 * g4 + 3]};
            else { v2u o; o.x = pk2(acc[4 * g4], acc[4 * g4 + 1]); o.y = pk2(acc[4 * g4 + 2], acc[4 * g4 + 3]);
                   *(LAS v2u*)(lds + (p == 1 ? R1_AAK : (p == 2 ? R1_ARB : R1_ARK)) + n * SBS + m0 * 2) = o; } }
    }
    LDS_BARRIER();
    if (w < 4) {
        const int mt = w >> 1, nt = w & 1;
        const f32x16 acc = wtile<4>(lds + R1_AAK + mt * 32 * SBS, SBS, lds + R1_VT + nt * 32 * SBS, SBS, zero16(), lane);
        LAS float* X = (LAS float*)(lds + R1_X);
#pragma unroll
        for (int r = 0; r < 16; ++r) X[(mt * 32 + crow(r, hh)) * 64 + nt * 32 + cl] = acc[r];
    } else if (w == 4) {
        const int bk = lane >> 4, c = lane & 15;
        const LAS float* AAB = (const LAS float*)(lds + R1_AAB);
        float Tc[16]; const float fc = (float)c;
#pragma unroll
        for (int s2 = 0; s2 < 16; ++s2) Tc[s2] = fmaxf(0.f, 1.f - fabsf((float)s2 - fc));
#pragma unroll
        for (int r = 0; r < 15; ++r)
#pragma unroll
            for (int s2 = r + 1; s2 < 16; ++s2) Tc[s2] += AAB[(16 * bk + s2) * 64 + 16 * bk + r] * Tc[r];
        LAS float* TII = (LAS float*)(lds + R1_TII);
#pragma unroll
        for (int s2 = 0; s2 < 16; ++s2) TII[(bk * 16 + s2) * 16 + c] = Tc[s2];
    }
    LDS_BARRIER();
    {
        const int c16 = lane & 15, g = lane >> 4;
        const LAS float* AAB = (const LAS float*)(lds + R1_AAB); const LAS float* TII = (const LAS float*)(lds + R1_TII); const LAS float* X = (const LAS float*)(lds + R1_X);
        f32x4 o[4];
#pragma unroll
        for (int i = 0; i < 4; ++i) {
            f32x4 acc;
            if (w < 4) {
#pragma unroll
                for (int q = 0; q < 4; ++q) acc[q] = bf2f(*(const LAS bf16*)(lds + R1_AT + (16 * i + 4 * g + q) * SBS + (16 * w + c16) * 2));
            } else {
#pragma unroll
                for (int q = 0; q < 4; ++q) acc[q] = X[(16 * i + 4 * g + q) * 64 + 16 * (w - 4) + c16];
            }
#pragma unroll
            for (int j = 0; j < i; ++j) { const f32x4 a4 = *(const LAS f32x4*)(AAB + (16 * i + c16) * 64 + 16 * j + 4 * g);
#pragma unroll
                for (int q = 0; q < 4; ++q) acc = __builtin_amdgcn_mfma_f32_16x16x4f32(a4[q], o[j][q], acc, 0, 0, 0); }
            const f32x4 t4 = *(const LAS f32x4*)(TII + (i * 16 + c16) * 16 + 4 * g);
            f32x4 res = (f32x4){0.f, 0.f, 0.f, 0.f};
#pragma unroll
            for (int q = 0; q < 4; ++q) res = __builtin_amdgcn_mfma_f32_16x16x4f32(t4[q], acc[q], res, 0, 0, 0);
            o[i] = res;
            v2u ov; ov.x = pk2(res[0], res[1]); ov.y = pk2(res[2], res[3]);
            *(LAS v2u*)(lds + (w < 4 ? R1_AHT : R1_U0T) + (16 * (w & 3) + c16) * SBS + (16 * i + 4 * g) * 2) = ov;
        }
    }
    LDS_BARRIER();
    {
        float* Mg = F.out + (size_t)item * 4096; float* NTg = F.out + (size_t)T * RWW + (size_t)item * 4096;
        float* Y0g = (float*)(F.ws + WS_RWY0) + (size_t)item * 4096; bf16* RHg = (bf16*)(F.ws + WS_RWRH) + (size_t)item * 4096;
#pragma unroll
        for (int u = 0; u < 2; ++u) {
            const int idx = w * 2 + u, p = idx >> 2, mt = (idx >> 1) & 1, nt = idx & 1; const int n = nt * 32 + cl;
            if (p == 0) {
                f32x16 acc = wtile<4>(lds + R1_AHT + mt * 32 * SBS, SBS, lds + R1_BBT + nt * 32 * SBS, SBS, zero16(), lane);
                const float we = ((const LAS float*)(lds + R1_WEND))[n];
#pragma unroll
                for (int g4 = 0; g4 < 4; ++g4) { const int m0 = mt * 32 + 8 * g4 + 4 * hh;
                    const f32x4 mv = (f32x4){acc[4 * g4] + (m0 == n ? we : 0.f), acc[4 * g4 + 1] + (m0 + 1 == n ? we : 0.f), acc[4 * g4 + 2] + (m0 + 2 == n ? we : 0.f), acc[4 * g4 + 3] + (m0 + 3 == n ? we : 0.f)};
                    *(GAS f32x4*)(Mg + n * 64 + m0) = mv;
                    v2u h_; h_.x = pk2(mv[0], mv[1]); h_.y = pk2(mv[2], mv[3]);
                    v2u l_; l_.x = pk2(mv[0] - bflo(h_.x), mv[1] - bfhi(h_.x)); l_.y = pk2(mv[2] - bflo(h_.y), mv[3] - bfhi(h_.y));
                    LAS unsigned char* fp_ = lds + R1_CF + (((n >> 4) * 2 + (m0 >> 5)) * 2) * 1024 + ((((m0 >> 2) & 3) * 16) + (n & 15)) * 16 + ((m0 >> 4) & 1) * 8;
                    *(LAS v2u*)fp_ = h_; *(LAS v2u*)(fp_ + 1024) = l_; }
            } else if (p == 1) {
                f32x16 acc = wtile<4>(lds + R1_BBT + mt * 32 * SBS, SBS, lds + R1_U0T + nt * 32 * SBS, SBS, zero16(), lane);
                acc = wtile<4>(lds + R1_KBT + mt * 32 * SBS, SBS, lds + R1_VT + nt * 32 * SBS, SBS, acc, lane);
#pragma unroll
                for (int g4 = 0; g4 < 4; ++g4) { const f32x4 nv_ = (f32x4){acc[4 * g4], acc[4 * g4 + 1], acc[4 * g4 + 2], acc[4 * g4 + 3]};
                    *(GAS f32x4*)(NTg + n * 64 + mt * 32 + 8 * g4 + 4 * hh) = nv_; *(LAS f32x4*)(lds + R1_CN + (n * 64 + mt * 32 + 8 * g4 + 4 * hh) * 4) = nv_; }
            } else if (p == 2) {
                f32x16 acc = wtile<4>(lds + R1_AHT + mt * 32 * SBS, SBS, lds + R1_ARB + nt * 32 * SBS, SBS, zero16(), lane);
#pragma unroll
                for (int g4 = 0; g4 < 4; ++g4) { const int m0 = mt * 32 + 8 * g4 + 4 * hh;
                    const v2u rt = *(const LAS v2u*)(lds + R1_RT + n * SBS + m0 * 2);
                    v2u ov; ov.x = pk2(acc[4 * g4] + bflo(rt.x), acc[4 * g4 + 1] + bfhi(rt.x)); ov.y = pk2(acc[4 * g4 + 2] + bflo(rt.y), acc[4 * g4 + 3] + bfhi(rt.y));
                    *(GAS v2u*)(RHg + n * 64 + m0) = ov; }
            } else {
                f32x16 acc = wtile<4>(lds + R1_U0T + mt * 32 * SBS, SBS, lds + R1_ARB + nt * 32 * SBS, SBS, zero16(), lane);
                acc = wtile<4>(lds + R1_VT + mt * 32 * SBS, SBS, lds + R1_ARK + nt * 32 * SBS, SBS, acc, lane);
#pragma unroll
                for (int g4 = 0; g4 < 4; ++g4) *(GAS f32x4*)(Y0g + n * 64 + mt * 32 + 8 * g4 + 4 * hh) = (f32x4){acc[4 * g4], acc[4 * g4 + 1], acc[4 * g4 + 2], acc[4 * g4 + 3]};
            }
        }
        if (tid < 64) ((float*)(F.ws + WS_BONUS))[(size_t)item * 64 + tid] = ((const LAS float*)(lds + R1_BONUS))[tid];
    }
    LDS_BARRIER();
    {
        const int n16 = lane & 15, g = lane >> 4;
        bf16x8 sh[2], sl[2];
#pragma unroll
        for (int ks = 0; ks < 2; ++ks) { const f32x4 a = cst[2 * ks], b = cst[2 * ks + 1];
            v4u h_; h_.x = pk2(a[0], a[1]); h_.y = pk2(a[2], a[3]); h_.z = pk2(b[0], b[1]); h_.w = pk2(b[2], b[3]);
            v4u l_; l_.x = pk2(a[0] - bflo(h_.x), a[1] - bfhi(h_.x)); l_.y = pk2(a[2] - bflo(h_.y), a[3] - bfhi(h_.y)); l_.z = pk2(b[0] - bflo(h_.z), b[1] - bfhi(h_.z)); l_.w = pk2(b[2] - bflo(h_.w), b[3] - bfhi(h_.w));
            sh[ks] = __builtin_bit_cast(bf16x8, h_); sl[ks] = __builtin_bit_cast(bf16x8, l_); }
        f32x4 nw[4];
#pragma unroll
        for (int rt = 0; rt < 4; ++rt) { f32x4 acc = (f32x4){0.f, 0.f, 0.f, 0.f};
            if (w >= 4) acc = *(const LAS f32x4*)(lds + R1_CN + ((16 * (w - 4) + n16) * 64 + 16 * rt + 4 * g) * 4);
#pragma unroll
            for (int ks = 0; ks < 2; ++ks) {
                const bf16x8 mh = *(const LAS bf16x8*)(lds + R1_CF + ((rt * 2 + ks) * 2) * 1024 + lane * 16), ml = *(const LAS bf16x8*)(lds + R1_CF + ((rt * 2 + ks) * 2 + 1) * 1024 + lane * 16);
                acc = __builtin_amdgcn_mfma_f32_16x16x32_bf16(mh, sh[ks], acc, 0, 0, 0);
                acc = __builtin_amdgcn_mfma_f32_16x16x32_bf16(mh, sl[ks], acc, 0, 0, 0);
                acc = __builtin_amdgcn_mfma_f32_16x16x32_bf16(ml, sh[ks], acc, 0, 0, 0); }
            nw[rt] = acc; }
#pragma unroll
        for (int rt = 0; rt < 4; ++rt) cst[rt] = nw[rt];
    }
    LDS_BARRIER();
}

constexpr int R2_RS = 272, R2_SLOT = 2 * 64 * R2_RS;
static_assert(2 * R2_SLOT <= LDSCTL_OFF, "R2 LDS");
template <int NSTEP, int R2_D> __device__ __forceinline__ void rwkv_scan(Frame& F, const float* Mg, const float* NTg, float* SSg, const float* S0g) {
    int tid_ = F.tid; asm volatile("" : "+v"(tid_));
    const int lane = tid_ & 63, w = __builtin_amdgcn_readfirstlane(tid_ >> 6);
    LAS unsigned char* lds = F.lds + RING_OFF;
    if (w >= 4) {
        const int L = w - 4, r = lane >> 2, f0 = (lane & 3) * 4;
        const size_t goff = (size_t)(16 * L + r) * 64 + f0 * 4;
        const int loff = (16 * L + r) * R2_RS + f0 * 16;
        f32x4 R[R2_D][8];
#define R2_ISSUE(slot_, step_) do { const int st_ = (step_) < NSTEP ? (step_) : NSTEP - 1; const float* mp_ = Mg + (size_t)st_ * 4096 + goff; const float* np_ = NTg + (size_t)st_ * 4096 + goff; \
            _Pragma("unroll") for (int k_ = 0; k_ < 4; ++k_) { R[slot_][k_] = *(const GAS f32x4*)(mp_ + 4 * k_); R[slot_][4 + k_] = *(const GAS f32x4*)(np_ + 4 * k_); } } while (0)
        const int q_ = lane & 3, froff = ((L * 2 + (q_ >> 1)) * 2) * 1024 + r * 16 + (q_ & 1) * 8;
#define R2_WRITE(slot_, buf_) do { LAS unsigned char* d_ = lds + (buf_) * R2_SLOT; \
            _Pragma("unroll") for (int k_ = 0; k_ < 4; ++k_) { const f32x4 a_ = R[slot_][k_]; \
                v2u h_; h_.x = pk2(a_[0], a_[1]); h_.y = pk2(a_[2], a_[3]); \
                v2u l_; l_.x = pk2(a_[0] - bflo(h_.x), a_[1] - bfhi(h_.x)); l_.y = pk2(a_[2] - bflo(h_.y), a_[3] - bfhi(h_.y)); \
                *(LAS v2u*)(d_ + froff + k_ * 256) = h_; *(LAS v2u*)(d_ + froff + 1024 + k_ * 256) = l_; \
                *(LAS f32x4*)(d_ + 64 * R2_RS + loff + 16 * k_) = R[slot_][4 + k_]; } } while (0)
#pragma unroll
        for (int u = 0; u < R2_D; ++u) R2_ISSUE(u, u);
        R2_WRITE(0, 0);
        R2_ISSUE(0, R2_D);
        LDS_BARRIER();
        int c0 = 0;
        for (; c0 + R2_D <= NSTEP - 1; c0 += R2_D) {
#pragma unroll
            for (int u = 0; u < R2_D; ++u) { const int c = c0 + u;
                R2_WRITE((u + 1) % R2_D, (c + 1) & 1);
                R2_ISSUE((u + 1) % R2_D, c + 1 + R2_D);
                LDS_BARRIER(); }
        }
#pragma unroll
        for (int u = 0; u < R2_D; ++u) { const int c = c0 + u;
            if (c < NSTEP - 1) { R2_WRITE((u + 1) % R2_D, (c + 1) & 1); LDS_BARRIER(); } }
        LDS_BARRIER();
#undef R2_ISSUE
#undef R2_WRITE
        return;
    }
    const int n16 = lane & 15, g = lane >> 4;
    f32x4 st[4];
#pragma unroll
    for (int rt = 0; rt < 4; ++rt) st[rt] = S0g ? *(const GAS f32x4*)(S0g + (16 * w + n16) * 64 + 16 * rt + 4 * g) : (f32x4){0.f, 0.f, 0.f, 0.f};
    LDS_BARRIER();
    for (int c = 0; c < NSTEP; ++c) {
#pragma unroll
        for (int rt = 0; rt < 4; ++rt) *(GAS f32x4*)(SSg + (size_t)c * 4096 + (16 * w + n16) * 64 + 16 * rt + 4 * g) = st[rt];
        const LAS unsigned char* sl_ = lds + (c & 1) * R2_SLOT;
        bf16x8 sh[2], sl[2];
#pragma unroll
        for (int ks = 0; ks < 2; ++ks) { const f32x4 a = st[2 * ks], b = st[2 * ks + 1];
            v4u h; h.x = pk2(a[0], a[1]); h.y = pk2(a[2], a[3]); h.z = pk2(b[0], b[1]); h.w = pk2(b[2], b[3]);
            v4u l; l.x = pk2(a[0] - bflo(h.x), a[1] - bfhi(h.x)); l.y = pk2(a[2] - bflo(h.y), a[3] - bfhi(h.y)); l.z = pk2(b[0] - bflo(h.z), b[1] - bfhi(h.z)); l.w = pk2(b[2] - bflo(h.w), b[3] - bfhi(h.w));
            sh[ks] = __builtin_bit_cast(bf16x8, h); sl[ks] = __builtin_bit_cast(bf16x8, l); }
        f32x4 nw[4];
#pragma unroll
        for (int rt = 0; rt < 4; ++rt) { f32x4 acc = *(const LAS f32x4*)(sl_ + 64 * R2_RS + (16 * w + n16) * R2_RS + (16 * rt + 4 * g) * 4);
#pragma unroll
            for (int ks = 0; ks < 2; ++ks) {
                const bf16x8 mh = *(const LAS bf16x8*)(sl_ + ((rt * 2 + ks) * 2) * 1024 + lane * 16), ml = *(const LAS bf16x8*)(sl_ + ((rt * 2 + ks) * 2 + 1) * 1024 + lane * 16);
                acc = __builtin_amdgcn_mfma_f32_16x16x32_bf16(mh, sh[ks], acc, 0, 0, 0);
                acc = __builtin_amdgcn_mfma_f32_16x16x32_bf16(mh, sl[ks], acc, 0, 0, 0);
                acc = __builtin_amdgcn_mfma_f32_16x16x32_bf16(ml, sh[ks], acc, 0, 0, 0); }
            nw[rt] = acc; }
#pragma unroll
        for (int rt = 0; rt < 4; ++rt) st[rt] = nw[rt];
        LDS_BARRIER();
    }
#pragma unroll
    for (int rt = 0; rt < 4; ++rt) *(GAS f32x4*)(SSg + (size_t)NSTEP * 4096 + (16 * w + n16) * 64 + 16 * rt + 4 * g) = st[rt];
}

constexpr int R3_RH = 0, R3_S = 9216, R3_SG = 18432, R3_SGS = 272, R3_YL = R3_SG + 64 * R3_SGS, R3_GL = R3_YL + 16384, R3_VS = R3_GL + 16384, R3_BON = R3_VS + 65 * 128, R3_END = R3_BON + 256;
constexpr int R3_PAR = R3_END;
static_assert(R3_PAR + 320 * 4 <= LDSCTL_OFF, "R3 LDS");
struct R3Pre { v4u rh; f32x4 ss[2]; v4u gd[2][2]; f32x4 y0[2]; v4u vv[2]; float bon; };
__device__ __forceinline__ void rwkv_r3_prefetch(Frame& F, int item, int tid, R3Pre& P) {
    const int chain = item >> 7, chunk = item & 127, b = chain >> 3, h = chain & 7, g0 = b * SEQ + chunk * 64;
    const bf16* Z = (const bf16*)(F.ws + WS_Z);
    const int t = tid >> 3, cg = tid & 7; const v4u z0 = (v4u){0u, 0u, 0u, 0u};
    P.rh = *(const GAS v4u*)((const bf16*)(F.ws + WS_RWRH) + (size_t)item * 4096 + t * 64 + cg * 8);
    const float* SSg = (const float*)(F.ws + WS_RWSS) + (size_t)item * 4096 + t * 64 + cg * 8;
    P.ss[0] = *(const GAS f32x4*)SSg; P.ss[1] = *(const GAS f32x4*)(SSg + 4);
    const bf16* zr = Z + (size_t)(g0 + t) * IN_COLS + C_GD + cg * 16; const bool first = (chunk == 0 && t == 0);
#pragma unroll
    for (int q = 0; q < 2; ++q) { P.gd[q][0] = *(const GAS v4u*)(zr + q * 8); P.gd[q][1] = z0; if (!first) P.gd[q][1] = *(const GAS v4u*)(zr - IN_COLS + q * 8); }
    const float* Y0g = (const float*)(F.ws + WS_RWY0) + (size_t)item * 4096;
    P.y0[0] = *(const GAS f32x4*)(Y0g + tid * 4); P.y0[1] = *(const GAS f32x4*)(Y0g + (tid + 512) * 4);
#pragma unroll
    for (int q = 0; q < 2; ++q) { const int p = tid + 512 * q; P.vv[q] = z0;
        if (p < 65 * 8) { const int row = p >> 3, ch = p & 7; if (!(chunk == 0 && row == 0)) P.vv[q] = *(const GAS v4u*)(Z + (size_t)(g0 - 1 + row) * IN_COLS + C_V + h * 64 + ch * 8); } }
    P.bon = tid < 64 ? ((const float*)(F.ws + WS_BONUS))[(size_t)item * 64 + tid] : 0.f;
}
__device__ __forceinline__ void r3_load_bfrag(Frame& F, int h, int w, int lane, bf16x8 (&bf)[8]) {
    const int nt = w & 1; const bf16* gut = (const bf16*)(F.ws + WS_GUPT) + (size_t)(h * 64 + nt * 32 + (lane & 31)) * 128 + 8 * (lane >> 5);
#pragma unroll
    for (int s2 = 0; s2 < 8; ++s2) bf[s2] = *(const GAS bf16x8*)(gut + 16 * s2);
}
__device__ __forceinline__ void r3_load_params(Frame& F, int h) {
    LAS float* PAR = (LAS float*)(F.lds + RING_OFF + R3_PAR); const float* mu = F.in[3];
    const int k = F.wave, c = F.lane, col = h * 64 + c;
    if (k < 2) PAR[k * 64 + c] = mu[C_GD + k * 64 + c];
    else if (k < 5) PAR[128 + (k - 2) * 64 + c] = (k == 2 ? mu + C_V : (k == 3 ? F.in[12] : F.in[13]))[col];
}
__device__ __forceinline__ void rwkv_r3_item(Frame& F, int item, int next_item, R3Pre& P, const bf16x8 (&bfr)[8]) {
    const int chain = item >> 7, chunk = item & 127, b = chain >> 3, h = chain & 7;
    const int g0 = b * SEQ + chunk * 64;
    int tid_ = F.tid; asm volatile("" : "+v"(tid_));
    const int tid = tid_, lane = tid & 63, w = __builtin_amdgcn_readfirstlane(tid >> 6), hh = lane >> 5, cl = lane & 31;
    LAS unsigned char* lds = F.lds + RING_OFF;
    const float* mu = F.in[3];
    {
        const int t = tid >> 3, cg = tid & 7;
        *(LAS v4u*)(lds + R3_RH + t * SBS + cg * 16) = P.rh;
        const f32x4 s0 = P.ss[0], s1 = P.ss[1];
        v4u o; o.x = pk2(s0[0], s0[1]); o.y = pk2(s0[2], s0[3]); o.z = pk2(s1[0], s1[1]); o.w = pk2(s1[2], s1[3]);
        *(LAS v4u*)(lds + R3_S + t * SBS + cg * 16) = o;
#pragma unroll
        for (int q = 0; q < 2; ++q) {
            const v4u cw = P.gd[q][0], pw = P.gd[q][1];
            float fw[8], qw[8];
            fw[0] = bflo(cw.x); fw[1] = bfhi(cw.x); fw[2] = bflo(cw.y); fw[3] = bfhi(cw.y); fw[4] = bflo(cw.z); fw[5] = bfhi(cw.z); fw[6] = bflo(cw.w); fw[7] = bfhi(cw.w);
            qw[0] = bflo(pw.x); qw[1] = bfhi(pw.x); qw[2] = bflo(pw.y); qw[3] = bfhi(pw.y); qw[4] = bflo(pw.z); qw[5] = bfhi(pw.z); qw[6] = bflo(pw.w); qw[7] = bfhi(pw.w);
            const f32x4 mg0 = *(const LAS f32x4*)(lds + R3_PAR + (cg * 16 + q * 8) * 4), mg1 = *(const LAS f32x4*)(lds + R3_PAR + (cg * 16 + q * 8 + 4) * 4);
#pragma unroll
            for (int j = 0; j < 8; ++j) { const float v = fw[j] + (qw[j] - fw[j]) * (j < 4 ? mg0[j & 3] : mg1[j & 3]); fw[j] = frcp(1.f + __expf(-v)); }
            v4u og; og.x = pk2(fw[0], fw[1]); og.y = pk2(fw[2], fw[3]); og.z = pk2(fw[4], fw[5]); og.w = pk2(fw[6], fw[7]);
            *(LAS v4u*)(lds + R3_SG + t * R3_SGS + (cg * 16 + q * 8) * 2) = og;
        }
        *(LAS f32x4*)(lds + R3_YL + tid * 16) = P.y0[0]; *(LAS f32x4*)(lds + R3_YL + (tid + 512) * 16) = P.y0[1];
#pragma unroll
        for (int q = 0; q < 2; ++q) { const int p = tid + 512 * q; if (p < 65 * 8) *(LAS v4u*)(lds + R3_VS + p * 16) = P.vv[q]; }
        if (tid < 64) ((LAS float*)(lds + R3_BON))[tid] = P.bon;
        if (next_item >= 0) rwkv_r3_prefetch(F, next_item, tid, P);
    }
    LDS_BARRIER();
    {
        const int mt = (w >> 1) & 1, nt = w & 1; const int n = nt * 32 + cl;
        if (w < 4) {
            LAS float* YL = (LAS float*)(lds + R3_YL);
            f32x16 acc;
#pragma unroll
            for (int r = 0; r < 16; ++r) acc[r] = YL[(mt * 32 + crow(r, hh)) * 64 + n];
            acc = wtile<4>(lds + R3_RH + mt * 32 * SBS, SBS, lds + R3_S + nt * 32 * SBS, SBS, acc, lane);
#pragma unroll
            for (int r = 0; r < 16; ++r) YL[(mt * 32 + crow(r, hh)) * 64 + n] = acc[r];
        } else {
            f32x16 acc = zero16();
            { const LAS unsigned char* A_ = lds + R3_SG + mt * 32 * R3_SGS + (lane & 31) * R3_SGS + 16 * hh;
#pragma unroll
              for (int s2 = 0; s2 < 8; ++s2) acc = __builtin_amdgcn_mfma_f32_32x32x16_bf16(*(const LAS bf16x8*)(A_ + 32 * s2), bfr[s2], acc, 0, 0, 0); }
            LAS float* GL = (LAS float*)(lds + R3_GL);
#pragma unroll
            for (int r = 0; r < 16; ++r) GL[(mt * 32 + crow(r, hh)) * 64 + n] = acc[r];
        }
    }
    LDS_BARRIER();
    {
        const int c = tid & 63, ts = tid >> 6, col = h * 64 + c;
        const LAS float* PAR = (const LAS float*)(lds + R3_PAR) + 128 + c;
        const float mu_v = PAR[0], gw = PAR[64], gb = PAR[128];
        const LAS float* YL = (const LAS float*)(lds + R3_YL); const LAS float* GL = (const LAS float*)(lds + R3_GL); const LAS float* BON = (const LAS float*)(lds + R3_BON);
        bf16* Y = (bf16*)(F.ws + WS_YMIX);
        const LAS bf16* vb = (const LAS bf16*)(lds + R3_VS) + (8 * ts) * 64 + c;
        float pv = bf2f(vb[0]);
#pragma unroll
        for (int i = 0; i < 8; ++i) { const int t = 8 * ts + i;
            const float zv = bf2f(vb[(i + 1) * 64]); const float v = zv + (pv - zv) * mu_v; pv = zv;
            const float y = YL[t * 64 + c];
            const float mean = wave_sum(y) * (1.f / 64.f); const float d = y - mean; const float var = wave_sum(d * d) * (1.f / 64.f);
            const float yn = d * frsq(var + GN_EPS) * gw + gb;
            const float o = (yn + BON[t] * v) * GL[t * 64 + c];
            Y[(size_t)(g0 + t) * DM + col] = (bf16)f2bf(o); }
    }
    LDS_BARRIER();
}

typedef short s16x4 __attribute__((ext_vector_type(4)));
typedef short v4i16_t __attribute__((ext_vector_type(4)));
constexpr int AT_XO = 0, AT_XO_STRIDE = 136, AT_XM = 512 * AT_XO_STRIDE, AT_XL = AT_XM + 2048, AT_V = AT_XL + 2048, AT_K = AT_V + 8 * 4096, AT_KS = 144, AT_LDS_END = AT_K + 8 * 32 * AT_KS;
static_assert(AT_LDS_END <= LDSCTL_OFF, "attention LDS");
__device__ __forceinline__ float xhalf(float v) { return __shfl_xor(v, 32); }
__device__ __forceinline__ void attn_block(Frame& F, int item) {
    const int bh = item >> 4, blk = item & 15, b = bh >> 3, h = bh & 7, t0 = blk * 512;
    int tid_ = F.tid; asm volatile("" : "+v"(tid_));
    const int lane = tid_ & 63, w = __builtin_amdgcn_readfirstlane(tid_ >> 6), ql = lane & 31, hh = lane >> 5;
    const bf16* Zb = (const bf16*)(F.ws + WS_Z) + (size_t)b * SEQ * IN_COLS;
    bf16* Y = (bf16*)(F.ws + WS_YMIX);
    LAS unsigned char* lds = F.lds + RING_OFF;
    LAS unsigned char* Vw = lds + AT_V + w * 4096;
    LAS unsigned char* Kw = lds + AT_K + w * 32 * AT_KS;
    LAS float* XM = (LAS float*)(lds + AT_XM); LAS float* XL = (LAS float*)(lds + AT_XL);
    constexpr float C2 = 0.125f * 1.4426950408889634f;
    const int lrow = lane >> 3, lch = lane & 7;
    __builtin_amdgcn_s_waitcnt(0x0F70);
#define AT_PARAMS(SI, sh_, d_, rho_, tau_, tkb_) do { const int ps_ = (SI) >> 1; sh_ = ps_ == 0 ? 4 : (ps_ == 1 ? 2 : 0); d_ = 1 << sh_; \
        const int u_ = w + 8 * ((SI) & 1); rho_ = u_ & (d_ - 1); tau_ = u_ >> sh_; tkb_ = t0 + rho_ + (32 * tau_ - 128) * d_; } while (0)
    const GAS char* zb8 = (const GAS char*)Zb;
#define AT_VOFF(d_) ((unsigned)(lrow * (d_)) * (unsigned)(IN_COLS * 2) + (unsigned)(lch * 16))
#define AT_LOADQ(d_, rho_, tau_, vo_) do { const GAS char* sb_ = zb8 + ((size_t)(t0 + rho_ + 32 * tau_ * d_) * IN_COLS + C_AQ + h * 64) * 2; \
        _Pragma("unroll") for (int i_ = 0; i_ < 4; ++i_) qr[i_] = *(const GAS v4u*)(sb_ + (size_t)(i_ * 8 * d_) * (IN_COLS * 2) + vo_); } while (0)
#define AT_LOADT(KT, COL, d_, tkb_, vo_) do { const int tk_ = tkb_ + 32 * (KT) * d_, tc_ = tk_ < 0 ? 0 : tk_; const GAS char* sb_ = zb8 + ((size_t)tc_ * IN_COLS + (COL) + h * 64) * 2; \
        _Pragma("unroll") for (int i_ = 0; i_ < 4; ++i_) R[KT][i_] = *(const GAS v4u*)(sb_ + (size_t)(i_ * 8 * d_) * (IN_COLS * 2) + vo_); } while (0)
    v4u R[5][4], qr[4];
    { int sh, d, rho, tau, tkb; AT_PARAMS(0, sh, d, rho, tau, tkb);
      const unsigned vo = AT_VOFF(d);
      AT_LOADQ(d, rho, tau, vo);
#pragma unroll
      for (int kt = 0; kt < 5; ++kt) AT_LOADT(kt, C_AK, d, tkb, vo); }
#pragma unroll 1
    for (int si = 0; si < 6; ++si) {
        int sh, d, rho, tau, tkb; AT_PARAMS(si, sh, d, rho, tau, tkb);
        const int sn = si < 5 ? si + 1 : 5;
        int sh2, d2, rho2, tau2, tkb2; AT_PARAMS(sn, sh2, d2, rho2, tau2, tkb2);
        const int qoff = rho + (32 * tau + ql) * d;
        const unsigned vo = AT_VOFF(d), vo2 = AT_VOFF(d2);
        bf16x8 qf[4];
#pragma unroll
        for (int i = 0; i < 4; ++i) *(LAS v4u*)(Kw + (i * 8 + lrow) * AT_KS + lch * 16) = qr[i];
#pragma unroll
        for (int s = 0; s < 4; ++s) qf[s] = *(const LAS bf16x8*)(Kw + ql * AT_KS + 32 * s + 16 * hh);
        f32x16 sc[5];
        float m = -INFINITY;
#pragma unroll
        for (int kt = 0; kt < 5; ++kt) {
            const int tk0 = tkb + 32 * kt * d;
            bf16x8 kf[4];
#pragma unroll
            for (int i = 0; i < 4; ++i) *(LAS v4u*)(Kw + (i * 8 + lrow) * AT_KS + lch * 16) = R[kt][i];
            AT_LOADT(kt, C_AV, d, tkb, vo);
#pragma unroll
            for (int s = 0; s < 4; ++s) kf[s] = *(const LAS bf16x8*)(Kw + ql * AT_KS + 32 * s + 16 * hh);
            f32x16 acc = zero16();
#pragma unroll
            for (int s = 0; s < 4; ++s) acc = __builtin_amdgcn_mfma_f32_32x32x16_bf16(kf[s], qf[s], acc, 0, 0, 0);
            if (kt == 0 || kt == 4) {
#pragma unroll
                for (int r = 0; r < 16; ++r) { const int kidx = (r & 3) + 8 * (r >> 2) + 4 * hh;
                    const bool ok = (kt == 0) ? (kidx >= ql) : (kidx <= ql);
                    acc[r] = ok ? acc[r] : -INFINITY; }
            }
            float mt = acc[0];
#pragma unroll
            for (int r = 1; r < 16; ++r) mt = fmaxf(mt, acc[r]);
            m = tk0 < 0 ? m : fmaxf(m, mt);
            sc[kt] = acc;
        }
        m = fmaxf(m, xhalf(m));
        const float ms = m * C2;
        f32x2 l2 = (f32x2){0.f, 0.f};
        unsigned pw[5][8];
#pragma unroll
        for (int kt = 0; kt < 5; ++kt) {
            const float mk = (tkb + 32 * kt * d) < 0 ? INFINITY : ms;
#pragma unroll
            for (int r = 0; r < 8; ++r) {
                const f32x2 t2 = __builtin_elementwise_fma((f32x2){sc[kt][2 * r], sc[kt][2 * r + 1]}, (f32x2){C2, C2}, (f32x2){-mk, -mk});
                const f32x2 p2 = (f32x2){__builtin_amdgcn_exp2f(t2[0]), __builtin_amdgcn_exp2f(t2[1])};
                l2 += p2; pw[kt][r] = pk2(p2[0], p2[1]); }
        }
        float l = l2[0] + l2[1];
        l += xhalf(l);
        AT_LOADQ(d2, rho2, tau2, vo2);
        f32x16 O[2];
#pragma unroll
        for (int r = 0; r < 16; ++r) { O[0][r] = 0.f; O[1][r] = 0.f; }
#pragma unroll
        for (int kt = 0; kt < 5; ++kt) {
#pragma unroll
            for (int i = 0; i < 4; ++i) { const int kidx = i * 8 + lrow;
                *(LAS v4u*)(Vw + kidx * 128 + ((lch ^ (((kidx >> 1) & 1) << 2)) << 4)) = R[kt][i]; }
            AT_LOADT(kt, C_AK, d2, tkb2, vo2);
#pragma unroll
            for (int s = 0; s < 2; ++s) {
                v4u pq; pq.x = pw[kt][4 * s]; pq.y = pw[kt][4 * s + 1]; pq.z = pw[kt][4 * s + 2]; pq.w = pw[kt][4 * s + 3];
                const bf16x8 pf = __builtin_bit_cast(bf16x8, pq);
#pragma unroll
                for (int dt = 0; dt < 2; ++dt) {
                    bf16x8 vf;
#pragma unroll
                    for (int pp = 0; pp < 2; ++pp) {
                        const int i16 = lane & 15, db = (lane >> 4) & 1;
                        const int row = 16 * s + 8 * pp + 4 * hh + (i16 >> 2);
                        const int byte = 64 * dt + 32 * db + 8 * (i16 & 3);
                        const int chunk = (byte >> 4) ^ (((row >> 1) & 1) << 2);
                        const s16x4 t4 = __builtin_bit_cast(s16x4, __builtin_amdgcn_ds_read_tr16_b64_v4i16((LAS v4i16_t*)(Vw + row * 128 + (chunk << 4) + (byte & 15))));
                        vf[4 * pp + 0] = t4[0]; vf[4 * pp + 1] = t4[1]; vf[4 * pp + 2] = t4[2]; vf[4 * pp + 3] = t4[3];
                    }
                    O[dt] = __builtin_amdgcn_mfma_f32_32x32x16_bf16(vf, pf, O[dt], 0, 0, 0);
                }
            }
        }
        LAS unsigned char* xo = lds + AT_XO + qoff * AT_XO_STRIDE + 8 * hh;
        float wa = 0.f, wb = 1.f, Mx = ms, ln = l;
        if (si >= 2) { const float msa = XM[qoff], la = XL[qoff]; Mx = fmaxf(msa, ms); wa = la * __builtin_amdgcn_exp2f(msa - Mx); wb = __builtin_amdgcn_exp2f(ms - Mx); ln = wa + wb * l; }
        const float inv = 1.f / ln;
#pragma unroll
        for (int dt = 0; dt < 2; ++dt)
#pragma unroll
            for (int g4 = 0; g4 < 4; ++g4) {
                LAS v2u* p = (LAS v2u*)(xo + (32 * dt + 8 * g4) * 2);
                float o0 = O[dt][4 * g4] * wb, o1 = O[dt][4 * g4 + 1] * wb, o2 = O[dt][4 * g4 + 2] * wb, o3 = O[dt][4 * g4 + 3] * wb;
                if (si >= 2) { const v2u old = *p; o0 += bflo(old.x) * wa; o1 += bfhi(old.x) * wa; o2 += bflo(old.y) * wa; o3 += bfhi(old.y) * wa; }
                v2u nw; nw.x = pk2(o0 * inv, o1 * inv); nw.y = pk2(o2 * inv, o3 * inv);
                *p = nw;
            }
        if (hh == 0) { XM[qoff] = Mx; XL[qoff] = ln; }
        if (si & 1) LDS_BARRIER();
    }
#undef AT_PARAMS
#undef AT_LOADQ
#undef AT_VOFF
#undef AT_LOADT
#pragma unroll
    for (int i = 0; i < 8; ++i) { const int row = (tid_ >> 3) + 64 * i, ch = tid_ & 7;
        LAS v2u* p = (LAS v2u*)(lds + AT_XO + row * AT_XO_STRIDE + ch * 16);
        const v2u a = p[0], c = p[1];
        v4u o; o.x = a.x; o.y = a.y; o.z = c.x; o.w = c.y;
        *(GAS v4u*)(Y + ((size_t)b * SEQ + t0 + row) * DM + RWW + h * 64 + ch * 8) = o; }
    LDS_BARRIER();
}

__device__ __forceinline__ void quantize_tables(Frame& F, int gw, int ngw) {
    for (int m = gw; m < 2 * NEXP; m += ngw) {
        const int tab = m >= NEXP, row = tab ? m - NEXP : m;
        const GAS f32x4* xr = (const GAS f32x4*)(F.in[18 + tab] + (size_t)row * DM) + F.lane * 4;
        f32x4 v[4]; float am = 0.f;
#pragma unroll
        for (int j = 0; j < 4; ++j) { v[j] = xr[j]; am = fmaxf(am, fmaxf(fmaxf(fabsf(v[j].x), fabsf(v[j].y)), fmaxf(fabsf(v[j].z), fabsf(v[j].w)))); }
        am = wave_max(am);
        const float qmax = tab ? 224.f : 127.f;
        const float sc = am > 0.f ? am / qmax : 1.f, inv = am > 0.f ? qmax / am : 0.f;
        v4u o;
#pragma unroll
        for (int j = 0; j < 4; ++j) {
            if (tab) { int w = __builtin_amdgcn_cvt_pk_fp8_f32(v[j].x * inv, v[j].y * inv, 0, false); w = __builtin_amdgcn_cvt_pk_fp8_f32(v[j].z * inv, v[j].w * inv, w, true); o[j] = (unsigned)w; }
            else {
            const unsigned b0 = (unsigned)(int)rintf(v[j].x * inv) & 255u, b1 = (unsigned)(int)rintf(v[j].y * inv) & 255u,
                           b2 = (unsigned)(int)rintf(v[j].z * inv) & 255u, b3 = (unsigned)(int)rintf(v[j].w * inv) & 255u;
            o[j] = b0 | (b1 << 8) | (b2 << 16) | (b3 << 24); } }
        *(GAS v4u*)(F.ws + (tab ? WS_VQ : WS_UQ) + (size_t)row * DM + F.lane * 16) = o;
        if (F.lane == 0) ((float*)(F.ws + (tab ? WS_SV : WS_SU)))[row] = sc;
    }
}

__device__ __forceinline__ void p3_mixers(Frame& F) {
    if (F.wg < NB * NHR) {
        const int chain = F.wg;
        const float* Pg = (const float*)(F.ws + WS_PQ) + (size_t)chain * 8 * 4096; const float* Qg = Pg + (size_t)256 * 4096;
        rwkv_scan<7, 3>(F, Pg, Qg, (float*)(F.ws + WS_SSEG) + (size_t)chain * 8 * 4096, nullptr);
        asm volatile("s_waitcnt vmcnt(0)" ::: "memory");
        __syncthreads();
        if (F.tid == 0) {
            __builtin_amdgcn_fence(__ATOMIC_RELEASE, "agent");
            asm volatile("s_waitcnt vmcnt(0)" ::: "memory");
            (void)xb_add((unsigned*)F.ctl + CW_SCAN + 16 * chain, 1u);
        }
    }
#ifndef ATTN_REPS
#define ATTN_REPS 1
#endif
    for (int rep = 0; rep < ATTN_REPS; ++rep)
    if (F.G == 256) { for (int r = 0; r < 2; ++r) { const int v = r * 32 + (F.wg >> 3); attn_block(F, (((F.wg & 7) * 4 + (v >> 4)) << 4) | (v & 15)); } }
    else for (int item = F.wg; item < NB * NHA * (SEQ / 512); item += F.G) attn_block(F, item);
}

constexpr int TK_SKS = 272, TK_SKH = 0, TK_SKL = 2 * 128 * TK_SKS, TK_LUT = 2 * TK_SKL, TK_END = TK_LUT + 8 * 2048;
__device__ __forceinline__ unsigned f2ord(float f) { const unsigned u = __builtin_bit_cast(unsigned, f); return u ^ ((unsigned)((int)u >> 31) | 0x80000000u); }
__device__ __forceinline__ float ord2f(unsigned o) { const unsigned u = (o & 0x80000000u) ? (o ^ 0x80000000u) : ~o; return __builtin_bit_cast(float, u); }
__device__ __forceinline__ void ce_desc(unsigned& a, unsigned& b) { const unsigned mx = a > b ? a : b, mn = a > b ? b : a; a = mx; b = mn; }
template <int N, int OFF, int TOT> __device__ __forceinline__ void bitonic_sort_desc(unsigned (&v)[TOT]) {
#pragma unroll
    for (int k = 2; k <= N; k <<= 1)
#pragma unroll
        for (int j = k >> 1; j > 0; j >>= 1)
#pragma unroll
            for (int i = 0; i < N; ++i) { const int l = i ^ j; if (l > i) { if ((i & k) == 0) ce_desc(v[OFF + i], v[OFF + l]); else ce_desc(v[OFF + l], v[OFF + i]); } }
}
template <int OFFA, int OFFB, int TOT> __device__ __forceinline__ void merge_top16(unsigned (&v)[TOT]) {
#pragma unroll
    for (int i = 0; i < 16; ++i) { const unsigned x = v[OFFA + i], y = v[OFFB + 15 - i]; v[OFFA + i] = x > y ? x : y; }
#pragma unroll
    for (int j = 8; j > 0; j >>= 1)
#pragma unroll
        for (int i = 0; i < 16; ++i) { const int l = i ^ j; if (l > i) ce_desc(v[OFFA + i], v[OFFA + l]); }
}
__device__ __forceinline__ void top16_of_64(unsigned (&k)[64]) {
    bitonic_sort_desc<16, 0, 64>(k); bitonic_sort_desc<16, 16, 64>(k); bitonic_sort_desc<16, 32, 64>(k); bitonic_sort_desc<16, 48, 64>(k);
    merge_top16<0, 16, 64>(k); merge_top16<32, 48, 64>(k); merge_top16<0, 32, 64>(k);
}
__device__ __forceinline__ void p7_topk(Frame& F) {
    static_assert(TK_END <= LDSCTL_OFF, "topk LDS");
    const bf16* QP = (const bf16*)(F.ws + WS_QP);
    int* EID = (int*)(F.ws + WS_EID); float* GATE = (float*)(F.ws + WS_GATE);
    const float* sk = F.in[17];
    LAS unsigned char* lds = F.lds + RING_OFF;
    for (int e = F.tid; e < 2 * 128 * 64; e += NTHREADS) {
        const int c = e >> 13, k = (e >> 6) & 127, d2 = e & 63;
        const f32x2 v = *(const GAS f32x2*)(sk + (size_t)(c * 128 + k) * 128 + 2 * d2);
        const unsigned h0 = f2bf(v.x), h1 = f2bf(v.y);
        const float r0 = v.x - __builtin_bit_cast(float, h0 << 16), r1 = v.y - __builtin_bit_cast(float, h1 << 16);
        *(LAS unsigned*)(lds + TK_SKH + (c * 128 + k) * TK_SKS + d2 * 4) = h0 | (h1 << 16);
        *(LAS unsigned*)(lds + TK_SKL + (c * 128 + k) * TK_SKS + d2 * 4) = pk2(r0, r1);
    }
    __syncthreads();
    const int gw = F.wg * NWAVES + F.wave, NGW = F.G * NWAVES;
    for (int tile = gw; tile < T * PHEADS / 32; tile += NGW) {
        int lane_ = F.lane; asm volatile("" : "+v"(lane_));
        const int lane = lane_, hh = lane >> 5, cl = lane & 31;
        const int P = tile * 32 + cl, t = P >> 3, h = P & 7;
        unsigned kAB[2][16];
#pragma unroll
        for (int c = 0; c < 2; ++c) {
            bf16x8 qf[8];
            const bf16* qp = QP + (size_t)t * PQ + h * 256 + c * 128 + 8 * hh;
#pragma unroll
            for (int s2 = 0; s2 < 8; ++s2) qf[s2] = *(const GAS bf16x8*)(qp + 16 * s2);
            unsigned k[64];
#pragma unroll
            for (int mt = 0; mt < 4; ++mt) {
                f32x16 acc = zero16();
                const LAS unsigned char* ah = lds + TK_SKH + (c * 128 + mt * 32 + cl) * TK_SKS + 16 * hh;
                const LAS unsigned char* al = lds + TK_SKL + (c * 128 + mt * 32 + cl) * TK_SKS + 16 * hh;
#pragma unroll
                for (int s2 = 0; s2 < 8; ++s2) {
                    acc = __builtin_amdgcn_mfma_f32_32x32x16_bf16(*(const LAS bf16x8*)(ah + 32 * s2), qf[s2], acc, 0, 0, 0);
                    acc = __builtin_amdgcn_mfma_f32_32x32x16_bf16(*(const LAS bf16x8*)(al + 32 * s2), qf[s2], acc, 0, 0, 0); }
#pragma unroll
                for (int r = 0; r < 16; ++r) { const int idx = 32 * mt + (r & 3) + 8 * (r >> 2) + 4 * hh; k[mt * 16 + r] = (f2ord(acc[r]) & ~127u) | (unsigned)(127 - idx); }
            }
            top16_of_64(k);
            unsigned m[32];
#pragma unroll
            for (int i = 0; i < 16; ++i) { m[i] = k[i]; m[16 + i] = (unsigned)__shfl_xor((int)k[i], 32); }
            merge_top16<0, 16, 32>(m);
#pragma unroll
            for (int i = 0; i < 16; ++i) kAB[c][i] = m[i];
        }
        float fa[16], fb[16];
#pragma unroll
        for (int i = 0; i < 16; ++i) { fa[i] = ord2f(kAB[0][i] & ~127u); fb[i] = ord2f(kAB[1][i] & ~127u); }
        unsigned cd[64]; int n = 0;
#pragma unroll
        for (int i = 0; i < 16; ++i)
#pragma unroll
            for (int j = 0; j < 16; ++j) if ((i + 1) * (j + 1) <= 16) { cd[n] = (f2ord(fa[i] + fb[j]) & ~255u) | (unsigned)(255 - (i * 16 + j)); ++n; }
#pragma unroll
        for (int q = 50; q < 64; ++q) cd[q] = 0u;
        top16_of_64(cd);
        LAS unsigned char* lut = lds + TK_LUT + (F.wave * 64 + lane) * 32;
#pragma unroll
        for (int q = 0; q < 4; ++q) {
            unsigned wa = 0u, wb = 0u;
#pragma unroll
            for (int b4 = 0; b4 < 4; ++b4) { wa |= (127u - (kAB[0][4 * q + b4] & 127u)) << (8 * b4); wb |= (127u - (kAB[1][4 * q + b4] & 127u)) << (8 * b4); }
            *(LAS unsigned*)(lut + 4 * q) = wa; *(LAS unsigned*)(lut + 16 + 4 * q) = wb; }
        float gv[16]; float den = 0.f; const float mx = ord2f(cd[0] & ~255u);
#pragma unroll
        for (int q = 0; q < 16; ++q) { gv[q] = __expf(ord2f(cd[q] & ~255u) - mx); den += gv[q]; }
        const float inv = 1.f / den;
        asm volatile("s_waitcnt lgkmcnt(0)" ::: "memory");
        int ev[16];
#pragma unroll
        for (int q = 0; q < 16; ++q) { const unsigned pos = 255u - (cd[q] & 255u);
            const unsigned ia = *(const LAS unsigned char*)(lut + (pos >> 4)), ib = *(const LAS unsigned char*)(lut + 16 + (pos & 15u));
            ev[q] = (int)(ia * NKEYS + ib); }
        if (hh == 0) {
            int* ep = EID + (size_t)t * 128 + h * 16; float* gp = GATE + (size_t)t * 128 + h * 16;
#pragma unroll
            for (int q = 0; q < 4; ++q) {
                *(GAS v4u*)(ep + 4 * q) = (v4u){(unsigned)ev[4 * q], (unsigned)ev[4 * q + 1], (unsigned)ev[4 * q + 2], (unsigned)ev[4 * q + 3]};
                *(GAS f32x4*)(gp + 4 * q) = (f32x4){gv[4 * q] * inv, gv[4 * q + 1] * inv, gv[4 * q + 2] * inv, gv[4 * q + 3] * inv}; }
        }
        asm volatile("s_waitcnt lgkmcnt(0)" ::: "memory");
    }
}

constexpr int GA_WAVE_BYTES = 10752, GA_CNT = 4096, GA_OFF = 4096 + 128, GA_ACT = 4608, GA_XQ = 6656;
__device__ __forceinline__ int wave_sum_i(int v) { v += dppi<0xB1>(v); v += dppi<0x4E>(v); v += dppi<0x141>(v); v += dppi<0x140>(v);
    return (__builtin_amdgcn_readlane(v, 0) + __builtin_amdgcn_readlane(v, 16)) + (__builtin_amdgcn_readlane(v, 32) + __builtin_amdgcn_readlane(v, 48)); }
__device__ __forceinline__ void p8_gather(Frame& F, float* outp) {
    const bf16* XN = (const bf16*)(F.ws + WS_XN);
    const unsigned char* UQ = F.ws + WS_UQ; const unsigned char* VQ = F.ws + WS_VQ;
    const float* SU = (const float*)(F.ws + WS_SU); const float* SV = (const float*)(F.ws + WS_SV);
    const int* EID = (const int*)(F.ws + WS_EID); const float* GATE = (const float*)(F.ws + WS_GATE);
    const float* nf = F.in[20];
    const int gw = F.wg * NWAVES + F.wave, NGW = F.G * NWAVES;
    LAS unsigned char* wl = F.lds + RING_OFF + F.wave * GA_WAVE_BYTES;
    for (int tg = gw, sweep = 0; tg < T / 4; tg += NGW, ++sweep) {
        int lane_ = F.lane; asm volatile("" : "+v"(lane_));
        const int lane = lane_;
        int xq[4][4]; float sx[4];
#pragma unroll
        for (int tk = 0; tk < 4; ++tk) {
            const GAS v4u* xp = (const GAS v4u*)(XN + (size_t)(4 * tg + tk) * DM + lane * 16);
            const v4u a = xp[0], b = xp[1];
            float x[16]; x[0] = bflo(a.x); x[1] = bfhi(a.x); x[2] = bflo(a.y); x[3] = bfhi(a.y); x[4] = bflo(a.z); x[5] = bfhi(a.z); x[6] = bflo(a.w); x[7] = bfhi(a.w);
            x[8] = bflo(b.x); x[9] = bfhi(b.x); x[10] = bflo(b.y); x[11] = bfhi(b.y); x[12] = bflo(b.z); x[13] = bfhi(b.z); x[14] = bflo(b.w); x[15] = bfhi(b.w);
            float am = 0.f;
#pragma unroll
            for (int i = 0; i < 16; ++i) am = fmaxf(am, fabsf(x[i]));
            am = wave_max(am);
            const float rs_ = frsq(((const float*)(F.ws + WS_SSQ))[4 * tg + tk] * (1.f / DM) + RMS_EPS);
            sx[tk] = (am > 0.f ? am * (1.f / 127.f) : 1.f) * rs_; const float inv = am > 0.f ? 127.f / am : 0.f;
#pragma unroll
            for (int q = 0; q < 4; ++q) {
                const unsigned b0 = (unsigned)(int)rintf(x[4 * q] * inv) & 255u, b1 = (unsigned)(int)rintf(x[4 * q + 1] * inv) & 255u, b2 = (unsigned)(int)rintf(x[4 * q + 2] * inv) & 255u, b3 = (unsigned)(int)rintf(x[4 * q + 3] * inv) & 255u;
                xq[tk][q] = (int)(b0 | (b1 << 8) | (b2 << 16) | (b3 << 24)); }
            *(LAS v4u*)(wl + GA_XQ + tk * 1024 + lane * 16) = (v4u){(unsigned)xq[tk][0], (unsigned)xq[tk][1], (unsigned)xq[tk][2], (unsigned)xq[tk][3]};
        }
        LAS unsigned* cnt = (LAS unsigned*)(wl + GA_CNT); LAS unsigned* offs = (LAS unsigned*)(wl + GA_OFF);
        if (lane < 32) cnt[lane] = 0u;
        asm volatile("s_waitcnt lgkmcnt(0)" ::: "memory");
        int ee[8]; float gg[8]; unsigned pos[8];
#pragma unroll
        for (int tk = 0; tk < 4; ++tk) {
            const size_t base = (size_t)(4 * tg + tk) * 128;
            ee[2 * tk] = (EID[base + lane] & (NEXP - 1)) | (tk << 14); ee[2 * tk + 1] = (EID[base + 64 + lane] & (NEXP - 1)) | (tk << 14);
            gg[2 * tk] = GATE[base + lane]; gg[2 * tk + 1] = GATE[base + 64 + lane]; }
#pragma unroll
        for (int q = 0; q < 8; ++q) pos[q] = __hip_atomic_fetch_add(cnt + ((ee[q] >> 9) & 31), 1u, __ATOMIC_RELAXED, __HIP_MEMORY_SCOPE_WAVEFRONT);
        asm volatile("s_waitcnt lgkmcnt(0)" ::: "memory");
        if (lane < 32) {
            const int c0 = (int)cnt[lane]; int v = c0;
            v += __builtin_amdgcn_update_dpp(0, v, 0x111, 0xF, 0xF, true); v += __builtin_amdgcn_update_dpp(0, v, 0x112, 0xF, 0xF, true);
            v += __builtin_amdgcn_update_dpp(0, v, 0x114, 0xF, 0xF, true); v += __builtin_amdgcn_update_dpp(0, v, 0x118, 0xF, 0xF, true);
            const int row0 = __builtin_amdgcn_readlane(v, 15);
            offs[lane] = (unsigned)(v - c0 + (lane >= 16 ? row0 : 0));
        }
        asm volatile("s_waitcnt lgkmcnt(0)" ::: "memory");
#pragma unroll
        for (int q = 0; q < 8; ++q) { const unsigned idx = offs[(ee[q] >> 9) & 31] + pos[q];
            *(LAS unsigned*)(wl + idx * 4) = (unsigned)ee[q]; *(LAS float*)(wl + 2048 + idx * 4) = gg[q]; }
        asm volatile("s_waitcnt lgkmcnt(0)" ::: "memory");
        LAS float* act = (LAS float*)(wl + GA_ACT);
#ifndef UPASS_REPS
#define UPASS_REPS 1
#endif
        for (int urep = 0; urep < UPASS_REPS; ++urep)
        {
            const int grp = lane >> 4, l16 = lane & 15;
            const LAS unsigned* ents = (const LAS unsigned*)wl;
            LAS int* hbuf = (LAS int*)(wl + GA_ACT);
            v4u rb[2][2][4]; unsigned eb[2][2];
#define GA_ULOAD(ST, QD, Q_) do { const unsigned e_ = ents[(Q_) * 4 + grp]; eb[ST][QD] = e_; const GAS v4u* rp_ = (const GAS v4u*)(UQ + (size_t)(e_ & (NEXP - 1)) * DM + l16 * 64); \
                rb[ST][QD][0] = rp_[0]; rb[ST][QD][1] = rp_[1]; rb[ST][QD][2] = rp_[2]; rb[ST][QD][3] = rp_[3]; } while (0)
#define GA_UDOT(ST, QD, Q_) do { const LAS v4u* xp_ = (const LAS v4u*)(wl + GA_XQ + ((eb[ST][QD] >> 14) & 3u) * 1024 + l16 * 64); int d_ = 0; \
                _Pragma("unroll") for (int k_ = 0; k_ < 4; ++k_) { const v4u x_ = xp_[k_], r_ = rb[ST][QD][k_]; \
                    d_ = __builtin_amdgcn_sdot4((int)x_.x, (int)r_.x, d_, false); d_ = __builtin_amdgcn_sdot4((int)x_.y, (int)r_.y, d_, false); \
                    d_ = __builtin_amdgcn_sdot4((int)x_.z, (int)r_.z, d_, false); d_ = __builtin_amdgcn_sdot4((int)x_.w, (int)r_.w, d_, false); } \
                d_ += dppi<0xB1>(d_); d_ += dppi<0x4E>(d_); d_ += dppi<0x141>(d_); d_ += dppi<0x140>(d_); \
                if (l16 == 0) hbuf[(Q_) * 4 + grp] = d_; } while (0)
            GA_ULOAD(0, 0, 0); GA_ULOAD(0, 1, 1);
            for (int q2 = 0; q2 < 128; q2 += 4) {
                GA_ULOAD(1, 0, q2 + 2); GA_ULOAD(1, 1, q2 + 3);
                __builtin_amdgcn_sched_barrier(0);
                GA_UDOT(0, 0, q2); GA_UDOT(0, 1, q2 + 1);
                __builtin_amdgcn_sched_barrier(0);
                if (q2 + 4 < 128) { GA_ULOAD(0, 0, q2 + 4); GA_ULOAD(0, 1, q2 + 5); }
                __builtin_amdgcn_sched_barrier(0);
                GA_UDOT(1, 0, q2 + 2); GA_UDOT(1, 1, q2 + 3);
                __builtin_amdgcn_sched_barrier(0);
            }
#undef GA_ULOAD
#undef GA_UDOT
            asm volatile("s_waitcnt lgkmcnt(0)" ::: "memory");
#pragma unroll 2
            for (int it = 0; it < 8; ++it) { const int p = it * 64 + lane;
                const unsigned e_ = ents[p]; const float g_ = *(const LAS float*)(wl + 2048 + p * 4); const int hs = hbuf[p];
                const int ex_ = (int)(e_ & (NEXP - 1)), tk_ = (int)(e_ >> 14) & 3;
                const float sxl = tk_ == 0 ? sx[0] : (tk_ == 1 ? sx[1] : (tk_ == 2 ? sx[2] : sx[3]));
                const float h_ = (float)hs * (SU[ex_] * sxl);
                act[p] = 0.5f * h_ * (1.f + erff(h_ * 0.70710678118654752f)) * g_ * SV[ex_]; }
        }
        asm volatile("s_waitcnt lgkmcnt(0)" ::: "memory");
        float y[4][16];
#pragma unroll
        for (int tk = 0; tk < 4; ++tk) {
#pragma unroll
            for (int i = 0; i < 16; ++i) y[tk][i] = 0.f; }
#define GA_AXPY(V, A, TK) do { \
            _Pragma("unroll") for (int q_ = 0; q_ < 4; ++q_) { const int w_ = (int)(V)[q_]; const f32x2 lo_ = __builtin_amdgcn_cvt_pk_f32_fp8(w_, false), hi_ = __builtin_amdgcn_cvt_pk_f32_fp8(w_, true); \
                y[TK][4 * q_] += (A) * lo_.x; y[TK][4 * q_ + 1] += (A) * lo_.y; y[TK][4 * q_ + 2] += (A) * hi_.x; y[TK][4 * q_ + 3] += (A) * hi_.y; } } while (0)
        for (int ch = 0; ch < 8; ++ch) {
            const unsigned ent = *(const LAS unsigned*)(wl + (ch * 64 + lane) * 4);
            const float areg = act[ch * 64 + lane];
            v4u vb[2][8]; int eb[2][8];
#pragma unroll
            for (int q = 0; q < 8; ++q) { eb[0][q] = __builtin_amdgcn_readlane((int)ent, q); vb[0][q] = *(const GAS v4u*)(VQ + (size_t)(eb[0][q] & (NEXP - 1)) * DM + lane * 16); }
#pragma unroll
            for (int jb = 0; jb < 8; ++jb) {
                if (jb + 1 < 8) {
#pragma unroll
                    for (int q = 0; q < 8; ++q) { eb[(jb + 1) & 1][q] = __builtin_amdgcn_readlane((int)ent, 8 * (jb + 1) + q); vb[(jb + 1) & 1][q] = *(const GAS v4u*)(VQ + (size_t)(eb[(jb + 1) & 1][q] & (NEXP - 1)) * DM + lane * 16); } }
                __builtin_amdgcn_sched_barrier(0);
#pragma unroll
                for (int q = 0; q < 8; ++q) { const int tk_ = (eb[jb & 1][q] >> 14) & 3; const v4u v_ = vb[jb & 1][q]; const float a_ = rdlane(areg, 8 * jb + q);
                    if (tk_ == 0) GA_AXPY(v_, a_, 0); else if (tk_ == 1) GA_AXPY(v_, a_, 1); else if (tk_ == 2) GA_AXPY(v_, a_, 2); else GA_AXPY(v_, a_, 3); }
                __builtin_amdgcn_sched_barrier(0);
            }
        }
#undef GA_AXPY
#pragma unroll
        for (int tk = 0; tk < 4; ++tk) {
            float* hrow = F.out + (size_t)(4 * tg + tk) * DM + lane * 16;
            float hv[16]; float ss = 0.f;
#pragma unroll
            for (int q = 0; q < 4; ++q) { const f32x4 h4 = *(const GAS f32x4*)(hrow + 4 * q);
#pragma unroll
                for (int i = 0; i < 4; ++i) { const float v = h4[i] + y[tk][4 * q + i]; hv[4 * q + i] = v; ss += v * v; } }
            const float rstd = frsq(wave_sum(ss) * (1.f / DM) + RMS_EPS);
#pragma unroll
            for (int q = 0; q < 4; ++q) { const f32x4 n4 = *(const GAS f32x4*)(nf + lane * 16 + 4 * q);
                *(GAS f32x4*)(outp + (size_t)(4 * tg + tk) * DM + lane * 16 + 4 * q) = (f32x4){hv[4 * q] * rstd * n4[0], hv[4 * q + 1] * rstd * n4[1], hv[4 * q + 2] * rstd * n4[2], hv[4 * q + 3] * rstd * n4[3]}; }
        }
    }
}

struct Args { const float* in[21]; float* out; unsigned char* ws; int ph_lo, ph_hi; };
static_assert(sizeof(Args) == 21 * 8 + 8 + 8 + 8, "Args has no padding");

__global__ void __launch_bounds__(NTHREADS, 2) fwd_kernel(Args args) {
    extern __shared__ __attribute__((aligned(16))) unsigned char lds[];
    Frame F;
    F.lds = (LAS unsigned char*)lds;
    F.MISC = (volatile LAS unsigned*)(F.lds + MISC_OFF);
    F.tid = threadIdx.x; F.lane = F.tid & 63; F.wave = __builtin_amdgcn_readfirstlane(F.tid >> 6);
    F.G = gridDim.x; F.wg = blockIdx.x;
#pragma unroll
    for (int i = 0; i < 21; ++i) F.in[i] = args.in[i];
    F.out = args.out; F.ws = args.ws;
    F.ctl = (gu32*)(args.ws + WS_CTL);
    for (int u = F.tid; u < (LDS_BYTES - LDSCTL_OFF) / 4; u += NTHREADS) ((LAS unsigned*)(F.lds + LDSCTL_OFF))[u] = 0u;
    __syncthreads();
    const int lo = args.ph_lo, hi = args.ph_hi;
    const bool fused = (hi - lo) > 1;
    XcdBarrier bar; bar.bar = (unsigned*)(F.ctl + CW_BAR); bar.x = 0; bar.st = nullptr;
    if (fused) bar = xcd_barrier_post((unsigned*)(F.ctl + CW_BAR), F.MISC + 8);
#define IN(k) (lo <= (k) && (k) < hi)
#define REPS(k) (((REP_MASK >> (k)) & 1) ? 2 : 1)
#define REPLOOP(k) for (int rep_ = 0; rep_ < REPS(k); ++rep_, (rep_ < REPS(k) ? xcd_barrier(bar) : (void)0))
#define SEAM(k) do { if (IN(k) && IN((k) + 1)) xcd_barrier(bar); } while (0)

    if (IN(0)) { REPLOOP(0) { p0_prologue(F); p0_rope_table(F); } SEAM(0); }
    if (IN(1)) { REPLOOP(1) {
        pg8::Gemm g{(const bf16*)(F.ws + WS_XN), (const bf16*)(F.ws + WS_WIN), T, IN_COLS, DM}; pg8::StaticOrder S; S.init(T, IN_COLS, F.G, F.wg);
        pg8::EpiBf16 E{(bf16*)(F.ws + WS_Z), IN_COLS};
        pg8::gemm_phase<pg8::EpiBf16, pg8::StaticOrder, true, true>(F.lds + RING_OFF, g, S, E); }
        {
            const int nwg = (T / 256) * (IN_COLS / 256), rem = nwg % F.G;
            if (rem == 0) quantize_tables(F, F.wg * NWAVES + F.wave, F.G * NWAVES);
            else if (F.wg >= rem) quantize_tables(F, (F.wg - rem) * NWAVES + F.wave, (F.G - rem) * NWAVES);
        }
        SEAM(1);
    }
    if (IN(2)) { p2_rope(F); REPLOOP(2) { const int cnt = r13_count(F.wg, F.G); R1Pre P;
            if (cnt > 0) rwkv_r1_prefetch(F, r13_item(F.wg, F.G, 0), F.tid, P);
            bf16x8 bfr[4]; int hcur = -1;
            f32x4 cst[4];
            { const int n16 = F.lane & 15, g = F.lane >> 4;
#pragma unroll
              for (int rt = 0; rt < 4; ++rt)
#pragma unroll
                  for (int q = 0; q < 4; ++q) cst[rt][q] = (F.wave < 4 && 16 * rt + 4 * g + q == 16 * F.wave + n16) ? 1.f : 0.f; }
            for (int i = 0; i < cnt; ++i) { const int it = r13_item(F.wg, F.G, i), hh_ = (it >> 7) & 7;
                if (hh_ != hcur) { r1_load_bfrag(F, hh_, F.wave, F.lane, bfr); __syncthreads(); r1_load_params(F, hh_); __syncthreads(); hcur = hh_; }
                rwkv_r1_item(F, it, i + 1 < cnt ? r13_item(F.wg, F.G, i + 1) : -1, P, bfr, cst); }
            { const int n16 = F.lane & 15, g = F.lane >> 4; float* Pg = (float*)(F.ws + WS_PQ) + (size_t)F.wg * 4096; float* Qg = Pg + (size_t)256 * 4096;
              if (F.wave < 4) {
#pragma unroll
                  for (int rt = 0; rt < 4; ++rt)
#pragma unroll
                      for (int q = 0; q < 4; ++q) Pg[(16 * rt + 4 * g + q) * 64 + 16 * F.wave + n16] = cst[rt][q];
              } else {
#pragma unroll
                  for (int rt = 0; rt < 4; ++rt) *(GAS f32x4*)(Qg + (16 * (F.wave - 4) + n16) * 64 + 16 * rt + 4 * g) = cst[rt];
              } } }
        SEAM(2); }
    if (IN(3)) { REPLOOP(3) p3_mixers(F); }
    if (IN(4)) { REPLOOP(4) { const int cnt = r13_count(F.wg, F.G); R3Pre P;
            asm volatile("s_waitcnt vmcnt(0)" ::: "memory");
            __syncthreads();
            if (F.tid == 0) { unsigned* fl = (unsigned*)F.ctl + CW_SCAN + 16 * (F.wg >> 3); XB_SPIN(xb_ld(fl) == 0u, (unsigned*)(F.ctl + CW_BAR)); __builtin_amdgcn_fence(__ATOMIC_ACQUIRE, "agent"); }
            __syncthreads();
            {
                const int item0 = r13_item(F.wg, F.G, 0);
                rwkv_scan<15, 7>(F, F.out + (size_t)item0 * 4096, F.out + (size_t)T * RWW + (size_t)item0 * 4096, (float*)(F.ws + WS_RWSS) + (size_t)item0 * 4096, (const float*)(F.ws + WS_SSEG) + (size_t)F.wg * 4096);
                asm volatile("s_waitcnt vmcnt(0)" ::: "memory"); __syncthreads();
            }
            if (cnt > 0) rwkv_r3_prefetch(F, r13_item(F.wg, F.G, 0), F.tid, P);
            bf16x8 bfr[8]; int hcur = -1;
            for (int i = 0; i < cnt; ++i) { const int it = r13_item(F.wg, F.G, i), hh_ = (it >> 7) & 7;
                if (hh_ != hcur) { r3_load_bfrag(F, hh_, F.wave, F.lane, bfr); __syncthreads(); r3_load_params(F, hh_); __syncthreads(); hcur = hh_; }
                rwkv_r3_item(F, it, i + 1 < cnt ? r13_item(F.wg, F.G, i + 1) : -1, P, bfr); } }
        SEAM(4); }
    if (IN(5)) {
        pg8::Gemm g{(const bf16*)(F.ws + WS_YMIX), (const bf16*)(F.ws + WS_WOUT), T, DM, DM}; pg8::StaticOrder S; S.init(T, DM, F.G, F.wg);
        pg8::EpiF32Res E{F.in[0], F.out, DM, (bf16*)(F.ws + WS_XN), F.in[15], (float*)(F.ws + WS_SSQ)};
        pg8::gemm_phase<pg8::EpiF32Res, pg8::StaticOrder, true, true>(F.lds + RING_OFF, g, S, E);
        SEAM(5);
    }
    if (IN(6)) { REPLOOP(6) {
        pg8::Gemm g{(const bf16*)(F.ws + WS_XN), (const bf16*)(F.ws + WS_WQ), T, PQ, DM}; pg8::StaticOrder S; S.init(T, PQ, F.G, F.wg);
        pg8::EpiBf16Rs E{(bf16*)(F.ws + WS_QP), PQ, (const float*)(F.ws + WS_SSQ)};
        pg8::gemm_phase<pg8::EpiBf16Rs, pg8::StaticOrder, true, true>(F.lds + RING_OFF, g, S, E); }
        SEAM(6);
    }
    if (IN(7)) { REPLOOP(7) p7_topk(F); if (IN(8)) { asm volatile("s_waitcnt vmcnt(0)" ::: "memory"); __syncthreads(); } }
    if (IN(8)) { if (REPS(8) > 1) { p8_gather(F, (float*)(F.ws + WS_Z)); xcd_barrier(bar); } p8_gather(F, F.out); }
#undef IN
#undef SEAM
}

extern "C" void kernel_launch(void* const* d_in, const int* in_sizes, int n_in, void* d_out, int out_size, void* d_ws, size_t ws_size, hipStream_t stream) {
    static int grid = 0;
    if (grid == 0) {
        if (n_in != 21 || in_sizes[0] != T * DM || out_size != T * DM || ws_size < WS_END) {
            fprintf(stderr, "kernel_launch: unexpected shapes: n_in %d in0 %d out %d ws %zu (need %zu); nothing launched\n", n_in, n_in > 0 ? in_sizes[0] : -1, out_size, ws_size, (size_t)WS_END); grid = -1; return; }
        int dev = 0, cus = 0, per_cu = 0;
        if (hipGetDevice(&dev) != hipSuccess || hipDeviceGetAttribute(&cus, hipDeviceAttributeMultiprocessorCount, dev) != hipSuccess) { grid = -1; return; }
        if (hipFuncSetAttribute((const void*)fwd_kernel, hipFuncAttributeMaxDynamicSharedMemorySize, LDS_BYTES) != hipSuccess) { fprintf(stderr, "kernel_launch: hipFuncSetAttribute failed\n"); grid = -1; return; }
        if (hipOccupancyMaxActiveBlocksPerMultiprocessor(&per_cu, (const void*)fwd_kernel, NTHREADS, LDS_BYTES) != hipSuccess || per_cu < 1) { fprintf(stderr, "kernel_launch: occupancy query says %d\n", per_cu); per_cu = 1; }
        (void)hipGetLastError();
        grid = cus;
        if (cus != 256) { fprintf(stderr, "kernel_launch: the RWKV segment mapping assumes 256 CUs (got %d); nothing launched\n", cus); grid = -1; return; }
    }
    if (grid < 0) return;
    (void)hipMemsetAsync((char*)d_ws + WS_CTL, 0, CTL_ZERO_BYTES, stream);
    Args a{};
    for (int i = 0; i < 21; ++i) a.in[i] = (const float*)d_in[i];
    a.out = (float*)d_out; a.ws = (unsigned char*)d_ws;
    if (MK_N_LAUNCHES == 1) {
        a.ph_lo = 0; a.ph_hi = NPHASE;
        void* kargs[] = {&a};
        hipError_t e = hipLaunchCooperativeKernel((const void*)fwd_kernel, dim3(grid), dim3(NTHREADS), kargs, LDS_BYTES, stream);
        if (e != hipSuccess) fprintf(stderr, "kernel_launch: cooperative launch failed: %s (grid %d)\n", hipGetErrorString(e), grid);
    } else {
        for (int p = 0; p < NPHASE; ++p) { a.ph_lo = p; a.ph_hi = p + 1;
            hipLaunchKernelGGL(fwd_kernel, dim3(grid), dim3(NTHREADS), LDS_BYTES, stream, a); }
    }
}
```

```cpp
#include <hip/hip_runtime.h>
#include <cstdio>
#include <cstdint>

#ifndef MK_N_LAUNCHES
#define MK_N_LAUNCHES 1
#endif

#ifndef REP_MASK
#define REP_MASK 0
#endif
#define GAS __attribute__((address_space(1)))
#define LAS __attribute__((address_space(3)))
typedef unsigned short bf16;
typedef unsigned v4u __attribute__((ext_vector_type(4)));
typedef unsigned v2u __attribute__((ext_vector_type(2)));
typedef float f32x4 __attribute__((ext_vector_type(4)));
typedef float f32x2 __attribute__((ext_vector_type(2)));
typedef short bf16x8 __attribute__((ext_vector_type(8)));
typedef GAS unsigned gu32;
#define RLX_AGENT __ATOMIC_RELAXED, __HIP_MEMORY_SCOPE_AGENT
#define LDS_WAIT() asm volatile("s_waitcnt lgkmcnt(0)" ::: "memory")
#define VM_WAIT() asm volatile("s_waitcnt vmcnt(0)" ::: "memory")
#define LDS_BARRIER() do { asm volatile("s_waitcnt lgkmcnt(0)" ::: "memory"); __builtin_amdgcn_s_barrier(); asm volatile("" ::: "memory"); } while (0)

constexpr int DM = 1024, NB = 4, SEQ = 8192, T = NB * SEQ;
constexpr int HD = 64, RWW = 512, NHR = 8, NHA = 8;
constexpr int IN_COLS = 3328;
constexpr int C_R = 0, C_K = 512, C_V = 1024, C_WD = 1536, C_AD = 1600, C_GD = 1664, C_AQ = 1792, C_AK = 2304, C_AV = 2816;
constexpr int PHEADS = 8, NKEYS = 128, PQ = 2048, TOPK = 16, NEXP = 16384;
constexpr float RMS_EPS = 1e-6f, GN_EPS = 64e-5f;
constexpr int NWAVES = 8, NTHREADS = 512;
constexpr int NPHASE = 9;

constexpr size_t MiB = 1u << 20;
constexpr size_t WS_CTL = 0, CTL_ZERO_BYTES = 1 * MiB;
constexpr size_t WS_WIN = 2 * MiB;
constexpr size_t WS_WOUT = 10 * MiB;
constexpr size_t WS_WQ = 12 * MiB;
constexpr size_t WS_XN = 16 * MiB;
constexpr size_t WS_Z = 80 * MiB;
constexpr size_t WS_QP = 80 * MiB;
constexpr size_t WS_HB = 208 * MiB;
constexpr size_t WS_G = 288 * MiB;
constexpr size_t WS_YMIX = 352 * MiB;
constexpr size_t WS_UQ = 416 * MiB;
constexpr size_t WS_VQ = 432 * MiB;
constexpr size_t WS_SU = 448 * MiB;
constexpr size_t WS_SV = 449 * MiB;
constexpr size_t WS_EID = 480 * MiB;
constexpr size_t WS_GATE = 496 * MiB;
constexpr size_t WS_SSEG = 450 * MiB;
constexpr size_t WS_PQ = 456 * MiB;
constexpr size_t WS_END = 512 * MiB;
constexpr size_t WS_WUPT = 1 * MiB, WS_AUPT = WS_WUPT + 65536, WS_GUPT = WS_AUPT + 65536;
constexpr size_t WS_BONUS = 9 * MiB;
constexpr size_t WS_RWY0 = WS_XN;
constexpr size_t WS_RWSS = WS_G;
constexpr size_t WS_RWRH = WS_EID;

constexpr int CW_BAR = 4096;
constexpr int CW_SCAN = 16384;
constexpr size_t WS_SSQ = 256 * 1024;

typedef __bf16 hbf16x2_t __attribute__((ext_vector_type(2)));
__device__ __forceinline__ unsigned pk2(float lo, float hi) { const f32x2 v = {lo, hi}; const hbf16x2_t b = __builtin_convertvector(v, hbf16x2_t); return __builtin_bit_cast(unsigned, b); }
__device__ __forceinline__ unsigned f2bf(float f) { return pk2(f, 0.f) & 0xffffu; }
__device__ __forceinline__ float frcp(float x) { return __builtin_amdgcn_rcpf(x); }
__device__ __forceinline__ float frsq(float x) { return __builtin_amdgcn_rsqf(x); }
__device__ __forceinline__ float bflo(unsigned u) { return __builtin_bit_cast(float, u << 16); }
__device__ __forceinline__ float bfhi(unsigned u) { return __builtin_bit_cast(float, u & 0xffff0000u); }
__device__ __forceinline__ float bf2f(bf16 h) { return __builtin_bit_cast(float, (unsigned)h << 16); }

template <int CTRL> __device__ __forceinline__ float dppf(float x) { return __builtin_bit_cast(float, __builtin_amdgcn_update_dpp(0, __builtin_bit_cast(int, x), CTRL, 0xF, 0xF, true)); }
template <int CTRL> __device__ __forceinline__ int dppi(int x) { return __builtin_amdgcn_update_dpp(0, x, CTRL, 0xF, 0xF, true); }
__device__ __forceinline__ float rdlane(float v, int l) { return __builtin_bit_cast(float, __builtin_amdgcn_readlane(__builtin_bit_cast(int, v), l)); }
__device__ __forceinline__ float sum8(float v) { v += dppf<0xB1>(v); v += dppf<0x4E>(v); v += dppf<0x141>(v); return v; }
__device__ __forceinline__ float sum16(float v) { v = sum8(v); v += dppf<0x140>(v); return v; }
__device__ __forceinline__ float wave_sum(float v) { v = sum16(v);
    asm volatile("s_nop 1\n\tv_add_f32_dpp %0, %0, %0 row_bcast:15 row_mask:0xa bank_mask:0xf\n\ts_nop 1\n\tv_add_f32_dpp %0, %0, %0 row_bcast:31 row_mask:0xc bank_mask:0xf\n\ts_nop 0" : "+v"(v));
    return rdlane(v, 63); }
__device__ __forceinline__ float rows_add32(float v) { float a = v, b = v; asm volatile("s_nop 1\n\tv_permlane32_swap_b32 %0, %1\n\ts_nop 1" : "+v"(a), "+v"(b)); return a + b; }
__device__ __forceinline__ float rows_add16(float v) { float a = v, b = v; asm volatile("s_nop 1\n\tv_permlane16_swap_b32 %0, %1\n\ts_nop 1" : "+v"(a), "+v"(b)); return a + b; }
__device__ __forceinline__ float wave_sum16(const float (&X)[16], int lane) {
    const bool b0 = (lane & 1) != 0, b1 = (lane & 2) != 0, b2 = (lane & 4) != 0, b3 = (lane & 8) != 0;
    float Y8[8], Z4[4], U2[2], V;
#pragma unroll
    for (int m = 0; m < 8; ++m) { const float kp = b0 ? X[2 * m + 1] : X[2 * m], sd = b0 ? X[2 * m] : X[2 * m + 1]; Y8[m] = kp + dppf<0xB1>(sd); }
#pragma unroll
    for (int m = 0; m < 4; ++m) { const float kp = b1 ? Y8[2 * m + 1] : Y8[2 * m], sd = b1 ? Y8[2 * m] : Y8[2 * m + 1]; Z4[m] = kp + dppf<0x4E>(sd); }
#pragma unroll
    for (int m = 0; m < 2; ++m) { const float kp = b2 ? Z4[2 * m + 1] : Z4[2 * m], sd = b2 ? Z4[2 * m] : Z4[2 * m + 1]; U2[m] = kp + dppf<0x124>(sd); }
    { const float kp = b3 ? U2[1] : U2[0], sd = b3 ? U2[0] : U2[1]; V = kp + dppf<0x128>(sd); }
    return rows_add16(rows_add32(V));
}
__device__ __forceinline__ float wave_max(float v) {
    v = fmaxf(v, dppf<0xB1>(v)); v = fmaxf(v, dppf<0x4E>(v)); v = fmaxf(v, dppf<0x141>(v)); v = fmaxf(v, dppf<0x140>(v));
    return fmaxf(fmaxf(rdlane(v, 0), rdlane(v, 16)), fmaxf(rdlane(v, 32), rdlane(v, 48)));
}

namespace pg8 {
#define PG8_LAS __attribute__((address_space(3)))
typedef unsigned short bf16_t;
typedef unsigned u32x4 __attribute__((ext_vector_type(4)));
constexpr int BM = 256, BK = 64, HALF = 128, HTB = HALF * BK * 2, STAGE_BYTES = 8 * HTB, NXCD = 8, WGM = 8;
__host__ __device__ __forceinline__ int lds_byte(int r, int c) { const int st = (r >> 4) * 2 + (c >> 5), rr = r & 15, cc = c & 31, ob = rr * 64 + cc * 2; return st * 1024 + (ob ^ (((ob >> 9) & 1) << 5)); }
__host__ __device__ __forceinline__ void stage_rc(int b, int& R, int& C) { const int st = b / 1024, sb = b % 1024, swz = sb ^ (((sb >> 9) & 1) << 5); R = (st >> 1) * 16 + swz / 64; C = (st & 1) * 32 + (swz % 64) / 2; }
__host__ __device__ __forceinline__ int perm32(int rho) { const int n = rho >> 4, i = rho & 15; return 8 * (i >> 2) + 4 * n + (i & 3); }
struct Unit { int pm, pn; };
struct Gemm { const bf16_t* A; const bf16_t* Bt; int M, N, K; };
struct StaticOrder {
    int nM, nN, nwg, G, c;
    __host__ __device__ void init(int M, int N, int G_, int c_) { nM = M / BM; nN = N / BM; nwg = nM * nN; G = G_; c = c_; }
    __host__ __device__ bool next(int i, Unit& u) const {
        const long L = (long)i * G + c; if (L >= nwg) return false;
        int wgid = (int)L; { const int q = nwg / NXCD, r = nwg % NXCD, xcd = wgid % NXCD, off = wgid / NXCD; wgid = (xcd < r ? xcd * (q + 1) : r * (q + 1) + (xcd - r) * q) + off; }
        const int nig = WGM * nN, gid = wgid / nig, fm = gid * WGM, gsz = (nM - fm) < WGM ? (nM - fm) : WGM;
        u.pm = fm + ((wgid % nig) % gsz); u.pn = (wgid % nig) / gsz; return true;
    }
    __device__ __forceinline__ void a_ready(const Unit&) const {}
    __device__ __forceinline__ void done(const Unit&) const {}
};
__device__ __forceinline__ unsigned cvt_pk_bf16(float lo, float hi) { unsigned r; asm volatile("v_cvt_pk_bf16_f32 %0, %1, %2" : "=v"(r) : "v"(lo), "v"(hi)); return r; }
struct EpiBf16 {
    static constexpr bool PERM = true, AFTER_DRAIN = false;
    bf16_t* O; int ldc;
    __device__ __forceinline__ void operator()(const f32x4 (&acc)[2][2][4][2], const Unit& u, int wr, int wc, int fr, int fq) const {
        const int row0 = u.pm * BM + wr * 64 + fr; const int col0 = u.pn * BM + wc * 32 + 8 * fq;
#pragma unroll
        for (int ai = 0; ai < 2; ++ai)
#pragma unroll
            for (int m = 0; m < 4; ++m) { bf16_t* rowp = O + (size_t)(row0 + ai * HALF + m * 16) * ldc + col0;
#pragma unroll
                for (int bj = 0; bj < 2; ++bj) { const f32x4 v0 = acc[ai][bj][m][0], v1 = acc[ai][bj][m][1];
                    u32x4 w; w.x = cvt_pk_bf16(v0[0], v0[1]); w.y = cvt_pk_bf16(v0[2], v0[3]); w.z = cvt_pk_bf16(v1[0], v1[1]); w.w = cvt_pk_bf16(v1[2], v1[3]);
                    *(u32x4*)(rowp + bj * HALF) = w; } }
    }
};
struct EpiBf16Rope {
    static constexpr bool PERM = true, AFTER_DRAIN = false;
    bf16_t* O; int ldc; const float* tab; int seq, pn_lo, pn_hi;
    __device__ __forceinline__ void operator()(const f32x4 (&acc)[2][2][4][2], const Unit& u, int wr, int wc, int fr, int fq) const {
        const int row0 = u.pm * BM + wr * 64 + fr; const int col0 = u.pn * BM + wc * 32 + 8 * fq;
        if (u.pn < pn_lo || u.pn >= pn_hi) {
#pragma unroll
            for (int ai = 0; ai < 2; ++ai)
#pragma unroll
                for (int m = 0; m < 4; ++m) { bf16_t* rowp = O + (size_t)(row0 + ai * HALF + m * 16) * ldc + col0;
#pragma unroll
                    for (int bj = 0; bj < 2; ++bj) { const f32x4 v0 = acc[ai][bj][m][0], v1 = acc[ai][bj][m][1];
                        u32x4 w; w.x = cvt_pk_bf16(v0[0], v0[1]); w.y = cvt_pk_bf16(v0[2], v0[3]); w.z = cvt_pk_bf16(v1[0], v1[1]); w.w = cvt_pk_bf16(v1[2], v1[3]);
                        *(u32x4*)(rowp + bj * HALF) = w; } }
            return;
        }
        const int i0 = (wc & 1) * 16 + 4 * fq;
#pragma unroll
        for (int ai = 0; ai < 2; ++ai) {
            f32x4 cs[4][2];
#pragma unroll
            for (int m = 0; m < 4; ++m) { const int pos = (row0 + ai * HALF + m * 16) & (seq - 1); const float* tp = tab + ((size_t)pos * 32 + i0) * 2;
                cs[m][0] = *(const f32x4*)tp; cs[m][1] = *(const f32x4*)(tp + 4); }
#pragma unroll
            for (int m = 0; m < 4; ++m) { bf16_t* rowp = O + (size_t)(row0 + ai * HALF + m * 16) * ldc + col0;
                const f32x4 c0 = cs[m][0], c1 = cs[m][1];
#pragma unroll
                for (int bj = 0; bj < 2; ++bj) { const f32x4 v0 = acc[ai][bj][m][0], v1 = acc[ai][bj][m][1];
                    u32x4 w; w.x = cvt_pk_bf16(v0[0] * c0[0] - v0[1] * c0[1], v0[0] * c0[1] + v0[1] * c0[0]); w.y = cvt_pk_bf16(v0[2] * c0[2] - v0[3] * c0[3], v0[2] * c0[3] + v0[3] * c0[2]);
                    w.z = cvt_pk_bf16(v1[0] * c1[0] - v1[1] * c1[1], v1[0] * c1[1] + v1[1] * c1[0]); w.w = cvt_pk_bf16(v1[2] * c1[2] - v1[3] * c1[3], v1[2] * c1[3] + v1[3] * c1[2]);
                    *(u32x4*)(rowp + bj * HALF) = w; } }
        }
    }
};
struct EpiF32Res {
    static constexpr bool PERM = true, AFTER_DRAIN = false;
    const float* res; bf16_t* O; int ldc; float* ssq;
    __device__ __forceinline__ void operator()(const f32x4 (&acc)[2][2][4][2], const Unit& u, int wr, int wc, int fr, int fq) const {
        const int row0 = u.pm * BM + wr * 64 + fr; const int col0 = u.pn * BM + wc * 32 + 8 * fq;
#pragma unroll
        for (int ai = 0; ai < 2; ++ai) {
            f32x4 rr[4][2][2];
#pragma unroll
            for (int m = 0; m < 4; ++m)
#pragma unroll
                for (int bj = 0; bj < 2; ++bj) { const size_t off = (size_t)(row0 + ai * HALF + m * 16) * ldc + col0 + bj * HALF;
                    rr[m][bj][0] = *(const f32x4*)(res + off); rr[m][bj][1] = *(const f32x4*)(res + off + 4); }
#pragma unroll
            for (int m = 0; m < 4; ++m) { const int row = row0 + ai * HALF + m * 16; const size_t off = (size_t)row * ldc + col0; float sq = 0.f;
#pragma unroll
                for (int bj = 0; bj < 2; ++bj) { const f32x4 r0 = rr[m][bj][0], r1 = rr[m][bj][1];
                    const f32x4 h0 = acc[ai][bj][m][0] + r0, h1 = acc[ai][bj][m][1] + r1;
                    { u32x4 wh; wh.x = cvt_pk_bf16(h0[0], h0[1]); wh.y = cvt_pk_bf16(h0[2], h0[3]); wh.z = cvt_pk_bf16(h1[0], h1[1]); wh.w = cvt_pk_bf16(h1[2], h1[3]);
                      *(u32x4*)(O + off + bj * HALF) = wh; }
                    sq += (h0[0] * h0[0] + h0[1] * h0[1]) + (h0[2] * h0[2] + h0[3] * h0[3]) + (h1[0] * h1[0] + h1[1] * h1[1]) + (h1[2] * h1[2] + h1[3] * h1[3]);
                }
                sq += __shfl_xor(sq, 16); sq += __shfl_xor(sq, 32);
                if (fq == 0) atomicAdd(ssq + row, sq); }
        }
    }
};
struct EpiBf16Rs {
    static constexpr bool PERM = true, AFTER_DRAIN = false;
    bf16_t* O; int ldc; const float* ssq;
    __device__ __forceinline__ void operator()(const f32x4 (&acc)[2][2][4][2], const Unit& u, int wr, int wc, int fr, int fq) const {
        const int row0 = u.pm * BM + wr * 64 + fr; const int col0 = u.pn * BM + wc * 32 + 8 * fq;
        float sqv[2][4];
#pragma unroll
        for (int ai = 0; ai < 2; ++ai)
#pragma unroll
            for (int m = 0; m < 4; ++m) sqv[ai][m] = ssq[row0 + ai * HALF + m * 16];
#pragma unroll
        for (int ai = 0; ai < 2; ++ai)
#pragma unroll
            for (int m = 0; m < 4; ++m) { const int row = row0 + ai * HALF + m * 16; bf16_t* rowp = O + (size_t)row * ldc + col0;
                const float rs = __builtin_amdgcn_rsqf(sqv[ai][m] * (1.f / 1024.f) + 1e-6f);
#pragma unroll
                for (int bj = 0; bj < 2; ++bj) { const f32x4 v0 = acc[ai][bj][m][0] * rs, v1 = acc[ai][bj][m][1] * rs;
                    u32x4 w; w.x = cvt_pk_bf16(v0[0], v0[1]); w.y = cvt_pk_bf16(v0[2], v0[3]); w.z = cvt_pk_bf16(v1[0], v1[1]); w.w = cvt_pk_bf16(v1[2], v1[3]);
                    *(u32x4*)(rowp + bj * HALF) = w; } }
    }
};

template <class Epi, class Sched, bool ALIGN_EPI = false, bool SP2 = false>
__device__ __forceinline__ void gemm_phase(PG8_LAS unsigned char* lds, const Gemm g, const Sched& S, const Epi& E) {
    const int tid = threadIdx.x, wid = __builtin_amdgcn_readfirstlane(tid >> 6), lane = tid & 63, wr = wid >> 2, wc = wid & 3, fr = lane & 15, fq = lane >> 4;
    const int K = g.K, nt = K / BK;
    unsigned voffA[2], voffB[2];
#pragma unroll
    for (int i = 0; i < 2; ++i) { int R, C; stage_rc(tid * 16 + i * 8192, R, C); const int Rb = Epi::PERM ? ((R & ~31) + perm32(R & 31)) : R;
        voffA[i] = (unsigned)(R * K + C) * 2u; voffB[i] = (unsigned)(Rb * K + C) * 2u; }
    const size_t kstep = (size_t)(BK * 2);
    const size_t hstep = (size_t)HALF * K * 2;
    const size_t tstep = 2 * hstep;
    const unsigned ldsw = (unsigned)wid * 1024u;
    const int aoff = lds_byte(wr * 64 + fr, fq * 8), boff = lds_byte(wc * 32 + fr, fq * 8);
#define PG8_SA(b, h) (((b) * 2 + (h)) * HTB)
#define PG8_SB(b, h) ((4 + (b) * 2 + (h)) * HTB)
#define PG8_STAGE(bufoff, gbase, voff) do { _Pragma("unroll") for (int _i = 0; _i < 2; ++_i) \
        __builtin_amdgcn_global_load_lds((const unsigned*)((const char*)(gbase) + (voff)[_i]), (PG8_LAS unsigned*)(lds + (bufoff) + ldsw + _i * 8192), 16, 0, 0); } while (0)
#define PG8_LDA(dst, b, h) do { _Pragma("unroll") for (int m = 0; m < 4; ++m) _Pragma("unroll") for (int k = 0; k < 2; ++k) dst[m][k] = *(const PG8_LAS bf16x8*)(lds + PG8_SA(b, h) + aoff + m * 2048 + k * 1024); } while (0)
#define PG8_LDB(dst, b, h) do { _Pragma("unroll") for (int n = 0; n < 2; ++n) _Pragma("unroll") for (int k = 0; k < 2; ++k) dst[n][k] = *(const PG8_LAS bf16x8*)(lds + PG8_SB(b, h) + boff + n * 2048 + k * 1024); } while (0)
#define PG8_MMA(ai, bj, At, Bt) do { __builtin_amdgcn_s_setprio(1); _Pragma("unroll") for (int m = 0; m < 4; ++m) _Pragma("unroll") for (int n = 0; n < 2; ++n) _Pragma("unroll") for (int k = 0; k < 2; ++k) \
        acc[ai][bj][m][n] = __builtin_amdgcn_mfma_f32_16x16x32_bf16(Bt[n][k], At[m][k], acc[ai][bj][m][n], 0, 0, 0); __builtin_amdgcn_s_setprio(0); } while (0)
#define PG8_WAIT_V(n) asm volatile("s_waitcnt vmcnt(" #n ")" ::: "memory")
#define PG8_WAIT_L(n) asm volatile("s_waitcnt lgkmcnt(" #n ")" ::: "memory")
#define PG8_BAR __builtin_amdgcn_s_barrier()
#define PG8_SCHED __builtin_amdgcn_sched_barrier(0)
    Unit cur, nxt; int ui = 0;
    if (!S.next(0, cur)) return;
    f32x4 acc[2][2][4][2];
#pragma unroll
    for (int a = 0; a < 2; ++a)
#pragma unroll
        for (int b = 0; b < 2; ++b)
#pragma unroll
            for (int m = 0; m < 4; ++m)
#pragma unroll
                for (int n = 0; n < 2; ++n) acc[a][b][m][n] = (f32x4){0.f, 0.f, 0.f, 0.f};
    bf16x8 At[4][2], B0[2][2], B1[2][2];
    const char* cA = (const char*)g.A + (size_t)cur.pm * tstep; const char* cB = (const char*)g.Bt + (size_t)cur.pn * tstep;
    S.a_ready(cur);
    if constexpr (SP2) {
        PG8_STAGE(PG8_SB(0, 0), cB, voffB); PG8_STAGE(PG8_SB(0, 1), cB + hstep, voffB); PG8_STAGE(PG8_SA(0, 0), cA, voffA); PG8_STAGE(PG8_SA(0, 1), cA + hstep, voffA);
        if (wr == 1) PG8_BAR;
        PG8_WAIT_V(2); PG8_BAR;
        PG8_STAGE(PG8_SB(1, 0), cB + kstep, voffB); PG8_STAGE(PG8_SA(1, 0), cA + kstep, voffA); PG8_STAGE(PG8_SB(1, 1), cB + hstep + kstep, voffB);
        PG8_WAIT_V(6); PG8_BAR;
    } else {
        PG8_STAGE(PG8_SB(0, 0), cB, voffB); PG8_STAGE(PG8_SA(0, 0), cA, voffA); PG8_STAGE(PG8_SB(0, 1), cB + hstep, voffB); PG8_STAGE(PG8_SA(0, 1), cA + hstep, voffA);
        if (wr == 1) PG8_BAR;
        PG8_WAIT_V(4); PG8_BAR;
        PG8_STAGE(PG8_SB(1, 0), cB + kstep, voffB); PG8_STAGE(PG8_SA(1, 0), cA + kstep, voffA); PG8_STAGE(PG8_SB(1, 1), cB + hstep + kstep, voffB);
        PG8_WAIT_V(6); PG8_BAR;
    }
    for (;;) {
        const bool has_next = S.next(ui + 1, nxt);
        const char* nA = has_next ? (const char*)g.A + (size_t)nxt.pm * tstep : cA; const char* nB = has_next ? (const char*)g.Bt + (size_t)nxt.pn * tstep : cB;
        for (int t = 0; t < nt; t += 2) {
            const bool last = (t == nt - 2);
            const char* a1 = cA + (size_t)(t + 1) * kstep;
            const char* a2 = last ? nA : cA + (size_t)(t + 2) * kstep; const char* b2 = last ? nB : cB + (size_t)(t + 2) * kstep;
            const char* a3 = a2 + kstep; const char* b3 = b2 + kstep;
            if (last && has_next) S.a_ready(nxt);
            if constexpr (SP2) {
            PG8_LDB(B0, 0, 0); PG8_LDB(B1, 0, 1); PG8_SCHED; PG8_LDA(At, 0, 0); PG8_STAGE(PG8_SA(1, 1), a1 + hstep, voffA);
            PG8_WAIT_V(8); PG8_WAIT_L(0); PG8_BAR; PG8_MMA(0, 0, At, B0); PG8_MMA(0, 1, At, B1); PG8_BAR; PG8_SCHED;
            PG8_LDA(At, 0, 1); PG8_STAGE(PG8_SB(0, 0), b2, voffB); PG8_STAGE(PG8_SB(0, 1), b2 + hstep, voffB); PG8_STAGE(PG8_SA(0, 0), a2, voffA);
            PG8_WAIT_V(8); PG8_WAIT_L(0); PG8_BAR; PG8_MMA(1, 0, At, B0); PG8_MMA(1, 1, At, B1); PG8_BAR; PG8_SCHED;
            PG8_LDB(B0, 1, 0); PG8_LDB(B1, 1, 1); PG8_SCHED; PG8_LDA(At, 1, 0); PG8_STAGE(PG8_SA(0, 1), a2 + hstep, voffA);
            PG8_WAIT_V(8); PG8_WAIT_L(0); PG8_BAR; PG8_MMA(0, 0, At, B0); PG8_MMA(0, 1, At, B1); PG8_BAR; PG8_SCHED;
            PG8_LDA(At, 1, 1); PG8_STAGE(PG8_SB(1, 0), b3, voffB); PG8_STAGE(PG8_SB(1, 1), b3 + hstep, voffB); PG8_STAGE(PG8_SA(1, 0), a3, voffA);
            PG8_WAIT_V(8); PG8_WAIT_L(0); PG8_BAR; PG8_MMA(1, 0, At, B0); PG8_MMA(1, 1, At, B1); PG8_BAR; PG8_SCHED;
            } else {
            PG8_LDB(B0, 0, 0); PG8_SCHED; PG8_LDA(At, 0, 0); PG8_STAGE(PG8_SA(1, 1), a1 + hstep, voffA);
            PG8_WAIT_L(8); PG8_BAR; PG8_WAIT_L(0); PG8_MMA(0, 0, At, B0); PG8_BAR; PG8_SCHED;
            PG8_LDB(B1, 0, 1); PG8_STAGE(PG8_SB(0, 0), b2, voffB);
            PG8_BAR; PG8_WAIT_L(0); PG8_MMA(0, 1, At, B1); PG8_BAR;
            PG8_LDA(At, 0, 1); PG8_STAGE(PG8_SA(0, 0), a2, voffA);
            PG8_BAR; PG8_WAIT_L(0); PG8_MMA(1, 0, At, B0); PG8_BAR; PG8_SCHED;
            PG8_STAGE(PG8_SB(0, 1), b2 + hstep, voffB);
            PG8_WAIT_V(6); PG8_BAR; PG8_MMA(1, 1, At, B1); PG8_BAR;
            PG8_LDB(B0, 1, 0); PG8_SCHED; PG8_LDA(At, 1, 0); PG8_STAGE(PG8_SA(0, 1), a2 + hstep, voffA);
            PG8_WAIT_L(8); PG8_BAR; PG8_WAIT_L(0); PG8_MMA(0, 0, At, B0); PG8_BAR; PG8_SCHED;
            PG8_LDB(B1, 1, 1); PG8_STAGE(PG8_SB(1, 0), b3, voffB);
            PG8_BAR; PG8_WAIT_L(0); PG8_MMA(0, 1, At, B1); PG8_BAR;
            PG8_LDA(At, 1, 1); PG8_STAGE(PG8_SA(1, 0), a3, voffA);
            PG8_BAR; PG8_WAIT_L(0); PG8_MMA(1, 0, At, B0); PG8_BAR; PG8_SCHED;
            PG8_STAGE(PG8_SB(1, 1), b3 + hstep, voffB);
            PG8_WAIT_V(6); PG8_BAR; PG8_MMA(1, 1, At, B1); PG8_BAR;
            }
        }
        if constexpr (ALIGN_EPI) { if (wr == 0) PG8_BAR; }
        if constexpr (!Epi::AFTER_DRAIN) { E(acc, cur, wr, wc, fr, fq); S.done(cur); }
        if (!has_next) break;
#pragma unroll
        for (int a = 0; a < 2; ++a)
#pragma unroll
            for (int b = 0; b < 2; ++b)
#pragma unroll
                for (int m = 0; m < 4; ++m)
#pragma unroll
                    for (int n = 0; n < 2; ++n) acc[a][b][m][n] = (f32x4){0.f, 0.f, 0.f, 0.f};
        cur = nxt; cA = nA; cB = nB; ++ui;
        if constexpr (ALIGN_EPI) { if (wr == 1) PG8_BAR; }
    }
    PG8_WAIT_V(0);
    if constexpr (!ALIGN_EPI) { if (wr == 0) PG8_BAR; }
    PG8_BAR;
#undef PG8_SA
#undef PG8_SB
#undef PG8_STAGE
#undef PG8_LDA
#undef PG8_LDB
#undef PG8_MMA
#undef PG8_WAIT_V
#undef PG8_WAIT_L
#undef PG8_BAR
#undef PG8_SCHED
}
}

#define XB_TMO      128
#define XB_XCNT(j)  (256  + 64 * (j))
#define XB_XSUB(j)  (1280 + 64 * (j))
#define XB_XGEN(j)  (2304 + 64 * (j))
#define XB_TOP      3328
#define XB_TOPGEN   3392
#define XCD_BAR_WORDS 3456
#define XB_SPIN_CAP (1u << 22)
__device__ __forceinline__ unsigned xb_ld(unsigned* p)              { return __hip_atomic_load(p, __ATOMIC_RELAXED, __HIP_MEMORY_SCOPE_AGENT); }
__device__ __forceinline__ unsigned xb_add(unsigned* p, unsigned v) { return __hip_atomic_fetch_add(p, v, __ATOMIC_RELAXED, __HIP_MEMORY_SCOPE_AGENT); }
__device__ __forceinline__ unsigned xb_xcc_id() { return (unsigned)__builtin_amdgcn_s_getreg((3 << 11) | 20) & 0xFu; }
#define XB_SPIN(cond, bar) do { unsigned _sp = 0; while (cond) { __builtin_amdgcn_s_sleep(1); \
    if ((++_sp & 255u) == 0u) { if (xb_ld(&(bar)[XB_TMO])) break; if (_sp > XB_SPIN_CAP) { atomicAdd(&(bar)[XB_TMO], 1u); break; } } } } while (0)
struct XcdBarrier { unsigned* bar; unsigned x; volatile LAS unsigned* st; };
__device__ __forceinline__ XcdBarrier xcd_barrier_post(unsigned* bar, volatile LAS unsigned* st) {
    XcdBarrier b; b.bar = bar; b.x = xb_xcc_id(); b.st = st;
    if (threadIdx.x == 0) (void)xb_add(&bar[XB_XCNT(b.x)], 1u);
    return b;
}
__device__ __forceinline__ void xcd_barrier_complete(unsigned* bar, unsigned x, unsigned& nloc, unsigned& nx) {
    const unsigned G = gridDim.x * gridDim.y * gridDim.z;
    unsigned sum, cnt, mine, sp = 0u;
    for (;;) {
        sum = 0u; cnt = 0u; mine = 0u;
#pragma unroll
        for (unsigned j = 0; j < 16; ++j) { const unsigned c = xb_ld(&bar[XB_XCNT(j)]); sum += c; cnt += (c > 0u) ? 1u : 0u; mine = (j == x) ? c : mine; }
        if (sum == G) break;
        __builtin_amdgcn_s_sleep(1);
        if ((++sp & 255u) == 0u) { if (xb_ld(&bar[XB_TMO])) break; if (sp > XB_SPIN_CAP) { atomicAdd(&bar[XB_TMO], 1u); break; } }
    }
    nloc = mine > 0u ? mine : 1u; nx = cnt > 0u ? cnt : 1u;
}
__device__ __forceinline__ void xcd_barrier(const XcdBarrier& b) {
    asm volatile("s_waitcnt vmcnt(0)" ::: "memory");
    __syncthreads();
    if (threadIdx.x == 0) {
        unsigned* bar = b.bar;
        __builtin_amdgcn_s_waitcnt(0);
        unsigned nloc = b.st[0], nx = b.st[1];
        if (nloc == 0u) { xcd_barrier_complete(bar, b.x, nloc, nx); b.st[0] = nloc; b.st[1] = nx; }
        const unsigned old = xb_add(&bar[XB_XSUB(b.x)], 1u);
        const unsigned gen = old / nloc;
        if (old + 1u == (gen + 1u) * nloc) {
            __builtin_amdgcn_fence(__ATOMIC_RELEASE, "agent");
            asm volatile("s_waitcnt vmcnt(0)" ::: "memory");
            const unsigned og = xb_add(&bar[XB_TOP], 1u);
            const unsigned tg = og / nx;
            if (og + 1u == (tg + 1u) * nx) xb_add(&bar[XB_TOPGEN], 1u);
            else XB_SPIN(xb_ld(&bar[XB_TOPGEN]) == tg, bar);
            __builtin_amdgcn_fence(__ATOMIC_ACQUIRE, "agent");
            xb_add(&bar[XB_XGEN(b.x)], 1u);
            asm volatile("s_waitcnt vmcnt(0)" ::: "memory");
        } else {
            XB_SPIN(xb_ld(&bar[XB_XGEN(b.x)]) == gen, bar);
            __builtin_amdgcn_fence(__ATOMIC_ACQUIRE, "agent");
            asm volatile("s_waitcnt vmcnt(0)" ::: "memory");
        }
    }
    __syncthreads();
}

constexpr int RING_OFF = 0, RING_BYTES = 131072;
constexpr int LDSCTL_OFF = 162816, MISC_OFF = LDSCTL_OFF + 320;
constexpr int LDS_BYTES = 163840;

struct Frame {
    LAS unsigned char* lds;
    volatile LAS unsigned* MISC;
    gu32* ctl;
    int tid, lane, wave, G, wg;
    const float* in[21];
    float* out;
    unsigned char* ws;
};

__device__ __forceinline__ void p0_transpose_item(const float* W, int K, int N, bf16* WT, LAS float* scr, int item, int lane, const float* kscale = nullptr, int rp_lo = 0, int rp_hi = 0) {
    const int nblk = N / 32, kb = item / nblk, nb = item % nblk, k0 = 64 * kb, n0 = 32 * nb;
    const int nn = n0 + (lane & 31), pp = nn & 63; const int ncol = (nn >= rp_lo && nn < rp_hi) ? (nn & ~63) + (pp >> 1) + 32 * (pp & 1) : nn;
    float wv[32];
#pragma unroll
    for (int i = 0; i < 32; ++i) { const int kk = 2 * i + (lane >> 5); wv[i] = W[(size_t)(k0 + kk) * N + ncol] * (kscale ? kscale[k0 + kk] : 1.f); }
#pragma unroll
    for (int i = 0; i < 32; ++i) { const int kk = 2 * i + (lane >> 5); scr[kk * 33 + (lane & 31)] = wv[i]; }
    LDS_WAIT(); asm volatile("" ::: "memory");
    const int c = lane & 7;
#pragma unroll
    for (int j = 0; j < 4; ++j) { const int n = (lane >> 3) + 8 * j; const LAS float* s = scr + (8 * c) * 33 + n;
        v4u o; o.x = pk2(s[0 * 33], s[1 * 33]); o.y = pk2(s[2 * 33], s[3 * 33]); o.z = pk2(s[4 * 33], s[5 * 33]); o.w = pk2(s[6 * 33], s[7 * 33]);
        *(GAS v4u*)(WT + (size_t)(n0 + n) * K + k0 + 8 * c) = o; }
    LDS_WAIT(); asm volatile("" ::: "memory");
}
__device__ __forceinline__ void rms_row_to_bf16(int lane, const float* xrow, const float* gain, bf16* orow) {
    const GAS f32x4* xr = (const GAS f32x4*)xrow + lane;
    const GAS f32x4* gr = (const GAS f32x4*)gain + lane;
    f32x4 v[4]; float s = 0.f;
#pragma unroll
    for (int j = 0; j < 4; ++j) { v[j] = xr[64 * j]; s += (v[j].x * v[j].x + v[j].y * v[j].y) + (v[j].z * v[j].z + v[j].w * v[j].w); }
    const float rstd = frsq(wave_sum(s) * (1.f / DM) + RMS_EPS);
    GAS unsigned long long* o8 = (GAS unsigned long long*)orow + lane;
#pragma unroll
    for (int j = 0; j < 4; ++j) { const f32x4 gg = gr[64 * j];
        o8[64 * j] = (unsigned long long)pk2(v[j].x * rstd * gg.x, v[j].y * rstd * gg.y) | ((unsigned long long)pk2(v[j].z * rstd * gg.z, v[j].w * rstd * gg.w) << 32); }
}
__device__ __forceinline__ void quantize_tables(Frame& F, int gw, int ngw);
__device__ __forceinline__ void p0_prologue(Frame& F) {
    LAS float* scr = (LAS float*)(F.lds + RING_OFF + F.wave * 16384);
    const int gw = F.wg * NWAVES + F.wave, NGW = F.G * NWAVES;
    constexpr int I_IN = (DM / 64) * (IN_COLS / 32), I_OUT = (DM / 64) * (DM / 32), I_Q = (DM / 64) * (PQ / 32);
    constexpr int NITEMS = I_IN + I_OUT + I_Q;
    bf16* win_t = (bf16*)(F.ws + WS_WIN); bf16* wout_t = (bf16*)(F.ws + WS_WOUT); bf16* wq_t = (bf16*)(F.ws + WS_WQ);
    for (int it = gw; it < NITEMS; it += NGW) {
        int r = it;
        if (r < I_IN) { p0_transpose_item(F.in[2], DM, IN_COLS, win_t, scr, r, F.lane, nullptr, C_AQ, C_AV); continue; } r -= I_IN;
        if (r < I_OUT) { p0_transpose_item(F.in[14], DM, DM, wout_t, scr, r, F.lane); continue; } r -= I_OUT;
        p0_transpose_item(F.in[16], DM, PQ, wq_t, scr, r, F.lane, F.in[15]);
    }
    {
        constexpr int I_W = (64 / 64) * (RWW / 32), I_G = (128 / 64) * (RWW / 32);
        for (int it = gw; it < 2 * I_W + I_G; it += NGW) {
            int r = it;
            if (r < I_W) { p0_transpose_item(F.in[5], 64, RWW, (bf16*)(F.ws + WS_WUPT), scr, r, F.lane); continue; } r -= I_W;
            if (r < I_W) { p0_transpose_item(F.in[7], 64, RWW, (bf16*)(F.ws + WS_AUPT), scr, r, F.lane); continue; } r -= I_W;
            p0_transpose_item(F.in[8], 128, RWW, (bf16*)(F.ws + WS_GUPT), scr, r, F.lane);
        }
    }
    bf16* XN = (bf16*)(F.ws + WS_XN);
    {
        const GAS f32x4* gr = (const GAS f32x4*)F.in[1] + F.lane;
        f32x4 gg[4];
#pragma unroll
        for (int j = 0; j < 4; ++j) gg[j] = gr[64 * j];
#define P0_LD(V, ROW) do { const GAS f32x4* xr_ = (const GAS f32x4*)(F.in[0] + (size_t)(ROW) * DM) + F.lane; _Pragma("unroll") for (int j_ = 0; j_ < 4; ++j_) V[j_] = xr_[64 * j_]; } while (0)
#define P0_ST(V, ROW) do { float s_ = 0.f; _Pragma("unroll") for (int j_ = 0; j_ < 4; ++j_) s_ += (V[j_].x * V[j_].x + V[j_].y * V[j_].y) + (V[j_].z * V[j_].z + V[j_].w * V[j_].w); \
            const float rstd_ = frsq(wave_sum(s_) * (1.f / DM) + RMS_EPS); GAS unsigned long long* o8_ = (GAS unsigned long long*)(XN + (size_t)(ROW) * DM) + F.lane; \
            _Pragma("unroll") for (int j_ = 0; j_ < 4; ++j_) o8_[64 * j_] = (unsigned long long)pk2(V[j_].x * rstd_ * gg[j_].x, V[j_].y * rstd_ * gg[j_].y) | ((unsigned long long)pk2(V[j_].z * rstd_ * gg[j_].z, V[j_].w * rstd_ * gg[j_].w) << 32); } while (0)
        if (gw < T) {
            f32x4 A[4], B[4], NA[4], NB[4];
            int m = gw, ra = m, rb = m + NGW < T ? m + NGW : T - 1;
            P0_LD(A, ra); P0_LD(B, rb);
            for (;;) {
                const int m2 = m + 2 * NGW; const bool more = m2 < T;
                const int na = more ? m2 : ra, nb = more ? (m2 + NGW < T ? m2 + NGW : T - 1) : rb;
                P0_LD(NA, na); P0_LD(NB, nb);
                __builtin_amdgcn_sched_barrier(0);
                P0_ST(A, ra); P0_ST(B, rb);
                __builtin_amdgcn_sched_barrier(0);
                if (!more) break;
#pragma unroll
                for (int j = 0; j < 4; ++j) { A[j] = NA[j]; B[j] = NB[j]; }
                ra = na; rb = nb; m = m2;
            }
        }
#undef P0_LD
#undef P0_ST
    }
}

constexpr size_t WS_ROPE = WS_G;
__device__ __forceinline__ void p0_rope_table(Frame& F) {
    f32x2* tab = (f32x2*)(F.ws + WS_ROPE);
    for (int e = F.wg * NTHREADS + F.tid; e < SEQ * 32; e += F.G * NTHREADS) {
        const int sp = e >> 5, i = e & 31;
        const float inv_freq = powf(10000.0f, -(float)(2 * i) / 64.0f);
        const float ang = (float)sp * inv_freq;
        const double r = (double)ang - rint((double)ang * 0.15915494309189535) * 6.283185307179586;
        const float rf = (float)r;
        tab[e] = (f32x2){cosf(rf), sinf(rf)};
    }
}
__device__ __forceinline__ void p2_rope(Frame& F) {
    bf16* Z = (bf16*)(F.ws + WS_Z);
    const f32x2* tab = (const f32x2*)(F.ws + WS_ROPE);
    const int tid = F.tid, tk = tid >> 6, grp = (tid >> 2) & 15, i0 = (tid & 3) * 8;
    for (int blk = F.wg; blk < T / 8; blk += F.G) {
        const int g = blk * 8 + tk, sp = g & (SEQ - 1);
        bf16* p = Z + (size_t)g * IN_COLS + C_AQ + grp * 64 + i0;
        const v4u a = *(const GAS v4u*)p, b = *(const GAS v4u*)(p + 32);
        const GAS f32x4* tp = (const GAS f32x4*)(tab + sp * 32 + i0);
        float x1[8], x2[8];
        x1[0] = bflo(a.x); x1[1] = bfhi(a.x); x1[2] = bflo(a.y); x1[3] = bfhi(a.y); x1[4] = bflo(a.z); x1[5] = bfhi(a.z); x1[6] = bflo(a.w); x1[7] = bfhi(a.w);
        x2[0] = bflo(b.x); x2[1] = bfhi(b.x); x2[2] = bflo(b.y); x2[3] = bfhi(b.y); x2[4] = bflo(b.z); x2[5] = bfhi(b.z); x2[6] = bflo(b.w); x2[7] = bfhi(b.w);
        float o1[8], o2[8];
#pragma unroll
        for (int q = 0; q < 4; ++q) { const f32x4 cs = tp[q];
            o1[2 * q] = x1[2 * q] * cs[0] - x2[2 * q] * cs[1]; o2[2 * q] = x1[2 * q] * cs[1] + x2[2 * q] * cs[0];
            o1[2 * q + 1] = x1[2 * q + 1] * cs[2] - x2[2 * q + 1] * cs[3]; o2[2 * q + 1] = x1[2 * q + 1] * cs[3] + x2[2 * q + 1] * cs[2]; }
        v4u oa, ob; oa.x = pk2(o1[0], o1[1]); oa.y = pk2(o1[2], o1[3]); oa.z = pk2(o1[4], o1[5]); oa.w = pk2(o1[6], o1[7]);
        ob.x = pk2(o2[0], o2[1]); ob.y = pk2(o2[2], o2[3]); ob.z = pk2(o2[4], o2[5]); ob.w = pk2(o2[6], o2[7]);
        *(GAS v4u*)p = oa; *(GAS v4u*)(p + 32) = ob;
    }
}

typedef float f32x16 __attribute__((ext_vector_type(16)));
constexpr int SBS = 144;
constexpr int R1_EPRE = 0, R1_APRE = 16384, R1_AAB = 0, R1_X = 16384;
constexpr int R1_AT = 32768, R1_BT = 41984, R1_KT = 51200, R1_RT = 60416, R1_AHT = R1_BT, R1_U0T = R1_KT;
constexpr int R1_BBT = 69632, R1_KBT = 78848, R1_VT = 88064;
constexpr int R1_ACTW = 97280, R1_ACTA = 106496, R1_AAK = 97280, R1_ARB = 106496, R1_ARK = 115712;
constexpr int R1_BONUS = 124928, R1_WEND = 125184, R1_SEGS = 125440, R1_TII = 125440, R1_END = 129536;
constexpr int R1_PAR = R1_END;
static_assert(R1_PAR + 640 * 4 <= LDSCTL_OFF, "R1 LDS");
__device__ __forceinline__ int crow(int r, int hh) { return (r & 3) + 8 * (r >> 2) + 4 * hh; }
template <int KS> __device__ __forceinline__ f32x16 wtile(const LAS unsigned char* A, int sa, const LAS unsigned char* B, int sb, f32x16 acc, int lane) {
    const int row = lane & 31, hh = lane >> 5;
#pragma unroll
    for (int s = 0; s < KS; ++s) { const bf16x8 a = *(const LAS bf16x8*)(A + row * sa + 32 * s + 16 * hh); const bf16x8 b = *(const LAS bf16x8*)(B + row * sb + 32 * s + 16 * hh);
        acc = __builtin_amdgcn_mfma_f32_32x32x16_bf16(a, b, acc, 0, 0, 0); }
    return acc;
}
__device__ __forceinline__ f32x16 zero16() { f32x16 z;
#pragma unroll
    for (int r = 0; r < 16; ++r) z[r] = 0.f;
    return z; }

struct R1Pre { v4u wd[2], ad[2], z[4]; };
__device__ __forceinline__ int r13_item(int wg, int G, int idx) { return (wg >> 3) * 128 + (wg & 7) * 16 + idx; }
__device__ __forceinline__ int r13_count(int wg, int G) { return 16; }
__device__ __forceinline__ void rwkv_r1_prefetch(Frame& F, int item, int tid, R1Pre& P) {
    const int chain = item >> 7, chunk = item & 127, b = chain >> 3, h = chain & 7, g0 = b * SEQ + chunk * 64;
    const bf16* Z = (const bf16*)(F.ws + WS_Z);
    const v4u z0 = (v4u){0u, 0u, 0u, 0u};
    { const int t = tid >> 3, cg = tid & 7; const bool first = (chunk == 0 && t == 0);
      const bf16* zr = Z + (size_t)(g0 + t) * IN_COLS;
      P.wd[0] = *(const GAS v4u*)(zr + C_WD + cg * 8); P.ad[0] = *(const GAS v4u*)(zr + C_AD + cg * 8);
      P.wd[1] = z0; P.ad[1] = z0;
      if (!first) { P.wd[1] = *(const GAS v4u*)(zr - IN_COLS + C_WD + cg * 8); P.ad[1] = *(const GAS v4u*)(zr - IN_COLS + C_AD + cg * 8); } }
    { const bf16* zt = Z + (size_t)(g0 + (tid >> 3)) * IN_COLS + h * 64 + (tid & 7) * 8;
#pragma unroll
      for (int q = 0; q < 3; ++q) P.z[q] = *(const GAS v4u*)(zt + q * 512);
      P.z[3] = z0;
      if (tid < 24 && chunk != 0) P.z[3] = *(const GAS v4u*)(Z + (size_t)(g0 - 1) * IN_COLS + (tid >> 3) * 512 + h * 64 + (tid & 7) * 8); }
}
constexpr int R1_ZS = R1_AT, R1_ZSS = 384;
static_assert(65 * R1_ZSS <= 4 * 9216, "ZS fits in the At..Rt region");
__device__ __forceinline__ void r1_load_bfrag(Frame& F, int h, int w, int lane, bf16x8 (&bf)[4]) {
    const int p = w >> 2, nt = w & 1; const bf16* upt = (const bf16*)(F.ws + (p == 0 ? WS_WUPT : WS_AUPT)) + (size_t)(h * 64 + nt * 32 + (lane & 31)) * 64 + 8 * (lane >> 5);
#pragma unroll
    for (int s2 = 0; s2 < 4; ++s2) bf[s2] = *(const GAS bf16x8*)(upt + 16 * s2);
}
__device__ __forceinline__ void r1_load_params(Frame& F, int h) {
    LAS float* PAR = (LAS float*)(F.lds + RING_OFF + R1_PAR); const float* mu = F.in[3];
    const int k = F.wave, c = F.lane, col = h * 64 + c;
    const float* src = k == 0 ? mu + C_R : (k == 1 ? mu + C_K : (k == 2 ? mu + C_V : (k == 3 ? F.in[9] : (k == 4 ? F.in[10] : (k == 5 ? F.in[11] : (k == 6 ? F.in[4] : F.in[6]))))));
    PAR[128 + k * 64 + c] = src[col];
    if (k < 2) PAR[k * 64 + c] = mu[(k == 0 ? C_WD : C_AD) + c];
}
constexpr int R1_CF = R1_AAB, R1_CN = R1_X;
__device__ __forceinline__ void rwkv_r1_item(Frame& F, int item, int next_item, R1Pre& P, const bf16x8 (&bfr)[4], f32x4 (&cst)[4]) {
    const int chain = item >> 7, chunk = item & 127, b = chain >> 3, h = chain & 7;
    const int g0 = b * SEQ + chunk * 64;
    int tid_ = F.tid; asm volatile("" : "+v"(tid_));
    const int tid = tid_, lane = tid & 63, w = __builtin_amdgcn_readfirstlane(tid >> 6), hh = lane >> 5, cl = lane & 31;
    const bf16* Z = (const bf16*)(F.ws + WS_Z);
    LAS unsigned char* lds = F.lds + RING_OFF;
    const float* mu = F.in[3];
    {
        const int t = tid >> 3, cg = tid & 7;
        const v4u cw = P.wd[0], ca = P.ad[0], pw = P.wd[1], pa = P.ad[1];
        float fw[8], fa[8], qw[8], qa[8];
        fw[0] = bflo(cw.x); fw[1] = bfhi(cw.x); fw[2] = bflo(cw.y); fw[3] = bfhi(cw.y); fw[4] = bflo(cw.z); fw[5] = bfhi(cw.z); fw[6] = bflo(cw.w); fw[7] = bfhi(cw.w);
        fa[0] = bflo(ca.x); fa[1] = bfhi(ca.x); fa[2] = bflo(ca.y); fa[3] = bfhi(ca.y); fa[4] = bflo(ca.z); fa[5] = bfhi(ca.z); fa[6] = bflo(ca.w); fa[7] = bfhi(ca.w);
        qw[0] = bflo(pw.x); qw[1] = bfhi(pw.x); qw[2] = bflo(pw.y); qw[3] = bfhi(pw.y); qw[4] = bflo(pw.z); qw[5] = bfhi(pw.z); qw[6] = bflo(pw.w); qw[7] = bfhi(pw.w);
        qa[0] = bflo(pa.x); qa[1] = bfhi(pa.x); qa[2] = bflo(pa.y); qa[3] = bfhi(pa.y); qa[4] = bflo(pa.z); qa[5] = bfhi(pa.z); qa[6] = bflo(pa.w); qa[7] = bfhi(pa.w);
        const LAS float* PAR = (const LAS float*)(lds + R1_PAR);
        const f32x4 mw0 = *(const LAS f32x4*)(PAR + cg * 8), mw1 = *(const LAS f32x4*)(PAR + cg * 8 + 4), ma0 = *(const LAS f32x4*)(PAR + 64 + cg * 8), ma1 = *(const LAS f32x4*)(PAR + 64 + cg * 8 + 4);
#pragma unroll
        for (int j = 0; j < 8; ++j) { const float xw = fw[j] + (qw[j] - fw[j]) * (j < 4 ? mw0[j & 3] : mw1[j & 3]);
            const float ex = __expf(2.f * xw); fw[j] = 1.f - 2.f * frcp(ex + 1.f);
            fa[j] = fa[j] + (qa[j] - fa[j]) * (j < 4 ? ma0[j & 3] : ma1[j & 3]); }
        v4u ow, oa; ow.x = pk2(fw[0], fw[1]); ow.y = pk2(fw[2], fw[3]); ow.z = pk2(fw[4], fw[5]); ow.w = pk2(fw[6], fw[7]);
        oa.x = pk2(fa[0], fa[1]); oa.y = pk2(fa[2], fa[3]); oa.z = pk2(fa[4], fa[5]); oa.w = pk2(fa[6], fa[7]);
        *(LAS v4u*)(lds + R1_ACTW + t * SBS + cg * 16) = ow; *(LAS v4u*)(lds + R1_ACTA + t * SBS + cg * 16) = oa;
        { LAS unsigned char* zs_ = lds + R1_ZS + (1 + t) * R1_ZSS + cg * 16;
#pragma unroll
          for (int q = 0; q < 3; ++q) *(LAS v4u*)(zs_ + q * 128) = P.z[q];
          if (tid < 24) *(LAS v4u*)(lds + R1_ZS + tid * 16) = P.z[3]; }
        if (next_item >= 0) rwkv_r1_prefetch(F, next_item, tid, P);
    }
    LDS_BARRIER();
    {
        const int p = w >> 2, mt = (w >> 1) & 1, nt = w & 1;
        f32x16 acc = zero16();
        { const LAS unsigned char* A_ = lds + (p == 0 ? R1_ACTW : R1_ACTA) + mt * 32 * SBS + (lane & 31) * SBS + 16 * hh;
#pragma unroll
          for (int s2 = 0; s2 < 4; ++s2) acc = __builtin_amdgcn_mfma_f32_32x32x16_bf16(*(const LAS bf16x8*)(A_ + 32 * s2), bfr[s2], acc, 0, 0, 0); }
        LAS float* O = (LAS float*)(lds + (p == 0 ? R1_EPRE : R1_APRE));
#pragma unroll
        for (int r = 0; r < 16; ++r) O[(mt * 32 + crow(r, hh)) * 64 + nt * 32 + cl] = acc[r];
    }
    LDS_BARRIER();
    {
        const int c = tid & 63, ts = tid >> 6, col = h * 64 + c;
        const LAS float* PAR = (const LAS float*)(lds + R1_PAR) + 128 + c;
        const float mu_r = PAR[0], mu_k = PAR[64], mu_v = PAR[128], kkc = PAR[192], kac = PAR[256], rkc = PAR[320], w0c = PAR[384], a0c = PAR[448];
        const LAS float* EP = (const LAS float*)(lds + R1_EPRE); const LAS float* AP = (const LAS float*)(lds + R1_APRE);
        LAS float* SEGS = (LAS float*)(lds + R1_SEGS); LAS float* BON = (LAS float*)(lds + R1_BONUS);
        const LAS bf16* zb = (const LAS bf16*)(lds + R1_ZS + (8 * ts) * R1_ZSS) + c;
        float pr = bf2f(zb[0]), pk = bf2f(zb[64]), pv = bf2f(zb[128]);
        float rr[8], k2[8], ai[8], bi[8], vv[8], cs[8]; float run = 0.f;
        float X[16];
#pragma unroll
        for (int i = 0; i < 8; ++i) {
            const float zr = bf2f(zb[(i + 1) * (R1_ZSS / 2)]), zk = bf2f(zb[(i + 1) * (R1_ZSS / 2) + 64]), zv = bf2f(zb[(i + 1) * (R1_ZSS / 2) + 128]);
            const float r = zr + (pr - zr) * mu_r, k = zk + (pk - zk) * mu_k, v = zv + (pv - zv) * mu_v; pr = zr; pk = zk; pv = zv;
            const float e = 0.60653066f * frcp(1.f + __expf(-(w0c + EP[(8 * ts + i) * 64 + c])));
            const float a = frcp(1.f + __expf(-(a0c + AP[(8 * ts + i) * 64 + c])));
            const float kk = k * kkc;
            const float kq = k * (1.f + (a - 1.f) * kac);
            X[2 * i] = kk * kk; X[2 * i + 1] = r * kq * rkc;
            rr[i] = r; k2[i] = kq; ai[i] = kk; bi[i] = a; vv[i] = v; run += e; cs[i] = run;
        }
        SEGS[ts * 64 + c] = run;
        {
            const float V = wave_sum16(X, c);
            const float rnv = frsq(fmaxf(V, 1e-24f));
#pragma unroll
            for (int i = 0; i < 8; ++i) { const float kn = ai[i] * rdlane(rnv, 2 * i); ai[i] = -kn; bi[i] = kn * bi[i]; }
            if (c < 16 && (c & 1)) BON[8 * ts + (c >> 1)] = V;
        }
        LDS_BARRIER();
        float off = 0.f, tot = 0.f;
#pragma unroll
        for (int q = 0; q < 8; ++q) { const float sv = SEGS[q * 64 + c]; tot += sv; off += (q < ts) ? sv : 0.f; }
        float bb[8], kb[8];
        const float wend = __expf(-tot); float Wprev = __expf(-off);
#pragma unroll
        for (int i = 0; i < 8; ++i) { const float L = off + cs[i];
            const float Wi = __expf(-L), iW = frcp(Wi), We = wend * iW, Wm = Wprev; Wprev = Wi;
            bb[i] = bi[i] * We; kb[i] = k2[i] * We;
            ai[i] = ai[i] * Wm; bi[i] = bi[i] * iW; k2[i] = k2[i] * iW; rr[i] = rr[i] * Wi; }
#pragma unroll
        for (int i = 0; i < 8; i += 2) { const int t = 8 * ts + i;
            const unsigned wa = pk2(ai[i], ai[i + 1]), wb = pk2(bi[i], bi[i + 1]), wk = pk2(k2[i], k2[i + 1]), wr = pk2(rr[i], rr[i + 1]);
            *(LAS bf16*)(lds + R1_AT + t * SBS + c * 2) = (bf16)(wa & 0xffffu); *(LAS bf16*)(lds + R1_AT + (t + 1) * SBS + c * 2) = (bf16)(wa >> 16);
            *(LAS bf16*)(lds + R1_BT + t * SBS + c * 2) = (bf16)(wb & 0xffffu); *(LAS bf16*)(lds + R1_BT + (t + 1) * SBS + c * 2) = (bf16)(wb >> 16);
            *(LAS bf16*)(lds + R1_KT + t * SBS + c * 2) = (bf16)(wk & 0xffffu); *(LAS bf16*)(lds + R1_KT + (t + 1) * SBS + c * 2) = (bf16)(wk >> 16);
            *(LAS bf16*)(lds + R1_RT + t * SBS + c * 2) = (bf16)(wr & 0xffffu); *(LAS bf16*)(lds + R1_RT + (t + 1) * SBS + c * 2) = (bf16)(wr >> 16); }
        v4u o; o.x = pk2(bb[0], bb[1]); o.y = pk2(bb[2], bb[3]); o.z = pk2(bb[4], bb[5]); o.w = pk2(bb[6], bb[7]);
        *(LAS v4u*)(lds + R1_BBT + c * SBS + ts * 16) = o;
        o.x = pk2(kb[0], kb[1]); o.y = pk2(kb[2], kb[3]); o.z = pk2(kb[4], kb[5]); o.w = pk2(kb[6], kb[7]);
        *(LAS v4u*)(lds + R1_KBT + c * SBS + ts * 16) = o;
        o.x = pk2(vv[0], vv[1]); o.y = pk2(vv[2], vv[3]); o.z = pk2(vv[4], vv[5]); o.w = pk2(vv[6], vv[7]);
        *(LAS v4u*)(lds + R1_VT + c * SBS + ts * 16) = o;
        if (ts == 0) ((LAS float*)(lds + R1_WEND))[c] = wend;
    }
    LDS_BARRIER();
#pragma unroll
    for (int u = 0; u < 2; ++u) {
        const int idx = w * 2 + u, p = idx >> 2, mt = (idx >> 1) & 1, nt = idx & 1;
        const LAS unsigned char* Aop = lds + ((p == 0 || p == 2) ? R1_BT : R1_KT) + mt * 32 * SBS;
        const LAS unsigned char* Bop = lds + (p < 2 ? R1_AT : R1_RT) + nt * 32 * SBS;
        const int n = nt * 32 + cl;
        f32x16 acc = zero16();
        if (mt <= nt) {
            acc = wtile<4>(Aop, SBS, Bop, SBS, acc, lane);
            if (mt == nt) { const int lim = cl + (p >= 2 ? 1 : 0) - 4 * hh;
#pragma unroll
                for (int r = 0; r < 16; ++r) acc[r] = ((r & 3) + 8 * (r >> 2)) < lim ? acc[r] : 0.f; }
        }
#pragma unroll
        for (int g4 = 0; g4 < 4; ++g4) { const int m0 = mt * 32 + 8 * g4 + 4 * hh;
            if (p == 0) *(LAS f32x4*)(lds + R1_AAB + (n * 64 + m0) * 4) = (f32x4){acc[4 * g4], acc[4 * g4 + 1], acc[4 * g4 + 2], acc[4 * g4 + 3]};
            else { v2u o; o.x = pk2(acc[4 * g4], acc[4 * g4 + 1]); o.y = pk2(acc[4 * g4 + 2], acc[4 * g4 + 3]);
                   *(LAS v2u*)(lds + (p == 1 ? R1_AAK : (p == 2 ? R1_ARB : R1_ARK)) + n * SBS + m0 * 2) = o; } }
    }
    LDS_BARRIER();
    if (w < 4) {
        const int mt = w >> 1, nt = w & 1;
        const f32x16 acc = wtile<4>(lds + R1_AAK + mt * 32 * SBS, SBS, lds + R1_VT + nt * 32 * SBS, SBS, zero16(), lane);
        LAS float* X = (LAS float*)(lds + R1_X);
#pragma unroll
        for (int r = 0; r < 16; ++r) X[(mt * 32 + crow(r, hh)) * 64 + nt * 32 + cl] = acc[r];
    } else if (w == 4) {
        const int bk = lane >> 4, c = lane & 15;
        const LAS float* AAB = (const LAS float*)(lds + R1_AAB);
        float Tc[16]; const float fc = (float)c;
#pragma unroll
        for (int s2 = 0; s2 < 16; ++s2) Tc[s2] = fmaxf(0.f, 1.f - fabsf((float)s2 - fc));
#pragma unroll
        for (int r = 0; r < 15; ++r)
#pragma unroll
            for (int s2 = r + 1; s2 < 16; ++s2) Tc[s2] += AAB[(16 * bk + s2) * 64 + 16 * bk + r] * Tc[r];
        LAS float* TII = (LAS float*)(lds + R1_TII);
#pragma unroll
        for (int s2 = 0; s2 < 16; ++s2) TII[(bk * 16 + s2) * 16 + c] = Tc[s2];
    }
    LDS_BARRIER();
    {
        const int c16 = lane & 15, g = lane >> 4;
        const LAS float* AAB = (const LAS float*)(lds + R1_AAB); const LAS float* TII = (const LAS float*)(lds + R1_TII); const LAS float* X = (const LAS float*)(lds + R1_X);
        f32x4 o[4];
#pragma unroll
        for (int i = 0; i < 4; ++i) {
            f32x4 acc;
            if (w < 4) {
#pragma unroll
                for (int q = 0; q < 4; ++q) acc[q] = bf2f(*(const LAS bf16*)(lds + R1_AT + (16 * i + 4 * g + q) * SBS + (16 * w + c16) * 2));
            } else {
#pragma unroll
                for (int q = 0; q < 4; ++q) acc[q] = X[(16 * i + 4 * g + q) * 64 + 16 * (w - 4) + c16];
            }
#pragma unroll
            for (int j = 0; j < i; ++j) { const f32x4 a4 = *(const LAS f32x4*)(AAB + (16 * i + c16) * 64 + 16 * j + 4 * g);
#pragma unroll
                for (int q = 0; q < 4; ++q) acc = __builtin_amdgcn_mfma_f32_16x16x4f32(a4[q], o[j][q], acc, 0, 0, 0); }
            const f32x4 t4 = *(const LAS f32x4*)(TII + (i * 16 + c16) * 16 + 4 * g);
            f32x4 res = (f32x4){0.f, 0.f, 0.f, 0.f};
#pragma unroll
            for (int q = 0; q < 4; ++q) res = __builtin_amdgcn_mfma_f32_16x16x4f32(t4[q], acc[q], res, 0, 0, 0);
            o[i] = res;
            v2u ov; ov.x = pk2(res[0], res[1]); ov.y = pk2(res[2], res[3]);
            *(LAS v2u*)(lds + (w < 4 ? R1_AHT : R1_U0T) + (16 * (w & 3) + c16) * SBS + (16 * i + 4 * g) * 2) = ov;
        }
    }
    LDS_BARRIER();
    {
        float* Mg = F.out + (size_t)item * 4096; float* NTg = F.out + (size_t)T * RWW + (size_t)item * 4096;
        float* Y0g = (float*)(F.ws + WS_RWY0) + (size_t)item * 4096; bf16* RHg = (bf16*)(F.ws + WS_RWRH) + (size_t)item * 4096;
#pragma unroll
        for (int u = 0; u < 2; ++u) {
            const int idx = w * 2 + u, p = idx >> 2, mt = (idx >> 1) & 1, nt = idx & 1; const int n = nt * 32 + cl;
            if (p == 0) {
                f32x16 acc = wtile<4>(lds + R1_AHT + mt * 32 * SBS, SBS, lds + R1_BBT + nt * 32 * SBS, SBS, zero16(), lane);
                const float we = ((const LAS float*)(lds + R1_WEND))[n];
                const int dd = cl - 4 * hh;
                LAS unsigned char* fb_ = lds + R1_CF + ((nt * 2 + (cl >> 4)) * 2 + mt) * 2048 + hh * 256 + (cl & 15) * 16;
#pragma unroll
                for (int g4 = 0; g4 < 4; ++g4) { const int m0 = mt * 32 + 8 * g4 + 4 * hh;
                    f32x4 mv = (f32x4){acc[4 * g4], acc[4 * g4 + 1], acc[4 * g4 + 2], acc[4 * g4 + 3]};
                    if (mt == nt) {
#pragma unroll
                        for (int k = 0; k < 4; ++k) mv[k] += (8 * g4 + k == dd) ? we : 0.f; }
                    *(GAS f32x4*)(Mg + n * 64 + m0) = mv;
                    v2u h_; h_.x = pk2(mv[0], mv[1]); h_.y = pk2(mv[2], mv[3]);
                    v2u l_; l_.x = pk2(mv[0] - bflo(h_.x), mv[1] - bfhi(h_.x)); l_.y = pk2(mv[2] - bflo(h_.y), mv[3] - bfhi(h_.y));
                    LAS unsigned char* fp_ = fb_ + (g4 & 1) * 512 + (g4 >> 1) * 8;
                    *(LAS v2u*)fp_ = h_; *(LAS v2u*)(fp_ + 1024) = l_; }
            } else if (p == 1) {
                f32x16 acc = wtile<4>(lds + R1_BBT + mt * 32 * SBS, SBS, lds + R1_U0T + nt * 32 * SBS, SBS, zero16(), lane);
                acc = wtile<4>(lds + R1_KBT + mt * 32 * SBS, SBS, lds + R1_VT + nt * 32 * SBS, SBS, acc, lane);
#pragma unroll
                for (int g4 = 0; g4 < 4; ++g4) { const f32x4 nv_ = (f32x4){acc[4 * g4], acc[4 * g4 + 1], acc[4 * g4 + 2], acc[4 * g4 + 3]};
                    *(GAS f32x4*)(NTg + n * 64 + mt * 32 + 8 * g4 + 4 * hh) = nv_; *(LAS f32x4*)(lds + R1_CN + (n * 64 + mt * 32 + 8 * g4 + 4 * hh) * 4) = nv_; }
            } else if (p == 2) {
                f32x16 acc = wtile<4>(lds + R1_AHT + mt * 32 * SBS, SBS, lds + R1_ARB + nt * 32 * SBS, SBS, zero16(), lane);
#pragma unroll
                for (int g4 = 0; g4 < 4; ++g4) { const int m0 = mt * 32 + 8 * g4 + 4 * hh;
                    const v2u rt = *(const LAS v2u*)(lds + R1_RT + n * SBS + m0 * 2);
                    v2u ov; ov.x = pk2(acc[4 * g4] + bflo(rt.x), acc[4 * g4 + 1] + bfhi(rt.x)); ov.y = pk2(acc[4 * g4 + 2] + bflo(rt.y), acc[4 * g4 + 3] + bfhi(rt.y));
                    *(GAS v2u*)(RHg + n * 64 + m0) = ov; }
            } else {
                f32x16 acc = wtile<4>(lds + R1_U0T + mt * 32 * SBS, SBS, lds + R1_ARB + nt * 32 * SBS, SBS, zero16(), lane);
                acc = wtile<4>(lds + R1_VT + mt * 32 * SBS, SBS, lds + R1_ARK + nt * 32 * SBS, SBS, acc, lane);
#pragma unroll
                for (int g4 = 0; g4 < 4; ++g4) *(GAS f32x4*)(Y0g + n * 64 + mt * 32 + 8 * g4 + 4 * hh) = (f32x4){acc[4 * g4], acc[4 * g4 + 1], acc[4 * g4 + 2], acc[4 * g4 + 3]};
            }
        }
        if (tid < 64) ((float*)(F.ws + WS_BONUS))[(size_t)item * 64 + tid] = ((const LAS float*)(lds + R1_BONUS))[tid];
    }
    LDS_BARRIER();
    {
        const int n16 = lane & 15, g = lane >> 4;
        bf16x8 sh[2], sl[2];
#pragma unroll
        for (int ks = 0; ks < 2; ++ks) { const f32x4 a = cst[2 * ks], b = cst[2 * ks + 1];
            v4u h_; h_.x = pk2(a[0], a[1]); h_.y = pk2(a[2], a[3]); h_.z = pk2(b[0], b[1]); h_.w = pk2(b[2], b[3]);
            v4u l_; l_.x = pk2(a[0] - bflo(h_.x), a[1] - bfhi(h_.x)); l_.y = pk2(a[2] - bflo(h_.y), a[3] - bfhi(h_.y)); l_.z = pk2(b[0] - bflo(h_.z), b[1] - bfhi(h_.z)); l_.w = pk2(b[2] - bflo(h_.w), b[3] - bfhi(h_.w));
            sh[ks] = __builtin_bit_cast(bf16x8, h_); sl[ks] = __builtin_bit_cast(bf16x8, l_); }
        f32x4 nw[4];
#pragma unroll
        for (int rt = 0; rt < 4; ++rt) { f32x4 acc = (f32x4){0.f, 0.f, 0.f, 0.f};
            if (w >= 4) acc = *(const LAS f32x4*)(lds + R1_CN + ((16 * (w - 4) + n16) * 64 + 16 * rt + 4 * g) * 4);
#pragma unroll
            for (int ks = 0; ks < 2; ++ks) {
                const bf16x8 mh = *(const LAS bf16x8*)(lds + R1_CF + ((rt * 2 + ks) * 2) * 1024 + lane * 16), ml = *(const LAS bf16x8*)(lds + R1_CF + ((rt * 2 + ks) * 2 + 1) * 1024 + lane * 16);
                acc = __builtin_amdgcn_mfma_f32_16x16x32_bf16(mh, sh[ks], acc, 0, 0, 0);
                acc = __builtin_amdgcn_mfma_f32_16x16x32_bf16(mh, sl[ks], acc, 0, 0, 0);
                acc = __builtin_amdgcn_mfma_f32_16x16x32_bf16(ml, sh[ks], acc, 0, 0, 0); }
            nw[rt] = acc; }
#pragma unroll
        for (int rt = 0; rt < 4; ++rt) cst[rt] = nw[rt];
    }
    LDS_BARRIER();
}

constexpr int R2_RS = 272, R2_SLOT = 2 * 64 * R2_RS;
static_assert(2 * R2_SLOT <= LDSCTL_OFF, "R2 LDS");
template <int NSTEP, int R2_D> __device__ __forceinline__ void rwkv_scan(Frame& F, const float* Mg, const float* NTg, float* SSg, const float* S0g) {
    int tid_ = F.tid; asm volatile("" : "+v"(tid_));
    const int lane = tid_ & 63, w = __builtin_amdgcn_readfirstlane(tid_ >> 6);
    LAS unsigned char* lds = F.lds + RING_OFF;
    if (w >= 4) {
        const int L = w - 4, r = lane >> 2, f0 = (lane & 3) * 4;
        const size_t goff = (size_t)(16 * L + r) * 64 + f0 * 4;
        const int loff = (16 * L + r) * R2_RS + f0 * 16;
        f32x4 R[R2_D][8];
#define R2_ISSUE(slot_, step_) do { const int st_ = (step_) < NSTEP ? (step_) : NSTEP - 1; const float* mp_ = Mg + (size_t)st_ * 4096 + goff; const float* np_ = NTg + (size_t)st_ * 4096 + goff; \
            _Pragma("unroll") for (int k_ = 0; k_ < 4; ++k_) { R[slot_][k_] = *(const GAS f32x4*)(mp_ + 4 * k_); R[slot_][4 + k_] = *(const GAS f32x4*)(np_ + 4 * k_); } } while (0)
        const int q_ = lane & 3, froff = ((L * 2 + (q_ >> 1)) * 2) * 1024 + r * 16 + (q_ & 1) * 8;
#define R2_WRITE(slot_, buf_) do { LAS unsigned char* d_ = lds + (buf_) * R2_SLOT; \
            _Pragma("unroll") for (int k_ = 0; k_ < 4; ++k_) { const f32x4 a_ = R[slot_][k_]; \
                v2u h_; h_.x = pk2(a_[0], a_[1]); h_.y = pk2(a_[2], a_[3]); \
                v2u l_; l_.x = pk2(a_[0] - bflo(h_.x), a_[1] - bfhi(h_.x)); l_.y = pk2(a_[2] - bflo(h_.y), a_[3] - bfhi(h_.y)); \
                *(LAS v2u*)(d_ + froff + k_ * 256) = h_; *(LAS v2u*)(d_ + froff + 1024 + k_ * 256) = l_; \
                *(LAS f32x4*)(d_ + 64 * R2_RS + loff + 16 * k_) = R[slot_][4 + k_]; } } while (0)
#pragma unroll
        for (int u = 0; u < R2_D; ++u) R2_ISSUE(u, u);
        R2_WRITE(0, 0);
        R2_ISSUE(0, R2_D);
        LDS_BARRIER();
        int c0 = 0;
        for (; c0 + R2_D <= NSTEP - 1; c0 += R2_D) {
#pragma unroll
            for (int u = 0; u < R2_D; ++u) { const int c = c0 + u;
                R2_WRITE((u + 1) % R2_D, (c + 1) & 1);
                R2_ISSUE((u + 1) % R2_D, c + 1 + R2_D);
                LDS_BARRIER(); }
        }
#pragma unroll
        for (int u = 0; u < R2_D; ++u) { const int c = c0 + u;
            if (c < NSTEP - 1) { R2_WRITE((u + 1) % R2_D, (c + 1) & 1); LDS_BARRIER(); } }
        LDS_BARRIER();
#undef R2_ISSUE
#undef R2_WRITE
        return;
    }
    const int n16 = lane & 15, g = lane >> 4;
    f32x4 st[4];
#pragma unroll
    for (int rt = 0; rt < 4; ++rt) st[rt] = S0g ? *(const GAS f32x4*)(S0g + (16 * w + n16) * 64 + 16 * rt + 4 * g) : (f32x4){0.f, 0.f, 0.f, 0.f};
    LDS_BARRIER();
    for (int c = 0; c < NSTEP; ++c) {
#pragma unroll
        for (int rt = 0; rt < 4; ++rt) *(GAS f32x4*)(SSg + (size_t)c * 4096 + (16 * w + n16) * 64 + 16 * rt + 4 * g) = st[rt];
        const LAS unsigned char* sl_ = lds + (c & 1) * R2_SLOT;
        bf16x8 sh[2], sl[2];
#pragma unroll
        for (int ks = 0; ks < 2; ++ks) { const f32x4 a = st[2 * ks], b = st[2 * ks + 1];
            v4u h; h.x = pk2(a[0], a[1]); h.y = pk2(a[2], a[3]); h.z = pk2(b[0], b[1]); h.w = pk2(b[2], b[3]);
            v4u l; l.x = pk2(a[0] - bflo(h.x), a[1] - bfhi(h.x)); l.y = pk2(a[2] - bflo(h.y), a[3] - bfhi(h.y)); l.z = pk2(b[0] - bflo(h.z), b[1] - bfhi(h.z)); l.w = pk2(b[2] - bflo(h.w), b[3] - bfhi(h.w));
            sh[ks] = __builtin_bit_cast(bf16x8, h); sl[ks] = __builtin_bit_cast(bf16x8, l); }
        f32x4 nw[4];
#pragma unroll
        for (int rt = 0; rt < 4; ++rt) { f32x4 acc = *(const LAS f32x4*)(sl_ + 64 * R2_RS + (16 * w + n16) * R2_RS + (16 * rt + 4 * g) * 4);
#pragma unroll
            for (int ks = 0; ks < 2; ++ks) {
                const bf16x8 mh = *(const LAS bf16x8*)(sl_ + ((rt * 2 + ks) * 2) * 1024 + lane * 16), ml = *(const LAS bf16x8*)(sl_ + ((rt * 2 + ks) * 2 + 1) * 1024 + lane * 16);
                acc = __builtin_amdgcn_mfma_f32_16x16x32_bf16(mh, sh[ks], acc, 0, 0, 0);
                acc = __builtin_amdgcn_mfma_f32_16x16x32_bf16(mh, sl[ks], acc, 0, 0, 0);
                acc = __builtin_amdgcn_mfma_f32_16x16x32_bf16(ml, sh[ks], acc, 0, 0, 0); }
            nw[rt] = acc; }
#pragma unroll
        for (int rt = 0; rt < 4; ++rt) st[rt] = nw[rt];
        LDS_BARRIER();
    }
#pragma unroll
    for (int rt = 0; rt < 4; ++rt) *(GAS f32x4*)(SSg + (size_t)NSTEP * 4096 + (16 * w + n16) * 64 + 16 * rt + 4 * g) = st[rt];
}

constexpr int R3_RH = 0, R3_S = 9216, R3_SG = 18432, R3_SGS = 272, R3_YL = R3_SG + 64 * R3_SGS, R3_GL = R3_YL + 16384, R3_VS = R3_GL + 16384, R3_BON = R3_VS + 65 * 128, R3_END = R3_BON + 256;
constexpr int R3_PAR = R3_END;
static_assert(R3_PAR + 320 * 4 <= LDSCTL_OFF, "R3 LDS");
struct R3Pre { v4u rh; f32x4 ss[2]; v4u gd[2][2]; f32x4 y0[2]; v4u vv[2]; float bon; };
__device__ __forceinline__ void rwkv_r3_prefetch(Frame& F, int item, int tid, R3Pre& P) {
    const int chain = item >> 7, chunk = item & 127, b = chain >> 3, h = chain & 7, g0 = b * SEQ + chunk * 64;
    const bf16* Z = (const bf16*)(F.ws + WS_Z);
    const int t = tid >> 3, cg = tid & 7; const v4u z0 = (v4u){0u, 0u, 0u, 0u};
    P.rh = *(const GAS v4u*)((const bf16*)(F.ws + WS_RWRH) + (size_t)item * 4096 + t * 64 + cg * 8);
    const float* SSg = (const float*)(F.ws + WS_RWSS) + (size_t)item * 4096 + t * 64 + cg * 8;
    P.ss[0] = *(const GAS f32x4*)SSg; P.ss[1] = *(const GAS f32x4*)(SSg + 4);
    const bf16* zr = Z + (size_t)(g0 + t) * IN_COLS + C_GD + cg * 16; const bool first = (chunk == 0 && t == 0);
#pragma unroll
    for (int q = 0; q < 2; ++q) { P.gd[q][0] = *(const GAS v4u*)(zr + q * 8); P.gd[q][1] = z0; if (!first) P.gd[q][1] = *(const GAS v4u*)(zr - IN_COLS + q * 8); }
    const float* Y0g = (const float*)(F.ws + WS_RWY0) + (size_t)item * 4096;
    P.y0[0] = *(const GAS f32x4*)(Y0g + tid * 4); P.y0[1] = *(const GAS f32x4*)(Y0g + (tid + 512) * 4);
#pragma unroll
    for (int q = 0; q < 2; ++q) { const int p = tid + 512 * q; P.vv[q] = z0;
        if (p < 65 * 8) { const int row = p >> 3, ch = p & 7; if (!(chunk == 0 && row == 0)) P.vv[q] = *(const GAS v4u*)(Z + (size_t)(g0 - 1 + row) * IN_COLS + C_V + h * 64 + ch * 8); } }
    P.bon = tid < 64 ? ((const float*)(F.ws + WS_BONUS))[(size_t)item * 64 + tid] : 0.f;
}
__device__ __forceinline__ void r3_load_bfrag(Frame& F, int h, int w, int lane, bf16x8 (&bf)[8]) {
    const int nt = w & 1; const bf16* gut = (const bf16*)(F.ws + WS_GUPT) + (size_t)(h * 64 + nt * 32 + (lane & 31)) * 128 + 8 * (lane >> 5);
#pragma unroll
    for (int s2 = 0; s2 < 8; ++s2) bf[s2] = *(const GAS bf16x8*)(gut + 16 * s2);
}
__device__ __forceinline__ void r3_load_params(Frame& F, int h) {
    LAS float* PAR = (LAS float*)(F.lds + RING_OFF + R3_PAR); const float* mu = F.in[3];
    const int k = F.wave, c = F.lane, col = h * 64 + c;
    if (k < 2) PAR[k * 64 + c] = mu[C_GD + k * 64 + c];
    else if (k < 5) PAR[128 + (k - 2) * 64 + c] = (k == 2 ? mu + C_V : (k == 3 ? F.in[12] : F.in[13]))[col];
}
__device__ __forceinline__ void rwkv_r3_item(Frame& F, int item, int next_item, R3Pre& P, const bf16x8 (&bfr)[8]) {
    const int chain = item >> 7, chunk = item & 127, b = chain >> 3, h = chain & 7;
    const int g0 = b * SEQ + chunk * 64;
    int tid_ = F.tid; asm volatile("" : "+v"(tid_));
    const int tid = tid_, lane = tid & 63, w = __builtin_amdgcn_readfirstlane(tid >> 6), hh = lane >> 5, cl = lane & 31;
    LAS unsigned char* lds = F.lds + RING_OFF;
    const float* mu = F.in[3];
    {
        const int t = tid >> 3, cg = tid & 7;
        *(LAS v4u*)(lds + R3_RH + t * SBS + cg * 16) = P.rh;
        const f32x4 s0 = P.ss[0], s1 = P.ss[1];
        v4u o; o.x = pk2(s0[0], s0[1]); o.y = pk2(s0[2], s0[3]); o.z = pk2(s1[0], s1[1]); o.w = pk2(s1[2], s1[3]);
        *(LAS v4u*)(lds + R3_S + t * SBS + cg * 16) = o;
#pragma unroll
        for (int q = 0; q < 2; ++q) {
            const v4u cw = P.gd[q][0], pw = P.gd[q][1];
            float fw[8], qw[8];
            fw[0] = bflo(cw.x); fw[1] = bfhi(cw.x); fw[2] = bflo(cw.y); fw[3] = bfhi(cw.y); fw[4] = bflo(cw.z); fw[5] = bfhi(cw.z); fw[6] = bflo(cw.w); fw[7] = bfhi(cw.w);
            qw[0] = bflo(pw.x); qw[1] = bfhi(pw.x); qw[2] = bflo(pw.y); qw[3] = bfhi(pw.y); qw[4] = bflo(pw.z); qw[5] = bfhi(pw.z); qw[6] = bflo(pw.w); qw[7] = bfhi(pw.w);
            const f32x4 mg0 = *(const LAS f32x4*)(lds + R3_PAR + (cg * 16 + q * 8) * 4), mg1 = *(const LAS f32x4*)(lds + R3_PAR + (cg * 16 + q * 8 + 4) * 4);
#pragma unroll
            for (int j = 0; j < 8; ++j) { const float v = fw[j] + (qw[j] - fw[j]) * (j < 4 ? mg0[j & 3] : mg1[j & 3]); fw[j] = frcp(1.f + __expf(-v)); }
            v4u og; og.x = pk2(fw[0], fw[1]); og.y = pk2(fw[2], fw[3]); og.z = pk2(fw[4], fw[5]); og.w = pk2(fw[6], fw[7]);
            *(LAS v4u*)(lds + R3_SG + t * R3_SGS + (cg * 16 + q * 8) * 2) = og;
        }
        *(LAS f32x4*)(lds + R3_YL + tid * 16) = P.y0[0]; *(LAS f32x4*)(lds + R3_YL + (tid + 512) * 16) = P.y0[1];
#pragma unroll
        for (int q = 0; q < 2; ++q) { const int p = tid + 512 * q; if (p < 65 * 8) *(LAS v4u*)(lds + R3_VS + p * 16) = P.vv[q]; }
        if (tid < 64) ((LAS float*)(lds + R3_BON))[tid] = P.bon;
        if (next_item >= 0) rwkv_r3_prefetch(F, next_item, tid, P);
    }
    LDS_BARRIER();
    {
        const int mt = (w >> 1) & 1, nt = w & 1; const int n = nt * 32 + cl;
        if (w < 4) {
            LAS float* YL = (LAS float*)(lds + R3_YL);
            f32x16 acc;
#pragma unroll
            for (int r = 0; r < 16; ++r) acc[r] = YL[(mt * 32 + crow(r, hh)) * 64 + n];
            acc = wtile<4>(lds + R3_RH + mt * 32 * SBS, SBS, lds + R3_S + nt * 32 * SBS, SBS, acc, lane);
#pragma unroll
            for (int r = 0; r < 16; ++r) YL[(mt * 32 + crow(r, hh)) * 64 + n] = acc[r];
        } else {
            f32x16 acc = zero16();
            { const LAS unsigned char* A_ = lds + R3_SG + mt * 32 * R3_SGS + (lane & 31) * R3_SGS + 16 * hh;
#pragma unroll
              for (int s2 = 0; s2 < 8; ++s2) acc = __builtin_amdgcn_mfma_f32_32x32x16_bf16(*(const LAS bf16x8*)(A_ + 32 * s2), bfr[s2], acc, 0, 0, 0); }
            LAS float* GL = (LAS float*)(lds + R3_GL);
#pragma unroll
            for (int r = 0; r < 16; ++r) GL[(mt * 32 + crow(r, hh)) * 64 + n] = acc[r];
        }
    }
    LDS_BARRIER();
    {
        const int c = tid & 63, ts = tid >> 6, col = h * 64 + c;
        const LAS float* PAR = (const LAS float*)(lds + R3_PAR) + 128 + c;
        const float mu_v = PAR[0], gw = PAR[64], gb = PAR[128];
        const LAS float* YL = (const LAS float*)(lds + R3_YL); const LAS float* GL = (const LAS float*)(lds + R3_GL); const LAS float* BON = (const LAS float*)(lds + R3_BON);
        bf16* Y = (bf16*)(F.ws + WS_YMIX);
        const LAS bf16* vb = (const LAS bf16*)(lds + R3_VS) + (8 * ts) * 64 + c;
        float pv = bf2f(vb[0]);
        float yv[8], X[16];
#pragma unroll
        for (int i = 0; i < 8; ++i) { yv[i] = YL[(8 * ts + i) * 64 + c]; X[2 * i] = yv[i]; X[2 * i + 1] = yv[i] * yv[i]; }
        const float SV_ = wave_sum16(X, c);
        const float meanv = SV_ * (1.f / 64.f);
        const float rstdv = frsq(fmaxf(dppf<0xB1>(SV_) * (1.f / 64.f) - meanv * meanv, 0.f) + GN_EPS);
#pragma unroll
        for (int i = 0; i < 8; ++i) { const int t = 8 * ts + i;
            const float zv = bf2f(vb[(i + 1) * 64]); const float v = zv + (pv - zv) * mu_v; pv = zv;
            const float y = yv[i];
            const float d = y - rdlane(meanv, 2 * i);
            const float yn = d * rdlane(rstdv, 2 * i) * gw + gb;
            const float o = (yn + BON[t] * v) * GL[t * 64 + c];
            Y[(size_t)(g0 + t) * DM + col] = (bf16)f2bf(o); }
    }
    LDS_BARRIER();
}

typedef short s16x4 __attribute__((ext_vector_type(4)));
typedef short v4i16_t __attribute__((ext_vector_type(4)));
constexpr int AT_XO = 0, AT_XO_STRIDE = 136, AT_XM = 512 * AT_XO_STRIDE, AT_XL = AT_XM + 2048, AT_V = AT_XL + 2048, AT_K = AT_V + 8 * 4096, AT_KS = 144, AT_LDS_END = AT_K + 8 * 32 * AT_KS;
static_assert(AT_LDS_END <= LDSCTL_OFF, "attention LDS");
__device__ __forceinline__ float xhalf(float v) { return __shfl_xor(v, 32); }
__device__ __forceinline__ void attn_block(Frame& F, int item) {
    const int bh = item >> 4, blk = item & 15, b = bh >> 3, h = bh & 7, t0 = blk * 512;
    int tid_ = F.tid; asm volatile("" : "+v"(tid_));
    const int lane = tid_ & 63, w = __builtin_amdgcn_readfirstlane(tid_ >> 6), ql = lane & 31, hh = lane >> 5;
    const bf16* Zb = (const bf16*)(F.ws + WS_Z) + (size_t)b * SEQ * IN_COLS;
    bf16* Y = (bf16*)(F.ws + WS_YMIX);
    LAS unsigned char* lds = F.lds + RING_OFF;
    LAS unsigned char* Vw = lds + AT_V + w * 4096;
    LAS unsigned char* Kw = lds + AT_K + w * 32 * AT_KS;
    LAS float* XM = (LAS float*)(lds + AT_XM); LAS float* XL = (LAS float*)(lds + AT_XL);
    constexpr float C2 = 0.125f * 1.4426950408889634f;
    const int lrow = lane >> 3, lch = lane & 7;
    __builtin_amdgcn_s_waitcnt(0x0F70);
#define AT_PARAMS(SI, sh_, d_, rho_, tau_, tkb_) do { const int ps_ = (SI) >> 1; sh_ = ps_ == 0 ? 4 : (ps_ == 1 ? 2 : 0); d_ = 1 << sh_; \
        const int u_ = w + 8 * ((SI) & 1); rho_ = u_ & (d_ - 1); tau_ = u_ >> sh_; tkb_ = t0 + rho_ + (32 * tau_ - 128) * d_; } while (0)
    const GAS char* zb8 = (const GAS char*)Zb;
#define AT_VOFF(d_) ((unsigned)(lrow * (d_)) * (unsigned)(IN_COLS * 2) + (unsigned)(lch * 16))
#define AT_LOADQ(d_, rho_, tau_, vo_) do { const GAS char* sb_ = zb8 + ((size_t)(t0 + rho_ + 32 * tau_ * d_) * IN_COLS + C_AQ + h * 64) * 2; \
        _Pragma("unroll") for (int i_ = 0; i_ < 4; ++i_) qr[i_] = *(const GAS v4u*)(sb_ + (size_t)(i_ * 8 * d_) * (IN_COLS * 2) + vo_); } while (0)
#define AT_LOADT(KT, COL, d_, tkb_, vo_) do { const int tk_ = tkb_ + 32 * (KT) * d_, tc_ = tk_ < 0 ? 0 : tk_; const GAS char* sb_ = zb8 + ((size_t)tc_ * IN_COLS + (COL) + h * 64) * 2; \
        _Pragma("unroll") for (int i_ = 0; i_ < 4; ++i_) R[KT][i_] = *(const GAS v4u*)(sb_ + (size_t)(i_ * 8 * d_) * (IN_COLS * 2) + vo_); } while (0)
    v4u R[5][4], qr[4];
    { int sh, d, rho, tau, tkb; AT_PARAMS(0, sh, d, rho, tau, tkb);
      const unsigned vo = AT_VOFF(d);
      AT_LOADQ(d, rho, tau, vo);
#pragma unroll
      for (int kt = 0; kt < 5; ++kt) AT_LOADT(kt, C_AK, d, tkb, vo); }
#pragma unroll 1
    for (int si = 0; si < 6; ++si) {
        int sh, d, rho, tau, tkb; AT_PARAMS(si, sh, d, rho, tau, tkb);
        const int sn = si < 5 ? si + 1 : 5;
        int sh2, d2, rho2, tau2, tkb2; AT_PARAMS(sn, sh2, d2, rho2, tau2, tkb2);
        const int qoff = rho + (32 * tau + ql) * d;
        const unsigned vo = AT_VOFF(d), vo2 = AT_VOFF(d2);
        bf16x8 qf[4];
#pragma unroll
        for (int i = 0; i < 4; ++i) *(LAS v4u*)(Kw + (i * 8 + lrow) * AT_KS + lch * 16) = qr[i];
#pragma unroll
        for (int s = 0; s < 4; ++s) qf[s] = *(const LAS bf16x8*)(Kw + ql * AT_KS + 32 * s + 16 * hh);
        f32x16 sc[5];
        float m = -INFINITY;
#pragma unroll
        for (int kt = 0; kt < 5; ++kt) {
            const int tk0 = tkb + 32 * kt * d;
            bf16x8 kf[4];
#pragma unroll
            for (int i = 0; i < 4; ++i) *(LAS v4u*)(Kw + (i * 8 + lrow) * AT_KS + lch * 16) = R[kt][i];
            AT_LOADT(kt, C_AV, d, tkb, vo);
#pragma unroll
            for (int s = 0; s < 4; ++s) kf[s] = *(const LAS bf16x8*)(Kw + ql * AT_KS + 32 * s + 16 * hh);
            f32x16 acc = zero16();
#pragma unroll
            for (int s = 0; s < 4; ++s) acc = __builtin_amdgcn_mfma_f32_32x32x16_bf16(kf[s], qf[s], acc, 0, 0, 0);
            if (kt == 0 || kt == 4) {
#pragma unroll
                for (int r = 0; r < 16; ++r) { const int kidx = (r & 3) + 8 * (r >> 2) + 4 * hh;
                    const bool ok = (kt == 0) ? (kidx >= ql) : (kidx <= ql);
                    acc[r] = ok ? acc[r] : -INFINITY; }
            }
            float mt = acc[0];
#pragma unroll
            for (int r = 1; r < 16; ++r) mt = fmaxf(mt, acc[r]);
            m = tk0 < 0 ? m : fmaxf(m, mt);
            sc[kt] = acc;
        }
        m = fmaxf(m, xhalf(m));
        const float ms = m * C2;
        f32x2 l2 = (f32x2){0.f, 0.f};
        unsigned pw[5][8];
#pragma unroll
        for (int kt = 0; kt < 5; ++kt) {
            const float mk = (tkb + 32 * kt * d) < 0 ? INFINITY : ms;
#pragma unroll
            for (int r = 0; r < 8; ++r) {
                const f32x2 t2 = __builtin_elementwise_fma((f32x2){sc[kt][2 * r], sc[kt][2 * r + 1]}, (f32x2){C2, C2}, (f32x2){-mk, -mk});
                const f32x2 p2 = (f32x2){__builtin_amdgcn_exp2f(t2[0]), __builtin_amdgcn_exp2f(t2[1])};
                l2 += p2; pw[kt][r] = pk2(p2[0], p2[1]); }
        }
        float l = l2[0] + l2[1];
        l += xhalf(l);
        AT_LOADQ(d2, rho2, tau2, vo2);
        f32x16 O[2];
#pragma unroll
        for (int r = 0; r < 16; ++r) { O[0][r] = 0.f; O[1][r] = 0.f; }
#pragma unroll
        for (int kt = 0; kt < 5; ++kt) {
#pragma unroll
            for (int i = 0; i < 4; ++i) { const int kidx = i * 8 + lrow;
                *(LAS v4u*)(Vw + kidx * 128 + ((lch ^ (((kidx >> 1) & 1) << 2)) << 4)) = R[kt][i]; }
            AT_LOADT(kt, C_AK, d2, tkb2, vo2);
#pragma unroll
            for (int s = 0; s < 2; ++s) {
                v4u pq; pq.x = pw[kt][4 * s]; pq.y = pw[kt][4 * s + 1]; pq.z = pw[kt][4 * s + 2]; pq.w = pw[kt][4 * s + 3];
                const bf16x8 pf = __builtin_bit_cast(bf16x8, pq);
#pragma unroll
                for (int dt = 0; dt < 2; ++dt) {
                    bf16x8 vf;
#pragma unroll
                    for (int pp = 0; pp < 2; ++pp) {
                        const int i16 = lane & 15, db = (lane >> 4) & 1;
                        const int row = 16 * s + 8 * pp + 4 * hh + (i16 >> 2);
                        const int byte = 64 * dt + 32 * db + 8 * (i16 & 3);
                        const int chunk = (byte >> 4) ^ (((row >> 1) & 1) << 2);
                        const s16x4 t4 = __builtin_bit_cast(s16x4, __builtin_amdgcn_ds_read_tr16_b64_v4i16((LAS v4i16_t*)(Vw + row * 128 + (chunk << 4) + (byte & 15))));
                        vf[4 * pp + 0] = t4[0]; vf[4 * pp + 1] = t4[1]; vf[4 * pp + 2] = t4[2]; vf[4 * pp + 3] = t4[3];
                    }
                    O[dt] = __builtin_amdgcn_mfma_f32_32x32x16_bf16(vf, pf, O[dt], 0, 0, 0);
                }
            }
        }
        LAS unsigned char* xo = lds + AT_XO + qoff * AT_XO_STRIDE + 8 * hh;
        float wa = 0.f, wb = 1.f, Mx = ms, ln = l;
        if (si >= 2) { const float msa = XM[qoff], la = XL[qoff]; Mx = fmaxf(msa, ms); wa = la * __builtin_amdgcn_exp2f(msa - Mx); wb = __builtin_amdgcn_exp2f(ms - Mx); ln = wa + wb * l; }
        const float inv = 1.f / ln;
#pragma unroll
        for (int dt = 0; dt < 2; ++dt)
#pragma unroll
            for (int g4 = 0; g4 < 4; ++g4) {
                LAS v2u* p = (LAS v2u*)(xo + (32 * dt + 8 * g4) * 2);
                float o0 = O[dt][4 * g4] * wb, o1 = O[dt][4 * g4 + 1] * wb, o2 = O[dt][4 * g4 + 2] * wb, o3 = O[dt][4 * g4 + 3] * wb;
                if (si >= 2) { const v2u old = *p; o0 += bflo(old.x) * wa; o1 += bfhi(old.x) * wa; o2 += bflo(old.y) * wa; o3 += bfhi(old.y) * wa; }
                v2u nw; nw.x = pk2(o0 * inv, o1 * inv); nw.y = pk2(o2 * inv, o3 * inv);
                *p = nw;
            }
        if (hh == 0) { XM[qoff] = Mx; XL[qoff] = ln; }
        if (si & 1) LDS_BARRIER();
    }
#undef AT_PARAMS
#undef AT_LOADQ
#undef AT_VOFF
#undef AT_LOADT
#pragma unroll
    for (int i = 0; i < 8; ++i) { const int row = (tid_ >> 3) + 64 * i, ch = tid_ & 7;
        LAS v2u* p = (LAS v2u*)(lds + AT_XO + row * AT_XO_STRIDE + ch * 16);
        const v2u a = p[0], c = p[1];
        v4u o; o.x = a.x; o.y = a.y; o.z = c.x; o.w = c.y;
        *(GAS v4u*)(Y + ((size_t)b * SEQ + t0 + row) * DM + RWW + h * 64 + ch * 8) = o; }
    LDS_BARRIER();
}

__device__ __forceinline__ void quantize_tables(Frame& F, int gw, int ngw) {
    for (int m0 = gw; m0 < 2 * NEXP; m0 += 4 * ngw) {
        f32x4 v[4][4];
#pragma unroll
        for (int r = 0; r < 4; ++r) { const int m = min(m0 + r * ngw, 2 * NEXP - 1); const int tab = m >= NEXP, row = tab ? m - NEXP : m;
            const GAS f32x4* xr = (const GAS f32x4*)(F.in[18 + tab] + (size_t)row * DM) + F.lane * 4;
#pragma unroll
            for (int j = 0; j < 4; ++j) v[r][j] = xr[j]; }
#pragma unroll
        for (int r = 0; r < 4; ++r) { const int m = min(m0 + r * ngw, 2 * NEXP - 1); const int tab = m >= NEXP, row = tab ? m - NEXP : m;
            float am = 0.f;
#pragma unroll
            for (int j = 0; j < 4; ++j) am = fmaxf(am, fmaxf(fmaxf(fabsf(v[r][j].x), fabsf(v[r][j].y)), fmaxf(fabsf(v[r][j].z), fabsf(v[r][j].w))));
            am = wave_max(am);
            const float qmax = tab ? 224.f : 127.f;
            const float sc = am > 0.f ? am / qmax : 1.f, inv = am > 0.f ? qmax / am : 0.f;
            v4u o;
#pragma unroll
            for (int j = 0; j < 4; ++j) {
                if (tab) { int w = __builtin_amdgcn_cvt_pk_fp8_f32(v[r][j].x * inv, v[r][j].y * inv, 0, false); w = __builtin_amdgcn_cvt_pk_fp8_f32(v[r][j].z * inv, v[r][j].w * inv, w, true); o[j] = (unsigned)w; }
                else {
                const unsigned b0 = (unsigned)(int)rintf(v[r][j].x * inv) & 255u, b1 = (unsigned)(int)rintf(v[r][j].y * inv) & 255u,
                               b2 = (unsigned)(int)rintf(v[r][j].z * inv) & 255u, b3 = (unsigned)(int)rintf(v[r][j].w * inv) & 255u;
                o[j] = b0 | (b1 << 8) | (b2 << 16) | (b3 << 24); } }
            *(GAS v4u*)(F.ws + (tab ? WS_VQ : WS_UQ) + (size_t)row * DM + F.lane * 16) = o;
            if (F.lane == 0) ((float*)(F.ws + (tab ? WS_SV : WS_SU)))[row] = sc;
        }
    }
}

__device__ __forceinline__ void p3_mixers(Frame& F) {
    if (F.wg < NB * NHR) {
        const int chain = F.wg;
        const float* Pg = (const float*)(F.ws + WS_PQ) + (size_t)chain * 8 * 4096; const float* Qg = Pg + (size_t)256 * 4096;
        rwkv_scan<7, 3>(F, Pg, Qg, (float*)(F.ws + WS_SSEG) + (size_t)chain * 8 * 4096, nullptr);
        asm volatile("s_waitcnt vmcnt(0)" ::: "memory");
        __syncthreads();
        if (F.tid == 0) {
            __builtin_amdgcn_fence(__ATOMIC_RELEASE, "agent");
            asm volatile("s_waitcnt vmcnt(0)" ::: "memory");
            (void)xb_add((unsigned*)F.ctl + CW_SCAN + 16 * chain, 1u);
        }
    }
#ifndef ATTN_REPS
#define ATTN_REPS 1
#endif
    for (int rep = 0; rep < ATTN_REPS; ++rep)
    if (F.G == 256) { for (int r = 0; r < 2; ++r) { const int v = r * 32 + (F.wg >> 3); attn_block(F, (((F.wg & 7) * 4 + (v >> 4)) << 4) | (v & 15)); } }
    else for (int item = F.wg; item < NB * NHA * (SEQ / 512); item += F.G) attn_block(F, item);
}

constexpr int TK_SKS = 272, TK_SKH = 0, TK_SKL = 2 * 128 * TK_SKS, TK_LUT = 2 * TK_SKL, TK_END = TK_LUT + 8 * 2048;
__device__ __forceinline__ unsigned f2ord(float f) { const unsigned u = __builtin_bit_cast(unsigned, f); return u ^ ((unsigned)((int)u >> 31) | 0x80000000u); }
__device__ __forceinline__ float ord2f(unsigned o) { const unsigned u = (o & 0x80000000u) ? (o ^ 0x80000000u) : ~o; return __builtin_bit_cast(float, u); }
__device__ __forceinline__ void ce_desc(unsigned& a, unsigned& b) { const unsigned mx = a > b ? a : b, mn = a > b ? b : a; a = mx; b = mn; }
template <int N, int OFF, int TOT> __device__ __forceinline__ void bitonic_sort_desc(unsigned (&v)[TOT]) {
#pragma unroll
    for (int k = 2; k <= N; k <<= 1)
#pragma unroll
        for (int j = k >> 1; j > 0; j >>= 1)
#pragma unroll
            for (int i = 0; i < N; ++i) { const int l = i ^ j; if (l > i) { if ((i & k) == 0) ce_desc(v[OFF + i], v[OFF + l]); else ce_desc(v[OFF + l], v[OFF + i]); } }
}
template <int OFFA, int OFFB, int TOT> __device__ __forceinline__ void merge_top16(unsigned (&v)[TOT]) {
#pragma unroll
    for (int i = 0; i < 16; ++i) { const unsigned x = v[OFFA + i], y = v[OFFB + 15 - i]; v[OFFA + i] = x > y ? x : y; }
#pragma unroll
    for (int j = 8; j > 0; j >>= 1)
#pragma unroll
        for (int i = 0; i < 16; ++i) { const int l = i ^ j; if (l > i) ce_desc(v[OFFA + i], v[OFFA + l]); }
}
__device__ __forceinline__ void top16_of_64(unsigned (&k)[64]) {
    bitonic_sort_desc<16, 0, 64>(k); bitonic_sort_desc<16, 16, 64>(k); bitonic_sort_desc<16, 32, 64>(k); bitonic_sort_desc<16, 48, 64>(k);
    merge_top16<0, 16, 64>(k); merge_top16<32, 48, 64>(k); merge_top16<0, 32, 64>(k);
}
#ifndef TK_SPLIT_KEYS
#define TK_SPLIT_KEYS 0
#endif
__device__ __forceinline__ void p7_topk(Frame& F) {
    static_assert(TK_END <= LDSCTL_OFF, "topk LDS");
    const bf16* QP = (const bf16*)(F.ws + WS_QP);
    int* EID = (int*)(F.ws + WS_EID); float* GATE = (float*)(F.ws + WS_GATE);
    const float* sk = F.in[17];
    LAS unsigned char* lds = F.lds + RING_OFF;
    {
        static_assert(2 * 128 * 64 == 32 * NTHREADS, "sub-key staging");
        f32x2 v[32];
#pragma unroll
        for (int j = 0; j < 32; ++j) { const int e = F.tid + j * NTHREADS, c = e >> 13, k = (e >> 6) & 127, d2 = e & 63;
            v[j] = *(const GAS f32x2*)(sk + (size_t)(c * 128 + k) * 128 + 2 * d2); }
#pragma unroll
        for (int j = 0; j < 32; ++j) { const int e = F.tid + j * NTHREADS, c = e >> 13, k = (e >> 6) & 127, d2 = e & 63;
            const unsigned hp = pk2(v[j].x, v[j].y);
            *(LAS unsigned*)(lds + TK_SKH + (c * 128 + k) * TK_SKS + d2 * 4) = hp;
#if TK_SPLIT_KEYS
            *(LAS unsigned*)(lds + TK_SKL + (c * 128 + k) * TK_SKS + d2 * 4) = pk2(v[j].x - bflo(hp), v[j].y - bfhi(hp));
#endif
        }
    }
    __syncthreads();
    const int gw = F.wg * NWAVES + F.wave, NGW = F.G * NWAVES;
    bf16x8 qn[8];
#define TK_QLOAD(TILE, C) do { const int tl_ = (TILE) < T * PHEADS / 32 ? (TILE) : gw; const int P_ = tl_ * 32 + (F.lane & 31); \
        const bf16* qp_ = QP + (size_t)(P_ >> 3) * PQ + (P_ & 7) * 256 + (C) * 128 + 8 * (F.lane >> 5); \
        _Pragma("unroll") for (int s2 = 0; s2 < 8; ++s2) qn[s2] = *(const GAS bf16x8*)(qp_ + 16 * s2); } while (0)
    if (gw < T * PHEADS / 32) TK_QLOAD(gw, 0);
    for (int tile = gw; tile < T * PHEADS / 32; tile += NGW) {
        int lane_ = F.lane; asm volatile("" : "+v"(lane_));
        const int lane = lane_, hh = lane >> 5, cl = lane & 31;
        const int P = tile * 32 + cl, t = P >> 3, h = P & 7;
        unsigned kAB[2][16];
#pragma unroll
        for (int c = 0; c < 2; ++c) {
            bf16x8 qf[8];
#pragma unroll
            for (int s2 = 0; s2 < 8; ++s2) qf[s2] = qn[s2];
            if (c == 0) TK_QLOAD(tile, 1); else TK_QLOAD(tile + NGW, 0);
            unsigned k[64];
#pragma unroll
            for (int mt = 0; mt < 4; ++mt) {
                f32x16 acc = zero16();
                const LAS unsigned char* ah = lds + TK_SKH + (c * 128 + mt * 32 + cl) * TK_SKS + 16 * hh;
                const LAS unsigned char* al = lds + TK_SKL + (c * 128 + mt * 32 + cl) * TK_SKS + 16 * hh;
#pragma unroll
                for (int s2 = 0; s2 < 8; ++s2) {
                    acc = __builtin_amdgcn_mfma_f32_32x32x16_bf16(*(const LAS bf16x8*)(ah + 32 * s2), qf[s2], acc, 0, 0, 0);
#if TK_SPLIT_KEYS
                    acc = __builtin_amdgcn_mfma_f32_32x32x16_bf16(*(const LAS bf16x8*)(al + 32 * s2), qf[s2], acc, 0, 0, 0);
#endif
                }
#pragma unroll
                for (int r = 0; r < 16; ++r) { const int idx = 32 * mt + (r & 3) + 8 * (r >> 2) + 4 * hh; k[mt * 16 + r] = (f2ord(acc[r]) & ~127u) | (unsigned)(127 - idx); }
            }
            top16_of_64(k);
            unsigned m[32];
#pragma unroll
            for (int i = 0; i < 16; ++i) { m[i] = k[i]; m[16 + i] = (unsigned)__shfl_xor((int)k[i], 32); }
            merge_top16<0, 16, 32>(m);
#pragma unroll
            for (int i = 0; i < 16; ++i) kAB[c][i] = m[i];
        }
        float fa[16], fb[16];
#pragma unroll
        for (int i = 0; i < 16; ++i) { fa[i] = ord2f(kAB[0][i] & ~127u); fb[i] = ord2f(kAB[1][i] & ~127u); }
        unsigned cd[64]; int n = 0;
#pragma unroll
        for (int i = 0; i < 16; ++i)
#pragma unroll
            for (int j = 0; j < 16; ++j) if ((i + 1) * (j + 1) <= 16) { cd[n] = (f2ord(fa[i] + fb[j]) & ~255u) | (unsigned)(255 - (i * 16 + j)); ++n; }
#pragma unroll
        for (int q = 50; q < 64; ++q) cd[q] = 0u;
        top16_of_64(cd);
        LAS unsigned char* lut = lds + TK_LUT + (F.wave * 64 + lane) * 32;
#pragma unroll
        for (int q = 0; q < 4; ++q) {
            unsigned wa = 0u, wb = 0u;
#pragma unroll
            for (int b4 = 0; b4 < 4; ++b4) { wa |= (127u - (kAB[0][4 * q + b4] & 127u)) << (8 * b4); wb |= (127u - (kAB[1][4 * q + b4] & 127u)) << (8 * b4); }
            *(LAS unsigned*)(lut + 4 * q) = wa; *(LAS unsigned*)(lut + 16 + 4 * q) = wb; }
        float gv[16]; float den = 0.f; const float mx = ord2f(cd[0] & ~255u);
#pragma unroll
        for (int q = 0; q < 16; ++q) { gv[q] = __expf(ord2f(cd[q] & ~255u) - mx); den += gv[q]; }
        const float inv = 1.f / den;
        asm volatile("s_waitcnt lgkmcnt(0)" ::: "memory");
        int ev[16];
#pragma unroll
        for (int q = 0; q < 16; ++q) { const unsigned pos = 255u - (cd[q] & 255u);
            const unsigned ia = *(const LAS unsigned char*)(lut + (pos >> 4)), ib = *(const LAS unsigned char*)(lut + 16 + (pos & 15u));
            ev[q] = (int)(ia * NKEYS + ib); }
        if (hh == 0) {
            int* ep = EID + (size_t)t * 128 + h * 16; float* gp = GATE + (size_t)t * 128 + h * 16;
#pragma unroll
            for (int q = 0; q < 4; ++q) {
                *(GAS v4u*)(ep + 4 * q) = (v4u){(unsigned)ev[4 * q], (unsigned)ev[4 * q + 1], (unsigned)ev[4 * q + 2], (unsigned)ev[4 * q + 3]};
                *(GAS f32x4*)(gp + 4 * q) = (f32x4){gv[4 * q] * inv, gv[4 * q + 1] * inv, gv[4 * q + 2] * inv, gv[4 * q + 3] * inv}; }
        }
        asm volatile("s_waitcnt lgkmcnt(0)" ::: "memory");
    }
}
#undef TK_QLOAD

constexpr int GA_WAVE_BYTES = 10752, GA_CNT = 4096, GA_OFF = 4096 + 128, GA_ACT = 4608, GA_XQ = 6656;
__device__ __forceinline__ int wave_sum_i(int v) { v += dppi<0xB1>(v); v += dppi<0x4E>(v); v += dppi<0x141>(v); v += dppi<0x140>(v);
    return (__builtin_amdgcn_readlane(v, 0) + __builtin_amdgcn_readlane(v, 16)) + (__builtin_amdgcn_readlane(v, 32) + __builtin_amdgcn_readlane(v, 48)); }
__device__ __forceinline__ void p8_gather(Frame& F, float* outp) {
    const bf16* XN = (const bf16*)(F.ws + WS_HB);
    const unsigned char* UQ = F.ws + WS_UQ; const unsigned char* VQ = F.ws + WS_VQ;
    const float* SU = (const float*)(F.ws + WS_SU); const float* SV = (const float*)(F.ws + WS_SV);
    const int* EID = (const int*)(F.ws + WS_EID); const float* GATE = (const float*)(F.ws + WS_GATE);
    const float* nf = F.in[20];
    const int gw = F.wg * NWAVES + F.wave, NGW = F.G * NWAVES;
    LAS unsigned char* wl = F.lds + RING_OFF + F.wave * GA_WAVE_BYTES;
    for (int tg = gw, sweep = 0; tg < T / 4; tg += NGW, ++sweep) {
        int lane_ = F.lane; asm volatile("" : "+v"(lane_));
        const int lane = lane_;
        int xq[4][4]; float sx[4];
        float gfn[16];
#pragma unroll
        for (int q = 0; q < 4; ++q) { const f32x4 g4 = *(const GAS f32x4*)(F.in[15] + lane * 16 + 4 * q); gfn[4 * q] = g4[0]; gfn[4 * q + 1] = g4[1]; gfn[4 * q + 2] = g4[2]; gfn[4 * q + 3] = g4[3]; }
        v4u xa[4], xb[4]; float ssqv[4];
#pragma unroll
        for (int tk = 0; tk < 4; ++tk) { const GAS v4u* xp = (const GAS v4u*)(XN + (size_t)(4 * tg + tk) * DM + lane * 16); xa[tk] = xp[0]; xb[tk] = xp[1];
            ssqv[tk] = ((const float*)(F.ws + WS_SSQ))[4 * tg + tk]; }
#pragma unroll
        for (int tk = 0; tk < 4; ++tk) {
            const v4u a = xa[tk], b = xb[tk];
            float x[16]; x[0] = bflo(a.x); x[1] = bfhi(a.x); x[2] = bflo(a.y); x[3] = bfhi(a.y); x[4] = bflo(a.z); x[5] = bfhi(a.z); x[6] = bflo(a.w); x[7] = bfhi(a.w);
            x[8] = bflo(b.x); x[9] = bfhi(b.x); x[10] = bflo(b.y); x[11] = bfhi(b.y); x[12] = bflo(b.z); x[13] = bfhi(b.z); x[14] = bflo(b.w); x[15] = bfhi(b.w);
#pragma unroll
            for (int i = 0; i < 16; ++i) x[i] *= gfn[i];
            float am = 0.f;
#pragma unroll
            for (int i = 0; i < 16; ++i) am = fmaxf(am, fabsf(x[i]));
            am = wave_max(am);
            const float rs_ = frsq(ssqv[tk] * (1.f / DM) + RMS_EPS);
            sx[tk] = (am > 0.f ? am * (1.f / 127.f) : 1.f) * rs_; const float inv = am > 0.f ? 127.f / am : 0.f;
#pragma unroll
            for (int q = 0; q < 4; ++q) {
                const unsigned b0 = (unsigned)(int)rintf(x[4 * q] * inv) & 255u, b1 = (unsigned)(int)rintf(x[4 * q + 1] * inv) & 255u, b2 = (unsigned)(int)rintf(x[4 * q + 2] * inv) & 255u, b3 = (unsigned)(int)rintf(x[4 * q + 3] * inv) & 255u;
                xq[tk][q] = (int)(b0 | (b1 << 8) | (b2 << 16) | (b3 << 24)); }
            *(LAS v4u*)(wl + GA_XQ + tk * 1024 + lane * 16) = (v4u){(unsigned)xq[tk][0], (unsigned)xq[tk][1], (unsigned)xq[tk][2], (unsigned)xq[tk][3]};
        }
        LAS unsigned* cnt = (LAS unsigned*)(wl + GA_CNT); LAS unsigned* offs = (LAS unsigned*)(wl + GA_OFF);
        if (lane < 32) cnt[lane] = 0u;
        asm volatile("s_waitcnt lgkmcnt(0)" ::: "memory");
        int ee[8]; float gg[8]; unsigned pos[8];
#pragma unroll
        for (int tk = 0; tk < 4; ++tk) {
            const size_t base = (size_t)(4 * tg + tk) * 128;
            ee[2 * tk] = (EID[base + lane] & (NEXP - 1)) | (tk << 14); ee[2 * tk + 1] = (EID[base + 64 + lane] & (NEXP - 1)) | (tk << 14);
            gg[2 * tk] = GATE[base + lane]; gg[2 * tk + 1] = GATE[base + 64 + lane]; }
#pragma unroll
        for (int q = 0; q < 8; ++q) pos[q] = __hip_atomic_fetch_add(cnt + ((ee[q] >> 9) & 31), 1u, __ATOMIC_RELAXED, __HIP_MEMORY_SCOPE_WAVEFRONT);
        asm volatile("s_waitcnt lgkmcnt(0)" ::: "memory");
        if (lane < 32) {
            const int c0 = (int)cnt[lane]; int v = c0;
            v += __builtin_amdgcn_update_dpp(0, v, 0x111, 0xF, 0xF, true); v += __builtin_amdgcn_update_dpp(0, v, 0x112, 0xF, 0xF, true);
            v += __builtin_amdgcn_update_dpp(0, v, 0x114, 0xF, 0xF, true); v += __builtin_amdgcn_update_dpp(0, v, 0x118, 0xF, 0xF, true);
            const int row0 = __builtin_amdgcn_readlane(v, 15);
            offs[lane] = (unsigned)(v - c0 + (lane >= 16 ? row0 : 0));
        }
        asm volatile("s_waitcnt lgkmcnt(0)" ::: "memory");
#pragma unroll
        for (int q = 0; q < 8; ++q) { const unsigned idx = offs[(ee[q] >> 9) & 31] + pos[q];
            *(LAS unsigned*)(wl + idx * 4) = (unsigned)ee[q]; *(LAS float*)(wl + 2048 + idx * 4) = gg[q]; }
        asm volatile("s_waitcnt lgkmcnt(0)" ::: "memory");
        LAS float* act = (LAS float*)(wl + GA_ACT);
#ifndef UPASS_REPS
#define UPASS_REPS 1
#endif
        for (int urep = 0; urep < UPASS_REPS; ++urep)
        {
            const int grp = lane >> 4, l16 = lane & 15;
            const LAS unsigned* ents = (const LAS unsigned*)wl;
            LAS int* hbuf = (LAS int*)(wl + GA_ACT);
            v4u rb[2][2][4]; unsigned eb[2][2];
#define GA_ULOAD(ST, QD, Q_) do { const unsigned e_ = ents[(Q_) * 4 + grp]; eb[ST][QD] = e_; const GAS v4u* rp_ = (const GAS v4u*)(UQ + (size_t)(e_ & (NEXP - 1)) * DM + l16 * 64); \
                rb[ST][QD][0] = rp_[0]; rb[ST][QD][1] = rp_[1]; rb[ST][QD][2] = rp_[2]; rb[ST][QD][3] = rp_[3]; } while (0)
#define GA_UDOT(ST, QD, Q_) do { const LAS v4u* xp_ = (const LAS v4u*)(wl + GA_XQ + ((eb[ST][QD] >> 14) & 3u) * 1024 + l16 * 64); int d_ = 0; \
                _Pragma("unroll") for (int k_ = 0; k_ < 4; ++k_) { const v4u x_ = xp_[k_], r_ = rb[ST][QD][k_]; \
                    d_ = __builtin_amdgcn_sdot4((int)x_.x, (int)r_.x, d_, false); d_ = __builtin_amdgcn_sdot4((int)x_.y, (int)r_.y, d_, false); \
                    d_ = __builtin_amdgcn_sdot4((int)x_.z, (int)r_.z, d_, false); d_ = __builtin_amdgcn_sdot4((int)x_.w, (int)r_.w, d_, false); } \
                d_ += dppi<0xB1>(d_); d_ += dppi<0x4E>(d_); d_ += dppi<0x141>(d_); d_ += dppi<0x140>(d_); \
                if (l16 == 0) hbuf[(Q_) * 4 + grp] = d_; } while (0)
            GA_ULOAD(0, 0, 0); GA_ULOAD(0, 1, 1);
            for (int q2 = 0; q2 < 128; q2 += 4) {
                GA_ULOAD(1, 0, q2 + 2); GA_ULOAD(1, 1, q2 + 3);
                __builtin_amdgcn_sched_barrier(0);
                GA_UDOT(0, 0, q2); GA_UDOT(0, 1, q2 + 1);
                __builtin_amdgcn_sched_barrier(0);
                if (q2 + 4 < 128) { GA_ULOAD(0, 0, q2 + 4); GA_ULOAD(0, 1, q2 + 5); }
                __builtin_amdgcn_sched_barrier(0);
                GA_UDOT(1, 0, q2 + 2); GA_UDOT(1, 1, q2 + 3);
                __builtin_amdgcn_sched_barrier(0);
            }
#undef GA_ULOAD
#undef GA_UDOT
            asm volatile("s_waitcnt lgkmcnt(0)" ::: "memory");
            float su_[8], sv_[8];
#pragma unroll
            for (int it = 0; it < 8; ++it) { const int ex_ = (int)(ents[it * 64 + lane] & (NEXP - 1)); su_[it] = SU[ex_]; sv_[it] = SV[ex_]; }
#pragma unroll 2
            for (int it = 0; it < 8; ++it) { const int p = it * 64 + lane;
                const unsigned e_ = ents[p]; const float g_ = *(const LAS float*)(wl + 2048 + p * 4); const int hs = hbuf[p];
                const int tk_ = (int)(e_ >> 14) & 3;
                const float sxl = tk_ == 0 ? sx[0] : (tk_ == 1 ? sx[1] : (tk_ == 2 ? sx[2] : sx[3]));
                const float h_ = (float)hs * (su_[it] * sxl);
                act[p] = 0.5f * h_ * (1.f + erff(h_ * 0.70710678118654752f)) * g_ * sv_[it]; }
        }
        asm volatile("s_waitcnt lgkmcnt(0)" ::: "memory");
        float y[4][16];
#pragma unroll
        for (int tk = 0; tk < 4; ++tk) {
#pragma unroll
            for (int i = 0; i < 16; ++i) y[tk][i] = 0.f; }
#define GA_AXPY(V, A, TK) do { \
            _Pragma("unroll") for (int q_ = 0; q_ < 4; ++q_) { const int w_ = (int)(V)[q_]; const f32x2 lo_ = __builtin_amdgcn_cvt_pk_f32_fp8(w_, false), hi_ = __builtin_amdgcn_cvt_pk_f32_fp8(w_, true); \
                y[TK][4 * q_] += (A) * lo_.x; y[TK][4 * q_ + 1] += (A) * lo_.y; y[TK][4 * q_ + 2] += (A) * hi_.x; y[TK][4 * q_ + 3] += (A) * hi_.y; } } while (0)
        for (int ch = 0; ch < 8; ++ch) {
            const unsigned ent = *(const LAS unsigned*)(wl + (ch * 64 + lane) * 4);
            const float areg = act[ch * 64 + lane];
            v4u vb[2][8]; int eb[2][8];
#pragma unroll
            for (int q = 0; q < 8; ++q) { eb[0][q] = __builtin_amdgcn_readlane((int)ent, q); vb[0][q] = *(const GAS v4u*)(VQ + (size_t)(eb[0][q] & (NEXP - 1)) * DM + lane * 16); }
#pragma unroll
            for (int jb = 0; jb < 8; ++jb) {
                if (jb + 1 < 8) {
#pragma unroll
                    for (int q = 0; q < 8; ++q) { eb[(jb + 1) & 1][q] = __builtin_amdgcn_readlane((int)ent, 8 * (jb + 1) + q); vb[(jb + 1) & 1][q] = *(const GAS v4u*)(VQ + (size_t)(eb[(jb + 1) & 1][q] & (NEXP - 1)) * DM + lane * 16); } }
                __builtin_amdgcn_sched_barrier(0);
#pragma unroll
                for (int q = 0; q < 8; ++q) { const int tk_ = (eb[jb & 1][q] >> 14) & 3; const v4u v_ = vb[jb & 1][q]; const float a_ = rdlane(areg, 8 * jb + q);
                    if (tk_ == 0) GA_AXPY(v_, a_, 0); else if (tk_ == 1) GA_AXPY(v_, a_, 1); else if (tk_ == 2) GA_AXPY(v_, a_, 2); else GA_AXPY(v_, a_, 3); }
                __builtin_amdgcn_sched_barrier(0);
            }
        }
#undef GA_AXPY
        v4u hA[4], hB[4]; f32x4 nfv[4];
#pragma unroll
        for (int tk = 0; tk < 4; ++tk) { const GAS v4u* hp = (const GAS v4u*)((const bf16*)(F.ws + WS_HB) + (size_t)(4 * tg + tk) * DM + lane * 16); hA[tk] = hp[0]; hB[tk] = hp[1]; }
#pragma unroll
        for (int q = 0; q < 4; ++q) nfv[q] = *(const GAS f32x4*)(nf + lane * 16 + 4 * q);
#pragma unroll
        for (int tk = 0; tk < 4; ++tk) {
            const v4u ha = hA[tk], hb_ = hB[tk];
            float hv[16]; float ss = 0.f;
            hv[0] = bflo(ha.x); hv[1] = bfhi(ha.x); hv[2] = bflo(ha.y); hv[3] = bfhi(ha.y); hv[4] = bflo(ha.z); hv[5] = bfhi(ha.z); hv[6] = bflo(ha.w); hv[7] = bfhi(ha.w);
            hv[8] = bflo(hb_.x); hv[9] = bfhi(hb_.x); hv[10] = bflo(hb_.y); hv[11] = bfhi(hb_.y); hv[12] = bflo(hb_.z); hv[13] = bfhi(hb_.z); hv[14] = bflo(hb_.w); hv[15] = bfhi(hb_.w);
#pragma unroll
            for (int i = 0; i < 16; ++i) { hv[i] += y[tk][i]; ss += hv[i] * hv[i]; }
            const float rstd = frsq(wave_sum(ss) * (1.f / DM) + RMS_EPS);
#pragma unroll
            for (int q = 0; q < 4; ++q) { const f32x4 n4 = nfv[q];
                *(GAS f32x4*)(outp + (size_t)(4 * tg + tk) * DM + lane * 16 + 4 * q) = (f32x4){hv[4 * q] * rstd * n4[0], hv[4 * q + 1] * rstd * n4[1], hv[4 * q + 2] * rstd * n4[2], hv[4 * q + 3] * rstd * n4[3]}; }
        }
    }
}

struct Args { const float* in[21]; float* out; unsigned char* ws; int ph_lo, ph_hi; };
static_assert(sizeof(Args) == 21 * 8 + 8 + 8 + 8, "Args has no padding");

__global__ void __launch_bounds__(NTHREADS, 2) fwd_kernel(Args args) {
    extern __shared__ __attribute__((aligned(16))) unsigned char lds[];
    Frame F;
    F.lds = (LAS unsigned char*)lds;
    F.MISC = (volatile LAS unsigned*)(F.lds + MISC_OFF);
    F.tid = threadIdx.x; F.lane = F.tid & 63; F.wave = __builtin_amdgcn_readfirstlane(F.tid >> 6);
    F.G = gridDim.x; F.wg = blockIdx.x;
#pragma unroll
    for (int i = 0; i < 21; ++i) F.in[i] = args.in[i];
    F.out = args.out; F.ws = args.ws;
    F.ctl = (gu32*)(args.ws + WS_CTL);
    for (int u = F.tid; u < (LDS_BYTES - LDSCTL_OFF) / 4; u += NTHREADS) ((LAS unsigned*)(F.lds + LDSCTL_OFF))[u] = 0u;
    __syncthreads();
    const int lo = args.ph_lo, hi = args.ph_hi;
    const bool fused = (hi - lo) > 1;
    XcdBarrier bar; bar.bar = (unsigned*)(F.ctl + CW_BAR); bar.x = 0; bar.st = nullptr;
    if (fused) bar = xcd_barrier_post((unsigned*)(F.ctl + CW_BAR), F.MISC + 8);
#define IN(k) (lo <= (k) && (k) < hi)
#define REPS(k) (((REP_MASK >> (k)) & 1) ? 2 : 1)
#define REPLOOP(k) for (int rep_ = 0; rep_ < REPS(k); ++rep_, (rep_ < REPS(k) ? xcd_barrier(bar) : (void)0))
#define SEAM(k) do { if (IN(k) && IN((k) + 1)) xcd_barrier(bar); } while (0)

    if (IN(0)) { REPLOOP(0) { p0_prologue(F); p0_rope_table(F); } SEAM(0); }
    if (IN(1)) { REPLOOP(1) {
        pg8::Gemm g{(const bf16*)(F.ws + WS_XN), (const bf16*)(F.ws + WS_WIN), T, IN_COLS, DM}; pg8::StaticOrder S; S.init(T, IN_COLS, F.G, F.wg);
        pg8::EpiBf16Rope E{(bf16*)(F.ws + WS_Z), IN_COLS, (const float*)(F.ws + WS_ROPE), SEQ, C_AQ / 256, C_AV / 256};
        pg8::gemm_phase<pg8::EpiBf16Rope, pg8::StaticOrder, true, true>(F.lds + RING_OFF, g, S, E); }
        {
            const int nwg = (T / 256) * (IN_COLS / 256), rem = nwg % F.G;
            if (rem == 0) quantize_tables(F, F.wg * NWAVES + F.wave, F.G * NWAVES);
            else if (F.wg >= rem) quantize_tables(F, (F.wg - rem) * NWAVES + F.wave, (F.G - rem) * NWAVES);
        }
        SEAM(1);
    }
    if (IN(2)) { REPLOOP(2) { const int cnt = r13_count(F.wg, F.G); R1Pre P;
            if (cnt > 0) rwkv_r1_prefetch(F, r13_item(F.wg, F.G, 0), F.tid, P);
            bf16x8 bfr[4]; int hcur = -1;
            f32x4 cst[4];
            { const int n16 = F.lane & 15, g = F.lane >> 4;
#pragma unroll
              for (int rt = 0; rt < 4; ++rt)
#pragma unroll
                  for (int q = 0; q < 4; ++q) cst[rt][q] = (F.wave < 4 && 16 * rt + 4 * g + q == 16 * F.wave + n16) ? 1.f : 0.f; }
            for (int i = 0; i < cnt; ++i) { const int it = r13_item(F.wg, F.G, i), hh_ = (it >> 7) & 7;
                if (hh_ != hcur) { r1_load_bfrag(F, hh_, F.wave, F.lane, bfr); __syncthreads(); r1_load_params(F, hh_); __syncthreads(); hcur = hh_; }
                rwkv_r1_item(F, it, i + 1 < cnt ? r13_item(F.wg, F.G, i + 1) : -1, P, bfr, cst); }
            { const int n16 = F.lane & 15, g = F.lane >> 4; float* Pg = (float*)(F.ws + WS_PQ) + (size_t)F.wg * 4096; float* Qg = Pg + (size_t)256 * 4096;
              if (F.wave < 4) {
#pragma unroll
                  for (int rt = 0; rt < 4; ++rt)
#pragma unroll
                      for (int q = 0; q < 4; ++q) Pg[(16 * rt + 4 * g + q) * 64 + 16 * F.wave + n16] = cst[rt][q];
              } else {
#pragma unroll
                  for (int rt = 0; rt < 4; ++rt) *(GAS f32x4*)(Qg + (16 * (F.wave - 4) + n16) * 64 + 16 * rt + 4 * g) = cst[rt];
              } } }
        SEAM(2); }
    if (IN(3)) { REPLOOP(3) p3_mixers(F); }
    if (IN(4)) { REPLOOP(4) { const int cnt = r13_count(F.wg, F.G); R3Pre P;
            asm volatile("s_waitcnt vmcnt(0)" ::: "memory");
            __syncthreads();
            if (F.tid == 0) { unsigned* fl = (unsigned*)F.ctl + CW_SCAN + 16 * (F.wg >> 3); XB_SPIN(xb_ld(fl) == 0u, (unsigned*)(F.ctl + CW_BAR)); __builtin_amdgcn_fence(__ATOMIC_ACQUIRE, "agent"); }
            __syncthreads();
            {
                const int item0 = r13_item(F.wg, F.G, 0);
                rwkv_scan<15, 7>(F, F.out + (size_t)item0 * 4096, F.out + (size_t)T * RWW + (size_t)item0 * 4096, (float*)(F.ws + WS_RWSS) + (size_t)item0 * 4096, (const float*)(F.ws + WS_SSEG) + (size_t)F.wg * 4096);
                asm volatile("s_waitcnt vmcnt(0)" ::: "memory"); __syncthreads();
            }
            if (cnt > 0) rwkv_r3_prefetch(F, r13_item(F.wg, F.G, 0), F.tid, P);
            bf16x8 bfr[8]; int hcur = -1;
            for (int i = 0; i < cnt; ++i) { const int it = r13_item(F.wg, F.G, i), hh_ = (it >> 7) & 7;
                if (hh_ != hcur) { r3_load_bfrag(F, hh_, F.wave, F.lane, bfr); __syncthreads(); r3_load_params(F, hh_); __syncthreads(); hcur = hh_; }
                rwkv_r3_item(F, it, i + 1 < cnt ? r13_item(F.wg, F.G, i + 1) : -1, P, bfr); } }
        SEAM(4); }
    if (IN(5)) {
        pg8::Gemm g{(const bf16*)(F.ws + WS_YMIX), (const bf16*)(F.ws + WS_WOUT), T, DM, DM}; pg8::StaticOrder S; S.init(T, DM, F.G, F.wg);
        pg8::EpiF32Res E{F.in[0], (bf16*)(F.ws + WS_HB), DM, (float*)(F.ws + WS_SSQ)};
        pg8::gemm_phase<pg8::EpiF32Res, pg8::StaticOrder, true, true>(F.lds + RING_OFF, g, S, E);
        SEAM(5);
    }
    if (IN(6)) { REPLOOP(6) {
        pg8::Gemm g{(const bf16*)(F.ws + WS_HB), (const bf16*)(F.ws + WS_WQ), T, PQ, DM}; pg8::StaticOrder S; S.init(T, PQ, F.G, F.wg);
        pg8::EpiBf16Rs E{(bf16*)(F.ws + WS_QP), PQ, (const float*)(F.ws + WS_SSQ)};
        pg8::gemm_phase<pg8::EpiBf16Rs, pg8::StaticOrder, true, true>(F.lds + RING_OFF, g, S, E); }
        SEAM(6);
    }
    if (IN(7)) { REPLOOP(7) p7_topk(F); if (IN(8)) { asm volatile("s_waitcnt vmcnt(0)" ::: "memory"); __syncthreads(); } }
    if (IN(8)) { if (REPS(8) > 1) { p8_gather(F, (float*)(F.ws + WS_Z)); xcd_barrier(bar); } p8_gather(F, F.out); }
#undef IN
#undef SEAM
}

extern "C" void kernel_launch(void* const* d_in, const int* in_sizes, int n_in, void* d_out, int out_size, void* d_ws, size_t ws_size, hipStream_t stream) {
    static int grid = 0;
    if (grid == 0) {
        if (n_in != 21 || in_sizes[0] != T * DM || out_size != T * DM || ws_size < WS_END) {
            fprintf(stderr, "kernel_launch: unexpected shapes: n_in %d in0 %d out %d ws %zu (need %zu); nothing launched\n", n_in, n_in > 0 ? in_sizes[0] : -1, out_size, ws_size, (size_t)WS_END); grid = -1; return; }
        int dev = 0, cus = 0, per_cu = 0;
        if (hipGetDevice(&dev) != hipSuccess || hipDeviceGetAttribute(&cus, hipDeviceAttributeMultiprocessorCount, dev) != hipSuccess) { grid = -1; return; }
        if (hipFuncSetAttribute((const void*)fwd_kernel, hipFuncAttributeMaxDynamicSharedMemorySize, LDS_BYTES) != hipSuccess) { fprintf(stderr, "kernel_launch: hipFuncSetAttribute failed\n"); grid = -1; return; }
        if (hipOccupancyMaxActiveBlocksPerMultiprocessor(&per_cu, (const void*)fwd_kernel, NTHREADS, LDS_BYTES) != hipSuccess || per_cu < 1) { fprintf(stderr, "kernel_launch: occupancy query says %d\n", per_cu); per_cu = 1; }
        (void)hipGetLastError();
        grid = cus;
        if (cus != 256) { fprintf(stderr, "kernel_launch: the RWKV segment mapping assumes 256 CUs (got %d); nothing launched\n", cus); grid = -1; return; }
    }
    if (grid < 0) return;
    (void)hipMemsetAsync((char*)d_ws + WS_CTL, 0, CTL_ZERO_BYTES, stream);
    Args a{};
    for (int i = 0; i < 21; ++i) a.in[i] = (const float*)d_in[i];
    a.out = (float*)d_out; a.ws = (unsigned char*)d_ws;
    if (MK_N_LAUNCHES == 1) {
        a.ph_lo = 0; a.ph_hi = NPHASE;
        void* kargs[] = {&a};
        hipError_t e = hipLaunchCooperativeKernel((const void*)fwd_kernel, dim3(grid), dim3(NTHREADS), kargs, LDS_BYTES, stream);
        if (e != hipSuccess) fprintf(stderr, "kernel_launch: cooperative launch failed: %s (grid %d)\n", hipGetErrorString(e), grid);
    } else {
        for (int p = 0; p < NPHASE; ++p) { a.ph_lo = p; a.ph_hi = p + 1;
            hipLaunchKernelGGL(fwd_kernel, dim3(grid), dim3(NTHREADS), LDS_BYTES, stream, a); }
    }
}
```

```cpp
#include <hip/hip_runtime.h>
#include <cstdio>
#include <cstdint>

#ifndef MK_N_LAUNCHES
#define MK_N_LAUNCHES 1
#endif

#ifndef REP_MASK
#define REP_MASK 0
#endif
#define GAS __attribute__((address_space(1)))
#define LAS __attribute__((address_space(3)))
typedef unsigned short bf16;
typedef unsigned v4u __attribute__((ext_vector_type(4)));
typedef unsigned v2u __attribute__((ext_vector_type(2)));
typedef float f32x4 __attribute__((ext_vector_type(4)));
typedef float f32x2 __attribute__((ext_vector_type(2)));
typedef short bf16x8 __attribute__((ext_vector_type(8)));
typedef GAS unsigned gu32;
#define RLX_AGENT __ATOMIC_RELAXED, __HIP_MEMORY_SCOPE_AGENT
#define LDS_WAIT() asm volatile("s_waitcnt lgkmcnt(0)" ::: "memory")
#define VM_WAIT() asm volatile("s_waitcnt vmcnt(0)" ::: "memory")
#define LDS_BARRIER() do { asm volatile("s_waitcnt lgkmcnt(0)" ::: "memory"); __builtin_amdgcn_s_barrier(); asm volatile("" ::: "memory"); } while (0)

constexpr int DM = 1024, NB = 4, SEQ = 8192, T = NB * SEQ;
constexpr int HD = 64, RWW = 512, NHR = 8, NHA = 8;
constexpr int IN_COLS = 3328;
constexpr int C_R = 0, C_K = 512, C_V = 1024, C_WD = 1536, C_AD = 1600, C_GD = 1664, C_AQ = 1792, C_AK = 2304, C_AV = 2816;
constexpr int PHEADS = 8, NKEYS = 128, PQ = 2048, TOPK = 16, NEXP = 16384;
constexpr float RMS_EPS = 1e-6f, GN_EPS = 64e-5f;
constexpr int NWAVES = 8, NTHREADS = 512;
constexpr int NPHASE = 9;

constexpr size_t MiB = 1u << 20;
constexpr size_t WS_CTL = 0, CTL_ZERO_BYTES = 1 * MiB;
constexpr size_t WS_WIN = 2 * MiB;
constexpr size_t WS_WOUT = 10 * MiB;
constexpr size_t WS_WQ = 12 * MiB;
constexpr size_t WS_XN = 16 * MiB;
constexpr size_t WS_Z = 80 * MiB;
constexpr size_t WS_QP = 80 * MiB;
constexpr size_t WS_HB = 208 * MiB;
constexpr size_t WS_G = 288 * MiB;
constexpr size_t WS_YMIX = 352 * MiB;
constexpr size_t WS_UQ = 416 * MiB;
constexpr size_t WS_VQ = 432 * MiB;
constexpr size_t WS_SU = 448 * MiB;
constexpr size_t WS_SV = 449 * MiB;
constexpr size_t WS_EID = 480 * MiB;
constexpr size_t WS_GATE = 496 * MiB;
constexpr size_t WS_SSEG = 450 * MiB;
constexpr size_t WS_PQ = 456 * MiB;
constexpr size_t WS_END = 512 * MiB;
constexpr size_t WS_WUPT = 1 * MiB, WS_AUPT = WS_WUPT + 65536, WS_GUPT = WS_AUPT + 65536;
constexpr size_t WS_BONUS = 9 * MiB;
constexpr size_t WS_RWY0 = 320 * MiB;
constexpr size_t WS_RWSS = WS_G;
constexpr size_t WS_RWRH = WS_EID;

constexpr int CW_BAR = 4096;
constexpr int CW_SCAN = 16384;
constexpr size_t WS_SSQ1 = 512 * 1024;
constexpr size_t WS_SSQ = 256 * 1024;

typedef __bf16 hbf16x2_t __attribute__((ext_vector_type(2)));
__device__ __forceinline__ unsigned pk2(float lo, float hi) { const f32x2 v = {lo, hi}; const hbf16x2_t b = __builtin_convertvector(v, hbf16x2_t); return __builtin_bit_cast(unsigned, b); }
__device__ __forceinline__ unsigned f2bf(float f) { return pk2(f, 0.f) & 0xffffu; }
__device__ __forceinline__ float frcp(float x) { return __builtin_amdgcn_rcpf(x); }
__device__ __forceinline__ float frsq(float x) { return __builtin_amdgcn_rsqf(x); }
__device__ __forceinline__ float bflo(unsigned u) { return __builtin_bit_cast(float, u << 16); }
__device__ __forceinline__ float bfhi(unsigned u) { return __builtin_bit_cast(float, u & 0xffff0000u); }
__device__ __forceinline__ float bf2f(bf16 h) { return __builtin_bit_cast(float, (unsigned)h << 16); }

template <int CTRL> __device__ __forceinline__ float dppf(float x) { return __builtin_bit_cast(float, __builtin_amdgcn_update_dpp(0, __builtin_bit_cast(int, x), CTRL, 0xF, 0xF, true)); }
template <int CTRL> __device__ __forceinline__ int dppi(int x) { return __builtin_amdgcn_update_dpp(0, x, CTRL, 0xF, 0xF, true); }
__device__ __forceinline__ float rdlane(float v, int l) { return __builtin_bit_cast(float, __builtin_amdgcn_readlane(__builtin_bit_cast(int, v), l)); }
__device__ __forceinline__ float sum8(float v) { v += dppf<0xB1>(v); v += dppf<0x4E>(v); v += dppf<0x141>(v); return v; }
__device__ __forceinline__ float sum16(float v) { v = sum8(v); v += dppf<0x140>(v); return v; }
__device__ __forceinline__ float wave_sum(float v) { v = sum16(v);
    asm volatile("s_nop 1\n\tv_add_f32_dpp %0, %0, %0 row_bcast:15 row_mask:0xa bank_mask:0xf\n\ts_nop 1\n\tv_add_f32_dpp %0, %0, %0 row_bcast:31 row_mask:0xc bank_mask:0xf\n\ts_nop 0" : "+v"(v));
    return rdlane(v, 63); }
__device__ __forceinline__ float rows_add32(float v) { float a = v, b = v; asm volatile("s_nop 1\n\tv_permlane32_swap_b32 %0, %1\n\ts_nop 1" : "+v"(a), "+v"(b)); return a + b; }
__device__ __forceinline__ float rows_add16(float v) { float a = v, b = v; asm volatile("s_nop 1\n\tv_permlane16_swap_b32 %0, %1\n\ts_nop 1" : "+v"(a), "+v"(b)); return a + b; }
__device__ __forceinline__ float wave_sum16(const float (&X)[16], int lane) {
    const bool b0 = (lane & 1) != 0, b1 = (lane & 2) != 0, b2 = (lane & 4) != 0, b3 = (lane & 8) != 0;
    float Y8[8], Z4[4], U2[2], V;
#pragma unroll
    for (int m = 0; m < 8; ++m) { const float kp = b0 ? X[2 * m + 1] : X[2 * m], sd = b0 ? X[2 * m] : X[2 * m + 1]; Y8[m] = kp + dppf<0xB1>(sd); }
#pragma unroll
    for (int m = 0; m < 4; ++m) { const float kp = b1 ? Y8[2 * m + 1] : Y8[2 * m], sd = b1 ? Y8[2 * m] : Y8[2 * m + 1]; Z4[m] = kp + dppf<0x4E>(sd); }
#pragma unroll
    for (int m = 0; m < 2; ++m) { const float kp = b2 ? Z4[2 * m + 1] : Z4[2 * m], sd = b2 ? Z4[2 * m] : Z4[2 * m + 1]; U2[m] = kp + dppf<0x124>(sd); }
    { const float kp = b3 ? U2[1] : U2[0], sd = b3 ? U2[0] : U2[1]; V = kp + dppf<0x128>(sd); }
    return rows_add16(rows_add32(V));
}
__device__ __forceinline__ float wave_max(float v) {
    v = fmaxf(v, dppf<0xB1>(v)); v = fmaxf(v, dppf<0x4E>(v)); v = fmaxf(v, dppf<0x141>(v)); v = fmaxf(v, dppf<0x140>(v));
    return fmaxf(fmaxf(rdlane(v, 0), rdlane(v, 16)), fmaxf(rdlane(v, 32), rdlane(v, 48)));
}

namespace pg8 {
#define PG8_LAS __attribute__((address_space(3)))
typedef unsigned short bf16_t;
typedef unsigned u32x4 __attribute__((ext_vector_type(4)));
constexpr int BM = 256, BK = 64, HALF = 128, HTB = HALF * BK * 2, STAGE_BYTES = 8 * HTB, NXCD = 8, WGM = 8;
__host__ __device__ __forceinline__ int lds_byte(int r, int c) { const int st = (r >> 4) * 2 + (c >> 5), rr = r & 15, cc = c & 31, ob = rr * 64 + cc * 2; return st * 1024 + (ob ^ (((ob >> 9) & 1) << 5)); }
__host__ __device__ __forceinline__ void stage_rc(int b, int& R, int& C) { const int st = b / 1024, sb = b % 1024, swz = sb ^ (((sb >> 9) & 1) << 5); R = (st >> 1) * 16 + swz / 64; C = (st & 1) * 32 + (swz % 64) / 2; }
__host__ __device__ __forceinline__ int perm32(int rho) { const int n = rho >> 4, i = rho & 15; return 8 * (i >> 2) + 4 * n + (i & 3); }
struct Unit { int pm, pn; };
struct Gemm { const bf16_t* A; const bf16_t* Bt; int M, N, K; };
struct StaticOrder {
    int nM, nN, nwg, G, c;
    __host__ __device__ void init(int M, int N, int G_, int c_) { nM = M / BM; nN = N / BM; nwg = nM * nN; G = G_; c = c_; }
    __host__ __device__ bool next(int i, Unit& u) const {
        const long L = (long)i * G + c; if (L >= nwg) return false;
        int wgid = (int)L; { const int q = nwg / NXCD, r = nwg % NXCD, xcd = wgid % NXCD, off = wgid / NXCD; wgid = (xcd < r ? xcd * (q + 1) : r * (q + 1) + (xcd - r) * q) + off; }
        const int nig = WGM * nN, gid = wgid / nig, fm = gid * WGM, gsz = (nM - fm) < WGM ? (nM - fm) : WGM;
        u.pm = fm + ((wgid % nig) % gsz); u.pn = (wgid % nig) / gsz; return true;
    }
    __device__ __forceinline__ void a_ready(const Unit&) const {}
    __device__ __forceinline__ void done(const Unit&) const {}
};
__device__ __forceinline__ unsigned cvt_pk_bf16(float lo, float hi) { unsigned r; asm volatile("v_cvt_pk_bf16_f32 %0, %1, %2" : "=v"(r) : "v"(lo), "v"(hi)); return r; }
struct EpiBf16 {
    static constexpr bool PERM = true, AFTER_DRAIN = false;
    bf16_t* O; int ldc;
    __device__ __forceinline__ void operator()(const f32x4 (&acc)[2][2][4][2], const Unit& u, int wr, int wc, int fr, int fq) const {
        const int row0 = u.pm * BM + wr * 64 + fr; const int col0 = u.pn * BM + wc * 32 + 8 * fq;
#pragma unroll
        for (int ai = 0; ai < 2; ++ai)
#pragma unroll
            for (int m = 0; m < 4; ++m) { bf16_t* rowp = O + (size_t)(row0 + ai * HALF + m * 16) * ldc + col0;
#pragma unroll
                for (int bj = 0; bj < 2; ++bj) { const f32x4 v0 = acc[ai][bj][m][0], v1 = acc[ai][bj][m][1];
                    u32x4 w; w.x = cvt_pk_bf16(v0[0], v0[1]); w.y = cvt_pk_bf16(v0[2], v0[3]); w.z = cvt_pk_bf16(v1[0], v1[1]); w.w = cvt_pk_bf16(v1[2], v1[3]);
                    *(u32x4*)(rowp + bj * HALF) = w; } }
    }
};
struct EpiBf16Rope {
    static constexpr bool PERM = true, AFTER_DRAIN = false;
    bf16_t* O; int ldc; const float* tab; int seq, pn_lo, pn_hi; const float* rsq;
    __device__ __forceinline__ void operator()(const f32x4 (&acc)[2][2][4][2], const Unit& u, int wr, int wc, int fr, int fq) const {
        const int row0 = u.pm * BM + wr * 64 + fr; const int col0 = u.pn * BM + wc * 32 + 8 * fq;
        float rsv[2][4];
#pragma unroll
        for (int ai = 0; ai < 2; ++ai)
#pragma unroll
            for (int m = 0; m < 4; ++m) rsv[ai][m] = rsq[row0 + ai * HALF + m * 16];
#pragma unroll
        for (int ai = 0; ai < 2; ++ai)
#pragma unroll
            for (int m = 0; m < 4; ++m) rsv[ai][m] = __builtin_amdgcn_rsqf(rsv[ai][m] * (1.f / 1024.f) + 1e-6f);
        if (u.pn < pn_lo || u.pn >= pn_hi) {
#pragma unroll
            for (int ai = 0; ai < 2; ++ai)
#pragma unroll
                for (int m = 0; m < 4; ++m) { bf16_t* rowp = O + (size_t)(row0 + ai * HALF + m * 16) * ldc + col0;
#pragma unroll
                    for (int bj = 0; bj < 2; ++bj) { const f32x4 v0 = acc[ai][bj][m][0] * rsv[ai][m], v1 = acc[ai][bj][m][1] * rsv[ai][m];
                        u32x4 w; w.x = cvt_pk_bf16(v0[0], v0[1]); w.y = cvt_pk_bf16(v0[2], v0[3]); w.z = cvt_pk_bf16(v1[0], v1[1]); w.w = cvt_pk_bf16(v1[2], v1[3]);
                        *(u32x4*)(rowp + bj * HALF) = w; } }
            return;
        }
        const int i0 = (wc & 1) * 16 + 4 * fq;
#pragma unroll
        for (int ai = 0; ai < 2; ++ai) {
            f32x4 cs[4][2];
#pragma unroll
            for (int m = 0; m < 4; ++m) { const int pos = (row0 + ai * HALF + m * 16) & (seq - 1); const float* tp = tab + ((size_t)pos * 32 + i0) * 2;
                cs[m][0] = *(const f32x4*)tp; cs[m][1] = *(const f32x4*)(tp + 4); }
#pragma unroll
            for (int m = 0; m < 4; ++m) { bf16_t* rowp = O + (size_t)(row0 + ai * HALF + m * 16) * ldc + col0;
                const f32x4 c0 = cs[m][0], c1 = cs[m][1];
#pragma unroll
                for (int bj = 0; bj < 2; ++bj) { const f32x4 v0 = acc[ai][bj][m][0] * rsv[ai][m], v1 = acc[ai][bj][m][1] * rsv[ai][m];
                    u32x4 w; w.x = cvt_pk_bf16(v0[0] * c0[0] - v0[1] * c0[1], v0[0] * c0[1] + v0[1] * c0[0]); w.y = cvt_pk_bf16(v0[2] * c0[2] - v0[3] * c0[3], v0[2] * c0[3] + v0[3] * c0[2]);
                    w.z = cvt_pk_bf16(v1[0] * c1[0] - v1[1] * c1[1], v1[0] * c1[1] + v1[1] * c1[0]); w.w = cvt_pk_bf16(v1[2] * c1[2] - v1[3] * c1[3], v1[2] * c1[3] + v1[3] * c1[2]);
                    *(u32x4*)(rowp + bj * HALF) = w; } }
        }
    }
};
struct EpiF32Res {
    static constexpr bool PERM = true, AFTER_DRAIN = false;
    const bf16_t* res; bf16_t* O; int ldc; float* ssq;
    __device__ __forceinline__ void operator()(const f32x4 (&acc)[2][2][4][2], const Unit& u, int wr, int wc, int fr, int fq) const {
        const int row0 = u.pm * BM + wr * 64 + fr; const int col0 = u.pn * BM + wc * 32 + 8 * fq;
#pragma unroll
        for (int ai = 0; ai < 2; ++ai) {
            u32x4 rr[4][2];
#pragma unroll
            for (int m = 0; m < 4; ++m)
#pragma unroll
                for (int bj = 0; bj < 2; ++bj) rr[m][bj] = *(const u32x4*)(res + (size_t)(row0 + ai * HALF + m * 16) * ldc + col0 + bj * HALF);
#pragma unroll
            for (int m = 0; m < 4; ++m) { const int row = row0 + ai * HALF + m * 16; const size_t off = (size_t)row * ldc + col0; float sq = 0.f;
#pragma unroll
                for (int bj = 0; bj < 2; ++bj) { const u32x4 rb = rr[m][bj];
                    const f32x4 r0 = (f32x4){__builtin_bit_cast(float, rb.x << 16), __builtin_bit_cast(float, rb.x & 0xffff0000u), __builtin_bit_cast(float, rb.y << 16), __builtin_bit_cast(float, rb.y & 0xffff0000u)};
                    const f32x4 r1 = (f32x4){__builtin_bit_cast(float, rb.z << 16), __builtin_bit_cast(float, rb.z & 0xffff0000u), __builtin_bit_cast(float, rb.w << 16), __builtin_bit_cast(float, rb.w & 0xffff0000u)};
                    const f32x4 h0 = acc[ai][bj][m][0] + r0, h1 = acc[ai][bj][m][1] + r1;
                    { u32x4 wh; wh.x = cvt_pk_bf16(h0[0], h0[1]); wh.y = cvt_pk_bf16(h0[2], h0[3]); wh.z = cvt_pk_bf16(h1[0], h1[1]); wh.w = cvt_pk_bf16(h1[2], h1[3]);
                      *(u32x4*)(O + off + bj * HALF) = wh; }
                    sq += (h0[0] * h0[0] + h0[1] * h0[1]) + (h0[2] * h0[2] + h0[3] * h0[3]) + (h1[0] * h1[0] + h1[1] * h1[1]) + (h1[2] * h1[2] + h1[3] * h1[3]);
                }
                sq += __shfl_xor(sq, 16); sq += __shfl_xor(sq, 32);
                if (fq == 0) atomicAdd(ssq + row, sq); }
        }
    }
};
struct EpiBf16Rs {
    static constexpr bool PERM = true, AFTER_DRAIN = false;
    bf16_t* O; int ldc; const float* ssq;
    __device__ __forceinline__ void operator()(const f32x4 (&acc)[2][2][4][2], const Unit& u, int wr, int wc, int fr, int fq) const {
        const int row0 = u.pm * BM + wr * 64 + fr; const int col0 = u.pn * BM + wc * 32 + 8 * fq;
        float sqv[2][4];
#pragma unroll
        for (int ai = 0; ai < 2; ++ai)
#pragma unroll
            for (int m = 0; m < 4; ++m) sqv[ai][m] = ssq[row0 + ai * HALF + m * 16];
#pragma unroll
        for (int ai = 0; ai < 2; ++ai)
#pragma unroll
            for (int m = 0; m < 4; ++m) { const int row = row0 + ai * HALF + m * 16; bf16_t* rowp = O + (size_t)row * ldc + col0;
                const float rs = __builtin_amdgcn_rsqf(sqv[ai][m] * (1.f / 1024.f) + 1e-6f);
#pragma unroll
                for (int bj = 0; bj < 2; ++bj) { const f32x4 v0 = acc[ai][bj][m][0] * rs, v1 = acc[ai][bj][m][1] * rs;
                    u32x4 w; w.x = cvt_pk_bf16(v0[0], v0[1]); w.y = cvt_pk_bf16(v0[2], v0[3]); w.z = cvt_pk_bf16(v1[0], v1[1]); w.w = cvt_pk_bf16(v1[2], v1[3]);
                    *(u32x4*)(rowp + bj * HALF) = w; } }
    }
};

template <class Epi, class Sched, bool ALIGN_EPI = false, bool SP2 = false>
__device__ __forceinline__ void gemm_phase(PG8_LAS unsigned char* lds, const Gemm g, const Sched& S, const Epi& E) {
    const int tid = threadIdx.x, wid = __builtin_amdgcn_readfirstlane(tid >> 6), lane = tid & 63, wr = wid >> 2, wc = wid & 3, fr = lane & 15, fq = lane >> 4;
    const int K = g.K, nt = K / BK;
    unsigned voffA[2], voffB[2];
#pragma unroll
    for (int i = 0; i < 2; ++i) { int R, C; stage_rc(tid * 16 + i * 8192, R, C); const int Rb = Epi::PERM ? ((R & ~31) + perm32(R & 31)) : R;
        voffA[i] = (unsigned)(R * K + C) * 2u; voffB[i] = (unsigned)(Rb * K + C) * 2u; }
    const size_t kstep = (size_t)(BK * 2);
    const size_t hstep = (size_t)HALF * K * 2;
    const size_t tstep = 2 * hstep;
    const unsigned ldsw = (unsigned)wid * 1024u;
    const int aoff = lds_byte(wr * 64 + fr, fq * 8), boff = lds_byte(wc * 32 + fr, fq * 8);
#define PG8_SA(b, h) (((b) * 2 + (h)) * HTB)
#define PG8_SB(b, h) ((4 + (b) * 2 + (h)) * HTB)
#define PG8_STAGE(bufoff, gbase, voff) do { _Pragma("unroll") for (int _i = 0; _i < 2; ++_i) \
        __builtin_amdgcn_global_load_lds((const unsigned*)((const char*)(gbase) + (voff)[_i]), (PG8_LAS unsigned*)(lds + (bufoff) + ldsw + _i * 8192), 16, 0, 0); } while (0)
#define PG8_LDA(dst, b, h) do { _Pragma("unroll") for (int m = 0; m < 4; ++m) _Pragma("unroll") for (int k = 0; k < 2; ++k) dst[m][k] = *(const PG8_LAS bf16x8*)(lds + PG8_SA(b, h) + aoff + m * 2048 + k * 1024); } while (0)
#define PG8_LDB(dst, b, h) do { _Pragma("unroll") for (int n = 0; n < 2; ++n) _Pragma("unroll") for (int k = 0; k < 2; ++k) dst[n][k] = *(const PG8_LAS bf16x8*)(lds + PG8_SB(b, h) + boff + n * 2048 + k * 1024); } while (0)
#define PG8_MMA(ai, bj, At, Bt) do { __builtin_amdgcn_s_setprio(1); _Pragma("unroll") for (int m = 0; m < 4; ++m) _Pragma("unroll") for (int n = 0; n < 2; ++n) _Pragma("unroll") for (int k = 0; k < 2; ++k) \
        acc[ai][bj][m][n] = __builtin_amdgcn_mfma_f32_16x16x32_bf16(Bt[n][k], At[m][k], acc[ai][bj][m][n], 0, 0, 0); __builtin_amdgcn_s_setprio(0); } while (0)
#define PG8_WAIT_V(n) asm volatile("s_waitcnt vmcnt(" #n ")" ::: "memory")
#define PG8_WAIT_L(n) asm volatile("s_waitcnt lgkmcnt(" #n ")" ::: "memory")
#define PG8_BAR __builtin_amdgcn_s_barrier()
#define PG8_SCHED __builtin_amdgcn_sched_barrier(0)
    Unit cur, nxt; int ui = 0;
    if (!S.next(0, cur)) return;
    f32x4 acc[2][2][4][2];
#pragma unroll
    for (int a = 0; a < 2; ++a)
#pragma unroll
        for (int b = 0; b < 2; ++b)
#pragma unroll
            for (int m = 0; m < 4; ++m)
#pragma unroll
                for (int n = 0; n < 2; ++n) acc[a][b][m][n] = (f32x4){0.f, 0.f, 0.f, 0.f};
    bf16x8 At[4][2], B0[2][2], B1[2][2];
    const char* cA = (const char*)g.A + (size_t)cur.pm * tstep; const char* cB = (const char*)g.Bt + (size_t)cur.pn * tstep;
    S.a_ready(cur);
    if constexpr (SP2) {
        PG8_STAGE(PG8_SB(0, 0), cB, voffB); PG8_STAGE(PG8_SB(0, 1), cB + hstep, voffB); PG8_STAGE(PG8_SA(0, 0), cA, voffA); PG8_STAGE(PG8_SA(0, 1), cA + hstep, voffA);
        if (wr == 1) PG8_BAR;
        PG8_WAIT_V(2); PG8_BAR;
        PG8_STAGE(PG8_SB(1, 0), cB + kstep, voffB); PG8_STAGE(PG8_SA(1, 0), cA + kstep, voffA); PG8_STAGE(PG8_SB(1, 1), cB + hstep + kstep, voffB);
        PG8_WAIT_V(6); PG8_BAR;
    } else {
        PG8_STAGE(PG8_SB(0, 0), cB, voffB); PG8_STAGE(PG8_SA(0, 0), cA, voffA); PG8_STAGE(PG8_SB(0, 1), cB + hstep, voffB); PG8_STAGE(PG8_SA(0, 1), cA + hstep, voffA);
        if (wr == 1) PG8_BAR;
        PG8_WAIT_V(4); PG8_BAR;
        PG8_STAGE(PG8_SB(1, 0), cB + kstep, voffB); PG8_STAGE(PG8_SA(1, 0), cA + kstep, voffA); PG8_STAGE(PG8_SB(1, 1), cB + hstep + kstep, voffB);
        PG8_WAIT_V(6); PG8_BAR;
    }
    for (;;) {
        const bool has_next = S.next(ui + 1, nxt);
        const char* nA = has_next ? (const char*)g.A + (size_t)nxt.pm * tstep : cA; const char* nB = has_next ? (const char*)g.Bt + (size_t)nxt.pn * tstep : cB;
        for (int t = 0; t < nt; t += 2) {
            const bool last = (t == nt - 2);
            const char* a1 = cA + (size_t)(t + 1) * kstep;
            const char* a2 = last ? nA : cA + (size_t)(t + 2) * kstep; const char* b2 = last ? nB : cB + (size_t)(t + 2) * kstep;
            const char* a3 = a2 + kstep; const char* b3 = b2 + kstep;
            if (last && has_next) S.a_ready(nxt);
            if constexpr (SP2) {
            PG8_LDB(B0, 0, 0); PG8_LDB(B1, 0, 1); PG8_SCHED; PG8_LDA(At, 0, 0); PG8_STAGE(PG8_SA(1, 1), a1 + hstep, voffA);
            PG8_WAIT_V(8); PG8_WAIT_L(0); PG8_BAR; PG8_MMA(0, 0, At, B0); PG8_MMA(0, 1, At, B1); PG8_BAR; PG8_SCHED;
            PG8_LDA(At, 0, 1); PG8_STAGE(PG8_SB(0, 0), b2, voffB); PG8_STAGE(PG8_SB(0, 1), b2 + hstep, voffB); PG8_STAGE(PG8_SA(0, 0), a2, voffA);
            PG8_WAIT_V(8); PG8_WAIT_L(0); PG8_BAR; PG8_MMA(1, 0, At, B0); PG8_MMA(1, 1, At, B1); PG8_BAR; PG8_SCHED;
            PG8_LDB(B0, 1, 0); PG8_LDB(B1, 1, 1); PG8_SCHED; PG8_LDA(At, 1, 0); PG8_STAGE(PG8_SA(0, 1), a2 + hstep, voffA);
            PG8_WAIT_V(8); PG8_WAIT_L(0); PG8_BAR; PG8_MMA(0, 0, At, B0); PG8_MMA(0, 1, At, B1); PG8_BAR; PG8_SCHED;
            PG8_LDA(At, 1, 1); PG8_STAGE(PG8_SB(1, 0), b3, voffB); PG8_STAGE(PG8_SB(1, 1), b3 + hstep, voffB); PG8_STAGE(PG8_SA(1, 0), a3, voffA);
            PG8_WAIT_V(8); PG8_WAIT_L(0); PG8_BAR; PG8_MMA(1, 0, At, B0); PG8_MMA(1, 1, At, B1); PG8_BAR; PG8_SCHED;
            } else {
            PG8_LDB(B0, 0, 0); PG8_SCHED; PG8_LDA(At, 0, 0); PG8_STAGE(PG8_SA(1, 1), a1 + hstep, voffA);
            PG8_WAIT_L(8); PG8_BAR; PG8_WAIT_L(0); PG8_MMA(0, 0, At, B0); PG8_BAR; PG8_SCHED;
            PG8_LDB(B1, 0, 1); PG8_STAGE(PG8_SB(0, 0), b2, voffB);
            PG8_BAR; PG8_WAIT_L(0); PG8_MMA(0, 1, At, B1); PG8_BAR;
            PG8_LDA(At, 0, 1); PG8_STAGE(PG8_SA(0, 0), a2, voffA);
            PG8_BAR; PG8_WAIT_L(0); PG8_MMA(1, 0, At, B0); PG8_BAR; PG8_SCHED;
            PG8_STAGE(PG8_SB(0, 1), b2 + hstep, voffB);
            PG8_WAIT_V(6); PG8_BAR; PG8_MMA(1, 1, At, B1); PG8_BAR;
            PG8_LDB(B0, 1, 0); PG8_SCHED; PG8_LDA(At, 1, 0); PG8_STAGE(PG8_SA(0, 1), a2 + hstep, voffA);
            PG8_WAIT_L(8); PG8_BAR; PG8_WAIT_L(0); PG8_MMA(0, 0, At, B0); PG8_BAR; PG8_SCHED;
            PG8_LDB(B1, 1, 1); PG8_STAGE(PG8_SB(1, 0), b3, voffB);
            PG8_BAR; PG8_WAIT_L(0); PG8_MMA(0, 1, At, B1); PG8_BAR;
            PG8_LDA(At, 1, 1); PG8_STAGE(PG8_SA(1, 0), a3, voffA);
            PG8_BAR; PG8_WAIT_L(0); PG8_MMA(1, 0, At, B0); PG8_BAR; PG8_SCHED;
            PG8_STAGE(PG8_SB(1, 1), b3 + hstep, voffB);
            PG8_WAIT_V(6); PG8_BAR; PG8_MMA(1, 1, At, B1); PG8_BAR;
            }
        }
        if constexpr (ALIGN_EPI) { if (wr == 0) PG8_BAR; }
        if constexpr (!Epi::AFTER_DRAIN) { E(acc, cur, wr, wc, fr, fq); S.done(cur); }
        if (!has_next) break;
#pragma unroll
        for (int a = 0; a < 2; ++a)
#pragma unroll
            for (int b = 0; b < 2; ++b)
#pragma unroll
                for (int m = 0; m < 4; ++m)
#pragma unroll
                    for (int n = 0; n < 2; ++n) acc[a][b][m][n] = (f32x4){0.f, 0.f, 0.f, 0.f};
        cur = nxt; cA = nA; cB = nB; ++ui;
        if constexpr (ALIGN_EPI) { if (wr == 1) PG8_BAR; }
    }
    PG8_WAIT_V(0);
    if constexpr (!ALIGN_EPI) { if (wr == 0) PG8_BAR; }
    PG8_BAR;
#undef PG8_SA
#undef PG8_SB
#undef PG8_STAGE
#undef PG8_LDA
#undef PG8_LDB
#undef PG8_MMA
#undef PG8_WAIT_V
#undef PG8_WAIT_L
#undef PG8_BAR
#undef PG8_SCHED
}
}

#define XB_TMO      128
#define XB_XCNT(j)  (256  + 64 * (j))
#define XB_XSUB(j)  (1280 + 64 * (j))
#define XB_XGEN(j)  (2304 + 64 * (j))
#define XB_TOP      3328
#define XB_TOPGEN   3392
#define XCD_BAR_WORDS 3456
#define XB_SPIN_CAP (1u << 22)
__device__ __forceinline__ unsigned xb_ld(unsigned* p)              { return __hip_atomic_load(p, __ATOMIC_RELAXED, __HIP_MEMORY_SCOPE_AGENT); }
__device__ __forceinline__ unsigned xb_add(unsigned* p, unsigned v) { return __hip_atomic_fetch_add(p, v, __ATOMIC_RELAXED, __HIP_MEMORY_SCOPE_AGENT); }
__device__ __forceinline__ unsigned xb_xcc_id() { return (unsigned)__builtin_amdgcn_s_getreg((3 << 11) | 20) & 0xFu; }
#define XB_SPIN(cond, bar) do { unsigned _sp = 0; while (cond) { __builtin_amdgcn_s_sleep(1); \
    if ((++_sp & 255u) == 0u) { if (xb_ld(&(bar)[XB_TMO])) break; if (_sp > XB_SPIN_CAP) { atomicAdd(&(bar)[XB_TMO], 1u); break; } } } } while (0)
struct XcdBarrier { unsigned* bar; unsigned x; volatile LAS unsigned* st; };
__device__ __forceinline__ XcdBarrier xcd_barrier_post(unsigned* bar, volatile LAS unsigned* st) {
    XcdBarrier b; b.bar = bar; b.x = xb_xcc_id(); b.st = st;
    if (threadIdx.x == 0) (void)xb_add(&bar[XB_XCNT(b.x)], 1u);
    return b;
}
__device__ __forceinline__ void xcd_barrier_complete(unsigned* bar, unsigned x, unsigned& nloc, unsigned& nx) {
    const unsigned G = gridDim.x * gridDim.y * gridDim.z;
    unsigned sum, cnt, mine, sp = 0u;
    for (;;) {
        sum = 0u; cnt = 0u; mine = 0u;
#pragma unroll
        for (unsigned j = 0; j < 16; ++j) { const unsigned c = xb_ld(&bar[XB_XCNT(j)]); sum += c; cnt += (c > 0u) ? 1u : 0u; mine = (j == x) ? c : mine; }
        if (sum == G) break;
        __builtin_amdgcn_s_sleep(1);
        if ((++sp & 255u) == 0u) { if (xb_ld(&bar[XB_TMO])) break; if (sp > XB_SPIN_CAP) { atomicAdd(&bar[XB_TMO], 1u); break; } }
    }
    nloc = mine > 0u ? mine : 1u; nx = cnt > 0u ? cnt : 1u;
}
__device__ __forceinline__ void xcd_barrier(const XcdBarrier& b) {
    asm volatile("s_waitcnt vmcnt(0)" ::: "memory");
    __syncthreads();
    if (threadIdx.x == 0) {
        unsigned* bar = b.bar;
        __builtin_amdgcn_s_waitcnt(0);
        unsigned nloc = b.st[0], nx = b.st[1];
        if (nloc == 0u) { xcd_barrier_complete(bar, b.x, nloc, nx); b.st[0] = nloc; b.st[1] = nx; }
        const unsigned old = xb_add(&bar[XB_XSUB(b.x)], 1u);
        const unsigned gen = old / nloc;
        if (old + 1u == (gen + 1u) * nloc) {
            __builtin_amdgcn_fence(__ATOMIC_RELEASE, "agent");
            asm volatile("s_waitcnt vmcnt(0)" ::: "memory");
            const unsigned og = xb_add(&bar[XB_TOP], 1u);
            const unsigned tg = og / nx;
            if (og + 1u == (tg + 1u) * nx) xb_add(&bar[XB_TOPGEN], 1u);
            else XB_SPIN(xb_ld(&bar[XB_TOPGEN]) == tg, bar);
            __builtin_amdgcn_fence(__ATOMIC_ACQUIRE, "agent");
            xb_add(&bar[XB_XGEN(b.x)], 1u);
            asm volatile("s_waitcnt vmcnt(0)" ::: "memory");
        } else {
            XB_SPIN(xb_ld(&bar[XB_XGEN(b.x)]) == gen, bar);
            __builtin_amdgcn_fence(__ATOMIC_ACQUIRE, "agent");
            asm volatile("s_waitcnt vmcnt(0)" ::: "memory");
        }
    }
    __syncthreads();
}

constexpr int RING_OFF = 0, RING_BYTES = 131072;
constexpr int LDSCTL_OFF = 162816, MISC_OFF = LDSCTL_OFF + 320;
constexpr int LDS_BYTES = 163840;

struct Frame {
    LAS unsigned char* lds;
    volatile LAS unsigned* MISC;
    gu32* ctl;
    int tid, lane, wave, G, wg;
    const float* in[21];
    float* out;
    unsigned char* ws;
};

__device__ __forceinline__ void p0_transpose_item(const float* W, int K, int N, bf16* WT, LAS float* scr, int item, int lane, const float* kscale = nullptr, int rp_lo = 0, int rp_hi = 0) {
    const int nblk = N / 32, kb = item / nblk, nb = item % nblk, k0 = 64 * kb, n0 = 32 * nb;
    const int nn = n0 + (lane & 31), pp = nn & 63; const int ncol = (nn >= rp_lo && nn < rp_hi) ? (nn & ~63) + (pp >> 1) + 32 * (pp & 1) : nn;
    float wv[32];
#pragma unroll
    for (int i = 0; i < 32; ++i) { const int kk = 2 * i + (lane >> 5); wv[i] = W[(size_t)(k0 + kk) * N + ncol] * (kscale ? kscale[k0 + kk] : 1.f); }
#pragma unroll
    for (int i = 0; i < 32; ++i) { const int kk = 2 * i + (lane >> 5); scr[kk * 33 + (lane & 31)] = wv[i]; }
    LDS_WAIT(); asm volatile("" ::: "memory");
    const int c = lane & 7;
#pragma unroll
    for (int j = 0; j < 4; ++j) { const int n = (lane >> 3) + 8 * j; const LAS float* s = scr + (8 * c) * 33 + n;
        v4u o; o.x = pk2(s[0 * 33], s[1 * 33]); o.y = pk2(s[2 * 33], s[3 * 33]); o.z = pk2(s[4 * 33], s[5 * 33]); o.w = pk2(s[6 * 33], s[7 * 33]);
        *(GAS v4u*)(WT + (size_t)(n0 + n) * K + k0 + 8 * c) = o; }
    LDS_WAIT(); asm volatile("" ::: "memory");
}
__device__ __forceinline__ void rms_row_to_bf16(int lane, const float* xrow, const float* gain, bf16* orow) {
    const GAS f32x4* xr = (const GAS f32x4*)xrow + lane;
    const GAS f32x4* gr = (const GAS f32x4*)gain + lane;
    f32x4 v[4]; float s = 0.f;
#pragma unroll
    for (int j = 0; j < 4; ++j) { v[j] = xr[64 * j]; s += (v[j].x * v[j].x + v[j].y * v[j].y) + (v[j].z * v[j].z + v[j].w * v[j].w); }
    const float rstd = frsq(wave_sum(s) * (1.f / DM) + RMS_EPS);
    GAS unsigned long long* o8 = (GAS unsigned long long*)orow + lane;
#pragma unroll
    for (int j = 0; j < 4; ++j) { const f32x4 gg = gr[64 * j];
        o8[64 * j] = (unsigned long long)pk2(v[j].x * rstd * gg.x, v[j].y * rstd * gg.y) | ((unsigned long long)pk2(v[j].z * rstd * gg.z, v[j].w * rstd * gg.w) << 32); }
}
__device__ __forceinline__ void quantize_tables(Frame& F, int gw, int ngw);
__device__ __forceinline__ void p0_prologue(Frame& F) {
    LAS float* scr = (LAS float*)(F.lds + RING_OFF + F.wave * 16384);
    const int gw = F.wg * NWAVES + F.wave, NGW = F.G * NWAVES;
    constexpr int I_IN = (DM / 64) * (IN_COLS / 32), I_OUT = (DM / 64) * (DM / 32), I_Q = (DM / 64) * (PQ / 32);
    constexpr int NITEMS = I_IN + I_OUT + I_Q;
    bf16* win_t = (bf16*)(F.ws + WS_WIN); bf16* wout_t = (bf16*)(F.ws + WS_WOUT); bf16* wq_t = (bf16*)(F.ws + WS_WQ);
    for (int it = gw; it < NITEMS; it += NGW) {
        int r = it;
        if (r < I_IN) { p0_transpose_item(F.in[2], DM, IN_COLS, win_t, scr, r, F.lane, F.in[1], C_AQ, C_AV); continue; } r -= I_IN;
        if (r < I_OUT) { p0_transpose_item(F.in[14], DM, DM, wout_t, scr, r, F.lane); continue; } r -= I_OUT;
        p0_transpose_item(F.in[16], DM, PQ, wq_t, scr, r, F.lane, F.in[15]);
    }
    {
        constexpr int I_W = (64 / 64) * (RWW / 32), I_G = (128 / 64) * (RWW / 32);
        for (int it = gw; it < 2 * I_W + I_G; it += NGW) {
            int r = it;
            if (r < I_W) { p0_transpose_item(F.in[5], 64, RWW, (bf16*)(F.ws + WS_WUPT), scr, r, F.lane); continue; } r -= I_W;
            if (r < I_W) { p0_transpose_item(F.in[7], 64, RWW, (bf16*)(F.ws + WS_AUPT), scr, r, F.lane); continue; } r -= I_W;
            p0_transpose_item(F.in[8], 128, RWW, (bf16*)(F.ws + WS_GUPT), scr, r, F.lane);
        }
    }
    bf16* XN = (bf16*)(F.ws + WS_XN);
    {
        const GAS f32x4* gr = (const GAS f32x4*)F.in[1] + F.lane;
        f32x4 gg[4];
#pragma unroll
        for (int j = 0; j < 4; ++j) gg[j] = gr[64 * j];
#define P0_LD(V, ROW) do { const GAS f32x4* xr_ = (const GAS f32x4*)(F.in[0] + (size_t)(ROW) * DM) + F.lane; _Pragma("unroll") for (int j_ = 0; j_ < 4; ++j_) V[j_] = xr_[64 * j_]; } while (0)
#define P0_ST(V, ROW) do { float s_ = 0.f; _Pragma("unroll") for (int j_ = 0; j_ < 4; ++j_) s_ += (V[j_].x * V[j_].x + V[j_].y * V[j_].y) + (V[j_].z * V[j_].z + V[j_].w * V[j_].w); \
            s_ = wave_sum(s_); if (F.lane == 0) ((float*)(F.ws + WS_SSQ1))[ROW] = s_; GAS unsigned long long* o8_ = (GAS unsigned long long*)(XN + (size_t)(ROW) * DM) + F.lane; \
            _Pragma("unroll") for (int j_ = 0; j_ < 4; ++j_) o8_[64 * j_] = (unsigned long long)pk2(V[j_].x, V[j_].y) | ((unsigned long long)pk2(V[j_].z, V[j_].w) << 32); } while (0)
        if (gw < T) {
            f32x4 A[4], B[4], NA[4], NB[4];
            int m = gw, ra = m, rb = m + NGW < T ? m + NGW : T - 1;
            P0_LD(A, ra); P0_LD(B, rb);
            for (;;) {
                const int m2 = m + 2 * NGW; const bool more = m2 < T;
                const int na = more ? m2 : ra, nb = more ? (m2 + NGW < T ? m2 + NGW : T - 1) : rb;
                P0_LD(NA, na); P0_LD(NB, nb);
                __builtin_amdgcn_sched_barrier(0);
                P0_ST(A, ra); P0_ST(B, rb);
                __builtin_amdgcn_sched_barrier(0);
                if (!more) break;
#pragma unroll
                for (int j = 0; j < 4; ++j) { A[j] = NA[j]; B[j] = NB[j]; }
                ra = na; rb = nb; m = m2;
            }
        }
#undef P0_LD
#undef P0_ST
    }
}

constexpr size_t WS_ROPE = WS_G;
__device__ __forceinline__ void p0_rope_table(Frame& F) {
    f32x2* tab = (f32x2*)(F.ws + WS_ROPE);
    for (int e = F.wg * NTHREADS + F.tid; e < SEQ * 32; e += F.G * NTHREADS) {
        const int sp = e >> 5, i = e & 31;
        const float inv_freq = powf(10000.0f, -(float)(2 * i) / 64.0f);
        const float ang = (float)sp * inv_freq;
        const double r = (double)ang - rint((double)ang * 0.15915494309189535) * 6.283185307179586;
        const float rf = (float)r;
        tab[e] = (f32x2){cosf(rf), sinf(rf)};
    }
}
__device__ __forceinline__ void p2_rope(Frame& F) {
    bf16* Z = (bf16*)(F.ws + WS_Z);
    const f32x2* tab = (const f32x2*)(F.ws + WS_ROPE);
    const int tid = F.tid, tk = tid >> 6, grp = (tid >> 2) & 15, i0 = (tid & 3) * 8;
    for (int blk = F.wg; blk < T / 8; blk += F.G) {
        const int g = blk * 8 + tk, sp = g & (SEQ - 1);
        bf16* p = Z + (size_t)g * IN_COLS + C_AQ + grp * 64 + i0;
        const v4u a = *(const GAS v4u*)p, b = *(const GAS v4u*)(p + 32);
        const GAS f32x4* tp = (const GAS f32x4*)(tab + sp * 32 + i0);
        float x1[8], x2[8];
        x1[0] = bflo(a.x); x1[1] = bfhi(a.x); x1[2] = bflo(a.y); x1[3] = bfhi(a.y); x1[4] = bflo(a.z); x1[5] = bfhi(a.z); x1[6] = bflo(a.w); x1[7] = bfhi(a.w);
        x2[0] = bflo(b.x); x2[1] = bfhi(b.x); x2[2] = bflo(b.y); x2[3] = bfhi(b.y); x2[4] = bflo(b.z); x2[5] = bfhi(b.z); x2[6] = bflo(b.w); x2[7] = bfhi(b.w);
        float o1[8], o2[8];
#pragma unroll
        for (int q = 0; q < 4; ++q) { const f32x4 cs = tp[q];
            o1[2 * q] = x1[2 * q] * cs[0] - x2[2 * q] * cs[1]; o2[2 * q] = x1[2 * q] * cs[1] + x2[2 * q] * cs[0];
            o1[2 * q + 1] = x1[2 * q + 1] * cs[2] - x2[2 * q + 1] * cs[3]; o2[2 * q + 1] = x1[2 * q + 1] * cs[3] + x2[2 * q + 1] * cs[2]; }
        v4u oa, ob; oa.x = pk2(o1[0], o1[1]); oa.y = pk2(o1[2], o1[3]); oa.z = pk2(o1[4], o1[5]); oa.w = pk2(o1[6], o1[7]);
        ob.x = pk2(o2[0], o2[1]); ob.y = pk2(o2[2], o2[3]); ob.z = pk2(o2[4], o2[5]); ob.w = pk2(o2[6], o2[7]);
        *(GAS v4u*)p = oa; *(GAS v4u*)(p + 32) = ob;
    }
}

typedef float f32x16 __attribute__((ext_vector_type(16)));
constexpr int SBS = 144;
constexpr int R1_EPRE = 0, R1_APRE = 16384, R1_AAB = 0, R1_X = 16384;
constexpr int R1_AT = 32768, R1_BT = 41984, R1_KT = 51200, R1_RT = 60416, R1_AHT = R1_BT, R1_U0T = R1_KT;
constexpr int R1_BBT = 69632, R1_KBT = 78848, R1_VT = 88064;
constexpr int R1_ACTW = 97280, R1_ACTA = 106496, R1_AAK = 97280, R1_ARB = 106496, R1_ARK = 115712;
constexpr int R1_BONUS = 124928, R1_WEND = 125184, R1_SEGS = 125440, R1_TII = 125440, R1_END = 129536;
constexpr int R1_PAR = R1_END;
static_assert(R1_PAR + 640 * 4 <= LDSCTL_OFF, "R1 LDS");
__device__ __forceinline__ int crow(int r, int hh) { return (r & 3) + 8 * (r >> 2) + 4 * hh; }
template <int KS> __device__ __forceinline__ f32x16 wtile(const LAS unsigned char* A, int sa, const LAS unsigned char* B, int sb, f32x16 acc, int lane) {
    const int row = lane & 31, hh = lane >> 5;
#pragma unroll
    for (int s = 0; s < KS; ++s) { const bf16x8 a = *(const LAS bf16x8*)(A + row * sa + 32 * s + 16 * hh); const bf16x8 b = *(const LAS bf16x8*)(B + row * sb + 32 * s + 16 * hh);
        acc = __builtin_amdgcn_mfma_f32_32x32x16_bf16(a, b, acc, 0, 0, 0); }
    return acc;
}
__device__ __forceinline__ f32x16 zero16() { f32x16 z;
#pragma unroll
    for (int r = 0; r < 16; ++r) z[r] = 0.f;
    return z; }

struct R1Pre { v4u wd[2], ad[2], z[4]; };
__device__ __forceinline__ int r13_item(int wg, int G, int idx) { return (wg >> 3) * 128 + (wg & 7) * 16 + idx; }
__device__ __forceinline__ int r13_count(int wg, int G) { return 16; }
__device__ __forceinline__ void rwkv_r1_prefetch(Frame& F, int item, int tid, R1Pre& P) {
    const int chain = item >> 7, chunk = item & 127, b = chain >> 3, h = chain & 7, g0 = b * SEQ + chunk * 64;
    const bf16* Z = (const bf16*)(F.ws + WS_Z);
    const v4u z0 = (v4u){0u, 0u, 0u, 0u};
    { const int t = tid >> 3, cg = tid & 7; const bool first = (chunk == 0 && t == 0);
      const bf16* zr = Z + (size_t)(g0 + t) * IN_COLS;
      P.wd[0] = *(const GAS v4u*)(zr + C_WD + cg * 8); P.ad[0] = *(const GAS v4u*)(zr + C_AD + cg * 8);
      P.wd[1] = z0; P.ad[1] = z0;
      if (!first) { P.wd[1] = *(const GAS v4u*)(zr - IN_COLS + C_WD + cg * 8); P.ad[1] = *(const GAS v4u*)(zr - IN_COLS + C_AD + cg * 8); } }
    { const bf16* zt = Z + (size_t)(g0 + (tid >> 3)) * IN_COLS + h * 64 + (tid & 7) * 8;
#pragma unroll
      for (int q = 0; q < 3; ++q) P.z[q] = *(const GAS v4u*)(zt + q * 512);
      P.z[3] = z0;
      if (tid < 24 && chunk != 0) P.z[3] = *(const GAS v4u*)(Z + (size_t)(g0 - 1) * IN_COLS + (tid >> 3) * 512 + h * 64 + (tid & 7) * 8); }
}
constexpr int R1_ZS = R1_AT, R1_ZSS = 384;
static_assert(65 * R1_ZSS <= 4 * 9216, "ZS fits in the At..Rt region");
__device__ __forceinline__ void r1_load_bfrag(Frame& F, int h, int w, int lane, bf16x8 (&bf)[4]) {
    const int p = w >> 2, nt = w & 1; const bf16* upt = (const bf16*)(F.ws + (p == 0 ? WS_WUPT : WS_AUPT)) + (size_t)(h * 64 + nt * 32 + (lane & 31)) * 64 + 8 * (lane >> 5);
#pragma unroll
    for (int s2 = 0; s2 < 4; ++s2) bf[s2] = *(const GAS bf16x8*)(upt + 16 * s2);
}
__device__ __forceinline__ void r1_load_params(Frame& F, int h) {
    LAS float* PAR = (LAS float*)(F.lds + RING_OFF + R1_PAR); const float* mu = F.in[3];
    const int k = F.wave, c = F.lane, col = h * 64 + c;
    const float* src = k == 0 ? mu + C_R : (k == 1 ? mu + C_K : (k == 2 ? mu + C_V : (k == 3 ? F.in[9] : (k == 4 ? F.in[10] : (k == 5 ? F.in[11] : (k == 6 ? F.in[4] : F.in[6]))))));
    PAR[128 + k * 64 + c] = src[col];
    if (k < 2) PAR[k * 64 + c] = mu[(k == 0 ? C_WD : C_AD) + c];
}
constexpr int R1_CF = R1_AAB, R1_CN = R1_X;
__device__ __forceinline__ void rwkv_r1_item(Frame& F, int item, int next_item, R1Pre& P, const bf16x8 (&bfr)[4], f32x4 (&cst)[4]) {
    const int chain = item >> 7, chunk = item & 127, b = chain >> 3, h = chain & 7;
    const int g0 = b * SEQ + chunk * 64;
    int tid_ = F.tid; asm volatile("" : "+v"(tid_));
    const int tid = tid_, lane = tid & 63, w = __builtin_amdgcn_readfirstlane(tid >> 6), hh = lane >> 5, cl = lane & 31;
    const bf16* Z = (const bf16*)(F.ws + WS_Z);
    LAS unsigned char* lds = F.lds + RING_OFF;
    const float* mu = F.in[3];
    {
        const int t = tid >> 3, cg = tid & 7;
        const v4u cw = P.wd[0], ca = P.ad[0], pw = P.wd[1], pa = P.ad[1];
        float fw[8], fa[8], qw[8], qa[8];
        fw[0] = bflo(cw.x); fw[1] = bfhi(cw.x); fw[2] = bflo(cw.y); fw[3] = bfhi(cw.y); fw[4] = bflo(cw.z); fw[5] = bfhi(cw.z); fw[6] = bflo(cw.w); fw[7] = bfhi(cw.w);
        fa[0] = bflo(ca.x); fa[1] = bfhi(ca.x); fa[2] = bflo(ca.y); fa[3] = bfhi(ca.y); fa[4] = bflo(ca.z); fa[5] = bfhi(ca.z); fa[6] = bflo(ca.w); fa[7] = bfhi(ca.w);
        qw[0] = bflo(pw.x); qw[1] = bfhi(pw.x); qw[2] = bflo(pw.y); qw[3] = bfhi(pw.y); qw[4] = bflo(pw.z); qw[5] = bfhi(pw.z); qw[6] = bflo(pw.w); qw[7] = bfhi(pw.w);
        qa[0] = bflo(pa.x); qa[1] = bfhi(pa.x); qa[2] = bflo(pa.y); qa[3] = bfhi(pa.y); qa[4] = bflo(pa.z); qa[5] = bfhi(pa.z); qa[6] = bflo(pa.w); qa[7] = bfhi(pa.w);
        const LAS float* PAR = (const LAS float*)(lds + R1_PAR);
        const f32x4 mw0 = *(const LAS f32x4*)(PAR + cg * 8), mw1 = *(const LAS f32x4*)(PAR + cg * 8 + 4), ma0 = *(const LAS f32x4*)(PAR + 64 + cg * 8), ma1 = *(const LAS f32x4*)(PAR + 64 + cg * 8 + 4);
#pragma unroll
        for (int j = 0; j < 8; ++j) { const float xw = fw[j] + (qw[j] - fw[j]) * (j < 4 ? mw0[j & 3] : mw1[j & 3]);
            const float ex = __expf(2.f * xw); fw[j] = 1.f - 2.f * frcp(ex + 1.f);
            fa[j] = fa[j] + (qa[j] - fa[j]) * (j < 4 ? ma0[j & 3] : ma1[j & 3]); }
        v4u ow, oa; ow.x = pk2(fw[0], fw[1]); ow.y = pk2(fw[2], fw[3]); ow.z = pk2(fw[4], fw[5]); ow.w = pk2(fw[6], fw[7]);
        oa.x = pk2(fa[0], fa[1]); oa.y = pk2(fa[2], fa[3]); oa.z = pk2(fa[4], fa[5]); oa.w = pk2(fa[6], fa[7]);
        *(LAS v4u*)(lds + R1_ACTW + t * SBS + cg * 16) = ow; *(LAS v4u*)(lds + R1_ACTA + t * SBS + cg * 16) = oa;
        { LAS unsigned char* zs_ = lds + R1_ZS + (1 + t) * R1_ZSS + cg * 16;
#pragma unroll
          for (int q = 0; q < 3; ++q) *(LAS v4u*)(zs_ + q * 128) = P.z[q];
          if (tid < 24) *(LAS v4u*)(lds + R1_ZS + tid * 16) = P.z[3]; }
        if (next_item >= 0) rwkv_r1_prefetch(F, next_item, tid, P);
    }
    LDS_BARRIER();
    {
        const int p = w >> 2, mt = (w >> 1) & 1, nt = w & 1;
        f32x16 acc = zero16();
        { const LAS unsigned char* A_ = lds + (p == 0 ? R1_ACTW : R1_ACTA) + mt * 32 * SBS + (lane & 31) * SBS + 16 * hh;
#pragma unroll
          for (int s2 = 0; s2 < 4; ++s2) acc = __builtin_amdgcn_mfma_f32_32x32x16_bf16(*(const LAS bf16x8*)(A_ + 32 * s2), bfr[s2], acc, 0, 0, 0); }
        LAS float* O = (LAS float*)(lds + (p == 0 ? R1_EPRE : R1_APRE));
#pragma unroll
        for (int r = 0; r < 16; ++r) O[(mt * 32 + crow(r, hh)) * 64 + nt * 32 + cl] = acc[r];
    }
    LDS_BARRIER();
    {
        const int c = tid & 63, ts = tid >> 6, col = h * 64 + c;
        const LAS float* PAR = (const LAS float*)(lds + R1_PAR) + 128 + c;
        const float mu_r = PAR[0], mu_k = PAR[64], mu_v = PAR[128], kkc = PAR[192], kac = PAR[256], rkc = PAR[320], w0c = PAR[384], a0c = PAR[448];
        const LAS float* EP = (const LAS float*)(lds + R1_EPRE); const LAS float* AP = (const LAS float*)(lds + R1_APRE);
        LAS float* SEGS = (LAS float*)(lds + R1_SEGS); LAS float* BON = (LAS float*)(lds + R1_BONUS);
        const LAS bf16* zb = (const LAS bf16*)(lds + R1_ZS + (8 * ts) * R1_ZSS) + c;
        float pr = bf2f(zb[0]), pk = bf2f(zb[64]), pv = bf2f(zb[128]);
        float rr[8], k2[8], ai[8], bi[8], vv[8], cs[8]; float run = 0.f;
        float X[16];
#pragma unroll
        for (int i = 0; i < 8; ++i) {
            const float zr = bf2f(zb[(i + 1) * (R1_ZSS / 2)]), zk = bf2f(zb[(i + 1) * (R1_ZSS / 2) + 64]), zv = bf2f(zb[(i + 1) * (R1_ZSS / 2) + 128]);
            const float r = zr + (pr - zr) * mu_r, k = zk + (pk - zk) * mu_k, v = zv + (pv - zv) * mu_v; pr = zr; pk = zk; pv = zv;
            const float e = 0.60653066f * frcp(1.f + __expf(-(w0c + EP[(8 * ts + i) * 64 + c])));
            const float a = frcp(1.f + __expf(-(a0c + AP[(8 * ts + i) * 64 + c])));
            const float kk = k * kkc;
            const float kq = k * (1.f + (a - 1.f) * kac);
            X[2 * i] = kk * kk; X[2 * i + 1] = r * kq * rkc;
            rr[i] = r; k2[i] = kq; ai[i] = kk; bi[i] = a; vv[i] = v; run += e; cs[i] = run;
        }
        SEGS[ts * 64 + c] = run;
        {
            const float V = wave_sum16(X, c);
            const float rnv = frsq(fmaxf(V, 1e-24f));
#pragma unroll
            for (int i = 0; i < 8; ++i) { const float kn = ai[i] * rdlane(rnv, 2 * i); ai[i] = -kn; bi[i] = kn * bi[i]; }
            if (c < 16 && (c & 1)) BON[8 * ts + (c >> 1)] = V;
        }
        LDS_BARRIER();
        float off = 0.f, tot = 0.f;
#pragma unroll
        for (int q = 0; q < 8; ++q) { const float sv = SEGS[q * 64 + c]; tot += sv; off += (q < ts) ? sv : 0.f; }
        float bb[8], kb[8];
        const float wend = __expf(-tot); float Wprev = __expf(-off);
#pragma unroll
        for (int i = 0; i < 8; ++i) { const float L = off + cs[i];
            const float Wi = __expf(-L), iW = frcp(Wi), We = wend * iW, Wm = Wprev; Wprev = Wi;
            bb[i] = bi[i] * We; kb[i] = k2[i] * We;
            ai[i] = ai[i] * Wm; bi[i] = bi[i] * iW; k2[i] = k2[i] * iW; rr[i] = rr[i] * Wi; }
#pragma unroll
        for (int i = 0; i < 8; i += 2) { const int t = 8 * ts + i;
            const unsigned wa = pk2(ai[i], ai[i + 1]), wb = pk2(bi[i], bi[i + 1]), wk = pk2(k2[i], k2[i + 1]), wr = pk2(rr[i], rr[i + 1]);
            *(LAS bf16*)(lds + R1_AT + t * SBS + c * 2) = (bf16)(wa & 0xffffu); *(LAS bf16*)(lds + R1_AT + (t + 1) * SBS + c * 2) = (bf16)(wa >> 16);
            *(LAS bf16*)(lds + R1_BT + t * SBS + c * 2) = (bf16)(wb & 0xffffu); *(LAS bf16*)(lds + R1_BT + (t + 1) * SBS + c * 2) = (bf16)(wb >> 16);
            *(LAS bf16*)(lds + R1_KT + t * SBS + c * 2) = (bf16)(wk & 0xffffu); *(LAS bf16*)(lds + R1_KT + (t + 1) * SBS + c * 2) = (bf16)(wk >> 16);
            *(LAS bf16*)(lds + R1_RT + t * SBS + c * 2) = (bf16)(wr & 0xffffu); *(LAS bf16*)(lds + R1_RT + (t + 1) * SBS + c * 2) = (bf16)(wr >> 16); }
        v4u o; o.x = pk2(bb[0], bb[1]); o.y = pk2(bb[2], bb[3]); o.z = pk2(bb[4], bb[5]); o.w = pk2(bb[6], bb[7]);
        *(LAS v4u*)(lds + R1_BBT + c * SBS + ts * 16) = o;
        o.x = pk2(kb[0], kb[1]); o.y = pk2(kb[2], kb[3]); o.z = pk2(kb[4], kb[5]); o.w = pk2(kb[6], kb[7]);
        *(LAS v4u*)(lds + R1_KBT + c * SBS + ts * 16) = o;
        o.x = pk2(vv[0], vv[1]); o.y = pk2(vv[2], vv[3]); o.z = pk2(vv[4], vv[5]); o.w = pk2(vv[6], vv[7]);
        *(LAS v4u*)(lds + R1_VT + c * SBS + ts * 16) = o;
        if (ts == 0) ((LAS float*)(lds + R1_WEND))[c] = wend;
    }
    LDS_BARRIER();
#pragma unroll
    for (int u = 0; u < 2; ++u) {
        const int idx = w * 2 + u, p = idx >> 2, mt = (idx >> 1) & 1, nt = idx & 1;
        const LAS unsigned char* Aop = lds + ((p == 0 || p == 2) ? R1_BT : R1_KT) + mt * 32 * SBS;
        const LAS unsigned char* Bop = lds + (p < 2 ? R1_AT : R1_RT) + nt * 32 * SBS;
        const int n = nt * 32 + cl;
        f32x16 acc = zero16();
        if (mt <= nt) {
            acc = wtile<4>(Aop, SBS, Bop, SBS, acc, lane);
            if (mt == nt) { const int lim = cl + (p >= 2 ? 1 : 0) - 4 * hh;
#pragma unroll
                for (int r = 0; r < 16; ++r) acc[r] = ((r & 3) + 8 * (r >> 2)) < lim ? acc[r] : 0.f; }
        }
#pragma unroll
        for (int g4 = 0; g4 < 4; ++g4) { const int m0 = mt * 32 + 8 * g4 + 4 * hh;
            if (p == 0) *(LAS f32x4*)(lds + R1_AAB + (n * 64 + m0) * 4) = (f32x4){acc[4 * g4], acc[4 * g4 + 1], acc[4 * g4 + 2], acc[4 * g4 + 3]};
            else { v2u o; o.x = pk2(acc[4 * g4], acc[4 * g4 + 1]); o.y = pk2(acc[4 * g4 + 2], acc[4 * g4 + 3]);
                   *(LAS v2u*)(lds + (p == 1 ? R1_AAK : (p == 2 ? R1_ARB : R1_ARK)) + n * SBS + m0 * 2) = o; } }
    }
    LDS_BARRIER();
    if (w < 4) {
        const int mt = w >> 1, nt = w & 1;
        const f32x16 acc = wtile<4>(lds + R1_AAK + mt * 32 * SBS, SBS, lds + R1_VT + nt * 32 * SBS, SBS, zero16(), lane);
        LAS float* X = (LAS float*)(lds + R1_X);
#pragma unroll
        for (int r = 0; r < 16; ++r) X[(mt * 32 + crow(r, hh)) * 64 + nt * 32 + cl] = acc[r];
    } else if (w == 4) {
        const int bk = lane >> 4, c = lane & 15;
        const LAS float* AAB = (const LAS float*)(lds + R1_AAB);
        float Tc[16]; const float fc = (float)c;
#pragma unroll
        for (int s2 = 0; s2 < 16; ++s2) Tc[s2] = fmaxf(0.f, 1.f - fabsf((float)s2 - fc));
#pragma unroll
        for (int r = 0; r < 15; ++r)
#pragma unroll
            for (int s2 = r + 1; s2 < 16; ++s2) Tc[s2] += AAB[(16 * bk + s2) * 64 + 16 * bk + r] * Tc[r];
        LAS float* TII = (LAS float*)(lds + R1_TII);
#pragma unroll
        for (int s2 = 0; s2 < 16; ++s2) TII[(bk * 16 + s2) * 16 + c] = Tc[s2];
    }
    LDS_BARRIER();
    {
        const int c16 = lane & 15, g = lane >> 4;
        const LAS float* AAB = (const LAS float*)(lds + R1_AAB); const LAS float* TII = (const LAS float*)(lds + R1_TII); const LAS float* X = (const LAS float*)(lds + R1_X);
        f32x4 o[4];
#pragma unroll
        for (int i = 0; i < 4; ++i) {
            f32x4 acc;
            if (w < 4) {
#pragma unroll
                for (int q = 0; q < 4; ++q) acc[q] = bf2f(*(const LAS bf16*)(lds + R1_AT + (16 * i + 4 * g + q) * SBS + (16 * w + c16) * 2));
            } else {
#pragma unroll
                for (int q = 0; q < 4; ++q) acc[q] = X[(16 * i + 4 * g + q) * 64 + 16 * (w - 4) + c16];
            }
#pragma unroll
            for (int j = 0; j < i; ++j) { const f32x4 a4 = *(const LAS f32x4*)(AAB + (16 * i + c16) * 64 + 16 * j + 4 * g);
#pragma unroll
                for (int q = 0; q < 4; ++q) acc = __builtin_amdgcn_mfma_f32_16x16x4f32(a4[q], o[j][q], acc, 0, 0, 0); }
            const f32x4 t4 = *(const LAS f32x4*)(TII + (i * 16 + c16) * 16 + 4 * g);
            f32x4 res = (f32x4){0.f, 0.f, 0.f, 0.f};
#pragma unroll
            for (int q = 0; q < 4; ++q) res = __builtin_amdgcn_mfma_f32_16x16x4f32(t4[q], acc[q], res, 0, 0, 0);
            o[i] = res;
            v2u ov; ov.x = pk2(res[0], res[1]); ov.y = pk2(res[2], res[3]);
            *(LAS v2u*)(lds + (w < 4 ? R1_AHT : R1_U0T) + (16 * (w & 3) + c16) * SBS + (16 * i + 4 * g) * 2) = ov;
        }
    }
    LDS_BARRIER();
    {
        float* Mg = F.out + (size_t)item * 4096; float* NTg = F.out + (size_t)T * RWW + (size_t)item * 4096;
        bf16* Y0g = (bf16*)(F.ws + WS_RWY0) + (size_t)item * 4096; bf16* RHg = (bf16*)(F.ws + WS_RWRH) + (size_t)item * 4096;
#pragma unroll
        for (int u = 0; u < 2; ++u) {
            const int idx = w * 2 + u, p = idx >> 2, mt = (idx >> 1) & 1, nt = idx & 1; const int n = nt * 32 + cl;
            if (p == 0) {
                f32x16 acc = wtile<4>(lds + R1_AHT + mt * 32 * SBS, SBS, lds + R1_BBT + nt * 32 * SBS, SBS, zero16(), lane);
                const float we = ((const LAS float*)(lds + R1_WEND))[n];
                const int dd = cl - 4 * hh;
                LAS unsigned char* fb_ = lds + R1_CF + ((nt * 2 + (cl >> 4)) * 2 + mt) * 2048 + hh * 256 + (cl & 15) * 16;
#pragma unroll
                for (int g4 = 0; g4 < 4; ++g4) { const int m0 = mt * 32 + 8 * g4 + 4 * hh;
                    f32x4 mv = (f32x4){acc[4 * g4], acc[4 * g4 + 1], acc[4 * g4 + 2], acc[4 * g4 + 3]};
                    if (mt == nt) {
#pragma unroll
                        for (int k = 0; k < 4; ++k) mv[k] += (8 * g4 + k == dd) ? we : 0.f; }
                    *(GAS f32x4*)(Mg + n * 64 + m0) = mv;
                    v2u h_; h_.x = pk2(mv[0], mv[1]); h_.y = pk2(mv[2], mv[3]);
                    v2u l_; l_.x = pk2(mv[0] - bflo(h_.x), mv[1] - bfhi(h_.x)); l_.y = pk2(mv[2] - bflo(h_.y), mv[3] - bfhi(h_.y));
                    LAS unsigned char* fp_ = fb_ + (g4 & 1) * 512 + (g4 >> 1) * 8;
                    *(LAS v2u*)fp_ = h_; *(LAS v2u*)(fp_ + 1024) = l_; }
            } else if (p == 1) {
                f32x16 acc = wtile<4>(lds + R1_BBT + mt * 32 * SBS, SBS, lds + R1_U0T + nt * 32 * SBS, SBS, zero16(), lane);
                acc = wtile<4>(lds + R1_KBT + mt * 32 * SBS, SBS, lds + R1_VT + nt * 32 * SBS, SBS, acc, lane);
#pragma unroll
                for (int g4 = 0; g4 < 4; ++g4) { const f32x4 nv_ = (f32x4){acc[4 * g4], acc[4 * g4 + 1], acc[4 * g4 + 2], acc[4 * g4 + 3]};
                    *(GAS f32x4*)(NTg + n * 64 + mt * 32 + 8 * g4 + 4 * hh) = nv_; *(LAS f32x4*)(lds + R1_CN + (n * 64 + mt * 32 + 8 * g4 + 4 * hh) * 4) = nv_; }
            } else if (p == 2) {
                f32x16 acc = wtile<4>(lds + R1_AHT + mt * 32 * SBS, SBS, lds + R1_ARB + nt * 32 * SBS, SBS, zero16(), lane);
#pragma unroll
                for (int g4 = 0; g4 < 4; ++g4) { const int m0 = mt * 32 + 8 * g4 + 4 * hh;
                    const v2u rt = *(const LAS v2u*)(lds + R1_RT + n * SBS + m0 * 2);
                    v2u ov; ov.x = pk2(acc[4 * g4] + bflo(rt.x), acc[4 * g4 + 1] + bfhi(rt.x)); ov.y = pk2(acc[4 * g4 + 2] + bflo(rt.y), acc[4 * g4 + 3] + bfhi(rt.y));
                    *(GAS v2u*)(RHg + n * 64 + m0) = ov; }
            } else {
                f32x16 acc = wtile<4>(lds + R1_U0T + mt * 32 * SBS, SBS, lds + R1_ARB + nt * 32 * SBS, SBS, zero16(), lane);
                acc = wtile<4>(lds + R1_VT + mt * 32 * SBS, SBS, lds + R1_ARK + nt * 32 * SBS, SBS, acc, lane);
#pragma unroll
                for (int g4 = 0; g4 < 4; ++g4) { v2u yb; yb.x = pk2(acc[4 * g4], acc[4 * g4 + 1]); yb.y = pk2(acc[4 * g4 + 2], acc[4 * g4 + 3]); *(GAS v2u*)(Y0g + n * 64 + mt * 32 + 8 * g4 + 4 * hh) = yb; }
            }
        }
        if (tid < 64) ((float*)(F.ws + WS_BONUS))[(size_t)item * 64 + tid] = ((const LAS float*)(lds + R1_BONUS))[tid];
    }
    LDS_BARRIER();
    {
        const int n16 = lane & 15, g = lane >> 4;
        bf16x8 sh[2], sl[2];
#pragma unroll
        for (int ks = 0; ks < 2; ++ks) { const f32x4 a = cst[2 * ks], b = cst[2 * ks + 1];
            v4u h_; h_.x = pk2(a[0], a[1]); h_.y = pk2(a[2], a[3]); h_.z = pk2(b[0], b[1]); h_.w = pk2(b[2], b[3]);
            v4u l_; l_.x = pk2(a[0] - bflo(h_.x), a[1] - bfhi(h_.x)); l_.y = pk2(a[2] - bflo(h_.y), a[3] - bfhi(h_.y)); l_.z = pk2(b[0] - bflo(h_.z), b[1] - bfhi(h_.z)); l_.w = pk2(b[2] - bflo(h_.w), b[3] - bfhi(h_.w));
            sh[ks] = __builtin_bit_cast(bf16x8, h_); sl[ks] = __builtin_bit_cast(bf16x8, l_); }
        f32x4 nw[4];
#pragma unroll
        for (int rt = 0; rt < 4; ++rt) { f32x4 acc = (f32x4){0.f, 0.f, 0.f, 0.f};
            if (w >= 4) acc = *(const LAS f32x4*)(lds + R1_CN + ((16 * (w - 4) + n16) * 64 + 16 * rt + 4 * g) * 4);
#pragma unroll
            for (int ks = 0; ks < 2; ++ks) {
                const bf16x8 mh = *(const LAS bf16x8*)(lds + R1_CF + ((rt * 2 + ks) * 2) * 1024 + lane * 16), ml = *(const LAS bf16x8*)(lds + R1_CF + ((rt * 2 + ks) * 2 + 1) * 1024 + lane * 16);
                acc = __builtin_amdgcn_mfma_f32_16x16x32_bf16(mh, sh[ks], acc, 0, 0, 0);
                acc = __builtin_amdgcn_mfma_f32_16x16x32_bf16(mh, sl[ks], acc, 0, 0, 0);
                acc = __builtin_amdgcn_mfma_f32_16x16x32_bf16(ml, sh[ks], acc, 0, 0, 0); }
            nw[rt] = acc; }
#pragma unroll
        for (int rt = 0; rt < 4; ++rt) cst[rt] = nw[rt];
    }
    LDS_BARRIER();
}

constexpr int R2_RS = 272, R2_SLOT = 2 * 64 * R2_RS;
static_assert(2 * R2_SLOT <= LDSCTL_OFF, "R2 LDS");
template <int NSTEP, int R2_D, bool OUT_BF16 = false> __device__ __forceinline__ void rwkv_scan(Frame& F, const float* Mg, const float* NTg, float* SSg, const float* S0g) {
    int tid_ = F.tid; asm volatile("" : "+v"(tid_));
    const int lane = tid_ & 63, w = __builtin_amdgcn_readfirstlane(tid_ >> 6);
    LAS unsigned char* lds = F.lds + RING_OFF;
    if (w >= 4) {
        const int L = w - 4, r = lane >> 2, f0 = (lane & 3) * 4;
        const size_t goff = (size_t)(16 * L + r) * 64 + f0 * 4;
        const int loff = (16 * L + r) * R2_RS + f0 * 16;
        f32x4 R[R2_D][8];
#define R2_ISSUE(slot_, step_) do { const int st_ = (step_) < NSTEP ? (step_) : NSTEP - 1; const float* mp_ = Mg + (size_t)st_ * 4096 + goff; const float* np_ = NTg + (size_t)st_ * 4096 + goff; \
            _Pragma("unroll") for (int k_ = 0; k_ < 4; ++k_) { R[slot_][k_] = *(const GAS f32x4*)(mp_ + 4 * k_); R[slot_][4 + k_] = *(const GAS f32x4*)(np_ + 4 * k_); } } while (0)
        const int q_ = lane & 3, froff = ((L * 2 + (q_ >> 1)) * 2) * 1024 + r * 16 + (q_ & 1) * 8;
#define R2_WRITE(slot_, buf_) do { LAS unsigned char* d_ = lds + (buf_) * R2_SLOT; \
            _Pragma("unroll") for (int k_ = 0; k_ < 4; ++k_) { const f32x4 a_ = R[slot_][k_]; \
                v2u h_; h_.x = pk2(a_[0], a_[1]); h_.y = pk2(a_[2], a_[3]); \
                v2u l_; l_.x = pk2(a_[0] - bflo(h_.x), a_[1] - bfhi(h_.x)); l_.y = pk2(a_[2] - bflo(h_.y), a_[3] - bfhi(h_.y)); \
                *(LAS v2u*)(d_ + froff + k_ * 256) = h_; *(LAS v2u*)(d_ + froff + 1024 + k_ * 256) = l_; \
                *(LAS f32x4*)(d_ + 64 * R2_RS + loff + 16 * k_) = R[slot_][4 + k_]; } } while (0)
#pragma unroll
        for (int u = 0; u < R2_D; ++u) R2_ISSUE(u, u);
        R2_WRITE(0, 0);
        R2_ISSUE(0, R2_D);
        LDS_BARRIER();
        int c0 = 0;
        for (; c0 + R2_D <= NSTEP - 1; c0 += R2_D) {
#pragma unroll
            for (int u = 0; u < R2_D; ++u) { const int c = c0 + u;
                R2_WRITE((u + 1) % R2_D, (c + 1) & 1);
                R2_ISSUE((u + 1) % R2_D, c + 1 + R2_D);
                LDS_BARRIER(); }
        }
#pragma unroll
        for (int u = 0; u < R2_D; ++u) { const int c = c0 + u;
            if (c < NSTEP - 1) { R2_WRITE((u + 1) % R2_D, (c + 1) & 1); LDS_BARRIER(); } }
        LDS_BARRIER();
#undef R2_ISSUE
#undef R2_WRITE
        return;
    }
    const int n16 = lane & 15, g = lane >> 4;
    f32x4 st[4];
#pragma unroll
    for (int rt = 0; rt < 4; ++rt) st[rt] = S0g ? *(const GAS f32x4*)(S0g + (16 * w + n16) * 64 + 16 * rt + 4 * g) : (f32x4){0.f, 0.f, 0.f, 0.f};
    LDS_BARRIER();
    for (int c = 0; c < NSTEP; ++c) {
#pragma unroll
        for (int rt = 0; rt < 4; ++rt) { const size_t o_ = (size_t)c * 4096 + (16 * w + n16) * 64 + 16 * rt + 4 * g;
            if constexpr (OUT_BF16) { v2u b_; b_.x = pk2(st[rt][0], st[rt][1]); b_.y = pk2(st[rt][2], st[rt][3]); *(GAS v2u*)((bf16*)SSg + o_) = b_; }
            else *(GAS f32x4*)(SSg + o_) = st[rt]; }
        const LAS unsigned char* sl_ = lds + (c & 1) * R2_SLOT;
        bf16x8 sh[2], sl[2];
#pragma unroll
        for (int ks = 0; ks < 2; ++ks) { const f32x4 a = st[2 * ks], b = st[2 * ks + 1];
            v4u h; h.x = pk2(a[0], a[1]); h.y = pk2(a[2], a[3]); h.z = pk2(b[0], b[1]); h.w = pk2(b[2], b[3]);
            v4u l; l.x = pk2(a[0] - bflo(h.x), a[1] - bfhi(h.x)); l.y = pk2(a[2] - bflo(h.y), a[3] - bfhi(h.y)); l.z = pk2(b[0] - bflo(h.z), b[1] - bfhi(h.z)); l.w = pk2(b[2] - bflo(h.w), b[3] - bfhi(h.w));
            sh[ks] = __builtin_bit_cast(bf16x8, h); sl[ks] = __builtin_bit_cast(bf16x8, l); }
        f32x4 nw[4];
#pragma unroll
        for (int rt = 0; rt < 4; ++rt) { f32x4 acc = *(const LAS f32x4*)(sl_ + 64 * R2_RS + (16 * w + n16) * R2_RS + (16 * rt + 4 * g) * 4);
#pragma unroll
            for (int ks = 0; ks < 2; ++ks) {
                const bf16x8 mh = *(const LAS bf16x8*)(sl_ + ((rt * 2 + ks) * 2) * 1024 + lane * 16), ml = *(const LAS bf16x8*)(sl_ + ((rt * 2 + ks) * 2 + 1) * 1024 + lane * 16);
                acc = __builtin_amdgcn_mfma_f32_16x16x32_bf16(mh, sh[ks], acc, 0, 0, 0);
                acc = __builtin_amdgcn_mfma_f32_16x16x32_bf16(mh, sl[ks], acc, 0, 0, 0);
                acc = __builtin_amdgcn_mfma_f32_16x16x32_bf16(ml, sh[ks], acc, 0, 0, 0); }
            nw[rt] = acc; }
#pragma unroll
        for (int rt = 0; rt < 4; ++rt) st[rt] = nw[rt];
        LDS_BARRIER();
    }
#pragma unroll
    for (int rt = 0; rt < 4; ++rt) { const size_t o_ = (size_t)NSTEP * 4096 + (16 * w + n16) * 64 + 16 * rt + 4 * g;
        if constexpr (OUT_BF16) { v2u b_; b_.x = pk2(st[rt][0], st[rt][1]); b_.y = pk2(st[rt][2], st[rt][3]); *(GAS v2u*)((bf16*)SSg + o_) = b_; }
        else *(GAS f32x4*)(SSg + o_) = st[rt]; }
}

constexpr int R3_RH = 0, R3_S = 9216, R3_SG = 18432, R3_SGS = 272, R3_YL = R3_SG + 64 * R3_SGS, R3_GL = R3_YL + 16384, R3_VS = R3_GL + 16384, R3_BON = R3_VS + 65 * 128, R3_END = R3_BON + 256;
constexpr int R3_PAR = R3_END;
static_assert(R3_PAR + 320 * 4 <= LDSCTL_OFF, "R3 LDS");
struct R3Pre { v4u rh; v4u ss; v4u gd[2][2]; v2u y0[2]; v4u vv[2]; float bon; };
__device__ __forceinline__ void rwkv_r3_prefetch(Frame& F, int item, int tid, R3Pre& P) {
    const int chain = item >> 7, chunk = item & 127, b = chain >> 3, h = chain & 7, g0 = b * SEQ + chunk * 64;
    const bf16* Z = (const bf16*)(F.ws + WS_Z);
    const int t = tid >> 3, cg = tid & 7; const v4u z0 = (v4u){0u, 0u, 0u, 0u};
    P.rh = *(const GAS v4u*)((const bf16*)(F.ws + WS_RWRH) + (size_t)item * 4096 + t * 64 + cg * 8);
    P.ss = *(const GAS v4u*)((const bf16*)(F.ws + WS_RWSS) + (size_t)item * 4096 + t * 64 + cg * 8);
    const bf16* zr = Z + (size_t)(g0 + t) * IN_COLS + C_GD + cg * 16; const bool first = (chunk == 0 && t == 0);
#pragma unroll
    for (int q = 0; q < 2; ++q) { P.gd[q][0] = *(const GAS v4u*)(zr + q * 8); P.gd[q][1] = z0; if (!first) P.gd[q][1] = *(const GAS v4u*)(zr - IN_COLS + q * 8); }
    const bf16* Y0g = (const bf16*)(F.ws + WS_RWY0) + (size_t)item * 4096;
    P.y0[0] = *(const GAS v2u*)(Y0g + tid * 4); P.y0[1] = *(const GAS v2u*)(Y0g + (tid + 512) * 4);
#pragma unroll
    for (int q = 0; q < 2; ++q) { const int p = tid + 512 * q; P.vv[q] = z0;
        if (p < 65 * 8) { const int row = p >> 3, ch = p & 7; if (!(chunk == 0 && row == 0)) P.vv[q] = *(const GAS v4u*)(Z + (size_t)(g0 - 1 + row) * IN_COLS + C_V + h * 64 + ch * 8); } }
    P.bon = tid < 64 ? ((const float*)(F.ws + WS_BONUS))[(size_t)item * 64 + tid] : 0.f;
}
__device__ __forceinline__ void r3_load_bfrag(Frame& F, int h, int w, int lane, bf16x8 (&bf)[8]) {
    const int nt = w & 1; const bf16* gut = (const bf16*)(F.ws + WS_GUPT) + (size_t)(h * 64 + nt * 32 + (lane & 31)) * 128 + 8 * (lane >> 5);
#pragma unroll
    for (int s2 = 0; s2 < 8; ++s2) bf[s2] = *(const GAS bf16x8*)(gut + 16 * s2);
}
__device__ __forceinline__ void r3_load_params(Frame& F, int h) {
    LAS float* PAR = (LAS float*)(F.lds + RING_OFF + R3_PAR); const float* mu = F.in[3];
    const int k = F.wave, c = F.lane, col = h * 64 + c;
    if (k < 2) PAR[k * 64 + c] = mu[C_GD + k * 64 + c];
    else if (k < 5) PAR[128 + (k - 2) * 64 + c] = (k == 2 ? mu + C_V : (k == 3 ? F.in[12] : F.in[13]))[col];
}
__device__ __forceinline__ void rwkv_r3_item(Frame& F, int item, int next_item, R3Pre& P, const bf16x8 (&bfr)[8]) {
    const int chain = item >> 7, chunk = item & 127, b = chain >> 3, h = chain & 7;
    const int g0 = b * SEQ + chunk * 64;
    int tid_ = F.tid; asm volatile("" : "+v"(tid_));
    const int tid = tid_, lane = tid & 63, w = __builtin_amdgcn_readfirstlane(tid >> 6), hh = lane >> 5, cl = lane & 31;
    LAS unsigned char* lds = F.lds + RING_OFF;
    const float* mu = F.in[3];
    {
        const int t = tid >> 3, cg = tid & 7;
        *(LAS v4u*)(lds + R3_RH + t * SBS + cg * 16) = P.rh;
        *(LAS v4u*)(lds + R3_S + t * SBS + cg * 16) = P.ss;
#pragma unroll
        for (int q = 0; q < 2; ++q) {
            const v4u cw = P.gd[q][0], pw = P.gd[q][1];
            float fw[8], qw[8];
            fw[0] = bflo(cw.x); fw[1] = bfhi(cw.x); fw[2] = bflo(cw.y); fw[3] = bfhi(cw.y); fw[4] = bflo(cw.z); fw[5] = bfhi(cw.z); fw[6] = bflo(cw.w); fw[7] = bfhi(cw.w);
            qw[0] = bflo(pw.x); qw[1] = bfhi(pw.x); qw[2] = bflo(pw.y); qw[3] = bfhi(pw.y); qw[4] = bflo(pw.z); qw[5] = bfhi(pw.z); qw[6] = bflo(pw.w); qw[7] = bfhi(pw.w);
            const f32x4 mg0 = *(const LAS f32x4*)(lds + R3_PAR + (cg * 16 + q * 8) * 4), mg1 = *(const LAS f32x4*)(lds + R3_PAR + (cg * 16 + q * 8 + 4) * 4);
#pragma unroll
            for (int j = 0; j < 8; ++j) { const float v = fw[j] + (qw[j] - fw[j]) * (j < 4 ? mg0[j & 3] : mg1[j & 3]); fw[j] = frcp(1.f + __expf(-v)); }
            v4u og; og.x = pk2(fw[0], fw[1]); og.y = pk2(fw[2], fw[3]); og.z = pk2(fw[4], fw[5]); og.w = pk2(fw[6], fw[7]);
            *(LAS v4u*)(lds + R3_SG + t * R3_SGS + (cg * 16 + q * 8) * 2) = og;
        }
        *(LAS f32x4*)(lds + R3_YL + tid * 16) = (f32x4){bflo(P.y0[0].x), bfhi(P.y0[0].x), bflo(P.y0[0].y), bfhi(P.y0[0].y)};
        *(LAS f32x4*)(lds + R3_YL + (tid + 512) * 16) = (f32x4){bflo(P.y0[1].x), bfhi(P.y0[1].x), bflo(P.y0[1].y), bfhi(P.y0[1].y)};
#pragma unroll
        for (int q = 0; q < 2; ++q) { const int p = tid + 512 * q; if (p < 65 * 8) *(LAS v4u*)(lds + R3_VS + p * 16) = P.vv[q]; }
        if (tid < 64) ((LAS float*)(lds + R3_BON))[tid] = P.bon;
        if (next_item >= 0) rwkv_r3_prefetch(F, next_item, tid, P);
    }
    LDS_BARRIER();
    {
        const int mt = (w >> 1) & 1, nt = w & 1; const int n = nt * 32 + cl;
        if (w < 4) {
            LAS float* YL = (LAS float*)(lds + R3_YL);
            f32x16 acc;
#pragma unroll
            for (int r = 0; r < 16; ++r) acc[r] = YL[(mt * 32 + crow(r, hh)) * 64 + n];
            acc = wtile<4>(lds + R3_RH + mt * 32 * SBS, SBS, lds + R3_S + nt * 32 * SBS, SBS, acc, lane);
#pragma unroll
            for (int r = 0; r < 16; ++r) YL[(mt * 32 + crow(r, hh)) * 64 + n] = acc[r];
        } else {
            f32x16 acc = zero16();
            { const LAS unsigned char* A_ = lds + R3_SG + mt * 32 * R3_SGS + (lane & 31) * R3_SGS + 16 * hh;
#pragma unroll
              for (int s2 = 0; s2 < 8; ++s2) acc = __builtin_amdgcn_mfma_f32_32x32x16_bf16(*(const LAS bf16x8*)(A_ + 32 * s2), bfr[s2], acc, 0, 0, 0); }
            LAS float* GL = (LAS float*)(lds + R3_GL);
#pragma unroll
            for (int r = 0; r < 16; ++r) GL[(mt * 32 + crow(r, hh)) * 64 + n] = acc[r];
        }
    }
    LDS_BARRIER();
    {
        const int c = tid & 63, ts = tid >> 6, col = h * 64 + c;
        const LAS float* PAR = (const LAS float*)(lds + R3_PAR) + 128 + c;
        const float mu_v = PAR[0], gw = PAR[64], gb = PAR[128];
        const LAS float* YL = (const LAS float*)(lds + R3_YL); const LAS float* GL = (const LAS float*)(lds + R3_GL); const LAS float* BON = (const LAS float*)(lds + R3_BON);
        bf16* Y = (bf16*)(F.ws + WS_YMIX);
        const LAS bf16* vb = (const LAS bf16*)(lds + R3_VS) + (8 * ts) * 64 + c;
        float pv = bf2f(vb[0]);
        float yv[8], X[16];
#pragma unroll
        for (int i = 0; i < 8; ++i) { yv[i] = YL[(8 * ts + i) * 64 + c]; X[2 * i] = yv[i]; X[2 * i + 1] = yv[i] * yv[i]; }
        const float SV_ = wave_sum16(X, c);
        const float meanv = SV_ * (1.f / 64.f);
        const float rstdv = frsq(fmaxf(dppf<0xB1>(SV_) * (1.f / 64.f) - meanv * meanv, 0.f) + GN_EPS);
#pragma unroll
        for (int i = 0; i < 8; ++i) { const int t = 8 * ts + i;
            const float zv = bf2f(vb[(i + 1) * 64]); const float v = zv + (pv - zv) * mu_v; pv = zv;
            const float y = yv[i];
            const float d = y - rdlane(meanv, 2 * i);
            const float yn = d * rdlane(rstdv, 2 * i) * gw + gb;
            const float o = (yn + BON[t] * v) * GL[t * 64 + c];
            Y[(size_t)(g0 + t) * DM + col] = (bf16)f2bf(o); }
    }
    LDS_BARRIER();
}

typedef short s16x4 __attribute__((ext_vector_type(4)));
typedef short v4i16_t __attribute__((ext_vector_type(4)));
constexpr int AT_XO = 0, AT_XO_STRIDE = 136, AT_XM = 512 * AT_XO_STRIDE, AT_XL = AT_XM + 2048, AT_V = AT_XL + 2048, AT_K = AT_V + 8 * 4096, AT_KS = 144, AT_LDS_END = AT_K + 8 * 32 * AT_KS;
static_assert(AT_LDS_END <= LDSCTL_OFF, "attention LDS");
__device__ __forceinline__ float xhalf(float v) { return __shfl_xor(v, 32); }
__device__ __forceinline__ void attn_block(Frame& F, int item) {
    const int bh = item >> 4, blk = item & 15, b = bh >> 3, h = bh & 7, t0 = blk * 512;
    int tid_ = F.tid; asm volatile("" : "+v"(tid_));
    const int lane = tid_ & 63, w = __builtin_amdgcn_readfirstlane(tid_ >> 6), ql = lane & 31, hh = lane >> 5;
    const bf16* Zb = (const bf16*)(F.ws + WS_Z) + (size_t)b * SEQ * IN_COLS;
    bf16* Y = (bf16*)(F.ws + WS_YMIX);
    LAS unsigned char* lds = F.lds + RING_OFF;
    LAS unsigned char* Vw = lds + AT_V + w * 4096;
    LAS unsigned char* Kw = lds + AT_K + w * 32 * AT_KS;
    LAS float* XM = (LAS float*)(lds + AT_XM); LAS float* XL = (LAS float*)(lds + AT_XL);
    constexpr float C2 = 0.125f * 1.4426950408889634f;
    const int lrow = lane >> 3, lch = lane & 7;
    __builtin_amdgcn_s_waitcnt(0x0F70);
#define AT_PARAMS(SI, sh_, d_, rho_, tau_, tkb_) do { const int ps_ = (SI) >> 1; sh_ = ps_ == 0 ? 4 : (ps_ == 1 ? 2 : 0); d_ = 1 << sh_; \
        const int u_ = w + 8 * ((SI) & 1); rho_ = u_ & (d_ - 1); tau_ = u_ >> sh_; tkb_ = t0 + rho_ + (32 * tau_ - 128) * d_; } while (0)
    const GAS char* zb8 = (const GAS char*)Zb;
#define AT_VOFF(d_) ((unsigned)(lrow * (d_)) * (unsigned)(IN_COLS * 2) + (unsigned)(lch * 16))
#define AT_LOADQ(d_, rho_, tau_, vo_) do { const GAS char* sb_ = zb8 + ((size_t)(t0 + rho_ + 32 * tau_ * d_) * IN_COLS + C_AQ + h * 64) * 2; \
        _Pragma("unroll") for (int i_ = 0; i_ < 4; ++i_) qr[i_] = *(const GAS v4u*)(sb_ + (size_t)(i_ * 8 * d_) * (IN_COLS * 2) + vo_); } while (0)
#define AT_LOADT(KT, COL, d_, tkb_, vo_) do { const int tk_ = tkb_ + 32 * (KT) * d_, tc_ = tk_ < 0 ? 0 : tk_; const GAS char* sb_ = zb8 + ((size_t)tc_ * IN_COLS + (COL) + h * 64) * 2; \
        _Pragma("unroll") for (int i_ = 0; i_ < 4; ++i_) R[KT][i_] = *(const GAS v4u*)(sb_ + (size_t)(i_ * 8 * d_) * (IN_COLS * 2) + vo_); } while (0)
    v4u R[5][4], qr[4];
    { int sh, d, rho, tau, tkb; AT_PARAMS(0, sh, d, rho, tau, tkb);
      const unsigned vo = AT_VOFF(d);
      AT_LOADQ(d, rho, tau, vo);
#pragma unroll
      for (int kt = 0; kt < 5; ++kt) AT_LOADT(kt, C_AK, d, tkb, vo); }
#pragma unroll 1
    for (int si = 0; si < 6; ++si) {
        int sh, d, rho, tau, tkb; AT_PARAMS(si, sh, d, rho, tau, tkb);
        const int sn = si < 5 ? si + 1 : 5;
        int sh2, d2, rho2, tau2, tkb2; AT_PARAMS(sn, sh2, d2, rho2, tau2, tkb2);
        const int qoff = rho + (32 * tau + ql) * d;
        const unsigned vo = AT_VOFF(d), vo2 = AT_VOFF(d2);
        bf16x8 qf[4];
#pragma unroll
        for (int i = 0; i < 4; ++i) *(LAS v4u*)(Kw + (i * 8 + lrow) * AT_KS + lch * 16) = qr[i];
#pragma unroll
        for (int s = 0; s < 4; ++s) qf[s] = *(const LAS bf16x8*)(Kw + ql * AT_KS + 32 * s + 16 * hh);
        f32x16 sc[5];
        float m = -INFINITY;
#pragma unroll
        for (int kt = 0; kt < 5; ++kt) {
            const int tk0 = tkb + 32 * kt * d;
            bf16x8 kf[4];
#pragma unroll
            for (int i = 0; i < 4; ++i) *(LAS v4u*)(Kw + (i * 8 + lrow) * AT_KS + lch * 16) = R[kt][i];
            AT_LOADT(kt, C_AV, d, tkb, vo);
#pragma unroll
            for (int s = 0; s < 4; ++s) kf[s] = *(const LAS bf16x8*)(Kw + ql * AT_KS + 32 * s + 16 * hh);
            f32x16 acc = zero16();
#pragma unroll
            for (int s = 0; s < 4; ++s) acc = __builtin_amdgcn_mfma_f32_32x32x16_bf16(kf[s], qf[s], acc, 0, 0, 0);
            if (kt == 0 || kt == 4) {
#pragma unroll
                for (int r = 0; r < 16; ++r) { const int kidx = (r & 3) + 8 * (r >> 2) + 4 * hh;
                    const bool ok = (kt == 0) ? (kidx >= ql) : (kidx <= ql);
                    acc[r] = ok ? acc[r] : -INFINITY; }
            }
            float mt = acc[0];
#pragma unroll
            for (int r = 1; r < 16; ++r) mt = fmaxf(mt, acc[r]);
            m = tk0 < 0 ? m : fmaxf(m, mt);
            sc[kt] = acc;
        }
        m = fmaxf(m, xhalf(m));
        const float ms = m * C2;
        f32x2 l2 = (f32x2){0.f, 0.f};
        unsigned pw[5][8];
#pragma unroll
        for (int kt = 0; kt < 5; ++kt) {
            const float mk = (tkb + 32 * kt * d) < 0 ? INFINITY : ms;
#pragma unroll
            for (int r = 0; r < 8; ++r) {
                const f32x2 t2 = __builtin_elementwise_fma((f32x2){sc[kt][2 * r], sc[kt][2 * r + 1]}, (f32x2){C2, C2}, (f32x2){-mk, -mk});
                const f32x2 p2 = (f32x2){__builtin_amdgcn_exp2f(t2[0]), __builtin_amdgcn_exp2f(t2[1])};
                l2 += p2; pw[kt][r] = pk2(p2[0], p2[1]); }
        }
        float l = l2[0] + l2[1];
        l += xhalf(l);
        AT_LOADQ(d2, rho2, tau2, vo2);
        f32x16 O[2];
#pragma unroll
        for (int r = 0; r < 16; ++r) { O[0][r] = 0.f; O[1][r] = 0.f; }
#pragma unroll
        for (int kt = 0; kt < 5; ++kt) {
#pragma unroll
            for (int i = 0; i < 4; ++i) { const int kidx = i * 8 + lrow;
                *(LAS v4u*)(Vw + kidx * 128 + ((lch ^ (((kidx >> 1) & 1) << 2)) << 4)) = R[kt][i]; }
            AT_LOADT(kt, C_AK, d2, tkb2, vo2);
#pragma unroll
            for (int s = 0; s < 2; ++s) {
                v4u pq; pq.x = pw[kt][4 * s]; pq.y = pw[kt][4 * s + 1]; pq.z = pw[kt][4 * s + 2]; pq.w = pw[kt][4 * s + 3];
                const bf16x8 pf = __builtin_bit_cast(bf16x8, pq);
#pragma unroll
                for (int dt = 0; dt < 2; ++dt) {
                    bf16x8 vf;
#pragma unroll
                    for (int pp = 0; pp < 2; ++pp) {
                        const int i16 = lane & 15, db = (lane >> 4) & 1;
                        const int row = 16 * s + 8 * pp + 4 * hh + (i16 >> 2);
                        const int byte = 64 * dt + 32 * db + 8 * (i16 & 3);
                        const int chunk = (byte >> 4) ^ (((row >> 1) & 1) << 2);
                        const s16x4 t4 = __builtin_bit_cast(s16x4, __builtin_amdgcn_ds_read_tr16_b64_v4i16((LAS v4i16_t*)(Vw + row * 128 + (chunk << 4) + (byte & 15))));
                        vf[4 * pp + 0] = t4[0]; vf[4 * pp + 1] = t4[1]; vf[4 * pp + 2] = t4[2]; vf[4 * pp + 3] = t4[3];
                    }
                    O[dt] = __builtin_amdgcn_mfma_f32_32x32x16_bf16(vf, pf, O[dt], 0, 0, 0);
                }
            }
        }
        LAS unsigned char* xo = lds + AT_XO + qoff * AT_XO_STRIDE + 8 * hh;
        float wa = 0.f, wb = 1.f, Mx = ms, ln = l;
        if (si >= 2) { const float msa = XM[qoff], la = XL[qoff]; Mx = fmaxf(msa, ms); wa = la * __builtin_amdgcn_exp2f(msa - Mx); wb = __builtin_amdgcn_exp2f(ms - Mx); ln = wa + wb * l; }
        const float inv = 1.f / ln;
#pragma unroll
        for (int dt = 0; dt < 2; ++dt)
#pragma unroll
            for (int g4 = 0; g4 < 4; ++g4) {
                LAS v2u* p = (LAS v2u*)(xo + (32 * dt + 8 * g4) * 2);
                float o0 = O[dt][4 * g4] * wb, o1 = O[dt][4 * g4 + 1] * wb, o2 = O[dt][4 * g4 + 2] * wb, o3 = O[dt][4 * g4 + 3] * wb;
                if (si >= 2) { const v2u old = *p; o0 += bflo(old.x) * wa; o1 += bfhi(old.x) * wa; o2 += bflo(old.y) * wa; o3 += bfhi(old.y) * wa; }
                v2u nw; nw.x = pk2(o0 * inv, o1 * inv); nw.y = pk2(o2 * inv, o3 * inv);
                *p = nw;
            }
        if (hh == 0) { XM[qoff] = Mx; XL[qoff] = ln; }
        if (si & 1) LDS_BARRIER();
    }
#undef AT_PARAMS
#undef AT_LOADQ
#undef AT_VOFF
#undef AT_LOADT
#pragma unroll
    for (int i = 0; i < 8; ++i) { const int row = (tid_ >> 3) + 64 * i, ch = tid_ & 7;
        LAS v2u* p = (LAS v2u*)(lds + AT_XO + row * AT_XO_STRIDE + ch * 16);
        const v2u a = p[0], c = p[1];
        v4u o; o.x = a.x; o.y = a.y; o.z = c.x; o.w = c.y;
        *(GAS v4u*)(Y + ((size_t)b * SEQ + t0 + row) * DM + RWW + h * 64 + ch * 8) = o; }
    LDS_BARRIER();
}

__device__ __forceinline__ void quantize_tables(Frame& F, int gw, int ngw) {
    for (int m0 = gw; m0 < 2 * NEXP; m0 += 4 * ngw) {
        f32x4 v[4][4];
#pragma unroll
        for (int r = 0; r < 4; ++r) { const int m = min(m0 + r * ngw, 2 * NEXP - 1); const int tab = m >= NEXP, row = tab ? m - NEXP : m;
            const GAS f32x4* xr = (const GAS f32x4*)(F.in[18 + tab] + (size_t)row * DM) + F.lane * 4;
#pragma unroll
            for (int j = 0; j < 4; ++j) v[r][j] = xr[j]; }
#pragma unroll
        for (int r = 0; r < 4; ++r) { const int m = min(m0 + r * ngw, 2 * NEXP - 1); const int tab = m >= NEXP, row = tab ? m - NEXP : m;
            float am = 0.f;
#pragma unroll
            for (int j = 0; j < 4; ++j) am = fmaxf(am, fmaxf(fmaxf(fabsf(v[r][j].x), fabsf(v[r][j].y)), fmaxf(fabsf(v[r][j].z), fabsf(v[r][j].w))));
            am = wave_max(am);
            const float qmax = tab ? 224.f : 127.f;
            const float sc = am > 0.f ? am / qmax : 1.f, inv = am > 0.f ? qmax / am : 0.f;
            v4u o;
#pragma unroll
            for (int j = 0; j < 4; ++j) {
                if (tab) { int w = __builtin_amdgcn_cvt_pk_fp8_f32(v[r][j].x * inv, v[r][j].y * inv, 0, false); w = __builtin_amdgcn_cvt_pk_fp8_f32(v[r][j].z * inv, v[r][j].w * inv, w, true); o[j] = (unsigned)w; }
                else {
                const unsigned b0 = (unsigned)(int)rintf(v[r][j].x * inv) & 255u, b1 = (unsigned)(int)rintf(v[r][j].y * inv) & 255u,
                               b2 = (unsigned)(int)rintf(v[r][j].z * inv) & 255u, b3 = (unsigned)(int)rintf(v[r][j].w * inv) & 255u;
                o[j] = b0 | (b1 << 8) | (b2 << 16) | (b3 << 24); } }
            *(GAS v4u*)(F.ws + (tab ? WS_VQ : WS_UQ) + (size_t)row * DM + F.lane * 16) = o;
            if (F.lane == 0) ((float*)(F.ws + (tab ? WS_SV : WS_SU)))[row] = sc;
        }
    }
}

__device__ __forceinline__ void p3_mixers(Frame& F) {
    if (F.wg < NB * NHR) {
        const int chain = F.wg;
        const float* Pg = (const float*)(F.ws + WS_PQ) + (size_t)chain * 8 * 4096; const float* Qg = Pg + (size_t)256 * 4096;
        rwkv_scan<7, 3>(F, Pg, Qg, (float*)(F.ws + WS_SSEG) + (size_t)chain * 8 * 4096, nullptr);
        asm volatile("s_waitcnt vmcnt(0)" ::: "memory");
        __syncthreads();
        if (F.tid == 0) {
            __builtin_amdgcn_fence(__ATOMIC_RELEASE, "agent");
            asm volatile("s_waitcnt vmcnt(0)" ::: "memory");
            (void)xb_add((unsigned*)F.ctl + CW_SCAN + 16 * chain, 1u);
        }
    }
#ifndef ATTN_REPS
#define ATTN_REPS 1
#endif
    for (int rep = 0; rep < ATTN_REPS; ++rep)
    if (F.G == 256) { for (int r = 0; r < 2; ++r) { const int v = r * 32 + (F.wg >> 3); attn_block(F, (((F.wg & 7) * 4 + (v >> 4)) << 4) | (v & 15)); } }
    else for (int item = F.wg; item < NB * NHA * (SEQ / 512); item += F.G) attn_block(F, item);
}

constexpr int TK_SKS = 272, TK_SKH = 0, TK_SKL = 2 * 128 * TK_SKS, TK_LUT = 2 * TK_SKL, TK_END = TK_LUT + 8 * 2048;
__device__ __forceinline__ unsigned f2ord(float f) { const unsigned u = __builtin_bit_cast(unsigned, f); return u ^ ((unsigned)((int)u >> 31) | 0x80000000u); }
__device__ __forceinline__ float ord2f(unsigned o) { const unsigned u = (o & 0x80000000u) ? (o ^ 0x80000000u) : ~o; return __builtin_bit_cast(float, u); }
__device__ __forceinline__ void ce_desc(unsigned& a, unsigned& b) { const unsigned mx = a > b ? a : b, mn = a > b ? b : a; a = mx; b = mn; }
template <int N, int OFF, int TOT> __device__ __forceinline__ void bitonic_sort_desc(unsigned (&v)[TOT]) {
#pragma unroll
    for (int k = 2; k <= N; k <<= 1)
#pragma unroll
        for (int j = k >> 1; j > 0; j >>= 1)
#pragma unroll
            for (int i = 0; i < N; ++i) { const int l = i ^ j; if (l > i) { if ((i & k) == 0) ce_desc(v[OFF + i], v[OFF + l]); else ce_desc(v[OFF + l], v[OFF + i]); } }
}
template <int OFFA, int OFFB, int TOT> __device__ __forceinline__ void merge_top16(unsigned (&v)[TOT]) {
#pragma unroll
    for (int i = 0; i < 16; ++i) { const unsigned x = v[OFFA + i], y = v[OFFB + 15 - i]; v[OFFA + i] = x > y ? x : y; }
#pragma unroll
    for (int j = 8; j > 0; j >>= 1)
#pragma unroll
        for (int i = 0; i < 16; ++i) { const int l = i ^ j; if (l > i) ce_desc(v[OFFA + i], v[OFFA + l]); }
}
__device__ __forceinline__ void top16_of_64(unsigned (&k)[64]) {
    bitonic_sort_desc<16, 0, 64>(k); bitonic_sort_desc<16, 16, 64>(k); bitonic_sort_desc<16, 32, 64>(k); bitonic_sort_desc<16, 48, 64>(k);
    merge_top16<0, 16, 64>(k); merge_top16<32, 48, 64>(k); merge_top16<0, 32, 64>(k);
}
#ifndef TK_SPLIT_KEYS
#define TK_SPLIT_KEYS 0
#endif
__device__ __forceinline__ void p7_topk(Frame& F) {
    static_assert(TK_END <= LDSCTL_OFF, "topk LDS");
    const bf16* QP = (const bf16*)(F.ws + WS_QP);
    int* EID = (int*)(F.ws + WS_EID); float* GATE = (float*)(F.ws + WS_GATE);
    const float* sk = F.in[17];
    LAS unsigned char* lds = F.lds + RING_OFF;
    {
        static_assert(2 * 128 * 64 == 32 * NTHREADS, "sub-key staging");
        f32x2 v[32];
#pragma unroll
        for (int j = 0; j < 32; ++j) { const int e = F.tid + j * NTHREADS, c = e >> 13, k = (e >> 6) & 127, d2 = e & 63;
            v[j] = *(const GAS f32x2*)(sk + (size_t)(c * 128 + k) * 128 + 2 * d2); }
#pragma unroll
        for (int j = 0; j < 32; ++j) { const int e = F.tid + j * NTHREADS, c = e >> 13, k = (e >> 6) & 127, d2 = e & 63;
            const unsigned hp = pk2(v[j].x, v[j].y);
            *(LAS unsigned*)(lds + TK_SKH + (c * 128 + k) * TK_SKS + d2 * 4) = hp;
#if TK_SPLIT_KEYS
            *(LAS unsigned*)(lds + TK_SKL + (c * 128 + k) * TK_SKS + d2 * 4) = pk2(v[j].x - bflo(hp), v[j].y - bfhi(hp));
#endif
        }
    }
    __syncthreads();
    const int gw = F.wg * NWAVES + F.wave, NGW = F.G * NWAVES;
    bf16x8 qn[8];
#define TK_QLOAD(TILE, C) do { const int tl_ = (TILE) < T * PHEADS / 32 ? (TILE) : gw; const int P_ = tl_ * 32 + (F.lane & 31); \
        const bf16* qp_ = QP + (size_t)(P_ >> 3) * PQ + (P_ & 7) * 256 + (C) * 128 + 8 * (F.lane >> 5); \
        _Pragma("unroll") for (int s2 = 0; s2 < 8; ++s2) qn[s2] = *(const GAS bf16x8*)(qp_ + 16 * s2); } while (0)
    if (gw < T * PHEADS / 32) TK_QLOAD(gw, 0);
    for (int tile = gw; tile < T * PHEADS / 32; tile += NGW) {
        int lane_ = F.lane; asm volatile("" : "+v"(lane_));
        const int lane = lane_, hh = lane >> 5, cl = lane & 31;
        const int P = tile * 32 + cl, t = P >> 3, h = P & 7;
        unsigned kAB[2][16];
#pragma unroll
        for (int c = 0; c < 2; ++c) {
            bf16x8 qf[8];
#pragma unroll
            for (int s2 = 0; s2 < 8; ++s2) qf[s2] = qn[s2];
            if (c == 0) TK_QLOAD(tile, 1); else TK_QLOAD(tile + NGW, 0);
            unsigned k[64];
#pragma unroll
            for (int mt = 0; mt < 4; ++mt) {
                f32x16 acc = zero16();
                const LAS unsigned char* ah = lds + TK_SKH + (c * 128 + mt * 32 + cl) * TK_SKS + 16 * hh;
                const LAS unsigned char* al = lds + TK_SKL + (c * 128 + mt * 32 + cl) * TK_SKS + 16 * hh;
#pragma unroll
                for (int s2 = 0; s2 < 8; ++s2) {
                    acc = __builtin_amdgcn_mfma_f32_32x32x16_bf16(*(const LAS bf16x8*)(ah + 32 * s2), qf[s2], acc, 0, 0, 0);
#if TK_SPLIT_KEYS
                    acc = __builtin_amdgcn_mfma_f32_32x32x16_bf16(*(const LAS bf16x8*)(al + 32 * s2), qf[s2], acc, 0, 0, 0);
#endif
                }
#pragma unroll
                for (int r = 0; r < 16; ++r) { const int idx = 32 * mt + (r & 3) + 8 * (r >> 2) + 4 * hh; k[mt * 16 + r] = (f2ord(acc[r]) & ~127u) | (unsigned)(127 - idx); }
            }
            top16_of_64(k);
            unsigned m[32];
#pragma unroll
            for (int i = 0; i < 16; ++i) { m[i] = k[i]; m[16 + i] = (unsigned)__shfl_xor((int)k[i], 32); }
            merge_top16<0, 16, 32>(m);
#pragma unroll
            for (int i = 0; i < 16; ++i) kAB[c][i] = m[i];
        }
        float fa[16], fb[16];
#pragma unroll
        for (int i = 0; i < 16; ++i) { fa[i] = ord2f(kAB[0][i] & ~127u); fb[i] = ord2f(kAB[1][i] & ~127u); }
        unsigned cd[64]; int n = 0;
#pragma unroll
        for (int i = 0; i < 16; ++i)
#pragma unroll
            for (int j = 0; j < 16; ++j) if ((i + 1) * (j + 1) <= 16) { cd[n] = (f2ord(fa[i] + fb[j]) & ~255u) | (unsigned)(255 - (i * 16 + j)); ++n; }
#pragma unroll
        for (int q = 50; q < 64; ++q) cd[q] = 0u;
        top16_of_64(cd);
        LAS unsigned char* lut = lds + TK_LUT + (F.wave * 64 + lane) * 32;
#pragma unroll
        for (int q = 0; q < 4; ++q) {
            unsigned wa = 0u, wb = 0u;
#pragma unroll
            for (int b4 = 0; b4 < 4; ++b4) { wa |= (127u - (kAB[0][4 * q + b4] & 127u)) << (8 * b4); wb |= (127u - (kAB[1][4 * q + b4] & 127u)) << (8 * b4); }
            *(LAS unsigned*)(lut + 4 * q) = wa; *(LAS unsigned*)(lut + 16 + 4 * q) = wb; }
        float gv[16]; float den = 0.f; const float mx = ord2f(cd[0] & ~255u);
#pragma unroll
        for (int q = 0; q < 16; ++q) { gv[q] = __expf(ord2f(cd[q] & ~255u) - mx); den += gv[q]; }
        const float inv = 1.f / den;
        asm volatile("s_waitcnt lgkmcnt(0)" ::: "memory");
        int ev[16];
#pragma unroll
        for (int q = 0; q < 16; ++q) { const unsigned pos = 255u - (cd[q] & 255u);
            const unsigned ia = *(const LAS unsigned char*)(lut + (pos >> 4)), ib = *(const LAS unsigned char*)(lut + 16 + (pos & 15u));
            ev[q] = (int)(ia * NKEYS + ib); }
        if (hh == 0) {
            int* ep = EID + (size_t)t * 128 + h * 16; float* gp = GATE + (size_t)t * 128 + h * 16;
#pragma unroll
            for (int q = 0; q < 4; ++q) {
                *(GAS v4u*)(ep + 4 * q) = (v4u){(unsigned)ev[4 * q], (unsigned)ev[4 * q + 1], (unsigned)ev[4 * q + 2], (unsigned)ev[4 * q + 3]};
                *(GAS f32x4*)(gp + 4 * q) = (f32x4){gv[4 * q] * inv, gv[4 * q + 1] * inv, gv[4 * q + 2] * inv, gv[4 * q + 3] * inv}; }
        }
        asm volatile("s_waitcnt lgkmcnt(0)" ::: "memory");
    }
}
#undef TK_QLOAD

constexpr int GA_WAVE_BYTES = 10752, GA_CNT = 4096, GA_OFF = 4096 + 128, GA_ACT = 4608, GA_XQ = 6656;
__device__ __forceinline__ int wave_sum_i(int v) { v += dppi<0xB1>(v); v += dppi<0x4E>(v); v += dppi<0x141>(v); v += dppi<0x140>(v);
    return (__builtin_amdgcn_readlane(v, 0) + __builtin_amdgcn_readlane(v, 16)) + (__builtin_amdgcn_readlane(v, 32) + __builtin_amdgcn_readlane(v, 48)); }
__device__ __forceinline__ void p8_gather(Frame& F, float* outp) {
    const bf16* XN = (const bf16*)(F.ws + WS_HB);
    const unsigned char* UQ = F.ws + WS_UQ; const unsigned char* VQ = F.ws + WS_VQ;
    const float* SU = (const float*)(F.ws + WS_SU); const float* SV = (const float*)(F.ws + WS_SV);
    const int* EID = (const int*)(F.ws + WS_EID); const float* GATE = (const float*)(F.ws + WS_GATE);
    const float* nf = F.in[20];
    const int gw = F.wg * NWAVES + F.wave, NGW = F.G * NWAVES;
    LAS unsigned char* wl = F.lds + RING_OFF + F.wave * GA_WAVE_BYTES;
    for (int tg = gw, sweep = 0; tg < T / 4; tg += NGW, ++sweep) {
        int lane_ = F.lane; asm volatile("" : "+v"(lane_));
        const int lane = lane_;
        int xq[4][4]; float sx[4];
        float gfn[16];
#pragma unroll
        for (int q = 0; q < 4; ++q) { const f32x4 g4 = *(const GAS f32x4*)(F.in[15] + lane * 16 + 4 * q); gfn[4 * q] = g4[0]; gfn[4 * q + 1] = g4[1]; gfn[4 * q + 2] = g4[2]; gfn[4 * q + 3] = g4[3]; }
        v4u xa[4], xb[4]; float ssqv[4];
#pragma unroll
        for (int tk = 0; tk < 4; ++tk) { const GAS v4u* xp = (const GAS v4u*)(XN + (size_t)(4 * tg + tk) * DM + lane * 16); xa[tk] = xp[0]; xb[tk] = xp[1];
            ssqv[tk] = ((const float*)(F.ws + WS_SSQ))[4 * tg + tk]; }
#pragma unroll
        for (int tk = 0; tk < 4; ++tk) {
            const v4u a = xa[tk], b = xb[tk];
            float x[16]; x[0] = bflo(a.x); x[1] = bfhi(a.x); x[2] = bflo(a.y); x[3] = bfhi(a.y); x[4] = bflo(a.z); x[5] = bfhi(a.z); x[6] = bflo(a.w); x[7] = bfhi(a.w);
            x[8] = bflo(b.x); x[9] = bfhi(b.x); x[10] = bflo(b.y); x[11] = bfhi(b.y); x[12] = bflo(b.z); x[13] = bfhi(b.z); x[14] = bflo(b.w); x[15] = bfhi(b.w);
#pragma unroll
            for (int i = 0; i < 16; ++i) x[i] *= gfn[i];
            float am = 0.f;
#pragma unroll
            for (int i = 0; i < 16; ++i) am = fmaxf(am, fabsf(x[i]));
            am = wave_max(am);
            const float rs_ = frsq(ssqv[tk] * (1.f / DM) + RMS_EPS);
            sx[tk] = (am > 0.f ? am * (1.f / 127.f) : 1.f) * rs_; const float inv = am > 0.f ? 127.f / am : 0.f;
#pragma unroll
            for (int q = 0; q < 4; ++q) {
                const unsigned b0 = (unsigned)(int)rintf(x[4 * q] * inv) & 255u, b1 = (unsigned)(int)rintf(x[4 * q + 1] * inv) & 255u, b2 = (unsigned)(int)rintf(x[4 * q + 2] * inv) & 255u, b3 = (unsigned)(int)rintf(x[4 * q + 3] * inv) & 255u;
                xq[tk][q] = (int)(b0 | (b1 << 8) | (b2 << 16) | (b3 << 24)); }
            *(LAS v4u*)(wl + GA_XQ + tk * 1024 + lane * 16) = (v4u){(unsigned)xq[tk][0], (unsigned)xq[tk][1], (unsigned)xq[tk][2], (unsigned)xq[tk][3]};
        }
        LAS unsigned* cnt = (LAS unsigned*)(wl + GA_CNT); LAS unsigned* offs = (LAS unsigned*)(wl + GA_OFF);
        if (lane < 32) cnt[lane] = 0u;
        asm volatile("s_waitcnt lgkmcnt(0)" ::: "memory");
        int ee[8]; float gg[8]; unsigned pos[8];
#pragma unroll
        for (int tk = 0; tk < 4; ++tk) {
            const size_t base = (size_t)(4 * tg + tk) * 128;
            ee[2 * tk] = (EID[base + lane] & (NEXP - 1)) | (tk << 14); ee[2 * tk + 1] = (EID[base + 64 + lane] & (NEXP - 1)) | (tk << 14);
            gg[2 * tk] = GATE[base + lane]; gg[2 * tk + 1] = GATE[base + 64 + lane]; }
#pragma unroll
        for (int q = 0; q < 8; ++q) pos[q] = __hip_atomic_fetch_add(cnt + ((ee[q] >> 9) & 31), 1u, __ATOMIC_RELAXED, __HIP_MEMORY_SCOPE_WAVEFRONT);
        asm volatile("s_waitcnt lgkmcnt(0)" ::: "memory");
        if (lane < 32) {
            const int c0 = (int)cnt[lane]; int v = c0;
            v += __builtin_amdgcn_update_dpp(0, v, 0x111, 0xF, 0xF, true); v += __builtin_amdgcn_update_dpp(0, v, 0x112, 0xF, 0xF, true);
            v += __builtin_amdgcn_update_dpp(0, v, 0x114, 0xF, 0xF, true); v += __builtin_amdgcn_update_dpp(0, v, 0x118, 0xF, 0xF, true);
            const int row0 = __builtin_amdgcn_readlane(v, 15);
            offs[lane] = (unsigned)(v - c0 + (lane >= 16 ? row0 : 0));
        }
        asm volatile("s_waitcnt lgkmcnt(0)" ::: "memory");
#pragma unroll
        for (int q = 0; q < 8; ++q) { const unsigned idx = offs[(ee[q] >> 9) & 31] + pos[q];
            *(LAS unsigned*)(wl + idx * 4) = (unsigned)ee[q]; *(LAS float*)(wl + 2048 + idx * 4) = gg[q]; }
        asm volatile("s_waitcnt lgkmcnt(0)" ::: "memory");
        LAS float* act = (LAS float*)(wl + GA_ACT);
#ifndef UPASS_REPS
#define UPASS_REPS 1
#endif
        for (int urep = 0; urep < UPASS_REPS; ++urep)
        {
            const int grp = lane >> 4, l16 = lane & 15;
            const LAS unsigned* ents = (const LAS unsigned*)wl;
            LAS int* hbuf = (LAS int*)(wl + GA_ACT);
            v4u rb[2][2][4]; unsigned eb[2][2];
#define GA_ULOAD(ST, QD, Q_) do { const unsigned e_ = ents[(Q_) * 4 + grp]; eb[ST][QD] = e_; const GAS v4u* rp_ = (const GAS v4u*)(UQ + (size_t)(e_ & (NEXP - 1)) * DM + l16 * 64); \
                rb[ST][QD][0] = rp_[0]; rb[ST][QD][1] = rp_[1]; rb[ST][QD][2] = rp_[2]; rb[ST][QD][3] = rp_[3]; } while (0)
#define GA_UDOT(ST, QD, Q_) do { const LAS v4u* xp_ = (const LAS v4u*)(wl + GA_XQ + ((eb[ST][QD] >> 14) & 3u) * 1024 + l16 * 64); int d_ = 0; \
                _Pragma("unroll") for (int k_ = 0; k_ < 4; ++k_) { const v4u x_ = xp_[k_], r_ = rb[ST][QD][k_]; \
                    d_ = __builtin_amdgcn_sdot4((int)x_.x, (int)r_.x, d_, false); d_ = __builtin_amdgcn_sdot4((int)x_.y, (int)r_.y, d_, false); \
                    d_ = __builtin_amdgcn_sdot4((int)x_.z, (int)r_.z, d_, false); d_ = __builtin_amdgcn_sdot4((int)x_.w, (int)r_.w, d_, false); } \
                d_ += dppi<0xB1>(d_); d_ += dppi<0x4E>(d_); d_ += dppi<0x141>(d_); d_ += dppi<0x140>(d_); \
                if (l16 == 0) hbuf[(Q_) * 4 + grp] = d_; } while (0)
            GA_ULOAD(0, 0, 0); GA_ULOAD(0, 1, 1);
            for (int q2 = 0; q2 < 128; q2 += 4) {
                GA_ULOAD(1, 0, q2 + 2); GA_ULOAD(1, 1, q2 + 3);
                __builtin_amdgcn_sched_barrier(0);
                GA_UDOT(0, 0, q2); GA_UDOT(0, 1, q2 + 1);
                __builtin_amdgcn_sched_barrier(0);
                if (q2 + 4 < 128) { GA_ULOAD(0, 0, q2 + 4); GA_ULOAD(0, 1, q2 + 5); }
                __builtin_amdgcn_sched_barrier(0);
                GA_UDOT(1, 0, q2 + 2); GA_UDOT(1, 1, q2 + 3);
                __builtin_amdgcn_sched_barrier(0);
            }
#undef GA_ULOAD
#undef GA_UDOT
            asm volatile("s_waitcnt lgkmcnt(0)" ::: "memory");
            float su_[8], sv_[8];
#pragma unroll
            for (int it = 0; it < 8; ++it) { const int ex_ = (int)(ents[it * 64 + lane] & (NEXP - 1)); su_[it] = SU[ex_]; sv_[it] = SV[ex_]; }
#pragma unroll 2
            for (int it = 0; it < 8; ++it) { const int p = it * 64 + lane;
                const unsigned e_ = ents[p]; const float g_ = *(const LAS float*)(wl + 2048 + p * 4); const int hs = hbuf[p];
                const int tk_ = (int)(e_ >> 14) & 3;
                const float sxl = tk_ == 0 ? sx[0] : (tk_ == 1 ? sx[1] : (tk_ == 2 ? sx[2] : sx[3]));
                const float h_ = (float)hs * (su_[it] * sxl);
                act[p] = 0.5f * h_ * (1.f + erff(h_ * 0.70710678118654752f)) * g_ * sv_[it]; }
        }
        asm volatile("s_waitcnt lgkmcnt(0)" ::: "memory");
        float y[4][16];
#pragma unroll
        for (int tk = 0; tk < 4; ++tk) {
#pragma unroll
            for (int i = 0; i < 16; ++i) y[tk][i] = 0.f; }
#define GA_AXPY(V, A, TK) do { \
            _Pragma("unroll") for (int q_ = 0; q_ < 4; ++q_) { const int w_ = (int)(V)[q_]; const f32x2 lo_ = __builtin_amdgcn_cvt_pk_f32_fp8(w_, false), hi_ = __builtin_amdgcn_cvt_pk_f32_fp8(w_, true); \
                y[TK][4 * q_] += (A) * lo_.x; y[TK][4 * q_ + 1] += (A) * lo_.y; y[TK][4 * q_ + 2] += (A) * hi_.x; y[TK][4 * q_ + 3] += (A) * hi_.y; } } while (0)
        for (int ch = 0; ch < 8; ++ch) {
            const unsigned ent = *(const LAS unsigned*)(wl + (ch * 64 + lane) * 4);
            const float areg = act[ch * 64 + lane];
            v4u vb[2][8]; int eb[2][8];
#pragma unroll
            for (int q = 0; q < 8; ++q) { eb[0][q] = __builtin_amdgcn_readlane((int)ent, q); vb[0][q] = *(const GAS v4u*)(VQ + (size_t)(eb[0][q] & (NEXP - 1)) * DM + lane * 16); }
#pragma unroll
            for (int jb = 0; jb < 8; ++jb) {
                if (jb + 1 < 8) {
#pragma unroll
                    for (int q = 0; q < 8; ++q) { eb[(jb + 1) & 1][q] = __builtin_amdgcn_readlane((int)ent, 8 * (jb + 1) + q); vb[(jb + 1) & 1][q] = *(const GAS v4u*)(VQ + (size_t)(eb[(jb + 1) & 1][q] & (NEXP - 1)) * DM + lane * 16); } }
                __builtin_amdgcn_sched_barrier(0);
#pragma unroll
                for (int q = 0; q < 8; ++q) { const int tk_ = (eb[jb & 1][q] >> 14) & 3; const v4u v_ = vb[jb & 1][q]; const float a_ = rdlane(areg, 8 * jb + q);
                    if (tk_ == 0) GA_AXPY(v_, a_, 0); else if (tk_ == 1) GA_AXPY(v_, a_, 1); else if (tk_ == 2) GA_AXPY(v_, a_, 2); else GA_AXPY(v_, a_, 3); }
                __builtin_amdgcn_sched_barrier(0);
            }
        }
#undef GA_AXPY
        v4u hA[4], hB[4]; f32x4 nfv[4];
#pragma unroll
        for (int tk = 0; tk < 4; ++tk) { const GAS v4u* hp = (const GAS v4u*)((const bf16*)(F.ws + WS_HB) + (size_t)(4 * tg + tk) * DM + lane * 16); hA[tk] = hp[0]; hB[tk] = hp[1]; }
#pragma unroll
        for (int q = 0; q < 4; ++q) nfv[q] = *(const GAS f32x4*)(nf + lane * 16 + 4 * q);
#pragma unroll
        for (int tk = 0; tk < 4; ++tk) {
            const v4u ha = hA[tk], hb_ = hB[tk];
            float hv[16]; float ss = 0.f;
            hv[0] = bflo(ha.x); hv[1] = bfhi(ha.x); hv[2] = bflo(ha.y); hv[3] = bfhi(ha.y); hv[4] = bflo(ha.z); hv[5] = bfhi(ha.z); hv[6] = bflo(ha.w); hv[7] = bfhi(ha.w);
            hv[8] = bflo(hb_.x); hv[9] = bfhi(hb_.x); hv[10] = bflo(hb_.y); hv[11] = bfhi(hb_.y); hv[12] = bflo(hb_.z); hv[13] = bfhi(hb_.z); hv[14] = bflo(hb_.w); hv[15] = bfhi(hb_.w);
#pragma unroll
            for (int i = 0; i < 16; ++i) { hv[i] += y[tk][i]; ss += hv[i] * hv[i]; }
            const float rstd = frsq(wave_sum(ss) * (1.f / DM) + RMS_EPS);
#pragma unroll
            for (int q = 0; q < 4; ++q) { const f32x4 n4 = nfv[q];
                *(GAS f32x4*)(outp + (size_t)(4 * tg + tk) * DM + lane * 16 + 4 * q) = (f32x4){hv[4 * q] * rstd * n4[0], hv[4 * q + 1] * rstd * n4[1], hv[4 * q + 2] * rstd * n4[2], hv[4 * q + 3] * rstd * n4[3]}; }
        }
    }
}

struct Args { const float* in[21]; float* out; unsigned char* ws; int ph_lo, ph_hi; };
static_assert(sizeof(Args) == 21 * 8 + 8 + 8 + 8, "Args has no padding");

__global__ void __launch_bounds__(NTHREADS, 2) fwd_kernel(Args args) {
    extern __shared__ __attribute__((aligned(16))) unsigned char lds[];
    Frame F;
    F.lds = (LAS unsigned char*)lds;
    F.MISC = (volatile LAS unsigned*)(F.lds + MISC_OFF);
    F.tid = threadIdx.x; F.lane = F.tid & 63; F.wave = __builtin_amdgcn_readfirstlane(F.tid >> 6);
    F.G = gridDim.x; F.wg = blockIdx.x;
#pragma unroll
    for (int i = 0; i < 21; ++i) F.in[i] = args.in[i];
    F.out = args.out; F.ws = args.ws;
    F.ctl = (gu32*)(args.ws + WS_CTL);
    for (int u = F.tid; u < (LDS_BYTES - LDSCTL_OFF) / 4; u += NTHREADS) ((LAS unsigned*)(F.lds + LDSCTL_OFF))[u] = 0u;
    __syncthreads();
    const int lo = args.ph_lo, hi = args.ph_hi;
    const bool fused = (hi - lo) > 1;
    XcdBarrier bar; bar.bar = (unsigned*)(F.ctl + CW_BAR); bar.x = 0; bar.st = nullptr;
    if (fused) bar = xcd_barrier_post((unsigned*)(F.ctl + CW_BAR), F.MISC + 8);
#define IN(k) (lo <= (k) && (k) < hi)
#define REPS(k) (((REP_MASK >> (k)) & 1) ? 2 : 1)
#define REPLOOP(k) for (int rep_ = 0; rep_ < REPS(k); ++rep_, (rep_ < REPS(k) ? xcd_barrier(bar) : (void)0))
#define SEAM(k) do { if (IN(k) && IN((k) + 1)) xcd_barrier(bar); } while (0)

    if (IN(0)) { REPLOOP(0) { p0_prologue(F); p0_rope_table(F); } SEAM(0); }
    if (IN(1)) { REPLOOP(1) {
        pg8::Gemm g{(const bf16*)(F.ws + WS_XN), (const bf16*)(F.ws + WS_WIN), T, IN_COLS, DM}; pg8::StaticOrder S; S.init(T, IN_COLS, F.G, F.wg);
        pg8::EpiBf16Rope E{(bf16*)(F.ws + WS_Z), IN_COLS, (const float*)(F.ws + WS_ROPE), SEQ, C_AQ / 256, C_AV / 256, (const float*)(F.ws + WS_SSQ1)};
        pg8::gemm_phase<pg8::EpiBf16Rope, pg8::StaticOrder, true, true>(F.lds + RING_OFF, g, S, E); }
        {
            const int nwg = (T / 256) * (IN_COLS / 256), rem = nwg % F.G;
            if (rem == 0) quantize_tables(F, F.wg * NWAVES + F.wave, F.G * NWAVES);
            else if (F.wg >= rem) quantize_tables(F, (F.wg - rem) * NWAVES + F.wave, (F.G - rem) * NWAVES);
        }
        SEAM(1);
    }
    if (IN(2)) { REPLOOP(2) { const int cnt = r13_count(F.wg, F.G); R1Pre P;
            if (cnt > 0) rwkv_r1_prefetch(F, r13_item(F.wg, F.G, 0), F.tid, P);
            bf16x8 bfr[4]; int hcur = -1;
            f32x4 cst[4];
            { const int n16 = F.lane & 15, g = F.lane >> 4;
#pragma unroll
              for (int rt = 0; rt < 4; ++rt)
#pragma unroll
                  for (int q = 0; q < 4; ++q) cst[rt][q] = (F.wave < 4 && 16 * rt + 4 * g + q == 16 * F.wave + n16) ? 1.f : 0.f; }
            for (int i = 0; i < cnt; ++i) { const int it = r13_item(F.wg, F.G, i), hh_ = (it >> 7) & 7;
                if (hh_ != hcur) { r1_load_bfrag(F, hh_, F.wave, F.lane, bfr); __syncthreads(); r1_load_params(F, hh_); __syncthreads(); hcur = hh_; }
                rwkv_r1_item(F, it, i + 1 < cnt ? r13_item(F.wg, F.G, i + 1) : -1, P, bfr, cst); }
            { const int n16 = F.lane & 15, g = F.lane >> 4; float* Pg = (float*)(F.ws + WS_PQ) + (size_t)F.wg * 4096; float* Qg = Pg + (size_t)256 * 4096;
              if (F.wave < 4) {
#pragma unroll
                  for (int rt = 0; rt < 4; ++rt)
#pragma unroll
                      for (int q = 0; q < 4; ++q) Pg[(16 * rt + 4 * g + q) * 64 + 16 * F.wave + n16] = cst[rt][q];
              } else {
#pragma unroll
                  for (int rt = 0; rt < 4; ++rt) *(GAS f32x4*)(Qg + (16 * (F.wave - 4) + n16) * 64 + 16 * rt + 4 * g) = cst[rt];
              } } }
        SEAM(2); }
    if (IN(3)) { REPLOOP(3) p3_mixers(F); }
    if (IN(4)) { REPLOOP(4) { const int cnt = r13_count(F.wg, F.G); R3Pre P;
            asm volatile("s_waitcnt vmcnt(0)" ::: "memory");
            __syncthreads();
            if (F.tid == 0) { unsigned* fl = (unsigned*)F.ctl + CW_SCAN + 16 * (F.wg >> 3); XB_SPIN(xb_ld(fl) == 0u, (unsigned*)(F.ctl + CW_BAR)); __builtin_amdgcn_fence(__ATOMIC_ACQUIRE, "agent"); }
            __syncthreads();
            {
                const int item0 = r13_item(F.wg, F.G, 0);
                rwkv_scan<15, 7, true>(F, F.out + (size_t)item0 * 4096, F.out + (size_t)T * RWW + (size_t)item0 * 4096, (float*)((bf16*)(F.ws + WS_RWSS) + (size_t)item0 * 4096), (const float*)(F.ws + WS_SSEG) + (size_t)F.wg * 4096);
                asm volatile("s_waitcnt vmcnt(0)" ::: "memory"); __syncthreads();
            }
            if (cnt > 0) rwkv_r3_prefetch(F, r13_item(F.wg, F.G, 0), F.tid, P);
            bf16x8 bfr[8]; int hcur = -1;
            for (int i = 0; i < cnt; ++i) { const int it = r13_item(F.wg, F.G, i), hh_ = (it >> 7) & 7;
                if (hh_ != hcur) { r3_load_bfrag(F, hh_, F.wave, F.lane, bfr); __syncthreads(); r3_load_params(F, hh_); __syncthreads(); hcur = hh_; }
                rwkv_r3_item(F, it, i + 1 < cnt ? r13_item(F.wg, F.G, i + 1) : -1, P, bfr); } }
        SEAM(4); }
    if (IN(5)) {
        pg8::Gemm g{(const bf16*)(F.ws + WS_YMIX), (const bf16*)(F.ws + WS_WOUT), T, DM, DM}; pg8::StaticOrder S; S.init(T, DM, F.G, F.wg);
        pg8::EpiF32Res E{(const bf16*)(F.ws + WS_XN), (bf16*)(F.ws + WS_HB), DM, (float*)(F.ws + WS_SSQ)};
        pg8::gemm_phase<pg8::EpiF32Res, pg8::StaticOrder, true, true>(F.lds + RING_OFF, g, S, E);
        SEAM(5);
    }
    if (IN(6)) { REPLOOP(6) {
        pg8::Gemm g{(const bf16*)(F.ws + WS_HB), (const bf16*)(F.ws + WS_WQ), T, PQ, DM}; pg8::StaticOrder S; S.init(T, PQ, F.G, F.wg);
        pg8::EpiBf16Rs E{(bf16*)(F.ws + WS_QP), PQ, (const float*)(F.ws + WS_SSQ)};
        pg8::gemm_phase<pg8::EpiBf16Rs, pg8::StaticOrder, true, true>(F.lds + RING_OFF, g, S, E); }
        SEAM(6);
    }
    if (IN(7)) { REPLOOP(7) p7_topk(F); if (IN(8)) { asm volatile("s_waitcnt vmcnt(0)" ::: "memory"); __syncthreads(); } }
    if (IN(8)) { if (REPS(8) > 1) { p8_gather(F, (float*)(F.ws + WS_Z)); xcd_barrier(bar); } p8_gather(F, F.out); }
#undef IN
#undef SEAM
}

extern "C" void kernel_launch(void* const* d_in, const int* in_sizes, int n_in, void* d_out, int out_size, void* d_ws, size_t ws_size, hipStream_t stream) {
    static int grid = 0;
    if (grid == 0) {
        if (n_in != 21 || in_sizes[0] != T * DM || out_size != T * DM || ws_size < WS_END) {
            fprintf(stderr, "kernel_launch: unexpected shapes: n_in %d in0 %d out %d ws %zu (need %zu); nothing launched\n", n_in, n_in > 0 ? in_sizes[0] : -1, out_size, ws_size, (size_t)WS_END); grid = -1; return; }
        int dev = 0, cus = 0, per_cu = 0;
        if (hipGetDevice(&dev) != hipSuccess || hipDeviceGetAttribute(&cus, hipDeviceAttributeMultiprocessorCount, dev) != hipSuccess) { grid = -1; return; }
        if (hipFuncSetAttribute((const void*)fwd_kernel, hipFuncAttributeMaxDynamicSharedMemorySize, LDS_BYTES) != hipSuccess) { fprintf(stderr, "kernel_launch: hipFuncSetAttribute failed\n"); grid = -1; return; }
        if (hipOccupancyMaxActiveBlocksPerMultiprocessor(&per_cu, (const void*)fwd_kernel, NTHREADS, LDS_BYTES) != hipSuccess || per_cu < 1) { fprintf(stderr, "kernel_launch: occupancy query says %d\n", per_cu); per_cu = 1; }
        (void)hipGetLastError();
        grid = cus;
        if (cus != 256) { fprintf(stderr, "kernel_launch: the RWKV segment mapping assumes 256 CUs (got %d); nothing launched\n", cus); grid = -1; return; }
    }
    if (grid < 0) return;
    (void)hipMemsetAsync((char*)d_ws + WS_CTL, 0, CTL_ZERO_BYTES, stream);
    Args a{};
    for (int i = 0; i < 21; ++i) a.in[i] = (const float*)d_in[i];
    a.out = (float*)d_out; a.ws = (unsigned char*)d_ws;
    if (MK_N_LAUNCHES == 1) {
        a.ph_lo = 0; a.ph_hi = NPHASE;
        void* kargs[] = {&a};
        hipError_t e = hipLaunchCooperativeKernel((const void*)fwd_kernel, dim3(grid), dim3(NTHREADS), kargs, LDS_BYTES, stream);
        if (e != hipSuccess) fprintf(stderr, "kernel_launch: cooperative launch failed: %s (grid %d)\n", hipGetErrorString(e), grid);
    } else {
        for (int p = 0; p < NPHASE; ++p) { a.ph_lo = p; a.ph_hi = p + 1;
            hipLaunchKernelGGL(fwd_kernel, dim3(grid), dim3(NTHREADS), LDS_BYTES, stream, a); }
    }
}
```
